# Optimizing an MI355X kernel written in HIP

```python
import math
import jax, jax.numpy as jnp
from jax import lax
import numpy as np

D_MODEL = 2048
BATCH = 4
SEQ = 4096
DEPTH = 4

GRID_W = 64
CTX_LEN = 256
N_BRANCH = 3
BRANCH_W = 1024
HY_W = 1024
HY_ORDER = 2
HY_EMB = 33
HY_HID = 64
HY_FAST = 0.3
HY_SLOW = 1.5
HY_TARGET = 1e-2
RET_HEADS = 8
RET_DK = 64
RET_DV = 128
RET_CHUNK = 128
NA_HEADS = 8
NA_DH = 128
NA_WR = 8
NA_WC = 16
D_FF = 5632
ROPE_BASE = 10000.0
EPS = 1e-6
NEG = -1e30

RET_QK_W = RET_HEADS * RET_DK
RET_V_W = RET_HEADS * RET_DV
NA_W = NA_HEADS * NA_DH
IN_SPLIT = (RET_QK_W, RET_V_W, NA_W, NA_W, RET_QK_W, RET_V_W, NA_W, (HY_ORDER + 1) * HY_W, N_BRANCH * D_MODEL)
CTX_STATE_W = RET_QK_W + RET_V_W + 2 * NA_W
IN_W = sum(IN_SPLIT)

kernel_name = "hybrid_hyena_retention_natten_dit"

F32 = jnp.float32


def _split(z, sizes):
    idx = np.cumsum(sizes)[:-1].tolist()
    return jnp.split(z, idx, axis=-1)


def _heads(a, h):
    return a.reshape(a.shape[0], a.shape[1], h, -1)


def _bhld(a):
    return a.transpose(0, 2, 1, 3)


def rmsnorm(x, g):
    xf = x.astype(F32)
    y = xf * lax.rsqrt(jnp.mean(xf * xf, axis=-1, keepdims=True) + EPS)
    return (y * g.astype(F32)).astype(x.dtype)


def modulate(h, shift, scale):
    return h * (1.0 + scale) + shift


def dwconv3(x, w, b):
    xp = jnp.pad(x, ((0, 0), (1, 1), (0, 0)))
    return xp[:, :-2] * w[0] + xp[:, 1:-1] * w[1] + xp[:, 2:] * w[2] + b


def axial_rope(x, rows, cols):
    d = x.shape[-1]
    half = d // 2
    n = half // 2
    inv = ROPE_BASE ** (-jnp.arange(n, dtype=F32) / n)

    def rot(xp, pos):
        ang = pos.astype(F32)[:, None] * inv[None]
        cos = jnp.cos(ang)[None, :, None, :]
        sin = jnp.sin(ang)[None, :, None, :]
        x1, x2 = xp[..., :n].astype(F32), xp[..., n:].astype(F32)
        return jnp.concatenate([x1 * cos - x2 * sin, x2 * cos + x1 * sin], axis=-1)

    return jnp.concatenate([rot(x[..., :half], rows), rot(x[..., half:], cols)], axis=-1).astype(x.dtype)


def hyena_filter_fft(L, w1, b1, w2, b2, w3, freq):
    t = jnp.linspace(0.0, 1.0, L, dtype=F32)[:, None]
    bands = (HY_EMB - 1) // 2
    w = 2.0 * math.pi * jnp.arange(L, dtype=F32)[:, None] / L
    fr = jnp.linspace(1e-4, bands - 1, bands, dtype=F32)[None]
    feat = jnp.concatenate([t, jnp.cos(fr * w), -jnp.sin(fr * w)], axis=-1)
    fq = freq.astype(F32)
    h = jnp.sin(fq * (feat @ w1.astype(F32) + b1.astype(F32)))
    h = jnp.sin(fq * (h @ w2.astype(F32) + b2.astype(F32)))
    h = (h @ w3.astype(F32)).reshape(L, HY_ORDER, 2, HY_W)
    deltas = jnp.abs(jnp.linspace(math.log(HY_TARGET) / HY_FAST, math.log(HY_TARGET) / HY_SLOW, HY_W, dtype=F32))
    h = h * jnp.exp(-t * deltas[None])[:, None, None, :]
    fwd, bwd = h[:, :, 0], h[:, :, 1]
    k = jnp.concatenate([fwd, jnp.zeros((1, HY_ORDER, HY_W), F32), bwd[:0:-1]], axis=0)
    k = k * lax.rsqrt(jnp.sum(k * k, axis=0, keepdims=True) + EPS)
    return jnp.fft.rfft(k, axis=0)


def hyena_mixer(z, conv_w, conv_b, kf, bias):
    L = z.shape[1]
    parts = jnp.split(dwconv3(z, conv_w, conv_b), HY_ORDER + 1, axis=-1)
    y = parts[-1].astype(F32)
    for o in range(HY_ORDER):
        yf = jnp.fft.rfft(y, n=2 * L, axis=1)
        conv = jnp.fft.irfft(yf * kf[None, :, o, :], n=2 * L, axis=1)[:, :L]
        y = parts[o].astype(F32) * (conv + bias[o].astype(F32) * y)
    return y.astype(z.dtype)


def ret_chunks(q, k, v, log_g, s0, strict):
    B, H, L, dk = q.shape
    dv = v.shape[-1]
    C = RET_CHUNK
    N = L // C
    qc = q.reshape(B, H, N, C, dk)
    kc = k.reshape(B, H, N, C, dk)
    vc = v.reshape(B, H, N, C, dv)
    pos = jnp.arange(C, dtype=F32)
    rel = pos[:, None] - pos[None, :]
    mask = (rel > 0) if strict else (rel >= 0)
    dmat = jnp.where(mask[None], jnp.exp(jnp.maximum(rel, 0.0)[None] * log_g[:, None, None]), 0.0)
    a = jnp.einsum('bhncd,bhnsd->bhncs', qc, kc) * dmat[None, :, None]
    o = jnp.einsum('bhncs,bhnse->bhnce', a, vc)
    zeta = jnp.exp((C - 1 - pos)[None] * log_g[:, None])
    kv = jnp.einsum('bhncd,bhnce->nbhde', kc * zeta[None, :, None, :, None], vc)
    g_chunk = jnp.exp(C * log_g)[None, :, None, None]

    def step(s, kv_n):
        return g_chunk * s + kv_n, s

    s_fin, s_prev = lax.scan(step, s0, kv)
    xi = jnp.exp((pos + 1)[None] * log_g[:, None])
    o = o + jnp.einsum('bhncd,nbhde->bhnce', qc * xi[None, :, None, :, None], s_prev)
    return o.reshape(B, H, L, dv), s_fin


def ret_final_state(k, v, log_g):
    L = k.shape[2]
    w = jnp.exp((L - 1 - jnp.arange(L, dtype=F32))[None] * log_g[:, None])
    return jnp.einsum('bhld,bhle->bhde', k * w[None, :, :, None], v)


def ret_bidir(q, k, v, log_g, s0_f, s0_b):
    flip = lambda a: a[:, :, ::-1]
    o_f, s_f = ret_chunks(q, k, v, log_g[0], s0_f, False)
    o_b, s_b = ret_chunks(flip(q), flip(k), flip(v), log_g[1], s0_b, True)
    return o_f + flip(o_b), s_f, s_b


def ret_output(o, g):
    o = o * lax.rsqrt(jnp.mean(o * o, axis=-1, keepdims=True) + EPS)
    B, H, L, dv = o.shape
    o = o.transpose(0, 2, 1, 3).reshape(B, L, H * dv)
    return (jax.nn.silu(g.astype(F32)) * o).astype(g.dtype)


def neighbourhood_attn(q, k, v, kc, vc, rpb):
    B, L, H, dh = q.shape
    R = L // GRID_W
    wr = min(NA_WR, R)
    grid = lambda a: a.reshape(B, R, GRID_W, H, dh).transpose(0, 3, 1, 2, 4)
    qg, kg, vg = grid(q), grid(k), grid(v)
    r = jnp.arange(R)
    rs = jnp.clip(r - NA_WR // 2, 0, R - wr)
    rows_idx = rs[:, None] + jnp.arange(wr)[None]
    ci = jnp.arange(GRID_W)
    cs = jnp.clip(ci - NA_WC // 2, 0, GRID_W - NA_WC)
    colmask = (ci[None, :] >= cs[:, None]) & (ci[None, :] < cs[:, None] + NA_WC)
    k_win = kg[:, :, rows_idx]
    v_win = vg[:, :, rows_idx]
    scale = dh ** -0.5
    s_win = jnp.einsum('bhrqd,bhrwkd->bhrqwk', qg, k_win).astype(F32) * scale
    dr = rows_idx - r[:, None] + (NA_WR - 1)
    dc = jnp.clip(ci[None, :] - ci[:, None] + NA_WC - 1, 0, 2 * NA_WC - 2)
    bias = rpb.astype(F32)[:, dr[:, None, :, None], dc[None, :, None, :]]
    s_win = jnp.where(colmask[:, None, :], s_win + bias[None], NEG).reshape(B, H, R, GRID_W, wr * GRID_W)
    kcx = _bhld(kc)
    vcx = _bhld(vc)
    s_ctx = jnp.einsum('bhrqd,bhjd->bhrqj', qg, kcx).astype(F32) * scale
    p = jax.nn.softmax(jnp.concatenate([s_win, s_ctx], axis=-1), axis=-1)
    p_win = p[..., :wr * GRID_W].reshape(B, H, R, GRID_W, wr, GRID_W).astype(v.dtype)
    p_ctx = p[..., wr * GRID_W:].astype(v.dtype)
    o = jnp.einsum('bhrqwk,bhrwkd->bhrqd', p_win, v_win) + jnp.einsum('bhrqj,bhjd->bhrqd', p_ctx, vcx)
    return o.transpose(0, 2, 3, 1, 4).reshape(B, L, H * dh)


def dense_attn(q, k, v):
    B, L, H, dh = q.shape
    s = jnp.einsum('bqhd,bkhd->bhqk', q, k).astype(F32) * dh ** -0.5
    p = jax.nn.softmax(s, axis=-1).astype(v.dtype)
    return jnp.einsum('bhqk,bkhd->bqhd', p, v).reshape(B, L, H * dh)


def merge_branches(ys, gate, w_branch, w_out):
    gates = jnp.split(gate, N_BRANCH, axis=-1)
    acc = jax.nn.sigmoid(gates[0]) * (ys[0] @ w_branch[0])
    for i in range(1, N_BRANCH):
        acc = acc + jax.nn.sigmoid(gates[i]) * (ys[i] @ w_branch[i])
    return acc @ w_out


def token_mixers(hl, hc, rows, cols, w_in, hy_conv_w, hy_conv_b, hy_f_w1, hy_f_b1, hy_f_w2, hy_f_b2,
                 hy_f_w3, hy_f_freq, hy_bias, ret_log_decay, na_rpb, w_branch, w_out, ctx_out):
    B, L, _ = hl.shape
    Lc = hc.shape[1]
    log_g = ret_log_decay.astype(F32)
    rk, rv, nk, nv, rq, rg, nq, hy, gate = _split(hl @ w_in, IN_SPLIT)
    if ctx_out:
        crk, crv, cnk, cnv, crq, crg, cnq, chy, cgate = _split(hc @ w_in, IN_SPLIT)
    else:
        crk, crv, cnk, cnv = _split(hc @ w_in[:, :CTX_STATE_W], IN_SPLIT[:4])

    ks = RET_DK ** -0.5
    ck = _bhld(_heads(crk, RET_HEADS)).astype(F32) * ks
    cv = _bhld(_heads(crv, RET_HEADS)).astype(F32)
    if ctx_out:
        cq = _bhld(_heads(crq, RET_HEADS)).astype(F32)
        zero = jnp.zeros((B, RET_HEADS, RET_DK, RET_DV), F32)
        co, s_f, s_b = ret_bidir(cq, ck, cv, log_g, zero, zero)
        yc_ret = ret_output(co, crg)
    else:
        s_f = ret_final_state(ck, cv, log_g[0])
        s_b = ret_final_state(ck[:, :, ::-1], cv[:, :, ::-1], log_g[1])
    lq = _bhld(axial_rope(_heads(rq, RET_HEADS), rows, cols)).astype(F32)
    lk = _bhld(axial_rope(_heads(rk, RET_HEADS), rows, cols)).astype(F32) * ks
    lv = _bhld(_heads(rv, RET_HEADS)).astype(F32)
    lo, _, _ = ret_bidir(lq, lk, lv, log_g, s_f, s_b)
    yl_ret = ret_output(lo, rg)

    cnk_h = _heads(cnk, NA_HEADS)
    cnv_h = _heads(cnv, NA_HEADS)
    yl_na = neighbourhood_attn(_heads(nq, NA_HEADS), _heads(nk, NA_HEADS), _heads(nv, NA_HEADS), cnk_h, cnv_h, na_rpb)

    kf_l = hyena_filter_fft(L, hy_f_w1, hy_f_b1, hy_f_w2, hy_f_b2, hy_f_w3, hy_f_freq)
    yl_hy = hyena_mixer(hy, hy_conv_w, hy_conv_b, kf_l, hy_bias)

    yl = merge_branches((yl_hy, yl_ret, yl_na), gate, w_branch, w_out)
    if not ctx_out:
        return yl, None
    yc_na = dense_attn(_heads(cnq, NA_HEADS), cnk_h, cnv_h)
    kf_c = hyena_filter_fft(Lc, hy_f_w1, hy_f_b1, hy_f_w2, hy_f_b2, hy_f_w3, hy_f_freq)
    yc_hy = hyena_mixer(chy, hy_conv_w, hy_conv_b, kf_c, hy_bias)
    yc = merge_branches((yc_hy, yc_ret, yc_na), cgate, w_branch, w_out)
    return yl, yc


def conv_ffn(h, w_in, conv_w, conv_b, w_out):
    a, b = jnp.split(h @ w_in, 2, axis=-1)
    a = dwconv3(a, conv_w, conv_b)
    return (jax.nn.gelu(a) * b) @ w_out


def setup_inputs(seed: int = 0) -> dict:
    key = jax.random.key(seed)
    ks = jax.random.split(key, 32)
    D = D_MODEL
    nrm = lambda k, shape, std: std * jax.random.normal(k, shape, F32)
    base_decay = jnp.log(1.0 - 2.0 ** (-5.0 - jnp.arange(RET_HEADS, dtype=F32)))
    return {
        "x": nrm(ks[0], (BATCH, SEQ, D), 1.0),
        "c": nrm(ks[1], (BATCH, D), 1.0),
        "ctx": nrm(ks[2], (BATCH, CTX_LEN, D), 1.0),
        "c_ctx": nrm(ks[3], (D,), 1.0),
        "w_mod": nrm(ks[4], (DEPTH, D, 6 * D), 0.5 * D ** -0.5),
        "b_mod": nrm(ks[5], (DEPTH, 6 * D), 0.02),
        "g_norm1": 1.0 + nrm(ks[6], (DEPTH, D), 0.02),
        "g_norm2": 1.0 + nrm(ks[7], (DEPTH, D), 0.02),
        "w_in": nrm(ks[8], (DEPTH, D, IN_W), D ** -0.5),
        "hy_conv_w": nrm(ks[9], (DEPTH, 3, (HY_ORDER + 1) * HY_W), 3 ** -0.5),
        "hy_conv_b": nrm(ks[10], (DEPTH, (HY_ORDER + 1) * HY_W), 0.02),
        "hy_f_w1": nrm(ks[11], (DEPTH, HY_EMB, HY_HID), HY_EMB ** -0.5),
        "hy_f_b1": nrm(ks[12], (DEPTH, HY_HID), 0.02),
        "hy_f_w2": nrm(ks[13], (DEPTH, HY_HID, HY_HID), HY_HID ** -0.5),
        "hy_f_b2": nrm(ks[14], (DEPTH, HY_HID), 0.02),
        "hy_f_w3": nrm(ks[15], (DEPTH, HY_HID, HY_ORDER * 2 * HY_W), HY_HID ** -0.5),
        "hy_f_freq": 1.0 + nrm(ks[16], (DEPTH, HY_HID), 0.02),
        "hy_bias": nrm(ks[17], (DEPTH, HY_ORDER, HY_W), 0.5),
        "ret_log_decay": base_decay * (1.0 + nrm(ks[18], (DEPTH, 2, RET_HEADS), 0.05)),
        "na_rpb": nrm(ks[19], (DEPTH, NA_HEADS, 2 * NA_WR - 1, 2 * NA_WC - 1), 0.02),
        "w_branch": nrm(ks[20], (DEPTH, N_BRANCH, BRANCH_W, D), BRANCH_W ** -0.5),
        "w_out": nrm(ks[21], (DEPTH, D, D), D ** -0.5),
        "ffn_w_in": nrm(ks[22], (DEPTH, D, 2 * D_FF), D ** -0.5),
        "ffn_conv_w": nrm(ks[23], (DEPTH, 3, D_FF), 3 ** -0.5),
        "ffn_conv_b": nrm(ks[24], (DEPTH, D_FF), 0.02),
        "ffn_w_out": nrm(ks[25], (DEPTH, D_FF, D), D_FF ** -0.5),
        "g_final": 1.0 + nrm(ks[26], (D,), 0.02),
    }


def reference(x, c, ctx, c_ctx, w_mod, b_mod, g_norm1, g_norm2, w_in, hy_conv_w, hy_conv_b, hy_f_w1, hy_f_b1,
              hy_f_w2, hy_f_b2, hy_f_w3, hy_f_freq, hy_bias, ret_log_decay, na_rpb, w_branch, w_out,
              ffn_w_in, ffn_conv_w, ffn_conv_b, ffn_w_out, g_final):
    B, L, D = x.shape
    t = jnp.arange(L)
    rows = t // GRID_W
    cols = t % GRID_W
    xl, xc = x, ctx
    sc_l = jax.nn.silu(c)
    sc_c = jax.nn.silu(c_ctx)
    for l in range(DEPTH):
        last = l == DEPTH - 1
        mod_l = (sc_l @ w_mod[l] + b_mod[l])[:, None, :]
        sh1, s1, g1, sh2, s2, g2 = jnp.split(mod_l, 6, axis=-1)
        n_cm = 2 if last else 6
        cmods = jnp.split(sc_c @ w_mod[l][:, :n_cm * D] + b_mod[l][:n_cm * D], n_cm)
        hl = modulate(rmsnorm(xl, g_norm1[l]), sh1, s1)
        hc = modulate(rmsnorm(xc, g_norm1[l]), cmods[0], cmods[1])
        yl, yc = token_mixers(hl, hc, rows, cols, w_in[l], hy_conv_w[l], hy_conv_b[l], hy_f_w1[l], hy_f_b1[l],
                              hy_f_w2[l], hy_f_b2[l], hy_f_w3[l], hy_f_freq[l], hy_bias[l], ret_log_decay[l],
                              na_rpb[l], w_branch[l], w_out[l], not last)
        xl = xl + g1 * yl
        xl = xl + g2 * conv_ffn(modulate(rmsnorm(xl, g_norm2[l]), sh2, s2), ffn_w_in[l], ffn_conv_w[l], ffn_conv_b[l], ffn_w_out[l])
        if not last:
            xc = xc + cmods[2] * yc
            xc = xc + cmods[5] * conv_ffn(modulate(rmsnorm(xc, g_norm2[l]), cmods[3], cmods[4]), ffn_w_in[l], ffn_conv_w[l], ffn_conv_b[l], ffn_w_out[l])
    return rmsnorm(xl, g_final)
```

```cpp
#include <hip/hip_runtime.h>
#include <cstdio>
#include <cstdint>
#ifndef MK_SINGLE
#define MK_SINGLE 0
#endif
namespace pg8 {
#define PG8_LAS __attribute__((address_space(3)))
typedef unsigned short bf16_t;
typedef short bf16x8 __attribute__((ext_vector_type(8)));
typedef float f32x4 __attribute__((ext_vector_type(4)));
typedef unsigned u32x4 __attribute__((ext_vector_type(4)));
constexpr int BM = 256, BK = 64, HALF = 128, HTB = HALF * BK * 2  , STAGE_BYTES = 8 * HTB, NXCD = 8, WGM = 8;

__host__ __device__ __forceinline__ int lds_byte(int r, int c) { const int st = (r >> 4) * 2 + (c >> 5), rr = r & 15, cc = c & 31, ob = rr * 64 + cc * 2; return st * 1024 + (ob ^ (((ob >> 9) & 1) << 5)); }
__host__ __device__ __forceinline__ void stage_rc(int b, int& R, int& C) { const int st = b / 1024, sb = b % 1024, swz = sb ^ (((sb >> 9) & 1) << 5); R = (st >> 1) * 16 + swz / 64; C = (st & 1) * 32 + (swz % 64) / 2; }
__host__ __device__ __forceinline__ int perm32(int rho) { const int n = rho >> 4, i = rho & 15; return 8 * (i >> 2) + 4 * n + (i & 3); }

struct Unit { int pm, pn; };
struct Gemm { const bf16_t* A; const bf16_t* Bt; int M, N, K; };

struct StaticOrder {
    int nM, nN, nwg, G, c;
    __host__ __device__ void init(int M, int N, int G_, int c_) { nM = M / BM; nN = N / BM; nwg = nM * nN; G = G_; c = c_; }
    __host__ __device__ bool next(int i, Unit& u) const {
        const long L = (long)i * G + c; if (L >= nwg) return false;
        int wgid = (int)L; { const int q = nwg / NXCD, r = nwg % NXCD, xcd = wgid % NXCD, off = wgid / NXCD; wgid = (xcd < r ? xcd * (q + 1) : r * (q + 1) + (xcd - r) * q) + off; }
        const int nig = WGM * nN, gid = wgid / nig, fm = gid * WGM, gsz = (nM - fm) < WGM ? (nM - fm) : WGM;
        u.pm = fm + ((wgid % nig) % gsz); u.pn = (wgid % nig) / gsz; return true;
    }
    __device__ __forceinline__ void a_ready(const Unit&) const {}
    __device__ __forceinline__ void done(const Unit&) const {}
};
__device__ __forceinline__ unsigned cvt_pk_bf16(float lo, float hi) { unsigned r; asm volatile("v_cvt_pk_bf16_f32 %0, %1, %2" : "=v"(r) : "v"(lo), "v"(hi)); return r; }
typedef float f32x2 __attribute__((ext_vector_type(2)));
__device__ __forceinline__ float bflo(unsigned w) { return __uint_as_float(w << 16); }
__device__ __forceinline__ float bfhi(unsigned w) { return __uint_as_float(w & 0xffff0000u); }
__device__ __forceinline__ float sigm(float x) { return 1.0f / (1.0f + __expf(-x)); }
struct EpiStore {
    static constexpr bool PERM = true, AFTER_DRAIN = false;
    bf16_t* O; int ldc;
    __device__ __forceinline__ void operator()(const f32x4 (&acc)[2][2][4][2], const Unit& u, int wr, int wc, int fr, int fq) const {
        const int row0 = u.pm * BM + wr * 64 + fr, col0 = u.pn * BM + wc * 32 + 8 * fq;
#pragma unroll
        for (int ai = 0; ai < 2; ++ai)
#pragma unroll
            for (int m = 0; m < 4; ++m) { bf16_t* rowp = O + (size_t)(row0 + ai * HALF + m * 16) * ldc + col0;
#pragma unroll
                for (int bj = 0; bj < 2; ++bj) { const f32x4 v0 = acc[ai][bj][m][0], v1 = acc[ai][bj][m][1];
                    u32x4 w; w.x = cvt_pk_bf16(v0[0], v0[1]); w.y = cvt_pk_bf16(v0[2], v0[3]); w.z = cvt_pk_bf16(v1[0], v1[1]); w.w = cvt_pk_bf16(v1[2], v1[3]);
                    *(u32x4*)(rowp + bj * HALF) = w; } }
    }
};
struct EpiMerge {
    static constexpr bool PERM = true, AFTER_DRAIN = false;
    bf16_t* O; const bf16_t* gate; int ldg; int first;
    __device__ __forceinline__ void operator()(const f32x4 (&acc)[2][2][4][2], const Unit& u, int wr, int wc, int fr, int fq) const {
        const int row0 = u.pm * BM + wr * 64 + fr, col0 = u.pn * BM + wc * 32 + 8 * fq;
#pragma unroll
        for (int ai = 0; ai < 2; ++ai)
#pragma unroll
            for (int m = 0; m < 4; ++m) { const size_t row = (size_t)(row0 + ai * HALF + m * 16);
#pragma unroll
                for (int bj = 0; bj < 2; ++bj) { const int col = col0 + bj * HALF;
                    const u32x4 gv = *(const u32x4*)(gate + row * ldg + col);
                    u32x4 pv = (u32x4){0u, 0u, 0u, 0u}; if (!first) pv = *(const u32x4*)(O + row * 2048 + col);
                    const f32x4 v0 = acc[ai][bj][m][0], v1 = acc[ai][bj][m][1];
                    u32x4 w;
                    w.x = cvt_pk_bf16(bflo(pv.x) + v0[0] * sigm(bflo(gv.x)), bfhi(pv.x) + v0[1] * sigm(bfhi(gv.x)));
                    w.y = cvt_pk_bf16(bflo(pv.y) + v0[2] * sigm(bflo(gv.y)), bfhi(pv.y) + v0[3] * sigm(bfhi(gv.y)));
                    w.z = cvt_pk_bf16(bflo(pv.z) + v1[0] * sigm(bflo(gv.z)), bfhi(pv.z) + v1[1] * sigm(bfhi(gv.z)));
                    w.w = cvt_pk_bf16(bflo(pv.w) + v1[2] * sigm(bflo(gv.w)), bfhi(pv.w) + v1[3] * sigm(bfhi(gv.w)));
                    *(u32x4*)(O + row * 2048 + col) = w; } }
    }
};
struct EpiResid {
    static constexpr bool PERM = false, AFTER_DRAIN = false;
    const float* base_lat; const float* base_ctx; float* out_lat; float* out_ctx; const float* modl; int goff;
    __device__ __forceinline__ void operator()(const f32x4 (&acc)[2][2][4][2], const Unit& u, int wr, int wc, int fr, int fq) const {
        const bool isctx = u.pm >= 64; const int r = isctx ? 4 : (u.pm >> 4);
        const float* gvp = modl + (size_t)r * 12288 + goff;
        const float* bs = isctx ? base_ctx : base_lat; float* os = isctx ? out_ctx : out_lat;
        const int row0 = (isctx ? u.pm - 64 : u.pm) * BM + wr * 64 + fr, col0 = u.pn * BM + wc * 32 + 4 * fq;
        f32x4 g4[2][2];
#pragma unroll
        for (int bj = 0; bj < 2; ++bj)
#pragma unroll
            for (int n = 0; n < 2; ++n) g4[bj][n] = *(const f32x4*)(gvp + col0 + bj * HALF + n * 16);
#pragma unroll
        for (int ai = 0; ai < 2; ++ai)
#pragma unroll
            for (int m = 0; m < 4; ++m) { const size_t off = (size_t)(row0 + ai * HALF + m * 16) * 2048 + col0;
#pragma unroll
                for (int bj = 0; bj < 2; ++bj)
#pragma unroll
                    for (int n = 0; n < 2; ++n) { const f32x4 b4 = *(const f32x4*)(bs + off + bj * HALF + n * 16);
                        *(f32x4*)(os + off + bj * HALF + n * 16) = b4 + g4[bj][n] * acc[ai][bj][m][n]; } }
    }
};
template <class Epi, class Sched, bool ALIGN_EPI = false, bool SP2 = false>
__device__ __forceinline__ void gemm_phase(PG8_LAS unsigned char* lds, const Gemm g, const Sched& S, const Epi& E) {
    int tid_ = threadIdx.x; asm volatile("" : "+v"(tid_)); const int tid = tid_, wid = __builtin_amdgcn_readfirstlane(tid >> 6), lane = tid & 63, wr = wid >> 2, wc = wid & 3, fr = lane & 15, fq = lane >> 4;
    const int K = g.K, nt = K / BK;
    unsigned voffA[2], voffB[2];
#pragma unroll
    for (int i = 0; i < 2; ++i) { int R, C; stage_rc(tid * 16 + i * 8192, R, C); const int Rb = Epi::PERM ? ((R & ~31) + perm32(R & 31)) : R;
        voffA[i] = (unsigned)(R * K + C) * 2u; voffB[i] = (unsigned)(Rb * K + C) * 2u; }
    const size_t kstep = (size_t)(BK * 2);
    const size_t hstep = (size_t)HALF * K * 2;
    const size_t tstep = 2 * hstep;
    const unsigned ldsw = (unsigned)wid * 1024u;
    const int aoff = lds_byte(wr * 64 + fr, fq * 8), boff = lds_byte(wc * 32 + fr, fq * 8);
#define PG8_SA(b, h) (((b) * 2 + (h)) * HTB)
#define PG8_SB(b, h) ((4 + (b) * 2 + (h)) * HTB)
#define PG8_STAGE(bufoff, gbase, voff) do { _Pragma("unroll") for (int _i = 0; _i < 2; ++_i) \
        __builtin_amdgcn_global_load_lds((const unsigned*)((const char*)(gbase) + (voff)[_i]), (PG8_LAS unsigned*)(lds + (bufoff) + ldsw + _i * 8192), 16, 0, 0); } while (0)
#define PG8_LDA(dst, b, h) do { _Pragma("unroll") for (int m = 0; m < 4; ++m) _Pragma("unroll") for (int k = 0; k < 2; ++k) dst[m][k] = *(const PG8_LAS bf16x8*)(lds + PG8_SA(b, h) + aoff + m * 2048 + k * 1024); } while (0)
#define PG8_LDB(dst, b, h) do { _Pragma("unroll") for (int n = 0; n < 2; ++n) _Pragma("unroll") for (int k = 0; k < 2; ++k) dst[n][k] = *(const PG8_LAS bf16x8*)(lds + PG8_SB(b, h) + boff + n * 2048 + k * 1024); } while (0)
#define PG8_MMA(ai, bj, At, Bt) do { __builtin_amdgcn_s_setprio(1); _Pragma("unroll") for (int m = 0; m < 4; ++m) _Pragma("unroll") for (int n = 0; n < 2; ++n) _Pragma("unroll") for (int k = 0; k < 2; ++k) \
        acc[ai][bj][m][n] = __builtin_amdgcn_mfma_f32_16x16x32_bf16(Bt[n][k], At[m][k], acc[ai][bj][m][n], 0, 0, 0); __builtin_amdgcn_s_setprio(0); } while (0)
#define PG8_WAIT_V(n) asm volatile("s_waitcnt vmcnt(" #n ")" ::: "memory")
#define PG8_WAIT_L(n) asm volatile("s_waitcnt lgkmcnt(" #n ")" ::: "memory")
#define PG8_BAR __builtin_amdgcn_s_barrier()
#define PG8_SCHED __builtin_amdgcn_sched_barrier(0)
    Unit cur, nxt; int ui = 0;
    if (!S.next(0, cur)) return;
    f32x4 acc[2][2][4][2];
#pragma unroll
    for (int a = 0; a < 2; ++a)
#pragma unroll
        for (int b = 0; b < 2; ++b)
#pragma unroll
            for (int m = 0; m < 4; ++m)
#pragma unroll
                for (int n = 0; n < 2; ++n) acc[a][b][m][n] = (f32x4){0.f, 0.f, 0.f, 0.f};
    bf16x8 At[4][2], B0[2][2], B1[2][2];
    const char* cA = (const char*)g.A + (size_t)cur.pm * tstep; const char* cB = (const char*)g.Bt + (size_t)cur.pn * tstep;
    S.a_ready(cur);
    if constexpr (SP2) {
        PG8_STAGE(PG8_SB(0, 0), cB, voffB); PG8_STAGE(PG8_SB(0, 1), cB + hstep, voffB); PG8_STAGE(PG8_SA(0, 0), cA, voffA); PG8_STAGE(PG8_SA(0, 1), cA + hstep, voffA);
        if (wr == 1) PG8_BAR;
        PG8_WAIT_V(2); PG8_BAR;
        PG8_STAGE(PG8_SB(1, 0), cB + kstep, voffB); PG8_STAGE(PG8_SA(1, 0), cA + kstep, voffA); PG8_STAGE(PG8_SB(1, 1), cB + hstep + kstep, voffB);
        PG8_WAIT_V(6); PG8_BAR;
    } else {
        PG8_STAGE(PG8_SB(0, 0), cB, voffB); PG8_STAGE(PG8_SA(0, 0), cA, voffA); PG8_STAGE(PG8_SB(0, 1), cB + hstep, voffB); PG8_STAGE(PG8_SA(0, 1), cA + hstep, voffA);
        if (wr == 1) PG8_BAR;
        PG8_WAIT_V(4); PG8_BAR;
        PG8_STAGE(PG8_SB(1, 0), cB + kstep, voffB); PG8_STAGE(PG8_SA(1, 0), cA + kstep, voffA); PG8_STAGE(PG8_SB(1, 1), cB + hstep + kstep, voffB);
        PG8_WAIT_V(6); PG8_BAR;
    }
    for (;;) {
        const bool has_next = S.next(ui + 1, nxt);
        const char* nA = has_next ? (const char*)g.A + (size_t)nxt.pm * tstep : cA; const char* nB = has_next ? (const char*)g.Bt + (size_t)nxt.pn * tstep : cB;
        for (int t = 0; t < nt; t += 2) {
            const bool last = (t == nt - 2);
            const char* a1 = cA + (size_t)(t + 1) * kstep;
            const char* a2 = last ? nA : cA + (size_t)(t + 2) * kstep; const char* b2 = last ? nB : cB + (size_t)(t + 2) * kstep;
            const char* a3 = a2 + kstep; const char* b3 = b2 + kstep;
            if (last && has_next) S.a_ready(nxt);
            if constexpr (SP2) {
            PG8_LDB(B0, 0, 0); PG8_LDB(B1, 0, 1); PG8_SCHED; PG8_LDA(At, 0, 0); PG8_STAGE(PG8_SA(1, 1), a1 + hstep, voffA);
            PG8_WAIT_V(8); PG8_WAIT_L(0); PG8_BAR; PG8_MMA(0, 0, At, B0); PG8_MMA(0, 1, At, B1); PG8_BAR; PG8_SCHED;
            PG8_LDA(At, 0, 1); PG8_STAGE(PG8_SB(0, 0), b2, voffB); PG8_STAGE(PG8_SB(0, 1), b2 + hstep, voffB); PG8_STAGE(PG8_SA(0, 0), a2, voffA);
            PG8_WAIT_V(8); PG8_WAIT_L(0); PG8_BAR; PG8_MMA(1, 0, At, B0); PG8_MMA(1, 1, At, B1); PG8_BAR; PG8_SCHED;
            PG8_LDB(B0, 1, 0); PG8_LDB(B1, 1, 1); PG8_SCHED; PG8_LDA(At, 1, 0); PG8_STAGE(PG8_SA(0, 1), a2 + hstep, voffA);
            PG8_WAIT_V(8); PG8_WAIT_L(0); PG8_BAR; PG8_MMA(0, 0, At, B0); PG8_MMA(0, 1, At, B1); PG8_BAR; PG8_SCHED;
            PG8_LDA(At, 1, 1); PG8_STAGE(PG8_SB(1, 0), b3, voffB); PG8_STAGE(PG8_SB(1, 1), b3 + hstep, voffB); PG8_STAGE(PG8_SA(1, 0), a3, voffA);
            PG8_WAIT_V(8); PG8_WAIT_L(0); PG8_BAR; PG8_MMA(1, 0, At, B0); PG8_MMA(1, 1, At, B1); PG8_BAR; PG8_SCHED;
            } else {
            PG8_LDB(B0, 0, 0); PG8_SCHED; PG8_LDA(At, 0, 0); PG8_STAGE(PG8_SA(1, 1), a1 + hstep, voffA);
            PG8_WAIT_L(8); PG8_BAR; PG8_WAIT_L(0); PG8_MMA(0, 0, At, B0); PG8_BAR; PG8_SCHED;
            PG8_LDB(B1, 0, 1); PG8_STAGE(PG8_SB(0, 0), b2, voffB);
            PG8_BAR; PG8_WAIT_L(0); PG8_MMA(0, 1, At, B1); PG8_BAR;
            PG8_LDA(At, 0, 1); PG8_STAGE(PG8_SA(0, 0), a2, voffA);
            PG8_BAR; PG8_WAIT_L(0); PG8_MMA(1, 0, At, B0); PG8_BAR; PG8_SCHED;
            PG8_STAGE(PG8_SB(0, 1), b2 + hstep, voffB);
            PG8_WAIT_V(6); PG8_BAR; PG8_MMA(1, 1, At, B1); PG8_BAR;
            PG8_LDB(B0, 1, 0); PG8_SCHED; PG8_LDA(At, 1, 0); PG8_STAGE(PG8_SA(0, 1), a2 + hstep, voffA);
            PG8_WAIT_L(8); PG8_BAR; PG8_WAIT_L(0); PG8_MMA(0, 0, At, B0); PG8_BAR; PG8_SCHED;
            PG8_LDB(B1, 1, 1); PG8_STAGE(PG8_SB(1, 0), b3, voffB);
            PG8_BAR; PG8_WAIT_L(0); PG8_MMA(0, 1, At, B1); PG8_BAR;
            PG8_LDA(At, 1, 1); PG8_STAGE(PG8_SA(1, 0), a3, voffA);
            PG8_BAR; PG8_WAIT_L(0); PG8_MMA(1, 0, At, B0); PG8_BAR; PG8_SCHED;
            PG8_STAGE(PG8_SB(1, 1), b3 + hstep, voffB);
            PG8_WAIT_V(6); PG8_BAR; PG8_MMA(1, 1, At, B1); PG8_BAR;
            }
        }
        if constexpr (ALIGN_EPI) { if (wr == 0) PG8_BAR; }
        if constexpr (!Epi::AFTER_DRAIN) { E(acc, cur, wr, wc, fr, fq); S.done(cur); }
        if (!has_next) break;
#pragma unroll
        for (int a = 0; a < 2; ++a)
#pragma unroll
            for (int b = 0; b < 2; ++b)
#pragma unroll
                for (int m = 0; m < 4; ++m)
#pragma unroll
                    for (int n = 0; n < 2; ++n) acc[a][b][m][n] = (f32x4){0.f, 0.f, 0.f, 0.f};
        cur = nxt; cA = nA; cB = nB; ++ui;
        if constexpr (ALIGN_EPI) { if (wr == 1) PG8_BAR; }
    }
    PG8_WAIT_V(0);
    if constexpr (!ALIGN_EPI) { if (wr == 0) PG8_BAR; }
    PG8_BAR;
    if constexpr (Epi::AFTER_DRAIN) { E.fused(acc, cur, wr, wc, fr, fq, lds, wid, lane); S.done(cur); }
#undef PG8_SA
#undef PG8_SB
#undef PG8_STAGE
#undef PG8_LDA
#undef PG8_LDB
#undef PG8_MMA
#undef PG8_WAIT_V
#undef PG8_WAIT_L
#undef PG8_BAR
#undef PG8_SCHED
}
}
#ifndef PG8_SP2
#define PG8_SP2 true
#endif
#ifndef PG8_ALIGN
#define PG8_ALIGN true
#endif
constexpr int D = 2048, NB = 4, SEQ = 4096, CL = 256, DEPTH = 4;
constexpr int ML = NB * SEQ, MC = NB * CL, MT = ML + MC;
constexpr int INW = 15360, DFF = 5632, NFF = 2 * DFF;
constexpr int C_RK = 0, C_RV = 512, C_NK = 1536, C_NV = 2560, C_RQ = 3584, C_RG = 4096, C_NQ = 5120, C_HY = 6144, C_GT = 9216;
constexpr float EPS = 1e-6f;
constexpr int NWAVES = 8;
constexpr size_t al256(size_t x) { return (x + 255) & ~(size_t)255; }
constexpr size_t WS_CTL = 0, CTL_ZERO_BYTES = 1u << 20;
constexpr size_t WS_MOD = WS_CTL + CTL_ZERO_BYTES;
constexpr size_t WS_ROPE = WS_MOD + al256((size_t)4 * 5 * 12288 * 4);
constexpr size_t WS_FH2 = WS_ROPE + al256(64 * 16 * 8);
constexpr size_t WS_TAPC = WS_FH2 + al256((size_t)4352 * 64 * 4);
constexpr size_t WS_KF = WS_TAPC + al256((size_t)2 * 2 * 1024 * 256 * 4);
constexpr size_t WS_WIN = WS_KF + al256((size_t)2 * 1024 * 8192 * 8);
constexpr size_t WS_WBR = WS_WIN + al256((size_t)INW * D * 2);
constexpr size_t WS_WOUT = WS_WBR + al256((size_t)3 * D * 1024 * 2);
constexpr size_t WS_WF1 = WS_WOUT + al256((size_t)D * D * 2);
constexpr size_t WS_WF2 = WS_WF1 + al256((size_t)NFF * D * 2);
constexpr size_t WS_XC = WS_WF2 + al256((size_t)D * DFF * 2);
constexpr size_t WS_H = WS_XC + al256((size_t)MC * D * 4);
constexpr size_t WS_Z = WS_H + al256((size_t)MT * D * 2);
constexpr size_t WS_HYT = WS_Z + al256((size_t)MT * INW * 2);
constexpr size_t WS_YT = WS_HYT + al256((size_t)3 * NB * 1024 * SEQ * 2);
constexpr size_t WS_YS = WS_YT + al256((size_t)NB * 1024 * SEQ * 2);
constexpr size_t WS_ACC = WS_YS + al256((size_t)3 * MT * 1024 * 2);
constexpr size_t WS_U = WS_ACC + al256((size_t)MT * D * 2);
constexpr size_t WS_KV = WS_U + al256((size_t)MT * DFF * 2);
constexpr size_t WS_END = WS_KV + al256((size_t)NB * 8 * 2 * 34 * 8192 * 4);
constexpr int CW_BAR = 4096;
constexpr int RING_BYTES = 131072, LDSCTL_OFF = RING_BYTES, MISC_OFF = LDSCTL_OFF + 320, LDS_BYTES = 147456;

#define GAS __attribute__((address_space(1)))
#define LAS __attribute__((address_space(3)))
typedef unsigned short bf16;
typedef unsigned v4u __attribute__((ext_vector_type(4)));
typedef unsigned v2u __attribute__((ext_vector_type(2)));
typedef float f32x4 __attribute__((ext_vector_type(4)));
typedef float f32x2 __attribute__((ext_vector_type(2)));
typedef short bf16x8 __attribute__((ext_vector_type(8)));
typedef GAS unsigned gu32;
#define LDS_WAIT() asm volatile("s_waitcnt lgkmcnt(0)" ::: "memory")
__device__ __forceinline__ unsigned f2bf(float f) { unsigned u = __builtin_bit_cast(unsigned, f); return (u + 0x7fffu + ((u >> 16) & 1u)) >> 16; }
__device__ __forceinline__ unsigned pk2(float lo, float hi) { return f2bf(lo) | (f2bf(hi) << 16); }
__device__ __forceinline__ float bflo(unsigned w) { return __uint_as_float(w << 16); }
__device__ __forceinline__ float bfhi(unsigned w) { return __uint_as_float(w & 0xffff0000u); }
__device__ __forceinline__ float bf1(bf16 b) { return __uint_as_float(((unsigned)b) << 16); }
__device__ __forceinline__ bf16x8 mk8(unsigned a, unsigned b, unsigned c, unsigned d) { v4u v = (v4u){a, b, c, d}; return __builtin_bit_cast(bf16x8, v); }
__device__ __forceinline__ f32x4 mfma16(bf16x8 a, bf16x8 b, f32x4 c) { return __builtin_amdgcn_mfma_f32_16x16x32_bf16(a, b, c, 0, 0, 0); }
__device__ __forceinline__ float sin_rev(float r) { return __builtin_amdgcn_sinf(r - floorf(r)); }
__device__ __forceinline__ float cos_rev(float r) { return __builtin_amdgcn_cosf(r - floorf(r)); }
__device__ __forceinline__ float sin_rad(float x) { return sin_rev(x * 0.15915494309189535f); }
__device__ __forceinline__ float ex2(float x) { return __builtin_amdgcn_exp2f(x); }
__device__ __forceinline__ float wave_sum(float v) {
#pragma unroll
    for (int o = 1; o < 64; o <<= 1) v += __shfl_xor(v, o);
    return v;
}
__device__ __forceinline__ int otid() { int t = threadIdx.x; asm volatile("" : "+v"(t)); return t; }
__device__ __forceinline__ int opq(int v) { asm volatile("" : "+s"(v)); return v; }
#define XB_TMO      128
#define XB_XCNT(j)  (256  + 64 * (j))
#define XB_XSUB(j)  (1280 + 64 * (j))
#define XB_XGEN(j)  (2304 + 64 * (j))
#define XB_TOP      3328
#define XB_TOPGEN   3392
#define XCD_BAR_WORDS 3456
#define XB_SPIN_CAP (1u << 18)

__device__ __forceinline__ unsigned xb_ld(unsigned* p)              { return __hip_atomic_load(p, __ATOMIC_RELAXED, __HIP_MEMORY_SCOPE_AGENT); }
__device__ __forceinline__ unsigned xb_add(unsigned* p, unsigned v) { return __hip_atomic_fetch_add(p, v, __ATOMIC_RELAXED, __HIP_MEMORY_SCOPE_AGENT); }
__device__ __forceinline__ unsigned xb_xcc_id() { return (unsigned)__builtin_amdgcn_s_getreg((3 << 11) | 20) & 0xFu; }
#define XB_SPIN(cond, bar) do { unsigned _sp = 0; while (cond) { __builtin_amdgcn_s_sleep(1); \
    if ((++_sp & 255u) == 0u) { if (xb_ld(&(bar)[XB_TMO])) break; if (_sp > XB_SPIN_CAP) { atomicAdd(&(bar)[XB_TMO], 1u); break; } } } } while (0)

struct XcdBarrier {
    unsigned* bar; unsigned x;
    volatile LAS unsigned* st;
};

__device__ __forceinline__ XcdBarrier xcd_barrier_post(unsigned* bar, volatile LAS unsigned* st) {
    XcdBarrier b; b.bar = bar; b.x = xb_xcc_id(); b.st = st;
    if (threadIdx.x == 0) (void)xb_add(&bar[XB_XCNT(b.x)], 1u);
    return b;
}
__device__ __forceinline__ void xcd_barrier_complete(unsigned* bar, unsigned x, unsigned& nloc, unsigned& nx) {
    const unsigned G = gridDim.x * gridDim.y * gridDim.z;
    unsigned sum, cnt, mine, sp = 0u;
    for (;;) {
        sum = 0u; cnt = 0u; mine = 0u;
#pragma unroll
        for (unsigned j = 0; j < 16; ++j) { const unsigned c = xb_ld(&bar[XB_XCNT(j)]); sum += c; cnt += (c > 0u) ? 1u : 0u; mine = (j == x) ? c : mine; }
        if (sum == G) break;
        __builtin_amdgcn_s_sleep(1);
        if ((++sp & 255u) == 0u) { if (xb_ld(&bar[XB_TMO])) break; if (sp > XB_SPIN_CAP) { atomicAdd(&bar[XB_TMO], 1u); break; } }
    }
    nloc = mine > 0u ? mine : 1u; nx = cnt > 0u ? cnt : 1u;
}

__device__ __forceinline__ void xcd_barrier(const XcdBarrier& b) {
    asm volatile("s_waitcnt vmcnt(0)" ::: "memory");
    __syncthreads();
    if (threadIdx.x == 0) {
        unsigned* bar = b.bar;
        __builtin_amdgcn_s_waitcnt(0);
        unsigned nloc = b.st[0], nx = b.st[1];
        if (nloc == 0u) { xcd_barrier_complete(bar, b.x, nloc, nx); b.st[0] = nloc; b.st[1] = nx; }
        const unsigned old = xb_add(&bar[XB_XSUB(b.x)], 1u);
        const unsigned gen = old / nloc;
        if (old + 1u == (gen + 1u) * nloc) {
            __builtin_amdgcn_fence(__ATOMIC_RELEASE, "agent");
            asm volatile("s_waitcnt vmcnt(0)" ::: "memory");
            const unsigned og = xb_add(&bar[XB_TOP], 1u);
            const unsigned tg = og / nx;
            if (og + 1u == (tg + 1u) * nx) xb_add(&bar[XB_TOPGEN], 1u);
            else XB_SPIN(xb_ld(&bar[XB_TOPGEN]) == tg, bar);
            __builtin_amdgcn_fence(__ATOMIC_ACQUIRE, "agent");
            xb_add(&bar[XB_XGEN(b.x)], 1u);
            asm volatile("s_waitcnt vmcnt(0)" ::: "memory");
        } else {
            XB_SPIN(xb_ld(&bar[XB_XGEN(b.x)]) == gen, bar);
            __builtin_amdgcn_fence(__ATOMIC_ACQUIRE, "agent");
            asm volatile("s_waitcnt vmcnt(0)" ::: "memory");
        }
    }
    __syncthreads();
}
__device__ __forceinline__ void p0_transpose_item(const float* W, int K, int N, bf16* WT, int row_off, LAS float* scr, int item, int lane) {
    const int nblk = N / 32, kb = item / nblk, nb = item % nblk, k0 = 64 * kb, n0 = 32 * nb;
#pragma unroll 8
    for (int i = 0; i < 32; ++i) { const int kk = 2 * i + (lane >> 5); scr[kk * 33 + (lane & 31)] = W[(size_t)(k0 + kk) * N + n0 + (lane & 31)]; }
    LDS_WAIT(); asm volatile("" ::: "memory");
    const int c = lane & 7;
#pragma unroll
    for (int j = 0; j < 4; ++j) { const int n = (lane >> 3) + 8 * j; const LAS float* s = scr + (8 * c) * 33 + n;
        v4u o; o.x = pk2(s[0 * 33], s[1 * 33]); o.y = pk2(s[2 * 33], s[3 * 33]); o.z = pk2(s[4 * 33], s[5 * 33]); o.w = pk2(s[6 * 33], s[7 * 33]);
        *(GAS v4u*)(WT + (size_t)(row_off + n0 + n) * K + k0 + 8 * c) = o; }
    LDS_WAIT(); asm volatile("" ::: "memory");
}
struct Args { const float* in[27]; float* out; unsigned char* ws; int seq_lo, seq_hi; };
__device__ __forceinline__ const float* inp(int i) { const char* ka = (const char*)__builtin_amdgcn_kernarg_segment_ptr(); int off = i * 8; asm volatile("" : "+s"(off)); return *(const float* const*)(ka + off); }
__device__ __forceinline__ unsigned char* wsb() { const char* ka = (const char*)__builtin_amdgcn_kernarg_segment_ptr(); int off = 27 * 8 + 8; asm volatile("" : "+s"(off)); return *(unsigned char* const*)(ka + off); }
__device__ __forceinline__ float* outb() { const char* ka = (const char*)__builtin_amdgcn_kernarg_segment_ptr(); int off = 27 * 8; asm volatile("" : "+s"(off)); return *(float* const*)(ka + off); }
enum { I_X = 0, I_C, I_CTX, I_CCTX, I_WMOD, I_BMOD, I_G1, I_G2, I_WIN, I_HCW, I_HCB, I_FW1, I_FB1, I_FW2, I_FB2, I_FW3, I_FFQ, I_HBIAS, I_RDEC, I_RPB, I_WBR, I_WOUT, I_FFW1, I_FFCW, I_FFCB, I_FFW2, I_GF };

__device__ __forceinline__ void ph_prologue(const Args& A, LAS unsigned char* lds, int tid) {
    LAS float* sc = (LAS float*)lds;
    LAS float* red = sc + 5 * 2048;
    const float* c = inp(I_C); const float* cc = inp(I_CCTX);
    for (int i = tid; i < 5 * 2048; i += 512) { const int r = i >> 11, k = i & 2047; const float v = (r < 4) ? c[r * 2048 + k] : cc[k]; sc[i] = v / (1.0f + __expf(-v)); }
    __syncthreads();
    float* mod = (float*)(wsb() + WS_MOD);
    const int kq = tid >> 6, col = tid & 63;
    for (int u = blockIdx.x; u < DEPTH * 192; u += gridDim.x) {
        const int l = u / 192, n0 = (u % 192) * 64;
        const float* W = inp(I_WMOD) + (size_t)l * 2048 * 12288 + n0 + col;
        float a0 = 0.f, a1 = 0.f, a2 = 0.f, a3 = 0.f, a4 = 0.f;
        for (int k = kq * 256; k < kq * 256 + 256; ++k) { const float w = W[(size_t)k * 12288];
            a0 += sc[k] * w; a1 += sc[2048 + k] * w; a2 += sc[4096 + k] * w; a3 += sc[6144 + k] * w; a4 += sc[8192 + k] * w; }
        red[(kq * 5 + 0) * 64 + col] = a0; red[(kq * 5 + 1) * 64 + col] = a1; red[(kq * 5 + 2) * 64 + col] = a2; red[(kq * 5 + 3) * 64 + col] = a3; red[(kq * 5 + 4) * 64 + col] = a4;
        __syncthreads();
        if (tid < 320) { const int r = tid >> 6; float s = inp(I_BMOD)[l * 12288 + n0 + col];
#pragma unroll
            for (int q = 0; q < 8; ++q) s += red[(q * 5 + r) * 64 + col];
            mod[((size_t)l * 5 + r) * 12288 + n0 + col] = s; }
        __syncthreads();
    }
    if (blockIdx.x == 0) { f32x2* rope = (f32x2*)(wsb() + WS_ROPE);
        for (int i = tid; i < 1024; i += 512) { const int pos = i >> 4, j = i & 15; const float inv = exp2f(-(float)j * (13.287712379549449f / 16.0f));
            const float rev = (float)pos * inv * 0.15915494309189535f; rope[i] = (f32x2){cos_rev(rev), sin_rev(rev)}; } }
}

__device__ __forceinline__ void ph_convert(const Args& A, int l, LAS unsigned char* lds, int wave, int lane) {
    LAS float* scr = (LAS float*)(lds + wave * 16384);
    const int gw = blockIdx.x * NWAVES + wave, NGW = gridDim.x * NWAVES;
    constexpr int I_IN = (D / 64) * (INW / 32), I_BR = (1024 / 64) * (D / 32), I_OUT = (D / 64) * (D / 32), I_F1 = (D / 64) * (NFF / 32), I_F2 = (DFF / 64) * (D / 32);
    constexpr int NITEMS = I_IN + 3 * I_BR + I_OUT + I_F1 + I_F2;
    const float* win = inp(I_WIN) + (size_t)l * D * INW; const float* wbr = inp(I_WBR) + (size_t)l * 3 * 1024 * D; const float* wout = inp(I_WOUT) + (size_t)l * D * D;
    const float* wf1 = inp(I_FFW1) + (size_t)l * D * NFF; const float* wf2 = inp(I_FFW2) + (size_t)l * DFF * D;
    bf16* WIN = (bf16*)(wsb() + WS_WIN); bf16* WBR = (bf16*)(wsb() + WS_WBR); bf16* WOUT = (bf16*)(wsb() + WS_WOUT); bf16* WF1 = (bf16*)(wsb() + WS_WF1); bf16* WF2 = (bf16*)(wsb() + WS_WF2);
    for (int it = gw; it < NITEMS; it += NGW) {
        int r = it;
        if (r < I_IN) { p0_transpose_item(win, D, INW, WIN, 0, scr, r, lane); continue; } r -= I_IN;
        if (r < I_BR) { p0_transpose_item(wbr, 1024, D, WBR, 0, scr, r, lane); continue; } r -= I_BR;
        if (r < I_BR) { p0_transpose_item(wbr + (size_t)1024 * D, 1024, D, WBR + (size_t)D * 1024, 0, scr, r, lane); continue; } r -= I_BR;
        if (r < I_BR) { p0_transpose_item(wbr + (size_t)2 * 1024 * D, 1024, D, WBR + (size_t)2 * D * 1024, 0, scr, r, lane); continue; } r -= I_BR;
        if (r < I_OUT) { p0_transpose_item(wout, D, D, WOUT, 0, scr, r, lane); continue; } r -= I_OUT;
        if (r < I_F1) { p0_transpose_item(wf1, D, NFF, WF1, 0, scr, r, lane); continue; } r -= I_F1;
        p0_transpose_item(wf2, DFF, D, WF2, 0, scr, r, lane);
    }
}
__device__ __forceinline__ void ph_filt1(const Args& A, int l, LAS unsigned char* lds, int tid) {
    LAS float* feat = (LAS float*)lds;
    LAS float* h1 = feat + 8 * 33;
    const float* w1 = inp(I_FW1) + (size_t)l * 33 * 64; const float* b1 = inp(I_FB1) + l * 64; const float* w2 = inp(I_FW2) + (size_t)l * 64 * 64; const float* b2 = inp(I_FB2) + l * 64;
    const float* fq = inp(I_FFQ) + l * 64; float* FH2 = (float*)(wsb() + WS_FH2);
    const int pl = tid >> 6, o = tid & 63;
    for (int u = blockIdx.x; u < 544; u += gridDim.x) {
        const int pos = u * 8 + pl; const bool isc = pos >= 4096; const int Lf = isc ? 256 : 4096, tp = isc ? pos - 4096 : pos;
        if (o < 33) { float f;
            if (o == 0) f = (float)tp / (float)(Lf - 1);
            else { const int i = (o - 1) & 15; const float fr = 1e-4f + (float)i * ((15.0f - 1e-4f) / 15.0f); const float rev = fr * (float)tp / (float)Lf; f = (o <= 16) ? cos_rev(rev) : -sin_rev(rev); }
            feat[pl * 33 + o] = f; }
        __syncthreads();
        float a = b1[o];
#pragma unroll 3
        for (int i = 0; i < 33; ++i) a += feat[pl * 33 + i] * w1[i * 64 + o];
        h1[pl * 64 + o] = sin_rad(fq[o] * a);
        __syncthreads();
        float b = b2[o];
#pragma unroll 4
        for (int j = 0; j < 64; ++j) b += h1[pl * 64 + j] * w2[j * 64 + o];
        FH2[(size_t)pos * 64 + o] = sin_rad(fq[o] * b);
        __syncthreads();
    }
}
__device__ __forceinline__ void ph_norm(const float* xlat, const float* xctx, const float* g, const float* modl, int sh_off, int sc_off, bf16* H, int Mrows, int wave, int lane) {
    const int gw = blockIdx.x * NWAVES + wave, NGW = gridDim.x * NWAVES;
    for (int m = gw; m < Mrows; m += NGW) {
        const float* xr; int r;
        if (m < ML) { xr = xlat + (size_t)m * D; r = m >> 12; } else { xr = xctx + (size_t)(m - ML) * D; r = 4; }
        const float* mv = modl + (size_t)r * 12288;
        f32x4 v[8]; float ss = 0.f;
#pragma unroll
        for (int j = 0; j < 8; ++j) { v[j] = *(const f32x4*)(xr + (lane + 64 * j) * 4); ss += (v[j].x * v[j].x + v[j].y * v[j].y) + (v[j].z * v[j].z + v[j].w * v[j].w); }
        const float rstd = 1.0f / sqrtf(wave_sum(ss) * (1.0f / D) + EPS);
#pragma unroll
        for (int j = 0; j < 8; ++j) { const int idx = (lane + 64 * j) * 4;
            const f32x4 gg = *(const f32x4*)(g + idx), sh = *(const f32x4*)(mv + sh_off + idx), sc = *(const f32x4*)(mv + sc_off + idx);
            const f32x4 y = v[j] * rstd * gg * (sc + 1.0f) + sh;
            v2u w; w.x = pk2(y.x, y.y); w.y = pk2(y.z, y.w);
            *(v2u*)(H + (size_t)m * D + idx) = w; }
    }
}

__device__ __forceinline__ void fft_dif(LAS f32x2* buf, int tid) {
    for (int s = 4096; s >= 1; s >>= 1) {
        const float inv2s = 0.5f / (float)s;
#pragma unroll
        for (int i = 0; i < 8; ++i) { const int idx = tid + 512 * i, j = idx & (s - 1), a = ((idx - j) << 1) + j, b = a + s;
            const f32x2 u = buf[a], v = buf[b]; const float fr = (float)j * inv2s; const float c = __builtin_amdgcn_cosf(fr), sn = __builtin_amdgcn_sinf(fr);
            buf[a] = u + v; const float dx = u.x - v.x, dy = u.y - v.y;
            buf[b] = (f32x2){dx * c + dy * sn, dy * c - dx * sn}; }
        __syncthreads();
    }
}
__device__ __forceinline__ void fft_idit(LAS f32x2* buf, int tid) {
    for (int s = 1; s <= 4096; s <<= 1) {
        const float inv2s = 0.5f / (float)s;
#pragma unroll
        for (int i = 0; i < 8; ++i) { const int idx = tid + 512 * i, j = idx & (s - 1), a = ((idx - j) << 1) + j, b = a + s;
            const f32x2 u = buf[a], q = buf[b]; const float fr = (float)j * inv2s; const float c = __builtin_amdgcn_cosf(fr), sn = __builtin_amdgcn_sinf(fr);
            const f32x2 v = (f32x2){q.x * c - q.y * sn, q.x * sn + q.y * c};
            buf[a] = u + v; buf[b] = u - v; }
        __syncthreads();
    }
}
__device__ __forceinline__ float block_sum(float v, LAS float* red, int tid) {
    v = wave_sum(v);
    __syncthreads();
    if ((tid & 63) == 0) red[tid >> 6] = v;
    __syncthreads();
    float s = 0.f;
#pragma unroll
    for (int i = 0; i < 8; ++i) s += red[i];
    return s;
}
__device__ __forceinline__ float hy_delta(int c) { const float d0 = -4.605170185988091f / 0.3f, d1 = -4.605170185988091f / 1.5f; return fabsf(d0 + (d1 - d0) * ((float)c / 1023.0f)); }
__device__ __forceinline__ void ph_filt2(const Args& A, int l, LAS unsigned char* lds, int tid) {
    LAS f32x2* buf = (LAS f32x2*)lds; LAS float* w3s = (LAS float*)(lds + 65536); LAS float* red = w3s + 128;
    const float* w3 = inp(I_FW3) + (size_t)l * 64 * 4096; const float* FH2 = (const float*)(wsb() + WS_FH2);
    f32x2* KF = (f32x2*)(wsb() + WS_KF); float* TAPC = (float*)(wsb() + WS_TAPC);
    for (int u = blockIdx.x; u < 2048; u += gridDim.x) {
        const int o = u >> 10, c = u & 1023;
        __syncthreads();
        if (tid < 128) w3s[tid] = w3[(size_t)(tid & 63) * 4096 + o * 2048 + (tid >> 6) * 1024 + c];
        __syncthreads();
        const float delta = hy_delta(c); float ssq = 0.f;
#pragma nounroll
        for (int i = 0; i < 8; ++i) { const int t = tid + 512 * i; const f32x4* row = (const f32x4*)(FH2 + (size_t)t * 64); float af = 0.f, ab = 0.f;
#pragma unroll 4
            for (int j4 = 0; j4 < 16; ++j4) { const f32x4 hv = row[j4];
                af += hv.x * w3s[4 * j4] + hv.y * w3s[4 * j4 + 1] + hv.z * w3s[4 * j4 + 2] + hv.w * w3s[4 * j4 + 3];
                ab += hv.x * w3s[64 + 4 * j4] + hv.y * w3s[64 + 4 * j4 + 1] + hv.z * w3s[64 + 4 * j4 + 2] + hv.w * w3s[64 + 4 * j4 + 3]; }
            const float dec = __expf(-((float)t / 4095.0f) * delta); const float tf = af * dec, tb = ab * dec;
            buf[t] = (f32x2){tf, 0.f}; ssq += tf * tf;
            if (t >= 1) { buf[8192 - t] = (f32x2){tb, 0.f}; ssq += tb * tb; } else buf[4096] = (f32x2){0.f, 0.f}; }
        const float tot = block_sum(ssq, red, tid); const float scl = 1.0f / sqrtf(tot + EPS);
        for (int i = 0; i < 16; ++i) { const int p = tid + 512 * i; f32x2 v = buf[p]; v.x *= scl; buf[p] = v; }
        __syncthreads();
        fft_dif(buf, tid);
        f32x2* dst = KF + (size_t)(o * 1024 + c) * 8192;
        for (int i = 0; i < 16; ++i) { const int p = tid + 512 * i; dst[p] = buf[p]; }
    }
    for (int u = blockIdx.x; u < 2048; u += gridDim.x) {
        const int o = u >> 10, c = u & 1023, dir = tid >> 8, m = tid & 255;
        __syncthreads();
        if (tid < 128) w3s[tid] = w3[(size_t)(tid & 63) * 4096 + o * 2048 + (tid >> 6) * 1024 + c];
        __syncthreads();
        const f32x4* row = (const f32x4*)(FH2 + (size_t)(4096 + m) * 64); float a = 0.f;
#pragma unroll
        for (int j4 = 0; j4 < 16; ++j4) { const f32x4 hv = row[j4]; a += hv.x * w3s[dir * 64 + 4 * j4] + hv.y * w3s[dir * 64 + 4 * j4 + 1] + hv.z * w3s[dir * 64 + 4 * j4 + 2] + hv.w * w3s[dir * 64 + 4 * j4 + 3]; }
        const float val = a * __expf(-((float)m / 255.0f) * hy_delta(c));
        const float tot = block_sum((dir == 0 || m >= 1) ? val * val : 0.f, red, tid);
        TAPC[((size_t)(o * 2 + dir) * 1024 + c) * 256 + m] = val / sqrtf(tot + EPS);
    }
}

__device__ __forceinline__ void ph_hyprep(const Args& A, int l, LAS unsigned char* lds, int tid) {
    LAS bf16* T = (LAS bf16*)lds;
    const bf16* Z = (const bf16*)(wsb() + WS_Z); bf16* HYT = (bf16*)(wsb() + WS_HYT);
    const float* cw = inp(I_HCW) + (size_t)l * 3 * 3072; const float* cb = inp(I_HCB) + (size_t)l * 3072;
    for (int u = blockIdx.x; u < 3072; u += gridDim.x) {
        const int cg = u % 12, tt = (u / 12) & 63, b = u / 768;
        __syncthreads();
        for (int q = tid; q < 66 * 32; q += 512) { const int r = q >> 5, ch8 = q & 31, t = tt * 64 - 1 + r;
            v4u v = (v4u){0u, 0u, 0u, 0u};
            if (t >= 0 && t < SEQ) v = *(const v4u*)(Z + (size_t)(b * SEQ + t) * INW + C_HY + cg * 256 + ch8 * 8);
            *(LAS v4u*)(T + r * 264 + ch8 * 8) = v; }
        __syncthreads();
        const int ch = tid & 255, half = tid >> 8, gch = cg * 256 + ch;
        const float w0 = cw[gch], w1 = cw[3072 + gch], w2 = cw[6144 + gch], bb = cb[gch];
        const int part = gch >> 10, c = gch & 1023;
        bf16* outp = HYT + ((size_t)(part * NB + b) * 1024 + c) * SEQ + tt * 64 + half * 32;
#pragma unroll
        for (int tq = 0; tq < 4; ++tq) { float vv[8];
#pragma unroll
            for (int e = 0; e < 8; ++e) { const int tl = half * 32 + tq * 8 + e;
                vv[e] = w0 * bf1(T[tl * 264 + ch]) + w1 * bf1(T[(tl + 1) * 264 + ch]) + w2 * bf1(T[(tl + 2) * 264 + ch]) + bb; }
            v4u w; w.x = pk2(vv[0], vv[1]); w.y = pk2(vv[2], vv[3]); w.z = pk2(vv[4], vv[5]); w.w = pk2(vv[6], vv[7]);
            *(v4u*)(outp + tq * 8) = w; }
    }
}
__device__ __forceinline__ void ph_hyctx(const Args& A, int l, LAS unsigned char* lds, int tid) {
    LAS float* S = (LAS float*)lds;
    const bf16* Z = (const bf16*)(wsb() + WS_Z); bf16* YS = (bf16*)(wsb() + WS_YS); const float* TAPC = (const float*)(wsb() + WS_TAPC);
    const float* cw = inp(I_HCW) + (size_t)l * 3 * 3072; const float* cb = inp(I_HCB) + (size_t)l * 3072; const float* hb = inp(I_HBIAS) + (size_t)l * 2 * 1024;
    const int cc = tid >> 8, t = tid & 255;
    LAS float* sv = S + cc * 2048; LAS float* sx1 = sv + 256; LAS float* sx2 = sv + 512; LAS float* sy1 = sv + 768;
    LAS float* tf0 = sv + 1024; LAS float* tb0 = sv + 1280; LAS float* tf1 = sv + 1536; LAS float* tb1 = sv + 1792;
    for (int u = blockIdx.x; u < 2048; u += gridDim.x) {
        const int b = u >> 9, c = (u & 511) * 2 + cc;
        __syncthreads();
        float pv[3];
#pragma unroll
        for (int part = 0; part < 3; ++part) { const int gch = part * 1024 + c; const bf16* zp = Z + (size_t)(ML + b * CL + t) * INW + C_HY + gch;
            const float zm = (t > 0) ? bf1(zp[-(ptrdiff_t)INW]) : 0.f, z0 = bf1(zp[0]), zq = (t < CL - 1) ? bf1(zp[INW]) : 0.f;
            pv[part] = cw[gch] * zm + cw[3072 + gch] * z0 + cw[6144 + gch] * zq + cb[gch]; }
        sx1[t] = pv[0]; sx2[t] = pv[1]; sv[t] = pv[2];
        tf0[t] = TAPC[((size_t)(0 * 2 + 0) * 1024 + c) * 256 + t]; tb0[t] = TAPC[((size_t)(0 * 2 + 1) * 1024 + c) * 256 + t];
        tf1[t] = TAPC[((size_t)(1 * 2 + 0) * 1024 + c) * 256 + t]; tb1[t] = TAPC[((size_t)(1 * 2 + 1) * 1024 + c) * 256 + t];
        __syncthreads();
        float acc = 0.f;
        for (int s = 0; s <= t; ++s) acc += sv[s] * tf0[t - s];
        for (int s = t + 1; s < CL; ++s) acc += sv[s] * tb0[s - t];
        const float y1 = pv[0] * (acc + hb[c] * pv[2]);
        sy1[t] = y1;
        __syncthreads();
        acc = 0.f;
        for (int s = 0; s <= t; ++s) acc += sy1[s] * tf1[t - s];
        for (int s = t + 1; s < CL; ++s) acc += sy1[s] * tb1[s - t];
        const float y = pv[1] * (acc + hb[1024 + c] * y1);
        YS[(size_t)(ML + b * CL + t) * 1024 + c] = (bf16)f2bf(y);
    }
}
__device__ __forceinline__ void unpack8(v4u v, float (&x)[8]) { x[0] = bflo(v.x); x[1] = bfhi(v.x); x[2] = bflo(v.y); x[3] = bfhi(v.y); x[4] = bflo(v.z); x[5] = bfhi(v.z); x[6] = bflo(v.w); x[7] = bfhi(v.w); }
__device__ __forceinline__ v4u pack8(const float (&x)[8]) { v4u w; w.x = pk2(x[0], x[1]); w.y = pk2(x[2], x[3]); w.z = pk2(x[4], x[5]); w.w = pk2(x[6], x[7]); return w; }
__device__ __forceinline__ void rope8(float (&lo)[8], float (&hi)[8], const f32x2* rt) {
#pragma unroll
    for (int e = 0; e < 8; ++e) { const f32x2 cs = rt[e]; const float a = lo[e], b = hi[e]; lo[e] = a * cs.x - b * cs.y; hi[e] = b * cs.x + a * cs.y; }
}
__device__ __forceinline__ void vt_store(LAS bf16* Vt, int ld, int d0, int r, v4u vv) {
    Vt[(d0 + 0) * ld + r] = (bf16)(vv.x & 0xffffu); Vt[(d0 + 1) * ld + r] = (bf16)(vv.x >> 16);
    Vt[(d0 + 2) * ld + r] = (bf16)(vv.y & 0xffffu); Vt[(d0 + 3) * ld + r] = (bf16)(vv.y >> 16);
    Vt[(d0 + 4) * ld + r] = (bf16)(vv.z & 0xffffu); Vt[(d0 + 5) * ld + r] = (bf16)(vv.z >> 16);
    Vt[(d0 + 6) * ld + r] = (bf16)(vv.w & 0xffffu); Vt[(d0 + 7) * ld + r] = (bf16)(vv.w >> 16);
}
constexpr float LOG2E = 1.4426950408889634f;
__device__ __forceinline__ void ph_ret1(const Args& A, int l, int nctx_units, LAS unsigned char* lds, int tid) {
    LAS bf16* KfT = (LAS bf16*)lds; LAS bf16* KbT = KfT + 64 * 136; LAS bf16* Vt = KbT + 64 * 136;
    const bf16* Z = (const bf16*)(wsb() + WS_Z); float* KV = (float*)(wsb() + WS_KV); const f32x2* rope = (const f32x2*)(wsb() + WS_ROPE);
    const int lane = tid & 63, w = tid >> 6, g = lane >> 4, li = lane & 15;
    for (int uid = blockIdx.x; uid < 1024 + nctx_units; uid += gridDim.x) {
        const bool isc = uid >= 1024; int b, h, n, ci; size_t m0;
        if (!isc) { b = uid >> 8; h = (uid >> 5) & 7; n = uid & 31; m0 = (size_t)b * SEQ + n * 128; ci = 2 + n; }
        else { const int i = uid - 1024; b = i >> 4; h = (i >> 1) & 7; n = i & 1; m0 = (size_t)ML + b * CL + n * 128; ci = n; }
        const float lgf = inp(I_RDEC)[(l * 2 + 0) * 8 + h] * LOG2E, lgb = inp(I_RDEC)[(l * 2 + 1) * 8 + h] * LOG2E;
        __syncthreads();
        { const int tok = tid >> 2, pp = tid & 3, a = (pp & 1) + ((pp >> 1) << 2);
            const bf16* kr = Z + (m0 + tok) * INW + C_RK + h * 64;
            float lo[8], hi[8]; unpack8(*(const v4u*)(kr + 8 * a), lo); unpack8(*(const v4u*)(kr + 8 * a + 16), hi);
            if (!isc) { const int t = n * 128 + tok; const int pos = (a < 4) ? (t >> 6) : (t & 63); rope8(lo, hi, rope + pos * 16 + 8 * (a & 1)); }
            const float zf = ex2(lgf * (float)(127 - tok)) * 0.125f, zb = ex2(lgb * (float)tok) * 0.125f;
#pragma unroll
            for (int e = 0; e < 8; ++e) { const int d = 8 * a + e;
                KfT[d * 136 + tok] = (bf16)f2bf(lo[e] * zf); KbT[d * 136 + tok] = (bf16)f2bf(lo[e] * zb);
                KfT[(d + 16) * 136 + tok] = (bf16)f2bf(hi[e] * zf); KbT[(d + 16) * 136 + tok] = (bf16)f2bf(hi[e] * zb); } }
        for (int q = tid; q < 2048; q += 512) { const int r = q >> 4, ch = q & 15; vt_store(Vt, 136, ch * 8, r, *(const v4u*)(Z + (m0 + r) * INW + C_RV + h * 128 + ch * 8)); }
        __syncthreads();
        bf16x8 af[4];
#pragma unroll
        for (int ks = 0; ks < 4; ++ks) af[ks] = *(const LAS bf16x8*)(Vt + (16 * w + li) * 136 + 32 * ks + 8 * g);
#pragma unroll
        for (int dir = 0; dir < 2; ++dir) { const LAS bf16* KT = dir ? KbT : KfT;
            float* dst = KV + ((size_t)((b * 8 + h) * 2 + dir) * 34 + ci) * 8192;
#pragma unroll
            for (int nc = 0; nc < 4; ++nc) { f32x4 acc = (f32x4){0.f, 0.f, 0.f, 0.f};
#pragma unroll
                for (int ks = 0; ks < 4; ++ks) acc = mfma16(af[ks], *(const LAS bf16x8*)(KT + (16 * nc + li) * 136 + 32 * ks + 8 * g), acc);
#pragma unroll
                for (int j = 0; j < 4; ++j) dst[(16 * w + 4 * g + j) * 64 + 16 * nc + li] = acc[j]; } }
    }
}
__device__ __forceinline__ void ph_natt(const Args& A, int l, int nctx_units, LAS unsigned char* lds, int tid) {
    LAS bf16* Qs = (LAS bf16*)lds; LAS bf16* Ks = Qs + 128 * 136; LAS bf16* Vt = Ks + 64 * 136; LAS float* rpbs = (LAS float*)(Vt + 128 * 68);
    const bf16* Z = (const bf16*)(wsb() + WS_Z); bf16* YS = (bf16*)(wsb() + WS_YS) + (size_t)2 * MT * 1024;
    const int lane = tid & 63, w = tid >> 6, g = lane >> 4, li = lane & 15;
    const float SCALE = 0.08838834764831845f;
    for (int uid = blockIdx.x; uid < 1024 + nctx_units; uid += gridDim.x) {
        const bool isc = uid >= 1024; int b, h, rp = 0; size_t m0;
        if (!isc) { b = uid >> 8; h = (uid >> 5) & 7; rp = uid & 31; m0 = (size_t)b * SEQ + rp * 128; }
        else { const int i = uid - 1024; b = i >> 4; h = (i >> 1) & 7; m0 = (size_t)ML + b * CL + (i & 1) * 128; }
        const size_t mc0 = (size_t)ML + b * CL;
        __syncthreads();
        for (int q = tid; q < 2048; q += 512) { const int r = q >> 4, ch = q & 15; *(LAS v4u*)(Qs + r * 136 + ch * 8) = *(const v4u*)(Z + (m0 + r) * INW + C_NQ + h * 128 + ch * 8); }
        if (!isc) for (int i = tid; i < 465; i += 512) rpbs[i] = inp(I_RPB)[((size_t)l * 8 + h) * 465 + i];
        __syncthreads();
        bf16x8 qf[4];
#pragma unroll
        for (int ks = 0; ks < 4; ++ks) qf[ks] = *(const LAS bf16x8*)(Qs + (16 * w + li) * 136 + 32 * ks + 8 * g);
        f32x4 o[8];
#pragma unroll
        for (int nd = 0; nd < 8; ++nd) o[nd] = (f32x4){0.f, 0.f, 0.f, 0.f};
        float mrun = -1e30f, lrun = 0.f;
        const int qr = 2 * rp + (w >> 2), qc = 16 * (w & 3) + li;
        const int cs = min(max(qc - 8, 0), 48), rs_w = min(max(qr - 4, 0), 56);
        const int kr_lo = min(max(2 * rp - 4, 0), 56), kr_hi = min(max(2 * rp - 3, 0), 56) + 7;
        const int nwin = isc ? 0 : (kr_hi - kr_lo + 1);
        for (int t = 0; t < nwin + 4; ++t) {
            const bool win = t < nwin; const int kr = kr_lo + t;
            const size_t mk0 = win ? ((size_t)b * SEQ + kr * 64) : (mc0 + (t - nwin) * 64);
            __syncthreads();
            for (int q = tid; q < 1024; q += 512) { const int r = q >> 4, ch = q & 15; const bf16* zr = Z + (mk0 + r) * INW + h * 128 + ch * 8;
                *(LAS v4u*)(Ks + r * 136 + ch * 8) = *(const v4u*)(zr + C_NK);
                vt_store(Vt, 68, ch * 8, r, *(const v4u*)(zr + C_NV)); }
            __syncthreads();
            const bool active = !win || (kr >= rs_w && kr <= rs_w + 7);
            if (active) {
                f32x4 s[4];
#pragma unroll
                for (int n = 0; n < 4; ++n) { s[n] = (f32x4){0.f, 0.f, 0.f, 0.f};
#pragma unroll
                    for (int ks = 0; ks < 4; ++ks) s[n] = mfma16(*(const LAS bf16x8*)(Ks + (16 * n + li) * 136 + 32 * ks + 8 * g), qf[ks], s[n]); }
                float tmax = -1e30f;
#pragma unroll
                for (int n = 0; n < 4; ++n)
#pragma unroll
                    for (int j = 0; j < 4; ++j) { float v = s[n][j] * SCALE;
                        if (win) { const int kc = 16 * n + 4 * g + j; const bool valid = (kc >= cs) && (kc < cs + 16);
                            const int dc = min(max(kc - qc + 15, 0), 30), dr = min(max(kr - qr + 7, 0), 14);
                            v = valid ? v + rpbs[dr * 31 + dc] : -1e30f; }
                        s[n][j] = v; tmax = fmaxf(tmax, v); }
                tmax = fmaxf(tmax, __shfl_xor(tmax, 16)); tmax = fmaxf(tmax, __shfl_xor(tmax, 32));
                const float mnew = fmaxf(mrun, tmax), alpha = __expf(mrun - mnew);
                float psum = 0.f;
#pragma unroll
                for (int n = 0; n < 4; ++n)
#pragma unroll
                    for (int j = 0; j < 4; ++j) { const float pv = __expf(s[n][j] - mnew); s[n][j] = pv; psum += pv; }
                psum += __shfl_xor(psum, 16); psum += __shfl_xor(psum, 32);
                lrun = lrun * alpha + psum; mrun = mnew;
#pragma unroll
                for (int nd = 0; nd < 8; ++nd) o[nd] = o[nd] * alpha;
#pragma unroll
                for (int kk = 0; kk < 2; ++kk) {
                    const bf16x8 pf = mk8(pk2(s[2 * kk][0], s[2 * kk][1]), pk2(s[2 * kk][2], s[2 * kk][3]), pk2(s[2 * kk + 1][0], s[2 * kk + 1][1]), pk2(s[2 * kk + 1][2], s[2 * kk + 1][3]));
#pragma unroll
                    for (int nd = 0; nd < 8; ++nd) { const LAS bf16* vp = Vt + (16 * nd + li) * 68 + 32 * kk + 4 * g;
                        const v2u lo = *(const LAS v2u*)vp, hi = *(const LAS v2u*)(vp + 16);
                        o[nd] = mfma16(mk8(lo.x, lo.y, hi.x, hi.y), pf, o[nd]); } }
            }
        }
        const float inv = 1.0f / lrun; const size_t mrow = m0 + 16 * w + li;
#pragma unroll
        for (int nd = 0; nd < 8; ++nd) { v2u wv; wv.x = pk2(o[nd][0] * inv, o[nd][1] * inv); wv.y = pk2(o[nd][2] * inv, o[nd][3] * inv);
            *(v2u*)(YS + mrow * 1024 + h * 128 + 16 * nd + 4 * g) = wv; }
    }
}

__device__ __forceinline__ void ph_hyfft(const Args& A, int l, LAS unsigned char* lds, int tid) {
    LAS f32x2* buf = (LAS f32x2*)lds;
    const bf16* HYT = (const bf16*)(wsb() + WS_HYT); bf16* YT = (bf16*)(wsb() + WS_YT); const f32x2* KF = (const f32x2*)(wsb() + WS_KF);
    const float* hb = inp(I_HBIAS) + (size_t)l * 2 * 1024;
    for (int u = blockIdx.x; u < 2048; u += gridDim.x) {
        const int c = u >> 1, b0 = (u & 1) * 2;
        const bf16* x1p = HYT + ((size_t)(0 * NB + b0) * 1024 + c) * SEQ; const bf16* x2p = HYT + ((size_t)(1 * NB + b0) * 1024 + c) * SEQ; const bf16* vp = HYT + ((size_t)(2 * NB + b0) * 1024 + c) * SEQ;
        const size_t bstr = (size_t)1024 * SEQ;
        float y0[8], y1[8];
        __syncthreads();
#pragma unroll
        for (int i = 0; i < 8; ++i) { const int t = tid + 512 * i; y0[i] = bf1(vp[t]); y1[i] = bf1(vp[bstr + t]); buf[t] = (f32x2){y0[i], y1[i]}; buf[4096 + t] = (f32x2){0.f, 0.f}; }
        __syncthreads();
#pragma unroll
        for (int ord = 0; ord < 2; ++ord) {
            fft_dif(buf, tid);
            const f32x2* kf = KF + (size_t)(ord * 1024 + c) * 8192;
            for (int i = 0; i < 16; ++i) { const int p = tid + 512 * i; const f32x2 k = kf[p], v = buf[p]; buf[p] = (f32x2){v.x * k.x - v.y * k.y, v.x * k.y + v.y * k.x}; }
            __syncthreads();
            fft_idit(buf, tid);
            const bf16* xp = ord ? x2p : x1p; const float bias = hb[ord * 1024 + c];
#pragma unroll
            for (int i = 0; i < 8; ++i) { const int t = tid + 512 * i; const f32x2 cv = buf[t] * (1.0f / 8192.0f);
                y0[i] = bf1(xp[t]) * (cv.x + bias * y0[i]); y1[i] = bf1(xp[bstr + t]) * (cv.y + bias * y1[i]);
                if (ord == 0) { buf[t] = (f32x2){y0[i], y1[i]}; buf[4096 + t] = (f32x2){0.f, 0.f}; } }
            __syncthreads();
        }
        bf16* o0 = YT + ((size_t)b0 * 1024 + c) * SEQ;
#pragma unroll
        for (int i = 0; i < 8; ++i) { const int t = tid + 512 * i; o0[t] = (bf16)f2bf(y0[i]); o0[bstr + t] = (bf16)f2bf(y1[i]); }
    }
}
__device__ __forceinline__ void ph_scan(const Args& A, int l, int tid) {
    float* KV = (float*)(wsb() + WS_KV);
    for (int gt = blockIdx.x * 512 + tid; gt < NB * 8 * 2 * 2048; gt += gridDim.x * 512) {
        const int bhd = gt >> 11, e4 = gt & 2047, dir = bhd & 1, h = (bhd >> 1) & 7;
        const float gC = ex2(inp(I_RDEC)[(l * 2 + dir) * 8 + h] * LOG2E * 128.0f);
        f32x4* base = (f32x4*)(KV + (size_t)bhd * 34 * 8192) + e4;
        f32x4 s = (f32x4){0.f, 0.f, 0.f, 0.f};
#pragma unroll 2
        for (int step = 0; step < 34; ++step) { const int ci = (dir == 0) ? step : (step == 0 ? 1 : (step == 1 ? 0 : 35 - step));
            const f32x4 tmp = base[(size_t)ci * 2048]; base[(size_t)ci * 2048] = s; s = s * gC + tmp; }
    }
}

__device__ __forceinline__ void ph_hypost(const Args& A, LAS unsigned char* lds, int tid) {
    LAS bf16* T = (LAS bf16*)lds;
    const bf16* YT = (const bf16*)(wsb() + WS_YT); bf16* YS = (bf16*)(wsb() + WS_YS);
    for (int u = blockIdx.x; u < 1024; u += gridDim.x) {
        const int cg = u & 3, tt = (u >> 2) & 63, b = u >> 8;
        __syncthreads();
        for (int q = tid; q < 2048; q += 512) { const int c = q >> 3, t8 = q & 7;
            *(LAS v4u*)(T + c * 72 + t8 * 8) = *(const v4u*)(YT + ((size_t)b * 1024 + cg * 256 + c) * SEQ + tt * 64 + t8 * 8); }
        __syncthreads();
        const int t = tid >> 3, c32 = tid & 7;
#pragma unroll
        for (int q = 0; q < 4; ++q) { const int cb = c32 * 32 + q * 8; v4u w;
            w.x = (unsigned)T[(cb + 0) * 72 + t] | ((unsigned)T[(cb + 1) * 72 + t] << 16); w.y = (unsigned)T[(cb + 2) * 72 + t] | ((unsigned)T[(cb + 3) * 72 + t] << 16);
            w.z = (unsigned)T[(cb + 4) * 72 + t] | ((unsigned)T[(cb + 5) * 72 + t] << 16); w.w = (unsigned)T[(cb + 6) * 72 + t] | ((unsigned)T[(cb + 7) * 72 + t] << 16);
            *(v4u*)(YS + (size_t)(b * SEQ + tt * 64 + t) * 1024 + cg * 256 + cb) = w; }
    }
}
__device__ __forceinline__ void ph_ret3(const Args& A, int l, int nctx_units, LAS unsigned char* lds, int tid) {
    LAS bf16* Qs = (LAS bf16*)lds; LAS bf16* Ks = Qs + 128 * 72; LAS bf16* Vt = Ks + 128 * 72; LAS bf16* Sf = Vt + 128 * 136; LAS bf16* Sb = Sf + 128 * 72;
    const bf16* Z = (const bf16*)(wsb() + WS_Z); const float* KV = (const float*)(wsb() + WS_KV); const f32x2* rope = (const f32x2*)(wsb() + WS_ROPE);
    bf16* YS = (bf16*)(wsb() + WS_YS) + (size_t)MT * 1024;
    const int lane = tid & 63, w = tid >> 6, g = lane >> 4, li = lane & 15;
    for (int uid = blockIdx.x; uid < 1024 + nctx_units; uid += gridDim.x) {
        const bool isc = uid >= 1024; int b, h, n, ci; size_t m0;
        if (!isc) { b = uid >> 8; h = (uid >> 5) & 7; n = uid & 31; m0 = (size_t)b * SEQ + n * 128; ci = 2 + n; }
        else { const int i = uid - 1024; b = i >> 4; h = (i >> 1) & 7; n = i & 1; m0 = (size_t)ML + b * CL + n * 128; ci = n; }
        const float lgf = inp(I_RDEC)[(l * 2 + 0) * 8 + h] * LOG2E, lgb = inp(I_RDEC)[(l * 2 + 1) * 8 + h] * LOG2E;
        __syncthreads();
        { const int tok = tid >> 2, pp = tid & 3, a = (pp & 1) + ((pp >> 1) << 2);
            const int t = n * 128 + tok; const int pos = (a < 4) ? (t >> 6) : (t & 63); const f32x2* rt = rope + pos * 16 + 8 * (a & 1);
            const bf16* qr = Z + (m0 + tok) * INW + C_RQ + h * 64; const bf16* kr = Z + (m0 + tok) * INW + C_RK + h * 64;
            float lo[8], hi[8];
            unpack8(*(const v4u*)(qr + 8 * a), lo); unpack8(*(const v4u*)(qr + 8 * a + 16), hi);
            if (!isc) rope8(lo, hi, rt);
            *(LAS v4u*)(Qs + tok * 72 + 8 * a) = pack8(lo); *(LAS v4u*)(Qs + tok * 72 + 8 * a + 16) = pack8(hi);
            unpack8(*(const v4u*)(kr + 8 * a), lo); unpack8(*(const v4u*)(kr + 8 * a + 16), hi);
            if (!isc) rope8(lo, hi, rt);
#pragma unroll
            for (int e = 0; e < 8; ++e) { lo[e] *= 0.125f; hi[e] *= 0.125f; }
            *(LAS v4u*)(Ks + tok * 72 + 8 * a) = pack8(lo); *(LAS v4u*)(Ks + tok * 72 + 8 * a + 16) = pack8(hi); }
        for (int q = tid; q < 2048; q += 512) { const int r = q >> 4, ch = q & 15; vt_store(Vt, 136, ch * 8, r, *(const v4u*)(Z + (m0 + r) * INW + C_RV + h * 128 + ch * 8)); }
#pragma unroll
        for (int dir = 0; dir < 2; ++dir) { const f32x4* src = (const f32x4*)(KV + ((size_t)((b * 8 + h) * 2 + dir) * 34 + ci) * 8192); LAS bf16* S = dir ? Sb : Sf;
            for (int q = tid; q < 2048; q += 512) { const f32x4 v = src[q]; v2u wv; wv.x = pk2(v.x, v.y); wv.y = pk2(v.z, v.w); *(LAS v2u*)(S + (q >> 4) * 72 + (q & 15) * 4) = wv; } }
        __syncthreads();
        const int iq = 16 * w + li;
        bf16x8 qf[2];
#pragma unroll
        for (int ks = 0; ks < 2; ++ks) qf[ks] = *(const LAS bf16x8*)(Qs + iq * 72 + 32 * ks + 8 * g);
        f32x4 s[8];
#pragma unroll
        for (int nn = 0; nn < 8; ++nn) { s[nn] = (f32x4){0.f, 0.f, 0.f, 0.f};
#pragma unroll
            for (int ks = 0; ks < 2; ++ks) s[nn] = mfma16(*(const LAS bf16x8*)(Ks + (16 * nn + li) * 72 + 32 * ks + 8 * g), qf[ks], s[nn]);
#pragma unroll
            for (int j = 0; j < 4; ++j) { const int d = iq - (16 * nn + 4 * g + j); s[nn][j] *= (d >= 0) ? ex2(lgf * (float)d) : ex2(lgb * (float)(-d)); } }
        f32x4 o[8];
#pragma unroll
        for (int nd = 0; nd < 8; ++nd) o[nd] = (f32x4){0.f, 0.f, 0.f, 0.f};
#pragma unroll
        for (int kk = 0; kk < 4; ++kk) {
            const bf16x8 pf = mk8(pk2(s[2 * kk][0], s[2 * kk][1]), pk2(s[2 * kk][2], s[2 * kk][3]), pk2(s[2 * kk + 1][0], s[2 * kk + 1][1]), pk2(s[2 * kk + 1][2], s[2 * kk + 1][3]));
#pragma unroll
            for (int nd = 0; nd < 8; ++nd) { const LAS bf16* vp = Vt + (16 * nd + li) * 136 + 32 * kk + 4 * g;
                const v2u lo = *(const LAS v2u*)vp, hi = *(const LAS v2u*)(vp + 16);
                o[nd] = mfma16(mk8(lo.x, lo.y, hi.x, hi.y), pf, o[nd]); } }
        const float xif = ex2(lgf * (float)(iq + 1)), xib = ex2(lgb * (float)(128 - iq));
        float ss = 0.f;
#pragma unroll
        for (int nd = 0; nd < 8; ++nd) { f32x4 tf = (f32x4){0.f, 0.f, 0.f, 0.f}, tb = (f32x4){0.f, 0.f, 0.f, 0.f};
#pragma unroll
            for (int ks = 0; ks < 2; ++ks) { tf = mfma16(*(const LAS bf16x8*)(Sf + (16 * nd + li) * 72 + 32 * ks + 8 * g), qf[ks], tf);
                tb = mfma16(*(const LAS bf16x8*)(Sb + (16 * nd + li) * 72 + 32 * ks + 8 * g), qf[ks], tb); }
            o[nd] = o[nd] + tf * xif + tb * xib;
            ss += (o[nd][0] * o[nd][0] + o[nd][1] * o[nd][1]) + (o[nd][2] * o[nd][2] + o[nd][3] * o[nd][3]); }
        ss += __shfl_xor(ss, 16); ss += __shfl_xor(ss, 32);
        const float rn = 1.0f / sqrtf(ss * (1.0f / 128.0f) + EPS);
        const size_t mrow = m0 + iq;
#pragma unroll
        for (int nd = 0; nd < 8; ++nd) { const int dv = 16 * nd + 4 * g; const v2u gv = *(const v2u*)(Z + mrow * INW + C_RG + h * 128 + dv);
            const float g0 = bflo(gv.x), g1 = bfhi(gv.x), g2 = bflo(gv.y), g3 = bfhi(gv.y);
            v2u wv; wv.x = pk2(g0 / (1.0f + __expf(-g0)) * o[nd][0] * rn, g1 / (1.0f + __expf(-g1)) * o[nd][1] * rn);
            wv.y = pk2(g2 / (1.0f + __expf(-g2)) * o[nd][2] * rn, g3 / (1.0f + __expf(-g3)) * o[nd][3] * rn);
            *(v2u*)(YS + mrow * 1024 + h * 128 + dv) = wv; }
    }
}

__device__ __forceinline__ float gelu_t(float x) { const float u = 0.7978845608028654f * (x + 0.044715f * x * x * x); const float e = __expf(2.0f * u); return 0.5f * x * (2.0f - 2.0f / (1.0f + e)); }
__device__ __forceinline__ void ph_ffnmid(const Args& A, int l, int Mrows, int tid) {
    const bf16* AB = (const bf16*)(wsb() + WS_Z); bf16* U = (bf16*)(wsb() + WS_U);
    const float* cw = inp(I_FFCW) + (size_t)l * 3 * DFF; const float* cb = inp(I_FFCB) + (size_t)l * DFF;
    const int cgi = tid & 63, rsub = tid >> 6; const int nunits = (Mrows / 32) * 11;
    for (int u = blockIdx.x; u < nunits; u += gridDim.x) {
        const int cblk = u % 11, rblk = u / 11, col = cblk * 512 + cgi * 8;
        float w0[8], w1[8], w2[8], bb[8];
#pragma unroll
        for (int e = 0; e < 8; ++e) { w0[e] = cw[col + e]; w1[e] = cw[DFF + col + e]; w2[e] = cw[2 * DFF + col + e]; bb[e] = cb[col + e]; }
#pragma unroll
        for (int rr = 0; rr < 4; ++rr) { const int m = rblk * 32 + rr * 8 + rsub;
            const bool first = (m < ML) ? ((m & (SEQ - 1)) == 0) : ((m & (CL - 1)) == 0), last = (m < ML) ? ((m & (SEQ - 1)) == SEQ - 1) : ((m & (CL - 1)) == CL - 1);
            const bf16* ap = AB + (size_t)m * NFF + col;
            float am[8], a0[8], aq[8], bg[8];
            const v4u z4 = (v4u){0u, 0u, 0u, 0u};
            unpack8(first ? z4 : *(const v4u*)(ap - NFF), am); unpack8(*(const v4u*)ap, a0); unpack8(last ? z4 : *(const v4u*)(ap + NFF), aq); unpack8(*(const v4u*)(ap + DFF), bg);
            float r[8];
#pragma unroll
            for (int e = 0; e < 8; ++e) r[e] = gelu_t(w0[e] * am[e] + w1[e] * a0[e] + w2[e] * aq[e] + bb[e]) * bg[e];
            *(v4u*)(U + (size_t)m * DFF + col) = pack8(r); }
    }
}
__device__ __forceinline__ void ph_final(const Args& A, int wave, int lane) {
    const int gw = blockIdx.x * NWAVES + wave, NGW = gridDim.x * NWAVES; const float* g = inp(I_GF);
    for (int m = gw; m < ML; m += NGW) { float* xr = outb() + (size_t)m * D; f32x4 v[8]; float ss = 0.f;
#pragma unroll
        for (int j = 0; j < 8; ++j) { v[j] = *(const f32x4*)(xr + (lane + 64 * j) * 4); ss += (v[j].x * v[j].x + v[j].y * v[j].y) + (v[j].z * v[j].z + v[j].w * v[j].w); }
        const float rstd = 1.0f / sqrtf(wave_sum(ss) * (1.0f / D) + EPS);
#pragma unroll
        for (int j = 0; j < 8; ++j) { const int idx = (lane + 64 * j) * 4; *(f32x4*)(xr + idx) = v[j] * rstd * *(const f32x4*)(g + idx); }
    }
}
constexpr int SEQ_PER_LAYER = 11, NSEQ = 1 + DEPTH * SEQ_PER_LAYER + 1;
__global__ void __launch_bounds__(NWAVES * 64, 2) fwd(Args A) {
    extern __shared__ __attribute__((aligned(16))) unsigned char lds_raw[];
    LAS unsigned char* lds = (LAS unsigned char*)lds_raw;
    volatile LAS unsigned* MISC = (volatile LAS unsigned*)(lds + MISC_OFF);
    for (int u = threadIdx.x; u < (LDS_BYTES - LDSCTL_OFF) / 4; u += NWAVES * 64) ((LAS unsigned*)(lds + LDSCTL_OFF))[u] = 0u;
    __syncthreads();
    (void)xcd_barrier_post((unsigned*)(wsb() + WS_CTL) + CW_BAR, MISC + 8);
    const int lo = A.seq_lo, hi = A.seq_hi;
#define G ((int)gridDim.x)
#define RUN(s) (lo <= (s) && (s) < hi)
#define TID_HERE const int tid = otid(), lane = tid & 63, wave = __builtin_amdgcn_readfirstlane(tid >> 6); (void)lane; (void)wave
#ifdef ONLY
#define PH_ON(k) ((k) == ONLY)
#elif defined(SKIP)
#define PH_ON(k) ((k) != SKIP)
#else
#define PH_ON(k) true
#endif
#define SEAM(s) do { if (RUN((s) + 1)) { XcdBarrier bar_; bar_.bar = (unsigned*)(wsb() + WS_CTL) + CW_BAR; bar_.x = xb_xcc_id(); bar_.st = (volatile LAS unsigned*)(lds + MISC_OFF) + 8; xcd_barrier(bar_); } } while (0)
#define H ((bf16*)(wsb() + WS_H))
#define Z ((bf16*)(wsb() + WS_Z))
#define ACC ((bf16*)(wsb() + WS_ACC))
#define U ((bf16*)(wsb() + WS_U))
#define YS ((bf16*)(wsb() + WS_YS))
#define XC ((float*)(wsb() + WS_XC))
#define WIN ((const bf16*)(wsb() + WS_WIN))
#define WBR ((const bf16*)(wsb() + WS_WBR))
#define WOUT ((const bf16*)(wsb() + WS_WOUT))
#define WF1 ((const bf16*)(wsb() + WS_WF1))
#define WF2 ((const bf16*)(wsb() + WS_WF2))

    if (PH_ON(100) && RUN(0)) { TID_HERE; ph_prologue(A, lds, tid); SEAM(0); }

    for (int l = 0; l < DEPTH; ++l) {
        const int sb = 1 + l * SEQ_PER_LAYER;
        if (hi <= sb || lo >= sb + SEQ_PER_LAYER) continue;
        const bool lastl = (l == DEPTH - 1);
        const int Mrows = lastl ? ML : MT, nctx = lastl ? 0 : 64;
#define modl ((const float*)(wsb() + WS_MOD) + (size_t)l * 5 * 12288)
#define xlat_in ((l == 0) ? inp(I_X) : (const float*)outb())
#define xctx_in ((l == 0) ? inp(I_CTX) : (const float*)XC)

        if (PH_ON(0) && RUN(sb + 0)) { TID_HERE;
#ifndef NO_A1
            ph_convert(A, l, lds, wave, lane);
#endif
            __syncthreads();
#ifndef NO_A2
            ph_filt1(A, l, lds, tid);
#endif
#ifndef NO_A3
            ph_norm(xlat_in, xctx_in, inp(I_G1) + (size_t)l * D, modl, 0, D, H, MT, wave, lane);
#endif
            SEAM(sb + 0);
        }
        if (PH_ON(1) && RUN(sb + 1)) { TID_HERE;
            { pg8::Gemm g{H, WIN, opq(MT), opq(INW), opq(D)}; pg8::StaticOrder S; S.init(g.M, g.N, G, (int)blockIdx.x);
              pg8::EpiStore E{Z, INW};
#ifndef NO_B1
              pg8::gemm_phase<pg8::EpiStore, pg8::StaticOrder, PG8_ALIGN, PG8_SP2>(lds, g, S, E);
#endif
 }
#ifndef NO_B2
            ph_filt2(A, l, lds, tid);
#endif
            SEAM(sb + 1);
        }
        if (PH_ON(2) && RUN(sb + 2)) { TID_HERE;
            ph_hyprep(A, l, lds, tid);
            ph_ret1(A, l, 64, lds, tid);
            ph_natt(A, l, nctx, lds, tid);
            if (!lastl) ph_hyctx(A, l, lds, tid);
            SEAM(sb + 2);
        }
        if (PH_ON(3) && RUN(sb + 3)) { TID_HERE;
#ifndef NO_D1
            ph_hyfft(A, l, lds, tid);
#endif
#ifndef NO_D2
            ph_scan(A, l, tid);
#endif
            SEAM(sb + 3);
        }
        if (PH_ON(4) && RUN(sb + 4)) { TID_HERE;
            ph_hypost(A, lds, tid);
            ph_ret3(A, l, nctx, lds, tid);
            SEAM(sb + 4);
        }
        if (PH_ON(5) && RUN(sb + 5)) { TID_HERE;
            __syncthreads();
            for (int i = 0; i < 3; ++i) {
                pg8::Gemm g{YS + (size_t)i * MT * 1024, WBR + (size_t)i * D * 1024, Mrows, opq(D), opq(1024)}; pg8::StaticOrder S; S.init(g.M, g.N, G, (int)blockIdx.x);
                pg8::EpiMerge E{ACC, Z + C_GT + i * D, INW, i == 0 ? 1 : 0};
                pg8::gemm_phase<pg8::EpiMerge, pg8::StaticOrder, PG8_ALIGN, PG8_SP2>(lds, g, S, E);
            }
            SEAM(sb + 5);
        }
        if (PH_ON(6) && RUN(sb + 6)) { TID_HERE;
            __syncthreads();
            pg8::Gemm g{ACC, WOUT, Mrows, opq(D), opq(D)}; pg8::StaticOrder S; S.init(g.M, g.N, G, (int)blockIdx.x);
            pg8::EpiResid E{xlat_in, xctx_in, outb(), XC, modl, 2 * D};
            pg8::gemm_phase<pg8::EpiResid, pg8::StaticOrder, PG8_ALIGN, PG8_SP2>(lds, g, S, E);
            SEAM(sb + 6);
        }
        if (PH_ON(7) && RUN(sb + 7)) { TID_HERE;
            ph_norm(outb(), XC, inp(I_G2) + (size_t)l * D, modl, 3 * D, 4 * D, H, Mrows, wave, lane);
            SEAM(sb + 7);
        }
        if (PH_ON(8) && RUN(sb + 8)) { TID_HERE;
            __syncthreads();
            pg8::Gemm g{H, WF1, Mrows, opq(NFF), opq(D)}; pg8::StaticOrder S; S.init(g.M, g.N, G, (int)blockIdx.x);
            pg8::EpiStore E{Z, NFF};
            pg8::gemm_phase<pg8::EpiStore, pg8::StaticOrder, PG8_ALIGN, PG8_SP2>(lds, g, S, E);
            SEAM(sb + 8);
        }
        if (PH_ON(9) && RUN(sb + 9)) { TID_HERE;
            ph_ffnmid(A, l, Mrows, tid);
            SEAM(sb + 9);
        }
        if (PH_ON(10) && RUN(sb + 10)) { TID_HERE;
            __syncthreads();
            pg8::Gemm g{U, WF2, Mrows, opq(D), opq(DFF)}; pg8::StaticOrder S; S.init(g.M, g.N, G, (int)blockIdx.x);
            pg8::EpiResid E{outb(), XC, outb(), XC, modl, 5 * D};
            pg8::gemm_phase<pg8::EpiResid, pg8::StaticOrder, PG8_ALIGN, PG8_SP2>(lds, g, S, E);
            SEAM(sb + 10);
        }
    }
    if (PH_ON(101) && RUN(NSEQ - 1)) { TID_HERE; ph_final(A, wave, lane); }
#undef RUN
#undef SEAM
#undef H
#undef Z
#undef ACC
#undef U
#undef YS
#undef XC
#undef WIN
#undef WBR
#undef WOUT
#undef WF1
#undef WF2
#undef G
#undef modl
#undef xlat_in
#undef xctx_in
}

extern "C" void kernel_launch(void* const* d_in, const int* in_sizes, int n_in, void* d_out, int out_size, void* d_ws, size_t ws_size, hipStream_t stream) {
    static int grid = 0;
    if (grid == 0) {
        if (n_in != 27 || out_size != ML * D || ws_size < WS_END) { fprintf(stderr, "kernel_launch: unexpected shapes (n_in %d out %d ws %zu need %zu)\n", n_in, out_size, ws_size, (size_t)WS_END); grid = -1; return; }
        int dev = 0, cus = 0, per_cu = 0;
        if (hipGetDevice(&dev) != hipSuccess || hipDeviceGetAttribute(&cus, hipDeviceAttributeMultiprocessorCount, dev) != hipSuccess) { grid = -1; return; }
        if (hipFuncSetAttribute((const void*)fwd, hipFuncAttributeMaxDynamicSharedMemorySize, LDS_BYTES) != hipSuccess) { fprintf(stderr, "kernel_launch: hipFuncSetAttribute failed\n"); grid = -1; return; }
        if (hipOccupancyMaxActiveBlocksPerMultiprocessor(&per_cu, (const void*)fwd, NWAVES * 64, LDS_BYTES) != hipSuccess || per_cu < 1) fprintf(stderr, "kernel_launch: occupancy query says %d\n", per_cu);
        (void)hipGetLastError();
        grid = cus;
    }
    if (grid < 0) return;
    (void)hipMemsetAsync((char*)d_ws + WS_CTL, 0, CTL_ZERO_BYTES, stream);
    Args a{};
    for (int i = 0; i < 27; ++i) a.in[i] = (const float*)d_in[i];
    a.out = (float*)d_out; a.ws = (unsigned char*)d_ws;
#if MK_SINGLE
    a.seq_lo = 0; a.seq_hi = NSEQ;
    hipLaunchKernelGGL(fwd, dim3(grid), dim3(NWAVES * 64), LDS_BYTES, stream, a);
#else
    for (int s = 0; s < NSEQ; ++s) { a.seq_lo = s; a.seq_hi = s + 1; hipLaunchKernelGGL(fwd, dim3(grid), dim3(NWAVES * 64), LDS_BYTES, stream, a); }
#endif
}
```

```cpp
#include <hip/hip_runtime.h>
#include <cstdio>
#include <cstdint>
#ifndef MK_SINGLE
#define MK_SINGLE 1
#endif
namespace pg8 {
#define PG8_LAS __attribute__((address_space(3)))
typedef unsigned short bf16_t;
typedef short bf16x8 __attribute__((ext_vector_type(8)));
typedef float f32x4 __attribute__((ext_vector_type(4)));
typedef unsigned u32x4 __attribute__((ext_vector_type(4)));
constexpr int BM = 256, BK = 64, HALF = 128, HTB = HALF * BK * 2  , STAGE_BYTES = 8 * HTB, NXCD = 8, WGM = 8;

__host__ __device__ __forceinline__ int lds_byte(int r, int c) { const int st = (r >> 4) * 2 + (c >> 5), rr = r & 15, cc = c & 31, ob = rr * 64 + cc * 2; return st * 1024 + (ob ^ (((ob >> 9) & 1) << 5)); }
__host__ __device__ __forceinline__ void stage_rc(int b, int& R, int& C) { const int st = b / 1024, sb = b % 1024, swz = sb ^ (((sb >> 9) & 1) << 5); R = (st >> 1) * 16 + swz / 64; C = (st & 1) * 32 + (swz % 64) / 2; }
__host__ __device__ __forceinline__ int perm32(int rho) { const int n = rho >> 4, i = rho & 15; return 8 * (i >> 2) + 4 * n + (i & 3); }

struct Unit { int pm, pn; };
struct Gemm { const bf16_t* A; const bf16_t* Bt; int M, N, K; };

struct StaticOrder {
    int nM, nN, nwg, G, c;
    __host__ __device__ void init(int M, int N, int G_, int c_) { nM = M / BM; nN = N / BM; nwg = nM * nN; G = G_; c = c_; }
    __host__ __device__ bool next(int i, Unit& u) const {
        const long L = (long)i * G + c; if (L >= nwg) return false;
        int wgid = (int)L; { const int q = nwg / NXCD, r = nwg % NXCD, xcd = wgid % NXCD, off = wgid / NXCD; wgid = (xcd < r ? xcd * (q + 1) : r * (q + 1) + (xcd - r) * q) + off; }
        const int nig = WGM * nN, gid = wgid / nig, fm = gid * WGM, gsz = (nM - fm) < WGM ? (nM - fm) : WGM;
        u.pm = fm + ((wgid % nig) % gsz); u.pn = (wgid % nig) / gsz; return true;
    }
    __device__ __forceinline__ void a_ready(const Unit&) const {}
    __device__ __forceinline__ void done(const Unit&) const {}
};
__device__ __forceinline__ unsigned cvt_pk_bf16(float lo, float hi) { unsigned r; asm volatile("v_cvt_pk_bf16_f32 %0, %1, %2" : "=v"(r) : "v"(lo), "v"(hi)); return r; }
typedef float f32x2 __attribute__((ext_vector_type(2)));
__device__ __forceinline__ float bflo(unsigned w) { return __uint_as_float(w << 16); }
__device__ __forceinline__ float bfhi(unsigned w) { return __uint_as_float(w & 0xffff0000u); }
__device__ __forceinline__ float sigm(float x) { return 1.0f / (1.0f + __expf(-x)); }
struct EpiStore {
    static constexpr bool PERM = true, AFTER_DRAIN = false;
    bf16_t* O; int ldc;
    __device__ __forceinline__ void operator()(const f32x4 (&acc)[2][2][4][2], const Unit& u, int wr, int wc, int fr, int fq) const {
        const int row0 = u.pm * BM + wr * 64 + fr, col0 = u.pn * BM + wc * 32 + 8 * fq;
#pragma unroll
        for (int ai = 0; ai < 2; ++ai)
#pragma unroll
            for (int m = 0; m < 4; ++m) { bf16_t* rowp = O + (size_t)(row0 + ai * HALF + m * 16) * ldc + col0;
#pragma unroll
                for (int bj = 0; bj < 2; ++bj) { const f32x4 v0 = acc[ai][bj][m][0], v1 = acc[ai][bj][m][1];
                    u32x4 w; w.x = cvt_pk_bf16(v0[0], v0[1]); w.y = cvt_pk_bf16(v0[2], v0[3]); w.z = cvt_pk_bf16(v1[0], v1[1]); w.w = cvt_pk_bf16(v1[2], v1[3]);
                    *(u32x4*)(rowp + bj * HALF) = w; } }
    }
};
struct EpiMerge {
    static constexpr bool PERM = true, AFTER_DRAIN = false;
    bf16_t* O; const bf16_t* gate; int ldg; int first;
    __device__ __forceinline__ void operator()(const f32x4 (&acc)[2][2][4][2], const Unit& u, int wr, int wc, int fr, int fq) const {
        const int row0 = u.pm * BM + wr * 64 + fr, col0 = u.pn * BM + wc * 32 + 8 * fq;
#pragma unroll
        for (int ai = 0; ai < 2; ++ai)
#pragma unroll
            for (int m = 0; m < 4; ++m) { const size_t row = (size_t)(row0 + ai * HALF + m * 16);
#pragma unroll
                for (int bj = 0; bj < 2; ++bj) { const int col = col0 + bj * HALF;
                    const u32x4 gv = *(const u32x4*)(gate + row * ldg + col);
                    u32x4 pv = (u32x4){0u, 0u, 0u, 0u}; if (!first) pv = *(const u32x4*)(O + row * 2048 + col);
                    const f32x4 v0 = acc[ai][bj][m][0], v1 = acc[ai][bj][m][1];
                    u32x4 w;
                    w.x = cvt_pk_bf16(bflo(pv.x) + v0[0] * sigm(bflo(gv.x)), bfhi(pv.x) + v0[1] * sigm(bfhi(gv.x)));
                    w.y = cvt_pk_bf16(bflo(pv.y) + v0[2] * sigm(bflo(gv.y)), bfhi(pv.y) + v0[3] * sigm(bfhi(gv.y)));
                    w.z = cvt_pk_bf16(bflo(pv.z) + v1[0] * sigm(bflo(gv.z)), bfhi(pv.z) + v1[1] * sigm(bfhi(gv.z)));
                    w.w = cvt_pk_bf16(bflo(pv.w) + v1[2] * sigm(bflo(gv.w)), bfhi(pv.w) + v1[3] * sigm(bfhi(gv.w)));
                    *(u32x4*)(O + row * 2048 + col) = w; } }
    }
};
struct EpiResid {
    static constexpr bool PERM = false, AFTER_DRAIN = false;
    const float* base_lat; const float* base_ctx; float* out_lat; float* out_ctx; const float* modl; int goff;
    __device__ __forceinline__ void operator()(const f32x4 (&acc)[2][2][4][2], const Unit& u, int wr, int wc, int fr, int fq) const {
        const bool isctx = u.pm >= 64; const int r = isctx ? 4 : (u.pm >> 4);
        const float* gvp = modl + (size_t)r * 12288 + goff;
        const float* bs = isctx ? base_ctx : base_lat; float* os = isctx ? out_ctx : out_lat;
        const int row0 = (isctx ? u.pm - 64 : u.pm) * BM + wr * 64 + fr, col0 = u.pn * BM + wc * 32 + 4 * fq;
        f32x4 g4[2][2];
#pragma unroll
        for (int bj = 0; bj < 2; ++bj)
#pragma unroll
            for (int n = 0; n < 2; ++n) g4[bj][n] = *(const f32x4*)(gvp + col0 + bj * HALF + n * 16);
#pragma unroll
        for (int ai = 0; ai < 2; ++ai)
#pragma unroll
            for (int m = 0; m < 4; ++m) { const size_t off = (size_t)(row0 + ai * HALF + m * 16) * 2048 + col0;
#pragma unroll
                for (int bj = 0; bj < 2; ++bj)
#pragma unroll
                    for (int n = 0; n < 2; ++n) { const f32x4 b4 = *(const f32x4*)(bs + off + bj * HALF + n * 16);
                        *(f32x4*)(os + off + bj * HALF + n * 16) = b4 + g4[bj][n] * acc[ai][bj][m][n]; } }
    }
};
template <class Epi, class Sched, bool ALIGN_EPI = false, bool SP2 = false>
__device__ __forceinline__ void gemm_phase(PG8_LAS unsigned char* lds, const Gemm g, const Sched& S, const Epi& E) {
    int tid_ = threadIdx.x; asm volatile("" : "+v"(tid_)); const int tid = tid_, wid = __builtin_amdgcn_readfirstlane(tid >> 6), lane = tid & 63, wr = wid >> 2, wc = wid & 3, fr = lane & 15, fq = lane >> 4;
    const int K = g.K, nt = K / BK;
    unsigned voffA[2], voffB[2];
#pragma unroll
    for (int i = 0; i < 2; ++i) { int R, C; stage_rc(tid * 16 + i * 8192, R, C); const int Rb = Epi::PERM ? ((R & ~31) + perm32(R & 31)) : R;
        voffA[i] = (unsigned)(R * K + C) * 2u; voffB[i] = (unsigned)(Rb * K + C) * 2u; }
    const size_t kstep = (size_t)(BK * 2);
    const size_t hstep = (size_t)HALF * K * 2;
    const size_t tstep = 2 * hstep;
    const unsigned ldsw = (unsigned)wid * 1024u;
    const int aoff = lds_byte(wr * 64 + fr, fq * 8), boff = lds_byte(wc * 32 + fr, fq * 8);
#define PG8_SA(b, h) (((b) * 2 + (h)) * HTB)
#define PG8_SB(b, h) ((4 + (b) * 2 + (h)) * HTB)
#define PG8_STAGE(bufoff, gbase, voff) do { _Pragma("unroll") for (int _i = 0; _i < 2; ++_i) \
        __builtin_amdgcn_global_load_lds((const unsigned*)((const char*)(gbase) + (voff)[_i]), (PG8_LAS unsigned*)(lds + (bufoff) + ldsw + _i * 8192), 16, 0, 0); } while (0)
#define PG8_LDA(dst, b, h) do { _Pragma("unroll") for (int m = 0; m < 4; ++m) _Pragma("unroll") for (int k = 0; k < 2; ++k) dst[m][k] = *(const PG8_LAS bf16x8*)(lds + PG8_SA(b, h) + aoff + m * 2048 + k * 1024); } while (0)
#define PG8_LDB(dst, b, h) do { _Pragma("unroll") for (int n = 0; n < 2; ++n) _Pragma("unroll") for (int k = 0; k < 2; ++k) dst[n][k] = *(const PG8_LAS bf16x8*)(lds + PG8_SB(b, h) + boff + n * 2048 + k * 1024); } while (0)
#define PG8_MMA(ai, bj, At, Bt) do { __builtin_amdgcn_s_setprio(1); _Pragma("unroll") for (int m = 0; m < 4; ++m) _Pragma("unroll") for (int n = 0; n < 2; ++n) _Pragma("unroll") for (int k = 0; k < 2; ++k) \
        acc[ai][bj][m][n] = __builtin_amdgcn_mfma_f32_16x16x32_bf16(Bt[n][k], At[m][k], acc[ai][bj][m][n], 0, 0, 0); __builtin_amdgcn_s_setprio(0); } while (0)
#define PG8_WAIT_V(n) asm volatile("s_waitcnt vmcnt(" #n ")" ::: "memory")
#define PG8_WAIT_L(n) asm volatile("s_waitcnt lgkmcnt(" #n ")" ::: "memory")
#define PG8_BAR __builtin_amdgcn_s_barrier()
#define PG8_SCHED __builtin_amdgcn_sched_barrier(0)
    Unit cur, nxt; int ui = 0;
    if (!S.next(0, cur)) return;
    f32x4 acc[2][2][4][2];
#pragma unroll
    for (int a = 0; a < 2; ++a)
#pragma unroll
        for (int b = 0; b < 2; ++b)
#pragma unroll
            for (int m = 0; m < 4; ++m)
#pragma unroll
                for (int n = 0; n < 2; ++n) acc[a][b][m][n] = (f32x4){0.f, 0.f, 0.f, 0.f};
    bf16x8 At[4][2], B0[2][2], B1[2][2];
    const char* cA = (const char*)g.A + (size_t)cur.pm * tstep; const char* cB = (const char*)g.Bt + (size_t)cur.pn * tstep;
    S.a_ready(cur);
    if constexpr (SP2) {
        PG8_STAGE(PG8_SB(0, 0), cB, voffB); PG8_STAGE(PG8_SB(0, 1), cB + hstep, voffB); PG8_STAGE(PG8_SA(0, 0), cA, voffA); PG8_STAGE(PG8_SA(0, 1), cA + hstep, voffA);
        if (wr == 1) PG8_BAR;
        PG8_WAIT_V(2); PG8_BAR;
        PG8_STAGE(PG8_SB(1, 0), cB + kstep, voffB); PG8_STAGE(PG8_SA(1, 0), cA + kstep, voffA); PG8_STAGE(PG8_SB(1, 1), cB + hstep + kstep, voffB);
        PG8_WAIT_V(6); PG8_BAR;
    } else {
        PG8_STAGE(PG8_SB(0, 0), cB, voffB); PG8_STAGE(PG8_SA(0, 0), cA, voffA); PG8_STAGE(PG8_SB(0, 1), cB + hstep, voffB); PG8_STAGE(PG8_SA(0, 1), cA + hstep, voffA);
        if (wr == 1) PG8_BAR;
        PG8_WAIT_V(4); PG8_BAR;
        PG8_STAGE(PG8_SB(1, 0), cB + kstep, voffB); PG8_STAGE(PG8_SA(1, 0), cA + kstep, voffA); PG8_STAGE(PG8_SB(1, 1), cB + hstep + kstep, voffB);
        PG8_WAIT_V(6); PG8_BAR;
    }
    for (;;) {
        const bool has_next = S.next(ui + 1, nxt);
        const char* nA = has_next ? (const char*)g.A + (size_t)nxt.pm * tstep : cA; const char* nB = has_next ? (const char*)g.Bt + (size_t)nxt.pn * tstep : cB;
        for (int t = 0; t < nt; t += 2) {
            const bool last = (t == nt - 2);
            const char* a1 = cA + (size_t)(t + 1) * kstep;
            const char* a2 = last ? nA : cA + (size_t)(t + 2) * kstep; const char* b2 = last ? nB : cB + (size_t)(t + 2) * kstep;
            const char* a3 = a2 + kstep; const char* b3 = b2 + kstep;
            if (last && has_next) S.a_ready(nxt);
            if constexpr (SP2) {
            PG8_LDB(B0, 0, 0); PG8_LDB(B1, 0, 1); PG8_SCHED; PG8_LDA(At, 0, 0); PG8_STAGE(PG8_SA(1, 1), a1 + hstep, voffA);
            PG8_WAIT_V(8); PG8_WAIT_L(0); PG8_BAR; PG8_MMA(0, 0, At, B0); PG8_MMA(0, 1, At, B1); PG8_BAR; PG8_SCHED;
            PG8_LDA(At, 0, 1); PG8_STAGE(PG8_SB(0, 0), b2, voffB); PG8_STAGE(PG8_SB(0, 1), b2 + hstep, voffB); PG8_STAGE(PG8_SA(0, 0), a2, voffA);
            PG8_WAIT_V(8); PG8_WAIT_L(0); PG8_BAR; PG8_MMA(1, 0, At, B0); PG8_MMA(1, 1, At, B1); PG8_BAR; PG8_SCHED;
            PG8_LDB(B0, 1, 0); PG8_LDB(B1, 1, 1); PG8_SCHED; PG8_LDA(At, 1, 0); PG8_STAGE(PG8_SA(0, 1), a2 + hstep, voffA);
            PG8_WAIT_V(8); PG8_WAIT_L(0); PG8_BAR; PG8_MMA(0, 0, At, B0); PG8_MMA(0, 1, At, B1); PG8_BAR; PG8_SCHED;
            PG8_LDA(At, 1, 1); PG8_STAGE(PG8_SB(1, 0), b3, voffB); PG8_STAGE(PG8_SB(1, 1), b3 + hstep, voffB); PG8_STAGE(PG8_SA(1, 0), a3, voffA);
            PG8_WAIT_V(8); PG8_WAIT_L(0); PG8_BAR; PG8_MMA(1, 0, At, B0); PG8_MMA(1, 1, At, B1); PG8_BAR; PG8_SCHED;
            } else {
            PG8_LDB(B0, 0, 0); PG8_SCHED; PG8_LDA(At, 0, 0); PG8_STAGE(PG8_SA(1, 1), a1 + hstep, voffA);
            PG8_WAIT_L(8); PG8_BAR; PG8_WAIT_L(0); PG8_MMA(0, 0, At, B0); PG8_BAR; PG8_SCHED;
            PG8_LDB(B1, 0, 1); PG8_STAGE(PG8_SB(0, 0), b2, voffB);
            PG8_BAR; PG8_WAIT_L(0); PG8_MMA(0, 1, At, B1); PG8_BAR;
            PG8_LDA(At, 0, 1); PG8_STAGE(PG8_SA(0, 0), a2, voffA);
            PG8_BAR; PG8_WAIT_L(0); PG8_MMA(1, 0, At, B0); PG8_BAR; PG8_SCHED;
            PG8_STAGE(PG8_SB(0, 1), b2 + hstep, voffB);
            PG8_WAIT_V(6); PG8_BAR; PG8_MMA(1, 1, At, B1); PG8_BAR;
            PG8_LDB(B0, 1, 0); PG8_SCHED; PG8_LDA(At, 1, 0); PG8_STAGE(PG8_SA(0, 1), a2 + hstep, voffA);
            PG8_WAIT_L(8); PG8_BAR; PG8_WAIT_L(0); PG8_MMA(0, 0, At, B0); PG8_BAR; PG8_SCHED;
            PG8_LDB(B1, 1, 1); PG8_STAGE(PG8_SB(1, 0), b3, voffB);
            PG8_BAR; PG8_WAIT_L(0); PG8_MMA(0, 1, At, B1); PG8_BAR;
            PG8_LDA(At, 1, 1); PG8_STAGE(PG8_SA(1, 0), a3, voffA);
            PG8_BAR; PG8_WAIT_L(0); PG8_MMA(1, 0, At, B0); PG8_BAR; PG8_SCHED;
            PG8_STAGE(PG8_SB(1, 1), b3 + hstep, voffB);
            PG8_WAIT_V(6); PG8_BAR; PG8_MMA(1, 1, At, B1); PG8_BAR;
            }
        }
        if constexpr (ALIGN_EPI) { if (wr == 0) PG8_BAR; }
        if constexpr (!Epi::AFTER_DRAIN) { E(acc, cur, wr, wc, fr, fq); S.done(cur); }
        if (!has_next) break;
#pragma unroll
        for (int a = 0; a < 2; ++a)
#pragma unroll
            for (int b = 0; b < 2; ++b)
#pragma unroll
                for (int m = 0; m < 4; ++m)
#pragma unroll
                    for (int n = 0; n < 2; ++n) acc[a][b][m][n] = (f32x4){0.f, 0.f, 0.f, 0.f};
        cur = nxt; cA = nA; cB = nB; ++ui;
        if constexpr (ALIGN_EPI) { if (wr == 1) PG8_BAR; }
    }
    PG8_WAIT_V(0);
    if constexpr (!ALIGN_EPI) { if (wr == 0) PG8_BAR; }
    PG8_BAR;
    if constexpr (Epi::AFTER_DRAIN) { E.fused(acc, cur, wr, wc, fr, fq, lds, wid, lane); S.done(cur); }
#undef PG8_SA
#undef PG8_SB
#undef PG8_STAGE
#undef PG8_LDA
#undef PG8_LDB
#undef PG8_MMA
#undef PG8_WAIT_V
#undef PG8_WAIT_L
#undef PG8_BAR
#undef PG8_SCHED
}
}
#ifndef PG8_SP2
#define PG8_SP2 true
#endif
#ifndef PG8_ALIGN
#define PG8_ALIGN true
#endif
constexpr int D = 2048, NB = 4, SEQ = 4096, CL = 256, DEPTH = 4;
constexpr int ML = NB * SEQ, MC = NB * CL, MT = ML + MC;
constexpr int INW = 15360, DFF = 5632, NFF = 2 * DFF;
constexpr int C_RK = 0, C_RV = 512, C_NK = 1536, C_NV = 2560, C_RQ = 3584, C_RG = 4096, C_NQ = 5120, C_HY = 6144, C_GT = 9216;
constexpr float EPS = 1e-6f;
constexpr int NWAVES = 8;
constexpr size_t al256(size_t x) { return (x + 255) & ~(size_t)255; }
constexpr size_t WS_CTL = 0, CTL_ZERO_BYTES = 1u << 20;
constexpr size_t WS_MOD = WS_CTL + CTL_ZERO_BYTES;
constexpr size_t WS_ROPE = WS_MOD + al256((size_t)4 * 5 * 12288 * 4);
constexpr size_t WS_FH2 = WS_ROPE + al256(64 * 16 * 8);
constexpr size_t WS_TAPC = WS_FH2 + al256((size_t)4352 * 64 * 4);
constexpr size_t WS_KF = WS_TAPC + al256((size_t)2 * 2 * 1024 * 256 * 4);
constexpr size_t WS_WIN = WS_KF + al256((size_t)2 * 1024 * 8192 * 8);
constexpr size_t WS_WBR = WS_WIN + al256((size_t)INW * D * 2);
constexpr size_t WS_WOUT = WS_WBR + al256((size_t)3 * D * 1024 * 2);
constexpr size_t WS_WF1 = WS_WOUT + al256((size_t)D * D * 2);
constexpr size_t WS_WF2 = WS_WF1 + al256((size_t)NFF * D * 2);
constexpr size_t WS_XC = WS_WF2 + al256((size_t)D * DFF * 2);
constexpr size_t WS_H = WS_XC + al256((size_t)MC * D * 4);
constexpr size_t WS_Z = WS_H + al256((size_t)MT * D * 2);
constexpr size_t WS_HYT = WS_Z + al256((size_t)MT * INW * 2);
constexpr size_t WS_YT = WS_HYT + al256((size_t)3 * NB * 1024 * SEQ * 2);
constexpr size_t WS_YS = WS_YT + al256((size_t)NB * 1024 * SEQ * 2);
constexpr size_t WS_ACC = WS_YS + al256((size_t)3 * MT * 1024 * 2);
constexpr size_t WS_U = WS_ACC + al256((size_t)MT * D * 2);
constexpr size_t WS_KV = WS_U + al256((size_t)MT * DFF * 2);
constexpr size_t WS_END = WS_KV + al256((size_t)NB * 8 * 2 * 34 * 8192 * 4);
constexpr int CW_BAR = 4096;
constexpr int RING_BYTES = 131072, LDSCTL_OFF = RING_BYTES, MISC_OFF = LDSCTL_OFF + 320, LDS_BYTES = 147456;

#define GAS __attribute__((address_space(1)))
#define LAS __attribute__((address_space(3)))
typedef unsigned short bf16;
typedef unsigned v4u __attribute__((ext_vector_type(4)));
typedef unsigned v2u __attribute__((ext_vector_type(2)));
typedef float f32x4 __attribute__((ext_vector_type(4)));
typedef float f32x2 __attribute__((ext_vector_type(2)));
typedef short bf16x8 __attribute__((ext_vector_type(8)));
typedef GAS unsigned gu32;
#define LDS_WAIT() asm volatile("s_waitcnt lgkmcnt(0)" ::: "memory")
__device__ __forceinline__ unsigned f2bf(float f) { unsigned u = __builtin_bit_cast(unsigned, f); return (u + 0x7fffu + ((u >> 16) & 1u)) >> 16; }
__device__ __forceinline__ unsigned pk2(float lo, float hi) { return f2bf(lo) | (f2bf(hi) << 16); }
__device__ __forceinline__ float bflo(unsigned w) { return __uint_as_float(w << 16); }
__device__ __forceinline__ float bfhi(unsigned w) { return __uint_as_float(w & 0xffff0000u); }
__device__ __forceinline__ float bf1(bf16 b) { return __uint_as_float(((unsigned)b) << 16); }
__device__ __forceinline__ bf16x8 mk8(unsigned a, unsigned b, unsigned c, unsigned d) { v4u v = (v4u){a, b, c, d}; return __builtin_bit_cast(bf16x8, v); }
__device__ __forceinline__ f32x4 mfma16(bf16x8 a, bf16x8 b, f32x4 c) { return __builtin_amdgcn_mfma_f32_16x16x32_bf16(a, b, c, 0, 0, 0); }
__device__ __forceinline__ float sin_rev(float r) { return __builtin_amdgcn_sinf(r - floorf(r)); }
__device__ __forceinline__ float cos_rev(float r) { return __builtin_amdgcn_cosf(r - floorf(r)); }
__device__ __forceinline__ float sin_rad(float x) { return sin_rev(x * 0.15915494309189535f); }
__device__ __forceinline__ float ex2(float x) { return __builtin_amdgcn_exp2f(x); }
__device__ __forceinline__ float wave_sum(float v) {
#pragma unroll
    for (int o = 1; o < 64; o <<= 1) v += __shfl_xor(v, o);
    return v;
}
__device__ __forceinline__ int otid() { int t = threadIdx.x; asm volatile("" : "+v"(t)); return t; }
__device__ __forceinline__ int opq(int v) { asm volatile("" : "+s"(v)); return v; }
#define XB_TMO      128
#define XB_XCNT(j)  (256  + 64 * (j))
#define XB_XSUB(j)  (1280 + 64 * (j))
#define XB_XGEN(j)  (2304 + 64 * (j))
#define XB_TOP      3328
#define XB_TOPGEN   3392
#define XCD_BAR_WORDS 3456
#define XB_SPIN_CAP (1u << 18)

__device__ __forceinline__ unsigned xb_ld(unsigned* p)              { return __hip_atomic_load(p, __ATOMIC_RELAXED, __HIP_MEMORY_SCOPE_AGENT); }
__device__ __forceinline__ unsigned xb_add(unsigned* p, unsigned v) { return __hip_atomic_fetch_add(p, v, __ATOMIC_RELAXED, __HIP_MEMORY_SCOPE_AGENT); }
__device__ __forceinline__ unsigned xb_xcc_id() { return (unsigned)__builtin_amdgcn_s_getreg((3 << 11) | 20) & 0xFu; }
#define XB_SPIN(cond, bar) do { unsigned _sp = 0; while (cond) { __builtin_amdgcn_s_sleep(1); \
    if ((++_sp & 255u) == 0u) { if (xb_ld(&(bar)[XB_TMO])) break; if (_sp > XB_SPIN_CAP) { atomicAdd(&(bar)[XB_TMO], 1u); break; } } } } while (0)

struct XcdBarrier {
    unsigned* bar; unsigned x;
    volatile LAS unsigned* st;
};

__device__ __forceinline__ XcdBarrier xcd_barrier_post(unsigned* bar, volatile LAS unsigned* st) {
    XcdBarrier b; b.bar = bar; b.x = xb_xcc_id(); b.st = st;
    if (threadIdx.x == 0) (void)xb_add(&bar[XB_XCNT(b.x)], 1u);
    return b;
}
__device__ __forceinline__ void xcd_barrier_complete(unsigned* bar, unsigned x, unsigned& nloc, unsigned& nx) {
    const unsigned G = gridDim.x * gridDim.y * gridDim.z;
    unsigned sum, cnt, mine, sp = 0u;
    for (;;) {
        sum = 0u; cnt = 0u; mine = 0u;
#pragma unroll
        for (unsigned j = 0; j < 16; ++j) { const unsigned c = xb_ld(&bar[XB_XCNT(j)]); sum += c; cnt += (c > 0u) ? 1u : 0u; mine = (j == x) ? c : mine; }
        if (sum == G) break;
        __builtin_amdgcn_s_sleep(1);
        if ((++sp & 255u) == 0u) { if (xb_ld(&bar[XB_TMO])) break; if (sp > XB_SPIN_CAP) { atomicAdd(&bar[XB_TMO], 1u); break; } }
    }
    nloc = mine > 0u ? mine : 1u; nx = cnt > 0u ? cnt : 1u;
}

__device__ __forceinline__ void xcd_barrier(const XcdBarrier& b) {
    asm volatile("s_waitcnt vmcnt(0)" ::: "memory");
    __syncthreads();
    if (threadIdx.x == 0) {
        unsigned* bar = b.bar;
        __builtin_amdgcn_s_waitcnt(0);
        unsigned nloc = b.st[0], nx = b.st[1];
        if (nloc == 0u) { xcd_barrier_complete(bar, b.x, nloc, nx); b.st[0] = nloc; b.st[1] = nx; }
        const unsigned old = xb_add(&bar[XB_XSUB(b.x)], 1u);
        const unsigned gen = old / nloc;
        if (old + 1u == (gen + 1u) * nloc) {
            __builtin_amdgcn_fence(__ATOMIC_RELEASE, "agent");
            asm volatile("s_waitcnt vmcnt(0)" ::: "memory");
            const unsigned og = xb_add(&bar[XB_TOP], 1u);
            const unsigned tg = og / nx;
            if (og + 1u == (tg + 1u) * nx) xb_add(&bar[XB_TOPGEN], 1u);
            else XB_SPIN(xb_ld(&bar[XB_TOPGEN]) == tg, bar);
            __builtin_amdgcn_fence(__ATOMIC_ACQUIRE, "agent");
            xb_add(&bar[XB_XGEN(b.x)], 1u);
            asm volatile("s_waitcnt vmcnt(0)" ::: "memory");
        } else {
            XB_SPIN(xb_ld(&bar[XB_XGEN(b.x)]) == gen, bar);
            __builtin_amdgcn_fence(__ATOMIC_ACQUIRE, "agent");
            asm volatile("s_waitcnt vmcnt(0)" ::: "memory");
        }
    }
    __syncthreads();
}
__device__ __forceinline__ void p0_transpose_item(const float* W, int K, int N, bf16* WT, int row_off, LAS float* scr, int item, int lane) {
    const int nblk = N / 32, kb = item / nblk, nb = item % nblk, k0 = 64 * kb, n0 = 32 * nb;
#pragma unroll 8
    for (int i = 0; i < 32; ++i) { const int kk = 2 * i + (lane >> 5); scr[kk * 33 + (lane & 31)] = W[(size_t)(k0 + kk) * N + n0 + (lane & 31)]; }
    LDS_WAIT(); asm volatile("" ::: "memory");
    const int c = lane & 7;
#pragma unroll
    for (int j = 0; j < 4; ++j) { const int n = (lane >> 3) + 8 * j; const LAS float* s = scr + (8 * c) * 33 + n;
        v4u o; o.x = pk2(s[0 * 33], s[1 * 33]); o.y = pk2(s[2 * 33], s[3 * 33]); o.z = pk2(s[4 * 33], s[5 * 33]); o.w = pk2(s[6 * 33], s[7 * 33]);
        *(GAS v4u*)(WT + (size_t)(row_off + n0 + n) * K + k0 + 8 * c) = o; }
    LDS_WAIT(); asm volatile("" ::: "memory");
}
struct Args { const float* in[27]; float* out; unsigned char* ws; int seq_lo, seq_hi; };
__device__ __forceinline__ const float* inp(int i) { const char* ka = (const char*)__builtin_amdgcn_kernarg_segment_ptr(); int off = i * 8; asm volatile("" : "+s"(off)); return *(const float* const*)(ka + off); }
__device__ __forceinline__ unsigned char* wsb() { const char* ka = (const char*)__builtin_amdgcn_kernarg_segment_ptr(); int off = 27 * 8 + 8; asm volatile("" : "+s"(off)); return *(unsigned char* const*)(ka + off); }
__device__ __forceinline__ float* outb() { const char* ka = (const char*)__builtin_amdgcn_kernarg_segment_ptr(); int off = 27 * 8; asm volatile("" : "+s"(off)); return *(float* const*)(ka + off); }
enum { I_X = 0, I_C, I_CTX, I_CCTX, I_WMOD, I_BMOD, I_G1, I_G2, I_WIN, I_HCW, I_HCB, I_FW1, I_FB1, I_FW2, I_FB2, I_FW3, I_FFQ, I_HBIAS, I_RDEC, I_RPB, I_WBR, I_WOUT, I_FFW1, I_FFCW, I_FFCB, I_FFW2, I_GF };

__device__ __forceinline__ void ph_prologue(const Args& A, LAS unsigned char* lds, int tid) {
    LAS float* sc = (LAS float*)lds;
    LAS float* red = sc + 5 * 2048;
    const float* c = inp(I_C); const float* cc = inp(I_CCTX);
    for (int i = tid; i < 5 * 2048; i += 512) { const int r = i >> 11, k = i & 2047; const float v = (r < 4) ? c[r * 2048 + k] : cc[k]; sc[i] = v / (1.0f + __expf(-v)); }
    __syncthreads();
    float* mod = (float*)(wsb() + WS_MOD);
    const int kq = tid >> 6, col = tid & 63;
    for (int u = blockIdx.x; u < DEPTH * 192; u += gridDim.x) {
        const int l = u / 192, n0 = (u % 192) * 64;
        const float* W = inp(I_WMOD) + (size_t)l * 2048 * 12288 + n0 + col;
        float a0 = 0.f, a1 = 0.f, a2 = 0.f, a3 = 0.f, a4 = 0.f;
        for (int k = kq * 256; k < kq * 256 + 256; ++k) { const float w = W[(size_t)k * 12288];
            a0 += sc[k] * w; a1 += sc[2048 + k] * w; a2 += sc[4096 + k] * w; a3 += sc[6144 + k] * w; a4 += sc[8192 + k] * w; }
        red[(kq * 5 + 0) * 64 + col] = a0; red[(kq * 5 + 1) * 64 + col] = a1; red[(kq * 5 + 2) * 64 + col] = a2; red[(kq * 5 + 3) * 64 + col] = a3; red[(kq * 5 + 4) * 64 + col] = a4;
        __syncthreads();
        if (tid < 320) { const int r = tid >> 6; float s = inp(I_BMOD)[l * 12288 + n0 + col];
#pragma unroll
            for (int q = 0; q < 8; ++q) s += red[(q * 5 + r) * 64 + col];
            mod[((size_t)l * 5 + r) * 12288 + n0 + col] = s; }
        __syncthreads();
    }
    if (blockIdx.x == 0) { f32x2* rope = (f32x2*)(wsb() + WS_ROPE);
        for (int i = tid; i < 1024; i += 512) { const int pos = i >> 4, j = i & 15; const float inv = exp2f(-(float)j * (13.287712379549449f / 16.0f));
            const float rev = (float)pos * inv * 0.15915494309189535f; rope[i] = (f32x2){cos_rev(rev), sin_rev(rev)}; } }
}

__device__ __forceinline__ void ph_convert(const Args& A, int l, LAS unsigned char* lds, int wave, int lane) {
    LAS float* scr = (LAS float*)(lds + wave * 16384);
    const int gw = blockIdx.x * NWAVES + wave, NGW = gridDim.x * NWAVES;
    constexpr int I_IN = (D / 64) * (INW / 32), I_BR = (1024 / 64) * (D / 32), I_OUT = (D / 64) * (D / 32), I_F1 = (D / 64) * (NFF / 32), I_F2 = (DFF / 64) * (D / 32);
    constexpr int NITEMS = I_IN + 3 * I_BR + I_OUT + I_F1 + I_F2;
    const float* win = inp(I_WIN) + (size_t)l * D * INW; const float* wbr = inp(I_WBR) + (size_t)l * 3 * 1024 * D; const float* wout = inp(I_WOUT) + (size_t)l * D * D;
    const float* wf1 = inp(I_FFW1) + (size_t)l * D * NFF; const float* wf2 = inp(I_FFW2) + (size_t)l * DFF * D;
    bf16* WIN = (bf16*)(wsb() + WS_WIN); bf16* WBR = (bf16*)(wsb() + WS_WBR); bf16* WOUT = (bf16*)(wsb() + WS_WOUT); bf16* WF1 = (bf16*)(wsb() + WS_WF1); bf16* WF2 = (bf16*)(wsb() + WS_WF2);
    for (int it = gw; it < NITEMS; it += NGW) {
        int r = it;
        if (r < I_IN) { p0_transpose_item(win, D, INW, WIN, 0, scr, r, lane); continue; } r -= I_IN;
        if (r < I_BR) { p0_transpose_item(wbr, 1024, D, WBR, 0, scr, r, lane); continue; } r -= I_BR;
        if (r < I_BR) { p0_transpose_item(wbr + (size_t)1024 * D, 1024, D, WBR + (size_t)D * 1024, 0, scr, r, lane); continue; } r -= I_BR;
        if (r < I_BR) { p0_transpose_item(wbr + (size_t)2 * 1024 * D, 1024, D, WBR + (size_t)2 * D * 1024, 0, scr, r, lane); continue; } r -= I_BR;
        if (r < I_OUT) { p0_transpose_item(wout, D, D, WOUT, 0, scr, r, lane); continue; } r -= I_OUT;
        if (r < I_F1) { p0_transpose_item(wf1, D, NFF, WF1, 0, scr, r, lane); continue; } r -= I_F1;
        p0_transpose_item(wf2, DFF, D, WF2, 0, scr, r, lane);
    }
}
__device__ __forceinline__ void ph_filt1(const Args& A, int l, LAS unsigned char* lds, int tid) {
    LAS float* feat = (LAS float*)lds;
    LAS float* h1 = feat + 8 * 33;
    const float* w1 = inp(I_FW1) + (size_t)l * 33 * 64; const float* b1 = inp(I_FB1) + l * 64; const float* w2 = inp(I_FW2) + (size_t)l * 64 * 64; const float* b2 = inp(I_FB2) + l * 64;
    const float* fq = inp(I_FFQ) + l * 64; float* FH2 = (float*)(wsb() + WS_FH2);
    const int pl = tid >> 6, o = tid & 63;
    for (int u = blockIdx.x; u < 544; u += gridDim.x) {
        const int pos = u * 8 + pl; const bool isc = pos >= 4096; const int Lf = isc ? 256 : 4096, tp = isc ? pos - 4096 : pos;
        if (o < 33) { float f;
            if (o == 0) f = (float)tp / (float)(Lf - 1);
            else { const int i = (o - 1) & 15; const float fr = 1e-4f + (float)i * ((15.0f - 1e-4f) / 15.0f); const float rev = fr * (float)tp / (float)Lf; f = (o <= 16) ? cos_rev(rev) : -sin_rev(rev); }
            feat[pl * 33 + o] = f; }
        __syncthreads();
        float a = b1[o];
#pragma unroll 3
        for (int i = 0; i < 33; ++i) a += feat[pl * 33 + i] * w1[i * 64 + o];
        h1[pl * 64 + o] = sin_rad(fq[o] * a);
        __syncthreads();
        float b = b2[o];
#pragma unroll 4
        for (int j = 0; j < 64; ++j) b += h1[pl * 64 + j] * w2[j * 64 + o];
        FH2[(size_t)pos * 64 + o] = sin_rad(fq[o] * b);
        __syncthreads();
    }
}
__device__ __forceinline__ void ph_norm(const float* xlat, const float* xctx, const float* g, const float* modl, int sh_off, int sc_off, bf16* H, int Mrows, int wave, int lane) {
    const int gw = blockIdx.x * NWAVES + wave, NGW = gridDim.x * NWAVES;
    for (int m = gw; m < Mrows; m += NGW) {
        const float* xr; int r;
        if (m < ML) { xr = xlat + (size_t)m * D; r = m >> 12; } else { xr = xctx + (size_t)(m - ML) * D; r = 4; }
        const float* mv = modl + (size_t)r * 12288;
        f32x4 v[8]; float ss = 0.f;
#pragma unroll
        for (int j = 0; j < 8; ++j) { v[j] = *(const f32x4*)(xr + (lane + 64 * j) * 4); ss += (v[j].x * v[j].x + v[j].y * v[j].y) + (v[j].z * v[j].z + v[j].w * v[j].w); }
        const float rstd = 1.0f / sqrtf(wave_sum(ss) * (1.0f / D) + EPS);
#pragma unroll
        for (int j = 0; j < 8; ++j) { const int idx = (lane + 64 * j) * 4;
            const f32x4 gg = *(const f32x4*)(g + idx), sh = *(const f32x4*)(mv + sh_off + idx), sc = *(const f32x4*)(mv + sc_off + idx);
            const f32x4 y = v[j] * rstd * gg * (sc + 1.0f) + sh;
            v2u w; w.x = pk2(y.x, y.y); w.y = pk2(y.z, y.w);
            *(v2u*)(H + (size_t)m * D + idx) = w; }
    }
}

__device__ __forceinline__ void fft_dif(LAS f32x2* buf, int tid) {
    for (int s = 4096; s >= 1; s >>= 1) {
        const float inv2s = 0.5f / (float)s;
#pragma unroll
        for (int i = 0; i < 8; ++i) { const int idx = tid + 512 * i, j = idx & (s - 1), a = ((idx - j) << 1) + j, b = a + s;
            const f32x2 u = buf[a], v = buf[b]; const float fr = (float)j * inv2s; const float c = __builtin_amdgcn_cosf(fr), sn = __builtin_amdgcn_sinf(fr);
            buf[a] = u + v; const float dx = u.x - v.x, dy = u.y - v.y;
            buf[b] = (f32x2){dx * c + dy * sn, dy * c - dx * sn}; }
        __syncthreads();
    }
}
__device__ __forceinline__ void fft_idit(LAS f32x2* buf, int tid) {
    for (int s = 1; s <= 4096; s <<= 1) {
        const float inv2s = 0.5f / (float)s;
#pragma unroll
        for (int i = 0; i < 8; ++i) { const int idx = tid + 512 * i, j = idx & (s - 1), a = ((idx - j) << 1) + j, b = a + s;
            const f32x2 u = buf[a], q = buf[b]; const float fr = (float)j * inv2s; const float c = __builtin_amdgcn_cosf(fr), sn = __builtin_amdgcn_sinf(fr);
            const f32x2 v = (f32x2){q.x * c - q.y * sn, q.x * sn + q.y * c};
            buf[a] = u + v; buf[b] = u - v; }
        __syncthreads();
    }
}
__device__ __forceinline__ float block_sum(float v, LAS float* red, int tid) {
    v = wave_sum(v);
    __syncthreads();
    if ((tid & 63) == 0) red[tid >> 6] = v;
    __syncthreads();
    float s = 0.f;
#pragma unroll
    for (int i = 0; i < 8; ++i) s += red[i];
    return s;
}
__device__ __forceinline__ float hy_delta(int c) { const float d0 = -4.605170185988091f / 0.3f, d1 = -4.605170185988091f / 1.5f; return fabsf(d0 + (d1 - d0) * ((float)c / 1023.0f)); }
__device__ __forceinline__ void ph_filt2(const Args& A, int l, LAS unsigned char* lds, int tid) {
    LAS f32x2* buf = (LAS f32x2*)lds; LAS float* w3s = (LAS float*)(lds + 65536); LAS float* red = w3s + 128;
    const float* w3 = inp(I_FW3) + (size_t)l * 64 * 4096; const float* FH2 = (const float*)(wsb() + WS_FH2);
    f32x2* KF = (f32x2*)(wsb() + WS_KF); float* TAPC = (float*)(wsb() + WS_TAPC);
    for (int u = blockIdx.x; u < 2048; u += gridDim.x) {
        const int o = u >> 10, c = u & 1023;
        __syncthreads();
        if (tid < 128) w3s[tid] = w3[(size_t)(tid & 63) * 4096 + o * 2048 + (tid >> 6) * 1024 + c];
        __syncthreads();
        const float delta = hy_delta(c); float ssq = 0.f;
#pragma nounroll
        for (int i = 0; i < 8; ++i) { const int t = tid + 512 * i; const f32x4* row = (const f32x4*)(FH2 + (size_t)t * 64); float af = 0.f, ab = 0.f;
#pragma unroll 4
            for (int j4 = 0; j4 < 16; ++j4) { const f32x4 hv = row[j4];
                af += hv.x * w3s[4 * j4] + hv.y * w3s[4 * j4 + 1] + hv.z * w3s[4 * j4 + 2] + hv.w * w3s[4 * j4 + 3];
                ab += hv.x * w3s[64 + 4 * j4] + hv.y * w3s[64 + 4 * j4 + 1] + hv.z * w3s[64 + 4 * j4 + 2] + hv.w * w3s[64 + 4 * j4 + 3]; }
            const float dec = __expf(-((float)t / 4095.0f) * delta); const float tf = af * dec, tb = ab * dec;
            buf[t] = (f32x2){tf, 0.f}; ssq += tf * tf;
            if (t >= 1) { buf[8192 - t] = (f32x2){tb, 0.f}; ssq += tb * tb; } else buf[4096] = (f32x2){0.f, 0.f}; }
        const float tot = block_sum(ssq, red, tid); const float scl = 1.0f / sqrtf(tot + EPS);
        for (int i = 0; i < 16; ++i) { const int p = tid + 512 * i; f32x2 v = buf[p]; v.x *= scl; buf[p] = v; }
        __syncthreads();
        fft_dif(buf, tid);
        f32x2* dst = KF + (size_t)(o * 1024 + c) * 8192;
        for (int i = 0; i < 16; ++i) { const int p = tid + 512 * i; dst[p] = buf[p]; }
    }
    for (int u = blockIdx.x; u < 2048; u += gridDim.x) {
        const int o = u >> 10, c = u & 1023, dir = tid >> 8, m = tid & 255;
        __syncthreads();
        if (tid < 128) w3s[tid] = w3[(size_t)(tid & 63) * 4096 + o * 2048 + (tid >> 6) * 1024 + c];
        __syncthreads();
        const f32x4* row = (const f32x4*)(FH2 + (size_t)(4096 + m) * 64); float a = 0.f;
#pragma unroll
        for (int j4 = 0; j4 < 16; ++j4) { const f32x4 hv = row[j4]; a += hv.x * w3s[dir * 64 + 4 * j4] + hv.y * w3s[dir * 64 + 4 * j4 + 1] + hv.z * w3s[dir * 64 + 4 * j4 + 2] + hv.w * w3s[dir * 64 + 4 * j4 + 3]; }
        const float val = a * __expf(-((float)m / 255.0f) * hy_delta(c));
        const float tot = block_sum((dir == 0 || m >= 1) ? val * val : 0.f, red, tid);
        TAPC[((size_t)(o * 2 + dir) * 1024 + c) * 256 + m] = val / sqrtf(tot + EPS);
    }
}

__device__ __forceinline__ void ph_hyprep(const Args& A, int l, LAS unsigned char* lds, int tid) {
    LAS bf16* T = (LAS bf16*)lds;
    const bf16* Z = (const bf16*)(wsb() + WS_Z); bf16* HYT = (bf16*)(wsb() + WS_HYT);
    const float* cw = inp(I_HCW) + (size_t)l * 3 * 3072; const float* cb = inp(I_HCB) + (size_t)l * 3072;
    for (int u = blockIdx.x; u < 3072; u += gridDim.x) {
        const int cg = u % 12, tt = (u / 12) & 63, b = u / 768;
        __syncthreads();
        for (int q = tid; q < 66 * 32; q += 512) { const int r = q >> 5, ch8 = q & 31, t = tt * 64 - 1 + r;
            v4u v = (v4u){0u, 0u, 0u, 0u};
            if (t >= 0 && t < SEQ) v = *(const v4u*)(Z + (size_t)(b * SEQ + t) * INW + C_HY + cg * 256 + ch8 * 8);
            *(LAS v4u*)(T + r * 264 + ch8 * 8) = v; }
        __syncthreads();
        const int ch = tid & 255, half = tid >> 8, gch = cg * 256 + ch;
        const float w0 = cw[gch], w1 = cw[3072 + gch], w2 = cw[6144 + gch], bb = cb[gch];
        const int part = gch >> 10, c = gch & 1023;
        bf16* outp = HYT + ((size_t)(part * NB + b) * 1024 + c) * SEQ + tt * 64 + half * 32;
#pragma unroll
        for (int tq = 0; tq < 4; ++tq) { float vv[8];
#pragma unroll
            for (int e = 0; e < 8; ++e) { const int tl = half * 32 + tq * 8 + e;
                vv[e] = w0 * bf1(T[tl * 264 + ch]) + w1 * bf1(T[(tl + 1) * 264 + ch]) + w2 * bf1(T[(tl + 2) * 264 + ch]) + bb; }
            v4u w; w.x = pk2(vv[0], vv[1]); w.y = pk2(vv[2], vv[3]); w.z = pk2(vv[4], vv[5]); w.w = pk2(vv[6], vv[7]);
            *(v4u*)(outp + tq * 8) = w; }
    }
}
__device__ __forceinline__ void ph_hyctx(const Args& A, int l, LAS unsigned char* lds, int tid) {
    LAS float* S = (LAS float*)lds;
    const bf16* Z = (const bf16*)(wsb() + WS_Z); bf16* YS = (bf16*)(wsb() + WS_YS); const float* TAPC = (const float*)(wsb() + WS_TAPC);
    const float* cw = inp(I_HCW) + (size_t)l * 3 * 3072; const float* cb = inp(I_HCB) + (size_t)l * 3072; const float* hb = inp(I_HBIAS) + (size_t)l * 2 * 1024;
    const int cc = tid >> 8, t = tid & 255;
    LAS float* sv = S + cc * 2048; LAS float* sx1 = sv + 256; LAS float* sx2 = sv + 512; LAS float* sy1 = sv + 768;
    LAS float* tf0 = sv + 1024; LAS float* tb0 = sv + 1280; LAS float* tf1 = sv + 1536; LAS float* tb1 = sv + 1792;
    for (int u = blockIdx.x; u < 2048; u += gridDim.x) {
        const int b = u >> 9, c = (u & 511) * 2 + cc;
        __syncthreads();
        float pv[3];
#pragma unroll
        for (int part = 0; part < 3; ++part) { const int gch = part * 1024 + c; const bf16* zp = Z + (size_t)(ML + b * CL + t) * INW + C_HY + gch;
            const float zm = (t > 0) ? bf1(zp[-(ptrdiff_t)INW]) : 0.f, z0 = bf1(zp[0]), zq = (t < CL - 1) ? bf1(zp[INW]) : 0.f;
            pv[part] = cw[gch] * zm + cw[3072 + gch] * z0 + cw[6144 + gch] * zq + cb[gch]; }
        sx1[t] = pv[0]; sx2[t] = pv[1]; sv[t] = pv[2];
        tf0[t] = TAPC[((size_t)(0 * 2 + 0) * 1024 + c) * 256 + t]; tb0[t] = TAPC[((size_t)(0 * 2 + 1) * 1024 + c) * 256 + t];
        tf1[t] = TAPC[((size_t)(1 * 2 + 0) * 1024 + c) * 256 + t]; tb1[t] = TAPC[((size_t)(1 * 2 + 1) * 1024 + c) * 256 + t];
        __syncthreads();
        float acc = 0.f;
        for (int s = 0; s <= t; ++s) acc += sv[s] * tf0[t - s];
        for (int s = t + 1; s < CL; ++s) acc += sv[s] * tb0[s - t];
        const float y1 = pv[0] * (acc + hb[c] * pv[2]);
        sy1[t] = y1;
        __syncthreads();
        acc = 0.f;
        for (int s = 0; s <= t; ++s) acc += sy1[s] * tf1[t - s];
        for (int s = t + 1; s < CL; ++s) acc += sy1[s] * tb1[s - t];
        const float y = pv[1] * (acc + hb[1024 + c] * y1);
        YS[(size_t)(ML + b * CL + t) * 1024 + c] = (bf16)f2bf(y);
    }
}
__device__ __forceinline__ void unpack8(v4u v, float (&x)[8]) { x[0] = bflo(v.x); x[1] = bfhi(v.x); x[2] = bflo(v.y); x[3] = bfhi(v.y); x[4] = bflo(v.z); x[5] = bfhi(v.z); x[6] = bflo(v.w); x[7] = bfhi(v.w); }
__device__ __forceinline__ v4u pack8(const float (&x)[8]) { v4u w; w.x = pk2(x[0], x[1]); w.y = pk2(x[2], x[3]); w.z = pk2(x[4], x[5]); w.w = pk2(x[6], x[7]); return w; }
__device__ __forceinline__ void rope8(float (&lo)[8], float (&hi)[8], const f32x2* rt) {
#pragma unroll
    for (int e = 0; e < 8; ++e) { const f32x2 cs = rt[e]; const float a = lo[e], b = hi[e]; lo[e] = a * cs.x - b * cs.y; hi[e] = b * cs.x + a * cs.y; }
}
__device__ __forceinline__ void vt_store(LAS bf16* Vt, int ld, int d0, int r, v4u vv) {
    Vt[(d0 + 0) * ld + r] = (bf16)(vv.x & 0xffffu); Vt[(d0 + 1) * ld + r] = (bf16)(vv.x >> 16);
    Vt[(d0 + 2) * ld + r] = (bf16)(vv.y & 0xffffu); Vt[(d0 + 3) * ld + r] = (bf16)(vv.y >> 16);
    Vt[(d0 + 4) * ld + r] = (bf16)(vv.z & 0xffffu); Vt[(d0 + 5) * ld + r] = (bf16)(vv.z >> 16);
    Vt[(d0 + 6) * ld + r] = (bf16)(vv.w & 0xffffu); Vt[(d0 + 7) * ld + r] = (bf16)(vv.w >> 16);
}
constexpr float LOG2E = 1.4426950408889634f;
__device__ __forceinline__ void ph_ret1(const Args& A, int l, int nctx_units, LAS unsigned char* lds, int tid) {
    LAS bf16* KfT = (LAS bf16*)lds; LAS bf16* KbT = KfT + 64 * 136; LAS bf16* Vt = KbT + 64 * 136;
    const bf16* Z = (const bf16*)(wsb() + WS_Z); float* KV = (float*)(wsb() + WS_KV); const f32x2* rope = (const f32x2*)(wsb() + WS_ROPE);
    const int lane = tid & 63, w = tid >> 6, g = lane >> 4, li = lane & 15;
    for (int uid = blockIdx.x; uid < 1024 + nctx_units; uid += gridDim.x) {
        const bool isc = uid >= 1024; int b, h, n, ci; size_t m0;
        if (!isc) { b = uid >> 8; h = (uid >> 5) & 7; n = uid & 31; m0 = (size_t)b * SEQ + n * 128; ci = 2 + n; }
        else { const int i = uid - 1024; b = i >> 4; h = (i >> 1) & 7; n = i & 1; m0 = (size_t)ML + b * CL + n * 128; ci = n; }
        const float lgf = inp(I_RDEC)[(l * 2 + 0) * 8 + h] * LOG2E, lgb = inp(I_RDEC)[(l * 2 + 1) * 8 + h] * LOG2E;
        __syncthreads();
        { const int tok = tid >> 2, pp = tid & 3, a = (pp & 1) + ((pp >> 1) << 2);
            const bf16* kr = Z + (m0 + tok) * INW + C_RK + h * 64;
            float lo[8], hi[8]; unpack8(*(const v4u*)(kr + 8 * a), lo); unpack8(*(const v4u*)(kr + 8 * a + 16), hi);
            if (!isc) { const int t = n * 128 + tok; const int pos = (a < 4) ? (t >> 6) : (t & 63); rope8(lo, hi, rope + pos * 16 + 8 * (a & 1)); }
            const float zf = ex2(lgf * (float)(127 - tok)) * 0.125f, zb = ex2(lgb * (float)tok) * 0.125f;
#pragma unroll
            for (int e = 0; e < 8; ++e) { const int d = 8 * a + e;
                KfT[d * 136 + tok] = (bf16)f2bf(lo[e] * zf); KbT[d * 136 + tok] = (bf16)f2bf(lo[e] * zb);
                KfT[(d + 16) * 136 + tok] = (bf16)f2bf(hi[e] * zf); KbT[(d + 16) * 136 + tok] = (bf16)f2bf(hi[e] * zb); } }
        for (int q = tid; q < 2048; q += 512) { const int r = q >> 4, ch = q & 15; vt_store(Vt, 136, ch * 8, r, *(const v4u*)(Z + (m0 + r) * INW + C_RV + h * 128 + ch * 8)); }
        __syncthreads();
        bf16x8 af[4];
#pragma unroll
        for (int ks = 0; ks < 4; ++ks) af[ks] = *(const LAS bf16x8*)(Vt + (16 * w + li) * 136 + 32 * ks + 8 * g);
#pragma unroll
        for (int dir = 0; dir < 2; ++dir) { const LAS bf16* KT = dir ? KbT : KfT;
            float* dst = KV + ((size_t)((b * 8 + h) * 2 + dir) * 34 + ci) * 8192;
#pragma unroll
            for (int nc = 0; nc < 4; ++nc) { f32x4 acc = (f32x4){0.f, 0.f, 0.f, 0.f};
#pragma unroll
                for (int ks = 0; ks < 4; ++ks) acc = mfma16(af[ks], *(const LAS bf16x8*)(KT + (16 * nc + li) * 136 + 32 * ks + 8 * g), acc);
#pragma unroll
                for (int j = 0; j < 4; ++j) dst[(16 * w + 4 * g + j) * 64 + 16 * nc + li] = acc[j]; } }
    }
}
__device__ __forceinline__ void ph_natt(const Args& A, int l, int nctx_units, LAS unsigned char* lds, int tid) {
    LAS bf16* Qs = (LAS bf16*)lds; LAS bf16* Ks = Qs + 128 * 136; LAS bf16* Vt = Ks + 64 * 136; LAS float* rpbs = (LAS float*)(Vt + 128 * 68);
    const bf16* Z = (const bf16*)(wsb() + WS_Z); bf16* YS = (bf16*)(wsb() + WS_YS) + (size_t)2 * MT * 1024;
    const int lane = tid & 63, w = tid >> 6, g = lane >> 4, li = lane & 15;
    const float SCALE = 0.08838834764831845f;
    for (int uid = blockIdx.x; uid < 1024 + nctx_units; uid += gridDim.x) {
        const bool isc = uid >= 1024; int b, h, rp = 0; size_t m0;
        if (!isc) { b = uid >> 8; h = (uid >> 5) & 7; rp = uid & 31; m0 = (size_t)b * SEQ + rp * 128; }
        else { const int i = uid - 1024; b = i >> 4; h = (i >> 1) & 7; m0 = (size_t)ML + b * CL + (i & 1) * 128; }
        const size_t mc0 = (size_t)ML + b * CL;
        __syncthreads();
        for (int q = tid; q < 2048; q += 512) { const int r = q >> 4, ch = q & 15; *(LAS v4u*)(Qs + r * 136 + ch * 8) = *(const v4u*)(Z + (m0 + r) * INW + C_NQ + h * 128 + ch * 8); }
        if (!isc) for (int i = tid; i < 465; i += 512) rpbs[i] = inp(I_RPB)[((size_t)l * 8 + h) * 465 + i];
        __syncthreads();
        bf16x8 qf[4];
#pragma unroll
        for (int ks = 0; ks < 4; ++ks) qf[ks] = *(const LAS bf16x8*)(Qs + (16 * w + li) * 136 + 32 * ks + 8 * g);
        f32x4 o[8];
#pragma unroll
        for (int nd = 0; nd < 8; ++nd) o[nd] = (f32x4){0.f, 0.f, 0.f, 0.f};
        float mrun = -1e30f, lrun = 0.f;
        const int qr = 2 * rp + (w >> 2), qc = 16 * (w & 3) + li;
        const int cs = min(max(qc - 8, 0), 48), rs_w = min(max(qr - 4, 0), 56);
        const int kr_lo = min(max(2 * rp - 4, 0), 56), kr_hi = min(max(2 * rp - 3, 0), 56) + 7;
        const int nwin = isc ? 0 : (kr_hi - kr_lo + 1);
        for (int t = 0; t < nwin + 4; ++t) {
            const bool win = t < nwin; const int kr = kr_lo + t;
            const size_t mk0 = win ? ((size_t)b * SEQ + kr * 64) : (mc0 + (t - nwin) * 64);
            __syncthreads();
            for (int q = tid; q < 1024; q += 512) { const int r = q >> 4, ch = q & 15; const bf16* zr = Z + (mk0 + r) * INW + h * 128 + ch * 8;
                *(LAS v4u*)(Ks + r * 136 + ch * 8) = *(const v4u*)(zr + C_NK);
                vt_store(Vt, 68, ch * 8, r, *(const v4u*)(zr + C_NV)); }
            __syncthreads();
            const bool active = !win || (kr >= rs_w && kr <= rs_w + 7);
            if (active) {
                f32x4 s[4];
#pragma unroll
                for (int n = 0; n < 4; ++n) { s[n] = (f32x4){0.f, 0.f, 0.f, 0.f};
#pragma unroll
                    for (int ks = 0; ks < 4; ++ks) s[n] = mfma16(*(const LAS bf16x8*)(Ks + (16 * n + li) * 136 + 32 * ks + 8 * g), qf[ks], s[n]); }
                float tmax = -1e30f;
#pragma unroll
                for (int n = 0; n < 4; ++n)
#pragma unroll
                    for (int j = 0; j < 4; ++j) { float v = s[n][j] * SCALE;
                        if (win) { const int kc = 16 * n + 4 * g + j; const bool valid = (kc >= cs) && (kc < cs + 16);
                            const int dc = min(max(kc - qc + 15, 0), 30), dr = min(max(kr - qr + 7, 0), 14);
                            v = valid ? v + rpbs[dr * 31 + dc] : -1e30f; }
                        s[n][j] = v; tmax = fmaxf(tmax, v); }
                tmax = fmaxf(tmax, __shfl_xor(tmax, 16)); tmax = fmaxf(tmax, __shfl_xor(tmax, 32));
                const float mnew = fmaxf(mrun, tmax), alpha = __expf(mrun - mnew);
                float psum = 0.f;
#pragma unroll
                for (int n = 0; n < 4; ++n)
#pragma unroll
                    for (int j = 0; j < 4; ++j) { const float pv = __expf(s[n][j] - mnew); s[n][j] = pv; psum += pv; }
                psum += __shfl_xor(psum, 16); psum += __shfl_xor(psum, 32);
                lrun = lrun * alpha + psum; mrun = mnew;
#pragma unroll
                for (int nd = 0; nd < 8; ++nd) o[nd] = o[nd] * alpha;
#pragma unroll
                for (int kk = 0; kk < 2; ++kk) {
                    const bf16x8 pf = mk8(pk2(s[2 * kk][0], s[2 * kk][1]), pk2(s[2 * kk][2], s[2 * kk][3]), pk2(s[2 * kk + 1][0], s[2 * kk + 1][1]), pk2(s[2 * kk + 1][2], s[2 * kk + 1][3]));
#pragma unroll
                    for (int nd = 0; nd < 8; ++nd) { const LAS bf16* vp = Vt + (16 * nd + li) * 68 + 32 * kk + 4 * g;
                        const v2u lo = *(const LAS v2u*)vp, hi = *(const LAS v2u*)(vp + 16);
                        o[nd] = mfma16(mk8(lo.x, lo.y, hi.x, hi.y), pf, o[nd]); } }
            }
        }
        const float inv = 1.0f / lrun; const size_t mrow = m0 + 16 * w + li;
#pragma unroll
        for (int nd = 0; nd < 8; ++nd) { v2u wv; wv.x = pk2(o[nd][0] * inv, o[nd][1] * inv); wv.y = pk2(o[nd][2] * inv, o[nd][3] * inv);
            *(v2u*)(YS + mrow * 1024 + h * 128 + 16 * nd + 4 * g) = wv; }
    }
}

__device__ __forceinline__ void ph_hyfft(const Args& A, int l, LAS unsigned char* lds, int tid) {
    LAS f32x2* buf = (LAS f32x2*)lds;
    const bf16* HYT = (const bf16*)(wsb() + WS_HYT); bf16* YT = (bf16*)(wsb() + WS_YT); const f32x2* KF = (const f32x2*)(wsb() + WS_KF);
    const float* hb = inp(I_HBIAS) + (size_t)l * 2 * 1024;
    for (int u = blockIdx.x; u < 2048; u += gridDim.x) {
        const int c = u >> 1, b0 = (u & 1) * 2;
        const bf16* x1p = HYT + ((size_t)(0 * NB + b0) * 1024 + c) * SEQ; const bf16* x2p = HYT + ((size_t)(1 * NB + b0) * 1024 + c) * SEQ; const bf16* vp = HYT + ((size_t)(2 * NB + b0) * 1024 + c) * SEQ;
        const size_t bstr = (size_t)1024 * SEQ;
        float y0[8], y1[8];
        __syncthreads();
#pragma unroll
        for (int i = 0; i < 8; ++i) { const int t = tid + 512 * i; y0[i] = bf1(vp[t]); y1[i] = bf1(vp[bstr + t]); buf[t] = (f32x2){y0[i], y1[i]}; buf[4096 + t] = (f32x2){0.f, 0.f}; }
        __syncthreads();
#pragma unroll
        for (int ord = 0; ord < 2; ++ord) {
            fft_dif(buf, tid);
            const f32x2* kf = KF + (size_t)(ord * 1024 + c) * 8192;
            for (int i = 0; i < 16; ++i) { const int p = tid + 512 * i; const f32x2 k = kf[p], v = buf[p]; buf[p] = (f32x2){v.x * k.x - v.y * k.y, v.x * k.y + v.y * k.x}; }
            __syncthreads();
            fft_idit(buf, tid);
            const bf16* xp = ord ? x2p : x1p; const float bias = hb[ord * 1024 + c];
#pragma unroll
            for (int i = 0; i < 8; ++i) { const int t = tid + 512 * i; const f32x2 cv = buf[t] * (1.0f / 8192.0f);
                y0[i] = bf1(xp[t]) * (cv.x + bias * y0[i]); y1[i] = bf1(xp[bstr + t]) * (cv.y + bias * y1[i]);
                if (ord == 0) { buf[t] = (f32x2){y0[i], y1[i]}; buf[4096 + t] = (f32x2){0.f, 0.f}; } }
            __syncthreads();
        }
        bf16* o0 = YT + ((size_t)b0 * 1024 + c) * SEQ;
#pragma unroll
        for (int i = 0; i < 8; ++i) { const int t = tid + 512 * i; o0[t] = (bf16)f2bf(y0[i]); o0[bstr + t] = (bf16)f2bf(y1[i]); }
    }
}
__device__ __forceinline__ void ph_scan(const Args& A, int l, int tid) {
    float* KV = (float*)(wsb() + WS_KV);
    for (int gt = blockIdx.x * 512 + tid; gt < NB * 8 * 2 * 2048; gt += gridDim.x * 512) {
        const int bhd = gt >> 11, e4 = gt & 2047, dir = bhd & 1, h = (bhd >> 1) & 7;
        const float gC = ex2(inp(I_RDEC)[(l * 2 + dir) * 8 + h] * LOG2E * 128.0f);
        f32x4* base = (f32x4*)(KV + (size_t)bhd * 34 * 8192) + e4;
        f32x4 s = (f32x4){0.f, 0.f, 0.f, 0.f};
#pragma unroll 2
        for (int step = 0; step < 34; ++step) { const int ci = (dir == 0) ? step : (step == 0 ? 1 : (step == 1 ? 0 : 35 - step));
            const f32x4 tmp = base[(size_t)ci * 2048]; base[(size_t)ci * 2048] = s; s = s * gC + tmp; }
    }
}

__device__ __forceinline__ void ph_hypost(const Args& A, LAS unsigned char* lds, int tid) {
    LAS bf16* T = (LAS bf16*)lds;
    const bf16* YT = (const bf16*)(wsb() + WS_YT); bf16* YS = (bf16*)(wsb() + WS_YS);
    for (int u = blockIdx.x; u < 1024; u += gridDim.x) {
        const int cg = u & 3, tt = (u >> 2) & 63, b = u >> 8;
        __syncthreads();
        for (int q = tid; q < 2048; q += 512) { const int c = q >> 3, t8 = q & 7;
            *(LAS v4u*)(T + c * 72 + t8 * 8) = *(const v4u*)(YT + ((size_t)b * 1024 + cg * 256 + c) * SEQ + tt * 64 + t8 * 8); }
        __syncthreads();
        const int t = tid >> 3, c32 = tid & 7;
#pragma unroll
        for (int q = 0; q < 4; ++q) { const int cb = c32 * 32 + q * 8; v4u w;
            w.x = (unsigned)T[(cb + 0) * 72 + t] | ((unsigned)T[(cb + 1) * 72 + t] << 16); w.y = (unsigned)T[(cb + 2) * 72 + t] | ((unsigned)T[(cb + 3) * 72 + t] << 16);
            w.z = (unsigned)T[(cb + 4) * 72 + t] | ((unsigned)T[(cb + 5) * 72 + t] << 16); w.w = (unsigned)T[(cb + 6) * 72 + t] | ((unsigned)T[(cb + 7) * 72 + t] << 16);
            *(v4u*)(YS + (size_t)(b * SEQ + tt * 64 + t) * 1024 + cg * 256 + cb) = w; }
    }
}
__device__ __forceinline__ void ph_ret3(const Args& A, int l, int nctx_units, LAS unsigned char* lds, int tid) {
    LAS bf16* Qs = (LAS bf16*)lds; LAS bf16* Ks = Qs + 128 * 72; LAS bf16* Vt = Ks + 128 * 72; LAS bf16* Sf = Vt + 128 * 136; LAS bf16* Sb = Sf + 128 * 72;
    const bf16* Z = (const bf16*)(wsb() + WS_Z); const float* KV = (const float*)(wsb() + WS_KV); const f32x2* rope = (const f32x2*)(wsb() + WS_ROPE);
    bf16* YS = (bf16*)(wsb() + WS_YS) + (size_t)MT * 1024;
    const int lane = tid & 63, w = tid >> 6, g = lane >> 4, li = lane & 15;
    for (int uid = blockIdx.x; uid < 1024 + nctx_units; uid += gridDim.x) {
        const bool isc = uid >= 1024; int b, h, n, ci; size_t m0;
        if (!isc) { b = uid >> 8; h = (uid >> 5) & 7; n = uid & 31; m0 = (size_t)b * SEQ + n * 128; ci = 2 + n; }
        else { const int i = uid - 1024; b = i >> 4; h = (i >> 1) & 7; n = i & 1; m0 = (size_t)ML + b * CL + n * 128; ci = n; }
        const float lgf = inp(I_RDEC)[(l * 2 + 0) * 8 + h] * LOG2E, lgb = inp(I_RDEC)[(l * 2 + 1) * 8 + h] * LOG2E;
        __syncthreads();
        { const int tok = tid >> 2, pp = tid & 3, a = (pp & 1) + ((pp >> 1) << 2);
            const int t = n * 128 + tok; const int pos = (a < 4) ? (t >> 6) : (t & 63); const f32x2* rt = rope + pos * 16 + 8 * (a & 1);
            const bf16* qr = Z + (m0 + tok) * INW + C_RQ + h * 64; const bf16* kr = Z + (m0 + tok) * INW + C_RK + h * 64;
            float lo[8], hi[8];
            unpack8(*(const v4u*)(qr + 8 * a), lo); unpack8(*(const v4u*)(qr + 8 * a + 16), hi);
            if (!isc) rope8(lo, hi, rt);
            *(LAS v4u*)(Qs + tok * 72 + 8 * a) = pack8(lo); *(LAS v4u*)(Qs + tok * 72 + 8 * a + 16) = pack8(hi);
            unpack8(*(const v4u*)(kr + 8 * a), lo); unpack8(*(const v4u*)(kr + 8 * a + 16), hi);
            if (!isc) rope8(lo, hi, rt);
#pragma unroll
            for (int e = 0; e < 8; ++e) { lo[e] *= 0.125f; hi[e] *= 0.125f; }
            *(LAS v4u*)(Ks + tok * 72 + 8 * a) = pack8(lo); *(LAS v4u*)(Ks + tok * 72 + 8 * a + 16) = pack8(hi); }
        for (int q = tid; q < 2048; q += 512) { const int r = q >> 4, ch = q & 15; vt_store(Vt, 136, ch * 8, r, *(const v4u*)(Z + (m0 + r) * INW + C_RV + h * 128 + ch * 8)); }
#pragma unroll
        for (int dir = 0; dir < 2; ++dir) { const f32x4* src = (const f32x4*)(KV + ((size_t)((b * 8 + h) * 2 + dir) * 34 + ci) * 8192); LAS bf16* S = dir ? Sb : Sf;
            for (int q = tid; q < 2048; q += 512) { const f32x4 v = src[q]; v2u wv; wv.x = pk2(v.x, v.y); wv.y = pk2(v.z, v.w); *(LAS v2u*)(S + (q >> 4) * 72 + (q & 15) * 4) = wv; } }
        __syncthreads();
        const int iq = 16 * w + li;
        bf16x8 qf[2];
#pragma unroll
        for (int ks = 0; ks < 2; ++ks) qf[ks] = *(const LAS bf16x8*)(Qs + iq * 72 + 32 * ks + 8 * g);
        f32x4 s[8];
#pragma unroll
        for (int nn = 0; nn < 8; ++nn) { s[nn] = (f32x4){0.f, 0.f, 0.f, 0.f};
#pragma unroll
            for (int ks = 0; ks < 2; ++ks) s[nn] = mfma16(*(const LAS bf16x8*)(Ks + (16 * nn + li) * 72 + 32 * ks + 8 * g), qf[ks], s[nn]);
#pragma unroll
            for (int j = 0; j < 4; ++j) { const int d = iq - (16 * nn + 4 * g + j); s[nn][j] *= (d >= 0) ? ex2(lgf * (float)d) : ex2(lgb * (float)(-d)); } }
        f32x4 o[8];
#pragma unroll
        for (int nd = 0; nd < 8; ++nd) o[nd] = (f32x4){0.f, 0.f, 0.f, 0.f};
#pragma unroll
        for (int kk = 0; kk < 4; ++kk) {
            const bf16x8 pf = mk8(pk2(s[2 * kk][0], s[2 * kk][1]), pk2(s[2 * kk][2], s[2 * kk][3]), pk2(s[2 * kk + 1][0], s[2 * kk + 1][1]), pk2(s[2 * kk + 1][2], s[2 * kk + 1][3]));
#pragma unroll
            for (int nd = 0; nd < 8; ++nd) { const LAS bf16* vp = Vt + (16 * nd + li) * 136 + 32 * kk + 4 * g;
                const v2u lo = *(const LAS v2u*)vp, hi = *(const LAS v2u*)(vp + 16);
                o[nd] = mfma16(mk8(lo.x, lo.y, hi.x, hi.y), pf, o[nd]); } }
        const float xif = ex2(lgf * (float)(iq + 1)), xib = ex2(lgb * (float)(128 - iq));
        float ss = 0.f;
#pragma unroll
        for (int nd = 0; nd < 8; ++nd) { f32x4 tf = (f32x4){0.f, 0.f, 0.f, 0.f}, tb = (f32x4){0.f, 0.f, 0.f, 0.f};
#pragma unroll
            for (int ks = 0; ks < 2; ++ks) { tf = mfma16(*(const LAS bf16x8*)(Sf + (16 * nd + li) * 72 + 32 * ks + 8 * g), qf[ks], tf);
                tb = mfma16(*(const LAS bf16x8*)(Sb + (16 * nd + li) * 72 + 32 * ks + 8 * g), qf[ks], tb); }
            o[nd] = o[nd] + tf * xif + tb * xib;
            ss += (o[nd][0] * o[nd][0] + o[nd][1] * o[nd][1]) + (o[nd][2] * o[nd][2] + o[nd][3] * o[nd][3]); }
        ss += __shfl_xor(ss, 16); ss += __shfl_xor(ss, 32);
        const float rn = 1.0f / sqrtf(ss * (1.0f / 128.0f) + EPS);
        const size_t mrow = m0 + iq;
#pragma unroll
        for (int nd = 0; nd < 8; ++nd) { const int dv = 16 * nd + 4 * g; const v2u gv = *(const v2u*)(Z + mrow * INW + C_RG + h * 128 + dv);
            const float g0 = bflo(gv.x), g1 = bfhi(gv.x), g2 = bflo(gv.y), g3 = bfhi(gv.y);
            v2u wv; wv.x = pk2(g0 / (1.0f + __expf(-g0)) * o[nd][0] * rn, g1 / (1.0f + __expf(-g1)) * o[nd][1] * rn);
            wv.y = pk2(g2 / (1.0f + __expf(-g2)) * o[nd][2] * rn, g3 / (1.0f + __expf(-g3)) * o[nd][3] * rn);
            *(v2u*)(YS + mrow * 1024 + h * 128 + dv) = wv; }
    }
}

__device__ __forceinline__ float gelu_t(float x) { const float u = 0.7978845608028654f * (x + 0.044715f * x * x * x); const float e = __expf(2.0f * u); return 0.5f * x * (2.0f - 2.0f / (1.0f + e)); }
__device__ __forceinline__ void ph_ffnmid(const Args& A, int l, int Mrows, int tid) {
    const bf16* AB = (const bf16*)(wsb() + WS_Z); bf16* U = (bf16*)(wsb() + WS_U);
    const float* cw = inp(I_FFCW) + (size_t)l * 3 * DFF; const float* cb = inp(I_FFCB) + (size_t)l * DFF;
    const int cgi = tid & 63, rsub = tid >> 6; const int nunits = (Mrows / 32) * 11;
    for (int u = blockIdx.x; u < nunits; u += gridDim.x) {
        const int cblk = u % 11, rblk = u / 11, col = cblk * 512 + cgi * 8;
        float w0[8], w1[8], w2[8], bb[8];
#pragma unroll
        for (int e = 0; e < 8; ++e) { w0[e] = cw[col + e]; w1[e] = cw[DFF + col + e]; w2[e] = cw[2 * DFF + col + e]; bb[e] = cb[col + e]; }
#pragma unroll
        for (int rr = 0; rr < 4; ++rr) { const int m = rblk * 32 + rr * 8 + rsub;
            const bool first = (m < ML) ? ((m & (SEQ - 1)) == 0) : ((m & (CL - 1)) == 0), last = (m < ML) ? ((m & (SEQ - 1)) == SEQ - 1) : ((m & (CL - 1)) == CL - 1);
            const bf16* ap = AB + (size_t)m * NFF + col;
            float am[8], a0[8], aq[8], bg[8];
            const v4u z4 = (v4u){0u, 0u, 0u, 0u};
            unpack8(first ? z4 : *(const v4u*)(ap - NFF), am); unpack8(*(const v4u*)ap, a0); unpack8(last ? z4 : *(const v4u*)(ap + NFF), aq); unpack8(*(const v4u*)(ap + DFF), bg);
            float r[8];
#pragma unroll
            for (int e = 0; e < 8; ++e) r[e] = gelu_t(w0[e] * am[e] + w1[e] * a0[e] + w2[e] * aq[e] + bb[e]) * bg[e];
            *(v4u*)(U + (size_t)m * DFF + col) = pack8(r); }
    }
}
__device__ __forceinline__ void ph_final(const Args& A, int wave, int lane) {
    const int gw = blockIdx.x * NWAVES + wave, NGW = gridDim.x * NWAVES; const float* g = inp(I_GF);
    for (int m = gw; m < ML; m += NGW) { float* xr = outb() + (size_t)m * D; f32x4 v[8]; float ss = 0.f;
#pragma unroll
        for (int j = 0; j < 8; ++j) { v[j] = *(const f32x4*)(xr + (lane + 64 * j) * 4); ss += (v[j].x * v[j].x + v[j].y * v[j].y) + (v[j].z * v[j].z + v[j].w * v[j].w); }
        const float rstd = 1.0f / sqrtf(wave_sum(ss) * (1.0f / D) + EPS);
#pragma unroll
        for (int j = 0; j < 8; ++j) { const int idx = (lane + 64 * j) * 4; *(f32x4*)(xr + idx) = v[j] * rstd * *(const f32x4*)(g + idx); }
    }
}
constexpr int SEQ_PER_LAYER = 11, NSEQ = 1 + DEPTH * SEQ_PER_LAYER + 1;
__global__ void __launch_bounds__(NWAVES * 64, 2) fwd(Args A) {
    extern __shared__ __attribute__((aligned(16))) unsigned char lds_raw[];
    LAS unsigned char* lds = (LAS unsigned char*)lds_raw;
    volatile LAS unsigned* MISC = (volatile LAS unsigned*)(lds + MISC_OFF);
    for (int u = threadIdx.x; u < (LDS_BYTES - LDSCTL_OFF) / 4; u += NWAVES * 64) ((LAS unsigned*)(lds + LDSCTL_OFF))[u] = 0u;
    __syncthreads();
    (void)xcd_barrier_post((unsigned*)(wsb() + WS_CTL) + CW_BAR, MISC + 8);
    const int lo = A.seq_lo, hi = A.seq_hi;
#define G ((int)gridDim.x)
#define RUN(s) (lo <= (s) && (s) < hi)
#define TID_HERE const int tid = otid(), lane = tid & 63, wave = __builtin_amdgcn_readfirstlane(tid >> 6); (void)lane; (void)wave
#ifdef ONLY
#define PH_ON(k) ((k) == ONLY)
#elif defined(SKIP)
#define PH_ON(k) ((k) != SKIP)
#else
#define PH_ON(k) true
#endif
#define SEAM(s) do { if (RUN((s) + 1)) { XcdBarrier bar_; bar_.bar = (unsigned*)(wsb() + WS_CTL) + CW_BAR; bar_.x = xb_xcc_id(); bar_.st = (volatile LAS unsigned*)(lds + MISC_OFF) + 8; xcd_barrier(bar_); } } while (0)
#define H ((bf16*)(wsb() + WS_H))
#define Z ((bf16*)(wsb() + WS_Z))
#define ACC ((bf16*)(wsb() + WS_ACC))
#define U ((bf16*)(wsb() + WS_U))
#define YS ((bf16*)(wsb() + WS_YS))
#define XC ((float*)(wsb() + WS_XC))
#define WIN ((const bf16*)(wsb() + WS_WIN))
#define WBR ((const bf16*)(wsb() + WS_WBR))
#define WOUT ((const bf16*)(wsb() + WS_WOUT))
#define WF1 ((const bf16*)(wsb() + WS_WF1))
#define WF2 ((const bf16*)(wsb() + WS_WF2))

    if (PH_ON(100) && RUN(0)) { TID_HERE; ph_prologue(A, lds, tid); SEAM(0); }

    for (int l = 0; l < DEPTH; ++l) {
        const int sb = 1 + l * SEQ_PER_LAYER;
        if (hi <= sb || lo >= sb + SEQ_PER_LAYER) continue;
        const bool lastl = (l == DEPTH - 1);
        const int Mrows = lastl ? ML : MT, nctx = lastl ? 0 : 64;
#define modl ((const float*)(wsb() + WS_MOD) + (size_t)l * 5 * 12288)
#define xlat_in ((l == 0) ? inp(I_X) : (const float*)outb())
#define xctx_in ((l == 0) ? inp(I_CTX) : (const float*)XC)

        if (PH_ON(0) && RUN(sb + 0)) { TID_HERE;
#ifndef NO_A1
            ph_convert(A, l, lds, wave, lane);
#endif
            __syncthreads();
#ifndef NO_A2
            ph_filt1(A, l, lds, tid);
#endif
#ifndef NO_A3
            ph_norm(xlat_in, xctx_in, inp(I_G1) + (size_t)l * D, modl, 0, D, H, MT, wave, lane);
#endif
            SEAM(sb + 0);
        }
        if (PH_ON(1) && RUN(sb + 1)) { TID_HERE;
            { pg8::Gemm g{H, WIN, opq(MT), opq(INW), opq(D)}; pg8::StaticOrder S; S.init(g.M, g.N, G, (int)blockIdx.x);
              pg8::EpiStore E{Z, INW};
#ifndef NO_B1
              pg8::gemm_phase<pg8::EpiStore, pg8::StaticOrder, PG8_ALIGN, PG8_SP2>(lds, g, S, E);
#endif
 }
#ifndef NO_B2
            ph_filt2(A, l, lds, tid);
#endif
            SEAM(sb + 1);
        }
        if (PH_ON(2) && RUN(sb + 2)) { TID_HERE;
            ph_hyprep(A, l, lds, tid);
            ph_ret1(A, l, 64, lds, tid);
            ph_natt(A, l, nctx, lds, tid);
            if (!lastl) ph_hyctx(A, l, lds, tid);
            SEAM(sb + 2);
        }
        if (PH_ON(3) && RUN(sb + 3)) { TID_HERE;
#ifndef NO_D1
            ph_hyfft(A, l, lds, tid);
#endif
#ifndef NO_D2
            ph_scan(A, l, tid);
#endif
            SEAM(sb + 3);
        }
        if (PH_ON(4) && RUN(sb + 4)) { TID_HERE;
            ph_hypost(A, lds, tid);
            ph_ret3(A, l, nctx, lds, tid);
            SEAM(sb + 4);
        }
        if (PH_ON(5) && RUN(sb + 5)) { TID_HERE;
            __syncthreads();
            for (int i = 0; i < 3; ++i) {
                pg8::Gemm g{YS + (size_t)i * MT * 1024, WBR + (size_t)i * D * 1024, Mrows, opq(D), opq(1024)}; pg8::StaticOrder S; S.init(g.M, g.N, G, (int)blockIdx.x);
                pg8::EpiMerge E{ACC, Z + C_GT + i * D, INW, i == 0 ? 1 : 0};
                pg8::gemm_phase<pg8::EpiMerge, pg8::StaticOrder, PG8_ALIGN, PG8_SP2>(lds, g, S, E);
            }
            SEAM(sb + 5);
        }
        if (PH_ON(6) && RUN(sb + 6)) { TID_HERE;
            __syncthreads();
            pg8::Gemm g{ACC, WOUT, Mrows, opq(D), opq(D)}; pg8::StaticOrder S; S.init(g.M, g.N, G, (int)blockIdx.x);
            pg8::EpiResid E{xlat_in, xctx_in, outb(), XC, modl, 2 * D};
            pg8::gemm_phase<pg8::EpiResid, pg8::StaticOrder, PG8_ALIGN, PG8_SP2>(lds, g, S, E);
            SEAM(sb + 6);
        }
        if (PH_ON(7) && RUN(sb + 7)) { TID_HERE;
            ph_norm(outb(), XC, inp(I_G2) + (size_t)l * D, modl, 3 * D, 4 * D, H, Mrows, wave, lane);
            SEAM(sb + 7);
        }
        if (PH_ON(8) && RUN(sb + 8)) { TID_HERE;
            __syncthreads();
            pg8::Gemm g{H, WF1, Mrows, opq(NFF), opq(D)}; pg8::StaticOrder S; S.init(g.M, g.N, G, (int)blockIdx.x);
            pg8::EpiStore E{Z, NFF};
            pg8::gemm_phase<pg8::EpiStore, pg8::StaticOrder, PG8_ALIGN, PG8_SP2>(lds, g, S, E);
            SEAM(sb + 8);
        }
        if (PH_ON(9) && RUN(sb + 9)) { TID_HERE;
            ph_ffnmid(A, l, Mrows, tid);
            SEAM(sb + 9);
        }
        if (PH_ON(10) && RUN(sb + 10)) { TID_HERE;
            __syncthreads();
            pg8::Gemm g{U, WF2, Mrows, opq(D), opq(DFF)}; pg8::StaticOrder S; S.init(g.M, g.N, G, (int)blockIdx.x);
            pg8::EpiResid E{outb(), XC, outb(), XC, modl, 5 * D};
            pg8::gemm_phase<pg8::EpiResid, pg8::StaticOrder, PG8_ALIGN, PG8_SP2>(lds, g, S, E);
            SEAM(sb + 10);
        }
    }
    if (PH_ON(101) && RUN(NSEQ - 1)) { TID_HERE; ph_final(A, wave, lane); }
#undef RUN
#undef SEAM
#undef H
#undef Z
#undef ACC
#undef U
#undef YS
#undef XC
#undef WIN
#undef WBR
#undef WOUT
#undef WF1
#undef WF2
#undef G
#undef modl
#undef xlat_in
#undef xctx_in
}

extern "C" void kernel_launch(void* const* d_in, const int* in_sizes, int n_in, void* d_out, int out_size, void* d_ws, size_t ws_size, hipStream_t stream) {
    static int grid = 0;
    if (grid == 0) {
        if (n_in != 27 || out_size != ML * D || ws_size < WS_END) { fprintf(stderr, "kernel_launch: unexpected shapes (n_in %d out %d ws %zu need %zu)\n", n_in, out_size, ws_size, (size_t)WS_END); grid = -1; return; }
        int dev = 0, cus = 0, per_cu = 0;
        if (hipGetDevice(&dev) != hipSuccess || hipDeviceGetAttribute(&cus, hipDeviceAttributeMultiprocessorCount, dev) != hipSuccess) { grid = -1; return; }
        if (hipFuncSetAttribute((const void*)fwd, hipFuncAttributeMaxDynamicSharedMemorySize, LDS_BYTES) != hipSuccess) { fprintf(stderr, "kernel_launch: hipFuncSetAttribute failed\n"); grid = -1; return; }
        if (hipOccupancyMaxActiveBlocksPerMultiprocessor(&per_cu, (const void*)fwd, NWAVES * 64, LDS_BYTES) != hipSuccess || per_cu < 1) fprintf(stderr, "kernel_launch: occupancy query says %d\n", per_cu);
        (void)hipGetLastError();
        grid = cus;
    }
    if (grid < 0) return;
    (void)hipMemsetAsync((char*)d_ws + WS_CTL, 0, CTL_ZERO_BYTES, stream);
    Args a{};
    for (int i = 0; i < 27; ++i) a.in[i] = (const float*)d_in[i];
    a.out = (float*)d_out; a.ws = (unsigned char*)d_ws;
#if MK_SINGLE
    a.seq_lo = 0; a.seq_hi = NSEQ;
    hipLaunchKernelGGL(fwd, dim3(grid), dim3(NWAVES * 64), LDS_BYTES, stream, a);
#else
    for (int s = 0; s < NSEQ; ++s) { a.seq_lo = s; a.seq_hi = s + 1; hipLaunchKernelGGL(fwd, dim3(grid), dim3(NWAVES * 64), LDS_BYTES, stream, a); }
#endif
}
```

```cpp
#include <hip/hip_runtime.h>
#include <cstdio>
#include <cstdint>
#ifndef MK_SINGLE
#define MK_SINGLE 1
#endif
namespace pg8 {
#define PG8_LAS __attribute__((address_space(3)))
typedef unsigned short bf16_t;
typedef short bf16x8 __attribute__((ext_vector_type(8)));
typedef float f32x4 __attribute__((ext_vector_type(4)));
typedef unsigned u32x4 __attribute__((ext_vector_type(4)));
constexpr int BM = 256, BK = 64, HALF = 128, HTB = HALF * BK * 2  , STAGE_BYTES = 8 * HTB, NXCD = 8, WGM = 8;

__host__ __device__ __forceinline__ int lds_byte(int r, int c) { const int st = (r >> 4) * 2 + (c >> 5), rr = r & 15, cc = c & 31, ob = rr * 64 + cc * 2; return st * 1024 + (ob ^ (((ob >> 9) & 1) << 5)); }
__host__ __device__ __forceinline__ void stage_rc(int b, int& R, int& C) { const int st = b / 1024, sb = b % 1024, swz = sb ^ (((sb >> 9) & 1) << 5); R = (st >> 1) * 16 + swz / 64; C = (st & 1) * 32 + (swz % 64) / 2; }
__host__ __device__ __forceinline__ int perm32(int rho) { const int n = rho >> 4, i = rho & 15; return 8 * (i >> 2) + 4 * n + (i & 3); }

struct Unit { int pm, pn; };
struct Gemm { const bf16_t* A; const bf16_t* Bt; int M, N, K; };

struct StaticOrder {
    int nM, nN, nwg, G, c;
    __host__ __device__ void init(int M, int N, int G_, int c_) { nM = M / BM; nN = N / BM; nwg = nM * nN; G = G_; c = c_; }
    __host__ __device__ bool next(int i, Unit& u) const {
        const long L = (long)i * G + c; if (L >= nwg) return false;
        int wgid = (int)L; { const int q = nwg / NXCD, r = nwg % NXCD, xcd = wgid % NXCD, off = wgid / NXCD; wgid = (xcd < r ? xcd * (q + 1) : r * (q + 1) + (xcd - r) * q) + off; }
        const int nig = WGM * nN, gid = wgid / nig, fm = gid * WGM, gsz = (nM - fm) < WGM ? (nM - fm) : WGM;
        u.pm = fm + ((wgid % nig) % gsz); u.pn = (wgid % nig) / gsz; return true;
    }
    __device__ __forceinline__ void a_ready(const Unit&) const {}
    __device__ __forceinline__ void done(const Unit&) const {}
};
__device__ __forceinline__ unsigned cvt_pk_bf16(float lo, float hi) { unsigned r; asm volatile("v_cvt_pk_bf16_f32 %0, %1, %2" : "=v"(r) : "v"(lo), "v"(hi)); return r; }
typedef float f32x2 __attribute__((ext_vector_type(2)));
__device__ __forceinline__ float bflo(unsigned w) { return __uint_as_float(w << 16); }
__device__ __forceinline__ float bfhi(unsigned w) { return __uint_as_float(w & 0xffff0000u); }
__device__ __forceinline__ float sigm(float x) { return 1.0f / (1.0f + __expf(-x)); }
struct EpiStore {
    static constexpr bool PERM = true, AFTER_DRAIN = false;
    bf16_t* O; int ldc;
    __device__ __forceinline__ void operator()(const f32x4 (&acc)[2][2][4][2], const Unit& u, int wr, int wc, int fr, int fq) const {
        const int row0 = u.pm * BM + wr * 64 + fr, col0 = u.pn * BM + wc * 32 + 8 * fq;
#pragma unroll
        for (int ai = 0; ai < 2; ++ai)
#pragma unroll
            for (int m = 0; m < 4; ++m) { bf16_t* rowp = O + (size_t)(row0 + ai * HALF + m * 16) * ldc + col0;
#pragma unroll
                for (int bj = 0; bj < 2; ++bj) { const f32x4 v0 = acc[ai][bj][m][0], v1 = acc[ai][bj][m][1];
                    u32x4 w; w.x = cvt_pk_bf16(v0[0], v0[1]); w.y = cvt_pk_bf16(v0[2], v0[3]); w.z = cvt_pk_bf16(v1[0], v1[1]); w.w = cvt_pk_bf16(v1[2], v1[3]);
                    *(u32x4*)(rowp + bj * HALF) = w; } }
    }
};
struct EpiMerge {
    static constexpr bool PERM = true, AFTER_DRAIN = false;
    bf16_t* O; const bf16_t* gate; int ldg; int first;
    __device__ __forceinline__ void operator()(const f32x4 (&acc)[2][2][4][2], const Unit& u, int wr, int wc, int fr, int fq) const {
        const int row0 = u.pm * BM + wr * 64 + fr, col0 = u.pn * BM + wc * 32 + 8 * fq;
#pragma unroll
        for (int ai = 0; ai < 2; ++ai)
#pragma unroll
            for (int m = 0; m < 4; ++m) { const size_t row = (size_t)(row0 + ai * HALF + m * 16);
#pragma unroll
                for (int bj = 0; bj < 2; ++bj) { const int col = col0 + bj * HALF;
                    const u32x4 gv = *(const u32x4*)(gate + row * ldg + col);
                    u32x4 pv = (u32x4){0u, 0u, 0u, 0u}; if (!first) pv = *(const u32x4*)(O + row * 2048 + col);
                    const f32x4 v0 = acc[ai][bj][m][0], v1 = acc[ai][bj][m][1];
                    u32x4 w;
                    w.x = cvt_pk_bf16(bflo(pv.x) + v0[0] * sigm(bflo(gv.x)), bfhi(pv.x) + v0[1] * sigm(bfhi(gv.x)));
                    w.y = cvt_pk_bf16(bflo(pv.y) + v0[2] * sigm(bflo(gv.y)), bfhi(pv.y) + v0[3] * sigm(bfhi(gv.y)));
                    w.z = cvt_pk_bf16(bflo(pv.z) + v1[0] * sigm(bflo(gv.z)), bfhi(pv.z) + v1[1] * sigm(bfhi(gv.z)));
                    w.w = cvt_pk_bf16(bflo(pv.w) + v1[2] * sigm(bflo(gv.w)), bfhi(pv.w) + v1[3] * sigm(bfhi(gv.w)));
                    *(u32x4*)(O + row * 2048 + col) = w; } }
    }
};
struct EpiResid {
    static constexpr bool PERM = false, AFTER_DRAIN = false;
    const float* base_lat; const float* base_ctx; float* out_lat; float* out_ctx; const float* modl; int goff;
    __device__ __forceinline__ void operator()(const f32x4 (&acc)[2][2][4][2], const Unit& u, int wr, int wc, int fr, int fq) const {
        const bool isctx = u.pm >= 64; const int r = isctx ? 4 : (u.pm >> 4);
        const float* gvp = modl + (size_t)r * 12288 + goff;
        const float* bs = isctx ? base_ctx : base_lat; float* os = isctx ? out_ctx : out_lat;
        const int row0 = (isctx ? u.pm - 64 : u.pm) * BM + wr * 64 + fr, col0 = u.pn * BM + wc * 32 + 4 * fq;
        f32x4 g4[2][2];
#pragma unroll
        for (int bj = 0; bj < 2; ++bj)
#pragma unroll
            for (int n = 0; n < 2; ++n) g4[bj][n] = *(const f32x4*)(gvp + col0 + bj * HALF + n * 16);
#pragma unroll
        for (int ai = 0; ai < 2; ++ai)
#pragma unroll
            for (int m = 0; m < 4; ++m) { const size_t off = (size_t)(row0 + ai * HALF + m * 16) * 2048 + col0;
#pragma unroll
                for (int bj = 0; bj < 2; ++bj)
#pragma unroll
                    for (int n = 0; n < 2; ++n) { const f32x4 b4 = *(const f32x4*)(bs + off + bj * HALF + n * 16);
                        *(f32x4*)(os + off + bj * HALF + n * 16) = b4 + g4[bj][n] * acc[ai][bj][m][n]; } }
    }
};
template <class Epi, class Sched, bool ALIGN_EPI = false, bool SP2 = false>
__device__ __forceinline__ void gemm_phase(PG8_LAS unsigned char* lds, const Gemm g, const Sched& S, const Epi& E) {
    int tid_ = threadIdx.x; asm volatile("" : "+v"(tid_)); const int tid = tid_, wid = __builtin_amdgcn_readfirstlane(tid >> 6), lane = tid & 63, wr = wid >> 2, wc = wid & 3, fr = lane & 15, fq = lane >> 4;
    const int K = g.K, nt = K / BK;
    unsigned voffA[2], voffB[2];
#pragma unroll
    for (int i = 0; i < 2; ++i) { int R, C; stage_rc(tid * 16 + i * 8192, R, C); const int Rb = Epi::PERM ? ((R & ~31) + perm32(R & 31)) : R;
        voffA[i] = (unsigned)(R * K + C) * 2u; voffB[i] = (unsigned)(Rb * K + C) * 2u; }
    const size_t kstep = (size_t)(BK * 2);
    const size_t hstep = (size_t)HALF * K * 2;
    const size_t tstep = 2 * hstep;
    const unsigned ldsw = (unsigned)wid * 1024u;
    const int aoff = lds_byte(wr * 64 + fr, fq * 8), boff = lds_byte(wc * 32 + fr, fq * 8);
#define PG8_SA(b, h) (((b) * 2 + (h)) * HTB)
#define PG8_SB(b, h) ((4 + (b) * 2 + (h)) * HTB)
#define PG8_STAGE(bufoff, gbase, voff) do { _Pragma("unroll") for (int _i = 0; _i < 2; ++_i) \
        __builtin_amdgcn_global_load_lds((const unsigned*)((const char*)(gbase) + (voff)[_i]), (PG8_LAS unsigned*)(lds + (bufoff) + ldsw + _i * 8192), 16, 0, 0); } while (0)
#define PG8_LDA(dst, b, h) do { _Pragma("unroll") for (int m = 0; m < 4; ++m) _Pragma("unroll") for (int k = 0; k < 2; ++k) dst[m][k] = *(const PG8_LAS bf16x8*)(lds + PG8_SA(b, h) + aoff + m * 2048 + k * 1024); } while (0)
#define PG8_LDB(dst, b, h) do { _Pragma("unroll") for (int n = 0; n < 2; ++n) _Pragma("unroll") for (int k = 0; k < 2; ++k) dst[n][k] = *(const PG8_LAS bf16x8*)(lds + PG8_SB(b, h) + boff + n * 2048 + k * 1024); } while (0)
#define PG8_MMA(ai, bj, At, Bt) do { __builtin_amdgcn_s_setprio(1); _Pragma("unroll") for (int m = 0; m < 4; ++m) _Pragma("unroll") for (int n = 0; n < 2; ++n) _Pragma("unroll") for (int k = 0; k < 2; ++k) \
        acc[ai][bj][m][n] = __builtin_amdgcn_mfma_f32_16x16x32_bf16(Bt[n][k], At[m][k], acc[ai][bj][m][n], 0, 0, 0); __builtin_amdgcn_s_setprio(0); } while (0)
#define PG8_WAIT_V(n) asm volatile("s_waitcnt vmcnt(" #n ")" ::: "memory")
#define PG8_WAIT_L(n) asm volatile("s_waitcnt lgkmcnt(" #n ")" ::: "memory")
#define PG8_BAR __builtin_amdgcn_s_barrier()
#define PG8_SCHED __builtin_amdgcn_sched_barrier(0)
    Unit cur, nxt; int ui = 0;
    if (!S.next(0, cur)) return;
    f32x4 acc[2][2][4][2];
#pragma unroll
    for (int a = 0; a < 2; ++a)
#pragma unroll
        for (int b = 0; b < 2; ++b)
#pragma unroll
            for (int m = 0; m < 4; ++m)
#pragma unroll
                for (int n = 0; n < 2; ++n) acc[a][b][m][n] = (f32x4){0.f, 0.f, 0.f, 0.f};
    bf16x8 At[4][2], B0[2][2], B1[2][2];
    const char* cA = (const char*)g.A + (size_t)cur.pm * tstep; const char* cB = (const char*)g.Bt + (size_t)cur.pn * tstep;
    S.a_ready(cur);
    if constexpr (SP2) {
        PG8_STAGE(PG8_SB(0, 0), cB, voffB); PG8_STAGE(PG8_SB(0, 1), cB + hstep, voffB); PG8_STAGE(PG8_SA(0, 0), cA, voffA); PG8_STAGE(PG8_SA(0, 1), cA + hstep, voffA);
        if (wr == 1) PG8_BAR;
        PG8_WAIT_V(2); PG8_BAR;
        PG8_STAGE(PG8_SB(1, 0), cB + kstep, voffB); PG8_STAGE(PG8_SA(1, 0), cA + kstep, voffA); PG8_STAGE(PG8_SB(1, 1), cB + hstep + kstep, voffB);
        PG8_WAIT_V(6); PG8_BAR;
    } else {
        PG8_STAGE(PG8_SB(0, 0), cB, voffB); PG8_STAGE(PG8_SA(0, 0), cA, voffA); PG8_STAGE(PG8_SB(0, 1), cB + hstep, voffB); PG8_STAGE(PG8_SA(0, 1), cA + hstep, voffA);
        if (wr == 1) PG8_BAR;
        PG8_WAIT_V(4); PG8_BAR;
        PG8_STAGE(PG8_SB(1, 0), cB + kstep, voffB); PG8_STAGE(PG8_SA(1, 0), cA + kstep, voffA); PG8_STAGE(PG8_SB(1, 1), cB + hstep + kstep, voffB);
        PG8_WAIT_V(6); PG8_BAR;
    }
    for (;;) {
        const bool has_next = S.next(ui + 1, nxt);
        const char* nA = has_next ? (const char*)g.A + (size_t)nxt.pm * tstep : cA; const char* nB = has_next ? (const char*)g.Bt + (size_t)nxt.pn * tstep : cB;
        for (int t = 0; t < nt; t += 2) {
            const bool last = (t == nt - 2);
            const char* a1 = cA + (size_t)(t + 1) * kstep;
            const char* a2 = last ? nA : cA + (size_t)(t + 2) * kstep; const char* b2 = last ? nB : cB + (size_t)(t + 2) * kstep;
            const char* a3 = a2 + kstep; const char* b3 = b2 + kstep;
            if (last && has_next) S.a_ready(nxt);
            if constexpr (SP2) {
            PG8_LDB(B0, 0, 0); PG8_LDB(B1, 0, 1); PG8_SCHED; PG8_LDA(At, 0, 0); PG8_STAGE(PG8_SA(1, 1), a1 + hstep, voffA);
            PG8_WAIT_V(8); PG8_WAIT_L(0); PG8_BAR; PG8_MMA(0, 0, At, B0); PG8_MMA(0, 1, At, B1); PG8_BAR; PG8_SCHED;
            PG8_LDA(At, 0, 1); PG8_STAGE(PG8_SB(0, 0), b2, voffB); PG8_STAGE(PG8_SB(0, 1), b2 + hstep, voffB); PG8_STAGE(PG8_SA(0, 0), a2, voffA);
            PG8_WAIT_V(8); PG8_WAIT_L(0); PG8_BAR; PG8_MMA(1, 0, At, B0); PG8_MMA(1, 1, At, B1); PG8_BAR; PG8_SCHED;
            PG8_LDB(B0, 1, 0); PG8_LDB(B1, 1, 1); PG8_SCHED; PG8_LDA(At, 1, 0); PG8_STAGE(PG8_SA(0, 1), a2 + hstep, voffA);
            PG8_WAIT_V(8); PG8_WAIT_L(0); PG8_BAR; PG8_MMA(0, 0, At, B0); PG8_MMA(0, 1, At, B1); PG8_BAR; PG8_SCHED;
            PG8_LDA(At, 1, 1); PG8_STAGE(PG8_SB(1, 0), b3, voffB); PG8_STAGE(PG8_SB(1, 1), b3 + hstep, voffB); PG8_STAGE(PG8_SA(1, 0), a3, voffA);
            PG8_WAIT_V(8); PG8_WAIT_L(0); PG8_BAR; PG8_MMA(1, 0, At, B0); PG8_MMA(1, 1, At, B1); PG8_BAR; PG8_SCHED;
            } else {
            PG8_LDB(B0, 0, 0); PG8_SCHED; PG8_LDA(At, 0, 0); PG8_STAGE(PG8_SA(1, 1), a1 + hstep, voffA);
            PG8_WAIT_L(8); PG8_BAR; PG8_WAIT_L(0); PG8_MMA(0, 0, At, B0); PG8_BAR; PG8_SCHED;
            PG8_LDB(B1, 0, 1); PG8_STAGE(PG8_SB(0, 0), b2, voffB);
            PG8_BAR; PG8_WAIT_L(0); PG8_MMA(0, 1, At, B1); PG8_BAR;
            PG8_LDA(At, 0, 1); PG8_STAGE(PG8_SA(0, 0), a2, voffA);
            PG8_BAR; PG8_WAIT_L(0); PG8_MMA(1, 0, At, B0); PG8_BAR; PG8_SCHED;
            PG8_STAGE(PG8_SB(0, 1), b2 + hstep, voffB);
            PG8_WAIT_V(6); PG8_BAR; PG8_MMA(1, 1, At, B1); PG8_BAR;
            PG8_LDB(B0, 1, 0); PG8_SCHED; PG8_LDA(At, 1, 0); PG8_STAGE(PG8_SA(0, 1), a2 + hstep, voffA);
            PG8_WAIT_L(8); PG8_BAR; PG8_WAIT_L(0); PG8_MMA(0, 0, At, B0); PG8_BAR; PG8_SCHED;
            PG8_LDB(B1, 1, 1); PG8_STAGE(PG8_SB(1, 0), b3, voffB);
            PG8_BAR; PG8_WAIT_L(0); PG8_MMA(0, 1, At, B1); PG8_BAR;
            PG8_LDA(At, 1, 1); PG8_STAGE(PG8_SA(1, 0), a3, voffA);
            PG8_BAR; PG8_WAIT_L(0); PG8_MMA(1, 0, At, B0); PG8_BAR; PG8_SCHED;
            PG8_STAGE(PG8_SB(1, 1), b3 + hstep, voffB);
            PG8_WAIT_V(6); PG8_BAR; PG8_MMA(1, 1, At, B1); PG8_BAR;
            }
        }
        if constexpr (ALIGN_EPI) { if (wr == 0) PG8_BAR; }
        if constexpr (!Epi::AFTER_DRAIN) { E(acc, cur, wr, wc, fr, fq); S.done(cur); }
        if (!has_next) break;
#pragma unroll
        for (int a = 0; a < 2; ++a)
#pragma unroll
            for (int b = 0; b < 2; ++b)
#pragma unroll
                for (int m = 0; m < 4; ++m)
#pragma unroll
                    for (int n = 0; n < 2; ++n) acc[a][b][m][n] = (f32x4){0.f, 0.f, 0.f, 0.f};
        cur = nxt; cA = nA; cB = nB; ++ui;
        if constexpr (ALIGN_EPI) { if (wr == 1) PG8_BAR; }
    }
    PG8_WAIT_V(0);
    if constexpr (!ALIGN_EPI) { if (wr == 0) PG8_BAR; }
    PG8_BAR;
    if constexpr (Epi::AFTER_DRAIN) { E.fused(acc, cur, wr, wc, fr, fq, lds, wid, lane); S.done(cur); }
#undef PG8_SA
#undef PG8_SB
#undef PG8_STAGE
#undef PG8_LDA
#undef PG8_LDB
#undef PG8_MMA
#undef PG8_WAIT_V
#undef PG8_WAIT_L
#undef PG8_BAR
#undef PG8_SCHED
}
}
#ifndef PG8_SP2
#define PG8_SP2 true
#endif
#ifndef PG8_ALIGN
#define PG8_ALIGN true
#endif
constexpr int D = 2048, NB = 4, SEQ = 4096, CL = 256, DEPTH = 4;
constexpr int ML = NB * SEQ, MC = NB * CL, MT = ML + MC;
constexpr int INW = 15360, DFF = 5632, NFF = 2 * DFF;
constexpr int C_RK = 0, C_RV = 512, C_NK = 1536, C_NV = 2560, C_RQ = 3584, C_RG = 4096, C_NQ = 5120, C_HY = 6144, C_GT = 9216;
constexpr float EPS = 1e-6f;
constexpr int NWAVES = 8;
constexpr size_t al256(size_t x) { return (x + 255) & ~(size_t)255; }
constexpr size_t WS_CTL = 0, CTL_ZERO_BYTES = 1u << 20;
constexpr size_t WS_MOD = WS_CTL + CTL_ZERO_BYTES;
constexpr size_t WS_ROPE = WS_MOD + al256((size_t)4 * 5 * 12288 * 4);
constexpr size_t WS_FH2 = WS_ROPE + al256(64 * 16 * 8);
constexpr size_t WS_TAPC = WS_FH2 + al256((size_t)4352 * 64 * 4);
constexpr size_t WS_KF = WS_TAPC + al256((size_t)2 * 2 * 1024 * 256 * 4);
constexpr size_t WS_WIN = WS_KF + al256((size_t)2 * 1024 * 8192 * 8);
constexpr size_t WS_WBR = WS_WIN + al256((size_t)INW * D * 2);
constexpr size_t WS_WOUT = WS_WBR + al256((size_t)3 * D * 1024 * 2);
constexpr size_t WS_WF1 = WS_WOUT + al256((size_t)D * D * 2);
constexpr size_t WS_WF2 = WS_WF1 + al256((size_t)NFF * D * 2);
constexpr size_t WS_XC = WS_WF2 + al256((size_t)D * DFF * 2);
constexpr size_t WS_H = WS_XC + al256((size_t)MC * D * 4);
constexpr size_t WS_Z = WS_H + al256((size_t)MT * D * 2);
constexpr size_t WS_HYT = WS_Z + al256((size_t)MT * INW * 2);
constexpr size_t WS_YT = WS_HYT + al256((size_t)3 * NB * 1024 * SEQ * 2);
constexpr size_t WS_YS = WS_YT + al256((size_t)NB * 1024 * SEQ * 2);
constexpr size_t WS_ACC = WS_YS + al256((size_t)3 * MT * 1024 * 2);
constexpr size_t WS_U = WS_ACC + al256((size_t)MT * D * 2);
constexpr size_t WS_KV = WS_U + al256((size_t)MT * DFF * 2);
constexpr size_t WS_END = WS_KV + al256((size_t)NB * 8 * 2 * 34 * 8192 * 4);
constexpr int CW_BAR = 4096;
constexpr int RING_BYTES = 131072, LDSCTL_OFF = RING_BYTES, MISC_OFF = LDSCTL_OFF + 320, LDS_BYTES = 147456;

#define GAS __attribute__((address_space(1)))
#define LAS __attribute__((address_space(3)))
typedef unsigned short bf16;
typedef unsigned v4u __attribute__((ext_vector_type(4)));
typedef unsigned v2u __attribute__((ext_vector_type(2)));
typedef float f32x4 __attribute__((ext_vector_type(4)));
typedef float f32x2 __attribute__((ext_vector_type(2)));
typedef short bf16x8 __attribute__((ext_vector_type(8)));
typedef GAS unsigned gu32;
#define LDS_WAIT() asm volatile("s_waitcnt lgkmcnt(0)" ::: "memory")
__device__ __forceinline__ unsigned f2bf(float f) { unsigned u = __builtin_bit_cast(unsigned, f); return (u + 0x7fffu + ((u >> 16) & 1u)) >> 16; }
__device__ __forceinline__ unsigned pk2(float lo, float hi) { return f2bf(lo) | (f2bf(hi) << 16); }
__device__ __forceinline__ float bflo(unsigned w) { return __uint_as_float(w << 16); }
__device__ __forceinline__ float bfhi(unsigned w) { return __uint_as_float(w & 0xffff0000u); }
__device__ __forceinline__ float bf1(bf16 b) { return __uint_as_float(((unsigned)b) << 16); }
__device__ __forceinline__ bf16x8 mk8(unsigned a, unsigned b, unsigned c, unsigned d) { v4u v = (v4u){a, b, c, d}; return __builtin_bit_cast(bf16x8, v); }
__device__ __forceinline__ f32x4 mfma16(bf16x8 a, bf16x8 b, f32x4 c) { return __builtin_amdgcn_mfma_f32_16x16x32_bf16(a, b, c, 0, 0, 0); }
__device__ __forceinline__ float sin_rev(float r) { return __builtin_amdgcn_sinf(r - floorf(r)); }
__device__ __forceinline__ float cos_rev(float r) { return __builtin_amdgcn_cosf(r - floorf(r)); }
__device__ __forceinline__ float sin_rad(float x) { return sin_rev(x * 0.15915494309189535f); }
__device__ __forceinline__ float ex2(float x) { return __builtin_amdgcn_exp2f(x); }
__device__ __forceinline__ float wave_sum(float v) {
#pragma unroll
    for (int o = 1; o < 64; o <<= 1) v += __shfl_xor(v, o);
    return v;
}
__device__ __forceinline__ int otid() { int t = threadIdx.x; asm volatile("" : "+v"(t)); return t; }
__device__ __forceinline__ int opq(int v) { asm volatile("" : "+s"(v)); return v; }
#define XB_TMO      128
#define XB_XCNT(j)  (256  + 64 * (j))
#define XB_XSUB(j)  (1280 + 64 * (j))
#define XB_XGEN(j)  (2304 + 64 * (j))
#define XB_TOP      3328
#define XB_TOPGEN   3392
#define XCD_BAR_WORDS 3456
#define XB_SPIN_CAP (1u << 18)

__device__ __forceinline__ unsigned xb_ld(unsigned* p)              { return __hip_atomic_load(p, __ATOMIC_RELAXED, __HIP_MEMORY_SCOPE_AGENT); }
__device__ __forceinline__ unsigned xb_add(unsigned* p, unsigned v) { return __hip_atomic_fetch_add(p, v, __ATOMIC_RELAXED, __HIP_MEMORY_SCOPE_AGENT); }
__device__ __forceinline__ unsigned xb_xcc_id() { return (unsigned)__builtin_amdgcn_s_getreg((3 << 11) | 20) & 0xFu; }
#define XB_SPIN(cond, bar) do { unsigned _sp = 0; while (cond) { __builtin_amdgcn_s_sleep(1); \
    if ((++_sp & 255u) == 0u) { if (xb_ld(&(bar)[XB_TMO])) break; if (_sp > XB_SPIN_CAP) { atomicAdd(&(bar)[XB_TMO], 1u); break; } } } } while (0)

struct XcdBarrier {
    unsigned* bar; unsigned x;
    volatile LAS unsigned* st;
};

__device__ __forceinline__ XcdBarrier xcd_barrier_post(unsigned* bar, volatile LAS unsigned* st) {
    XcdBarrier b; b.bar = bar; b.x = xb_xcc_id(); b.st = st;
    if (threadIdx.x == 0) (void)xb_add(&bar[XB_XCNT(b.x)], 1u);
    return b;
}
__device__ __forceinline__ void xcd_barrier_complete(unsigned* bar, unsigned x, unsigned& nloc, unsigned& nx) {
    const unsigned G = gridDim.x * gridDim.y * gridDim.z;
    unsigned sum, cnt, mine, sp = 0u;
    for (;;) {
        sum = 0u; cnt = 0u; mine = 0u;
#pragma unroll
        for (unsigned j = 0; j < 16; ++j) { const unsigned c = xb_ld(&bar[XB_XCNT(j)]); sum += c; cnt += (c > 0u) ? 1u : 0u; mine = (j == x) ? c : mine; }
        if (sum == G) break;
        __builtin_amdgcn_s_sleep(1);
        if ((++sp & 255u) == 0u) { if (xb_ld(&bar[XB_TMO])) break; if (sp > XB_SPIN_CAP) { atomicAdd(&bar[XB_TMO], 1u); break; } }
    }
    nloc = mine > 0u ? mine : 1u; nx = cnt > 0u ? cnt : 1u;
}

__device__ __forceinline__ void xcd_barrier(const XcdBarrier& b) {
    asm volatile("s_waitcnt vmcnt(0)" ::: "memory");
    __syncthreads();
    if (threadIdx.x == 0) {
        unsigned* bar = b.bar;
        __builtin_amdgcn_s_waitcnt(0);
        unsigned nloc = b.st[0], nx = b.st[1];
        if (nloc == 0u) { xcd_barrier_complete(bar, b.x, nloc, nx); b.st[0] = nloc; b.st[1] = nx; }
        const unsigned old = xb_add(&bar[XB_XSUB(b.x)], 1u);
        const unsigned gen = old / nloc;
        if (old + 1u == (gen + 1u) * nloc) {
            __builtin_amdgcn_fence(__ATOMIC_RELEASE, "agent");
            asm volatile("s_waitcnt vmcnt(0)" ::: "memory");
            const unsigned og = xb_add(&bar[XB_TOP], 1u);
            const unsigned tg = og / nx;
            if (og + 1u == (tg + 1u) * nx) xb_add(&bar[XB_TOPGEN], 1u);
            else XB_SPIN(xb_ld(&bar[XB_TOPGEN]) == tg, bar);
            __builtin_amdgcn_fence(__ATOMIC_ACQUIRE, "agent");
            xb_add(&bar[XB_XGEN(b.x)], 1u);
            asm volatile("s_waitcnt vmcnt(0)" ::: "memory");
        } else {
            XB_SPIN(xb_ld(&bar[XB_XGEN(b.x)]) == gen, bar);
            __builtin_amdgcn_fence(__ATOMIC_ACQUIRE, "agent");
            asm volatile("s_waitcnt vmcnt(0)" ::: "memory");
        }
    }
    __syncthreads();
}
__device__ __forceinline__ void p0_transpose_item(const float* W, int K, int N, bf16* WT, int row_off, LAS float* scr, int item, int lane) {
    const int nblk = N / 32, kb = item / nblk, nb = item % nblk, k0 = 64 * kb, n0 = 32 * nb;
#pragma unroll 8
    for (int i = 0; i < 32; ++i) { const int kk = 2 * i + (lane >> 5); scr[kk * 33 + (lane & 31)] = W[(size_t)(k0 + kk) * N + n0 + (lane & 31)]; }
    LDS_WAIT(); asm volatile("" ::: "memory");
    const int c = lane & 7;
#pragma unroll
    for (int j = 0; j < 4; ++j) { const int n = (lane >> 3) + 8 * j; const LAS float* s = scr + (8 * c) * 33 + n;
        v4u o; o.x = pk2(s[0 * 33], s[1 * 33]); o.y = pk2(s[2 * 33], s[3 * 33]); o.z = pk2(s[4 * 33], s[5 * 33]); o.w = pk2(s[6 * 33], s[7 * 33]);
        *(GAS v4u*)(WT + (size_t)(row_off + n0 + n) * K + k0 + 8 * c) = o; }
    LDS_WAIT(); asm volatile("" ::: "memory");
}
struct Args { const float* in[27]; float* out; unsigned char* ws; int seq_lo, seq_hi; };
__device__ __forceinline__ const float* inp(int i) { const char* ka = (const char*)__builtin_amdgcn_kernarg_segment_ptr(); int off = i * 8; asm volatile("" : "+s"(off)); return *(const float* const*)(ka + off); }
__device__ __forceinline__ unsigned char* wsb() { const char* ka = (const char*)__builtin_amdgcn_kernarg_segment_ptr(); int off = 27 * 8 + 8; asm volatile("" : "+s"(off)); return *(unsigned char* const*)(ka + off); }
__device__ __forceinline__ float* outb() { const char* ka = (const char*)__builtin_amdgcn_kernarg_segment_ptr(); int off = 27 * 8; asm volatile("" : "+s"(off)); return *(float* const*)(ka + off); }
enum { I_X = 0, I_C, I_CTX, I_CCTX, I_WMOD, I_BMOD, I_G1, I_G2, I_WIN, I_HCW, I_HCB, I_FW1, I_FB1, I_FW2, I_FB2, I_FW3, I_FFQ, I_HBIAS, I_RDEC, I_RPB, I_WBR, I_WOUT, I_FFW1, I_FFCW, I_FFCB, I_FFW2, I_GF };

__device__ __forceinline__ void ph_prologue(const Args& A, LAS unsigned char* lds, int tid) {
    LAS float* sc = (LAS float*)lds;
    LAS float* red = sc + 5 * 2048;
    const float* c = inp(I_C); const float* cc = inp(I_CCTX);
    for (int i = tid; i < 5 * 2048; i += 512) { const int r = i >> 11, k = i & 2047; const float v = (r < 4) ? c[r * 2048 + k] : cc[k]; sc[i] = v / (1.0f + __expf(-v)); }
    __syncthreads();
    float* mod = (float*)(wsb() + WS_MOD);
    const int kq = tid >> 6, col = tid & 63;
    for (int u = blockIdx.x; u < DEPTH * 192; u += gridDim.x) {
        const int l = u / 192, n0 = (u % 192) * 64;
        const float* W = inp(I_WMOD) + (size_t)l * 2048 * 12288 + n0 + col;
        float a0 = 0.f, a1 = 0.f, a2 = 0.f, a3 = 0.f, a4 = 0.f;
        for (int k = kq * 256; k < kq * 256 + 256; ++k) { const float w = W[(size_t)k * 12288];
            a0 += sc[k] * w; a1 += sc[2048 + k] * w; a2 += sc[4096 + k] * w; a3 += sc[6144 + k] * w; a4 += sc[8192 + k] * w; }
        red[(kq * 5 + 0) * 64 + col] = a0; red[(kq * 5 + 1) * 64 + col] = a1; red[(kq * 5 + 2) * 64 + col] = a2; red[(kq * 5 + 3) * 64 + col] = a3; red[(kq * 5 + 4) * 64 + col] = a4;
        __syncthreads();
        if (tid < 320) { const int r = tid >> 6; float s = inp(I_BMOD)[l * 12288 + n0 + col];
#pragma unroll
            for (int q = 0; q < 8; ++q) s += red[(q * 5 + r) * 64 + col];
            mod[((size_t)l * 5 + r) * 12288 + n0 + col] = s; }
        __syncthreads();
    }
    if (blockIdx.x == 0) { f32x2* rope = (f32x2*)(wsb() + WS_ROPE);
        for (int i = tid; i < 1024; i += 512) { const int pos = i >> 4, j = i & 15; const float inv = exp2f(-(float)j * (13.287712379549449f / 16.0f));
            const float rev = (float)pos * inv * 0.15915494309189535f; rope[i] = (f32x2){cos_rev(rev), sin_rev(rev)}; } }
}

__device__ __forceinline__ void ph_convert(const Args& A, int l, LAS unsigned char* lds, int wave, int lane) {
    LAS float* scr = (LAS float*)(lds + wave * 16384);
    const int gw = blockIdx.x * NWAVES + wave, NGW = gridDim.x * NWAVES;
    constexpr int I_IN = (D / 64) * (INW / 32), I_BR = (1024 / 64) * (D / 32), I_OUT = (D / 64) * (D / 32), I_F1 = (D / 64) * (NFF / 32), I_F2 = (DFF / 64) * (D / 32);
    constexpr int NITEMS = I_IN + 3 * I_BR + I_OUT + I_F1 + I_F2;
    const float* win = inp(I_WIN) + (size_t)l * D * INW; const float* wbr = inp(I_WBR) + (size_t)l * 3 * 1024 * D; const float* wout = inp(I_WOUT) + (size_t)l * D * D;
    const float* wf1 = inp(I_FFW1) + (size_t)l * D * NFF; const float* wf2 = inp(I_FFW2) + (size_t)l * DFF * D;
    bf16* WIN = (bf16*)(wsb() + WS_WIN); bf16* WBR = (bf16*)(wsb() + WS_WBR); bf16* WOUT = (bf16*)(wsb() + WS_WOUT); bf16* WF1 = (bf16*)(wsb() + WS_WF1); bf16* WF2 = (bf16*)(wsb() + WS_WF2);
    for (int it = gw; it < NITEMS; it += NGW) {
        int r = it;
        if (r < I_IN) { p0_transpose_item(win, D, INW, WIN, 0, scr, r, lane); continue; } r -= I_IN;
        if (r < I_BR) { p0_transpose_item(wbr, 1024, D, WBR, 0, scr, r, lane); continue; } r -= I_BR;
        if (r < I_BR) { p0_transpose_item(wbr + (size_t)1024 * D, 1024, D, WBR + (size_t)D * 1024, 0, scr, r, lane); continue; } r -= I_BR;
        if (r < I_BR) { p0_transpose_item(wbr + (size_t)2 * 1024 * D, 1024, D, WBR + (size_t)2 * D * 1024, 0, scr, r, lane); continue; } r -= I_BR;
        if (r < I_OUT) { p0_transpose_item(wout, D, D, WOUT, 0, scr, r, lane); continue; } r -= I_OUT;
        if (r < I_F1) { p0_transpose_item(wf1, D, NFF, WF1, 0, scr, r, lane); continue; } r -= I_F1;
        p0_transpose_item(wf2, DFF, D, WF2, 0, scr, r, lane);
    }
}
__device__ __forceinline__ void ph_filt1(const Args& A, int l, LAS unsigned char* lds, int tid) {
    LAS float* feat = (LAS float*)lds;
    LAS float* h1 = feat + 8 * 33;
    const float* w1 = inp(I_FW1) + (size_t)l * 33 * 64; const float* b1 = inp(I_FB1) + l * 64; const float* w2 = inp(I_FW2) + (size_t)l * 64 * 64; const float* b2 = inp(I_FB2) + l * 64;
    const float* fq = inp(I_FFQ) + l * 64; float* FH2 = (float*)(wsb() + WS_FH2);
    const int pl = tid >> 6, o = tid & 63;
    for (int u = blockIdx.x; u < 544; u += gridDim.x) {
        const int pos = u * 8 + pl; const bool isc = pos >= 4096; const int Lf = isc ? 256 : 4096, tp = isc ? pos - 4096 : pos;
        if (o < 33) { float f;
            if (o == 0) f = (float)tp / (float)(Lf - 1);
            else { const int i = (o - 1) & 15; const float fr = 1e-4f + (float)i * ((15.0f - 1e-4f) / 15.0f); const float rev = fr * (float)tp / (float)Lf; f = (o <= 16) ? cos_rev(rev) : -sin_rev(rev); }
            feat[pl * 33 + o] = f; }
        __syncthreads();
        float a = b1[o];
#pragma unroll 3
        for (int i = 0; i < 33; ++i) a += feat[pl * 33 + i] * w1[i * 64 + o];
        h1[pl * 64 + o] = sin_rad(fq[o] * a);
        __syncthreads();
        float b = b2[o];
#pragma unroll 4
        for (int j = 0; j < 64; ++j) b += h1[pl * 64 + j] * w2[j * 64 + o];
        FH2[(size_t)pos * 64 + o] = sin_rad(fq[o] * b);
        __syncthreads();
    }
}
__device__ __forceinline__ void ph_norm(const float* xlat, const float* xctx, const float* g, const float* modl, int sh_off, int sc_off, bf16* H, int Mrows, int wave, int lane) {
    const int gw = blockIdx.x * NWAVES + wave, NGW = gridDim.x * NWAVES;
    for (int m = gw; m < Mrows; m += NGW) {
        const float* xr; int r;
        if (m < ML) { xr = xlat + (size_t)m * D; r = m >> 12; } else { xr = xctx + (size_t)(m - ML) * D; r = 4; }
        const float* mv = modl + (size_t)r * 12288;
        f32x4 v[8]; float ss = 0.f;
#pragma unroll
        for (int j = 0; j < 8; ++j) { v[j] = *(const f32x4*)(xr + (lane + 64 * j) * 4); ss += (v[j].x * v[j].x + v[j].y * v[j].y) + (v[j].z * v[j].z + v[j].w * v[j].w); }
        const float rstd = 1.0f / sqrtf(wave_sum(ss) * (1.0f / D) + EPS);
#pragma unroll
        for (int j = 0; j < 8; ++j) { const int idx = (lane + 64 * j) * 4;
            const f32x4 gg = *(const f32x4*)(g + idx), sh = *(const f32x4*)(mv + sh_off + idx), sc = *(const f32x4*)(mv + sc_off + idx);
            const f32x4 y = v[j] * rstd * gg * (sc + 1.0f) + sh;
            v2u w; w.x = pk2(y.x, y.y); w.y = pk2(y.z, y.w);
            *(v2u*)(H + (size_t)m * D + idx) = w; }
    }
}

__device__ __forceinline__ int fphys(int i) { return i + 2 * (i >> 5); }
__device__ __forceinline__ void bfly_dif(f32x2& a, f32x2& b, float c, float s) { const f32x2 u = a, v = b; a = u + v; const float dx = u.x - v.x, dy = u.y - v.y; b = (f32x2){dx * c + dy * s, dy * c - dx * s}; }
__device__ __forceinline__ void bfly_idit(f32x2& a, f32x2& b, float c, float s) { const f32x2 u = a, q = b; const f32x2 v = (f32x2){q.x * c - q.y * s, q.x * s + q.y * c}; a = u + v; b = u - v; }
template <bool ZHI> __device__ __forceinline__ void dif16(f32x2 (&x)[16], float th) {
    asm volatile("" : "+v"(th));
#pragma unroll
    for (int k = 0; k < 8; ++k) { const float fr = th + (float)k * 0.0625f; const float c = __builtin_amdgcn_cosf(fr), s = __builtin_amdgcn_sinf(fr);
        if (ZHI) { const f32x2 u = x[k]; x[k + 8] = (f32x2){u.x * c + u.y * s, u.y * c - u.x * s}; } else bfly_dif(x[k], x[k + 8], c, s); }
#pragma unroll
    for (int k = 0; k < 4; ++k) { const float fr = 2.0f * th + (float)k * 0.125f; const float c = __builtin_amdgcn_cosf(fr), s = __builtin_amdgcn_sinf(fr);
        bfly_dif(x[k], x[k + 4], c, s); bfly_dif(x[8 + k], x[12 + k], c, s); }
#pragma unroll
    for (int k = 0; k < 2; ++k) { const float fr = 4.0f * th + (float)k * 0.25f; const float c = __builtin_amdgcn_cosf(fr), s = __builtin_amdgcn_sinf(fr);
#pragma unroll
        for (int b = 0; b < 16; b += 4) bfly_dif(x[b + k], x[b + k + 2], c, s); }
    { const float fr = 8.0f * th; const float c = __builtin_amdgcn_cosf(fr), s = __builtin_amdgcn_sinf(fr);
#pragma unroll
        for (int b = 0; b < 16; b += 2) bfly_dif(x[b], x[b + 1], c, s); }
}
__device__ __forceinline__ void idit16(f32x2 (&x)[16], float th) {
    asm volatile("" : "+v"(th));
    { const float fr = 8.0f * th; const float c = __builtin_amdgcn_cosf(fr), s = __builtin_amdgcn_sinf(fr);
#pragma unroll
        for (int b = 0; b < 16; b += 2) bfly_idit(x[b], x[b + 1], c, s); }
#pragma unroll
    for (int k = 0; k < 2; ++k) { const float fr = 4.0f * th + (float)k * 0.25f; const float c = __builtin_amdgcn_cosf(fr), s = __builtin_amdgcn_sinf(fr);
#pragma unroll
        for (int b = 0; b < 16; b += 4) bfly_idit(x[b + k], x[b + k + 2], c, s); }
#pragma unroll
    for (int k = 0; k < 4; ++k) { const float fr = 2.0f * th + (float)k * 0.125f; const float c = __builtin_amdgcn_cosf(fr), s = __builtin_amdgcn_sinf(fr);
        bfly_idit(x[k], x[k + 4], c, s); bfly_idit(x[8 + k], x[12 + k], c, s); }
#pragma unroll
    for (int k = 0; k < 8; ++k) { const float fr = th + (float)k * 0.0625f; const float c = __builtin_amdgcn_cosf(fr), s = __builtin_amdgcn_sinf(fr); bfly_idit(x[k], x[k + 8], c, s); }
}
template <bool INV> __device__ __forceinline__ void fft_pass(LAS f32x2* buf, int base, int stride, float th) {
    f32x2 x[16];
#pragma unroll
    for (int k = 0; k < 16; ++k) x[k] = buf[fphys(base + k * stride)];
    if (INV) idit16(x, th); else dif16<false>(x, th);
#pragma unroll
    for (int k = 0; k < 16; ++k) buf[fphys(base + k * stride)] = x[k];
}
constexpr int FFT_LDS_BYTES = (8192 + 512 + 8) * 8;
__device__ __forceinline__ float block_sum(float v, LAS float* red, int tid) {
    v = wave_sum(v);
    __syncthreads();
    if ((tid & 63) == 0) red[tid >> 6] = v;
    __syncthreads();
    float s = 0.f;
#pragma unroll
    for (int i = 0; i < 8; ++i) s += red[i];
    return s;
}
__device__ __forceinline__ float hy_delta(int c) { const float d0 = -4.605170185988091f / 0.3f, d1 = -4.605170185988091f / 1.5f; return fabsf(d0 + (d1 - d0) * ((float)c / 1023.0f)); }
__device__ __forceinline__ void ph_filt2(const Args& A, int l, LAS unsigned char* lds, int tid) {
    LAS f32x2* buf = (LAS f32x2*)lds; LAS float* red = (LAS float*)(lds + FFT_LDS_BYTES + 64); LAS float* w3s = red + 32;
    const float* w3 = inp(I_FW3) + (size_t)l * 64 * 4096; const float* FH2 = (const float*)(wsb() + WS_FH2);
    f32x2* KF = (f32x2*)(wsb() + WS_KF); float* TAPC = (float*)(wsb() + WS_TAPC);
    for (int c = blockIdx.x; c < 1024; c += gridDim.x) {
        __syncthreads();
        if (tid < 256) w3s[tid] = w3[(size_t)(tid & 63) * 4096 + (tid >> 7) * 2048 + ((tid >> 6) & 1) * 1024 + c];
        __syncthreads();
        const float delta = hy_delta(c); float ssq0 = 0.f, ssq1 = 0.f;
#pragma nounroll
        for (int i = 0; i < 8; ++i) { const int t = tid + 512 * i; const f32x4* row = (const f32x4*)(FH2 + (size_t)t * 64); float a0 = 0.f, a1 = 0.f, a2 = 0.f, a3 = 0.f;
#pragma unroll 4
            for (int j4 = 0; j4 < 16; ++j4) { const f32x4 hv = row[j4];
                a0 += hv.x * w3s[4 * j4] + hv.y * w3s[4 * j4 + 1] + hv.z * w3s[4 * j4 + 2] + hv.w * w3s[4 * j4 + 3];
                a1 += hv.x * w3s[64 + 4 * j4] + hv.y * w3s[64 + 4 * j4 + 1] + hv.z * w3s[64 + 4 * j4 + 2] + hv.w * w3s[64 + 4 * j4 + 3];
                a2 += hv.x * w3s[128 + 4 * j4] + hv.y * w3s[128 + 4 * j4 + 1] + hv.z * w3s[128 + 4 * j4 + 2] + hv.w * w3s[128 + 4 * j4 + 3];
                a3 += hv.x * w3s[192 + 4 * j4] + hv.y * w3s[192 + 4 * j4 + 1] + hv.z * w3s[192 + 4 * j4 + 2] + hv.w * w3s[192 + 4 * j4 + 3]; }
            const float dec = __expf(-((float)t / 4095.0f) * delta); const float f0 = a0 * dec, b0 = a1 * dec, f1 = a2 * dec, b1 = a3 * dec;
            buf[fphys(t)] = (f32x2){f0, f1}; ssq0 += f0 * f0; ssq1 += f1 * f1;
            if (t >= 1) { buf[fphys(8192 - t)] = (f32x2){b0, b1}; ssq0 += b0 * b0; ssq1 += b1 * b1; } else buf[fphys(4096)] = (f32x2){0.f, 0.f}; }
        const float scl0 = (1.0f / 8192.0f) / sqrtf(block_sum(ssq0, red, tid) + EPS), scl1 = (1.0f / 8192.0f) / sqrtf(block_sum(ssq1, red, tid) + EPS);
        __syncthreads();
        fft_pass<false>(buf, tid, 512, (float)tid * (1.0f / 8192.0f));
        __syncthreads();
        fft_pass<false>(buf, (tid >> 5) * 512 + (tid & 31), 32, (float)(tid & 31) * (1.0f / 512.0f));
        __syncthreads();
        fft_pass<false>(buf, (tid >> 1) * 32 + (tid & 1), 2, (float)(tid & 1) * (1.0f / 32.0f));
        __syncthreads();
#pragma unroll
        for (int r = 0; r < 8; ++r) { LAS f32x4* pp = (LAS f32x4*)(buf + fphys(2 * (tid + 512 * r))); const f32x4 ab = *pp; *pp = (f32x4){ab.x + ab.z, ab.y + ab.w, ab.x - ab.z, ab.y - ab.w}; }
        __syncthreads();
        f32x2* d0 = KF + (size_t)c * 8192; f32x2* d1 = KF + (size_t)(1024 + c) * 8192;
#pragma unroll 4
        for (int i = 0; i < 16; ++i) { const int p = tid + 512 * i; const int f = (int)(__brev((unsigned)p) >> 19); const int pp = (int)(__brev((unsigned)((8192 - f) & 8191)) >> 19);
            const f32x2 z = buf[fphys(p)], zp = buf[fphys(pp)];
            d0[p] = (f32x2){(z.x + zp.x) * 0.5f * scl0, (z.y - zp.y) * 0.5f * scl0};
            d1[p] = (f32x2){(z.y + zp.y) * 0.5f * scl1, (zp.x - z.x) * 0.5f * scl1}; }
        { const int dir = tid >> 8, m = tid & 255; const f32x4* row = (const f32x4*)(FH2 + (size_t)(4096 + m) * 64); float a0 = 0.f, a1 = 0.f;
#pragma unroll 4
            for (int j4 = 0; j4 < 16; ++j4) { const f32x4 hv = row[j4];
                a0 += hv.x * w3s[dir * 64 + 4 * j4] + hv.y * w3s[dir * 64 + 4 * j4 + 1] + hv.z * w3s[dir * 64 + 4 * j4 + 2] + hv.w * w3s[dir * 64 + 4 * j4 + 3];
                a1 += hv.x * w3s[128 + dir * 64 + 4 * j4] + hv.y * w3s[128 + dir * 64 + 4 * j4 + 1] + hv.z * w3s[128 + dir * 64 + 4 * j4 + 2] + hv.w * w3s[128 + dir * 64 + 4 * j4 + 3]; }
            const float dec = __expf(-((float)m / 255.0f) * delta); const float v0 = a0 * dec, v1 = a1 * dec; const bool cnt = (dir == 0) || (m >= 1);
            const float t0 = block_sum(cnt ? v0 * v0 : 0.f, red, tid), t1 = block_sum(cnt ? v1 * v1 : 0.f, red, tid);
            TAPC[((size_t)(0 * 2 + dir) * 1024 + c) * 256 + m] = v0 / sqrtf(t0 + EPS);
            TAPC[((size_t)(1 * 2 + dir) * 1024 + c) * 256 + m] = v1 / sqrtf(t1 + EPS); }
    }
}

__device__ __forceinline__ void ph_hyprep(const Args& A, int l, LAS unsigned char* lds, int tid) {
    LAS bf16* T = (LAS bf16*)lds;
    const bf16* Z = (const bf16*)(wsb() + WS_Z); bf16* HYT = (bf16*)(wsb() + WS_HYT);
    const float* cw = inp(I_HCW) + (size_t)l * 3 * 3072; const float* cb = inp(I_HCB) + (size_t)l * 3072;
    for (int u = blockIdx.x; u < 3072; u += gridDim.x) {
        const int cg = u % 12, tt = (u / 12) & 63, b = u / 768;
        __syncthreads();
        for (int q = tid; q < 66 * 32; q += 512) { const int r = q >> 5, ch8 = q & 31, t = tt * 64 - 1 + r;
            v4u v = (v4u){0u, 0u, 0u, 0u};
            if (t >= 0 && t < SEQ) v = *(const v4u*)(Z + (size_t)(b * SEQ + t) * INW + C_HY + cg * 256 + ch8 * 8);
            *(LAS v4u*)(T + r * 264 + ch8 * 8) = v; }
        __syncthreads();
        const int ch = tid & 255, half = tid >> 8, gch = cg * 256 + ch;
        const float w0 = cw[gch], w1 = cw[3072 + gch], w2 = cw[6144 + gch], bb = cb[gch];
        const int part = gch >> 10, c = gch & 1023;
        bf16* outp = HYT + ((size_t)(part * NB + b) * 1024 + c) * SEQ + tt * 64 + half * 32;
#pragma unroll
        for (int tq = 0; tq < 4; ++tq) { float vv[8];
#pragma unroll
            for (int e = 0; e < 8; ++e) { const int tl = half * 32 + tq * 8 + e;
                vv[e] = w0 * bf1(T[tl * 264 + ch]) + w1 * bf1(T[(tl + 1) * 264 + ch]) + w2 * bf1(T[(tl + 2) * 264 + ch]) + bb; }
            v4u w; w.x = pk2(vv[0], vv[1]); w.y = pk2(vv[2], vv[3]); w.z = pk2(vv[4], vv[5]); w.w = pk2(vv[6], vv[7]);
            *(v4u*)(outp + tq * 8) = w; }
    }
}
__device__ __forceinline__ void ph_hyctx(const Args& A, int l, LAS unsigned char* lds, int tid) {
    LAS float* S = (LAS float*)lds;
    const bf16* Z = (const bf16*)(wsb() + WS_Z); bf16* YS = (bf16*)(wsb() + WS_YS); const float* TAPC = (const float*)(wsb() + WS_TAPC);
    const float* cw = inp(I_HCW) + (size_t)l * 3 * 3072; const float* cb = inp(I_HCB) + (size_t)l * 3072; const float* hb = inp(I_HBIAS) + (size_t)l * 2 * 1024;
    const int cc = tid >> 8, t = tid & 255;
    LAS float* sv = S + cc * 2048; LAS float* sx1 = sv + 256; LAS float* sx2 = sv + 512; LAS float* sy1 = sv + 768;
    LAS float* tf0 = sv + 1024; LAS float* tb0 = sv + 1280; LAS float* tf1 = sv + 1536; LAS float* tb1 = sv + 1792;
    for (int u = blockIdx.x; u < 2048; u += gridDim.x) {
        const int b = u >> 9, c = (u & 511) * 2 + cc;
        __syncthreads();
        float pv[3];
#pragma unroll
        for (int part = 0; part < 3; ++part) { const int gch = part * 1024 + c; const bf16* zp = Z + (size_t)(ML + b * CL + t) * INW + C_HY + gch;
            const float zm = (t > 0) ? bf1(zp[-(ptrdiff_t)INW]) : 0.f, z0 = bf1(zp[0]), zq = (t < CL - 1) ? bf1(zp[INW]) : 0.f;
            pv[part] = cw[gch] * zm + cw[3072 + gch] * z0 + cw[6144 + gch] * zq + cb[gch]; }
        sx1[t] = pv[0]; sx2[t] = pv[1]; sv[t] = pv[2];
        tf0[t] = TAPC[((size_t)(0 * 2 + 0) * 1024 + c) * 256 + t]; tb0[t] = TAPC[((size_t)(0 * 2 + 1) * 1024 + c) * 256 + t];
        tf1[t] = TAPC[((size_t)(1 * 2 + 0) * 1024 + c) * 256 + t]; tb1[t] = TAPC[((size_t)(1 * 2 + 1) * 1024 + c) * 256 + t];
        __syncthreads();
        float acc = 0.f;
        for (int s = 0; s <= t; ++s) acc += sv[s] * tf0[t - s];
        for (int s = t + 1; s < CL; ++s) acc += sv[s] * tb0[s - t];
        const float y1 = pv[0] * (acc + hb[c] * pv[2]);
        sy1[t] = y1;
        __syncthreads();
        acc = 0.f;
        for (int s = 0; s <= t; ++s) acc += sy1[s] * tf1[t - s];
        for (int s = t + 1; s < CL; ++s) acc += sy1[s] * tb1[s - t];
        const float y = pv[1] * (acc + hb[1024 + c] * y1);
        YS[(size_t)(ML + b * CL + t) * 1024 + c] = (bf16)f2bf(y);
    }
}
__device__ __forceinline__ void unpack8(v4u v, float (&x)[8]) { x[0] = bflo(v.x); x[1] = bfhi(v.x); x[2] = bflo(v.y); x[3] = bfhi(v.y); x[4] = bflo(v.z); x[5] = bfhi(v.z); x[6] = bflo(v.w); x[7] = bfhi(v.w); }
__device__ __forceinline__ v4u pack8(const float (&x)[8]) { v4u w; w.x = pk2(x[0], x[1]); w.y = pk2(x[2], x[3]); w.z = pk2(x[4], x[5]); w.w = pk2(x[6], x[7]); return w; }
__device__ __forceinline__ void rope8(float (&lo)[8], float (&hi)[8], const f32x2* rt) {
#pragma unroll
    for (int e = 0; e < 8; ++e) { const f32x2 cs = rt[e]; const float a = lo[e], b = hi[e]; lo[e] = a * cs.x - b * cs.y; hi[e] = b * cs.x + a * cs.y; }
}
__device__ __forceinline__ void vt_store(LAS bf16* Vt, int ld, int d0, int r, v4u vv) {
    Vt[(d0 + 0) * ld + r] = (bf16)(vv.x & 0xffffu); Vt[(d0 + 1) * ld + r] = (bf16)(vv.x >> 16);
    Vt[(d0 + 2) * ld + r] = (bf16)(vv.y & 0xffffu); Vt[(d0 + 3) * ld + r] = (bf16)(vv.y >> 16);
    Vt[(d0 + 4) * ld + r] = (bf16)(vv.z & 0xffffu); Vt[(d0 + 5) * ld + r] = (bf16)(vv.z >> 16);
    Vt[(d0 + 6) * ld + r] = (bf16)(vv.w & 0xffffu); Vt[(d0 + 7) * ld + r] = (bf16)(vv.w >> 16);
}
constexpr float LOG2E = 1.4426950408889634f;
__device__ __forceinline__ void ph_ret1(const Args& A, int l, int nctx_units, LAS unsigned char* lds, int tid) {
    LAS bf16* KfT = (LAS bf16*)lds; LAS bf16* KbT = KfT + 64 * 136; LAS bf16* Vt = KbT + 64 * 136;
    const bf16* Z = (const bf16*)(wsb() + WS_Z); float* KV = (float*)(wsb() + WS_KV); const f32x2* rope = (const f32x2*)(wsb() + WS_ROPE);
    const int lane = tid & 63, w = tid >> 6, g = lane >> 4, li = lane & 15;
    for (int uid = blockIdx.x; uid < 1024 + nctx_units; uid += gridDim.x) {
        const bool isc = uid >= 1024; int b, h, n, ci; size_t m0;
        if (!isc) { b = uid >> 8; h = (uid >> 5) & 7; n = uid & 31; m0 = (size_t)b * SEQ + n * 128; ci = 2 + n; }
        else { const int i = uid - 1024; b = i >> 4; h = (i >> 1) & 7; n = i & 1; m0 = (size_t)ML + b * CL + n * 128; ci = n; }
        const float lgf = inp(I_RDEC)[(l * 2 + 0) * 8 + h] * LOG2E, lgb = inp(I_RDEC)[(l * 2 + 1) * 8 + h] * LOG2E;
        __syncthreads();
        { const int tok = tid >> 2, pp = tid & 3, a = (pp & 1) + ((pp >> 1) << 2);
            const bf16* kr = Z + (m0 + tok) * INW + C_RK + h * 64;
            float lo[8], hi[8]; unpack8(*(const v4u*)(kr + 8 * a), lo); unpack8(*(const v4u*)(kr + 8 * a + 16), hi);
            if (!isc) { const int t = n * 128 + tok; const int pos = (a < 4) ? (t >> 6) : (t & 63); rope8(lo, hi, rope + pos * 16 + 8 * (a & 1)); }
            const float zf = ex2(lgf * (float)(127 - tok)) * 0.125f, zb = ex2(lgb * (float)tok) * 0.125f;
#pragma unroll
            for (int e = 0; e < 8; ++e) { const int d = 8 * a + e;
                KfT[d * 136 + tok] = (bf16)f2bf(lo[e] * zf); KbT[d * 136 + tok] = (bf16)f2bf(lo[e] * zb);
                KfT[(d + 16) * 136 + tok] = (bf16)f2bf(hi[e] * zf); KbT[(d + 16) * 136 + tok] = (bf16)f2bf(hi[e] * zb); } }
        for (int q = tid; q < 2048; q += 512) { const int r = q >> 4, ch = q & 15; vt_store(Vt, 136, ch * 8, r, *(const v4u*)(Z + (m0 + r) * INW + C_RV + h * 128 + ch * 8)); }
        __syncthreads();
        bf16x8 af[4];
#pragma unroll
        for (int ks = 0; ks < 4; ++ks) af[ks] = *(const LAS bf16x8*)(Vt + (16 * w + li) * 136 + 32 * ks + 8 * g);
#pragma unroll
        for (int dir = 0; dir < 2; ++dir) { const LAS bf16* KT = dir ? KbT : KfT;
            float* dst = KV + ((size_t)((b * 8 + h) * 2 + dir) * 34 + ci) * 8192;
#pragma unroll
            for (int nc = 0; nc < 4; ++nc) { f32x4 acc = (f32x4){0.f, 0.f, 0.f, 0.f};
#pragma unroll
                for (int ks = 0; ks < 4; ++ks) acc = mfma16(af[ks], *(const LAS bf16x8*)(KT + (16 * nc + li) * 136 + 32 * ks + 8 * g), acc);
#pragma unroll
                for (int j = 0; j < 4; ++j) dst[(16 * w + 4 * g + j) * 64 + 16 * nc + li] = acc[j]; } }
    }
}
__device__ __forceinline__ void ph_natt(const Args& A, int l, int nctx_units, LAS unsigned char* lds, int tid) {
    LAS bf16* Qs = (LAS bf16*)lds; LAS bf16* Ks = Qs + 128 * 136; LAS bf16* Vt = Ks + 64 * 136; LAS float* rpbs = (LAS float*)(Vt + 128 * 68);
    const bf16* Z = (const bf16*)(wsb() + WS_Z); bf16* YS = (bf16*)(wsb() + WS_YS) + (size_t)2 * MT * 1024;
    const int lane = tid & 63, w = tid >> 6, g = lane >> 4, li = lane & 15;
    const float SCALE = 0.08838834764831845f;
    for (int uid = blockIdx.x; uid < 1024 + nctx_units; uid += gridDim.x) {
        const bool isc = uid >= 1024; int b, h, rp = 0; size_t m0;
        if (!isc) { b = uid >> 8; h = (uid >> 5) & 7; rp = uid & 31; m0 = (size_t)b * SEQ + rp * 128; }
        else { const int i = uid - 1024; b = i >> 4; h = (i >> 1) & 7; m0 = (size_t)ML + b * CL + (i & 1) * 128; }
        const size_t mc0 = (size_t)ML + b * CL;
        __syncthreads();
        for (int q = tid; q < 2048; q += 512) { const int r = q >> 4, ch = q & 15; *(LAS v4u*)(Qs + r * 136 + ch * 8) = *(const v4u*)(Z + (m0 + r) * INW + C_NQ + h * 128 + ch * 8); }
        if (!isc) for (int i = tid; i < 465; i += 512) rpbs[i] = inp(I_RPB)[((size_t)l * 8 + h) * 465 + i];
        __syncthreads();
        bf16x8 qf[4];
#pragma unroll
        for (int ks = 0; ks < 4; ++ks) qf[ks] = *(const LAS bf16x8*)(Qs + (16 * w + li) * 136 + 32 * ks + 8 * g);
        f32x4 o[8];
#pragma unroll
        for (int nd = 0; nd < 8; ++nd) o[nd] = (f32x4){0.f, 0.f, 0.f, 0.f};
        float mrun = -1e30f, lrun = 0.f;
        const int qr = 2 * rp + (w >> 2), qc = 16 * (w & 3) + li;
        const int cs = min(max(qc - 8, 0), 48), rs_w = min(max(qr - 4, 0), 56);
        const int kr_lo = min(max(2 * rp - 4, 0), 56), kr_hi = min(max(2 * rp - 3, 0), 56) + 7;
        const int nwin = isc ? 0 : (kr_hi - kr_lo + 1);
        for (int t = 0; t < nwin + 4; ++t) {
            const bool win = t < nwin; const int kr = kr_lo + t;
            const size_t mk0 = win ? ((size_t)b * SEQ + kr * 64) : (mc0 + (t - nwin) * 64);
            __syncthreads();
            for (int q = tid; q < 1024; q += 512) { const int r = q >> 4, ch = q & 15; const bf16* zr = Z + (mk0 + r) * INW + h * 128 + ch * 8;
                *(LAS v4u*)(Ks + r * 136 + ch * 8) = *(const v4u*)(zr + C_NK);
                vt_store(Vt, 68, ch * 8, r, *(const v4u*)(zr + C_NV)); }
            __syncthreads();
            const bool active = !win || (kr >= rs_w && kr <= rs_w + 7);
            if (active) {
                f32x4 s[4];
#pragma unroll
                for (int n = 0; n < 4; ++n) { s[n] = (f32x4){0.f, 0.f, 0.f, 0.f};
#pragma unroll
                    for (int ks = 0; ks < 4; ++ks) s[n] = mfma16(*(const LAS bf16x8*)(Ks + (16 * n + li) * 136 + 32 * ks + 8 * g), qf[ks], s[n]); }
                float tmax = -1e30f;
#pragma unroll
                for (int n = 0; n < 4; ++n)
#pragma unroll
                    for (int j = 0; j < 4; ++j) { float v = s[n][j] * SCALE;
                        if (win) { const int kc = 16 * n + 4 * g + j; const bool valid = (kc >= cs) && (kc < cs + 16);
                            const int dc = min(max(kc - qc + 15, 0), 30), dr = min(max(kr - qr + 7, 0), 14);
                            v = valid ? v + rpbs[dr * 31 + dc] : -1e30f; }
                        s[n][j] = v; tmax = fmaxf(tmax, v); }
                tmax = fmaxf(tmax, __shfl_xor(tmax, 16)); tmax = fmaxf(tmax, __shfl_xor(tmax, 32));
                const float mnew = fmaxf(mrun, tmax), alpha = __expf(mrun - mnew);
                float psum = 0.f;
#pragma unroll
                for (int n = 0; n < 4; ++n)
#pragma unroll
                    for (int j = 0; j < 4; ++j) { const float pv = __expf(s[n][j] - mnew); s[n][j] = pv; psum += pv; }
                psum += __shfl_xor(psum, 16); psum += __shfl_xor(psum, 32);
                lrun = lrun * alpha + psum; mrun = mnew;
#pragma unroll
                for (int nd = 0; nd < 8; ++nd) o[nd] = o[nd] * alpha;
#pragma unroll
                for (int kk = 0; kk < 2; ++kk) {
                    const bf16x8 pf = mk8(pk2(s[2 * kk][0], s[2 * kk][1]), pk2(s[2 * kk][2], s[2 * kk][3]), pk2(s[2 * kk + 1][0], s[2 * kk + 1][1]), pk2(s[2 * kk + 1][2], s[2 * kk + 1][3]));
#pragma unroll
                    for (int nd = 0; nd < 8; ++nd) { const LAS bf16* vp = Vt + (16 * nd + li) * 68 + 32 * kk + 4 * g;
                        const v2u lo = *(const LAS v2u*)vp, hi = *(const LAS v2u*)(vp + 16);
                        o[nd] = mfma16(mk8(lo.x, lo.y, hi.x, hi.y), pf, o[nd]); } }
            }
        }
        const float inv = 1.0f / lrun; const size_t mrow = m0 + 16 * w + li;
#pragma unroll
        for (int nd = 0; nd < 8; ++nd) { v2u wv; wv.x = pk2(o[nd][0] * inv, o[nd][1] * inv); wv.y = pk2(o[nd][2] * inv, o[nd][3] * inv);
            *(v2u*)(YS + mrow * 1024 + h * 128 + 16 * nd + 4 * g) = wv; }
    }
}

__device__ __forceinline__ void ph_hyfft(const Args& A, int l, LAS unsigned char* lds, int tid) {
    LAS f32x2* buf = (LAS f32x2*)lds;
    const bf16* HYT = (const bf16*)(wsb() + WS_HYT); bf16* YT = (bf16*)(wsb() + WS_YT); const f32x2* KF = (const f32x2*)(wsb() + WS_KF);
    const float* hb = inp(I_HBIAS) + (size_t)l * 2 * 1024;
    const int baseB = (tid >> 5) * 512 + (tid & 31), baseC = (tid >> 1) * 32 + (tid & 1);
    const float thA = (float)tid * (1.0f / 8192.0f), thB = (float)(tid & 31) * (1.0f / 512.0f), thC = (float)(tid & 1) * (1.0f / 32.0f);
    for (int u = blockIdx.x; u < 2048; u += gridDim.x) {
        const int c = u >> 1, b0 = (u & 1) * 2;
        const bf16* x1p = HYT + ((size_t)(0 * NB + b0) * 1024 + c) * SEQ; const bf16* x2p = HYT + ((size_t)(1 * NB + b0) * 1024 + c) * SEQ; const bf16* vp = HYT + ((size_t)(2 * NB + b0) * 1024 + c) * SEQ;
        const size_t bstr = (size_t)1024 * SEQ;
        float y0[8], y1[8];
#pragma unroll
        for (int i = 0; i < 8; ++i) { const int t = tid + 512 * i; y0[i] = bf1(vp[t]); y1[i] = bf1(vp[bstr + t]); }
#pragma unroll
        for (int ord = 0; ord < 2; ++ord) {
            { f32x2 x[16];
#pragma unroll
                for (int k = 0; k < 8; ++k) { x[k] = (f32x2){y0[k], y1[k]}; x[k + 8] = (f32x2){0.f, 0.f}; }
                dif16<true>(x, thA);
                __syncthreads();
#pragma unroll
                for (int k = 0; k < 16; ++k) buf[fphys(tid + 512 * k)] = x[k]; }
            __syncthreads();
            fft_pass<false>(buf, baseB, 32, thB);
            __syncthreads();
            fft_pass<false>(buf, baseC, 2, thC);
            __syncthreads();
            { const f32x4* kf = (const f32x4*)(KF + (size_t)(ord * 1024 + c) * 8192);
#pragma unroll
                for (int r = 0; r < 8; ++r) { const int i = tid + 512 * r; LAS f32x4* pp = (LAS f32x4*)(buf + fphys(2 * i)); const f32x4 ab = *pp; const f32x4 kk = kf[i];
                    const float ax = ab.x + ab.z, ay = ab.y + ab.w, bx = ab.x - ab.z, by = ab.y - ab.w;
                    const float px = ax * kk.x - ay * kk.y, py = ax * kk.y + ay * kk.x, qx = bx * kk.z - by * kk.w, qy = bx * kk.w + by * kk.z;
                    *pp = (f32x4){px + qx, py + qy, px - qx, py - qy}; } }
            __syncthreads();
            fft_pass<true>(buf, baseC, 2, thC);
            __syncthreads();
            fft_pass<true>(buf, baseB, 32, thB);
            __syncthreads();
            { f32x2 x[16];
#pragma unroll
                for (int k = 0; k < 16; ++k) x[k] = buf[fphys(tid + 512 * k)];
                idit16(x, thA);
                const bf16* xp = ord ? x2p : x1p; const float bias = hb[ord * 1024 + c];
#pragma unroll
                for (int k = 0; k < 8; ++k) { const int t = tid + 512 * k;
                    y0[k] = bf1(xp[t]) * (x[k].x + bias * y0[k]); y1[k] = bf1(xp[bstr + t]) * (x[k].y + bias * y1[k]); } }
        }
        bf16* o0 = YT + ((size_t)b0 * 1024 + c) * SEQ;
#pragma unroll
        for (int i = 0; i < 8; ++i) { const int t = tid + 512 * i; o0[t] = (bf16)f2bf(y0[i]); o0[bstr + t] = (bf16)f2bf(y1[i]); }
    }
}
__device__ __forceinline__ void ph_scan(const Args& A, int l, int tid) {
    float* KV = (float*)(wsb() + WS_KV);
    for (int gt = blockIdx.x * 512 + tid; gt < NB * 8 * 2 * 2048; gt += gridDim.x * 512) {
        const int bhd = gt >> 11, e4 = gt & 2047, dir = bhd & 1, h = (bhd >> 1) & 7;
        const float gC = ex2(inp(I_RDEC)[(l * 2 + dir) * 8 + h] * LOG2E * 128.0f);
        f32x4* base = (f32x4*)(KV + (size_t)bhd * 34 * 8192) + e4;
        f32x4 s = (f32x4){0.f, 0.f, 0.f, 0.f};
#pragma unroll 2
        for (int step = 0; step < 34; ++step) { const int ci = (dir == 0) ? step : (step == 0 ? 1 : (step == 1 ? 0 : 35 - step));
            const f32x4 tmp = base[(size_t)ci * 2048]; base[(size_t)ci * 2048] = s; s = s * gC + tmp; }
    }
}

__device__ __forceinline__ void ph_hypost(const Args& A, LAS unsigned char* lds, int tid) {
    LAS bf16* T = (LAS bf16*)lds;
    const bf16* YT = (const bf16*)(wsb() + WS_YT); bf16* YS = (bf16*)(wsb() + WS_YS);
    for (int u = blockIdx.x; u < 1024; u += gridDim.x) {
        const int cg = u & 3, tt = (u >> 2) & 63, b = u >> 8;
        __syncthreads();
        for (int q = tid; q < 2048; q += 512) { const int c = q >> 3, t8 = q & 7;
            *(LAS v4u*)(T + c * 72 + t8 * 8) = *(const v4u*)(YT + ((size_t)b * 1024 + cg * 256 + c) * SEQ + tt * 64 + t8 * 8); }
        __syncthreads();
        const int t = tid >> 3, c32 = tid & 7;
#pragma unroll
        for (int q = 0; q < 4; ++q) { const int cb = c32 * 32 + q * 8; v4u w;
            w.x = (unsigned)T[(cb + 0) * 72 + t] | ((unsigned)T[(cb + 1) * 72 + t] << 16); w.y = (unsigned)T[(cb + 2) * 72 + t] | ((unsigned)T[(cb + 3) * 72 + t] << 16);
            w.z = (unsigned)T[(cb + 4) * 72 + t] | ((unsigned)T[(cb + 5) * 72 + t] << 16); w.w = (unsigned)T[(cb + 6) * 72 + t] | ((unsigned)T[(cb + 7) * 72 + t] << 16);
            *(v4u*)(YS + (size_t)(b * SEQ + tt * 64 + t) * 1024 + cg * 256 + cb) = w; }
    }
}
__device__ __forceinline__ void ph_ret3(const Args& A, int l, int nctx_units, LAS unsigned char* lds, int tid) {
    LAS bf16* Qs = (LAS bf16*)lds; LAS bf16* Ks = Qs + 128 * 72; LAS bf16* Vt = Ks + 128 * 72; LAS bf16* Sf = Vt + 128 * 136; LAS bf16* Sb = Sf + 128 * 72;
    const bf16* Z = (const bf16*)(wsb() + WS_Z); const float* KV = (const float*)(wsb() + WS_KV); const f32x2* rope = (const f32x2*)(wsb() + WS_ROPE);
    bf16* YS = (bf16*)(wsb() + WS_YS) + (size_t)MT * 1024;
    const int lane = tid & 63, w = tid >> 6, g = lane >> 4, li = lane & 15;
    for (int uid = blockIdx.x; uid < 1024 + nctx_units; uid += gridDim.x) {
        const bool isc = uid >= 1024; int b, h, n, ci; size_t m0;
        if (!isc) { b = uid >> 8; h = (uid >> 5) & 7; n = uid & 31; m0 = (size_t)b * SEQ + n * 128; ci = 2 + n; }
        else { const int i = uid - 1024; b = i >> 4; h = (i >> 1) & 7; n = i & 1; m0 = (size_t)ML + b * CL + n * 128; ci = n; }
        const float lgf = inp(I_RDEC)[(l * 2 + 0) * 8 + h] * LOG2E, lgb = inp(I_RDEC)[(l * 2 + 1) * 8 + h] * LOG2E;
        __syncthreads();
        { const int tok = tid >> 2, pp = tid & 3, a = (pp & 1) + ((pp >> 1) << 2);
            const int t = n * 128 + tok; const int pos = (a < 4) ? (t >> 6) : (t & 63); const f32x2* rt = rope + pos * 16 + 8 * (a & 1);
            const bf16* qr = Z + (m0 + tok) * INW + C_RQ + h * 64; const bf16* kr = Z + (m0 + tok) * INW + C_RK + h * 64;
            float lo[8], hi[8];
            unpack8(*(const v4u*)(qr + 8 * a), lo); unpack8(*(const v4u*)(qr + 8 * a + 16), hi);
            if (!isc) rope8(lo, hi, rt);
            *(LAS v4u*)(Qs + tok * 72 + 8 * a) = pack8(lo); *(LAS v4u*)(Qs + tok * 72 + 8 * a + 16) = pack8(hi);
            unpack8(*(const v4u*)(kr + 8 * a), lo); unpack8(*(const v4u*)(kr + 8 * a + 16), hi);
            if (!isc) rope8(lo, hi, rt);
#pragma unroll
            for (int e = 0; e < 8; ++e) { lo[e] *= 0.125f; hi[e] *= 0.125f; }
            *(LAS v4u*)(Ks + tok * 72 + 8 * a) = pack8(lo); *(LAS v4u*)(Ks + tok * 72 + 8 * a + 16) = pack8(hi); }
        for (int q = tid; q < 2048; q += 512) { const int r = q >> 4, ch = q & 15; vt_store(Vt, 136, ch * 8, r, *(const v4u*)(Z + (m0 + r) * INW + C_RV + h * 128 + ch * 8)); }
#pragma unroll
        for (int dir = 0; dir < 2; ++dir) { const f32x4* src = (const f32x4*)(KV + ((size_t)((b * 8 + h) * 2 + dir) * 34 + ci) * 8192); LAS bf16* S = dir ? Sb : Sf;
            for (int q = tid; q < 2048; q += 512) { const f32x4 v = src[q]; v2u wv; wv.x = pk2(v.x, v.y); wv.y = pk2(v.z, v.w); *(LAS v2u*)(S + (q >> 4) * 72 + (q & 15) * 4) = wv; } }
        __syncthreads();
        const int iq = 16 * w + li;
        bf16x8 qf[2];
#pragma unroll
        for (int ks = 0; ks < 2; ++ks) qf[ks] = *(const LAS bf16x8*)(Qs + iq * 72 + 32 * ks + 8 * g);
        f32x4 s[8];
#pragma unroll
        for (int nn = 0; nn < 8; ++nn) { s[nn] = (f32x4){0.f, 0.f, 0.f, 0.f};
#pragma unroll
            for (int ks = 0; ks < 2; ++ks) s[nn] = mfma16(*(const LAS bf16x8*)(Ks + (16 * nn + li) * 72 + 32 * ks + 8 * g), qf[ks], s[nn]);
#pragma unroll
            for (int j = 0; j < 4; ++j) { const int d = iq - (16 * nn + 4 * g + j); s[nn][j] *= (d >= 0) ? ex2(lgf * (float)d) : ex2(lgb * (float)(-d)); } }
        f32x4 o[8];
#pragma unroll
        for (int nd = 0; nd < 8; ++nd) o[nd] = (f32x4){0.f, 0.f, 0.f, 0.f};
#pragma unroll
        for (int kk = 0; kk < 4; ++kk) {
            const bf16x8 pf = mk8(pk2(s[2 * kk][0], s[2 * kk][1]), pk2(s[2 * kk][2], s[2 * kk][3]), pk2(s[2 * kk + 1][0], s[2 * kk + 1][1]), pk2(s[2 * kk + 1][2], s[2 * kk + 1][3]));
#pragma unroll
            for (int nd = 0; nd < 8; ++nd) { const LAS bf16* vp = Vt + (16 * nd + li) * 136 + 32 * kk + 4 * g;
                const v2u lo = *(const LAS v2u*)vp, hi = *(const LAS v2u*)(vp + 16);
                o[nd] = mfma16(mk8(lo.x, lo.y, hi.x, hi.y), pf, o[nd]); } }
        const float xif = ex2(lgf * (float)(iq + 1)), xib = ex2(lgb * (float)(128 - iq));
        float ss = 0.f;
#pragma unroll
        for (int nd = 0; nd < 8; ++nd) { f32x4 tf = (f32x4){0.f, 0.f, 0.f, 0.f}, tb = (f32x4){0.f, 0.f, 0.f, 0.f};
#pragma unroll
            for (int ks = 0; ks < 2; ++ks) { tf = mfma16(*(const LAS bf16x8*)(Sf + (16 * nd + li) * 72 + 32 * ks + 8 * g), qf[ks], tf);
                tb = mfma16(*(const LAS bf16x8*)(Sb + (16 * nd + li) * 72 + 32 * ks + 8 * g), qf[ks], tb); }
            o[nd] = o[nd] + tf * xif + tb * xib;
            ss += (o[nd][0] * o[nd][0] + o[nd][1] * o[nd][1]) + (o[nd][2] * o[nd][2] + o[nd][3] * o[nd][3]); }
        ss += __shfl_xor(ss, 16); ss += __shfl_xor(ss, 32);
        const float rn = 1.0f / sqrtf(ss * (1.0f / 128.0f) + EPS);
        const size_t mrow = m0 + iq;
#pragma unroll
        for (int nd = 0; nd < 8; ++nd) { const int dv = 16 * nd + 4 * g; const v2u gv = *(const v2u*)(Z + mrow * INW + C_RG + h * 128 + dv);
            const float g0 = bflo(gv.x), g1 = bfhi(gv.x), g2 = bflo(gv.y), g3 = bfhi(gv.y);
            v2u wv; wv.x = pk2(g0 / (1.0f + __expf(-g0)) * o[nd][0] * rn, g1 / (1.0f + __expf(-g1)) * o[nd][1] * rn);
            wv.y = pk2(g2 / (1.0f + __expf(-g2)) * o[nd][2] * rn, g3 / (1.0f + __expf(-g3)) * o[nd][3] * rn);
            *(v2u*)(YS + mrow * 1024 + h * 128 + dv) = wv; }
    }
}

__device__ __forceinline__ float gelu_t(float x) { const float u = 0.7978845608028654f * (x + 0.044715f * x * x * x); const float e = __expf(2.0f * u); return 0.5f * x * (2.0f - 2.0f / (1.0f + e)); }
__device__ __forceinline__ void ph_ffnmid(const Args& A, int l, int Mrows, int tid) {
    const bf16* AB = (const bf16*)(wsb() + WS_Z); bf16* U = (bf16*)(wsb() + WS_U);
    const float* cw = inp(I_FFCW) + (size_t)l * 3 * DFF; const float* cb = inp(I_FFCB) + (size_t)l * DFF;
    const int cgi = tid & 63, rsub = tid >> 6; const int nunits = (Mrows / 32) * 11;
    for (int u = blockIdx.x; u < nunits; u += gridDim.x) {
        const int cblk = u % 11, rblk = u / 11, col = cblk * 512 + cgi * 8;
        float w0[8], w1[8], w2[8], bb[8];
#pragma unroll
        for (int e = 0; e < 8; ++e) { w0[e] = cw[col + e]; w1[e] = cw[DFF + col + e]; w2[e] = cw[2 * DFF + col + e]; bb[e] = cb[col + e]; }
#pragma unroll
        for (int rr = 0; rr < 4; ++rr) { const int m = rblk * 32 + rr * 8 + rsub;
            const bool first = (m < ML) ? ((m & (SEQ - 1)) == 0) : ((m & (CL - 1)) == 0), last = (m < ML) ? ((m & (SEQ - 1)) == SEQ - 1) : ((m & (CL - 1)) == CL - 1);
            const bf16* ap = AB + (size_t)m * NFF + col;
            float am[8], a0[8], aq[8], bg[8];
            const v4u z4 = (v4u){0u, 0u, 0u, 0u};
            unpack8(first ? z4 : *(const v4u*)(ap - NFF), am); unpack8(*(const v4u*)ap, a0); unpack8(last ? z4 : *(const v4u*)(ap + NFF), aq); unpack8(*(const v4u*)(ap + DFF), bg);
            float r[8];
#pragma unroll
            for (int e = 0; e < 8; ++e) r[e] = gelu_t(w0[e] * am[e] + w1[e] * a0[e] + w2[e] * aq[e] + bb[e]) * bg[e];
            *(v4u*)(U + (size_t)m * DFF + col) = pack8(r); }
    }
}
__device__ __forceinline__ void ph_final(const Args& A, int wave, int lane) {
    const int gw = blockIdx.x * NWAVES + wave, NGW = gridDim.x * NWAVES; const float* g = inp(I_GF);
    for (int m = gw; m < ML; m += NGW) { float* xr = outb() + (size_t)m * D; f32x4 v[8]; float ss = 0.f;
#pragma unroll
        for (int j = 0; j < 8; ++j) { v[j] = *(const f32x4*)(xr + (lane + 64 * j) * 4); ss += (v[j].x * v[j].x + v[j].y * v[j].y) + (v[j].z * v[j].z + v[j].w * v[j].w); }
        const float rstd = 1.0f / sqrtf(wave_sum(ss) * (1.0f / D) + EPS);
#pragma unroll
        for (int j = 0; j < 8; ++j) { const int idx = (lane + 64 * j) * 4; *(f32x4*)(xr + idx) = v[j] * rstd * *(const f32x4*)(g + idx); }
    }
}
constexpr int SEQ_PER_LAYER = 11, NSEQ = 1 + DEPTH * SEQ_PER_LAYER + 1;
__global__ void __launch_bounds__(NWAVES * 64, 2) fwd(Args A) {
    extern __shared__ __attribute__((aligned(16))) unsigned char lds_raw[];
    LAS unsigned char* lds = (LAS unsigned char*)lds_raw;
    volatile LAS unsigned* MISC = (volatile LAS unsigned*)(lds + MISC_OFF);
    for (int u = threadIdx.x; u < (LDS_BYTES - LDSCTL_OFF) / 4; u += NWAVES * 64) ((LAS unsigned*)(lds + LDSCTL_OFF))[u] = 0u;
    __syncthreads();
    (void)xcd_barrier_post((unsigned*)(wsb() + WS_CTL) + CW_BAR, MISC + 8);
    const int lo = A.seq_lo, hi = A.seq_hi;
#define G ((int)gridDim.x)
#define RUN(s) (lo <= (s) && (s) < hi)
#ifndef DUP
#define DUP 0
#endif
#define DUPN(id) ((((DUP) >> (id)) & 1) ? 2 : 1)
#define TID_HERE const int tid = otid(), lane = tid & 63, wave = __builtin_amdgcn_readfirstlane(tid >> 6); (void)lane; (void)wave
#ifdef ONLY
#define PH_ON(k) ((k) == ONLY)
#elif defined(SKIP)
#define PH_ON(k) ((k) != SKIP)
#else
#define PH_ON(k) true
#endif
#define SEAM(s) do { if (RUN((s) + 1)) { XcdBarrier bar_; bar_.bar = (unsigned*)(wsb() + WS_CTL) + CW_BAR; bar_.x = xb_xcc_id(); bar_.st = (volatile LAS unsigned*)(lds + MISC_OFF) + 8; xcd_barrier(bar_); } } while (0)
#define H ((bf16*)(wsb() + WS_H))
#define Z ((bf16*)(wsb() + WS_Z))
#define ACC ((bf16*)(wsb() + WS_ACC))
#define U ((bf16*)(wsb() + WS_U))
#define YS ((bf16*)(wsb() + WS_YS))
#define XC ((float*)(wsb() + WS_XC))
#define WIN ((const bf16*)(wsb() + WS_WIN))
#define WBR ((const bf16*)(wsb() + WS_WBR))
#define WOUT ((const bf16*)(wsb() + WS_WOUT))
#define WF1 ((const bf16*)(wsb() + WS_WF1))
#define WF2 ((const bf16*)(wsb() + WS_WF2))

    if (PH_ON(100) && RUN(0)) { TID_HERE; ph_prologue(A, lds, tid); SEAM(0); }

    for (int l = 0; l < DEPTH; ++l) {
        const int sb = 1 + l * SEQ_PER_LAYER;
        if (hi <= sb || lo >= sb + SEQ_PER_LAYER) continue;
        const bool lastl = (l == DEPTH - 1);
        const int Mrows = lastl ? ML : MT, nctx = lastl ? 0 : 64;
#define modl ((const float*)(wsb() + WS_MOD) + (size_t)l * 5 * 12288)
#define xlat_in ((l == 0) ? inp(I_X) : (const float*)outb())
#define xctx_in ((l == 0) ? inp(I_CTX) : (const float*)XC)

        if (PH_ON(0) && RUN(sb + 0)) { TID_HERE;
#ifndef NO_A1
            for (int r_ = 0; r_ < DUPN(1); ++r_) ph_convert(A, l, lds, wave, lane);
#endif
            __syncthreads();
#ifndef NO_A2
            for (int r_ = 0; r_ < DUPN(2); ++r_) ph_filt1(A, l, lds, tid);
#endif
#ifndef NO_A3
            for (int r_ = 0; r_ < DUPN(2); ++r_) ph_norm(xlat_in, xctx_in, inp(I_G1) + (size_t)l * D, modl, 0, D, H, MT, wave, lane);
#endif
            SEAM(sb + 0);
        }
        if (PH_ON(1) && RUN(sb + 1)) { TID_HERE;
            { pg8::Gemm g{H, WIN, opq(MT), opq(INW), opq(D)}; pg8::StaticOrder S; S.init(g.M, g.N, G, (int)blockIdx.x);
              pg8::EpiStore E{Z, INW};
#ifndef NO_B1
              pg8::gemm_phase<pg8::EpiStore, pg8::StaticOrder, PG8_ALIGN, PG8_SP2>(lds, g, S, E);
#endif
 }
#ifndef NO_B2
            for (int r_ = 0; r_ < DUPN(3); ++r_) ph_filt2(A, l, lds, tid);
#endif
            SEAM(sb + 1);
        }
        if (PH_ON(2) && RUN(sb + 2)) { TID_HERE;
            for (int r_ = 0; r_ < DUPN(4); ++r_) ph_hyprep(A, l, lds, tid);
            for (int r_ = 0; r_ < DUPN(5); ++r_) ph_ret1(A, l, 64, lds, tid);
            for (int r_ = 0; r_ < DUPN(6); ++r_) ph_natt(A, l, nctx, lds, tid);
            for (int r_ = 0; r_ < DUPN(7); ++r_) if (!lastl) ph_hyctx(A, l, lds, tid);
            SEAM(sb + 2);
        }
        if (PH_ON(3) && RUN(sb + 3)) { TID_HERE;
#ifndef NO_D1
            for (int r_ = 0; r_ < DUPN(8); ++r_) ph_hyfft(A, l, lds, tid);
#endif
#ifndef NO_D2
            ph_scan(A, l, tid);
#endif
            SEAM(sb + 3);
        }
        if (PH_ON(4) && RUN(sb + 4)) { TID_HERE;
            for (int r_ = 0; r_ < DUPN(9); ++r_) ph_hypost(A, lds, tid);
            for (int r_ = 0; r_ < DUPN(10); ++r_) ph_ret3(A, l, nctx, lds, tid);
            SEAM(sb + 4);
        }
        if (PH_ON(5) && RUN(sb + 5)) { TID_HERE;
            __syncthreads();
            for (int r_ = 0; r_ < DUPN(13); ++r_)
            for (int i = 0; i < 3; ++i) {
                pg8::Gemm g{YS + (size_t)i * MT * 1024, WBR + (size_t)i * D * 1024, Mrows, opq(D), opq(1024)}; pg8::StaticOrder S; S.init(g.M, g.N, G, (int)blockIdx.x);
                pg8::EpiMerge E{ACC, Z + C_GT + i * D, INW, i == 0 ? 1 : 0};
                pg8::gemm_phase<pg8::EpiMerge, pg8::StaticOrder, PG8_ALIGN, PG8_SP2>(lds, g, S, E);
            }
            SEAM(sb + 5);
        }
        if (PH_ON(6) && RUN(sb + 6)) { TID_HERE;
            __syncthreads();
            pg8::Gemm g{ACC, WOUT, Mrows, opq(D), opq(D)}; pg8::StaticOrder S; S.init(g.M, g.N, G, (int)blockIdx.x);
            pg8::EpiResid E{xlat_in, xctx_in, outb(), XC, modl, 2 * D};
            pg8::gemm_phase<pg8::EpiResid, pg8::StaticOrder, PG8_ALIGN, PG8_SP2>(lds, g, S, E);
            SEAM(sb + 6);
        }
        if (PH_ON(7) && RUN(sb + 7)) { TID_HERE;
            for (int r_ = 0; r_ < DUPN(12); ++r_) ph_norm(outb(), XC, inp(I_G2) + (size_t)l * D, modl, 3 * D, 4 * D, H, Mrows, wave, lane);
            SEAM(sb + 7);
        }
        if (PH_ON(8) && RUN(sb + 8)) { TID_HERE;
            __syncthreads();
            pg8::Gemm g{H, WF1, Mrows, opq(NFF), opq(D)}; pg8::StaticOrder S; S.init(g.M, g.N, G, (int)blockIdx.x);
            pg8::EpiStore E{Z, NFF};
            for (int r_ = 0; r_ < DUPN(14); ++r_) pg8::gemm_phase<pg8::EpiStore, pg8::StaticOrder, PG8_ALIGN, PG8_SP2>(lds, g, S, E);
            SEAM(sb + 8);
        }
        if (PH_ON(9) && RUN(sb + 9)) { TID_HERE;
            for (int r_ = 0; r_ < DUPN(11); ++r_) ph_ffnmid(A, l, Mrows, tid);
            SEAM(sb + 9);
        }
        if (PH_ON(10) && RUN(sb + 10)) { TID_HERE;
            __syncthreads();
            pg8::Gemm g{U, WF2, Mrows, opq(D), opq(DFF)}; pg8::StaticOrder S; S.init(g.M, g.N, G, (int)blockIdx.x);
            pg8::EpiResid E{outb(), XC, outb(), XC, modl, 5 * D};
            pg8::gemm_phase<pg8::EpiResid, pg8::StaticOrder, PG8_ALIGN, PG8_SP2>(lds, g, S, E);
            SEAM(sb + 10);
        }
    }
    if (PH_ON(101) && RUN(NSEQ - 1)) { TID_HERE; ph_final(A, wave, lane); }
#undef RUN
#undef SEAM
#undef H
#undef Z
#undef ACC
#undef U
#undef YS
#undef XC
#undef WIN
#undef WBR
#undef WOUT
#undef WF1
#undef WF2
#undef G
#undef modl
#undef xlat_in
#undef xctx_in
}

extern "C" void kernel_launch(void* const* d_in, const int* in_sizes, int n_in, void* d_out, int out_size, void* d_ws, size_t ws_size, hipStream_t stream) {
    static int grid = 0;
    if (grid == 0) {
        if (n_in != 27 || out_size != ML * D || ws_size < WS_END) { fprintf(stderr, "kernel_launch: unexpected shapes (n_in %d out %d ws %zu need %zu)\n", n_in, out_size, ws_size, (size_t)WS_END); grid = -1; return; }
        int dev = 0, cus = 0, per_cu = 0;
        if (hipGetDevice(&dev) != hipSuccess || hipDeviceGetAttribute(&cus, hipDeviceAttributeMultiprocessorCount, dev) != hipSuccess) { grid = -1; return; }
        if (hipFuncSetAttribute((const void*)fwd, hipFuncAttributeMaxDynamicSharedMemorySize, LDS_BYTES) != hipSuccess) { fprintf(stderr, "kernel_launch: hipFuncSetAttribute failed\n"); grid = -1; return; }
        if (hipOccupancyMaxActiveBlocksPerMultiprocessor(&per_cu, (const void*)fwd, NWAVES * 64, LDS_BYTES) != hipSuccess || per_cu < 1) fprintf(stderr, "kernel_launch: occupancy query says %d\n", per_cu);
        (void)hipGetLastError();
        grid = cus;
    }
    if (grid < 0) return;
    (void)hipMemsetAsync((char*)d_ws + WS_CTL, 0, CTL_ZERO_BYTES, stream);
    Args a{};
    for (int i = 0; i < 27; ++i) a.in[i] = (const float*)d_in[i];
    a.out = (float*)d_out; a.ws = (unsigned char*)d_ws;
#if MK_SINGLE
    a.seq_lo = 0; a.seq_hi = NSEQ;
    hipLaunchKernelGGL(fwd, dim3(grid), dim3(NWAVES * 64), LDS_BYTES, stream, a);
#else
    for (int s = 0; s < NSEQ; ++s) { a.seq_lo = s; a.seq_hi = s + 1; hipLaunchKernelGGL(fwd, dim3(grid), dim3(NWAVES * 64), LDS_BYTES, stream, a); }
#endif
}
```

```cpp
#include <hip/hip_runtime.h>
#include <cstdio>
#include <cstdint>
#ifndef MK_SINGLE
#define MK_SINGLE 1
#endif
namespace pg8 {
#define PG8_LAS __attribute__((address_space(3)))
typedef unsigned short bf16_t;
typedef short bf16x8 __attribute__((ext_vector_type(8)));
typedef float f32x4 __attribute__((ext_vector_type(4)));
typedef unsigned u32x4 __attribute__((ext_vector_type(4)));
constexpr int BM = 256, BK = 64, HALF = 128, HTB = HALF * BK * 2  , STAGE_BYTES = 8 * HTB, NXCD = 8, WGM = 8;

__host__ __device__ __forceinline__ int lds_byte(int r, int c) { const int st = (r >> 4) * 2 + (c >> 5), rr = r & 15, cc = c & 31, ob = rr * 64 + cc * 2; return st * 1024 + (ob ^ (((ob >> 9) & 1) << 5)); }
__host__ __device__ __forceinline__ void stage_rc(int b, int& R, int& C) { const int st = b / 1024, sb = b % 1024, swz = sb ^ (((sb >> 9) & 1) << 5); R = (st >> 1) * 16 + swz / 64; C = (st & 1) * 32 + (swz % 64) / 2; }
__host__ __device__ __forceinline__ int perm32(int rho) { const int n = rho >> 4, i = rho & 15; return 8 * (i >> 2) + 4 * n + (i & 3); }

struct Unit { int pm, pn; };
struct Gemm { const bf16_t* A; const bf16_t* Bt; int M, N, K; };

struct StaticOrder {
    int nM, nN, nwg, G, c;
    __host__ __device__ void init(int M, int N, int G_, int c_) { nM = M / BM; nN = N / BM; nwg = nM * nN; G = G_; c = c_; }
    __host__ __device__ bool next(int i, Unit& u) const {
        const long L = (long)i * G + c; if (L >= nwg) return false;
        int wgid = (int)L; { const int q = nwg / NXCD, r = nwg % NXCD, xcd = wgid % NXCD, off = wgid / NXCD; wgid = (xcd < r ? xcd * (q + 1) : r * (q + 1) + (xcd - r) * q) + off; }
        const int nig = WGM * nN, gid = wgid / nig, fm = gid * WGM, gsz = (nM - fm) < WGM ? (nM - fm) : WGM;
        u.pm = fm + ((wgid % nig) % gsz); u.pn = (wgid % nig) / gsz; return true;
    }
    __device__ __forceinline__ void a_ready(const Unit&) const {}
    __device__ __forceinline__ void done(const Unit&) const {}
};
__device__ __forceinline__ unsigned cvt_pk_bf16(float lo, float hi) { unsigned r; asm volatile("v_cvt_pk_bf16_f32 %0, %1, %2" : "=v"(r) : "v"(lo), "v"(hi)); return r; }
typedef float f32x2 __attribute__((ext_vector_type(2)));
__device__ __forceinline__ float bflo(unsigned w) { return __uint_as_float(w << 16); }
__device__ __forceinline__ float bfhi(unsigned w) { return __uint_as_float(w & 0xffff0000u); }
__device__ __forceinline__ float sigm(float x) { return 1.0f / (1.0f + __expf(-x)); }
struct EpiStore {
    static constexpr bool PERM = true, AFTER_DRAIN = false;
    bf16_t* O; int ldc;
    __device__ __forceinline__ void operator()(const f32x4 (&acc)[2][2][4][2], const Unit& u, int wr, int wc, int fr, int fq) const {
        const int row0 = u.pm * BM + wr * 64 + fr, col0 = u.pn * BM + wc * 32 + 8 * fq;
#pragma unroll
        for (int ai = 0; ai < 2; ++ai)
#pragma unroll
            for (int m = 0; m < 4; ++m) { bf16_t* rowp = O + (size_t)(row0 + ai * HALF + m * 16) * ldc + col0;
#pragma unroll
                for (int bj = 0; bj < 2; ++bj) { const f32x4 v0 = acc[ai][bj][m][0], v1 = acc[ai][bj][m][1];
                    u32x4 w; w.x = cvt_pk_bf16(v0[0], v0[1]); w.y = cvt_pk_bf16(v0[2], v0[3]); w.z = cvt_pk_bf16(v1[0], v1[1]); w.w = cvt_pk_bf16(v1[2], v1[3]);
                    *(u32x4*)(rowp + bj * HALF) = w; } }
    }
};
struct EpiMerge {
    static constexpr bool PERM = true, AFTER_DRAIN = false;
    bf16_t* O; const bf16_t* gate; int ldg; int first;
    __device__ __forceinline__ void operator()(const f32x4 (&acc)[2][2][4][2], const Unit& u, int wr, int wc, int fr, int fq) const {
        const int row0 = u.pm * BM + wr * 64 + fr, col0 = u.pn * BM + wc * 32 + 8 * fq;
#pragma unroll
        for (int ai = 0; ai < 2; ++ai)
#pragma unroll
            for (int m = 0; m < 4; ++m) { const size_t row = (size_t)(row0 + ai * HALF + m * 16);
#pragma unroll
                for (int bj = 0; bj < 2; ++bj) { const int col = col0 + bj * HALF;
                    const u32x4 gv = *(const u32x4*)(gate + row * ldg + col);
                    u32x4 pv = (u32x4){0u, 0u, 0u, 0u}; if (!first) pv = *(const u32x4*)(O + row * 2048 + col);
                    const f32x4 v0 = acc[ai][bj][m][0], v1 = acc[ai][bj][m][1];
                    u32x4 w;
                    w.x = cvt_pk_bf16(bflo(pv.x) + v0[0] * sigm(bflo(gv.x)), bfhi(pv.x) + v0[1] * sigm(bfhi(gv.x)));
                    w.y = cvt_pk_bf16(bflo(pv.y) + v0[2] * sigm(bflo(gv.y)), bfhi(pv.y) + v0[3] * sigm(bfhi(gv.y)));
                    w.z = cvt_pk_bf16(bflo(pv.z) + v1[0] * sigm(bflo(gv.z)), bfhi(pv.z) + v1[1] * sigm(bfhi(gv.z)));
                    w.w = cvt_pk_bf16(bflo(pv.w) + v1[2] * sigm(bflo(gv.w)), bfhi(pv.w) + v1[3] * sigm(bfhi(gv.w)));
                    *(u32x4*)(O + row * 2048 + col) = w; } }
    }
};
struct EpiResid {
    static constexpr bool PERM = false, AFTER_DRAIN = false;
    const float* base_lat; const float* base_ctx; float* out_lat; float* out_ctx; const float* modl; int goff;
    __device__ __forceinline__ void operator()(const f32x4 (&acc)[2][2][4][2], const Unit& u, int wr, int wc, int fr, int fq) const {
        const bool isctx = u.pm >= 64; const int r = isctx ? 4 : (u.pm >> 4);
        const float* gvp = modl + (size_t)r * 12288 + goff;
        const float* bs = isctx ? base_ctx : base_lat; float* os = isctx ? out_ctx : out_lat;
        const int row0 = (isctx ? u.pm - 64 : u.pm) * BM + wr * 64 + fr, col0 = u.pn * BM + wc * 32 + 4 * fq;
        f32x4 g4[2][2];
#pragma unroll
        for (int bj = 0; bj < 2; ++bj)
#pragma unroll
            for (int n = 0; n < 2; ++n) g4[bj][n] = *(const f32x4*)(gvp + col0 + bj * HALF + n * 16);
#pragma unroll
        for (int ai = 0; ai < 2; ++ai)
#pragma unroll
            for (int m = 0; m < 4; ++m) { const size_t off = (size_t)(row0 + ai * HALF + m * 16) * 2048 + col0;
#pragma unroll
                for (int bj = 0; bj < 2; ++bj)
#pragma unroll
                    for (int n = 0; n < 2; ++n) { const f32x4 b4 = *(const f32x4*)(bs + off + bj * HALF + n * 16);
                        *(f32x4*)(os + off + bj * HALF + n * 16) = b4 + g4[bj][n] * acc[ai][bj][m][n]; } }
    }
};
template <class Epi, class Sched, bool ALIGN_EPI = false, bool SP2 = false>
__device__ __forceinline__ void gemm_phase(PG8_LAS unsigned char* lds, const Gemm g, const Sched& S, const Epi& E) {
    int tid_ = threadIdx.x; asm volatile("" : "+v"(tid_)); const int tid = tid_, wid = __builtin_amdgcn_readfirstlane(tid >> 6), lane = tid & 63, wr = wid >> 2, wc = wid & 3, fr = lane & 15, fq = lane >> 4;
    const int K = g.K, nt = K / BK;
    unsigned voffA[2], voffB[2];
#pragma unroll
    for (int i = 0; i < 2; ++i) { int R, C; stage_rc(tid * 16 + i * 8192, R, C); const int Rb = Epi::PERM ? ((R & ~31) + perm32(R & 31)) : R;
        voffA[i] = (unsigned)(R * K + C) * 2u; voffB[i] = (unsigned)(Rb * K + C) * 2u; }
    const size_t kstep = (size_t)(BK * 2);
    const size_t hstep = (size_t)HALF * K * 2;
    const size_t tstep = 2 * hstep;
    const unsigned ldsw = (unsigned)wid * 1024u;
    const int aoff = lds_byte(wr * 64 + fr, fq * 8), boff = lds_byte(wc * 32 + fr, fq * 8);
#define PG8_SA(b, h) (((b) * 2 + (h)) * HTB)
#define PG8_SB(b, h) ((4 + (b) * 2 + (h)) * HTB)
#define PG8_STAGE(bufoff, gbase, voff) do { _Pragma("unroll") for (int _i = 0; _i < 2; ++_i) \
        __builtin_amdgcn_global_load_lds((const unsigned*)((const char*)(gbase) + (voff)[_i]), (PG8_LAS unsigned*)(lds + (bufoff) + ldsw + _i * 8192), 16, 0, 0); } while (0)
#define PG8_LDA(dst, b, h) do { _Pragma("unroll") for (int m = 0; m < 4; ++m) _Pragma("unroll") for (int k = 0; k < 2; ++k) dst[m][k] = *(const PG8_LAS bf16x8*)(lds + PG8_SA(b, h) + aoff + m * 2048 + k * 1024); } while (0)
#define PG8_LDB(dst, b, h) do { _Pragma("unroll") for (int n = 0; n < 2; ++n) _Pragma("unroll") for (int k = 0; k < 2; ++k) dst[n][k] = *(const PG8_LAS bf16x8*)(lds + PG8_SB(b, h) + boff + n * 2048 + k * 1024); } while (0)
#define PG8_MMA(ai, bj, At, Bt) do { __builtin_amdgcn_s_setprio(1); _Pragma("unroll") for (int m = 0; m < 4; ++m) _Pragma("unroll") for (int n = 0; n < 2; ++n) _Pragma("unroll") for (int k = 0; k < 2; ++k) \
        acc[ai][bj][m][n] = __builtin_amdgcn_mfma_f32_16x16x32_bf16(Bt[n][k], At[m][k], acc[ai][bj][m][n], 0, 0, 0); __builtin_amdgcn_s_setprio(0); } while (0)
#define PG8_WAIT_V(n) asm volatile("s_waitcnt vmcnt(" #n ")" ::: "memory")
#define PG8_WAIT_L(n) asm volatile("s_waitcnt lgkmcnt(" #n ")" ::: "memory")
#define PG8_BAR __builtin_amdgcn_s_barrier()
#define PG8_SCHED __builtin_amdgcn_sched_barrier(0)
    Unit cur, nxt; int ui = 0;
    if (!S.next(0, cur)) return;
    f32x4 acc[2][2][4][2];
#pragma unroll
    for (int a = 0; a < 2; ++a)
#pragma unroll
        for (int b = 0; b < 2; ++b)
#pragma unroll
            for (int m = 0; m < 4; ++m)
#pragma unroll
                for (int n = 0; n < 2; ++n) acc[a][b][m][n] = (f32x4){0.f, 0.f, 0.f, 0.f};
    bf16x8 At[4][2], B0[2][2], B1[2][2];
    const char* cA = (const char*)g.A + (size_t)cur.pm * tstep; const char* cB = (const char*)g.Bt + (size_t)cur.pn * tstep;
    S.a_ready(cur);
    if constexpr (SP2) {
        PG8_STAGE(PG8_SB(0, 0), cB, voffB); PG8_STAGE(PG8_SB(0, 1), cB + hstep, voffB); PG8_STAGE(PG8_SA(0, 0), cA, voffA); PG8_STAGE(PG8_SA(0, 1), cA + hstep, voffA);
        if (wr == 1) PG8_BAR;
        PG8_WAIT_V(2); PG8_BAR;
        PG8_STAGE(PG8_SB(1, 0), cB + kstep, voffB); PG8_STAGE(PG8_SA(1, 0), cA + kstep, voffA); PG8_STAGE(PG8_SB(1, 1), cB + hstep + kstep, voffB);
        PG8_WAIT_V(6); PG8_BAR;
    } else {
        PG8_STAGE(PG8_SB(0, 0), cB, voffB); PG8_STAGE(PG8_SA(0, 0), cA, voffA); PG8_STAGE(PG8_SB(0, 1), cB + hstep, voffB); PG8_STAGE(PG8_SA(0, 1), cA + hstep, voffA);
        if (wr == 1) PG8_BAR;
        PG8_WAIT_V(4); PG8_BAR;
        PG8_STAGE(PG8_SB(1, 0), cB + kstep, voffB); PG8_STAGE(PG8_SA(1, 0), cA + kstep, voffA); PG8_STAGE(PG8_SB(1, 1), cB + hstep + kstep, voffB);
        PG8_WAIT_V(6); PG8_BAR;
    }
    for (;;) {
        const bool has_next = S.next(ui + 1, nxt);
        const char* nA = has_next ? (const char*)g.A + (size_t)nxt.pm * tstep : cA; const char* nB = has_next ? (const char*)g.Bt + (size_t)nxt.pn * tstep : cB;
        for (int t = 0; t < nt; t += 2) {
            const bool last = (t == nt - 2);
            const char* a1 = cA + (size_t)(t + 1) * kstep;
            const char* a2 = last ? nA : cA + (size_t)(t + 2) * kstep; const char* b2 = last ? nB : cB + (size_t)(t + 2) * kstep;
            const char* a3 = a2 + kstep; const char* b3 = b2 + kstep;
            if (last && has_next) S.a_ready(nxt);
            if constexpr (SP2) {
            PG8_LDB(B0, 0, 0); PG8_LDB(B1, 0, 1); PG8_SCHED; PG8_LDA(At, 0, 0); PG8_STAGE(PG8_SA(1, 1), a1 + hstep, voffA);
            PG8_WAIT_V(8); PG8_WAIT_L(0); PG8_BAR; PG8_MMA(0, 0, At, B0); PG8_MMA(0, 1, At, B1); PG8_BAR; PG8_SCHED;
            PG8_LDA(At, 0, 1); PG8_STAGE(PG8_SB(0, 0), b2, voffB); PG8_STAGE(PG8_SB(0, 1), b2 + hstep, voffB); PG8_STAGE(PG8_SA(0, 0), a2, voffA);
            PG8_WAIT_V(8); PG8_WAIT_L(0); PG8_BAR; PG8_MMA(1, 0, At, B0); PG8_MMA(1, 1, At, B1); PG8_BAR; PG8_SCHED;
            PG8_LDB(B0, 1, 0); PG8_LDB(B1, 1, 1); PG8_SCHED; PG8_LDA(At, 1, 0); PG8_STAGE(PG8_SA(0, 1), a2 + hstep, voffA);
            PG8_WAIT_V(8); PG8_WAIT_L(0); PG8_BAR; PG8_MMA(0, 0, At, B0); PG8_MMA(0, 1, At, B1); PG8_BAR; PG8_SCHED;
            PG8_LDA(At, 1, 1); PG8_STAGE(PG8_SB(1, 0), b3, voffB); PG8_STAGE(PG8_SB(1, 1), b3 + hstep, voffB); PG8_STAGE(PG8_SA(1, 0), a3, voffA);
            PG8_WAIT_V(8); PG8_WAIT_L(0); PG8_BAR; PG8_MMA(1, 0, At, B0); PG8_MMA(1, 1, At, B1); PG8_BAR; PG8_SCHED;
            } else {
            PG8_LDB(B0, 0, 0); PG8_SCHED; PG8_LDA(At, 0, 0); PG8_STAGE(PG8_SA(1, 1), a1 + hstep, voffA);
            PG8_WAIT_L(8); PG8_BAR; PG8_WAIT_L(0); PG8_MMA(0, 0, At, B0); PG8_BAR; PG8_SCHED;
            PG8_LDB(B1, 0, 1); PG8_STAGE(PG8_SB(0, 0), b2, voffB);
            PG8_BAR; PG8_WAIT_L(0); PG8_MMA(0, 1, At, B1); PG8_BAR;
            PG8_LDA(At, 0, 1); PG8_STAGE(PG8_SA(0, 0), a2, voffA);
            PG8_BAR; PG8_WAIT_L(0); PG8_MMA(1, 0, At, B0); PG8_BAR; PG8_SCHED;
            PG8_STAGE(PG8_SB(0, 1), b2 + hstep, voffB);
            PG8_WAIT_V(6); PG8_BAR; PG8_MMA(1, 1, At, B1); PG8_BAR;
            PG8_LDB(B0, 1, 0); PG8_SCHED; PG8_LDA(At, 1, 0); PG8_STAGE(PG8_SA(0, 1), a2 + hstep, voffA);
            PG8_WAIT_L(8); PG8_BAR; PG8_WAIT_L(0); PG8_MMA(0, 0, At, B0); PG8_BAR; PG8_SCHED;
            PG8_LDB(B1, 1, 1); PG8_STAGE(PG8_SB(1, 0), b3, voffB);
            PG8_BAR; PG8_WAIT_L(0); PG8_MMA(0, 1, At, B1); PG8_BAR;
            PG8_LDA(At, 1, 1); PG8_STAGE(PG8_SA(1, 0), a3, voffA);
            PG8_BAR; PG8_WAIT_L(0); PG8_MMA(1, 0, At, B0); PG8_BAR; PG8_SCHED;
            PG8_STAGE(PG8_SB(1, 1), b3 + hstep, voffB);
            PG8_WAIT_V(6); PG8_BAR; PG8_MMA(1, 1, At, B1); PG8_BAR;
            }
        }
        if constexpr (ALIGN_EPI) { if (wr == 0) PG8_BAR; }
        if constexpr (!Epi::AFTER_DRAIN) { E(acc, cur, wr, wc, fr, fq); S.done(cur); }
        if (!has_next) break;
#pragma unroll
        for (int a = 0; a < 2; ++a)
#pragma unroll
            for (int b = 0; b < 2; ++b)
#pragma unroll
                for (int m = 0; m < 4; ++m)
#pragma unroll
                    for (int n = 0; n < 2; ++n) acc[a][b][m][n] = (f32x4){0.f, 0.f, 0.f, 0.f};
        cur = nxt; cA = nA; cB = nB; ++ui;
        if constexpr (ALIGN_EPI) { if (wr == 1) PG8_BAR; }
    }
    PG8_WAIT_V(0);
    if constexpr (!ALIGN_EPI) { if (wr == 0) PG8_BAR; }
    PG8_BAR;
    if constexpr (Epi::AFTER_DRAIN) { E.fused(acc, cur, wr, wc, fr, fq, lds, wid, lane); S.done(cur); }
#undef PG8_SA
#undef PG8_SB
#undef PG8_STAGE
#undef PG8_LDA
#undef PG8_LDB
#undef PG8_MMA
#undef PG8_WAIT_V
#undef PG8_WAIT_L
#undef PG8_BAR
#undef PG8_SCHED
}
}
#ifndef PG8_SP2
#define PG8_SP2 true
#endif
#ifndef PG8_ALIGN
#define PG8_ALIGN true
#endif
constexpr int D = 2048, NB = 4, SEQ = 4096, CL = 256, DEPTH = 4;
constexpr int ML = NB * SEQ, MC = NB * CL, MT = ML + MC;
constexpr int INW = 15360, DFF = 5632, NFF = 2 * DFF;
constexpr int C_RK = 0, C_RV = 512, C_NK = 1536, C_NV = 2560, C_RQ = 3584, C_RG = 4096, C_NQ = 5120, C_HY = 6144, C_GT = 9216;
constexpr float EPS = 1e-6f;
constexpr int NWAVES = 8;
constexpr size_t al256(size_t x) { return (x + 255) & ~(size_t)255; }
constexpr size_t WS_CTL = 0, CTL_ZERO_BYTES = 1u << 20;
constexpr size_t WS_MOD = WS_CTL + CTL_ZERO_BYTES;
constexpr size_t WS_ROPE = WS_MOD + al256((size_t)4 * 5 * 12288 * 4);
constexpr size_t WS_FH2 = WS_ROPE + al256(64 * 16 * 8);
constexpr size_t WS_TAPC = WS_FH2 + al256((size_t)4352 * 64 * 4);
constexpr size_t WS_KF = WS_TAPC + al256((size_t)2 * 2 * 1024 * 256 * 4);
constexpr size_t WS_WIN = WS_KF + al256((size_t)2 * 1024 * 8192 * 8);
constexpr size_t WS_WBR = WS_WIN + al256((size_t)INW * D * 2);
constexpr size_t WS_WOUT = WS_WBR + al256((size_t)3 * D * 1024 * 2);
constexpr size_t WS_WF1 = WS_WOUT + al256((size_t)D * D * 2);
constexpr size_t WS_WF2 = WS_WF1 + al256((size_t)NFF * D * 2);
constexpr size_t WS_XC = WS_WF2 + al256((size_t)D * DFF * 2);
constexpr size_t WS_H = WS_XC + al256((size_t)MC * D * 4);
constexpr size_t WS_Z = WS_H + al256((size_t)MT * D * 2);
constexpr size_t WS_HYT = WS_Z + al256((size_t)MT * INW * 2);
constexpr size_t WS_YT = WS_HYT + al256((size_t)3 * NB * 1024 * SEQ * 2);
constexpr size_t WS_YS = WS_YT + al256((size_t)NB * 1024 * SEQ * 2);
constexpr size_t WS_ACC = WS_YS + al256((size_t)3 * MT * 1024 * 2);
constexpr size_t WS_U = WS_ACC + al256((size_t)MT * D * 2);
constexpr size_t WS_KV = WS_U + al256((size_t)MT * DFF * 2);
constexpr size_t WS_END = WS_KV + al256((size_t)NB * 8 * 2 * 34 * 8192 * 4);
constexpr int CW_BAR = 4096;
constexpr int RING_BYTES = 131072, LDSCTL_OFF = RING_BYTES, MISC_OFF = LDSCTL_OFF + 320, LDS_BYTES = 147456;

#define GAS __attribute__((address_space(1)))
#define LAS __attribute__((address_space(3)))
typedef unsigned short bf16;
typedef unsigned v4u __attribute__((ext_vector_type(4)));
typedef unsigned v2u __attribute__((ext_vector_type(2)));
typedef float f32x4 __attribute__((ext_vector_type(4)));
typedef float f32x2 __attribute__((ext_vector_type(2)));
typedef short bf16x8 __attribute__((ext_vector_type(8)));
typedef GAS unsigned gu32;
#define LDS_WAIT() asm volatile("s_waitcnt lgkmcnt(0)" ::: "memory")
__device__ __forceinline__ unsigned f2bf(float f) { unsigned u = __builtin_bit_cast(unsigned, f); return (u + 0x7fffu + ((u >> 16) & 1u)) >> 16; }
__device__ __forceinline__ unsigned pk2(float lo, float hi) { return f2bf(lo) | (f2bf(hi) << 16); }
__device__ __forceinline__ float bflo(unsigned w) { return __uint_as_float(w << 16); }
__device__ __forceinline__ float bfhi(unsigned w) { return __uint_as_float(w & 0xffff0000u); }
__device__ __forceinline__ float bf1(bf16 b) { return __uint_as_float(((unsigned)b) << 16); }
__device__ __forceinline__ bf16x8 mk8(unsigned a, unsigned b, unsigned c, unsigned d) { v4u v = (v4u){a, b, c, d}; return __builtin_bit_cast(bf16x8, v); }
__device__ __forceinline__ f32x4 mfma16(bf16x8 a, bf16x8 b, f32x4 c) { return __builtin_amdgcn_mfma_f32_16x16x32_bf16(a, b, c, 0, 0, 0); }
__device__ __forceinline__ float sin_rev(float r) { return __builtin_amdgcn_sinf(r - floorf(r)); }
__device__ __forceinline__ float cos_rev(float r) { return __builtin_amdgcn_cosf(r - floorf(r)); }
__device__ __forceinline__ float sin_rad(float x) { return sin_rev(x * 0.15915494309189535f); }
__device__ __forceinline__ float ex2(float x) { return __builtin_amdgcn_exp2f(x); }
__device__ __forceinline__ float wave_sum(float v) {
#pragma unroll
    for (int o = 1; o < 64; o <<= 1) v += __shfl_xor(v, o);
    return v;
}
__device__ __forceinline__ int otid() { int t = threadIdx.x; asm volatile("" : "+v"(t)); return t; }
__device__ __forceinline__ int opq(int v) { asm volatile("" : "+s"(v)); return v; }
#define XB_TMO      128
#define XB_XCNT(j)  (256  + 64 * (j))
#define XB_XSUB(j)  (1280 + 64 * (j))
#define XB_XGEN(j)  (2304 + 64 * (j))
#define XB_TOP      3328
#define XB_TOPGEN   3392
#define XCD_BAR_WORDS 3456
#define XB_SPIN_CAP (1u << 18)

__device__ __forceinline__ unsigned xb_ld(unsigned* p)              { return __hip_atomic_load(p, __ATOMIC_RELAXED, __HIP_MEMORY_SCOPE_AGENT); }
__device__ __forceinline__ unsigned xb_add(unsigned* p, unsigned v) { return __hip_atomic_fetch_add(p, v, __ATOMIC_RELAXED, __HIP_MEMORY_SCOPE_AGENT); }
__device__ __forceinline__ unsigned xb_xcc_id() { return (unsigned)__builtin_amdgcn_s_getreg((3 << 11) | 20) & 0xFu; }
#define XB_SPIN(cond, bar) do { unsigned _sp = 0; while (cond) { __builtin_amdgcn_s_sleep(1); \
    if ((++_sp & 255u) == 0u) { if (xb_ld(&(bar)[XB_TMO])) break; if (_sp > XB_SPIN_CAP) { atomicAdd(&(bar)[XB_TMO], 1u); break; } } } } while (0)

struct XcdBarrier {
    unsigned* bar; unsigned x;
    volatile LAS unsigned* st;
};

__device__ __forceinline__ XcdBarrier xcd_barrier_post(unsigned* bar, volatile LAS unsigned* st) {
    XcdBarrier b; b.bar = bar; b.x = xb_xcc_id(); b.st = st;
    if (threadIdx.x == 0) (void)xb_add(&bar[XB_XCNT(b.x)], 1u);
    return b;
}
__device__ __forceinline__ void xcd_barrier_complete(unsigned* bar, unsigned x, unsigned& nloc, unsigned& nx) {
    const unsigned G = gridDim.x * gridDim.y * gridDim.z;
    unsigned sum, cnt, mine, sp = 0u;
    for (;;) {
        sum = 0u; cnt = 0u; mine = 0u;
#pragma unroll
        for (unsigned j = 0; j < 16; ++j) { const unsigned c = xb_ld(&bar[XB_XCNT(j)]); sum += c; cnt += (c > 0u) ? 1u : 0u; mine = (j == x) ? c : mine; }
        if (sum == G) break;
        __builtin_amdgcn_s_sleep(1);
        if ((++sp & 255u) == 0u) { if (xb_ld(&bar[XB_TMO])) break; if (sp > XB_SPIN_CAP) { atomicAdd(&bar[XB_TMO], 1u); break; } }
    }
    nloc = mine > 0u ? mine : 1u; nx = cnt > 0u ? cnt : 1u;
}

__device__ __forceinline__ void xcd_barrier(const XcdBarrier& b) {
    asm volatile("s_waitcnt vmcnt(0)" ::: "memory");
    __syncthreads();
    if (threadIdx.x == 0) {
        unsigned* bar = b.bar;
        __builtin_amdgcn_s_waitcnt(0);
        unsigned nloc = b.st[0], nx = b.st[1];
        if (nloc == 0u) { xcd_barrier_complete(bar, b.x, nloc, nx); b.st[0] = nloc; b.st[1] = nx; }
        const unsigned old = xb_add(&bar[XB_XSUB(b.x)], 1u);
        const unsigned gen = old / nloc;
        if (old + 1u == (gen + 1u) * nloc) {
            __builtin_amdgcn_fence(__ATOMIC_RELEASE, "agent");
            asm volatile("s_waitcnt vmcnt(0)" ::: "memory");
            const unsigned og = xb_add(&bar[XB_TOP], 1u);
            const unsigned tg = og / nx;
            if (og + 1u == (tg + 1u) * nx) xb_add(&bar[XB_TOPGEN], 1u);
            else XB_SPIN(xb_ld(&bar[XB_TOPGEN]) == tg, bar);
            __builtin_amdgcn_fence(__ATOMIC_ACQUIRE, "agent");
            xb_add(&bar[XB_XGEN(b.x)], 1u);
            asm volatile("s_waitcnt vmcnt(0)" ::: "memory");
        } else {
            XB_SPIN(xb_ld(&bar[XB_XGEN(b.x)]) == gen, bar);
            __builtin_amdgcn_fence(__ATOMIC_ACQUIRE, "agent");
            asm volatile("s_waitcnt vmcnt(0)" ::: "memory");
        }
    }
    __syncthreads();
}
__device__ __forceinline__ void p0_transpose_item(const float* W, int K, int N, bf16* WT, int row_off, LAS float* scr, int item, int lane) {
    const int nblk = N / 32, kb = item / nblk, nb = item % nblk, k0 = 64 * kb, n0 = 32 * nb;
#pragma unroll 8
    for (int i = 0; i < 32; ++i) { const int kk = 2 * i + (lane >> 5); scr[kk * 33 + (lane & 31)] = W[(size_t)(k0 + kk) * N + n0 + (lane & 31)]; }
    LDS_WAIT(); asm volatile("" ::: "memory");
    const int c = lane & 7;
#pragma unroll
    for (int j = 0; j < 4; ++j) { const int n = (lane >> 3) + 8 * j; const LAS float* s = scr + (8 * c) * 33 + n;
        v4u o; o.x = pk2(s[0 * 33], s[1 * 33]); o.y = pk2(s[2 * 33], s[3 * 33]); o.z = pk2(s[4 * 33], s[5 * 33]); o.w = pk2(s[6 * 33], s[7 * 33]);
        *(GAS v4u*)(WT + (size_t)(row_off + n0 + n) * K + k0 + 8 * c) = o; }
    LDS_WAIT(); asm volatile("" ::: "memory");
}
struct Args { const float* in[27]; float* out; unsigned char* ws; int seq_lo, seq_hi; };
__device__ __forceinline__ const float* inp(int i) { const char* ka = (const char*)__builtin_amdgcn_kernarg_segment_ptr(); int off = i * 8; asm volatile("" : "+s"(off)); return *(const float* const*)(ka + off); }
__device__ __forceinline__ unsigned char* wsb() { const char* ka = (const char*)__builtin_amdgcn_kernarg_segment_ptr(); int off = 27 * 8 + 8; asm volatile("" : "+s"(off)); return *(unsigned char* const*)(ka + off); }
__device__ __forceinline__ float* outb() { const char* ka = (const char*)__builtin_amdgcn_kernarg_segment_ptr(); int off = 27 * 8; asm volatile("" : "+s"(off)); return *(float* const*)(ka + off); }
enum { I_X = 0, I_C, I_CTX, I_CCTX, I_WMOD, I_BMOD, I_G1, I_G2, I_WIN, I_HCW, I_HCB, I_FW1, I_FB1, I_FW2, I_FB2, I_FW3, I_FFQ, I_HBIAS, I_RDEC, I_RPB, I_WBR, I_WOUT, I_FFW1, I_FFCW, I_FFCB, I_FFW2, I_GF };

__device__ __forceinline__ void ph_prologue(const Args& A, LAS unsigned char* lds, int tid) {
    LAS float* sc = (LAS float*)lds;
    LAS float* red = sc + 5 * 2048;
    const float* c = inp(I_C); const float* cc = inp(I_CCTX);
    for (int i = tid; i < 5 * 2048; i += 512) { const int r = i >> 11, k = i & 2047; const float v = (r < 4) ? c[r * 2048 + k] : cc[k]; sc[i] = v / (1.0f + __expf(-v)); }
    __syncthreads();
    float* mod = (float*)(wsb() + WS_MOD);
    const int kq = tid >> 6, col = tid & 63;
    for (int u = blockIdx.x; u < DEPTH * 192; u += gridDim.x) {
        const int l = u / 192, n0 = (u % 192) * 64;
        const float* W = inp(I_WMOD) + (size_t)l * 2048 * 12288 + n0 + col;
        float a0 = 0.f, a1 = 0.f, a2 = 0.f, a3 = 0.f, a4 = 0.f;
        for (int k = kq * 256; k < kq * 256 + 256; ++k) { const float w = W[(size_t)k * 12288];
            a0 += sc[k] * w; a1 += sc[2048 + k] * w; a2 += sc[4096 + k] * w; a3 += sc[6144 + k] * w; a4 += sc[8192 + k] * w; }
        red[(kq * 5 + 0) * 64 + col] = a0; red[(kq * 5 + 1) * 64 + col] = a1; red[(kq * 5 + 2) * 64 + col] = a2; red[(kq * 5 + 3) * 64 + col] = a3; red[(kq * 5 + 4) * 64 + col] = a4;
        __syncthreads();
        if (tid < 320) { const int r = tid >> 6; float s = inp(I_BMOD)[l * 12288 + n0 + col];
#pragma unroll
            for (int q = 0; q < 8; ++q) s += red[(q * 5 + r) * 64 + col];
            mod[((size_t)l * 5 + r) * 12288 + n0 + col] = s; }
        __syncthreads();
    }
    if (blockIdx.x == 0) { f32x2* rope = (f32x2*)(wsb() + WS_ROPE);
        for (int i = tid; i < 1024; i += 512) { const int pos = i >> 4, j = i & 15; const float inv = exp2f(-(float)j * (13.287712379549449f / 16.0f));
            const float rev = (float)pos * inv * 0.15915494309189535f; rope[i] = (f32x2){cos_rev(rev), sin_rev(rev)}; } }
}

__device__ __forceinline__ void ph_convert(const Args& A, int l, LAS unsigned char* lds, int wave, int lane) {
    LAS float* scr = (LAS float*)(lds + wave * 16384);
    const int gw = blockIdx.x * NWAVES + wave, NGW = gridDim.x * NWAVES;
    constexpr int I_IN = (D / 64) * (INW / 32), I_BR = (1024 / 64) * (D / 32), I_OUT = (D / 64) * (D / 32), I_F1 = (D / 64) * (NFF / 32), I_F2 = (DFF / 64) * (D / 32);
    constexpr int NITEMS = I_IN + 3 * I_BR + I_OUT + I_F1 + I_F2;
    const float* win = inp(I_WIN) + (size_t)l * D * INW; const float* wbr = inp(I_WBR) + (size_t)l * 3 * 1024 * D; const float* wout = inp(I_WOUT) + (size_t)l * D * D;
    const float* wf1 = inp(I_FFW1) + (size_t)l * D * NFF; const float* wf2 = inp(I_FFW2) + (size_t)l * DFF * D;
    bf16* WIN = (bf16*)(wsb() + WS_WIN); bf16* WBR = (bf16*)(wsb() + WS_WBR); bf16* WOUT = (bf16*)(wsb() + WS_WOUT); bf16* WF1 = (bf16*)(wsb() + WS_WF1); bf16* WF2 = (bf16*)(wsb() + WS_WF2);
    for (int it = gw; it < NITEMS; it += NGW) {
        int r = it;
        if (r < I_IN) { p0_transpose_item(win, D, INW, WIN, 0, scr, r, lane); continue; } r -= I_IN;
        if (r < I_BR) { p0_transpose_item(wbr, 1024, D, WBR, 0, scr, r, lane); continue; } r -= I_BR;
        if (r < I_BR) { p0_transpose_item(wbr + (size_t)1024 * D, 1024, D, WBR + (size_t)D * 1024, 0, scr, r, lane); continue; } r -= I_BR;
        if (r < I_BR) { p0_transpose_item(wbr + (size_t)2 * 1024 * D, 1024, D, WBR + (size_t)2 * D * 1024, 0, scr, r, lane); continue; } r -= I_BR;
        if (r < I_OUT) { p0_transpose_item(wout, D, D, WOUT, 0, scr, r, lane); continue; } r -= I_OUT;
        if (r < I_F1) { p0_transpose_item(wf1, D, NFF, WF1, 0, scr, r, lane); continue; } r -= I_F1;
        p0_transpose_item(wf2, DFF, D, WF2, 0, scr, r, lane);
    }
}
__device__ __forceinline__ void ph_filt1(const Args& A, int l, LAS unsigned char* lds, int tid) {
    LAS float* feat = (LAS float*)lds;
    LAS float* h1 = feat + 8 * 33;
    const float* w1 = inp(I_FW1) + (size_t)l * 33 * 64; const float* b1 = inp(I_FB1) + l * 64; const float* w2 = inp(I_FW2) + (size_t)l * 64 * 64; const float* b2 = inp(I_FB2) + l * 64;
    const float* fq = inp(I_FFQ) + l * 64; float* FH2 = (float*)(wsb() + WS_FH2);
    const int pl = tid >> 6, o = tid & 63;
    for (int u = blockIdx.x; u < 544; u += gridDim.x) {
        const int pos = u * 8 + pl; const bool isc = pos >= 4096; const int Lf = isc ? 256 : 4096, tp = isc ? pos - 4096 : pos;
        if (o < 33) { float f;
            if (o == 0) f = (float)tp / (float)(Lf - 1);
            else { const int i = (o - 1) & 15; const float fr = 1e-4f + (float)i * ((15.0f - 1e-4f) / 15.0f); const float rev = fr * (float)tp / (float)Lf; f = (o <= 16) ? cos_rev(rev) : -sin_rev(rev); }
            feat[pl * 33 + o] = f; }
        __syncthreads();
        float a = b1[o];
#pragma unroll 3
        for (int i = 0; i < 33; ++i) a += feat[pl * 33 + i] * w1[i * 64 + o];
        h1[pl * 64 + o] = sin_rad(fq[o] * a);
        __syncthreads();
        float b = b2[o];
#pragma unroll 4
        for (int j = 0; j < 64; ++j) b += h1[pl * 64 + j] * w2[j * 64 + o];
        FH2[(size_t)pos * 64 + o] = sin_rad(fq[o] * b);
        __syncthreads();
    }
}
__device__ __forceinline__ void ph_norm(const float* xlat, const float* xctx, const float* g, const float* modl, int sh_off, int sc_off, bf16* H, int Mrows, int wave, int lane) {
    const int gw = blockIdx.x * NWAVES + wave, NGW = gridDim.x * NWAVES;
    for (int m = gw; m < Mrows; m += NGW) {
        const float* xr; int r;
        if (m < ML) { xr = xlat + (size_t)m * D; r = m >> 12; } else { xr = xctx + (size_t)(m - ML) * D; r = 4; }
        const float* mv = modl + (size_t)r * 12288;
        f32x4 v[8]; float ss = 0.f;
#pragma unroll
        for (int j = 0; j < 8; ++j) { v[j] = *(const f32x4*)(xr + (lane + 64 * j) * 4); ss += (v[j].x * v[j].x + v[j].y * v[j].y) + (v[j].z * v[j].z + v[j].w * v[j].w); }
        const float rstd = 1.0f / sqrtf(wave_sum(ss) * (1.0f / D) + EPS);
#pragma unroll
        for (int j = 0; j < 8; ++j) { const int idx = (lane + 64 * j) * 4;
            const f32x4 gg = *(const f32x4*)(g + idx), sh = *(const f32x4*)(mv + sh_off + idx), sc = *(const f32x4*)(mv + sc_off + idx);
            const f32x4 y = v[j] * rstd * gg * (sc + 1.0f) + sh;
            v2u w; w.x = pk2(y.x, y.y); w.y = pk2(y.z, y.w);
            *(v2u*)(H + (size_t)m * D + idx) = w; }
    }
}

__device__ __forceinline__ int fphys(int i) { return i + 2 * (i >> 5); }
__device__ __forceinline__ void bfly_dif(f32x2& a, f32x2& b, float c, float s) { const f32x2 u = a, v = b; a = u + v; const float dx = u.x - v.x, dy = u.y - v.y; b = (f32x2){dx * c + dy * s, dy * c - dx * s}; }
__device__ __forceinline__ void bfly_idit(f32x2& a, f32x2& b, float c, float s) { const f32x2 u = a, q = b; const f32x2 v = (f32x2){q.x * c - q.y * s, q.x * s + q.y * c}; a = u + v; b = u - v; }
template <bool ZHI> __device__ __forceinline__ void dif16(f32x2 (&x)[16], float th) {
    asm volatile("" : "+v"(th));
#pragma unroll
    for (int k = 0; k < 8; ++k) { const float fr = th + (float)k * 0.0625f; const float c = __builtin_amdgcn_cosf(fr), s = __builtin_amdgcn_sinf(fr);
        if (ZHI) { const f32x2 u = x[k]; x[k + 8] = (f32x2){u.x * c + u.y * s, u.y * c - u.x * s}; } else bfly_dif(x[k], x[k + 8], c, s); }
#pragma unroll
    for (int k = 0; k < 4; ++k) { const float fr = 2.0f * th + (float)k * 0.125f; const float c = __builtin_amdgcn_cosf(fr), s = __builtin_amdgcn_sinf(fr);
        bfly_dif(x[k], x[k + 4], c, s); bfly_dif(x[8 + k], x[12 + k], c, s); }
#pragma unroll
    for (int k = 0; k < 2; ++k) { const float fr = 4.0f * th + (float)k * 0.25f; const float c = __builtin_amdgcn_cosf(fr), s = __builtin_amdgcn_sinf(fr);
#pragma unroll
        for (int b = 0; b < 16; b += 4) bfly_dif(x[b + k], x[b + k + 2], c, s); }
    { const float fr = 8.0f * th; const float c = __builtin_amdgcn_cosf(fr), s = __builtin_amdgcn_sinf(fr);
#pragma unroll
        for (int b = 0; b < 16; b += 2) bfly_dif(x[b], x[b + 1], c, s); }
}
__device__ __forceinline__ void idit16(f32x2 (&x)[16], float th) {
    asm volatile("" : "+v"(th));
    { const float fr = 8.0f * th; const float c = __builtin_amdgcn_cosf(fr), s = __builtin_amdgcn_sinf(fr);
#pragma unroll
        for (int b = 0; b < 16; b += 2) bfly_idit(x[b], x[b + 1], c, s); }
#pragma unroll
    for (int k = 0; k < 2; ++k) { const float fr = 4.0f * th + (float)k * 0.25f; const float c = __builtin_amdgcn_cosf(fr), s = __builtin_amdgcn_sinf(fr);
#pragma unroll
        for (int b = 0; b < 16; b += 4) bfly_idit(x[b + k], x[b + k + 2], c, s); }
#pragma unroll
    for (int k = 0; k < 4; ++k) { const float fr = 2.0f * th + (float)k * 0.125f; const float c = __builtin_amdgcn_cosf(fr), s = __builtin_amdgcn_sinf(fr);
        bfly_idit(x[k], x[k + 4], c, s); bfly_idit(x[8 + k], x[12 + k], c, s); }
#pragma unroll
    for (int k = 0; k < 8; ++k) { const float fr = th + (float)k * 0.0625f; const float c = __builtin_amdgcn_cosf(fr), s = __builtin_amdgcn_sinf(fr); bfly_idit(x[k], x[k + 8], c, s); }
}
template <bool INV> __device__ __forceinline__ void fft_pass(LAS f32x2* buf, int base, int stride, float th) {
    f32x2 x[16];
#pragma unroll
    for (int k = 0; k < 16; ++k) x[k] = buf[fphys(base + k * stride)];
    if (INV) idit16(x, th); else dif16<false>(x, th);
#pragma unroll
    for (int k = 0; k < 16; ++k) buf[fphys(base + k * stride)] = x[k];
}
constexpr int FFT_LDS_BYTES = (8192 + 512 + 8) * 8;
__device__ __forceinline__ float block_sum(float v, LAS float* red, int tid) {
    v = wave_sum(v);
    __syncthreads();
    if ((tid & 63) == 0) red[tid >> 6] = v;
    __syncthreads();
    float s = 0.f;
#pragma unroll
    for (int i = 0; i < 8; ++i) s += red[i];
    return s;
}
__device__ __forceinline__ float hy_delta(int c) { const float d0 = -4.605170185988091f / 0.3f, d1 = -4.605170185988091f / 1.5f; return fabsf(d0 + (d1 - d0) * ((float)c / 1023.0f)); }
__device__ __forceinline__ void ph_filt2(const Args& A, int l, LAS unsigned char* lds, int tid) {
    LAS f32x2* buf = (LAS f32x2*)lds; LAS float* red = (LAS float*)(lds + FFT_LDS_BYTES + 64); LAS float* w3s = red + 32;
    const float* w3 = inp(I_FW3) + (size_t)l * 64 * 4096; const float* FH2 = (const float*)(wsb() + WS_FH2);
    f32x2* KF = (f32x2*)(wsb() + WS_KF); float* TAPC = (float*)(wsb() + WS_TAPC);
    for (int c = blockIdx.x; c < 1024; c += gridDim.x) {
        __syncthreads();
        if (tid < 256) w3s[tid] = w3[(size_t)(tid & 63) * 4096 + (tid >> 7) * 2048 + ((tid >> 6) & 1) * 1024 + c];
        __syncthreads();
        const float delta = hy_delta(c); float ssq0 = 0.f, ssq1 = 0.f;
#pragma nounroll
        for (int i = 0; i < 8; ++i) { const int t = tid + 512 * i; const f32x4* row = (const f32x4*)(FH2 + (size_t)t * 64); float a0 = 0.f, a1 = 0.f, a2 = 0.f, a3 = 0.f;
#pragma unroll 4
            for (int j4 = 0; j4 < 16; ++j4) { const f32x4 hv = row[j4];
                a0 += hv.x * w3s[4 * j4] + hv.y * w3s[4 * j4 + 1] + hv.z * w3s[4 * j4 + 2] + hv.w * w3s[4 * j4 + 3];
                a1 += hv.x * w3s[64 + 4 * j4] + hv.y * w3s[64 + 4 * j4 + 1] + hv.z * w3s[64 + 4 * j4 + 2] + hv.w * w3s[64 + 4 * j4 + 3];
                a2 += hv.x * w3s[128 + 4 * j4] + hv.y * w3s[128 + 4 * j4 + 1] + hv.z * w3s[128 + 4 * j4 + 2] + hv.w * w3s[128 + 4 * j4 + 3];
                a3 += hv.x * w3s[192 + 4 * j4] + hv.y * w3s[192 + 4 * j4 + 1] + hv.z * w3s[192 + 4 * j4 + 2] + hv.w * w3s[192 + 4 * j4 + 3]; }
            const float dec = __expf(-((float)t / 4095.0f) * delta); const float f0 = a0 * dec, b0 = a1 * dec, f1 = a2 * dec, b1 = a3 * dec;
            buf[fphys(t)] = (f32x2){f0, f1}; ssq0 += f0 * f0; ssq1 += f1 * f1;
            if (t >= 1) { buf[fphys(8192 - t)] = (f32x2){b0, b1}; ssq0 += b0 * b0; ssq1 += b1 * b1; } else buf[fphys(4096)] = (f32x2){0.f, 0.f}; }
        const float scl0 = (1.0f / 8192.0f) / sqrtf(block_sum(ssq0, red, tid) + EPS), scl1 = (1.0f / 8192.0f) / sqrtf(block_sum(ssq1, red, tid) + EPS);
        __syncthreads();
        fft_pass<false>(buf, tid, 512, (float)tid * (1.0f / 8192.0f));
        __syncthreads();
        fft_pass<false>(buf, (tid >> 5) * 512 + (tid & 31), 32, (float)(tid & 31) * (1.0f / 512.0f));
        __syncthreads();
        fft_pass<false>(buf, (tid >> 1) * 32 + (tid & 1), 2, (float)(tid & 1) * (1.0f / 32.0f));
        __syncthreads();
#pragma unroll
        for (int r = 0; r < 8; ++r) { LAS f32x4* pp = (LAS f32x4*)(buf + fphys(2 * (tid + 512 * r))); const f32x4 ab = *pp; *pp = (f32x4){ab.x + ab.z, ab.y + ab.w, ab.x - ab.z, ab.y - ab.w}; }
        __syncthreads();
        f32x2* d0 = KF + (size_t)c * 8192; f32x2* d1 = KF + (size_t)(1024 + c) * 8192;
#pragma unroll 4
        for (int i = 0; i < 16; ++i) { const int p = tid + 512 * i; const int f = (int)(__brev((unsigned)p) >> 19); const int pp = (int)(__brev((unsigned)((8192 - f) & 8191)) >> 19);
            const f32x2 z = buf[fphys(p)], zp = buf[fphys(pp)];
            d0[p] = (f32x2){(z.x + zp.x) * 0.5f * scl0, (z.y - zp.y) * 0.5f * scl0};
            d1[p] = (f32x2){(z.y + zp.y) * 0.5f * scl1, (zp.x - z.x) * 0.5f * scl1}; }
        { const int dir = tid >> 8, m = tid & 255; const f32x4* row = (const f32x4*)(FH2 + (size_t)(4096 + m) * 64); float a0 = 0.f, a1 = 0.f;
#pragma unroll 4
            for (int j4 = 0; j4 < 16; ++j4) { const f32x4 hv = row[j4];
                a0 += hv.x * w3s[dir * 64 + 4 * j4] + hv.y * w3s[dir * 64 + 4 * j4 + 1] + hv.z * w3s[dir * 64 + 4 * j4 + 2] + hv.w * w3s[dir * 64 + 4 * j4 + 3];
                a1 += hv.x * w3s[128 + dir * 64 + 4 * j4] + hv.y * w3s[128 + dir * 64 + 4 * j4 + 1] + hv.z * w3s[128 + dir * 64 + 4 * j4 + 2] + hv.w * w3s[128 + dir * 64 + 4 * j4 + 3]; }
            const float dec = __expf(-((float)m / 255.0f) * delta); const float v0 = a0 * dec, v1 = a1 * dec; const bool cnt = (dir == 0) || (m >= 1);
            const float t0 = block_sum(cnt ? v0 * v0 : 0.f, red, tid), t1 = block_sum(cnt ? v1 * v1 : 0.f, red, tid);
            TAPC[((size_t)(0 * 2 + dir) * 1024 + c) * 256 + m] = v0 / sqrtf(t0 + EPS);
            TAPC[((size_t)(1 * 2 + dir) * 1024 + c) * 256 + m] = v1 / sqrtf(t1 + EPS); }
    }
}

__device__ __forceinline__ void ph_hyprep(const Args& A, int l, LAS unsigned char* lds, int tid) {
    LAS bf16* T = (LAS bf16*)lds;
    const bf16* Z = (const bf16*)(wsb() + WS_Z); bf16* HYT = (bf16*)(wsb() + WS_HYT);
    const float* cw = inp(I_HCW) + (size_t)l * 3 * 3072; const float* cb = inp(I_HCB) + (size_t)l * 3072;
    for (int u = blockIdx.x; u < 3072; u += gridDim.x) {
        const int cg = u % 12, tt = (u / 12) & 63, b = u / 768;
        __syncthreads();
        for (int q = tid; q < 66 * 32; q += 512) { const int r = q >> 5, ch8 = q & 31, t = tt * 64 - 1 + r;
            v4u v = (v4u){0u, 0u, 0u, 0u};
            if (t >= 0 && t < SEQ) v = *(const v4u*)(Z + (size_t)(b * SEQ + t) * INW + C_HY + cg * 256 + ch8 * 8);
            *(LAS v4u*)(T + r * 264 + ch8 * 8) = v; }
        __syncthreads();
        const int ch = tid & 255, half = tid >> 8, gch = cg * 256 + ch;
        const float w0 = cw[gch], w1 = cw[3072 + gch], w2 = cw[6144 + gch], bb = cb[gch];
        const int part = gch >> 10, c = gch & 1023;
        bf16* outp = HYT + ((size_t)(part * NB + b) * 1024 + c) * SEQ + tt * 64 + half * 32;
#pragma unroll
        for (int tq = 0; tq < 4; ++tq) { float vv[8];
#pragma unroll
            for (int e = 0; e < 8; ++e) { const int tl = half * 32 + tq * 8 + e;
                vv[e] = w0 * bf1(T[tl * 264 + ch]) + w1 * bf1(T[(tl + 1) * 264 + ch]) + w2 * bf1(T[(tl + 2) * 264 + ch]) + bb; }
            v4u w; w.x = pk2(vv[0], vv[1]); w.y = pk2(vv[2], vv[3]); w.z = pk2(vv[4], vv[5]); w.w = pk2(vv[6], vv[7]);
            *(v4u*)(outp + tq * 8) = w; }
    }
}
__device__ __forceinline__ void ph_hyctx(const Args& A, int l, LAS unsigned char* lds, int tid) {
    const bf16* Z = (const bf16*)(wsb() + WS_Z); bf16* YS = (bf16*)(wsb() + WS_YS); const float* TAPC = (const float*)(wsb() + WS_TAPC);
    const float* cw = inp(I_HCW) + (size_t)l * 3 * 3072; const float* cb = inp(I_HCB) + (size_t)l * 3072; const float* hb = inp(I_HBIAS) + (size_t)l * 2 * 1024;
    const int ch = tid >> 6, q = tid & 63, t0 = 4 * q;
    LAS float* Y = (LAS float*)lds + ch * 1552; LAS float* Y1 = Y + 256; LAS float* G0 = Y + 512; LAS float* G1 = Y + 1032;
    for (int u = blockIdx.x; u < 512; u += gridDim.x) {
        const int b = u >> 7, c = (u & 127) * 8 + ch;
        __syncthreads();
        float pv[3][4];
#pragma unroll
        for (int part = 0; part < 3; ++part) { const int gch = part * 1024 + c; const float w0 = cw[gch], w1 = cw[3072 + gch], w2 = cw[6144 + gch], bb = cb[gch];
            const bf16* zp = Z + (size_t)(ML + b * CL + t0) * INW + C_HY + gch;
            float zz[6];
#pragma unroll
            for (int e = 0; e < 6; ++e) { const int t = t0 - 1 + e; zz[e] = (t >= 0 && t < CL) ? bf1(zp[(ptrdiff_t)(e - 1) * INW]) : 0.f; }
#pragma unroll
            for (int r = 0; r < 4; ++r) pv[part][r] = w0 * zz[r] + w1 * zz[r + 1] + w2 * zz[r + 2] + bb; }
        *(LAS f32x4*)(Y + t0) = (f32x4){pv[2][0], pv[2][1], pv[2][2], pv[2][3]};
#pragma unroll
        for (int r = 0; r < 4; ++r) { const int m = t0 + r;
            G0[m + 259] = TAPC[((size_t)(0 * 2 + 0) * 1024 + c) * 256 + m]; G1[m + 259] = TAPC[((size_t)(1 * 2 + 0) * 1024 + c) * 256 + m];
            if (m >= 1) { G0[259 - m] = TAPC[((size_t)(0 * 2 + 1) * 1024 + c) * 256 + m]; G1[259 - m] = TAPC[((size_t)(1 * 2 + 1) * 1024 + c) * 256 + m]; } }
        if (q == 0) { G0[515] = 0.f; G1[515] = 0.f; G0[516] = 0.f; G1[516] = 0.f; }
        __syncthreads();
        float yprev[4] = {pv[2][0], pv[2][1], pv[2][2], pv[2][3]};
#pragma unroll
        for (int ord = 0; ord < 2; ++ord) {
            const LAS float* Ys = ord ? Y1 : Y; const LAS float* G = ord ? G1 : G0;
            float acc[4] = {0.f, 0.f, 0.f, 0.f};
#pragma unroll 4
            for (int sp = 0; sp < 64; ++sp) { const f32x4 yv = *(const LAS f32x4*)(Ys + 4 * sp); const LAS float* gp = G + 4 * (q - sp) + 256;
                const f32x4 ga = *(const LAS f32x4*)gp, gb = *(const LAS f32x4*)(gp + 4);
                const float g[8] = {ga.x, ga.y, ga.z, ga.w, gb.x, gb.y, gb.z, gb.w}; const float yy[4] = {yv.x, yv.y, yv.z, yv.w};
#pragma unroll
                for (int r = 0; r < 4; ++r)
#pragma unroll
                    for (int j = 0; j < 4; ++j) acc[r] += yy[j] * g[r - j + 3]; }
            const float bias = hb[ord * 1024 + c];
#pragma unroll
            for (int r = 0; r < 4; ++r) yprev[r] = pv[ord][r] * (acc[r] + bias * yprev[r]);
            if (ord == 0) { *(LAS f32x4*)(Y1 + t0) = (f32x4){yprev[0], yprev[1], yprev[2], yprev[3]}; __syncthreads(); }
        }
#pragma unroll
        for (int r = 0; r < 4; ++r) YS[(size_t)(ML + b * CL + t0 + r) * 1024 + c] = (bf16)f2bf(yprev[r]);
    }
}
__device__ __forceinline__ void unpack8(v4u v, float (&x)[8]) { x[0] = bflo(v.x); x[1] = bfhi(v.x); x[2] = bflo(v.y); x[3] = bfhi(v.y); x[4] = bflo(v.z); x[5] = bfhi(v.z); x[6] = bflo(v.w); x[7] = bfhi(v.w); }
__device__ __forceinline__ v4u pack8(const float (&x)[8]) { v4u w; w.x = pk2(x[0], x[1]); w.y = pk2(x[2], x[3]); w.z = pk2(x[4], x[5]); w.w = pk2(x[6], x[7]); return w; }
__device__ __forceinline__ void rope8(float (&lo)[8], float (&hi)[8], const f32x2* rt) {
#pragma unroll
    for (int e = 0; e < 8; ++e) { const f32x2 cs = rt[e]; const float a = lo[e], b = hi[e]; lo[e] = a * cs.x - b * cs.y; hi[e] = b * cs.x + a * cs.y; }
}
__device__ __forceinline__ void vt_store(LAS bf16* Vt, int ld, int d0, int r, v4u vv) {
    Vt[(d0 + 0) * ld + r] = (bf16)(vv.x & 0xffffu); Vt[(d0 + 1) * ld + r] = (bf16)(vv.x >> 16);
    Vt[(d0 + 2) * ld + r] = (bf16)(vv.y & 0xffffu); Vt[(d0 + 3) * ld + r] = (bf16)(vv.y >> 16);
    Vt[(d0 + 4) * ld + r] = (bf16)(vv.z & 0xffffu); Vt[(d0 + 5) * ld + r] = (bf16)(vv.z >> 16);
    Vt[(d0 + 6) * ld + r] = (bf16)(vv.w & 0xffffu); Vt[(d0 + 7) * ld + r] = (bf16)(vv.w >> 16);
}
constexpr float LOG2E = 1.4426950408889634f;
__device__ __forceinline__ void ph_ret1(const Args& A, int l, int nctx_units, LAS unsigned char* lds, int tid) {
    LAS bf16* KfT = (LAS bf16*)lds; LAS bf16* KbT = KfT + 64 * 136; LAS bf16* Vt = KbT + 64 * 136;
    const bf16* Z = (const bf16*)(wsb() + WS_Z); float* KV = (float*)(wsb() + WS_KV); const f32x2* rope = (const f32x2*)(wsb() + WS_ROPE);
    const int lane = tid & 63, w = tid >> 6, g = lane >> 4, li = lane & 15;
    for (int uid = blockIdx.x; uid < 1024 + nctx_units; uid += gridDim.x) {
        const bool isc = uid >= 1024; int b, h, n, ci; size_t m0;
        if (!isc) { b = uid >> 8; h = (uid >> 5) & 7; n = uid & 31; m0 = (size_t)b * SEQ + n * 128; ci = 2 + n; }
        else { const int i = uid - 1024; b = i >> 4; h = (i >> 1) & 7; n = i & 1; m0 = (size_t)ML + b * CL + n * 128; ci = n; }
        const float lgf = inp(I_RDEC)[(l * 2 + 0) * 8 + h] * LOG2E, lgb = inp(I_RDEC)[(l * 2 + 1) * 8 + h] * LOG2E;
        __syncthreads();
        { const int tok = tid >> 2, pp = tid & 3, a = (pp & 1) + ((pp >> 1) << 2);
            const bf16* kr = Z + (m0 + tok) * INW + C_RK + h * 64;
            float lo[8], hi[8]; unpack8(*(const v4u*)(kr + 8 * a), lo); unpack8(*(const v4u*)(kr + 8 * a + 16), hi);
            if (!isc) { const int t = n * 128 + tok; const int pos = (a < 4) ? (t >> 6) : (t & 63); rope8(lo, hi, rope + pos * 16 + 8 * (a & 1)); }
            const float zf = ex2(lgf * (float)(127 - tok)) * 0.125f, zb = ex2(lgb * (float)tok) * 0.125f;
#pragma unroll
            for (int e = 0; e < 8; ++e) { const int d = 8 * a + e;
                KfT[d * 136 + tok] = (bf16)f2bf(lo[e] * zf); KbT[d * 136 + tok] = (bf16)f2bf(lo[e] * zb);
                KfT[(d + 16) * 136 + tok] = (bf16)f2bf(hi[e] * zf); KbT[(d + 16) * 136 + tok] = (bf16)f2bf(hi[e] * zb); } }
        for (int q = tid; q < 2048; q += 512) { const int r = q >> 4, ch = q & 15; vt_store(Vt, 136, ch * 8, r, *(const v4u*)(Z + (m0 + r) * INW + C_RV + h * 128 + ch * 8)); }
        __syncthreads();
        bf16x8 af[4];
#pragma unroll
        for (int ks = 0; ks < 4; ++ks) af[ks] = *(const LAS bf16x8*)(Vt + (16 * w + li) * 136 + 32 * ks + 8 * g);
#pragma unroll
        for (int dir = 0; dir < 2; ++dir) { const LAS bf16* KT = dir ? KbT : KfT;
            float* dst = KV + ((size_t)((b * 8 + h) * 2 + dir) * 34 + ci) * 8192;
#pragma unroll
            for (int nc = 0; nc < 4; ++nc) { f32x4 acc = (f32x4){0.f, 0.f, 0.f, 0.f};
#pragma unroll
                for (int ks = 0; ks < 4; ++ks) acc = mfma16(af[ks], *(const LAS bf16x8*)(KT + (16 * nc + li) * 136 + 32 * ks + 8 * g), acc);
#pragma unroll
                for (int j = 0; j < 4; ++j) dst[(16 * w + 4 * g + j) * 64 + 16 * nc + li] = acc[j]; } }
    }
}
__device__ __forceinline__ void ph_natt(const Args& A, int l, int nctx_units, LAS unsigned char* lds, int tid) {
    LAS bf16* Qs = (LAS bf16*)lds; LAS bf16* KV0 = Qs + 128 * 136; LAS float* rpbs = (LAS float*)(KV0 + 2 * (64 * 136 + 128 * 68));
    const bf16* Z = (const bf16*)(wsb() + WS_Z); bf16* YS = (bf16*)(wsb() + WS_YS) + (size_t)2 * MT * 1024;
    const int lane = tid & 63, w = tid >> 6, g = lane >> 4, li = lane & 15;
    const float SCALE = 0.08838834764831845f;
    const int sr0 = tid >> 4, sch = tid & 15;
    for (int uid = blockIdx.x; uid < 1024 + nctx_units; uid += gridDim.x) {
        const bool isc = uid >= 1024; int b, h, rp = 0; size_t m0;
        if (!isc) { b = uid >> 8; h = (uid >> 5) & 7; rp = uid & 31; m0 = (size_t)b * SEQ + rp * 128; }
        else { const int i = uid - 1024; b = i >> 4; h = (i >> 1) & 7; m0 = (size_t)ML + b * CL + (i & 1) * 128; }
        const size_t mc0 = (size_t)ML + b * CL;
        const int qr = 2 * rp + (w >> 2), cw = w & 3, qc = 16 * cw + li;
        const int cs = min(max(qc - 8, 0), 48), rs_w = min(max(qr - 4, 0), 56);
        const int kr_lo = min(max(2 * rp - 4, 0), 56), kr_hi = min(max(2 * rp - 3, 0), 56) + 7;
        const int nwin = isc ? 0 : (kr_hi - kr_lo + 1), ntile = nwin + 4;
        const int nlo_w = (cw <= 1) ? 0 : cw - 1, nhi_w = (cw == 0) ? 1 : ((cw == 3) ? 3 : cw + 1);
        v4u kreg[2], vreg[2];
#define NA_LOAD(t_) do { const int t__ = (t_); const size_t mk = (t__ < nwin) ? ((size_t)b * SEQ + (kr_lo + t__) * 64) : (mc0 + (t__ - nwin) * 64); \
            _Pragma("unroll") for (int e = 0; e < 2; ++e) { const bf16* zr = Z + (mk + sr0 + 32 * e) * INW + h * 128 + sch * 8; kreg[e] = *(const v4u*)(zr + C_NK); vreg[e] = *(const v4u*)(zr + C_NV); } } while (0)
#define NA_STORE(buf_) do { LAS bf16* Kd = KV0 + (buf_) * (64 * 136 + 128 * 68); LAS bf16* Vd = Kd + 64 * 136; \
            _Pragma("unroll") for (int e = 0; e < 2; ++e) { *(LAS v4u*)(Kd + (sr0 + 32 * e) * 136 + sch * 8) = kreg[e]; vt_store(Vd, 68, sch * 8, sr0 + 32 * e, vreg[e]); } } while (0)
        __syncthreads();
        NA_LOAD(0);
        for (int q = tid; q < 2048; q += 512) { const int r = q >> 4, chn = q & 15; *(LAS v4u*)(Qs + r * 136 + chn * 8) = *(const v4u*)(Z + (m0 + r) * INW + C_NQ + h * 128 + chn * 8); }
        if (!isc) for (int i = tid; i < 465; i += 512) rpbs[i] = inp(I_RPB)[((size_t)l * 8 + h) * 465 + i];
        NA_STORE(0);
        __syncthreads();
        bf16x8 qf[4];
#pragma unroll
        for (int ks = 0; ks < 4; ++ks) qf[ks] = *(const LAS bf16x8*)(Qs + (16 * w + li) * 136 + 32 * ks + 8 * g);
        f32x4 o[8];
#pragma unroll
        for (int nd = 0; nd < 8; ++nd) o[nd] = (f32x4){0.f, 0.f, 0.f, 0.f};
        float mrun = -1e30f, lrun = 0.f;
        for (int t = 0; t < ntile; ++t) {
            const bool win = t < nwin; const int kr = kr_lo + t;
            if (t + 1 < ntile) NA_LOAD(t + 1);
            const LAS bf16* Ks = KV0 + (t & 1) * (64 * 136 + 128 * 68); const LAS bf16* Vt = Ks + 64 * 136;
            const bool active = !win || (kr >= rs_w && kr <= rs_w + 7);
            if (active) {
                const int nlo = win ? nlo_w : 0, nhi = win ? nhi_w : 3;
                f32x4 s[4];
#pragma unroll
                for (int n = 0; n < 4; ++n) { s[n] = (f32x4){0.f, 0.f, 0.f, 0.f};
                    if (n >= nlo && n <= nhi) {
#pragma unroll
                        for (int ks = 0; ks < 4; ++ks) s[n] = mfma16(*(const LAS bf16x8*)(Ks + (16 * n + li) * 136 + 32 * ks + 8 * g), qf[ks], s[n]); } }
                float tmax = -1e30f;
#pragma unroll
                for (int n = 0; n < 4; ++n)
#pragma unroll
                    for (int j = 0; j < 4; ++j) { float v = s[n][j] * SCALE;
                        if (win) { const int kc = 16 * n + 4 * g + j; const bool valid = (kc >= cs) && (kc < cs + 16);
                            const int dc = min(max(kc - qc + 15, 0), 30), dr = min(max(kr - qr + 7, 0), 14);
                            v = valid ? v + rpbs[dr * 31 + dc] : -1e30f; }
                        s[n][j] = v; tmax = fmaxf(tmax, v); }
                tmax = fmaxf(tmax, __shfl_xor(tmax, 16)); tmax = fmaxf(tmax, __shfl_xor(tmax, 32));
                const float mnew = fmaxf(mrun, tmax), alpha = __expf(mrun - mnew);
                float psum = 0.f;
#pragma unroll
                for (int n = 0; n < 4; ++n)
#pragma unroll
                    for (int j = 0; j < 4; ++j) { const float pv = __expf(s[n][j] - mnew); s[n][j] = pv; psum += pv; }
                psum += __shfl_xor(psum, 16); psum += __shfl_xor(psum, 32);
                lrun = lrun * alpha + psum; mrun = mnew;
#pragma unroll
                for (int nd = 0; nd < 8; ++nd) o[nd] = o[nd] * alpha;
#pragma unroll
                for (int kk = 0; kk < 2; ++kk) {
                    if (2 * kk + 1 >= nlo && 2 * kk <= nhi) {
                        const bf16x8 pf = mk8(pk2(s[2 * kk][0], s[2 * kk][1]), pk2(s[2 * kk][2], s[2 * kk][3]), pk2(s[2 * kk + 1][0], s[2 * kk + 1][1]), pk2(s[2 * kk + 1][2], s[2 * kk + 1][3]));
#pragma unroll
                        for (int nd = 0; nd < 8; ++nd) { const LAS bf16* vp = Vt + (16 * nd + li) * 68 + 32 * kk + 4 * g;
                            const v2u lo = *(const LAS v2u*)vp, hi = *(const LAS v2u*)(vp + 16);
                            o[nd] = mfma16(mk8(lo.x, lo.y, hi.x, hi.y), pf, o[nd]); } } }
            }
            if (t + 1 < ntile) NA_STORE((t + 1) & 1);
            __syncthreads();
        }
#undef NA_LOAD
#undef NA_STORE
        const float inv = 1.0f / lrun; const size_t mrow = m0 + 16 * w + li;
#pragma unroll
        for (int nd = 0; nd < 8; ++nd) { v2u wv; wv.x = pk2(o[nd][0] * inv, o[nd][1] * inv); wv.y = pk2(o[nd][2] * inv, o[nd][3] * inv);
            *(v2u*)(YS + mrow * 1024 + h * 128 + 16 * nd + 4 * g) = wv; }
    }
}

__device__ __forceinline__ void ph_hyfft(const Args& A, int l, LAS unsigned char* lds, int tid) {
    LAS f32x2* buf = (LAS f32x2*)lds;
    const bf16* HYT = (const bf16*)(wsb() + WS_HYT); bf16* YT = (bf16*)(wsb() + WS_YT); const f32x2* KF = (const f32x2*)(wsb() + WS_KF);
    const float* hb = inp(I_HBIAS) + (size_t)l * 2 * 1024;
    const int baseB = (tid >> 5) * 512 + (tid & 31), baseC = (tid >> 1) * 32 + (tid & 1);
    const float thA = (float)tid * (1.0f / 8192.0f), thB = (float)(tid & 31) * (1.0f / 512.0f), thC = (float)(tid & 1) * (1.0f / 32.0f);
    for (int u = blockIdx.x; u < 2048; u += gridDim.x) {
        const int c = u >> 1, b0 = (u & 1) * 2;
        const bf16* x1p = HYT + ((size_t)(0 * NB + b0) * 1024 + c) * SEQ; const bf16* x2p = HYT + ((size_t)(1 * NB + b0) * 1024 + c) * SEQ; const bf16* vp = HYT + ((size_t)(2 * NB + b0) * 1024 + c) * SEQ;
        const size_t bstr = (size_t)1024 * SEQ;
        float y0[8], y1[8];
#pragma unroll
        for (int i = 0; i < 8; ++i) { const int t = tid + 512 * i; y0[i] = bf1(vp[t]); y1[i] = bf1(vp[bstr + t]); }
#pragma unroll
        for (int ord = 0; ord < 2; ++ord) {
            { f32x2 x[16];
#pragma unroll
                for (int k = 0; k < 8; ++k) { x[k] = (f32x2){y0[k], y1[k]}; x[k + 8] = (f32x2){0.f, 0.f}; }
                dif16<true>(x, thA);
                __syncthreads();
#pragma unroll
                for (int k = 0; k < 16; ++k) buf[fphys(tid + 512 * k)] = x[k]; }
            __syncthreads();
            fft_pass<false>(buf, baseB, 32, thB);
            __syncthreads();
            fft_pass<false>(buf, baseC, 2, thC);
            __syncthreads();
            { const f32x4* kf = (const f32x4*)(KF + (size_t)(ord * 1024 + c) * 8192);
#pragma unroll
                for (int r = 0; r < 8; ++r) { const int i = tid + 512 * r; LAS f32x4* pp = (LAS f32x4*)(buf + fphys(2 * i)); const f32x4 ab = *pp; const f32x4 kk = kf[i];
                    const float ax = ab.x + ab.z, ay = ab.y + ab.w, bx = ab.x - ab.z, by = ab.y - ab.w;
                    const float px = ax * kk.x - ay * kk.y, py = ax * kk.y + ay * kk.x, qx = bx * kk.z - by * kk.w, qy = bx * kk.w + by * kk.z;
                    *pp = (f32x4){px + qx, py + qy, px - qx, py - qy}; } }
            __syncthreads();
            fft_pass<true>(buf, baseC, 2, thC);
            __syncthreads();
            fft_pass<true>(buf, baseB, 32, thB);
            __syncthreads();
            { f32x2 x[16];
#pragma unroll
                for (int k = 0; k < 16; ++k) x[k] = buf[fphys(tid + 512 * k)];
                idit16(x, thA);
                const bf16* xp = ord ? x2p : x1p; const float bias = hb[ord * 1024 + c];
#pragma unroll
                for (int k = 0; k < 8; ++k) { const int t = tid + 512 * k;
                    y0[k] = bf1(xp[t]) * (x[k].x + bias * y0[k]); y1[k] = bf1(xp[bstr + t]) * (x[k].y + bias * y1[k]); } }
        }
        bf16* o0 = YT + ((size_t)b0 * 1024 + c) * SEQ;
#pragma unroll
        for (int i = 0; i < 8; ++i) { const int t = tid + 512 * i; o0[t] = (bf16)f2bf(y0[i]); o0[bstr + t] = (bf16)f2bf(y1[i]); }
    }
}
__device__ __forceinline__ void ph_scan(const Args& A, int l, int tid) {
    float* KV = (float*)(wsb() + WS_KV);
    for (int gt = blockIdx.x * 512 + tid; gt < NB * 8 * 2 * 2048; gt += gridDim.x * 512) {
        const int bhd = gt >> 11, e4 = gt & 2047, dir = bhd & 1, h = (bhd >> 1) & 7;
        const float gC = ex2(inp(I_RDEC)[(l * 2 + dir) * 8 + h] * LOG2E * 128.0f);
        f32x4* base = (f32x4*)(KV + (size_t)bhd * 34 * 8192) + e4;
        f32x4 s = (f32x4){0.f, 0.f, 0.f, 0.f};
#pragma unroll 2
        for (int step = 0; step < 34; ++step) { const int ci = (dir == 0) ? step : (step == 0 ? 1 : (step == 1 ? 0 : 35 - step));
            const f32x4 tmp = base[(size_t)ci * 2048]; base[(size_t)ci * 2048] = s; s = s * gC + tmp; }
    }
}

__device__ __forceinline__ void ph_hypost(const Args& A, LAS unsigned char* lds, int tid) {
    LAS bf16* T = (LAS bf16*)lds;
    const bf16* YT = (const bf16*)(wsb() + WS_YT); bf16* YS = (bf16*)(wsb() + WS_YS);
    for (int u = blockIdx.x; u < 1024; u += gridDim.x) {
        const int cg = u & 3, tt = (u >> 2) & 63, b = u >> 8;
        __syncthreads();
        for (int q = tid; q < 2048; q += 512) { const int c = q >> 3, t8 = q & 7;
            *(LAS v4u*)(T + c * 72 + t8 * 8) = *(const v4u*)(YT + ((size_t)b * 1024 + cg * 256 + c) * SEQ + tt * 64 + t8 * 8); }
        __syncthreads();
        const int t = tid >> 3, c32 = tid & 7;
#pragma unroll
        for (int q = 0; q < 4; ++q) { const int cb = c32 * 32 + q * 8; v4u w;
            w.x = (unsigned)T[(cb + 0) * 72 + t] | ((unsigned)T[(cb + 1) * 72 + t] << 16); w.y = (unsigned)T[(cb + 2) * 72 + t] | ((unsigned)T[(cb + 3) * 72 + t] << 16);
            w.z = (unsigned)T[(cb + 4) * 72 + t] | ((unsigned)T[(cb + 5) * 72 + t] << 16); w.w = (unsigned)T[(cb + 6) * 72 + t] | ((unsigned)T[(cb + 7) * 72 + t] << 16);
            *(v4u*)(YS + (size_t)(b * SEQ + tt * 64 + t) * 1024 + cg * 256 + cb) = w; }
    }
}
__device__ __forceinline__ void ph_ret3(const Args& A, int l, int nctx_units, LAS unsigned char* lds, int tid) {
    LAS bf16* Qs = (LAS bf16*)lds; LAS bf16* Ks = Qs + 128 * 72; LAS bf16* Vt = Ks + 128 * 72; LAS bf16* Sf = Vt + 128 * 136; LAS bf16* Sb = Sf + 128 * 72;
    const bf16* Z = (const bf16*)(wsb() + WS_Z); const float* KV = (const float*)(wsb() + WS_KV); const f32x2* rope = (const f32x2*)(wsb() + WS_ROPE);
    bf16* YS = (bf16*)(wsb() + WS_YS) + (size_t)MT * 1024;
    const int lane = tid & 63, w = tid >> 6, g = lane >> 4, li = lane & 15;
    for (int uid = blockIdx.x; uid < 1024 + nctx_units; uid += gridDim.x) {
        const bool isc = uid >= 1024; int b, h, n, ci; size_t m0;
        if (!isc) { b = uid >> 8; h = (uid >> 5) & 7; n = uid & 31; m0 = (size_t)b * SEQ + n * 128; ci = 2 + n; }
        else { const int i = uid - 1024; b = i >> 4; h = (i >> 1) & 7; n = i & 1; m0 = (size_t)ML + b * CL + n * 128; ci = n; }
        const float lgf = inp(I_RDEC)[(l * 2 + 0) * 8 + h] * LOG2E, lgb = inp(I_RDEC)[(l * 2 + 1) * 8 + h] * LOG2E;
        __syncthreads();
        { const int tok = tid >> 2, pp = tid & 3, a = (pp & 1) + ((pp >> 1) << 2);
            const int t = n * 128 + tok; const int pos = (a < 4) ? (t >> 6) : (t & 63); const f32x2* rt = rope + pos * 16 + 8 * (a & 1);
            const bf16* qr = Z + (m0 + tok) * INW + C_RQ + h * 64; const bf16* kr = Z + (m0 + tok) * INW + C_RK + h * 64;
            float lo[8], hi[8];
            unpack8(*(const v4u*)(qr + 8 * a), lo); unpack8(*(const v4u*)(qr + 8 * a + 16), hi);
            if (!isc) rope8(lo, hi, rt);
            *(LAS v4u*)(Qs + tok * 72 + 8 * a) = pack8(lo); *(LAS v4u*)(Qs + tok * 72 + 8 * a + 16) = pack8(hi);
            unpack8(*(const v4u*)(kr + 8 * a), lo); unpack8(*(const v4u*)(kr + 8 * a + 16), hi);
            if (!isc) rope8(lo, hi, rt);
#pragma unroll
            for (int e = 0; e < 8; ++e) { lo[e] *= 0.125f; hi[e] *= 0.125f; }
            *(LAS v4u*)(Ks + tok * 72 + 8 * a) = pack8(lo); *(LAS v4u*)(Ks + tok * 72 + 8 * a + 16) = pack8(hi); }
        for (int q = tid; q < 2048; q += 512) { const int r = q >> 4, ch = q & 15; vt_store(Vt, 136, ch * 8, r, *(const v4u*)(Z + (m0 + r) * INW + C_RV + h * 128 + ch * 8)); }
#pragma unroll
        for (int dir = 0; dir < 2; ++dir) { const f32x4* src = (const f32x4*)(KV + ((size_t)((b * 8 + h) * 2 + dir) * 34 + ci) * 8192); LAS bf16* S = dir ? Sb : Sf;
            for (int q = tid; q < 2048; q += 512) { const f32x4 v = src[q]; v2u wv; wv.x = pk2(v.x, v.y); wv.y = pk2(v.z, v.w); *(LAS v2u*)(S + (q >> 4) * 72 + (q & 15) * 4) = wv; } }
        __syncthreads();
        const int iq = 16 * w + li;
        bf16x8 qf[2];
#pragma unroll
        for (int ks = 0; ks < 2; ++ks) qf[ks] = *(const LAS bf16x8*)(Qs + iq * 72 + 32 * ks + 8 * g);
        f32x4 s[8];
#pragma unroll
        for (int nn = 0; nn < 8; ++nn) { s[nn] = (f32x4){0.f, 0.f, 0.f, 0.f};
#pragma unroll
            for (int ks = 0; ks < 2; ++ks) s[nn] = mfma16(*(const LAS bf16x8*)(Ks + (16 * nn + li) * 72 + 32 * ks + 8 * g), qf[ks], s[nn]);
#pragma unroll
            for (int j = 0; j < 4; ++j) { const int d = iq - (16 * nn + 4 * g + j); s[nn][j] *= (d >= 0) ? ex2(lgf * (float)d) : ex2(lgb * (float)(-d)); } }
        f32x4 o[8];
#pragma unroll
        for (int nd = 0; nd < 8; ++nd) o[nd] = (f32x4){0.f, 0.f, 0.f, 0.f};
#pragma unroll
        for (int kk = 0; kk < 4; ++kk) {
            const bf16x8 pf = mk8(pk2(s[2 * kk][0], s[2 * kk][1]), pk2(s[2 * kk][2], s[2 * kk][3]), pk2(s[2 * kk + 1][0], s[2 * kk + 1][1]), pk2(s[2 * kk + 1][2], s[2 * kk + 1][3]));
#pragma unroll
            for (int nd = 0; nd < 8; ++nd) { const LAS bf16* vp = Vt + (16 * nd + li) * 136 + 32 * kk + 4 * g;
                const v2u lo = *(const LAS v2u*)vp, hi = *(const LAS v2u*)(vp + 16);
                o[nd] = mfma16(mk8(lo.x, lo.y, hi.x, hi.y), pf, o[nd]); } }
        const float xif = ex2(lgf * (float)(iq + 1)), xib = ex2(lgb * (float)(128 - iq));
        float ss = 0.f;
#pragma unroll
        for (int nd = 0; nd < 8; ++nd) { f32x4 tf = (f32x4){0.f, 0.f, 0.f, 0.f}, tb = (f32x4){0.f, 0.f, 0.f, 0.f};
#pragma unroll
            for (int ks = 0; ks < 2; ++ks) { tf = mfma16(*(const LAS bf16x8*)(Sf + (16 * nd + li) * 72 + 32 * ks + 8 * g), qf[ks], tf);
                tb = mfma16(*(const LAS bf16x8*)(Sb + (16 * nd + li) * 72 + 32 * ks + 8 * g), qf[ks], tb); }
            o[nd] = o[nd] + tf * xif + tb * xib;
            ss += (o[nd][0] * o[nd][0] + o[nd][1] * o[nd][1]) + (o[nd][2] * o[nd][2] + o[nd][3] * o[nd][3]); }
        ss += __shfl_xor(ss, 16); ss += __shfl_xor(ss, 32);
        const float rn = 1.0f / sqrtf(ss * (1.0f / 128.0f) + EPS);
        const size_t mrow = m0 + iq;
#pragma unroll
        for (int nd = 0; nd < 8; ++nd) { const int dv = 16 * nd + 4 * g; const v2u gv = *(const v2u*)(Z + mrow * INW + C_RG + h * 128 + dv);
            const float g0 = bflo(gv.x), g1 = bfhi(gv.x), g2 = bflo(gv.y), g3 = bfhi(gv.y);
            v2u wv; wv.x = pk2(g0 / (1.0f + __expf(-g0)) * o[nd][0] * rn, g1 / (1.0f + __expf(-g1)) * o[nd][1] * rn);
            wv.y = pk2(g2 / (1.0f + __expf(-g2)) * o[nd][2] * rn, g3 / (1.0f + __expf(-g3)) * o[nd][3] * rn);
            *(v2u*)(YS + mrow * 1024 + h * 128 + dv) = wv; }
    }
}

__device__ __forceinline__ float gelu_t(float x) { const float u = 0.7978845608028654f * (x + 0.044715f * x * x * x); const float e = __expf(2.0f * u); return 0.5f * x * (2.0f - 2.0f / (1.0f + e)); }
__device__ __forceinline__ void ph_ffnmid(const Args& A, int l, int Mrows, int tid) {
    const bf16* AB = (const bf16*)(wsb() + WS_Z); bf16* U = (bf16*)(wsb() + WS_U);
    const float* cw = inp(I_FFCW) + (size_t)l * 3 * DFF; const float* cb = inp(I_FFCB) + (size_t)l * DFF;
    const int cgi = tid & 63, rsub = tid >> 6; const int nunits = (Mrows / 32) * 11;
    for (int u = blockIdx.x; u < nunits; u += gridDim.x) {
        const int cblk = u % 11, rblk = u / 11, col = cblk * 512 + cgi * 8;
        float w0[8], w1[8], w2[8], bb[8];
#pragma unroll
        for (int e = 0; e < 8; ++e) { w0[e] = cw[col + e]; w1[e] = cw[DFF + col + e]; w2[e] = cw[2 * DFF + col + e]; bb[e] = cb[col + e]; }
#pragma unroll
        for (int rr = 0; rr < 4; ++rr) { const int m = rblk * 32 + rr * 8 + rsub;
            const bool first = (m < ML) ? ((m & (SEQ - 1)) == 0) : ((m & (CL - 1)) == 0), last = (m < ML) ? ((m & (SEQ - 1)) == SEQ - 1) : ((m & (CL - 1)) == CL - 1);
            const bf16* ap = AB + (size_t)m * NFF + col;
            float am[8], a0[8], aq[8], bg[8];
            const v4u z4 = (v4u){0u, 0u, 0u, 0u};
            unpack8(first ? z4 : *(const v4u*)(ap - NFF), am); unpack8(*(const v4u*)ap, a0); unpack8(last ? z4 : *(const v4u*)(ap + NFF), aq); unpack8(*(const v4u*)(ap + DFF), bg);
            float r[8];
#pragma unroll
            for (int e = 0; e < 8; ++e) r[e] = gelu_t(w0[e] * am[e] + w1[e] * a0[e] + w2[e] * aq[e] + bb[e]) * bg[e];
            *(v4u*)(U + (size_t)m * DFF + col) = pack8(r); }
    }
}
__device__ __forceinline__ void ph_final(const Args& A, int wave, int lane) {
    const int gw = blockIdx.x * NWAVES + wave, NGW = gridDim.x * NWAVES; const float* g = inp(I_GF);
    for (int m = gw; m < ML; m += NGW) { float* xr = outb() + (size_t)m * D; f32x4 v[8]; float ss = 0.f;
#pragma unroll
        for (int j = 0; j < 8; ++j) { v[j] = *(const f32x4*)(xr + (lane + 64 * j) * 4); ss += (v[j].x * v[j].x + v[j].y * v[j].y) + (v[j].z * v[j].z + v[j].w * v[j].w); }
        const float rstd = 1.0f / sqrtf(wave_sum(ss) * (1.0f / D) + EPS);
#pragma unroll
        for (int j = 0; j < 8; ++j) { const int idx = (lane + 64 * j) * 4; *(f32x4*)(xr + idx) = v[j] * rstd * *(const f32x4*)(g + idx); }
    }
}
constexpr int SEQ_PER_LAYER = 11, NSEQ = 1 + DEPTH * SEQ_PER_LAYER + 1;
__global__ void __launch_bounds__(NWAVES * 64, 2) fwd(Args A) {
    extern __shared__ __attribute__((aligned(16))) unsigned char lds_raw[];
    LAS unsigned char* lds = (LAS unsigned char*)lds_raw;
    volatile LAS unsigned* MISC = (volatile LAS unsigned*)(lds + MISC_OFF);
    for (int u = threadIdx.x; u < (LDS_BYTES - LDSCTL_OFF) / 4; u += NWAVES * 64) ((LAS unsigned*)(lds + LDSCTL_OFF))[u] = 0u;
    __syncthreads();
    (void)xcd_barrier_post((unsigned*)(wsb() + WS_CTL) + CW_BAR, MISC + 8);
    const int lo = A.seq_lo, hi = A.seq_hi;
#define G ((int)gridDim.x)
#define RUN(s) (lo <= (s) && (s) < hi)
#ifndef DUP
#define DUP 0
#endif
#define DUPN(id) ((((DUP) >> (id)) & 1) ? 2 : 1)
#define TID_HERE const int tid = otid(), lane = tid & 63, wave = __builtin_amdgcn_readfirstlane(tid >> 6); (void)lane; (void)wave
#ifdef ONLY
#define PH_ON(k) ((k) == ONLY)
#elif defined(SKIP)
#define PH_ON(k) ((k) != SKIP)
#else
#define PH_ON(k) true
#endif
#define SEAM(s) do { if (RUN((s) + 1)) { XcdBarrier bar_; bar_.bar = (unsigned*)(wsb() + WS_CTL) + CW_BAR; bar_.x = xb_xcc_id(); bar_.st = (volatile LAS unsigned*)(lds + MISC_OFF) + 8; xcd_barrier(bar_); } } while (0)
#define H ((bf16*)(wsb() + WS_H))
#define Z ((bf16*)(wsb() + WS_Z))
#define ACC ((bf16*)(wsb() + WS_ACC))
#define U ((bf16*)(wsb() + WS_U))
#define YS ((bf16*)(wsb() + WS_YS))
#define XC ((float*)(wsb() + WS_XC))
#define WIN ((const bf16*)(wsb() + WS_WIN))
#define WBR ((const bf16*)(wsb() + WS_WBR))
#define WOUT ((const bf16*)(wsb() + WS_WOUT))
#define WF1 ((const bf16*)(wsb() + WS_WF1))
#define WF2 ((const bf16*)(wsb() + WS_WF2))

    if (PH_ON(100) && RUN(0)) { TID_HERE; ph_prologue(A, lds, tid); SEAM(0); }

    for (int l = 0; l < DEPTH; ++l) {
        const int sb = 1 + l * SEQ_PER_LAYER;
        if (hi <= sb || lo >= sb + SEQ_PER_LAYER) continue;
        const bool lastl = (l == DEPTH - 1);
        const int Mrows = lastl ? ML : MT, nctx = lastl ? 0 : 64;
#define modl ((const float*)(wsb() + WS_MOD) + (size_t)l * 5 * 12288)
#define xlat_in ((l == 0) ? inp(I_X) : (const float*)outb())
#define xctx_in ((l == 0) ? inp(I_CTX) : (const float*)XC)

        if (PH_ON(0) && RUN(sb + 0)) { TID_HERE;
#ifndef NO_A1
            for (int r_ = 0; r_ < DUPN(1); ++r_) ph_convert(A, l, lds, wave, lane);
#endif
            __syncthreads();
#ifndef NO_A2
            for (int r_ = 0; r_ < DUPN(2); ++r_) ph_filt1(A, l, lds, tid);
#endif
#ifndef NO_A3
            for (int r_ = 0; r_ < DUPN(2); ++r_) ph_norm(xlat_in, xctx_in, inp(I_G1) + (size_t)l * D, modl, 0, D, H, MT, wave, lane);
#endif
            SEAM(sb + 0);
        }
        if (PH_ON(1) && RUN(sb + 1)) { TID_HERE;
            { pg8::Gemm g{H, WIN, opq(MT), opq(INW), opq(D)}; pg8::StaticOrder S; S.init(g.M, g.N, G, (int)blockIdx.x);
              pg8::EpiStore E{Z, INW};
#ifndef NO_B1
              pg8::gemm_phase<pg8::EpiStore, pg8::StaticOrder, PG8_ALIGN, PG8_SP2>(lds, g, S, E);
#endif
 }
#ifndef NO_B2
            for (int r_ = 0; r_ < DUPN(3); ++r_) ph_filt2(A, l, lds, tid);
#endif
            SEAM(sb + 1);
        }
        if (PH_ON(2) && RUN(sb + 2)) { TID_HERE;
            for (int r_ = 0; r_ < DUPN(4); ++r_) ph_hyprep(A, l, lds, tid);
            for (int r_ = 0; r_ < DUPN(5); ++r_) ph_ret1(A, l, 64, lds, tid);
            for (int r_ = 0; r_ < DUPN(6); ++r_) ph_natt(A, l, nctx, lds, tid);
            for (int r_ = 0; r_ < DUPN(7); ++r_) if (!lastl) ph_hyctx(A, l, lds, tid);
            SEAM(sb + 2);
        }
        if (PH_ON(3) && RUN(sb + 3)) { TID_HERE;
#ifndef NO_D1
            for (int r_ = 0; r_ < DUPN(8); ++r_) ph_hyfft(A, l, lds, tid);
#endif
#ifndef NO_D2
            ph_scan(A, l, tid);
#endif
            SEAM(sb + 3);
        }
        if (PH_ON(4) && RUN(sb + 4)) { TID_HERE;
            for (int r_ = 0; r_ < DUPN(9); ++r_) ph_hypost(A, lds, tid);
            for (int r_ = 0; r_ < DUPN(10); ++r_) ph_ret3(A, l, nctx, lds, tid);
            SEAM(sb + 4);
        }
        if (PH_ON(5) && RUN(sb + 5)) { TID_HERE;
            __syncthreads();
            for (int r_ = 0; r_ < DUPN(13); ++r_)
            for (int i = 0; i < 3; ++i) {
                pg8::Gemm g{YS + (size_t)i * MT * 1024, WBR + (size_t)i * D * 1024, Mrows, opq(D), opq(1024)}; pg8::StaticOrder S; S.init(g.M, g.N, G, (int)blockIdx.x);
                pg8::EpiMerge E{ACC, Z + C_GT + i * D, INW, i == 0 ? 1 : 0};
                pg8::gemm_phase<pg8::EpiMerge, pg8::StaticOrder, PG8_ALIGN, PG8_SP2>(lds, g, S, E);
            }
            SEAM(sb + 5);
        }
        if (PH_ON(6) && RUN(sb + 6)) { TID_HERE;
            __syncthreads();
            pg8::Gemm g{ACC, WOUT, Mrows, opq(D), opq(D)}; pg8::StaticOrder S; S.init(g.M, g.N, G, (int)blockIdx.x);
            pg8::EpiResid E{xlat_in, xctx_in, outb(), XC, modl, 2 * D};
            pg8::gemm_phase<pg8::EpiResid, pg8::StaticOrder, PG8_ALIGN, PG8_SP2>(lds, g, S, E);
            SEAM(sb + 6);
        }
        if (PH_ON(7) && RUN(sb + 7)) { TID_HERE;
            for (int r_ = 0; r_ < DUPN(12); ++r_) ph_norm(outb(), XC, inp(I_G2) + (size_t)l * D, modl, 3 * D, 4 * D, H, Mrows, wave, lane);
            SEAM(sb + 7);
        }
        if (PH_ON(8) && RUN(sb + 8)) { TID_HERE;
            __syncthreads();
            pg8::Gemm g{H, WF1, Mrows, opq(NFF), opq(D)}; pg8::StaticOrder S; S.init(g.M, g.N, G, (int)blockIdx.x);
            pg8::EpiStore E{Z, NFF};
            for (int r_ = 0; r_ < DUPN(14); ++r_) pg8::gemm_phase<pg8::EpiStore, pg8::StaticOrder, PG8_ALIGN, PG8_SP2>(lds, g, S, E);
            SEAM(sb + 8);
        }
        if (PH_ON(9) && RUN(sb + 9)) { TID_HERE;
            for (int r_ = 0; r_ < DUPN(11); ++r_) ph_ffnmid(A, l, Mrows, tid);
            SEAM(sb + 9);
        }
        if (PH_ON(10) && RUN(sb + 10)) { TID_HERE;
            __syncthreads();
            pg8::Gemm g{U, WF2, Mrows, opq(D), opq(DFF)}; pg8::StaticOrder S; S.init(g.M, g.N, G, (int)blockIdx.x);
            pg8::EpiResid E{outb(), XC, outb(), XC, modl, 5 * D};
            pg8::gemm_phase<pg8::EpiResid, pg8::StaticOrder, PG8_ALIGN, PG8_SP2>(lds, g, S, E);
            SEAM(sb + 10);
        }
    }
    if (PH_ON(101) && RUN(NSEQ - 1)) { TID_HERE; ph_final(A, wave, lane); }
#undef RUN
#undef SEAM
#undef H
#undef Z
#undef ACC
#undef U
#undef YS
#undef XC
#undef WIN
#undef WBR
#undef WOUT
#undef WF1
#undef WF2
#undef G
#undef modl
#undef xlat_in
#undef xctx_in
}

extern "C" void kernel_launch(void* const* d_in, const int* in_sizes, int n_in, void* d_out, int out_size, void* d_ws, size_t ws_size, hipStream_t stream) {
    static int grid = 0;
    if (grid == 0) {
        if (n_in != 27 || out_size != ML * D || ws_size < WS_END) { fprintf(stderr, "kernel_launch: unexpected shapes (n_in %d out %d ws %zu need %zu)\n", n_in, out_size, ws_size, (size_t)WS_END); grid = -1; return; }
        int dev = 0, cus = 0, per_cu = 0;
        if (hipGetDevice(&dev) != hipSuccess || hipDeviceGetAttribute(&cus, hipDeviceAttributeMultiprocessorCount, dev) != hipSuccess) { grid = -1; return; }
        if (hipFuncSetAttribute((const void*)fwd, hipFuncAttributeMaxDynamicSharedMemorySize, LDS_BYTES) != hipSuccess) { fprintf(stderr, "kernel_launch: hipFuncSetAttribute failed\n"); grid = -1; return; }
        if (hipOccupancyMaxActiveBlocksPerMultiprocessor(&per_cu, (const void*)fwd, NWAVES * 64, LDS_BYTES) != hipSuccess || per_cu < 1) fprintf(stderr, "kernel_launch: occupancy query says %d\n", per_cu);
        (void)hipGetLastError();
        grid = cus;
    }
    if (grid < 0) return;
    (void)hipMemsetAsync((char*)d_ws + WS_CTL, 0, CTL_ZERO_BYTES, stream);
    Args a{};
    for (int i = 0; i < 27; ++i) a.in[i] = (const float*)d_in[i];
    a.out = (float*)d_out; a.ws = (unsigned char*)d_ws;
#if MK_SINGLE
    a.seq_lo = 0; a.seq_hi = NSEQ;
    hipLaunchKernelGGL(fwd, dim3(grid), dim3(NWAVES * 64), LDS_BYTES, stream, a);
#else
    for (int s = 0; s < NSEQ; ++s) { a.seq_lo = s; a.seq_hi = s + 1; hipLaunchKernelGGL(fwd, dim3(grid), dim3(NWAVES * 64), LDS_BYTES, stream, a); }
#endif
}
```

```cpp
#include <hip/hip_runtime.h>
#include <cstdio>
#include <cstdint>
#ifndef MK_SINGLE
#define MK_SINGLE 1
#endif
namespace pg8 {
#define PG8_LAS __attribute__((address_space(3)))
typedef unsigned short bf16_t;
typedef short bf16x8 __attribute__((ext_vector_type(8)));
typedef float f32x4 __attribute__((ext_vector_type(4)));
typedef unsigned u32x4 __attribute__((ext_vector_type(4)));
constexpr int BM = 256, BK = 64, HALF = 128, HTB = HALF * BK * 2  , STAGE_BYTES = 8 * HTB, NXCD = 8, WGM = 8;

__host__ __device__ __forceinline__ int lds_byte(int r, int c) { const int st = (r >> 4) * 2 + (c >> 5), rr = r & 15, cc = c & 31, ob = rr * 64 + cc * 2; return st * 1024 + (ob ^ (((ob >> 9) & 1) << 5)); }
__host__ __device__ __forceinline__ void stage_rc(int b, int& R, int& C) { const int st = b / 1024, sb = b % 1024, swz = sb ^ (((sb >> 9) & 1) << 5); R = (st >> 1) * 16 + swz / 64; C = (st & 1) * 32 + (swz % 64) / 2; }
__host__ __device__ __forceinline__ int perm32(int rho) { const int n = rho >> 4, i = rho & 15; return 8 * (i >> 2) + 4 * n + (i & 3); }

struct Unit { int pm, pn; };
struct Gemm { const bf16_t* A; const bf16_t* Bt; int M, N, K; };

struct StaticOrder {
    int nM, nN, nwg, G, c;
    __host__ __device__ void init(int M, int N, int G_, int c_) { nM = M / BM; nN = N / BM; nwg = nM * nN; G = G_; c = c_; }
    __host__ __device__ bool next(int i, Unit& u) const {
        const long L = (long)i * G + c; if (L >= nwg) return false;
        int wgid = (int)L; { const int q = nwg / NXCD, r = nwg % NXCD, xcd = wgid % NXCD, off = wgid / NXCD; wgid = (xcd < r ? xcd * (q + 1) : r * (q + 1) + (xcd - r) * q) + off; }
        const int nig = WGM * nN, gid = wgid / nig, fm = gid * WGM, gsz = (nM - fm) < WGM ? (nM - fm) : WGM;
        u.pm = fm + ((wgid % nig) % gsz); u.pn = (wgid % nig) / gsz; return true;
    }
    __device__ __forceinline__ void a_ready(const Unit&) const {}
    __device__ __forceinline__ void done(const Unit&) const {}
};
__device__ __forceinline__ unsigned cvt_pk_bf16(float lo, float hi) { unsigned r; asm volatile("v_cvt_pk_bf16_f32 %0, %1, %2" : "=v"(r) : "v"(lo), "v"(hi)); return r; }
typedef float f32x2 __attribute__((ext_vector_type(2)));
__device__ __forceinline__ float bflo(unsigned w) { return __uint_as_float(w << 16); }
__device__ __forceinline__ float bfhi(unsigned w) { return __uint_as_float(w & 0xffff0000u); }
__device__ __forceinline__ float sigm(float x) { return 1.0f / (1.0f + __expf(-x)); }
struct EpiStore {
    static constexpr bool PERM = true, AFTER_DRAIN = false;
    bf16_t* O; int ldc;
    __device__ __forceinline__ void operator()(const f32x4 (&acc)[2][2][4][2], const Unit& u, int wr, int wc, int fr, int fq) const {
        const int row0 = u.pm * BM + wr * 64 + fr, col0 = u.pn * BM + wc * 32 + 8 * fq;
#pragma unroll
        for (int ai = 0; ai < 2; ++ai)
#pragma unroll
            for (int m = 0; m < 4; ++m) { bf16_t* rowp = O + (size_t)(row0 + ai * HALF + m * 16) * ldc + col0;
#pragma unroll
                for (int bj = 0; bj < 2; ++bj) { const f32x4 v0 = acc[ai][bj][m][0], v1 = acc[ai][bj][m][1];
                    u32x4 w; w.x = cvt_pk_bf16(v0[0], v0[1]); w.y = cvt_pk_bf16(v0[2], v0[3]); w.z = cvt_pk_bf16(v1[0], v1[1]); w.w = cvt_pk_bf16(v1[2], v1[3]);
                    *(u32x4*)(rowp + bj * HALF) = w; } }
    }
};
struct EpiMerge {
    static constexpr bool PERM = true, AFTER_DRAIN = false;
    bf16_t* O; const bf16_t* gate; int ldg; int first;
    __device__ __forceinline__ void operator()(const f32x4 (&acc)[2][2][4][2], const Unit& u, int wr, int wc, int fr, int fq) const {
        const int row0 = u.pm * BM + wr * 64 + fr, col0 = u.pn * BM + wc * 32 + 8 * fq;
#pragma unroll
        for (int ai = 0; ai < 2; ++ai)
#pragma unroll
            for (int m = 0; m < 4; ++m) { const size_t row = (size_t)(row0 + ai * HALF + m * 16);
#pragma unroll
                for (int bj = 0; bj < 2; ++bj) { const int col = col0 + bj * HALF;
                    const u32x4 gv = *(const u32x4*)(gate + row * ldg + col);
                    u32x4 pv = (u32x4){0u, 0u, 0u, 0u}; if (!first) pv = *(const u32x4*)(O + row * 2048 + col);
                    const f32x4 v0 = acc[ai][bj][m][0], v1 = acc[ai][bj][m][1];
                    u32x4 w;
                    w.x = cvt_pk_bf16(bflo(pv.x) + v0[0] * sigm(bflo(gv.x)), bfhi(pv.x) + v0[1] * sigm(bfhi(gv.x)));
                    w.y = cvt_pk_bf16(bflo(pv.y) + v0[2] * sigm(bflo(gv.y)), bfhi(pv.y) + v0[3] * sigm(bfhi(gv.y)));
                    w.z = cvt_pk_bf16(bflo(pv.z) + v1[0] * sigm(bflo(gv.z)), bfhi(pv.z) + v1[1] * sigm(bfhi(gv.z)));
                    w.w = cvt_pk_bf16(bflo(pv.w) + v1[2] * sigm(bflo(gv.w)), bfhi(pv.w) + v1[3] * sigm(bfhi(gv.w)));
                    *(u32x4*)(O + row * 2048 + col) = w; } }
    }
};
struct EpiResid {
    static constexpr bool PERM = false, AFTER_DRAIN = false;
    const float* base_lat; const float* base_ctx; float* out_lat; float* out_ctx; const float* modl; int goff;
    __device__ __forceinline__ void operator()(const f32x4 (&acc)[2][2][4][2], const Unit& u, int wr, int wc, int fr, int fq) const {
        const bool isctx = u.pm >= 64; const int r = isctx ? 4 : (u.pm >> 4);
        const float* gvp = modl + (size_t)r * 12288 + goff;
        const float* bs = isctx ? base_ctx : base_lat; float* os = isctx ? out_ctx : out_lat;
        const int row0 = (isctx ? u.pm - 64 : u.pm) * BM + wr * 64 + fr, col0 = u.pn * BM + wc * 32 + 4 * fq;
        f32x4 g4[2][2];
#pragma unroll
        for (int bj = 0; bj < 2; ++bj)
#pragma unroll
            for (int n = 0; n < 2; ++n) g4[bj][n] = *(const f32x4*)(gvp + col0 + bj * HALF + n * 16);
#pragma unroll
        for (int ai = 0; ai < 2; ++ai)
#pragma unroll
            for (int m = 0; m < 4; ++m) { const size_t off = (size_t)(row0 + ai * HALF + m * 16) * 2048 + col0;
#pragma unroll
                for (int bj = 0; bj < 2; ++bj)
#pragma unroll
                    for (int n = 0; n < 2; ++n) { const f32x4 b4 = *(const f32x4*)(bs + off + bj * HALF + n * 16);
                        *(f32x4*)(os + off + bj * HALF + n * 16) = b4 + g4[bj][n] * acc[ai][bj][m][n]; } }
    }
};
template <class Epi, class Sched, bool ALIGN_EPI = false, bool SP2 = false>
__device__ __forceinline__ void gemm_phase(PG8_LAS unsigned char* lds, const Gemm g, const Sched& S, const Epi& E) {
    int tid_ = threadIdx.x; asm volatile("" : "+v"(tid_)); const int tid = tid_, wid = __builtin_amdgcn_readfirstlane(tid >> 6), lane = tid & 63, wr = wid >> 2, wc = wid & 3, fr = lane & 15, fq = lane >> 4;
    const int K = g.K, nt = K / BK;
    unsigned voffA[2], voffB[2];
#pragma unroll
    for (int i = 0; i < 2; ++i) { int R, C; stage_rc(tid * 16 + i * 8192, R, C); const int Rb = Epi::PERM ? ((R & ~31) + perm32(R & 31)) : R;
        voffA[i] = (unsigned)(R * K + C) * 2u; voffB[i] = (unsigned)(Rb * K + C) * 2u; }
    const size_t kstep = (size_t)(BK * 2);
    const size_t hstep = (size_t)HALF * K * 2;
    const size_t tstep = 2 * hstep;
    const unsigned ldsw = (unsigned)wid * 1024u;
    const int aoff = lds_byte(wr * 64 + fr, fq * 8), boff = lds_byte(wc * 32 + fr, fq * 8);
#define PG8_SA(b, h) (((b) * 2 + (h)) * HTB)
#define PG8_SB(b, h) ((4 + (b) * 2 + (h)) * HTB)
#define PG8_STAGE(bufoff, gbase, voff) do { _Pragma("unroll") for (int _i = 0; _i < 2; ++_i) \
        __builtin_amdgcn_global_load_lds((const unsigned*)((const char*)(gbase) + (voff)[_i]), (PG8_LAS unsigned*)(lds + (bufoff) + ldsw + _i * 8192), 16, 0, 0); } while (0)
#define PG8_LDA(dst, b, h) do { _Pragma("unroll") for (int m = 0; m < 4; ++m) _Pragma("unroll") for (int k = 0; k < 2; ++k) dst[m][k] = *(const PG8_LAS bf16x8*)(lds + PG8_SA(b, h) + aoff + m * 2048 + k * 1024); } while (0)
#define PG8_LDB(dst, b, h) do { _Pragma("unroll") for (int n = 0; n < 2; ++n) _Pragma("unroll") for (int k = 0; k < 2; ++k) dst[n][k] = *(const PG8_LAS bf16x8*)(lds + PG8_SB(b, h) + boff + n * 2048 + k * 1024); } while (0)
#define PG8_MMA(ai, bj, At, Bt) do { __builtin_amdgcn_s_setprio(1); _Pragma("unroll") for (int m = 0; m < 4; ++m) _Pragma("unroll") for (int n = 0; n < 2; ++n) _Pragma("unroll") for (int k = 0; k < 2; ++k) \
        acc[ai][bj][m][n] = __builtin_amdgcn_mfma_f32_16x16x32_bf16(Bt[n][k], At[m][k], acc[ai][bj][m][n], 0, 0, 0); __builtin_amdgcn_s_setprio(0); } while (0)
#define PG8_WAIT_V(n) asm volatile("s_waitcnt vmcnt(" #n ")" ::: "memory")
#define PG8_WAIT_L(n) asm volatile("s_waitcnt lgkmcnt(" #n ")" ::: "memory")
#define PG8_BAR __builtin_amdgcn_s_barrier()
#define PG8_SCHED __builtin_amdgcn_sched_barrier(0)
    Unit cur, nxt; int ui = 0;
    if (!S.next(0, cur)) return;
    f32x4 acc[2][2][4][2];
#pragma unroll
    for (int a = 0; a < 2; ++a)
#pragma unroll
        for (int b = 0; b < 2; ++b)
#pragma unroll
            for (int m = 0; m < 4; ++m)
#pragma unroll
                for (int n = 0; n < 2; ++n) acc[a][b][m][n] = (f32x4){0.f, 0.f, 0.f, 0.f};
    bf16x8 At[4][2], B0[2][2], B1[2][2];
    const char* cA = (const char*)g.A + (size_t)cur.pm * tstep; const char* cB = (const char*)g.Bt + (size_t)cur.pn * tstep;
    S.a_ready(cur);
    if constexpr (SP2) {
        PG8_STAGE(PG8_SB(0, 0), cB, voffB); PG8_STAGE(PG8_SB(0, 1), cB + hstep, voffB); PG8_STAGE(PG8_SA(0, 0), cA, voffA); PG8_STAGE(PG8_SA(0, 1), cA + hstep, voffA);
        if (wr == 1) PG8_BAR;
        PG8_WAIT_V(2); PG8_BAR;
        PG8_STAGE(PG8_SB(1, 0), cB + kstep, voffB); PG8_STAGE(PG8_SA(1, 0), cA + kstep, voffA); PG8_STAGE(PG8_SB(1, 1), cB + hstep + kstep, voffB);
        PG8_WAIT_V(6); PG8_BAR;
    } else {
        PG8_STAGE(PG8_SB(0, 0), cB, voffB); PG8_STAGE(PG8_SA(0, 0), cA, voffA); PG8_STAGE(PG8_SB(0, 1), cB + hstep, voffB); PG8_STAGE(PG8_SA(0, 1), cA + hstep, voffA);
        if (wr == 1) PG8_BAR;
        PG8_WAIT_V(4); PG8_BAR;
        PG8_STAGE(PG8_SB(1, 0), cB + kstep, voffB); PG8_STAGE(PG8_SA(1, 0), cA + kstep, voffA); PG8_STAGE(PG8_SB(1, 1), cB + hstep + kstep, voffB);
        PG8_WAIT_V(6); PG8_BAR;
    }
    for (;;) {
        const bool has_next = S.next(ui + 1, nxt);
        const char* nA = has_next ? (const char*)g.A + (size_t)nxt.pm * tstep : cA; const char* nB = has_next ? (const char*)g.Bt + (size_t)nxt.pn * tstep : cB;
        for (int t = 0; t < nt; t += 2) {
            const bool last = (t == nt - 2);
            const char* a1 = cA + (size_t)(t + 1) * kstep;
            const char* a2 = last ? nA : cA + (size_t)(t + 2) * kstep; const char* b2 = last ? nB : cB + (size_t)(t + 2) * kstep;
            const char* a3 = a2 + kstep; const char* b3 = b2 + kstep;
            if (last && has_next) S.a_ready(nxt);
            if constexpr (SP2) {
            PG8_LDB(B0, 0, 0); PG8_LDB(B1, 0, 1); PG8_SCHED; PG8_LDA(At, 0, 0); PG8_STAGE(PG8_SA(1, 1), a1 + hstep, voffA);
            PG8_WAIT_V(8); PG8_WAIT_L(0); PG8_BAR; PG8_MMA(0, 0, At, B0); PG8_MMA(0, 1, At, B1); PG8_BAR; PG8_SCHED;
            PG8_LDA(At, 0, 1); PG8_STAGE(PG8_SB(0, 0), b2, voffB); PG8_STAGE(PG8_SB(0, 1), b2 + hstep, voffB); PG8_STAGE(PG8_SA(0, 0), a2, voffA);
            PG8_WAIT_V(8); PG8_WAIT_L(0); PG8_BAR; PG8_MMA(1, 0, At, B0); PG8_MMA(1, 1, At, B1); PG8_BAR; PG8_SCHED;
            PG8_LDB(B0, 1, 0); PG8_LDB(B1, 1, 1); PG8_SCHED; PG8_LDA(At, 1, 0); PG8_STAGE(PG8_SA(0, 1), a2 + hstep, voffA);
            PG8_WAIT_V(8); PG8_WAIT_L(0); PG8_BAR; PG8_MMA(0, 0, At, B0); PG8_MMA(0, 1, At, B1); PG8_BAR; PG8_SCHED;
            PG8_LDA(At, 1, 1); PG8_STAGE(PG8_SB(1, 0), b3, voffB); PG8_STAGE(PG8_SB(1, 1), b3 + hstep, voffB); PG8_STAGE(PG8_SA(1, 0), a3, voffA);
            PG8_WAIT_V(8); PG8_WAIT_L(0); PG8_BAR; PG8_MMA(1, 0, At, B0); PG8_MMA(1, 1, At, B1); PG8_BAR; PG8_SCHED;
            } else {
            PG8_LDB(B0, 0, 0); PG8_SCHED; PG8_LDA(At, 0, 0); PG8_STAGE(PG8_SA(1, 1), a1 + hstep, voffA);
            PG8_WAIT_L(8); PG8_BAR; PG8_WAIT_L(0); PG8_MMA(0, 0, At, B0); PG8_BAR; PG8_SCHED;
            PG8_LDB(B1, 0, 1); PG8_STAGE(PG8_SB(0, 0), b2, voffB);
            PG8_BAR; PG8_WAIT_L(0); PG8_MMA(0, 1, At, B1); PG8_BAR;
            PG8_LDA(At, 0, 1); PG8_STAGE(PG8_SA(0, 0), a2, voffA);
            PG8_BAR; PG8_WAIT_L(0); PG8_MMA(1, 0, At, B0); PG8_BAR; PG8_SCHED;
            PG8_STAGE(PG8_SB(0, 1), b2 + hstep, voffB);
            PG8_WAIT_V(6); PG8_BAR; PG8_MMA(1, 1, At, B1); PG8_BAR;
            PG8_LDB(B0, 1, 0); PG8_SCHED; PG8_LDA(At, 1, 0); PG8_STAGE(PG8_SA(0, 1), a2 + hstep, voffA);
            PG8_WAIT_L(8); PG8_BAR; PG8_WAIT_L(0); PG8_MMA(0, 0, At, B0); PG8_BAR; PG8_SCHED;
            PG8_LDB(B1, 1, 1); PG8_STAGE(PG8_SB(1, 0), b3, voffB);
            PG8_BAR; PG8_WAIT_L(0); PG8_MMA(0, 1, At, B1); PG8_BAR;
            PG8_LDA(At, 1, 1); PG8_STAGE(PG8_SA(1, 0), a3, voffA);
            PG8_BAR; PG8_WAIT_L(0); PG8_MMA(1, 0, At, B0); PG8_BAR; PG8_SCHED;
            PG8_STAGE(PG8_SB(1, 1), b3 + hstep, voffB);
            PG8_WAIT_V(6); PG8_BAR; PG8_MMA(1, 1, At, B1); PG8_BAR;
            }
        }
        if constexpr (ALIGN_EPI) { if (wr == 0) PG8_BAR; }
        if constexpr (!Epi::AFTER_DRAIN) { E(acc, cur, wr, wc, fr, fq); S.done(cur); }
        if (!has_next) break;
#pragma unroll
        for (int a = 0; a < 2; ++a)
#pragma unroll
            for (int b = 0; b < 2; ++b)
#pragma unroll
                for (int m = 0; m < 4; ++m)
#pragma unroll
                    for (int n = 0; n < 2; ++n) acc[a][b][m][n] = (f32x4){0.f, 0.f, 0.f, 0.f};
        cur = nxt; cA = nA; cB = nB; ++ui;
        if constexpr (ALIGN_EPI) { if (wr == 1) PG8_BAR; }
    }
    PG8_WAIT_V(0);
    if constexpr (!ALIGN_EPI) { if (wr == 0) PG8_BAR; }
    PG8_BAR;
    if constexpr (Epi::AFTER_DRAIN) { E.fused(acc, cur, wr, wc, fr, fq, lds, wid, lane); S.done(cur); }
#undef PG8_SA
#undef PG8_SB
#undef PG8_STAGE
#undef PG8_LDA
#undef PG8_LDB
#undef PG8_MMA
#undef PG8_WAIT_V
#undef PG8_WAIT_L
#undef PG8_BAR
#undef PG8_SCHED
}
}
#ifndef PG8_SP2
#define PG8_SP2 true
#endif
#ifndef PG8_ALIGN
#define PG8_ALIGN true
#endif
constexpr int D = 2048, NB = 4, SEQ = 4096, CL = 256, DEPTH = 4;
constexpr int ML = NB * SEQ, MC = NB * CL, MT = ML + MC;
constexpr int INW = 15360, DFF = 5632, NFF = 2 * DFF;
constexpr int C_RK = 0, C_RV = 512, C_NK = 1536, C_NV = 2560, C_RQ = 3584, C_RG = 4096, C_NQ = 5120, C_HY = 6144, C_GT = 9216;
constexpr float EPS = 1e-6f;
constexpr int NWAVES = 8;
constexpr size_t al256(size_t x) { return (x + 255) & ~(size_t)255; }
constexpr size_t WS_CTL = 0, CTL_ZERO_BYTES = 1u << 20;
constexpr size_t WS_MOD = WS_CTL + CTL_ZERO_BYTES;
constexpr size_t WS_ROPE = WS_MOD + al256((size_t)4 * 5 * 12288 * 4);
constexpr size_t PS_FH2 = 0;
constexpr size_t PS_FH2B = PS_FH2 + al256((size_t)4352 * 64 * 4);
constexpr size_t PS_TAPC = PS_FH2B + al256((size_t)4352 * 64 * 2);
constexpr size_t PS_KF = PS_TAPC + al256((size_t)2 * 2 * 1024 * 256 * 4);
constexpr size_t PS_WIN = PS_KF + al256((size_t)2 * 1024 * 8192 * 8);
constexpr size_t PS_WBR = PS_WIN + al256((size_t)INW * D * 2);
constexpr size_t PS_WOUT = PS_WBR + al256((size_t)3 * D * 1024 * 2);
constexpr size_t PS_WF1 = PS_WOUT + al256((size_t)D * D * 2);
constexpr size_t PS_WF2 = PS_WF1 + al256((size_t)NFF * D * 2);
constexpr size_t PS_BYTES = PS_WF2 + al256((size_t)D * DFF * 2);
constexpr size_t WS_PSET = WS_ROPE + al256(64 * 16 * 8);
constexpr size_t WS_XC = WS_PSET + 2 * PS_BYTES;
constexpr size_t WS_H = WS_XC + al256((size_t)MC * D * 4);
constexpr size_t WS_Z = WS_H + al256((size_t)MT * D * 2);
constexpr size_t WS_HYT = WS_Z + al256((size_t)MT * INW * 2);
constexpr size_t WS_YT = WS_HYT + al256((size_t)3 * NB * 1024 * SEQ * 2);
constexpr size_t WS_YS = WS_YT + al256((size_t)NB * 1024 * SEQ * 2);
constexpr size_t WS_ACC = WS_YS + al256((size_t)3 * MT * 1024 * 2);
constexpr size_t WS_U = WS_ACC + al256((size_t)MT * D * 2);
constexpr size_t WS_KV = WS_U + al256((size_t)MT * DFF * 2);
constexpr size_t WS_END = WS_KV + al256((size_t)NB * 8 * 2 * 34 * 8192 * 4);
constexpr int CW_BAR = 4096;
constexpr int RING_BYTES = 131072, LDSCTL_OFF = RING_BYTES, MISC_OFF = LDSCTL_OFF + 320, LDS_BYTES = 147456;

#define GAS __attribute__((address_space(1)))
#define LAS __attribute__((address_space(3)))
typedef unsigned short bf16;
typedef unsigned v4u __attribute__((ext_vector_type(4)));
typedef unsigned v2u __attribute__((ext_vector_type(2)));
typedef float f32x4 __attribute__((ext_vector_type(4)));
typedef float f32x2 __attribute__((ext_vector_type(2)));
typedef short bf16x8 __attribute__((ext_vector_type(8)));
typedef GAS unsigned gu32;
#define LDS_WAIT() asm volatile("s_waitcnt lgkmcnt(0)" ::: "memory")
__device__ __forceinline__ unsigned f2bf(float f) { unsigned u = __builtin_bit_cast(unsigned, f); return (u + 0x7fffu + ((u >> 16) & 1u)) >> 16; }
__device__ __forceinline__ unsigned pk2(float lo, float hi) { return f2bf(lo) | (f2bf(hi) << 16); }
__device__ __forceinline__ float bflo(unsigned w) { return __uint_as_float(w << 16); }
__device__ __forceinline__ float bfhi(unsigned w) { return __uint_as_float(w & 0xffff0000u); }
__device__ __forceinline__ float bf1(bf16 b) { return __uint_as_float(((unsigned)b) << 16); }
__device__ __forceinline__ bf16x8 mk8(unsigned a, unsigned b, unsigned c, unsigned d) { v4u v = (v4u){a, b, c, d}; return __builtin_bit_cast(bf16x8, v); }
__device__ __forceinline__ f32x4 mfma16(bf16x8 a, bf16x8 b, f32x4 c) { return __builtin_amdgcn_mfma_f32_16x16x32_bf16(a, b, c, 0, 0, 0); }
__device__ __forceinline__ float sin_rev(float r) { return __builtin_amdgcn_sinf(r - floorf(r)); }
__device__ __forceinline__ float cos_rev(float r) { return __builtin_amdgcn_cosf(r - floorf(r)); }
__device__ __forceinline__ float sin_rad(float x) { return sin_rev(x * 0.15915494309189535f); }
__device__ __forceinline__ float ex2(float x) { return __builtin_amdgcn_exp2f(x); }
__device__ __forceinline__ float wave_sum(float v) {
#pragma unroll
    for (int o = 1; o < 64; o <<= 1) v += __shfl_xor(v, o);
    return v;
}
__device__ __forceinline__ int otid() { int t = threadIdx.x; asm volatile("" : "+v"(t)); return t; }
__device__ __forceinline__ int opq(int v) { asm volatile("" : "+s"(v)); return v; }
#define XB_TMO      128
#define XB_XCNT(j)  (256  + 64 * (j))
#define XB_XSUB(j)  (1280 + 64 * (j))
#define XB_XGEN(j)  (2304 + 64 * (j))
#define XB_TOP      3328
#define XB_TOPGEN   3392
#define XCD_BAR_WORDS 3456
#define XB_SPIN_CAP (1u << 18)

__device__ __forceinline__ unsigned xb_ld(unsigned* p)              { return __hip_atomic_load(p, __ATOMIC_RELAXED, __HIP_MEMORY_SCOPE_AGENT); }
__device__ __forceinline__ unsigned xb_add(unsigned* p, unsigned v) { return __hip_atomic_fetch_add(p, v, __ATOMIC_RELAXED, __HIP_MEMORY_SCOPE_AGENT); }
__device__ __forceinline__ unsigned xb_xcc_id() { return (unsigned)__builtin_amdgcn_s_getreg((3 << 11) | 20) & 0xFu; }
#define XB_SPIN(cond, bar) do { unsigned _sp = 0; while (cond) { __builtin_amdgcn_s_sleep(1); \
    if ((++_sp & 255u) == 0u) { if (xb_ld(&(bar)[XB_TMO])) break; if (_sp > XB_SPIN_CAP) { atomicAdd(&(bar)[XB_TMO], 1u); break; } } } } while (0)

struct XcdBarrier {
    unsigned* bar; unsigned x;
    volatile LAS unsigned* st;
};

__device__ __forceinline__ XcdBarrier xcd_barrier_post(unsigned* bar, volatile LAS unsigned* st) {
    XcdBarrier b; b.bar = bar; b.x = xb_xcc_id(); b.st = st;
    if (threadIdx.x == 0) (void)xb_add(&bar[XB_XCNT(b.x)], 1u);
    return b;
}
__device__ __forceinline__ void xcd_barrier_complete(unsigned* bar, unsigned x, unsigned& nloc, unsigned& nx) {
    const unsigned G = gridDim.x * gridDim.y * gridDim.z;
    unsigned sum, cnt, mine, sp = 0u;
    for (;;) {
        sum = 0u; cnt = 0u; mine = 0u;
#pragma unroll
        for (unsigned j = 0; j < 16; ++j) { const unsigned c = xb_ld(&bar[XB_XCNT(j)]); sum += c; cnt += (c > 0u) ? 1u : 0u; mine = (j == x) ? c : mine; }
        if (sum == G) break;
        __builtin_amdgcn_s_sleep(1);
        if ((++sp & 255u) == 0u) { if (xb_ld(&bar[XB_TMO])) break; if (sp > XB_SPIN_CAP) { atomicAdd(&bar[XB_TMO], 1u); break; } }
    }
    nloc = mine > 0u ? mine : 1u; nx = cnt > 0u ? cnt : 1u;
}

__device__ __forceinline__ void xcd_barrier(const XcdBarrier& b) {
    asm volatile("s_waitcnt vmcnt(0)" ::: "memory");
    __syncthreads();
    if (threadIdx.x == 0) {
        unsigned* bar = b.bar;
        __builtin_amdgcn_s_waitcnt(0);
        unsigned nloc = b.st[0], nx = b.st[1];
        if (nloc == 0u) { xcd_barrier_complete(bar, b.x, nloc, nx); b.st[0] = nloc; b.st[1] = nx; }
        const unsigned old = xb_add(&bar[XB_XSUB(b.x)], 1u);
        const unsigned gen = old / nloc;
        if (old + 1u == (gen + 1u) * nloc) {
            __builtin_amdgcn_fence(__ATOMIC_RELEASE, "agent");
            asm volatile("s_waitcnt vmcnt(0)" ::: "memory");
            const unsigned og = xb_add(&bar[XB_TOP], 1u);
            const unsigned tg = og / nx;
            if (og + 1u == (tg + 1u) * nx) xb_add(&bar[XB_TOPGEN], 1u);
            else XB_SPIN(xb_ld(&bar[XB_TOPGEN]) == tg, bar);
            __builtin_amdgcn_fence(__ATOMIC_ACQUIRE, "agent");
            xb_add(&bar[XB_XGEN(b.x)], 1u);
            asm volatile("s_waitcnt vmcnt(0)" ::: "memory");
        } else {
            XB_SPIN(xb_ld(&bar[XB_XGEN(b.x)]) == gen, bar);
            __builtin_amdgcn_fence(__ATOMIC_ACQUIRE, "agent");
            asm volatile("s_waitcnt vmcnt(0)" ::: "memory");
        }
    }
    __syncthreads();
}
__device__ __forceinline__ void p0_transpose_item(const float* W, int K, int N, bf16* WT, int row_off, LAS float* scr, int item, int lane) {
    const int nblk = N / 32, kb = item / nblk, nb = item % nblk, k0 = 64 * kb, n0 = 32 * nb;
#pragma unroll 8
    for (int i = 0; i < 32; ++i) { const int kk = 2 * i + (lane >> 5); scr[kk * 33 + (lane & 31)] = __builtin_nontemporal_load(W + (size_t)(k0 + kk) * N + n0 + (lane & 31)); }
    LDS_WAIT(); asm volatile("" ::: "memory");
    const int c = lane & 7;
#pragma unroll
    for (int j = 0; j < 4; ++j) { const int n = (lane >> 3) + 8 * j; const LAS float* s = scr + (8 * c) * 33 + n;
        v4u o; o.x = pk2(s[0 * 33], s[1 * 33]); o.y = pk2(s[2 * 33], s[3 * 33]); o.z = pk2(s[4 * 33], s[5 * 33]); o.w = pk2(s[6 * 33], s[7 * 33]);
        __builtin_nontemporal_store(o, (GAS v4u*)(WT + (size_t)(row_off + n0 + n) * K + k0 + 8 * c)); }
    LDS_WAIT(); asm volatile("" ::: "memory");
}
struct Args { const float* in[27]; float* out; unsigned char* ws; int seq_lo, seq_hi; };
__device__ __forceinline__ const float* inp(int i) { const char* ka = (const char*)__builtin_amdgcn_kernarg_segment_ptr(); int off = i * 8; asm volatile("" : "+s"(off)); return *(const float* const*)(ka + off); }
__device__ __forceinline__ unsigned char* wsb() { const char* ka = (const char*)__builtin_amdgcn_kernarg_segment_ptr(); int off = 27 * 8 + 8; asm volatile("" : "+s"(off)); return *(unsigned char* const*)(ka + off); }
__device__ __forceinline__ float* outb() { const char* ka = (const char*)__builtin_amdgcn_kernarg_segment_ptr(); int off = 27 * 8; asm volatile("" : "+s"(off)); return *(float* const*)(ka + off); }
__device__ __forceinline__ unsigned char* psb(int set) { return wsb() + WS_PSET + (size_t)set * PS_BYTES; }
enum { I_X = 0, I_C, I_CTX, I_CCTX, I_WMOD, I_BMOD, I_G1, I_G2, I_WIN, I_HCW, I_HCB, I_FW1, I_FB1, I_FW2, I_FB2, I_FW3, I_FFQ, I_HBIAS, I_RDEC, I_RPB, I_WBR, I_WOUT, I_FFW1, I_FFCW, I_FFCB, I_FFW2, I_GF };

__device__ __forceinline__ void ph_prologue(const Args& A, LAS unsigned char* lds, int tid) {
    LAS float* sc = (LAS float*)lds;
    LAS float* red = sc + 5 * 2048;
    const float* c = inp(I_C); const float* cc = inp(I_CCTX);
    for (int i = tid; i < 5 * 2048; i += 512) { const int r = i >> 11, k = i & 2047; const float v = (r < 4) ? c[r * 2048 + k] : cc[k]; sc[i] = v / (1.0f + __expf(-v)); }
    __syncthreads();
    float* mod = (float*)(wsb() + WS_MOD);
    const int kq = tid >> 6, col = tid & 63;
    for (int u = blockIdx.x; u < DEPTH * 192; u += gridDim.x) {
        const int l = u / 192, n0 = (u % 192) * 64;
        const float* W = inp(I_WMOD) + (size_t)l * 2048 * 12288 + n0 + col;
        float a0 = 0.f, a1 = 0.f, a2 = 0.f, a3 = 0.f, a4 = 0.f;
        for (int k = kq * 256; k < kq * 256 + 256; ++k) { const float w = W[(size_t)k * 12288];
            a0 += sc[k] * w; a1 += sc[2048 + k] * w; a2 += sc[4096 + k] * w; a3 += sc[6144 + k] * w; a4 += sc[8192 + k] * w; }
        red[(kq * 5 + 0) * 64 + col] = a0; red[(kq * 5 + 1) * 64 + col] = a1; red[(kq * 5 + 2) * 64 + col] = a2; red[(kq * 5 + 3) * 64 + col] = a3; red[(kq * 5 + 4) * 64 + col] = a4;
        __syncthreads();
        if (tid < 320) { const int r = tid >> 6; float s = inp(I_BMOD)[l * 12288 + n0 + col];
#pragma unroll
            for (int q = 0; q < 8; ++q) s += red[(q * 5 + r) * 64 + col];
            mod[((size_t)l * 5 + r) * 12288 + n0 + col] = s; }
        __syncthreads();
    }
    if (blockIdx.x == 0) { f32x2* rope = (f32x2*)(wsb() + WS_ROPE);
        for (int i = tid; i < 1024; i += 512) { const int pos = i >> 4, j = i & 15; const float inv = exp2f(-(float)j * (13.287712379549449f / 16.0f));
            const float rev = (float)pos * inv * 0.15915494309189535f; rope[i] = (f32x2){cos_rev(rev), sin_rev(rev)}; } }
}

__device__ __forceinline__ void ph_convert(const Args& A, int l, int set, int it_lo, int it_hi, int wk, int nwk, LAS unsigned char* lds, int wave, int lane) {
    LAS float* scr = (LAS float*)(lds + wave * 16384);
    const int gw = wk * NWAVES + wave, NGW = nwk * NWAVES;
    constexpr int I_IN = (D / 64) * (INW / 32), I_BR = (1024 / 64) * (D / 32), I_OUT = (D / 64) * (D / 32), I_F1 = (D / 64) * (NFF / 32);
    const float* win = inp(I_WIN) + (size_t)l * D * INW; const float* wbr = inp(I_WBR) + (size_t)l * 3 * 1024 * D; const float* wout = inp(I_WOUT) + (size_t)l * D * D;
    const float* wf1 = inp(I_FFW1) + (size_t)l * D * NFF; const float* wf2 = inp(I_FFW2) + (size_t)l * DFF * D;
    unsigned char* ps = psb(set);
    bf16* WIN = (bf16*)(ps + PS_WIN); bf16* WBR = (bf16*)(ps + PS_WBR); bf16* WOUT = (bf16*)(ps + PS_WOUT); bf16* WF1 = (bf16*)(ps + PS_WF1); bf16* WF2 = (bf16*)(ps + PS_WF2);
    for (int it = it_lo + gw; it < it_hi; it += NGW) {
        int r = it;
        if (r < I_IN) { p0_transpose_item(win, D, INW, WIN, 0, scr, r, lane); continue; } r -= I_IN;
        if (r < I_BR) { p0_transpose_item(wbr, 1024, D, WBR, 0, scr, r, lane); continue; } r -= I_BR;
        if (r < I_BR) { p0_transpose_item(wbr + (size_t)1024 * D, 1024, D, WBR + (size_t)D * 1024, 0, scr, r, lane); continue; } r -= I_BR;
        if (r < I_BR) { p0_transpose_item(wbr + (size_t)2 * 1024 * D, 1024, D, WBR + (size_t)2 * D * 1024, 0, scr, r, lane); continue; } r -= I_BR;
        if (r < I_OUT) { p0_transpose_item(wout, D, D, WOUT, 0, scr, r, lane); continue; } r -= I_OUT;
        if (r < I_F1) { p0_transpose_item(wf1, D, NFF, WF1, 0, scr, r, lane); continue; } r -= I_F1;
        p0_transpose_item(wf2, DFF, D, WF2, 0, scr, r, lane);
    }
}
constexpr int CONV_ITEMS = (D / 64) * (INW / 32) + 3 * (1024 / 64) * (D / 32) + (D / 64) * (D / 32) + (D / 64) * (NFF / 32) + (DFF / 64) * (D / 32);
__device__ __forceinline__ void ph_filt1(const Args& A, int l, int set, int wk, int nwk, LAS unsigned char* lds, int tid) {
    LAS float* feat = (LAS float*)lds;
    LAS float* h1 = feat + 8 * 33;
    const float* w1 = inp(I_FW1) + (size_t)l * 33 * 64; const float* b1 = inp(I_FB1) + l * 64; const float* w2 = inp(I_FW2) + (size_t)l * 64 * 64; const float* b2 = inp(I_FB2) + l * 64;
    const float* fq = inp(I_FFQ) + l * 64; float* FH2 = (float*)(psb(set) + PS_FH2); bf16* FH2B = (bf16*)(psb(set) + PS_FH2B);
    const int pl = tid >> 6, o = tid & 63;
    for (int u = wk; u < 544; u += nwk) {
        const int pos = u * 8 + pl; const bool isc = pos >= 4096; const int Lf = isc ? 256 : 4096, tp = isc ? pos - 4096 : pos;
        if (o < 33) { float f;
            if (o == 0) f = (float)tp / (float)(Lf - 1);
            else { const int i = (o - 1) & 15; const float fr = 1e-4f + (float)i * ((15.0f - 1e-4f) / 15.0f); const float rev = fr * (float)tp / (float)Lf; f = (o <= 16) ? cos_rev(rev) : -sin_rev(rev); }
            feat[pl * 33 + o] = f; }
        __syncthreads();
        float a = b1[o];
#pragma unroll 3
        for (int i = 0; i < 33; ++i) a += feat[pl * 33 + i] * w1[i * 64 + o];
        h1[pl * 64 + o] = sin_rad(fq[o] * a);
        __syncthreads();
        float b = b2[o];
#pragma unroll 4
        for (int j = 0; j < 64; ++j) b += h1[pl * 64 + j] * w2[j * 64 + o];
        { const float hv = sin_rad(fq[o] * b); FH2[(size_t)pos * 64 + o] = hv; FH2B[(size_t)pos * 64 + o] = (bf16)f2bf(hv); }
        __syncthreads();
    }
}
__device__ __forceinline__ void ph_norm(const float* xlat, const float* xctx, const float* g, const float* modl, int sh_off, int sc_off, bf16* H, int Mrows, int wave, int lane) {
    const int gw = blockIdx.x * NWAVES + wave, NGW = gridDim.x * NWAVES;
    for (int m = gw; m < Mrows; m += NGW) {
        const float* xr; int r;
        if (m < ML) { xr = xlat + (size_t)m * D; r = m >> 12; } else { xr = xctx + (size_t)(m - ML) * D; r = 4; }
        const float* mv = modl + (size_t)r * 12288;
        f32x4 v[8]; float ss = 0.f;
#pragma unroll
        for (int j = 0; j < 8; ++j) { v[j] = *(const f32x4*)(xr + (lane + 64 * j) * 4); ss += (v[j].x * v[j].x + v[j].y * v[j].y) + (v[j].z * v[j].z + v[j].w * v[j].w); }
        const float rstd = 1.0f / sqrtf(wave_sum(ss) * (1.0f / D) + EPS);
#pragma unroll
        for (int j = 0; j < 8; ++j) { const int idx = (lane + 64 * j) * 4;
            const f32x4 gg = *(const f32x4*)(g + idx), sh = *(const f32x4*)(mv + sh_off + idx), sc = *(const f32x4*)(mv + sc_off + idx);
            const f32x4 y = v[j] * rstd * gg * (sc + 1.0f) + sh;
            v2u w; w.x = pk2(y.x, y.y); w.y = pk2(y.z, y.w);
            *(v2u*)(H + (size_t)m * D + idx) = w; }
    }
}

__device__ __forceinline__ int fphys(int i) { return i + 2 * (i >> 5); }
__device__ __forceinline__ void bfly_dif(f32x2& a, f32x2& b, float c, float s) { const f32x2 u = a, v = b; a = u + v; const float dx = u.x - v.x, dy = u.y - v.y; b = (f32x2){dx * c + dy * s, dy * c - dx * s}; }
__device__ __forceinline__ void bfly_idit(f32x2& a, f32x2& b, float c, float s) { const f32x2 u = a, q = b; const f32x2 v = (f32x2){q.x * c - q.y * s, q.x * s + q.y * c}; a = u + v; b = u - v; }
template <bool ZHI> __device__ __forceinline__ void dif16(f32x2 (&x)[16], float th) {
    asm volatile("" : "+v"(th));
#pragma unroll
    for (int k = 0; k < 8; ++k) { const float fr = th + (float)k * 0.0625f; const float c = __builtin_amdgcn_cosf(fr), s = __builtin_amdgcn_sinf(fr);
        if (ZHI) { const f32x2 u = x[k]; x[k + 8] = (f32x2){u.x * c + u.y * s, u.y * c - u.x * s}; } else bfly_dif(x[k], x[k + 8], c, s); }
#pragma unroll
    for (int k = 0; k < 4; ++k) { const float fr = 2.0f * th + (float)k * 0.125f; const float c = __builtin_amdgcn_cosf(fr), s = __builtin_amdgcn_sinf(fr);
        bfly_dif(x[k], x[k + 4], c, s); bfly_dif(x[8 + k], x[12 + k], c, s); }
#pragma unroll
    for (int k = 0; k < 2; ++k) { const float fr = 4.0f * th + (float)k * 0.25f; const float c = __builtin_amdgcn_cosf(fr), s = __builtin_amdgcn_sinf(fr);
#pragma unroll
        for (int b = 0; b < 16; b += 4) bfly_dif(x[b + k], x[b + k + 2], c, s); }
    { const float fr = 8.0f * th; const float c = __builtin_amdgcn_cosf(fr), s = __builtin_amdgcn_sinf(fr);
#pragma unroll
        for (int b = 0; b < 16; b += 2) bfly_dif(x[b], x[b + 1], c, s); }
}
__device__ __forceinline__ void idit16(f32x2 (&x)[16], float th) {
    asm volatile("" : "+v"(th));
    { const float fr = 8.0f * th; const float c = __builtin_amdgcn_cosf(fr), s = __builtin_amdgcn_sinf(fr);
#pragma unroll
        for (int b = 0; b < 16; b += 2) bfly_idit(x[b], x[b + 1], c, s); }
#pragma unroll
    for (int k = 0; k < 2; ++k) { const float fr = 4.0f * th + (float)k * 0.25f; const float c = __builtin_amdgcn_cosf(fr), s = __builtin_amdgcn_sinf(fr);
#pragma unroll
        for (int b = 0; b < 16; b += 4) bfly_idit(x[b + k], x[b + k + 2], c, s); }
#pragma unroll
    for (int k = 0; k < 4; ++k) { const float fr = 2.0f * th + (float)k * 0.125f; const float c = __builtin_amdgcn_cosf(fr), s = __builtin_amdgcn_sinf(fr);
        bfly_idit(x[k], x[k + 4], c, s); bfly_idit(x[8 + k], x[12 + k], c, s); }
#pragma unroll
    for (int k = 0; k < 8; ++k) { const float fr = th + (float)k * 0.0625f; const float c = __builtin_amdgcn_cosf(fr), s = __builtin_amdgcn_sinf(fr); bfly_idit(x[k], x[k + 8], c, s); }
}
template <bool INV> __device__ __forceinline__ void fft_pass(LAS f32x2* buf, int base, int stride, float th) {
    f32x2 x[16];
#pragma unroll
    for (int k = 0; k < 16; ++k) x[k] = buf[fphys(base + k * stride)];
    if (INV) idit16(x, th); else dif16<false>(x, th);
#pragma unroll
    for (int k = 0; k < 16; ++k) buf[fphys(base + k * stride)] = x[k];
}
constexpr int FFT_LDS_BYTES = (8192 + 512 + 8) * 8;
__device__ __forceinline__ float block_sum(float v, LAS float* red, int tid) {
    v = wave_sum(v);
    __syncthreads();
    if ((tid & 63) == 0) red[tid >> 6] = v;
    __syncthreads();
    float s = 0.f;
#pragma unroll
    for (int i = 0; i < 8; ++i) s += red[i];
    return s;
}
__device__ __forceinline__ float hy_delta(int c) { const float d0 = -4.605170185988091f / 0.3f, d1 = -4.605170185988091f / 1.5f; return fabsf(d0 + (d1 - d0) * ((float)c / 1023.0f)); }
__device__ __forceinline__ void ph_filt2(const Args& A, int l, int set, int wk, int nwk, LAS unsigned char* lds, int tid) {
    LAS f32x2* buf = (LAS f32x2*)lds; LAS float* bufs = (LAS float*)lds; LAS float* red = (LAS float*)(lds + FFT_LDS_BYTES + 64); LAS float* w3s = red + 32;
    LAS float* ctap = w3s + 256;
    const float* w3 = inp(I_FW3) + (size_t)l * 64 * 4096; const bf16* FH2B = (const bf16*)(psb(set) + PS_FH2B);
    f32x2* KF = (f32x2*)(psb(set) + PS_KF); float* TAPC = (float*)(psb(set) + PS_TAPC);
    const int lane = tid & 63, w = tid >> 6, g = lane >> 4, li = lane & 15;
    for (int c = wk; c < 1024; c += nwk) {
        __syncthreads();
        if (tid < 256) w3s[tid] = w3[(size_t)(tid & 63) * 4096 + (tid >> 7) * 2048 + ((tid >> 6) & 1) * 1024 + c];
        __syncthreads();
        bf16x8 bfr[2];
#pragma unroll
        for (int ks = 0; ks < 2; ++ks) { float v[8];
#pragma unroll
            for (int j = 0; j < 8; ++j) v[j] = (li < 4) ? w3s[li * 64 + 32 * ks + 8 * g + j] : 0.f;
            bfr[ks] = mk8(pk2(v[0], v[1]), pk2(v[2], v[3]), pk2(v[4], v[5]), pk2(v[6], v[7])); }
        const float delta = hy_delta(c); float ssq = 0.f, ssqc = 0.f;
        const int comp = li >> 1;
#pragma unroll 1
        for (int rb = 0; rb < 272; rb += 64)
#pragma unroll
        for (int rk = 0; rk < 8; ++rk) { const int rt = rb + w + 8 * rk; if (rt >= 272) break; const int t0 = rt * 16;
            const bf16* ap = FH2B + (size_t)(t0 + li) * 64 + 8 * g;
            f32x4 acc = (f32x4){0.f, 0.f, 0.f, 0.f};
            acc = mfma16(*(const bf16x8*)ap, bfr[0], acc); acc = mfma16(*(const bf16x8*)(ap + 32), bfr[1], acc);
            if (li < 4) {
                if (rt < 256) {
#pragma unroll
                    for (int j = 0; j < 4; ++j) { const int t = t0 + 4 * g + j; const float val = acc[j] * __expf(-((float)t / 4095.0f) * delta);
                        if ((li & 1) == 0) { bufs[2 * fphys(t) + comp] = val; ssq += val * val; }
                        else if (t >= 1) { bufs[2 * fphys(8192 - t) + comp] = val; ssq += val * val; }
                        else bufs[2 * fphys(4096) + comp] = 0.f; }
                } else {
#pragma unroll
                    for (int j = 0; j < 4; ++j) { const int m = t0 - 4096 + 4 * g + j; const float val = acc[j] * __expf(-((float)m / 255.0f) * delta);
                        ctap[li * 256 + m] = val; if ((li & 1) == 0 || m >= 1) ssqc += val * val; }
                }
            }
        }
        const bool o0 = (li < 2), o1 = (li == 2 || li == 3);
        const float scl0 = (1.0f / 8192.0f) / sqrtf(block_sum(o0 ? ssq : 0.f, red, tid) + EPS), scl1 = (1.0f / 8192.0f) / sqrtf(block_sum(o1 ? ssq : 0.f, red, tid) + EPS);
        const float sc0 = 1.0f / sqrtf(block_sum(o0 ? ssqc : 0.f, red, tid) + EPS), sc1 = 1.0f / sqrtf(block_sum(o1 ? ssqc : 0.f, red, tid) + EPS);
        __syncthreads();
        fft_pass<false>(buf, tid, 512, (float)tid * (1.0f / 8192.0f));
        __syncthreads();
        fft_pass<false>(buf, (tid >> 5) * 512 + (tid & 31), 32, (float)(tid & 31) * (1.0f / 512.0f));
        __syncthreads();
        fft_pass<false>(buf, (tid >> 1) * 32 + (tid & 1), 2, (float)(tid & 1) * (1.0f / 32.0f));
        __syncthreads();
#pragma unroll
        for (int r = 0; r < 8; ++r) { LAS f32x4* pp = (LAS f32x4*)(buf + fphys(2 * (tid + 512 * r))); const f32x4 ab = *pp; *pp = (f32x4){ab.x + ab.z, ab.y + ab.w, ab.x - ab.z, ab.y - ab.w}; }
        __syncthreads();
        f32x2* d0 = KF + (size_t)c * 8192; f32x2* d1 = KF + (size_t)(1024 + c) * 8192;
#pragma unroll 4
        for (int i = 0; i < 16; ++i) { const int p = tid + 512 * i; const int f = (int)(__brev((unsigned)p) >> 19); const int pp = (int)(__brev((unsigned)((8192 - f) & 8191)) >> 19);
            const f32x2 z = buf[fphys(p)], zp = buf[fphys(pp)];
            d0[p] = (f32x2){(z.x + zp.x) * 0.5f * scl0, (z.y - zp.y) * 0.5f * scl0};
            d1[p] = (f32x2){(z.y + zp.y) * 0.5f * scl1, (zp.x - z.x) * 0.5f * scl1}; }
        for (int q = tid; q < 1024; q += 512) { const int od = q >> 8, m = q & 255; TAPC[((size_t)od * 1024 + c) * 256 + m] = ctap[q] * ((od < 2) ? sc0 : sc1); }
    }
}

__device__ __forceinline__ void ph_hyprep(const Args& A, int l, LAS unsigned char* lds, int tid) {
    LAS bf16* T = (LAS bf16*)lds;
    const bf16* Z = (const bf16*)(wsb() + WS_Z); bf16* HYT = (bf16*)(wsb() + WS_HYT);
    const float* cw = inp(I_HCW) + (size_t)l * 3 * 3072; const float* cb = inp(I_HCB) + (size_t)l * 3072;
    for (int u = blockIdx.x; u < 3072; u += gridDim.x) {
        const int cg = u % 12, tt = (u / 12) & 63, b = u / 768;
        __syncthreads();
        for (int q = tid; q < 66 * 32; q += 512) { const int r = q >> 5, ch8 = q & 31, t = tt * 64 - 1 + r;
            v4u v = (v4u){0u, 0u, 0u, 0u};
            if (t >= 0 && t < SEQ) v = *(const v4u*)(Z + (size_t)(b * SEQ + t) * INW + C_HY + cg * 256 + ch8 * 8);
            *(LAS v4u*)(T + r * 264 + ch8 * 8) = v; }
        __syncthreads();
        const int ch = tid & 255, half = tid >> 8, gch = cg * 256 + ch;
        const float w0 = cw[gch], w1 = cw[3072 + gch], w2 = cw[6144 + gch], bb = cb[gch];
        const int part = gch >> 10, c = gch & 1023;
        bf16* outp = HYT + ((size_t)(part * NB + b) * 1024 + c) * SEQ + tt * 64 + half * 32;
#pragma unroll
        for (int tq = 0; tq < 4; ++tq) { float vv[8];
#pragma unroll
            for (int e = 0; e < 8; ++e) { const int tl = half * 32 + tq * 8 + e;
                vv[e] = w0 * bf1(T[tl * 264 + ch]) + w1 * bf1(T[(tl + 1) * 264 + ch]) + w2 * bf1(T[(tl + 2) * 264 + ch]) + bb; }
            v4u w; w.x = pk2(vv[0], vv[1]); w.y = pk2(vv[2], vv[3]); w.z = pk2(vv[4], vv[5]); w.w = pk2(vv[6], vv[7]);
            *(v4u*)(outp + tq * 8) = w; }
    }
}
__device__ __forceinline__ void ph_hyctx(const Args& A, int l, LAS unsigned char* lds, int tid) {
    const bf16* Z = (const bf16*)(wsb() + WS_Z); bf16* YS = (bf16*)(wsb() + WS_YS); const float* TAPC = (const float*)(psb(l & 1) + PS_TAPC);
    const float* cw = inp(I_HCW) + (size_t)l * 3 * 3072; const float* cb = inp(I_HCB) + (size_t)l * 3072; const float* hb = inp(I_HBIAS) + (size_t)l * 2 * 1024;
    const int ch = tid >> 6, q = tid & 63, t0 = 4 * q;
    LAS float* Y = (LAS float*)lds + ch * 1552; LAS float* Y1 = Y + 256; LAS float* G0 = Y + 512; LAS float* G1 = Y + 1032;
    for (int u = blockIdx.x; u < 512; u += gridDim.x) {
        const int b = u >> 7, c = (u & 127) * 8 + ch;
        __syncthreads();
        float pv[3][4];
#pragma unroll
        for (int part = 0; part < 3; ++part) { const int gch = part * 1024 + c; const float w0 = cw[gch], w1 = cw[3072 + gch], w2 = cw[6144 + gch], bb = cb[gch];
            const bf16* zp = Z + (size_t)(ML + b * CL + t0) * INW + C_HY + gch;
            float zz[6];
#pragma unroll
            for (int e = 0; e < 6; ++e) { const int t = t0 - 1 + e; zz[e] = (t >= 0 && t < CL) ? bf1(zp[(ptrdiff_t)(e - 1) * INW]) : 0.f; }
#pragma unroll
            for (int r = 0; r < 4; ++r) pv[part][r] = w0 * zz[r] + w1 * zz[r + 1] + w2 * zz[r + 2] + bb; }
        *(LAS f32x4*)(Y + t0) = (f32x4){pv[2][0], pv[2][1], pv[2][2], pv[2][3]};
#pragma unroll
        for (int r = 0; r < 4; ++r) { const int m = t0 + r;
            G0[m + 259] = TAPC[((size_t)(0 * 2 + 0) * 1024 + c) * 256 + m]; G1[m + 259] = TAPC[((size_t)(1 * 2 + 0) * 1024 + c) * 256 + m];
            if (m >= 1) { G0[259 - m] = TAPC[((size_t)(0 * 2 + 1) * 1024 + c) * 256 + m]; G1[259 - m] = TAPC[((size_t)(1 * 2 + 1) * 1024 + c) * 256 + m]; } }
        if (q == 0) { G0[515] = 0.f; G1[515] = 0.f; G0[516] = 0.f; G1[516] = 0.f; }
        __syncthreads();
        float yprev[4] = {pv[2][0], pv[2][1], pv[2][2], pv[2][3]};
#pragma unroll
        for (int ord = 0; ord < 2; ++ord) {
            const LAS float* Ys = ord ? Y1 : Y; const LAS float* G = ord ? G1 : G0;
            float acc[4] = {0.f, 0.f, 0.f, 0.f};
#pragma unroll 4
            for (int sp = 0; sp < 64; ++sp) { const f32x4 yv = *(const LAS f32x4*)(Ys + 4 * sp); const LAS float* gp = G + 4 * (q - sp) + 256;
                const f32x4 ga = *(const LAS f32x4*)gp, gb = *(const LAS f32x4*)(gp + 4);
                const float g[8] = {ga.x, ga.y, ga.z, ga.w, gb.x, gb.y, gb.z, gb.w}; const float yy[4] = {yv.x, yv.y, yv.z, yv.w};
#pragma unroll
                for (int r = 0; r < 4; ++r)
#pragma unroll
                    for (int j = 0; j < 4; ++j) acc[r] += yy[j] * g[r - j + 3]; }
            const float bias = hb[ord * 1024 + c];
#pragma unroll
            for (int r = 0; r < 4; ++r) yprev[r] = pv[ord][r] * (acc[r] + bias * yprev[r]);
            if (ord == 0) { *(LAS f32x4*)(Y1 + t0) = (f32x4){yprev[0], yprev[1], yprev[2], yprev[3]}; __syncthreads(); }
        }
#pragma unroll
        for (int r = 0; r < 4; ++r) YS[(size_t)(ML + b * CL + t0 + r) * 1024 + c] = (bf16)f2bf(yprev[r]);
    }
}
__device__ __forceinline__ void unpack8(v4u v, float (&x)[8]) { x[0] = bflo(v.x); x[1] = bfhi(v.x); x[2] = bflo(v.y); x[3] = bfhi(v.y); x[4] = bflo(v.z); x[5] = bfhi(v.z); x[6] = bflo(v.w); x[7] = bfhi(v.w); }
__device__ __forceinline__ v4u pack8(const float (&x)[8]) { v4u w; w.x = pk2(x[0], x[1]); w.y = pk2(x[2], x[3]); w.z = pk2(x[4], x[5]); w.w = pk2(x[6], x[7]); return w; }
__device__ __forceinline__ void rope8(float (&lo)[8], float (&hi)[8], const f32x2* rt) {
#pragma unroll
    for (int e = 0; e < 8; ++e) { const f32x2 cs = rt[e]; const float a = lo[e], b = hi[e]; lo[e] = a * cs.x - b * cs.y; hi[e] = b * cs.x + a * cs.y; }
}
__device__ __forceinline__ void vt_store(LAS bf16* Vt, int ld, int d0, int r, v4u vv) {
    Vt[(d0 + 0) * ld + r] = (bf16)(vv.x & 0xffffu); Vt[(d0 + 1) * ld + r] = (bf16)(vv.x >> 16);
    Vt[(d0 + 2) * ld + r] = (bf16)(vv.y & 0xffffu); Vt[(d0 + 3) * ld + r] = (bf16)(vv.y >> 16);
    Vt[(d0 + 4) * ld + r] = (bf16)(vv.z & 0xffffu); Vt[(d0 + 5) * ld + r] = (bf16)(vv.z >> 16);
    Vt[(d0 + 6) * ld + r] = (bf16)(vv.w & 0xffffu); Vt[(d0 + 7) * ld + r] = (bf16)(vv.w >> 16);
}
constexpr float LOG2E = 1.4426950408889634f;
__device__ __forceinline__ void ph_ret1(const Args& A, int l, int nctx_units, LAS unsigned char* lds, int tid) {
    LAS bf16* KfT = (LAS bf16*)lds; LAS bf16* KbT = KfT + 64 * 136; LAS bf16* Vt = KbT + 64 * 136;
    const bf16* Z = (const bf16*)(wsb() + WS_Z); float* KV = (float*)(wsb() + WS_KV); const f32x2* rope = (const f32x2*)(wsb() + WS_ROPE);
    const int lane = tid & 63, w = tid >> 6, g = lane >> 4, li = lane & 15;
    for (int uid = blockIdx.x; uid < 1024 + nctx_units; uid += gridDim.x) {
        const bool isc = uid >= 1024; int b, h, n, ci; size_t m0;
        if (!isc) { b = uid >> 8; h = (uid >> 5) & 7; n = uid & 31; m0 = (size_t)b * SEQ + n * 128; ci = 2 + n; }
        else { const int i = uid - 1024; b = i >> 4; h = (i >> 1) & 7; n = i & 1; m0 = (size_t)ML + b * CL + n * 128; ci = n; }
        const float lgf = inp(I_RDEC)[(l * 2 + 0) * 8 + h] * LOG2E, lgb = inp(I_RDEC)[(l * 2 + 1) * 8 + h] * LOG2E;
        __syncthreads();
        { const int tok = tid >> 2, pp = tid & 3, a = (pp & 1) + ((pp >> 1) << 2);
            const bf16* kr = Z + (m0 + tok) * INW + C_RK + h * 64;
            float lo[8], hi[8]; unpack8(*(const v4u*)(kr + 8 * a), lo); unpack8(*(const v4u*)(kr + 8 * a + 16), hi);
            if (!isc) { const int t = n * 128 + tok; const int pos = (a < 4) ? (t >> 6) : (t & 63); rope8(lo, hi, rope + pos * 16 + 8 * (a & 1)); }
            const float zf = ex2(lgf * (float)(127 - tok)) * 0.125f, zb = ex2(lgb * (float)tok) * 0.125f;
#pragma unroll
            for (int e = 0; e < 8; ++e) { const int d = 8 * a + e;
                KfT[d * 136 + tok] = (bf16)f2bf(lo[e] * zf); KbT[d * 136 + tok] = (bf16)f2bf(lo[e] * zb);
                KfT[(d + 16) * 136 + tok] = (bf16)f2bf(hi[e] * zf); KbT[(d + 16) * 136 + tok] = (bf16)f2bf(hi[e] * zb); } }
        for (int q = tid; q < 2048; q += 512) { const int r = q >> 4, ch = q & 15; vt_store(Vt, 136, ch * 8, r, *(const v4u*)(Z + (m0 + r) * INW + C_RV + h * 128 + ch * 8)); }
        __syncthreads();
        bf16x8 af[4];
#pragma unroll
        for (int ks = 0; ks < 4; ++ks) af[ks] = *(const LAS bf16x8*)(Vt + (16 * w + li) * 136 + 32 * ks + 8 * g);
#pragma unroll
        for (int dir = 0; dir < 2; ++dir) { const LAS bf16* KT = dir ? KbT : KfT;
            float* dst = KV + ((size_t)((b * 8 + h) * 2 + dir) * 34 + ci) * 8192;
#pragma unroll
            for (int nc = 0; nc < 4; ++nc) { f32x4 acc = (f32x4){0.f, 0.f, 0.f, 0.f};
#pragma unroll
                for (int ks = 0; ks < 4; ++ks) acc = mfma16(af[ks], *(const LAS bf16x8*)(KT + (16 * nc + li) * 136 + 32 * ks + 8 * g), acc);
#pragma unroll
                for (int j = 0; j < 4; ++j) dst[(16 * w + 4 * g + j) * 64 + 16 * nc + li] = acc[j]; } }
    }
}
__device__ __forceinline__ void ph_natt(const Args& A, int l, int nctx_units, LAS unsigned char* lds, int tid) {
    LAS bf16* Qs = (LAS bf16*)lds; LAS bf16* KV0 = Qs + 128 * 136; LAS float* rpbs = (LAS float*)(KV0 + 2 * (64 * 136 + 128 * 68));
    const bf16* Z = (const bf16*)(wsb() + WS_Z); bf16* YS = (bf16*)(wsb() + WS_YS) + (size_t)2 * MT * 1024;
    const int lane = tid & 63, w = tid >> 6, g = lane >> 4, li = lane & 15;
    const float SCALE = 0.08838834764831845f;
    const int sr0 = tid >> 4, sch = tid & 15;
    for (int uid = blockIdx.x; uid < 1024 + nctx_units; uid += gridDim.x) {
        const bool isc = uid >= 1024; int b, h, rp = 0; size_t m0;
        if (!isc) { b = uid >> 8; h = (uid >> 5) & 7; rp = uid & 31; m0 = (size_t)b * SEQ + rp * 128; }
        else { const int i = uid - 1024; b = i >> 4; h = (i >> 1) & 7; m0 = (size_t)ML + b * CL + (i & 1) * 128; }
        const size_t mc0 = (size_t)ML + b * CL;
        const int qr = 2 * rp + (w >> 2), cw = w & 3, qc = 16 * cw + li;
        const int cs = min(max(qc - 8, 0), 48), rs_w = min(max(qr - 4, 0), 56);
        const int kr_lo = min(max(2 * rp - 4, 0), 56), kr_hi = min(max(2 * rp - 3, 0), 56) + 7;
        const int nwin = isc ? 0 : (kr_hi - kr_lo + 1), ntile = nwin + 4;
        const int nlo_w = (cw <= 1) ? 0 : cw - 1, nhi_w = (cw == 0) ? 1 : ((cw == 3) ? 3 : cw + 1);
        v4u kreg[2], vreg[2];
#define NA_LOAD(t_) do { const int t__ = (t_); const size_t mk = (t__ < nwin) ? ((size_t)b * SEQ + (kr_lo + t__) * 64) : (mc0 + (t__ - nwin) * 64); \
            _Pragma("unroll") for (int e = 0; e < 2; ++e) { const bf16* zr = Z + (mk + sr0 + 32 * e) * INW + h * 128 + sch * 8; kreg[e] = *(const v4u*)(zr + C_NK); vreg[e] = *(const v4u*)(zr + C_NV); } } while (0)
#define NA_STORE(buf_) do { LAS bf16* Kd = KV0 + (buf_) * (64 * 136 + 128 * 68); LAS bf16* Vd = Kd + 64 * 136; \
            _Pragma("unroll") for (int e = 0; e < 2; ++e) { *(LAS v4u*)(Kd + (sr0 + 32 * e) * 136 + sch * 8) = kreg[e]; vt_store(Vd, 68, sch * 8, sr0 + 32 * e, vreg[e]); } } while (0)
        __syncthreads();
        NA_LOAD(0);
        for (int q = tid; q < 2048; q += 512) { const int r = q >> 4, chn = q & 15; *(LAS v4u*)(Qs + r * 136 + chn * 8) = *(const v4u*)(Z + (m0 + r) * INW + C_NQ + h * 128 + chn * 8); }
        if (!isc) for (int i = tid; i < 465; i += 512) rpbs[i] = inp(I_RPB)[((size_t)l * 8 + h) * 465 + i];
        NA_STORE(0);
        __syncthreads();
        bf16x8 qf[4];
#pragma unroll
        for (int ks = 0; ks < 4; ++ks) qf[ks] = *(const LAS bf16x8*)(Qs + (16 * w + li) * 136 + 32 * ks + 8 * g);
        f32x4 o[8];
#pragma unroll
        for (int nd = 0; nd < 8; ++nd) o[nd] = (f32x4){0.f, 0.f, 0.f, 0.f};
        float mrun = -1e30f, lrun = 0.f;
        for (int t = 0; t < ntile; ++t) {
            const bool win = t < nwin; const int kr = kr_lo + t;
            if (t + 1 < ntile) NA_LOAD(t + 1);
            const LAS bf16* Ks = KV0 + (t & 1) * (64 * 136 + 128 * 68); const LAS bf16* Vt = Ks + 64 * 136;
            const bool active = !win || (kr >= rs_w && kr <= rs_w + 7);
            if (active) {
                const int nlo = win ? nlo_w : 0, nhi = win ? nhi_w : 3;
                f32x4 s[4];
#pragma unroll
                for (int n = 0; n < 4; ++n) { s[n] = (f32x4){0.f, 0.f, 0.f, 0.f};
                    if (n >= nlo && n <= nhi) {
#pragma unroll
                        for (int ks = 0; ks < 4; ++ks) s[n] = mfma16(*(const LAS bf16x8*)(Ks + (16 * n + li) * 136 + 32 * ks + 8 * g), qf[ks], s[n]); } }
                float tmax = -1e30f;
#pragma unroll
                for (int n = 0; n < 4; ++n)
#pragma unroll
                    for (int j = 0; j < 4; ++j) { float v = s[n][j] * SCALE;
                        if (win) { const int kc = 16 * n + 4 * g + j; const bool valid = (kc >= cs) && (kc < cs + 16);
                            const int dc = min(max(kc - qc + 15, 0), 30), dr = min(max(kr - qr + 7, 0), 14);
                            v = valid ? v + rpbs[dr * 31 + dc] : -1e30f; }
                        s[n][j] = v; tmax = fmaxf(tmax, v); }
                tmax = fmaxf(tmax, __shfl_xor(tmax, 16)); tmax = fmaxf(tmax, __shfl_xor(tmax, 32));
                const float mnew = fmaxf(mrun, tmax), alpha = __expf(mrun - mnew);
                float psum = 0.f;
#pragma unroll
                for (int n = 0; n < 4; ++n)
#pragma unroll
                    for (int j = 0; j < 4; ++j) { const float pv = __expf(s[n][j] - mnew); s[n][j] = pv; psum += pv; }
                psum += __shfl_xor(psum, 16); psum += __shfl_xor(psum, 32);
                lrun = lrun * alpha + psum; mrun = mnew;
#pragma unroll
                for (int nd = 0; nd < 8; ++nd) o[nd] = o[nd] * alpha;
#pragma unroll
                for (int kk = 0; kk < 2; ++kk) {
                    if (2 * kk + 1 >= nlo && 2 * kk <= nhi) {
                        const bf16x8 pf = mk8(pk2(s[2 * kk][0], s[2 * kk][1]), pk2(s[2 * kk][2], s[2 * kk][3]), pk2(s[2 * kk + 1][0], s[2 * kk + 1][1]), pk2(s[2 * kk + 1][2], s[2 * kk + 1][3]));
#pragma unroll
                        for (int nd = 0; nd < 8; ++nd) { const LAS bf16* vp = Vt + (16 * nd + li) * 68 + 32 * kk + 4 * g;
                            const v2u lo = *(const LAS v2u*)vp, hi = *(const LAS v2u*)(vp + 16);
                            o[nd] = mfma16(mk8(lo.x, lo.y, hi.x, hi.y), pf, o[nd]); } } }
            }
            if (t + 1 < ntile) NA_STORE((t + 1) & 1);
            __syncthreads();
        }
#undef NA_LOAD
#undef NA_STORE
        const float inv = 1.0f / lrun; const size_t mrow = m0 + 16 * w + li;
#pragma unroll
        for (int nd = 0; nd < 8; ++nd) { v2u wv; wv.x = pk2(o[nd][0] * inv, o[nd][1] * inv); wv.y = pk2(o[nd][2] * inv, o[nd][3] * inv);
            *(v2u*)(YS + mrow * 1024 + h * 128 + 16 * nd + 4 * g) = wv; }
    }
}

__device__ __forceinline__ void ph_hyfft(const Args& A, int l, LAS unsigned char* lds, int tid) {
    LAS f32x2* buf = (LAS f32x2*)lds;
    const bf16* HYT = (const bf16*)(wsb() + WS_HYT); bf16* YT = (bf16*)(wsb() + WS_YT); const f32x2* KF = (const f32x2*)(psb(l & 1) + PS_KF);
    const float* hb = inp(I_HBIAS) + (size_t)l * 2 * 1024;
    const int baseB = (tid >> 5) * 512 + (tid & 31), baseC = (tid >> 1) * 32 + (tid & 1);
    const float thA = (float)tid * (1.0f / 8192.0f), thB = (float)(tid & 31) * (1.0f / 512.0f), thC = (float)(tid & 1) * (1.0f / 32.0f);
    for (int u = blockIdx.x; u < 2048; u += gridDim.x) {
        const int c = u >> 1, b0 = (u & 1) * 2;
        const bf16* x1p = HYT + ((size_t)(0 * NB + b0) * 1024 + c) * SEQ; const bf16* x2p = HYT + ((size_t)(1 * NB + b0) * 1024 + c) * SEQ; const bf16* vp = HYT + ((size_t)(2 * NB + b0) * 1024 + c) * SEQ;
        const size_t bstr = (size_t)1024 * SEQ;
        float y0[8], y1[8];
#pragma unroll
        for (int i = 0; i < 8; ++i) { const int t = tid + 512 * i; y0[i] = bf1(vp[t]); y1[i] = bf1(vp[bstr + t]); }
#pragma unroll
        for (int ord = 0; ord < 2; ++ord) {
            { f32x2 x[16];
#pragma unroll
                for (int k = 0; k < 8; ++k) { x[k] = (f32x2){y0[k], y1[k]}; x[k + 8] = (f32x2){0.f, 0.f}; }
                dif16<true>(x, thA);
                __syncthreads();
#pragma unroll
                for (int k = 0; k < 16; ++k) buf[fphys(tid + 512 * k)] = x[k]; }
            __syncthreads();
            fft_pass<false>(buf, baseB, 32, thB);
            __syncthreads();
            fft_pass<false>(buf, baseC, 2, thC);
            __syncthreads();
            { const f32x4* kf = (const f32x4*)(KF + (size_t)(ord * 1024 + c) * 8192);
#pragma unroll
                for (int r = 0; r < 8; ++r) { const int i = tid + 512 * r; LAS f32x4* pp = (LAS f32x4*)(buf + fphys(2 * i)); const f32x4 ab = *pp; const f32x4 kk = kf[i];
                    const float ax = ab.x + ab.z, ay = ab.y + ab.w, bx = ab.x - ab.z, by = ab.y - ab.w;
                    const float px = ax * kk.x - ay * kk.y, py = ax * kk.y + ay * kk.x, qx = bx * kk.z - by * kk.w, qy = bx * kk.w + by * kk.z;
                    *pp = (f32x4){px + qx, py + qy, px - qx, py - qy}; } }
            __syncthreads();
            fft_pass<true>(buf, baseC, 2, thC);
            __syncthreads();
            fft_pass<true>(buf, baseB, 32, thB);
            __syncthreads();
            { f32x2 x[16];
#pragma unroll
                for (int k = 0; k < 16; ++k) x[k] = buf[fphys(tid + 512 * k)];
                idit16(x, thA);
                const bf16* xp = ord ? x2p : x1p; const float bias = hb[ord * 1024 + c];
#pragma unroll
                for (int k = 0; k < 8; ++k) { const int t = tid + 512 * k;
                    y0[k] = bf1(xp[t]) * (x[k].x + bias * y0[k]); y1[k] = bf1(xp[bstr + t]) * (x[k].y + bias * y1[k]); } }
        }
        bf16* o0 = YT + ((size_t)b0 * 1024 + c) * SEQ;
#pragma unroll
        for (int i = 0; i < 8; ++i) { const int t = tid + 512 * i; o0[t] = (bf16)f2bf(y0[i]); o0[bstr + t] = (bf16)f2bf(y1[i]); }
    }
}
__device__ __forceinline__ void ph_scan(const Args& A, int l, int tid) {
    float* KV = (float*)(wsb() + WS_KV);
    for (int gt = blockIdx.x * 512 + tid; gt < NB * 8 * 2 * 2048; gt += gridDim.x * 512) {
        const int bhd = gt >> 11, e4 = gt & 2047, dir = bhd & 1, h = (bhd >> 1) & 7;
        const float gC = ex2(inp(I_RDEC)[(l * 2 + dir) * 8 + h] * LOG2E * 128.0f);
        f32x4* base = (f32x4*)(KV + (size_t)bhd * 34 * 8192) + e4;
        f32x4 s = (f32x4){0.f, 0.f, 0.f, 0.f};
#pragma unroll 2
        for (int step = 0; step < 34; ++step) { const int ci = (dir == 0) ? step : (step == 0 ? 1 : (step == 1 ? 0 : 35 - step));
            const f32x4 tmp = base[(size_t)ci * 2048]; base[(size_t)ci * 2048] = s; s = s * gC + tmp; }
    }
}

__device__ __forceinline__ void ph_hypost(const Args& A, LAS unsigned char* lds, int tid) {
    LAS bf16* T = (LAS bf16*)lds;
    const bf16* YT = (const bf16*)(wsb() + WS_YT); bf16* YS = (bf16*)(wsb() + WS_YS);
    for (int u = blockIdx.x; u < 1024; u += gridDim.x) {
        const int cg = u & 3, tt = (u >> 2) & 63, b = u >> 8;
        __syncthreads();
        for (int q = tid; q < 2048; q += 512) { const int c = q >> 3, t8 = q & 7;
            *(LAS v4u*)(T + c * 72 + t8 * 8) = *(const v4u*)(YT + ((size_t)b * 1024 + cg * 256 + c) * SEQ + tt * 64 + t8 * 8); }
        __syncthreads();
        const int t = tid >> 3, c32 = tid & 7;
#pragma unroll
        for (int q = 0; q < 4; ++q) { const int cb = c32 * 32 + q * 8; v4u w;
            w.x = (unsigned)T[(cb + 0) * 72 + t] | ((unsigned)T[(cb + 1) * 72 + t] << 16); w.y = (unsigned)T[(cb + 2) * 72 + t] | ((unsigned)T[(cb + 3) * 72 + t] << 16);
            w.z = (unsigned)T[(cb + 4) * 72 + t] | ((unsigned)T[(cb + 5) * 72 + t] << 16); w.w = (unsigned)T[(cb + 6) * 72 + t] | ((unsigned)T[(cb + 7) * 72 + t] << 16);
            *(v4u*)(YS + (size_t)(b * SEQ + tt * 64 + t) * 1024 + cg * 256 + cb) = w; }
    }
}
__device__ __forceinline__ void ph_ret3(const Args& A, int l, int nctx_units, LAS unsigned char* lds, int tid) {
    LAS bf16* Qs = (LAS bf16*)lds; LAS bf16* Ks = Qs + 128 * 72; LAS bf16* Vt = Ks + 128 * 72; LAS bf16* Sf = Vt + 128 * 136; LAS bf16* Sb = Sf + 128 * 72;
    const bf16* Z = (const bf16*)(wsb() + WS_Z); const float* KV = (const float*)(wsb() + WS_KV); const f32x2* rope = (const f32x2*)(wsb() + WS_ROPE);
    bf16* YS = (bf16*)(wsb() + WS_YS) + (size_t)MT * 1024;
    const int lane = tid & 63, w = tid >> 6, g = lane >> 4, li = lane & 15;
    for (int uid = blockIdx.x; uid < 1024 + nctx_units; uid += gridDim.x) {
        const bool isc = uid >= 1024; int b, h, n, ci; size_t m0;
        if (!isc) { b = uid >> 8; h = (uid >> 5) & 7; n = uid & 31; m0 = (size_t)b * SEQ + n * 128; ci = 2 + n; }
        else { const int i = uid - 1024; b = i >> 4; h = (i >> 1) & 7; n = i & 1; m0 = (size_t)ML + b * CL + n * 128; ci = n; }
        const float lgf = inp(I_RDEC)[(l * 2 + 0) * 8 + h] * LOG2E, lgb = inp(I_RDEC)[(l * 2 + 1) * 8 + h] * LOG2E;
        __syncthreads();
        { const int tok = tid >> 2, pp = tid & 3, a = (pp & 1) + ((pp >> 1) << 2);
            const int t = n * 128 + tok; const int pos = (a < 4) ? (t >> 6) : (t & 63); const f32x2* rt = rope + pos * 16 + 8 * (a & 1);
            const bf16* qr = Z + (m0 + tok) * INW + C_RQ + h * 64; const bf16* kr = Z + (m0 + tok) * INW + C_RK + h * 64;
            float lo[8], hi[8];
            unpack8(*(const v4u*)(qr + 8 * a), lo); unpack8(*(const v4u*)(qr + 8 * a + 16), hi);
            if (!isc) rope8(lo, hi, rt);
            *(LAS v4u*)(Qs + tok * 72 + 8 * a) = pack8(lo); *(LAS v4u*)(Qs + tok * 72 + 8 * a + 16) = pack8(hi);
            unpack8(*(const v4u*)(kr + 8 * a), lo); unpack8(*(const v4u*)(kr + 8 * a + 16), hi);
            if (!isc) rope8(lo, hi, rt);
#pragma unroll
            for (int e = 0; e < 8; ++e) { lo[e] *= 0.125f; hi[e] *= 0.125f; }
            *(LAS v4u*)(Ks + tok * 72 + 8 * a) = pack8(lo); *(LAS v4u*)(Ks + tok * 72 + 8 * a + 16) = pack8(hi); }
        for (int q = tid; q < 2048; q += 512) { const int r = q >> 4, ch = q & 15; vt_store(Vt, 136, ch * 8, r, *(const v4u*)(Z + (m0 + r) * INW + C_RV + h * 128 + ch * 8)); }
#pragma unroll
        for (int dir = 0; dir < 2; ++dir) { const f32x4* src = (const f32x4*)(KV + ((size_t)((b * 8 + h) * 2 + dir) * 34 + ci) * 8192); LAS bf16* S = dir ? Sb : Sf;
            for (int q = tid; q < 2048; q += 512) { const f32x4 v = src[q]; v2u wv; wv.x = pk2(v.x, v.y); wv.y = pk2(v.z, v.w); *(LAS v2u*)(S + (q >> 4) * 72 + (q & 15) * 4) = wv; } }
        __syncthreads();
        const int iq = 16 * w + li;
        bf16x8 qf[2];
#pragma unroll
        for (int ks = 0; ks < 2; ++ks) qf[ks] = *(const LAS bf16x8*)(Qs + iq * 72 + 32 * ks + 8 * g);
        f32x4 s[8];
#pragma unroll
        for (int nn = 0; nn < 8; ++nn) { s[nn] = (f32x4){0.f, 0.f, 0.f, 0.f};
#pragma unroll
            for (int ks = 0; ks < 2; ++ks) s[nn] = mfma16(*(const LAS bf16x8*)(Ks + (16 * nn + li) * 72 + 32 * ks + 8 * g), qf[ks], s[nn]);
#pragma unroll
            for (int j = 0; j < 4; ++j) { const int d = iq - (16 * nn + 4 * g + j); s[nn][j] *= (d >= 0) ? ex2(lgf * (float)d) : ex2(lgb * (float)(-d)); } }
        f32x4 o[8];
#pragma unroll
        for (int nd = 0; nd < 8; ++nd) o[nd] = (f32x4){0.f, 0.f, 0.f, 0.f};
#pragma unroll
        for (int kk = 0; kk < 4; ++kk) {
            const bf16x8 pf = mk8(pk2(s[2 * kk][0], s[2 * kk][1]), pk2(s[2 * kk][2], s[2 * kk][3]), pk2(s[2 * kk + 1][0], s[2 * kk + 1][1]), pk2(s[2 * kk + 1][2], s[2 * kk + 1][3]));
#pragma unroll
            for (int nd = 0; nd < 8; ++nd) { const LAS bf16* vp = Vt + (16 * nd + li) * 136 + 32 * kk + 4 * g;
                const v2u lo = *(const LAS v2u*)vp, hi = *(const LAS v2u*)(vp + 16);
                o[nd] = mfma16(mk8(lo.x, lo.y, hi.x, hi.y), pf, o[nd]); } }
        const float xif = ex2(lgf * (float)(iq + 1)), xib = ex2(lgb * (float)(128 - iq));
        float ss = 0.f;
#pragma unroll
        for (int nd = 0; nd < 8; ++nd) { f32x4 tf = (f32x4){0.f, 0.f, 0.f, 0.f}, tb = (f32x4){0.f, 0.f, 0.f, 0.f};
#pragma unroll
            for (int ks = 0; ks < 2; ++ks) { tf = mfma16(*(const LAS bf16x8*)(Sf + (16 * nd + li) * 72 + 32 * ks + 8 * g), qf[ks], tf);
                tb = mfma16(*(const LAS bf16x8*)(Sb + (16 * nd + li) * 72 + 32 * ks + 8 * g), qf[ks], tb); }
            o[nd] = o[nd] + tf * xif + tb * xib;
            ss += (o[nd][0] * o[nd][0] + o[nd][1] * o[nd][1]) + (o[nd][2] * o[nd][2] + o[nd][3] * o[nd][3]); }
        ss += __shfl_xor(ss, 16); ss += __shfl_xor(ss, 32);
        const float rn = 1.0f / sqrtf(ss * (1.0f / 128.0f) + EPS);
        const size_t mrow = m0 + iq;
#pragma unroll
        for (int nd = 0; nd < 8; ++nd) { const int dv = 16 * nd + 4 * g; const v2u gv = *(const v2u*)(Z + mrow * INW + C_RG + h * 128 + dv);
            const float g0 = bflo(gv.x), g1 = bfhi(gv.x), g2 = bflo(gv.y), g3 = bfhi(gv.y);
            v2u wv; wv.x = pk2(g0 / (1.0f + __expf(-g0)) * o[nd][0] * rn, g1 / (1.0f + __expf(-g1)) * o[nd][1] * rn);
            wv.y = pk2(g2 / (1.0f + __expf(-g2)) * o[nd][2] * rn, g3 / (1.0f + __expf(-g3)) * o[nd][3] * rn);
            *(v2u*)(YS + mrow * 1024 + h * 128 + dv) = wv; }
    }
}

__device__ __forceinline__ float gelu_t(float x) { const float u = 0.7978845608028654f * (x + 0.044715f * x * x * x); const float e = __expf(2.0f * u); return 0.5f * x * (2.0f - 2.0f / (1.0f + e)); }
__device__ __forceinline__ void ph_ffnmid(const Args& A, int l, int Mrows, int tid) {
    const bf16* AB = (const bf16*)(wsb() + WS_Z); bf16* U = (bf16*)(wsb() + WS_U);
    const float* cw = inp(I_FFCW) + (size_t)l * 3 * DFF; const float* cb = inp(I_FFCB) + (size_t)l * DFF;
    const int cgi = tid & 63, rsub = tid >> 6; const int nunits = (Mrows / 32) * 11;
    for (int u = blockIdx.x; u < nunits; u += gridDim.x) {
        const int cblk = u % 11, rblk = u / 11, col = cblk * 512 + cgi * 8;
        float w0[8], w1[8], w2[8], bb[8];
#pragma unroll
        for (int e = 0; e < 8; ++e) { w0[e] = cw[col + e]; w1[e] = cw[DFF + col + e]; w2[e] = cw[2 * DFF + col + e]; bb[e] = cb[col + e]; }
#pragma unroll
        for (int rr = 0; rr < 4; ++rr) { const int m = rblk * 32 + rr * 8 + rsub;
            const bool first = (m < ML) ? ((m & (SEQ - 1)) == 0) : ((m & (CL - 1)) == 0), last = (m < ML) ? ((m & (SEQ - 1)) == SEQ - 1) : ((m & (CL - 1)) == CL - 1);
            const bf16* ap = AB + (size_t)m * NFF + col;
            float am[8], a0[8], aq[8], bg[8];
            const v4u z4 = (v4u){0u, 0u, 0u, 0u};
            unpack8(first ? z4 : *(const v4u*)(ap - NFF), am); unpack8(*(const v4u*)ap, a0); unpack8(last ? z4 : *(const v4u*)(ap + NFF), aq); unpack8(*(const v4u*)(ap + DFF), bg);
            float r[8];
#pragma unroll
            for (int e = 0; e < 8; ++e) r[e] = gelu_t(w0[e] * am[e] + w1[e] * a0[e] + w2[e] * aq[e] + bb[e]) * bg[e];
            *(v4u*)(U + (size_t)m * DFF + col) = pack8(r); }
    }
}
__device__ __forceinline__ void ph_final(const Args& A, int wave, int lane) {
    const int gw = blockIdx.x * NWAVES + wave, NGW = gridDim.x * NWAVES; const float* g = inp(I_GF);
    for (int m = gw; m < ML; m += NGW) { float* xr = outb() + (size_t)m * D; f32x4 v[8]; float ss = 0.f;
#pragma unroll
        for (int j = 0; j < 8; ++j) { v[j] = *(const f32x4*)(xr + (lane + 64 * j) * 4); ss += (v[j].x * v[j].x + v[j].y * v[j].y) + (v[j].z * v[j].z + v[j].w * v[j].w); }
        const float rstd = 1.0f / sqrtf(wave_sum(ss) * (1.0f / D) + EPS);
#pragma unroll
        for (int j = 0; j < 8; ++j) { const int idx = (lane + 64 * j) * 4; *(f32x4*)(xr + idx) = v[j] * rstd * *(const f32x4*)(g + idx); }
    }
}
constexpr int BG_SPLIT = 22016;
constexpr int SEQ_PER_LAYER = 11, NSEQ = 1 + DEPTH * SEQ_PER_LAYER + 1;
__global__ void __launch_bounds__(NWAVES * 64, 2) fwd(Args A) {
    extern __shared__ __attribute__((aligned(16))) unsigned char lds_raw[];
    LAS unsigned char* lds = (LAS unsigned char*)lds_raw;
    volatile LAS unsigned* MISC = (volatile LAS unsigned*)(lds + MISC_OFF);
    for (int u = threadIdx.x; u < (LDS_BYTES - LDSCTL_OFF) / 4; u += NWAVES * 64) ((LAS unsigned*)(lds + LDSCTL_OFF))[u] = 0u;
    __syncthreads();
    (void)xcd_barrier_post((unsigned*)(wsb() + WS_CTL) + CW_BAR, MISC + 8);
    const int lo = A.seq_lo, hi = A.seq_hi;
#define G ((int)gridDim.x)
#define RUN(s) (lo <= (s) && (s) < hi)
#ifndef DUP
#define DUP 0
#endif
#define DUPN(id) ((((DUP) >> (id)) & 1) ? 2 : 1)
#define TID_HERE const int tid = otid(), lane = tid & 63, wave = __builtin_amdgcn_readfirstlane(tid >> 6); (void)lane; (void)wave
#ifdef ONLY
#define PH_ON(k) ((k) == ONLY)
#elif defined(SKIP)
#define PH_ON(k) ((k) != SKIP)
#else
#define PH_ON(k) true
#endif
#define SEAM(s) do { if (RUN((s) + 1)) { XcdBarrier bar_; bar_.bar = (unsigned*)(wsb() + WS_CTL) + CW_BAR; bar_.x = xb_xcc_id(); bar_.st = (volatile LAS unsigned*)(lds + MISC_OFF) + 8; xcd_barrier(bar_); } } while (0)
#define H ((bf16*)(wsb() + WS_H))
#define Z ((bf16*)(wsb() + WS_Z))
#define ACC ((bf16*)(wsb() + WS_ACC))
#define U ((bf16*)(wsb() + WS_U))
#define YS ((bf16*)(wsb() + WS_YS))
#define XC ((float*)(wsb() + WS_XC))
#define WIN ((const bf16*)(psb(l & 1) + PS_WIN))
#define WBR ((const bf16*)(psb(l & 1) + PS_WBR))
#define WOUT ((const bf16*)(psb(l & 1) + PS_WOUT))
#define WF1 ((const bf16*)(psb(l & 1) + PS_WF1))
#define WF2 ((const bf16*)(psb(l & 1) + PS_WF2))

    if (PH_ON(100) && RUN(0)) { TID_HERE; ph_prologue(A, lds, tid); __syncthreads(); ph_convert(A, 0, 0, 0, CONV_ITEMS, (int)blockIdx.x, G, lds, wave, lane); __syncthreads(); ph_filt1(A, 0, 0, (int)blockIdx.x, G, lds, tid); SEAM(0); }

    for (int l = 0; l < DEPTH; ++l) {
        const int sb = 1 + l * SEQ_PER_LAYER;
        if (hi <= sb || lo >= sb + SEQ_PER_LAYER) continue;
        const bool lastl = (l == DEPTH - 1);
        const int Mrows = lastl ? ML : MT, nctx = lastl ? 0 : 64;
#define modl ((const float*)(wsb() + WS_MOD) + (size_t)l * 5 * 12288)
#define xlat_in ((l == 0) ? inp(I_X) : (const float*)outb())
#define xctx_in ((l == 0) ? inp(I_CTX) : (const float*)XC)

        if (PH_ON(0) && RUN(sb + 0)) { TID_HERE;
            if (l == 0) ph_filt2(A, 0, 0, (int)blockIdx.x, G, lds, tid);
            for (int r_ = 0; r_ < DUPN(2); ++r_) ph_norm(xlat_in, xctx_in, inp(I_G1) + (size_t)l * D, modl, 0, D, H, MT, wave, lane);
            SEAM(sb + 0);
        }
        if (PH_ON(1) && RUN(sb + 1)) { TID_HERE;
            { pg8::Gemm g{H, WIN, opq(MT), opq(INW), opq(D)}; pg8::StaticOrder S; S.init(g.M, g.N, G, (int)blockIdx.x);
              pg8::EpiStore E{Z, INW};
              pg8::gemm_phase<pg8::EpiStore, pg8::StaticOrder, PG8_ALIGN, PG8_SP2>(lds, g, S, E); }
            SEAM(sb + 1);
        }
        if (PH_ON(2) && RUN(sb + 2)) { TID_HERE;
            for (int r_ = 0; r_ < DUPN(4); ++r_) ph_hyprep(A, l, lds, tid);
            for (int r_ = 0; r_ < DUPN(5); ++r_) ph_ret1(A, l, 64, lds, tid);
            for (int r_ = 0; r_ < DUPN(6); ++r_) ph_natt(A, l, nctx, lds, tid);
            for (int r_ = 0; r_ < DUPN(7); ++r_) if (!lastl) ph_hyctx(A, l, lds, tid);
            SEAM(sb + 2);
        }
        if (PH_ON(3) && RUN(sb + 3)) { TID_HERE;
#ifndef NO_D1
            for (int r_ = 0; r_ < DUPN(8); ++r_) ph_hyfft(A, l, lds, tid);
#endif
#ifndef NO_D2
            ph_scan(A, l, tid);
#endif
            SEAM(sb + 3);
        }
        if (PH_ON(4) && RUN(sb + 4)) { TID_HERE;
            for (int r_ = 0; r_ < DUPN(9); ++r_) ph_hypost(A, lds, tid);
            for (int r_ = 0; r_ < DUPN(10); ++r_) ph_ret3(A, l, nctx, lds, tid);
            SEAM(sb + 4);
        }
        if (PH_ON(5) && RUN(sb + 5)) { TID_HERE;
            __syncthreads();
            for (int r_ = 0; r_ < DUPN(13); ++r_)
            for (int i = 0; i < 3; ++i) {
                pg8::Gemm g{YS + (size_t)i * MT * 1024, WBR + (size_t)i * D * 1024, Mrows, opq(D), opq(1024)}; pg8::StaticOrder S; S.init(g.M, g.N, G, (int)blockIdx.x);
                pg8::EpiMerge E{ACC, Z + C_GT + i * D, INW, i == 0 ? 1 : 0};
                pg8::gemm_phase<pg8::EpiMerge, pg8::StaticOrder, PG8_ALIGN, PG8_SP2>(lds, g, S, E);
            }
            if (!lastl && blockIdx.x >= 32) { const int wk = (int)blockIdx.x - 32, nwk = G - 32; __syncthreads();
                ph_filt1(A, l + 1, (l + 1) & 1, wk, nwk, lds, tid); __syncthreads();
                ph_convert(A, l + 1, (l + 1) & 1, 0, BG_SPLIT, wk, nwk, lds, wave, lane); }
            SEAM(sb + 5);
        }
        if (PH_ON(6) && RUN(sb + 6)) { TID_HERE;
            __syncthreads();
            pg8::Gemm g{ACC, WOUT, Mrows, opq(D), opq(D)}; pg8::StaticOrder S; S.init(g.M, g.N, G, (int)blockIdx.x);
            pg8::EpiResid E{xlat_in, xctx_in, outb(), XC, modl, 2 * D};
            pg8::gemm_phase<pg8::EpiResid, pg8::StaticOrder, PG8_ALIGN, PG8_SP2>(lds, g, S, E);
            if (!lastl && blockIdx.x >= 32) { __syncthreads(); ph_convert(A, l + 1, (l + 1) & 1, BG_SPLIT, CONV_ITEMS, (int)blockIdx.x - 32, G - 32, lds, wave, lane); }
            SEAM(sb + 6);
        }
        if (PH_ON(7) && RUN(sb + 7)) { TID_HERE;
            for (int r_ = 0; r_ < DUPN(12); ++r_) ph_norm(outb(), XC, inp(I_G2) + (size_t)l * D, modl, 3 * D, 4 * D, H, Mrows, wave, lane);
            SEAM(sb + 7);
        }
        if (PH_ON(8) && RUN(sb + 8)) { TID_HERE;
            __syncthreads();
            pg8::Gemm g{H, WF1, Mrows, opq(NFF), opq(D)}; pg8::StaticOrder S; S.init(g.M, g.N, G, (int)blockIdx.x);
            pg8::EpiStore E{Z, NFF};
            for (int r_ = 0; r_ < DUPN(14); ++r_) pg8::gemm_phase<pg8::EpiStore, pg8::StaticOrder, PG8_ALIGN, PG8_SP2>(lds, g, S, E);
            SEAM(sb + 8);
        }
        if (PH_ON(9) && RUN(sb + 9)) { TID_HERE;
            for (int r_ = 0; r_ < DUPN(11); ++r_) ph_ffnmid(A, l, Mrows, tid);
            SEAM(sb + 9);
        }
        if (PH_ON(10) && RUN(sb + 10)) { TID_HERE;
            __syncthreads();
            pg8::Gemm g{U, WF2, Mrows, opq(D), opq(DFF)}; pg8::StaticOrder S; S.init(g.M, g.N, G, (int)blockIdx.x);
            pg8::EpiResid E{outb(), XC, outb(), XC, modl, 5 * D};
            pg8::gemm_phase<pg8::EpiResid, pg8::StaticOrder, PG8_ALIGN, PG8_SP2>(lds, g, S, E);
            if (!lastl && blockIdx.x >= 32) { __syncthreads(); ph_filt2(A, l + 1, (l + 1) & 1, (int)blockIdx.x - 32, G - 32, lds, tid); }
            SEAM(sb + 10);
        }
    }
    if (PH_ON(101) && RUN(NSEQ - 1)) { TID_HERE; ph_final(A, wave, lane); }
#undef RUN
#undef SEAM
#undef H
#undef Z
#undef ACC
#undef U
#undef YS
#undef XC
#undef WIN
#undef WBR
#undef WOUT
#undef WF1
#undef WF2
#undef G
#undef modl
#undef xlat_in
#undef xctx_in
}

extern "C" void kernel_launch(void* const* d_in, const int* in_sizes, int n_in, void* d_out, int out_size, void* d_ws, size_t ws_size, hipStream_t stream) {
    static int grid = 0;
    if (grid == 0) {
        if (n_in != 27 || out_size != ML * D || ws_size < WS_END) { fprintf(stderr, "kernel_launch: unexpected shapes (n_in %d out %d ws %zu need %zu)\n", n_in, out_size, ws_size, (size_t)WS_END); grid = -1; return; }
        int dev = 0, cus = 0, per_cu = 0;
        if (hipGetDevice(&dev) != hipSuccess || hipDeviceGetAttribute(&cus, hipDeviceAttributeMultiprocessorCount, dev) != hipSuccess) { grid = -1; return; }
        if (hipFuncSetAttribute((const void*)fwd, hipFuncAttributeMaxDynamicSharedMemorySize, LDS_BYTES) != hipSuccess) { fprintf(stderr, "kernel_launch: hipFuncSetAttribute failed\n"); grid = -1; return; }
        if (hipOccupancyMaxActiveBlocksPerMultiprocessor(&per_cu, (const void*)fwd, NWAVES * 64, LDS_BYTES) != hipSuccess || per_cu < 1) fprintf(stderr, "kernel_launch: occupancy query says %d\n", per_cu);
        (void)hipGetLastError();
        grid = cus;
    }
    if (grid < 0) return;
    (void)hipMemsetAsync((char*)d_ws + WS_CTL, 0, CTL_ZERO_BYTES, stream);
    Args a{};
    for (int i = 0; i < 27; ++i) a.in[i] = (const float*)d_in[i];
    a.out = (float*)d_out; a.ws = (unsigned char*)d_ws;
#if MK_SINGLE
    a.seq_lo = 0; a.seq_hi = NSEQ;
    hipLaunchKernelGGL(fwd, dim3(grid), dim3(NWAVES * 64), LDS_BYTES, stream, a);
#else
    for (int s = 0; s < NSEQ; ++s) { a.seq_lo = s; a.seq_hi = s + 1; hipLaunchKernelGGL(fwd, dim3(grid), dim3(NWAVES * 64), LDS_BYTES, stream, a); }
#endif
}
```

```cpp
#include <hip/hip_runtime.h>
#include <cstdio>
#include <cstdint>
#ifndef MK_SINGLE
#define MK_SINGLE 1
#endif
namespace pg8 {
#define PG8_LAS __attribute__((address_space(3)))
typedef unsigned short bf16_t;
typedef short bf16x8 __attribute__((ext_vector_type(8)));
typedef float f32x4 __attribute__((ext_vector_type(4)));
typedef unsigned u32x4 __attribute__((ext_vector_type(4)));
constexpr int BM = 256, BK = 64, HALF = 128, HTB = HALF * BK * 2  , STAGE_BYTES = 8 * HTB, NXCD = 8, WGM = 8;

__host__ __device__ __forceinline__ int lds_byte(int r, int c) { const int st = (r >> 4) * 2 + (c >> 5), rr = r & 15, cc = c & 31, ob = rr * 64 + cc * 2; return st * 1024 + (ob ^ (((ob >> 9) & 1) << 5)); }
__host__ __device__ __forceinline__ void stage_rc(int b, int& R, int& C) { const int st = b / 1024, sb = b % 1024, swz = sb ^ (((sb >> 9) & 1) << 5); R = (st >> 1) * 16 + swz / 64; C = (st & 1) * 32 + (swz % 64) / 2; }
__host__ __device__ __forceinline__ int perm32(int rho) { const int n = rho >> 4, i = rho & 15; return 8 * (i >> 2) + 4 * n + (i & 3); }

struct Unit { int pm, pn; };
struct Gemm { const bf16_t* A; const bf16_t* Bt; int M, N, K; };

struct StaticOrder {
    int nM, nN, nwg, G, c;
    __host__ __device__ void init(int M, int N, int G_, int c_) { nM = M / BM; nN = N / BM; nwg = nM * nN; G = G_; c = c_; }
    __host__ __device__ bool next(int i, Unit& u) const {
        const long L = (long)i * G + c; if (L >= nwg) return false;
        int wgid = (int)L; { const int q = nwg / NXCD, r = nwg % NXCD, xcd = wgid % NXCD, off = wgid / NXCD; wgid = (xcd < r ? xcd * (q + 1) : r * (q + 1) + (xcd - r) * q) + off; }
        const int nig = WGM * nN, gid = wgid / nig, fm = gid * WGM, gsz = (nM - fm) < WGM ? (nM - fm) : WGM;
        u.pm = fm + ((wgid % nig) % gsz); u.pn = (wgid % nig) / gsz; return true;
    }
    __device__ __forceinline__ void a_ready(const Unit&) const {}
    __device__ __forceinline__ void done(const Unit&) const {}
};
__device__ __forceinline__ unsigned cvt_pk_bf16(float lo, float hi) { unsigned r; asm volatile("v_cvt_pk_bf16_f32 %0, %1, %2" : "=v"(r) : "v"(lo), "v"(hi)); return r; }
typedef float f32x2 __attribute__((ext_vector_type(2)));
__device__ __forceinline__ float bflo(unsigned w) { return __uint_as_float(w << 16); }
__device__ __forceinline__ float bfhi(unsigned w) { return __uint_as_float(w & 0xffff0000u); }
__device__ __forceinline__ float sigm(float x) { return 1.0f / (1.0f + __expf(-x)); }
struct EpiStore {
    static constexpr bool PERM = true, AFTER_DRAIN = false;
    bf16_t* O; int ldc;
    __device__ __forceinline__ void operator()(const f32x4 (&acc)[2][2][4][2], const Unit& u, int wr, int wc, int fr, int fq) const {
        const int row0 = u.pm * BM + wr * 64 + fr, col0 = u.pn * BM + wc * 32 + 8 * fq;
#pragma unroll
        for (int ai = 0; ai < 2; ++ai)
#pragma unroll
            for (int m = 0; m < 4; ++m) { bf16_t* rowp = O + (size_t)(row0 + ai * HALF + m * 16) * ldc + col0;
#pragma unroll
                for (int bj = 0; bj < 2; ++bj) { const f32x4 v0 = acc[ai][bj][m][0], v1 = acc[ai][bj][m][1];
                    u32x4 w; w.x = cvt_pk_bf16(v0[0], v0[1]); w.y = cvt_pk_bf16(v0[2], v0[3]); w.z = cvt_pk_bf16(v1[0], v1[1]); w.w = cvt_pk_bf16(v1[2], v1[3]);
                    *(u32x4*)(rowp + bj * HALF) = w; } }
    }
};
struct EpiMerge {
    static constexpr bool PERM = true, AFTER_DRAIN = false;
    bf16_t* O; const bf16_t* gate; int ldg; int first;
    __device__ __forceinline__ void operator()(const f32x4 (&acc)[2][2][4][2], const Unit& u, int wr, int wc, int fr, int fq) const {
        const int row0 = u.pm * BM + wr * 64 + fr, col0 = u.pn * BM + wc * 32 + 8 * fq;
#pragma unroll
        for (int ai = 0; ai < 2; ++ai)
#pragma unroll
            for (int m = 0; m < 4; ++m) { const size_t row = (size_t)(row0 + ai * HALF + m * 16);
#pragma unroll
                for (int bj = 0; bj < 2; ++bj) { const int col = col0 + bj * HALF;
                    const u32x4 gv = *(const u32x4*)(gate + row * ldg + col);
                    u32x4 pv = (u32x4){0u, 0u, 0u, 0u}; if (!first) pv = *(const u32x4*)(O + row * 2048 + col);
                    const f32x4 v0 = acc[ai][bj][m][0], v1 = acc[ai][bj][m][1];
                    u32x4 w;
                    w.x = cvt_pk_bf16(bflo(pv.x) + v0[0] * sigm(bflo(gv.x)), bfhi(pv.x) + v0[1] * sigm(bfhi(gv.x)));
                    w.y = cvt_pk_bf16(bflo(pv.y) + v0[2] * sigm(bflo(gv.y)), bfhi(pv.y) + v0[3] * sigm(bfhi(gv.y)));
                    w.z = cvt_pk_bf16(bflo(pv.z) + v1[0] * sigm(bflo(gv.z)), bfhi(pv.z) + v1[1] * sigm(bfhi(gv.z)));
                    w.w = cvt_pk_bf16(bflo(pv.w) + v1[2] * sigm(bflo(gv.w)), bfhi(pv.w) + v1[3] * sigm(bfhi(gv.w)));
                    *(u32x4*)(O + row * 2048 + col) = w; } }
    }
};
struct EpiResid {
    static constexpr bool PERM = false, AFTER_DRAIN = false;
    const float* base_lat; const float* base_ctx; float* out_lat; float* out_ctx; const float* modl; int goff;
    __device__ __forceinline__ void operator()(const f32x4 (&acc)[2][2][4][2], const Unit& u, int wr, int wc, int fr, int fq) const {
        const bool isctx = u.pm >= 64; const int r = isctx ? 4 : (u.pm >> 4);
        const float* gvp = modl + (size_t)r * 12288 + goff;
        const float* bs = isctx ? base_ctx : base_lat; float* os = isctx ? out_ctx : out_lat;
        const int row0 = (isctx ? u.pm - 64 : u.pm) * BM + wr * 64 + fr, col0 = u.pn * BM + wc * 32 + 4 * fq;
        f32x4 g4[2][2];
#pragma unroll
        for (int bj = 0; bj < 2; ++bj)
#pragma unroll
            for (int n = 0; n < 2; ++n) g4[bj][n] = *(const f32x4*)(gvp + col0 + bj * HALF + n * 16);
#pragma unroll
        for (int ai = 0; ai < 2; ++ai)
#pragma unroll
            for (int m = 0; m < 4; ++m) { const size_t off = (size_t)(row0 + ai * HALF + m * 16) * 2048 + col0;
#pragma unroll
                for (int bj = 0; bj < 2; ++bj)
#pragma unroll
                    for (int n = 0; n < 2; ++n) { const f32x4 b4 = *(const f32x4*)(bs + off + bj * HALF + n * 16);
                        *(f32x4*)(os + off + bj * HALF + n * 16) = b4 + g4[bj][n] * acc[ai][bj][m][n]; } }
    }
};

__device__ __forceinline__ float dpp_ror1(float v) { return __int_as_float(__builtin_amdgcn_update_dpp(0, __float_as_int(v), 0x121, 0xf, 0xf, false)); }
__device__ __forceinline__ float dpp_rol1(float v) { return __int_as_float(__builtin_amdgcn_update_dpp(0, __float_as_int(v), 0x12f, 0xf, 0xf, false)); }
__device__ __forceinline__ float gelu_fast(float x) { const float x2 = x * x; const float arg = x * (x2 * (-2.0f * 1.4426950408889634f * 0.7978845608028654f * 0.044715f) + (-2.0f * 1.4426950408889634f * 0.7978845608028654f));
    return x * __builtin_amdgcn_rcpf(1.0f + __builtin_amdgcn_exp2f(arg)); }
struct EpiFfn {
    static constexpr bool PERM = true, AFTER_DRAIN = false;
    bf16_t* U; bf16_t* SA; bf16_t* SB; const float* cw; const float* cb;
    __device__ __forceinline__ void operator()(const f32x4 (&acc)[2][2][4][2], const Unit& u, int wr, int wc, int fr, int fq) const {
        const int f0 = u.pn * 128 + wc * 32 + 8 * fq;
        f32x4 w0[2], w1[2], w2[2], bb[2];
#pragma unroll
        for (int n = 0; n < 2; ++n) { w0[n] = *(const f32x4*)(cw + f0 + 4 * n); w1[n] = *(const f32x4*)(cw + 5632 + f0 + 4 * n); w2[n] = *(const f32x4*)(cw + 2 * 5632 + f0 + 4 * n); bb[n] = *(const f32x4*)(cb + f0 + 4 * n); }
#pragma unroll
        for (int ai = 0; ai < 2; ++ai) {
            const int row0 = u.pm * BM + ai * HALF + wr * 64 + fr, blk = u.pm * 4 + ai * 2 + wr;
            f32x4 o[4][2];
#pragma unroll
            for (int n = 0; n < 2; ++n)
#pragma unroll
                for (int e = 0; e < 4; ++e) {
                    const float a0 = acc[ai][0][0][n][e], a1 = acc[ai][0][1][n][e], a2 = acc[ai][0][2][n][e], a3 = acc[ai][0][3][n][e];
                    const float r0 = dpp_ror1(a0), r1 = dpp_ror1(a1), r2 = dpp_ror1(a2), r3 = dpp_ror1(a3);
                    const float l0 = dpp_rol1(a0), l1 = dpp_rol1(a1), l2 = dpp_rol1(a2), l3 = dpp_rol1(a3);
                    const bool first = (fr == 0), last = (fr == 15);
                    const float p0 = r0, p1 = first ? r0 : r1, p2 = first ? r1 : r2, p3 = first ? r2 : r3;
                    const float n0 = last ? l1 : l0, n1 = last ? l2 : l1, n2 = last ? l3 : l2, n3 = l3;
                    const float k0 = w0[n][e], k1 = w1[n][e], k2 = w2[n][e], kb = bb[n][e];
                    o[0][n][e] = gelu_fast(k0 * p0 + k1 * a0 + k2 * n0 + kb) * acc[ai][1][0][n][e];
                    o[1][n][e] = gelu_fast(k0 * p1 + k1 * a1 + k2 * n1 + kb) * acc[ai][1][1][n][e];
                    o[2][n][e] = gelu_fast(k0 * p2 + k1 * a2 + k2 * n2 + kb) * acc[ai][1][2][n][e];
                    o[3][n][e] = gelu_fast(k0 * p3 + k1 * a3 + k2 * n3 + kb) * acc[ai][1][3][n][e];
                }
#pragma unroll
            for (int m = 0; m < 4; ++m) { u32x4 w; w.x = cvt_pk_bf16(o[m][0][0], o[m][0][1]); w.y = cvt_pk_bf16(o[m][0][2], o[m][0][3]); w.z = cvt_pk_bf16(o[m][1][0], o[m][1][1]); w.w = cvt_pk_bf16(o[m][1][2], o[m][1][3]);
                *(u32x4*)(U + (size_t)(row0 + m * 16) * 5632 + f0) = w; }
            const int sel = (fr == 0) ? 0 : (fr == 1) ? 1 : (fr == 14) ? 2 : (fr == 15) ? 3 : -1;
            if (sel >= 0) { const int m = (sel < 2) ? 0 : 3;
                const f32x4 a0 = (m == 0) ? acc[ai][0][0][0] : acc[ai][0][3][0], a1 = (m == 0) ? acc[ai][0][0][1] : acc[ai][0][3][1];
                u32x4 w; w.x = cvt_pk_bf16(a0[0], a0[1]); w.y = cvt_pk_bf16(a0[2], a0[3]); w.z = cvt_pk_bf16(a1[0], a1[1]); w.w = cvt_pk_bf16(a1[2], a1[3]);
                *(u32x4*)(SA + ((size_t)blk * 4 + sel) * 5632 + f0) = w;
                if (sel == 0 || sel == 3) { const f32x4 b0 = (m == 0) ? acc[ai][1][0][0] : acc[ai][1][3][0], b1 = (m == 0) ? acc[ai][1][0][1] : acc[ai][1][3][1];
                    u32x4 v; v.x = cvt_pk_bf16(b0[0], b0[1]); v.y = cvt_pk_bf16(b0[2], b0[3]); v.z = cvt_pk_bf16(b1[0], b1[1]); v.w = cvt_pk_bf16(b1[2], b1[3]);
                    *(u32x4*)(SB + ((size_t)blk * 2 + (sel == 0 ? 0 : 1)) * 5632 + f0) = v; } }
        }
    }
};
template <class Epi, class Sched, bool ALIGN_EPI = false, bool SP2 = false>
__device__ __forceinline__ void gemm_phase(PG8_LAS unsigned char* lds, const Gemm g, const Sched& S, const Epi& E) {
    int tid_ = threadIdx.x; asm volatile("" : "+v"(tid_)); const int tid = tid_, wid = __builtin_amdgcn_readfirstlane(tid >> 6), lane = tid & 63, wr = wid >> 2, wc = wid & 3, fr = lane & 15, fq = lane >> 4;
    const int K = g.K, nt = K / BK;
    unsigned voffA[2], voffB[2];
#pragma unroll
    for (int i = 0; i < 2; ++i) { int R, C; stage_rc(tid * 16 + i * 8192, R, C); const int Rb = Epi::PERM ? ((R & ~31) + perm32(R & 31)) : R;
        voffA[i] = (unsigned)(R * K + C) * 2u; voffB[i] = (unsigned)(Rb * K + C) * 2u; }
    const size_t kstep = (size_t)(BK * 2);
    const size_t hstep = (size_t)HALF * K * 2;
    const size_t tstep = 2 * hstep;
    const unsigned ldsw = (unsigned)wid * 1024u;
    const int aoff = lds_byte(wr * 64 + fr, fq * 8), boff = lds_byte(wc * 32 + fr, fq * 8);
#define PG8_SA(b, h) (((b) * 2 + (h)) * HTB)
#define PG8_SB(b, h) ((4 + (b) * 2 + (h)) * HTB)
#define PG8_STAGE(bufoff, gbase, voff) do { _Pragma("unroll") for (int _i = 0; _i < 2; ++_i) \
        __builtin_amdgcn_global_load_lds((const unsigned*)((const char*)(gbase) + (voff)[_i]), (PG8_LAS unsigned*)(lds + (bufoff) + ldsw + _i * 8192), 16, 0, 0); } while (0)
#define PG8_LDA(dst, b, h) do { _Pragma("unroll") for (int m = 0; m < 4; ++m) _Pragma("unroll") for (int k = 0; k < 2; ++k) dst[m][k] = *(const PG8_LAS bf16x8*)(lds + PG8_SA(b, h) + aoff + m * 2048 + k * 1024); } while (0)
#define PG8_LDB(dst, b, h) do { _Pragma("unroll") for (int n = 0; n < 2; ++n) _Pragma("unroll") for (int k = 0; k < 2; ++k) dst[n][k] = *(const PG8_LAS bf16x8*)(lds + PG8_SB(b, h) + boff + n * 2048 + k * 1024); } while (0)
#define PG8_MMA(ai, bj, At, Bt) do { __builtin_amdgcn_s_setprio(1); _Pragma("unroll") for (int m = 0; m < 4; ++m) _Pragma("unroll") for (int n = 0; n < 2; ++n) _Pragma("unroll") for (int k = 0; k < 2; ++k) \
        acc[ai][bj][m][n] = __builtin_amdgcn_mfma_f32_16x16x32_bf16(Bt[n][k], At[m][k], acc[ai][bj][m][n], 0, 0, 0); __builtin_amdgcn_s_setprio(0); } while (0)
#define PG8_WAIT_V(n) asm volatile("s_waitcnt vmcnt(" #n ")" ::: "memory")
#define PG8_WAIT_L(n) asm volatile("s_waitcnt lgkmcnt(" #n ")" ::: "memory")
#define PG8_BAR __builtin_amdgcn_s_barrier()
#define PG8_SCHED __builtin_amdgcn_sched_barrier(0)
    Unit cur, nxt; int ui = 0;
    if (!S.next(0, cur)) return;
    f32x4 acc[2][2][4][2];
#pragma unroll
    for (int a = 0; a < 2; ++a)
#pragma unroll
        for (int b = 0; b < 2; ++b)
#pragma unroll
            for (int m = 0; m < 4; ++m)
#pragma unroll
                for (int n = 0; n < 2; ++n) acc[a][b][m][n] = (f32x4){0.f, 0.f, 0.f, 0.f};
    bf16x8 At[4][2], B0[2][2], B1[2][2];
    const char* cA = (const char*)g.A + (size_t)cur.pm * tstep; const char* cB = (const char*)g.Bt + (size_t)cur.pn * tstep;
    S.a_ready(cur);
    if constexpr (SP2) {
        PG8_STAGE(PG8_SB(0, 0), cB, voffB); PG8_STAGE(PG8_SB(0, 1), cB + hstep, voffB); PG8_STAGE(PG8_SA(0, 0), cA, voffA); PG8_STAGE(PG8_SA(0, 1), cA + hstep, voffA);
        if (wr == 1) PG8_BAR;
        PG8_WAIT_V(2); PG8_BAR;
        PG8_STAGE(PG8_SB(1, 0), cB + kstep, voffB); PG8_STAGE(PG8_SA(1, 0), cA + kstep, voffA); PG8_STAGE(PG8_SB(1, 1), cB + hstep + kstep, voffB);
        PG8_WAIT_V(6); PG8_BAR;
    } else {
        PG8_STAGE(PG8_SB(0, 0), cB, voffB); PG8_STAGE(PG8_SA(0, 0), cA, voffA); PG8_STAGE(PG8_SB(0, 1), cB + hstep, voffB); PG8_STAGE(PG8_SA(0, 1), cA + hstep, voffA);
        if (wr == 1) PG8_BAR;
        PG8_WAIT_V(4); PG8_BAR;
        PG8_STAGE(PG8_SB(1, 0), cB + kstep, voffB); PG8_STAGE(PG8_SA(1, 0), cA + kstep, voffA); PG8_STAGE(PG8_SB(1, 1), cB + hstep + kstep, voffB);
        PG8_WAIT_V(6); PG8_BAR;
    }
    for (;;) {
        const bool has_next = S.next(ui + 1, nxt);
        const char* nA = has_next ? (const char*)g.A + (size_t)nxt.pm * tstep : cA; const char* nB = has_next ? (const char*)g.Bt + (size_t)nxt.pn * tstep : cB;
        for (int t = 0; t < nt; t += 2) {
            const bool last = (t == nt - 2);
            const char* a1 = cA + (size_t)(t + 1) * kstep;
            const char* a2 = last ? nA : cA + (size_t)(t + 2) * kstep; const char* b2 = last ? nB : cB + (size_t)(t + 2) * kstep;
            const char* a3 = a2 + kstep; const char* b3 = b2 + kstep;
            if (last && has_next) S.a_ready(nxt);
            if constexpr (SP2) {
            PG8_LDB(B0, 0, 0); PG8_LDB(B1, 0, 1); PG8_SCHED; PG8_LDA(At, 0, 0); PG8_STAGE(PG8_SA(1, 1), a1 + hstep, voffA);
            PG8_WAIT_V(8); PG8_WAIT_L(0); PG8_BAR; PG8_MMA(0, 0, At, B0); PG8_MMA(0, 1, At, B1); PG8_BAR; PG8_SCHED;
            PG8_LDA(At, 0, 1); PG8_STAGE(PG8_SB(0, 0), b2, voffB); PG8_STAGE(PG8_SB(0, 1), b2 + hstep, voffB); PG8_STAGE(PG8_SA(0, 0), a2, voffA);
            PG8_WAIT_V(8); PG8_WAIT_L(0); PG8_BAR; PG8_MMA(1, 0, At, B0); PG8_MMA(1, 1, At, B1); PG8_BAR; PG8_SCHED;
            PG8_LDB(B0, 1, 0); PG8_LDB(B1, 1, 1); PG8_SCHED; PG8_LDA(At, 1, 0); PG8_STAGE(PG8_SA(0, 1), a2 + hstep, voffA);
            PG8_WAIT_V(8); PG8_WAIT_L(0); PG8_BAR; PG8_MMA(0, 0, At, B0); PG8_MMA(0, 1, At, B1); PG8_BAR; PG8_SCHED;
            PG8_LDA(At, 1, 1); PG8_STAGE(PG8_SB(1, 0), b3, voffB); PG8_STAGE(PG8_SB(1, 1), b3 + hstep, voffB); PG8_STAGE(PG8_SA(1, 0), a3, voffA);
            PG8_WAIT_V(8); PG8_WAIT_L(0); PG8_BAR; PG8_MMA(1, 0, At, B0); PG8_MMA(1, 1, At, B1); PG8_BAR; PG8_SCHED;
            } else {
            PG8_LDB(B0, 0, 0); PG8_SCHED; PG8_LDA(At, 0, 0); PG8_STAGE(PG8_SA(1, 1), a1 + hstep, voffA);
            PG8_WAIT_L(8); PG8_BAR; PG8_WAIT_L(0); PG8_MMA(0, 0, At, B0); PG8_BAR; PG8_SCHED;
            PG8_LDB(B1, 0, 1); PG8_STAGE(PG8_SB(0, 0), b2, voffB);
            PG8_BAR; PG8_WAIT_L(0); PG8_MMA(0, 1, At, B1); PG8_BAR;
            PG8_LDA(At, 0, 1); PG8_STAGE(PG8_SA(0, 0), a2, voffA);
            PG8_BAR; PG8_WAIT_L(0); PG8_MMA(1, 0, At, B0); PG8_BAR; PG8_SCHED;
            PG8_STAGE(PG8_SB(0, 1), b2 + hstep, voffB);
            PG8_WAIT_V(6); PG8_BAR; PG8_MMA(1, 1, At, B1); PG8_BAR;
            PG8_LDB(B0, 1, 0); PG8_SCHED; PG8_LDA(At, 1, 0); PG8_STAGE(PG8_SA(0, 1), a2 + hstep, voffA);
            PG8_WAIT_L(8); PG8_BAR; PG8_WAIT_L(0); PG8_MMA(0, 0, At, B0); PG8_BAR; PG8_SCHED;
            PG8_LDB(B1, 1, 1); PG8_STAGE(PG8_SB(1, 0), b3, voffB);
            PG8_BAR; PG8_WAIT_L(0); PG8_MMA(0, 1, At, B1); PG8_BAR;
            PG8_LDA(At, 1, 1); PG8_STAGE(PG8_SA(1, 0), a3, voffA);
            PG8_BAR; PG8_WAIT_L(0); PG8_MMA(1, 0, At, B0); PG8_BAR; PG8_SCHED;
            PG8_STAGE(PG8_SB(1, 1), b3 + hstep, voffB);
            PG8_WAIT_V(6); PG8_BAR; PG8_MMA(1, 1, At, B1); PG8_BAR;
            }
        }
        if constexpr (ALIGN_EPI) { if (wr == 0) PG8_BAR; }
        if constexpr (!Epi::AFTER_DRAIN) { E(acc, cur, wr, wc, fr, fq); S.done(cur); }
        if (!has_next) break;
#pragma unroll
        for (int a = 0; a < 2; ++a)
#pragma unroll
            for (int b = 0; b < 2; ++b)
#pragma unroll
                for (int m = 0; m < 4; ++m)
#pragma unroll
                    for (int n = 0; n < 2; ++n) acc[a][b][m][n] = (f32x4){0.f, 0.f, 0.f, 0.f};
        cur = nxt; cA = nA; cB = nB; ++ui;
        if constexpr (ALIGN_EPI) { if (wr == 1) PG8_BAR; }
    }
    PG8_WAIT_V(0);
    if constexpr (!ALIGN_EPI) { if (wr == 0) PG8_BAR; }
    PG8_BAR;
    if constexpr (Epi::AFTER_DRAIN) { E.fused(acc, cur, wr, wc, fr, fq, lds, wid, lane); S.done(cur); }
#undef PG8_SA
#undef PG8_SB
#undef PG8_STAGE
#undef PG8_LDA
#undef PG8_LDB
#undef PG8_MMA
#undef PG8_WAIT_V
#undef PG8_WAIT_L
#undef PG8_BAR
#undef PG8_SCHED
}
}
#ifndef PG8_SP2
#define PG8_SP2 true
#endif
#ifndef PG8_ALIGN
#define PG8_ALIGN true
#endif
constexpr int D = 2048, NB = 4, SEQ = 4096, CL = 256, DEPTH = 4;
constexpr int ML = NB * SEQ, MC = NB * CL, MT = ML + MC;
constexpr int INW = 15360, DFF = 5632, NFF = 2 * DFF;
constexpr int C_RK = 0, C_RV = 512, C_NK = 1536, C_NV = 2560, C_RQ = 3584, C_RG = 4096, C_NQ = 5120, C_HY = 6144, C_GT = 9216;
constexpr float EPS = 1e-6f;
constexpr int NWAVES = 8;
constexpr size_t al256(size_t x) { return (x + 255) & ~(size_t)255; }
constexpr size_t WS_CTL = 0, CTL_ZERO_BYTES = 1u << 20;
constexpr size_t WS_MOD = WS_CTL + CTL_ZERO_BYTES;
constexpr size_t WS_ROPE = WS_MOD + al256((size_t)4 * 5 * 12288 * 4);
constexpr size_t PS_FH2 = 0;
constexpr size_t PS_FH2B = PS_FH2 + al256((size_t)4352 * 64 * 4);
constexpr size_t PS_TAPC = PS_FH2B + al256((size_t)4352 * 64 * 2);
constexpr size_t PS_KF = PS_TAPC + al256((size_t)2 * 2 * 1024 * 256 * 4);
constexpr size_t PS_WIN = PS_KF + al256((size_t)2 * 1024 * 8192 * 8);
constexpr size_t PS_WBR = PS_WIN + al256((size_t)INW * D * 2);
constexpr size_t PS_WOUT = PS_WBR + al256((size_t)3 * D * 1024 * 2);
constexpr size_t PS_WF1 = PS_WOUT + al256((size_t)D * D * 2);
constexpr size_t PS_WF2 = PS_WF1 + al256((size_t)NFF * D * 2);
constexpr size_t PS_BYTES = PS_WF2 + al256((size_t)D * DFF * 2);
constexpr size_t WS_PSET = WS_ROPE + al256(64 * 16 * 8);
constexpr size_t WS_XC = WS_PSET + 2 * PS_BYTES;
constexpr size_t WS_H = WS_XC + al256((size_t)MC * D * 4);
constexpr size_t WS_Z = WS_H + al256((size_t)MT * D * 2);
constexpr size_t WS_HYT = WS_Z + al256((size_t)MT * INW * 2);
constexpr size_t WS_YT = WS_HYT + al256((size_t)3 * NB * 1024 * SEQ * 2);
constexpr size_t WS_YS = WS_YT + al256((size_t)NB * 1024 * SEQ * 2);
constexpr size_t WS_ACC = WS_YS + al256((size_t)3 * MT * 1024 * 2);
constexpr size_t WS_U = WS_ACC + al256((size_t)MT * D * 2);
constexpr size_t WS_KV = WS_U + al256((size_t)MT * DFF * 2);
constexpr size_t WS_SA = WS_KV + al256((size_t)NB * 8 * 2 * 34 * 8192 * 4);
constexpr size_t WS_SB = WS_SA + al256((size_t)272 * 4 * DFF * 2);
constexpr size_t WS_END = WS_SB + al256((size_t)272 * 2 * DFF * 2);
constexpr int CW_BAR = 4096;
constexpr int RING_BYTES = 131072, LDSCTL_OFF = RING_BYTES, MISC_OFF = LDSCTL_OFF + 320, LDS_BYTES = 147456;

#define GAS __attribute__((address_space(1)))
#define LAS __attribute__((address_space(3)))
typedef unsigned short bf16;
typedef unsigned v4u __attribute__((ext_vector_type(4)));
typedef unsigned v2u __attribute__((ext_vector_type(2)));
typedef float f32x4 __attribute__((ext_vector_type(4)));
typedef float f32x2 __attribute__((ext_vector_type(2)));
typedef short bf16x8 __attribute__((ext_vector_type(8)));
typedef GAS unsigned gu32;
#define LDS_WAIT() asm volatile("s_waitcnt lgkmcnt(0)" ::: "memory")
__device__ __forceinline__ unsigned f2bf(float f) { unsigned u = __builtin_bit_cast(unsigned, f); return (u + 0x7fffu + ((u >> 16) & 1u)) >> 16; }
__device__ __forceinline__ unsigned pk2(float lo, float hi) { return f2bf(lo) | (f2bf(hi) << 16); }
__device__ __forceinline__ float bflo(unsigned w) { return __uint_as_float(w << 16); }
__device__ __forceinline__ float bfhi(unsigned w) { return __uint_as_float(w & 0xffff0000u); }
__device__ __forceinline__ float bf1(bf16 b) { return __uint_as_float(((unsigned)b) << 16); }
__device__ __forceinline__ bf16x8 mk8(unsigned a, unsigned b, unsigned c, unsigned d) { v4u v = (v4u){a, b, c, d}; return __builtin_bit_cast(bf16x8, v); }
__device__ __forceinline__ f32x4 mfma16(bf16x8 a, bf16x8 b, f32x4 c) { return __builtin_amdgcn_mfma_f32_16x16x32_bf16(a, b, c, 0, 0, 0); }
__device__ __forceinline__ float sin_rev(float r) { return __builtin_amdgcn_sinf(r - floorf(r)); }
__device__ __forceinline__ float cos_rev(float r) { return __builtin_amdgcn_cosf(r - floorf(r)); }
__device__ __forceinline__ float sin_rad(float x) { return sin_rev(x * 0.15915494309189535f); }
__device__ __forceinline__ float ex2(float x) { return __builtin_amdgcn_exp2f(x); }
__device__ __forceinline__ float wave_sum(float v) {
#pragma unroll
    for (int o = 1; o < 64; o <<= 1) v += __shfl_xor(v, o);
    return v;
}
__device__ __forceinline__ int otid() { int t = threadIdx.x; asm volatile("" : "+v"(t)); return t; }
__device__ __forceinline__ int opq(int v) { asm volatile("" : "+s"(v)); return v; }
#define XB_TMO      128
#define XB_XCNT(j)  (256  + 64 * (j))
#define XB_XSUB(j)  (1280 + 64 * (j))
#define XB_XGEN(j)  (2304 + 64 * (j))
#define XB_TOP      3328
#define XB_TOPGEN   3392
#define XCD_BAR_WORDS 3456
#define XB_SPIN_CAP (1u << 18)

__device__ __forceinline__ unsigned xb_ld(unsigned* p)              { return __hip_atomic_load(p, __ATOMIC_RELAXED, __HIP_MEMORY_SCOPE_AGENT); }
__device__ __forceinline__ unsigned xb_add(unsigned* p, unsigned v) { return __hip_atomic_fetch_add(p, v, __ATOMIC_RELAXED, __HIP_MEMORY_SCOPE_AGENT); }
__device__ __forceinline__ unsigned xb_xcc_id() { return (unsigned)__builtin_amdgcn_s_getreg((3 << 11) | 20) & 0xFu; }
#define XB_SPIN(cond, bar) do { unsigned _sp = 0; while (cond) { __builtin_amdgcn_s_sleep(1); \
    if ((++_sp & 255u) == 0u) { if (xb_ld(&(bar)[XB_TMO])) break; if (_sp > XB_SPIN_CAP) { atomicAdd(&(bar)[XB_TMO], 1u); break; } } } } while (0)

struct XcdBarrier {
    unsigned* bar; unsigned x;
    volatile LAS unsigned* st;
};

__device__ __forceinline__ XcdBarrier xcd_barrier_post(unsigned* bar, volatile LAS unsigned* st) {
    XcdBarrier b; b.bar = bar; b.x = xb_xcc_id(); b.st = st;
    if (threadIdx.x == 0) (void)xb_add(&bar[XB_XCNT(b.x)], 1u);
    return b;
}
__device__ __forceinline__ void xcd_barrier_complete(unsigned* bar, unsigned x, unsigned& nloc, unsigned& nx) {
    const unsigned G = gridDim.x * gridDim.y * gridDim.z;
    unsigned sum, cnt, mine, sp = 0u;
    for (;;) {
        sum = 0u; cnt = 0u; mine = 0u;
#pragma unroll
        for (unsigned j = 0; j < 16; ++j) { const unsigned c = xb_ld(&bar[XB_XCNT(j)]); sum += c; cnt += (c > 0u) ? 1u : 0u; mine = (j == x) ? c : mine; }
        if (sum == G) break;
        __builtin_amdgcn_s_sleep(1);
        if ((++sp & 255u) == 0u) { if (xb_ld(&bar[XB_TMO])) break; if (sp > XB_SPIN_CAP) { atomicAdd(&bar[XB_TMO], 1u); break; } }
    }
    nloc = mine > 0u ? mine : 1u; nx = cnt > 0u ? cnt : 1u;
}

__device__ __forceinline__ void xcd_barrier(const XcdBarrier& b) {
    asm volatile("s_waitcnt vmcnt(0)" ::: "memory");
    __syncthreads();
    if (threadIdx.x == 0) {
        unsigned* bar = b.bar;
        __builtin_amdgcn_s_waitcnt(0);
        unsigned nloc = b.st[0], nx = b.st[1];
        if (nloc == 0u) { xcd_barrier_complete(bar, b.x, nloc, nx); b.st[0] = nloc; b.st[1] = nx; }
        const unsigned old = xb_add(&bar[XB_XSUB(b.x)], 1u);
        const unsigned gen = old / nloc;
        if (old + 1u == (gen + 1u) * nloc) {
            __builtin_amdgcn_fence(__ATOMIC_RELEASE, "agent");
            asm volatile("s_waitcnt vmcnt(0)" ::: "memory");
            const unsigned og = xb_add(&bar[XB_TOP], 1u);
            const unsigned tg = og / nx;
            if (og + 1u == (tg + 1u) * nx) xb_add(&bar[XB_TOPGEN], 1u);
            else XB_SPIN(xb_ld(&bar[XB_TOPGEN]) == tg, bar);
            __builtin_amdgcn_fence(__ATOMIC_ACQUIRE, "agent");
            xb_add(&bar[XB_XGEN(b.x)], 1u);
            asm volatile("s_waitcnt vmcnt(0)" ::: "memory");
        } else {
            XB_SPIN(xb_ld(&bar[XB_XGEN(b.x)]) == gen, bar);
            __builtin_amdgcn_fence(__ATOMIC_ACQUIRE, "agent");
            asm volatile("s_waitcnt vmcnt(0)" ::: "memory");
        }
    }
    __syncthreads();
}
__device__ __forceinline__ void p0_transpose_item(const float* W, int K, int N, bf16* WT, int row_off, LAS float* scr, int item, int lane) {
    const int nblk = N / 32, kb = item / nblk, nb = item % nblk, k0 = 64 * kb, n0 = 32 * nb;
#pragma unroll 8
    for (int i = 0; i < 32; ++i) { const int kk = 2 * i + (lane >> 5); scr[kk * 33 + (lane & 31)] = __builtin_nontemporal_load(W + (size_t)(k0 + kk) * N + n0 + (lane & 31)); }
    LDS_WAIT(); asm volatile("" ::: "memory");
    const int c = lane & 7;
#pragma unroll
    for (int j = 0; j < 4; ++j) { const int n = (lane >> 3) + 8 * j; const LAS float* s = scr + (8 * c) * 33 + n;
        v4u o; o.x = pk2(s[0 * 33], s[1 * 33]); o.y = pk2(s[2 * 33], s[3 * 33]); o.z = pk2(s[4 * 33], s[5 * 33]); o.w = pk2(s[6 * 33], s[7 * 33]);
        __builtin_nontemporal_store(o, (GAS v4u*)(WT + (size_t)(row_off + n0 + n) * K + k0 + 8 * c)); }
    LDS_WAIT(); asm volatile("" ::: "memory");
}
struct Args { const float* in[27]; float* out; unsigned char* ws; int seq_lo, seq_hi; };
__device__ __forceinline__ const float* inp(int i) { const char* ka = (const char*)__builtin_amdgcn_kernarg_segment_ptr(); int off = i * 8; asm volatile("" : "+s"(off)); return *(const float* const*)(ka + off); }
__device__ __forceinline__ unsigned char* wsb() { const char* ka = (const char*)__builtin_amdgcn_kernarg_segment_ptr(); int off = 27 * 8 + 8; asm volatile("" : "+s"(off)); return *(unsigned char* const*)(ka + off); }
__device__ __forceinline__ float* outb() { const char* ka = (const char*)__builtin_amdgcn_kernarg_segment_ptr(); int off = 27 * 8; asm volatile("" : "+s"(off)); return *(float* const*)(ka + off); }
__device__ __forceinline__ unsigned char* psb(int set) { return wsb() + WS_PSET + (size_t)set * PS_BYTES; }
enum { I_X = 0, I_C, I_CTX, I_CCTX, I_WMOD, I_BMOD, I_G1, I_G2, I_WIN, I_HCW, I_HCB, I_FW1, I_FB1, I_FW2, I_FB2, I_FW3, I_FFQ, I_HBIAS, I_RDEC, I_RPB, I_WBR, I_WOUT, I_FFW1, I_FFCW, I_FFCB, I_FFW2, I_GF };

__device__ __forceinline__ void ph_prologue(const Args& A, LAS unsigned char* lds, int tid) {
    LAS float* sc = (LAS float*)lds;
    LAS float* red = sc + 5 * 2048;
    const float* c = inp(I_C); const float* cc = inp(I_CCTX);
    for (int i = tid; i < 5 * 2048; i += 512) { const int r = i >> 11, k = i & 2047; const float v = (r < 4) ? c[r * 2048 + k] : cc[k]; sc[i] = v / (1.0f + __expf(-v)); }
    __syncthreads();
    float* mod = (float*)(wsb() + WS_MOD);
    const int kq = tid >> 6, col = tid & 63;
    for (int u = blockIdx.x; u < DEPTH * 192; u += gridDim.x) {
        const int l = u / 192, n0 = (u % 192) * 64;
        const float* W = inp(I_WMOD) + (size_t)l * 2048 * 12288 + n0 + col;
        float a0 = 0.f, a1 = 0.f, a2 = 0.f, a3 = 0.f, a4 = 0.f;
        for (int k = kq * 256; k < kq * 256 + 256; ++k) { const float w = W[(size_t)k * 12288];
            a0 += sc[k] * w; a1 += sc[2048 + k] * w; a2 += sc[4096 + k] * w; a3 += sc[6144 + k] * w; a4 += sc[8192 + k] * w; }
        red[(kq * 5 + 0) * 64 + col] = a0; red[(kq * 5 + 1) * 64 + col] = a1; red[(kq * 5 + 2) * 64 + col] = a2; red[(kq * 5 + 3) * 64 + col] = a3; red[(kq * 5 + 4) * 64 + col] = a4;
        __syncthreads();
        if (tid < 320) { const int r = tid >> 6; float s = inp(I_BMOD)[l * 12288 + n0 + col];
#pragma unroll
            for (int q = 0; q < 8; ++q) s += red[(q * 5 + r) * 64 + col];
            mod[((size_t)l * 5 + r) * 12288 + n0 + col] = s; }
        __syncthreads();
    }
    if (blockIdx.x == 0) { f32x2* rope = (f32x2*)(wsb() + WS_ROPE);
        for (int i = tid; i < 1024; i += 512) { const int pos = i >> 4, j = i & 15; const float inv = exp2f(-(float)j * (13.287712379549449f / 16.0f));
            const float rev = (float)pos * inv * 0.15915494309189535f; rope[i] = (f32x2){cos_rev(rev), sin_rev(rev)}; } }
}

__device__ __forceinline__ void ph_convert(const Args& A, int l, int set, int it_lo, int it_hi, int wk, int nwk, LAS unsigned char* lds, int wave, int lane) {
    LAS float* scr = (LAS float*)(lds + wave * 16384);
    const int gw = wk * NWAVES + wave, NGW = nwk * NWAVES;
    constexpr int I_IN = (D / 64) * (INW / 32), I_BR = (1024 / 64) * (D / 32), I_OUT = (D / 64) * (D / 32), I_F1 = (D / 64) * (NFF / 32);
    const float* win = inp(I_WIN) + (size_t)l * D * INW; const float* wbr = inp(I_WBR) + (size_t)l * 3 * 1024 * D; const float* wout = inp(I_WOUT) + (size_t)l * D * D;
    const float* wf1 = inp(I_FFW1) + (size_t)l * D * NFF; const float* wf2 = inp(I_FFW2) + (size_t)l * DFF * D;
    unsigned char* ps = psb(set);
    bf16* WIN = (bf16*)(ps + PS_WIN); bf16* WBR = (bf16*)(ps + PS_WBR); bf16* WOUT = (bf16*)(ps + PS_WOUT); bf16* WF1 = (bf16*)(ps + PS_WF1); bf16* WF2 = (bf16*)(ps + PS_WF2);
    for (int it = it_lo + gw; it < it_hi; it += NGW) {
        int r = it;
        if (r < I_IN) { p0_transpose_item(win, D, INW, WIN, 0, scr, r, lane); continue; } r -= I_IN;
        if (r < I_BR) { p0_transpose_item(wbr, 1024, D, WBR, 0, scr, r, lane); continue; } r -= I_BR;
        if (r < I_BR) { p0_transpose_item(wbr + (size_t)1024 * D, 1024, D, WBR + (size_t)D * 1024, 0, scr, r, lane); continue; } r -= I_BR;
        if (r < I_BR) { p0_transpose_item(wbr + (size_t)2 * 1024 * D, 1024, D, WBR + (size_t)2 * D * 1024, 0, scr, r, lane); continue; } r -= I_BR;
        if (r < I_OUT) { p0_transpose_item(wout, D, D, WOUT, 0, scr, r, lane); continue; } r -= I_OUT;
        if (r < I_F1) { const int n0 = (r % (NFF / 32)) * 32, f0 = (n0 < DFF) ? n0 : n0 - DFF, nrow = 256 * (f0 >> 7) + ((n0 < DFF) ? 0 : 128) + (f0 & 127);
            p0_transpose_item(wf1, D, NFF, WF1, nrow - n0, scr, r, lane); continue; } r -= I_F1;
        p0_transpose_item(wf2, DFF, D, WF2, 0, scr, r, lane);
    }
}
constexpr int CONV_ITEMS = (D / 64) * (INW / 32) + 3 * (1024 / 64) * (D / 32) + (D / 64) * (D / 32) + (D / 64) * (NFF / 32) + (DFF / 64) * (D / 32);
__device__ __forceinline__ void ph_filt1(const Args& A, int l, int set, int wk, int nwk, LAS unsigned char* lds, int tid) {
    LAS float* feat = (LAS float*)lds;
    LAS float* h1 = feat + 8 * 33;
    const float* w1 = inp(I_FW1) + (size_t)l * 33 * 64; const float* b1 = inp(I_FB1) + l * 64; const float* w2 = inp(I_FW2) + (size_t)l * 64 * 64; const float* b2 = inp(I_FB2) + l * 64;
    const float* fq = inp(I_FFQ) + l * 64; float* FH2 = (float*)(psb(set) + PS_FH2); bf16* FH2B = (bf16*)(psb(set) + PS_FH2B);
    const int pl = tid >> 6, o = tid & 63;
    for (int u = wk; u < 544; u += nwk) {
        const int pos = u * 8 + pl; const bool isc = pos >= 4096; const int Lf = isc ? 256 : 4096, tp = isc ? pos - 4096 : pos;
        if (o < 33) { float f;
            if (o == 0) f = (float)tp / (float)(Lf - 1);
            else { const int i = (o - 1) & 15; const float fr = 1e-4f + (float)i * ((15.0f - 1e-4f) / 15.0f); const float rev = fr * (float)tp / (float)Lf; f = (o <= 16) ? cos_rev(rev) : -sin_rev(rev); }
            feat[pl * 33 + o] = f; }
        __syncthreads();
        float a = b1[o];
#pragma unroll 3
        for (int i = 0; i < 33; ++i) a += feat[pl * 33 + i] * w1[i * 64 + o];
        h1[pl * 64 + o] = sin_rad(fq[o] * a);
        __syncthreads();
        float b = b2[o];
#pragma unroll 4
        for (int j = 0; j < 64; ++j) b += h1[pl * 64 + j] * w2[j * 64 + o];
        { const float hv = sin_rad(fq[o] * b); FH2[(size_t)pos * 64 + o] = hv; FH2B[(size_t)pos * 64 + o] = (bf16)f2bf(hv); }
        __syncthreads();
    }
}
__device__ __forceinline__ void ph_norm(const float* xlat, const float* xctx, const float* g, const float* modl, int sh_off, int sc_off, bf16* H, int Mrows, int wave, int lane) {
    const int gw = blockIdx.x * NWAVES + wave, NGW = gridDim.x * NWAVES;
    for (int m = gw; m < Mrows; m += NGW) {
        const float* xr; int r;
        if (m < ML) { xr = xlat + (size_t)m * D; r = m >> 12; } else { xr = xctx + (size_t)(m - ML) * D; r = 4; }
        const float* mv = modl + (size_t)r * 12288;
        f32x4 v[8]; float ss = 0.f;
#pragma unroll
        for (int j = 0; j < 8; ++j) { v[j] = *(const f32x4*)(xr + (lane + 64 * j) * 4); ss += (v[j].x * v[j].x + v[j].y * v[j].y) + (v[j].z * v[j].z + v[j].w * v[j].w); }
        const float rstd = 1.0f / sqrtf(wave_sum(ss) * (1.0f / D) + EPS);
#pragma unroll
        for (int j = 0; j < 8; ++j) { const int idx = (lane + 64 * j) * 4;
            const f32x4 gg = *(const f32x4*)(g + idx), sh = *(const f32x4*)(mv + sh_off + idx), sc = *(const f32x4*)(mv + sc_off + idx);
            const f32x4 y = v[j] * rstd * gg * (sc + 1.0f) + sh;
            v2u w; w.x = pk2(y.x, y.y); w.y = pk2(y.z, y.w);
            *(v2u*)(H + (size_t)m * D + idx) = w; }
    }
}

__device__ __forceinline__ int fphys(int i) { return i + 2 * (i >> 5); }
__device__ __forceinline__ void bfly_dif(f32x2& a, f32x2& b, float c, float s) { const f32x2 u = a, v = b; a = u + v; const float dx = u.x - v.x, dy = u.y - v.y; b = (f32x2){dx * c + dy * s, dy * c - dx * s}; }
__device__ __forceinline__ void bfly_idit(f32x2& a, f32x2& b, float c, float s) { const f32x2 u = a, q = b; const f32x2 v = (f32x2){q.x * c - q.y * s, q.x * s + q.y * c}; a = u + v; b = u - v; }
template <bool ZHI> __device__ __forceinline__ void dif16(f32x2 (&x)[16], float th) {
    asm volatile("" : "+v"(th));
#pragma unroll
    for (int k = 0; k < 8; ++k) { const float fr = th + (float)k * 0.0625f; const float c = __builtin_amdgcn_cosf(fr), s = __builtin_amdgcn_sinf(fr);
        if (ZHI) { const f32x2 u = x[k]; x[k + 8] = (f32x2){u.x * c + u.y * s, u.y * c - u.x * s}; } else bfly_dif(x[k], x[k + 8], c, s); }
#pragma unroll
    for (int k = 0; k < 4; ++k) { const float fr = 2.0f * th + (float)k * 0.125f; const float c = __builtin_amdgcn_cosf(fr), s = __builtin_amdgcn_sinf(fr);
        bfly_dif(x[k], x[k + 4], c, s); bfly_dif(x[8 + k], x[12 + k], c, s); }
#pragma unroll
    for (int k = 0; k < 2; ++k) { const float fr = 4.0f * th + (float)k * 0.25f; const float c = __builtin_amdgcn_cosf(fr), s = __builtin_amdgcn_sinf(fr);
#pragma unroll
        for (int b = 0; b < 16; b += 4) bfly_dif(x[b + k], x[b + k + 2], c, s); }
    { const float fr = 8.0f * th; const float c = __builtin_amdgcn_cosf(fr), s = __builtin_amdgcn_sinf(fr);
#pragma unroll
        for (int b = 0; b < 16; b += 2) bfly_dif(x[b], x[b + 1], c, s); }
}
__device__ __forceinline__ void idit16(f32x2 (&x)[16], float th) {
    asm volatile("" : "+v"(th));
    { const float fr = 8.0f * th; const float c = __builtin_amdgcn_cosf(fr), s = __builtin_amdgcn_sinf(fr);
#pragma unroll
        for (int b = 0; b < 16; b += 2) bfly_idit(x[b], x[b + 1], c, s); }
#pragma unroll
    for (int k = 0; k < 2; ++k) { const float fr = 4.0f * th + (float)k * 0.25f; const float c = __builtin_amdgcn_cosf(fr), s = __builtin_amdgcn_sinf(fr);
#pragma unroll
        for (int b = 0; b < 16; b += 4) bfly_idit(x[b + k], x[b + k + 2], c, s); }
#pragma unroll
    for (int k = 0; k < 4; ++k) { const float fr = 2.0f * th + (float)k * 0.125f; const float c = __builtin_amdgcn_cosf(fr), s = __builtin_amdgcn_sinf(fr);
        bfly_idit(x[k], x[k + 4], c, s); bfly_idit(x[8 + k], x[12 + k], c, s); }
#pragma unroll
    for (int k = 0; k < 8; ++k) { const float fr = th + (float)k * 0.0625f; const float c = __builtin_amdgcn_cosf(fr), s = __builtin_amdgcn_sinf(fr); bfly_idit(x[k], x[k + 8], c, s); }
}
template <bool INV> __device__ __forceinline__ void fft_pass(LAS f32x2* buf, int base, int stride, float th) {
    f32x2 x[16];
#pragma unroll
    for (int k = 0; k < 16; ++k) x[k] = buf[fphys(base + k * stride)];
    if (INV) idit16(x, th); else dif16<false>(x, th);
#pragma unroll
    for (int k = 0; k < 16; ++k) buf[fphys(base + k * stride)] = x[k];
}
constexpr int FFT_LDS_BYTES = (8192 + 512 + 8) * 8;
__device__ __forceinline__ float block_sum(float v, LAS float* red, int tid) {
    v = wave_sum(v);
    __syncthreads();
    if ((tid & 63) == 0) red[tid >> 6] = v;
    __syncthreads();
    float s = 0.f;
#pragma unroll
    for (int i = 0; i < 8; ++i) s += red[i];
    return s;
}
__device__ __forceinline__ float hy_delta(int c) { const float d0 = -4.605170185988091f / 0.3f, d1 = -4.605170185988091f / 1.5f; return fabsf(d0 + (d1 - d0) * ((float)c / 1023.0f)); }
__device__ __forceinline__ void ph_filt2(const Args& A, int l, int set, int wk, int nwk, LAS unsigned char* lds, int tid) {
    LAS f32x2* buf = (LAS f32x2*)lds; LAS float* bufs = (LAS float*)lds; LAS float* red = (LAS float*)(lds + FFT_LDS_BYTES + 64); LAS float* w3s = red + 32;
    LAS float* ctap = w3s + 256;
    const float* w3 = inp(I_FW3) + (size_t)l * 64 * 4096; const bf16* FH2B = (const bf16*)(psb(set) + PS_FH2B);
    f32x2* KF = (f32x2*)(psb(set) + PS_KF); float* TAPC = (float*)(psb(set) + PS_TAPC);
    const int lane = tid & 63, w = tid >> 6, g = lane >> 4, li = lane & 15;
    for (int c = wk; c < 1024; c += nwk) {
        __syncthreads();
        if (tid < 256) w3s[tid] = w3[(size_t)(tid & 63) * 4096 + (tid >> 7) * 2048 + ((tid >> 6) & 1) * 1024 + c];
        __syncthreads();
        bf16x8 bfr[2];
#pragma unroll
        for (int ks = 0; ks < 2; ++ks) { float v[8];
#pragma unroll
            for (int j = 0; j < 8; ++j) v[j] = (li < 4) ? w3s[li * 64 + 32 * ks + 8 * g + j] : 0.f;
            bfr[ks] = mk8(pk2(v[0], v[1]), pk2(v[2], v[3]), pk2(v[4], v[5]), pk2(v[6], v[7])); }
        const float delta = hy_delta(c); float ssq = 0.f, ssqc = 0.f;
        const int comp = li >> 1;
#pragma unroll 1
        for (int rb = 0; rb < 272; rb += 64)
#pragma unroll
        for (int rk = 0; rk < 8; ++rk) { const int rt = rb + w + 8 * rk; if (rt >= 272) break; const int t0 = rt * 16;
            const bf16* ap = FH2B + (size_t)(t0 + li) * 64 + 8 * g;
            f32x4 acc = (f32x4){0.f, 0.f, 0.f, 0.f};
            acc = mfma16(*(const bf16x8*)ap, bfr[0], acc); acc = mfma16(*(const bf16x8*)(ap + 32), bfr[1], acc);
            if (li < 4) {
                if (rt < 256) {
#pragma unroll
                    for (int j = 0; j < 4; ++j) { const int t = t0 + 4 * g + j; const float val = acc[j] * __expf(-((float)t / 4095.0f) * delta);
                        if ((li & 1) == 0) { bufs[2 * fphys(t) + comp] = val; ssq += val * val; }
                        else if (t >= 1) { bufs[2 * fphys(8192 - t) + comp] = val; ssq += val * val; }
                        else bufs[2 * fphys(4096) + comp] = 0.f; }
                } else {
#pragma unroll
                    for (int j = 0; j < 4; ++j) { const int m = t0 - 4096 + 4 * g + j; const float val = acc[j] * __expf(-((float)m / 255.0f) * delta);
                        ctap[li * 256 + m] = val; if ((li & 1) == 0 || m >= 1) ssqc += val * val; }
                }
            }
        }
        const bool o0 = (li < 2), o1 = (li == 2 || li == 3);
        const float scl0 = (1.0f / 8192.0f) / sqrtf(block_sum(o0 ? ssq : 0.f, red, tid) + EPS), scl1 = (1.0f / 8192.0f) / sqrtf(block_sum(o1 ? ssq : 0.f, red, tid) + EPS);
        const float sc0 = 1.0f / sqrtf(block_sum(o0 ? ssqc : 0.f, red, tid) + EPS), sc1 = 1.0f / sqrtf(block_sum(o1 ? ssqc : 0.f, red, tid) + EPS);
        __syncthreads();
        fft_pass<false>(buf, tid, 512, (float)tid * (1.0f / 8192.0f));
        __syncthreads();
        fft_pass<false>(buf, (tid >> 5) * 512 + (tid & 31), 32, (float)(tid & 31) * (1.0f / 512.0f));
        __syncthreads();
        fft_pass<false>(buf, (tid >> 1) * 32 + (tid & 1), 2, (float)(tid & 1) * (1.0f / 32.0f));
        __syncthreads();
#pragma unroll
        for (int r = 0; r < 8; ++r) { LAS f32x4* pp = (LAS f32x4*)(buf + fphys(2 * (tid + 512 * r))); const f32x4 ab = *pp; *pp = (f32x4){ab.x + ab.z, ab.y + ab.w, ab.x - ab.z, ab.y - ab.w}; }
        __syncthreads();
        f32x2* d0 = KF + (size_t)c * 8192; f32x2* d1 = KF + (size_t)(1024 + c) * 8192;
#pragma unroll 4
        for (int i = 0; i < 16; ++i) { const int p = tid + 512 * i; const int f = (int)(__brev((unsigned)p) >> 19); const int pp = (int)(__brev((unsigned)((8192 - f) & 8191)) >> 19);
            const f32x2 z = buf[fphys(p)], zp = buf[fphys(pp)];
            d0[p] = (f32x2){(z.x + zp.x) * 0.5f * scl0, (z.y - zp.y) * 0.5f * scl0};
            d1[p] = (f32x2){(z.y + zp.y) * 0.5f * scl1, (zp.x - z.x) * 0.5f * scl1}; }
        for (int q = tid; q < 1024; q += 512) { const int od = q >> 8, m = q & 255; TAPC[((size_t)od * 1024 + c) * 256 + m] = ctap[q] * ((od < 2) ? sc0 : sc1); }
    }
}

__device__ __forceinline__ void ph_hyprep(const Args& A, int l, LAS unsigned char* lds, int tid) {
    LAS bf16* T = (LAS bf16*)lds;
    const bf16* Z = (const bf16*)(wsb() + WS_Z); bf16* HYT = (bf16*)(wsb() + WS_HYT);
    const float* cw = inp(I_HCW) + (size_t)l * 3 * 3072; const float* cb = inp(I_HCB) + (size_t)l * 3072;
    for (int u = blockIdx.x; u < 3072; u += gridDim.x) {
        const int cg = u % 12, tt = (u / 12) & 63, b = u / 768;
        __syncthreads();
        for (int q = tid; q < 66 * 32; q += 512) { const int r = q >> 5, ch8 = q & 31, t = tt * 64 - 1 + r;
            v4u v = (v4u){0u, 0u, 0u, 0u};
            if (t >= 0 && t < SEQ) v = *(const v4u*)(Z + (size_t)(b * SEQ + t) * INW + C_HY + cg * 256 + ch8 * 8);
            *(LAS v4u*)(T + r * 264 + ch8 * 8) = v; }
        __syncthreads();
        const int ch = tid & 255, half = tid >> 8, gch = cg * 256 + ch;
        const float w0 = cw[gch], w1 = cw[3072 + gch], w2 = cw[6144 + gch], bb = cb[gch];
        const int part = gch >> 10, c = gch & 1023;
        bf16* outp = HYT + ((size_t)(part * NB + b) * 1024 + c) * SEQ + tt * 64 + half * 32;
#pragma unroll
        for (int tq = 0; tq < 4; ++tq) { float vv[8];
#pragma unroll
            for (int e = 0; e < 8; ++e) { const int tl = half * 32 + tq * 8 + e;
                vv[e] = w0 * bf1(T[tl * 264 + ch]) + w1 * bf1(T[(tl + 1) * 264 + ch]) + w2 * bf1(T[(tl + 2) * 264 + ch]) + bb; }
            v4u w; w.x = pk2(vv[0], vv[1]); w.y = pk2(vv[2], vv[3]); w.z = pk2(vv[4], vv[5]); w.w = pk2(vv[6], vv[7]);
            *(v4u*)(outp + tq * 8) = w; }
    }
}
__device__ __forceinline__ void ph_hyctx(const Args& A, int l, LAS unsigned char* lds, int tid) {
    const bf16* Z = (const bf16*)(wsb() + WS_Z); bf16* YS = (bf16*)(wsb() + WS_YS); const float* TAPC = (const float*)(psb(l & 1) + PS_TAPC);
    const float* cw = inp(I_HCW) + (size_t)l * 3 * 3072; const float* cb = inp(I_HCB) + (size_t)l * 3072; const float* hb = inp(I_HBIAS) + (size_t)l * 2 * 1024;
    const int ch = tid >> 6, q = tid & 63, t0 = 4 * q;
    LAS float* Y = (LAS float*)lds + ch * 1552; LAS float* Y1 = Y + 256; LAS float* G0 = Y + 512; LAS float* G1 = Y + 1032;
    for (int u = blockIdx.x; u < 512; u += gridDim.x) {
        const int b = u >> 7, c = (u & 127) * 8 + ch;
        __syncthreads();
        float pv[3][4];
#pragma unroll
        for (int part = 0; part < 3; ++part) { const int gch = part * 1024 + c; const float w0 = cw[gch], w1 = cw[3072 + gch], w2 = cw[6144 + gch], bb = cb[gch];
            const bf16* zp = Z + (size_t)(ML + b * CL + t0) * INW + C_HY + gch;
            float zz[6];
#pragma unroll
            for (int e = 0; e < 6; ++e) { const int t = t0 - 1 + e; zz[e] = (t >= 0 && t < CL) ? bf1(zp[(ptrdiff_t)(e - 1) * INW]) : 0.f; }
#pragma unroll
            for (int r = 0; r < 4; ++r) pv[part][r] = w0 * zz[r] + w1 * zz[r + 1] + w2 * zz[r + 2] + bb; }
        *(LAS f32x4*)(Y + t0) = (f32x4){pv[2][0], pv[2][1], pv[2][2], pv[2][3]};
#pragma unroll
        for (int r = 0; r < 4; ++r) { const int m = t0 + r;
            G0[m + 259] = TAPC[((size_t)(0 * 2 + 0) * 1024 + c) * 256 + m]; G1[m + 259] = TAPC[((size_t)(1 * 2 + 0) * 1024 + c) * 256 + m];
            if (m >= 1) { G0[259 - m] = TAPC[((size_t)(0 * 2 + 1) * 1024 + c) * 256 + m]; G1[259 - m] = TAPC[((size_t)(1 * 2 + 1) * 1024 + c) * 256 + m]; } }
        if (q == 0) { G0[515] = 0.f; G1[515] = 0.f; G0[516] = 0.f; G1[516] = 0.f; }
        __syncthreads();
        float yprev[4] = {pv[2][0], pv[2][1], pv[2][2], pv[2][3]};
#pragma unroll
        for (int ord = 0; ord < 2; ++ord) {
            const LAS float* Ys = ord ? Y1 : Y; const LAS float* G = ord ? G1 : G0;
            float acc[4] = {0.f, 0.f, 0.f, 0.f};
#pragma unroll 4
            for (int sp = 0; sp < 64; ++sp) { const f32x4 yv = *(const LAS f32x4*)(Ys + 4 * sp); const LAS float* gp = G + 4 * (q - sp) + 256;
                const f32x4 ga = *(const LAS f32x4*)gp, gb = *(const LAS f32x4*)(gp + 4);
                const float g[8] = {ga.x, ga.y, ga.z, ga.w, gb.x, gb.y, gb.z, gb.w}; const float yy[4] = {yv.x, yv.y, yv.z, yv.w};
#pragma unroll
                for (int r = 0; r < 4; ++r)
#pragma unroll
                    for (int j = 0; j < 4; ++j) acc[r] += yy[j] * g[r - j + 3]; }
            const float bias = hb[ord * 1024 + c];
#pragma unroll
            for (int r = 0; r < 4; ++r) yprev[r] = pv[ord][r] * (acc[r] + bias * yprev[r]);
            if (ord == 0) { *(LAS f32x4*)(Y1 + t0) = (f32x4){yprev[0], yprev[1], yprev[2], yprev[3]}; __syncthreads(); }
        }
#pragma unroll
        for (int r = 0; r < 4; ++r) YS[(size_t)(ML + b * CL + t0 + r) * 1024 + c] = (bf16)f2bf(yprev[r]);
    }
}
__device__ __forceinline__ void unpack8(v4u v, float (&x)[8]) { x[0] = bflo(v.x); x[1] = bfhi(v.x); x[2] = bflo(v.y); x[3] = bfhi(v.y); x[4] = bflo(v.z); x[5] = bfhi(v.z); x[6] = bflo(v.w); x[7] = bfhi(v.w); }
__device__ __forceinline__ v4u pack8(const float (&x)[8]) { v4u w; w.x = pk2(x[0], x[1]); w.y = pk2(x[2], x[3]); w.z = pk2(x[4], x[5]); w.w = pk2(x[6], x[7]); return w; }
__device__ __forceinline__ void rope8(float (&lo)[8], float (&hi)[8], const f32x2* rt) {
#pragma unroll
    for (int e = 0; e < 8; ++e) { const f32x2 cs = rt[e]; const float a = lo[e], b = hi[e]; lo[e] = a * cs.x - b * cs.y; hi[e] = b * cs.x + a * cs.y; }
}
__device__ __forceinline__ void vt_store(LAS bf16* Vt, int ld, int d0, int r, v4u vv) {
    Vt[(d0 + 0) * ld + r] = (bf16)(vv.x & 0xffffu); Vt[(d0 + 1) * ld + r] = (bf16)(vv.x >> 16);
    Vt[(d0 + 2) * ld + r] = (bf16)(vv.y & 0xffffu); Vt[(d0 + 3) * ld + r] = (bf16)(vv.y >> 16);
    Vt[(d0 + 4) * ld + r] = (bf16)(vv.z & 0xffffu); Vt[(d0 + 5) * ld + r] = (bf16)(vv.z >> 16);
    Vt[(d0 + 6) * ld + r] = (bf16)(vv.w & 0xffffu); Vt[(d0 + 7) * ld + r] = (bf16)(vv.w >> 16);
}
constexpr float LOG2E = 1.4426950408889634f;
__device__ __forceinline__ void ph_ret1(const Args& A, int l, int nctx_units, LAS unsigned char* lds, int tid) {
    LAS bf16* KfT = (LAS bf16*)lds; LAS bf16* KbT = KfT + 64 * 136; LAS bf16* Vt = KbT + 64 * 136;
    const bf16* Z = (const bf16*)(wsb() + WS_Z); float* KV = (float*)(wsb() + WS_KV); const f32x2* rope = (const f32x2*)(wsb() + WS_ROPE);
    const int lane = tid & 63, w = tid >> 6, g = lane >> 4, li = lane & 15;
    for (int uid = blockIdx.x; uid < 1024 + nctx_units; uid += gridDim.x) {
        const bool isc = uid >= 1024; int b, h, n, ci; size_t m0;
        if (!isc) { b = uid >> 8; h = (uid >> 5) & 7; n = uid & 31; m0 = (size_t)b * SEQ + n * 128; ci = 2 + n; }
        else { const int i = uid - 1024; b = i >> 4; h = (i >> 1) & 7; n = i & 1; m0 = (size_t)ML + b * CL + n * 128; ci = n; }
        const float lgf = inp(I_RDEC)[(l * 2 + 0) * 8 + h] * LOG2E, lgb = inp(I_RDEC)[(l * 2 + 1) * 8 + h] * LOG2E;
        __syncthreads();
        { const int tok = tid >> 2, pp = tid & 3, a = (pp & 1) + ((pp >> 1) << 2);
            const bf16* kr = Z + (m0 + tok) * INW + C_RK + h * 64;
            float lo[8], hi[8]; unpack8(*(const v4u*)(kr + 8 * a), lo); unpack8(*(const v4u*)(kr + 8 * a + 16), hi);
            if (!isc) { const int t = n * 128 + tok; const int pos = (a < 4) ? (t >> 6) : (t & 63); rope8(lo, hi, rope + pos * 16 + 8 * (a & 1)); }
            const float zf = ex2(lgf * (float)(127 - tok)) * 0.125f, zb = ex2(lgb * (float)tok) * 0.125f;
#pragma unroll
            for (int e = 0; e < 8; ++e) { const int d = 8 * a + e;
                KfT[d * 136 + tok] = (bf16)f2bf(lo[e] * zf); KbT[d * 136 + tok] = (bf16)f2bf(lo[e] * zb);
                KfT[(d + 16) * 136 + tok] = (bf16)f2bf(hi[e] * zf); KbT[(d + 16) * 136 + tok] = (bf16)f2bf(hi[e] * zb); } }
        for (int q = tid; q < 2048; q += 512) { const int r = q >> 4, ch = q & 15; vt_store(Vt, 136, ch * 8, r, *(const v4u*)(Z + (m0 + r) * INW + C_RV + h * 128 + ch * 8)); }
        __syncthreads();
        bf16x8 af[4];
#pragma unroll
        for (int ks = 0; ks < 4; ++ks) af[ks] = *(const LAS bf16x8*)(Vt + (16 * w + li) * 136 + 32 * ks + 8 * g);
#pragma unroll
        for (int dir = 0; dir < 2; ++dir) { const LAS bf16* KT = dir ? KbT : KfT;
            float* dst = KV + ((size_t)((b * 8 + h) * 2 + dir) * 34 + ci) * 8192;
#pragma unroll
            for (int nc = 0; nc < 4; ++nc) { f32x4 acc = (f32x4){0.f, 0.f, 0.f, 0.f};
#pragma unroll
                for (int ks = 0; ks < 4; ++ks) acc = mfma16(af[ks], *(const LAS bf16x8*)(KT + (16 * nc + li) * 136 + 32 * ks + 8 * g), acc);
#pragma unroll
                for (int j = 0; j < 4; ++j) dst[(16 * w + 4 * g + j) * 64 + 16 * nc + li] = acc[j]; } }
    }
}
__device__ __forceinline__ void ph_natt(const Args& A, int l, int nctx_units, LAS unsigned char* lds, int tid) {
    LAS bf16* Qs = (LAS bf16*)lds; LAS bf16* KV0 = Qs + 128 * 136; LAS float* rpbs = (LAS float*)(KV0 + 2 * (64 * 136 + 128 * 68));
    const bf16* Z = (const bf16*)(wsb() + WS_Z); bf16* YS = (bf16*)(wsb() + WS_YS) + (size_t)2 * MT * 1024;
    const int lane = tid & 63, w = tid >> 6, g = lane >> 4, li = lane & 15;
    const float SCALE = 0.08838834764831845f;
    const int sr0 = tid >> 4, sch = tid & 15;
    for (int uid = blockIdx.x; uid < 1024 + nctx_units; uid += gridDim.x) {
        const bool isc = uid >= 1024; int b, h, rp = 0; size_t m0;
        if (!isc) { b = uid >> 8; h = (uid >> 5) & 7; rp = uid & 31; m0 = (size_t)b * SEQ + rp * 128; }
        else { const int i = uid - 1024; b = i >> 4; h = (i >> 1) & 7; m0 = (size_t)ML + b * CL + (i & 1) * 128; }
        const size_t mc0 = (size_t)ML + b * CL;
        const int qr = 2 * rp + (w >> 2), cw = w & 3, qc = 16 * cw + li;
        const int cs = min(max(qc - 8, 0), 48), rs_w = min(max(qr - 4, 0), 56);
        const int kr_lo = min(max(2 * rp - 4, 0), 56), kr_hi = min(max(2 * rp - 3, 0), 56) + 7;
        const int nwin = isc ? 0 : (kr_hi - kr_lo + 1), ntile = nwin + 4;
        const int nlo_w = (cw <= 1) ? 0 : cw - 1, nhi_w = (cw == 0) ? 1 : ((cw == 3) ? 3 : cw + 1);
        v4u kreg[2], vreg[2];
#define NA_LOAD(t_) do { const int t__ = (t_); const size_t mk = (t__ < nwin) ? ((size_t)b * SEQ + (kr_lo + t__) * 64) : (mc0 + (t__ - nwin) * 64); \
            _Pragma("unroll") for (int e = 0; e < 2; ++e) { const bf16* zr = Z + (mk + sr0 + 32 * e) * INW + h * 128 + sch * 8; kreg[e] = *(const v4u*)(zr + C_NK); vreg[e] = *(const v4u*)(zr + C_NV); } } while (0)
#define NA_STORE(buf_) do { LAS bf16* Kd = KV0 + (buf_) * (64 * 136 + 128 * 68); LAS bf16* Vd = Kd + 64 * 136; \
            _Pragma("unroll") for (int e = 0; e < 2; ++e) { *(LAS v4u*)(Kd + (sr0 + 32 * e) * 136 + sch * 8) = kreg[e]; vt_store(Vd, 68, sch * 8, sr0 + 32 * e, vreg[e]); } } while (0)
        __syncthreads();
        NA_LOAD(0);
        for (int q = tid; q < 2048; q += 512) { const int r = q >> 4, chn = q & 15; *(LAS v4u*)(Qs + r * 136 + chn * 8) = *(const v4u*)(Z + (m0 + r) * INW + C_NQ + h * 128 + chn * 8); }
        if (!isc) for (int i = tid; i < 465; i += 512) rpbs[i] = inp(I_RPB)[((size_t)l * 8 + h) * 465 + i];
        NA_STORE(0);
        __syncthreads();
        bf16x8 qf[4];
#pragma unroll
        for (int ks = 0; ks < 4; ++ks) qf[ks] = *(const LAS bf16x8*)(Qs + (16 * w + li) * 136 + 32 * ks + 8 * g);
        f32x4 o[8];
#pragma unroll
        for (int nd = 0; nd < 8; ++nd) o[nd] = (f32x4){0.f, 0.f, 0.f, 0.f};
        float mrun = -1e30f, lrun = 0.f;
        for (int t = 0; t < ntile; ++t) {
            const bool win = t < nwin; const int kr = kr_lo + t;
            if (t + 1 < ntile) NA_LOAD(t + 1);
            const LAS bf16* Ks = KV0 + (t & 1) * (64 * 136 + 128 * 68); const LAS bf16* Vt = Ks + 64 * 136;
            const bool active = !win || (kr >= rs_w && kr <= rs_w + 7);
            if (active) {
                const int nlo = win ? nlo_w : 0, nhi = win ? nhi_w : 3;
                f32x4 s[4];
#pragma unroll
                for (int n = 0; n < 4; ++n) { s[n] = (f32x4){0.f, 0.f, 0.f, 0.f};
                    if (n >= nlo && n <= nhi) {
#pragma unroll
                        for (int ks = 0; ks < 4; ++ks) s[n] = mfma16(*(const LAS bf16x8*)(Ks + (16 * n + li) * 136 + 32 * ks + 8 * g), qf[ks], s[n]); } }
                float tmax = -1e30f;
#pragma unroll
                for (int n = 0; n < 4; ++n)
#pragma unroll
                    for (int j = 0; j < 4; ++j) { float v = s[n][j] * SCALE;
                        if (win) { const int kc = 16 * n + 4 * g + j; const bool valid = (kc >= cs) && (kc < cs + 16);
                            const int dc = min(max(kc - qc + 15, 0), 30), dr = min(max(kr - qr + 7, 0), 14);
                            v = valid ? v + rpbs[dr * 31 + dc] : -1e30f; }
                        s[n][j] = v; tmax = fmaxf(tmax, v); }
                tmax = fmaxf(tmax, __shfl_xor(tmax, 16)); tmax = fmaxf(tmax, __shfl_xor(tmax, 32));
                const float mnew = fmaxf(mrun, tmax), alpha = __expf(mrun - mnew);
                float psum = 0.f;
#pragma unroll
                for (int n = 0; n < 4; ++n)
#pragma unroll
                    for (int j = 0; j < 4; ++j) { const float pv = __expf(s[n][j] - mnew); s[n][j] = pv; psum += pv; }
                psum += __shfl_xor(psum, 16); psum += __shfl_xor(psum, 32);
                lrun = lrun * alpha + psum; mrun = mnew;
#pragma unroll
                for (int nd = 0; nd < 8; ++nd) o[nd] = o[nd] * alpha;
#pragma unroll
                for (int kk = 0; kk < 2; ++kk) {
                    if (2 * kk + 1 >= nlo && 2 * kk <= nhi) {
                        const bf16x8 pf = mk8(pk2(s[2 * kk][0], s[2 * kk][1]), pk2(s[2 * kk][2], s[2 * kk][3]), pk2(s[2 * kk + 1][0], s[2 * kk + 1][1]), pk2(s[2 * kk + 1][2], s[2 * kk + 1][3]));
#pragma unroll
                        for (int nd = 0; nd < 8; ++nd) { const LAS bf16* vp = Vt + (16 * nd + li) * 68 + 32 * kk + 4 * g;
                            const v2u lo = *(const LAS v2u*)vp, hi = *(const LAS v2u*)(vp + 16);
                            o[nd] = mfma16(mk8(lo.x, lo.y, hi.x, hi.y), pf, o[nd]); } } }
            }
            if (t + 1 < ntile) NA_STORE((t + 1) & 1);
            __syncthreads();
        }
#undef NA_LOAD
#undef NA_STORE
        const float inv = 1.0f / lrun; const size_t mrow = m0 + 16 * w + li;
#pragma unroll
        for (int nd = 0; nd < 8; ++nd) { v2u wv; wv.x = pk2(o[nd][0] * inv, o[nd][1] * inv); wv.y = pk2(o[nd][2] * inv, o[nd][3] * inv);
            *(v2u*)(YS + mrow * 1024 + h * 128 + 16 * nd + 4 * g) = wv; }
    }
}

__device__ __forceinline__ void ph_hyfft(const Args& A, int l, LAS unsigned char* lds, int tid) {
    LAS f32x2* buf = (LAS f32x2*)lds;
    const bf16* HYT = (const bf16*)(wsb() + WS_HYT); bf16* YT = (bf16*)(wsb() + WS_YT); const f32x2* KF = (const f32x2*)(psb(l & 1) + PS_KF);
    const float* hb = inp(I_HBIAS) + (size_t)l * 2 * 1024;
    const int baseB = (tid >> 5) * 512 + (tid & 31), baseC = (tid >> 1) * 32 + (tid & 1);
    const float thA = (float)tid * (1.0f / 8192.0f), thB = (float)(tid & 31) * (1.0f / 512.0f), thC = (float)(tid & 1) * (1.0f / 32.0f);
    for (int u = blockIdx.x; u < 2048; u += gridDim.x) {
        const int c = u >> 1, b0 = (u & 1) * 2;
        const bf16* x1p = HYT + ((size_t)(0 * NB + b0) * 1024 + c) * SEQ; const bf16* x2p = HYT + ((size_t)(1 * NB + b0) * 1024 + c) * SEQ; const bf16* vp = HYT + ((size_t)(2 * NB + b0) * 1024 + c) * SEQ;
        const size_t bstr = (size_t)1024 * SEQ;
        float y0[8], y1[8];
#pragma unroll
        for (int i = 0; i < 8; ++i) { const int t = tid + 512 * i; y0[i] = bf1(vp[t]); y1[i] = bf1(vp[bstr + t]); }
#pragma unroll
        for (int ord = 0; ord < 2; ++ord) {
            { f32x2 x[16];
#pragma unroll
                for (int k = 0; k < 8; ++k) { x[k] = (f32x2){y0[k], y1[k]}; x[k + 8] = (f32x2){0.f, 0.f}; }
                dif16<true>(x, thA);
                __syncthreads();
#pragma unroll
                for (int k = 0; k < 16; ++k) buf[fphys(tid + 512 * k)] = x[k]; }
            __syncthreads();
            fft_pass<false>(buf, baseB, 32, thB);
            __syncthreads();
            fft_pass<false>(buf, baseC, 2, thC);
            __syncthreads();
            { const f32x4* kf = (const f32x4*)(KF + (size_t)(ord * 1024 + c) * 8192);
#pragma unroll
                for (int r = 0; r < 8; ++r) { const int i = tid + 512 * r; LAS f32x4* pp = (LAS f32x4*)(buf + fphys(2 * i)); const f32x4 ab = *pp; const f32x4 kk = kf[i];
                    const float ax = ab.x + ab.z, ay = ab.y + ab.w, bx = ab.x - ab.z, by = ab.y - ab.w;
                    const float px = ax * kk.x - ay * kk.y, py = ax * kk.y + ay * kk.x, qx = bx * kk.z - by * kk.w, qy = bx * kk.w + by * kk.z;
                    *pp = (f32x4){px + qx, py + qy, px - qx, py - qy}; } }
            __syncthreads();
            fft_pass<true>(buf, baseC, 2, thC);
            __syncthreads();
            fft_pass<true>(buf, baseB, 32, thB);
            __syncthreads();
            { f32x2 x[16];
#pragma unroll
                for (int k = 0; k < 16; ++k) x[k] = buf[fphys(tid + 512 * k)];
                idit16(x, thA);
                const bf16* xp = ord ? x2p : x1p; const float bias = hb[ord * 1024 + c];
#pragma unroll
                for (int k = 0; k < 8; ++k) { const int t = tid + 512 * k;
                    y0[k] = bf1(xp[t]) * (x[k].x + bias * y0[k]); y1[k] = bf1(xp[bstr + t]) * (x[k].y + bias * y1[k]); } }
        }
        bf16* o0 = YT + ((size_t)b0 * 1024 + c) * SEQ;
#pragma unroll
        for (int i = 0; i < 8; ++i) { const int t = tid + 512 * i; o0[t] = (bf16)f2bf(y0[i]); o0[bstr + t] = (bf16)f2bf(y1[i]); }
    }
}
__device__ __forceinline__ void ph_scan(const Args& A, int l, int tid) {
    float* KV = (float*)(wsb() + WS_KV);
    for (int gt = blockIdx.x * 512 + tid; gt < NB * 8 * 2 * 2048; gt += gridDim.x * 512) {
        const int bhd = gt >> 11, e4 = gt & 2047, dir = bhd & 1, h = (bhd >> 1) & 7;
        const float gC = ex2(inp(I_RDEC)[(l * 2 + dir) * 8 + h] * LOG2E * 128.0f);
        f32x4* base = (f32x4*)(KV + (size_t)bhd * 34 * 8192) + e4;
        f32x4 s = (f32x4){0.f, 0.f, 0.f, 0.f};
#pragma unroll 2
        for (int step = 0; step < 34; ++step) { const int ci = (dir == 0) ? step : (step == 0 ? 1 : (step == 1 ? 0 : 35 - step));
            const f32x4 tmp = base[(size_t)ci * 2048]; base[(size_t)ci * 2048] = s; s = s * gC + tmp; }
    }
}

__device__ __forceinline__ void ph_hypost(const Args& A, LAS unsigned char* lds, int tid) {
    LAS bf16* T = (LAS bf16*)lds;
    const bf16* YT = (const bf16*)(wsb() + WS_YT); bf16* YS = (bf16*)(wsb() + WS_YS);
    for (int u = blockIdx.x; u < 1024; u += gridDim.x) {
        const int cg = u & 3, tt = (u >> 2) & 63, b = u >> 8;
        __syncthreads();
        for (int q = tid; q < 2048; q += 512) { const int c = q >> 3, t8 = q & 7;
            *(LAS v4u*)(T + c * 72 + t8 * 8) = *(const v4u*)(YT + ((size_t)b * 1024 + cg * 256 + c) * SEQ + tt * 64 + t8 * 8); }
        __syncthreads();
        const int t = tid >> 3, c32 = tid & 7;
#pragma unroll
        for (int q = 0; q < 4; ++q) { const int cb = c32 * 32 + q * 8; v4u w;
            w.x = (unsigned)T[(cb + 0) * 72 + t] | ((unsigned)T[(cb + 1) * 72 + t] << 16); w.y = (unsigned)T[(cb + 2) * 72 + t] | ((unsigned)T[(cb + 3) * 72 + t] << 16);
            w.z = (unsigned)T[(cb + 4) * 72 + t] | ((unsigned)T[(cb + 5) * 72 + t] << 16); w.w = (unsigned)T[(cb + 6) * 72 + t] | ((unsigned)T[(cb + 7) * 72 + t] << 16);
            *(v4u*)(YS + (size_t)(b * SEQ + tt * 64 + t) * 1024 + cg * 256 + cb) = w; }
    }
}
__device__ __forceinline__ void ph_ret3(const Args& A, int l, int nctx_units, LAS unsigned char* lds, int tid) {
    LAS bf16* Qs = (LAS bf16*)lds; LAS bf16* Ks = Qs + 128 * 72; LAS bf16* Vt = Ks + 128 * 72; LAS bf16* Sf = Vt + 128 * 136; LAS bf16* Sb = Sf + 128 * 72;
    const bf16* Z = (const bf16*)(wsb() + WS_Z); const float* KV = (const float*)(wsb() + WS_KV); const f32x2* rope = (const f32x2*)(wsb() + WS_ROPE);
    bf16* YS = (bf16*)(wsb() + WS_YS) + (size_t)MT * 1024;
    const int lane = tid & 63, w = tid >> 6, g = lane >> 4, li = lane & 15;
    for (int uid = blockIdx.x; uid < 1024 + nctx_units; uid += gridDim.x) {
        const bool isc = uid >= 1024; int b, h, n, ci; size_t m0;
        if (!isc) { b = uid >> 8; h = (uid >> 5) & 7; n = uid & 31; m0 = (size_t)b * SEQ + n * 128; ci = 2 + n; }
        else { const int i = uid - 1024; b = i >> 4; h = (i >> 1) & 7; n = i & 1; m0 = (size_t)ML + b * CL + n * 128; ci = n; }
        const float lgf = inp(I_RDEC)[(l * 2 + 0) * 8 + h] * LOG2E, lgb = inp(I_RDEC)[(l * 2 + 1) * 8 + h] * LOG2E;
        __syncthreads();
        { const int tok = tid >> 2, pp = tid & 3, a = (pp & 1) + ((pp >> 1) << 2);
            const int t = n * 128 + tok; const int pos = (a < 4) ? (t >> 6) : (t & 63); const f32x2* rt = rope + pos * 16 + 8 * (a & 1);
            const bf16* qr = Z + (m0 + tok) * INW + C_RQ + h * 64; const bf16* kr = Z + (m0 + tok) * INW + C_RK + h * 64;
            float lo[8], hi[8];
            unpack8(*(const v4u*)(qr + 8 * a), lo); unpack8(*(const v4u*)(qr + 8 * a + 16), hi);
            if (!isc) rope8(lo, hi, rt);
            *(LAS v4u*)(Qs + tok * 72 + 8 * a) = pack8(lo); *(LAS v4u*)(Qs + tok * 72 + 8 * a + 16) = pack8(hi);
            unpack8(*(const v4u*)(kr + 8 * a), lo); unpack8(*(const v4u*)(kr + 8 * a + 16), hi);
            if (!isc) rope8(lo, hi, rt);
#pragma unroll
            for (int e = 0; e < 8; ++e) { lo[e] *= 0.125f; hi[e] *= 0.125f; }
            *(LAS v4u*)(Ks + tok * 72 + 8 * a) = pack8(lo); *(LAS v4u*)(Ks + tok * 72 + 8 * a + 16) = pack8(hi); }
        for (int q = tid; q < 2048; q += 512) { const int r = q >> 4, ch = q & 15; vt_store(Vt, 136, ch * 8, r, *(const v4u*)(Z + (m0 + r) * INW + C_RV + h * 128 + ch * 8)); }
#pragma unroll
        for (int dir = 0; dir < 2; ++dir) { const f32x4* src = (const f32x4*)(KV + ((size_t)((b * 8 + h) * 2 + dir) * 34 + ci) * 8192); LAS bf16* S = dir ? Sb : Sf;
            for (int q = tid; q < 2048; q += 512) { const f32x4 v = src[q]; v2u wv; wv.x = pk2(v.x, v.y); wv.y = pk2(v.z, v.w); *(LAS v2u*)(S + (q >> 4) * 72 + (q & 15) * 4) = wv; } }
        __syncthreads();
        const int iq = 16 * w + li;
        bf16x8 qf[2];
#pragma unroll
        for (int ks = 0; ks < 2; ++ks) qf[ks] = *(const LAS bf16x8*)(Qs + iq * 72 + 32 * ks + 8 * g);
        f32x4 s[8];
#pragma unroll
        for (int nn = 0; nn < 8; ++nn) { s[nn] = (f32x4){0.f, 0.f, 0.f, 0.f};
#pragma unroll
            for (int ks = 0; ks < 2; ++ks) s[nn] = mfma16(*(const LAS bf16x8*)(Ks + (16 * nn + li) * 72 + 32 * ks + 8 * g), qf[ks], s[nn]);
#pragma unroll
            for (int j = 0; j < 4; ++j) { const int d = iq - (16 * nn + 4 * g + j); s[nn][j] *= (d >= 0) ? ex2(lgf * (float)d) : ex2(lgb * (float)(-d)); } }
        f32x4 o[8];
#pragma unroll
        for (int nd = 0; nd < 8; ++nd) o[nd] = (f32x4){0.f, 0.f, 0.f, 0.f};
#pragma unroll
        for (int kk = 0; kk < 4; ++kk) {
            const bf16x8 pf = mk8(pk2(s[2 * kk][0], s[2 * kk][1]), pk2(s[2 * kk][2], s[2 * kk][3]), pk2(s[2 * kk + 1][0], s[2 * kk + 1][1]), pk2(s[2 * kk + 1][2], s[2 * kk + 1][3]));
#pragma unroll
            for (int nd = 0; nd < 8; ++nd) { const LAS bf16* vp = Vt + (16 * nd + li) * 136 + 32 * kk + 4 * g;
                const v2u lo = *(const LAS v2u*)vp, hi = *(const LAS v2u*)(vp + 16);
                o[nd] = mfma16(mk8(lo.x, lo.y, hi.x, hi.y), pf, o[nd]); } }
        const float xif = ex2(lgf * (float)(iq + 1)), xib = ex2(lgb * (float)(128 - iq));
        float ss = 0.f;
#pragma unroll
        for (int nd = 0; nd < 8; ++nd) { f32x4 tf = (f32x4){0.f, 0.f, 0.f, 0.f}, tb = (f32x4){0.f, 0.f, 0.f, 0.f};
#pragma unroll
            for (int ks = 0; ks < 2; ++ks) { tf = mfma16(*(const LAS bf16x8*)(Sf + (16 * nd + li) * 72 + 32 * ks + 8 * g), qf[ks], tf);
                tb = mfma16(*(const LAS bf16x8*)(Sb + (16 * nd + li) * 72 + 32 * ks + 8 * g), qf[ks], tb); }
            o[nd] = o[nd] + tf * xif + tb * xib;
            ss += (o[nd][0] * o[nd][0] + o[nd][1] * o[nd][1]) + (o[nd][2] * o[nd][2] + o[nd][3] * o[nd][3]); }
        ss += __shfl_xor(ss, 16); ss += __shfl_xor(ss, 32);
        const float rn = 1.0f / sqrtf(ss * (1.0f / 128.0f) + EPS);
        const size_t mrow = m0 + iq;
#pragma unroll
        for (int nd = 0; nd < 8; ++nd) { const int dv = 16 * nd + 4 * g; const v2u gv = *(const v2u*)(Z + mrow * INW + C_RG + h * 128 + dv);
            const float g0 = bflo(gv.x), g1 = bfhi(gv.x), g2 = bflo(gv.y), g3 = bfhi(gv.y);
            v2u wv; wv.x = pk2(g0 / (1.0f + __expf(-g0)) * o[nd][0] * rn, g1 / (1.0f + __expf(-g1)) * o[nd][1] * rn);
            wv.y = pk2(g2 / (1.0f + __expf(-g2)) * o[nd][2] * rn, g3 / (1.0f + __expf(-g3)) * o[nd][3] * rn);
            *(v2u*)(YS + mrow * 1024 + h * 128 + dv) = wv; }
    }
}

__device__ __forceinline__ float gelu_fx(float x) { const float x2 = x * x; const float arg = x * (x2 * (-2.0f * 1.4426950408889634f * 0.7978845608028654f * 0.044715f) + (-2.0f * 1.4426950408889634f * 0.7978845608028654f));
    return x * __builtin_amdgcn_rcpf(1.0f + __builtin_amdgcn_exp2f(arg)); }
__device__ __forceinline__ void ph_ffnfix(const Args& A, int l, int Mrows, int tid) {
    const bf16* SA = (const bf16*)(wsb() + WS_SA); const bf16* SB = (const bf16*)(wsb() + WS_SB); bf16* U = (bf16*)(wsb() + WS_U);
    const float* cw = inp(I_FFCW) + (size_t)l * 3 * DFF; const float* cb = inp(I_FFCB) + (size_t)l * DFF;
    const int nblk = Mrows / 64;
    for (int u = blockIdx.x; u < nblk * 2; u += gridDim.x) {
        const int blk = u >> 1, hi = u & 1, R = blk * 64 + (hi ? 63 : 0);
        const bool seq_first = (R < ML) ? ((R & (SEQ - 1)) == 0) : ((R & (CL - 1)) == 0), seq_last = (R < ML) ? ((R & (SEQ - 1)) == SEQ - 1) : ((R & (CL - 1)) == CL - 1);
        const bf16* pprev = hi ? SA + ((size_t)blk * 4 + 2) * DFF : SA + ((size_t)(blk - 1) * 4 + 3) * DFF;
        const bf16* pcur = SA + ((size_t)blk * 4 + (hi ? 3 : 0)) * DFF;
        const bf16* pnext = hi ? SA + ((size_t)(blk + 1) * 4 + 0) * DFF : SA + ((size_t)blk * 4 + 1) * DFF;
        const bf16* pb = SB + ((size_t)blk * 2 + hi) * DFF;
        const bool zp = (!hi && seq_first), zn = (hi && seq_last);
        for (int q = tid; q < DFF / 8; q += 512) { const int f = q * 8;
            float am[8], a0[8], aq[8], bg[8]; const v4u z4 = (v4u){0u, 0u, 0u, 0u};
            unpack8(zp ? z4 : *(const v4u*)(pprev + f), am); unpack8(*(const v4u*)(pcur + f), a0); unpack8(zn ? z4 : *(const v4u*)(pnext + f), aq); unpack8(*(const v4u*)(pb + f), bg);
            float r[8];
#pragma unroll
            for (int e = 0; e < 8; ++e) r[e] = gelu_fx(cw[f + e] * am[e] + cw[DFF + f + e] * a0[e] + cw[2 * DFF + f + e] * aq[e] + cb[f + e]) * bg[e];
            *(v4u*)(U + (size_t)R * DFF + f) = pack8(r); }
    }
}
__device__ __forceinline__ void ph_final(const Args& A, int wave, int lane) {
    const int gw = blockIdx.x * NWAVES + wave, NGW = gridDim.x * NWAVES; const float* g = inp(I_GF);
    for (int m = gw; m < ML; m += NGW) { float* xr = outb() + (size_t)m * D; f32x4 v[8]; float ss = 0.f;
#pragma unroll
        for (int j = 0; j < 8; ++j) { v[j] = *(const f32x4*)(xr + (lane + 64 * j) * 4); ss += (v[j].x * v[j].x + v[j].y * v[j].y) + (v[j].z * v[j].z + v[j].w * v[j].w); }
        const float rstd = 1.0f / sqrtf(wave_sum(ss) * (1.0f / D) + EPS);
#pragma unroll
        for (int j = 0; j < 8; ++j) { const int idx = (lane + 64 * j) * 4; *(f32x4*)(xr + idx) = v[j] * rstd * *(const f32x4*)(g + idx); }
    }
}
constexpr int BG_SPLIT = 22016;
constexpr int SEQ_PER_LAYER = 11, NSEQ = 1 + DEPTH * SEQ_PER_LAYER + 1;
__global__ void __launch_bounds__(NWAVES * 64, 2) fwd(Args A) {
    extern __shared__ __attribute__((aligned(16))) unsigned char lds_raw[];
    LAS unsigned char* lds = (LAS unsigned char*)lds_raw;
    volatile LAS unsigned* MISC = (volatile LAS unsigned*)(lds + MISC_OFF);
    for (int u = threadIdx.x; u < (LDS_BYTES - LDSCTL_OFF) / 4; u += NWAVES * 64) ((LAS unsigned*)(lds + LDSCTL_OFF))[u] = 0u;
    __syncthreads();
    (void)xcd_barrier_post((unsigned*)(wsb() + WS_CTL) + CW_BAR, MISC + 8);
    const int lo = A.seq_lo, hi = A.seq_hi;
#define G ((int)gridDim.x)
#define RUN(s) (lo <= (s) && (s) < hi)
#ifndef DUP
#define DUP 0
#endif
#define DUPN(id) ((((DUP) >> (id)) & 1) ? 2 : 1)
#define TID_HERE const int tid = otid(), lane = tid & 63, wave = __builtin_amdgcn_readfirstlane(tid >> 6); (void)lane; (void)wave
#ifdef ONLY
#define PH_ON(k) ((k) == ONLY)
#elif defined(SKIP)
#define PH_ON(k) ((k) != SKIP)
#else
#define PH_ON(k) true
#endif
#define SEAM(s) do { if (RUN((s) + 1)) { XcdBarrier bar_; bar_.bar = (unsigned*)(wsb() + WS_CTL) + CW_BAR; bar_.x = xb_xcc_id(); bar_.st = (volatile LAS unsigned*)(lds + MISC_OFF) + 8; xcd_barrier(bar_); } } while (0)
#define H ((bf16*)(wsb() + WS_H))
#define Z ((bf16*)(wsb() + WS_Z))
#define ACC ((bf16*)(wsb() + WS_ACC))
#define U ((bf16*)(wsb() + WS_U))
#define YS ((bf16*)(wsb() + WS_YS))
#define XC ((float*)(wsb() + WS_XC))
#define WIN ((const bf16*)(psb(l & 1) + PS_WIN))
#define WBR ((const bf16*)(psb(l & 1) + PS_WBR))
#define WOUT ((const bf16*)(psb(l & 1) + PS_WOUT))
#define WF1 ((const bf16*)(psb(l & 1) + PS_WF1))
#define WF2 ((const bf16*)(psb(l & 1) + PS_WF2))

    if (PH_ON(100) && RUN(0)) { TID_HERE; ph_prologue(A, lds, tid); __syncthreads(); ph_convert(A, 0, 0, 0, CONV_ITEMS, (int)blockIdx.x, G, lds, wave, lane); __syncthreads(); ph_filt1(A, 0, 0, (int)blockIdx.x, G, lds, tid); SEAM(0); }

    for (int l = 0; l < DEPTH; ++l) {
        const int sb = 1 + l * SEQ_PER_LAYER;
        if (hi <= sb || lo >= sb + SEQ_PER_LAYER) continue;
        const bool lastl = (l == DEPTH - 1);
        const int Mrows = lastl ? ML : MT, nctx = lastl ? 0 : 64;
#define modl ((const float*)(wsb() + WS_MOD) + (size_t)l * 5 * 12288)
#define xlat_in ((l == 0) ? inp(I_X) : (const float*)outb())
#define xctx_in ((l == 0) ? inp(I_CTX) : (const float*)XC)

        if (PH_ON(0) && RUN(sb + 0)) { TID_HERE;
            if (l == 0) ph_filt2(A, 0, 0, (int)blockIdx.x, G, lds, tid);
            for (int r_ = 0; r_ < DUPN(2); ++r_) ph_norm(xlat_in, xctx_in, inp(I_G1) + (size_t)l * D, modl, 0, D, H, MT, wave, lane);
            SEAM(sb + 0);
        }
        if (PH_ON(1) && RUN(sb + 1)) { TID_HERE;
            { pg8::Gemm g{H, WIN, opq(MT), opq(INW), opq(D)}; pg8::StaticOrder S; S.init(g.M, g.N, G, (int)blockIdx.x);
              pg8::EpiStore E{Z, INW};
              pg8::gemm_phase<pg8::EpiStore, pg8::StaticOrder, PG8_ALIGN, PG8_SP2>(lds, g, S, E); }
            SEAM(sb + 1);
        }
        if (PH_ON(2) && RUN(sb + 2)) { TID_HERE;
            for (int r_ = 0; r_ < DUPN(4); ++r_) ph_hyprep(A, l, lds, tid);
            for (int r_ = 0; r_ < DUPN(5); ++r_) ph_ret1(A, l, 64, lds, tid);
            for (int r_ = 0; r_ < DUPN(6); ++r_) ph_natt(A, l, nctx, lds, tid);
            for (int r_ = 0; r_ < DUPN(7); ++r_) if (!lastl) ph_hyctx(A, l, lds, tid);
            SEAM(sb + 2);
        }
        if (PH_ON(3) && RUN(sb + 3)) { TID_HERE;
#ifndef NO_D1
            for (int r_ = 0; r_ < DUPN(8); ++r_) ph_hyfft(A, l, lds, tid);
#endif
#ifndef NO_D2
            ph_scan(A, l, tid);
#endif
            SEAM(sb + 3);
        }
        if (PH_ON(4) && RUN(sb + 4)) { TID_HERE;
            for (int r_ = 0; r_ < DUPN(9); ++r_) ph_hypost(A, lds, tid);
            for (int r_ = 0; r_ < DUPN(10); ++r_) ph_ret3(A, l, nctx, lds, tid);
            SEAM(sb + 4);
        }
        if (PH_ON(5) && RUN(sb + 5)) { TID_HERE;
            __syncthreads();
            for (int r_ = 0; r_ < DUPN(13); ++r_)
            for (int i = 0; i < 3; ++i) {
                pg8::Gemm g{YS + (size_t)i * MT * 1024, WBR + (size_t)i * D * 1024, Mrows, opq(D), opq(1024)}; pg8::StaticOrder S; S.init(g.M, g.N, G, (int)blockIdx.x);
                pg8::EpiMerge E{ACC, Z + C_GT + i * D, INW, i == 0 ? 1 : 0};
                pg8::gemm_phase<pg8::EpiMerge, pg8::StaticOrder, PG8_ALIGN, PG8_SP2>(lds, g, S, E);
            }
            if (!lastl && blockIdx.x >= 32) { const int wk = (int)blockIdx.x - 32, nwk = G - 32; __syncthreads();
                ph_filt1(A, l + 1, (l + 1) & 1, wk, nwk, lds, tid); __syncthreads();
                ph_convert(A, l + 1, (l + 1) & 1, 0, BG_SPLIT, wk, nwk, lds, wave, lane); }
            SEAM(sb + 5);
        }
        if (PH_ON(6) && RUN(sb + 6)) { TID_HERE;
            __syncthreads();
            pg8::Gemm g{ACC, WOUT, Mrows, opq(D), opq(D)}; pg8::StaticOrder S; S.init(g.M, g.N, G, (int)blockIdx.x);
            pg8::EpiResid E{xlat_in, xctx_in, outb(), XC, modl, 2 * D};
            pg8::gemm_phase<pg8::EpiResid, pg8::StaticOrder, PG8_ALIGN, PG8_SP2>(lds, g, S, E);
            if (!lastl && blockIdx.x >= 32) { __syncthreads(); ph_convert(A, l + 1, (l + 1) & 1, BG_SPLIT, CONV_ITEMS, (int)blockIdx.x - 32, G - 32, lds, wave, lane); }
            SEAM(sb + 6);
        }
        if (PH_ON(7) && RUN(sb + 7)) { TID_HERE;
            for (int r_ = 0; r_ < DUPN(12); ++r_) ph_norm(outb(), XC, inp(I_G2) + (size_t)l * D, modl, 3 * D, 4 * D, H, Mrows, wave, lane);
            SEAM(sb + 7);
        }
        if (PH_ON(8) && RUN(sb + 8)) { TID_HERE;
            __syncthreads();
            pg8::Gemm g{H, WF1, Mrows, opq(NFF), opq(D)}; pg8::StaticOrder S; S.init(g.M, g.N, G, (int)blockIdx.x);
            pg8::EpiFfn E{U, (bf16*)(wsb() + WS_SA), (bf16*)(wsb() + WS_SB), inp(I_FFCW) + (size_t)l * 3 * DFF, inp(I_FFCB) + (size_t)l * DFF};
            for (int r_ = 0; r_ < DUPN(14); ++r_) pg8::gemm_phase<pg8::EpiFfn, pg8::StaticOrder, PG8_ALIGN, PG8_SP2>(lds, g, S, E);
            SEAM(sb + 8);
        }
        if (PH_ON(9) && RUN(sb + 9)) { TID_HERE;
            for (int r_ = 0; r_ < DUPN(11); ++r_) ph_ffnfix(A, l, Mrows, tid);
            SEAM(sb + 9);
        }
        if (PH_ON(10) && RUN(sb + 10)) { TID_HERE;
            __syncthreads();
            pg8::Gemm g{U, WF2, Mrows, opq(D), opq(DFF)}; pg8::StaticOrder S; S.init(g.M, g.N, G, (int)blockIdx.x);
            pg8::EpiResid E{outb(), XC, outb(), XC, modl, 5 * D};
            pg8::gemm_phase<pg8::EpiResid, pg8::StaticOrder, PG8_ALIGN, PG8_SP2>(lds, g, S, E);
            if (!lastl && blockIdx.x >= 32) { __syncthreads(); ph_filt2(A, l + 1, (l + 1) & 1, (int)blockIdx.x - 32, G - 32, lds, tid); }
            SEAM(sb + 10);
        }
    }
    if (PH_ON(101) && RUN(NSEQ - 1)) { TID_HERE; ph_final(A, wave, lane); }
#undef RUN
#undef SEAM
#undef H
#undef Z
#undef ACC
#undef U
#undef YS
#undef XC
#undef WIN
#undef WBR
#undef WOUT
#undef WF1
#undef WF2
#undef G
#undef modl
#undef xlat_in
#undef xctx_in
}

extern "C" void kernel_launch(void* const* d_in, const int* in_sizes, int n_in, void* d_out, int out_size, void* d_ws, size_t ws_size, hipStream_t stream) {
    static int grid = 0;
    if (grid == 0) {
        if (n_in != 27 || out_size != ML * D || ws_size < WS_END) { fprintf(stderr, "kernel_launch: unexpected shapes (n_in %d out %d ws %zu need %zu)\n", n_in, out_size, ws_size, (size_t)WS_END); grid = -1; return; }
        int dev = 0, cus = 0, per_cu = 0;
        if (hipGetDevice(&dev) != hipSuccess || hipDeviceGetAttribute(&cus, hipDeviceAttributeMultiprocessorCount, dev) != hipSuccess) { grid = -1; return; }
        if (hipFuncSetAttribute((const void*)fwd, hipFuncAttributeMaxDynamicSharedMemorySize, LDS_BYTES) != hipSuccess) { fprintf(stderr, "kernel_launch: hipFuncSetAttribute failed\n"); grid = -1; return; }
        if (hipOccupancyMaxActiveBlocksPerMultiprocessor(&per_cu, (const void*)fwd, NWAVES * 64, LDS_BYTES) != hipSuccess || per_cu < 1) fprintf(stderr, "kernel_launch: occupancy query says %d\n", per_cu);
        (void)hipGetLastError();
        grid = cus;
    }
    if (grid < 0) return;
    (void)hipMemsetAsync((char*)d_ws + WS_CTL, 0, CTL_ZERO_BYTES, stream);
    Args a{};
    for (int i = 0; i < 27; ++i) a.in[i] = (const float*)d_in[i];
    a.out = (float*)d_out; a.ws = (unsigned char*)d_ws;
#if MK_SINGLE
    a.seq_lo = 0; a.seq_hi = NSEQ;
    hipLaunchKernelGGL(fwd, dim3(grid), dim3(NWAVES * 64), LDS_BYTES, stream, a);
#else
    for (int s = 0; s < NSEQ; ++s) { a.seq_lo = s; a.seq_hi = s + 1; hipLaunchKernelGGL(fwd, dim3(grid), dim3(NWAVES * 64), LDS_BYTES, stream, a); }
#endif
}
```

```cpp
#include <hip/hip_runtime.h>
#include <cstdio>
#include <cstdint>
#ifndef MK_SINGLE
#define MK_SINGLE 1
#endif
namespace pg8 {
#define PG8_LAS __attribute__((address_space(3)))
typedef unsigned short bf16_t;
typedef short bf16x8 __attribute__((ext_vector_type(8)));
typedef float f32x4 __attribute__((ext_vector_type(4)));
typedef unsigned u32x4 __attribute__((ext_vector_type(4)));
constexpr int BM = 256, BK = 64, HALF = 128, HTB = HALF * BK * 2  , STAGE_BYTES = 8 * HTB, NXCD = 8, WGM = 8;

__host__ __device__ __forceinline__ int lds_byte(int r, int c) { const int st = (r >> 4) * 2 + (c >> 5), rr = r & 15, cc = c & 31, ob = rr * 64 + cc * 2; return st * 1024 + (ob ^ (((ob >> 9) & 1) << 5)); }
__host__ __device__ __forceinline__ void stage_rc(int b, int& R, int& C) { const int st = b / 1024, sb = b % 1024, swz = sb ^ (((sb >> 9) & 1) << 5); R = (st >> 1) * 16 + swz / 64; C = (st & 1) * 32 + (swz % 64) / 2; }
__host__ __device__ __forceinline__ int perm32(int rho) { const int n = rho >> 4, i = rho & 15; return 8 * (i >> 2) + 4 * n + (i & 3); }

struct Unit { int pm, pn, ko; };
struct Gemm { const bf16_t* A; const bf16_t* Bt; int M, N, K, ld; };

struct StaticOrder {
    int nM, nN, nwg, G, c;
    __host__ __device__ void init(int M, int N, int G_, int c_) { nM = M / BM; nN = N / BM; nwg = nM * nN; G = G_; c = c_; }
    __host__ __device__ bool next(int i, Unit& u) const {
        const long L = (long)i * G + c; if (L >= nwg) return false;
        int wgid = (int)L; { const int q = nwg / NXCD, r = nwg % NXCD, xcd = wgid % NXCD, off = wgid / NXCD; wgid = (xcd < r ? xcd * (q + 1) : r * (q + 1) + (xcd - r) * q) + off; }
        const int nig = WGM * nN, gid = wgid / nig, fm = gid * WGM, gsz = (nM - fm) < WGM ? (nM - fm) : WGM;
        u.pm = fm + ((wgid % nig) % gsz); u.pn = (wgid % nig) / gsz; u.ko = 0; return true;
    }
    __device__ __forceinline__ void a_ready(const Unit&) const {}
    __device__ __forceinline__ void done(const Unit&) const {}
};
__device__ __forceinline__ unsigned cvt_pk_bf16(float lo, float hi) { unsigned r; asm volatile("v_cvt_pk_bf16_f32 %0, %1, %2" : "=v"(r) : "v"(lo), "v"(hi)); return r; }
typedef float f32x2 __attribute__((ext_vector_type(2)));
__device__ __forceinline__ float bflo(unsigned w) { return __uint_as_float(w << 16); }
__device__ __forceinline__ float bfhi(unsigned w) { return __uint_as_float(w & 0xffff0000u); }
__device__ __forceinline__ float sigm(float x) { return 1.0f / (1.0f + __expf(-x)); }
struct EpiStore {
    static constexpr bool PERM = true, AFTER_DRAIN = false;
    bf16_t* O; int ldc;
    __device__ __forceinline__ void operator()(const f32x4 (&acc)[2][2][4][2], const Unit& u, int wr, int wc, int fr, int fq) const {
        const int row0 = u.pm * BM + wr * 64 + fr, col0 = u.pn * BM + wc * 32 + 8 * fq;
#pragma unroll
        for (int ai = 0; ai < 2; ++ai)
#pragma unroll
            for (int m = 0; m < 4; ++m) { bf16_t* rowp = O + (size_t)(row0 + ai * HALF + m * 16) * ldc + col0;
#pragma unroll
                for (int bj = 0; bj < 2; ++bj) { const f32x4 v0 = acc[ai][bj][m][0], v1 = acc[ai][bj][m][1];
                    u32x4 w; w.x = cvt_pk_bf16(v0[0], v0[1]); w.y = cvt_pk_bf16(v0[2], v0[3]); w.z = cvt_pk_bf16(v1[0], v1[1]); w.w = cvt_pk_bf16(v1[2], v1[3]);
                    *(u32x4*)(rowp + bj * HALF) = w; } }
    }
};
struct EpiMerge {
    static constexpr bool PERM = true, AFTER_DRAIN = false;
    bf16_t* O; const bf16_t* gate; int ldg; int first;
    __device__ __forceinline__ void operator()(const f32x4 (&acc)[2][2][4][2], const Unit& u, int wr, int wc, int fr, int fq) const {
        const int row0 = u.pm * BM + wr * 64 + fr, col0 = u.pn * BM + wc * 32 + 8 * fq;
#pragma unroll
        for (int ai = 0; ai < 2; ++ai)
#pragma unroll
            for (int m = 0; m < 4; ++m) { const size_t row = (size_t)(row0 + ai * HALF + m * 16);
#pragma unroll
                for (int bj = 0; bj < 2; ++bj) { const int col = col0 + bj * HALF;
                    const u32x4 gv = *(const u32x4*)(gate + row * ldg + col);
                    u32x4 pv = (u32x4){0u, 0u, 0u, 0u}; if (!first) pv = *(const u32x4*)(O + row * 2048 + col);
                    const f32x4 v0 = acc[ai][bj][m][0], v1 = acc[ai][bj][m][1];
                    u32x4 w;
                    w.x = cvt_pk_bf16(bflo(pv.x) + v0[0] * sigm(bflo(gv.x)), bfhi(pv.x) + v0[1] * sigm(bfhi(gv.x)));
                    w.y = cvt_pk_bf16(bflo(pv.y) + v0[2] * sigm(bflo(gv.y)), bfhi(pv.y) + v0[3] * sigm(bfhi(gv.y)));
                    w.z = cvt_pk_bf16(bflo(pv.z) + v1[0] * sigm(bflo(gv.z)), bfhi(pv.z) + v1[1] * sigm(bfhi(gv.z)));
                    w.w = cvt_pk_bf16(bflo(pv.w) + v1[2] * sigm(bflo(gv.w)), bfhi(pv.w) + v1[3] * sigm(bfhi(gv.w)));
                    *(u32x4*)(O + row * 2048 + col) = w; } }
    }
};
struct EpiResid {
    static constexpr bool PERM = false, AFTER_DRAIN = false;
    const float* base_lat; const float* base_ctx; float* out_lat; float* out_ctx; const float* modl; int goff;
    __device__ __forceinline__ void operator()(const f32x4 (&acc)[2][2][4][2], const Unit& u, int wr, int wc, int fr, int fq) const {
        const bool isctx = u.pm >= 64; const int r = isctx ? 4 : (u.pm >> 4);
        const float* gvp = modl + (size_t)r * 12288 + goff;
        const float* bs = isctx ? base_ctx : base_lat; float* os = isctx ? out_ctx : out_lat;
        const int row0 = (isctx ? u.pm - 64 : u.pm) * BM + wr * 64 + fr, col0 = u.pn * BM + wc * 32 + 4 * fq;
        f32x4 g4[2][2];
#pragma unroll
        for (int bj = 0; bj < 2; ++bj)
#pragma unroll
            for (int n = 0; n < 2; ++n) g4[bj][n] = *(const f32x4*)(gvp + col0 + bj * HALF + n * 16);
#pragma unroll
        for (int ai = 0; ai < 2; ++ai)
#pragma unroll
            for (int m = 0; m < 4; ++m) { const size_t off = (size_t)(row0 + ai * HALF + m * 16) * 2048 + col0;
#pragma unroll
                for (int bj = 0; bj < 2; ++bj)
#pragma unroll
                    for (int n = 0; n < 2; ++n) { const f32x4 b4 = *(const f32x4*)(bs + off + bj * HALF + n * 16);
                        *(f32x4*)(os + off + bj * HALF + n * 16) = b4 + g4[bj][n] * acc[ai][bj][m][n]; } }
    }
};

__device__ __forceinline__ float dpp_ror1(float v) { return __int_as_float(__builtin_amdgcn_update_dpp(0, __float_as_int(v), 0x121, 0xf, 0xf, false)); }
__device__ __forceinline__ float dpp_rol1(float v) { return __int_as_float(__builtin_amdgcn_update_dpp(0, __float_as_int(v), 0x12f, 0xf, 0xf, false)); }
__device__ __forceinline__ float gelu_fast(float x) { const float x2 = x * x; const float arg = x * (x2 * (-2.0f * 1.4426950408889634f * 0.7978845608028654f * 0.044715f) + (-2.0f * 1.4426950408889634f * 0.7978845608028654f));
    return x * __builtin_amdgcn_rcpf(1.0f + __builtin_amdgcn_exp2f(arg)); }
struct EpiFfn {
    static constexpr bool PERM = true, AFTER_DRAIN = false;
    bf16_t* U; bf16_t* SA; bf16_t* SB; const float* cw; const float* cb;
    __device__ __forceinline__ void operator()(const f32x4 (&acc)[2][2][4][2], const Unit& u, int wr, int wc, int fr, int fq) const {
        const int f0 = u.pn * 128 + wc * 32 + 8 * fq;
        f32x4 w0[2], w1[2], w2[2], bb[2];
#pragma unroll
        for (int n = 0; n < 2; ++n) { w0[n] = *(const f32x4*)(cw + f0 + 4 * n); w1[n] = *(const f32x4*)(cw + 5632 + f0 + 4 * n); w2[n] = *(const f32x4*)(cw + 2 * 5632 + f0 + 4 * n); bb[n] = *(const f32x4*)(cb + f0 + 4 * n); }
#pragma unroll
        for (int ai = 0; ai < 2; ++ai) {
            const int row0 = u.pm * BM + ai * HALF + wr * 64 + fr, blk = u.pm * 4 + ai * 2 + wr;
            f32x4 o[4][2];
#pragma unroll
            for (int n = 0; n < 2; ++n)
#pragma unroll
                for (int e = 0; e < 4; ++e) {
                    const float a0 = acc[ai][0][0][n][e], a1 = acc[ai][0][1][n][e], a2 = acc[ai][0][2][n][e], a3 = acc[ai][0][3][n][e];
                    const float r0 = dpp_ror1(a0), r1 = dpp_ror1(a1), r2 = dpp_ror1(a2), r3 = dpp_ror1(a3);
                    const float l0 = dpp_rol1(a0), l1 = dpp_rol1(a1), l2 = dpp_rol1(a2), l3 = dpp_rol1(a3);
                    const bool first = (fr == 0), last = (fr == 15);
                    const float p0 = r0, p1 = first ? r0 : r1, p2 = first ? r1 : r2, p3 = first ? r2 : r3;
                    const float n0 = last ? l1 : l0, n1 = last ? l2 : l1, n2 = last ? l3 : l2, n3 = l3;
                    const float k0 = w0[n][e], k1 = w1[n][e], k2 = w2[n][e], kb = bb[n][e];
                    o[0][n][e] = gelu_fast(k0 * p0 + k1 * a0 + k2 * n0 + kb) * acc[ai][1][0][n][e];
                    o[1][n][e] = gelu_fast(k0 * p1 + k1 * a1 + k2 * n1 + kb) * acc[ai][1][1][n][e];
                    o[2][n][e] = gelu_fast(k0 * p2 + k1 * a2 + k2 * n2 + kb) * acc[ai][1][2][n][e];
                    o[3][n][e] = gelu_fast(k0 * p3 + k1 * a3 + k2 * n3 + kb) * acc[ai][1][3][n][e];
                }
#pragma unroll
            for (int m = 0; m < 4; ++m) { u32x4 w; w.x = cvt_pk_bf16(o[m][0][0], o[m][0][1]); w.y = cvt_pk_bf16(o[m][0][2], o[m][0][3]); w.z = cvt_pk_bf16(o[m][1][0], o[m][1][1]); w.w = cvt_pk_bf16(o[m][1][2], o[m][1][3]);
                *(u32x4*)(U + (size_t)(row0 + m * 16) * 5632 + f0) = w; }
            const int sel = (fr == 0) ? 0 : (fr == 1) ? 1 : (fr == 14) ? 2 : (fr == 15) ? 3 : -1;
            if (sel >= 0) { const int m = (sel < 2) ? 0 : 3;
                const f32x4 a0 = (m == 0) ? acc[ai][0][0][0] : acc[ai][0][3][0], a1 = (m == 0) ? acc[ai][0][0][1] : acc[ai][0][3][1];
                u32x4 w; w.x = cvt_pk_bf16(a0[0], a0[1]); w.y = cvt_pk_bf16(a0[2], a0[3]); w.z = cvt_pk_bf16(a1[0], a1[1]); w.w = cvt_pk_bf16(a1[2], a1[3]);
                *(u32x4*)(SA + ((size_t)blk * 4 + sel) * 5632 + f0) = w;
                if (sel == 0 || sel == 3) { const f32x4 b0 = (m == 0) ? acc[ai][1][0][0] : acc[ai][1][3][0], b1 = (m == 0) ? acc[ai][1][0][1] : acc[ai][1][3][1];
                    u32x4 v; v.x = cvt_pk_bf16(b0[0], b0[1]); v.y = cvt_pk_bf16(b0[2], b0[3]); v.z = cvt_pk_bf16(b1[0], b1[1]); v.w = cvt_pk_bf16(b1[2], b1[3]);
                    *(u32x4*)(SB + ((size_t)blk * 2 + (sel == 0 ? 0 : 1)) * 5632 + f0) = v; } }
        }
    }
};

struct CtxSplitOrder {
    int nsplit, klen, c;
    __device__ __forceinline__ bool next(int i, Unit& u) const { if (i > 0 || c >= 32 * nsplit) return false; const int tile = c / nsplit, s = c - tile * nsplit; u.pm = 64 + (tile >> 3); u.pn = tile & 7; u.ko = s * klen; return true; }
    __device__ __forceinline__ void a_ready(const Unit&) const {}
    __device__ __forceinline__ void done(const Unit&) const {}
};
struct EpiSlab {
    static constexpr bool PERM = false, AFTER_DRAIN = false;
    float* slab; int klen;
    __device__ __forceinline__ void operator()(const f32x4 (&acc)[2][2][4][2], const Unit& u, int wr, int wc, int fr, int fq) const {
        float* os = slab + (size_t)(u.ko / klen) * 1024 * 2048;
        const int row0 = (u.pm - 64) * BM + wr * 64 + fr, col0 = u.pn * BM + wc * 32 + 4 * fq;
#pragma unroll
        for (int ai = 0; ai < 2; ++ai)
#pragma unroll
            for (int m = 0; m < 4; ++m) { const size_t off = (size_t)(row0 + ai * HALF + m * 16) * 2048 + col0;
#pragma unroll
                for (int bj = 0; bj < 2; ++bj)
#pragma unroll
                    for (int n = 0; n < 2; ++n) *(f32x4*)(os + off + bj * HALF + n * 16) = acc[ai][bj][m][n]; }
    }
};
template <class Epi, class Sched, bool ALIGN_EPI = false, bool SP2 = false>
__device__ __forceinline__ void gemm_phase(PG8_LAS unsigned char* lds, const Gemm g, const Sched& S, const Epi& E) {
    int tid_ = threadIdx.x; asm volatile("" : "+v"(tid_)); const int tid = tid_, wid = __builtin_amdgcn_readfirstlane(tid >> 6), lane = tid & 63, wr = wid >> 2, wc = wid & 3, fr = lane & 15, fq = lane >> 4;
    const int K = g.K, nt = K / BK, LD = g.ld ? g.ld : g.K;
    unsigned voffA[2], voffB[2];
#pragma unroll
    for (int i = 0; i < 2; ++i) { int R, C; stage_rc(tid * 16 + i * 8192, R, C); const int Rb = Epi::PERM ? ((R & ~31) + perm32(R & 31)) : R;
        voffA[i] = (unsigned)(R * LD + C) * 2u; voffB[i] = (unsigned)(Rb * LD + C) * 2u; }
    const size_t kstep = (size_t)(BK * 2);
    const size_t hstep = (size_t)HALF * LD * 2;
    const size_t tstep = 2 * hstep;
    const unsigned ldsw = (unsigned)wid * 1024u;
    const int aoff = lds_byte(wr * 64 + fr, fq * 8), boff = lds_byte(wc * 32 + fr, fq * 8);
#define PG8_SA(b, h) (((b) * 2 + (h)) * HTB)
#define PG8_SB(b, h) ((4 + (b) * 2 + (h)) * HTB)
#define PG8_STAGE(bufoff, gbase, voff) do { _Pragma("unroll") for (int _i = 0; _i < 2; ++_i) \
        __builtin_amdgcn_global_load_lds((const unsigned*)((const char*)(gbase) + (voff)[_i]), (PG8_LAS unsigned*)(lds + (bufoff) + ldsw + _i * 8192), 16, 0, 0); } while (0)
#define PG8_LDA(dst, b, h) do { _Pragma("unroll") for (int m = 0; m < 4; ++m) _Pragma("unroll") for (int k = 0; k < 2; ++k) dst[m][k] = *(const PG8_LAS bf16x8*)(lds + PG8_SA(b, h) + aoff + m * 2048 + k * 1024); } while (0)
#define PG8_LDB(dst, b, h) do { _Pragma("unroll") for (int n = 0; n < 2; ++n) _Pragma("unroll") for (int k = 0; k < 2; ++k) dst[n][k] = *(const PG8_LAS bf16x8*)(lds + PG8_SB(b, h) + boff + n * 2048 + k * 1024); } while (0)
#define PG8_MMA(ai, bj, At, Bt) do { __builtin_amdgcn_s_setprio(1); _Pragma("unroll") for (int m = 0; m < 4; ++m) _Pragma("unroll") for (int n = 0; n < 2; ++n) _Pragma("unroll") for (int k = 0; k < 2; ++k) \
        acc[ai][bj][m][n] = __builtin_amdgcn_mfma_f32_16x16x32_bf16(Bt[n][k], At[m][k], acc[ai][bj][m][n], 0, 0, 0); __builtin_amdgcn_s_setprio(0); } while (0)
#define PG8_WAIT_V(n) asm volatile("s_waitcnt vmcnt(" #n ")" ::: "memory")
#define PG8_WAIT_L(n) asm volatile("s_waitcnt lgkmcnt(" #n ")" ::: "memory")
#define PG8_BAR __builtin_amdgcn_s_barrier()
#define PG8_SCHED __builtin_amdgcn_sched_barrier(0)
    Unit cur, nxt; int ui = 0;
    if (!S.next(0, cur)) return;
    f32x4 acc[2][2][4][2];
#pragma unroll
    for (int a = 0; a < 2; ++a)
#pragma unroll
        for (int b = 0; b < 2; ++b)
#pragma unroll
            for (int m = 0; m < 4; ++m)
#pragma unroll
                for (int n = 0; n < 2; ++n) acc[a][b][m][n] = (f32x4){0.f, 0.f, 0.f, 0.f};
    bf16x8 At[4][2], B0[2][2], B1[2][2];
    const char* cA = (const char*)g.A + (size_t)cur.pm * tstep + (size_t)cur.ko * 2; const char* cB = (const char*)g.Bt + (size_t)cur.pn * tstep + (size_t)cur.ko * 2;
    S.a_ready(cur);
    if constexpr (SP2) {
        PG8_STAGE(PG8_SB(0, 0), cB, voffB); PG8_STAGE(PG8_SB(0, 1), cB + hstep, voffB); PG8_STAGE(PG8_SA(0, 0), cA, voffA); PG8_STAGE(PG8_SA(0, 1), cA + hstep, voffA);
        if (wr == 1) PG8_BAR;
        PG8_WAIT_V(2); PG8_BAR;
        PG8_STAGE(PG8_SB(1, 0), cB + kstep, voffB); PG8_STAGE(PG8_SA(1, 0), cA + kstep, voffA); PG8_STAGE(PG8_SB(1, 1), cB + hstep + kstep, voffB);
        PG8_WAIT_V(6); PG8_BAR;
    } else {
        PG8_STAGE(PG8_SB(0, 0), cB, voffB); PG8_STAGE(PG8_SA(0, 0), cA, voffA); PG8_STAGE(PG8_SB(0, 1), cB + hstep, voffB); PG8_STAGE(PG8_SA(0, 1), cA + hstep, voffA);
        if (wr == 1) PG8_BAR;
        PG8_WAIT_V(4); PG8_BAR;
        PG8_STAGE(PG8_SB(1, 0), cB + kstep, voffB); PG8_STAGE(PG8_SA(1, 0), cA + kstep, voffA); PG8_STAGE(PG8_SB(1, 1), cB + hstep + kstep, voffB);
        PG8_WAIT_V(6); PG8_BAR;
    }
    for (;;) {
        const bool has_next = S.next(ui + 1, nxt);
        const char* nA = has_next ? (const char*)g.A + (size_t)nxt.pm * tstep + (size_t)nxt.ko * 2 : cA; const char* nB = has_next ? (const char*)g.Bt + (size_t)nxt.pn * tstep + (size_t)nxt.ko * 2 : cB;
        for (int t = 0; t < nt; t += 2) {
            const bool last = (t == nt - 2);
            const char* a1 = cA + (size_t)(t + 1) * kstep;
            const char* a2 = last ? nA : cA + (size_t)(t + 2) * kstep; const char* b2 = last ? nB : cB + (size_t)(t + 2) * kstep;
            const char* a3 = a2 + kstep; const char* b3 = b2 + kstep;
            if (last && has_next) S.a_ready(nxt);
            if constexpr (SP2) {
            PG8_LDB(B0, 0, 0); PG8_LDB(B1, 0, 1); PG8_SCHED; PG8_LDA(At, 0, 0); PG8_STAGE(PG8_SA(1, 1), a1 + hstep, voffA);
            PG8_WAIT_V(8); PG8_WAIT_L(0); PG8_BAR; PG8_MMA(0, 0, At, B0); PG8_MMA(0, 1, At, B1); PG8_BAR; PG8_SCHED;
            PG8_LDA(At, 0, 1); PG8_STAGE(PG8_SB(0, 0), b2, voffB); PG8_STAGE(PG8_SB(0, 1), b2 + hstep, voffB); PG8_STAGE(PG8_SA(0, 0), a2, voffA);
            PG8_WAIT_V(8); PG8_WAIT_L(0); PG8_BAR; PG8_MMA(1, 0, At, B0); PG8_MMA(1, 1, At, B1); PG8_BAR; PG8_SCHED;
            PG8_LDB(B0, 1, 0); PG8_LDB(B1, 1, 1); PG8_SCHED; PG8_LDA(At, 1, 0); PG8_STAGE(PG8_SA(0, 1), a2 + hstep, voffA);
            PG8_WAIT_V(8); PG8_WAIT_L(0); PG8_BAR; PG8_MMA(0, 0, At, B0); PG8_MMA(0, 1, At, B1); PG8_BAR; PG8_SCHED;
            PG8_LDA(At, 1, 1); PG8_STAGE(PG8_SB(1, 0), b3, voffB); PG8_STAGE(PG8_SB(1, 1), b3 + hstep, voffB); PG8_STAGE(PG8_SA(1, 0), a3, voffA);
            PG8_WAIT_V(8); PG8_WAIT_L(0); PG8_BAR; PG8_MMA(1, 0, At, B0); PG8_MMA(1, 1, At, B1); PG8_BAR; PG8_SCHED;
            } else {
            PG8_LDB(B0, 0, 0); PG8_SCHED; PG8_LDA(At, 0, 0); PG8_STAGE(PG8_SA(1, 1), a1 + hstep, voffA);
            PG8_WAIT_L(8); PG8_BAR; PG8_WAIT_L(0); PG8_MMA(0, 0, At, B0); PG8_BAR; PG8_SCHED;
            PG8_LDB(B1, 0, 1); PG8_STAGE(PG8_SB(0, 0), b2, voffB);
            PG8_BAR; PG8_WAIT_L(0); PG8_MMA(0, 1, At, B1); PG8_BAR;
            PG8_LDA(At, 0, 1); PG8_STAGE(PG8_SA(0, 0), a2, voffA);
            PG8_BAR; PG8_WAIT_L(0); PG8_MMA(1, 0, At, B0); PG8_BAR; PG8_SCHED;
            PG8_STAGE(PG8_SB(0, 1), b2 + hstep, voffB);
            PG8_WAIT_V(6); PG8_BAR; PG8_MMA(1, 1, At, B1); PG8_BAR;
            PG8_LDB(B0, 1, 0); PG8_SCHED; PG8_LDA(At, 1, 0); PG8_STAGE(PG8_SA(0, 1), a2 + hstep, voffA);
            PG8_WAIT_L(8); PG8_BAR; PG8_WAIT_L(0); PG8_MMA(0, 0, At, B0); PG8_BAR; PG8_SCHED;
            PG8_LDB(B1, 1, 1); PG8_STAGE(PG8_SB(1, 0), b3, voffB);
            PG8_BAR; PG8_WAIT_L(0); PG8_MMA(0, 1, At, B1); PG8_BAR;
            PG8_LDA(At, 1, 1); PG8_STAGE(PG8_SA(1, 0), a3, voffA);
            PG8_BAR; PG8_WAIT_L(0); PG8_MMA(1, 0, At, B0); PG8_BAR; PG8_SCHED;
            PG8_STAGE(PG8_SB(1, 1), b3 + hstep, voffB);
            PG8_WAIT_V(6); PG8_BAR; PG8_MMA(1, 1, At, B1); PG8_BAR;
            }
        }
        if constexpr (ALIGN_EPI) { if (wr == 0) PG8_BAR; }
        if constexpr (!Epi::AFTER_DRAIN) { E(acc, cur, wr, wc, fr, fq); S.done(cur); }
        if (!has_next) break;
#pragma unroll
        for (int a = 0; a < 2; ++a)
#pragma unroll
            for (int b = 0; b < 2; ++b)
#pragma unroll
                for (int m = 0; m < 4; ++m)
#pragma unroll
                    for (int n = 0; n < 2; ++n) acc[a][b][m][n] = (f32x4){0.f, 0.f, 0.f, 0.f};
        cur = nxt; cA = nA; cB = nB; ++ui;
        if constexpr (ALIGN_EPI) { if (wr == 1) PG8_BAR; }
    }
    PG8_WAIT_V(0);
    if constexpr (!ALIGN_EPI) { if (wr == 0) PG8_BAR; }
    PG8_BAR;
    if constexpr (Epi::AFTER_DRAIN) { E.fused(acc, cur, wr, wc, fr, fq, lds, wid, lane); S.done(cur); }
#undef PG8_SA
#undef PG8_SB
#undef PG8_STAGE
#undef PG8_LDA
#undef PG8_LDB
#undef PG8_MMA
#undef PG8_WAIT_V
#undef PG8_WAIT_L
#undef PG8_BAR
#undef PG8_SCHED
}
}
#ifndef PG8_SP2
#define PG8_SP2 true
#endif
#ifndef PG8_ALIGN
#define PG8_ALIGN true
#endif
constexpr int D = 2048, NB = 4, SEQ = 4096, CL = 256, DEPTH = 4;
constexpr int ML = NB * SEQ, MC = NB * CL, MT = ML + MC;
constexpr int INW = 15360, DFF = 5632, NFF = 2 * DFF;
constexpr int C_RK = 0, C_RV = 512, C_NK = 1536, C_NV = 2560, C_RQ = 3584, C_RG = 4096, C_NQ = 5120, C_HY = 6144, C_GT = 9216;
constexpr float EPS = 1e-6f;
constexpr int NWAVES = 8;
constexpr size_t al256(size_t x) { return (x + 255) & ~(size_t)255; }
constexpr size_t WS_CTL = 0, CTL_ZERO_BYTES = 1u << 20;
constexpr size_t WS_MOD = WS_CTL + CTL_ZERO_BYTES;
constexpr size_t WS_ROPE = WS_MOD + al256((size_t)4 * 5 * 12288 * 4);
constexpr size_t PS_FH2 = 0;
constexpr size_t PS_FH2B = PS_FH2 + al256((size_t)4352 * 64 * 4);
constexpr size_t PS_TAPC = PS_FH2B + al256((size_t)4352 * 64 * 2);
constexpr size_t PS_KF = PS_TAPC + al256((size_t)2 * 2 * 1024 * 256 * 4);
constexpr size_t PS_WIN = PS_KF + al256((size_t)2 * 1024 * 8192 * 8);
constexpr size_t PS_WBR = PS_WIN + al256((size_t)INW * D * 2);
constexpr size_t PS_WOUT = PS_WBR + al256((size_t)3 * D * 1024 * 2);
constexpr size_t PS_WF1 = PS_WOUT + al256((size_t)D * D * 2);
constexpr size_t PS_WF2 = PS_WF1 + al256((size_t)NFF * D * 2);
constexpr size_t PS_BYTES = PS_WF2 + al256((size_t)D * DFF * 2);
constexpr size_t WS_PSET = WS_ROPE + al256(64 * 16 * 8);
constexpr size_t WS_XC = WS_PSET + 2 * PS_BYTES;
constexpr size_t WS_H = WS_XC + al256((size_t)MC * D * 4);
constexpr size_t WS_Z = WS_H + al256((size_t)MT * D * 2);
constexpr size_t WS_HYT = WS_Z + al256((size_t)MT * INW * 2);
constexpr size_t WS_YT = WS_HYT + al256((size_t)3 * NB * 1024 * SEQ * 2);
constexpr size_t WS_YS = WS_YT + al256((size_t)NB * 1024 * SEQ * 2);
constexpr size_t WS_ACC = WS_YS + al256((size_t)3 * MT * 1024 * 2);
constexpr size_t WS_U = WS_ACC + al256((size_t)MT * D * 2);
constexpr size_t WS_KV = WS_U + al256((size_t)MT * DFF * 2);
constexpr size_t WS_SA = WS_KV + al256((size_t)NB * 8 * 2 * 34 * 8192 * 4);
constexpr size_t WS_SB = WS_SA + al256((size_t)272 * 4 * DFF * 2);
constexpr size_t WS_SLAB = WS_SB + al256((size_t)272 * 2 * DFF * 2);
constexpr size_t WS_FB4 = WS_SLAB + al256((size_t)4 * MC * D * 4);
constexpr size_t WS_END = WS_FB4 + al256((size_t)4 * 4352 * 64 * 2);
constexpr int NSPLIT = 4;
constexpr int CW_BAR = 4096;
constexpr int RING_BYTES = 131072, LDSCTL_OFF = RING_BYTES, MISC_OFF = LDSCTL_OFF + 320, LDS_BYTES = 147456;

#define GAS __attribute__((address_space(1)))
#define LAS __attribute__((address_space(3)))
typedef unsigned short bf16;
typedef unsigned v4u __attribute__((ext_vector_type(4)));
typedef unsigned v2u __attribute__((ext_vector_type(2)));
typedef float f32x4 __attribute__((ext_vector_type(4)));
typedef float f32x2 __attribute__((ext_vector_type(2)));
typedef short bf16x8 __attribute__((ext_vector_type(8)));
typedef GAS unsigned gu32;
#define LDS_WAIT() asm volatile("s_waitcnt lgkmcnt(0)" ::: "memory")
__device__ __forceinline__ unsigned f2bf(float f) { unsigned u = __builtin_bit_cast(unsigned, f); return (u + 0x7fffu + ((u >> 16) & 1u)) >> 16; }
__device__ __forceinline__ unsigned pk2(float lo, float hi) { return f2bf(lo) | (f2bf(hi) << 16); }
__device__ __forceinline__ float bflo(unsigned w) { return __uint_as_float(w << 16); }
__device__ __forceinline__ float bfhi(unsigned w) { return __uint_as_float(w & 0xffff0000u); }
__device__ __forceinline__ float bf1(bf16 b) { return __uint_as_float(((unsigned)b) << 16); }
__device__ __forceinline__ bf16x8 mk8(unsigned a, unsigned b, unsigned c, unsigned d) { v4u v = (v4u){a, b, c, d}; return __builtin_bit_cast(bf16x8, v); }
__device__ __forceinline__ f32x4 mfma16(bf16x8 a, bf16x8 b, f32x4 c) { return __builtin_amdgcn_mfma_f32_16x16x32_bf16(a, b, c, 0, 0, 0); }
__device__ __forceinline__ float sin_rev(float r) { return __builtin_amdgcn_sinf(r - floorf(r)); }
__device__ __forceinline__ float cos_rev(float r) { return __builtin_amdgcn_cosf(r - floorf(r)); }
__device__ __forceinline__ float sin_rad(float x) { return sin_rev(x * 0.15915494309189535f); }
__device__ __forceinline__ float ex2(float x) { return __builtin_amdgcn_exp2f(x); }
__device__ __forceinline__ float wave_sum(float v) {
#pragma unroll
    for (int o = 1; o < 64; o <<= 1) v += __shfl_xor(v, o);
    return v;
}
__device__ __forceinline__ int otid() { int t = threadIdx.x; asm volatile("" : "+v"(t)); return t; }
__device__ __forceinline__ int opq(int v) { asm volatile("" : "+s"(v)); return v; }
#define XB_TMO      128
#define XB_XCNT(j)  (256  + 64 * (j))
#define XB_XSUB(j)  (1280 + 64 * (j))
#define XB_XGEN(j)  (2304 + 64 * (j))
#define XB_TOP      3328
#define XB_TOPGEN   3392
#define XCD_BAR_WORDS 3456
#define XB_SPIN_CAP (1u << 18)

__device__ __forceinline__ unsigned xb_ld(unsigned* p)              { return __hip_atomic_load(p, __ATOMIC_RELAXED, __HIP_MEMORY_SCOPE_AGENT); }
__device__ __forceinline__ unsigned xb_add(unsigned* p, unsigned v) { return __hip_atomic_fetch_add(p, v, __ATOMIC_RELAXED, __HIP_MEMORY_SCOPE_AGENT); }
__device__ __forceinline__ unsigned xb_xcc_id() { return (unsigned)__builtin_amdgcn_s_getreg((3 << 11) | 20) & 0xFu; }
#define XB_SPIN(cond, bar) do { unsigned _sp = 0; while (cond) { __builtin_amdgcn_s_sleep(1); \
    if ((++_sp & 255u) == 0u) { if (xb_ld(&(bar)[XB_TMO])) break; if (_sp > XB_SPIN_CAP) { atomicAdd(&(bar)[XB_TMO], 1u); break; } } } } while (0)

struct XcdBarrier {
    unsigned* bar; unsigned x;
    volatile LAS unsigned* st;
};

__device__ __forceinline__ XcdBarrier xcd_barrier_post(unsigned* bar, volatile LAS unsigned* st) {
    XcdBarrier b; b.bar = bar; b.x = xb_xcc_id(); b.st = st;
    if (threadIdx.x == 0) (void)xb_add(&bar[XB_XCNT(b.x)], 1u);
    return b;
}
__device__ __forceinline__ void xcd_barrier_complete(unsigned* bar, unsigned x, unsigned& nloc, unsigned& nx) {
    const unsigned G = gridDim.x * gridDim.y * gridDim.z;
    unsigned sum, cnt, mine, sp = 0u;
    for (;;) {
        sum = 0u; cnt = 0u; mine = 0u;
#pragma unroll
        for (unsigned j = 0; j < 16; ++j) { const unsigned c = xb_ld(&bar[XB_XCNT(j)]); sum += c; cnt += (c > 0u) ? 1u : 0u; mine = (j == x) ? c : mine; }
        if (sum == G) break;
        __builtin_amdgcn_s_sleep(1);
        if ((++sp & 255u) == 0u) { if (xb_ld(&bar[XB_TMO])) break; if (sp > XB_SPIN_CAP) { atomicAdd(&bar[XB_TMO], 1u); break; } }
    }
    nloc = mine > 0u ? mine : 1u; nx = cnt > 0u ? cnt : 1u;
}

__device__ __forceinline__ void xcd_barrier(const XcdBarrier& b) {
    asm volatile("s_waitcnt vmcnt(0)" ::: "memory");
    __syncthreads();
    if (threadIdx.x == 0) {
        unsigned* bar = b.bar;
        __builtin_amdgcn_s_waitcnt(0);
        unsigned nloc = b.st[0], nx = b.st[1];
        if (nloc == 0u) { xcd_barrier_complete(bar, b.x, nloc, nx); b.st[0] = nloc; b.st[1] = nx; }
        const unsigned old = xb_add(&bar[XB_XSUB(b.x)], 1u);
        const unsigned gen = old / nloc;
        if (old + 1u == (gen + 1u) * nloc) {
            __builtin_amdgcn_fence(__ATOMIC_RELEASE, "agent");
            asm volatile("s_waitcnt vmcnt(0)" ::: "memory");
            const unsigned og = xb_add(&bar[XB_TOP], 1u);
            const unsigned tg = og / nx;
            if (og + 1u == (tg + 1u) * nx) xb_add(&bar[XB_TOPGEN], 1u);
            else XB_SPIN(xb_ld(&bar[XB_TOPGEN]) == tg, bar);
            __builtin_amdgcn_fence(__ATOMIC_ACQUIRE, "agent");
            xb_add(&bar[XB_XGEN(b.x)], 1u);
            asm volatile("s_waitcnt vmcnt(0)" ::: "memory");
        } else {
            XB_SPIN(xb_ld(&bar[XB_XGEN(b.x)]) == gen, bar);
            __builtin_amdgcn_fence(__ATOMIC_ACQUIRE, "agent");
            asm volatile("s_waitcnt vmcnt(0)" ::: "memory");
        }
    }
    __syncthreads();
}
__device__ __forceinline__ void p0_transpose_item(const float* W, int K, int N, bf16* WT, int row_off, LAS float* scr, int item, int lane) {
    const int nblk = N / 32, kb = item / nblk, nb = item % nblk, k0 = 64 * kb, n0 = 32 * nb;
#pragma unroll 8
    for (int i = 0; i < 32; ++i) { const int kk = 2 * i + (lane >> 5); scr[kk * 33 + (lane & 31)] = __builtin_nontemporal_load(W + (size_t)(k0 + kk) * N + n0 + (lane & 31)); }
    LDS_WAIT(); asm volatile("" ::: "memory");
    const int c = lane & 7;
#pragma unroll
    for (int j = 0; j < 4; ++j) { const int n = (lane >> 3) + 8 * j; const LAS float* s = scr + (8 * c) * 33 + n;
        v4u o; o.x = pk2(s[0 * 33], s[1 * 33]); o.y = pk2(s[2 * 33], s[3 * 33]); o.z = pk2(s[4 * 33], s[5 * 33]); o.w = pk2(s[6 * 33], s[7 * 33]);
        __builtin_nontemporal_store(o, (GAS v4u*)(WT + (size_t)(row_off + n0 + n) * K + k0 + 8 * c)); }
    LDS_WAIT(); asm volatile("" ::: "memory");
}
struct Args { const float* in[27]; float* out; unsigned char* ws; int seq_lo, seq_hi; };
__device__ __forceinline__ const float* inp(int i) { const char* ka = (const char*)__builtin_amdgcn_kernarg_segment_ptr(); int off = i * 8; asm volatile("" : "+s"(off)); return *(const float* const*)(ka + off); }
__device__ __forceinline__ unsigned char* wsb() { const char* ka = (const char*)__builtin_amdgcn_kernarg_segment_ptr(); int off = 27 * 8 + 8; asm volatile("" : "+s"(off)); return *(unsigned char* const*)(ka + off); }
__device__ __forceinline__ float* outb() { const char* ka = (const char*)__builtin_amdgcn_kernarg_segment_ptr(); int off = 27 * 8; asm volatile("" : "+s"(off)); return *(float* const*)(ka + off); }
__device__ __forceinline__ unsigned char* psb(int set) { return wsb() + WS_PSET + (size_t)set * PS_BYTES; }
enum { I_X = 0, I_C, I_CTX, I_CCTX, I_WMOD, I_BMOD, I_G1, I_G2, I_WIN, I_HCW, I_HCB, I_FW1, I_FB1, I_FW2, I_FB2, I_FW3, I_FFQ, I_HBIAS, I_RDEC, I_RPB, I_WBR, I_WOUT, I_FFW1, I_FFCW, I_FFCB, I_FFW2, I_GF };

__device__ __forceinline__ void ph_prologue(const Args& A, LAS unsigned char* lds, int tid) {
    LAS float* sc = (LAS float*)lds;
    LAS float* red = sc + 5 * 2048;
    const float* c = inp(I_C); const float* cc = inp(I_CCTX);
    for (int i = tid; i < 5 * 2048; i += 512) { const int r = i >> 11, k = i & 2047; const float v = (r < 4) ? c[r * 2048 + k] : cc[k]; sc[i] = v / (1.0f + __expf(-v)); }
    __syncthreads();
    float* mod = (float*)(wsb() + WS_MOD);
    const int kq = tid >> 6, col = tid & 63;
    for (int u = blockIdx.x; u < DEPTH * 192; u += gridDim.x) {
        const int l = u / 192, n0 = (u % 192) * 64;
        const float* W = inp(I_WMOD) + (size_t)l * 2048 * 12288 + n0 + col;
        float a0 = 0.f, a1 = 0.f, a2 = 0.f, a3 = 0.f, a4 = 0.f;
        for (int k = kq * 256; k < kq * 256 + 256; ++k) { const float w = W[(size_t)k * 12288];
            a0 += sc[k] * w; a1 += sc[2048 + k] * w; a2 += sc[4096 + k] * w; a3 += sc[6144 + k] * w; a4 += sc[8192 + k] * w; }
        red[(kq * 5 + 0) * 64 + col] = a0; red[(kq * 5 + 1) * 64 + col] = a1; red[(kq * 5 + 2) * 64 + col] = a2; red[(kq * 5 + 3) * 64 + col] = a3; red[(kq * 5 + 4) * 64 + col] = a4;
        __syncthreads();
        if (tid < 320) { const int r = tid >> 6; float s = inp(I_BMOD)[l * 12288 + n0 + col];
#pragma unroll
            for (int q = 0; q < 8; ++q) s += red[(q * 5 + r) * 64 + col];
            mod[((size_t)l * 5 + r) * 12288 + n0 + col] = s; }
        __syncthreads();
    }
    if (blockIdx.x == 0) { f32x2* rope = (f32x2*)(wsb() + WS_ROPE);
        for (int i = tid; i < 1024; i += 512) { const int pos = i >> 4, j = i & 15; const float inv = exp2f(-(float)j * (13.287712379549449f / 16.0f));
            const float rev = (float)pos * inv * 0.15915494309189535f; rope[i] = (f32x2){cos_rev(rev), sin_rev(rev)}; } }
}

__device__ __forceinline__ void ph_convert(const Args& A, int l, int set, int it_lo, int it_hi, int wk, int nwk, LAS unsigned char* lds, int wave, int lane) {
    LAS float* scr = (LAS float*)(lds + wave * 16384);
    const int gw = wk * NWAVES + wave, NGW = nwk * NWAVES;
    constexpr int I_IN = (D / 64) * (INW / 32), I_BR = (1024 / 64) * (D / 32), I_OUT = (D / 64) * (D / 32), I_F1 = (D / 64) * (NFF / 32);
    const float* win = inp(I_WIN) + (size_t)l * D * INW; const float* wbr = inp(I_WBR) + (size_t)l * 3 * 1024 * D; const float* wout = inp(I_WOUT) + (size_t)l * D * D;
    const float* wf1 = inp(I_FFW1) + (size_t)l * D * NFF; const float* wf2 = inp(I_FFW2) + (size_t)l * DFF * D;
    unsigned char* ps = psb(set);
    bf16* WIN = (bf16*)(ps + PS_WIN); bf16* WBR = (bf16*)(ps + PS_WBR); bf16* WOUT = (bf16*)(ps + PS_WOUT); bf16* WF1 = (bf16*)(ps + PS_WF1); bf16* WF2 = (bf16*)(ps + PS_WF2);
    for (int it = it_lo + gw; it < it_hi; it += NGW) {
        int r = it;
        if (r < I_IN) { p0_transpose_item(win, D, INW, WIN, 0, scr, r, lane); continue; } r -= I_IN;
        if (r < I_BR) { p0_transpose_item(wbr, 1024, D, WBR, 0, scr, r, lane); continue; } r -= I_BR;
        if (r < I_BR) { p0_transpose_item(wbr + (size_t)1024 * D, 1024, D, WBR + (size_t)D * 1024, 0, scr, r, lane); continue; } r -= I_BR;
        if (r < I_BR) { p0_transpose_item(wbr + (size_t)2 * 1024 * D, 1024, D, WBR + (size_t)2 * D * 1024, 0, scr, r, lane); continue; } r -= I_BR;
        if (r < I_OUT) { p0_transpose_item(wout, D, D, WOUT, 0, scr, r, lane); continue; } r -= I_OUT;
        if (r < I_F1) { const int n0 = (r % (NFF / 32)) * 32, f0 = (n0 < DFF) ? n0 : n0 - DFF, nrow = 256 * (f0 >> 7) + ((n0 < DFF) ? 0 : 128) + (f0 & 127);
            p0_transpose_item(wf1, D, NFF, WF1, nrow - n0, scr, r, lane); continue; } r -= I_F1;
        p0_transpose_item(wf2, DFF, D, WF2, 0, scr, r, lane);
    }
}
constexpr int CONV_ITEMS = (D / 64) * (INW / 32) + 3 * (1024 / 64) * (D / 32) + (D / 64) * (D / 32) + (D / 64) * (NFF / 32) + (DFF / 64) * (D / 32);
__device__ __forceinline__ void ph_filt1(const Args& A, int l, int set, int wk, int nwk, LAS unsigned char* lds, int tid) {
    LAS float* feat = (LAS float*)lds;
    LAS float* h1 = feat + 8 * 33;
    const float* w1 = inp(I_FW1) + (size_t)l * 33 * 64; const float* b1 = inp(I_FB1) + l * 64; const float* w2 = inp(I_FW2) + (size_t)l * 64 * 64; const float* b2 = inp(I_FB2) + l * 64;
    const float* fq = inp(I_FFQ) + l * 64; bf16* FH2B = (bf16*)(wsb() + WS_FB4) + (size_t)l * 4352 * 64;
    const int pl = tid >> 6, o = tid & 63;
    for (int u = wk; u < 544; u += nwk) {
        const int pos = u * 8 + pl; const bool isc = pos >= 4096; const int Lf = isc ? 256 : 4096, tp = isc ? pos - 4096 : pos;
        if (o < 33) { float f;
            if (o == 0) f = (float)tp / (float)(Lf - 1);
            else { const int i = (o - 1) & 15; const float fr = 1e-4f + (float)i * ((15.0f - 1e-4f) / 15.0f); const float rev = fr * (float)tp / (float)Lf; f = (o <= 16) ? cos_rev(rev) : -sin_rev(rev); }
            feat[pl * 33 + o] = f; }
        __syncthreads();
        float a = b1[o];
#pragma unroll 3
        for (int i = 0; i < 33; ++i) a += feat[pl * 33 + i] * w1[i * 64 + o];
        h1[pl * 64 + o] = sin_rad(fq[o] * a);
        __syncthreads();
        float b = b2[o];
#pragma unroll 4
        for (int j = 0; j < 64; ++j) b += h1[pl * 64 + j] * w2[j * 64 + o];
        { const float hv = sin_rad(fq[o] * b); FH2B[(size_t)pos * 64 + o] = (bf16)f2bf(hv); }
        __syncthreads();
    }
}
__device__ __forceinline__ void ph_norm(const float* xlat, const float* xctx, const float* g, const float* modl, int sh_off, int sc_off, bf16* H, int Mrows, const float* slab, const float* sgate, float* xc_out, int wave, int lane) {
    const int gw = blockIdx.x * NWAVES + wave, NGW = gridDim.x * NWAVES;
    for (int m = gw; m < Mrows; m += NGW) {
        const float* xr; int r; const bool isc = m >= ML;
        if (!isc) { xr = xlat + (size_t)m * D; r = m >> 12; } else { xr = xctx + (size_t)(m - ML) * D; r = 4; }
        const float* mv = modl + (size_t)r * 12288;
        f32x4 v[8]; float ss = 0.f;
#pragma unroll
        for (int j = 0; j < 8; ++j) { const int idx = (lane + 64 * j) * 4; v[j] = *(const f32x4*)(xr + idx);
            if (isc && slab) { const float* sp = slab + (size_t)(m - ML) * D + idx; f32x4 p = *(const f32x4*)sp;
#pragma unroll
                for (int q = 1; q < NSPLIT; ++q) p = p + *(const f32x4*)(sp + (size_t)q * MC * D);
                v[j] = v[j] + *(const f32x4*)(sgate + idx) * p; *(f32x4*)(xc_out + (size_t)(m - ML) * D + idx) = v[j]; }
            ss += (v[j].x * v[j].x + v[j].y * v[j].y) + (v[j].z * v[j].z + v[j].w * v[j].w); }
        const float rstd = 1.0f / sqrtf(wave_sum(ss) * (1.0f / D) + EPS);
#pragma unroll
        for (int j = 0; j < 8; ++j) { const int idx = (lane + 64 * j) * 4;
            const f32x4 gg = *(const f32x4*)(g + idx), sh = *(const f32x4*)(mv + sh_off + idx), sc = *(const f32x4*)(mv + sc_off + idx);
            const f32x4 y = v[j] * rstd * gg * (sc + 1.0f) + sh;
            v2u w; w.x = pk2(y.x, y.y); w.y = pk2(y.z, y.w);
            *(v2u*)(H + (size_t)m * D + idx) = w; }
    }
}

__device__ __forceinline__ int fphys(int i) { return i + 2 * (i >> 5); }
__device__ __forceinline__ void bfly_dif(f32x2& a, f32x2& b, float c, float s) { const f32x2 u = a, v = b; a = u + v; const float dx = u.x - v.x, dy = u.y - v.y; b = (f32x2){dx * c + dy * s, dy * c - dx * s}; }
__device__ __forceinline__ void bfly_idit(f32x2& a, f32x2& b, float c, float s) { const f32x2 u = a, q = b; const f32x2 v = (f32x2){q.x * c - q.y * s, q.x * s + q.y * c}; a = u + v; b = u - v; }
template <bool ZHI> __device__ __forceinline__ void dif16(f32x2 (&x)[16], float th) {
    asm volatile("" : "+v"(th));
#pragma unroll
    for (int k = 0; k < 8; ++k) { const float fr = th + (float)k * 0.0625f; const float c = __builtin_amdgcn_cosf(fr), s = __builtin_amdgcn_sinf(fr);
        if (ZHI) { const f32x2 u = x[k]; x[k + 8] = (f32x2){u.x * c + u.y * s, u.y * c - u.x * s}; } else bfly_dif(x[k], x[k + 8], c, s); }
#pragma unroll
    for (int k = 0; k < 4; ++k) { const float fr = 2.0f * th + (float)k * 0.125f; const float c = __builtin_amdgcn_cosf(fr), s = __builtin_amdgcn_sinf(fr);
        bfly_dif(x[k], x[k + 4], c, s); bfly_dif(x[8 + k], x[12 + k], c, s); }
#pragma unroll
    for (int k = 0; k < 2; ++k) { const float fr = 4.0f * th + (float)k * 0.25f; const float c = __builtin_amdgcn_cosf(fr), s = __builtin_amdgcn_sinf(fr);
#pragma unroll
        for (int b = 0; b < 16; b += 4) bfly_dif(x[b + k], x[b + k + 2], c, s); }
    { const float fr = 8.0f * th; const float c = __builtin_amdgcn_cosf(fr), s = __builtin_amdgcn_sinf(fr);
#pragma unroll
        for (int b = 0; b < 16; b += 2) bfly_dif(x[b], x[b + 1], c, s); }
}
__device__ __forceinline__ void idit16(f32x2 (&x)[16], float th) {
    asm volatile("" : "+v"(th));
    { const float fr = 8.0f * th; const float c = __builtin_amdgcn_cosf(fr), s = __builtin_amdgcn_sinf(fr);
#pragma unroll
        for (int b = 0; b < 16; b += 2) bfly_idit(x[b], x[b + 1], c, s); }
#pragma unroll
    for (int k = 0; k < 2; ++k) { const float fr = 4.0f * th + (float)k * 0.25f; const float c = __builtin_amdgcn_cosf(fr), s = __builtin_amdgcn_sinf(fr);
#pragma unroll
        for (int b = 0; b < 16; b += 4) bfly_idit(x[b + k], x[b + k + 2], c, s); }
#pragma unroll
    for (int k = 0; k < 4; ++k) { const float fr = 2.0f * th + (float)k * 0.125f; const float c = __builtin_amdgcn_cosf(fr), s = __builtin_amdgcn_sinf(fr);
        bfly_idit(x[k], x[k + 4], c, s); bfly_idit(x[8 + k], x[12 + k], c, s); }
#pragma unroll
    for (int k = 0; k < 8; ++k) { const float fr = th + (float)k * 0.0625f; const float c = __builtin_amdgcn_cosf(fr), s = __builtin_amdgcn_sinf(fr); bfly_idit(x[k], x[k + 8], c, s); }
}
template <bool INV> __device__ __forceinline__ void fft_pass(LAS f32x2* buf, int base, int stride, float th) {
    f32x2 x[16];
#pragma unroll
    for (int k = 0; k < 16; ++k) x[k] = buf[fphys(base + k * stride)];
    if (INV) idit16(x, th); else dif16<false>(x, th);
#pragma unroll
    for (int k = 0; k < 16; ++k) buf[fphys(base + k * stride)] = x[k];
}
constexpr int FFT_LDS_BYTES = (8192 + 512 + 8) * 8;
__device__ __forceinline__ float block_sum(float v, LAS float* red, int tid) {
    v = wave_sum(v);
    __syncthreads();
    if ((tid & 63) == 0) red[tid >> 6] = v;
    __syncthreads();
    float s = 0.f;
#pragma unroll
    for (int i = 0; i < 8; ++i) s += red[i];
    return s;
}
__device__ __forceinline__ float hy_delta(int c) { const float d0 = -4.605170185988091f / 0.3f, d1 = -4.605170185988091f / 1.5f; return fabsf(d0 + (d1 - d0) * ((float)c / 1023.0f)); }
__device__ __forceinline__ void ph_filt2(const Args& A, int l, int set, int wk, int nwk, LAS unsigned char* lds, int tid) {
    LAS f32x2* buf = (LAS f32x2*)lds; LAS float* bufs = (LAS float*)lds; LAS float* red = (LAS float*)(lds + FFT_LDS_BYTES + 64); LAS float* w3s = red + 32;
    LAS float* ctap = w3s + 256;
    const float* w3 = inp(I_FW3) + (size_t)l * 64 * 4096; const bf16* FH2B = (const bf16*)(wsb() + WS_FB4) + (size_t)l * 4352 * 64;
    f32x2* KF = (f32x2*)(psb(set) + PS_KF); float* TAPC = (float*)(psb(set) + PS_TAPC);
    const int lane = tid & 63, w = tid >> 6, g = lane >> 4, li = lane & 15;
    for (int c = wk; c < 1024; c += nwk) {
        __syncthreads();
        if (tid < 256) w3s[tid] = w3[(size_t)(tid & 63) * 4096 + (tid >> 7) * 2048 + ((tid >> 6) & 1) * 1024 + c];
        __syncthreads();
        bf16x8 bfr[2];
#pragma unroll
        for (int ks = 0; ks < 2; ++ks) { float v[8];
#pragma unroll
            for (int j = 0; j < 8; ++j) v[j] = (li < 4) ? w3s[li * 64 + 32 * ks + 8 * g + j] : 0.f;
            bfr[ks] = mk8(pk2(v[0], v[1]), pk2(v[2], v[3]), pk2(v[4], v[5]), pk2(v[6], v[7])); }
        const float delta = hy_delta(c); float ssq = 0.f, ssqc = 0.f;
        const int comp = li >> 1;
#pragma unroll 1
        for (int rb = 0; rb < 272; rb += 64)
#pragma unroll
        for (int rk = 0; rk < 8; ++rk) { const int rt = rb + w + 8 * rk; if (rt >= 272) break; const int t0 = rt * 16;
            const bf16* ap = FH2B + (size_t)(t0 + li) * 64 + 8 * g;
            f32x4 acc = (f32x4){0.f, 0.f, 0.f, 0.f};
            acc = mfma16(*(const bf16x8*)ap, bfr[0], acc); acc = mfma16(*(const bf16x8*)(ap + 32), bfr[1], acc);
            if (li < 4) {
                if (rt < 256) {
#pragma unroll
                    for (int j = 0; j < 4; ++j) { const int t = t0 + 4 * g + j; const float val = acc[j] * __expf(-((float)t / 4095.0f) * delta);
                        if ((li & 1) == 0) { bufs[2 * fphys(t) + comp] = val; ssq += val * val; }
                        else if (t >= 1) { bufs[2 * fphys(8192 - t) + comp] = val; ssq += val * val; }
                        else bufs[2 * fphys(4096) + comp] = 0.f; }
                } else {
#pragma unroll
                    for (int j = 0; j < 4; ++j) { const int m = t0 - 4096 + 4 * g + j; const float val = acc[j] * __expf(-((float)m / 255.0f) * delta);
                        ctap[li * 256 + m] = val; if ((li & 1) == 0 || m >= 1) ssqc += val * val; }
                }
            }
        }
        const bool o0 = (li < 2), o1 = (li == 2 || li == 3);
        const float scl0 = (1.0f / 8192.0f) / sqrtf(block_sum(o0 ? ssq : 0.f, red, tid) + EPS), scl1 = (1.0f / 8192.0f) / sqrtf(block_sum(o1 ? ssq : 0.f, red, tid) + EPS);
        const float sc0 = 1.0f / sqrtf(block_sum(o0 ? ssqc : 0.f, red, tid) + EPS), sc1 = 1.0f / sqrtf(block_sum(o1 ? ssqc : 0.f, red, tid) + EPS);
        __syncthreads();
        fft_pass<false>(buf, tid, 512, (float)tid * (1.0f / 8192.0f));
        __syncthreads();
        fft_pass<false>(buf, (tid >> 5) * 512 + (tid & 31), 32, (float)(tid & 31) * (1.0f / 512.0f));
        __syncthreads();
        fft_pass<false>(buf, (tid >> 1) * 32 + (tid & 1), 2, (float)(tid & 1) * (1.0f / 32.0f));
        __syncthreads();
#pragma unroll
        for (int r = 0; r < 8; ++r) { LAS f32x4* pp = (LAS f32x4*)(buf + fphys(2 * (tid + 512 * r))); const f32x4 ab = *pp; *pp = (f32x4){ab.x + ab.z, ab.y + ab.w, ab.x - ab.z, ab.y - ab.w}; }
        __syncthreads();
        f32x2* d0 = KF + (size_t)c * 8192; f32x2* d1 = KF + (size_t)(1024 + c) * 8192;
#pragma unroll 4
        for (int i = 0; i < 16; ++i) { const int p = tid + 512 * i; const int f = (int)(__brev((unsigned)p) >> 19); const int pp = (int)(__brev((unsigned)((8192 - f) & 8191)) >> 19);
            const f32x2 z = buf[fphys(p)], zp = buf[fphys(pp)];
            d0[p] = (f32x2){(z.x + zp.x) * 0.5f * scl0, (z.y - zp.y) * 0.5f * scl0};
            d1[p] = (f32x2){(z.y + zp.y) * 0.5f * scl1, (zp.x - z.x) * 0.5f * scl1}; }
        for (int q = tid; q < 1024; q += 512) { const int od = q >> 8, m = q & 255; TAPC[((size_t)od * 1024 + c) * 256 + m] = ctap[q] * ((od < 2) ? sc0 : sc1); }
    }
}

__device__ __forceinline__ void ph_hyprep(const Args& A, int l, LAS unsigned char* lds, int tid) {
    LAS bf16* T = (LAS bf16*)lds;
    const bf16* Z = (const bf16*)(wsb() + WS_Z); bf16* HYT = (bf16*)(wsb() + WS_HYT);
    const float* cw = inp(I_HCW) + (size_t)l * 3 * 3072; const float* cb = inp(I_HCB) + (size_t)l * 3072;
    for (int u = blockIdx.x; u < 3072; u += gridDim.x) {
        const int cg = u % 12, tt = (u / 12) & 63, b = u / 768;
        __syncthreads();
        for (int q = tid; q < 66 * 32; q += 512) { const int r = q >> 5, ch8 = q & 31, t = tt * 64 - 1 + r;
            v4u v = (v4u){0u, 0u, 0u, 0u};
            if (t >= 0 && t < SEQ) v = *(const v4u*)(Z + (size_t)(b * SEQ + t) * INW + C_HY + cg * 256 + ch8 * 8);
            *(LAS v4u*)(T + r * 264 + ch8 * 8) = v; }
        __syncthreads();
        const int ch = tid & 255, half = tid >> 8, gch = cg * 256 + ch;
        const float w0 = cw[gch], w1 = cw[3072 + gch], w2 = cw[6144 + gch], bb = cb[gch];
        const int part = gch >> 10, c = gch & 1023;
        bf16* outp = HYT + ((size_t)(part * NB + b) * 1024 + c) * SEQ + tt * 64 + half * 32;
#pragma unroll
        for (int tq = 0; tq < 4; ++tq) { float vv[8];
#pragma unroll
            for (int e = 0; e < 8; ++e) { const int tl = half * 32 + tq * 8 + e;
                vv[e] = w0 * bf1(T[tl * 264 + ch]) + w1 * bf1(T[(tl + 1) * 264 + ch]) + w2 * bf1(T[(tl + 2) * 264 + ch]) + bb; }
            v4u w; w.x = pk2(vv[0], vv[1]); w.y = pk2(vv[2], vv[3]); w.z = pk2(vv[4], vv[5]); w.w = pk2(vv[6], vv[7]);
            *(v4u*)(outp + tq * 8) = w; }
    }
}
__device__ __forceinline__ void ph_hyctx(const Args& A, int l, LAS unsigned char* lds, int tid) {
    const bf16* Z = (const bf16*)(wsb() + WS_Z); bf16* YS = (bf16*)(wsb() + WS_YS); const float* TAPC = (const float*)(psb(l & 1) + PS_TAPC);
    const float* cw = inp(I_HCW) + (size_t)l * 3 * 3072; const float* cb = inp(I_HCB) + (size_t)l * 3072; const float* hb = inp(I_HBIAS) + (size_t)l * 2 * 1024;
    const int ch = tid >> 6, q = tid & 63, t0 = 4 * q;
    LAS float* Y = (LAS float*)lds + ch * 1552; LAS float* Y1 = Y + 256; LAS float* G0 = Y + 512; LAS float* G1 = Y + 1032;
    for (int u = blockIdx.x; u < 512; u += gridDim.x) {
        const int b = u >> 7, c = (u & 127) * 8 + ch;
        __syncthreads();
        float pv[3][4];
#pragma unroll
        for (int part = 0; part < 3; ++part) { const int gch = part * 1024 + c; const float w0 = cw[gch], w1 = cw[3072 + gch], w2 = cw[6144 + gch], bb = cb[gch];
            const bf16* zp = Z + (size_t)(ML + b * CL + t0) * INW + C_HY + gch;
            float zz[6];
#pragma unroll
            for (int e = 0; e < 6; ++e) { const int t = t0 - 1 + e; zz[e] = (t >= 0 && t < CL) ? bf1(zp[(ptrdiff_t)(e - 1) * INW]) : 0.f; }
#pragma unroll
            for (int r = 0; r < 4; ++r) pv[part][r] = w0 * zz[r] + w1 * zz[r + 1] + w2 * zz[r + 2] + bb; }
        *(LAS f32x4*)(Y + t0) = (f32x4){pv[2][0], pv[2][1], pv[2][2], pv[2][3]};
#pragma unroll
        for (int r = 0; r < 4; ++r) { const int m = t0 + r;
            G0[m + 259] = TAPC[((size_t)(0 * 2 + 0) * 1024 + c) * 256 + m]; G1[m + 259] = TAPC[((size_t)(1 * 2 + 0) * 1024 + c) * 256 + m];
            if (m >= 1) { G0[259 - m] = TAPC[((size_t)(0 * 2 + 1) * 1024 + c) * 256 + m]; G1[259 - m] = TAPC[((size_t)(1 * 2 + 1) * 1024 + c) * 256 + m]; } }
        if (q == 0) { G0[515] = 0.f; G1[515] = 0.f; G0[516] = 0.f; G1[516] = 0.f; }
        __syncthreads();
        float yprev[4] = {pv[2][0], pv[2][1], pv[2][2], pv[2][3]};
#pragma unroll
        for (int ord = 0; ord < 2; ++ord) {
            const LAS float* Ys = ord ? Y1 : Y; const LAS float* G = ord ? G1 : G0;
            float acc[4] = {0.f, 0.f, 0.f, 0.f};
#pragma unroll 4
            for (int sp = 0; sp < 64; ++sp) { const f32x4 yv = *(const LAS f32x4*)(Ys + 4 * sp); const LAS float* gp = G + 4 * (q - sp) + 256;
                const f32x4 ga = *(const LAS f32x4*)gp, gb = *(const LAS f32x4*)(gp + 4);
                const float g[8] = {ga.x, ga.y, ga.z, ga.w, gb.x, gb.y, gb.z, gb.w}; const float yy[4] = {yv.x, yv.y, yv.z, yv.w};
#pragma unroll
                for (int r = 0; r < 4; ++r)
#pragma unroll
                    for (int j = 0; j < 4; ++j) acc[r] += yy[j] * g[r - j + 3]; }
            const float bias = hb[ord * 1024 + c];
#pragma unroll
            for (int r = 0; r < 4; ++r) yprev[r] = pv[ord][r] * (acc[r] + bias * yprev[r]);
            if (ord == 0) { *(LAS f32x4*)(Y1 + t0) = (f32x4){yprev[0], yprev[1], yprev[2], yprev[3]}; __syncthreads(); }
        }
#pragma unroll
        for (int r = 0; r < 4; ++r) YS[(size_t)(ML + b * CL + t0 + r) * 1024 + c] = (bf16)f2bf(yprev[r]);
    }
}
__device__ __forceinline__ void unpack8(v4u v, float (&x)[8]) { x[0] = bflo(v.x); x[1] = bfhi(v.x); x[2] = bflo(v.y); x[3] = bfhi(v.y); x[4] = bflo(v.z); x[5] = bfhi(v.z); x[6] = bflo(v.w); x[7] = bfhi(v.w); }
__device__ __forceinline__ v4u pack8(const float (&x)[8]) { v4u w; w.x = pk2(x[0], x[1]); w.y = pk2(x[2], x[3]); w.z = pk2(x[4], x[5]); w.w = pk2(x[6], x[7]); return w; }
__device__ __forceinline__ void rope8(float (&lo)[8], float (&hi)[8], const f32x2* rt) {
#pragma unroll
    for (int e = 0; e < 8; ++e) { const f32x2 cs = rt[e]; const float a = lo[e], b = hi[e]; lo[e] = a * cs.x - b * cs.y; hi[e] = b * cs.x + a * cs.y; }
}
__device__ __forceinline__ void vt_store(LAS bf16* Vt, int ld, int d0, int r, v4u vv) {
    Vt[(d0 + 0) * ld + r] = (bf16)(vv.x & 0xffffu); Vt[(d0 + 1) * ld + r] = (bf16)(vv.x >> 16);
    Vt[(d0 + 2) * ld + r] = (bf16)(vv.y & 0xffffu); Vt[(d0 + 3) * ld + r] = (bf16)(vv.y >> 16);
    Vt[(d0 + 4) * ld + r] = (bf16)(vv.z & 0xffffu); Vt[(d0 + 5) * ld + r] = (bf16)(vv.z >> 16);
    Vt[(d0 + 6) * ld + r] = (bf16)(vv.w & 0xffffu); Vt[(d0 + 7) * ld + r] = (bf16)(vv.w >> 16);
}
constexpr float LOG2E = 1.4426950408889634f;
typedef short s16x4 __attribute__((ext_vector_type(4)));
__device__ __forceinline__ bf16x8 tr_frag(const LAS bf16* tile, int ld, int r0, int r1, int c0, int li) {
    const s16x4 lo = __builtin_amdgcn_ds_read_tr16_b64_v4i16((LAS s16x4*)(tile + (r0 + (li >> 2)) * ld + c0 + 4 * (li & 3)));
    const s16x4 hi = __builtin_amdgcn_ds_read_tr16_b64_v4i16((LAS s16x4*)(tile + (r1 + (li >> 2)) * ld + c0 + 4 * (li & 3)));
    return (bf16x8){lo.x, lo.y, lo.z, lo.w, hi.x, hi.y, hi.z, hi.w};
}
__device__ __forceinline__ void ph_ret1(const Args& A, int l, int nctx_units, LAS unsigned char* lds, int tid) {
    LAS bf16* Kf = (LAS bf16*)lds; LAS bf16* Kb = Kf + 128 * 72; LAS bf16* Vs = Kb + 128 * 72;
    const bf16* Z = (const bf16*)(wsb() + WS_Z); float* KV = (float*)(wsb() + WS_KV); const f32x2* rope = (const f32x2*)(wsb() + WS_ROPE);
    const int lane = tid & 63, w = tid >> 6, g = lane >> 4, li = lane & 15;
    for (int uid = blockIdx.x; uid < 1024 + nctx_units; uid += gridDim.x) {
        const bool isc = uid >= 1024; int b, h, n, ci; size_t m0;
        if (!isc) { b = uid >> 8; h = (uid >> 5) & 7; n = uid & 31; m0 = (size_t)b * SEQ + n * 128; ci = 2 + n; }
        else { const int i = uid - 1024; b = i >> 4; h = (i >> 1) & 7; n = i & 1; m0 = (size_t)ML + b * CL + n * 128; ci = n; }
        const float lgf = inp(I_RDEC)[(l * 2 + 0) * 8 + h] * LOG2E, lgb = inp(I_RDEC)[(l * 2 + 1) * 8 + h] * LOG2E;
        __syncthreads();
        { const int tok = tid >> 2, pp = tid & 3, a = (pp & 1) + ((pp >> 1) << 2);
            const bf16* kr = Z + (m0 + tok) * INW + C_RK + h * 64;
            float lo[8], hi[8]; unpack8(*(const v4u*)(kr + 8 * a), lo); unpack8(*(const v4u*)(kr + 8 * a + 16), hi);
            if (!isc) { const int t = n * 128 + tok; const int pos = (a < 4) ? (t >> 6) : (t & 63); rope8(lo, hi, rope + pos * 16 + 8 * (a & 1)); }
            const float zf = ex2(lgf * (float)(127 - tok)) * 0.125f, zb = ex2(lgb * (float)tok) * 0.125f;
            float lf[8], hf[8];
#pragma unroll
            for (int e = 0; e < 8; ++e) { lf[e] = lo[e] * zf; hf[e] = hi[e] * zf; lo[e] *= zb; hi[e] *= zb; }
            *(LAS v4u*)(Kf + tok * 72 + 8 * a) = pack8(lf); *(LAS v4u*)(Kf + tok * 72 + 8 * a + 16) = pack8(hf);
            *(LAS v4u*)(Kb + tok * 72 + 8 * a) = pack8(lo); *(LAS v4u*)(Kb + tok * 72 + 8 * a + 16) = pack8(hi); }
        for (int q = tid; q < 2048; q += 512) { const int r = q >> 4, ch = q & 15; *(LAS v4u*)(Vs + r * 144 + ch * 8) = *(const v4u*)(Z + (m0 + r) * INW + C_RV + h * 128 + ch * 8); }
        __syncthreads();
        bf16x8 af[4];
#pragma unroll
        for (int ks = 0; ks < 4; ++ks) af[ks] = tr_frag(Vs, 144, 32 * ks + 8 * g, 32 * ks + 8 * g + 4, 16 * w, li);
#pragma unroll
        for (int dir = 0; dir < 2; ++dir) { const LAS bf16* KT = dir ? Kb : Kf;
            float* dst = KV + ((size_t)((b * 8 + h) * 2 + dir) * 34 + ci) * 8192;
#pragma unroll
            for (int nc = 0; nc < 4; ++nc) { f32x4 acc = (f32x4){0.f, 0.f, 0.f, 0.f};
#pragma unroll
                for (int ks = 0; ks < 4; ++ks) acc = mfma16(af[ks], tr_frag(KT, 72, 32 * ks + 8 * g, 32 * ks + 8 * g + 4, 16 * nc, li), acc);
#pragma unroll
                for (int j = 0; j < 4; ++j) dst[(16 * w + 4 * g + j) * 64 + 16 * nc + li] = acc[j]; } }
    }
}
__device__ __forceinline__ void ph_natt(const Args& A, int l, int nctx_units, LAS unsigned char* lds, int tid) {
    LAS bf16* Qs = (LAS bf16*)lds; LAS bf16* KV0 = Qs + 128 * 136; LAS float* rpbs = (LAS float*)(KV0 + 2 * (64 * 136 + 64 * 144));
    const bf16* Z = (const bf16*)(wsb() + WS_Z); bf16* YS = (bf16*)(wsb() + WS_YS) + (size_t)2 * MT * 1024;
    const int lane = tid & 63, w = tid >> 6, g = lane >> 4, li = lane & 15;
    const float SCALE = 0.08838834764831845f;
    const int sr0 = tid >> 4, sch = tid & 15;
    for (int uid = blockIdx.x; uid < 1024 + nctx_units; uid += gridDim.x) {
        const bool isc = uid >= 1024; int b, h, rp = 0; size_t m0;
        if (!isc) { b = uid >> 8; h = (uid >> 5) & 7; rp = uid & 31; m0 = (size_t)b * SEQ + rp * 128; }
        else { const int i = uid - 1024; b = i >> 4; h = (i >> 1) & 7; m0 = (size_t)ML + b * CL + (i & 1) * 128; }
        const size_t mc0 = (size_t)ML + b * CL;
        const int qr = 2 * rp + (w >> 2), cw = w & 3, qc = 16 * cw + li;
        const int cs = min(max(qc - 8, 0), 48), rs_w = min(max(qr - 4, 0), 56);
        const int kr_lo = min(max(2 * rp - 4, 0), 56), kr_hi = min(max(2 * rp - 3, 0), 56) + 7;
        const int nwin = isc ? 0 : (kr_hi - kr_lo + 1), ntile = nwin + 4;
        const int nlo_w = (cw <= 1) ? 0 : cw - 1, nhi_w = (cw == 0) ? 1 : ((cw == 3) ? 3 : cw + 1);
        v4u kreg[2], vreg[2];
#define NA_LOAD(t_) do { const int t__ = (t_); const size_t mk = (t__ < nwin) ? ((size_t)b * SEQ + (kr_lo + t__) * 64) : (mc0 + (t__ - nwin) * 64); \
            _Pragma("unroll") for (int e = 0; e < 2; ++e) { const bf16* zr = Z + (mk + sr0 + 32 * e) * INW + h * 128 + sch * 8; kreg[e] = *(const v4u*)(zr + C_NK); vreg[e] = *(const v4u*)(zr + C_NV); } } while (0)
#define NA_STORE(buf_) do { LAS bf16* Kd = KV0 + (buf_) * (64 * 136 + 64 * 144); LAS bf16* Vd = Kd + 64 * 136; \
            _Pragma("unroll") for (int e = 0; e < 2; ++e) { *(LAS v4u*)(Kd + (sr0 + 32 * e) * 136 + sch * 8) = kreg[e]; *(LAS v4u*)(Vd + (sr0 + 32 * e) * 144 + sch * 8) = vreg[e]; } } while (0)
        __syncthreads();
        NA_LOAD(0);
        for (int q = tid; q < 2048; q += 512) { const int r = q >> 4, chn = q & 15; *(LAS v4u*)(Qs + r * 136 + chn * 8) = *(const v4u*)(Z + (m0 + r) * INW + C_NQ + h * 128 + chn * 8); }
        if (!isc) for (int i = tid; i < 465; i += 512) rpbs[i] = inp(I_RPB)[((size_t)l * 8 + h) * 465 + i];
        NA_STORE(0);
        __syncthreads();
        bf16x8 qf[4];
#pragma unroll
        for (int ks = 0; ks < 4; ++ks) qf[ks] = *(const LAS bf16x8*)(Qs + (16 * w + li) * 136 + 32 * ks + 8 * g);
        f32x4 o[8];
#pragma unroll
        for (int nd = 0; nd < 8; ++nd) o[nd] = (f32x4){0.f, 0.f, 0.f, 0.f};
        float mrun = -1e30f, lrun = 0.f;
        for (int t = 0; t < ntile; ++t) {
            const bool win = t < nwin; const int kr = kr_lo + t;
            if (t + 1 < ntile) NA_LOAD(t + 1);
            const LAS bf16* Ks = KV0 + (t & 1) * (64 * 136 + 64 * 144); const LAS bf16* Vs = Ks + 64 * 136;
            const bool active = !win || (kr >= rs_w && kr <= rs_w + 7);
            if (active) {
                const int nlo = win ? nlo_w : 0, nhi = win ? nhi_w : 3;
                f32x4 s[4];
#pragma unroll
                for (int n = 0; n < 4; ++n) { s[n] = (f32x4){0.f, 0.f, 0.f, 0.f};
                    if (n >= nlo && n <= nhi) {
#pragma unroll
                        for (int ks = 0; ks < 4; ++ks) s[n] = mfma16(*(const LAS bf16x8*)(Ks + (16 * n + li) * 136 + 32 * ks + 8 * g), qf[ks], s[n]); } }
                float tmax = -1e30f;
#pragma unroll
                for (int n = 0; n < 4; ++n)
#pragma unroll
                    for (int j = 0; j < 4; ++j) { float v = s[n][j] * SCALE;
                        if (win) { const int kc = 16 * n + 4 * g + j; const bool valid = (kc >= cs) && (kc < cs + 16);
                            const int dc = min(max(kc - qc + 15, 0), 30), dr = min(max(kr - qr + 7, 0), 14);
                            v = valid ? v + rpbs[dr * 31 + dc] : -1e30f; }
                        s[n][j] = v; tmax = fmaxf(tmax, v); }
                tmax = fmaxf(tmax, __shfl_xor(tmax, 16)); tmax = fmaxf(tmax, __shfl_xor(tmax, 32));
                const float mnew = fmaxf(mrun, tmax), alpha = __expf(mrun - mnew);
                float psum = 0.f;
#pragma unroll
                for (int n = 0; n < 4; ++n)
#pragma unroll
                    for (int j = 0; j < 4; ++j) { const float pv = __expf(s[n][j] - mnew); s[n][j] = pv; psum += pv; }
                psum += __shfl_xor(psum, 16); psum += __shfl_xor(psum, 32);
                lrun = lrun * alpha + psum; mrun = mnew;
#pragma unroll
                for (int nd = 0; nd < 8; ++nd) o[nd] = o[nd] * alpha;
#pragma unroll
                for (int kk = 0; kk < 2; ++kk) {
                    if (2 * kk + 1 >= nlo && 2 * kk <= nhi) {
                        const bf16x8 pf = mk8(pk2(s[2 * kk][0], s[2 * kk][1]), pk2(s[2 * kk][2], s[2 * kk][3]), pk2(s[2 * kk + 1][0], s[2 * kk + 1][1]), pk2(s[2 * kk + 1][2], s[2 * kk + 1][3]));
#pragma unroll
                        for (int nd = 0; nd < 8; ++nd) o[nd] = mfma16(tr_frag(Vs, 144, 32 * kk + 4 * g, 32 * kk + 16 + 4 * g, 16 * nd, li), pf, o[nd]); } }
            }
            if (t + 1 < ntile) NA_STORE((t + 1) & 1);
            __syncthreads();
        }
#undef NA_LOAD
#undef NA_STORE
        const float inv = 1.0f / lrun; const size_t mrow = m0 + 16 * w + li;
#pragma unroll
        for (int nd = 0; nd < 8; ++nd) { v2u wv; wv.x = pk2(o[nd][0] * inv, o[nd][1] * inv); wv.y = pk2(o[nd][2] * inv, o[nd][3] * inv);
            *(v2u*)(YS + mrow * 1024 + h * 128 + 16 * nd + 4 * g) = wv; }
    }
}

__device__ __forceinline__ void ph_hyfft(const Args& A, int l, LAS unsigned char* lds, int tid) {
    LAS f32x2* buf = (LAS f32x2*)lds;
    const bf16* HYT = (const bf16*)(wsb() + WS_HYT); bf16* YT = (bf16*)(wsb() + WS_YT); const f32x2* KF = (const f32x2*)(psb(l & 1) + PS_KF);
    const float* hb = inp(I_HBIAS) + (size_t)l * 2 * 1024;
    const int baseB = (tid >> 5) * 512 + (tid & 31), baseC = (tid >> 1) * 32 + (tid & 1);
    const float thA = (float)tid * (1.0f / 8192.0f), thB = (float)(tid & 31) * (1.0f / 512.0f), thC = (float)(tid & 1) * (1.0f / 32.0f);
    for (int u = blockIdx.x; u < 2048; u += gridDim.x) {
        const int c = u >> 1, b0 = (u & 1) * 2;
        const bf16* x1p = HYT + ((size_t)(0 * NB + b0) * 1024 + c) * SEQ; const bf16* x2p = HYT + ((size_t)(1 * NB + b0) * 1024 + c) * SEQ; const bf16* vp = HYT + ((size_t)(2 * NB + b0) * 1024 + c) * SEQ;
        const size_t bstr = (size_t)1024 * SEQ;
        float y0[8], y1[8];
#pragma unroll
        for (int i = 0; i < 8; ++i) { const int t = tid + 512 * i; y0[i] = bf1(vp[t]); y1[i] = bf1(vp[bstr + t]); }
#pragma unroll
        for (int ord = 0; ord < 2; ++ord) {
            { f32x2 x[16];
#pragma unroll
                for (int k = 0; k < 8; ++k) { x[k] = (f32x2){y0[k], y1[k]}; x[k + 8] = (f32x2){0.f, 0.f}; }
                dif16<true>(x, thA);
                __syncthreads();
#pragma unroll
                for (int k = 0; k < 16; ++k) buf[fphys(tid + 512 * k)] = x[k]; }
            __syncthreads();
            fft_pass<false>(buf, baseB, 32, thB);
            __syncthreads();
            fft_pass<false>(buf, baseC, 2, thC);
            __syncthreads();
            { const f32x4* kf = (const f32x4*)(KF + (size_t)(ord * 1024 + c) * 8192);
#pragma unroll
                for (int r = 0; r < 8; ++r) { const int i = tid + 512 * r; LAS f32x4* pp = (LAS f32x4*)(buf + fphys(2 * i)); const f32x4 ab = *pp; const f32x4 kk = kf[i];
                    const float ax = ab.x + ab.z, ay = ab.y + ab.w, bx = ab.x - ab.z, by = ab.y - ab.w;
                    const float px = ax * kk.x - ay * kk.y, py = ax * kk.y + ay * kk.x, qx = bx * kk.z - by * kk.w, qy = bx * kk.w + by * kk.z;
                    *pp = (f32x4){px + qx, py + qy, px - qx, py - qy}; } }
            __syncthreads();
            fft_pass<true>(buf, baseC, 2, thC);
            __syncthreads();
            fft_pass<true>(buf, baseB, 32, thB);
            __syncthreads();
            { f32x2 x[16];
#pragma unroll
                for (int k = 0; k < 16; ++k) x[k] = buf[fphys(tid + 512 * k)];
                idit16(x, thA);
                const bf16* xp = ord ? x2p : x1p; const float bias = hb[ord * 1024 + c];
#pragma unroll
                for (int k = 0; k < 8; ++k) { const int t = tid + 512 * k;
                    y0[k] = bf1(xp[t]) * (x[k].x + bias * y0[k]); y1[k] = bf1(xp[bstr + t]) * (x[k].y + bias * y1[k]); } }
        }
        bf16* o0 = YT + ((size_t)b0 * 1024 + c) * SEQ;
#pragma unroll
        for (int i = 0; i < 8; ++i) { const int t = tid + 512 * i; o0[t] = (bf16)f2bf(y0[i]); o0[bstr + t] = (bf16)f2bf(y1[i]); }
    }
}
__device__ __forceinline__ void ph_scan(const Args& A, int l, int tid) {
    float* KV = (float*)(wsb() + WS_KV);
    for (int gt = blockIdx.x * 512 + tid; gt < NB * 8 * 2 * 2048; gt += gridDim.x * 512) {
        const int bhd = gt >> 11, e4 = gt & 2047, dir = bhd & 1, h = (bhd >> 1) & 7;
        const float gC = ex2(inp(I_RDEC)[(l * 2 + dir) * 8 + h] * LOG2E * 128.0f);
        f32x4* base = (f32x4*)(KV + (size_t)bhd * 34 * 8192) + e4;
        f32x4 s = (f32x4){0.f, 0.f, 0.f, 0.f};
#pragma unroll 2
        for (int step = 0; step < 34; ++step) { const int ci = (dir == 0) ? step : (step == 0 ? 1 : (step == 1 ? 0 : 35 - step));
            const f32x4 tmp = base[(size_t)ci * 2048]; base[(size_t)ci * 2048] = s; s = s * gC + tmp; }
    }
}

__device__ __forceinline__ void ph_hypost(const Args& A, LAS unsigned char* lds, int tid) {
    LAS bf16* T = (LAS bf16*)lds;
    const bf16* YT = (const bf16*)(wsb() + WS_YT); bf16* YS = (bf16*)(wsb() + WS_YS);
    for (int u = blockIdx.x; u < 1024; u += gridDim.x) {
        const int cg = u & 3, tt = (u >> 2) & 63, b = u >> 8;
        __syncthreads();
        for (int q = tid; q < 2048; q += 512) { const int c = q >> 3, t8 = q & 7;
            *(LAS v4u*)(T + c * 72 + t8 * 8) = *(const v4u*)(YT + ((size_t)b * 1024 + cg * 256 + c) * SEQ + tt * 64 + t8 * 8); }
        __syncthreads();
        const int t = tid >> 3, c32 = tid & 7;
#pragma unroll
        for (int q = 0; q < 4; ++q) { const int cb = c32 * 32 + q * 8; v4u w;
            w.x = (unsigned)T[(cb + 0) * 72 + t] | ((unsigned)T[(cb + 1) * 72 + t] << 16); w.y = (unsigned)T[(cb + 2) * 72 + t] | ((unsigned)T[(cb + 3) * 72 + t] << 16);
            w.z = (unsigned)T[(cb + 4) * 72 + t] | ((unsigned)T[(cb + 5) * 72 + t] << 16); w.w = (unsigned)T[(cb + 6) * 72 + t] | ((unsigned)T[(cb + 7) * 72 + t] << 16);
            *(v4u*)(YS + (size_t)(b * SEQ + tt * 64 + t) * 1024 + cg * 256 + cb) = w; }
    }
}
__device__ __forceinline__ void ph_ret3(const Args& A, int l, int nctx_units, LAS unsigned char* lds, int tid) {
    LAS bf16* Qs = (LAS bf16*)lds; LAS bf16* Ks = Qs + 128 * 72; LAS bf16* Vs = Ks + 128 * 72; LAS bf16* Sf = Vs + 128 * 144; LAS bf16* Sb = Sf + 128 * 72;
    const bf16* Z = (const bf16*)(wsb() + WS_Z); const float* KV = (const float*)(wsb() + WS_KV); const f32x2* rope = (const f32x2*)(wsb() + WS_ROPE);
    bf16* YS = (bf16*)(wsb() + WS_YS) + (size_t)MT * 1024;
    const int lane = tid & 63, w = tid >> 6, g = lane >> 4, li = lane & 15;
    for (int uid = blockIdx.x; uid < 1024 + nctx_units; uid += gridDim.x) {
        const bool isc = uid >= 1024; int b, h, n, ci; size_t m0;
        if (!isc) { b = uid >> 8; h = (uid >> 5) & 7; n = uid & 31; m0 = (size_t)b * SEQ + n * 128; ci = 2 + n; }
        else { const int i = uid - 1024; b = i >> 4; h = (i >> 1) & 7; n = i & 1; m0 = (size_t)ML + b * CL + n * 128; ci = n; }
        const float lgf = inp(I_RDEC)[(l * 2 + 0) * 8 + h] * LOG2E, lgb = inp(I_RDEC)[(l * 2 + 1) * 8 + h] * LOG2E;
        __syncthreads();
        { const int tok = tid >> 2, pp = tid & 3, a = (pp & 1) + ((pp >> 1) << 2);
            const int t = n * 128 + tok; const int pos = (a < 4) ? (t >> 6) : (t & 63); const f32x2* rt = rope + pos * 16 + 8 * (a & 1);
            const bf16* qr = Z + (m0 + tok) * INW + C_RQ + h * 64; const bf16* kr = Z + (m0 + tok) * INW + C_RK + h * 64;
            float lo[8], hi[8];
            unpack8(*(const v4u*)(qr + 8 * a), lo); unpack8(*(const v4u*)(qr + 8 * a + 16), hi);
            if (!isc) rope8(lo, hi, rt);
            *(LAS v4u*)(Qs + tok * 72 + 8 * a) = pack8(lo); *(LAS v4u*)(Qs + tok * 72 + 8 * a + 16) = pack8(hi);
            unpack8(*(const v4u*)(kr + 8 * a), lo); unpack8(*(const v4u*)(kr + 8 * a + 16), hi);
            if (!isc) rope8(lo, hi, rt);
#pragma unroll
            for (int e = 0; e < 8; ++e) { lo[e] *= 0.125f; hi[e] *= 0.125f; }
            *(LAS v4u*)(Ks + tok * 72 + 8 * a) = pack8(lo); *(LAS v4u*)(Ks + tok * 72 + 8 * a + 16) = pack8(hi); }
        for (int q = tid; q < 2048; q += 512) { const int r = q >> 4, ch = q & 15; *(LAS v4u*)(Vs + r * 144 + ch * 8) = *(const v4u*)(Z + (m0 + r) * INW + C_RV + h * 128 + ch * 8); }
#pragma unroll
        for (int dir = 0; dir < 2; ++dir) { const f32x4* src = (const f32x4*)(KV + ((size_t)((b * 8 + h) * 2 + dir) * 34 + ci) * 8192); LAS bf16* S = dir ? Sb : Sf;
            for (int q = tid; q < 2048; q += 512) { const f32x4 v = src[q]; v2u wv; wv.x = pk2(v.x, v.y); wv.y = pk2(v.z, v.w); *(LAS v2u*)(S + (q >> 4) * 72 + (q & 15) * 4) = wv; } }
        __syncthreads();
        const int iq = 16 * w + li;
        bf16x8 qf[2];
#pragma unroll
        for (int ks = 0; ks < 2; ++ks) qf[ks] = *(const LAS bf16x8*)(Qs + iq * 72 + 32 * ks + 8 * g);
        f32x4 s[8];
#pragma unroll
        for (int nn = 0; nn < 8; ++nn) { s[nn] = (f32x4){0.f, 0.f, 0.f, 0.f};
#pragma unroll
            for (int ks = 0; ks < 2; ++ks) s[nn] = mfma16(*(const LAS bf16x8*)(Ks + (16 * nn + li) * 72 + 32 * ks + 8 * g), qf[ks], s[nn]);
#pragma unroll
            for (int j = 0; j < 4; ++j) { const int d = iq - (16 * nn + 4 * g + j); s[nn][j] *= (d >= 0) ? ex2(lgf * (float)d) : ex2(lgb * (float)(-d)); } }
        f32x4 o[8];
#pragma unroll
        for (int nd = 0; nd < 8; ++nd) o[nd] = (f32x4){0.f, 0.f, 0.f, 0.f};
#pragma unroll
        for (int kk = 0; kk < 4; ++kk) {
            const bf16x8 pf = mk8(pk2(s[2 * kk][0], s[2 * kk][1]), pk2(s[2 * kk][2], s[2 * kk][3]), pk2(s[2 * kk + 1][0], s[2 * kk + 1][1]), pk2(s[2 * kk + 1][2], s[2 * kk + 1][3]));
#pragma unroll
            for (int nd = 0; nd < 8; ++nd) o[nd] = mfma16(tr_frag(Vs, 144, 32 * kk + 4 * g, 32 * kk + 16 + 4 * g, 16 * nd, li), pf, o[nd]); }
        const float xif = ex2(lgf * (float)(iq + 1)), xib = ex2(lgb * (float)(128 - iq));
        float ss = 0.f;
#pragma unroll
        for (int nd = 0; nd < 8; ++nd) { f32x4 tf = (f32x4){0.f, 0.f, 0.f, 0.f}, tb = (f32x4){0.f, 0.f, 0.f, 0.f};
#pragma unroll
            for (int ks = 0; ks < 2; ++ks) { tf = mfma16(*(const LAS bf16x8*)(Sf + (16 * nd + li) * 72 + 32 * ks + 8 * g), qf[ks], tf);
                tb = mfma16(*(const LAS bf16x8*)(Sb + (16 * nd + li) * 72 + 32 * ks + 8 * g), qf[ks], tb); }
            o[nd] = o[nd] + tf * xif + tb * xib;
            ss += (o[nd][0] * o[nd][0] + o[nd][1] * o[nd][1]) + (o[nd][2] * o[nd][2] + o[nd][3] * o[nd][3]); }
        ss += __shfl_xor(ss, 16); ss += __shfl_xor(ss, 32);
        const float rn = 1.0f / sqrtf(ss * (1.0f / 128.0f) + EPS);
        const size_t mrow = m0 + iq;
#pragma unroll
        for (int nd = 0; nd < 8; ++nd) { const int dv = 16 * nd + 4 * g; const v2u gv = *(const v2u*)(Z + mrow * INW + C_RG + h * 128 + dv);
            const float g0 = bflo(gv.x), g1 = bfhi(gv.x), g2 = bflo(gv.y), g3 = bfhi(gv.y);
            v2u wv; wv.x = pk2(g0 / (1.0f + __expf(-g0)) * o[nd][0] * rn, g1 / (1.0f + __expf(-g1)) * o[nd][1] * rn);
            wv.y = pk2(g2 / (1.0f + __expf(-g2)) * o[nd][2] * rn, g3 / (1.0f + __expf(-g3)) * o[nd][3] * rn);
            *(v2u*)(YS + mrow * 1024 + h * 128 + dv) = wv; }
    }
}

__device__ __forceinline__ float gelu_fx(float x) { const float x2 = x * x; const float arg = x * (x2 * (-2.0f * 1.4426950408889634f * 0.7978845608028654f * 0.044715f) + (-2.0f * 1.4426950408889634f * 0.7978845608028654f));
    return x * __builtin_amdgcn_rcpf(1.0f + __builtin_amdgcn_exp2f(arg)); }
__device__ __forceinline__ void ph_ffnfix(const Args& A, int l, int Mrows, int tid) {
    const bf16* SA = (const bf16*)(wsb() + WS_SA); const bf16* SB = (const bf16*)(wsb() + WS_SB); bf16* U = (bf16*)(wsb() + WS_U);
    const float* cw = inp(I_FFCW) + (size_t)l * 3 * DFF; const float* cb = inp(I_FFCB) + (size_t)l * DFF;
    const int nblk = Mrows / 64;
    for (int u = blockIdx.x; u < nblk * 2; u += gridDim.x) {
        const int blk = u >> 1, hi = u & 1, R = blk * 64 + (hi ? 63 : 0);
        const bool seq_first = (R < ML) ? ((R & (SEQ - 1)) == 0) : ((R & (CL - 1)) == 0), seq_last = (R < ML) ? ((R & (SEQ - 1)) == SEQ - 1) : ((R & (CL - 1)) == CL - 1);
        const bf16* pprev = hi ? SA + ((size_t)blk * 4 + 2) * DFF : SA + ((size_t)(blk - 1) * 4 + 3) * DFF;
        const bf16* pcur = SA + ((size_t)blk * 4 + (hi ? 3 : 0)) * DFF;
        const bf16* pnext = hi ? SA + ((size_t)(blk + 1) * 4 + 0) * DFF : SA + ((size_t)blk * 4 + 1) * DFF;
        const bf16* pb = SB + ((size_t)blk * 2 + hi) * DFF;
        const bool zp = (!hi && seq_first), zn = (hi && seq_last);
        for (int q = tid; q < DFF / 8; q += 512) { const int f = q * 8;
            float am[8], a0[8], aq[8], bg[8]; const v4u z4 = (v4u){0u, 0u, 0u, 0u};
            unpack8(zp ? z4 : *(const v4u*)(pprev + f), am); unpack8(*(const v4u*)(pcur + f), a0); unpack8(zn ? z4 : *(const v4u*)(pnext + f), aq); unpack8(*(const v4u*)(pb + f), bg);
            float r[8];
#pragma unroll
            for (int e = 0; e < 8; ++e) r[e] = gelu_fx(cw[f + e] * am[e] + cw[DFF + f + e] * a0[e] + cw[2 * DFF + f + e] * aq[e] + cb[f + e]) * bg[e];
            *(v4u*)(U + (size_t)R * DFF + f) = pack8(r); }
    }
}
__device__ __forceinline__ void ph_final(const Args& A, int wave, int lane) {
    const int gw = blockIdx.x * NWAVES + wave, NGW = gridDim.x * NWAVES; const float* g = inp(I_GF);
    for (int m = gw; m < ML; m += NGW) { float* xr = outb() + (size_t)m * D; f32x4 v[8]; float ss = 0.f;
#pragma unroll
        for (int j = 0; j < 8; ++j) { v[j] = *(const f32x4*)(xr + (lane + 64 * j) * 4); ss += (v[j].x * v[j].x + v[j].y * v[j].y) + (v[j].z * v[j].z + v[j].w * v[j].w); }
        const float rstd = 1.0f / sqrtf(wave_sum(ss) * (1.0f / D) + EPS);
#pragma unroll
        for (int j = 0; j < 8; ++j) { const int idx = (lane + 64 * j) * 4; *(f32x4*)(xr + idx) = v[j] * rstd * *(const f32x4*)(g + idx); }
    }
}
constexpr int BG_SPLIT = 22016;
constexpr int SEQ_PER_LAYER = 11, NSEQ = 1 + DEPTH * SEQ_PER_LAYER + 1;
__global__ void __launch_bounds__(NWAVES * 64, 2) fwd(Args A) {
    extern __shared__ __attribute__((aligned(16))) unsigned char lds_raw[];
    LAS unsigned char* lds = (LAS unsigned char*)lds_raw;
    volatile LAS unsigned* MISC = (volatile LAS unsigned*)(lds + MISC_OFF);
    for (int u = threadIdx.x; u < (LDS_BYTES - LDSCTL_OFF) / 4; u += NWAVES * 64) ((LAS unsigned*)(lds + LDSCTL_OFF))[u] = 0u;
    __syncthreads();
    (void)xcd_barrier_post((unsigned*)(wsb() + WS_CTL) + CW_BAR, MISC + 8);
    const int lo = A.seq_lo, hi = A.seq_hi;
#define G ((int)gridDim.x)
#define RUN(s) (lo <= (s) && (s) < hi)
#ifndef DUP
#define DUP 0
#endif
#define DUPN(id) ((((DUP) >> (id)) & 1) ? 2 : 1)
#define TID_HERE const int tid = otid(), lane = tid & 63, wave = __builtin_amdgcn_readfirstlane(tid >> 6); (void)lane; (void)wave
#ifdef ONLY
#define PH_ON(k) ((k) == ONLY)
#elif defined(SKIP)
#define PH_ON(k) ((k) != SKIP)
#else
#define PH_ON(k) true
#endif
#define SEAM(s) do { if (RUN((s) + 1)) { XcdBarrier bar_; bar_.bar = (unsigned*)(wsb() + WS_CTL) + CW_BAR; bar_.x = xb_xcc_id(); bar_.st = (volatile LAS unsigned*)(lds + MISC_OFF) + 8; xcd_barrier(bar_); } } while (0)
#define H ((bf16*)(wsb() + WS_H))
#define Z ((bf16*)(wsb() + WS_Z))
#define ACC ((bf16*)(wsb() + WS_ACC))
#define U ((bf16*)(wsb() + WS_U))
#define YS ((bf16*)(wsb() + WS_YS))
#define XC ((float*)(wsb() + WS_XC))
#define WIN ((const bf16*)(psb(l & 1) + PS_WIN))
#define WBR ((const bf16*)(psb(l & 1) + PS_WBR))
#define WOUT ((const bf16*)(psb(l & 1) + PS_WOUT))
#define WF1 ((const bf16*)(psb(l & 1) + PS_WF1))
#define WF2 ((const bf16*)(psb(l & 1) + PS_WF2))

    if (PH_ON(100) && RUN(0)) { TID_HERE; ph_prologue(A, lds, tid); __syncthreads(); ph_convert(A, 0, 0, 0, CONV_ITEMS, (int)blockIdx.x, G, lds, wave, lane); __syncthreads(); for (int fl = 0; fl < DEPTH; ++fl) ph_filt1(A, fl, 0, (int)blockIdx.x, G, lds, tid); SEAM(0); }

    for (int l = 0; l < DEPTH; ++l) {
        const int sb = 1 + l * SEQ_PER_LAYER;
        if (hi <= sb || lo >= sb + SEQ_PER_LAYER) continue;
        const bool lastl = (l == DEPTH - 1);
        const int Mrows = lastl ? ML : MT, nctx = lastl ? 0 : 64;
#define modl ((const float*)(wsb() + WS_MOD) + (size_t)l * 5 * 12288)
#define xlat_in ((l == 0) ? inp(I_X) : (const float*)outb())
#define xctx_in ((l == 0) ? inp(I_CTX) : (const float*)XC)

        if (PH_ON(0) && RUN(sb + 0)) { TID_HERE;
            if (l == 0) ph_filt2(A, 0, 0, (int)blockIdx.x, G, lds, tid);
            else ph_convert(A, l, l & 1, 0, CONV_ITEMS, (int)blockIdx.x, G, lds, wave, lane);
            ph_norm(xlat_in, xctx_in, inp(I_G1) + (size_t)l * D, modl, 0, D, H, MT, (l > 0) ? (const float*)(wsb() + WS_SLAB) : (const float*)nullptr,
                    (const float*)(wsb() + WS_MOD) + ((size_t)(l - 1) * 5 + 4) * 12288 + 5 * D, XC, wave, lane);
            SEAM(sb + 0);
        }
        if (PH_ON(1) && RUN(sb + 1)) { TID_HERE;
            { pg8::Gemm g{H, WIN, opq(MT), opq(INW), opq(D), 0}; pg8::StaticOrder S; S.init(g.M, g.N, G, (int)blockIdx.x);
              pg8::EpiStore E{Z, INW};
              pg8::gemm_phase<pg8::EpiStore, pg8::StaticOrder, PG8_ALIGN, PG8_SP2>(lds, g, S, E); }
            SEAM(sb + 1);
        }
        if (PH_ON(2) && RUN(sb + 2)) { TID_HERE;
            for (int r_ = 0; r_ < DUPN(4); ++r_) ph_hyprep(A, l, lds, tid);
            for (int r_ = 0; r_ < DUPN(5); ++r_) ph_ret1(A, l, 64, lds, tid);
            for (int r_ = 0; r_ < DUPN(6); ++r_) ph_natt(A, l, nctx, lds, tid);
            for (int r_ = 0; r_ < DUPN(7); ++r_) if (!lastl) ph_hyctx(A, l, lds, tid);
            SEAM(sb + 2);
        }
        if (PH_ON(3) && RUN(sb + 3)) { TID_HERE;
#ifndef NO_D1
            for (int r_ = 0; r_ < DUPN(8); ++r_) ph_hyfft(A, l, lds, tid);
#endif
#ifndef NO_D2
            ph_scan(A, l, tid);
#endif
            SEAM(sb + 3);
        }
        if (PH_ON(4) && RUN(sb + 4)) { TID_HERE;
            for (int r_ = 0; r_ < DUPN(9); ++r_) ph_hypost(A, lds, tid);
            for (int r_ = 0; r_ < DUPN(10); ++r_) ph_ret3(A, l, nctx, lds, tid);
            SEAM(sb + 4);
        }
        if (PH_ON(5) && RUN(sb + 5)) { TID_HERE;
            __syncthreads();
            for (int r_ = 0; r_ < DUPN(13); ++r_)
            for (int i = 0; i < 3; ++i) {
                pg8::Gemm g{YS + (size_t)i * MT * 1024, WBR + (size_t)i * D * 1024, Mrows, opq(D), opq(1024), 0}; pg8::StaticOrder S; S.init(g.M, g.N, G, (int)blockIdx.x);
                pg8::EpiMerge E{ACC, Z + C_GT + i * D, INW, i == 0 ? 1 : 0};
                pg8::gemm_phase<pg8::EpiMerge, pg8::StaticOrder, PG8_ALIGN, PG8_SP2>(lds, g, S, E);
            }
            if (!lastl && blockIdx.x >= 32) { __syncthreads(); ph_filt2(A, l + 1, (l + 1) & 1, (int)blockIdx.x - 32, G - 32, lds, tid); }
            SEAM(sb + 5);
        }
        if (PH_ON(6) && RUN(sb + 6)) { TID_HERE;
            __syncthreads();
            { pg8::Gemm g{ACC, WOUT, opq(ML), opq(D), opq(D), 0}; pg8::StaticOrder S; S.init(g.M, g.N, G, (int)blockIdx.x);
              pg8::EpiResid E{xlat_in, xctx_in, outb(), XC, modl, 2 * D};
              pg8::gemm_phase<pg8::EpiResid, pg8::StaticOrder, PG8_ALIGN, PG8_SP2>(lds, g, S, E); }
            if (!lastl) { pg8::Gemm g{ACC, WOUT, opq(MT), opq(D), opq(D / NSPLIT), opq(D)}; pg8::CtxSplitOrder S{NSPLIT, D / NSPLIT, (int)blockIdx.x};
              pg8::EpiSlab E{(float*)(wsb() + WS_SLAB), D / NSPLIT};
              pg8::gemm_phase<pg8::EpiSlab, pg8::CtxSplitOrder, PG8_ALIGN, PG8_SP2>(lds, g, S, E); }
            SEAM(sb + 6);
        }
        if (PH_ON(7) && RUN(sb + 7)) { TID_HERE;
            ph_norm(outb(), xctx_in, inp(I_G2) + (size_t)l * D, modl, 3 * D, 4 * D, H, Mrows, (const float*)(wsb() + WS_SLAB), modl + (size_t)4 * 12288 + 2 * D, XC, wave, lane);
            SEAM(sb + 7);
        }
        if (PH_ON(8) && RUN(sb + 8)) { TID_HERE;
            __syncthreads();
            pg8::Gemm g{H, WF1, Mrows, opq(NFF), opq(D), 0}; pg8::StaticOrder S; S.init(g.M, g.N, G, (int)blockIdx.x);
            pg8::EpiFfn E{U, (bf16*)(wsb() + WS_SA), (bf16*)(wsb() + WS_SB), inp(I_FFCW) + (size_t)l * 3 * DFF, inp(I_FFCB) + (size_t)l * DFF};
            for (int r_ = 0; r_ < DUPN(14); ++r_) pg8::gemm_phase<pg8::EpiFfn, pg8::StaticOrder, PG8_ALIGN, PG8_SP2>(lds, g, S, E);
            SEAM(sb + 8);
        }
        if (PH_ON(9) && RUN(sb + 9)) { TID_HERE;
            for (int r_ = 0; r_ < DUPN(11); ++r_) ph_ffnfix(A, l, Mrows, tid);
            SEAM(sb + 9);
        }
        if (PH_ON(10) && RUN(sb + 10)) { TID_HERE;
            __syncthreads();
            { pg8::Gemm g{U, WF2, opq(ML), opq(D), opq(DFF), 0}; pg8::StaticOrder S; S.init(g.M, g.N, G, (int)blockIdx.x);
              pg8::EpiResid E{outb(), XC, outb(), XC, modl, 5 * D};
              pg8::gemm_phase<pg8::EpiResid, pg8::StaticOrder, PG8_ALIGN, PG8_SP2>(lds, g, S, E); }
            if (!lastl) { pg8::Gemm g{U, WF2, opq(MT), opq(D), opq(DFF / NSPLIT), opq(DFF)}; pg8::CtxSplitOrder S{NSPLIT, DFF / NSPLIT, (int)blockIdx.x};
              pg8::EpiSlab E{(float*)(wsb() + WS_SLAB), DFF / NSPLIT};
              pg8::gemm_phase<pg8::EpiSlab, pg8::CtxSplitOrder, PG8_ALIGN, PG8_SP2>(lds, g, S, E); }
            SEAM(sb + 10);
        }
    }
    if (PH_ON(101) && RUN(NSEQ - 1)) { TID_HERE; ph_final(A, wave, lane); }
#undef RUN
#undef SEAM
#undef H
#undef Z
#undef ACC
#undef U
#undef YS
#undef XC
#undef WIN
#undef WBR
#undef WOUT
#undef WF1
#undef WF2
#undef G
#undef modl
#undef xlat_in
#undef xctx_in
}

extern "C" void kernel_launch(void* const* d_in, const int* in_sizes, int n_in, void* d_out, int out_size, void* d_ws, size_t ws_size, hipStream_t stream) {
    static int grid = 0;
    if (grid == 0) {
        if (n_in != 27 || out_size != ML * D || ws_size < WS_END) { fprintf(stderr, "kernel_launch: unexpected shapes (n_in %d out %d ws %zu need %zu)\n", n_in, out_size, ws_size, (size_t)WS_END); grid = -1; return; }
        int dev = 0, cus = 0, per_cu = 0;
        if (hipGetDevice(&dev) != hipSuccess || hipDeviceGetAttribute(&cus, hipDeviceAttributeMultiprocessorCount, dev) != hipSuccess) { grid = -1; return; }
        if (hipFuncSetAttribute((const void*)fwd, hipFuncAttributeMaxDynamicSharedMemorySize, LDS_BYTES) != hipSuccess) { fprintf(stderr, "kernel_launch: hipFuncSetAttribute failed\n"); grid = -1; return; }
        if (hipOccupancyMaxActiveBlocksPerMultiprocessor(&per_cu, (const void*)fwd, NWAVES * 64, LDS_BYTES) != hipSuccess || per_cu < 1) fprintf(stderr, "kernel_launch: occupancy query says %d\n", per_cu);
        (void)hipGetLastError();
        grid = cus;
    }
    if (grid < 0) return;
    (void)hipMemsetAsync((char*)d_ws + WS_CTL, 0, CTL_ZERO_BYTES, stream);
    Args a{};
    for (int i = 0; i < 27; ++i) a.in[i] = (const float*)d_in[i];
    a.out = (float*)d_out; a.ws = (unsigned char*)d_ws;
#if MK_SINGLE
    a.seq_lo = 0; a.seq_hi = NSEQ;
    hipLaunchKernelGGL(fwd, dim3(grid), dim3(NWAVES * 64), LDS_BYTES, stream, a);
#else
    for (int s = 0; s < NSEQ; ++s) { a.seq_lo = s; a.seq_hi = s + 1; hipLaunchKernelGGL(fwd, dim3(grid), dim3(NWAVES * 64), LDS_BYTES, stream, a); }
#endif
}
```

```cpp
#include <hip/hip_runtime.h>
#include <cstdio>
#include <cstdint>
#ifndef MK_SINGLE
#define MK_SINGLE 1
#endif
namespace pg8 {
#define PG8_LAS __attribute__((address_space(3)))
typedef unsigned short bf16_t;
typedef short bf16x8 __attribute__((ext_vector_type(8)));
typedef float f32x4 __attribute__((ext_vector_type(4)));
typedef unsigned u32x4 __attribute__((ext_vector_type(4)));
constexpr int BM = 256, BK = 64, HALF = 128, HTB = HALF * BK * 2  , STAGE_BYTES = 8 * HTB, NXCD = 8, WGM = 8;

__host__ __device__ __forceinline__ int lds_byte(int r, int c) { const int st = (r >> 4) * 2 + (c >> 5), rr = r & 15, cc = c & 31, ob = rr * 64 + cc * 2; return st * 1024 + (ob ^ (((ob >> 9) & 1) << 5)); }
__host__ __device__ __forceinline__ void stage_rc(int b, int& R, int& C) { const int st = b / 1024, sb = b % 1024, swz = sb ^ (((sb >> 9) & 1) << 5); R = (st >> 1) * 16 + swz / 64; C = (st & 1) * 32 + (swz % 64) / 2; }
__host__ __device__ __forceinline__ int perm32(int rho) { const int n = rho >> 4, i = rho & 15; return 8 * (i >> 2) + 4 * n + (i & 3); }

struct Unit { int pm, pn, ko; };
struct Gemm { const bf16_t* A; const bf16_t* Bt; int M, N, K, ld; };

struct StaticOrder {
    int nM, nN, nwg, G, c;
    __host__ __device__ void init(int M, int N, int G_, int c_) { nM = M / BM; nN = N / BM; nwg = nM * nN; G = G_; c = c_; }
    __host__ __device__ bool next(int i, Unit& u) const {
        const long L = (long)i * G + c; if (L >= nwg) return false;
        int wgid = (int)L; { const int q = nwg / NXCD, r = nwg % NXCD, xcd = wgid % NXCD, off = wgid / NXCD; wgid = (xcd < r ? xcd * (q + 1) : r * (q + 1) + (xcd - r) * q) + off; }
        const int nig = WGM * nN, gid = wgid / nig, fm = gid * WGM, gsz = (nM - fm) < WGM ? (nM - fm) : WGM;
        u.pm = fm + ((wgid % nig) % gsz); u.pn = (wgid % nig) / gsz; u.ko = 0; return true;
    }
    __device__ __forceinline__ void a_ready(const Unit&) const {}
    __device__ __forceinline__ void done(const Unit&) const {}
};
__device__ __forceinline__ unsigned cvt_pk_bf16(float lo, float hi) { unsigned r; asm volatile("v_cvt_pk_bf16_f32 %0, %1, %2" : "=v"(r) : "v"(lo), "v"(hi)); return r; }
typedef float f32x2 __attribute__((ext_vector_type(2)));
__device__ __forceinline__ float bflo(unsigned w) { return __uint_as_float(w << 16); }
__device__ __forceinline__ float bfhi(unsigned w) { return __uint_as_float(w & 0xffff0000u); }
__device__ __forceinline__ float sigm(float x) { return 1.0f / (1.0f + __expf(-x)); }
struct EpiStore {
    static constexpr bool PERM = true, AFTER_DRAIN = false;
    bf16_t* O; int ldc;
    __device__ __forceinline__ void operator()(const f32x4 (&acc)[2][2][4][2], const Unit& u, int wr, int wc, int fr, int fq) const {
        const int row0 = u.pm * BM + wr * 64 + fr, col0 = u.pn * BM + wc * 32 + 8 * fq;
#pragma unroll
        for (int ai = 0; ai < 2; ++ai)
#pragma unroll
            for (int m = 0; m < 4; ++m) { bf16_t* rowp = O + (size_t)(row0 + ai * HALF + m * 16) * ldc + col0;
#pragma unroll
                for (int bj = 0; bj < 2; ++bj) { const f32x4 v0 = acc[ai][bj][m][0], v1 = acc[ai][bj][m][1];
                    u32x4 w; w.x = cvt_pk_bf16(v0[0], v0[1]); w.y = cvt_pk_bf16(v0[2], v0[3]); w.z = cvt_pk_bf16(v1[0], v1[1]); w.w = cvt_pk_bf16(v1[2], v1[3]);
                    *(u32x4*)(rowp + bj * HALF) = w; } }
    }
};
struct EpiMerge {
    static constexpr bool PERM = true, AFTER_DRAIN = false;
    bf16_t* O; const bf16_t* gate; int ldg; int first;
    __device__ __forceinline__ void operator()(const f32x4 (&acc)[2][2][4][2], const Unit& u, int wr, int wc, int fr, int fq) const {
        const int row0 = u.pm * BM + wr * 64 + fr, col0 = u.pn * BM + wc * 32 + 8 * fq;
#pragma unroll
        for (int ai = 0; ai < 2; ++ai)
#pragma unroll
            for (int m = 0; m < 4; ++m) { const size_t row = (size_t)(row0 + ai * HALF + m * 16);
#pragma unroll
                for (int bj = 0; bj < 2; ++bj) { const int col = col0 + bj * HALF;
                    const u32x4 gv = *(const u32x4*)(gate + row * ldg + col);
                    u32x4 pv = (u32x4){0u, 0u, 0u, 0u}; if (!first) pv = *(const u32x4*)(O + row * 2048 + col);
                    const f32x4 v0 = acc[ai][bj][m][0], v1 = acc[ai][bj][m][1];
                    u32x4 w;
                    w.x = cvt_pk_bf16(bflo(pv.x) + v0[0] * sigm(bflo(gv.x)), bfhi(pv.x) + v0[1] * sigm(bfhi(gv.x)));
                    w.y = cvt_pk_bf16(bflo(pv.y) + v0[2] * sigm(bflo(gv.y)), bfhi(pv.y) + v0[3] * sigm(bfhi(gv.y)));
                    w.z = cvt_pk_bf16(bflo(pv.z) + v1[0] * sigm(bflo(gv.z)), bfhi(pv.z) + v1[1] * sigm(bfhi(gv.z)));
                    w.w = cvt_pk_bf16(bflo(pv.w) + v1[2] * sigm(bflo(gv.w)), bfhi(pv.w) + v1[3] * sigm(bfhi(gv.w)));
                    *(u32x4*)(O + row * 2048 + col) = w; } }
    }
};
struct EpiResid {
    static constexpr bool PERM = false, AFTER_DRAIN = false;
    const float* base_lat; const float* base_ctx; float* out_lat; float* out_ctx; const float* modl; int goff;
    __device__ __forceinline__ void operator()(const f32x4 (&acc)[2][2][4][2], const Unit& u, int wr, int wc, int fr, int fq) const {
        const bool isctx = u.pm >= 64; const int r = isctx ? 4 : (u.pm >> 4);
        const float* gvp = modl + (size_t)r * 12288 + goff;
        const float* bs = isctx ? base_ctx : base_lat; float* os = isctx ? out_ctx : out_lat;
        const int row0 = (isctx ? u.pm - 64 : u.pm) * BM + wr * 64 + fr, col0 = u.pn * BM + wc * 32 + 4 * fq;
        f32x4 g4[2][2];
#pragma unroll
        for (int bj = 0; bj < 2; ++bj)
#pragma unroll
            for (int n = 0; n < 2; ++n) g4[bj][n] = *(const f32x4*)(gvp + col0 + bj * HALF + n * 16);
#pragma unroll
        for (int ai = 0; ai < 2; ++ai)
#pragma unroll
            for (int m = 0; m < 4; ++m) { const size_t off = (size_t)(row0 + ai * HALF + m * 16) * 2048 + col0;
#pragma unroll
                for (int bj = 0; bj < 2; ++bj)
#pragma unroll
                    for (int n = 0; n < 2; ++n) { const f32x4 b4 = *(const f32x4*)(bs + off + bj * HALF + n * 16);
                        *(f32x4*)(os + off + bj * HALF + n * 16) = b4 + g4[bj][n] * acc[ai][bj][m][n]; } }
    }
};

__device__ __forceinline__ float dpp_ror1(float v) { return __int_as_float(__builtin_amdgcn_update_dpp(0, __float_as_int(v), 0x121, 0xf, 0xf, false)); }
__device__ __forceinline__ float dpp_rol1(float v) { return __int_as_float(__builtin_amdgcn_update_dpp(0, __float_as_int(v), 0x12f, 0xf, 0xf, false)); }
__device__ __forceinline__ float gelu_fast(float x) { const float x2 = x * x; const float arg = x * (x2 * (-2.0f * 1.4426950408889634f * 0.7978845608028654f * 0.044715f) + (-2.0f * 1.4426950408889634f * 0.7978845608028654f));
    return x * __builtin_amdgcn_rcpf(1.0f + __builtin_amdgcn_exp2f(arg)); }
struct EpiFfn {
    static constexpr bool PERM = true, AFTER_DRAIN = false;
    bf16_t* U; bf16_t* SA; bf16_t* SB; const float* cw; const float* cb;
    __device__ __forceinline__ void operator()(const f32x4 (&acc)[2][2][4][2], const Unit& u, int wr, int wc, int fr, int fq) const {
        const int f0 = u.pn * 128 + wc * 32 + 8 * fq;
        f32x4 w0[2], w1[2], w2[2], bb[2];
#pragma unroll
        for (int n = 0; n < 2; ++n) { w0[n] = *(const f32x4*)(cw + f0 + 4 * n); w1[n] = *(const f32x4*)(cw + 5632 + f0 + 4 * n); w2[n] = *(const f32x4*)(cw + 2 * 5632 + f0 + 4 * n); bb[n] = *(const f32x4*)(cb + f0 + 4 * n); }
#pragma unroll
        for (int ai = 0; ai < 2; ++ai) {
            const int row0 = u.pm * BM + ai * HALF + wr * 64 + fr, blk = u.pm * 4 + ai * 2 + wr;
            f32x4 o[4][2];
#pragma unroll
            for (int n = 0; n < 2; ++n)
#pragma unroll
                for (int e = 0; e < 4; ++e) {
                    const float a0 = acc[ai][0][0][n][e], a1 = acc[ai][0][1][n][e], a2 = acc[ai][0][2][n][e], a3 = acc[ai][0][3][n][e];
                    const float r0 = dpp_ror1(a0), r1 = dpp_ror1(a1), r2 = dpp_ror1(a2), r3 = dpp_ror1(a3);
                    const float l0 = dpp_rol1(a0), l1 = dpp_rol1(a1), l2 = dpp_rol1(a2), l3 = dpp_rol1(a3);
                    const bool first = (fr == 0), last = (fr == 15);
                    const float p0 = r0, p1 = first ? r0 : r1, p2 = first ? r1 : r2, p3 = first ? r2 : r3;
                    const float n0 = last ? l1 : l0, n1 = last ? l2 : l1, n2 = last ? l3 : l2, n3 = l3;
                    const float k0 = w0[n][e], k1 = w1[n][e], k2 = w2[n][e], kb = bb[n][e];
                    o[0][n][e] = gelu_fast(k0 * p0 + k1 * a0 + k2 * n0 + kb) * acc[ai][1][0][n][e];
                    o[1][n][e] = gelu_fast(k0 * p1 + k1 * a1 + k2 * n1 + kb) * acc[ai][1][1][n][e];
                    o[2][n][e] = gelu_fast(k0 * p2 + k1 * a2 + k2 * n2 + kb) * acc[ai][1][2][n][e];
                    o[3][n][e] = gelu_fast(k0 * p3 + k1 * a3 + k2 * n3 + kb) * acc[ai][1][3][n][e];
                }
#pragma unroll
            for (int m = 0; m < 4; ++m) { u32x4 w; w.x = cvt_pk_bf16(o[m][0][0], o[m][0][1]); w.y = cvt_pk_bf16(o[m][0][2], o[m][0][3]); w.z = cvt_pk_bf16(o[m][1][0], o[m][1][1]); w.w = cvt_pk_bf16(o[m][1][2], o[m][1][3]);
                *(u32x4*)(U + (size_t)(row0 + m * 16) * 5632 + f0) = w; }
            const int sel = (fr == 0) ? 0 : (fr == 1) ? 1 : (fr == 14) ? 2 : (fr == 15) ? 3 : -1;
            if (sel >= 0) { const int m = (sel < 2) ? 0 : 3;
                const f32x4 a0 = (m == 0) ? acc[ai][0][0][0] : acc[ai][0][3][0], a1 = (m == 0) ? acc[ai][0][0][1] : acc[ai][0][3][1];
                u32x4 w; w.x = cvt_pk_bf16(a0[0], a0[1]); w.y = cvt_pk_bf16(a0[2], a0[3]); w.z = cvt_pk_bf16(a1[0], a1[1]); w.w = cvt_pk_bf16(a1[2], a1[3]);
                *(u32x4*)(SA + ((size_t)blk * 4 + sel) * 5632 + f0) = w;
                if (sel == 0 || sel == 3) { const f32x4 b0 = (m == 0) ? acc[ai][1][0][0] : acc[ai][1][3][0], b1 = (m == 0) ? acc[ai][1][0][1] : acc[ai][1][3][1];
                    u32x4 v; v.x = cvt_pk_bf16(b0[0], b0[1]); v.y = cvt_pk_bf16(b0[2], b0[3]); v.z = cvt_pk_bf16(b1[0], b1[1]); v.w = cvt_pk_bf16(b1[2], b1[3]);
                    *(u32x4*)(SB + ((size_t)blk * 2 + (sel == 0 ? 0 : 1)) * 5632 + f0) = v; } }
        }
    }
};

struct CtxSplitOrder {
    int nsplit, klen, c;
    __device__ __forceinline__ bool next(int i, Unit& u) const { if (i > 0 || c >= 32 * nsplit) return false; const int tile = c / nsplit, s = c - tile * nsplit; u.pm = 64 + (tile >> 3); u.pn = tile & 7; u.ko = s * klen; return true; }
    __device__ __forceinline__ void a_ready(const Unit&) const {}
    __device__ __forceinline__ void done(const Unit&) const {}
};
struct EpiSlab {
    static constexpr bool PERM = false, AFTER_DRAIN = false;
    float* slab; int klen;
    __device__ __forceinline__ void operator()(const f32x4 (&acc)[2][2][4][2], const Unit& u, int wr, int wc, int fr, int fq) const {
        float* os = slab + (size_t)(u.ko / klen) * 1024 * 2048;
        const int row0 = (u.pm - 64) * BM + wr * 64 + fr, col0 = u.pn * BM + wc * 32 + 4 * fq;
#pragma unroll
        for (int ai = 0; ai < 2; ++ai)
#pragma unroll
            for (int m = 0; m < 4; ++m) { const size_t off = (size_t)(row0 + ai * HALF + m * 16) * 2048 + col0;
#pragma unroll
                for (int bj = 0; bj < 2; ++bj)
#pragma unroll
                    for (int n = 0; n < 2; ++n) *(f32x4*)(os + off + bj * HALF + n * 16) = acc[ai][bj][m][n]; }
    }
};
template <class Epi, class Sched, bool ALIGN_EPI = false, bool SP2 = false>
__device__ __forceinline__ void gemm_phase(PG8_LAS unsigned char* lds, const Gemm g, const Sched& S, const Epi& E) {
    int tid_ = threadIdx.x; asm volatile("" : "+v"(tid_)); const int tid = tid_, wid = __builtin_amdgcn_readfirstlane(tid >> 6), lane = tid & 63, wr = wid >> 2, wc = wid & 3, fr = lane & 15, fq = lane >> 4;
    const int K = g.K, nt = K / BK, LD = g.ld ? g.ld : g.K;
    unsigned voffA[2], voffB[2];
#pragma unroll
    for (int i = 0; i < 2; ++i) { int R, C; stage_rc(tid * 16 + i * 8192, R, C); const int Rb = Epi::PERM ? ((R & ~31) + perm32(R & 31)) : R;
        voffA[i] = (unsigned)(R * LD + C) * 2u; voffB[i] = (unsigned)(Rb * LD + C) * 2u; }
    const size_t kstep = (size_t)(BK * 2);
    const size_t hstep = (size_t)HALF * LD * 2;
    const size_t tstep = 2 * hstep;
    const unsigned ldsw = (unsigned)wid * 1024u;
    const int aoff = lds_byte(wr * 64 + fr, fq * 8), boff = lds_byte(wc * 32 + fr, fq * 8);
#define PG8_SA(b, h) (((b) * 2 + (h)) * HTB)
#define PG8_SB(b, h) ((4 + (b) * 2 + (h)) * HTB)
#define PG8_STAGE(bufoff, gbase, voff) do { _Pragma("unroll") for (int _i = 0; _i < 2; ++_i) \
        __builtin_amdgcn_global_load_lds((const unsigned*)((const char*)(gbase) + (voff)[_i]), (PG8_LAS unsigned*)(lds + (bufoff) + ldsw + _i * 8192), 16, 0, 0); } while (0)
#define PG8_LDA(dst, b, h) do { _Pragma("unroll") for (int m = 0; m < 4; ++m) _Pragma("unroll") for (int k = 0; k < 2; ++k) dst[m][k] = *(const PG8_LAS bf16x8*)(lds + PG8_SA(b, h) + aoff + m * 2048 + k * 1024); } while (0)
#define PG8_LDB(dst, b, h) do { _Pragma("unroll") for (int n = 0; n < 2; ++n) _Pragma("unroll") for (int k = 0; k < 2; ++k) dst[n][k] = *(const PG8_LAS bf16x8*)(lds + PG8_SB(b, h) + boff + n * 2048 + k * 1024); } while (0)
#define PG8_MMA(ai, bj, At, Bt) do { __builtin_amdgcn_s_setprio(1); _Pragma("unroll") for (int m = 0; m < 4; ++m) _Pragma("unroll") for (int n = 0; n < 2; ++n) _Pragma("unroll") for (int k = 0; k < 2; ++k) \
        acc[ai][bj][m][n] = __builtin_amdgcn_mfma_f32_16x16x32_bf16(Bt[n][k], At[m][k], acc[ai][bj][m][n], 0, 0, 0); __builtin_amdgcn_s_setprio(0); } while (0)
#define PG8_WAIT_V(n) asm volatile("s_waitcnt vmcnt(" #n ")" ::: "memory")
#define PG8_WAIT_L(n) asm volatile("s_waitcnt lgkmcnt(" #n ")" ::: "memory")
#define PG8_BAR __builtin_amdgcn_s_barrier()
#define PG8_SCHED __builtin_amdgcn_sched_barrier(0)
    Unit cur, nxt; int ui = 0;
    if (!S.next(0, cur)) return;
    f32x4 acc[2][2][4][2];
#pragma unroll
    for (int a = 0; a < 2; ++a)
#pragma unroll
        for (int b = 0; b < 2; ++b)
#pragma unroll
            for (int m = 0; m < 4; ++m)
#pragma unroll
                for (int n = 0; n < 2; ++n) acc[a][b][m][n] = (f32x4){0.f, 0.f, 0.f, 0.f};
    bf16x8 At[4][2], B0[2][2], B1[2][2];
    const char* cA = (const char*)g.A + (size_t)cur.pm * tstep + (size_t)cur.ko * 2; const char* cB = (const char*)g.Bt + (size_t)cur.pn * tstep + (size_t)cur.ko * 2;
    S.a_ready(cur);
    if constexpr (SP2) {
        PG8_STAGE(PG8_SB(0, 0), cB, voffB); PG8_STAGE(PG8_SB(0, 1), cB + hstep, voffB); PG8_STAGE(PG8_SA(0, 0), cA, voffA); PG8_STAGE(PG8_SA(0, 1), cA + hstep, voffA);
        if (wr == 1) PG8_BAR;
        PG8_WAIT_V(2); PG8_BAR;
        PG8_STAGE(PG8_SB(1, 0), cB + kstep, voffB); PG8_STAGE(PG8_SA(1, 0), cA + kstep, voffA); PG8_STAGE(PG8_SB(1, 1), cB + hstep + kstep, voffB);
        PG8_WAIT_V(6); PG8_BAR;
    } else {
        PG8_STAGE(PG8_SB(0, 0), cB, voffB); PG8_STAGE(PG8_SA(0, 0), cA, voffA); PG8_STAGE(PG8_SB(0, 1), cB + hstep, voffB); PG8_STAGE(PG8_SA(0, 1), cA + hstep, voffA);
        if (wr == 1) PG8_BAR;
        PG8_WAIT_V(4); PG8_BAR;
        PG8_STAGE(PG8_SB(1, 0), cB + kstep, voffB); PG8_STAGE(PG8_SA(1, 0), cA + kstep, voffA); PG8_STAGE(PG8_SB(1, 1), cB + hstep + kstep, voffB);
        PG8_WAIT_V(6); PG8_BAR;
    }
    for (;;) {
        const bool has_next = S.next(ui + 1, nxt);
        const char* nA = has_next ? (const char*)g.A + (size_t)nxt.pm * tstep + (size_t)nxt.ko * 2 : cA; const char* nB = has_next ? (const char*)g.Bt + (size_t)nxt.pn * tstep + (size_t)nxt.ko * 2 : cB;
        for (int t = 0; t < nt; t += 2) {
            const bool last = (t == nt - 2);
            const char* a1 = cA + (size_t)(t + 1) * kstep;
            const char* a2 = last ? nA : cA + (size_t)(t + 2) * kstep; const char* b2 = last ? nB : cB + (size_t)(t + 2) * kstep;
            const char* a3 = a2 + kstep; const char* b3 = b2 + kstep;
            if (last && has_next) S.a_ready(nxt);
            if constexpr (SP2) {
            PG8_LDB(B0, 0, 0); PG8_LDB(B1, 0, 1); PG8_SCHED; PG8_LDA(At, 0, 0); PG8_STAGE(PG8_SA(1, 1), a1 + hstep, voffA);
            PG8_WAIT_V(8); PG8_WAIT_L(0); PG8_BAR; PG8_MMA(0, 0, At, B0); PG8_MMA(0, 1, At, B1); PG8_BAR; PG8_SCHED;
            PG8_LDA(At, 0, 1); PG8_STAGE(PG8_SB(0, 0), b2, voffB); PG8_STAGE(PG8_SB(0, 1), b2 + hstep, voffB); PG8_STAGE(PG8_SA(0, 0), a2, voffA);
            PG8_WAIT_V(8); PG8_WAIT_L(0); PG8_BAR; PG8_MMA(1, 0, At, B0); PG8_MMA(1, 1, At, B1); PG8_BAR; PG8_SCHED;
            PG8_LDB(B0, 1, 0); PG8_LDB(B1, 1, 1); PG8_SCHED; PG8_LDA(At, 1, 0); PG8_STAGE(PG8_SA(0, 1), a2 + hstep, voffA);
            PG8_WAIT_V(8); PG8_WAIT_L(0); PG8_BAR; PG8_MMA(0, 0, At, B0); PG8_MMA(0, 1, At, B1); PG8_BAR; PG8_SCHED;
            PG8_LDA(At, 1, 1); PG8_STAGE(PG8_SB(1, 0), b3, voffB); PG8_STAGE(PG8_SB(1, 1), b3 + hstep, voffB); PG8_STAGE(PG8_SA(1, 0), a3, voffA);
            PG8_WAIT_V(8); PG8_WAIT_L(0); PG8_BAR; PG8_MMA(1, 0, At, B0); PG8_MMA(1, 1, At, B1); PG8_BAR; PG8_SCHED;
            } else {
            PG8_LDB(B0, 0, 0); PG8_SCHED; PG8_LDA(At, 0, 0); PG8_STAGE(PG8_SA(1, 1), a1 + hstep, voffA);
            PG8_WAIT_L(8); PG8_BAR; PG8_WAIT_L(0); PG8_MMA(0, 0, At, B0); PG8_BAR; PG8_SCHED;
            PG8_LDB(B1, 0, 1); PG8_STAGE(PG8_SB(0, 0), b2, voffB);
            PG8_BAR; PG8_WAIT_L(0); PG8_MMA(0, 1, At, B1); PG8_BAR;
            PG8_LDA(At, 0, 1); PG8_STAGE(PG8_SA(0, 0), a2, voffA);
            PG8_BAR; PG8_WAIT_L(0); PG8_MMA(1, 0, At, B0); PG8_BAR; PG8_SCHED;
            PG8_STAGE(PG8_SB(0, 1), b2 + hstep, voffB);
            PG8_WAIT_V(6); PG8_BAR; PG8_MMA(1, 1, At, B1); PG8_BAR;
            PG8_LDB(B0, 1, 0); PG8_SCHED; PG8_LDA(At, 1, 0); PG8_STAGE(PG8_SA(0, 1), a2 + hstep, voffA);
            PG8_WAIT_L(8); PG8_BAR; PG8_WAIT_L(0); PG8_MMA(0, 0, At, B0); PG8_BAR; PG8_SCHED;
            PG8_LDB(B1, 1, 1); PG8_STAGE(PG8_SB(1, 0), b3, voffB);
            PG8_BAR; PG8_WAIT_L(0); PG8_MMA(0, 1, At, B1); PG8_BAR;
            PG8_LDA(At, 1, 1); PG8_STAGE(PG8_SA(1, 0), a3, voffA);
            PG8_BAR; PG8_WAIT_L(0); PG8_MMA(1, 0, At, B0); PG8_BAR; PG8_SCHED;
            PG8_STAGE(PG8_SB(1, 1), b3 + hstep, voffB);
            PG8_WAIT_V(6); PG8_BAR; PG8_MMA(1, 1, At, B1); PG8_BAR;
            }
        }
        if constexpr (ALIGN_EPI) { if (wr == 0) PG8_BAR; }
        if constexpr (!Epi::AFTER_DRAIN) { E(acc, cur, wr, wc, fr, fq); S.done(cur); }
        if (!has_next) break;
#pragma unroll
        for (int a = 0; a < 2; ++a)
#pragma unroll
            for (int b = 0; b < 2; ++b)
#pragma unroll
                for (int m = 0; m < 4; ++m)
#pragma unroll
                    for (int n = 0; n < 2; ++n) acc[a][b][m][n] = (f32x4){0.f, 0.f, 0.f, 0.f};
        cur = nxt; cA = nA; cB = nB; ++ui;
        if constexpr (ALIGN_EPI) { if (wr == 1) PG8_BAR; }
    }
    PG8_WAIT_V(0);
    if constexpr (!ALIGN_EPI) { if (wr == 0) PG8_BAR; }
    PG8_BAR;
    if constexpr (Epi::AFTER_DRAIN) { E.fused(acc, cur, wr, wc, fr, fq, lds, wid, lane); S.done(cur); }
#undef PG8_SA
#undef PG8_SB
#undef PG8_STAGE
#undef PG8_LDA
#undef PG8_LDB
#undef PG8_MMA
#undef PG8_WAIT_V
#undef PG8_WAIT_L
#undef PG8_BAR
#undef PG8_SCHED
}
}
#ifndef PG8_SP2
#define PG8_SP2 true
#endif
#ifndef PG8_ALIGN
#define PG8_ALIGN true
#endif
constexpr int D = 2048, NB = 4, SEQ = 4096, CL = 256, DEPTH = 4;
constexpr int ML = NB * SEQ, MC = NB * CL, MT = ML + MC;
constexpr int INW = 15360, DFF = 5632, NFF = 2 * DFF;
constexpr int C_RK = 0, C_RV = 512, C_NK = 1536, C_NV = 2560, C_RQ = 3584, C_RG = 4096, C_NQ = 5120, C_HY = 6144, C_GT = 9216;
constexpr float EPS = 1e-6f;
constexpr int NWAVES = 8;
constexpr size_t al256(size_t x) { return (x + 255) & ~(size_t)255; }
constexpr size_t WS_CTL = 0, CTL_ZERO_BYTES = 1u << 20;
constexpr size_t WS_MOD = WS_CTL + CTL_ZERO_BYTES;
constexpr size_t WS_ROPE = WS_MOD + al256((size_t)4 * 5 * 12288 * 4);
constexpr size_t PS_FH2 = 0;
constexpr size_t PS_FH2B = PS_FH2 + al256((size_t)4352 * 64 * 4);
constexpr size_t PS_TAPC = PS_FH2B + al256((size_t)4352 * 64 * 2);
constexpr size_t PS_KF = PS_TAPC + al256((size_t)2 * 2 * 1024 * 256 * 4);
constexpr size_t PS_WIN = PS_KF + al256((size_t)2 * 1024 * 8192 * 8);
constexpr size_t PS_WBR = PS_WIN + al256((size_t)INW * D * 2);
constexpr size_t PS_WOUT = PS_WBR + al256((size_t)3 * D * 1024 * 2);
constexpr size_t PS_WF1 = PS_WOUT + al256((size_t)D * D * 2);
constexpr size_t PS_WF2 = PS_WF1 + al256((size_t)NFF * D * 2);
constexpr size_t PS_BYTES = PS_WF2 + al256((size_t)D * DFF * 2);
constexpr size_t WS_PSET = WS_ROPE + al256(64 * 16 * 8);
constexpr size_t WS_XC = WS_PSET + 2 * PS_BYTES;
constexpr size_t WS_H = WS_XC + al256((size_t)MC * D * 4);
constexpr size_t WS_Z = WS_H + al256((size_t)MT * D * 2);
constexpr size_t WS_HYT = WS_Z + al256((size_t)MT * INW * 2);
constexpr size_t WS_YT = WS_HYT + al256((size_t)3 * NB * 1024 * SEQ * 2);
constexpr size_t WS_YS = WS_YT + al256((size_t)NB * 1024 * SEQ * 2);
constexpr size_t WS_ACC = WS_YS + al256((size_t)3 * MT * 1024 * 2);
constexpr size_t WS_U = WS_ACC + al256((size_t)MT * D * 2);
constexpr size_t WS_KV = WS_U + al256((size_t)MT * DFF * 2);
constexpr size_t WS_SA = WS_KV + al256((size_t)NB * 8 * 2 * 34 * 8192 * 4);
constexpr size_t WS_SB = WS_SA + al256((size_t)272 * 4 * DFF * 2);
constexpr size_t WS_SLAB = WS_SB + al256((size_t)272 * 2 * DFF * 2);
constexpr size_t WS_FB4 = WS_SLAB + al256((size_t)4 * MC * D * 4);
constexpr size_t WS_END = WS_FB4 + al256((size_t)4 * 4352 * 64 * 2);
constexpr int NSPLIT = 4;
constexpr int CW_BAR = 4096;
constexpr int RING_BYTES = 131072, LDSCTL_OFF = RING_BYTES, MISC_OFF = LDSCTL_OFF + 320, LDS_BYTES = 147456;

#define GAS __attribute__((address_space(1)))
#define LAS __attribute__((address_space(3)))
typedef unsigned short bf16;
typedef unsigned v4u __attribute__((ext_vector_type(4)));
typedef unsigned v2u __attribute__((ext_vector_type(2)));
typedef float f32x4 __attribute__((ext_vector_type(4)));
typedef float f32x2 __attribute__((ext_vector_type(2)));
typedef short bf16x8 __attribute__((ext_vector_type(8)));
typedef GAS unsigned gu32;
#define LDS_WAIT() asm volatile("s_waitcnt lgkmcnt(0)" ::: "memory")
__device__ __forceinline__ unsigned f2bf(float f) { unsigned u = __builtin_bit_cast(unsigned, f); return (u + 0x7fffu + ((u >> 16) & 1u)) >> 16; }
__device__ __forceinline__ unsigned pk2(float lo, float hi) { return f2bf(lo) | (f2bf(hi) << 16); }
__device__ __forceinline__ float bflo(unsigned w) { return __uint_as_float(w << 16); }
__device__ __forceinline__ float bfhi(unsigned w) { return __uint_as_float(w & 0xffff0000u); }
__device__ __forceinline__ float bf1(bf16 b) { return __uint_as_float(((unsigned)b) << 16); }
__device__ __forceinline__ bf16x8 mk8(unsigned a, unsigned b, unsigned c, unsigned d) { v4u v = (v4u){a, b, c, d}; return __builtin_bit_cast(bf16x8, v); }
__device__ __forceinline__ f32x4 mfma16(bf16x8 a, bf16x8 b, f32x4 c) { return __builtin_amdgcn_mfma_f32_16x16x32_bf16(a, b, c, 0, 0, 0); }
__device__ __forceinline__ float sin_rev(float r) { return __builtin_amdgcn_sinf(r - floorf(r)); }
__device__ __forceinline__ float cos_rev(float r) { return __builtin_amdgcn_cosf(r - floorf(r)); }
__device__ __forceinline__ float sin_rad(float x) { return sin_rev(x * 0.15915494309189535f); }
__device__ __forceinline__ float ex2(float x) { return __builtin_amdgcn_exp2f(x); }
__device__ __forceinline__ float wave_sum(float v) {
#pragma unroll
    for (int o = 1; o < 64; o <<= 1) v += __shfl_xor(v, o);
    return v;
}
__device__ __forceinline__ int otid() { int t = threadIdx.x; asm volatile("" : "+v"(t)); return t; }
__device__ __forceinline__ int opq(int v) { asm volatile("" : "+s"(v)); return v; }
#define XB_TMO      128
#define XB_XCNT(j)  (256  + 64 * (j))
#define XB_XSUB(j)  (1280 + 64 * (j))
#define XB_XGEN(j)  (2304 + 64 * (j))
#define XB_TOP      3328
#define XB_TOPGEN   3392
#define XCD_BAR_WORDS 3456
#define XB_SPIN_CAP (1u << 18)

__device__ __forceinline__ unsigned xb_ld(unsigned* p)              { return __hip_atomic_load(p, __ATOMIC_RELAXED, __HIP_MEMORY_SCOPE_AGENT); }
__device__ __forceinline__ unsigned xb_add(unsigned* p, unsigned v) { return __hip_atomic_fetch_add(p, v, __ATOMIC_RELAXED, __HIP_MEMORY_SCOPE_AGENT); }
__device__ __forceinline__ unsigned xb_xcc_id() { return (unsigned)__builtin_amdgcn_s_getreg((3 << 11) | 20) & 0xFu; }
#define XB_SPIN(cond, bar) do { unsigned _sp = 0; while (cond) { __builtin_amdgcn_s_sleep(1); \
    if ((++_sp & 255u) == 0u) { if (xb_ld(&(bar)[XB_TMO])) break; if (_sp > XB_SPIN_CAP) { atomicAdd(&(bar)[XB_TMO], 1u); break; } } } } while (0)

struct XcdBarrier {
    unsigned* bar; unsigned x;
    volatile LAS unsigned* st;
};

__device__ __forceinline__ XcdBarrier xcd_barrier_post(unsigned* bar, volatile LAS unsigned* st) {
    XcdBarrier b; b.bar = bar; b.x = xb_xcc_id(); b.st = st;
    if (threadIdx.x == 0) (void)xb_add(&bar[XB_XCNT(b.x)], 1u);
    return b;
}
__device__ __forceinline__ void xcd_barrier_complete(unsigned* bar, unsigned x, unsigned& nloc, unsigned& nx) {
    const unsigned G = gridDim.x * gridDim.y * gridDim.z;
    unsigned sum, cnt, mine, sp = 0u;
    for (;;) {
        sum = 0u; cnt = 0u; mine = 0u;
#pragma unroll
        for (unsigned j = 0; j < 16; ++j) { const unsigned c = xb_ld(&bar[XB_XCNT(j)]); sum += c; cnt += (c > 0u) ? 1u : 0u; mine = (j == x) ? c : mine; }
        if (sum == G) break;
        __builtin_amdgcn_s_sleep(1);
        if ((++sp & 255u) == 0u) { if (xb_ld(&bar[XB_TMO])) break; if (sp > XB_SPIN_CAP) { atomicAdd(&bar[XB_TMO], 1u); break; } }
    }
    nloc = mine > 0u ? mine : 1u; nx = cnt > 0u ? cnt : 1u;
}

__device__ __forceinline__ void xcd_barrier(const XcdBarrier& b) {
    asm volatile("s_waitcnt vmcnt(0)" ::: "memory");
    __syncthreads();
    if (threadIdx.x == 0) {
        unsigned* bar = b.bar;
        __builtin_amdgcn_s_waitcnt(0);
        unsigned nloc = b.st[0], nx = b.st[1];
        if (nloc == 0u) { xcd_barrier_complete(bar, b.x, nloc, nx); b.st[0] = nloc; b.st[1] = nx; }
        const unsigned old = xb_add(&bar[XB_XSUB(b.x)], 1u);
        const unsigned gen = old / nloc;
        if (old + 1u == (gen + 1u) * nloc) {
            __builtin_amdgcn_fence(__ATOMIC_RELEASE, "agent");
            asm volatile("s_waitcnt vmcnt(0)" ::: "memory");
            const unsigned og = xb_add(&bar[XB_TOP], 1u);
            const unsigned tg = og / nx;
            if (og + 1u == (tg + 1u) * nx) xb_add(&bar[XB_TOPGEN], 1u);
            else XB_SPIN(xb_ld(&bar[XB_TOPGEN]) == tg, bar);
            __builtin_amdgcn_fence(__ATOMIC_ACQUIRE, "agent");
            xb_add(&bar[XB_XGEN(b.x)], 1u);
            asm volatile("s_waitcnt vmcnt(0)" ::: "memory");
        } else {
            XB_SPIN(xb_ld(&bar[XB_XGEN(b.x)]) == gen, bar);
            __builtin_amdgcn_fence(__ATOMIC_ACQUIRE, "agent");
            asm volatile("s_waitcnt vmcnt(0)" ::: "memory");
        }
    }
    __syncthreads();
}
__device__ __forceinline__ void p0_transpose_item(const float* W, int K, int N, bf16* WT, int row_off, LAS float* scr, int item, int lane) {
    const int nblk = N / 32, kb = item / nblk, nb = item % nblk, k0 = 64 * kb, n0 = 32 * nb;
#pragma unroll 8
    for (int i = 0; i < 32; ++i) { const int kk = 2 * i + (lane >> 5); scr[kk * 33 + (lane & 31)] = __builtin_nontemporal_load(W + (size_t)(k0 + kk) * N + n0 + (lane & 31)); }
    LDS_WAIT(); asm volatile("" ::: "memory");
    const int c = lane & 7;
#pragma unroll
    for (int j = 0; j < 4; ++j) { const int n = (lane >> 3) + 8 * j; const LAS float* s = scr + (8 * c) * 33 + n;
        v4u o; o.x = pk2(s[0 * 33], s[1 * 33]); o.y = pk2(s[2 * 33], s[3 * 33]); o.z = pk2(s[4 * 33], s[5 * 33]); o.w = pk2(s[6 * 33], s[7 * 33]);
        __builtin_nontemporal_store(o, (GAS v4u*)(WT + (size_t)(row_off + n0 + n) * K + k0 + 8 * c)); }
    LDS_WAIT(); asm volatile("" ::: "memory");
}
struct Args { const float* in[27]; float* out; unsigned char* ws; int seq_lo, seq_hi; };
__device__ __forceinline__ const float* inp(int i) { const char* ka = (const char*)__builtin_amdgcn_kernarg_segment_ptr(); int off = i * 8; asm volatile("" : "+s"(off)); return *(const float* const*)(ka + off); }
__device__ __forceinline__ unsigned char* wsb() { const char* ka = (const char*)__builtin_amdgcn_kernarg_segment_ptr(); int off = 27 * 8 + 8; asm volatile("" : "+s"(off)); return *(unsigned char* const*)(ka + off); }
__device__ __forceinline__ float* outb() { const char* ka = (const char*)__builtin_amdgcn_kernarg_segment_ptr(); int off = 27 * 8; asm volatile("" : "+s"(off)); return *(float* const*)(ka + off); }
__device__ __forceinline__ unsigned char* psb(int set) { return wsb() + WS_PSET + (size_t)set * PS_BYTES; }
enum { I_X = 0, I_C, I_CTX, I_CCTX, I_WMOD, I_BMOD, I_G1, I_G2, I_WIN, I_HCW, I_HCB, I_FW1, I_FB1, I_FW2, I_FB2, I_FW3, I_FFQ, I_HBIAS, I_RDEC, I_RPB, I_WBR, I_WOUT, I_FFW1, I_FFCW, I_FFCB, I_FFW2, I_GF };

__device__ __forceinline__ void ph_prologue(const Args& A, LAS unsigned char* lds, int tid) {
    LAS float* sc = (LAS float*)lds;
    LAS float* red = sc + 5 * 2048;
    const float* c = inp(I_C); const float* cc = inp(I_CCTX);
    for (int i = tid; i < 5 * 2048; i += 512) { const int r = i >> 11, k = i & 2047; const float v = (r < 4) ? c[r * 2048 + k] : cc[k]; sc[i] = v / (1.0f + __expf(-v)); }
    __syncthreads();
    float* mod = (float*)(wsb() + WS_MOD);
    const int kq = tid >> 6, col = tid & 63;
    for (int u = blockIdx.x; u < DEPTH * 192; u += gridDim.x) {
        const int l = u / 192, n0 = (u % 192) * 64;
        const float* W = inp(I_WMOD) + (size_t)l * 2048 * 12288 + n0 + col;
        float a0 = 0.f, a1 = 0.f, a2 = 0.f, a3 = 0.f, a4 = 0.f;
        for (int k = kq * 256; k < kq * 256 + 256; ++k) { const float w = W[(size_t)k * 12288];
            a0 += sc[k] * w; a1 += sc[2048 + k] * w; a2 += sc[4096 + k] * w; a3 += sc[6144 + k] * w; a4 += sc[8192 + k] * w; }
        red[(kq * 5 + 0) * 64 + col] = a0; red[(kq * 5 + 1) * 64 + col] = a1; red[(kq * 5 + 2) * 64 + col] = a2; red[(kq * 5 + 3) * 64 + col] = a3; red[(kq * 5 + 4) * 64 + col] = a4;
        __syncthreads();
        if (tid < 320) { const int r = tid >> 6; float s = inp(I_BMOD)[l * 12288 + n0 + col];
#pragma unroll
            for (int q = 0; q < 8; ++q) s += red[(q * 5 + r) * 64 + col];
            mod[((size_t)l * 5 + r) * 12288 + n0 + col] = s; }
        __syncthreads();
    }
    if (blockIdx.x == 0) { f32x2* rope = (f32x2*)(wsb() + WS_ROPE);
        for (int i = tid; i < 1024; i += 512) { const int pos = i >> 4, j = i & 15; const float inv = exp2f(-(float)j * (13.287712379549449f / 16.0f));
            const float rev = (float)pos * inv * 0.15915494309189535f; rope[i] = (f32x2){cos_rev(rev), sin_rev(rev)}; } }
}

__device__ __forceinline__ void ph_convert(const Args& A, int l, int set, int it_lo, int it_hi, int wk, int nwk, LAS unsigned char* lds, int wave, int lane) {
    LAS float* scr = (LAS float*)(lds + wave * 16384);
    const int gw = wk * NWAVES + wave, NGW = nwk * NWAVES;
    constexpr int I_IN = (D / 64) * (INW / 32), I_BR = (1024 / 64) * (D / 32), I_OUT = (D / 64) * (D / 32), I_F1 = (D / 64) * (NFF / 32);
    const float* win = inp(I_WIN) + (size_t)l * D * INW; const float* wbr = inp(I_WBR) + (size_t)l * 3 * 1024 * D; const float* wout = inp(I_WOUT) + (size_t)l * D * D;
    const float* wf1 = inp(I_FFW1) + (size_t)l * D * NFF; const float* wf2 = inp(I_FFW2) + (size_t)l * DFF * D;
    unsigned char* ps = psb(set);
    bf16* WIN = (bf16*)(ps + PS_WIN); bf16* WBR = (bf16*)(ps + PS_WBR); bf16* WOUT = (bf16*)(ps + PS_WOUT); bf16* WF1 = (bf16*)(ps + PS_WF1); bf16* WF2 = (bf16*)(ps + PS_WF2);
    for (int it = it_lo + gw; it < it_hi; it += NGW) {
        int r = it;
        if (r < I_IN) { p0_transpose_item(win, D, INW, WIN, 0, scr, r, lane); continue; } r -= I_IN;
        if (r < I_BR) { p0_transpose_item(wbr, 1024, D, WBR, 0, scr, r, lane); continue; } r -= I_BR;
        if (r < I_BR) { p0_transpose_item(wbr + (size_t)1024 * D, 1024, D, WBR + (size_t)D * 1024, 0, scr, r, lane); continue; } r -= I_BR;
        if (r < I_BR) { p0_transpose_item(wbr + (size_t)2 * 1024 * D, 1024, D, WBR + (size_t)2 * D * 1024, 0, scr, r, lane); continue; } r -= I_BR;
        if (r < I_OUT) { p0_transpose_item(wout, D, D, WOUT, 0, scr, r, lane); continue; } r -= I_OUT;
        if (r < I_F1) { const int n0 = (r % (NFF / 32)) * 32, f0 = (n0 < DFF) ? n0 : n0 - DFF, nrow = 256 * (f0 >> 7) + ((n0 < DFF) ? 0 : 128) + (f0 & 127);
            p0_transpose_item(wf1, D, NFF, WF1, nrow - n0, scr, r, lane); continue; } r -= I_F1;
        p0_transpose_item(wf2, DFF, D, WF2, 0, scr, r, lane);
    }
}
constexpr int CONV_ITEMS = (D / 64) * (INW / 32) + 3 * (1024 / 64) * (D / 32) + (D / 64) * (D / 32) + (D / 64) * (NFF / 32) + (DFF / 64) * (D / 32);
__device__ __forceinline__ void ph_filt1(const Args& A, int l, int set, int wk, int nwk, LAS unsigned char* lds, int tid) {
    LAS float* feat = (LAS float*)lds;
    LAS float* h1 = feat + 8 * 33;
    const float* w1 = inp(I_FW1) + (size_t)l * 33 * 64; const float* b1 = inp(I_FB1) + l * 64; const float* w2 = inp(I_FW2) + (size_t)l * 64 * 64; const float* b2 = inp(I_FB2) + l * 64;
    const float* fq = inp(I_FFQ) + l * 64; bf16* FH2B = (bf16*)(wsb() + WS_FB4) + (size_t)l * 4352 * 64;
    const int pl = tid >> 6, o = tid & 63;
    for (int u = wk; u < 544; u += nwk) {
        const int pos = u * 8 + pl; const bool isc = pos >= 4096; const int Lf = isc ? 256 : 4096, tp = isc ? pos - 4096 : pos;
        if (o < 33) { float f;
            if (o == 0) f = (float)tp / (float)(Lf - 1);
            else { const int i = (o - 1) & 15; const float fr = 1e-4f + (float)i * ((15.0f - 1e-4f) / 15.0f); const float rev = fr * (float)tp / (float)Lf; f = (o <= 16) ? cos_rev(rev) : -sin_rev(rev); }
            feat[pl * 33 + o] = f; }
        __syncthreads();
        float a = b1[o];
#pragma unroll 3
        for (int i = 0; i < 33; ++i) a += feat[pl * 33 + i] * w1[i * 64 + o];
        h1[pl * 64 + o] = sin_rad(fq[o] * a);
        __syncthreads();
        float b = b2[o];
#pragma unroll 4
        for (int j = 0; j < 64; ++j) b += h1[pl * 64 + j] * w2[j * 64 + o];
        { const float hv = sin_rad(fq[o] * b); FH2B[(size_t)pos * 64 + o] = (bf16)f2bf(hv); }
        __syncthreads();
    }
}
__device__ __forceinline__ void ph_norm(const float* xlat, const float* xctx, const float* g, const float* modl, int sh_off, int sc_off, bf16* H, int Mrows, const float* slab, const float* sgate, float* xc_out, int wave, int lane) {
    const int gw = blockIdx.x * NWAVES + wave, NGW = gridDim.x * NWAVES;
    for (int m = gw; m < Mrows; m += NGW) {
        const float* xr; int r; const bool isc = m >= ML;
        if (!isc) { xr = xlat + (size_t)m * D; r = m >> 12; } else { xr = xctx + (size_t)(m - ML) * D; r = 4; }
        const float* mv = modl + (size_t)r * 12288;
        f32x4 v[8]; float ss = 0.f;
#pragma unroll
        for (int j = 0; j < 8; ++j) { const int idx = (lane + 64 * j) * 4; v[j] = *(const f32x4*)(xr + idx);
            if (isc && slab) { const float* sp = slab + (size_t)(m - ML) * D + idx; f32x4 p = *(const f32x4*)sp;
#pragma unroll
                for (int q = 1; q < NSPLIT; ++q) p = p + *(const f32x4*)(sp + (size_t)q * MC * D);
                v[j] = v[j] + *(const f32x4*)(sgate + idx) * p; *(f32x4*)(xc_out + (size_t)(m - ML) * D + idx) = v[j]; }
            ss += (v[j].x * v[j].x + v[j].y * v[j].y) + (v[j].z * v[j].z + v[j].w * v[j].w); }
        const float rstd = 1.0f / sqrtf(wave_sum(ss) * (1.0f / D) + EPS);
#pragma unroll
        for (int j = 0; j < 8; ++j) { const int idx = (lane + 64 * j) * 4;
            const f32x4 gg = *(const f32x4*)(g + idx), sh = *(const f32x4*)(mv + sh_off + idx), sc = *(const f32x4*)(mv + sc_off + idx);
            const f32x4 y = v[j] * rstd * gg * (sc + 1.0f) + sh;
            v2u w; w.x = pk2(y.x, y.y); w.y = pk2(y.z, y.w);
            *(v2u*)(H + (size_t)m * D + idx) = w; }
    }
}

__device__ __forceinline__ int fphys(int i) { return i + 2 * (i >> 5); }
__device__ __forceinline__ void bfly_dif(f32x2& a, f32x2& b, float c, float s) { const f32x2 u = a, v = b; a = u + v; const f32x2 d = u - v; b = __builtin_elementwise_fma(d.yx, (f32x2){s, -s}, d * (f32x2){c, c}); }
__device__ __forceinline__ void bfly_idit(f32x2& a, f32x2& b, float c, float s) { const f32x2 u = a, q = b; const f32x2 v = __builtin_elementwise_fma(q.yx, (f32x2){-s, s}, q * (f32x2){c, c}); a = u + v; b = u - v; }
template <bool ZHI> __device__ __forceinline__ void dif16(f32x2 (&x)[16], float th) {
    asm volatile("" : "+v"(th));
#pragma unroll
    for (int k = 0; k < 8; ++k) { const float fr = th + (float)k * 0.0625f; const float c = __builtin_amdgcn_cosf(fr), s = __builtin_amdgcn_sinf(fr);
        if (ZHI) { const f32x2 u = x[k]; x[k + 8] = (f32x2){u.x * c + u.y * s, u.y * c - u.x * s}; } else bfly_dif(x[k], x[k + 8], c, s); }
#pragma unroll
    for (int k = 0; k < 4; ++k) { const float fr = 2.0f * th + (float)k * 0.125f; const float c = __builtin_amdgcn_cosf(fr), s = __builtin_amdgcn_sinf(fr);
        bfly_dif(x[k], x[k + 4], c, s); bfly_dif(x[8 + k], x[12 + k], c, s); }
#pragma unroll
    for (int k = 0; k < 2; ++k) { const float fr = 4.0f * th + (float)k * 0.25f; const float c = __builtin_amdgcn_cosf(fr), s = __builtin_amdgcn_sinf(fr);
#pragma unroll
        for (int b = 0; b < 16; b += 4) bfly_dif(x[b + k], x[b + k + 2], c, s); }
    { const float fr = 8.0f * th; const float c = __builtin_amdgcn_cosf(fr), s = __builtin_amdgcn_sinf(fr);
#pragma unroll
        for (int b = 0; b < 16; b += 2) bfly_dif(x[b], x[b + 1], c, s); }
}
__device__ __forceinline__ void idit16(f32x2 (&x)[16], float th) {
    asm volatile("" : "+v"(th));
    { const float fr = 8.0f * th; const float c = __builtin_amdgcn_cosf(fr), s = __builtin_amdgcn_sinf(fr);
#pragma unroll
        for (int b = 0; b < 16; b += 2) bfly_idit(x[b], x[b + 1], c, s); }
#pragma unroll
    for (int k = 0; k < 2; ++k) { const float fr = 4.0f * th + (float)k * 0.25f; const float c = __builtin_amdgcn_cosf(fr), s = __builtin_amdgcn_sinf(fr);
#pragma unroll
        for (int b = 0; b < 16; b += 4) bfly_idit(x[b + k], x[b + k + 2], c, s); }
#pragma unroll
    for (int k = 0; k < 4; ++k) { const float fr = 2.0f * th + (float)k * 0.125f; const float c = __builtin_amdgcn_cosf(fr), s = __builtin_amdgcn_sinf(fr);
        bfly_idit(x[k], x[k + 4], c, s); bfly_idit(x[8 + k], x[12 + k], c, s); }
#pragma unroll
    for (int k = 0; k < 8; ++k) { const float fr = th + (float)k * 0.0625f; const float c = __builtin_amdgcn_cosf(fr), s = __builtin_amdgcn_sinf(fr); bfly_idit(x[k], x[k + 8], c, s); }
}
template <bool INV, int PSTRIDE> __device__ __forceinline__ void fft_pass(LAS f32x2* buf, int base, float th) {
    LAS f32x2* p = buf + fphys(base);
    f32x2 x[16];
#pragma unroll
    for (int k = 0; k < 16; ++k) x[k] = p[k * PSTRIDE];
    if (INV) idit16(x, th); else dif16<false>(x, th);
#pragma unroll
    for (int k = 0; k < 16; ++k) p[k * PSTRIDE] = x[k];
}
constexpr int FFT_LDS_BYTES = (8192 + 512 + 8) * 8;
__device__ __forceinline__ float block_sum(float v, LAS float* red, int tid) {
    v = wave_sum(v);
    __syncthreads();
    if ((tid & 63) == 0) red[tid >> 6] = v;
    __syncthreads();
    float s = 0.f;
#pragma unroll
    for (int i = 0; i < 8; ++i) s += red[i];
    return s;
}
__device__ __forceinline__ float hy_delta(int c) { const float d0 = -4.605170185988091f / 0.3f, d1 = -4.605170185988091f / 1.5f; return fabsf(d0 + (d1 - d0) * ((float)c / 1023.0f)); }
__device__ __forceinline__ void ph_filt2(const Args& A, int l, int set, int wk, int nwk, LAS unsigned char* lds, int tid) {
    LAS f32x2* buf = (LAS f32x2*)lds; LAS float* bufs = (LAS float*)lds; LAS float* red = (LAS float*)(lds + FFT_LDS_BYTES + 64); LAS float* w3s = red + 32;
    LAS float* ctap = w3s + 256;
    const float* w3 = inp(I_FW3) + (size_t)l * 64 * 4096; const bf16* FH2B = (const bf16*)(wsb() + WS_FB4) + (size_t)l * 4352 * 64;
    f32x2* KF = (f32x2*)(psb(set) + PS_KF); float* TAPC = (float*)(psb(set) + PS_TAPC);
    const int lane = tid & 63, w = tid >> 6, g = lane >> 4, li = lane & 15;
    for (int c = wk; c < 1024; c += nwk) {
        __syncthreads();
        if (tid < 256) w3s[tid] = w3[(size_t)(tid & 63) * 4096 + (tid >> 7) * 2048 + ((tid >> 6) & 1) * 1024 + c];
        __syncthreads();
        bf16x8 bfr[2];
#pragma unroll
        for (int ks = 0; ks < 2; ++ks) { float v[8];
#pragma unroll
            for (int j = 0; j < 8; ++j) v[j] = (li < 4) ? w3s[li * 64 + 32 * ks + 8 * g + j] : 0.f;
            bfr[ks] = mk8(pk2(v[0], v[1]), pk2(v[2], v[3]), pk2(v[4], v[5]), pk2(v[6], v[7])); }
        const float delta = hy_delta(c); float ssq = 0.f, ssqc = 0.f;
        const int comp = li >> 1;
#pragma unroll 1
        for (int rb = 0; rb < 272; rb += 64) {
            bf16x8 a0[8], a1[8];
#pragma unroll
            for (int rk = 0; rk < 8; ++rk) { const int rt = rb + w + 8 * rk; const bf16* ap = FH2B + (size_t)((rt < 272 ? rt : 0) * 16 + li) * 64 + 8 * g;
                a0[rk] = *(const bf16x8*)ap; a1[rk] = *(const bf16x8*)(ap + 32); }
#pragma unroll
            for (int rk = 0; rk < 8; ++rk) { const int rt = rb + w + 8 * rk; const int t0 = rt * 16;
                f32x4 acc = (f32x4){0.f, 0.f, 0.f, 0.f};
                acc = mfma16(a0[rk], bfr[0], acc); acc = mfma16(a1[rk], bfr[1], acc);
                if (li < 4 && rt < 272) {
                    if (rt < 256) {
#pragma unroll
                        for (int j = 0; j < 4; ++j) { const int t = t0 + 4 * g + j; const float val = acc[j] * __expf(-((float)t / 4095.0f) * delta);
                            if ((li & 1) == 0) { bufs[2 * fphys(t) + comp] = val; ssq += val * val; }
                            else if (t >= 1) { bufs[2 * fphys(8192 - t) + comp] = val; ssq += val * val; }
                            else bufs[2 * fphys(4096) + comp] = 0.f; }
                    } else {
#pragma unroll
                        for (int j = 0; j < 4; ++j) { const int m = t0 - 4096 + 4 * g + j; const float val = acc[j] * __expf(-((float)m / 255.0f) * delta);
                            ctap[li * 256 + m] = val; if ((li & 1) == 0 || m >= 1) ssqc += val * val; }
                    }
                }
            }
        }
        const bool o0 = (li < 2), o1 = (li == 2 || li == 3);
        const float scl0 = (1.0f / 8192.0f) / sqrtf(block_sum(o0 ? ssq : 0.f, red, tid) + EPS), scl1 = (1.0f / 8192.0f) / sqrtf(block_sum(o1 ? ssq : 0.f, red, tid) + EPS);
        const float sc0 = 1.0f / sqrtf(block_sum(o0 ? ssqc : 0.f, red, tid) + EPS), sc1 = 1.0f / sqrtf(block_sum(o1 ? ssqc : 0.f, red, tid) + EPS);
        __syncthreads();
        fft_pass<false, 544>(buf, tid, (float)tid * (1.0f / 8192.0f));
        __syncthreads();
        fft_pass<false, 34>(buf, (tid >> 5) * 512 + (tid & 31), (float)(tid & 31) * (1.0f / 512.0f));
        __syncthreads();
        fft_pass<false, 2>(buf, (tid >> 1) * 32 + (tid & 1), (float)(tid & 1) * (1.0f / 32.0f));
        __syncthreads();
#pragma unroll
        for (int r = 0; r < 8; ++r) { LAS f32x4* pp = (LAS f32x4*)(buf + fphys(2 * (tid + 512 * r))); const f32x4 ab = *pp; *pp = (f32x4){ab.x + ab.z, ab.y + ab.w, ab.x - ab.z, ab.y - ab.w}; }
        __syncthreads();
        f32x2* d0 = KF + (size_t)c * 8192; f32x2* d1 = KF + (size_t)(1024 + c) * 8192;
#pragma unroll 4
        for (int i = 0; i < 16; ++i) { const int p = tid + 512 * i; const int f = (int)(__brev((unsigned)p) >> 19); const int pp = (int)(__brev((unsigned)((8192 - f) & 8191)) >> 19);
            const f32x2 z = buf[fphys(p)], zp = buf[fphys(pp)];
            d0[p] = (f32x2){(z.x + zp.x) * 0.5f * scl0, (z.y - zp.y) * 0.5f * scl0};
            d1[p] = (f32x2){(z.y + zp.y) * 0.5f * scl1, (zp.x - z.x) * 0.5f * scl1}; }
        for (int q = tid; q < 1024; q += 512) { const int od = q >> 8, m = q & 255; TAPC[((size_t)od * 1024 + c) * 256 + m] = ctap[q] * ((od < 2) ? sc0 : sc1); }
    }
}

__device__ __forceinline__ void ph_hyprep(const Args& A, int l, LAS unsigned char* lds, int tid) {
    LAS bf16* T = (LAS bf16*)lds;
    const bf16* Z = (const bf16*)(wsb() + WS_Z); bf16* HYT = (bf16*)(wsb() + WS_HYT);
    const float* cw = inp(I_HCW) + (size_t)l * 3 * 3072; const float* cb = inp(I_HCB) + (size_t)l * 3072;
    for (int u = blockIdx.x; u < 3072; u += gridDim.x) {
        const int cg = u % 12, tt = (u / 12) & 63, b = u / 768;
        __syncthreads();
        for (int q = tid; q < 66 * 32; q += 512) { const int r = q >> 5, ch8 = q & 31, t = tt * 64 - 1 + r;
            v4u v = (v4u){0u, 0u, 0u, 0u};
            if (t >= 0 && t < SEQ) v = *(const v4u*)(Z + (size_t)(b * SEQ + t) * INW + C_HY + cg * 256 + ch8 * 8);
            *(LAS v4u*)(T + r * 264 + ch8 * 8) = v; }
        __syncthreads();
        const int ch = tid & 255, half = tid >> 8, gch = cg * 256 + ch;
        const float w0 = cw[gch], w1 = cw[3072 + gch], w2 = cw[6144 + gch], bb = cb[gch];
        const int part = gch >> 10, c = gch & 1023;
        bf16* outp = HYT + ((size_t)(part * NB + b) * 1024 + c) * SEQ + tt * 64 + half * 32;
#pragma unroll
        for (int tq = 0; tq < 4; ++tq) { float vv[8];
#pragma unroll
            for (int e = 0; e < 8; ++e) { const int tl = half * 32 + tq * 8 + e;
                vv[e] = w0 * bf1(T[tl * 264 + ch]) + w1 * bf1(T[(tl + 1) * 264 + ch]) + w2 * bf1(T[(tl + 2) * 264 + ch]) + bb; }
            v4u w; w.x = pk2(vv[0], vv[1]); w.y = pk2(vv[2], vv[3]); w.z = pk2(vv[4], vv[5]); w.w = pk2(vv[6], vv[7]);
            *(v4u*)(outp + tq * 8) = w; }
    }
}
__device__ __forceinline__ void ph_hyctx(const Args& A, int l, LAS unsigned char* lds, int tid) {
    const bf16* Z = (const bf16*)(wsb() + WS_Z); bf16* YS = (bf16*)(wsb() + WS_YS); const float* TAPC = (const float*)(psb(l & 1) + PS_TAPC);
    const float* cw = inp(I_HCW) + (size_t)l * 3 * 3072; const float* cb = inp(I_HCB) + (size_t)l * 3072; const float* hb = inp(I_HBIAS) + (size_t)l * 2 * 1024;
    const int ch = tid >> 6, q = tid & 63, t0 = 4 * q;
    LAS float* Y = (LAS float*)lds + ch * 1552; LAS float* Y1 = Y + 256; LAS float* G0 = Y + 512; LAS float* G1 = Y + 1032;
    for (int u = blockIdx.x; u < 512; u += gridDim.x) {
        const int b = u >> 7, c = (u & 127) * 8 + ch;
        __syncthreads();
        float pv[3][4];
#pragma unroll
        for (int part = 0; part < 3; ++part) { const int gch = part * 1024 + c; const float w0 = cw[gch], w1 = cw[3072 + gch], w2 = cw[6144 + gch], bb = cb[gch];
            const bf16* zp = Z + (size_t)(ML + b * CL + t0) * INW + C_HY + gch;
            float zz[6];
#pragma unroll
            for (int e = 0; e < 6; ++e) { const int t = t0 - 1 + e; zz[e] = (t >= 0 && t < CL) ? bf1(zp[(ptrdiff_t)(e - 1) * INW]) : 0.f; }
#pragma unroll
            for (int r = 0; r < 4; ++r) pv[part][r] = w0 * zz[r] + w1 * zz[r + 1] + w2 * zz[r + 2] + bb; }
        *(LAS f32x4*)(Y + t0) = (f32x4){pv[2][0], pv[2][1], pv[2][2], pv[2][3]};
#pragma unroll
        for (int r = 0; r < 4; ++r) { const int m = t0 + r;
            G0[m + 259] = TAPC[((size_t)(0 * 2 + 0) * 1024 + c) * 256 + m]; G1[m + 259] = TAPC[((size_t)(1 * 2 + 0) * 1024 + c) * 256 + m];
            if (m >= 1) { G0[259 - m] = TAPC[((size_t)(0 * 2 + 1) * 1024 + c) * 256 + m]; G1[259 - m] = TAPC[((size_t)(1 * 2 + 1) * 1024 + c) * 256 + m]; } }
        if (q == 0) { G0[515] = 0.f; G1[515] = 0.f; G0[516] = 0.f; G1[516] = 0.f; }
        __syncthreads();
        float yprev[4] = {pv[2][0], pv[2][1], pv[2][2], pv[2][3]};
#pragma unroll
        for (int ord = 0; ord < 2; ++ord) {
            const LAS float* Ys = ord ? Y1 : Y; const LAS float* G = ord ? G1 : G0;
            float acc[4] = {0.f, 0.f, 0.f, 0.f};
#pragma unroll 4
            for (int sp = 0; sp < 64; ++sp) { const f32x4 yv = *(const LAS f32x4*)(Ys + 4 * sp); const LAS float* gp = G + 4 * (q - sp) + 256;
                const f32x4 ga = *(const LAS f32x4*)gp, gb = *(const LAS f32x4*)(gp + 4);
                const float g[8] = {ga.x, ga.y, ga.z, ga.w, gb.x, gb.y, gb.z, gb.w}; const float yy[4] = {yv.x, yv.y, yv.z, yv.w};
#pragma unroll
                for (int r = 0; r < 4; ++r)
#pragma unroll
                    for (int j = 0; j < 4; ++j) acc[r] += yy[j] * g[r - j + 3]; }
            const float bias = hb[ord * 1024 + c];
#pragma unroll
            for (int r = 0; r < 4; ++r) yprev[r] = pv[ord][r] * (acc[r] + bias * yprev[r]);
            if (ord == 0) { *(LAS f32x4*)(Y1 + t0) = (f32x4){yprev[0], yprev[1], yprev[2], yprev[3]}; __syncthreads(); }
        }
#pragma unroll
        for (int r = 0; r < 4; ++r) YS[(size_t)(ML + b * CL + t0 + r) * 1024 + c] = (bf16)f2bf(yprev[r]);
    }
}
__device__ __forceinline__ void unpack8(v4u v, float (&x)[8]) { x[0] = bflo(v.x); x[1] = bfhi(v.x); x[2] = bflo(v.y); x[3] = bfhi(v.y); x[4] = bflo(v.z); x[5] = bfhi(v.z); x[6] = bflo(v.w); x[7] = bfhi(v.w); }
__device__ __forceinline__ v4u pack8(const float (&x)[8]) { v4u w; w.x = pk2(x[0], x[1]); w.y = pk2(x[2], x[3]); w.z = pk2(x[4], x[5]); w.w = pk2(x[6], x[7]); return w; }
__device__ __forceinline__ void rope8(float (&lo)[8], float (&hi)[8], const f32x2* rt) {
#pragma unroll
    for (int e = 0; e < 8; ++e) { const f32x2 cs = rt[e]; const float a = lo[e], b = hi[e]; lo[e] = a * cs.x - b * cs.y; hi[e] = b * cs.x + a * cs.y; }
}
__device__ __forceinline__ void vt_store(LAS bf16* Vt, int ld, int d0, int r, v4u vv) {
    Vt[(d0 + 0) * ld + r] = (bf16)(vv.x & 0xffffu); Vt[(d0 + 1) * ld + r] = (bf16)(vv.x >> 16);
    Vt[(d0 + 2) * ld + r] = (bf16)(vv.y & 0xffffu); Vt[(d0 + 3) * ld + r] = (bf16)(vv.y >> 16);
    Vt[(d0 + 4) * ld + r] = (bf16)(vv.z & 0xffffu); Vt[(d0 + 5) * ld + r] = (bf16)(vv.z >> 16);
    Vt[(d0 + 6) * ld + r] = (bf16)(vv.w & 0xffffu); Vt[(d0 + 7) * ld + r] = (bf16)(vv.w >> 16);
}
constexpr float LOG2E = 1.4426950408889634f;
typedef short s16x4 __attribute__((ext_vector_type(4)));
__device__ __forceinline__ bf16x8 tr_frag(const LAS bf16* tile, int ld, int r0, int r1, int c0, int li) {
    const s16x4 lo = __builtin_amdgcn_ds_read_tr16_b64_v4i16((LAS s16x4*)(tile + (r0 + (li >> 2)) * ld + c0 + 4 * (li & 3)));
    const s16x4 hi = __builtin_amdgcn_ds_read_tr16_b64_v4i16((LAS s16x4*)(tile + (r1 + (li >> 2)) * ld + c0 + 4 * (li & 3)));
    return (bf16x8){lo.x, lo.y, lo.z, lo.w, hi.x, hi.y, hi.z, hi.w};
}
__device__ __forceinline__ void ph_ret1(const Args& A, int l, int nctx_units, LAS unsigned char* lds, int tid) {
    LAS bf16* Kf = (LAS bf16*)lds; LAS bf16* Kb = Kf + 128 * 72; LAS bf16* Vs = Kb + 128 * 72;
    const bf16* Z = (const bf16*)(wsb() + WS_Z); float* KV = (float*)(wsb() + WS_KV); const f32x2* rope = (const f32x2*)(wsb() + WS_ROPE);
    const int lane = tid & 63, w = tid >> 6, g = lane >> 4, li = lane & 15;
    for (int uid = blockIdx.x; uid < 1024 + nctx_units; uid += gridDim.x) {
        const bool isc = uid >= 1024; int b, h, n, ci; size_t m0;
        if (!isc) { b = uid >> 8; h = (uid >> 5) & 7; n = uid & 31; m0 = (size_t)b * SEQ + n * 128; ci = 2 + n; }
        else { const int i = uid - 1024; b = i >> 4; h = (i >> 1) & 7; n = i & 1; m0 = (size_t)ML + b * CL + n * 128; ci = n; }
        const float lgf = inp(I_RDEC)[(l * 2 + 0) * 8 + h] * LOG2E, lgb = inp(I_RDEC)[(l * 2 + 1) * 8 + h] * LOG2E;
        __syncthreads();
        { const int tok = tid >> 2, pp = tid & 3, a = (pp & 1) + ((pp >> 1) << 2);
            const bf16* kr = Z + (m0 + tok) * INW + C_RK + h * 64;
            float lo[8], hi[8]; unpack8(*(const v4u*)(kr + 8 * a), lo); unpack8(*(const v4u*)(kr + 8 * a + 16), hi);
            if (!isc) { const int t = n * 128 + tok; const int pos = (a < 4) ? (t >> 6) : (t & 63); rope8(lo, hi, rope + pos * 16 + 8 * (a & 1)); }
            const float zf = ex2(lgf * (float)(127 - tok)) * 0.125f, zb = ex2(lgb * (float)tok) * 0.125f;
            float lf[8], hf[8];
#pragma unroll
            for (int e = 0; e < 8; ++e) { lf[e] = lo[e] * zf; hf[e] = hi[e] * zf; lo[e] *= zb; hi[e] *= zb; }
            *(LAS v4u*)(Kf + tok * 72 + 8 * a) = pack8(lf); *(LAS v4u*)(Kf + tok * 72 + 8 * a + 16) = pack8(hf);
            *(LAS v4u*)(Kb + tok * 72 + 8 * a) = pack8(lo); *(LAS v4u*)(Kb + tok * 72 + 8 * a + 16) = pack8(hi); }
        for (int q = tid; q < 2048; q += 512) { const int r = q >> 4, ch = q & 15; *(LAS v4u*)(Vs + r * 144 + ch * 8) = *(const v4u*)(Z + (m0 + r) * INW + C_RV + h * 128 + ch * 8); }
        __syncthreads();
        bf16x8 af[4];
#pragma unroll
        for (int ks = 0; ks < 4; ++ks) af[ks] = tr_frag(Vs, 144, 32 * ks + 8 * g, 32 * ks + 8 * g + 4, 16 * w, li);
#pragma unroll
        for (int dir = 0; dir < 2; ++dir) { const LAS bf16* KT = dir ? Kb : Kf;
            float* dst = KV + ((size_t)((b * 8 + h) * 2 + dir) * 34 + ci) * 8192;
#pragma unroll
            for (int nc = 0; nc < 4; ++nc) { f32x4 acc = (f32x4){0.f, 0.f, 0.f, 0.f};
#pragma unroll
                for (int ks = 0; ks < 4; ++ks) acc = mfma16(af[ks], tr_frag(KT, 72, 32 * ks + 8 * g, 32 * ks + 8 * g + 4, 16 * nc, li), acc);
#pragma unroll
                for (int j = 0; j < 4; ++j) dst[(16 * w + 4 * g + j) * 64 + 16 * nc + li] = acc[j]; } }
    }
}
__device__ __forceinline__ void ph_natt(const Args& A, int l, int nctx_units, LAS unsigned char* lds, int tid) {
    LAS bf16* Qs = (LAS bf16*)lds; LAS bf16* KV0 = Qs + 128 * 136; LAS float* rpbs = (LAS float*)(KV0 + 2 * (64 * 136 + 64 * 144));
    const bf16* Z = (const bf16*)(wsb() + WS_Z); bf16* YS = (bf16*)(wsb() + WS_YS) + (size_t)2 * MT * 1024;
    const int lane = tid & 63, w = tid >> 6, g = lane >> 4, li = lane & 15;
    const float SCALE = 0.08838834764831845f;
    const int sr0 = tid >> 4, sch = tid & 15;
    for (int uid = blockIdx.x; uid < 1024 + nctx_units; uid += gridDim.x) {
        const bool isc = uid >= 1024; int b, h, rp = 0; size_t m0;
        if (!isc) { b = uid >> 8; h = (uid >> 5) & 7; rp = uid & 31; m0 = (size_t)b * SEQ + rp * 128; }
        else { const int i = uid - 1024; b = i >> 4; h = (i >> 1) & 7; m0 = (size_t)ML + b * CL + (i & 1) * 128; }
        const size_t mc0 = (size_t)ML + b * CL;
        const int qr = 2 * rp + (w >> 2), cw = w & 3, qc = 16 * cw + li;
        const int cs = min(max(qc - 8, 0), 48), rs_w = min(max(qr - 4, 0), 56);
        const int kr_lo = min(max(2 * rp - 4, 0), 56), kr_hi = min(max(2 * rp - 3, 0), 56) + 7;
        const int nwin = isc ? 0 : (kr_hi - kr_lo + 1), ntile = nwin + 4;
        const int nlo_w = (cw <= 1) ? 0 : cw - 1, nhi_w = (cw == 0) ? 1 : ((cw == 3) ? 3 : cw + 1);
        v4u kreg[2], vreg[2];
#define NA_LOAD(t_) do { const int t__ = (t_); const size_t mk = (t__ < nwin) ? ((size_t)b * SEQ + (kr_lo + t__) * 64) : (mc0 + (t__ - nwin) * 64); \
            _Pragma("unroll") for (int e = 0; e < 2; ++e) { const bf16* zr = Z + (mk + sr0 + 32 * e) * INW + h * 128 + sch * 8; kreg[e] = *(const v4u*)(zr + C_NK); vreg[e] = *(const v4u*)(zr + C_NV); } } while (0)
#define NA_STORE(buf_) do { LAS bf16* Kd = KV0 + (buf_) * (64 * 136 + 64 * 144); LAS bf16* Vd = Kd + 64 * 136; \
            _Pragma("unroll") for (int e = 0; e < 2; ++e) { *(LAS v4u*)(Kd + (sr0 + 32 * e) * 136 + sch * 8) = kreg[e]; *(LAS v4u*)(Vd + (sr0 + 32 * e) * 144 + sch * 8) = vreg[e]; } } while (0)
        __syncthreads();
        NA_LOAD(0);
        for (int q = tid; q < 2048; q += 512) { const int r = q >> 4, chn = q & 15; *(LAS v4u*)(Qs + r * 136 + chn * 8) = *(const v4u*)(Z + (m0 + r) * INW + C_NQ + h * 128 + chn * 8); }
        if (!isc) for (int i = tid; i < 465; i += 512) rpbs[i] = inp(I_RPB)[((size_t)l * 8 + h) * 465 + i];
        NA_STORE(0);
        __syncthreads();
        bf16x8 qf[4];
#pragma unroll
        for (int ks = 0; ks < 4; ++ks) qf[ks] = *(const LAS bf16x8*)(Qs + (16 * w + li) * 136 + 32 * ks + 8 * g);
        f32x4 o[8];
#pragma unroll
        for (int nd = 0; nd < 8; ++nd) o[nd] = (f32x4){0.f, 0.f, 0.f, 0.f};
        float mrun = -1e30f, lrun = 0.f;
        for (int t = 0; t < ntile; ++t) {
            const bool win = t < nwin; const int kr = kr_lo + t;
            if (t + 1 < ntile) NA_LOAD(t + 1);
            const LAS bf16* Ks = KV0 + (t & 1) * (64 * 136 + 64 * 144); const LAS bf16* Vs = Ks + 64 * 136;
            const bool active = !win || (kr >= rs_w && kr <= rs_w + 7);
            if (active) {
                const int nlo = win ? nlo_w : 0, nhi = win ? nhi_w : 3;
                f32x4 s[4];
#pragma unroll
                for (int n = 0; n < 4; ++n) { s[n] = (f32x4){0.f, 0.f, 0.f, 0.f};
                    if (n >= nlo && n <= nhi) {
#pragma unroll
                        for (int ks = 0; ks < 4; ++ks) s[n] = mfma16(*(const LAS bf16x8*)(Ks + (16 * n + li) * 136 + 32 * ks + 8 * g), qf[ks], s[n]); } }
                float tmax = -1e30f;
#pragma unroll
                for (int n = 0; n < 4; ++n)
#pragma unroll
                    for (int j = 0; j < 4; ++j) { float v = s[n][j] * SCALE;
                        if (win) { const int kc = 16 * n + 4 * g + j; const bool valid = (kc >= cs) && (kc < cs + 16);
                            const int dc = min(max(kc - qc + 15, 0), 30), dr = min(max(kr - qr + 7, 0), 14);
                            v = valid ? v + rpbs[dr * 31 + dc] : -1e30f; }
                        s[n][j] = v; tmax = fmaxf(tmax, v); }
                tmax = fmaxf(tmax, __shfl_xor(tmax, 16)); tmax = fmaxf(tmax, __shfl_xor(tmax, 32));
                const float mnew = fmaxf(mrun, tmax), alpha = __expf(mrun - mnew);
                float psum = 0.f;
#pragma unroll
                for (int n = 0; n < 4; ++n)
#pragma unroll
                    for (int j = 0; j < 4; ++j) { const float pv = __expf(s[n][j] - mnew); s[n][j] = pv; psum += pv; }
                psum += __shfl_xor(psum, 16); psum += __shfl_xor(psum, 32);
                lrun = lrun * alpha + psum; mrun = mnew;
#pragma unroll
                for (int nd = 0; nd < 8; ++nd) o[nd] = o[nd] * alpha;
#pragma unroll
                for (int kk = 0; kk < 2; ++kk) {
                    if (2 * kk + 1 >= nlo && 2 * kk <= nhi) {
                        const bf16x8 pf = mk8(pk2(s[2 * kk][0], s[2 * kk][1]), pk2(s[2 * kk][2], s[2 * kk][3]), pk2(s[2 * kk + 1][0], s[2 * kk + 1][1]), pk2(s[2 * kk + 1][2], s[2 * kk + 1][3]));
#pragma unroll
                        for (int nd = 0; nd < 8; ++nd) o[nd] = mfma16(tr_frag(Vs, 144, 32 * kk + 4 * g, 32 * kk + 16 + 4 * g, 16 * nd, li), pf, o[nd]); } }
            }
            if (t + 1 < ntile) NA_STORE((t + 1) & 1);
            __syncthreads();
        }
#undef NA_LOAD
#undef NA_STORE
        const float inv = 1.0f / lrun; const size_t mrow = m0 + 16 * w + li;
#pragma unroll
        for (int nd = 0; nd < 8; ++nd) { v2u wv; wv.x = pk2(o[nd][0] * inv, o[nd][1] * inv); wv.y = pk2(o[nd][2] * inv, o[nd][3] * inv);
            *(v2u*)(YS + mrow * 1024 + h * 128 + 16 * nd + 4 * g) = wv; }
    }
}

__device__ __forceinline__ void ph_hyfft(const Args& A, int l, LAS unsigned char* lds, int tid) {
    LAS f32x2* buf = (LAS f32x2*)lds;
    const bf16* HYT = (const bf16*)(wsb() + WS_HYT); bf16* YT = (bf16*)(wsb() + WS_YT); const f32x2* KF = (const f32x2*)(psb(l & 1) + PS_KF);
    const float* hb = inp(I_HBIAS) + (size_t)l * 2 * 1024;
    const int baseB = (tid >> 5) * 512 + (tid & 31), baseC = (tid >> 1) * 32 + (tid & 1);
    const float thA = (float)tid * (1.0f / 8192.0f), thB = (float)(tid & 31) * (1.0f / 512.0f), thC = (float)(tid & 1) * (1.0f / 32.0f);
    for (int u = blockIdx.x; u < 2048; u += gridDim.x) {
        const int c = u >> 1, b0 = (u & 1) * 2;
        const bf16* x1p = HYT + ((size_t)(0 * NB + b0) * 1024 + c) * SEQ; const bf16* x2p = HYT + ((size_t)(1 * NB + b0) * 1024 + c) * SEQ; const bf16* vp = HYT + ((size_t)(2 * NB + b0) * 1024 + c) * SEQ;
        const size_t bstr = (size_t)1024 * SEQ;
        float y0[8], y1[8];
#pragma unroll
        for (int i = 0; i < 8; ++i) { const int t = tid + 512 * i; y0[i] = bf1(vp[t]); y1[i] = bf1(vp[bstr + t]); }
#pragma unroll
        for (int ord = 0; ord < 2; ++ord) {
            { f32x2 x[16];
#pragma unroll
                for (int k = 0; k < 8; ++k) { x[k] = (f32x2){y0[k], y1[k]}; x[k + 8] = (f32x2){0.f, 0.f}; }
                dif16<true>(x, thA);
                __syncthreads();
#pragma unroll
                for (int k = 0; k < 16; ++k) buf[fphys(tid) + 544 * k] = x[k]; }
            __syncthreads();
            fft_pass<false, 34>(buf, baseB, thB);
            __syncthreads();
            fft_pass<false, 2>(buf, baseC, thC);
            __syncthreads();
            { const f32x4* kf = (const f32x4*)(KF + (size_t)(ord * 1024 + c) * 8192);
#pragma unroll
                for (int r = 0; r < 8; ++r) { const int i = tid + 512 * r; LAS f32x4* pp = (LAS f32x4*)(buf + fphys(2 * i)); const f32x4 ab = *pp; const f32x4 kk = kf[i];
                    const float ax = ab.x + ab.z, ay = ab.y + ab.w, bx = ab.x - ab.z, by = ab.y - ab.w;
                    const float px = ax * kk.x - ay * kk.y, py = ax * kk.y + ay * kk.x, qx = bx * kk.z - by * kk.w, qy = bx * kk.w + by * kk.z;
                    *pp = (f32x4){px + qx, py + qy, px - qx, py - qy}; } }
            __syncthreads();
            fft_pass<true, 2>(buf, baseC, thC);
            __syncthreads();
            fft_pass<true, 34>(buf, baseB, thB);
            __syncthreads();
            { f32x2 x[16];
#pragma unroll
                for (int k = 0; k < 16; ++k) x[k] = buf[fphys(tid) + 544 * k];
                idit16(x, thA);
                const bf16* xp = ord ? x2p : x1p; const float bias = hb[ord * 1024 + c];
#pragma unroll
                for (int k = 0; k < 8; ++k) { const int t = tid + 512 * k;
                    y0[k] = bf1(xp[t]) * (x[k].x + bias * y0[k]); y1[k] = bf1(xp[bstr + t]) * (x[k].y + bias * y1[k]); } }
        }
        bf16* o0 = YT + ((size_t)b0 * 1024 + c) * SEQ;
#pragma unroll
        for (int i = 0; i < 8; ++i) { const int t = tid + 512 * i; o0[t] = (bf16)f2bf(y0[i]); o0[bstr + t] = (bf16)f2bf(y1[i]); }
    }
}
__device__ __forceinline__ void ph_scan(const Args& A, int l, int tid) {
    float* KV = (float*)(wsb() + WS_KV);
    for (int gt = blockIdx.x * 512 + tid; gt < NB * 8 * 2 * 2048; gt += gridDim.x * 512) {
        const int bhd = gt >> 11, e4 = gt & 2047, dir = bhd & 1, h = (bhd >> 1) & 7;
        const float gC = ex2(inp(I_RDEC)[(l * 2 + dir) * 8 + h] * LOG2E * 128.0f);
        f32x4* base = (f32x4*)(KV + (size_t)bhd * 34 * 8192) + e4;
        f32x4 s = (f32x4){0.f, 0.f, 0.f, 0.f};
#pragma unroll 1
        for (int sb8 = 0; sb8 < 34; sb8 += 8) {
            f32x4 tv[8];
#pragma unroll
            for (int k = 0; k < 8; ++k) { const int step = min(sb8 + k, 33); const int ci = (dir == 0) ? step : (step == 0 ? 1 : (step == 1 ? 0 : 35 - step)); tv[k] = base[(size_t)ci * 2048]; }
#pragma unroll
            for (int k = 0; k < 8; ++k) { const int step = sb8 + k; if (step < 34) { const int ci = (dir == 0) ? step : (step == 0 ? 1 : (step == 1 ? 0 : 35 - step)); base[(size_t)ci * 2048] = s; s = s * gC + tv[k]; } } }
    }
}

__device__ __forceinline__ void ph_hypost(const Args& A, LAS unsigned char* lds, int tid) {
    LAS bf16* T = (LAS bf16*)lds;
    const bf16* YT = (const bf16*)(wsb() + WS_YT); bf16* YS = (bf16*)(wsb() + WS_YS);
    for (int u = blockIdx.x; u < 1024; u += gridDim.x) {
        const int cg = u & 3, tt = (u >> 2) & 63, b = u >> 8;
        __syncthreads();
        for (int q = tid; q < 2048; q += 512) { const int c = q >> 3, t8 = q & 7;
            *(LAS v4u*)(T + c * 72 + t8 * 8) = *(const v4u*)(YT + ((size_t)b * 1024 + cg * 256 + c) * SEQ + tt * 64 + t8 * 8); }
        __syncthreads();
        const int t = tid >> 3, c32 = tid & 7;
#pragma unroll
        for (int q = 0; q < 4; ++q) { const int cb = c32 * 32 + q * 8; v4u w;
            w.x = (unsigned)T[(cb + 0) * 72 + t] | ((unsigned)T[(cb + 1) * 72 + t] << 16); w.y = (unsigned)T[(cb + 2) * 72 + t] | ((unsigned)T[(cb + 3) * 72 + t] << 16);
            w.z = (unsigned)T[(cb + 4) * 72 + t] | ((unsigned)T[(cb + 5) * 72 + t] << 16); w.w = (unsigned)T[(cb + 6) * 72 + t] | ((unsigned)T[(cb + 7) * 72 + t] << 16);
            *(v4u*)(YS + (size_t)(b * SEQ + tt * 64 + t) * 1024 + cg * 256 + cb) = w; }
    }
}
__device__ __forceinline__ void ph_ret3(const Args& A, int l, int nctx_units, LAS unsigned char* lds, int tid) {
    LAS bf16* Qs = (LAS bf16*)lds; LAS bf16* Ks = Qs + 128 * 72; LAS bf16* Vs = Ks + 128 * 72; LAS bf16* Sf = Vs + 128 * 144; LAS bf16* Sb = Sf + 128 * 72;
    const bf16* Z = (const bf16*)(wsb() + WS_Z); const float* KV = (const float*)(wsb() + WS_KV); const f32x2* rope = (const f32x2*)(wsb() + WS_ROPE);
    bf16* YS = (bf16*)(wsb() + WS_YS) + (size_t)MT * 1024;
    const int lane = tid & 63, w = tid >> 6, g = lane >> 4, li = lane & 15;
    for (int uid = blockIdx.x; uid < 1024 + nctx_units; uid += gridDim.x) {
        const bool isc = uid >= 1024; int b, h, n, ci; size_t m0;
        if (!isc) { b = uid >> 8; h = (uid >> 5) & 7; n = uid & 31; m0 = (size_t)b * SEQ + n * 128; ci = 2 + n; }
        else { const int i = uid - 1024; b = i >> 4; h = (i >> 1) & 7; n = i & 1; m0 = (size_t)ML + b * CL + n * 128; ci = n; }
        const float lgf = inp(I_RDEC)[(l * 2 + 0) * 8 + h] * LOG2E, lgb = inp(I_RDEC)[(l * 2 + 1) * 8 + h] * LOG2E;
        __syncthreads();
        { const int tok = tid >> 2, pp = tid & 3, a = (pp & 1) + ((pp >> 1) << 2);
            const int t = n * 128 + tok; const int pos = (a < 4) ? (t >> 6) : (t & 63); const f32x2* rt = rope + pos * 16 + 8 * (a & 1);
            const bf16* qr = Z + (m0 + tok) * INW + C_RQ + h * 64; const bf16* kr = Z + (m0 + tok) * INW + C_RK + h * 64;
            float lo[8], hi[8];
            unpack8(*(const v4u*)(qr + 8 * a), lo); unpack8(*(const v4u*)(qr + 8 * a + 16), hi);
            if (!isc) rope8(lo, hi, rt);
            *(LAS v4u*)(Qs + tok * 72 + 8 * a) = pack8(lo); *(LAS v4u*)(Qs + tok * 72 + 8 * a + 16) = pack8(hi);
            unpack8(*(const v4u*)(kr + 8 * a), lo); unpack8(*(const v4u*)(kr + 8 * a + 16), hi);
            if (!isc) rope8(lo, hi, rt);
#pragma unroll
            for (int e = 0; e < 8; ++e) { lo[e] *= 0.125f; hi[e] *= 0.125f; }
            *(LAS v4u*)(Ks + tok * 72 + 8 * a) = pack8(lo); *(LAS v4u*)(Ks + tok * 72 + 8 * a + 16) = pack8(hi); }
        for (int q = tid; q < 2048; q += 512) { const int r = q >> 4, ch = q & 15; *(LAS v4u*)(Vs + r * 144 + ch * 8) = *(const v4u*)(Z + (m0 + r) * INW + C_RV + h * 128 + ch * 8); }
#pragma unroll
        for (int dir = 0; dir < 2; ++dir) { const f32x4* src = (const f32x4*)(KV + ((size_t)((b * 8 + h) * 2 + dir) * 34 + ci) * 8192); LAS bf16* S = dir ? Sb : Sf;
            for (int q = tid; q < 2048; q += 512) { const f32x4 v = src[q]; v2u wv; wv.x = pk2(v.x, v.y); wv.y = pk2(v.z, v.w); *(LAS v2u*)(S + (q >> 4) * 72 + (q & 15) * 4) = wv; } }
        __syncthreads();
        const int iq = 16 * w + li;
        bf16x8 qf[2];
#pragma unroll
        for (int ks = 0; ks < 2; ++ks) qf[ks] = *(const LAS bf16x8*)(Qs + iq * 72 + 32 * ks + 8 * g);
        f32x4 s[8];
#pragma unroll
        for (int nn = 0; nn < 8; ++nn) { s[nn] = (f32x4){0.f, 0.f, 0.f, 0.f};
#pragma unroll
            for (int ks = 0; ks < 2; ++ks) s[nn] = mfma16(*(const LAS bf16x8*)(Ks + (16 * nn + li) * 72 + 32 * ks + 8 * g), qf[ks], s[nn]);
#pragma unroll
            for (int j = 0; j < 4; ++j) { const int d = iq - (16 * nn + 4 * g + j); s[nn][j] *= (d >= 0) ? ex2(lgf * (float)d) : ex2(lgb * (float)(-d)); } }
        f32x4 o[8];
#pragma unroll
        for (int nd = 0; nd < 8; ++nd) o[nd] = (f32x4){0.f, 0.f, 0.f, 0.f};
#pragma unroll
        for (int kk = 0; kk < 4; ++kk) {
            const bf16x8 pf = mk8(pk2(s[2 * kk][0], s[2 * kk][1]), pk2(s[2 * kk][2], s[2 * kk][3]), pk2(s[2 * kk + 1][0], s[2 * kk + 1][1]), pk2(s[2 * kk + 1][2], s[2 * kk + 1][3]));
#pragma unroll
            for (int nd = 0; nd < 8; ++nd) o[nd] = mfma16(tr_frag(Vs, 144, 32 * kk + 4 * g, 32 * kk + 16 + 4 * g, 16 * nd, li), pf, o[nd]); }
        const float xif = ex2(lgf * (float)(iq + 1)), xib = ex2(lgb * (float)(128 - iq));
        float ss = 0.f;
#pragma unroll
        for (int nd = 0; nd < 8; ++nd) { f32x4 tf = (f32x4){0.f, 0.f, 0.f, 0.f}, tb = (f32x4){0.f, 0.f, 0.f, 0.f};
#pragma unroll
            for (int ks = 0; ks < 2; ++ks) { tf = mfma16(*(const LAS bf16x8*)(Sf + (16 * nd + li) * 72 + 32 * ks + 8 * g), qf[ks], tf);
                tb = mfma16(*(const LAS bf16x8*)(Sb + (16 * nd + li) * 72 + 32 * ks + 8 * g), qf[ks], tb); }
            o[nd] = o[nd] + tf * xif + tb * xib;
            ss += (o[nd][0] * o[nd][0] + o[nd][1] * o[nd][1]) + (o[nd][2] * o[nd][2] + o[nd][3] * o[nd][3]); }
        ss += __shfl_xor(ss, 16); ss += __shfl_xor(ss, 32);
        const float rn = 1.0f / sqrtf(ss * (1.0f / 128.0f) + EPS);
        const size_t mrow = m0 + iq;
#pragma unroll
        for (int nd = 0; nd < 8; ++nd) { const int dv = 16 * nd + 4 * g; const v2u gv = *(const v2u*)(Z + mrow * INW + C_RG + h * 128 + dv);
            const float g0 = bflo(gv.x), g1 = bfhi(gv.x), g2 = bflo(gv.y), g3 = bfhi(gv.y);
            v2u wv; wv.x = pk2(g0 / (1.0f + __expf(-g0)) * o[nd][0] * rn, g1 / (1.0f + __expf(-g1)) * o[nd][1] * rn);
            wv.y = pk2(g2 / (1.0f + __expf(-g2)) * o[nd][2] * rn, g3 / (1.0f + __expf(-g3)) * o[nd][3] * rn);
            *(v2u*)(YS + mrow * 1024 + h * 128 + dv) = wv; }
    }
}

__device__ __forceinline__ float gelu_fx(float x) { const float x2 = x * x; const float arg = x * (x2 * (-2.0f * 1.4426950408889634f * 0.7978845608028654f * 0.044715f) + (-2.0f * 1.4426950408889634f * 0.7978845608028654f));
    return x * __builtin_amdgcn_rcpf(1.0f + __builtin_amdgcn_exp2f(arg)); }
__device__ __forceinline__ void ph_ffnfix(const Args& A, int l, int Mrows, int tid) {
    const bf16* SA = (const bf16*)(wsb() + WS_SA); const bf16* SB = (const bf16*)(wsb() + WS_SB); bf16* U = (bf16*)(wsb() + WS_U);
    const float* cw = inp(I_FFCW) + (size_t)l * 3 * DFF; const float* cb = inp(I_FFCB) + (size_t)l * DFF;
    const int nblk = Mrows / 64;
    for (int u = blockIdx.x; u < nblk * 2; u += gridDim.x) {
        const int blk = u >> 1, hi = u & 1, R = blk * 64 + (hi ? 63 : 0);
        const bool seq_first = (R < ML) ? ((R & (SEQ - 1)) == 0) : ((R & (CL - 1)) == 0), seq_last = (R < ML) ? ((R & (SEQ - 1)) == SEQ - 1) : ((R & (CL - 1)) == CL - 1);
        const bf16* pprev = hi ? SA + ((size_t)blk * 4 + 2) * DFF : SA + ((size_t)(blk - 1) * 4 + 3) * DFF;
        const bf16* pcur = SA + ((size_t)blk * 4 + (hi ? 3 : 0)) * DFF;
        const bf16* pnext = hi ? SA + ((size_t)(blk + 1) * 4 + 0) * DFF : SA + ((size_t)blk * 4 + 1) * DFF;
        const bf16* pb = SB + ((size_t)blk * 2 + hi) * DFF;
        const bool zp = (!hi && seq_first), zn = (hi && seq_last);
        for (int q = tid; q < DFF / 8; q += 512) { const int f = q * 8;
            float am[8], a0[8], aq[8], bg[8]; const v4u z4 = (v4u){0u, 0u, 0u, 0u};
            unpack8(zp ? z4 : *(const v4u*)(pprev + f), am); unpack8(*(const v4u*)(pcur + f), a0); unpack8(zn ? z4 : *(const v4u*)(pnext + f), aq); unpack8(*(const v4u*)(pb + f), bg);
            float r[8];
#pragma unroll
            for (int e = 0; e < 8; ++e) r[e] = gelu_fx(cw[f + e] * am[e] + cw[DFF + f + e] * a0[e] + cw[2 * DFF + f + e] * aq[e] + cb[f + e]) * bg[e];
            *(v4u*)(U + (size_t)R * DFF + f) = pack8(r); }
    }
}
__device__ __forceinline__ void ph_final(const Args& A, int wave, int lane) {
    const int gw = blockIdx.x * NWAVES + wave, NGW = gridDim.x * NWAVES; const float* g = inp(I_GF);
    for (int m = gw; m < ML; m += NGW) { float* xr = outb() + (size_t)m * D; f32x4 v[8]; float ss = 0.f;
#pragma unroll
        for (int j = 0; j < 8; ++j) { v[j] = *(const f32x4*)(xr + (lane + 64 * j) * 4); ss += (v[j].x * v[j].x + v[j].y * v[j].y) + (v[j].z * v[j].z + v[j].w * v[j].w); }
        const float rstd = 1.0f / sqrtf(wave_sum(ss) * (1.0f / D) + EPS);
#pragma unroll
        for (int j = 0; j < 8; ++j) { const int idx = (lane + 64 * j) * 4; *(f32x4*)(xr + idx) = v[j] * rstd * *(const f32x4*)(g + idx); }
    }
}
#ifndef SKEW_US
#define SKEW_US 0
#endif
__device__ __forceinline__ void spin_us(int us) { if (us > 0) { const unsigned long long t0 = __builtin_amdgcn_s_memrealtime(); while (__builtin_amdgcn_s_memrealtime() - t0 < (unsigned long long)us * 100ull) __builtin_amdgcn_s_sleep(8); } }
constexpr int BG_SPLIT = 22016;
constexpr int SEQ_PER_LAYER = 11, NSEQ = 1 + DEPTH * SEQ_PER_LAYER + 1;
__global__ void __launch_bounds__(NWAVES * 64, 2) fwd(Args A) {
    extern __shared__ __attribute__((aligned(16))) unsigned char lds_raw[];
    LAS unsigned char* lds = (LAS unsigned char*)lds_raw;
    volatile LAS unsigned* MISC = (volatile LAS unsigned*)(lds + MISC_OFF);
    for (int u = threadIdx.x; u < (LDS_BYTES - LDSCTL_OFF) / 4; u += NWAVES * 64) ((LAS unsigned*)(lds + LDSCTL_OFF))[u] = 0u;
    __syncthreads();
    (void)xcd_barrier_post((unsigned*)(wsb() + WS_CTL) + CW_BAR, MISC + 8);
    const int lo = A.seq_lo, hi = A.seq_hi;
#define G ((int)gridDim.x)
#define RUN(s) (lo <= (s) && (s) < hi)
#ifndef DUP
#define DUP 0
#endif
#define DUPN(id) ((((DUP) >> (id)) & 1) ? 2 : 1)
#define TID_HERE const int tid = otid(), lane = tid & 63, wave = __builtin_amdgcn_readfirstlane(tid >> 6); (void)lane; (void)wave
#ifdef ONLY
#define PH_ON(k) ((k) == ONLY)
#elif defined(SKIP)
#define PH_ON(k) ((k) != SKIP)
#else
#define PH_ON(k) true
#endif
#define SEAM(s) do { if (RUN((s) + 1)) { XcdBarrier bar_; bar_.bar = (unsigned*)(wsb() + WS_CTL) + CW_BAR; bar_.x = xb_xcc_id(); bar_.st = (volatile LAS unsigned*)(lds + MISC_OFF) + 8; xcd_barrier(bar_); if (DUPN(16) > 1) xcd_barrier(bar_); } } while (0)
#define H ((bf16*)(wsb() + WS_H))
#define Z ((bf16*)(wsb() + WS_Z))
#define ACC ((bf16*)(wsb() + WS_ACC))
#define U ((bf16*)(wsb() + WS_U))
#define YS ((bf16*)(wsb() + WS_YS))
#define XC ((float*)(wsb() + WS_XC))
#define WIN ((const bf16*)(psb(l & 1) + PS_WIN))
#define WBR ((const bf16*)(psb(l & 1) + PS_WBR))
#define WOUT ((const bf16*)(psb(l & 1) + PS_WOUT))
#define WF1 ((const bf16*)(psb(l & 1) + PS_WF1))
#define WF2 ((const bf16*)(psb(l & 1) + PS_WF2))

    if (PH_ON(100) && RUN(0)) { TID_HERE; ph_prologue(A, lds, tid); __syncthreads(); ph_convert(A, 0, 0, 0, CONV_ITEMS, (int)blockIdx.x, G, lds, wave, lane); __syncthreads(); for (int fl = 0; fl < DEPTH; ++fl) ph_filt1(A, fl, 0, (int)blockIdx.x, G, lds, tid); SEAM(0); }

    for (int l = 0; l < DEPTH; ++l) {
        const int sb = 1 + l * SEQ_PER_LAYER;
        if (hi <= sb || lo >= sb + SEQ_PER_LAYER) continue;
        const bool lastl = (l == DEPTH - 1);
        const int Mrows = lastl ? ML : MT, nctx = lastl ? 0 : 64;
#define modl ((const float*)(wsb() + WS_MOD) + (size_t)l * 5 * 12288)
#define xlat_in ((l == 0) ? inp(I_X) : (const float*)outb())
#define xctx_in ((l == 0) ? inp(I_CTX) : (const float*)XC)

        if (PH_ON(0) && RUN(sb + 0)) { TID_HERE;
            if (l == 0) ph_filt2(A, 0, 0, (int)blockIdx.x, G, lds, tid);
            else ph_convert(A, l, l & 1, 0, CONV_ITEMS, (int)blockIdx.x, G, lds, wave, lane);
            ph_norm(xlat_in, xctx_in, inp(I_G1) + (size_t)l * D, modl, 0, D, H, MT, (l > 0) ? (const float*)(wsb() + WS_SLAB) : (const float*)nullptr,
                    (const float*)(wsb() + WS_MOD) + ((size_t)(l - 1) * 5 + 4) * 12288 + 5 * D, XC, wave, lane);
            SEAM(sb + 0);
        }
        if (PH_ON(1) && RUN(sb + 1)) { TID_HERE;
            if (SKEW_US > 0 && (blockIdx.x & 8)) spin_us(SKEW_US);
            { pg8::Gemm g{H, WIN, opq(MT), opq(INW), opq(D), 0}; pg8::StaticOrder S; S.init(g.M, g.N, G, (int)blockIdx.x);
              pg8::EpiStore E{Z, INW};
              for (int r_ = 0; r_ < DUPN(15); ++r_) pg8::gemm_phase<pg8::EpiStore, pg8::StaticOrder, PG8_ALIGN, PG8_SP2>(lds, g, S, E); }
            SEAM(sb + 1);
        }
        if (PH_ON(2) && RUN(sb + 2)) { TID_HERE;
            for (int r_ = 0; r_ < DUPN(4); ++r_) ph_hyprep(A, l, lds, tid);
            for (int r_ = 0; r_ < DUPN(5); ++r_) ph_ret1(A, l, 64, lds, tid);
            for (int r_ = 0; r_ < DUPN(6); ++r_) ph_natt(A, l, nctx, lds, tid);
            for (int r_ = 0; r_ < DUPN(7); ++r_) if (!lastl) ph_hyctx(A, l, lds, tid);
            SEAM(sb + 2);
        }
        if (PH_ON(3) && RUN(sb + 3)) { TID_HERE;
#ifndef NO_D1
            for (int r_ = 0; r_ < DUPN(8); ++r_) ph_hyfft(A, l, lds, tid);
#endif
#ifndef NO_D2
            ph_scan(A, l, tid);
#endif
            SEAM(sb + 3);
        }
        if (PH_ON(4) && RUN(sb + 4)) { TID_HERE;
            for (int r_ = 0; r_ < DUPN(9); ++r_) ph_hypost(A, lds, tid);
            for (int r_ = 0; r_ < DUPN(10); ++r_) ph_ret3(A, l, nctx, lds, tid);
            SEAM(sb + 4);
        }
        if (PH_ON(5) && RUN(sb + 5)) { TID_HERE;
            __syncthreads();
            for (int r_ = 0; r_ < DUPN(13); ++r_)
            for (int i = 0; i < 3; ++i) {
                pg8::Gemm g{YS + (size_t)i * MT * 1024, WBR + (size_t)i * D * 1024, Mrows, opq(D), opq(1024), 0}; pg8::StaticOrder S; S.init(g.M, g.N, G, (int)blockIdx.x);
                pg8::EpiMerge E{ACC, Z + C_GT + i * D, INW, i == 0 ? 1 : 0};
                pg8::gemm_phase<pg8::EpiMerge, pg8::StaticOrder, PG8_ALIGN, PG8_SP2>(lds, g, S, E);
            }
            if (!lastl && blockIdx.x >= 32) { __syncthreads(); ph_filt2(A, l + 1, (l + 1) & 1, (int)blockIdx.x - 32, G - 32, lds, tid); }
            SEAM(sb + 5);
        }
        if (PH_ON(6) && RUN(sb + 6)) { TID_HERE;
            __syncthreads();
            { pg8::Gemm g{ACC, WOUT, opq(ML), opq(D), opq(D), 0}; pg8::StaticOrder S; S.init(g.M, g.N, G, (int)blockIdx.x);
              pg8::EpiResid E{xlat_in, xctx_in, outb(), XC, modl, 2 * D};
              pg8::gemm_phase<pg8::EpiResid, pg8::StaticOrder, PG8_ALIGN, PG8_SP2>(lds, g, S, E); }
            if (!lastl) { pg8::Gemm g{ACC, WOUT, opq(MT), opq(D), opq(D / NSPLIT), opq(D)}; pg8::CtxSplitOrder S{NSPLIT, D / NSPLIT, (int)blockIdx.x};
              pg8::EpiSlab E{(float*)(wsb() + WS_SLAB), D / NSPLIT};
              pg8::gemm_phase<pg8::EpiSlab, pg8::CtxSplitOrder, PG8_ALIGN, PG8_SP2>(lds, g, S, E); }
            SEAM(sb + 6);
        }
        if (PH_ON(7) && RUN(sb + 7)) { TID_HERE;
            ph_norm(outb(), xctx_in, inp(I_G2) + (size_t)l * D, modl, 3 * D, 4 * D, H, Mrows, (const float*)(wsb() + WS_SLAB), modl + (size_t)4 * 12288 + 2 * D, XC, wave, lane);
            SEAM(sb + 7);
        }
        if (PH_ON(8) && RUN(sb + 8)) { TID_HERE;
            __syncthreads();
            if (SKEW_US > 0 && (blockIdx.x & 8)) spin_us(SKEW_US);
            pg8::Gemm g{H, WF1, Mrows, opq(NFF), opq(D), 0}; pg8::StaticOrder S; S.init(g.M, g.N, G, (int)blockIdx.x);
            pg8::EpiFfn E{U, (bf16*)(wsb() + WS_SA), (bf16*)(wsb() + WS_SB), inp(I_FFCW) + (size_t)l * 3 * DFF, inp(I_FFCB) + (size_t)l * DFF};
            for (int r_ = 0; r_ < DUPN(14); ++r_) pg8::gemm_phase<pg8::EpiFfn, pg8::StaticOrder, PG8_ALIGN, PG8_SP2>(lds, g, S, E);
            SEAM(sb + 8);
        }
        if (PH_ON(9) && RUN(sb + 9)) { TID_HERE;
            for (int r_ = 0; r_ < DUPN(11); ++r_) ph_ffnfix(A, l, Mrows, tid);
            SEAM(sb + 9);
        }
        if (PH_ON(10) && RUN(sb + 10)) { TID_HERE;
            __syncthreads();
            { pg8::Gemm g{U, WF2, opq(ML), opq(D), opq(DFF), 0}; pg8::StaticOrder S; S.init(g.M, g.N, G, (int)blockIdx.x);
              pg8::EpiResid E{outb(), XC, outb(), XC, modl, 5 * D};
              pg8::gemm_phase<pg8::EpiResid, pg8::StaticOrder, PG8_ALIGN, PG8_SP2>(lds, g, S, E); }
            if (!lastl) { pg8::Gemm g{U, WF2, opq(MT), opq(D), opq(DFF / NSPLIT), opq(DFF)}; pg8::CtxSplitOrder S{NSPLIT, DFF / NSPLIT, (int)blockIdx.x};
              pg8::EpiSlab E{(float*)(wsb() + WS_SLAB), DFF / NSPLIT};
              pg8::gemm_phase<pg8::EpiSlab, pg8::CtxSplitOrder, PG8_ALIGN, PG8_SP2>(lds, g, S, E); }
            SEAM(sb + 10);
        }
    }
    if (PH_ON(101) && RUN(NSEQ - 1)) { TID_HERE; ph_final(A, wave, lane); }
#undef RUN
#undef SEAM
#undef H
#undef Z
#undef ACC
#undef U
#undef YS
#undef XC
#undef WIN
#undef WBR
#undef WOUT
#undef WF1
#undef WF2
#undef G
#undef modl
#undef xlat_in
#undef xctx_in
}

extern "C" void kernel_launch(void* const* d_in, const int* in_sizes, int n_in, void* d_out, int out_size, void* d_ws, size_t ws_size, hipStream_t stream) {
    static int grid = 0;
    if (grid == 0) {
        if (n_in != 27 || out_size != ML * D || ws_size < WS_END) { fprintf(stderr, "kernel_launch: unexpected shapes (n_in %d out %d ws %zu need %zu)\n", n_in, out_size, ws_size, (size_t)WS_END); grid = -1; return; }
        int dev = 0, cus = 0, per_cu = 0;
        if (hipGetDevice(&dev) != hipSuccess || hipDeviceGetAttribute(&cus, hipDeviceAttributeMultiprocessorCount, dev) != hipSuccess) { grid = -1; return; }
        if (hipFuncSetAttribute((const void*)fwd, hipFuncAttributeMaxDynamicSharedMemorySize, LDS_BYTES) != hipSuccess) { fprintf(stderr, "kernel_launch: hipFuncSetAttribute failed\n"); grid = -1; return; }
        if (hipOccupancyMaxActiveBlocksPerMultiprocessor(&per_cu, (const void*)fwd, NWAVES * 64, LDS_BYTES) != hipSuccess || per_cu < 1) fprintf(stderr, "kernel_launch: occupancy query says %d\n", per_cu);
        (void)hipGetLastError();
        grid = cus;
    }
    if (grid < 0) return;
    (void)hipMemsetAsync((char*)d_ws + WS_CTL, 0, CTL_ZERO_BYTES, stream);
    Args a{};
    for (int i = 0; i < 27; ++i) a.in[i] = (const float*)d_in[i];
    a.out = (float*)d_out; a.ws = (unsigned char*)d_ws;
#if MK_SINGLE
    a.seq_lo = 0; a.seq_hi = NSEQ;
    hipLaunchKernelGGL(fwd, dim3(grid), dim3(NWAVES * 64), LDS_BYTES, stream, a);
#else
    for (int s = 0; s < NSEQ; ++s) { a.seq_lo = s; a.seq_hi = s + 1; hipLaunchKernelGGL(fwd, dim3(grid), dim3(NWAVES * 64), LDS_BYTES, stream, a); }
#endif
}
```

```cpp
#include <hip/hip_runtime.h>
#include <cstdio>
#include <cstdint>
#ifndef MK_SINGLE
#define MK_SINGLE 1
#endif
namespace pg8 {
#define PG8_LAS __attribute__((address_space(3)))
typedef unsigned short bf16_t;
typedef short bf16x8 __attribute__((ext_vector_type(8)));
typedef float f32x4 __attribute__((ext_vector_type(4)));
typedef unsigned u32x4 __attribute__((ext_vector_type(4)));
constexpr int BM = 256, BK = 64, HALF = 128, HTB = HALF * BK * 2  , STAGE_BYTES = 8 * HTB, NXCD = 8, WGM = 8;

__host__ __device__ __forceinline__ int lds_byte(int r, int c) { const int st = (r >> 4) * 2 + (c >> 5), rr = r & 15, cc = c & 31, ob = rr * 64 + cc * 2; return st * 1024 + (ob ^ (((ob >> 9) & 1) << 5)); }
__host__ __device__ __forceinline__ void stage_rc(int b, int& R, int& C) { const int st = b / 1024, sb = b % 1024, swz = sb ^ (((sb >> 9) & 1) << 5); R = (st >> 1) * 16 + swz / 64; C = (st & 1) * 32 + (swz % 64) / 2; }
__host__ __device__ __forceinline__ int perm32(int rho) { const int n = rho >> 4, i = rho & 15; return 8 * (i >> 2) + 4 * n + (i & 3); }

struct Unit { int pm, pn, ko; };
struct Gemm { const bf16_t* A; const bf16_t* Bt; int M, N, K, ld; };

struct StaticOrder {
    int nM, nN, nwg, G, c;
    __host__ __device__ void init(int M, int N, int G_, int c_) { nM = M / BM; nN = N / BM; nwg = nM * nN; G = G_; c = c_; }
    __host__ __device__ bool next(int i, Unit& u) const {
        const long L = (long)i * G + c; if (L >= nwg) return false;
        int wgid = (int)L; { const int q = nwg / NXCD, r = nwg % NXCD, xcd = wgid % NXCD, off = wgid / NXCD; wgid = (xcd < r ? xcd * (q + 1) : r * (q + 1) + (xcd - r) * q) + off; }
        const int nig = WGM * nN, gid = wgid / nig, fm = gid * WGM, gsz = (nM - fm) < WGM ? (nM - fm) : WGM;
        u.pm = fm + ((wgid % nig) % gsz); u.pn = (wgid % nig) / gsz; u.ko = 0; return true;
    }
    __device__ __forceinline__ void a_ready(const Unit&) const {}
    __device__ __forceinline__ void done(const Unit&) const {}
};
__device__ __forceinline__ unsigned cvt_pk_bf16(float lo, float hi) { unsigned r; asm volatile("v_cvt_pk_bf16_f32 %0, %1, %2" : "=v"(r) : "v"(lo), "v"(hi)); return r; }
typedef float f32x2 __attribute__((ext_vector_type(2)));
__device__ __forceinline__ float bflo(unsigned w) { return __uint_as_float(w << 16); }
__device__ __forceinline__ float bfhi(unsigned w) { return __uint_as_float(w & 0xffff0000u); }
__device__ __forceinline__ float sigm(float x) { return 1.0f / (1.0f + __expf(-x)); }
struct EpiStore {
    static constexpr bool PERM = true, AFTER_DRAIN = false;
    bf16_t* O; int ldc;
    __device__ __forceinline__ void operator()(const f32x4 (&acc)[2][2][4][2], const Unit& u, int wr, int wc, int fr, int fq) const {
        const int row0 = u.pm * BM + wr * 64 + fr, col0 = u.pn * BM + wc * 32 + 8 * fq;
#pragma unroll
        for (int ai = 0; ai < 2; ++ai)
#pragma unroll
            for (int m = 0; m < 4; ++m) { bf16_t* rowp = O + (size_t)(row0 + ai * HALF + m * 16) * ldc + col0;
#pragma unroll
                for (int bj = 0; bj < 2; ++bj) { const f32x4 v0 = acc[ai][bj][m][0], v1 = acc[ai][bj][m][1];
                    u32x4 w; w.x = cvt_pk_bf16(v0[0], v0[1]); w.y = cvt_pk_bf16(v0[2], v0[3]); w.z = cvt_pk_bf16(v1[0], v1[1]); w.w = cvt_pk_bf16(v1[2], v1[3]);
                    *(u32x4*)(rowp + bj * HALF) = w; } }
    }
};
struct EpiMerge {
    static constexpr bool PERM = true, AFTER_DRAIN = false;
    bf16_t* O; const bf16_t* gate; int ldg; int first;
    __device__ __forceinline__ void operator()(const f32x4 (&acc)[2][2][4][2], const Unit& u, int wr, int wc, int fr, int fq) const {
        const int row0 = u.pm * BM + wr * 64 + fr, col0 = u.pn * BM + wc * 32 + 8 * fq;
#pragma unroll
        for (int ai = 0; ai < 2; ++ai)
#pragma unroll
            for (int m = 0; m < 4; ++m) { const size_t row = (size_t)(row0 + ai * HALF + m * 16);
#pragma unroll
                for (int bj = 0; bj < 2; ++bj) { const int col = col0 + bj * HALF;
                    const u32x4 gv = *(const u32x4*)(gate + row * ldg + col);
                    u32x4 pv = (u32x4){0u, 0u, 0u, 0u}; if (!first) pv = *(const u32x4*)(O + row * 2048 + col);
                    const f32x4 v0 = acc[ai][bj][m][0], v1 = acc[ai][bj][m][1];
                    u32x4 w;
                    w.x = cvt_pk_bf16(bflo(pv.x) + v0[0] * sigm(bflo(gv.x)), bfhi(pv.x) + v0[1] * sigm(bfhi(gv.x)));
                    w.y = cvt_pk_bf16(bflo(pv.y) + v0[2] * sigm(bflo(gv.y)), bfhi(pv.y) + v0[3] * sigm(bfhi(gv.y)));
                    w.z = cvt_pk_bf16(bflo(pv.z) + v1[0] * sigm(bflo(gv.z)), bfhi(pv.z) + v1[1] * sigm(bfhi(gv.z)));
                    w.w = cvt_pk_bf16(bflo(pv.w) + v1[2] * sigm(bflo(gv.w)), bfhi(pv.w) + v1[3] * sigm(bfhi(gv.w)));
                    *(u32x4*)(O + row * 2048 + col) = w; } }
    }
};
struct EpiResid {
    static constexpr bool PERM = false, AFTER_DRAIN = false;
    const float* base_lat; const float* base_ctx; float* out_lat; float* out_ctx; const float* modl; int goff;
    __device__ __forceinline__ void operator()(const f32x4 (&acc)[2][2][4][2], const Unit& u, int wr, int wc, int fr, int fq) const {
        const bool isctx = u.pm >= 64; const int r = isctx ? 4 : (u.pm >> 4);
        const float* gvp = modl + (size_t)r * 12288 + goff;
        const float* bs = isctx ? base_ctx : base_lat; float* os = isctx ? out_ctx : out_lat;
        const int row0 = (isctx ? u.pm - 64 : u.pm) * BM + wr * 64 + fr, col0 = u.pn * BM + wc * 32 + 4 * fq;
        f32x4 g4[2][2];
#pragma unroll
        for (int bj = 0; bj < 2; ++bj)
#pragma unroll
            for (int n = 0; n < 2; ++n) g4[bj][n] = *(const f32x4*)(gvp + col0 + bj * HALF + n * 16);
#pragma unroll
        for (int ai = 0; ai < 2; ++ai)
#pragma unroll
            for (int m = 0; m < 4; ++m) { const size_t off = (size_t)(row0 + ai * HALF + m * 16) * 2048 + col0;
#pragma unroll
                for (int bj = 0; bj < 2; ++bj)
#pragma unroll
                    for (int n = 0; n < 2; ++n) { const f32x4 b4 = *(const f32x4*)(bs + off + bj * HALF + n * 16);
                        *(f32x4*)(os + off + bj * HALF + n * 16) = b4 + g4[bj][n] * acc[ai][bj][m][n]; } }
    }
};

__device__ __forceinline__ float dpp_ror1(float v) { return __int_as_float(__builtin_amdgcn_update_dpp(0, __float_as_int(v), 0x121, 0xf, 0xf, false)); }
__device__ __forceinline__ float dpp_rol1(float v) { return __int_as_float(__builtin_amdgcn_update_dpp(0, __float_as_int(v), 0x12f, 0xf, 0xf, false)); }
__device__ __forceinline__ float gelu_fast(float x) { const float x2 = x * x; const float arg = x * (x2 * (-2.0f * 1.4426950408889634f * 0.7978845608028654f * 0.044715f) + (-2.0f * 1.4426950408889634f * 0.7978845608028654f));
    return x * __builtin_amdgcn_rcpf(1.0f + __builtin_amdgcn_exp2f(arg)); }
struct EpiFfn {
    static constexpr bool PERM = true, AFTER_DRAIN = false;
    bf16_t* U; bf16_t* SA; bf16_t* SB; const float* cw; const float* cb;
    __device__ __forceinline__ void operator()(const f32x4 (&acc)[2][2][4][2], const Unit& u, int wr, int wc, int fr, int fq) const {
        const int f0 = u.pn * 128 + wc * 32 + 8 * fq;
        f32x4 w0[2], w1[2], w2[2], bb[2];
#pragma unroll
        for (int n = 0; n < 2; ++n) { w0[n] = *(const f32x4*)(cw + f0 + 4 * n); w1[n] = *(const f32x4*)(cw + 5632 + f0 + 4 * n); w2[n] = *(const f32x4*)(cw + 2 * 5632 + f0 + 4 * n); bb[n] = *(const f32x4*)(cb + f0 + 4 * n); }
#pragma unroll
        for (int ai = 0; ai < 2; ++ai) {
            const int row0 = u.pm * BM + ai * HALF + wr * 64 + fr, blk = u.pm * 4 + ai * 2 + wr;
            f32x4 o[4][2];
#pragma unroll
            for (int n = 0; n < 2; ++n)
#pragma unroll
                for (int e = 0; e < 4; ++e) {
                    const float a0 = acc[ai][0][0][n][e], a1 = acc[ai][0][1][n][e], a2 = acc[ai][0][2][n][e], a3 = acc[ai][0][3][n][e];
                    const float r0 = dpp_ror1(a0), r1 = dpp_ror1(a1), r2 = dpp_ror1(a2), r3 = dpp_ror1(a3);
                    const float l0 = dpp_rol1(a0), l1 = dpp_rol1(a1), l2 = dpp_rol1(a2), l3 = dpp_rol1(a3);
                    const bool first = (fr == 0), last = (fr == 15);
                    const float p0 = r0, p1 = first ? r0 : r1, p2 = first ? r1 : r2, p3 = first ? r2 : r3;
                    const float n0 = last ? l1 : l0, n1 = last ? l2 : l1, n2 = last ? l3 : l2, n3 = l3;
                    const float k0 = w0[n][e], k1 = w1[n][e], k2 = w2[n][e], kb = bb[n][e];
                    o[0][n][e] = gelu_fast(k0 * p0 + k1 * a0 + k2 * n0 + kb) * acc[ai][1][0][n][e];
                    o[1][n][e] = gelu_fast(k0 * p1 + k1 * a1 + k2 * n1 + kb) * acc[ai][1][1][n][e];
                    o[2][n][e] = gelu_fast(k0 * p2 + k1 * a2 + k2 * n2 + kb) * acc[ai][1][2][n][e];
                    o[3][n][e] = gelu_fast(k0 * p3 + k1 * a3 + k2 * n3 + kb) * acc[ai][1][3][n][e];
                }
#pragma unroll
            for (int m = 0; m < 4; ++m) { u32x4 w; w.x = cvt_pk_bf16(o[m][0][0], o[m][0][1]); w.y = cvt_pk_bf16(o[m][0][2], o[m][0][3]); w.z = cvt_pk_bf16(o[m][1][0], o[m][1][1]); w.w = cvt_pk_bf16(o[m][1][2], o[m][1][3]);
                *(u32x4*)(U + (size_t)(row0 + m * 16) * 5632 + f0) = w; }
            const int sel = (fr == 0) ? 0 : (fr == 1) ? 1 : (fr == 14) ? 2 : (fr == 15) ? 3 : -1;
            if (sel >= 0) { const int m = (sel < 2) ? 0 : 3;
                const f32x4 a0 = (m == 0) ? acc[ai][0][0][0] : acc[ai][0][3][0], a1 = (m == 0) ? acc[ai][0][0][1] : acc[ai][0][3][1];
                u32x4 w; w.x = cvt_pk_bf16(a0[0], a0[1]); w.y = cvt_pk_bf16(a0[2], a0[3]); w.z = cvt_pk_bf16(a1[0], a1[1]); w.w = cvt_pk_bf16(a1[2], a1[3]);
                *(u32x4*)(SA + ((size_t)blk * 4 + sel) * 5632 + f0) = w;
                if (sel == 0 || sel == 3) { const f32x4 b0 = (m == 0) ? acc[ai][1][0][0] : acc[ai][1][3][0], b1 = (m == 0) ? acc[ai][1][0][1] : acc[ai][1][3][1];
                    u32x4 v; v.x = cvt_pk_bf16(b0[0], b0[1]); v.y = cvt_pk_bf16(b0[2], b0[3]); v.z = cvt_pk_bf16(b1[0], b1[1]); v.w = cvt_pk_bf16(b1[2], b1[3]);
                    *(u32x4*)(SB + ((size_t)blk * 2 + (sel == 0 ? 0 : 1)) * 5632 + f0) = v; } }
        }
    }
};

struct CtxSplitOrder {
    int nsplit, klen, c;
    __device__ __forceinline__ bool next(int i, Unit& u) const { if (i > 0 || c >= 32 * nsplit) return false; const int tile = c / nsplit, s = c - tile * nsplit; u.pm = 64 + (tile >> 3); u.pn = tile & 7; u.ko = s * klen; return true; }
    __device__ __forceinline__ void a_ready(const Unit&) const {}
    __device__ __forceinline__ void done(const Unit&) const {}
};
struct EpiSlab {
    static constexpr bool PERM = false, AFTER_DRAIN = false;
    float* slab; int klen;
    __device__ __forceinline__ void operator()(const f32x4 (&acc)[2][2][4][2], const Unit& u, int wr, int wc, int fr, int fq) const {
        float* os = slab + (size_t)(u.ko / klen) * 1024 * 2048;
        const int row0 = (u.pm - 64) * BM + wr * 64 + fr, col0 = u.pn * BM + wc * 32 + 4 * fq;
#pragma unroll
        for (int ai = 0; ai < 2; ++ai)
#pragma unroll
            for (int m = 0; m < 4; ++m) { const size_t off = (size_t)(row0 + ai * HALF + m * 16) * 2048 + col0;
#pragma unroll
                for (int bj = 0; bj < 2; ++bj)
#pragma unroll
                    for (int n = 0; n < 2; ++n) *(f32x4*)(os + off + bj * HALF + n * 16) = acc[ai][bj][m][n]; }
    }
};
template <class Epi, class Sched, bool ALIGN_EPI = false, bool SP2 = false>
__device__ __forceinline__ void gemm_phase(PG8_LAS unsigned char* lds, const Gemm g, const Sched& S, const Epi& E) {
    int tid_ = threadIdx.x; asm volatile("" : "+v"(tid_)); const int tid = tid_, wid = __builtin_amdgcn_readfirstlane(tid >> 6), lane = tid & 63, wr = wid >> 2, wc = wid & 3, fr = lane & 15, fq = lane >> 4;
    const int K = g.K, nt = K / BK, LD = g.ld ? g.ld : g.K;
    unsigned voffA[2], voffB[2];
#pragma unroll
    for (int i = 0; i < 2; ++i) { int R, C; stage_rc(tid * 16 + i * 8192, R, C); const int Rb = Epi::PERM ? ((R & ~31) + perm32(R & 31)) : R;
        voffA[i] = (unsigned)(R * LD + C) * 2u; voffB[i] = (unsigned)(Rb * LD + C) * 2u; }
    const size_t kstep = (size_t)(BK * 2);
    const size_t hstep = (size_t)HALF * LD * 2;
    const size_t tstep = 2 * hstep;
    const unsigned ldsw = (unsigned)wid * 1024u;
    const int aoff = lds_byte(wr * 64 + fr, fq * 8), boff = lds_byte(wc * 32 + fr, fq * 8);
#define PG8_SA(b, h) (((b) * 2 + (h)) * HTB)
#define PG8_SB(b, h) ((4 + (b) * 2 + (h)) * HTB)
#define PG8_STAGE(bufoff, gbase, voff) do { _Pragma("unroll") for (int _i = 0; _i < 2; ++_i) \
        __builtin_amdgcn_global_load_lds((const unsigned*)((const char*)(gbase) + (voff)[_i]), (PG8_LAS unsigned*)(lds + (bufoff) + ldsw + _i * 8192), 16, 0, 0); } while (0)
#define PG8_LDA(dst, b, h) do { _Pragma("unroll") for (int m = 0; m < 4; ++m) _Pragma("unroll") for (int k = 0; k < 2; ++k) dst[m][k] = *(const PG8_LAS bf16x8*)(lds + PG8_SA(b, h) + aoff + m * 2048 + k * 1024); } while (0)
#define PG8_LDB(dst, b, h) do { _Pragma("unroll") for (int n = 0; n < 2; ++n) _Pragma("unroll") for (int k = 0; k < 2; ++k) dst[n][k] = *(const PG8_LAS bf16x8*)(lds + PG8_SB(b, h) + boff + n * 2048 + k * 1024); } while (0)
#define PG8_MMA(ai, bj, At, Bt) do { __builtin_amdgcn_s_setprio(1); _Pragma("unroll") for (int m = 0; m < 4; ++m) _Pragma("unroll") for (int n = 0; n < 2; ++n) _Pragma("unroll") for (int k = 0; k < 2; ++k) \
        acc[ai][bj][m][n] = __builtin_amdgcn_mfma_f32_16x16x32_bf16(Bt[n][k], At[m][k], acc[ai][bj][m][n], 0, 0, 0); __builtin_amdgcn_s_setprio(0); } while (0)
#define PG8_WAIT_V(n) asm volatile("s_waitcnt vmcnt(" #n ")" ::: "memory")
#define PG8_WAIT_L(n) asm volatile("s_waitcnt lgkmcnt(" #n ")" ::: "memory")
#define PG8_BAR __builtin_amdgcn_s_barrier()
#define PG8_SCHED __builtin_amdgcn_sched_barrier(0)
    Unit cur, nxt; int ui = 0;
    if (!S.next(0, cur)) return;
    f32x4 acc[2][2][4][2];
#pragma unroll
    for (int a = 0; a < 2; ++a)
#pragma unroll
        for (int b = 0; b < 2; ++b)
#pragma unroll
            for (int m = 0; m < 4; ++m)
#pragma unroll
                for (int n = 0; n < 2; ++n) acc[a][b][m][n] = (f32x4){0.f, 0.f, 0.f, 0.f};
    bf16x8 At[4][2], B0[2][2], B1[2][2];
    const char* cA = (const char*)g.A + (size_t)cur.pm * tstep + (size_t)cur.ko * 2; const char* cB = (const char*)g.Bt + (size_t)cur.pn * tstep + (size_t)cur.ko * 2;
    S.a_ready(cur);
    if constexpr (SP2) {
        PG8_STAGE(PG8_SB(0, 0), cB, voffB); PG8_STAGE(PG8_SB(0, 1), cB + hstep, voffB); PG8_STAGE(PG8_SA(0, 0), cA, voffA); PG8_STAGE(PG8_SA(0, 1), cA + hstep, voffA);
        if (wr == 1) PG8_BAR;
        PG8_WAIT_V(2); PG8_BAR;
        PG8_STAGE(PG8_SB(1, 0), cB + kstep, voffB); PG8_STAGE(PG8_SA(1, 0), cA + kstep, voffA); PG8_STAGE(PG8_SB(1, 1), cB + hstep + kstep, voffB);
        PG8_WAIT_V(6); PG8_BAR;
    } else {
        PG8_STAGE(PG8_SB(0, 0), cB, voffB); PG8_STAGE(PG8_SA(0, 0), cA, voffA); PG8_STAGE(PG8_SB(0, 1), cB + hstep, voffB); PG8_STAGE(PG8_SA(0, 1), cA + hstep, voffA);
        if (wr == 1) PG8_BAR;
        PG8_WAIT_V(4); PG8_BAR;
        PG8_STAGE(PG8_SB(1, 0), cB + kstep, voffB); PG8_STAGE(PG8_SA(1, 0), cA + kstep, voffA); PG8_STAGE(PG8_SB(1, 1), cB + hstep + kstep, voffB);
        PG8_WAIT_V(6); PG8_BAR;
    }
    for (;;) {
        const bool has_next = S.next(ui + 1, nxt);
        const char* nA = has_next ? (const char*)g.A + (size_t)nxt.pm * tstep + (size_t)nxt.ko * 2 : cA; const char* nB = has_next ? (const char*)g.Bt + (size_t)nxt.pn * tstep + (size_t)nxt.ko * 2 : cB;
        for (int t = 0; t < nt; t += 2) {
            const bool last = (t == nt - 2);
            const char* a1 = cA + (size_t)(t + 1) * kstep;
            const char* a2 = last ? nA : cA + (size_t)(t + 2) * kstep; const char* b2 = last ? nB : cB + (size_t)(t + 2) * kstep;
            const char* a3 = a2 + kstep; const char* b3 = b2 + kstep;
            if (last && has_next) S.a_ready(nxt);
            if constexpr (SP2) {
            PG8_LDB(B0, 0, 0); PG8_LDB(B1, 0, 1); PG8_SCHED; PG8_LDA(At, 0, 0); PG8_STAGE(PG8_SA(1, 1), a1 + hstep, voffA);
            PG8_WAIT_V(8); PG8_WAIT_L(0); PG8_BAR; PG8_MMA(0, 0, At, B0); PG8_MMA(0, 1, At, B1); PG8_BAR; PG8_SCHED;
            PG8_LDA(At, 0, 1); PG8_STAGE(PG8_SB(0, 0), b2, voffB); PG8_STAGE(PG8_SB(0, 1), b2 + hstep, voffB); PG8_STAGE(PG8_SA(0, 0), a2, voffA);
            PG8_WAIT_V(8); PG8_WAIT_L(0); PG8_BAR; PG8_MMA(1, 0, At, B0); PG8_MMA(1, 1, At, B1); PG8_BAR; PG8_SCHED;
            PG8_LDB(B0, 1, 0); PG8_LDB(B1, 1, 1); PG8_SCHED; PG8_LDA(At, 1, 0); PG8_STAGE(PG8_SA(0, 1), a2 + hstep, voffA);
            PG8_WAIT_V(8); PG8_WAIT_L(0); PG8_BAR; PG8_MMA(0, 0, At, B0); PG8_MMA(0, 1, At, B1); PG8_BAR; PG8_SCHED;
            PG8_LDA(At, 1, 1); PG8_STAGE(PG8_SB(1, 0), b3, voffB); PG8_STAGE(PG8_SB(1, 1), b3 + hstep, voffB); PG8_STAGE(PG8_SA(1, 0), a3, voffA);
            PG8_WAIT_V(8); PG8_WAIT_L(0); PG8_BAR; PG8_MMA(1, 0, At, B0); PG8_MMA(1, 1, At, B1); PG8_BAR; PG8_SCHED;
            } else {
            PG8_LDB(B0, 0, 0); PG8_SCHED; PG8_LDA(At, 0, 0); PG8_STAGE(PG8_SA(1, 1), a1 + hstep, voffA);
            PG8_WAIT_L(8); PG8_BAR; PG8_WAIT_L(0); PG8_MMA(0, 0, At, B0); PG8_BAR; PG8_SCHED;
            PG8_LDB(B1, 0, 1); PG8_STAGE(PG8_SB(0, 0), b2, voffB);
            PG8_BAR; PG8_WAIT_L(0); PG8_MMA(0, 1, At, B1); PG8_BAR;
            PG8_LDA(At, 0, 1); PG8_STAGE(PG8_SA(0, 0), a2, voffA);
            PG8_BAR; PG8_WAIT_L(0); PG8_MMA(1, 0, At, B0); PG8_BAR; PG8_SCHED;
            PG8_STAGE(PG8_SB(0, 1), b2 + hstep, voffB);
            PG8_WAIT_V(6); PG8_BAR; PG8_MMA(1, 1, At, B1); PG8_BAR;
            PG8_LDB(B0, 1, 0); PG8_SCHED; PG8_LDA(At, 1, 0); PG8_STAGE(PG8_SA(0, 1), a2 + hstep, voffA);
            PG8_WAIT_L(8); PG8_BAR; PG8_WAIT_L(0); PG8_MMA(0, 0, At, B0); PG8_BAR; PG8_SCHED;
            PG8_LDB(B1, 1, 1); PG8_STAGE(PG8_SB(1, 0), b3, voffB);
            PG8_BAR; PG8_WAIT_L(0); PG8_MMA(0, 1, At, B1); PG8_BAR;
            PG8_LDA(At, 1, 1); PG8_STAGE(PG8_SA(1, 0), a3, voffA);
            PG8_BAR; PG8_WAIT_L(0); PG8_MMA(1, 0, At, B0); PG8_BAR; PG8_SCHED;
            PG8_STAGE(PG8_SB(1, 1), b3 + hstep, voffB);
            PG8_WAIT_V(6); PG8_BAR; PG8_MMA(1, 1, At, B1); PG8_BAR;
            }
        }
        if constexpr (ALIGN_EPI) { if (wr == 0) PG8_BAR; }
        if constexpr (!Epi::AFTER_DRAIN) { E(acc, cur, wr, wc, fr, fq); S.done(cur); }
        if (!has_next) break;
#pragma unroll
        for (int a = 0; a < 2; ++a)
#pragma unroll
            for (int b = 0; b < 2; ++b)
#pragma unroll
                for (int m = 0; m < 4; ++m)
#pragma unroll
                    for (int n = 0; n < 2; ++n) acc[a][b][m][n] = (f32x4){0.f, 0.f, 0.f, 0.f};
        cur = nxt; cA = nA; cB = nB; ++ui;
        if constexpr (ALIGN_EPI) { if (wr == 1) PG8_BAR; }
    }
    PG8_WAIT_V(0);
    if constexpr (!ALIGN_EPI) { if (wr == 0) PG8_BAR; }
    PG8_BAR;
    if constexpr (Epi::AFTER_DRAIN) { E.fused(acc, cur, wr, wc, fr, fq, lds, wid, lane); S.done(cur); }
#undef PG8_SA
#undef PG8_SB
#undef PG8_STAGE
#undef PG8_LDA
#undef PG8_LDB
#undef PG8_MMA
#undef PG8_WAIT_V
#undef PG8_WAIT_L
#undef PG8_BAR
#undef PG8_SCHED
}
}
#ifndef PG8_SP2
#define PG8_SP2 true
#endif
#ifndef PG8_ALIGN
#define PG8_ALIGN true
#endif
constexpr int D = 2048, NB = 4, SEQ = 4096, CL = 256, DEPTH = 4;
constexpr int ML = NB * SEQ, MC = NB * CL, MT = ML + MC;
constexpr int INW = 15360, DFF = 5632, NFF = 2 * DFF;
constexpr int C_RK = 0, C_RV = 512, C_NK = 1536, C_NV = 2560, C_RQ = 3584, C_RG = 4096, C_NQ = 5120, C_HY = 6144, C_GT = 9216;
constexpr float EPS = 1e-6f;
constexpr int NWAVES = 8;
constexpr size_t al256(size_t x) { return (x + 255) & ~(size_t)255; }
constexpr size_t WS_CTL = 0, CTL_ZERO_BYTES = 1u << 20;
constexpr size_t WS_MOD = WS_CTL + CTL_ZERO_BYTES;
constexpr size_t WS_ROPE = WS_MOD + al256((size_t)4 * 5 * 12288 * 4);
constexpr size_t PS_FH2 = 0;
constexpr size_t PS_FH2B = PS_FH2 + al256((size_t)4352 * 64 * 4);
constexpr size_t PS_TAPC = PS_FH2B + al256((size_t)4352 * 64 * 2);
constexpr size_t PS_KF = PS_TAPC + al256((size_t)2 * 2 * 1024 * 256 * 4);
constexpr size_t PS_WIN = PS_KF + al256((size_t)2 * 1024 * 8192 * 8);
constexpr size_t PS_WBR = PS_WIN + al256((size_t)INW * D * 2);
constexpr size_t PS_WOUT = PS_WBR + al256((size_t)3 * D * 1024 * 2);
constexpr size_t PS_WF1 = PS_WOUT + al256((size_t)D * D * 2);
constexpr size_t PS_WF2 = PS_WF1 + al256((size_t)NFF * D * 2);
constexpr size_t PS_BYTES = PS_WF2 + al256((size_t)D * DFF * 2);
constexpr size_t WS_PSET = WS_ROPE + al256(64 * 16 * 8);
constexpr size_t WS_XC = WS_PSET + 2 * PS_BYTES;
constexpr size_t WS_H = WS_XC + al256((size_t)MC * D * 4);
constexpr size_t WS_Z = WS_H + al256((size_t)MT * D * 2);
constexpr size_t WS_HYT = WS_Z + al256((size_t)MT * INW * 2);
constexpr size_t WS_YT = WS_HYT + al256((size_t)3 * NB * 1024 * SEQ * 2);
constexpr size_t WS_YS = WS_YT + al256((size_t)NB * 1024 * SEQ * 2);
constexpr size_t WS_ACC = WS_YS + al256((size_t)3 * MT * 1024 * 2);
constexpr size_t WS_U = WS_ACC + al256((size_t)MT * D * 2);
constexpr size_t WS_KV = WS_U + al256((size_t)MT * DFF * 2);
constexpr size_t WS_SA = WS_KV + al256((size_t)NB * 8 * 2 * 34 * 8192 * 4);
constexpr size_t WS_SB = WS_SA + al256((size_t)272 * 4 * DFF * 2);
constexpr size_t WS_SLAB = WS_SB + al256((size_t)272 * 2 * DFF * 2);
constexpr size_t WS_FB4 = WS_SLAB + al256((size_t)4 * MC * D * 4);
constexpr size_t WS_END = WS_FB4 + al256((size_t)4 * 4352 * 64 * 2);
constexpr int NSPLIT = 4;
constexpr int CW_BAR = 4096;
constexpr int RING_BYTES = 131072, LDSCTL_OFF = RING_BYTES, MISC_OFF = LDSCTL_OFF + 320, LDS_BYTES = 147456;

#define GAS __attribute__((address_space(1)))
#define LAS __attribute__((address_space(3)))
typedef unsigned short bf16;
typedef unsigned v4u __attribute__((ext_vector_type(4)));
typedef unsigned v2u __attribute__((ext_vector_type(2)));
typedef float f32x4 __attribute__((ext_vector_type(4)));
typedef float f32x2 __attribute__((ext_vector_type(2)));
typedef short bf16x8 __attribute__((ext_vector_type(8)));
typedef GAS unsigned gu32;
#define LDS_WAIT() asm volatile("s_waitcnt lgkmcnt(0)" ::: "memory")
__device__ __forceinline__ unsigned f2bf(float f) { unsigned u = __builtin_bit_cast(unsigned, f); return (u + 0x7fffu + ((u >> 16) & 1u)) >> 16; }
__device__ __forceinline__ unsigned pk2(float lo, float hi) { return f2bf(lo) | (f2bf(hi) << 16); }
__device__ __forceinline__ float bflo(unsigned w) { return __uint_as_float(w << 16); }
__device__ __forceinline__ float bfhi(unsigned w) { return __uint_as_float(w & 0xffff0000u); }
__device__ __forceinline__ float bf1(bf16 b) { return __uint_as_float(((unsigned)b) << 16); }
__device__ __forceinline__ bf16x8 mk8(unsigned a, unsigned b, unsigned c, unsigned d) { v4u v = (v4u){a, b, c, d}; return __builtin_bit_cast(bf16x8, v); }
__device__ __forceinline__ f32x4 mfma16(bf16x8 a, bf16x8 b, f32x4 c) { return __builtin_amdgcn_mfma_f32_16x16x32_bf16(a, b, c, 0, 0, 0); }
__device__ __forceinline__ float sin_rev(float r) { return __builtin_amdgcn_sinf(r - floorf(r)); }
__device__ __forceinline__ float cos_rev(float r) { return __builtin_amdgcn_cosf(r - floorf(r)); }
__device__ __forceinline__ float sin_rad(float x) { return sin_rev(x * 0.15915494309189535f); }
__device__ __forceinline__ float ex2(float x) { return __builtin_amdgcn_exp2f(x); }
__device__ __forceinline__ float wave_sum(float v) {
#pragma unroll
    for (int o = 1; o < 64; o <<= 1) v += __shfl_xor(v, o);
    return v;
}
__device__ __forceinline__ int otid() { int t = threadIdx.x; asm volatile("" : "+v"(t)); return t; }
__device__ __forceinline__ int opq(int v) { asm volatile("" : "+s"(v)); return v; }
#define XB_TMO      128
#define XB_XCNT(j)  (256  + 64 * (j))
#define XB_XSUB(j)  (1280 + 64 * (j))
#define XB_XGEN(j)  (2304 + 64 * (j))
#define XB_TOP      3328
#define XB_TOPGEN   3392
#define XCD_BAR_WORDS 3456
#define XB_SPIN_CAP (1u << 18)

__device__ __forceinline__ unsigned xb_ld(unsigned* p)              { return __hip_atomic_load(p, __ATOMIC_RELAXED, __HIP_MEMORY_SCOPE_AGENT); }
__device__ __forceinline__ unsigned xb_add(unsigned* p, unsigned v) { return __hip_atomic_fetch_add(p, v, __ATOMIC_RELAXED, __HIP_MEMORY_SCOPE_AGENT); }
__device__ __forceinline__ unsigned xb_xcc_id() { return (unsigned)__builtin_amdgcn_s_getreg((3 << 11) | 20) & 0xFu; }
#define XB_SPIN(cond, bar) do { unsigned _sp = 0; while (cond) { __builtin_amdgcn_s_sleep(1); \
    if ((++_sp & 255u) == 0u) { if (xb_ld(&(bar)[XB_TMO])) break; if (_sp > XB_SPIN_CAP) { atomicAdd(&(bar)[XB_TMO], 1u); break; } } } } while (0)

struct XcdBarrier {
    unsigned* bar; unsigned x;
    volatile LAS unsigned* st;
};

__device__ __forceinline__ XcdBarrier xcd_barrier_post(unsigned* bar, volatile LAS unsigned* st) {
    XcdBarrier b; b.bar = bar; b.x = xb_xcc_id(); b.st = st;
    if (threadIdx.x == 0) (void)xb_add(&bar[XB_XCNT(b.x)], 1u);
    return b;
}
__device__ __forceinline__ void xcd_barrier_complete(unsigned* bar, unsigned x, unsigned& nloc, unsigned& nx) {
    const unsigned G = gridDim.x * gridDim.y * gridDim.z;
    unsigned sum, cnt, mine, sp = 0u;
    for (;;) {
        sum = 0u; cnt = 0u; mine = 0u;
#pragma unroll
        for (unsigned j = 0; j < 16; ++j) { const unsigned c = xb_ld(&bar[XB_XCNT(j)]); sum += c; cnt += (c > 0u) ? 1u : 0u; mine = (j == x) ? c : mine; }
        if (sum == G) break;
        __builtin_amdgcn_s_sleep(1);
        if ((++sp & 255u) == 0u) { if (xb_ld(&bar[XB_TMO])) break; if (sp > XB_SPIN_CAP) { atomicAdd(&bar[XB_TMO], 1u); break; } }
    }
    nloc = mine > 0u ? mine : 1u; nx = cnt > 0u ? cnt : 1u;
}

__device__ __forceinline__ void xcd_barrier(const XcdBarrier& b) {
    asm volatile("s_waitcnt vmcnt(0)" ::: "memory");
    __syncthreads();
    if (threadIdx.x == 0) {
        unsigned* bar = b.bar;
        __builtin_amdgcn_s_waitcnt(0);
        unsigned nloc = b.st[0], nx = b.st[1];
        if (nloc == 0u) { xcd_barrier_complete(bar, b.x, nloc, nx); b.st[0] = nloc; b.st[1] = nx; }
        const unsigned old = xb_add(&bar[XB_XSUB(b.x)], 1u);
        const unsigned gen = old / nloc;
        if (old + 1u == (gen + 1u) * nloc) {
            __builtin_amdgcn_fence(__ATOMIC_RELEASE, "agent");
            asm volatile("s_waitcnt vmcnt(0)" ::: "memory");
            const unsigned og = xb_add(&bar[XB_TOP], 1u);
            const unsigned tg = og / nx;
            if (og + 1u == (tg + 1u) * nx) xb_add(&bar[XB_TOPGEN], 1u);
            else XB_SPIN(xb_ld(&bar[XB_TOPGEN]) == tg, bar);
            __builtin_amdgcn_fence(__ATOMIC_ACQUIRE, "agent");
            xb_add(&bar[XB_XGEN(b.x)], 1u);
            asm volatile("s_waitcnt vmcnt(0)" ::: "memory");
        } else {
            XB_SPIN(xb_ld(&bar[XB_XGEN(b.x)]) == gen, bar);
            __builtin_amdgcn_fence(__ATOMIC_ACQUIRE, "agent");
            asm volatile("s_waitcnt vmcnt(0)" ::: "memory");
        }
    }
    __syncthreads();
}
__device__ __forceinline__ void p0_transpose_item(const float* W, int K, int N, bf16* WT, int row_off, LAS float* scr, int item, int lane) {
    const int nblk = N / 32, kb = item / nblk, nb = item % nblk, k0 = 64 * kb, n0 = 32 * nb;
#pragma unroll 8
    for (int i = 0; i < 32; ++i) { const int kk = 2 * i + (lane >> 5); scr[kk * 33 + (lane & 31)] = __builtin_nontemporal_load(W + (size_t)(k0 + kk) * N + n0 + (lane & 31)); }
    LDS_WAIT(); asm volatile("" ::: "memory");
    const int c = lane & 7;
#pragma unroll
    for (int j = 0; j < 4; ++j) { const int n = (lane >> 3) + 8 * j; const LAS float* s = scr + (8 * c) * 33 + n;
        v4u o; o.x = pk2(s[0 * 33], s[1 * 33]); o.y = pk2(s[2 * 33], s[3 * 33]); o.z = pk2(s[4 * 33], s[5 * 33]); o.w = pk2(s[6 * 33], s[7 * 33]);
        __builtin_nontemporal_store(o, (GAS v4u*)(WT + (size_t)(row_off + n0 + n) * K + k0 + 8 * c)); }
    LDS_WAIT(); asm volatile("" ::: "memory");
}
struct Args { const float* in[27]; float* out; unsigned char* ws; int seq_lo, seq_hi; };
__device__ __forceinline__ const float* inp(int i) { const char* ka = (const char*)__builtin_amdgcn_kernarg_segment_ptr(); int off = i * 8; asm volatile("" : "+s"(off)); return *(const float* const*)(ka + off); }
__device__ __forceinline__ unsigned char* wsb() { const char* ka = (const char*)__builtin_amdgcn_kernarg_segment_ptr(); int off = 27 * 8 + 8; asm volatile("" : "+s"(off)); return *(unsigned char* const*)(ka + off); }
__device__ __forceinline__ float* outb() { const char* ka = (const char*)__builtin_amdgcn_kernarg_segment_ptr(); int off = 27 * 8; asm volatile("" : "+s"(off)); return *(float* const*)(ka + off); }
__device__ __forceinline__ unsigned char* psb(int set) { return wsb() + WS_PSET + (size_t)set * PS_BYTES; }
enum { I_X = 0, I_C, I_CTX, I_CCTX, I_WMOD, I_BMOD, I_G1, I_G2, I_WIN, I_HCW, I_HCB, I_FW1, I_FB1, I_FW2, I_FB2, I_FW3, I_FFQ, I_HBIAS, I_RDEC, I_RPB, I_WBR, I_WOUT, I_FFW1, I_FFCW, I_FFCB, I_FFW2, I_GF };

__device__ __forceinline__ void ph_prologue(const Args& A, LAS unsigned char* lds, int tid) {
    LAS float* sc = (LAS float*)lds;
    LAS float* red = sc + 5 * 2048;
    const float* c = inp(I_C); const float* cc = inp(I_CCTX);
    for (int i = tid; i < 5 * 2048; i += 512) { const int r = i >> 11, k = i & 2047; const float v = (r < 4) ? c[r * 2048 + k] : cc[k]; sc[i] = v / (1.0f + __expf(-v)); }
    __syncthreads();
    float* mod = (float*)(wsb() + WS_MOD);
    const int kq = tid >> 6, col = tid & 63;
    for (int u = blockIdx.x; u < DEPTH * 192; u += gridDim.x) {
        const int l = u / 192, n0 = (u % 192) * 64;
        const float* W = inp(I_WMOD) + (size_t)l * 2048 * 12288 + n0 + col;
        float a0 = 0.f, a1 = 0.f, a2 = 0.f, a3 = 0.f, a4 = 0.f;
        for (int k = kq * 256; k < kq * 256 + 256; ++k) { const float w = W[(size_t)k * 12288];
            a0 += sc[k] * w; a1 += sc[2048 + k] * w; a2 += sc[4096 + k] * w; a3 += sc[6144 + k] * w; a4 += sc[8192 + k] * w; }
        red[(kq * 5 + 0) * 64 + col] = a0; red[(kq * 5 + 1) * 64 + col] = a1; red[(kq * 5 + 2) * 64 + col] = a2; red[(kq * 5 + 3) * 64 + col] = a3; red[(kq * 5 + 4) * 64 + col] = a4;
        __syncthreads();
        if (tid < 320) { const int r = tid >> 6; float s = inp(I_BMOD)[l * 12288 + n0 + col];
#pragma unroll
            for (int q = 0; q < 8; ++q) s += red[(q * 5 + r) * 64 + col];
            mod[((size_t)l * 5 + r) * 12288 + n0 + col] = s; }
        __syncthreads();
    }
    if (blockIdx.x == 0) { f32x2* rope = (f32x2*)(wsb() + WS_ROPE);
        for (int i = tid; i < 1024; i += 512) { const int pos = i >> 4, j = i & 15; const float inv = exp2f(-(float)j * (13.287712379549449f / 16.0f));
            const float rev = (float)pos * inv * 0.15915494309189535f; rope[i] = (f32x2){cos_rev(rev), sin_rev(rev)}; } }
}

__device__ __forceinline__ void ph_convert(const Args& A, int l, int set, int it_lo, int it_hi, int wk, int nwk, LAS unsigned char* lds, int wave, int lane) {
    LAS float* scr = (LAS float*)(lds + wave * 16384);
    const int gw = wk * NWAVES + wave, NGW = nwk * NWAVES;
    constexpr int I_IN = (D / 64) * (INW / 32), I_BR = (1024 / 64) * (D / 32), I_OUT = (D / 64) * (D / 32), I_F1 = (D / 64) * (NFF / 32);
    const float* win = inp(I_WIN) + (size_t)l * D * INW; const float* wbr = inp(I_WBR) + (size_t)l * 3 * 1024 * D; const float* wout = inp(I_WOUT) + (size_t)l * D * D;
    const float* wf1 = inp(I_FFW1) + (size_t)l * D * NFF; const float* wf2 = inp(I_FFW2) + (size_t)l * DFF * D;
    unsigned char* ps = psb(set);
    bf16* WIN = (bf16*)(ps + PS_WIN); bf16* WBR = (bf16*)(ps + PS_WBR); bf16* WOUT = (bf16*)(ps + PS_WOUT); bf16* WF1 = (bf16*)(ps + PS_WF1); bf16* WF2 = (bf16*)(ps + PS_WF2);
    for (int it = it_lo + gw; it < it_hi; it += NGW) {
        int r = it;
        if (r < I_IN) { p0_transpose_item(win, D, INW, WIN, 0, scr, r, lane); continue; } r -= I_IN;
        if (r < I_BR) { p0_transpose_item(wbr, 1024, D, WBR, 0, scr, r, lane); continue; } r -= I_BR;
        if (r < I_BR) { p0_transpose_item(wbr + (size_t)1024 * D, 1024, D, WBR + (size_t)D * 1024, 0, scr, r, lane); continue; } r -= I_BR;
        if (r < I_BR) { p0_transpose_item(wbr + (size_t)2 * 1024 * D, 1024, D, WBR + (size_t)2 * D * 1024, 0, scr, r, lane); continue; } r -= I_BR;
        if (r < I_OUT) { p0_transpose_item(wout, D, D, WOUT, 0, scr, r, lane); continue; } r -= I_OUT;
        if (r < I_F1) { const int n0 = (r % (NFF / 32)) * 32, f0 = (n0 < DFF) ? n0 : n0 - DFF, nrow = 256 * (f0 >> 7) + ((n0 < DFF) ? 0 : 128) + (f0 & 127);
            p0_transpose_item(wf1, D, NFF, WF1, nrow - n0, scr, r, lane); continue; } r -= I_F1;
        p0_transpose_item(wf2, DFF, D, WF2, 0, scr, r, lane);
    }
}
constexpr int CONV_ITEMS = (D / 64) * (INW / 32) + 3 * (1024 / 64) * (D / 32) + (D / 64) * (D / 32) + (D / 64) * (NFF / 32) + (DFF / 64) * (D / 32);
__device__ __forceinline__ void ph_filt1(const Args& A, int l, int set, int wk, int nwk, LAS unsigned char* lds, int tid) {
    LAS float* feat = (LAS float*)lds;
    LAS float* h1 = feat + 8 * 33;
    const float* w1 = inp(I_FW1) + (size_t)l * 33 * 64; const float* b1 = inp(I_FB1) + l * 64; const float* w2 = inp(I_FW2) + (size_t)l * 64 * 64; const float* b2 = inp(I_FB2) + l * 64;
    const float* fq = inp(I_FFQ) + l * 64; bf16* FH2B = (bf16*)(wsb() + WS_FB4) + (size_t)l * 4352 * 64;
    const int pl = tid >> 6, o = tid & 63;
    for (int u = wk; u < 544; u += nwk) {
        const int pos = u * 8 + pl; const bool isc = pos >= 4096; const int Lf = isc ? 256 : 4096, tp = isc ? pos - 4096 : pos;
        if (o < 33) { float f;
            if (o == 0) f = (float)tp / (float)(Lf - 1);
            else { const int i = (o - 1) & 15; const float fr = 1e-4f + (float)i * ((15.0f - 1e-4f) / 15.0f); const float rev = fr * (float)tp / (float)Lf; f = (o <= 16) ? cos_rev(rev) : -sin_rev(rev); }
            feat[pl * 33 + o] = f; }
        __syncthreads();
        float a = b1[o];
#pragma unroll 3
        for (int i = 0; i < 33; ++i) a += feat[pl * 33 + i] * w1[i * 64 + o];
        h1[pl * 64 + o] = sin_rad(fq[o] * a);
        __syncthreads();
        float b = b2[o];
#pragma unroll 4
        for (int j = 0; j < 64; ++j) b += h1[pl * 64 + j] * w2[j * 64 + o];
        { const float hv = sin_rad(fq[o] * b); FH2B[(size_t)pos * 64 + o] = (bf16)f2bf(hv); }
        __syncthreads();
    }
}
__device__ __forceinline__ void ph_norm(const float* xlat, const float* xctx, const float* g, const float* modl, int sh_off, int sc_off, bf16* H, int Mrows, const float* slab, const float* sgate, float* xc_out, int wave, int lane) {
    const int gw = blockIdx.x * NWAVES + wave, NGW = gridDim.x * NWAVES;
    for (int m = gw; m < Mrows; m += NGW) {
        const float* xr; int r; const bool isc = m >= ML;
        if (!isc) { xr = xlat + (size_t)m * D; r = m >> 12; } else { xr = xctx + (size_t)(m - ML) * D; r = 4; }
        const float* mv = modl + (size_t)r * 12288;
        f32x4 v[8]; float ss = 0.f;
#pragma unroll
        for (int j = 0; j < 8; ++j) { const int idx = (lane + 64 * j) * 4; v[j] = *(const f32x4*)(xr + idx);
            if (isc && slab) { const float* sp = slab + (size_t)(m - ML) * D + idx; f32x4 p = *(const f32x4*)sp;
#pragma unroll
                for (int q = 1; q < NSPLIT; ++q) p = p + *(const f32x4*)(sp + (size_t)q * MC * D);
                v[j] = v[j] + *(const f32x4*)(sgate + idx) * p; *(f32x4*)(xc_out + (size_t)(m - ML) * D + idx) = v[j]; }
            ss += (v[j].x * v[j].x + v[j].y * v[j].y) + (v[j].z * v[j].z + v[j].w * v[j].w); }
        const float rstd = 1.0f / sqrtf(wave_sum(ss) * (1.0f / D) + EPS);
#pragma unroll
        for (int j = 0; j < 8; ++j) { const int idx = (lane + 64 * j) * 4;
            const f32x4 gg = *(const f32x4*)(g + idx), sh = *(const f32x4*)(mv + sh_off + idx), sc = *(const f32x4*)(mv + sc_off + idx);
            const f32x4 y = v[j] * rstd * gg * (sc + 1.0f) + sh;
            v2u w; w.x = pk2(y.x, y.y); w.y = pk2(y.z, y.w);
            *(v2u*)(H + (size_t)m * D + idx) = w; }
    }
}

__device__ __forceinline__ int fphys(int i) { return i + 2 * (i >> 5); }
__device__ __forceinline__ void bfly_dif(f32x2& a, f32x2& b, float c, float s) { const f32x2 u = a, v = b; a = u + v; const f32x2 d = u - v; b = __builtin_elementwise_fma(d.yx, (f32x2){s, -s}, d * (f32x2){c, c}); }
__device__ __forceinline__ void bfly_idit(f32x2& a, f32x2& b, float c, float s) { const f32x2 u = a, q = b; const f32x2 v = __builtin_elementwise_fma(q.yx, (f32x2){-s, s}, q * (f32x2){c, c}); a = u + v; b = u - v; }
template <bool ZHI> __device__ __forceinline__ void dif16(f32x2 (&x)[16], float th) {
    asm volatile("" : "+v"(th));
#pragma unroll
    for (int k = 0; k < 8; ++k) { const float fr = th + (float)k * 0.0625f; const float c = __builtin_amdgcn_cosf(fr), s = __builtin_amdgcn_sinf(fr);
        if (ZHI) { const f32x2 u = x[k]; x[k + 8] = (f32x2){u.x * c + u.y * s, u.y * c - u.x * s}; } else bfly_dif(x[k], x[k + 8], c, s); }
#pragma unroll
    for (int k = 0; k < 4; ++k) { const float fr = 2.0f * th + (float)k * 0.125f; const float c = __builtin_amdgcn_cosf(fr), s = __builtin_amdgcn_sinf(fr);
        bfly_dif(x[k], x[k + 4], c, s); bfly_dif(x[8 + k], x[12 + k], c, s); }
#pragma unroll
    for (int k = 0; k < 2; ++k) { const float fr = 4.0f * th + (float)k * 0.25f; const float c = __builtin_amdgcn_cosf(fr), s = __builtin_amdgcn_sinf(fr);
#pragma unroll
        for (int b = 0; b < 16; b += 4) bfly_dif(x[b + k], x[b + k + 2], c, s); }
    { const float fr = 8.0f * th; const float c = __builtin_amdgcn_cosf(fr), s = __builtin_amdgcn_sinf(fr);
#pragma unroll
        for (int b = 0; b < 16; b += 2) bfly_dif(x[b], x[b + 1], c, s); }
}
__device__ __forceinline__ void idit16(f32x2 (&x)[16], float th) {
    asm volatile("" : "+v"(th));
    { const float fr = 8.0f * th; const float c = __builtin_amdgcn_cosf(fr), s = __builtin_amdgcn_sinf(fr);
#pragma unroll
        for (int b = 0; b < 16; b += 2) bfly_idit(x[b], x[b + 1], c, s); }
#pragma unroll
    for (int k = 0; k < 2; ++k) { const float fr = 4.0f * th + (float)k * 0.25f; const float c = __builtin_amdgcn_cosf(fr), s = __builtin_amdgcn_sinf(fr);
#pragma unroll
        for (int b = 0; b < 16; b += 4) bfly_idit(x[b + k], x[b + k + 2], c, s); }
#pragma unroll
    for (int k = 0; k < 4; ++k) { const float fr = 2.0f * th + (float)k * 0.125f; const float c = __builtin_amdgcn_cosf(fr), s = __builtin_amdgcn_sinf(fr);
        bfly_idit(x[k], x[k + 4], c, s); bfly_idit(x[8 + k], x[12 + k], c, s); }
#pragma unroll
    for (int k = 0; k < 8; ++k) { const float fr = th + (float)k * 0.0625f; const float c = __builtin_amdgcn_cosf(fr), s = __builtin_amdgcn_sinf(fr); bfly_idit(x[k], x[k + 8], c, s); }
}
template <bool INV, int PSTRIDE> __device__ __forceinline__ void fft_pass(LAS f32x2* buf, int base, float th) {
    LAS f32x2* p = buf + fphys(base);
    f32x2 x[16];
#pragma unroll
    for (int k = 0; k < 16; ++k) x[k] = p[k * PSTRIDE];
    if (INV) idit16(x, th); else dif16<false>(x, th);
#pragma unroll
    for (int k = 0; k < 16; ++k) p[k * PSTRIDE] = x[k];
}
constexpr int FFT_LDS_BYTES = (8192 + 512 + 8) * 8;
__device__ __forceinline__ float block_sum(float v, LAS float* red, int tid) {
    v = wave_sum(v);
    __syncthreads();
    if ((tid & 63) == 0) red[tid >> 6] = v;
    __syncthreads();
    float s = 0.f;
#pragma unroll
    for (int i = 0; i < 8; ++i) s += red[i];
    return s;
}
__device__ __forceinline__ float hy_delta(int c) { const float d0 = -4.605170185988091f / 0.3f, d1 = -4.605170185988091f / 1.5f; return fabsf(d0 + (d1 - d0) * ((float)c / 1023.0f)); }
__device__ __forceinline__ void ph_filt2(const Args& A, int l, int set, int wk, int nwk, LAS unsigned char* lds, int tid) {
    LAS f32x2* buf = (LAS f32x2*)lds; LAS float* bufs = (LAS float*)lds; LAS float* red = (LAS float*)(lds + FFT_LDS_BYTES + 64); LAS float* w3s = red + 32;
    LAS float* ctap = w3s + 256;
    const float* w3 = inp(I_FW3) + (size_t)l * 64 * 4096; const bf16* FH2B = (const bf16*)(wsb() + WS_FB4) + (size_t)l * 4352 * 64;
    f32x2* KF = (f32x2*)(psb(set) + PS_KF); float* TAPC = (float*)(psb(set) + PS_TAPC);
    const int lane = tid & 63, w = tid >> 6, g = lane >> 4, li = lane & 15;
    for (int c = wk; c < 1024; c += nwk) {
        __syncthreads();
        if (tid < 256) w3s[tid] = w3[(size_t)(tid & 63) * 4096 + (tid >> 7) * 2048 + ((tid >> 6) & 1) * 1024 + c];
        __syncthreads();
        bf16x8 bfr[2];
#pragma unroll
        for (int ks = 0; ks < 2; ++ks) { float v[8];
#pragma unroll
            for (int j = 0; j < 8; ++j) v[j] = (li < 4) ? w3s[li * 64 + 32 * ks + 8 * g + j] : 0.f;
            bfr[ks] = mk8(pk2(v[0], v[1]), pk2(v[2], v[3]), pk2(v[4], v[5]), pk2(v[6], v[7])); }
        const float delta = hy_delta(c); float ssq = 0.f, ssqc = 0.f;
        const int comp = li >> 1;
#pragma unroll 1
        for (int rb = 0; rb < 272; rb += 64) {
            bf16x8 a0[8], a1[8];
#pragma unroll
            for (int rk = 0; rk < 8; ++rk) { const int rt = rb + w + 8 * rk; const bf16* ap = FH2B + (size_t)((rt < 272 ? rt : 0) * 16 + li) * 64 + 8 * g;
                a0[rk] = *(const bf16x8*)ap; a1[rk] = *(const bf16x8*)(ap + 32); }
#pragma unroll
            for (int rk = 0; rk < 8; ++rk) { const int rt = rb + w + 8 * rk; const int t0 = rt * 16;
                f32x4 acc = (f32x4){0.f, 0.f, 0.f, 0.f};
                acc = mfma16(a0[rk], bfr[0], acc); acc = mfma16(a1[rk], bfr[1], acc);
                if (li < 4 && rt < 272) {
                    if (rt < 256) {
#pragma unroll
                        for (int j = 0; j < 4; ++j) { const int t = t0 + 4 * g + j; const float val = acc[j] * __expf(-((float)t / 4095.0f) * delta);
                            if ((li & 1) == 0) { bufs[2 * fphys(t) + comp] = val; ssq += val * val; }
                            else if (t >= 1) { bufs[2 * fphys(8192 - t) + comp] = val; ssq += val * val; }
                            else bufs[2 * fphys(4096) + comp] = 0.f; }
                    } else {
#pragma unroll
                        for (int j = 0; j < 4; ++j) { const int m = t0 - 4096 + 4 * g + j; const float val = acc[j] * __expf(-((float)m / 255.0f) * delta);
                            ctap[li * 256 + m] = val; if ((li & 1) == 0 || m >= 1) ssqc += val * val; }
                    }
                }
            }
        }
        const bool o0 = (li < 2), o1 = (li == 2 || li == 3);
        const float scl0 = (1.0f / 8192.0f) / sqrtf(block_sum(o0 ? ssq : 0.f, red, tid) + EPS), scl1 = (1.0f / 8192.0f) / sqrtf(block_sum(o1 ? ssq : 0.f, red, tid) + EPS);
        const float sc0 = 1.0f / sqrtf(block_sum(o0 ? ssqc : 0.f, red, tid) + EPS), sc1 = 1.0f / sqrtf(block_sum(o1 ? ssqc : 0.f, red, tid) + EPS);
        __syncthreads();
        fft_pass<false, 544>(buf, tid, (float)tid * (1.0f / 8192.0f));
        __syncthreads();
        fft_pass<false, 34>(buf, (tid >> 5) * 512 + (tid & 31), (float)(tid & 31) * (1.0f / 512.0f));
        __syncthreads();
        fft_pass<false, 2>(buf, (tid >> 1) * 32 + (tid & 1), (float)(tid & 1) * (1.0f / 32.0f));
        __syncthreads();
#pragma unroll
        for (int r = 0; r < 8; ++r) { LAS f32x4* pp = (LAS f32x4*)(buf + fphys(2 * tid) + 1088 * r); const f32x4 ab = *pp; *pp = (f32x4){ab.x + ab.z, ab.y + ab.w, ab.x - ab.z, ab.y - ab.w}; }
        __syncthreads();
        f32x2* d0 = KF + (size_t)c * 8192; f32x2* d1 = KF + (size_t)(1024 + c) * 8192;
#pragma unroll 4
        for (int i = 0; i < 16; ++i) { const int p = tid + 512 * i; const int f = (int)(__brev((unsigned)p) >> 19); const int pp = (int)(__brev((unsigned)((8192 - f) & 8191)) >> 19);
            const f32x2 z = buf[fphys(p)], zp = buf[fphys(pp)];
            d0[p] = (f32x2){(z.x + zp.x) * 0.5f * scl0, (z.y - zp.y) * 0.5f * scl0};
            d1[p] = (f32x2){(z.y + zp.y) * 0.5f * scl1, (zp.x - z.x) * 0.5f * scl1}; }
        for (int q = tid; q < 1024; q += 512) { const int od = q >> 8, m = q & 255; TAPC[((size_t)od * 1024 + c) * 256 + m] = ctap[q] * ((od < 2) ? sc0 : sc1); }
    }
}

__device__ __forceinline__ void ph_hyprep(const Args& A, int l, LAS unsigned char* lds, int tid) {
    LAS bf16* T = (LAS bf16*)lds;
    const bf16* Z = (const bf16*)(wsb() + WS_Z); bf16* HYT = (bf16*)(wsb() + WS_HYT);
    const float* cw = inp(I_HCW) + (size_t)l * 3 * 3072; const float* cb = inp(I_HCB) + (size_t)l * 3072;
    for (int u = blockIdx.x; u < 3072; u += gridDim.x) {
        const int cg = u % 12, tt = (u / 12) & 63, b = u / 768;
        __syncthreads();
        for (int q = tid; q < 66 * 32; q += 512) { const int r = q >> 5, ch8 = q & 31, t = tt * 64 - 1 + r;
            v4u v = (v4u){0u, 0u, 0u, 0u};
            if (t >= 0 && t < SEQ) v = *(const v4u*)(Z + (size_t)(b * SEQ + t) * INW + C_HY + cg * 256 + ch8 * 8);
            *(LAS v4u*)(T + r * 264 + ch8 * 8) = v; }
        __syncthreads();
        const int ch = tid & 255, half = tid >> 8, gch = cg * 256 + ch;
        const float w0 = cw[gch], w1 = cw[3072 + gch], w2 = cw[6144 + gch], bb = cb[gch];
        const int part = gch >> 10, c = gch & 1023;
        bf16* outp = HYT + ((size_t)(part * NB + b) * 1024 + c) * SEQ + tt * 64 + half * 32;
#pragma unroll
        for (int tq = 0; tq < 4; ++tq) { float vv[8];
#pragma unroll
            for (int e = 0; e < 8; ++e) { const int tl = half * 32 + tq * 8 + e;
                vv[e] = w0 * bf1(T[tl * 264 + ch]) + w1 * bf1(T[(tl + 1) * 264 + ch]) + w2 * bf1(T[(tl + 2) * 264 + ch]) + bb; }
            v4u w; w.x = pk2(vv[0], vv[1]); w.y = pk2(vv[2], vv[3]); w.z = pk2(vv[4], vv[5]); w.w = pk2(vv[6], vv[7]);
            *(v4u*)(outp + tq * 8) = w; }
    }
}
__device__ __forceinline__ void ph_hyctx(const Args& A, int l, LAS unsigned char* lds, int tid) {
    const bf16* Z = (const bf16*)(wsb() + WS_Z); bf16* YS = (bf16*)(wsb() + WS_YS); const float* TAPC = (const float*)(psb(l & 1) + PS_TAPC);
    const float* cw = inp(I_HCW) + (size_t)l * 3 * 3072; const float* cb = inp(I_HCB) + (size_t)l * 3072; const float* hb = inp(I_HBIAS) + (size_t)l * 2 * 1024;
    const int ch = tid >> 6, q = tid & 63, t0 = 4 * q;
    LAS float* Y = (LAS float*)lds + ch * 1552; LAS float* Y1 = Y + 256; LAS float* G0 = Y + 512; LAS float* G1 = Y + 1032;
    for (int u = blockIdx.x; u < 512; u += gridDim.x) {
        const int b = u >> 7, c = (u & 127) * 8 + ch;
        __syncthreads();
        float pv[3][4];
#pragma unroll
        for (int part = 0; part < 3; ++part) { const int gch = part * 1024 + c; const float w0 = cw[gch], w1 = cw[3072 + gch], w2 = cw[6144 + gch], bb = cb[gch];
            const bf16* zp = Z + (size_t)(ML + b * CL + t0) * INW + C_HY + gch;
            float zz[6];
#pragma unroll
            for (int e = 0; e < 6; ++e) { const int t = t0 - 1 + e; zz[e] = (t >= 0 && t < CL) ? bf1(zp[(ptrdiff_t)(e - 1) * INW]) : 0.f; }
#pragma unroll
            for (int r = 0; r < 4; ++r) pv[part][r] = w0 * zz[r] + w1 * zz[r + 1] + w2 * zz[r + 2] + bb; }
        *(LAS f32x4*)(Y + t0) = (f32x4){pv[2][0], pv[2][1], pv[2][2], pv[2][3]};
#pragma unroll
        for (int r = 0; r < 4; ++r) { const int m = t0 + r;
            G0[m + 259] = TAPC[((size_t)(0 * 2 + 0) * 1024 + c) * 256 + m]; G1[m + 259] = TAPC[((size_t)(1 * 2 + 0) * 1024 + c) * 256 + m];
            if (m >= 1) { G0[259 - m] = TAPC[((size_t)(0 * 2 + 1) * 1024 + c) * 256 + m]; G1[259 - m] = TAPC[((size_t)(1 * 2 + 1) * 1024 + c) * 256 + m]; } }
        if (q == 0) { G0[515] = 0.f; G1[515] = 0.f; G0[516] = 0.f; G1[516] = 0.f; }
        __syncthreads();
        float yprev[4] = {pv[2][0], pv[2][1], pv[2][2], pv[2][3]};
#pragma unroll
        for (int ord = 0; ord < 2; ++ord) {
            const LAS float* Ys = ord ? Y1 : Y; const LAS float* G = ord ? G1 : G0;
            float acc[4] = {0.f, 0.f, 0.f, 0.f};
#pragma unroll 4
            for (int sp = 0; sp < 64; ++sp) { const f32x4 yv = *(const LAS f32x4*)(Ys + 4 * sp); const LAS float* gp = G + 4 * (q - sp) + 256;
                const f32x4 ga = *(const LAS f32x4*)gp, gb = *(const LAS f32x4*)(gp + 4);
                const float g[8] = {ga.x, ga.y, ga.z, ga.w, gb.x, gb.y, gb.z, gb.w}; const float yy[4] = {yv.x, yv.y, yv.z, yv.w};
#pragma unroll
                for (int r = 0; r < 4; ++r)
#pragma unroll
                    for (int j = 0; j < 4; ++j) acc[r] += yy[j] * g[r - j + 3]; }
            const float bias = hb[ord * 1024 + c];
#pragma unroll
            for (int r = 0; r < 4; ++r) yprev[r] = pv[ord][r] * (acc[r] + bias * yprev[r]);
            if (ord == 0) { *(LAS f32x4*)(Y1 + t0) = (f32x4){yprev[0], yprev[1], yprev[2], yprev[3]}; __syncthreads(); }
        }
#pragma unroll
        for (int r = 0; r < 4; ++r) YS[(size_t)(ML + b * CL + t0 + r) * 1024 + c] = (bf16)f2bf(yprev[r]);
    }
}
__device__ __forceinline__ void unpack8(v4u v, float (&x)[8]) { x[0] = bflo(v.x); x[1] = bfhi(v.x); x[2] = bflo(v.y); x[3] = bfhi(v.y); x[4] = bflo(v.z); x[5] = bfhi(v.z); x[6] = bflo(v.w); x[7] = bfhi(v.w); }
__device__ __forceinline__ v4u pack8(const float (&x)[8]) { v4u w; w.x = pk2(x[0], x[1]); w.y = pk2(x[2], x[3]); w.z = pk2(x[4], x[5]); w.w = pk2(x[6], x[7]); return w; }
__device__ __forceinline__ void rope8(float (&lo)[8], float (&hi)[8], const f32x2* rt) {
#pragma unroll
    for (int e = 0; e < 8; ++e) { const f32x2 cs = rt[e]; const float a = lo[e], b = hi[e]; lo[e] = a * cs.x - b * cs.y; hi[e] = b * cs.x + a * cs.y; }
}
__device__ __forceinline__ void vt_store(LAS bf16* Vt, int ld, int d0, int r, v4u vv) {
    Vt[(d0 + 0) * ld + r] = (bf16)(vv.x & 0xffffu); Vt[(d0 + 1) * ld + r] = (bf16)(vv.x >> 16);
    Vt[(d0 + 2) * ld + r] = (bf16)(vv.y & 0xffffu); Vt[(d0 + 3) * ld + r] = (bf16)(vv.y >> 16);
    Vt[(d0 + 4) * ld + r] = (bf16)(vv.z & 0xffffu); Vt[(d0 + 5) * ld + r] = (bf16)(vv.z >> 16);
    Vt[(d0 + 6) * ld + r] = (bf16)(vv.w & 0xffffu); Vt[(d0 + 7) * ld + r] = (bf16)(vv.w >> 16);
}
constexpr float LOG2E = 1.4426950408889634f;
typedef short s16x4 __attribute__((ext_vector_type(4)));
__device__ __forceinline__ bf16x8 tr_frag(const LAS bf16* tile, int ld, int r0, int r1, int c0, int li) {
    const s16x4 lo = __builtin_amdgcn_ds_read_tr16_b64_v4i16((LAS s16x4*)(tile + (r0 + (li >> 2)) * ld + c0 + 4 * (li & 3)));
    const s16x4 hi = __builtin_amdgcn_ds_read_tr16_b64_v4i16((LAS s16x4*)(tile + (r1 + (li >> 2)) * ld + c0 + 4 * (li & 3)));
    return (bf16x8){lo.x, lo.y, lo.z, lo.w, hi.x, hi.y, hi.z, hi.w};
}
__device__ __forceinline__ void ph_ret1(const Args& A, int l, int nctx_units, LAS unsigned char* lds, int tid) {
    LAS bf16* Kf = (LAS bf16*)lds; LAS bf16* Kb = Kf + 128 * 72; LAS bf16* Vs = Kb + 128 * 72;
    const bf16* Z = (const bf16*)(wsb() + WS_Z); float* KV = (float*)(wsb() + WS_KV); const f32x2* rope = (const f32x2*)(wsb() + WS_ROPE);
    const int lane = tid & 63, w = tid >> 6, g = lane >> 4, li = lane & 15;
    for (int uid = blockIdx.x; uid < 1024 + nctx_units; uid += gridDim.x) {
        const bool isc = uid >= 1024; int b, h, n, ci; size_t m0;
        if (!isc) { b = uid >> 8; h = (uid >> 5) & 7; n = uid & 31; m0 = (size_t)b * SEQ + n * 128; ci = 2 + n; }
        else { const int i = uid - 1024; b = i >> 4; h = (i >> 1) & 7; n = i & 1; m0 = (size_t)ML + b * CL + n * 128; ci = n; }
        const float lgf = inp(I_RDEC)[(l * 2 + 0) * 8 + h] * LOG2E, lgb = inp(I_RDEC)[(l * 2 + 1) * 8 + h] * LOG2E;
        __syncthreads();
        { const int tok = tid >> 2, pp = tid & 3, a = (pp & 1) + ((pp >> 1) << 2);
            const bf16* kr = Z + (m0 + tok) * INW + C_RK + h * 64;
            float lo[8], hi[8]; unpack8(*(const v4u*)(kr + 8 * a), lo); unpack8(*(const v4u*)(kr + 8 * a + 16), hi);
            if (!isc) { const int t = n * 128 + tok; const int pos = (a < 4) ? (t >> 6) : (t & 63); rope8(lo, hi, rope + pos * 16 + 8 * (a & 1)); }
            const float zf = ex2(lgf * (float)(127 - tok)) * 0.125f, zb = ex2(lgb * (float)tok) * 0.125f;
            float lf[8], hf[8];
#pragma unroll
            for (int e = 0; e < 8; ++e) { lf[e] = lo[e] * zf; hf[e] = hi[e] * zf; lo[e] *= zb; hi[e] *= zb; }
            *(LAS v4u*)(Kf + tok * 72 + 8 * a) = pack8(lf); *(LAS v4u*)(Kf + tok * 72 + 8 * a + 16) = pack8(hf);
            *(LAS v4u*)(Kb + tok * 72 + 8 * a) = pack8(lo); *(LAS v4u*)(Kb + tok * 72 + 8 * a + 16) = pack8(hi); }
        for (int q = tid; q < 2048; q += 512) { const int r = q >> 4, ch = q & 15; *(LAS v4u*)(Vs + r * 144 + ch * 8) = *(const v4u*)(Z + (m0 + r) * INW + C_RV + h * 128 + ch * 8); }
        __syncthreads();
        bf16x8 af[4];
#pragma unroll
        for (int ks = 0; ks < 4; ++ks) af[ks] = tr_frag(Vs, 144, 32 * ks + 8 * g, 32 * ks + 8 * g + 4, 16 * w, li);
#pragma unroll
        for (int dir = 0; dir < 2; ++dir) { const LAS bf16* KT = dir ? Kb : Kf;
            float* dst = KV + ((size_t)((b * 8 + h) * 2 + dir) * 34 + ci) * 8192;
#pragma unroll
            for (int nc = 0; nc < 4; ++nc) { f32x4 acc = (f32x4){0.f, 0.f, 0.f, 0.f};
#pragma unroll
                for (int ks = 0; ks < 4; ++ks) acc = mfma16(af[ks], tr_frag(KT, 72, 32 * ks + 8 * g, 32 * ks + 8 * g + 4, 16 * nc, li), acc);
#pragma unroll
                for (int j = 0; j < 4; ++j) dst[(16 * w + 4 * g + j) * 64 + 16 * nc + li] = acc[j]; } }
    }
}
__device__ __forceinline__ void ph_natt(const Args& A, int l, int mode, LAS unsigned char* lds, int tid) {
    LAS bf16* Qs = (LAS bf16*)lds; LAS bf16* KV0 = (LAS bf16*)lds; LAS float* rpbs = (LAS float*)(lds + 2 * (64 * 136 + 64 * 144) * 2);
    const bf16* Z = (const bf16*)(wsb() + WS_Z); bf16* YS = (bf16*)(wsb() + WS_YS) + (size_t)2 * MT * 1024;
    const int lane = tid & 63, w = tid >> 6, g = lane >> 4, li = lane & 15;
    const float SCALE = 0.08838834764831845f;
    const int sr0 = tid >> 4, sch = tid & 15;
    const int ufirst = mode ? ((int)blockIdx.x - ((int)gridDim.x - 32)) : (int)blockIdx.x, ucount = mode ? 32 : 512;
    if (ufirst < 0) return;
    for (int uid = ufirst; uid < ucount; uid += (mode ? 32 : (int)gridDim.x)) {
        int b, h, rq = 0; size_t m0;
        if (!mode) { b = uid >> 7; h = (uid >> 4) & 7; rq = uid & 15; m0 = (size_t)b * SEQ + rq * 256; }
        else { b = uid >> 3; h = uid & 7; m0 = (size_t)ML + b * CL; }
        const size_t mc0 = (size_t)ML + b * CL;
        const int qr = 4 * rq + (w >> 1), rs_w = min(max(qr - 4, 0), 56);
        const int kr_lo = min(max(4 * rq - 4, 0), 56), kr_hi = min(max(4 * rq - 1, 0), 56) + 7;
        const int nwin = mode ? 0 : (kr_hi - kr_lo + 1), ntile = nwin + 4;
        int qc[2], cs[2], nlo_w[2], nhi_w[2];
#pragma unroll
        for (int i = 0; i < 2; ++i) { const int cw = 2 * (w & 1) + i; qc[i] = 16 * cw + li; cs[i] = min(max(qc[i] - 8, 0), 48);
            nlo_w[i] = (cw <= 1) ? 0 : cw - 1; nhi_w[i] = (cw == 0) ? 1 : ((cw == 3) ? 3 : cw + 1); }
        v4u kreg[2], vreg[2];
#define NA_LOAD(t_) do { const int t__ = (t_); const size_t mk = (t__ < nwin) ? ((size_t)b * SEQ + (kr_lo + t__) * 64) : (mc0 + (t__ - nwin) * 64); \
            _Pragma("unroll") for (int e = 0; e < 2; ++e) { const bf16* zr = Z + (mk + sr0 + 32 * e) * INW + h * 128 + sch * 8; kreg[e] = *(const v4u*)(zr + C_NK); vreg[e] = *(const v4u*)(zr + C_NV); } } while (0)
#define NA_STORE(buf_) do { LAS bf16* Kd = KV0 + (buf_) * (64 * 136 + 64 * 144); LAS bf16* Vd = Kd + 64 * 136; \
            _Pragma("unroll") for (int e = 0; e < 2; ++e) { *(LAS v4u*)(Kd + (sr0 + 32 * e) * 136 + sch * 8) = kreg[e]; *(LAS v4u*)(Vd + (sr0 + 32 * e) * 144 + sch * 8) = vreg[e]; } } while (0)
        __syncthreads();
        NA_LOAD(0);
        for (int q = tid; q < 4096; q += 512) { const int r = q >> 4, chn = q & 15; *(LAS v4u*)(Qs + r * 136 + chn * 8) = *(const v4u*)(Z + (m0 + r) * INW + C_NQ + h * 128 + chn * 8); }
        if (!mode) for (int i = tid; i < 465; i += 512) rpbs[i] = inp(I_RPB)[((size_t)l * 8 + h) * 465 + i];
        __syncthreads();
        bf16x8 qf[2][4];
#pragma unroll
        for (int i = 0; i < 2; ++i)
#pragma unroll
            for (int ks = 0; ks < 4; ++ks) qf[i][ks] = *(const LAS bf16x8*)(Qs + (32 * w + 16 * i + li) * 136 + 32 * ks + 8 * g);
        __syncthreads();
        NA_STORE(0);
        __syncthreads();
        f32x4 o[2][8];
#pragma unroll
        for (int i = 0; i < 2; ++i)
#pragma unroll
            for (int nd = 0; nd < 8; ++nd) o[i][nd] = (f32x4){0.f, 0.f, 0.f, 0.f};
        float mrun[2] = {-1e30f, -1e30f}, lrun[2] = {0.f, 0.f};
        for (int t = 0; t < ntile; ++t) {
            const bool win = t < nwin; const int kr = kr_lo + t;
            if (t + 1 < ntile) NA_LOAD(t + 1);
            const LAS bf16* Ks = KV0 + (t & 1) * (64 * 136 + 64 * 144); const LAS bf16* Vs = Ks + 64 * 136;
            const bool active = !win || (kr >= rs_w && kr <= rs_w + 7);
            if (active) {
                const int nlo0 = win ? nlo_w[0] : 0, nhi0 = win ? nhi_w[0] : 3, nlo1 = win ? nlo_w[1] : 0, nhi1 = win ? nhi_w[1] : 3;
                f32x4 s[2][4];
#pragma unroll
                for (int n = 0; n < 4; ++n) { s[0][n] = (f32x4){0.f, 0.f, 0.f, 0.f}; s[1][n] = (f32x4){0.f, 0.f, 0.f, 0.f};
                    const bool u0 = (n >= nlo0 && n <= nhi0), u1 = (n >= nlo1 && n <= nhi1);
                    if (u0 || u1) {
#pragma unroll
                        for (int ks = 0; ks < 4; ++ks) { const bf16x8 kf = *(const LAS bf16x8*)(Ks + (16 * n + li) * 136 + 32 * ks + 8 * g);
                            if (u0) s[0][n] = mfma16(kf, qf[0][ks], s[0][n]);
                            if (u1) s[1][n] = mfma16(kf, qf[1][ks], s[1][n]); } } }
                bf16x8 pf[2][2];
#pragma unroll
                for (int i = 0; i < 2; ++i) {
                    float tmax = -1e30f;
#pragma unroll
                    for (int n = 0; n < 4; ++n)
#pragma unroll
                        for (int j = 0; j < 4; ++j) { float v = s[i][n][j] * SCALE;
                            if (win) { const int kc = 16 * n + 4 * g + j; const bool valid = (kc >= cs[i]) && (kc < cs[i] + 16);
                                const int dc = min(max(kc - qc[i] + 15, 0), 30), dr = min(max(kr - qr + 7, 0), 14);
                                v = valid ? v + rpbs[dr * 31 + dc] : -1e30f; }
                            s[i][n][j] = v; tmax = fmaxf(tmax, v); }
                    tmax = fmaxf(tmax, __shfl_xor(tmax, 16)); tmax = fmaxf(tmax, __shfl_xor(tmax, 32));
                    const float mnew = fmaxf(mrun[i], tmax), alpha = __expf(mrun[i] - mnew);
                    float psum = 0.f;
#pragma unroll
                    for (int n = 0; n < 4; ++n)
#pragma unroll
                        for (int j = 0; j < 4; ++j) { const float pv = __expf(s[i][n][j] - mnew); s[i][n][j] = pv; psum += pv; }
                    psum += __shfl_xor(psum, 16); psum += __shfl_xor(psum, 32);
                    lrun[i] = lrun[i] * alpha + psum; mrun[i] = mnew;
#pragma unroll
                    for (int nd = 0; nd < 8; ++nd) o[i][nd] = o[i][nd] * alpha;
#pragma unroll
                    for (int kk = 0; kk < 2; ++kk) pf[i][kk] = mk8(pk2(s[i][2 * kk][0], s[i][2 * kk][1]), pk2(s[i][2 * kk][2], s[i][2 * kk][3]), pk2(s[i][2 * kk + 1][0], s[i][2 * kk + 1][1]), pk2(s[i][2 * kk + 1][2], s[i][2 * kk + 1][3]));
                }
#pragma unroll
                for (int kk = 0; kk < 2; ++kk) { const bool u0 = (2 * kk + 1 >= nlo0 && 2 * kk <= nhi0), u1 = (2 * kk + 1 >= nlo1 && 2 * kk <= nhi1);
                    if (u0 || u1) {
#pragma unroll
                        for (int nd = 0; nd < 8; ++nd) { const bf16x8 vf = tr_frag(Vs, 144, 32 * kk + 4 * g, 32 * kk + 16 + 4 * g, 16 * nd, li);
                            if (u0) o[0][nd] = mfma16(vf, pf[0][kk], o[0][nd]);
                            if (u1) o[1][nd] = mfma16(vf, pf[1][kk], o[1][nd]); } } }
            }
            if (t + 1 < ntile) NA_STORE((t + 1) & 1);
            __syncthreads();
        }
#undef NA_LOAD
#undef NA_STORE
#pragma unroll
        for (int i = 0; i < 2; ++i) { const float inv = 1.0f / lrun[i]; const size_t mrow = m0 + 32 * w + 16 * i + li;
#pragma unroll
            for (int nd = 0; nd < 8; ++nd) { v2u wv; wv.x = pk2(o[i][nd][0] * inv, o[i][nd][1] * inv); wv.y = pk2(o[i][nd][2] * inv, o[i][nd][3] * inv);
                *(v2u*)(YS + mrow * 1024 + h * 128 + 16 * nd + 4 * g) = wv; } }
    }
}

__device__ __forceinline__ void ph_hyfft(const Args& A, int l, LAS unsigned char* lds, int tid) {
    LAS f32x2* buf = (LAS f32x2*)lds;
    const bf16* HYT = (const bf16*)(wsb() + WS_HYT); bf16* YT = (bf16*)(wsb() + WS_YT); const f32x2* KF = (const f32x2*)(psb(l & 1) + PS_KF);
    const float* hb = inp(I_HBIAS) + (size_t)l * 2 * 1024;
    const int baseB = (tid >> 5) * 512 + (tid & 31), baseC = (tid >> 1) * 32 + (tid & 1);
    const float thA = (float)tid * (1.0f / 8192.0f), thB = (float)(tid & 31) * (1.0f / 512.0f), thC = (float)(tid & 1) * (1.0f / 32.0f);
    for (int u = blockIdx.x; u < 2048; u += gridDim.x) {
        const int c = u >> 1, b0 = (u & 1) * 2;
        const bf16* x1p = HYT + ((size_t)(0 * NB + b0) * 1024 + c) * SEQ; const bf16* x2p = HYT + ((size_t)(1 * NB + b0) * 1024 + c) * SEQ; const bf16* vp = HYT + ((size_t)(2 * NB + b0) * 1024 + c) * SEQ;
        const size_t bstr = (size_t)1024 * SEQ;
        float y0[8], y1[8];
#pragma unroll
        for (int i = 0; i < 8; ++i) { const int t = tid + 512 * i; y0[i] = bf1(vp[t]); y1[i] = bf1(vp[bstr + t]); }
#pragma unroll
        for (int ord = 0; ord < 2; ++ord) {
            { f32x2 x[16];
#pragma unroll
                for (int k = 0; k < 8; ++k) { x[k] = (f32x2){y0[k], y1[k]}; x[k + 8] = (f32x2){0.f, 0.f}; }
                dif16<true>(x, thA);
                __syncthreads();
#pragma unroll
                for (int k = 0; k < 16; ++k) buf[fphys(tid) + 544 * k] = x[k]; }
            __syncthreads();
            fft_pass<false, 34>(buf, baseB, thB);
            __syncthreads();
            fft_pass<false, 2>(buf, baseC, thC);
            __syncthreads();
            { const f32x4* kf = (const f32x4*)(KF + (size_t)(ord * 1024 + c) * 8192);
#pragma unroll
                for (int r = 0; r < 8; ++r) { const int i = tid + 512 * r; LAS f32x4* pp = (LAS f32x4*)(buf + fphys(2 * tid) + 1088 * r); const f32x4 ab = *pp; const f32x4 kk = kf[i];
                    const float ax = ab.x + ab.z, ay = ab.y + ab.w, bx = ab.x - ab.z, by = ab.y - ab.w;
                    const float px = ax * kk.x - ay * kk.y, py = ax * kk.y + ay * kk.x, qx = bx * kk.z - by * kk.w, qy = bx * kk.w + by * kk.z;
                    *pp = (f32x4){px + qx, py + qy, px - qx, py - qy}; } }
            __syncthreads();
            fft_pass<true, 2>(buf, baseC, thC);
            __syncthreads();
            fft_pass<true, 34>(buf, baseB, thB);
            __syncthreads();
            { f32x2 x[16];
#pragma unroll
                for (int k = 0; k < 16; ++k) x[k] = buf[fphys(tid) + 544 * k];
                idit16(x, thA);
                const bf16* xp = ord ? x2p : x1p; const float bias = hb[ord * 1024 + c];
#pragma unroll
                for (int k = 0; k < 8; ++k) { const int t = tid + 512 * k;
                    y0[k] = bf1(xp[t]) * (x[k].x + bias * y0[k]); y1[k] = bf1(xp[bstr + t]) * (x[k].y + bias * y1[k]); } }
        }
        bf16* o0 = YT + ((size_t)b0 * 1024 + c) * SEQ;
#pragma unroll
        for (int i = 0; i < 8; ++i) { const int t = tid + 512 * i; o0[t] = (bf16)f2bf(y0[i]); o0[bstr + t] = (bf16)f2bf(y1[i]); }
    }
}
__device__ __forceinline__ void ph_scan(const Args& A, int l, int tid) {
    float* KV = (float*)(wsb() + WS_KV);
    for (int gt = blockIdx.x * 512 + tid; gt < NB * 8 * 2 * 2048; gt += gridDim.x * 512) {
        const int bhd = gt >> 11, e4 = gt & 2047, dir = bhd & 1, h = (bhd >> 1) & 7;
        const float gC = ex2(inp(I_RDEC)[(l * 2 + dir) * 8 + h] * LOG2E * 128.0f);
        f32x4* base = (f32x4*)(KV + (size_t)bhd * 34 * 8192) + e4;
        f32x4 s = (f32x4){0.f, 0.f, 0.f, 0.f};
#pragma unroll 1
        for (int sb8 = 0; sb8 < 34; sb8 += 8) {
            f32x4 tv[8];
#pragma unroll
            for (int k = 0; k < 8; ++k) { const int step = min(sb8 + k, 33); const int ci = (dir == 0) ? step : (step == 0 ? 1 : (step == 1 ? 0 : 35 - step)); tv[k] = base[(size_t)ci * 2048]; }
#pragma unroll
            for (int k = 0; k < 8; ++k) { const int step = sb8 + k; if (step < 34) { const int ci = (dir == 0) ? step : (step == 0 ? 1 : (step == 1 ? 0 : 35 - step)); base[(size_t)ci * 2048] = s; s = s * gC + tv[k]; } } }
    }
}

__device__ __forceinline__ void ph_hypost(const Args& A, LAS unsigned char* lds, int tid) {
    LAS bf16* T = (LAS bf16*)lds;
    const bf16* YT = (const bf16*)(wsb() + WS_YT); bf16* YS = (bf16*)(wsb() + WS_YS);
    for (int u = blockIdx.x; u < 1024; u += gridDim.x) {
        const int cg = u & 3, tt = (u >> 2) & 63, b = u >> 8;
        __syncthreads();
        for (int q = tid; q < 2048; q += 512) { const int c = q >> 3, t8 = q & 7;
            *(LAS v4u*)(T + c * 72 + t8 * 8) = *(const v4u*)(YT + ((size_t)b * 1024 + cg * 256 + c) * SEQ + tt * 64 + t8 * 8); }
        __syncthreads();
        const int t = tid >> 3, c32 = tid & 7;
#pragma unroll
        for (int q = 0; q < 4; ++q) { const int cb = c32 * 32 + q * 8; v4u w;
            w.x = (unsigned)T[(cb + 0) * 72 + t] | ((unsigned)T[(cb + 1) * 72 + t] << 16); w.y = (unsigned)T[(cb + 2) * 72 + t] | ((unsigned)T[(cb + 3) * 72 + t] << 16);
            w.z = (unsigned)T[(cb + 4) * 72 + t] | ((unsigned)T[(cb + 5) * 72 + t] << 16); w.w = (unsigned)T[(cb + 6) * 72 + t] | ((unsigned)T[(cb + 7) * 72 + t] << 16);
            *(v4u*)(YS + (size_t)(b * SEQ + tt * 64 + t) * 1024 + cg * 256 + cb) = w; }
    }
}
__device__ __forceinline__ void ph_ret3(const Args& A, int l, int nctx_units, LAS unsigned char* lds, int tid) {
    LAS bf16* Qs = (LAS bf16*)lds; LAS bf16* Ks = Qs + 128 * 72; LAS bf16* Vs = Ks + 128 * 72; LAS bf16* Sf = Vs + 128 * 144; LAS bf16* Sb = Sf + 128 * 72;
    const bf16* Z = (const bf16*)(wsb() + WS_Z); const float* KV = (const float*)(wsb() + WS_KV); const f32x2* rope = (const f32x2*)(wsb() + WS_ROPE);
    bf16* YS = (bf16*)(wsb() + WS_YS) + (size_t)MT * 1024;
    const int lane = tid & 63, w = tid >> 6, g = lane >> 4, li = lane & 15;
    for (int uid = blockIdx.x; uid < 1024 + nctx_units; uid += gridDim.x) {
        const bool isc = uid >= 1024; int b, h, n, ci; size_t m0;
        if (!isc) { b = uid >> 8; h = (uid >> 5) & 7; n = uid & 31; m0 = (size_t)b * SEQ + n * 128; ci = 2 + n; }
        else { const int i = uid - 1024; b = i >> 4; h = (i >> 1) & 7; n = i & 1; m0 = (size_t)ML + b * CL + n * 128; ci = n; }
        const float lgf = inp(I_RDEC)[(l * 2 + 0) * 8 + h] * LOG2E, lgb = inp(I_RDEC)[(l * 2 + 1) * 8 + h] * LOG2E;
        __syncthreads();
        { const int tok = tid >> 2, pp = tid & 3, a = (pp & 1) + ((pp >> 1) << 2);
            const int t = n * 128 + tok; const int pos = (a < 4) ? (t >> 6) : (t & 63); const f32x2* rt = rope + pos * 16 + 8 * (a & 1);
            const bf16* qr = Z + (m0 + tok) * INW + C_RQ + h * 64; const bf16* kr = Z + (m0 + tok) * INW + C_RK + h * 64;
            float lo[8], hi[8];
            unpack8(*(const v4u*)(qr + 8 * a), lo); unpack8(*(const v4u*)(qr + 8 * a + 16), hi);
            if (!isc) rope8(lo, hi, rt);
            *(LAS v4u*)(Qs + tok * 72 + 8 * a) = pack8(lo); *(LAS v4u*)(Qs + tok * 72 + 8 * a + 16) = pack8(hi);
            unpack8(*(const v4u*)(kr + 8 * a), lo); unpack8(*(const v4u*)(kr + 8 * a + 16), hi);
            if (!isc) rope8(lo, hi, rt);
#pragma unroll
            for (int e = 0; e < 8; ++e) { lo[e] *= 0.125f; hi[e] *= 0.125f; }
            *(LAS v4u*)(Ks + tok * 72 + 8 * a) = pack8(lo); *(LAS v4u*)(Ks + tok * 72 + 8 * a + 16) = pack8(hi); }
        for (int q = tid; q < 2048; q += 512) { const int r = q >> 4, ch = q & 15; *(LAS v4u*)(Vs + r * 144 + ch * 8) = *(const v4u*)(Z + (m0 + r) * INW + C_RV + h * 128 + ch * 8); }
#pragma unroll
        for (int dir = 0; dir < 2; ++dir) { const f32x4* src = (const f32x4*)(KV + ((size_t)((b * 8 + h) * 2 + dir) * 34 + ci) * 8192); LAS bf16* S = dir ? Sb : Sf;
            for (int q = tid; q < 2048; q += 512) { const f32x4 v = src[q]; v2u wv; wv.x = pk2(v.x, v.y); wv.y = pk2(v.z, v.w); *(LAS v2u*)(S + (q >> 4) * 72 + (q & 15) * 4) = wv; } }
        __syncthreads();
        const int iq = 16 * w + li;
        bf16x8 qf[2];
#pragma unroll
        for (int ks = 0; ks < 2; ++ks) qf[ks] = *(const LAS bf16x8*)(Qs + iq * 72 + 32 * ks + 8 * g);
        f32x4 s[8];
#pragma unroll
        for (int nn = 0; nn < 8; ++nn) { s[nn] = (f32x4){0.f, 0.f, 0.f, 0.f};
#pragma unroll
            for (int ks = 0; ks < 2; ++ks) s[nn] = mfma16(*(const LAS bf16x8*)(Ks + (16 * nn + li) * 72 + 32 * ks + 8 * g), qf[ks], s[nn]);
#pragma unroll
            for (int j = 0; j < 4; ++j) { const int d = iq - (16 * nn + 4 * g + j); s[nn][j] *= (d >= 0) ? ex2(lgf * (float)d) : ex2(lgb * (float)(-d)); } }
        f32x4 o[8];
#pragma unroll
        for (int nd = 0; nd < 8; ++nd) o[nd] = (f32x4){0.f, 0.f, 0.f, 0.f};
#pragma unroll
        for (int kk = 0; kk < 4; ++kk) {
            const bf16x8 pf = mk8(pk2(s[2 * kk][0], s[2 * kk][1]), pk2(s[2 * kk][2], s[2 * kk][3]), pk2(s[2 * kk + 1][0], s[2 * kk + 1][1]), pk2(s[2 * kk + 1][2], s[2 * kk + 1][3]));
#pragma unroll
            for (int nd = 0; nd < 8; ++nd) o[nd] = mfma16(tr_frag(Vs, 144, 32 * kk + 4 * g, 32 * kk + 16 + 4 * g, 16 * nd, li), pf, o[nd]); }
        const float xif = ex2(lgf * (float)(iq + 1)), xib = ex2(lgb * (float)(128 - iq));
        float ss = 0.f;
#pragma unroll
        for (int nd = 0; nd < 8; ++nd) { f32x4 tf = (f32x4){0.f, 0.f, 0.f, 0.f}, tb = (f32x4){0.f, 0.f, 0.f, 0.f};
#pragma unroll
            for (int ks = 0; ks < 2; ++ks) { tf = mfma16(*(const LAS bf16x8*)(Sf + (16 * nd + li) * 72 + 32 * ks + 8 * g), qf[ks], tf);
                tb = mfma16(*(const LAS bf16x8*)(Sb + (16 * nd + li) * 72 + 32 * ks + 8 * g), qf[ks], tb); }
            o[nd] = o[nd] + tf * xif + tb * xib;
            ss += (o[nd][0] * o[nd][0] + o[nd][1] * o[nd][1]) + (o[nd][2] * o[nd][2] + o[nd][3] * o[nd][3]); }
        ss += __shfl_xor(ss, 16); ss += __shfl_xor(ss, 32);
        const float rn = 1.0f / sqrtf(ss * (1.0f / 128.0f) + EPS);
        const size_t mrow = m0 + iq;
#pragma unroll
        for (int nd = 0; nd < 8; ++nd) { const int dv = 16 * nd + 4 * g; const v2u gv = *(const v2u*)(Z + mrow * INW + C_RG + h * 128 + dv);
            const float g0 = bflo(gv.x), g1 = bfhi(gv.x), g2 = bflo(gv.y), g3 = bfhi(gv.y);
            v2u wv; wv.x = pk2(g0 / (1.0f + __expf(-g0)) * o[nd][0] * rn, g1 / (1.0f + __expf(-g1)) * o[nd][1] * rn);
            wv.y = pk2(g2 / (1.0f + __expf(-g2)) * o[nd][2] * rn, g3 / (1.0f + __expf(-g3)) * o[nd][3] * rn);
            *(v2u*)(YS + mrow * 1024 + h * 128 + dv) = wv; }
    }
}

__device__ __forceinline__ float gelu_fx(float x) { const float x2 = x * x; const float arg = x * (x2 * (-2.0f * 1.4426950408889634f * 0.7978845608028654f * 0.044715f) + (-2.0f * 1.4426950408889634f * 0.7978845608028654f));
    return x * __builtin_amdgcn_rcpf(1.0f + __builtin_amdgcn_exp2f(arg)); }
__device__ __forceinline__ void ph_ffnfix(const Args& A, int l, int Mrows, int tid) {
    const bf16* SA = (const bf16*)(wsb() + WS_SA); const bf16* SB = (const bf16*)(wsb() + WS_SB); bf16* U = (bf16*)(wsb() + WS_U);
    const float* cw = inp(I_FFCW) + (size_t)l * 3 * DFF; const float* cb = inp(I_FFCB) + (size_t)l * DFF;
    const int nblk = Mrows / 64;
    for (int u = blockIdx.x; u < nblk * 2; u += gridDim.x) {
        const int blk = u >> 1, hi = u & 1, R = blk * 64 + (hi ? 63 : 0);
        const bool seq_first = (R < ML) ? ((R & (SEQ - 1)) == 0) : ((R & (CL - 1)) == 0), seq_last = (R < ML) ? ((R & (SEQ - 1)) == SEQ - 1) : ((R & (CL - 1)) == CL - 1);
        const bf16* pprev = hi ? SA + ((size_t)blk * 4 + 2) * DFF : SA + ((size_t)(blk - 1) * 4 + 3) * DFF;
        const bf16* pcur = SA + ((size_t)blk * 4 + (hi ? 3 : 0)) * DFF;
        const bf16* pnext = hi ? SA + ((size_t)(blk + 1) * 4 + 0) * DFF : SA + ((size_t)blk * 4 + 1) * DFF;
        const bf16* pb = SB + ((size_t)blk * 2 + hi) * DFF;
        const bool zp = (!hi && seq_first), zn = (hi && seq_last);
        for (int q = tid; q < DFF / 8; q += 512) { const int f = q * 8;
            float am[8], a0[8], aq[8], bg[8]; const v4u z4 = (v4u){0u, 0u, 0u, 0u};
            unpack8(zp ? z4 : *(const v4u*)(pprev + f), am); unpack8(*(const v4u*)(pcur + f), a0); unpack8(zn ? z4 : *(const v4u*)(pnext + f), aq); unpack8(*(const v4u*)(pb + f), bg);
            float r[8];
#pragma unroll
            for (int e = 0; e < 8; ++e) r[e] = gelu_fx(cw[f + e] * am[e] + cw[DFF + f + e] * a0[e] + cw[2 * DFF + f + e] * aq[e] + cb[f + e]) * bg[e];
            *(v4u*)(U + (size_t)R * DFF + f) = pack8(r); }
    }
}
__device__ __forceinline__ void ph_final(const Args& A, int wave, int lane) {
    const int gw = blockIdx.x * NWAVES + wave, NGW = gridDim.x * NWAVES; const float* g = inp(I_GF);
    for (int m = gw; m < ML; m += NGW) { float* xr = outb() + (size_t)m * D; f32x4 v[8]; float ss = 0.f;
#pragma unroll
        for (int j = 0; j < 8; ++j) { v[j] = *(const f32x4*)(xr + (lane + 64 * j) * 4); ss += (v[j].x * v[j].x + v[j].y * v[j].y) + (v[j].z * v[j].z + v[j].w * v[j].w); }
        const float rstd = 1.0f / sqrtf(wave_sum(ss) * (1.0f / D) + EPS);
#pragma unroll
        for (int j = 0; j < 8; ++j) { const int idx = (lane + 64 * j) * 4; *(f32x4*)(xr + idx) = v[j] * rstd * *(const f32x4*)(g + idx); }
    }
}
#ifndef SKEW_US
#define SKEW_US 0
#endif
__device__ __forceinline__ void spin_us(int us) { if (us > 0) { const unsigned long long t0 = __builtin_amdgcn_s_memrealtime(); while (__builtin_amdgcn_s_memrealtime() - t0 < (unsigned long long)us * 100ull) __builtin_amdgcn_s_sleep(8); } }
constexpr int BG_SPLIT = 22016;
constexpr int SEQ_PER_LAYER = 11, NSEQ = 1 + DEPTH * SEQ_PER_LAYER + 1;
__global__ void __launch_bounds__(NWAVES * 64, 2) fwd(Args A) {
    extern __shared__ __attribute__((aligned(16))) unsigned char lds_raw[];
    LAS unsigned char* lds = (LAS unsigned char*)lds_raw;
    volatile LAS unsigned* MISC = (volatile LAS unsigned*)(lds + MISC_OFF);
    for (int u = threadIdx.x; u < (LDS_BYTES - LDSCTL_OFF) / 4; u += NWAVES * 64) ((LAS unsigned*)(lds + LDSCTL_OFF))[u] = 0u;
    __syncthreads();
    (void)xcd_barrier_post((unsigned*)(wsb() + WS_CTL) + CW_BAR, MISC + 8);
    const int lo = A.seq_lo, hi = A.seq_hi;
#define G ((int)gridDim.x)
#define RUN(s) (lo <= (s) && (s) < hi)
#ifndef DUP
#define DUP 0
#endif
#define DUPN(id) ((((DUP) >> (id)) & 1) ? 2 : 1)
#define TID_HERE const int tid = otid(), lane = tid & 63, wave = __builtin_amdgcn_readfirstlane(tid >> 6); (void)lane; (void)wave
#ifdef ONLY
#define PH_ON(k) ((k) == ONLY)
#elif defined(SKIP)
#define PH_ON(k) ((k) != SKIP)
#else
#define PH_ON(k) true
#endif
#define SEAM(s) do { if (RUN((s) + 1)) { XcdBarrier bar_; bar_.bar = (unsigned*)(wsb() + WS_CTL) + CW_BAR; bar_.x = xb_xcc_id(); bar_.st = (volatile LAS unsigned*)(lds + MISC_OFF) + 8; xcd_barrier(bar_); if (DUPN(16) > 1) xcd_barrier(bar_); } } while (0)
#define H ((bf16*)(wsb() + WS_H))
#define Z ((bf16*)(wsb() + WS_Z))
#define ACC ((bf16*)(wsb() + WS_ACC))
#define U ((bf16*)(wsb() + WS_U))
#define YS ((bf16*)(wsb() + WS_YS))
#define XC ((float*)(wsb() + WS_XC))
#define WIN ((const bf16*)(psb(l & 1) + PS_WIN))
#define WBR ((const bf16*)(psb(l & 1) + PS_WBR))
#define WOUT ((const bf16*)(psb(l & 1) + PS_WOUT))
#define WF1 ((const bf16*)(psb(l & 1) + PS_WF1))
#define WF2 ((const bf16*)(psb(l & 1) + PS_WF2))

    if (PH_ON(100) && RUN(0)) { TID_HERE; ph_prologue(A, lds, tid); __syncthreads(); ph_convert(A, 0, 0, 0, CONV_ITEMS, (int)blockIdx.x, G, lds, wave, lane); __syncthreads(); for (int fl = 0; fl < DEPTH; ++fl) ph_filt1(A, fl, 0, (int)blockIdx.x, G, lds, tid); SEAM(0); }

    for (int l = 0; l < DEPTH; ++l) {
        const int sb = 1 + l * SEQ_PER_LAYER;
        if (hi <= sb || lo >= sb + SEQ_PER_LAYER) continue;
        const bool lastl = (l == DEPTH - 1);
        const int Mrows = lastl ? ML : MT, nctx = lastl ? 0 : 64;
#define modl ((const float*)(wsb() + WS_MOD) + (size_t)l * 5 * 12288)
#define xlat_in ((l == 0) ? inp(I_X) : (const float*)outb())
#define xctx_in ((l == 0) ? inp(I_CTX) : (const float*)XC)

        if (PH_ON(0) && RUN(sb + 0)) { TID_HERE;
            if (l == 0) for (int r_ = 0; r_ < DUPN(17); ++r_) ph_filt2(A, 0, 0, (int)blockIdx.x, G, lds, tid);
            else ph_convert(A, l, l & 1, 0, CONV_ITEMS, (int)blockIdx.x, G, lds, wave, lane);
            ph_norm(xlat_in, xctx_in, inp(I_G1) + (size_t)l * D, modl, 0, D, H, MT, (l > 0) ? (const float*)(wsb() + WS_SLAB) : (const float*)nullptr,
                    (const float*)(wsb() + WS_MOD) + ((size_t)(l - 1) * 5 + 4) * 12288 + 5 * D, XC, wave, lane);
            SEAM(sb + 0);
        }
        if (PH_ON(1) && RUN(sb + 1)) { TID_HERE;
            if (SKEW_US > 0 && (blockIdx.x & 8)) spin_us(SKEW_US);
            { pg8::Gemm g{H, WIN, opq(MT), opq(INW), opq(D), 0}; pg8::StaticOrder S; S.init(g.M, g.N, G, (int)blockIdx.x);
              pg8::EpiStore E{Z, INW};
              for (int r_ = 0; r_ < DUPN(15); ++r_) pg8::gemm_phase<pg8::EpiStore, pg8::StaticOrder, PG8_ALIGN, PG8_SP2>(lds, g, S, E); }
            SEAM(sb + 1);
        }
        if (PH_ON(2) && RUN(sb + 2)) { TID_HERE;
            for (int r_ = 0; r_ < DUPN(4); ++r_) ph_hyprep(A, l, lds, tid);
            for (int r_ = 0; r_ < DUPN(5); ++r_) ph_ret1(A, l, 64, lds, tid);
            for (int r_ = 0; r_ < DUPN(6); ++r_) ph_natt(A, l, 0, lds, tid);
            for (int r_ = 0; r_ < DUPN(7); ++r_) if (!lastl) ph_hyctx(A, l, lds, tid);
            SEAM(sb + 2);
        }
        if (PH_ON(3) && RUN(sb + 3)) { TID_HERE;
#ifndef NO_D1
            for (int r_ = 0; r_ < DUPN(8); ++r_) ph_hyfft(A, l, lds, tid);
#endif
#ifndef NO_D2
            ph_scan(A, l, tid);
#endif
            SEAM(sb + 3);
        }
        if (PH_ON(4) && RUN(sb + 4)) { TID_HERE;
            for (int r_ = 0; r_ < DUPN(9); ++r_) ph_hypost(A, lds, tid);
            for (int r_ = 0; r_ < DUPN(10); ++r_) ph_ret3(A, l, nctx, lds, tid);
            if (!lastl) { __syncthreads(); ph_natt(A, l, 1, lds, tid); }
            SEAM(sb + 4);
        }
        if (PH_ON(5) && RUN(sb + 5)) { TID_HERE;
            __syncthreads();
            for (int r_ = 0; r_ < DUPN(13); ++r_)
            for (int i = 0; i < 3; ++i) {
                pg8::Gemm g{YS + (size_t)i * MT * 1024, WBR + (size_t)i * D * 1024, Mrows, opq(D), opq(1024), 0}; pg8::StaticOrder S; S.init(g.M, g.N, G, (int)blockIdx.x);
                pg8::EpiMerge E{ACC, Z + C_GT + i * D, INW, i == 0 ? 1 : 0};
                pg8::gemm_phase<pg8::EpiMerge, pg8::StaticOrder, PG8_ALIGN, PG8_SP2>(lds, g, S, E);
            }
            if (!lastl && blockIdx.x >= 32) { __syncthreads(); for (int r_ = 0; r_ < DUPN(3); ++r_) ph_filt2(A, l + 1, (l + 1) & 1, (int)blockIdx.x - 32, G - 32, lds, tid); }
            SEAM(sb + 5);
        }
        if (PH_ON(6) && RUN(sb + 6)) { TID_HERE;
            __syncthreads();
            { pg8::Gemm g{ACC, WOUT, opq(ML), opq(D), opq(D), 0}; pg8::StaticOrder S; S.init(g.M, g.N, G, (int)blockIdx.x);
              pg8::EpiResid E{xlat_in, xctx_in, outb(), XC, modl, 2 * D};
              pg8::gemm_phase<pg8::EpiResid, pg8::StaticOrder, PG8_ALIGN, PG8_SP2>(lds, g, S, E); }
            if (!lastl) { pg8::Gemm g{ACC, WOUT, opq(MT), opq(D), opq(D / NSPLIT), opq(D)}; pg8::CtxSplitOrder S{NSPLIT, D / NSPLIT, (int)blockIdx.x};
              pg8::EpiSlab E{(float*)(wsb() + WS_SLAB), D / NSPLIT};
              pg8::gemm_phase<pg8::EpiSlab, pg8::CtxSplitOrder, PG8_ALIGN, PG8_SP2>(lds, g, S, E); }
            SEAM(sb + 6);
        }
        if (PH_ON(7) && RUN(sb + 7)) { TID_HERE;
            ph_norm(outb(), xctx_in, inp(I_G2) + (size_t)l * D, modl, 3 * D, 4 * D, H, Mrows, (const float*)(wsb() + WS_SLAB), modl + (size_t)4 * 12288 + 2 * D, XC, wave, lane);
            SEAM(sb + 7);
        }
        if (PH_ON(8) && RUN(sb + 8)) { TID_HERE;
            __syncthreads();
            if (SKEW_US > 0 && (blockIdx.x & 8)) spin_us(SKEW_US);
            pg8::Gemm g{H, WF1, Mrows, opq(NFF), opq(D), 0}; pg8::StaticOrder S; S.init(g.M, g.N, G, (int)blockIdx.x);
            pg8::EpiFfn E{U, (bf16*)(wsb() + WS_SA), (bf16*)(wsb() + WS_SB), inp(I_FFCW) + (size_t)l * 3 * DFF, inp(I_FFCB) + (size_t)l * DFF};
            for (int r_ = 0; r_ < DUPN(14); ++r_) pg8::gemm_phase<pg8::EpiFfn, pg8::StaticOrder, PG8_ALIGN, PG8_SP2>(lds, g, S, E);
            SEAM(sb + 8);
        }
        if (PH_ON(9) && RUN(sb + 9)) { TID_HERE;
            for (int r_ = 0; r_ < DUPN(11); ++r_) ph_ffnfix(A, l, Mrows, tid);
            SEAM(sb + 9);
        }
        if (PH_ON(10) && RUN(sb + 10)) { TID_HERE;
            __syncthreads();
            { pg8::Gemm g{U, WF2, opq(ML), opq(D), opq(DFF), 0}; pg8::StaticOrder S; S.init(g.M, g.N, G, (int)blockIdx.x);
              pg8::EpiResid E{outb(), XC, outb(), XC, modl, 5 * D};
              pg8::gemm_phase<pg8::EpiResid, pg8::StaticOrder, PG8_ALIGN, PG8_SP2>(lds, g, S, E); }
            if (!lastl) { pg8::Gemm g{U, WF2, opq(MT), opq(D), opq(DFF / NSPLIT), opq(DFF)}; pg8::CtxSplitOrder S{NSPLIT, DFF / NSPLIT, (int)blockIdx.x};
              pg8::EpiSlab E{(float*)(wsb() + WS_SLAB), DFF / NSPLIT};
              pg8::gemm_phase<pg8::EpiSlab, pg8::CtxSplitOrder, PG8_ALIGN, PG8_SP2>(lds, g, S, E); }
            SEAM(sb + 10);
        }
    }
    if (PH_ON(101) && RUN(NSEQ - 1)) { TID_HERE; ph_final(A, wave, lane); }
#undef RUN
#undef SEAM
#undef H
#undef Z
#undef ACC
#undef U
#undef YS
#undef XC
#undef WIN
#undef WBR
#undef WOUT
#undef WF1
#undef WF2
#undef G
#undef modl
#undef xlat_in
#undef xctx_in
}

extern "C" void kernel_launch(void* const* d_in, const int* in_sizes, int n_in, void* d_out, int out_size, void* d_ws, size_t ws_size, hipStream_t stream) {
    static int grid = 0;
    if (grid == 0) {
        if (n_in != 27 || out_size != ML * D || ws_size < WS_END) { fprintf(stderr, "kernel_launch: unexpected shapes (n_in %d out %d ws %zu need %zu)\n", n_in, out_size, ws_size, (size_t)WS_END); grid = -1; return; }
        int dev = 0, cus = 0, per_cu = 0;
        if (hipGetDevice(&dev) != hipSuccess || hipDeviceGetAttribute(&cus, hipDeviceAttributeMultiprocessorCount, dev) != hipSuccess) { grid = -1; return; }
        if (hipFuncSetAttribute((const void*)fwd, hipFuncAttributeMaxDynamicSharedMemorySize, LDS_BYTES) != hipSuccess) { fprintf(stderr, "kernel_launch: hipFuncSetAttribute failed\n"); grid = -1; return; }
        if (hipOccupancyMaxActiveBlocksPerMultiprocessor(&per_cu, (const void*)fwd, NWAVES * 64, LDS_BYTES) != hipSuccess || per_cu < 1) fprintf(stderr, "kernel_launch: occupancy query says %d\n", per_cu);
        (void)hipGetLastError();
        grid = cus;
    }
    if (grid < 0) return;
    (void)hipMemsetAsync((char*)d_ws + WS_CTL, 0, CTL_ZERO_BYTES, stream);
    Args a{};
    for (int i = 0; i < 27; ++i) a.in[i] = (const float*)d_in[i];
    a.out = (float*)d_out; a.ws = (unsigned char*)d_ws;
#if MK_SINGLE
    a.seq_lo = 0; a.seq_hi = NSEQ;
    hipLaunchKernelGGL(fwd, dim3(grid), dim3(NWAVES * 64), LDS_BYTES, stream, a);
#else
    for (int s = 0; s < NSEQ; ++s) { a.seq_lo = s; a.seq_hi = s + 1; hipLaunchKernelGGL(fwd, dim3(grid), dim3(NWAVES * 64), LDS_BYTES, stream, a); }
#endif
}
```

```cpp
#include <hip/hip_runtime.h>
#include <cstdio>
#include <cstdint>
#ifndef MK_SINGLE
#define MK_SINGLE 1
#endif
namespace pg8 {
#define PG8_LAS __attribute__((address_space(3)))
typedef unsigned short bf16_t;
typedef short bf16x8 __attribute__((ext_vector_type(8)));
typedef float f32x4 __attribute__((ext_vector_type(4)));
typedef unsigned u32x4 __attribute__((ext_vector_type(4)));
constexpr int BM = 256, BK = 64, HALF = 128, HTB = HALF * BK * 2  , STAGE_BYTES = 8 * HTB, NXCD = 8, WGM = 8;

__host__ __device__ __forceinline__ int lds_byte(int r, int c) { const int st = (r >> 4) * 2 + (c >> 5), rr = r & 15, cc = c & 31, ob = rr * 64 + cc * 2; return st * 1024 + (ob ^ (((ob >> 9) & 1) << 5)); }
__host__ __device__ __forceinline__ void stage_rc(int b, int& R, int& C) { const int st = b / 1024, sb = b % 1024, swz = sb ^ (((sb >> 9) & 1) << 5); R = (st >> 1) * 16 + swz / 64; C = (st & 1) * 32 + (swz % 64) / 2; }
__host__ __device__ __forceinline__ int perm32(int rho) { const int n = rho >> 4, i = rho & 15; return 8 * (i >> 2) + 4 * n + (i & 3); }

struct Unit { int pm, pn, ko; };
struct Gemm { const bf16_t* A; const bf16_t* Bt; int M, N, K, ld; };

struct StaticOrder {
    int nM, nN, nwg, G, c;
    __host__ __device__ void init(int M, int N, int G_, int c_) { nM = M / BM; nN = N / BM; nwg = nM * nN; G = G_; c = c_; }
    __host__ __device__ bool next(int i, Unit& u) const {
        const long L = (long)i * G + c; if (L >= nwg) return false;
        int wgid = (int)L; { const int q = nwg / NXCD, r = nwg % NXCD, xcd = wgid % NXCD, off = wgid / NXCD; wgid = (xcd < r ? xcd * (q + 1) : r * (q + 1) + (xcd - r) * q) + off; }
        const int nig = WGM * nN, gid = wgid / nig, fm = gid * WGM, gsz = (nM - fm) < WGM ? (nM - fm) : WGM;
        u.pm = fm + ((wgid % nig) % gsz); u.pn = (wgid % nig) / gsz; u.ko = 0; return true;
    }
    __device__ __forceinline__ void a_ready(const Unit&) const {}
    __device__ __forceinline__ void done(const Unit&) const {}
};
__device__ __forceinline__ unsigned cvt_pk_bf16(float lo, float hi) { unsigned r; asm volatile("v_cvt_pk_bf16_f32 %0, %1, %2" : "=v"(r) : "v"(lo), "v"(hi)); return r; }
typedef float f32x2 __attribute__((ext_vector_type(2)));
__device__ __forceinline__ float bflo(unsigned w) { return __uint_as_float(w << 16); }
__device__ __forceinline__ float bfhi(unsigned w) { return __uint_as_float(w & 0xffff0000u); }
__device__ __forceinline__ float sigm(float x) { return 1.0f / (1.0f + __expf(-x)); }
struct EpiStore {
    static constexpr bool PERM = true, AFTER_DRAIN = false;
    bf16_t* O; int ldc;
    __device__ __forceinline__ void operator()(const f32x4 (&acc)[2][2][4][2], const Unit& u, int wr, int wc, int fr, int fq) const {
        const int row0 = u.pm * BM + wr * 64 + fr, col0 = u.pn * BM + wc * 32 + 8 * fq;
#pragma unroll
        for (int ai = 0; ai < 2; ++ai)
#pragma unroll
            for (int m = 0; m < 4; ++m) { bf16_t* rowp = O + (size_t)(row0 + ai * HALF + m * 16) * ldc + col0;
#pragma unroll
                for (int bj = 0; bj < 2; ++bj) { const f32x4 v0 = acc[ai][bj][m][0], v1 = acc[ai][bj][m][1];
                    u32x4 w; w.x = cvt_pk_bf16(v0[0], v0[1]); w.y = cvt_pk_bf16(v0[2], v0[3]); w.z = cvt_pk_bf16(v1[0], v1[1]); w.w = cvt_pk_bf16(v1[2], v1[3]);
                    *(u32x4*)(rowp + bj * HALF) = w; } }
    }
};
struct EpiMerge {
    static constexpr bool PERM = true, AFTER_DRAIN = false;
    bf16_t* O; const bf16_t* gate; int ldg; int first;
    __device__ __forceinline__ void operator()(const f32x4 (&acc)[2][2][4][2], const Unit& u, int wr, int wc, int fr, int fq) const {
        const int row0 = u.pm * BM + wr * 64 + fr, col0 = u.pn * BM + wc * 32 + 8 * fq;
#pragma unroll
        for (int ai = 0; ai < 2; ++ai)
#pragma unroll
            for (int m = 0; m < 4; ++m) { const size_t row = (size_t)(row0 + ai * HALF + m * 16);
#pragma unroll
                for (int bj = 0; bj < 2; ++bj) { const int col = col0 + bj * HALF;
                    const u32x4 gv = *(const u32x4*)(gate + row * ldg + col);
                    u32x4 pv = (u32x4){0u, 0u, 0u, 0u}; if (!first) pv = *(const u32x4*)(O + row * 2048 + col);
                    const f32x4 v0 = acc[ai][bj][m][0], v1 = acc[ai][bj][m][1];
                    u32x4 w;
                    w.x = cvt_pk_bf16(bflo(pv.x) + v0[0] * sigm(bflo(gv.x)), bfhi(pv.x) + v0[1] * sigm(bfhi(gv.x)));
                    w.y = cvt_pk_bf16(bflo(pv.y) + v0[2] * sigm(bflo(gv.y)), bfhi(pv.y) + v0[3] * sigm(bfhi(gv.y)));
                    w.z = cvt_pk_bf16(bflo(pv.z) + v1[0] * sigm(bflo(gv.z)), bfhi(pv.z) + v1[1] * sigm(bfhi(gv.z)));
                    w.w = cvt_pk_bf16(bflo(pv.w) + v1[2] * sigm(bflo(gv.w)), bfhi(pv.w) + v1[3] * sigm(bfhi(gv.w)));
                    *(u32x4*)(O + row * 2048 + col) = w; } }
    }
};
struct EpiResid {
    static constexpr bool PERM = false, AFTER_DRAIN = false;
    const float* base_lat; const float* base_ctx; float* out_lat; float* out_ctx; const float* modl; int goff;
    __device__ __forceinline__ void operator()(const f32x4 (&acc)[2][2][4][2], const Unit& u, int wr, int wc, int fr, int fq) const {
        const bool isctx = u.pm >= 64; const int r = isctx ? 4 : (u.pm >> 4);
        const float* gvp = modl + (size_t)r * 12288 + goff;
        const float* bs = isctx ? base_ctx : base_lat; float* os = isctx ? out_ctx : out_lat;
        const int row0 = (isctx ? u.pm - 64 : u.pm) * BM + wr * 64 + fr, col0 = u.pn * BM + wc * 32 + 4 * fq;
        f32x4 g4[2][2];
#pragma unroll
        for (int bj = 0; bj < 2; ++bj)
#pragma unroll
            for (int n = 0; n < 2; ++n) g4[bj][n] = *(const f32x4*)(gvp + col0 + bj * HALF + n * 16);
#pragma unroll
        for (int ai = 0; ai < 2; ++ai)
#pragma unroll
            for (int m = 0; m < 4; ++m) { const size_t off = (size_t)(row0 + ai * HALF + m * 16) * 2048 + col0;
#pragma unroll
                for (int bj = 0; bj < 2; ++bj)
#pragma unroll
                    for (int n = 0; n < 2; ++n) { const f32x4 b4 = *(const f32x4*)(bs + off + bj * HALF + n * 16);
                        *(f32x4*)(os + off + bj * HALF + n * 16) = b4 + g4[bj][n] * acc[ai][bj][m][n]; } }
    }
};

__device__ __forceinline__ float dpp_ror1(float v) { return __int_as_float(__builtin_amdgcn_update_dpp(0, __float_as_int(v), 0x121, 0xf, 0xf, false)); }
__device__ __forceinline__ float dpp_rol1(float v) { return __int_as_float(__builtin_amdgcn_update_dpp(0, __float_as_int(v), 0x12f, 0xf, 0xf, false)); }
__device__ __forceinline__ float gelu_fast(float x) { const float x2 = x * x; const float arg = x * (x2 * (-2.0f * 1.4426950408889634f * 0.7978845608028654f * 0.044715f) + (-2.0f * 1.4426950408889634f * 0.7978845608028654f));
    return x * __builtin_amdgcn_rcpf(1.0f + __builtin_amdgcn_exp2f(arg)); }
struct EpiFfn {
    static constexpr bool PERM = true, AFTER_DRAIN = false;
    bf16_t* U; bf16_t* SA; bf16_t* SB; const float* cw; const float* cb;
    __device__ __forceinline__ void operator()(const f32x4 (&acc)[2][2][4][2], const Unit& u, int wr, int wc, int fr, int fq) const {
        const int f0 = u.pn * 128 + wc * 32 + 8 * fq;
        f32x4 w0[2], w1[2], w2[2], bb[2];
#pragma unroll
        for (int n = 0; n < 2; ++n) { w0[n] = *(const f32x4*)(cw + f0 + 4 * n); w1[n] = *(const f32x4*)(cw + 5632 + f0 + 4 * n); w2[n] = *(const f32x4*)(cw + 2 * 5632 + f0 + 4 * n); bb[n] = *(const f32x4*)(cb + f0 + 4 * n); }
#pragma unroll
        for (int ai = 0; ai < 2; ++ai) {
            const int row0 = u.pm * BM + ai * HALF + wr * 64 + fr, blk = u.pm * 4 + ai * 2 + wr;
            f32x4 o[4][2];
#pragma unroll
            for (int n = 0; n < 2; ++n)
#pragma unroll
                for (int e = 0; e < 4; ++e) {
                    const float a0 = acc[ai][0][0][n][e], a1 = acc[ai][0][1][n][e], a2 = acc[ai][0][2][n][e], a3 = acc[ai][0][3][n][e];
                    const float r0 = dpp_ror1(a0), r1 = dpp_ror1(a1), r2 = dpp_ror1(a2), r3 = dpp_ror1(a3);
                    const float l0 = dpp_rol1(a0), l1 = dpp_rol1(a1), l2 = dpp_rol1(a2), l3 = dpp_rol1(a3);
                    const bool first = (fr == 0), last = (fr == 15);
                    const float p0 = r0, p1 = first ? r0 : r1, p2 = first ? r1 : r2, p3 = first ? r2 : r3;
                    const float n0 = last ? l1 : l0, n1 = last ? l2 : l1, n2 = last ? l3 : l2, n3 = l3;
                    const float k0 = w0[n][e], k1 = w1[n][e], k2 = w2[n][e], kb = bb[n][e];
                    o[0][n][e] = gelu_fast(k0 * p0 + k1 * a0 + k2 * n0 + kb) * acc[ai][1][0][n][e];
                    o[1][n][e] = gelu_fast(k0 * p1 + k1 * a1 + k2 * n1 + kb) * acc[ai][1][1][n][e];
                    o[2][n][e] = gelu_fast(k0 * p2 + k1 * a2 + k2 * n2 + kb) * acc[ai][1][2][n][e];
                    o[3][n][e] = gelu_fast(k0 * p3 + k1 * a3 + k2 * n3 + kb) * acc[ai][1][3][n][e];
                }
#pragma unroll
            for (int m = 0; m < 4; ++m) { u32x4 w; w.x = cvt_pk_bf16(o[m][0][0], o[m][0][1]); w.y = cvt_pk_bf16(o[m][0][2], o[m][0][3]); w.z = cvt_pk_bf16(o[m][1][0], o[m][1][1]); w.w = cvt_pk_bf16(o[m][1][2], o[m][1][3]);
                *(u32x4*)(U + (size_t)(row0 + m * 16) * 5632 + f0) = w; }
            const int sel = (fr == 0) ? 0 : (fr == 1) ? 1 : (fr == 14) ? 2 : (fr == 15) ? 3 : -1;
            if (sel >= 0) { const int m = (sel < 2) ? 0 : 3;
                const f32x4 a0 = (m == 0) ? acc[ai][0][0][0] : acc[ai][0][3][0], a1 = (m == 0) ? acc[ai][0][0][1] : acc[ai][0][3][1];
                u32x4 w; w.x = cvt_pk_bf16(a0[0], a0[1]); w.y = cvt_pk_bf16(a0[2], a0[3]); w.z = cvt_pk_bf16(a1[0], a1[1]); w.w = cvt_pk_bf16(a1[2], a1[3]);
                *(u32x4*)(SA + ((size_t)blk * 4 + sel) * 5632 + f0) = w;
                if (sel == 0 || sel == 3) { const f32x4 b0 = (m == 0) ? acc[ai][1][0][0] : acc[ai][1][3][0], b1 = (m == 0) ? acc[ai][1][0][1] : acc[ai][1][3][1];
                    u32x4 v; v.x = cvt_pk_bf16(b0[0], b0[1]); v.y = cvt_pk_bf16(b0[2], b0[3]); v.z = cvt_pk_bf16(b1[0], b1[1]); v.w = cvt_pk_bf16(b1[2], b1[3]);
                    *(u32x4*)(SB + ((size_t)blk * 2 + (sel == 0 ? 0 : 1)) * 5632 + f0) = v; } }
        }
    }
};

struct CtxSplitOrder {
    int nsplit, klen, c;
    __device__ __forceinline__ bool next(int i, Unit& u) const { if (i > 0 || c >= 32 * nsplit) return false; const int tile = c / nsplit, s = c - tile * nsplit; u.pm = 64 + (tile >> 3); u.pn = tile & 7; u.ko = s * klen; return true; }
    __device__ __forceinline__ void a_ready(const Unit&) const {}
    __device__ __forceinline__ void done(const Unit&) const {}
};
struct EpiSlab {
    static constexpr bool PERM = false, AFTER_DRAIN = false;
    float* slab; int klen;
    __device__ __forceinline__ void operator()(const f32x4 (&acc)[2][2][4][2], const Unit& u, int wr, int wc, int fr, int fq) const {
        float* os = slab + (size_t)(u.ko / klen) * 1024 * 2048;
        const int row0 = (u.pm - 64) * BM + wr * 64 + fr, col0 = u.pn * BM + wc * 32 + 4 * fq;
#pragma unroll
        for (int ai = 0; ai < 2; ++ai)
#pragma unroll
            for (int m = 0; m < 4; ++m) { const size_t off = (size_t)(row0 + ai * HALF + m * 16) * 2048 + col0;
#pragma unroll
                for (int bj = 0; bj < 2; ++bj)
#pragma unroll
                    for (int n = 0; n < 2; ++n) *(f32x4*)(os + off + bj * HALF + n * 16) = acc[ai][bj][m][n]; }
    }
};
template <class Epi, class Sched, bool ALIGN_EPI = false, bool SP2 = false>
__device__ __forceinline__ void gemm_phase(PG8_LAS unsigned char* lds, const Gemm g, const Sched& S, const Epi& E) {
    int tid_ = threadIdx.x; asm volatile("" : "+v"(tid_)); const int tid = tid_, wid = __builtin_amdgcn_readfirstlane(tid >> 6), lane = tid & 63, wr = wid >> 2, wc = wid & 3, fr = lane & 15, fq = lane >> 4;
    const int K = g.K, nt = K / BK, LD = g.ld ? g.ld : g.K;
    unsigned voffA[2], voffB[2];
#pragma unroll
    for (int i = 0; i < 2; ++i) { int R, C; stage_rc(tid * 16 + i * 8192, R, C); const int Rb = Epi::PERM ? ((R & ~31) + perm32(R & 31)) : R;
        voffA[i] = (unsigned)(R * LD + C) * 2u; voffB[i] = (unsigned)(Rb * LD + C) * 2u; }
    const size_t kstep = (size_t)(BK * 2);
    const size_t hstep = (size_t)HALF * LD * 2;
    const size_t tstep = 2 * hstep;
    const unsigned ldsw = (unsigned)wid * 1024u;
    const int aoff = lds_byte(wr * 64 + fr, fq * 8), boff = lds_byte(wc * 32 + fr, fq * 8);
#define PG8_SA(b, h) (((b) * 2 + (h)) * HTB)
#define PG8_SB(b, h) ((4 + (b) * 2 + (h)) * HTB)
#define PG8_STAGE(bufoff, gbase, voff) do { _Pragma("unroll") for (int _i = 0; _i < 2; ++_i) \
        __builtin_amdgcn_global_load_lds((const unsigned*)((const char*)(gbase) + (voff)[_i]), (PG8_LAS unsigned*)(lds + (bufoff) + ldsw + _i * 8192), 16, 0, 0); } while (0)
#define PG8_LDA(dst, b, h) do { _Pragma("unroll") for (int m = 0; m < 4; ++m) _Pragma("unroll") for (int k = 0; k < 2; ++k) dst[m][k] = *(const PG8_LAS bf16x8*)(lds + PG8_SA(b, h) + aoff + m * 2048 + k * 1024); } while (0)
#define PG8_LDB(dst, b, h) do { _Pragma("unroll") for (int n = 0; n < 2; ++n) _Pragma("unroll") for (int k = 0; k < 2; ++k) dst[n][k] = *(const PG8_LAS bf16x8*)(lds + PG8_SB(b, h) + boff + n * 2048 + k * 1024); } while (0)
#define PG8_MMA(ai, bj, At, Bt) do { __builtin_amdgcn_s_setprio(1); _Pragma("unroll") for (int m = 0; m < 4; ++m) _Pragma("unroll") for (int n = 0; n < 2; ++n) _Pragma("unroll") for (int k = 0; k < 2; ++k) \
        acc[ai][bj][m][n] = __builtin_amdgcn_mfma_f32_16x16x32_bf16(Bt[n][k], At[m][k], acc[ai][bj][m][n], 0, 0, 0); __builtin_amdgcn_s_setprio(0); } while (0)
#define PG8_WAIT_V(n) asm volatile("s_waitcnt vmcnt(" #n ")" ::: "memory")
#define PG8_WAIT_L(n) asm volatile("s_waitcnt lgkmcnt(" #n ")" ::: "memory")
#define PG8_BAR __builtin_amdgcn_s_barrier()
#define PG8_SCHED __builtin_amdgcn_sched_barrier(0)
    Unit cur, nxt; int ui = 0;
    if (!S.next(0, cur)) return;
    f32x4 acc[2][2][4][2];
#pragma unroll
    for (int a = 0; a < 2; ++a)
#pragma unroll
        for (int b = 0; b < 2; ++b)
#pragma unroll
            for (int m = 0; m < 4; ++m)
#pragma unroll
                for (int n = 0; n < 2; ++n) acc[a][b][m][n] = (f32x4){0.f, 0.f, 0.f, 0.f};
    bf16x8 At[4][2], B0[2][2], B1[2][2];
    const char* cA = (const char*)g.A + (size_t)cur.pm * tstep + (size_t)cur.ko * 2; const char* cB = (const char*)g.Bt + (size_t)cur.pn * tstep + (size_t)cur.ko * 2;
    S.a_ready(cur);
    if constexpr (SP2) {
        PG8_STAGE(PG8_SB(0, 0), cB, voffB); PG8_STAGE(PG8_SB(0, 1), cB + hstep, voffB); PG8_STAGE(PG8_SA(0, 0), cA, voffA); PG8_STAGE(PG8_SA(0, 1), cA + hstep, voffA);
        if (wr == 1) PG8_BAR;
        PG8_WAIT_V(2); PG8_BAR;
        PG8_STAGE(PG8_SB(1, 0), cB + kstep, voffB); PG8_STAGE(PG8_SA(1, 0), cA + kstep, voffA); PG8_STAGE(PG8_SB(1, 1), cB + hstep + kstep, voffB);
        PG8_WAIT_V(6); PG8_BAR;
    } else {
        PG8_STAGE(PG8_SB(0, 0), cB, voffB); PG8_STAGE(PG8_SA(0, 0), cA, voffA); PG8_STAGE(PG8_SB(0, 1), cB + hstep, voffB); PG8_STAGE(PG8_SA(0, 1), cA + hstep, voffA);
        if (wr == 1) PG8_BAR;
        PG8_WAIT_V(4); PG8_BAR;
        PG8_STAGE(PG8_SB(1, 0), cB + kstep, voffB); PG8_STAGE(PG8_SA(1, 0), cA + kstep, voffA); PG8_STAGE(PG8_SB(1, 1), cB + hstep + kstep, voffB);
        PG8_WAIT_V(6); PG8_BAR;
    }
    for (;;) {
        const bool has_next = S.next(ui + 1, nxt);
        const char* nA = has_next ? (const char*)g.A + (size_t)nxt.pm * tstep + (size_t)nxt.ko * 2 : cA; const char* nB = has_next ? (const char*)g.Bt + (size_t)nxt.pn * tstep + (size_t)nxt.ko * 2 : cB;
        for (int t = 0; t < nt; t += 2) {
            const bool last = (t == nt - 2);
            const char* a1 = cA + (size_t)(t + 1) * kstep;
            const char* a2 = last ? nA : cA + (size_t)(t + 2) * kstep; const char* b2 = last ? nB : cB + (size_t)(t + 2) * kstep;
            const char* a3 = a2 + kstep; const char* b3 = b2 + kstep;
            if (last && has_next) S.a_ready(nxt);
            if constexpr (SP2) {
            PG8_LDB(B0, 0, 0); PG8_LDB(B1, 0, 1); PG8_SCHED; PG8_LDA(At, 0, 0); PG8_STAGE(PG8_SA(1, 1), a1 + hstep, voffA);
            PG8_WAIT_V(8); PG8_WAIT_L(0); PG8_BAR; PG8_MMA(0, 0, At, B0); PG8_MMA(0, 1, At, B1); PG8_BAR; PG8_SCHED;
            PG8_LDA(At, 0, 1); PG8_STAGE(PG8_SB(0, 0), b2, voffB); PG8_STAGE(PG8_SB(0, 1), b2 + hstep, voffB); PG8_STAGE(PG8_SA(0, 0), a2, voffA);
            PG8_WAIT_V(8); PG8_WAIT_L(0); PG8_BAR; PG8_MMA(1, 0, At, B0); PG8_MMA(1, 1, At, B1); PG8_BAR; PG8_SCHED;
            PG8_LDB(B0, 1, 0); PG8_LDB(B1, 1, 1); PG8_SCHED; PG8_LDA(At, 1, 0); PG8_STAGE(PG8_SA(0, 1), a2 + hstep, voffA);
            PG8_WAIT_V(8); PG8_WAIT_L(0); PG8_BAR; PG8_MMA(0, 0, At, B0); PG8_MMA(0, 1, At, B1); PG8_BAR; PG8_SCHED;
            PG8_LDA(At, 1, 1); PG8_STAGE(PG8_SB(1, 0), b3, voffB); PG8_STAGE(PG8_SB(1, 1), b3 + hstep, voffB); PG8_STAGE(PG8_SA(1, 0), a3, voffA);
            PG8_WAIT_V(8); PG8_WAIT_L(0); PG8_BAR; PG8_MMA(1, 0, At, B0); PG8_MMA(1, 1, At, B1); PG8_BAR; PG8_SCHED;
            } else {
            PG8_LDB(B0, 0, 0); PG8_SCHED; PG8_LDA(At, 0, 0); PG8_STAGE(PG8_SA(1, 1), a1 + hstep, voffA);
            PG8_WAIT_L(8); PG8_BAR; PG8_WAIT_L(0); PG8_MMA(0, 0, At, B0); PG8_BAR; PG8_SCHED;
            PG8_LDB(B1, 0, 1); PG8_STAGE(PG8_SB(0, 0), b2, voffB);
            PG8_BAR; PG8_WAIT_L(0); PG8_MMA(0, 1, At, B1); PG8_BAR;
            PG8_LDA(At, 0, 1); PG8_STAGE(PG8_SA(0, 0), a2, voffA);
            PG8_BAR; PG8_WAIT_L(0); PG8_MMA(1, 0, At, B0); PG8_BAR; PG8_SCHED;
            PG8_STAGE(PG8_SB(0, 1), b2 + hstep, voffB);
            PG8_WAIT_V(6); PG8_BAR; PG8_MMA(1, 1, At, B1); PG8_BAR;
            PG8_LDB(B0, 1, 0); PG8_SCHED; PG8_LDA(At, 1, 0); PG8_STAGE(PG8_SA(0, 1), a2 + hstep, voffA);
            PG8_WAIT_L(8); PG8_BAR; PG8_WAIT_L(0); PG8_MMA(0, 0, At, B0); PG8_BAR; PG8_SCHED;
            PG8_LDB(B1, 1, 1); PG8_STAGE(PG8_SB(1, 0), b3, voffB);
            PG8_BAR; PG8_WAIT_L(0); PG8_MMA(0, 1, At, B1); PG8_BAR;
            PG8_LDA(At, 1, 1); PG8_STAGE(PG8_SA(1, 0), a3, voffA);
            PG8_BAR; PG8_WAIT_L(0); PG8_MMA(1, 0, At, B0); PG8_BAR; PG8_SCHED;
            PG8_STAGE(PG8_SB(1, 1), b3 + hstep, voffB);
            PG8_WAIT_V(6); PG8_BAR; PG8_MMA(1, 1, At, B1); PG8_BAR;
            }
        }
        if constexpr (ALIGN_EPI) { if (wr == 0) PG8_BAR; }
        if constexpr (!Epi::AFTER_DRAIN) { E(acc, cur, wr, wc, fr, fq); S.done(cur); }
        if (!has_next) break;
#pragma unroll
        for (int a = 0; a < 2; ++a)
#pragma unroll
            for (int b = 0; b < 2; ++b)
#pragma unroll
                for (int m = 0; m < 4; ++m)
#pragma unroll
                    for (int n = 0; n < 2; ++n) acc[a][b][m][n] = (f32x4){0.f, 0.f, 0.f, 0.f};
        cur = nxt; cA = nA; cB = nB; ++ui;
        if constexpr (ALIGN_EPI) { if (wr == 1) PG8_BAR; }
    }
    PG8_WAIT_V(0);
    if constexpr (!ALIGN_EPI) { if (wr == 0) PG8_BAR; }
    PG8_BAR;
    if constexpr (Epi::AFTER_DRAIN) { E.fused(acc, cur, wr, wc, fr, fq, lds, wid, lane); S.done(cur); }
#undef PG8_SA
#undef PG8_SB
#undef PG8_STAGE
#undef PG8_LDA
#undef PG8_LDB
#undef PG8_MMA
#undef PG8_WAIT_V
#undef PG8_WAIT_L
#undef PG8_BAR
#undef PG8_SCHED
}
}
#ifndef PG8_SP2
#define PG8_SP2 true
#endif
#ifndef PG8_ALIGN
#define PG8_ALIGN true
#endif
constexpr int D = 2048, NB = 4, SEQ = 4096, CL = 256, DEPTH = 4;
constexpr int ML = NB * SEQ, MC = NB * CL, MT = ML + MC;
constexpr int INW = 15360, DFF = 5632, NFF = 2 * DFF;
constexpr int C_RK = 0, C_RV = 512, C_NK = 1536, C_NV = 2560, C_RQ = 3584, C_RG = 4096, C_NQ = 5120, C_HY = 6144, C_GT = 9216;
constexpr float EPS = 1e-6f;
constexpr int NWAVES = 8;
constexpr size_t al256(size_t x) { return (x + 255) & ~(size_t)255; }
constexpr size_t WS_CTL = 0, CTL_ZERO_BYTES = 1u << 20;
constexpr size_t WS_MOD = WS_CTL + CTL_ZERO_BYTES;
constexpr size_t WS_ROPE = WS_MOD + al256((size_t)4 * 5 * 12288 * 4);
constexpr size_t PS_FH2 = 0;
constexpr size_t PS_FH2B = PS_FH2 + al256((size_t)4352 * 64 * 4);
constexpr size_t PS_TAPC = PS_FH2B + al256((size_t)4352 * 64 * 2);
constexpr size_t PS_KF = PS_TAPC + al256((size_t)2 * 2 * 1024 * 256 * 4);
constexpr size_t PS_WIN = PS_KF + al256((size_t)2 * 1024 * 8192 * 8);
constexpr size_t PS_WBR = PS_WIN + al256((size_t)INW * D * 2);
constexpr size_t PS_WOUT = PS_WBR + al256((size_t)3 * D * 1024 * 2);
constexpr size_t PS_WF1 = PS_WOUT + al256((size_t)D * D * 2);
constexpr size_t PS_WF2 = PS_WF1 + al256((size_t)NFF * D * 2);
constexpr size_t PS_BYTES = PS_WF2 + al256((size_t)D * DFF * 2);
constexpr size_t WS_PSET = WS_ROPE + al256(64 * 16 * 8);
constexpr size_t WS_XC = WS_PSET + 2 * PS_BYTES;
constexpr size_t WS_H = WS_XC + al256((size_t)MC * D * 4);
constexpr size_t WS_Z = WS_H + al256((size_t)MT * D * 2);
constexpr size_t WS_HYT = WS_Z + al256((size_t)MT * INW * 2);
constexpr size_t WS_YT = WS_HYT + al256((size_t)3 * NB * 1024 * SEQ * 2);
constexpr size_t WS_YS = WS_YT + al256((size_t)NB * 1024 * SEQ * 2);
constexpr size_t WS_ACC = WS_YS + al256((size_t)3 * MT * 1024 * 2);
constexpr size_t WS_U = WS_ACC + al256((size_t)MT * D * 2);
constexpr size_t WS_KV = WS_U + al256((size_t)MT * DFF * 2);
constexpr size_t WS_SA = WS_KV + al256((size_t)NB * 8 * 2 * 34 * 8192 * 4);
constexpr size_t WS_SB = WS_SA + al256((size_t)272 * 4 * DFF * 2);
constexpr size_t WS_SLAB = WS_SB + al256((size_t)272 * 2 * DFF * 2);
constexpr size_t WS_FB4 = WS_SLAB + al256((size_t)4 * MC * D * 4);
constexpr size_t WS_END = WS_FB4 + al256((size_t)4 * 4352 * 64 * 2);
constexpr int NSPLIT = 4;
constexpr int CW_BAR = 4096;
constexpr int RING_BYTES = 131072, LDSCTL_OFF = RING_BYTES, MISC_OFF = LDSCTL_OFF + 320, LDS_BYTES = 147456;

#define GAS __attribute__((address_space(1)))
#define LAS __attribute__((address_space(3)))
typedef unsigned short bf16;
typedef unsigned v4u __attribute__((ext_vector_type(4)));
typedef unsigned v2u __attribute__((ext_vector_type(2)));
typedef float f32x4 __attribute__((ext_vector_type(4)));
typedef float f32x2 __attribute__((ext_vector_type(2)));
typedef short bf16x8 __attribute__((ext_vector_type(8)));
typedef GAS unsigned gu32;
#define LDS_WAIT() asm volatile("s_waitcnt lgkmcnt(0)" ::: "memory")
__device__ __forceinline__ unsigned f2bf(float f) { unsigned u = __builtin_bit_cast(unsigned, f); return (u + 0x7fffu + ((u >> 16) & 1u)) >> 16; }
__device__ __forceinline__ unsigned pk2(float lo, float hi) { return f2bf(lo) | (f2bf(hi) << 16); }
__device__ __forceinline__ float bflo(unsigned w) { return __uint_as_float(w << 16); }
__device__ __forceinline__ float bfhi(unsigned w) { return __uint_as_float(w & 0xffff0000u); }
__device__ __forceinline__ float bf1(bf16 b) { return __uint_as_float(((unsigned)b) << 16); }
__device__ __forceinline__ bf16x8 mk8(unsigned a, unsigned b, unsigned c, unsigned d) { v4u v = (v4u){a, b, c, d}; return __builtin_bit_cast(bf16x8, v); }
__device__ __forceinline__ f32x4 mfma16(bf16x8 a, bf16x8 b, f32x4 c) { return __builtin_amdgcn_mfma_f32_16x16x32_bf16(a, b, c, 0, 0, 0); }
__device__ __forceinline__ float sin_rev(float r) { return __builtin_amdgcn_sinf(r - floorf(r)); }
__device__ __forceinline__ float cos_rev(float r) { return __builtin_amdgcn_cosf(r - floorf(r)); }
__device__ __forceinline__ float sin_rad(float x) { return sin_rev(x * 0.15915494309189535f); }
__device__ __forceinline__ float ex2(float x) { return __builtin_amdgcn_exp2f(x); }
__device__ __forceinline__ float wave_sum(float v) {
#pragma unroll
    for (int o = 1; o < 64; o <<= 1) v += __shfl_xor(v, o);
    return v;
}
__device__ __forceinline__ int otid() { int t = threadIdx.x; asm volatile("" : "+v"(t)); return t; }
__device__ __forceinline__ int opq(int v) { asm volatile("" : "+s"(v)); return v; }
#define XB_TMO      128
#define XB_XCNT(j)  (256  + 64 * (j))
#define XB_XSUB(j)  (1280 + 64 * (j))
#define XB_XGEN(j)  (2304 + 64 * (j))
#define XB_TOP      3328
#define XB_TOPGEN   3392
#define XCD_BAR_WORDS 3456
#define XB_SPIN_CAP (1u << 18)

__device__ __forceinline__ unsigned xb_ld(unsigned* p)              { return __hip_atomic_load(p, __ATOMIC_RELAXED, __HIP_MEMORY_SCOPE_AGENT); }
__device__ __forceinline__ unsigned xb_add(unsigned* p, unsigned v) { return __hip_atomic_fetch_add(p, v, __ATOMIC_RELAXED, __HIP_MEMORY_SCOPE_AGENT); }
__device__ __forceinline__ unsigned xb_xcc_id() { return (unsigned)__builtin_amdgcn_s_getreg((3 << 11) | 20) & 0xFu; }
#define XB_SPIN(cond, bar) do { unsigned _sp = 0; while (cond) { __builtin_amdgcn_s_sleep(1); \
    if ((++_sp & 255u) == 0u) { if (xb_ld(&(bar)[XB_TMO])) break; if (_sp > XB_SPIN_CAP) { atomicAdd(&(bar)[XB_TMO], 1u); break; } } } } while (0)

struct XcdBarrier {
    unsigned* bar; unsigned x;
    volatile LAS unsigned* st;
};

__device__ __forceinline__ XcdBarrier xcd_barrier_post(unsigned* bar, volatile LAS unsigned* st) {
    XcdBarrier b; b.bar = bar; b.x = xb_xcc_id(); b.st = st;
    if (threadIdx.x == 0) (void)xb_add(&bar[XB_XCNT(b.x)], 1u);
    return b;
}
__device__ __forceinline__ void xcd_barrier_complete(unsigned* bar, unsigned x, unsigned& nloc, unsigned& nx) {
    const unsigned G = gridDim.x * gridDim.y * gridDim.z;
    unsigned sum, cnt, mine, sp = 0u;
    for (;;) {
        sum = 0u; cnt = 0u; mine = 0u;
#pragma unroll
        for (unsigned j = 0; j < 16; ++j) { const unsigned c = xb_ld(&bar[XB_XCNT(j)]); sum += c; cnt += (c > 0u) ? 1u : 0u; mine = (j == x) ? c : mine; }
        if (sum == G) break;
        __builtin_amdgcn_s_sleep(1);
        if ((++sp & 255u) == 0u) { if (xb_ld(&bar[XB_TMO])) break; if (sp > XB_SPIN_CAP) { atomicAdd(&bar[XB_TMO], 1u); break; } }
    }
    nloc = mine > 0u ? mine : 1u; nx = cnt > 0u ? cnt : 1u;
}

__device__ __forceinline__ void xcd_barrier(const XcdBarrier& b) {
    asm volatile("s_waitcnt vmcnt(0)" ::: "memory");
    __syncthreads();
    if (threadIdx.x == 0) {
        unsigned* bar = b.bar;
        __builtin_amdgcn_s_waitcnt(0);
        unsigned nloc = b.st[0], nx = b.st[1];
        if (nloc == 0u) { xcd_barrier_complete(bar, b.x, nloc, nx); b.st[0] = nloc; b.st[1] = nx; }
        const unsigned old = xb_add(&bar[XB_XSUB(b.x)], 1u);
        const unsigned gen = old / nloc;
        if (old + 1u == (gen + 1u) * nloc) {
            __builtin_amdgcn_fence(__ATOMIC_RELEASE, "agent");
            asm volatile("s_waitcnt vmcnt(0)" ::: "memory");
            const unsigned og = xb_add(&bar[XB_TOP], 1u);
            const unsigned tg = og / nx;
            if (og + 1u == (tg + 1u) * nx) xb_add(&bar[XB_TOPGEN], 1u);
            else XB_SPIN(xb_ld(&bar[XB_TOPGEN]) == tg, bar);
            __builtin_amdgcn_fence(__ATOMIC_ACQUIRE, "agent");
            xb_add(&bar[XB_XGEN(b.x)], 1u);
            asm volatile("s_waitcnt vmcnt(0)" ::: "memory");
        } else {
            XB_SPIN(xb_ld(&bar[XB_XGEN(b.x)]) == gen, bar);
            __builtin_amdgcn_fence(__ATOMIC_ACQUIRE, "agent");
            asm volatile("s_waitcnt vmcnt(0)" ::: "memory");
        }
    }
    __syncthreads();
}
__device__ __forceinline__ void p0_transpose_item(const float* W, int K, int N, bf16* WT, int row_off, LAS float* scr, int item, int lane) {
    const int nblk = N / 32, kb = item / nblk, nb = item % nblk, k0 = 64 * kb, n0 = 32 * nb;
#pragma unroll 8
    for (int i = 0; i < 32; ++i) { const int kk = 2 * i + (lane >> 5); scr[kk * 33 + (lane & 31)] = __builtin_nontemporal_load(W + (size_t)(k0 + kk) * N + n0 + (lane & 31)); }
    LDS_WAIT(); asm volatile("" ::: "memory");
    const int c = lane & 7;
#pragma unroll
    for (int j = 0; j < 4; ++j) { const int n = (lane >> 3) + 8 * j; const LAS float* s = scr + (8 * c) * 33 + n;
        v4u o; o.x = pk2(s[0 * 33], s[1 * 33]); o.y = pk2(s[2 * 33], s[3 * 33]); o.z = pk2(s[4 * 33], s[5 * 33]); o.w = pk2(s[6 * 33], s[7 * 33]);
        __builtin_nontemporal_store(o, (GAS v4u*)(WT + (size_t)(row_off + n0 + n) * K + k0 + 8 * c)); }
    LDS_WAIT(); asm volatile("" ::: "memory");
}
struct Args { const float* in[27]; float* out; unsigned char* ws; int seq_lo, seq_hi; };
__device__ __forceinline__ const float* inp(int i) { const char* ka = (const char*)__builtin_amdgcn_kernarg_segment_ptr(); int off = i * 8; asm volatile("" : "+s"(off)); return *(const float* const*)(ka + off); }
__device__ __forceinline__ unsigned char* wsb() { const char* ka = (const char*)__builtin_amdgcn_kernarg_segment_ptr(); int off = 27 * 8 + 8; asm volatile("" : "+s"(off)); return *(unsigned char* const*)(ka + off); }
__device__ __forceinline__ float* outb() { const char* ka = (const char*)__builtin_amdgcn_kernarg_segment_ptr(); int off = 27 * 8; asm volatile("" : "+s"(off)); return *(float* const*)(ka + off); }
__device__ __forceinline__ unsigned char* psb(int set) { return wsb() + WS_PSET + (size_t)set * PS_BYTES; }
enum { I_X = 0, I_C, I_CTX, I_CCTX, I_WMOD, I_BMOD, I_G1, I_G2, I_WIN, I_HCW, I_HCB, I_FW1, I_FB1, I_FW2, I_FB2, I_FW3, I_FFQ, I_HBIAS, I_RDEC, I_RPB, I_WBR, I_WOUT, I_FFW1, I_FFCW, I_FFCB, I_FFW2, I_GF };

__device__ __forceinline__ void ph_prologue(const Args& A, LAS unsigned char* lds, int tid) {
    LAS float* sc = (LAS float*)lds;
    LAS float* red = sc + 5 * 2048;
    const float* c = inp(I_C); const float* cc = inp(I_CCTX);
    for (int i = tid; i < 5 * 2048; i += 512) { const int r = i >> 11, k = i & 2047; const float v = (r < 4) ? c[r * 2048 + k] : cc[k]; sc[i] = v / (1.0f + __expf(-v)); }
    __syncthreads();
    float* mod = (float*)(wsb() + WS_MOD);
    const int kq = tid >> 6, col = tid & 63;
    for (int u = blockIdx.x; u < DEPTH * 192; u += gridDim.x) {
        const int l = u / 192, n0 = (u % 192) * 64;
        const float* W = inp(I_WMOD) + (size_t)l * 2048 * 12288 + n0 + col;
        float a0 = 0.f, a1 = 0.f, a2 = 0.f, a3 = 0.f, a4 = 0.f;
        for (int k = kq * 256; k < kq * 256 + 256; ++k) { const float w = W[(size_t)k * 12288];
            a0 += sc[k] * w; a1 += sc[2048 + k] * w; a2 += sc[4096 + k] * w; a3 += sc[6144 + k] * w; a4 += sc[8192 + k] * w; }
        red[(kq * 5 + 0) * 64 + col] = a0; red[(kq * 5 + 1) * 64 + col] = a1; red[(kq * 5 + 2) * 64 + col] = a2; red[(kq * 5 + 3) * 64 + col] = a3; red[(kq * 5 + 4) * 64 + col] = a4;
        __syncthreads();
        if (tid < 320) { const int r = tid >> 6; float s = inp(I_BMOD)[l * 12288 + n0 + col];
#pragma unroll
            for (int q = 0; q < 8; ++q) s += red[(q * 5 + r) * 64 + col];
            mod[((size_t)l * 5 + r) * 12288 + n0 + col] = s; }
        __syncthreads();
    }
    if (blockIdx.x == 0) { f32x2* rope = (f32x2*)(wsb() + WS_ROPE);
        for (int i = tid; i < 1024; i += 512) { const int pos = i >> 4, j = i & 15; const float inv = exp2f(-(float)j * (13.287712379549449f / 16.0f));
            const float rev = (float)pos * inv * 0.15915494309189535f; rope[i] = (f32x2){cos_rev(rev), sin_rev(rev)}; } }
}

__device__ __forceinline__ void ph_convert(const Args& A, int l, int set, int it_lo, int it_hi, int wk, int nwk, LAS unsigned char* lds, int wave, int lane) {
    LAS float* scr = (LAS float*)(lds + wave * 16384);
    const int gw = wk * NWAVES + wave, NGW = nwk * NWAVES;
    constexpr int I_IN = (D / 64) * (INW / 32), I_BR = (1024 / 64) * (D / 32), I_OUT = (D / 64) * (D / 32), I_F1 = (D / 64) * (NFF / 32);
    const float* win = inp(I_WIN) + (size_t)l * D * INW; const float* wbr = inp(I_WBR) + (size_t)l * 3 * 1024 * D; const float* wout = inp(I_WOUT) + (size_t)l * D * D;
    const float* wf1 = inp(I_FFW1) + (size_t)l * D * NFF; const float* wf2 = inp(I_FFW2) + (size_t)l * DFF * D;
    unsigned char* ps = psb(set);
    bf16* WIN = (bf16*)(ps + PS_WIN); bf16* WBR = (bf16*)(ps + PS_WBR); bf16* WOUT = (bf16*)(ps + PS_WOUT); bf16* WF1 = (bf16*)(ps + PS_WF1); bf16* WF2 = (bf16*)(ps + PS_WF2);
    for (int it = it_lo + gw; it < it_hi; it += NGW) {
        int r = it;
        if (r < I_IN) { p0_transpose_item(win, D, INW, WIN, 0, scr, r, lane); continue; } r -= I_IN;
        if (r < I_BR) { p0_transpose_item(wbr, 1024, D, WBR, 0, scr, r, lane); continue; } r -= I_BR;
        if (r < I_BR) { p0_transpose_item(wbr + (size_t)1024 * D, 1024, D, WBR + (size_t)D * 1024, 0, scr, r, lane); continue; } r -= I_BR;
        if (r < I_BR) { p0_transpose_item(wbr + (size_t)2 * 1024 * D, 1024, D, WBR + (size_t)2 * D * 1024, 0, scr, r, lane); continue; } r -= I_BR;
        if (r < I_OUT) { p0_transpose_item(wout, D, D, WOUT, 0, scr, r, lane); continue; } r -= I_OUT;
        if (r < I_F1) { const int n0 = (r % (NFF / 32)) * 32, f0 = (n0 < DFF) ? n0 : n0 - DFF, nrow = 256 * (f0 >> 7) + ((n0 < DFF) ? 0 : 128) + (f0 & 127);
            p0_transpose_item(wf1, D, NFF, WF1, nrow - n0, scr, r, lane); continue; } r -= I_F1;
        p0_transpose_item(wf2, DFF, D, WF2, 0, scr, r, lane);
    }
}
constexpr int CONV_ITEMS = (D / 64) * (INW / 32) + 3 * (1024 / 64) * (D / 32) + (D / 64) * (D / 32) + (D / 64) * (NFF / 32) + (DFF / 64) * (D / 32);
__device__ __forceinline__ void ph_filt1(const Args& A, int l, int set, int wk, int nwk, LAS unsigned char* lds, int tid) {
    LAS float* feat = (LAS float*)lds;
    LAS float* h1 = feat + 8 * 33;
    const float* w1 = inp(I_FW1) + (size_t)l * 33 * 64; const float* b1 = inp(I_FB1) + l * 64; const float* w2 = inp(I_FW2) + (size_t)l * 64 * 64; const float* b2 = inp(I_FB2) + l * 64;
    const float* fq = inp(I_FFQ) + l * 64; bf16* FH2B = (bf16*)(wsb() + WS_FB4) + (size_t)l * 4352 * 64;
    const int pl = tid >> 6, o = tid & 63;
    for (int u = wk; u < 544; u += nwk) {
        const int pos = u * 8 + pl; const bool isc = pos >= 4096; const int Lf = isc ? 256 : 4096, tp = isc ? pos - 4096 : pos;
        if (o < 33) { float f;
            if (o == 0) f = (float)tp / (float)(Lf - 1);
            else { const int i = (o - 1) & 15; const float fr = 1e-4f + (float)i * ((15.0f - 1e-4f) / 15.0f); const float rev = fr * (float)tp / (float)Lf; f = (o <= 16) ? cos_rev(rev) : -sin_rev(rev); }
            feat[pl * 33 + o] = f; }
        __syncthreads();
        float a = b1[o];
#pragma unroll 3
        for (int i = 0; i < 33; ++i) a += feat[pl * 33 + i] * w1[i * 64 + o];
        h1[pl * 64 + o] = sin_rad(fq[o] * a);
        __syncthreads();
        float b = b2[o];
#pragma unroll 4
        for (int j = 0; j < 64; ++j) b += h1[pl * 64 + j] * w2[j * 64 + o];
        { const float hv = sin_rad(fq[o] * b); FH2B[(size_t)pos * 64 + o] = (bf16)f2bf(hv); }
        __syncthreads();
    }
}
__device__ __forceinline__ void ph_norm(const float* xlat, const float* xctx, const float* g, const float* modl, int sh_off, int sc_off, bf16* H, int Mrows, const float* slab, const float* sgate, float* xc_out, int wave, int lane) {
    const int gw = blockIdx.x * NWAVES + wave, NGW = gridDim.x * NWAVES;
    for (int base = gw * 8; base < ML; base += NGW * 8) {
        const float* mv = modl + (size_t)(base >> 12) * 12288;
        f32x4 Gv[8], Sv[8];
#pragma unroll
        for (int j = 0; j < 8; ++j) { const int idx = (lane + 64 * j) * 4; Gv[j] = *(const f32x4*)(g + idx) * (*(const f32x4*)(mv + sc_off + idx) + 1.0f); Sv[j] = *(const f32x4*)(mv + sh_off + idx); }
        f32x4 v[8], nx[8];
#pragma unroll
        for (int j = 0; j < 8; ++j) nx[j] = *(const f32x4*)(xlat + (size_t)base * D + (lane + 64 * j) * 4);
#pragma unroll 1
        for (int i = 0; i < 8; ++i) { const int m = base + i; float ss = 0.f;
#pragma unroll
            for (int j = 0; j < 8; ++j) { v[j] = nx[j]; ss += (v[j].x * v[j].x + v[j].y * v[j].y) + (v[j].z * v[j].z + v[j].w * v[j].w); }
            if (i < 7) {
#pragma unroll
                for (int j = 0; j < 8; ++j) nx[j] = *(const f32x4*)(xlat + (size_t)(m + 1) * D + (lane + 64 * j) * 4); }
            const float rstd = 1.0f / sqrtf(wave_sum(ss) * (1.0f / D) + EPS);
#pragma unroll
            for (int j = 0; j < 8; ++j) { const int idx = (lane + 64 * j) * 4; const f32x4 y = v[j] * rstd * Gv[j] + Sv[j];
                v2u w; w.x = pk2(y.x, y.y); w.y = pk2(y.z, y.w); *(v2u*)(H + (size_t)m * D + idx) = w; } }
    }
    for (int m = ML + gw; m < Mrows; m += NGW) {
        const float* xr = xctx + (size_t)(m - ML) * D; const float* mv = modl + (size_t)4 * 12288;
        f32x4 v[8]; float ss = 0.f;
#pragma unroll
        for (int j = 0; j < 8; ++j) { const int idx = (lane + 64 * j) * 4; v[j] = *(const f32x4*)(xr + idx);
            if (slab) { const float* sp = slab + (size_t)(m - ML) * D + idx; f32x4 p = *(const f32x4*)sp;
#pragma unroll
                for (int q = 1; q < NSPLIT; ++q) p = p + *(const f32x4*)(sp + (size_t)q * MC * D);
                v[j] = v[j] + *(const f32x4*)(sgate + idx) * p; *(f32x4*)(xc_out + (size_t)(m - ML) * D + idx) = v[j]; }
            ss += (v[j].x * v[j].x + v[j].y * v[j].y) + (v[j].z * v[j].z + v[j].w * v[j].w); }
        const float rstd = 1.0f / sqrtf(wave_sum(ss) * (1.0f / D) + EPS);
#pragma unroll
        for (int j = 0; j < 8; ++j) { const int idx = (lane + 64 * j) * 4;
            const f32x4 gg = *(const f32x4*)(g + idx), sh = *(const f32x4*)(mv + sh_off + idx), sc = *(const f32x4*)(mv + sc_off + idx);
            const f32x4 y = v[j] * rstd * gg * (sc + 1.0f) + sh;
            v2u w; w.x = pk2(y.x, y.y); w.y = pk2(y.z, y.w);
            *(v2u*)(H + (size_t)m * D + idx) = w; }
    }
}

__device__ __forceinline__ int fphys(int i) { return i + 2 * (i >> 5); }
__device__ __forceinline__ void bfly_dif(f32x2& a, f32x2& b, float c, float s) { const f32x2 u = a, v = b; a = u + v; const f32x2 d = u - v; b = __builtin_elementwise_fma(d.yx, (f32x2){s, -s}, d * (f32x2){c, c}); }
__device__ __forceinline__ void bfly_idit(f32x2& a, f32x2& b, float c, float s) { const f32x2 u = a, q = b; const f32x2 v = __builtin_elementwise_fma(q.yx, (f32x2){-s, s}, q * (f32x2){c, c}); a = u + v; b = u - v; }
template <bool ZHI> __device__ __forceinline__ void dif16(f32x2 (&x)[16], float th) {
    asm volatile("" : "+v"(th));
#pragma unroll
    for (int k = 0; k < 8; ++k) { const float fr = th + (float)k * 0.0625f; const float c = __builtin_amdgcn_cosf(fr), s = __builtin_amdgcn_sinf(fr);
        if (ZHI) { const f32x2 u = x[k]; x[k + 8] = (f32x2){u.x * c + u.y * s, u.y * c - u.x * s}; } else bfly_dif(x[k], x[k + 8], c, s); }
#pragma unroll
    for (int k = 0; k < 4; ++k) { const float fr = 2.0f * th + (float)k * 0.125f; const float c = __builtin_amdgcn_cosf(fr), s = __builtin_amdgcn_sinf(fr);
        bfly_dif(x[k], x[k + 4], c, s); bfly_dif(x[8 + k], x[12 + k], c, s); }
#pragma unroll
    for (int k = 0; k < 2; ++k) { const float fr = 4.0f * th + (float)k * 0.25f; const float c = __builtin_amdgcn_cosf(fr), s = __builtin_amdgcn_sinf(fr);
#pragma unroll
        for (int b = 0; b < 16; b += 4) bfly_dif(x[b + k], x[b + k + 2], c, s); }
    { const float fr = 8.0f * th; const float c = __builtin_amdgcn_cosf(fr), s = __builtin_amdgcn_sinf(fr);
#pragma unroll
        for (int b = 0; b < 16; b += 2) bfly_dif(x[b], x[b + 1], c, s); }
}
__device__ __forceinline__ void idit16(f32x2 (&x)[16], float th) {
    asm volatile("" : "+v"(th));
    { const float fr = 8.0f * th; const float c = __builtin_amdgcn_cosf(fr), s = __builtin_amdgcn_sinf(fr);
#pragma unroll
        for (int b = 0; b < 16; b += 2) bfly_idit(x[b], x[b + 1], c, s); }
#pragma unroll
    for (int k = 0; k < 2; ++k) { const float fr = 4.0f * th + (float)k * 0.25f; const float c = __builtin_amdgcn_cosf(fr), s = __builtin_amdgcn_sinf(fr);
#pragma unroll
        for (int b = 0; b < 16; b += 4) bfly_idit(x[b + k], x[b + k + 2], c, s); }
#pragma unroll
    for (int k = 0; k < 4; ++k) { const float fr = 2.0f * th + (float)k * 0.125f; const float c = __builtin_amdgcn_cosf(fr), s = __builtin_amdgcn_sinf(fr);
        bfly_idit(x[k], x[k + 4], c, s); bfly_idit(x[8 + k], x[12 + k], c, s); }
#pragma unroll
    for (int k = 0; k < 8; ++k) { const float fr = th + (float)k * 0.0625f; const float c = __builtin_amdgcn_cosf(fr), s = __builtin_amdgcn_sinf(fr); bfly_idit(x[k], x[k + 8], c, s); }
}
template <bool INV, int PSTRIDE> __device__ __forceinline__ void fft_pass(LAS f32x2* buf, int base, float th) {
    LAS f32x2* p = buf + fphys(base);
    f32x2 x[16];
#pragma unroll
    for (int k = 0; k < 16; ++k) x[k] = p[k * PSTRIDE];
    if (INV) idit16(x, th); else dif16<false>(x, th);
#pragma unroll
    for (int k = 0; k < 16; ++k) p[k * PSTRIDE] = x[k];
}
constexpr int FFT_LDS_BYTES = (8192 + 512 + 8) * 8;
__device__ __forceinline__ float block_sum(float v, LAS float* red, int tid) {
    v = wave_sum(v);
    __syncthreads();
    if ((tid & 63) == 0) red[tid >> 6] = v;
    __syncthreads();
    float s = 0.f;
#pragma unroll
    for (int i = 0; i < 8; ++i) s += red[i];
    return s;
}
__device__ __forceinline__ float hy_delta(int c) { const float d0 = -4.605170185988091f / 0.3f, d1 = -4.605170185988091f / 1.5f; return fabsf(d0 + (d1 - d0) * ((float)c / 1023.0f)); }
__device__ __forceinline__ void ph_filt2(const Args& A, int l, int set, int c_lo, int c_hi, int wk, int nwk, LAS unsigned char* lds, int tid) {
    LAS f32x2* buf = (LAS f32x2*)lds; LAS float* bufs = (LAS float*)lds; LAS float* red = (LAS float*)(lds + FFT_LDS_BYTES + 64); LAS float* w3s = red + 32;
    LAS float* ctap = w3s + 256;
    const float* w3 = inp(I_FW3) + (size_t)l * 64 * 4096; const bf16* FH2B = (const bf16*)(wsb() + WS_FB4) + (size_t)l * 4352 * 64;
    f32x2* KF = (f32x2*)(psb(set) + PS_KF); float* TAPC = (float*)(psb(set) + PS_TAPC);
    const int lane = tid & 63, w = tid >> 6, g = lane >> 4, li = lane & 15;
    for (int c = c_lo + wk; c < c_hi; c += nwk) {
        __syncthreads();
        if (tid < 256) w3s[tid] = w3[(size_t)(tid & 63) * 4096 + (tid >> 7) * 2048 + ((tid >> 6) & 1) * 1024 + c];
        __syncthreads();
        bf16x8 bfr[2];
#pragma unroll
        for (int ks = 0; ks < 2; ++ks) { float v[8];
#pragma unroll
            for (int j = 0; j < 8; ++j) v[j] = (li < 4) ? w3s[li * 64 + 32 * ks + 8 * g + j] : 0.f;
            bfr[ks] = mk8(pk2(v[0], v[1]), pk2(v[2], v[3]), pk2(v[4], v[5]), pk2(v[6], v[7])); }
        const float delta = hy_delta(c); float ssq = 0.f, ssqc = 0.f;
        const int comp = li >> 1;
#pragma unroll 1
        for (int rb = 0; rb < 272; rb += 64) {
            bf16x8 a0[8], a1[8];
#pragma unroll
            for (int rk = 0; rk < 8; ++rk) { const int rt = rb + w + 8 * rk; const bf16* ap = FH2B + (size_t)((rt < 272 ? rt : 0) * 16 + li) * 64 + 8 * g;
                a0[rk] = *(const bf16x8*)ap; a1[rk] = *(const bf16x8*)(ap + 32); }
#pragma unroll
            for (int rk = 0; rk < 8; ++rk) { const int rt = rb + w + 8 * rk; const int t0 = rt * 16;
                f32x4 acc = (f32x4){0.f, 0.f, 0.f, 0.f};
                acc = mfma16(a0[rk], bfr[0], acc); acc = mfma16(a1[rk], bfr[1], acc);
                if (li < 4 && rt < 272) {
                    if (rt < 256) {
#pragma unroll
                        for (int j = 0; j < 4; ++j) { const int t = t0 + 4 * g + j; const float val = acc[j] * __expf(-((float)t / 4095.0f) * delta);
                            if ((li & 1) == 0) { bufs[2 * fphys(t) + comp] = val; ssq += val * val; }
                            else if (t >= 1) { bufs[2 * fphys(8192 - t) + comp] = val; ssq += val * val; }
                            else bufs[2 * fphys(4096) + comp] = 0.f; }
                    } else {
#pragma unroll
                        for (int j = 0; j < 4; ++j) { const int m = t0 - 4096 + 4 * g + j; const float val = acc[j] * __expf(-((float)m / 255.0f) * delta);
                            ctap[li * 256 + m] = val; if ((li & 1) == 0 || m >= 1) ssqc += val * val; }
                    }
                }
            }
        }
        const bool o0 = (li < 2), o1 = (li == 2 || li == 3);
        const float scl0 = (1.0f / 8192.0f) / sqrtf(block_sum(o0 ? ssq : 0.f, red, tid) + EPS), scl1 = (1.0f / 8192.0f) / sqrtf(block_sum(o1 ? ssq : 0.f, red, tid) + EPS);
        const float sc0 = 1.0f / sqrtf(block_sum(o0 ? ssqc : 0.f, red, tid) + EPS), sc1 = 1.0f / sqrtf(block_sum(o1 ? ssqc : 0.f, red, tid) + EPS);
        __syncthreads();
        fft_pass<false, 544>(buf, tid, (float)tid * (1.0f / 8192.0f));
        __syncthreads();
        fft_pass<false, 34>(buf, (tid >> 5) * 512 + (tid & 31), (float)(tid & 31) * (1.0f / 512.0f));
        __syncthreads();
        fft_pass<false, 2>(buf, (tid >> 1) * 32 + (tid & 1), (float)(tid & 1) * (1.0f / 32.0f));
        __syncthreads();
#pragma unroll
        for (int r = 0; r < 8; ++r) { LAS f32x4* pp = (LAS f32x4*)(buf + fphys(2 * tid) + 1088 * r); const f32x4 ab = *pp; *pp = (f32x4){ab.x + ab.z, ab.y + ab.w, ab.x - ab.z, ab.y - ab.w}; }
        __syncthreads();
        f32x2* d0 = KF + (size_t)c * 8192; f32x2* d1 = KF + (size_t)(1024 + c) * 8192;
#pragma unroll 4
        for (int i = 0; i < 16; ++i) { const int p = tid + 512 * i; const int f = (int)(__brev((unsigned)p) >> 19); const int pp = (int)(__brev((unsigned)((8192 - f) & 8191)) >> 19);
            const f32x2 z = buf[fphys(p)], zp = buf[fphys(pp)];
            d0[p] = (f32x2){(z.x + zp.x) * 0.5f * scl0, (z.y - zp.y) * 0.5f * scl0};
            d1[p] = (f32x2){(z.y + zp.y) * 0.5f * scl1, (zp.x - z.x) * 0.5f * scl1}; }
        for (int q = tid; q < 1024; q += 512) { const int od = q >> 8, m = q & 255; TAPC[((size_t)od * 1024 + c) * 256 + m] = ctap[q] * ((od < 2) ? sc0 : sc1); }
    }
}

__device__ __forceinline__ void ph_hyprep(const Args& A, int l, LAS unsigned char* lds, int tid) {
    LAS bf16* T = (LAS bf16*)lds;
    const bf16* Z = (const bf16*)(wsb() + WS_Z); bf16* HYT = (bf16*)(wsb() + WS_HYT);
    const float* cw = inp(I_HCW) + (size_t)l * 3 * 3072; const float* cb = inp(I_HCB) + (size_t)l * 3072;
    v4u pre[5];
#define HP_LOAD(u_) do { const int cg_ = (u_) % 12, tt_ = ((u_) / 12) & 63, b_ = (u_) / 768; \
        _Pragma("unroll") for (int e = 0; e < 5; ++e) { const int q = tid + 512 * e; const int r = q >> 5, ch8 = q & 31, t = tt_ * 64 - 1 + r; pre[e] = (v4u){0u, 0u, 0u, 0u}; \
            if (q < 66 * 32 && t >= 0 && t < SEQ) pre[e] = *(const v4u*)(Z + (size_t)(b_ * SEQ + t) * INW + C_HY + cg_ * 256 + ch8 * 8); } } while (0)
    int u = blockIdx.x;
    if (u < 3072) HP_LOAD(u);
    for (; u < 3072; u += gridDim.x) {
        const int cg = u % 12, tt = (u / 12) & 63, b = u / 768;
        __syncthreads();
#pragma unroll
        for (int e = 0; e < 5; ++e) { const int q = tid + 512 * e; if (q < 66 * 32) *(LAS v4u*)(T + (q >> 5) * 264 + (q & 31) * 8) = pre[e]; }
        __syncthreads();
        if (u + (int)gridDim.x < 3072) HP_LOAD(u + (int)gridDim.x);
        const int ch = tid & 255, half = tid >> 8, gch = cg * 256 + ch;
        const float w0 = cw[gch], w1 = cw[3072 + gch], w2 = cw[6144 + gch], bb = cb[gch];
        const int part = gch >> 10, c = gch & 1023;
        bf16* outp = HYT + ((size_t)(part * NB + b) * 1024 + c) * SEQ + tt * 64 + half * 32;
#pragma unroll
        for (int tq = 0; tq < 4; ++tq) { float vv[8];
#pragma unroll
            for (int e = 0; e < 8; ++e) { const int tl = half * 32 + tq * 8 + e;
                vv[e] = w0 * bf1(T[tl * 264 + ch]) + w1 * bf1(T[(tl + 1) * 264 + ch]) + w2 * bf1(T[(tl + 2) * 264 + ch]) + bb; }
            v4u w; w.x = pk2(vv[0], vv[1]); w.y = pk2(vv[2], vv[3]); w.z = pk2(vv[4], vv[5]); w.w = pk2(vv[6], vv[7]);
            *(v4u*)(outp + tq * 8) = w; }
    }
#undef HP_LOAD
}
__device__ __forceinline__ void ph_hyctx(const Args& A, int l, LAS unsigned char* lds, int tid) {
    const bf16* Z = (const bf16*)(wsb() + WS_Z); bf16* YS = (bf16*)(wsb() + WS_YS); const float* TAPC = (const float*)(psb(l & 1) + PS_TAPC);
    const float* cw = inp(I_HCW) + (size_t)l * 3 * 3072; const float* cb = inp(I_HCB) + (size_t)l * 3072; const float* hb = inp(I_HBIAS) + (size_t)l * 2 * 1024;
    const int ch = tid >> 6, q = tid & 63, t0 = 4 * q;
    LAS float* Y = (LAS float*)lds + ch * 1552; LAS float* Y1 = Y + 256; LAS float* G0 = Y + 512; LAS float* G1 = Y + 1032;
    for (int u = blockIdx.x; u < 512; u += gridDim.x) {
        const int b = u >> 7, c = (u & 127) * 8 + ch;
        __syncthreads();
        float pv[3][4];
#pragma unroll
        for (int part = 0; part < 3; ++part) { const int gch = part * 1024 + c; const float w0 = cw[gch], w1 = cw[3072 + gch], w2 = cw[6144 + gch], bb = cb[gch];
            const bf16* zp = Z + (size_t)(ML + b * CL + t0) * INW + C_HY + gch;
            float zz[6];
#pragma unroll
            for (int e = 0; e < 6; ++e) { const int t = t0 - 1 + e; zz[e] = (t >= 0 && t < CL) ? bf1(zp[(ptrdiff_t)(e - 1) * INW]) : 0.f; }
#pragma unroll
            for (int r = 0; r < 4; ++r) pv[part][r] = w0 * zz[r] + w1 * zz[r + 1] + w2 * zz[r + 2] + bb; }
        *(LAS f32x4*)(Y + t0) = (f32x4){pv[2][0], pv[2][1], pv[2][2], pv[2][3]};
#pragma unroll
        for (int r = 0; r < 4; ++r) { const int m = t0 + r;
            G0[m + 259] = TAPC[((size_t)(0 * 2 + 0) * 1024 + c) * 256 + m]; G1[m + 259] = TAPC[((size_t)(1 * 2 + 0) * 1024 + c) * 256 + m];
            if (m >= 1) { G0[259 - m] = TAPC[((size_t)(0 * 2 + 1) * 1024 + c) * 256 + m]; G1[259 - m] = TAPC[((size_t)(1 * 2 + 1) * 1024 + c) * 256 + m]; } }
        if (q == 0) { G0[515] = 0.f; G1[515] = 0.f; G0[516] = 0.f; G1[516] = 0.f; }
        __syncthreads();
        float yprev[4] = {pv[2][0], pv[2][1], pv[2][2], pv[2][3]};
#pragma unroll
        for (int ord = 0; ord < 2; ++ord) {
            const LAS float* Ys = ord ? Y1 : Y; const LAS float* G = ord ? G1 : G0;
            float acc[4] = {0.f, 0.f, 0.f, 0.f};
#pragma unroll 4
            for (int sp = 0; sp < 64; ++sp) { const f32x4 yv = *(const LAS f32x4*)(Ys + 4 * sp); const LAS float* gp = G + 4 * (q - sp) + 256;
                const f32x4 ga = *(const LAS f32x4*)gp, gb = *(const LAS f32x4*)(gp + 4);
                const float g[8] = {ga.x, ga.y, ga.z, ga.w, gb.x, gb.y, gb.z, gb.w}; const float yy[4] = {yv.x, yv.y, yv.z, yv.w};
#pragma unroll
                for (int r = 0; r < 4; ++r)
#pragma unroll
                    for (int j = 0; j < 4; ++j) acc[r] += yy[j] * g[r - j + 3]; }
            const float bias = hb[ord * 1024 + c];
#pragma unroll
            for (int r = 0; r < 4; ++r) yprev[r] = pv[ord][r] * (acc[r] + bias * yprev[r]);
            if (ord == 0) { *(LAS f32x4*)(Y1 + t0) = (f32x4){yprev[0], yprev[1], yprev[2], yprev[3]}; __syncthreads(); }
        }
#pragma unroll
        for (int r = 0; r < 4; ++r) YS[(size_t)(ML + b * CL + t0 + r) * 1024 + c] = (bf16)f2bf(yprev[r]);
    }
}
__device__ __forceinline__ void unpack8(v4u v, float (&x)[8]) { x[0] = bflo(v.x); x[1] = bfhi(v.x); x[2] = bflo(v.y); x[3] = bfhi(v.y); x[4] = bflo(v.z); x[5] = bfhi(v.z); x[6] = bflo(v.w); x[7] = bfhi(v.w); }
__device__ __forceinline__ v4u pack8(const float (&x)[8]) { v4u w; w.x = pk2(x[0], x[1]); w.y = pk2(x[2], x[3]); w.z = pk2(x[4], x[5]); w.w = pk2(x[6], x[7]); return w; }
__device__ __forceinline__ void rope8(float (&lo)[8], float (&hi)[8], const f32x2* rt) {
#pragma unroll
    for (int e = 0; e < 8; ++e) { const f32x2 cs = rt[e]; const float a = lo[e], b = hi[e]; lo[e] = a * cs.x - b * cs.y; hi[e] = b * cs.x + a * cs.y; }
}
__device__ __forceinline__ void vt_store(LAS bf16* Vt, int ld, int d0, int r, v4u vv) {
    Vt[(d0 + 0) * ld + r] = (bf16)(vv.x & 0xffffu); Vt[(d0 + 1) * ld + r] = (bf16)(vv.x >> 16);
    Vt[(d0 + 2) * ld + r] = (bf16)(vv.y & 0xffffu); Vt[(d0 + 3) * ld + r] = (bf16)(vv.y >> 16);
    Vt[(d0 + 4) * ld + r] = (bf16)(vv.z & 0xffffu); Vt[(d0 + 5) * ld + r] = (bf16)(vv.z >> 16);
    Vt[(d0 + 6) * ld + r] = (bf16)(vv.w & 0xffffu); Vt[(d0 + 7) * ld + r] = (bf16)(vv.w >> 16);
}
constexpr float LOG2E = 1.4426950408889634f;
typedef short s16x4 __attribute__((ext_vector_type(4)));
__device__ __forceinline__ bf16x8 tr_frag(const LAS bf16* tile, int ld, int r0, int r1, int c0, int li) {
    const s16x4 lo = __builtin_amdgcn_ds_read_tr16_b64_v4i16((LAS s16x4*)(tile + (r0 + (li >> 2)) * ld + c0 + 4 * (li & 3)));
    const s16x4 hi = __builtin_amdgcn_ds_read_tr16_b64_v4i16((LAS s16x4*)(tile + (r1 + (li >> 2)) * ld + c0 + 4 * (li & 3)));
    return (bf16x8){lo.x, lo.y, lo.z, lo.w, hi.x, hi.y, hi.z, hi.w};
}
__device__ __forceinline__ void ph_ret1(const Args& A, int l, int nctx_units, LAS unsigned char* lds, int tid) {
    LAS bf16* Kf = (LAS bf16*)lds; LAS bf16* Kb = Kf + 128 * 72; LAS bf16* Vs = Kb + 128 * 72;
    const bf16* Z = (const bf16*)(wsb() + WS_Z); float* KV = (float*)(wsb() + WS_KV); const f32x2* rope = (const f32x2*)(wsb() + WS_ROPE);
    const int lane = tid & 63, w = tid >> 6, g = lane >> 4, li = lane & 15;
    for (int uid = blockIdx.x; uid < 1024 + nctx_units; uid += gridDim.x) {
        const bool isc = uid >= 1024; int b, h, n, ci; size_t m0;
        if (!isc) { b = uid >> 8; h = (uid >> 5) & 7; n = uid & 31; m0 = (size_t)b * SEQ + n * 128; ci = 2 + n; }
        else { const int i = uid - 1024; b = i >> 4; h = (i >> 1) & 7; n = i & 1; m0 = (size_t)ML + b * CL + n * 128; ci = n; }
        const float lgf = inp(I_RDEC)[(l * 2 + 0) * 8 + h] * LOG2E, lgb = inp(I_RDEC)[(l * 2 + 1) * 8 + h] * LOG2E;
        __syncthreads();
        { const int tok = tid >> 2, pp = tid & 3, a = (pp & 1) + ((pp >> 1) << 2);
            const bf16* kr = Z + (m0 + tok) * INW + C_RK + h * 64;
            float lo[8], hi[8]; unpack8(*(const v4u*)(kr + 8 * a), lo); unpack8(*(const v4u*)(kr + 8 * a + 16), hi);
            if (!isc) { const int t = n * 128 + tok; const int pos = (a < 4) ? (t >> 6) : (t & 63); rope8(lo, hi, rope + pos * 16 + 8 * (a & 1)); }
            const float zf = ex2(lgf * (float)(127 - tok)) * 0.125f, zb = ex2(lgb * (float)tok) * 0.125f;
            float lf[8], hf[8];
#pragma unroll
            for (int e = 0; e < 8; ++e) { lf[e] = lo[e] * zf; hf[e] = hi[e] * zf; lo[e] *= zb; hi[e] *= zb; }
            *(LAS v4u*)(Kf + tok * 72 + 8 * a) = pack8(lf); *(LAS v4u*)(Kf + tok * 72 + 8 * a + 16) = pack8(hf);
            *(LAS v4u*)(Kb + tok * 72 + 8 * a) = pack8(lo); *(LAS v4u*)(Kb + tok * 72 + 8 * a + 16) = pack8(hi); }
        for (int q = tid; q < 2048; q += 512) { const int r = q >> 4, ch = q & 15; *(LAS v4u*)(Vs + r * 144 + ch * 8) = *(const v4u*)(Z + (m0 + r) * INW + C_RV + h * 128 + ch * 8); }
        __syncthreads();
        bf16x8 af[4];
#pragma unroll
        for (int ks = 0; ks < 4; ++ks) af[ks] = tr_frag(Vs, 144, 32 * ks + 8 * g, 32 * ks + 8 * g + 4, 16 * w, li);
#pragma unroll
        for (int dir = 0; dir < 2; ++dir) { const LAS bf16* KT = dir ? Kb : Kf;
            float* dst = KV + ((size_t)((b * 8 + h) * 2 + dir) * 34 + ci) * 8192;
#pragma unroll
            for (int nc = 0; nc < 4; ++nc) { f32x4 acc = (f32x4){0.f, 0.f, 0.f, 0.f};
#pragma unroll
                for (int ks = 0; ks < 4; ++ks) acc = mfma16(af[ks], tr_frag(KT, 72, 32 * ks + 8 * g, 32 * ks + 8 * g + 4, 16 * nc, li), acc);
#pragma unroll
                for (int j = 0; j < 4; ++j) dst[(16 * w + 4 * g + j) * 64 + 16 * nc + li] = acc[j]; } }
    }
}
__device__ __forceinline__ void ph_natt(const Args& A, int l, int mode, LAS unsigned char* lds, int tid) {
    LAS bf16* Qs = (LAS bf16*)lds; LAS bf16* KV0 = (LAS bf16*)lds; LAS float* rpbs = (LAS float*)(lds + 2 * (64 * 136 + 64 * 144) * 2);
    const bf16* Z = (const bf16*)(wsb() + WS_Z); bf16* YS = (bf16*)(wsb() + WS_YS) + (size_t)2 * MT * 1024;
    const int lane = tid & 63, w = tid >> 6, g = lane >> 4, li = lane & 15;
    const float SCALE = 0.08838834764831845f * LOG2E;
    const int sr0 = tid >> 4, sch = tid & 15;
    const int ufirst = mode ? ((int)blockIdx.x - ((int)gridDim.x - 32)) : (int)blockIdx.x, ucount = mode ? 32 : 512;
    if (ufirst < 0) return;
    for (int uid = ufirst; uid < ucount; uid += (mode ? 32 : (int)gridDim.x)) {
        int b, h, rq = 0; size_t m0;
        if (!mode) { b = uid >> 7; h = (uid >> 4) & 7; rq = uid & 15; m0 = (size_t)b * SEQ + rq * 256; }
        else { b = uid >> 3; h = uid & 7; m0 = (size_t)ML + b * CL; }
        const size_t mc0 = (size_t)ML + b * CL;
        const int qr = 4 * rq + (w >> 1), rs_w = min(max(qr - 4, 0), 56);
        const int kr_lo = min(max(4 * rq - 4, 0), 56), kr_hi = min(max(4 * rq - 1, 0), 56) + 7;
        const int nwin = mode ? 0 : (kr_hi - kr_lo + 1), ntile = nwin + 4;
        int qc[2], cs[2], nlo_w[2], nhi_w[2];
#pragma unroll
        for (int i = 0; i < 2; ++i) { const int cw = 2 * (w & 1) + i; qc[i] = 16 * cw + li; cs[i] = min(max(qc[i] - 8, 0), 48);
            nlo_w[i] = (cw <= 1) ? 0 : cw - 1; nhi_w[i] = (cw == 0) ? 1 : ((cw == 3) ? 3 : cw + 1); }
        v4u kreg[2], vreg[2];
#define NA_LOAD(t_) do { const int t__ = (t_); const size_t mk = (t__ < nwin) ? ((size_t)b * SEQ + (kr_lo + t__) * 64) : (mc0 + (t__ - nwin) * 64); \
            _Pragma("unroll") for (int e = 0; e < 2; ++e) { const bf16* zr = Z + (mk + sr0 + 32 * e) * INW + h * 128 + sch * 8; kreg[e] = *(const v4u*)(zr + C_NK); vreg[e] = *(const v4u*)(zr + C_NV); } } while (0)
#define NA_STORE(buf_) do { LAS bf16* Kd = KV0 + (buf_) * (64 * 136 + 64 * 144); LAS bf16* Vd = Kd + 64 * 136; \
            _Pragma("unroll") for (int e = 0; e < 2; ++e) { *(LAS v4u*)(Kd + (sr0 + 32 * e) * 136 + sch * 8) = kreg[e]; *(LAS v4u*)(Vd + (sr0 + 32 * e) * 144 + sch * 8) = vreg[e]; } } while (0)
        __syncthreads();
        NA_LOAD(0);
        for (int q = tid; q < 4096; q += 512) { const int r = q >> 4, chn = q & 15; *(LAS v4u*)(Qs + r * 136 + chn * 8) = *(const v4u*)(Z + (m0 + r) * INW + C_NQ + h * 128 + chn * 8); }
        if (!mode) for (int i = tid; i < 465; i += 512) rpbs[i] = inp(I_RPB)[((size_t)l * 8 + h) * 465 + i] * LOG2E;
        __syncthreads();
        bf16x8 qf[2][4];
#pragma unroll
        for (int i = 0; i < 2; ++i)
#pragma unroll
            for (int ks = 0; ks < 4; ++ks) qf[i][ks] = *(const LAS bf16x8*)(Qs + (32 * w + 16 * i + li) * 136 + 32 * ks + 8 * g);
        __syncthreads();
        NA_STORE(0);
        __syncthreads();
        f32x4 o[2][8];
#pragma unroll
        for (int i = 0; i < 2; ++i)
#pragma unroll
            for (int nd = 0; nd < 8; ++nd) o[i][nd] = (f32x4){0.f, 0.f, 0.f, 0.f};
        float mrun[2] = {-1e30f, -1e30f}, lrun[2] = {0.f, 0.f};
        for (int t = 0; t < ntile; ++t) {
            const bool win = t < nwin; const int kr = kr_lo + t;
            if (t + 1 < ntile) NA_LOAD(t + 1);
            const LAS bf16* Ks = KV0 + (t & 1) * (64 * 136 + 64 * 144); const LAS bf16* Vs = Ks + 64 * 136;
            const bool active = !win || (kr >= rs_w && kr <= rs_w + 7);
            if (active) {
                const int nlo0 = win ? nlo_w[0] : 0, nhi0 = win ? nhi_w[0] : 3, nlo1 = win ? nlo_w[1] : 0, nhi1 = win ? nhi_w[1] : 3;
                f32x4 s[2][4];
#pragma unroll
                for (int n = 0; n < 4; ++n) { s[0][n] = (f32x4){0.f, 0.f, 0.f, 0.f}; s[1][n] = (f32x4){0.f, 0.f, 0.f, 0.f};
                    const bool u0 = (n >= nlo0 && n <= nhi0), u1 = (n >= nlo1 && n <= nhi1);
                    if (u0 || u1) {
#pragma unroll
                        for (int ks = 0; ks < 4; ++ks) { const bf16x8 kf = *(const LAS bf16x8*)(Ks + (16 * n + li) * 136 + 32 * ks + 8 * g);
                            if (u0) s[0][n] = mfma16(kf, qf[0][ks], s[0][n]);
                            if (u1) s[1][n] = mfma16(kf, qf[1][ks], s[1][n]); } } }
                bf16x8 pf[2][2];
#pragma unroll
                for (int i = 0; i < 2; ++i) {
                    float tmax = -1e30f;
#pragma unroll
                    for (int n = 0; n < 4; ++n)
#pragma unroll
                        for (int j = 0; j < 4; ++j) { float v = s[i][n][j] * SCALE;
                            if (win) { const int kc = 16 * n + 4 * g + j; const bool valid = (kc >= cs[i]) && (kc < cs[i] + 16);
                                const int dc = min(max(kc - qc[i] + 15, 0), 30), dr = min(max(kr - qr + 7, 0), 14);
                                v = valid ? v + rpbs[dr * 31 + dc] : -1e30f; }
                            s[i][n][j] = v; tmax = fmaxf(tmax, v); }
                    tmax = fmaxf(tmax, __shfl_xor(tmax, 16)); tmax = fmaxf(tmax, __shfl_xor(tmax, 32));
                    const bool upd = tmax > mrun[i] + 8.0f;
                    const float mnew = upd ? tmax : mrun[i];
                    float psum = 0.f;
#pragma unroll
                    for (int n = 0; n < 4; ++n)
#pragma unroll
                        for (int j = 0; j < 4; ++j) { const float pv = ex2(s[i][n][j] - mnew); s[i][n][j] = pv; psum += pv; }
                    psum += __shfl_xor(psum, 16); psum += __shfl_xor(psum, 32);
                    if (__any(upd)) { const float alpha = ex2(mrun[i] - mnew); lrun[i] *= alpha;
#pragma unroll
                        for (int nd = 0; nd < 8; ++nd) o[i][nd] = o[i][nd] * alpha; }
                    lrun[i] += psum; mrun[i] = mnew;
#pragma unroll
                    for (int kk = 0; kk < 2; ++kk) pf[i][kk] = mk8(pk2(s[i][2 * kk][0], s[i][2 * kk][1]), pk2(s[i][2 * kk][2], s[i][2 * kk][3]), pk2(s[i][2 * kk + 1][0], s[i][2 * kk + 1][1]), pk2(s[i][2 * kk + 1][2], s[i][2 * kk + 1][3]));
                }
#pragma unroll
                for (int kk = 0; kk < 2; ++kk) { const bool u0 = (2 * kk + 1 >= nlo0 && 2 * kk <= nhi0), u1 = (2 * kk + 1 >= nlo1 && 2 * kk <= nhi1);
                    if (u0 || u1) {
#pragma unroll
                        for (int nd = 0; nd < 8; ++nd) { const bf16x8 vf = tr_frag(Vs, 144, 32 * kk + 4 * g, 32 * kk + 16 + 4 * g, 16 * nd, li);
                            if (u0) o[0][nd] = mfma16(vf, pf[0][kk], o[0][nd]);
                            if (u1) o[1][nd] = mfma16(vf, pf[1][kk], o[1][nd]); } } }
            }
            if (t + 1 < ntile) NA_STORE((t + 1) & 1);
            __syncthreads();
        }
#undef NA_LOAD
#undef NA_STORE
#pragma unroll
        for (int i = 0; i < 2; ++i) { const float inv = 1.0f / lrun[i]; const size_t mrow = m0 + 32 * w + 16 * i + li;
#pragma unroll
            for (int nd = 0; nd < 8; ++nd) { v2u wv; wv.x = pk2(o[i][nd][0] * inv, o[i][nd][1] * inv); wv.y = pk2(o[i][nd][2] * inv, o[i][nd][3] * inv);
                *(v2u*)(YS + mrow * 1024 + h * 128 + 16 * nd + 4 * g) = wv; } }
    }
}

__device__ __forceinline__ void ph_hyfft(const Args& A, int l, LAS unsigned char* lds, int tid) {
    LAS f32x2* buf = (LAS f32x2*)lds;
    const bf16* HYT = (const bf16*)(wsb() + WS_HYT); bf16* YT = (bf16*)(wsb() + WS_YT); const f32x2* KF = (const f32x2*)(psb(l & 1) + PS_KF);
    const float* hb = inp(I_HBIAS) + (size_t)l * 2 * 1024;
    const int baseB = (tid >> 5) * 512 + (tid & 31), baseC = (tid >> 1) * 32 + (tid & 1);
    const float thA = (float)tid * (1.0f / 8192.0f), thB = (float)(tid & 31) * (1.0f / 512.0f), thC = (float)(tid & 1) * (1.0f / 32.0f);
    const size_t bstr = (size_t)1024 * SEQ;
    bf16 vr0[8], vr1[8];
#define HF_PTR(u_, part_) (HYT + ((size_t)((part_) * NB + ((u_) & 1) * 2) * 1024 + ((u_) >> 1)) * SEQ)
    int u = blockIdx.x;
    if (u < 2048) { const bf16* vp = HF_PTR(u, 2);
#pragma unroll
        for (int i = 0; i < 8; ++i) { vr0[i] = vp[tid + 512 * i]; vr1[i] = vp[bstr + tid + 512 * i]; } }
    for (; u < 2048; u += gridDim.x) {
        const int c = u >> 1, b0 = (u & 1) * 2;
        float y0[8], y1[8];
#pragma unroll
        for (int i = 0; i < 8; ++i) { y0[i] = bf1(vr0[i]); y1[i] = bf1(vr1[i]); }
#pragma unroll
        for (int ord = 0; ord < 2; ++ord) {
            f32x4 kreg[8]; bf16 xr0[8], xr1[8];
            { const f32x4* kf = (const f32x4*)(KF + (size_t)(ord * 1024 + c) * 8192); const bf16* xp = HF_PTR(u, ord);
#pragma unroll
                for (int r = 0; r < 8; ++r) { kreg[r] = kf[tid + 512 * r]; xr0[r] = xp[tid + 512 * r]; xr1[r] = xp[bstr + tid + 512 * r]; } }
            { f32x2 x[16];
#pragma unroll
                for (int k = 0; k < 8; ++k) { x[k] = (f32x2){y0[k], y1[k]}; x[k + 8] = (f32x2){0.f, 0.f}; }
                dif16<true>(x, thA);
                __syncthreads();
#pragma unroll
                for (int k = 0; k < 16; ++k) buf[fphys(tid) + 544 * k] = x[k]; }
            __syncthreads();
            fft_pass<false, 34>(buf, baseB, thB);
            __syncthreads();
            fft_pass<false, 2>(buf, baseC, thC);
            __syncthreads();
#pragma unroll
            for (int r = 0; r < 8; ++r) { LAS f32x4* pp = (LAS f32x4*)(buf + fphys(2 * tid) + 1088 * r); const f32x4 ab = *pp; const f32x4 kk = kreg[r];
                const float ax = ab.x + ab.z, ay = ab.y + ab.w, bx = ab.x - ab.z, by = ab.y - ab.w;
                const float px = ax * kk.x - ay * kk.y, py = ax * kk.y + ay * kk.x, qx = bx * kk.z - by * kk.w, qy = bx * kk.w + by * kk.z;
                *pp = (f32x4){px + qx, py + qy, px - qx, py - qy}; }
            __syncthreads();
            fft_pass<true, 2>(buf, baseC, thC);
            __syncthreads();
            fft_pass<true, 34>(buf, baseB, thB);
            __syncthreads();
            if (ord == 1 && u + (int)gridDim.x < 2048) { const bf16* vp = HF_PTR(u + (int)gridDim.x, 2);
#pragma unroll
                for (int i = 0; i < 8; ++i) { vr0[i] = vp[tid + 512 * i]; vr1[i] = vp[bstr + tid + 512 * i]; } }
            { f32x2 x[16];
#pragma unroll
                for (int k = 0; k < 16; ++k) x[k] = buf[fphys(tid) + 544 * k];
                idit16(x, thA);
                const float bias = hb[ord * 1024 + c];
#pragma unroll
                for (int k = 0; k < 8; ++k) { y0[k] = bf1(xr0[k]) * (x[k].x + bias * y0[k]); y1[k] = bf1(xr1[k]) * (x[k].y + bias * y1[k]); } }
        }
        bf16* o0 = YT + ((size_t)b0 * 1024 + c) * SEQ;
#pragma unroll
        for (int i = 0; i < 8; ++i) { const int t = tid + 512 * i; o0[t] = (bf16)f2bf(y0[i]); o0[bstr + t] = (bf16)f2bf(y1[i]); }
    }
#undef HF_PTR
}
__device__ __forceinline__ void ph_scan(const Args& A, int l, int tid) {
    float* KV = (float*)(wsb() + WS_KV);
    for (int gt = blockIdx.x * 512 + tid; gt < NB * 8 * 2 * 2048; gt += gridDim.x * 512) {
        const int bhd = gt >> 11, e4 = gt & 2047, dir = bhd & 1, h = (bhd >> 1) & 7;
        const float gC = ex2(inp(I_RDEC)[(l * 2 + dir) * 8 + h] * LOG2E * 128.0f);
        f32x4* base = (f32x4*)(KV + (size_t)bhd * 34 * 8192) + e4;
        f32x4 s = (f32x4){0.f, 0.f, 0.f, 0.f};
#pragma unroll 1
        for (int sb8 = 0; sb8 < 34; sb8 += 8) {
            f32x4 tv[8];
#pragma unroll
            for (int k = 0; k < 8; ++k) { const int step = min(sb8 + k, 33); const int ci = (dir == 0) ? step : (step == 0 ? 1 : (step == 1 ? 0 : 35 - step)); tv[k] = base[(size_t)ci * 2048]; }
#pragma unroll
            for (int k = 0; k < 8; ++k) { const int step = sb8 + k; if (step < 34) { const int ci = (dir == 0) ? step : (step == 0 ? 1 : (step == 1 ? 0 : 35 - step)); base[(size_t)ci * 2048] = s; s = s * gC + tv[k]; } } }
    }
}

__device__ __forceinline__ void ph_hypost(const Args& A, LAS unsigned char* lds, int tid) {
    LAS bf16* T = (LAS bf16*)lds;
    const bf16* YT = (const bf16*)(wsb() + WS_YT); bf16* YS = (bf16*)(wsb() + WS_YS);
    for (int u = blockIdx.x; u < 1024; u += gridDim.x) {
        const int cg = u & 3, tt = (u >> 2) & 63, b = u >> 8;
        __syncthreads();
        for (int q = tid; q < 2048; q += 512) { const int c = q >> 3, t8 = q & 7;
            *(LAS v4u*)(T + c * 72 + t8 * 8) = *(const v4u*)(YT + ((size_t)b * 1024 + cg * 256 + c) * SEQ + tt * 64 + t8 * 8); }
        __syncthreads();
        const int t = tid >> 3, c32 = tid & 7;
#pragma unroll
        for (int q = 0; q < 4; ++q) { const int cb = c32 * 32 + q * 8; v4u w;
            w.x = (unsigned)T[(cb + 0) * 72 + t] | ((unsigned)T[(cb + 1) * 72 + t] << 16); w.y = (unsigned)T[(cb + 2) * 72 + t] | ((unsigned)T[(cb + 3) * 72 + t] << 16);
            w.z = (unsigned)T[(cb + 4) * 72 + t] | ((unsigned)T[(cb + 5) * 72 + t] << 16); w.w = (unsigned)T[(cb + 6) * 72 + t] | ((unsigned)T[(cb + 7) * 72 + t] << 16);
            *(v4u*)(YS + (size_t)(b * SEQ + tt * 64 + t) * 1024 + cg * 256 + cb) = w; }
    }
}
__device__ __forceinline__ void ph_ret3(const Args& A, int l, int nctx_units, LAS unsigned char* lds, int tid) {
    LAS bf16* Qs = (LAS bf16*)lds; LAS bf16* Ks = Qs + 128 * 72; LAS bf16* Vs = Ks + 128 * 72; LAS bf16* Sf = Vs + 128 * 144; LAS bf16* Sb = Sf + 128 * 72;
    const bf16* Z = (const bf16*)(wsb() + WS_Z); const float* KV = (const float*)(wsb() + WS_KV); const f32x2* rope = (const f32x2*)(wsb() + WS_ROPE);
    bf16* YS = (bf16*)(wsb() + WS_YS) + (size_t)MT * 1024;
    const int lane = tid & 63, w = tid >> 6, g = lane >> 4, li = lane & 15;
    for (int uid = blockIdx.x; uid < 1024 + nctx_units; uid += gridDim.x) {
        const bool isc = uid >= 1024; int b, h, n, ci; size_t m0;
        if (!isc) { b = uid >> 8; h = (uid >> 5) & 7; n = uid & 31; m0 = (size_t)b * SEQ + n * 128; ci = 2 + n; }
        else { const int i = uid - 1024; b = i >> 4; h = (i >> 1) & 7; n = i & 1; m0 = (size_t)ML + b * CL + n * 128; ci = n; }
        const float lgf = inp(I_RDEC)[(l * 2 + 0) * 8 + h] * LOG2E, lgb = inp(I_RDEC)[(l * 2 + 1) * 8 + h] * LOG2E;
        __syncthreads();
        { const int tok = tid >> 2, pp = tid & 3, a = (pp & 1) + ((pp >> 1) << 2);
            const int t = n * 128 + tok; const int pos = (a < 4) ? (t >> 6) : (t & 63); const f32x2* rt = rope + pos * 16 + 8 * (a & 1);
            const bf16* qr = Z + (m0 + tok) * INW + C_RQ + h * 64; const bf16* kr = Z + (m0 + tok) * INW + C_RK + h * 64;
            float lo[8], hi[8];
            unpack8(*(const v4u*)(qr + 8 * a), lo); unpack8(*(const v4u*)(qr + 8 * a + 16), hi);
            if (!isc) rope8(lo, hi, rt);
            *(LAS v4u*)(Qs + tok * 72 + 8 * a) = pack8(lo); *(LAS v4u*)(Qs + tok * 72 + 8 * a + 16) = pack8(hi);
            unpack8(*(const v4u*)(kr + 8 * a), lo); unpack8(*(const v4u*)(kr + 8 * a + 16), hi);
            if (!isc) rope8(lo, hi, rt);
#pragma unroll
            for (int e = 0; e < 8; ++e) { lo[e] *= 0.125f; hi[e] *= 0.125f; }
            *(LAS v4u*)(Ks + tok * 72 + 8 * a) = pack8(lo); *(LAS v4u*)(Ks + tok * 72 + 8 * a + 16) = pack8(hi); }
        for (int q = tid; q < 2048; q += 512) { const int r = q >> 4, ch = q & 15; *(LAS v4u*)(Vs + r * 144 + ch * 8) = *(const v4u*)(Z + (m0 + r) * INW + C_RV + h * 128 + ch * 8); }
#pragma unroll
        for (int dir = 0; dir < 2; ++dir) { const f32x4* src = (const f32x4*)(KV + ((size_t)((b * 8 + h) * 2 + dir) * 34 + ci) * 8192); LAS bf16* S = dir ? Sb : Sf;
            for (int q = tid; q < 2048; q += 512) { const f32x4 v = src[q]; v2u wv; wv.x = pk2(v.x, v.y); wv.y = pk2(v.z, v.w); *(LAS v2u*)(S + (q >> 4) * 72 + (q & 15) * 4) = wv; } }
        __syncthreads();
        const int iq = 16 * w + li;
        bf16x8 qf[2];
#pragma unroll
        for (int ks = 0; ks < 2; ++ks) qf[ks] = *(const LAS bf16x8*)(Qs + iq * 72 + 32 * ks + 8 * g);
        f32x4 s[8];
#pragma unroll
        for (int nn = 0; nn < 8; ++nn) { s[nn] = (f32x4){0.f, 0.f, 0.f, 0.f};
#pragma unroll
            for (int ks = 0; ks < 2; ++ks) s[nn] = mfma16(*(const LAS bf16x8*)(Ks + (16 * nn + li) * 72 + 32 * ks + 8 * g), qf[ks], s[nn]);
#pragma unroll
            for (int j = 0; j < 4; ++j) { const int d = iq - (16 * nn + 4 * g + j); s[nn][j] *= (d >= 0) ? ex2(lgf * (float)d) : ex2(lgb * (float)(-d)); } }
        f32x4 o[8];
#pragma unroll
        for (int nd = 0; nd < 8; ++nd) o[nd] = (f32x4){0.f, 0.f, 0.f, 0.f};
#pragma unroll
        for (int kk = 0; kk < 4; ++kk) {
            const bf16x8 pf = mk8(pk2(s[2 * kk][0], s[2 * kk][1]), pk2(s[2 * kk][2], s[2 * kk][3]), pk2(s[2 * kk + 1][0], s[2 * kk + 1][1]), pk2(s[2 * kk + 1][2], s[2 * kk + 1][3]));
#pragma unroll
            for (int nd = 0; nd < 8; ++nd) o[nd] = mfma16(tr_frag(Vs, 144, 32 * kk + 4 * g, 32 * kk + 16 + 4 * g, 16 * nd, li), pf, o[nd]); }
        const float xif = ex2(lgf * (float)(iq + 1)), xib = ex2(lgb * (float)(128 - iq));
        float ss = 0.f;
#pragma unroll
        for (int nd = 0; nd < 8; ++nd) { f32x4 tf = (f32x4){0.f, 0.f, 0.f, 0.f}, tb = (f32x4){0.f, 0.f, 0.f, 0.f};
#pragma unroll
            for (int ks = 0; ks < 2; ++ks) { tf = mfma16(*(const LAS bf16x8*)(Sf + (16 * nd + li) * 72 + 32 * ks + 8 * g), qf[ks], tf);
                tb = mfma16(*(const LAS bf16x8*)(Sb + (16 * nd + li) * 72 + 32 * ks + 8 * g), qf[ks], tb); }
            o[nd] = o[nd] + tf * xif + tb * xib;
            ss += (o[nd][0] * o[nd][0] + o[nd][1] * o[nd][1]) + (o[nd][2] * o[nd][2] + o[nd][3] * o[nd][3]); }
        ss += __shfl_xor(ss, 16); ss += __shfl_xor(ss, 32);
        const float rn = 1.0f / sqrtf(ss * (1.0f / 128.0f) + EPS);
        const size_t mrow = m0 + iq;
#pragma unroll
        for (int nd = 0; nd < 8; ++nd) { const int dv = 16 * nd + 4 * g; const v2u gv = *(const v2u*)(Z + mrow * INW + C_RG + h * 128 + dv);
            const float g0 = bflo(gv.x), g1 = bfhi(gv.x), g2 = bflo(gv.y), g3 = bfhi(gv.y);
            v2u wv; wv.x = pk2(g0 / (1.0f + __expf(-g0)) * o[nd][0] * rn, g1 / (1.0f + __expf(-g1)) * o[nd][1] * rn);
            wv.y = pk2(g2 / (1.0f + __expf(-g2)) * o[nd][2] * rn, g3 / (1.0f + __expf(-g3)) * o[nd][3] * rn);
            *(v2u*)(YS + mrow * 1024 + h * 128 + dv) = wv; }
    }
}

__device__ __forceinline__ float gelu_fx(float x) { const float x2 = x * x; const float arg = x * (x2 * (-2.0f * 1.4426950408889634f * 0.7978845608028654f * 0.044715f) + (-2.0f * 1.4426950408889634f * 0.7978845608028654f));
    return x * __builtin_amdgcn_rcpf(1.0f + __builtin_amdgcn_exp2f(arg)); }
__device__ __forceinline__ void ph_ffnfix(const Args& A, int l, int Mrows, int tid) {
    const bf16* SA = (const bf16*)(wsb() + WS_SA); const bf16* SB = (const bf16*)(wsb() + WS_SB); bf16* U = (bf16*)(wsb() + WS_U);
    const float* cw = inp(I_FFCW) + (size_t)l * 3 * DFF; const float* cb = inp(I_FFCB) + (size_t)l * DFF;
    const int nblk = Mrows / 64;
    for (int u = blockIdx.x; u < nblk * 2; u += gridDim.x) {
        const int blk = u >> 1, hi = u & 1, R = blk * 64 + (hi ? 63 : 0);
        const bool seq_first = (R < ML) ? ((R & (SEQ - 1)) == 0) : ((R & (CL - 1)) == 0), seq_last = (R < ML) ? ((R & (SEQ - 1)) == SEQ - 1) : ((R & (CL - 1)) == CL - 1);
        const bf16* pprev = hi ? SA + ((size_t)blk * 4 + 2) * DFF : SA + ((size_t)(blk - 1) * 4 + 3) * DFF;
        const bf16* pcur = SA + ((size_t)blk * 4 + (hi ? 3 : 0)) * DFF;
        const bf16* pnext = hi ? SA + ((size_t)(blk + 1) * 4 + 0) * DFF : SA + ((size_t)blk * 4 + 1) * DFF;
        const bf16* pb = SB + ((size_t)blk * 2 + hi) * DFF;
        const bool zp = (!hi && seq_first), zn = (hi && seq_last);
        for (int q = tid; q < DFF / 8; q += 512) { const int f = q * 8;
            float am[8], a0[8], aq[8], bg[8]; const v4u z4 = (v4u){0u, 0u, 0u, 0u};
            unpack8(zp ? z4 : *(const v4u*)(pprev + f), am); unpack8(*(const v4u*)(pcur + f), a0); unpack8(zn ? z4 : *(const v4u*)(pnext + f), aq); unpack8(*(const v4u*)(pb + f), bg);
            float r[8];
#pragma unroll
            for (int e = 0; e < 8; ++e) r[e] = gelu_fx(cw[f + e] * am[e] + cw[DFF + f + e] * a0[e] + cw[2 * DFF + f + e] * aq[e] + cb[f + e]) * bg[e];
            *(v4u*)(U + (size_t)R * DFF + f) = pack8(r); }
    }
}
__device__ __forceinline__ void ph_final(const Args& A, int wave, int lane) {
    const int gw = blockIdx.x * NWAVES + wave, NGW = gridDim.x * NWAVES; const float* g = inp(I_GF);
    for (int m = gw; m < ML; m += NGW) { float* xr = outb() + (size_t)m * D; f32x4 v[8]; float ss = 0.f;
#pragma unroll
        for (int j = 0; j < 8; ++j) { v[j] = *(const f32x4*)(xr + (lane + 64 * j) * 4); ss += (v[j].x * v[j].x + v[j].y * v[j].y) + (v[j].z * v[j].z + v[j].w * v[j].w); }
        const float rstd = 1.0f / sqrtf(wave_sum(ss) * (1.0f / D) + EPS);
#pragma unroll
        for (int j = 0; j < 8; ++j) { const int idx = (lane + 64 * j) * 4; *(f32x4*)(xr + idx) = v[j] * rstd * *(const f32x4*)(g + idx); }
    }
}
#ifndef SKEW_US
#define SKEW_US 0
#endif
__device__ __forceinline__ void spin_us(int us) { if (us > 0) { const unsigned long long t0 = __builtin_amdgcn_s_memrealtime(); while (__builtin_amdgcn_s_memrealtime() - t0 < (unsigned long long)us * 100ull) __builtin_amdgcn_s_sleep(8); } }
constexpr int FILT_F = 816, FILT_I = 896;
constexpr int BG_SPLIT = 22016;
constexpr int SEQ_PER_LAYER = 11, NSEQ = 1 + DEPTH * SEQ_PER_LAYER + 1;
__global__ void __launch_bounds__(NWAVES * 64, 2) fwd(Args A) {
    extern __shared__ __attribute__((aligned(16))) unsigned char lds_raw[];
    LAS unsigned char* lds = (LAS unsigned char*)lds_raw;
    volatile LAS unsigned* MISC = (volatile LAS unsigned*)(lds + MISC_OFF);
    for (int u = threadIdx.x; u < (LDS_BYTES - LDSCTL_OFF) / 4; u += NWAVES * 64) ((LAS unsigned*)(lds + LDSCTL_OFF))[u] = 0u;
    __syncthreads();
    (void)xcd_barrier_post((unsigned*)(wsb() + WS_CTL) + CW_BAR, MISC + 8);
    const int lo = A.seq_lo, hi = A.seq_hi;
#ifdef PROBE_K
    unsigned long long pr_acc = 0ull, pr_prev = __builtin_amdgcn_s_memrealtime();
#endif
#define G ((int)gridDim.x)
#ifdef PROBE_SUB
#define PROBE_K 999
#define SUBT(n, stmt) do { unsigned long long t0_ = 0; if ((n) == PROBE_SUB && blockIdx.x == PROBE_WG && threadIdx.x == 0) t0_ = __builtin_amdgcn_s_memrealtime(); stmt; if ((n) == PROBE_SUB && blockIdx.x == PROBE_WG && threadIdx.x == 0) pr_acc += __builtin_amdgcn_s_memrealtime() - t0_; } while (0)
#else
#define SUBT(n, stmt) do { stmt; } while (0)
#endif
#ifdef PROBE_K
#ifndef PROBE_WG
#define PROBE_WG 0
#endif
#ifndef PROBE_WAIT
#define PROBE_WAIT 0
#endif
#define PROBE_PH(s) (((s) == 0) ? 100 : (((s) - 1) % SEQ_PER_LAYER))
#define PROBE_ARRIVE(s) do { if (blockIdx.x == PROBE_WG && threadIdx.x == 0) { const unsigned long long now_ = __builtin_amdgcn_s_memrealtime(); if (!PROBE_WAIT && PROBE_PH(s) == PROBE_K) pr_acc += now_ - pr_prev; pr_prev = now_; } } while (0)
#define PROBE_EXIT(s) do { if (blockIdx.x == PROBE_WG && threadIdx.x == 0) { const unsigned long long now_ = __builtin_amdgcn_s_memrealtime(); if (PROBE_WAIT && PROBE_PH(s) == PROBE_K) pr_acc += now_ - pr_prev; pr_prev = now_; } } while (0)
#else
#define PROBE_ARRIVE(s) do { } while (0)
#define PROBE_EXIT(s) do { } while (0)
#endif
#define RUN(s) (lo <= (s) && (s) < hi)
#ifndef DUP
#define DUP 0
#endif
#define DUPN(id) ((((DUP) >> (id)) & 1) ? 2 : 1)
#define TID_HERE const int tid = otid(), lane = tid & 63, wave = __builtin_amdgcn_readfirstlane(tid >> 6); (void)lane; (void)wave
#ifdef ONLY
#define PH_ON(k) ((k) == ONLY)
#elif defined(SKIP)
#define PH_ON(k) ((k) != SKIP)
#else
#define PH_ON(k) true
#endif
#define SEAM(s) do { PROBE_ARRIVE(s); if (RUN((s) + 1)) { XcdBarrier bar_; bar_.bar = (unsigned*)(wsb() + WS_CTL) + CW_BAR; bar_.x = xb_xcc_id(); bar_.st = (volatile LAS unsigned*)(lds + MISC_OFF) + 8; xcd_barrier(bar_); if (DUPN(16) > 1) xcd_barrier(bar_); } PROBE_EXIT(s); } while (0)
#define H ((bf16*)(wsb() + WS_H))
#define Z ((bf16*)(wsb() + WS_Z))
#define ACC ((bf16*)(wsb() + WS_ACC))
#define U ((bf16*)(wsb() + WS_U))
#define YS ((bf16*)(wsb() + WS_YS))
#define XC ((float*)(wsb() + WS_XC))
#define WIN ((const bf16*)(psb(l & 1) + PS_WIN))
#define WBR ((const bf16*)(psb(l & 1) + PS_WBR))
#define WOUT ((const bf16*)(psb(l & 1) + PS_WOUT))
#define WF1 ((const bf16*)(psb(l & 1) + PS_WF1))
#define WF2 ((const bf16*)(psb(l & 1) + PS_WF2))

    if (PH_ON(100) && RUN(0)) { TID_HERE; ph_prologue(A, lds, tid); __syncthreads(); ph_convert(A, 0, 0, 0, CONV_ITEMS, (int)blockIdx.x, G, lds, wave, lane); __syncthreads(); for (int fl = 0; fl < DEPTH; ++fl) ph_filt1(A, fl, 0, (int)blockIdx.x, G, lds, tid); SEAM(0); }

    for (int l = 0; l < DEPTH; ++l) {
        const int sb = 1 + l * SEQ_PER_LAYER;
        if (hi <= sb || lo >= sb + SEQ_PER_LAYER) continue;
        const bool lastl = (l == DEPTH - 1);
        const int Mrows = lastl ? ML : MT, nctx = lastl ? 0 : 64;
#define modl ((const float*)(wsb() + WS_MOD) + (size_t)l * 5 * 12288)
#define xlat_in ((l == 0) ? inp(I_X) : (const float*)outb())
#define xctx_in ((l == 0) ? inp(I_CTX) : (const float*)XC)

        if (PH_ON(0) && RUN(sb + 0)) { TID_HERE;
            if (l == 0) ph_filt2(A, 0, 0, 0, 1024, (int)blockIdx.x, G, lds, tid);
            else ph_convert(A, l, l & 1, 0, CONV_ITEMS, (int)blockIdx.x, G, lds, wave, lane);
            ph_norm(xlat_in, xctx_in, inp(I_G1) + (size_t)l * D, modl, 0, D, H, MT, (l > 0) ? (const float*)(wsb() + WS_SLAB) : (const float*)nullptr,
                    (const float*)(wsb() + WS_MOD) + ((size_t)(l - 1) * 5 + 4) * 12288 + 5 * D, XC, wave, lane);
            SEAM(sb + 0);
        }
        if (PH_ON(1) && RUN(sb + 1)) { TID_HERE;
            if (SKEW_US > 0 && (blockIdx.x & 8)) spin_us(SKEW_US);
            { pg8::Gemm g{H, WIN, opq(MT), opq(INW), opq(D), 0}; pg8::StaticOrder S; S.init(g.M, g.N, G, (int)blockIdx.x);
              pg8::EpiStore E{Z, INW};
              for (int r_ = 0; r_ < DUPN(15); ++r_) pg8::gemm_phase<pg8::EpiStore, pg8::StaticOrder, PG8_ALIGN, PG8_SP2>(lds, g, S, E); }
            SEAM(sb + 1);
        }
        if (PH_ON(2) && RUN(sb + 2)) { TID_HERE;
            SUBT(1, ph_hyprep(A, l, lds, tid));
            SUBT(2, ph_ret1(A, l, 64, lds, tid));
            SUBT(3, ph_natt(A, l, 0, lds, tid));
            SUBT(4, if (!lastl) ph_hyctx(A, l, lds, tid));
            SEAM(sb + 2);
        }
        if (PH_ON(3) && RUN(sb + 3)) { TID_HERE;
#ifndef NO_D1
            SUBT(5, ph_hyfft(A, l, lds, tid));
#endif
#ifndef NO_D2
            SUBT(6, ph_scan(A, l, tid));
#endif
            SEAM(sb + 3);
        }
        if (PH_ON(4) && RUN(sb + 4)) { TID_HERE;
            SUBT(7, ph_hypost(A, lds, tid));
            SUBT(8, ph_ret3(A, l, nctx, lds, tid));
            if (!lastl) { __syncthreads(); ph_natt(A, l, 1, lds, tid); }
            SEAM(sb + 4);
        }
        if (PH_ON(5) && RUN(sb + 5)) { TID_HERE;
            __syncthreads();
            for (int r_ = 0; r_ < DUPN(13); ++r_)
            for (int i = 0; i < 3; ++i) {
                pg8::Gemm g{YS + (size_t)i * MT * 1024, WBR + (size_t)i * D * 1024, Mrows, opq(D), opq(1024), 0}; pg8::StaticOrder S; S.init(g.M, g.N, G, (int)blockIdx.x);
                pg8::EpiMerge E{ACC, Z + C_GT + i * D, INW, i == 0 ? 1 : 0};
                pg8::gemm_phase<pg8::EpiMerge, pg8::StaticOrder, PG8_ALIGN, PG8_SP2>(lds, g, S, E);
            }
            if (!lastl && blockIdx.x >= 32) { __syncthreads(); ph_filt2(A, l + 1, (l + 1) & 1, 0, FILT_F, (int)blockIdx.x - 32, G - 32, lds, tid); }
            SEAM(sb + 5);
        }
        if (PH_ON(6) && RUN(sb + 6)) { TID_HERE;
            __syncthreads();
            { pg8::Gemm g{ACC, WOUT, opq(ML), opq(D), opq(D), 0}; pg8::StaticOrder S; S.init(g.M, g.N, G, (int)blockIdx.x);
              pg8::EpiResid E{xlat_in, xctx_in, outb(), XC, modl, 2 * D};
              pg8::gemm_phase<pg8::EpiResid, pg8::StaticOrder, PG8_ALIGN, PG8_SP2>(lds, g, S, E); }
            if (!lastl) { pg8::Gemm g{ACC, WOUT, opq(MT), opq(D), opq(D / NSPLIT), opq(D)}; pg8::CtxSplitOrder S{NSPLIT, D / NSPLIT, (int)blockIdx.x};
              pg8::EpiSlab E{(float*)(wsb() + WS_SLAB), D / NSPLIT};
              pg8::gemm_phase<pg8::EpiSlab, pg8::CtxSplitOrder, PG8_ALIGN, PG8_SP2>(lds, g, S, E); }
            SEAM(sb + 6);
        }
        if (PH_ON(7) && RUN(sb + 7)) { TID_HERE;
            ph_norm(outb(), xctx_in, inp(I_G2) + (size_t)l * D, modl, 3 * D, 4 * D, H, Mrows, (const float*)(wsb() + WS_SLAB), modl + (size_t)4 * 12288 + 2 * D, XC, wave, lane);
            SEAM(sb + 7);
        }
        if (PH_ON(8) && RUN(sb + 8)) { TID_HERE;
            __syncthreads();
            if (SKEW_US > 0 && (blockIdx.x & 8)) spin_us(SKEW_US);
            pg8::Gemm g{H, WF1, Mrows, opq(NFF), opq(D), 0}; pg8::StaticOrder S; S.init(g.M, g.N, G, (int)blockIdx.x);
            pg8::EpiFfn E{U, (bf16*)(wsb() + WS_SA), (bf16*)(wsb() + WS_SB), inp(I_FFCW) + (size_t)l * 3 * DFF, inp(I_FFCB) + (size_t)l * DFF};
            for (int r_ = 0; r_ < DUPN(14); ++r_) pg8::gemm_phase<pg8::EpiFfn, pg8::StaticOrder, PG8_ALIGN, PG8_SP2>(lds, g, S, E);
            if (!lastl && blockIdx.x >= 176) { __syncthreads(); ph_filt2(A, l + 1, (l + 1) & 1, FILT_F, FILT_I, (int)blockIdx.x - 176, G - 176, lds, tid); }
            SEAM(sb + 8);
        }
        if (PH_ON(9) && RUN(sb + 9)) { TID_HERE;
            for (int r_ = 0; r_ < DUPN(11); ++r_) ph_ffnfix(A, l, Mrows, tid);
            SEAM(sb + 9);
        }
        if (PH_ON(10) && RUN(sb + 10)) { TID_HERE;
            __syncthreads();
            { pg8::Gemm g{U, WF2, opq(ML), opq(D), opq(DFF), 0}; pg8::StaticOrder S; S.init(g.M, g.N, G, (int)blockIdx.x);
              pg8::EpiResid E{outb(), XC, outb(), XC, modl, 5 * D};
              pg8::gemm_phase<pg8::EpiResid, pg8::StaticOrder, PG8_ALIGN, PG8_SP2>(lds, g, S, E); }
            if (!lastl) { pg8::Gemm g{U, WF2, opq(MT), opq(D), opq(DFF / NSPLIT), opq(DFF)}; pg8::CtxSplitOrder S{NSPLIT, DFF / NSPLIT, (int)blockIdx.x};
              pg8::EpiSlab E{(float*)(wsb() + WS_SLAB), DFF / NSPLIT};
              pg8::gemm_phase<pg8::EpiSlab, pg8::CtxSplitOrder, PG8_ALIGN, PG8_SP2>(lds, g, S, E); }
            if (!lastl && blockIdx.x >= 128) { __syncthreads(); ph_filt2(A, l + 1, (l + 1) & 1, FILT_I, 1024, (int)blockIdx.x - 128, G - 128, lds, tid); }
            SEAM(sb + 10);
        }
    }
    if (PH_ON(101) && RUN(NSEQ - 1)) { TID_HERE; ph_final(A, wave, lane); }
#ifdef PROBE_K
    if (blockIdx.x == PROBE_WG && threadIdx.x == 0) { const unsigned long long t0 = __builtin_amdgcn_s_memrealtime(); while (__builtin_amdgcn_s_memrealtime() - t0 < 4ull * pr_acc) __builtin_amdgcn_s_sleep(8); }
#endif
#undef RUN
#undef SEAM
#undef H
#undef Z
#undef ACC
#undef U
#undef YS
#undef XC
#undef WIN
#undef WBR
#undef WOUT
#undef WF1
#undef WF2
#undef G
#undef modl
#undef xlat_in
#undef xctx_in
}

extern "C" void kernel_launch(void* const* d_in, const int* in_sizes, int n_in, void* d_out, int out_size, void* d_ws, size_t ws_size, hipStream_t stream) {
    static int grid = 0;
    if (grid == 0) {
        if (n_in != 27 || out_size != ML * D || ws_size < WS_END) { fprintf(stderr, "kernel_launch: unexpected shapes (n_in %d out %d ws %zu need %zu)\n", n_in, out_size, ws_size, (size_t)WS_END); grid = -1; return; }
        int dev = 0, cus = 0, per_cu = 0;
        if (hipGetDevice(&dev) != hipSuccess || hipDeviceGetAttribute(&cus, hipDeviceAttributeMultiprocessorCount, dev) != hipSuccess) { grid = -1; return; }
        if (hipFuncSetAttribute((const void*)fwd, hipFuncAttributeMaxDynamicSharedMemorySize, LDS_BYTES) != hipSuccess) { fprintf(stderr, "kernel_launch: hipFuncSetAttribute failed\n"); grid = -1; return; }
        if (hipOccupancyMaxActiveBlocksPerMultiprocessor(&per_cu, (const void*)fwd, NWAVES * 64, LDS_BYTES) != hipSuccess || per_cu < 1) fprintf(stderr, "kernel_launch: occupancy query says %d\n", per_cu);
        (void)hipGetLastError();
        grid = cus;
    }
    if (grid < 0) return;
    (void)hipMemsetAsync((char*)d_ws + WS_CTL, 0, CTL_ZERO_BYTES, stream);
    Args a{};
    for (int i = 0; i < 27; ++i) a.in[i] = (const float*)d_in[i];
    a.out = (float*)d_out; a.ws = (unsigned char*)d_ws;
#if MK_SINGLE
    a.seq_lo = 0; a.seq_hi = NSEQ;
    hipLaunchKernelGGL(fwd, dim3(grid), dim3(NWAVES * 64), LDS_BYTES, stream, a);
#else
    for (int s = 0; s < NSEQ; ++s) { a.seq_lo = s; a.seq_hi = s + 1; hipLaunchKernelGGL(fwd, dim3(grid), dim3(NWAVES * 64), LDS_BYTES, stream, a); }
#endif
}
```

```cpp
#include <hip/hip_runtime.h>
#include <cstdio>
#include <cstdint>
#ifndef MK_SINGLE
#define MK_SINGLE 1
#endif
namespace pg8 {
#define PG8_LAS __attribute__((address_space(3)))
typedef unsigned short bf16_t;
typedef short bf16x8 __attribute__((ext_vector_type(8)));
typedef float f32x4 __attribute__((ext_vector_type(4)));
typedef unsigned u32x4 __attribute__((ext_vector_type(4)));
constexpr int BM = 256, BK = 64, HALF = 128, HTB = HALF * BK * 2  , STAGE_BYTES = 8 * HTB, NXCD = 8, WGM = 8;

__host__ __device__ __forceinline__ int lds_byte(int r, int c) { const int st = (r >> 4) * 2 + (c >> 5), rr = r & 15, cc = c & 31, ob = rr * 64 + cc * 2; return st * 1024 + (ob ^ (((ob >> 9) & 1) << 5)); }
__host__ __device__ __forceinline__ void stage_rc(int b, int& R, int& C) { const int st = b / 1024, sb = b % 1024, swz = sb ^ (((sb >> 9) & 1) << 5); R = (st >> 1) * 16 + swz / 64; C = (st & 1) * 32 + (swz % 64) / 2; }
__host__ __device__ __forceinline__ int perm32(int rho) { const int n = rho >> 4, i = rho & 15; return 8 * (i >> 2) + 4 * n + (i & 3); }

struct Unit { int pm, pn, ko; };
struct Gemm { const bf16_t* A; const bf16_t* Bt; int M, N, K, ld; };

struct StaticOrder {
    int nM, nN, nwg, G, c;
    __host__ __device__ void init(int M, int N, int G_, int c_) { nM = M / BM; nN = N / BM; nwg = nM * nN; G = G_; c = c_; }
    __host__ __device__ bool next(int i, Unit& u) const {
        const long L = (long)i * G + c; if (L >= nwg) return false;
        int wgid = (int)L; { const int q = nwg / NXCD, r = nwg % NXCD, xcd = wgid % NXCD, off = wgid / NXCD; wgid = (xcd < r ? xcd * (q + 1) : r * (q + 1) + (xcd - r) * q) + off; }
        const int nig = WGM * nN, gid = wgid / nig, fm = gid * WGM, gsz = (nM - fm) < WGM ? (nM - fm) : WGM;
        u.pm = fm + ((wgid % nig) % gsz); u.pn = (wgid % nig) / gsz; u.ko = 0; return true;
    }
    __device__ __forceinline__ void a_ready(const Unit&) const {}
    __device__ __forceinline__ void done(const Unit&) const {}
};
__device__ __forceinline__ unsigned cvt_pk_bf16(float lo, float hi) { unsigned r; asm volatile("v_cvt_pk_bf16_f32 %0, %1, %2" : "=v"(r) : "v"(lo), "v"(hi)); return r; }
typedef float f32x2 __attribute__((ext_vector_type(2)));
__device__ __forceinline__ float bflo(unsigned w) { return __uint_as_float(w << 16); }
__device__ __forceinline__ float bfhi(unsigned w) { return __uint_as_float(w & 0xffff0000u); }
__device__ __forceinline__ float sigm(float x) { return 1.0f / (1.0f + __expf(-x)); }
struct EpiStore {
    static constexpr bool PERM = true, AFTER_DRAIN = false;
    bf16_t* O; int ldc;
    __device__ __forceinline__ void operator()(const f32x4 (&acc)[2][2][4][2], const Unit& u, int wr, int wc, int fr, int fq) const {
        const int row0 = u.pm * BM + wr * 64 + fr, col0 = u.pn * BM + wc * 32 + 8 * fq;
#pragma unroll
        for (int ai = 0; ai < 2; ++ai)
#pragma unroll
            for (int m = 0; m < 4; ++m) { bf16_t* rowp = O + (size_t)(row0 + ai * HALF + m * 16) * ldc + col0;
#pragma unroll
                for (int bj = 0; bj < 2; ++bj) { const f32x4 v0 = acc[ai][bj][m][0], v1 = acc[ai][bj][m][1];
                    u32x4 w; w.x = cvt_pk_bf16(v0[0], v0[1]); w.y = cvt_pk_bf16(v0[2], v0[3]); w.z = cvt_pk_bf16(v1[0], v1[1]); w.w = cvt_pk_bf16(v1[2], v1[3]);
                    *(u32x4*)(rowp + bj * HALF) = w; } }
    }
};
struct EpiMerge {
    static constexpr bool PERM = true, AFTER_DRAIN = false;
    bf16_t* O; const bf16_t* gate; int ldg; int first;
    __device__ __forceinline__ void operator()(const f32x4 (&acc)[2][2][4][2], const Unit& u, int wr, int wc, int fr, int fq) const {
        const int row0 = u.pm * BM + wr * 64 + fr, col0 = u.pn * BM + wc * 32 + 8 * fq;
#pragma unroll
        for (int ai = 0; ai < 2; ++ai)
#pragma unroll
            for (int m = 0; m < 4; ++m) { const size_t row = (size_t)(row0 + ai * HALF + m * 16);
#pragma unroll
                for (int bj = 0; bj < 2; ++bj) { const int col = col0 + bj * HALF;
                    const u32x4 gv = *(const u32x4*)(gate + row * ldg + col);
                    u32x4 pv = (u32x4){0u, 0u, 0u, 0u}; if (!first) pv = *(const u32x4*)(O + row * 2048 + col);
                    const f32x4 v0 = acc[ai][bj][m][0], v1 = acc[ai][bj][m][1];
                    u32x4 w;
                    w.x = cvt_pk_bf16(bflo(pv.x) + v0[0] * sigm(bflo(gv.x)), bfhi(pv.x) + v0[1] * sigm(bfhi(gv.x)));
                    w.y = cvt_pk_bf16(bflo(pv.y) + v0[2] * sigm(bflo(gv.y)), bfhi(pv.y) + v0[3] * sigm(bfhi(gv.y)));
                    w.z = cvt_pk_bf16(bflo(pv.z) + v1[0] * sigm(bflo(gv.z)), bfhi(pv.z) + v1[1] * sigm(bfhi(gv.z)));
                    w.w = cvt_pk_bf16(bflo(pv.w) + v1[2] * sigm(bflo(gv.w)), bfhi(pv.w) + v1[3] * sigm(bfhi(gv.w)));
                    *(u32x4*)(O + row * 2048 + col) = w; } }
    }
};
struct EpiResid {
    static constexpr bool PERM = false, AFTER_DRAIN = false;
    const float* base_lat; const float* base_ctx; float* out_lat; float* out_ctx; const float* modl; int goff;
    __device__ __forceinline__ void operator()(const f32x4 (&acc)[2][2][4][2], const Unit& u, int wr, int wc, int fr, int fq) const {
        const bool isctx = u.pm >= 64; const int r = isctx ? 4 : (u.pm >> 4);
        const float* gvp = modl + (size_t)r * 12288 + goff;
        const float* bs = isctx ? base_ctx : base_lat; float* os = isctx ? out_ctx : out_lat;
        const int row0 = (isctx ? u.pm - 64 : u.pm) * BM + wr * 64 + fr, col0 = u.pn * BM + wc * 32 + 4 * fq;
        f32x4 g4[2][2];
#pragma unroll
        for (int bj = 0; bj < 2; ++bj)
#pragma unroll
            for (int n = 0; n < 2; ++n) g4[bj][n] = *(const f32x4*)(gvp + col0 + bj * HALF + n * 16);
#pragma unroll
        for (int ai = 0; ai < 2; ++ai)
#pragma unroll
            for (int m = 0; m < 4; ++m) { const size_t off = (size_t)(row0 + ai * HALF + m * 16) * 2048 + col0;
#pragma unroll
                for (int bj = 0; bj < 2; ++bj)
#pragma unroll
                    for (int n = 0; n < 2; ++n) { const f32x4 b4 = *(const f32x4*)(bs + off + bj * HALF + n * 16);
                        *(f32x4*)(os + off + bj * HALF + n * 16) = b4 + g4[bj][n] * acc[ai][bj][m][n]; } }
    }
};

__device__ __forceinline__ float dpp_ror1(float v) { return __int_as_float(__builtin_amdgcn_update_dpp(0, __float_as_int(v), 0x121, 0xf, 0xf, false)); }
__device__ __forceinline__ float dpp_rol1(float v) { return __int_as_float(__builtin_amdgcn_update_dpp(0, __float_as_int(v), 0x12f, 0xf, 0xf, false)); }
__device__ __forceinline__ float gelu_fast(float x) { const float x2 = x * x; const float arg = x * (x2 * (-2.0f * 1.4426950408889634f * 0.7978845608028654f * 0.044715f) + (-2.0f * 1.4426950408889634f * 0.7978845608028654f));
    return x * __builtin_amdgcn_rcpf(1.0f + __builtin_amdgcn_exp2f(arg)); }
struct EpiFfn {
    static constexpr bool PERM = true, AFTER_DRAIN = false;
    bf16_t* U; bf16_t* SA; bf16_t* SB; const float* cw; const float* cb;
    __device__ __forceinline__ void operator()(const f32x4 (&acc)[2][2][4][2], const Unit& u, int wr, int wc, int fr, int fq) const {
        const int f0 = u.pn * 128 + wc * 32 + 8 * fq;
        f32x4 w0[2], w1[2], w2[2], bb[2];
#pragma unroll
        for (int n = 0; n < 2; ++n) { w0[n] = *(const f32x4*)(cw + f0 + 4 * n); w1[n] = *(const f32x4*)(cw + 5632 + f0 + 4 * n); w2[n] = *(const f32x4*)(cw + 2 * 5632 + f0 + 4 * n); bb[n] = *(const f32x4*)(cb + f0 + 4 * n); }
#pragma unroll
        for (int ai = 0; ai < 2; ++ai) {
            const int row0 = u.pm * BM + ai * HALF + wr * 64 + fr, blk = u.pm * 4 + ai * 2 + wr;
            f32x4 o[4][2];
#pragma unroll
            for (int n = 0; n < 2; ++n)
#pragma unroll
                for (int e = 0; e < 4; ++e) {
                    const float a0 = acc[ai][0][0][n][e], a1 = acc[ai][0][1][n][e], a2 = acc[ai][0][2][n][e], a3 = acc[ai][0][3][n][e];
                    const float r0 = dpp_ror1(a0), r1 = dpp_ror1(a1), r2 = dpp_ror1(a2), r3 = dpp_ror1(a3);
                    const float l0 = dpp_rol1(a0), l1 = dpp_rol1(a1), l2 = dpp_rol1(a2), l3 = dpp_rol1(a3);
                    const bool first = (fr == 0), last = (fr == 15);
                    const float p0 = r0, p1 = first ? r0 : r1, p2 = first ? r1 : r2, p3 = first ? r2 : r3;
                    const float n0 = last ? l1 : l0, n1 = last ? l2 : l1, n2 = last ? l3 : l2, n3 = l3;
                    const float k0 = w0[n][e], k1 = w1[n][e], k2 = w2[n][e], kb = bb[n][e];
                    o[0][n][e] = gelu_fast(k0 * p0 + k1 * a0 + k2 * n0 + kb) * acc[ai][1][0][n][e];
                    o[1][n][e] = gelu_fast(k0 * p1 + k1 * a1 + k2 * n1 + kb) * acc[ai][1][1][n][e];
                    o[2][n][e] = gelu_fast(k0 * p2 + k1 * a2 + k2 * n2 + kb) * acc[ai][1][2][n][e];
                    o[3][n][e] = gelu_fast(k0 * p3 + k1 * a3 + k2 * n3 + kb) * acc[ai][1][3][n][e];
                }
#pragma unroll
            for (int m = 0; m < 4; ++m) { u32x4 w; w.x = cvt_pk_bf16(o[m][0][0], o[m][0][1]); w.y = cvt_pk_bf16(o[m][0][2], o[m][0][3]); w.z = cvt_pk_bf16(o[m][1][0], o[m][1][1]); w.w = cvt_pk_bf16(o[m][1][2], o[m][1][3]);
                *(u32x4*)(U + (size_t)(row0 + m * 16) * 5632 + f0) = w; }
            const int sel = (fr == 0) ? 0 : (fr == 1) ? 1 : (fr == 14) ? 2 : (fr == 15) ? 3 : -1;
            if (sel >= 0) { const int m = (sel < 2) ? 0 : 3;
                const f32x4 a0 = (m == 0) ? acc[ai][0][0][0] : acc[ai][0][3][0], a1 = (m == 0) ? acc[ai][0][0][1] : acc[ai][0][3][1];
                u32x4 w; w.x = cvt_pk_bf16(a0[0], a0[1]); w.y = cvt_pk_bf16(a0[2], a0[3]); w.z = cvt_pk_bf16(a1[0], a1[1]); w.w = cvt_pk_bf16(a1[2], a1[3]);
                *(u32x4*)(SA + ((size_t)blk * 4 + sel) * 5632 + f0) = w;
                if (sel == 0 || sel == 3) { const f32x4 b0 = (m == 0) ? acc[ai][1][0][0] : acc[ai][1][3][0], b1 = (m == 0) ? acc[ai][1][0][1] : acc[ai][1][3][1];
                    u32x4 v; v.x = cvt_pk_bf16(b0[0], b0[1]); v.y = cvt_pk_bf16(b0[2], b0[3]); v.z = cvt_pk_bf16(b1[0], b1[1]); v.w = cvt_pk_bf16(b1[2], b1[3]);
                    *(u32x4*)(SB + ((size_t)blk * 2 + (sel == 0 ? 0 : 1)) * 5632 + f0) = v; } }
        }
    }
};

struct CtxSplitOrder {
    int nsplit, klen, c;
    __device__ __forceinline__ bool next(int i, Unit& u) const { if (i > 0 || c >= 32 * nsplit) return false; const int tile = c / nsplit, s = c - tile * nsplit; u.pm = 64 + (tile >> 3); u.pn = tile & 7; u.ko = s * klen; return true; }
    __device__ __forceinline__ void a_ready(const Unit&) const {}
    __device__ __forceinline__ void done(const Unit&) const {}
};
struct EpiSlab {
    static constexpr bool PERM = false, AFTER_DRAIN = false;
    float* slab; int klen;
    __device__ __forceinline__ void operator()(const f32x4 (&acc)[2][2][4][2], const Unit& u, int wr, int wc, int fr, int fq) const {
        float* os = slab + (size_t)(u.ko / klen) * 1024 * 2048;
        const int row0 = (u.pm - 64) * BM + wr * 64 + fr, col0 = u.pn * BM + wc * 32 + 4 * fq;
#pragma unroll
        for (int ai = 0; ai < 2; ++ai)
#pragma unroll
            for (int m = 0; m < 4; ++m) { const size_t off = (size_t)(row0 + ai * HALF + m * 16) * 2048 + col0;
#pragma unroll
                for (int bj = 0; bj < 2; ++bj)
#pragma unroll
                    for (int n = 0; n < 2; ++n) *(f32x4*)(os + off + bj * HALF + n * 16) = acc[ai][bj][m][n]; }
    }
};
template <class Epi, class Sched, bool ALIGN_EPI = false, bool SP2 = false>
__device__ __forceinline__ void gemm_phase(PG8_LAS unsigned char* lds, const Gemm g, const Sched& S, const Epi& E) {
    int tid_ = threadIdx.x; asm volatile("" : "+v"(tid_)); const int tid = tid_, wid = __builtin_amdgcn_readfirstlane(tid >> 6), lane = tid & 63, wr = wid >> 2, wc = wid & 3, fr = lane & 15, fq = lane >> 4;
    const int K = g.K, nt = K / BK, LD = g.ld ? g.ld : g.K;
    unsigned voffA[2], voffB[2];
#pragma unroll
    for (int i = 0; i < 2; ++i) { int R, C; stage_rc(tid * 16 + i * 8192, R, C); const int Rb = Epi::PERM ? ((R & ~31) + perm32(R & 31)) : R;
        voffA[i] = (unsigned)(R * LD + C) * 2u; voffB[i] = (unsigned)(Rb * LD + C) * 2u; }
    const size_t kstep = (size_t)(BK * 2);
    const size_t hstep = (size_t)HALF * LD * 2;
    const size_t tstep = 2 * hstep;
    const unsigned ldsw = (unsigned)wid * 1024u;
    const int aoff = lds_byte(wr * 64 + fr, fq * 8), boff = lds_byte(wc * 32 + fr, fq * 8);
#define PG8_SA(b, h) (((b) * 2 + (h)) * HTB)
#define PG8_SB(b, h) ((4 + (b) * 2 + (h)) * HTB)
#define PG8_STAGE(bufoff, gbase, voff) do { _Pragma("unroll") for (int _i = 0; _i < 2; ++_i) \
        __builtin_amdgcn_global_load_lds((const unsigned*)((const char*)(gbase) + (voff)[_i]), (PG8_LAS unsigned*)(lds + (bufoff) + ldsw + _i * 8192), 16, 0, 0); } while (0)
#define PG8_LDA(dst, b, h) do { _Pragma("unroll") for (int m = 0; m < 4; ++m) _Pragma("unroll") for (int k = 0; k < 2; ++k) dst[m][k] = *(const PG8_LAS bf16x8*)(lds + PG8_SA(b, h) + aoff + m * 2048 + k * 1024); } while (0)
#define PG8_LDB(dst, b, h) do { _Pragma("unroll") for (int n = 0; n < 2; ++n) _Pragma("unroll") for (int k = 0; k < 2; ++k) dst[n][k] = *(const PG8_LAS bf16x8*)(lds + PG8_SB(b, h) + boff + n * 2048 + k * 1024); } while (0)
#define PG8_MMA(ai, bj, At, Bt) do { __builtin_amdgcn_s_setprio(1); _Pragma("unroll") for (int m = 0; m < 4; ++m) _Pragma("unroll") for (int n = 0; n < 2; ++n) _Pragma("unroll") for (int k = 0; k < 2; ++k) \
        acc[ai][bj][m][n] = __builtin_amdgcn_mfma_f32_16x16x32_bf16(Bt[n][k], At[m][k], acc[ai][bj][m][n], 0, 0, 0); __builtin_amdgcn_s_setprio(0); } while (0)
#define PG8_WAIT_V(n) asm volatile("s_waitcnt vmcnt(" #n ")" ::: "memory")
#define PG8_WAIT_L(n) asm volatile("s_waitcnt lgkmcnt(" #n ")" ::: "memory")
#define PG8_BAR __builtin_amdgcn_s_barrier()
#define PG8_SCHED __builtin_amdgcn_sched_barrier(0)
    Unit cur, nxt; int ui = 0;
    if (!S.next(0, cur)) return;
    f32x4 acc[2][2][4][2];
#pragma unroll
    for (int a = 0; a < 2; ++a)
#pragma unroll
        for (int b = 0; b < 2; ++b)
#pragma unroll
            for (int m = 0; m < 4; ++m)
#pragma unroll
                for (int n = 0; n < 2; ++n) acc[a][b][m][n] = (f32x4){0.f, 0.f, 0.f, 0.f};
    bf16x8 At[4][2], B0[2][2], B1[2][2];
    const char* cA = (const char*)g.A + (size_t)cur.pm * tstep + (size_t)cur.ko * 2; const char* cB = (const char*)g.Bt + (size_t)cur.pn * tstep + (size_t)cur.ko * 2;
    S.a_ready(cur);
    if constexpr (SP2) {
        PG8_STAGE(PG8_SB(0, 0), cB, voffB); PG8_STAGE(PG8_SB(0, 1), cB + hstep, voffB); PG8_STAGE(PG8_SA(0, 0), cA, voffA); PG8_STAGE(PG8_SA(0, 1), cA + hstep, voffA);
        if (wr == 1) PG8_BAR;
        PG8_WAIT_V(2); PG8_BAR;
        PG8_STAGE(PG8_SB(1, 0), cB + kstep, voffB); PG8_STAGE(PG8_SA(1, 0), cA + kstep, voffA); PG8_STAGE(PG8_SB(1, 1), cB + hstep + kstep, voffB);
        PG8_WAIT_V(6); PG8_BAR;
    } else {
        PG8_STAGE(PG8_SB(0, 0), cB, voffB); PG8_STAGE(PG8_SA(0, 0), cA, voffA); PG8_STAGE(PG8_SB(0, 1), cB + hstep, voffB); PG8_STAGE(PG8_SA(0, 1), cA + hstep, voffA);
        if (wr == 1) PG8_BAR;
        PG8_WAIT_V(4); PG8_BAR;
        PG8_STAGE(PG8_SB(1, 0), cB + kstep, voffB); PG8_STAGE(PG8_SA(1, 0), cA + kstep, voffA); PG8_STAGE(PG8_SB(1, 1), cB + hstep + kstep, voffB);
        PG8_WAIT_V(6); PG8_BAR;
    }
    for (;;) {
        const bool has_next = S.next(ui + 1, nxt);
        const char* nA = has_next ? (const char*)g.A + (size_t)nxt.pm * tstep + (size_t)nxt.ko * 2 : cA; const char* nB = has_next ? (const char*)g.Bt + (size_t)nxt.pn * tstep + (size_t)nxt.ko * 2 : cB;
        for (int t = 0; t < nt; t += 2) {
            const bool last = (t == nt - 2);
            const char* a1 = cA + (size_t)(t + 1) * kstep;
            const char* a2 = last ? nA : cA + (size_t)(t + 2) * kstep; const char* b2 = last ? nB : cB + (size_t)(t + 2) * kstep;
            const char* a3 = a2 + kstep; const char* b3 = b2 + kstep;
            if (last && has_next) S.a_ready(nxt);
            if constexpr (SP2) {
            PG8_LDB(B0, 0, 0); PG8_LDB(B1, 0, 1); PG8_SCHED; PG8_LDA(At, 0, 0); PG8_STAGE(PG8_SA(1, 1), a1 + hstep, voffA);
            PG8_WAIT_V(8); PG8_WAIT_L(0); PG8_BAR; PG8_MMA(0, 0, At, B0); PG8_MMA(0, 1, At, B1); PG8_BAR; PG8_SCHED;
            PG8_LDA(At, 0, 1); PG8_STAGE(PG8_SB(0, 0), b2, voffB); PG8_STAGE(PG8_SB(0, 1), b2 + hstep, voffB); PG8_STAGE(PG8_SA(0, 0), a2, voffA);
            PG8_WAIT_V(8); PG8_WAIT_L(0); PG8_BAR; PG8_MMA(1, 0, At, B0); PG8_MMA(1, 1, At, B1); PG8_BAR; PG8_SCHED;
            PG8_LDB(B0, 1, 0); PG8_LDB(B1, 1, 1); PG8_SCHED; PG8_LDA(At, 1, 0); PG8_STAGE(PG8_SA(0, 1), a2 + hstep, voffA);
            PG8_WAIT_V(8); PG8_WAIT_L(0); PG8_BAR; PG8_MMA(0, 0, At, B0); PG8_MMA(0, 1, At, B1); PG8_BAR; PG8_SCHED;
            PG8_LDA(At, 1, 1); PG8_STAGE(PG8_SB(1, 0), b3, voffB); PG8_STAGE(PG8_SB(1, 1), b3 + hstep, voffB); PG8_STAGE(PG8_SA(1, 0), a3, voffA);
            PG8_WAIT_V(8); PG8_WAIT_L(0); PG8_BAR; PG8_MMA(1, 0, At, B0); PG8_MMA(1, 1, At, B1); PG8_BAR; PG8_SCHED;
            } else {
            PG8_LDB(B0, 0, 0); PG8_SCHED; PG8_LDA(At, 0, 0); PG8_STAGE(PG8_SA(1, 1), a1 + hstep, voffA);
            PG8_WAIT_L(8); PG8_BAR; PG8_WAIT_L(0); PG8_MMA(0, 0, At, B0); PG8_BAR; PG8_SCHED;
            PG8_LDB(B1, 0, 1); PG8_STAGE(PG8_SB(0, 0), b2, voffB);
            PG8_BAR; PG8_WAIT_L(0); PG8_MMA(0, 1, At, B1); PG8_BAR;
            PG8_LDA(At, 0, 1); PG8_STAGE(PG8_SA(0, 0), a2, voffA);
            PG8_BAR; PG8_WAIT_L(0); PG8_MMA(1, 0, At, B0); PG8_BAR; PG8_SCHED;
            PG8_STAGE(PG8_SB(0, 1), b2 + hstep, voffB);
            PG8_WAIT_V(6); PG8_BAR; PG8_MMA(1, 1, At, B1); PG8_BAR;
            PG8_LDB(B0, 1, 0); PG8_SCHED; PG8_LDA(At, 1, 0); PG8_STAGE(PG8_SA(0, 1), a2 + hstep, voffA);
            PG8_WAIT_L(8); PG8_BAR; PG8_WAIT_L(0); PG8_MMA(0, 0, At, B0); PG8_BAR; PG8_SCHED;
            PG8_LDB(B1, 1, 1); PG8_STAGE(PG8_SB(1, 0), b3, voffB);
            PG8_BAR; PG8_WAIT_L(0); PG8_MMA(0, 1, At, B1); PG8_BAR;
            PG8_LDA(At, 1, 1); PG8_STAGE(PG8_SA(1, 0), a3, voffA);
            PG8_BAR; PG8_WAIT_L(0); PG8_MMA(1, 0, At, B0); PG8_BAR; PG8_SCHED;
            PG8_STAGE(PG8_SB(1, 1), b3 + hstep, voffB);
            PG8_WAIT_V(6); PG8_BAR; PG8_MMA(1, 1, At, B1); PG8_BAR;
            }
        }
        if constexpr (ALIGN_EPI) { if (wr == 0) PG8_BAR; }
        if constexpr (!Epi::AFTER_DRAIN) { E(acc, cur, wr, wc, fr, fq); S.done(cur); }
        if (!has_next) break;
#pragma unroll
        for (int a = 0; a < 2; ++a)
#pragma unroll
            for (int b = 0; b < 2; ++b)
#pragma unroll
                for (int m = 0; m < 4; ++m)
#pragma unroll
                    for (int n = 0; n < 2; ++n) acc[a][b][m][n] = (f32x4){0.f, 0.f, 0.f, 0.f};
        cur = nxt; cA = nA; cB = nB; ++ui;
        if constexpr (ALIGN_EPI) { if (wr == 1) PG8_BAR; }
    }
    PG8_WAIT_V(0);
    if constexpr (!ALIGN_EPI) { if (wr == 0) PG8_BAR; }
    PG8_BAR;
    if constexpr (Epi::AFTER_DRAIN) { E.fused(acc, cur, wr, wc, fr, fq, lds, wid, lane); S.done(cur); }
#undef PG8_SA
#undef PG8_SB
#undef PG8_STAGE
#undef PG8_LDA
#undef PG8_LDB
#undef PG8_MMA
#undef PG8_WAIT_V
#undef PG8_WAIT_L
#undef PG8_BAR
#undef PG8_SCHED
}
}
#ifndef PG8_SP2
#define PG8_SP2 true
#endif
#ifndef PG8_ALIGN
#define PG8_ALIGN true
#endif
constexpr int D = 2048, NB = 4, SEQ = 4096, CL = 256, DEPTH = 4;
constexpr int ML = NB * SEQ, MC = NB * CL, MT = ML + MC;
constexpr int INW = 15360, DFF = 5632, NFF = 2 * DFF;
constexpr int C_RK = 0, C_RV = 512, C_NK = 1536, C_NV = 2560, C_RQ = 3584, C_RG = 4096, C_NQ = 5120, C_HY = 6144, C_GT = 9216;
constexpr float EPS = 1e-6f;
constexpr int NWAVES = 8;
constexpr size_t al256(size_t x) { return (x + 255) & ~(size_t)255; }
constexpr size_t WS_CTL = 0, CTL_ZERO_BYTES = 1u << 20;
constexpr size_t WS_MOD = WS_CTL + CTL_ZERO_BYTES;
constexpr size_t WS_ROPE = WS_MOD + al256((size_t)4 * 5 * 12288 * 4);
constexpr size_t PS_FH2 = 0;
constexpr size_t PS_FH2B = PS_FH2 + al256((size_t)4352 * 64 * 4);
constexpr size_t PS_TAPC = PS_FH2B + al256((size_t)4352 * 64 * 2);
constexpr size_t PS_KF = PS_TAPC + al256((size_t)2 * 2 * 1024 * 256 * 4);
constexpr size_t PS_WIN = PS_KF + al256((size_t)2 * 1024 * 8192 * 8);
constexpr size_t PS_WBR = PS_WIN + al256((size_t)INW * D * 2);
constexpr size_t PS_WOUT = PS_WBR + al256((size_t)3 * D * 1024 * 2);
constexpr size_t PS_WF1 = PS_WOUT + al256((size_t)D * D * 2);
constexpr size_t PS_WF2 = PS_WF1 + al256((size_t)NFF * D * 2);
constexpr size_t PS_BYTES = PS_WF2 + al256((size_t)D * DFF * 2);
constexpr size_t WS_PSET = WS_ROPE + al256(64 * 16 * 8);
constexpr size_t WS_XC = WS_PSET + 2 * PS_BYTES;
constexpr size_t WS_H = WS_XC + al256((size_t)MC * D * 4);
constexpr size_t WS_Z = WS_H + al256((size_t)MT * D * 2);
constexpr size_t WS_HYT = WS_Z + al256((size_t)MT * INW * 2);
constexpr size_t WS_YT = WS_HYT + al256((size_t)3 * NB * 1024 * SEQ * 2);
constexpr size_t WS_YS = WS_YT + al256((size_t)NB * 1024 * SEQ * 2);
constexpr size_t WS_ACC = WS_YS + al256((size_t)3 * MT * 1024 * 2);
constexpr size_t WS_U = WS_ACC + al256((size_t)MT * D * 2);
constexpr size_t WS_KV = WS_U + al256((size_t)MT * DFF * 2);
constexpr size_t WS_SA = WS_KV + al256((size_t)NB * 8 * 2 * 34 * 8192 * 4);
constexpr size_t WS_SB = WS_SA + al256((size_t)272 * 4 * DFF * 2);
constexpr size_t WS_SLAB = WS_SB + al256((size_t)272 * 2 * DFF * 2);
constexpr size_t WS_FB4 = WS_SLAB + al256((size_t)4 * MC * D * 4);
constexpr size_t WS_END = WS_FB4 + al256((size_t)4 * 4352 * 64 * 2);
constexpr int NSPLIT = 4;
constexpr int CW_BAR = 4096;
constexpr int RING_BYTES = 131072, LDSCTL_OFF = RING_BYTES, MISC_OFF = LDSCTL_OFF + 320, LDS_BYTES = 147456;

#define GAS __attribute__((address_space(1)))
#define LAS __attribute__((address_space(3)))
typedef unsigned short bf16;
typedef unsigned v4u __attribute__((ext_vector_type(4)));
typedef unsigned v2u __attribute__((ext_vector_type(2)));
typedef float f32x4 __attribute__((ext_vector_type(4)));
typedef float f32x2 __attribute__((ext_vector_type(2)));
typedef short bf16x8 __attribute__((ext_vector_type(8)));
typedef GAS unsigned gu32;
#define LDS_WAIT() asm volatile("s_waitcnt lgkmcnt(0)" ::: "memory")
__device__ __forceinline__ unsigned f2bf(float f) { unsigned u = __builtin_bit_cast(unsigned, f); return (u + 0x7fffu + ((u >> 16) & 1u)) >> 16; }
__device__ __forceinline__ unsigned pk2(float lo, float hi) { return f2bf(lo) | (f2bf(hi) << 16); }
__device__ __forceinline__ float bflo(unsigned w) { return __uint_as_float(w << 16); }
__device__ __forceinline__ float bfhi(unsigned w) { return __uint_as_float(w & 0xffff0000u); }
__device__ __forceinline__ float bf1(bf16 b) { return __uint_as_float(((unsigned)b) << 16); }
__device__ __forceinline__ bf16x8 mk8(unsigned a, unsigned b, unsigned c, unsigned d) { v4u v = (v4u){a, b, c, d}; return __builtin_bit_cast(bf16x8, v); }
__device__ __forceinline__ f32x4 mfma16(bf16x8 a, bf16x8 b, f32x4 c) { return __builtin_amdgcn_mfma_f32_16x16x32_bf16(a, b, c, 0, 0, 0); }
__device__ __forceinline__ float sin_rev(float r) { return __builtin_amdgcn_sinf(r - floorf(r)); }
__device__ __forceinline__ float cos_rev(float r) { return __builtin_amdgcn_cosf(r - floorf(r)); }
__device__ __forceinline__ float sin_rad(float x) { return sin_rev(x * 0.15915494309189535f); }
__device__ __forceinline__ float ex2(float x) { return __builtin_amdgcn_exp2f(x); }
__device__ __forceinline__ float wave_sum(float v) {
#pragma unroll
    for (int o = 1; o < 64; o <<= 1) v += __shfl_xor(v, o);
    return v;
}
__device__ __forceinline__ int otid() { int t = threadIdx.x; asm volatile("" : "+v"(t)); return t; }
__device__ __forceinline__ int opq(int v) { asm volatile("" : "+s"(v)); return v; }
#define XB_TMO      128
#define XB_XCNT(j)  (256  + 64 * (j))
#define XB_XSUB(j)  (1280 + 64 * (j))
#define XB_XGEN(j)  (2304 + 64 * (j))
#define XB_TOP      3328
#define XB_TOPGEN   3392
#define XCD_BAR_WORDS 3456
#define XB_SPIN_CAP (1u << 18)

__device__ __forceinline__ unsigned xb_ld(unsigned* p)              { return __hip_atomic_load(p, __ATOMIC_RELAXED, __HIP_MEMORY_SCOPE_AGENT); }
__device__ __forceinline__ unsigned xb_add(unsigned* p, unsigned v) { return __hip_atomic_fetch_add(p, v, __ATOMIC_RELAXED, __HIP_MEMORY_SCOPE_AGENT); }
__device__ __forceinline__ unsigned xb_xcc_id() { return (unsigned)__builtin_amdgcn_s_getreg((3 << 11) | 20) & 0xFu; }
#define XB_SPIN(cond, bar) do { unsigned _sp = 0; while (cond) { __builtin_amdgcn_s_sleep(1); \
    if ((++_sp & 255u) == 0u) { if (xb_ld(&(bar)[XB_TMO])) break; if (_sp > XB_SPIN_CAP) { atomicAdd(&(bar)[XB_TMO], 1u); break; } } } } while (0)

struct XcdBarrier {
    unsigned* bar; unsigned x;
    volatile LAS unsigned* st;
};

__device__ __forceinline__ XcdBarrier xcd_barrier_post(unsigned* bar, volatile LAS unsigned* st) {
    XcdBarrier b; b.bar = bar; b.x = xb_xcc_id(); b.st = st;
    if (threadIdx.x == 0) (void)xb_add(&bar[XB_XCNT(b.x)], 1u);
    return b;
}
__device__ __forceinline__ void xcd_barrier_complete(unsigned* bar, unsigned x, unsigned& nloc, unsigned& nx) {
    const unsigned G = gridDim.x * gridDim.y * gridDim.z;
    unsigned sum, cnt, mine, sp = 0u;
    for (;;) {
        sum = 0u; cnt = 0u; mine = 0u;
#pragma unroll
        for (unsigned j = 0; j < 16; ++j) { const unsigned c = xb_ld(&bar[XB_XCNT(j)]); sum += c; cnt += (c > 0u) ? 1u : 0u; mine = (j == x) ? c : mine; }
        if (sum == G) break;
        __builtin_amdgcn_s_sleep(1);
        if ((++sp & 255u) == 0u) { if (xb_ld(&bar[XB_TMO])) break; if (sp > XB_SPIN_CAP) { atomicAdd(&bar[XB_TMO], 1u); break; } }
    }
    nloc = mine > 0u ? mine : 1u; nx = cnt > 0u ? cnt : 1u;
}

__device__ __forceinline__ void xcd_barrier(const XcdBarrier& b) {
    asm volatile("s_waitcnt vmcnt(0)" ::: "memory");
    __syncthreads();
    if (threadIdx.x == 0) {
        unsigned* bar = b.bar;
        __builtin_amdgcn_s_waitcnt(0);
        unsigned nloc = b.st[0], nx = b.st[1];
        if (nloc == 0u) { xcd_barrier_complete(bar, b.x, nloc, nx); b.st[0] = nloc; b.st[1] = nx; }
        const unsigned old = xb_add(&bar[XB_XSUB(b.x)], 1u);
        const unsigned gen = old / nloc;
        if (old + 1u == (gen + 1u) * nloc) {
            __builtin_amdgcn_fence(__ATOMIC_RELEASE, "agent");
            asm volatile("s_waitcnt vmcnt(0)" ::: "memory");
            const unsigned og = xb_add(&bar[XB_TOP], 1u);
            const unsigned tg = og / nx;
            if (og + 1u == (tg + 1u) * nx) xb_add(&bar[XB_TOPGEN], 1u);
            else XB_SPIN(xb_ld(&bar[XB_TOPGEN]) == tg, bar);
            __builtin_amdgcn_fence(__ATOMIC_ACQUIRE, "agent");
            xb_add(&bar[XB_XGEN(b.x)], 1u);
            asm volatile("s_waitcnt vmcnt(0)" ::: "memory");
        } else {
            XB_SPIN(xb_ld(&bar[XB_XGEN(b.x)]) == gen, bar);
            __builtin_amdgcn_fence(__ATOMIC_ACQUIRE, "agent");
            asm volatile("s_waitcnt vmcnt(0)" ::: "memory");
        }
    }
    __syncthreads();
}
__device__ __forceinline__ void p0_transpose_item(const float* W, int K, int N, bf16* WT, int row_off, LAS float* scr, int item, int lane) {
    const int nblk = N / 32, kb = item / nblk, nb = item % nblk, k0 = 64 * kb, n0 = 32 * nb;
#pragma unroll 16
    for (int i = 0; i < 32; ++i) { const int kk = 2 * i + (lane >> 5); scr[kk * 33 + (lane & 31)] = __builtin_nontemporal_load(W + (size_t)(k0 + kk) * N + n0 + (lane & 31)); }
    LDS_WAIT(); asm volatile("" ::: "memory");
    const int c = lane & 7;
#pragma unroll
    for (int j = 0; j < 4; ++j) { const int n = (lane >> 3) + 8 * j; const LAS float* s = scr + (8 * c) * 33 + n;
        v4u o; o.x = pk2(s[0 * 33], s[1 * 33]); o.y = pk2(s[2 * 33], s[3 * 33]); o.z = pk2(s[4 * 33], s[5 * 33]); o.w = pk2(s[6 * 33], s[7 * 33]);
        __builtin_nontemporal_store(o, (GAS v4u*)(WT + (size_t)(row_off + n0 + n) * K + k0 + 8 * c)); }
    LDS_WAIT(); asm volatile("" ::: "memory");
}
struct Args { const float* in[27]; float* out; unsigned char* ws; int seq_lo, seq_hi; };
__device__ __forceinline__ const float* inp(int i) { const char* ka = (const char*)__builtin_amdgcn_kernarg_segment_ptr(); int off = i * 8; asm volatile("" : "+s"(off)); return *(const float* const*)(ka + off); }
__device__ __forceinline__ unsigned char* wsb() { const char* ka = (const char*)__builtin_amdgcn_kernarg_segment_ptr(); int off = 27 * 8 + 8; asm volatile("" : "+s"(off)); return *(unsigned char* const*)(ka + off); }
__device__ __forceinline__ float* outb() { const char* ka = (const char*)__builtin_amdgcn_kernarg_segment_ptr(); int off = 27 * 8; asm volatile("" : "+s"(off)); return *(float* const*)(ka + off); }
__device__ __forceinline__ unsigned char* psb(int set) { return wsb() + WS_PSET + (size_t)set * PS_BYTES; }
enum { I_X = 0, I_C, I_CTX, I_CCTX, I_WMOD, I_BMOD, I_G1, I_G2, I_WIN, I_HCW, I_HCB, I_FW1, I_FB1, I_FW2, I_FB2, I_FW3, I_FFQ, I_HBIAS, I_RDEC, I_RPB, I_WBR, I_WOUT, I_FFW1, I_FFCW, I_FFCB, I_FFW2, I_GF };

__device__ __forceinline__ void ph_prologue(const Args& A, LAS unsigned char* lds, int tid) {
    LAS float* sc = (LAS float*)lds;
    LAS float* red = sc + 5 * 2048;
    const float* c = inp(I_C); const float* cc = inp(I_CCTX);
    for (int i = tid; i < 5 * 2048; i += 512) { const int r = i >> 11, k = i & 2047; const float v = (r < 4) ? c[r * 2048 + k] : cc[k]; sc[i] = v / (1.0f + __expf(-v)); }
    __syncthreads();
    float* mod = (float*)(wsb() + WS_MOD);
    const int kq = tid >> 6, col = tid & 63;
    for (int u = blockIdx.x; u < DEPTH * 192; u += gridDim.x) {
        const int l = u / 192, n0 = (u % 192) * 64;
        const float* W = inp(I_WMOD) + (size_t)l * 2048 * 12288 + n0 + col;
        float a0 = 0.f, a1 = 0.f, a2 = 0.f, a3 = 0.f, a4 = 0.f;
#pragma unroll 16
        for (int k = kq * 256; k < kq * 256 + 256; ++k) { const float w = W[(size_t)k * 12288];
            a0 += sc[k] * w; a1 += sc[2048 + k] * w; a2 += sc[4096 + k] * w; a3 += sc[6144 + k] * w; a4 += sc[8192 + k] * w; }
        red[(kq * 5 + 0) * 64 + col] = a0; red[(kq * 5 + 1) * 64 + col] = a1; red[(kq * 5 + 2) * 64 + col] = a2; red[(kq * 5 + 3) * 64 + col] = a3; red[(kq * 5 + 4) * 64 + col] = a4;
        __syncthreads();
        if (tid < 320) { const int r = tid >> 6; float s = inp(I_BMOD)[l * 12288 + n0 + col];
#pragma unroll
            for (int q = 0; q < 8; ++q) s += red[(q * 5 + r) * 64 + col];
            mod[((size_t)l * 5 + r) * 12288 + n0 + col] = s; }
        __syncthreads();
    }
    if (blockIdx.x == 0) { f32x2* rope = (f32x2*)(wsb() + WS_ROPE);
        for (int i = tid; i < 1024; i += 512) { const int pos = i >> 4, j = i & 15; const float inv = exp2f(-(float)j * (13.287712379549449f / 16.0f));
            const float rev = (float)pos * inv * 0.15915494309189535f; rope[i] = (f32x2){cos_rev(rev), sin_rev(rev)}; } }
}

__device__ __forceinline__ void ph_convert(const Args& A, int l, int set, int it_lo, int it_hi, int wk, int nwk, LAS unsigned char* lds, int wave, int lane) {
    LAS float* scr = (LAS float*)(lds + wave * 16384);
    const int gw = wk * NWAVES + wave, NGW = nwk * NWAVES;
    constexpr int I_IN = (D / 64) * (INW / 32), I_BR = (1024 / 64) * (D / 32), I_OUT = (D / 64) * (D / 32), I_F1 = (D / 64) * (NFF / 32);
    const float* win = inp(I_WIN) + (size_t)l * D * INW; const float* wbr = inp(I_WBR) + (size_t)l * 3 * 1024 * D; const float* wout = inp(I_WOUT) + (size_t)l * D * D;
    const float* wf1 = inp(I_FFW1) + (size_t)l * D * NFF; const float* wf2 = inp(I_FFW2) + (size_t)l * DFF * D;
    unsigned char* ps = psb(set);
    bf16* WIN = (bf16*)(ps + PS_WIN); bf16* WBR = (bf16*)(ps + PS_WBR); bf16* WOUT = (bf16*)(ps + PS_WOUT); bf16* WF1 = (bf16*)(ps + PS_WF1); bf16* WF2 = (bf16*)(ps + PS_WF2);
    for (int it = it_lo + gw; it < it_hi; it += NGW) {
        int r = it;
        if (r < I_IN) { p0_transpose_item(win, D, INW, WIN, 0, scr, r, lane); continue; } r -= I_IN;
        if (r < I_BR) { p0_transpose_item(wbr, 1024, D, WBR, 0, scr, r, lane); continue; } r -= I_BR;
        if (r < I_BR) { p0_transpose_item(wbr + (size_t)1024 * D, 1024, D, WBR + (size_t)D * 1024, 0, scr, r, lane); continue; } r -= I_BR;
        if (r < I_BR) { p0_transpose_item(wbr + (size_t)2 * 1024 * D, 1024, D, WBR + (size_t)2 * D * 1024, 0, scr, r, lane); continue; } r -= I_BR;
        if (r < I_OUT) { p0_transpose_item(wout, D, D, WOUT, 0, scr, r, lane); continue; } r -= I_OUT;
        if (r < I_F1) { const int n0 = (r % (NFF / 32)) * 32, f0 = (n0 < DFF) ? n0 : n0 - DFF, nrow = 256 * (f0 >> 7) + ((n0 < DFF) ? 0 : 128) + (f0 & 127);
            p0_transpose_item(wf1, D, NFF, WF1, nrow - n0, scr, r, lane); continue; } r -= I_F1;
        p0_transpose_item(wf2, DFF, D, WF2, 0, scr, r, lane);
    }
}
constexpr int CONV_ITEMS = (D / 64) * (INW / 32) + 3 * (1024 / 64) * (D / 32) + (D / 64) * (D / 32) + (D / 64) * (NFF / 32) + (DFF / 64) * (D / 32);
__device__ __forceinline__ void ph_filt1(const Args& A, int l, int set, int wk, int nwk, LAS unsigned char* lds, int tid) {
    LAS float* feat = (LAS float*)lds;
    LAS float* h1 = feat + 8 * 33;
    LAS float* w1s = h1 + 8 * 64;
    LAS float* w2s = w1s + 33 * 64;
    const float* w1 = inp(I_FW1) + (size_t)l * 33 * 64; const float* b1 = inp(I_FB1) + l * 64; const float* w2 = inp(I_FW2) + (size_t)l * 64 * 64; const float* b2 = inp(I_FB2) + l * 64;
    const float* fq = inp(I_FFQ) + l * 64; bf16* FH2B = (bf16*)(wsb() + WS_FB4) + (size_t)l * 4352 * 64;
    const int pl = tid >> 6, o = tid & 63;
    __syncthreads();
    for (int i = tid; i < 33 * 64; i += 512) w1s[i] = w1[i];
    for (int i = tid; i < 64 * 64; i += 512) w2s[i] = w2[i];
    const float b1o = b1[o], b2o = b2[o], fqo = fq[o];
    __syncthreads();
    for (int u = wk; u < 544; u += nwk) {
        const int pos = u * 8 + pl; const bool isc = pos >= 4096; const int Lf = isc ? 256 : 4096, tp = isc ? pos - 4096 : pos;
        if (o < 33) { float f;
            if (o == 0) f = (float)tp / (float)(Lf - 1);
            else { const int i = (o - 1) & 15; const float fr = 1e-4f + (float)i * ((15.0f - 1e-4f) / 15.0f); const float rev = fr * (float)tp / (float)Lf; f = (o <= 16) ? cos_rev(rev) : -sin_rev(rev); }
            feat[pl * 33 + o] = f; }
        __syncthreads();
        float a = b1o;
#pragma unroll 11
        for (int i = 0; i < 33; ++i) a += feat[pl * 33 + i] * w1s[i * 64 + o];
        h1[pl * 64 + o] = sin_rad(fqo * a);
        __syncthreads();
        float b = b2o;
#pragma unroll 16
        for (int j = 0; j < 64; ++j) b += h1[pl * 64 + j] * w2s[j * 64 + o];
        FH2B[(size_t)pos * 64 + o] = (bf16)f2bf(sin_rad(fqo * b));
        __syncthreads();
    }
}
__device__ __forceinline__ void ph_norm(const float* xlat, const float* xctx, const float* g, const float* modl, int sh_off, int sc_off, bf16* H, int Mrows, const float* slab, const float* sgate, float* xc_out, int wave, int lane) {
    const int gw = blockIdx.x * NWAVES + wave, NGW = gridDim.x * NWAVES;
    for (int base = gw * 8; base < ML; base += NGW * 8) {
        const float* mv = modl + (size_t)(base >> 12) * 12288;
        f32x4 Gv[8], Sv[8];
#pragma unroll
        for (int j = 0; j < 8; ++j) { const int idx = (lane + 64 * j) * 4; Gv[j] = *(const f32x4*)(g + idx) * (*(const f32x4*)(mv + sc_off + idx) + 1.0f); Sv[j] = *(const f32x4*)(mv + sh_off + idx); }
        f32x4 v[8], nx[8];
#pragma unroll
        for (int j = 0; j < 8; ++j) nx[j] = *(const f32x4*)(xlat + (size_t)base * D + (lane + 64 * j) * 4);
#pragma unroll 1
        for (int i = 0; i < 8; ++i) { const int m = base + i; float ss = 0.f;
#pragma unroll
            for (int j = 0; j < 8; ++j) { v[j] = nx[j]; ss += (v[j].x * v[j].x + v[j].y * v[j].y) + (v[j].z * v[j].z + v[j].w * v[j].w); }
            if (i < 7) {
#pragma unroll
                for (int j = 0; j < 8; ++j) nx[j] = *(const f32x4*)(xlat + (size_t)(m + 1) * D + (lane + 64 * j) * 4); }
            const float rstd = 1.0f / sqrtf(wave_sum(ss) * (1.0f / D) + EPS);
#pragma unroll
            for (int j = 0; j < 8; ++j) { const int idx = (lane + 64 * j) * 4; const f32x4 y = v[j] * rstd * Gv[j] + Sv[j];
                v2u w; w.x = pk2(y.x, y.y); w.y = pk2(y.z, y.w); *(v2u*)(H + (size_t)m * D + idx) = w; } }
    }
    for (int m = ML + gw; m < Mrows; m += NGW) {
        const float* xr = xctx + (size_t)(m - ML) * D; const float* mv = modl + (size_t)4 * 12288;
        f32x4 v[8]; float ss = 0.f;
#pragma unroll
        for (int j = 0; j < 8; ++j) { const int idx = (lane + 64 * j) * 4; v[j] = *(const f32x4*)(xr + idx);
            if (slab) { const float* sp = slab + (size_t)(m - ML) * D + idx; f32x4 p = *(const f32x4*)sp;
#pragma unroll
                for (int q = 1; q < NSPLIT; ++q) p = p + *(const f32x4*)(sp + (size_t)q * MC * D);
                v[j] = v[j] + *(const f32x4*)(sgate + idx) * p; *(f32x4*)(xc_out + (size_t)(m - ML) * D + idx) = v[j]; }
            ss += (v[j].x * v[j].x + v[j].y * v[j].y) + (v[j].z * v[j].z + v[j].w * v[j].w); }
        const float rstd = 1.0f / sqrtf(wave_sum(ss) * (1.0f / D) + EPS);
#pragma unroll
        for (int j = 0; j < 8; ++j) { const int idx = (lane + 64 * j) * 4;
            const f32x4 gg = *(const f32x4*)(g + idx), sh = *(const f32x4*)(mv + sh_off + idx), sc = *(const f32x4*)(mv + sc_off + idx);
            const f32x4 y = v[j] * rstd * gg * (sc + 1.0f) + sh;
            v2u w; w.x = pk2(y.x, y.y); w.y = pk2(y.z, y.w);
            *(v2u*)(H + (size_t)m * D + idx) = w; }
    }
}

__device__ __forceinline__ int fphys(int i) { return i + 2 * (i >> 5); }
__device__ __forceinline__ void bfly_dif(f32x2& a, f32x2& b, float c, float s) { const f32x2 u = a, v = b; a = u + v; const f32x2 d = u - v; b = __builtin_elementwise_fma(d.yx, (f32x2){s, -s}, d * (f32x2){c, c}); }
__device__ __forceinline__ void bfly_idit(f32x2& a, f32x2& b, float c, float s) { const f32x2 u = a, q = b; const f32x2 v = __builtin_elementwise_fma(q.yx, (f32x2){-s, s}, q * (f32x2){c, c}); a = u + v; b = u - v; }
template <bool ZHI> __device__ __forceinline__ void dif16(f32x2 (&x)[16], float th) {
    asm volatile("" : "+v"(th));
#pragma unroll
    for (int k = 0; k < 8; ++k) { const float fr = th + (float)k * 0.0625f; const float c = __builtin_amdgcn_cosf(fr), s = __builtin_amdgcn_sinf(fr);
        if (ZHI) { const f32x2 u = x[k]; x[k + 8] = (f32x2){u.x * c + u.y * s, u.y * c - u.x * s}; } else bfly_dif(x[k], x[k + 8], c, s); }
#pragma unroll
    for (int k = 0; k < 4; ++k) { const float fr = 2.0f * th + (float)k * 0.125f; const float c = __builtin_amdgcn_cosf(fr), s = __builtin_amdgcn_sinf(fr);
        bfly_dif(x[k], x[k + 4], c, s); bfly_dif(x[8 + k], x[12 + k], c, s); }
#pragma unroll
    for (int k = 0; k < 2; ++k) { const float fr = 4.0f * th + (float)k * 0.25f; const float c = __builtin_amdgcn_cosf(fr), s = __builtin_amdgcn_sinf(fr);
#pragma unroll
        for (int b = 0; b < 16; b += 4) bfly_dif(x[b + k], x[b + k + 2], c, s); }
    { const float fr = 8.0f * th; const float c = __builtin_amdgcn_cosf(fr), s = __builtin_amdgcn_sinf(fr);
#pragma unroll
        for (int b = 0; b < 16; b += 2) bfly_dif(x[b], x[b + 1], c, s); }
}
__device__ __forceinline__ void idit16(f32x2 (&x)[16], float th) {
    asm volatile("" : "+v"(th));
    { const float fr = 8.0f * th; const float c = __builtin_amdgcn_cosf(fr), s = __builtin_amdgcn_sinf(fr);
#pragma unroll
        for (int b = 0; b < 16; b += 2) bfly_idit(x[b], x[b + 1], c, s); }
#pragma unroll
    for (int k = 0; k < 2; ++k) { const float fr = 4.0f * th + (float)k * 0.25f; const float c = __builtin_amdgcn_cosf(fr), s = __builtin_amdgcn_sinf(fr);
#pragma unroll
        for (int b = 0; b < 16; b += 4) bfly_idit(x[b + k], x[b + k + 2], c, s); }
#pragma unroll
    for (int k = 0; k < 4; ++k) { const float fr = 2.0f * th + (float)k * 0.125f; const float c = __builtin_amdgcn_cosf(fr), s = __builtin_amdgcn_sinf(fr);
        bfly_idit(x[k], x[k + 4], c, s); bfly_idit(x[8 + k], x[12 + k], c, s); }
#pragma unroll
    for (int k = 0; k < 8; ++k) { const float fr = th + (float)k * 0.0625f; const float c = __builtin_amdgcn_cosf(fr), s = __builtin_amdgcn_sinf(fr); bfly_idit(x[k], x[k + 8], c, s); }
}
template <bool INV, int PSTRIDE> __device__ __forceinline__ void fft_pass(LAS f32x2* buf, int base, float th) {
    LAS f32x2* p = buf + fphys(base);
    f32x2 x[16];
#pragma unroll
    for (int k = 0; k < 16; ++k) x[k] = p[k * PSTRIDE];
    if (INV) idit16(x, th); else dif16<false>(x, th);
#pragma unroll
    for (int k = 0; k < 16; ++k) p[k * PSTRIDE] = x[k];
}
constexpr int FFT_LDS_BYTES = (8192 + 512 + 8) * 8;
__device__ __forceinline__ float block_sum(float v, LAS float* red, int tid) {
    v = wave_sum(v);
    __syncthreads();
    if ((tid & 63) == 0) red[tid >> 6] = v;
    __syncthreads();
    float s = 0.f;
#pragma unroll
    for (int i = 0; i < 8; ++i) s += red[i];
    return s;
}
__device__ __forceinline__ float hy_delta(int c) { const float d0 = -4.605170185988091f / 0.3f, d1 = -4.605170185988091f / 1.5f; return fabsf(d0 + (d1 - d0) * ((float)c / 1023.0f)); }
__device__ __forceinline__ void ph_filt2(const Args& A, int l, int set, int c_lo, int c_hi, int wk, int nwk, LAS unsigned char* lds, int tid) {
    LAS f32x2* buf = (LAS f32x2*)lds; LAS float* bufs = (LAS float*)lds; LAS float* red = (LAS float*)(lds + FFT_LDS_BYTES + 64); LAS float* w3s = red + 32;
    LAS float* ctap = w3s + 256;
    const float* w3 = inp(I_FW3) + (size_t)l * 64 * 4096; const bf16* FH2B = (const bf16*)(wsb() + WS_FB4) + (size_t)l * 4352 * 64;
    f32x2* KF = (f32x2*)(psb(set) + PS_KF); float* TAPC = (float*)(psb(set) + PS_TAPC);
    const int lane = tid & 63, w = tid >> 6, g = lane >> 4, li = lane & 15;
    for (int c = c_lo + wk; c < c_hi; c += nwk) {
        __syncthreads();
        if (tid < 256) w3s[tid] = w3[(size_t)(tid & 63) * 4096 + (tid >> 7) * 2048 + ((tid >> 6) & 1) * 1024 + c];
        __syncthreads();
        bf16x8 bfr[2];
#pragma unroll
        for (int ks = 0; ks < 2; ++ks) { float v[8];
#pragma unroll
            for (int j = 0; j < 8; ++j) v[j] = (li < 4) ? w3s[li * 64 + 32 * ks + 8 * g + j] : 0.f;
            bfr[ks] = mk8(pk2(v[0], v[1]), pk2(v[2], v[3]), pk2(v[4], v[5]), pk2(v[6], v[7])); }
        const float delta = hy_delta(c); float ssq = 0.f, ssqc = 0.f;
        const int comp = li >> 1;
#pragma unroll 1
        for (int rb = 0; rb < 272; rb += 64) {
            bf16x8 a0[8], a1[8];
#pragma unroll
            for (int rk = 0; rk < 8; ++rk) { const int rt = rb + w + 8 * rk; const bf16* ap = FH2B + (size_t)((rt < 272 ? rt : 0) * 16 + li) * 64 + 8 * g;
                a0[rk] = *(const bf16x8*)ap; a1[rk] = *(const bf16x8*)(ap + 32); }
#pragma unroll
            for (int rk = 0; rk < 8; ++rk) { const int rt = rb + w + 8 * rk; const int t0 = rt * 16;
                f32x4 acc = (f32x4){0.f, 0.f, 0.f, 0.f};
                acc = mfma16(a0[rk], bfr[0], acc); acc = mfma16(a1[rk], bfr[1], acc);
                if (li < 4 && rt < 272) {
                    if (rt < 256) {
#pragma unroll
                        for (int j = 0; j < 4; ++j) { const int t = t0 + 4 * g + j; const float val = acc[j] * __expf(-((float)t / 4095.0f) * delta);
                            if ((li & 1) == 0) { bufs[2 * fphys(t) + comp] = val; ssq += val * val; }
                            else if (t >= 1) { bufs[2 * fphys(8192 - t) + comp] = val; ssq += val * val; }
                            else bufs[2 * fphys(4096) + comp] = 0.f; }
                    } else {
#pragma unroll
                        for (int j = 0; j < 4; ++j) { const int m = t0 - 4096 + 4 * g + j; const float val = acc[j] * __expf(-((float)m / 255.0f) * delta);
                            ctap[li * 256 + m] = val; if ((li & 1) == 0 || m >= 1) ssqc += val * val; }
                    }
                }
            }
        }
        const bool o0 = (li < 2), o1 = (li == 2 || li == 3);
        const float scl0 = (1.0f / 8192.0f) / sqrtf(block_sum(o0 ? ssq : 0.f, red, tid) + EPS), scl1 = (1.0f / 8192.0f) / sqrtf(block_sum(o1 ? ssq : 0.f, red, tid) + EPS);
        const float sc0 = 1.0f / sqrtf(block_sum(o0 ? ssqc : 0.f, red, tid) + EPS), sc1 = 1.0f / sqrtf(block_sum(o1 ? ssqc : 0.f, red, tid) + EPS);
        __syncthreads();
        fft_pass<false, 544>(buf, tid, (float)tid * (1.0f / 8192.0f));
        __syncthreads();
        fft_pass<false, 34>(buf, (tid >> 5) * 512 + (tid & 31), (float)(tid & 31) * (1.0f / 512.0f));
        __syncthreads();
        fft_pass<false, 2>(buf, (tid >> 1) * 32 + (tid & 1), (float)(tid & 1) * (1.0f / 32.0f));
        __syncthreads();
#pragma unroll
        for (int r = 0; r < 8; ++r) { LAS f32x4* pp = (LAS f32x4*)(buf + fphys(2 * tid) + 1088 * r); const f32x4 ab = *pp; *pp = (f32x4){ab.x + ab.z, ab.y + ab.w, ab.x - ab.z, ab.y - ab.w}; }
        __syncthreads();
        f32x2* d0 = KF + (size_t)c * 8192; f32x2* d1 = KF + (size_t)(1024 + c) * 8192;
#pragma unroll 4
        for (int i = 0; i < 16; ++i) { const int p = tid + 512 * i; const int f = (int)(__brev((unsigned)p) >> 19); const int pp = (int)(__brev((unsigned)((8192 - f) & 8191)) >> 19);
            const f32x2 z = buf[fphys(p)], zp = buf[fphys(pp)];
            d0[p] = (f32x2){(z.x + zp.x) * 0.5f * scl0, (z.y - zp.y) * 0.5f * scl0};
            d1[p] = (f32x2){(z.y + zp.y) * 0.5f * scl1, (zp.x - z.x) * 0.5f * scl1}; }
        for (int q = tid; q < 1024; q += 512) { const int od = q >> 8, m = q & 255; TAPC[((size_t)od * 1024 + c) * 256 + m] = ctap[q] * ((od < 2) ? sc0 : sc1); }
    }
}

__device__ __forceinline__ void ph_hyprep(const Args& A, int l, LAS unsigned char* lds, int tid) {
    LAS bf16* T = (LAS bf16*)lds;
    const bf16* Z = (const bf16*)(wsb() + WS_Z); bf16* HYT = (bf16*)(wsb() + WS_HYT);
    const float* cw = inp(I_HCW) + (size_t)l * 3 * 3072; const float* cb = inp(I_HCB) + (size_t)l * 3072;
    v4u pre[5];
#define HP_LOAD(u_) do { const int cg_ = (u_) % 12, tt_ = ((u_) / 12) & 63, b_ = (u_) / 768; \
        _Pragma("unroll") for (int e = 0; e < 5; ++e) { const int q = tid + 512 * e; const int r = q >> 5, ch8 = q & 31, t = tt_ * 64 - 1 + r; pre[e] = (v4u){0u, 0u, 0u, 0u}; \
            if (q < 66 * 32 && t >= 0 && t < SEQ) pre[e] = *(const v4u*)(Z + (size_t)(b_ * SEQ + t) * INW + C_HY + cg_ * 256 + ch8 * 8); } } while (0)
    int u = blockIdx.x;
    if (u < 3072) HP_LOAD(u);
    for (; u < 3072; u += gridDim.x) {
        const int cg = u % 12, tt = (u / 12) & 63, b = u / 768;
        __syncthreads();
#pragma unroll
        for (int e = 0; e < 5; ++e) { const int q = tid + 512 * e; if (q < 66 * 32) *(LAS v4u*)(T + (q >> 5) * 264 + (q & 31) * 8) = pre[e]; }
        __syncthreads();
        if (u + (int)gridDim.x < 3072) HP_LOAD(u + (int)gridDim.x);
        const int ch = tid & 255, half = tid >> 8, gch = cg * 256 + ch;
        const float w0 = cw[gch], w1 = cw[3072 + gch], w2 = cw[6144 + gch], bb = cb[gch];
        const int part = gch >> 10, c = gch & 1023;
        bf16* outp = HYT + ((size_t)(part * NB + b) * 1024 + c) * SEQ + tt * 64 + half * 32;
#pragma unroll
        for (int tq = 0; tq < 4; ++tq) { float vv[8];
#pragma unroll
            for (int e = 0; e < 8; ++e) { const int tl = half * 32 + tq * 8 + e;
                vv[e] = w0 * bf1(T[tl * 264 + ch]) + w1 * bf1(T[(tl + 1) * 264 + ch]) + w2 * bf1(T[(tl + 2) * 264 + ch]) + bb; }
            v4u w; w.x = pk2(vv[0], vv[1]); w.y = pk2(vv[2], vv[3]); w.z = pk2(vv[4], vv[5]); w.w = pk2(vv[6], vv[7]);
            *(v4u*)(outp + tq * 8) = w; }
    }
#undef HP_LOAD
}
__device__ __forceinline__ void ph_hyctx(const Args& A, int l, LAS unsigned char* lds, int tid) {
    const bf16* Z = (const bf16*)(wsb() + WS_Z); bf16* YS = (bf16*)(wsb() + WS_YS); const float* TAPC = (const float*)(psb(l & 1) + PS_TAPC);
    const float* cw = inp(I_HCW) + (size_t)l * 3 * 3072; const float* cb = inp(I_HCB) + (size_t)l * 3072; const float* hb = inp(I_HBIAS) + (size_t)l * 2 * 1024;
    const int ch = tid >> 6, q = tid & 63, t0 = 4 * q;
    LAS float* Y = (LAS float*)lds + ch * 1552; LAS float* Y1 = Y + 256; LAS float* G0 = Y + 512; LAS float* G1 = Y + 1032;
    for (int u = blockIdx.x; u < 512; u += gridDim.x) {
        const int b = u >> 7, c = (u & 127) * 8 + ch;
        __syncthreads();
        float pv[3][4];
#pragma unroll
        for (int part = 0; part < 3; ++part) { const int gch = part * 1024 + c; const float w0 = cw[gch], w1 = cw[3072 + gch], w2 = cw[6144 + gch], bb = cb[gch];
            const bf16* zp = Z + (size_t)(ML + b * CL + t0) * INW + C_HY + gch;
            float zz[6];
#pragma unroll
            for (int e = 0; e < 6; ++e) { const int t = t0 - 1 + e; zz[e] = (t >= 0 && t < CL) ? bf1(zp[(ptrdiff_t)(e - 1) * INW]) : 0.f; }
#pragma unroll
            for (int r = 0; r < 4; ++r) pv[part][r] = w0 * zz[r] + w1 * zz[r + 1] + w2 * zz[r + 2] + bb; }
        *(LAS f32x4*)(Y + t0) = (f32x4){pv[2][0], pv[2][1], pv[2][2], pv[2][3]};
#pragma unroll
        for (int r = 0; r < 4; ++r) { const int m = t0 + r;
            G0[m + 259] = TAPC[((size_t)(0 * 2 + 0) * 1024 + c) * 256 + m]; G1[m + 259] = TAPC[((size_t)(1 * 2 + 0) * 1024 + c) * 256 + m];
            if (m >= 1) { G0[259 - m] = TAPC[((size_t)(0 * 2 + 1) * 1024 + c) * 256 + m]; G1[259 - m] = TAPC[((size_t)(1 * 2 + 1) * 1024 + c) * 256 + m]; } }
        if (q == 0) { G0[515] = 0.f; G1[515] = 0.f; G0[516] = 0.f; G1[516] = 0.f; }
        __syncthreads();
        float yprev[4] = {pv[2][0], pv[2][1], pv[2][2], pv[2][3]};
#pragma unroll
        for (int ord = 0; ord < 2; ++ord) {
            const LAS float* Ys = ord ? Y1 : Y; const LAS float* G = ord ? G1 : G0;
            float acc[4] = {0.f, 0.f, 0.f, 0.f};
#pragma unroll 4
            for (int sp = 0; sp < 64; ++sp) { const f32x4 yv = *(const LAS f32x4*)(Ys + 4 * sp); const LAS float* gp = G + 4 * (q - sp) + 256;
                const f32x4 ga = *(const LAS f32x4*)gp, gb = *(const LAS f32x4*)(gp + 4);
                const float g[8] = {ga.x, ga.y, ga.z, ga.w, gb.x, gb.y, gb.z, gb.w}; const float yy[4] = {yv.x, yv.y, yv.z, yv.w};
#pragma unroll
                for (int r = 0; r < 4; ++r)
#pragma unroll
                    for (int j = 0; j < 4; ++j) acc[r] += yy[j] * g[r - j + 3]; }
            const float bias = hb[ord * 1024 + c];
#pragma unroll
            for (int r = 0; r < 4; ++r) yprev[r] = pv[ord][r] * (acc[r] + bias * yprev[r]);
            if (ord == 0) { *(LAS f32x4*)(Y1 + t0) = (f32x4){yprev[0], yprev[1], yprev[2], yprev[3]}; __syncthreads(); }
        }
#pragma unroll
        for (int r = 0; r < 4; ++r) YS[(size_t)(ML + b * CL + t0 + r) * 1024 + c] = (bf16)f2bf(yprev[r]);
    }
}
__device__ __forceinline__ void unpack8(v4u v, float (&x)[8]) { x[0] = bflo(v.x); x[1] = bfhi(v.x); x[2] = bflo(v.y); x[3] = bfhi(v.y); x[4] = bflo(v.z); x[5] = bfhi(v.z); x[6] = bflo(v.w); x[7] = bfhi(v.w); }
__device__ __forceinline__ v4u pack8(const float (&x)[8]) { v4u w; w.x = pk2(x[0], x[1]); w.y = pk2(x[2], x[3]); w.z = pk2(x[4], x[5]); w.w = pk2(x[6], x[7]); return w; }
__device__ __forceinline__ void rope8(float (&lo)[8], float (&hi)[8], const f32x2* rt) {
#pragma unroll
    for (int e = 0; e < 8; ++e) { const f32x2 cs = rt[e]; const float a = lo[e], b = hi[e]; lo[e] = a * cs.x - b * cs.y; hi[e] = b * cs.x + a * cs.y; }
}
__device__ __forceinline__ void vt_store(LAS bf16* Vt, int ld, int d0, int r, v4u vv) {
    Vt[(d0 + 0) * ld + r] = (bf16)(vv.x & 0xffffu); Vt[(d0 + 1) * ld + r] = (bf16)(vv.x >> 16);
    Vt[(d0 + 2) * ld + r] = (bf16)(vv.y & 0xffffu); Vt[(d0 + 3) * ld + r] = (bf16)(vv.y >> 16);
    Vt[(d0 + 4) * ld + r] = (bf16)(vv.z & 0xffffu); Vt[(d0 + 5) * ld + r] = (bf16)(vv.z >> 16);
    Vt[(d0 + 6) * ld + r] = (bf16)(vv.w & 0xffffu); Vt[(d0 + 7) * ld + r] = (bf16)(vv.w >> 16);
}
constexpr float LOG2E = 1.4426950408889634f;
typedef short s16x4 __attribute__((ext_vector_type(4)));
__device__ __forceinline__ bf16x8 tr_frag(const LAS bf16* tile, int ld, int r0, int r1, int c0, int li) {
    const s16x4 lo = __builtin_amdgcn_ds_read_tr16_b64_v4i16((LAS s16x4*)(tile + (r0 + (li >> 2)) * ld + c0 + 4 * (li & 3)));
    const s16x4 hi = __builtin_amdgcn_ds_read_tr16_b64_v4i16((LAS s16x4*)(tile + (r1 + (li >> 2)) * ld + c0 + 4 * (li & 3)));
    return (bf16x8){lo.x, lo.y, lo.z, lo.w, hi.x, hi.y, hi.z, hi.w};
}
__device__ __forceinline__ void ph_ret1(const Args& A, int l, int nctx_units, LAS unsigned char* lds, int tid) {
    LAS bf16* Kf = (LAS bf16*)lds; LAS bf16* Kb = Kf + 128 * 72; LAS bf16* Vs = Kb + 128 * 72;
    const bf16* Z = (const bf16*)(wsb() + WS_Z); float* KV = (float*)(wsb() + WS_KV); const f32x2* rope = (const f32x2*)(wsb() + WS_ROPE);
    const int lane = tid & 63, w = tid >> 6, g = lane >> 4, li = lane & 15;
    const int tok = tid >> 2, pp = tid & 3, a = (pp & 1) + ((pp >> 1) << 2);
    const int nunits = 1024 + nctx_units;
    v4u pk[2], pv[4];
#define R1_DEC(uid_, b_, h_, n_, ci_, m0_, isc_) const bool isc_ = (uid_) >= 1024; int b_, h_, n_, ci_; size_t m0_; \
        if (!isc_) { b_ = (uid_) >> 8; h_ = ((uid_) >> 5) & 7; n_ = (uid_) & 31; m0_ = (size_t)b_ * SEQ + n_ * 128; ci_ = 2 + n_; } \
        else { const int i_ = (uid_) - 1024; b_ = i_ >> 4; h_ = (i_ >> 1) & 7; n_ = i_ & 1; m0_ = (size_t)ML + b_ * CL + n_ * 128; ci_ = n_; }
#define R1_LOAD(uid_) do { R1_DEC(uid_, b2, h2, n2, ci2, m02, isc2) (void)ci2; (void)n2; (void)isc2; const bf16* kr = Z + (m02 + tok) * INW + C_RK + h2 * 64; pk[0] = *(const v4u*)(kr + 8 * a); pk[1] = *(const v4u*)(kr + 8 * a + 16); \
        _Pragma("unroll") for (int e = 0; e < 4; ++e) { const int q = tid + 512 * e; pv[e] = *(const v4u*)(Z + (m02 + (q >> 4)) * INW + C_RV + h2 * 128 + (q & 15) * 8); } } while (0)
    int uid = blockIdx.x;
    if (uid < nunits) R1_LOAD(uid);
    for (; uid < nunits; uid += gridDim.x) {
        R1_DEC(uid, b, h, n, ci, m0, isc) (void)m0;
        const float lgf = inp(I_RDEC)[(l * 2 + 0) * 8 + h] * LOG2E, lgb = inp(I_RDEC)[(l * 2 + 1) * 8 + h] * LOG2E;
        __syncthreads();
        { float lo[8], hi[8]; unpack8(pk[0], lo); unpack8(pk[1], hi);
            if (!isc) { const int t = n * 128 + tok; const int pos = (a < 4) ? (t >> 6) : (t & 63); rope8(lo, hi, rope + pos * 16 + 8 * (a & 1)); }
            const float zf = ex2(lgf * (float)(127 - tok)) * 0.125f, zb = ex2(lgb * (float)tok) * 0.125f;
            float lf[8], hf[8];
#pragma unroll
            for (int e = 0; e < 8; ++e) { lf[e] = lo[e] * zf; hf[e] = hi[e] * zf; lo[e] *= zb; hi[e] *= zb; }
            *(LAS v4u*)(Kf + tok * 72 + 8 * a) = pack8(lf); *(LAS v4u*)(Kf + tok * 72 + 8 * a + 16) = pack8(hf);
            *(LAS v4u*)(Kb + tok * 72 + 8 * a) = pack8(lo); *(LAS v4u*)(Kb + tok * 72 + 8 * a + 16) = pack8(hi); }
#pragma unroll
        for (int e = 0; e < 4; ++e) { const int q = tid + 512 * e; *(LAS v4u*)(Vs + (q >> 4) * 144 + (q & 15) * 8) = pv[e]; }
        __syncthreads();
        if (uid + (int)gridDim.x < nunits) R1_LOAD(uid + (int)gridDim.x);
        bf16x8 af[4];
#pragma unroll
        for (int ks = 0; ks < 4; ++ks) af[ks] = tr_frag(Vs, 144, 32 * ks + 8 * g, 32 * ks + 8 * g + 4, 16 * w, li);
#pragma unroll
        for (int dir = 0; dir < 2; ++dir) { const LAS bf16* KT = dir ? Kb : Kf;
            float* dst = KV + ((size_t)((b * 8 + h) * 2 + dir) * 34 + ci) * 8192;
#pragma unroll
            for (int nc = 0; nc < 4; ++nc) { f32x4 acc = (f32x4){0.f, 0.f, 0.f, 0.f};
#pragma unroll
                for (int ks = 0; ks < 4; ++ks) acc = mfma16(af[ks], tr_frag(KT, 72, 32 * ks + 8 * g, 32 * ks + 8 * g + 4, 16 * nc, li), acc);
#pragma unroll
                for (int j = 0; j < 4; ++j) dst[(16 * w + 4 * g + j) * 64 + 16 * nc + li] = acc[j]; } }
    }
#undef R1_LOAD
}
__device__ __forceinline__ void ph_natt(const Args& A, int l, int mode, LAS unsigned char* lds, int tid) {
    LAS bf16* Qs = (LAS bf16*)lds; LAS bf16* KV0 = (LAS bf16*)lds; LAS float* rpbs = (LAS float*)(lds + 2 * (64 * 136 + 64 * 144) * 2);
    const bf16* Z = (const bf16*)(wsb() + WS_Z); bf16* YS = (bf16*)(wsb() + WS_YS) + (size_t)2 * MT * 1024;
    const int lane = tid & 63, w = tid >> 6, g = lane >> 4, li = lane & 15;
    const float SCALE = 0.08838834764831845f * LOG2E;
    const int sr0 = tid >> 4, sch = tid & 15;
    const int ufirst = mode ? ((int)blockIdx.x - ((int)gridDim.x - 32)) : (int)blockIdx.x, ucount = mode ? 32 : 512;
    if (ufirst < 0) return;
    for (int uid = ufirst; uid < ucount; uid += (mode ? 32 : (int)gridDim.x)) {
        int b, h, rq = 0; size_t m0;
        if (!mode) { b = uid >> 7; h = (uid >> 4) & 7; rq = uid & 15; m0 = (size_t)b * SEQ + rq * 256; }
        else { b = uid >> 3; h = uid & 7; m0 = (size_t)ML + b * CL; }
        const size_t mc0 = (size_t)ML + b * CL;
        const int qr = 4 * rq + (w >> 1), rs_w = min(max(qr - 4, 0), 56);
        const int kr_lo = min(max(4 * rq - 4, 0), 56), kr_hi = min(max(4 * rq - 1, 0), 56) + 7;
        const int nwin = mode ? 0 : (kr_hi - kr_lo + 1), ntile = nwin + 4;
        int qc[2], cs[2], nlo_w[2], nhi_w[2];
#pragma unroll
        for (int i = 0; i < 2; ++i) { const int cw = 2 * (w & 1) + i; qc[i] = 16 * cw + li; cs[i] = min(max(qc[i] - 8, 0), 48);
            nlo_w[i] = (cw <= 1) ? 0 : cw - 1; nhi_w[i] = (cw == 0) ? 1 : ((cw == 3) ? 3 : cw + 1); }
        v4u kreg[2], vreg[2];
#define NA_LOAD(t_) do { const int t__ = (t_); const size_t mk = (t__ < nwin) ? ((size_t)b * SEQ + (kr_lo + t__) * 64) : (mc0 + (t__ - nwin) * 64); \
            _Pragma("unroll") for (int e = 0; e < 2; ++e) { const bf16* zr = Z + (mk + sr0 + 32 * e) * INW + h * 128 + sch * 8; kreg[e] = *(const v4u*)(zr + C_NK); vreg[e] = *(const v4u*)(zr + C_NV); } } while (0)
#define NA_STORE(buf_) do { LAS bf16* Kd = KV0 + (buf_) * (64 * 136 + 64 * 144); LAS bf16* Vd = Kd + 64 * 136; \
            _Pragma("unroll") for (int e = 0; e < 2; ++e) { *(LAS v4u*)(Kd + (sr0 + 32 * e) * 136 + sch * 8) = kreg[e]; *(LAS v4u*)(Vd + (sr0 + 32 * e) * 144 + sch * 8) = vreg[e]; } } while (0)
        __syncthreads();
        NA_LOAD(0);
        for (int q = tid; q < 4096; q += 512) { const int r = q >> 4, chn = q & 15; *(LAS v4u*)(Qs + r * 136 + chn * 8) = *(const v4u*)(Z + (m0 + r) * INW + C_NQ + h * 128 + chn * 8); }
        if (!mode) for (int i = tid; i < 465; i += 512) rpbs[i] = inp(I_RPB)[((size_t)l * 8 + h) * 465 + i] * LOG2E;
        __syncthreads();
        bf16x8 qf[2][4];
#pragma unroll
        for (int i = 0; i < 2; ++i)
#pragma unroll
            for (int ks = 0; ks < 4; ++ks) qf[i][ks] = *(const LAS bf16x8*)(Qs + (32 * w + 16 * i + li) * 136 + 32 * ks + 8 * g);
        __syncthreads();
        NA_STORE(0);
        __syncthreads();
        f32x4 o[2][8];
#pragma unroll
        for (int i = 0; i < 2; ++i)
#pragma unroll
            for (int nd = 0; nd < 8; ++nd) o[i][nd] = (f32x4){0.f, 0.f, 0.f, 0.f};
        float mrun[2] = {-1e30f, -1e30f}, lrun[2] = {0.f, 0.f};
        for (int t = 0; t < ntile; ++t) {
            const bool win = t < nwin; const int kr = kr_lo + t;
            if (t + 1 < ntile) NA_LOAD(t + 1);
            const LAS bf16* Ks = KV0 + (t & 1) * (64 * 136 + 64 * 144); const LAS bf16* Vs = Ks + 64 * 136;
            const bool active = !win || (kr >= rs_w && kr <= rs_w + 7);
            if (active) {
                const int nlo0 = win ? nlo_w[0] : 0, nhi0 = win ? nhi_w[0] : 3, nlo1 = win ? nlo_w[1] : 0, nhi1 = win ? nhi_w[1] : 3;
                f32x4 s[2][4];
#pragma unroll
                for (int n = 0; n < 4; ++n) { s[0][n] = (f32x4){0.f, 0.f, 0.f, 0.f}; s[1][n] = (f32x4){0.f, 0.f, 0.f, 0.f};
                    const bool u0 = (n >= nlo0 && n <= nhi0), u1 = (n >= nlo1 && n <= nhi1);
                    if (u0 || u1) {
#pragma unroll
                        for (int ks = 0; ks < 4; ++ks) { const bf16x8 kf = *(const LAS bf16x8*)(Ks + (16 * n + li) * 136 + 32 * ks + 8 * g);
                            if (u0) s[0][n] = mfma16(kf, qf[0][ks], s[0][n]);
                            if (u1) s[1][n] = mfma16(kf, qf[1][ks], s[1][n]); } } }
                bf16x8 pf[2][2];
#pragma unroll
                for (int i = 0; i < 2; ++i) {
                    float tmax = -1e30f;
#pragma unroll
                    for (int n = 0; n < 4; ++n)
#pragma unroll
                        for (int j = 0; j < 4; ++j) { float v = s[i][n][j] * SCALE;
                            if (win) { const int kc = 16 * n + 4 * g + j; const bool valid = (kc >= cs[i]) && (kc < cs[i] + 16);
                                const int dc = min(max(kc - qc[i] + 15, 0), 30), dr = min(max(kr - qr + 7, 0), 14);
                                v = valid ? v + rpbs[dr * 31 + dc] : -1e30f; }
                            s[i][n][j] = v; tmax = fmaxf(tmax, v); }
                    tmax = fmaxf(tmax, __shfl_xor(tmax, 16)); tmax = fmaxf(tmax, __shfl_xor(tmax, 32));
                    const bool upd = tmax > mrun[i] + 8.0f;
                    const float mnew = upd ? tmax : mrun[i];
                    float psum = 0.f;
#pragma unroll
                    for (int n = 0; n < 4; ++n)
#pragma unroll
                        for (int j = 0; j < 4; ++j) { const float pv = ex2(s[i][n][j] - mnew); s[i][n][j] = pv; psum += pv; }
                    psum += __shfl_xor(psum, 16); psum += __shfl_xor(psum, 32);
                    if (__any(upd)) { const float alpha = ex2(mrun[i] - mnew); lrun[i] *= alpha;
#pragma unroll
                        for (int nd = 0; nd < 8; ++nd) o[i][nd] = o[i][nd] * alpha; }
                    lrun[i] += psum; mrun[i] = mnew;
#pragma unroll
                    for (int kk = 0; kk < 2; ++kk) pf[i][kk] = mk8(pk2(s[i][2 * kk][0], s[i][2 * kk][1]), pk2(s[i][2 * kk][2], s[i][2 * kk][3]), pk2(s[i][2 * kk + 1][0], s[i][2 * kk + 1][1]), pk2(s[i][2 * kk + 1][2], s[i][2 * kk + 1][3]));
                }
#pragma unroll
                for (int kk = 0; kk < 2; ++kk) { const bool u0 = (2 * kk + 1 >= nlo0 && 2 * kk <= nhi0), u1 = (2 * kk + 1 >= nlo1 && 2 * kk <= nhi1);
                    if (u0 || u1) {
#pragma unroll
                        for (int nd = 0; nd < 8; ++nd) { const bf16x8 vf = tr_frag(Vs, 144, 32 * kk + 4 * g, 32 * kk + 16 + 4 * g, 16 * nd, li);
                            if (u0) o[0][nd] = mfma16(vf, pf[0][kk], o[0][nd]);
                            if (u1) o[1][nd] = mfma16(vf, pf[1][kk], o[1][nd]); } } }
            }
            if (t + 1 < ntile) NA_STORE((t + 1) & 1);
            __syncthreads();
        }
#undef NA_LOAD
#undef NA_STORE
#pragma unroll
        for (int i = 0; i < 2; ++i) { const float inv = 1.0f / lrun[i]; const size_t mrow = m0 + 32 * w + 16 * i + li;
#pragma unroll
            for (int nd = 0; nd < 8; ++nd) { v2u wv; wv.x = pk2(o[i][nd][0] * inv, o[i][nd][1] * inv); wv.y = pk2(o[i][nd][2] * inv, o[i][nd][3] * inv);
                *(v2u*)(YS + mrow * 1024 + h * 128 + 16 * nd + 4 * g) = wv; } }
    }
}

__device__ __forceinline__ void ph_hyfft(const Args& A, int l, LAS unsigned char* lds, int tid) {
    LAS f32x2* buf = (LAS f32x2*)lds;
    const bf16* HYT = (const bf16*)(wsb() + WS_HYT); bf16* YT = (bf16*)(wsb() + WS_YT); const f32x2* KF = (const f32x2*)(psb(l & 1) + PS_KF);
    const float* hb = inp(I_HBIAS) + (size_t)l * 2 * 1024;
    const int baseB = (tid >> 5) * 512 + (tid & 31), baseC = (tid >> 1) * 32 + (tid & 1);
    const float thA = (float)tid * (1.0f / 8192.0f), thB = (float)(tid & 31) * (1.0f / 512.0f), thC = (float)(tid & 1) * (1.0f / 32.0f);
    const size_t bstr = (size_t)1024 * SEQ;
    bf16 vr0[8], vr1[8];
#define HF_PTR(u_, part_) (HYT + ((size_t)((part_) * NB + ((u_) & 1) * 2) * 1024 + ((u_) >> 1)) * SEQ)
    int u = blockIdx.x;
    if (u < 2048) { const bf16* vp = HF_PTR(u, 2);
#pragma unroll
        for (int i = 0; i < 8; ++i) { vr0[i] = vp[tid + 512 * i]; vr1[i] = vp[bstr + tid + 512 * i]; } }
    for (; u < 2048; u += gridDim.x) {
        const int c = u >> 1, b0 = (u & 1) * 2;
        float y0[8], y1[8];
#pragma unroll
        for (int i = 0; i < 8; ++i) { y0[i] = bf1(vr0[i]); y1[i] = bf1(vr1[i]); }
#pragma unroll
        for (int ord = 0; ord < 2; ++ord) {
            f32x4 kreg[8]; bf16 xr0[8], xr1[8];
            { const f32x4* kf = (const f32x4*)(KF + (size_t)(ord * 1024 + c) * 8192); const bf16* xp = HF_PTR(u, ord);
#pragma unroll
                for (int r = 0; r < 8; ++r) { kreg[r] = kf[tid + 512 * r]; xr0[r] = xp[tid + 512 * r]; xr1[r] = xp[bstr + tid + 512 * r]; } }
            { f32x2 x[16];
#pragma unroll
                for (int k = 0; k < 8; ++k) { x[k] = (f32x2){y0[k], y1[k]}; x[k + 8] = (f32x2){0.f, 0.f}; }
                dif16<true>(x, thA);
                __syncthreads();
#pragma unroll
                for (int k = 0; k < 16; ++k) buf[fphys(tid) + 544 * k] = x[k]; }
            __syncthreads();
            fft_pass<false, 34>(buf, baseB, thB);
            __syncthreads();
            fft_pass<false, 2>(buf, baseC, thC);
            __syncthreads();
#pragma unroll
            for (int r = 0; r < 8; ++r) { LAS f32x4* pp = (LAS f32x4*)(buf + fphys(2 * tid) + 1088 * r); const f32x4 ab = *pp; const f32x4 kk = kreg[r];
                const float ax = ab.x + ab.z, ay = ab.y + ab.w, bx = ab.x - ab.z, by = ab.y - ab.w;
                const float px = ax * kk.x - ay * kk.y, py = ax * kk.y + ay * kk.x, qx = bx * kk.z - by * kk.w, qy = bx * kk.w + by * kk.z;
                *pp = (f32x4){px + qx, py + qy, px - qx, py - qy}; }
            __syncthreads();
            fft_pass<true, 2>(buf, baseC, thC);
            __syncthreads();
            fft_pass<true, 34>(buf, baseB, thB);
            __syncthreads();
            if (ord == 1 && u + (int)gridDim.x < 2048) { const bf16* vp = HF_PTR(u + (int)gridDim.x, 2);
#pragma unroll
                for (int i = 0; i < 8; ++i) { vr0[i] = vp[tid + 512 * i]; vr1[i] = vp[bstr + tid + 512 * i]; } }
            { f32x2 x[16];
#pragma unroll
                for (int k = 0; k < 16; ++k) x[k] = buf[fphys(tid) + 544 * k];
                idit16(x, thA);
                const float bias = hb[ord * 1024 + c];
#pragma unroll
                for (int k = 0; k < 8; ++k) { y0[k] = bf1(xr0[k]) * (x[k].x + bias * y0[k]); y1[k] = bf1(xr1[k]) * (x[k].y + bias * y1[k]); } }
        }
        bf16* o0 = YT + ((size_t)b0 * 1024 + c) * SEQ;
#pragma unroll
        for (int i = 0; i < 8; ++i) { const int t = tid + 512 * i; o0[t] = (bf16)f2bf(y0[i]); o0[bstr + t] = (bf16)f2bf(y1[i]); }
    }
#undef HF_PTR
}
__device__ __forceinline__ void ph_scan(const Args& A, int l, int tid) {
    float* KV = (float*)(wsb() + WS_KV);
    for (int gt = blockIdx.x * 512 + tid; gt < NB * 8 * 2 * 2048; gt += gridDim.x * 512) {
        const int bhd = gt >> 11, e4 = gt & 2047, dir = bhd & 1, h = (bhd >> 1) & 7;
        const float gC = ex2(inp(I_RDEC)[(l * 2 + dir) * 8 + h] * LOG2E * 128.0f);
        f32x4* base = (f32x4*)(KV + (size_t)bhd * 34 * 8192) + e4;
        f32x4 s = (f32x4){0.f, 0.f, 0.f, 0.f};
#pragma unroll 1
        for (int sb8 = 0; sb8 < 34; sb8 += 8) {
            f32x4 tv[8];
#pragma unroll
            for (int k = 0; k < 8; ++k) { const int step = min(sb8 + k, 33); const int ci = (dir == 0) ? step : (step == 0 ? 1 : (step == 1 ? 0 : 35 - step)); tv[k] = base[(size_t)ci * 2048]; }
#pragma unroll
            for (int k = 0; k < 8; ++k) { const int step = sb8 + k; if (step < 34) { const int ci = (dir == 0) ? step : (step == 0 ? 1 : (step == 1 ? 0 : 35 - step)); base[(size_t)ci * 2048] = s; s = s * gC + tv[k]; } } }
    }
}

__device__ __forceinline__ void ph_hypost(const Args& A, LAS unsigned char* lds, int tid) {
    LAS bf16* T = (LAS bf16*)lds;
    const bf16* YT = (const bf16*)(wsb() + WS_YT); bf16* YS = (bf16*)(wsb() + WS_YS);
    for (int u = blockIdx.x; u < 1024; u += gridDim.x) {
        const int cg = u & 3, tt = (u >> 2) & 63, b = u >> 8;
        __syncthreads();
        for (int q = tid; q < 2048; q += 512) { const int c = q >> 3, t8 = q & 7;
            *(LAS v4u*)(T + c * 72 + t8 * 8) = *(const v4u*)(YT + ((size_t)b * 1024 + cg * 256 + c) * SEQ + tt * 64 + t8 * 8); }
        __syncthreads();
        const int t = tid >> 3, c32 = tid & 7;
#pragma unroll
        for (int q = 0; q < 4; ++q) { const int cb = c32 * 32 + q * 8; v4u w;
            w.x = (unsigned)T[(cb + 0) * 72 + t] | ((unsigned)T[(cb + 1) * 72 + t] << 16); w.y = (unsigned)T[(cb + 2) * 72 + t] | ((unsigned)T[(cb + 3) * 72 + t] << 16);
            w.z = (unsigned)T[(cb + 4) * 72 + t] | ((unsigned)T[(cb + 5) * 72 + t] << 16); w.w = (unsigned)T[(cb + 6) * 72 + t] | ((unsigned)T[(cb + 7) * 72 + t] << 16);
            *(v4u*)(YS + (size_t)(b * SEQ + tt * 64 + t) * 1024 + cg * 256 + cb) = w; }
    }
}
__device__ __forceinline__ void ph_ret3(const Args& A, int l, int nctx_units, LAS unsigned char* lds, int tid) {
    LAS bf16* Qs = (LAS bf16*)lds; LAS bf16* Ks = Qs + 128 * 72; LAS bf16* Vs = Ks + 128 * 72; LAS bf16* Sf = Vs + 128 * 144; LAS bf16* Sb = Sf + 128 * 72;
    const bf16* Z = (const bf16*)(wsb() + WS_Z); const float* KV = (const float*)(wsb() + WS_KV); const f32x2* rope = (const f32x2*)(wsb() + WS_ROPE);
    bf16* YS = (bf16*)(wsb() + WS_YS) + (size_t)MT * 1024;
    const int lane = tid & 63, w = tid >> 6, g = lane >> 4, li = lane & 15;
    const int tok = tid >> 2, pp = tid & 3, a = (pp & 1) + ((pp >> 1) << 2);
    const int nunits = 1024 + nctx_units;
    v4u pq[2], pk[2], pv[4];
#define R3_LOAD(uid_) do { R1_DEC(uid_, b2, h2, n2, ci2, m02, isc2) (void)n2; (void)isc2; const bf16* qr = Z + (m02 + tok) * INW + C_RQ + h2 * 64; const bf16* kr = Z + (m02 + tok) * INW + C_RK + h2 * 64; \
        pq[0] = *(const v4u*)(qr + 8 * a); pq[1] = *(const v4u*)(qr + 8 * a + 16); pk[0] = *(const v4u*)(kr + 8 * a); pk[1] = *(const v4u*)(kr + 8 * a + 16); \
        (void)ci2; _Pragma("unroll") for (int e = 0; e < 4; ++e) { const int q = tid + 512 * e; pv[e] = *(const v4u*)(Z + (m02 + (q >> 4)) * INW + C_RV + h2 * 128 + (q & 15) * 8); } } while (0)
    int uid = blockIdx.x;
    if (uid < nunits) R3_LOAD(uid);
    for (; uid < nunits; uid += gridDim.x) {
        R1_DEC(uid, b, h, n, ci, m0, isc)
        const float lgf = inp(I_RDEC)[(l * 2 + 0) * 8 + h] * LOG2E, lgb = inp(I_RDEC)[(l * 2 + 1) * 8 + h] * LOG2E;
        __syncthreads();
        { const int t = n * 128 + tok; const int pos = (a < 4) ? (t >> 6) : (t & 63); const f32x2* rt = rope + pos * 16 + 8 * (a & 1);
            float lo[8], hi[8];
            unpack8(pq[0], lo); unpack8(pq[1], hi);
            if (!isc) rope8(lo, hi, rt);
            *(LAS v4u*)(Qs + tok * 72 + 8 * a) = pack8(lo); *(LAS v4u*)(Qs + tok * 72 + 8 * a + 16) = pack8(hi);
            unpack8(pk[0], lo); unpack8(pk[1], hi);
            if (!isc) rope8(lo, hi, rt);
#pragma unroll
            for (int e = 0; e < 8; ++e) { lo[e] *= 0.125f; hi[e] *= 0.125f; }
            *(LAS v4u*)(Ks + tok * 72 + 8 * a) = pack8(lo); *(LAS v4u*)(Ks + tok * 72 + 8 * a + 16) = pack8(hi); }
#pragma unroll
        for (int e = 0; e < 4; ++e) { const int q = tid + 512 * e; *(LAS v4u*)(Vs + (q >> 4) * 144 + (q & 15) * 8) = pv[e]; }
#pragma unroll
        for (int dir = 0; dir < 2; ++dir) { LAS bf16* S = dir ? Sb : Sf; const f32x4* src = (const f32x4*)(KV + ((size_t)((b * 8 + h) * 2 + dir) * 34 + ci) * 8192);
#pragma unroll
            for (int e = 0; e < 4; ++e) { const int q = tid + 512 * e; const f32x4 v = src[q]; v2u wv; wv.x = pk2(v.x, v.y); wv.y = pk2(v.z, v.w); *(LAS v2u*)(S + (q >> 4) * 72 + (q & 15) * 4) = wv; } }
        __syncthreads();
        if (uid + (int)gridDim.x < nunits) R3_LOAD(uid + (int)gridDim.x);
        const int iq = 16 * w + li; const size_t mrow = m0 + iq;
        v2u gq[8];
#pragma unroll
        for (int nd = 0; nd < 8; ++nd) gq[nd] = *(const v2u*)(Z + mrow * INW + C_RG + h * 128 + 16 * nd + 4 * g);
        bf16x8 qf[2];
#pragma unroll
        for (int ks = 0; ks < 2; ++ks) qf[ks] = *(const LAS bf16x8*)(Qs + iq * 72 + 32 * ks + 8 * g);
        f32x4 s[8];
#pragma unroll
        for (int nn = 0; nn < 8; ++nn) { s[nn] = (f32x4){0.f, 0.f, 0.f, 0.f};
#pragma unroll
            for (int ks = 0; ks < 2; ++ks) s[nn] = mfma16(*(const LAS bf16x8*)(Ks + (16 * nn + li) * 72 + 32 * ks + 8 * g), qf[ks], s[nn]);
#pragma unroll
            for (int j = 0; j < 4; ++j) { const int d = iq - (16 * nn + 4 * g + j); s[nn][j] *= (d >= 0) ? ex2(lgf * (float)d) : ex2(lgb * (float)(-d)); } }
        f32x4 o[8];
#pragma unroll
        for (int nd = 0; nd < 8; ++nd) o[nd] = (f32x4){0.f, 0.f, 0.f, 0.f};
#pragma unroll
        for (int kk = 0; kk < 4; ++kk) {
            const bf16x8 pf = mk8(pk2(s[2 * kk][0], s[2 * kk][1]), pk2(s[2 * kk][2], s[2 * kk][3]), pk2(s[2 * kk + 1][0], s[2 * kk + 1][1]), pk2(s[2 * kk + 1][2], s[2 * kk + 1][3]));
#pragma unroll
            for (int nd = 0; nd < 8; ++nd) o[nd] = mfma16(tr_frag(Vs, 144, 32 * kk + 4 * g, 32 * kk + 16 + 4 * g, 16 * nd, li), pf, o[nd]); }
        const float xif = ex2(lgf * (float)(iq + 1)), xib = ex2(lgb * (float)(128 - iq));
        float ss = 0.f;
#pragma unroll
        for (int nd = 0; nd < 8; ++nd) { f32x4 tf = (f32x4){0.f, 0.f, 0.f, 0.f}, tb = (f32x4){0.f, 0.f, 0.f, 0.f};
#pragma unroll
            for (int ks = 0; ks < 2; ++ks) { tf = mfma16(*(const LAS bf16x8*)(Sf + (16 * nd + li) * 72 + 32 * ks + 8 * g), qf[ks], tf);
                tb = mfma16(*(const LAS bf16x8*)(Sb + (16 * nd + li) * 72 + 32 * ks + 8 * g), qf[ks], tb); }
            o[nd] = o[nd] + tf * xif + tb * xib;
            ss += (o[nd][0] * o[nd][0] + o[nd][1] * o[nd][1]) + (o[nd][2] * o[nd][2] + o[nd][3] * o[nd][3]); }
        ss += __shfl_xor(ss, 16); ss += __shfl_xor(ss, 32);
        const float rn = 1.0f / sqrtf(ss * (1.0f / 128.0f) + EPS);
#pragma unroll
        for (int nd = 0; nd < 8; ++nd) { const int dv = 16 * nd + 4 * g; const v2u gv = gq[nd];
            const float g0 = bflo(gv.x), g1 = bfhi(gv.x), g2 = bflo(gv.y), g3 = bfhi(gv.y);
            v2u wv; wv.x = pk2(g0 / (1.0f + __expf(-g0)) * o[nd][0] * rn, g1 / (1.0f + __expf(-g1)) * o[nd][1] * rn);
            wv.y = pk2(g2 / (1.0f + __expf(-g2)) * o[nd][2] * rn, g3 / (1.0f + __expf(-g3)) * o[nd][3] * rn);
            *(v2u*)(YS + mrow * 1024 + h * 128 + dv) = wv; }
    }
#undef R3_LOAD
#undef R1_DEC
}

__device__ __forceinline__ float gelu_fx(float x) { const float x2 = x * x; const float arg = x * (x2 * (-2.0f * 1.4426950408889634f * 0.7978845608028654f * 0.044715f) + (-2.0f * 1.4426950408889634f * 0.7978845608028654f));
    return x * __builtin_amdgcn_rcpf(1.0f + __builtin_amdgcn_exp2f(arg)); }
__device__ __forceinline__ void ph_ffnfix(const Args& A, int l, int Mrows, int tid) {
    const bf16* SA = (const bf16*)(wsb() + WS_SA); const bf16* SB = (const bf16*)(wsb() + WS_SB); bf16* U = (bf16*)(wsb() + WS_U);
    const float* cw = inp(I_FFCW) + (size_t)l * 3 * DFF; const float* cb = inp(I_FFCB) + (size_t)l * DFF;
    const int nblk = Mrows / 64;
    for (int u = blockIdx.x; u < nblk * 2; u += gridDim.x) {
        const int blk = u >> 1, hi = u & 1, R = blk * 64 + (hi ? 63 : 0);
        const bool seq_first = (R < ML) ? ((R & (SEQ - 1)) == 0) : ((R & (CL - 1)) == 0), seq_last = (R < ML) ? ((R & (SEQ - 1)) == SEQ - 1) : ((R & (CL - 1)) == CL - 1);
        const bf16* pprev = hi ? SA + ((size_t)blk * 4 + 2) * DFF : SA + ((size_t)(blk - 1) * 4 + 3) * DFF;
        const bf16* pcur = SA + ((size_t)blk * 4 + (hi ? 3 : 0)) * DFF;
        const bf16* pnext = hi ? SA + ((size_t)(blk + 1) * 4 + 0) * DFF : SA + ((size_t)blk * 4 + 1) * DFF;
        const bf16* pb = SB + ((size_t)blk * 2 + hi) * DFF;
        const bool zp = (!hi && seq_first), zn = (hi && seq_last);
        for (int q = tid; q < DFF / 8; q += 512) { const int f = q * 8;
            float am[8], a0[8], aq[8], bg[8]; const v4u z4 = (v4u){0u, 0u, 0u, 0u};
            unpack8(zp ? z4 : *(const v4u*)(pprev + f), am); unpack8(*(const v4u*)(pcur + f), a0); unpack8(zn ? z4 : *(const v4u*)(pnext + f), aq); unpack8(*(const v4u*)(pb + f), bg);
            float r[8];
#pragma unroll
            for (int e = 0; e < 8; ++e) r[e] = gelu_fx(cw[f + e] * am[e] + cw[DFF + f + e] * a0[e] + cw[2 * DFF + f + e] * aq[e] + cb[f + e]) * bg[e];
            *(v4u*)(U + (size_t)R * DFF + f) = pack8(r); }
    }
}
__device__ __forceinline__ void ph_final(const Args& A, int wave, int lane) {
    const int gw = blockIdx.x * NWAVES + wave, NGW = gridDim.x * NWAVES; const float* g = inp(I_GF);
    for (int m = gw; m < ML; m += NGW) { float* xr = outb() + (size_t)m * D; f32x4 v[8]; float ss = 0.f;
#pragma unroll
        for (int j = 0; j < 8; ++j) { v[j] = *(const f32x4*)(xr + (lane + 64 * j) * 4); ss += (v[j].x * v[j].x + v[j].y * v[j].y) + (v[j].z * v[j].z + v[j].w * v[j].w); }
        const float rstd = 1.0f / sqrtf(wave_sum(ss) * (1.0f / D) + EPS);
#pragma unroll
        for (int j = 0; j < 8; ++j) { const int idx = (lane + 64 * j) * 4; *(f32x4*)(xr + idx) = v[j] * rstd * *(const f32x4*)(g + idx); }
    }
}
#ifndef SKEW_US
#define SKEW_US 0
#endif
__device__ __forceinline__ void spin_us(int us) { if (us > 0) { const unsigned long long t0 = __builtin_amdgcn_s_memrealtime(); while (__builtin_amdgcn_s_memrealtime() - t0 < (unsigned long long)us * 100ull) __builtin_amdgcn_s_sleep(8); } }
constexpr int FILT_F = 816, FILT_I = 896;
constexpr int BG_SPLIT = 22016;
constexpr int SEQ_PER_LAYER = 11, NSEQ = 1 + DEPTH * SEQ_PER_LAYER + 1;
__global__ void __launch_bounds__(NWAVES * 64, 2) fwd(Args A) {
    extern __shared__ __attribute__((aligned(16))) unsigned char lds_raw[];
    LAS unsigned char* lds = (LAS unsigned char*)lds_raw;
    volatile LAS unsigned* MISC = (volatile LAS unsigned*)(lds + MISC_OFF);
    for (int u = threadIdx.x; u < (LDS_BYTES - LDSCTL_OFF) / 4; u += NWAVES * 64) ((LAS unsigned*)(lds + LDSCTL_OFF))[u] = 0u;
    __syncthreads();
    (void)xcd_barrier_post((unsigned*)(wsb() + WS_CTL) + CW_BAR, MISC + 8);
    const int lo = A.seq_lo, hi = A.seq_hi;
#ifdef PROBE_K
    unsigned long long pr_acc = 0ull, pr_prev = __builtin_amdgcn_s_memrealtime();
#endif
#define G ((int)gridDim.x)
#ifdef PROBE_SUB
#define PROBE_K 999
#define SUBT(n, stmt) do { unsigned long long t0_ = 0; if ((n) == PROBE_SUB && blockIdx.x == PROBE_WG && threadIdx.x == 0) t0_ = __builtin_amdgcn_s_memrealtime(); stmt; if ((n) == PROBE_SUB && blockIdx.x == PROBE_WG && threadIdx.x == 0) pr_acc += __builtin_amdgcn_s_memrealtime() - t0_; } while (0)
#else
#define SUBT(n, stmt) do { stmt; } while (0)
#endif
#ifdef PROBE_K
#ifndef PROBE_WG
#define PROBE_WG 0
#endif
#ifndef PROBE_WAIT
#define PROBE_WAIT 0
#endif
#define PROBE_PH(s) (((s) == 0) ? 100 : (((s) - 1) % SEQ_PER_LAYER))
#define PROBE_ARRIVE(s) do { if (blockIdx.x == PROBE_WG && threadIdx.x == 0) { const unsigned long long now_ = __builtin_amdgcn_s_memrealtime(); if (!PROBE_WAIT && PROBE_PH(s) == PROBE_K) pr_acc += now_ - pr_prev; pr_prev = now_; } } while (0)
#define PROBE_EXIT(s) do { if (blockIdx.x == PROBE_WG && threadIdx.x == 0) { const unsigned long long now_ = __builtin_amdgcn_s_memrealtime(); if (PROBE_WAIT && PROBE_PH(s) == PROBE_K) pr_acc += now_ - pr_prev; pr_prev = now_; } } while (0)
#else
#define PROBE_ARRIVE(s) do { } while (0)
#define PROBE_EXIT(s) do { } while (0)
#endif
#define RUN(s) (lo <= (s) && (s) < hi)
#ifndef DUP
#define DUP 0
#endif
#define DUPN(id) ((((DUP) >> (id)) & 1) ? 2 : 1)
#define TID_HERE const int tid = otid(), lane = tid & 63, wave = __builtin_amdgcn_readfirstlane(tid >> 6); (void)lane; (void)wave
#ifdef ONLY
#define PH_ON(k) ((k) == ONLY)
#elif defined(SKIP)
#define PH_ON(k) ((k) != SKIP)
#else
#define PH_ON(k) true
#endif
#define SEAM(s) do { PROBE_ARRIVE(s); if (RUN((s) + 1)) { XcdBarrier bar_; bar_.bar = (unsigned*)(wsb() + WS_CTL) + CW_BAR; bar_.x = xb_xcc_id(); bar_.st = (volatile LAS unsigned*)(lds + MISC_OFF) + 8; xcd_barrier(bar_); if (DUPN(16) > 1) xcd_barrier(bar_); } PROBE_EXIT(s); } while (0)
#define H ((bf16*)(wsb() + WS_H))
#define Z ((bf16*)(wsb() + WS_Z))
#define ACC ((bf16*)(wsb() + WS_ACC))
#define U ((bf16*)(wsb() + WS_U))
#define YS ((bf16*)(wsb() + WS_YS))
#define XC ((float*)(wsb() + WS_XC))
#define WIN ((const bf16*)(psb(l & 1) + PS_WIN))
#define WBR ((const bf16*)(psb(l & 1) + PS_WBR))
#define WOUT ((const bf16*)(psb(l & 1) + PS_WOUT))
#define WF1 ((const bf16*)(psb(l & 1) + PS_WF1))
#define WF2 ((const bf16*)(psb(l & 1) + PS_WF2))

    if (PH_ON(100) && RUN(0)) { TID_HERE; ph_prologue(A, lds, tid); __syncthreads(); ph_convert(A, 0, 0, 0, CONV_ITEMS, (int)blockIdx.x, G, lds, wave, lane); __syncthreads(); for (int fl = 0; fl < DEPTH; ++fl) ph_filt1(A, fl, 0, (int)blockIdx.x, G, lds, tid); SEAM(0); }

    for (int l = 0; l < DEPTH; ++l) {
        const int sb = 1 + l * SEQ_PER_LAYER;
        if (hi <= sb || lo >= sb + SEQ_PER_LAYER) continue;
        const bool lastl = (l == DEPTH - 1);
        const int Mrows = lastl ? ML : MT, nctx = lastl ? 0 : 64;
#define modl ((const float*)(wsb() + WS_MOD) + (size_t)l * 5 * 12288)
#define xlat_in ((l == 0) ? inp(I_X) : (const float*)outb())
#define xctx_in ((l == 0) ? inp(I_CTX) : (const float*)XC)

        if (PH_ON(0) && RUN(sb + 0)) { TID_HERE;
            if (l == 0) ph_filt2(A, 0, 0, 0, 1024, (int)blockIdx.x, G, lds, tid);
            else ph_convert(A, l, l & 1, 0, CONV_ITEMS, (int)blockIdx.x, G, lds, wave, lane);
            ph_norm(xlat_in, xctx_in, inp(I_G1) + (size_t)l * D, modl, 0, D, H, MT, (l > 0) ? (const float*)(wsb() + WS_SLAB) : (const float*)nullptr,
                    (const float*)(wsb() + WS_MOD) + ((size_t)(l - 1) * 5 + 4) * 12288 + 5 * D, XC, wave, lane);
            SEAM(sb + 0);
        }
        if (PH_ON(1) && RUN(sb + 1)) { TID_HERE;
            if (SKEW_US > 0 && (blockIdx.x & 8)) spin_us(SKEW_US);
            { pg8::Gemm g{H, WIN, opq(MT), opq(INW), opq(D), 0}; pg8::StaticOrder S; S.init(g.M, g.N, G, (int)blockIdx.x);
              pg8::EpiStore E{Z, INW};
              for (int r_ = 0; r_ < DUPN(15); ++r_) pg8::gemm_phase<pg8::EpiStore, pg8::StaticOrder, PG8_ALIGN, PG8_SP2>(lds, g, S, E); }
            SEAM(sb + 1);
        }
        if (PH_ON(2) && RUN(sb + 2)) { TID_HERE;
            SUBT(1, ph_hyprep(A, l, lds, tid));
            SUBT(2, ph_ret1(A, l, 64, lds, tid));
            SUBT(3, ph_natt(A, l, 0, lds, tid));
            SUBT(4, if (!lastl) ph_hyctx(A, l, lds, tid));
            SEAM(sb + 2);
        }
        if (PH_ON(3) && RUN(sb + 3)) { TID_HERE;
#ifndef NO_D1
            SUBT(5, ph_hyfft(A, l, lds, tid));
#endif
#ifndef NO_D2
            SUBT(6, ph_scan(A, l, tid));
#endif
            SEAM(sb + 3);
        }
        if (PH_ON(4) && RUN(sb + 4)) { TID_HERE;
            SUBT(7, ph_hypost(A, lds, tid));
            SUBT(8, ph_ret3(A, l, nctx, lds, tid));
            if (!lastl) { __syncthreads(); ph_natt(A, l, 1, lds, tid); }
            SEAM(sb + 4);
        }
        if (PH_ON(5) && RUN(sb + 5)) { TID_HERE;
            __syncthreads();
            for (int r_ = 0; r_ < DUPN(13); ++r_)
            for (int i = 0; i < 3; ++i) {
                pg8::Gemm g{YS + (size_t)i * MT * 1024, WBR + (size_t)i * D * 1024, Mrows, opq(D), opq(1024), 0}; pg8::StaticOrder S; S.init(g.M, g.N, G, (int)blockIdx.x);
                pg8::EpiMerge E{ACC, Z + C_GT + i * D, INW, i == 0 ? 1 : 0};
                pg8::gemm_phase<pg8::EpiMerge, pg8::StaticOrder, PG8_ALIGN, PG8_SP2>(lds, g, S, E);
            }
            if (!lastl && blockIdx.x >= 32) { __syncthreads(); ph_filt2(A, l + 1, (l + 1) & 1, 0, FILT_F, (int)blockIdx.x - 32, G - 32, lds, tid); }
            SEAM(sb + 5);
        }
        if (PH_ON(6) && RUN(sb + 6)) { TID_HERE;
            __syncthreads();
            { pg8::Gemm g{ACC, WOUT, opq(ML), opq(D), opq(D), 0}; pg8::StaticOrder S; S.init(g.M, g.N, G, (int)blockIdx.x);
              pg8::EpiResid E{xlat_in, xctx_in, outb(), XC, modl, 2 * D};
              pg8::gemm_phase<pg8::EpiResid, pg8::StaticOrder, PG8_ALIGN, PG8_SP2>(lds, g, S, E); }
            if (!lastl) { pg8::Gemm g{ACC, WOUT, opq(MT), opq(D), opq(D / NSPLIT), opq(D)}; pg8::CtxSplitOrder S{NSPLIT, D / NSPLIT, (int)blockIdx.x};
              pg8::EpiSlab E{(float*)(wsb() + WS_SLAB), D / NSPLIT};
              pg8::gemm_phase<pg8::EpiSlab, pg8::CtxSplitOrder, PG8_ALIGN, PG8_SP2>(lds, g, S, E); }
            SEAM(sb + 6);
        }
        if (PH_ON(7) && RUN(sb + 7)) { TID_HERE;
            ph_norm(outb(), xctx_in, inp(I_G2) + (size_t)l * D, modl, 3 * D, 4 * D, H, Mrows, (const float*)(wsb() + WS_SLAB), modl + (size_t)4 * 12288 + 2 * D, XC, wave, lane);
            SEAM(sb + 7);
        }
        if (PH_ON(8) && RUN(sb + 8)) { TID_HERE;
            __syncthreads();
            if (SKEW_US > 0 && (blockIdx.x & 8)) spin_us(SKEW_US);
            pg8::Gemm g{H, WF1, Mrows, opq(NFF), opq(D), 0}; pg8::StaticOrder S; S.init(g.M, g.N, G, (int)blockIdx.x);
            pg8::EpiFfn E{U, (bf16*)(wsb() + WS_SA), (bf16*)(wsb() + WS_SB), inp(I_FFCW) + (size_t)l * 3 * DFF, inp(I_FFCB) + (size_t)l * DFF};
            for (int r_ = 0; r_ < DUPN(14); ++r_) pg8::gemm_phase<pg8::EpiFfn, pg8::StaticOrder, PG8_ALIGN, PG8_SP2>(lds, g, S, E);
            if (!lastl && blockIdx.x >= 176) { __syncthreads(); ph_filt2(A, l + 1, (l + 1) & 1, FILT_F, FILT_I, (int)blockIdx.x - 176, G - 176, lds, tid); }
            SEAM(sb + 8);
        }
        if (PH_ON(9) && RUN(sb + 9)) { TID_HERE;
            for (int r_ = 0; r_ < DUPN(11); ++r_) ph_ffnfix(A, l, Mrows, tid);
            SEAM(sb + 9);
        }
        if (PH_ON(10) && RUN(sb + 10)) { TID_HERE;
            __syncthreads();
            { pg8::Gemm g{U, WF2, opq(ML), opq(D), opq(DFF), 0}; pg8::StaticOrder S; S.init(g.M, g.N, G, (int)blockIdx.x);
              pg8::EpiResid E{outb(), XC, outb(), XC, modl, 5 * D};
              pg8::gemm_phase<pg8::EpiResid, pg8::StaticOrder, PG8_ALIGN, PG8_SP2>(lds, g, S, E); }
            if (!lastl) { pg8::Gemm g{U, WF2, opq(MT), opq(D), opq(DFF / NSPLIT), opq(DFF)}; pg8::CtxSplitOrder S{NSPLIT, DFF / NSPLIT, (int)blockIdx.x};
              pg8::EpiSlab E{(float*)(wsb() + WS_SLAB), DFF / NSPLIT};
              pg8::gemm_phase<pg8::EpiSlab, pg8::CtxSplitOrder, PG8_ALIGN, PG8_SP2>(lds, g, S, E); }
            if (!lastl && blockIdx.x >= 128) { __syncthreads(); ph_filt2(A, l + 1, (l + 1) & 1, FILT_I, 1024, (int)blockIdx.x - 128, G - 128, lds, tid); }
            SEAM(sb + 10);
        }
    }
    if (PH_ON(101) && RUN(NSEQ - 1)) { TID_HERE; ph_final(A, wave, lane); }
#ifdef PROBE_K
    if (blockIdx.x == PROBE_WG && threadIdx.x == 0) { const unsigned long long t0 = __builtin_amdgcn_s_memrealtime(); while (__builtin_amdgcn_s_memrealtime() - t0 < 4ull * pr_acc) __builtin_amdgcn_s_sleep(8); }
#endif
#undef RUN
#undef SEAM
#undef H
#undef Z
#undef ACC
#undef U
#undef YS
#undef XC
#undef WIN
#undef WBR
#undef WOUT
#undef WF1
#undef WF2
#undef G
#undef modl
#undef xlat_in
#undef xctx_in
}

extern "C" void kernel_launch(void* const* d_in, const int* in_sizes, int n_in, void* d_out, int out_size, void* d_ws, size_t ws_size, hipStream_t stream) {
    static int grid = 0;
    if (grid == 0) {
        if (n_in != 27 || out_size != ML * D || ws_size < WS_END) { fprintf(stderr, "kernel_launch: unexpected shapes (n_in %d out %d ws %zu need %zu)\n", n_in, out_size, ws_size, (size_t)WS_END); grid = -1; return; }
        int dev = 0, cus = 0, per_cu = 0;
        if (hipGetDevice(&dev) != hipSuccess || hipDeviceGetAttribute(&cus, hipDeviceAttributeMultiprocessorCount, dev) != hipSuccess) { grid = -1; return; }
        if (hipFuncSetAttribute((const void*)fwd, hipFuncAttributeMaxDynamicSharedMemorySize, LDS_BYTES) != hipSuccess) { fprintf(stderr, "kernel_launch: hipFuncSetAttribute failed\n"); grid = -1; return; }
        if (hipOccupancyMaxActiveBlocksPerMultiprocessor(&per_cu, (const void*)fwd, NWAVES * 64, LDS_BYTES) != hipSuccess || per_cu < 1) fprintf(stderr, "kernel_launch: occupancy query says %d\n", per_cu);
        (void)hipGetLastError();
        grid = cus;
    }
    if (grid < 0) return;
    (void)hipMemsetAsync((char*)d_ws + WS_CTL, 0, CTL_ZERO_BYTES, stream);
    Args a{};
    for (int i = 0; i < 27; ++i) a.in[i] = (const float*)d_in[i];
    a.out = (float*)d_out; a.ws = (unsigned char*)d_ws;
#if MK_SINGLE
    a.seq_lo = 0; a.seq_hi = NSEQ;
    hipLaunchKernelGGL(fwd, dim3(grid), dim3(NWAVES * 64), LDS_BYTES, stream, a);
#else
    for (int s = 0; s < NSEQ; ++s) { a.seq_lo = s; a.seq_hi = s + 1; hipLaunchKernelGGL(fwd, dim3(grid), dim3(NWAVES * 64), LDS_BYTES, stream, a); }
#endif
}
```

```cpp
#include <hip/hip_runtime.h>
#include <cstdio>
#include <cstdint>
#ifndef MK_SINGLE
#define MK_SINGLE 1
#endif
namespace pg8 {
#define PG8_LAS __attribute__((address_space(3)))
typedef unsigned short bf16_t;
typedef short bf16x8 __attribute__((ext_vector_type(8)));
typedef float f32x4 __attribute__((ext_vector_type(4)));
typedef unsigned u32x4 __attribute__((ext_vector_type(4)));
constexpr int BM = 256, BK = 64, HALF = 128, HTB = HALF * BK * 2  , STAGE_BYTES = 8 * HTB, NXCD = 8, WGM = 8;

__host__ __device__ __forceinline__ int lds_byte(int r, int c) { const int st = (r >> 4) * 2 + (c >> 5), rr = r & 15, cc = c & 31, ob = rr * 64 + cc * 2; return st * 1024 + (ob ^ (((ob >> 9) & 1) << 5)); }
__host__ __device__ __forceinline__ void stage_rc(int b, int& R, int& C) { const int st = b / 1024, sb = b % 1024, swz = sb ^ (((sb >> 9) & 1) << 5); R = (st >> 1) * 16 + swz / 64; C = (st & 1) * 32 + (swz % 64) / 2; }
__host__ __device__ __forceinline__ int perm32(int rho) { const int n = rho >> 4, i = rho & 15; return 8 * (i >> 2) + 4 * n + (i & 3); }

struct Unit { int pm, pn, ko; };
struct Gemm { const bf16_t* A; const bf16_t* Bt; int M, N, K, ld; };

struct StaticOrder {
    int nM, nN, nwg, G, c;
    __host__ __device__ void init(int M, int N, int G_, int c_) { nM = M / BM; nN = N / BM; nwg = nM * nN; G = G_; c = c_; }
    __host__ __device__ bool next(int i, Unit& u) const {
        const long L = (long)i * G + c; if (L >= nwg) return false;
        int wgid = (int)L; { const int q = nwg / NXCD, r = nwg % NXCD, xcd = wgid % NXCD, off = wgid / NXCD; wgid = (xcd < r ? xcd * (q + 1) : r * (q + 1) + (xcd - r) * q) + off; }
        const int nig = WGM * nN, gid = wgid / nig, fm = gid * WGM, gsz = (nM - fm) < WGM ? (nM - fm) : WGM;
        u.pm = fm + ((wgid % nig) % gsz); u.pn = (wgid % nig) / gsz; u.ko = 0; return true;
    }
    __device__ __forceinline__ void a_ready(const Unit&) const {}
    __device__ __forceinline__ void done(const Unit&) const {}
};
__device__ __forceinline__ unsigned cvt_pk_bf16(float lo, float hi) { unsigned r; asm volatile("v_cvt_pk_bf16_f32 %0, %1, %2" : "=v"(r) : "v"(lo), "v"(hi)); return r; }
typedef float f32x2 __attribute__((ext_vector_type(2)));
__device__ __forceinline__ float bflo(unsigned w) { return __uint_as_float(w << 16); }
__device__ __forceinline__ float bfhi(unsigned w) { return __uint_as_float(w & 0xffff0000u); }
__device__ __forceinline__ float sigm(float x) { return __builtin_amdgcn_rcpf(1.0f + __expf(-x)); }
struct EpiStore {
    static constexpr bool PERM = true, AFTER_DRAIN = false;
    bf16_t* O; int ldc;
    __device__ __forceinline__ void operator()(const f32x4 (&acc)[2][2][4][2], const Unit& u, int wr, int wc, int fr, int fq) const {
        const int row0 = u.pm * BM + wr * 64 + fr, col0 = u.pn * BM + wc * 32 + 8 * fq;
#pragma unroll
        for (int ai = 0; ai < 2; ++ai)
#pragma unroll
            for (int m = 0; m < 4; ++m) { bf16_t* rowp = O + (size_t)(row0 + ai * HALF + m * 16) * ldc + col0;
#pragma unroll
                for (int bj = 0; bj < 2; ++bj) { const f32x4 v0 = acc[ai][bj][m][0], v1 = acc[ai][bj][m][1];
                    u32x4 w; w.x = cvt_pk_bf16(v0[0], v0[1]); w.y = cvt_pk_bf16(v0[2], v0[3]); w.z = cvt_pk_bf16(v1[0], v1[1]); w.w = cvt_pk_bf16(v1[2], v1[3]);
                    *(u32x4*)(rowp + bj * HALF) = w; } }
    }
};
struct EpiMerge {
    static constexpr bool PERM = true, AFTER_DRAIN = false;
    bf16_t* O; const bf16_t* gate; int ldg; int first;
    __device__ __forceinline__ void operator()(const f32x4 (&acc)[2][2][4][2], const Unit& u, int wr, int wc, int fr, int fq) const {
        const int row0 = u.pm * BM + wr * 64 + fr, col0 = u.pn * BM + wc * 32 + 8 * fq;
#pragma unroll
        for (int ai = 0; ai < 2; ++ai)
#pragma unroll
            for (int m = 0; m < 4; ++m) { const size_t row = (size_t)(row0 + ai * HALF + m * 16);
#pragma unroll
                for (int bj = 0; bj < 2; ++bj) { const int col = col0 + bj * HALF;
                    const u32x4 gv = *(const u32x4*)(gate + row * ldg + col);
                    u32x4 pv = (u32x4){0u, 0u, 0u, 0u}; if (!first) pv = *(const u32x4*)(O + row * 2048 + col);
                    const f32x4 v0 = acc[ai][bj][m][0], v1 = acc[ai][bj][m][1];
                    u32x4 w;
                    w.x = cvt_pk_bf16(bflo(pv.x) + v0[0] * sigm(bflo(gv.x)), bfhi(pv.x) + v0[1] * sigm(bfhi(gv.x)));
                    w.y = cvt_pk_bf16(bflo(pv.y) + v0[2] * sigm(bflo(gv.y)), bfhi(pv.y) + v0[3] * sigm(bfhi(gv.y)));
                    w.z = cvt_pk_bf16(bflo(pv.z) + v1[0] * sigm(bflo(gv.z)), bfhi(pv.z) + v1[1] * sigm(bfhi(gv.z)));
                    w.w = cvt_pk_bf16(bflo(pv.w) + v1[2] * sigm(bflo(gv.w)), bfhi(pv.w) + v1[3] * sigm(bfhi(gv.w)));
                    *(u32x4*)(O + row * 2048 + col) = w; } }
    }
};
struct EpiResid {
    static constexpr bool PERM = false, AFTER_DRAIN = false;
    const float* base_lat; const float* base_ctx; float* out_lat; float* out_ctx; const float* modl; int goff;
    __device__ __forceinline__ void operator()(const f32x4 (&acc)[2][2][4][2], const Unit& u, int wr, int wc, int fr, int fq) const {
        const bool isctx = u.pm >= 64; const int r = isctx ? 4 : (u.pm >> 4);
        const float* gvp = modl + (size_t)r * 12288 + goff;
        const float* bs = isctx ? base_ctx : base_lat; float* os = isctx ? out_ctx : out_lat;
        const int row0 = (isctx ? u.pm - 64 : u.pm) * BM + wr * 64 + fr, col0 = u.pn * BM + wc * 32 + 4 * fq;
        f32x4 g4[2][2];
#pragma unroll
        for (int bj = 0; bj < 2; ++bj)
#pragma unroll
            for (int n = 0; n < 2; ++n) g4[bj][n] = *(const f32x4*)(gvp + col0 + bj * HALF + n * 16);
#pragma unroll
        for (int ai = 0; ai < 2; ++ai)
#pragma unroll
            for (int m = 0; m < 4; ++m) { const size_t off = (size_t)(row0 + ai * HALF + m * 16) * 2048 + col0;
#pragma unroll
                for (int bj = 0; bj < 2; ++bj)
#pragma unroll
                    for (int n = 0; n < 2; ++n) { const f32x4 b4 = *(const f32x4*)(bs + off + bj * HALF + n * 16);
                        *(f32x4*)(os + off + bj * HALF + n * 16) = b4 + g4[bj][n] * acc[ai][bj][m][n]; } }
    }
};

__device__ __forceinline__ float dpp_ror1(float v) { return __int_as_float(__builtin_amdgcn_update_dpp(0, __float_as_int(v), 0x121, 0xf, 0xf, false)); }
__device__ __forceinline__ float dpp_rol1(float v) { return __int_as_float(__builtin_amdgcn_update_dpp(0, __float_as_int(v), 0x12f, 0xf, 0xf, false)); }
__device__ __forceinline__ float gelu_fast(float x) { const float x2 = x * x; const float arg = x * (x2 * (-2.0f * 1.4426950408889634f * 0.7978845608028654f * 0.044715f) + (-2.0f * 1.4426950408889634f * 0.7978845608028654f));
    return x * __builtin_amdgcn_rcpf(1.0f + __builtin_amdgcn_exp2f(arg)); }
struct EpiFfn {
    static constexpr bool PERM = true, AFTER_DRAIN = false;
    bf16_t* U; bf16_t* SA; bf16_t* SB; const float* cw; const float* cb;
    __device__ __forceinline__ void operator()(const f32x4 (&acc)[2][2][4][2], const Unit& u, int wr, int wc, int fr, int fq) const {
        const int f0 = u.pn * 128 + wc * 32 + 8 * fq;
        f32x4 w0[2], w1[2], w2[2], bb[2];
#pragma unroll
        for (int n = 0; n < 2; ++n) { w0[n] = *(const f32x4*)(cw + f0 + 4 * n); w1[n] = *(const f32x4*)(cw + 5632 + f0 + 4 * n); w2[n] = *(const f32x4*)(cw + 2 * 5632 + f0 + 4 * n); bb[n] = *(const f32x4*)(cb + f0 + 4 * n); }
#pragma unroll
        for (int ai = 0; ai < 2; ++ai) {
            const int row0 = u.pm * BM + ai * HALF + wr * 64 + fr, blk = u.pm * 4 + ai * 2 + wr;
            f32x4 o[4][2];
#pragma unroll
            for (int n = 0; n < 2; ++n)
#pragma unroll
                for (int e = 0; e < 4; ++e) {
                    const float a0 = acc[ai][0][0][n][e], a1 = acc[ai][0][1][n][e], a2 = acc[ai][0][2][n][e], a3 = acc[ai][0][3][n][e];
                    const float r0 = dpp_ror1(a0), r1 = dpp_ror1(a1), r2 = dpp_ror1(a2), r3 = dpp_ror1(a3);
                    const float l0 = dpp_rol1(a0), l1 = dpp_rol1(a1), l2 = dpp_rol1(a2), l3 = dpp_rol1(a3);
                    const bool first = (fr == 0), last = (fr == 15);
                    const float p0 = r0, p1 = first ? r0 : r1, p2 = first ? r1 : r2, p3 = first ? r2 : r3;
                    const float n0 = last ? l1 : l0, n1 = last ? l2 : l1, n2 = last ? l3 : l2, n3 = l3;
                    const float k0 = w0[n][e], k1 = w1[n][e], k2 = w2[n][e], kb = bb[n][e];
                    o[0][n][e] = gelu_fast(k0 * p0 + k1 * a0 + k2 * n0 + kb) * acc[ai][1][0][n][e];
                    o[1][n][e] = gelu_fast(k0 * p1 + k1 * a1 + k2 * n1 + kb) * acc[ai][1][1][n][e];
                    o[2][n][e] = gelu_fast(k0 * p2 + k1 * a2 + k2 * n2 + kb) * acc[ai][1][2][n][e];
                    o[3][n][e] = gelu_fast(k0 * p3 + k1 * a3 + k2 * n3 + kb) * acc[ai][1][3][n][e];
                }
#pragma unroll
            for (int m = 0; m < 4; ++m) { u32x4 w; w.x = cvt_pk_bf16(o[m][0][0], o[m][0][1]); w.y = cvt_pk_bf16(o[m][0][2], o[m][0][3]); w.z = cvt_pk_bf16(o[m][1][0], o[m][1][1]); w.w = cvt_pk_bf16(o[m][1][2], o[m][1][3]);
                *(u32x4*)(U + (size_t)(row0 + m * 16) * 5632 + f0) = w; }
            const int sel = (fr == 0) ? 0 : (fr == 1) ? 1 : (fr == 14) ? 2 : (fr == 15) ? 3 : -1;
            if (sel >= 0) { const int m = (sel < 2) ? 0 : 3;
                const f32x4 a0 = (m == 0) ? acc[ai][0][0][0] : acc[ai][0][3][0], a1 = (m == 0) ? acc[ai][0][0][1] : acc[ai][0][3][1];
                u32x4 w; w.x = cvt_pk_bf16(a0[0], a0[1]); w.y = cvt_pk_bf16(a0[2], a0[3]); w.z = cvt_pk_bf16(a1[0], a1[1]); w.w = cvt_pk_bf16(a1[2], a1[3]);
                *(u32x4*)(SA + ((size_t)blk * 4 + sel) * 5632 + f0) = w;
                if (sel == 0 || sel == 3) { const f32x4 b0 = (m == 0) ? acc[ai][1][0][0] : acc[ai][1][3][0], b1 = (m == 0) ? acc[ai][1][0][1] : acc[ai][1][3][1];
                    u32x4 v; v.x = cvt_pk_bf16(b0[0], b0[1]); v.y = cvt_pk_bf16(b0[2], b0[3]); v.z = cvt_pk_bf16(b1[0], b1[1]); v.w = cvt_pk_bf16(b1[2], b1[3]);
                    *(u32x4*)(SB + ((size_t)blk * 2 + (sel == 0 ? 0 : 1)) * 5632 + f0) = v; } }
        }
    }
};

struct CtxSplitOrder {
    int nsplit, klen, c;
    __device__ __forceinline__ bool next(int i, Unit& u) const { if (i > 0 || c >= 32 * nsplit) return false; const int tile = c / nsplit, s = c - tile * nsplit; u.pm = 64 + (tile >> 3); u.pn = tile & 7; u.ko = s * klen; return true; }
    __device__ __forceinline__ void a_ready(const Unit&) const {}
    __device__ __forceinline__ void done(const Unit&) const {}
};
struct EpiSlab {
    static constexpr bool PERM = false, AFTER_DRAIN = false;
    float* slab; int klen;
    __device__ __forceinline__ void operator()(const f32x4 (&acc)[2][2][4][2], const Unit& u, int wr, int wc, int fr, int fq) const {
        float* os = slab + (size_t)(u.ko / klen) * 1024 * 2048;
        const int row0 = (u.pm - 64) * BM + wr * 64 + fr, col0 = u.pn * BM + wc * 32 + 4 * fq;
#pragma unroll
        for (int ai = 0; ai < 2; ++ai)
#pragma unroll
            for (int m = 0; m < 4; ++m) { const size_t off = (size_t)(row0 + ai * HALF + m * 16) * 2048 + col0;
#pragma unroll
                for (int bj = 0; bj < 2; ++bj)
#pragma unroll
                    for (int n = 0; n < 2; ++n) *(f32x4*)(os + off + bj * HALF + n * 16) = acc[ai][bj][m][n]; }
    }
};
template <class Epi, class Sched, bool ALIGN_EPI = false, bool SP2 = false>
__device__ __forceinline__ void gemm_phase(PG8_LAS unsigned char* lds, const Gemm g, const Sched& S, const Epi& E) {
    int tid_ = threadIdx.x; asm volatile("" : "+v"(tid_)); const int tid = tid_, wid = __builtin_amdgcn_readfirstlane(tid >> 6), lane = tid & 63, wr = wid >> 2, wc = wid & 3, fr = lane & 15, fq = lane >> 4;
    const int K = g.K, nt = K / BK, LD = g.ld ? g.ld : g.K;
    unsigned voffA[2], voffB[2];
#pragma unroll
    for (int i = 0; i < 2; ++i) { int R, C; stage_rc(tid * 16 + i * 8192, R, C); const int Rb = Epi::PERM ? ((R & ~31) + perm32(R & 31)) : R;
        voffA[i] = (unsigned)(R * LD + C) * 2u; voffB[i] = (unsigned)(Rb * LD + C) * 2u; }
    const size_t kstep = (size_t)(BK * 2);
    const size_t hstep = (size_t)HALF * LD * 2;
    const size_t tstep = 2 * hstep;
    const unsigned ldsw = (unsigned)wid * 1024u;
    const int aoff = lds_byte(wr * 64 + fr, fq * 8), boff = lds_byte(wc * 32 + fr, fq * 8);
#define PG8_SA(b, h) (((b) * 2 + (h)) * HTB)
#define PG8_SB(b, h) ((4 + (b) * 2 + (h)) * HTB)
#define PG8_STAGE(bufoff, gbase, voff) do { _Pragma("unroll") for (int _i = 0; _i < 2; ++_i) \
        __builtin_amdgcn_global_load_lds((const unsigned*)((const char*)(gbase) + (voff)[_i]), (PG8_LAS unsigned*)(lds + (bufoff) + ldsw + _i * 8192), 16, 0, 0); } while (0)
#define PG8_LDA(dst, b, h) do { _Pragma("unroll") for (int m = 0; m < 4; ++m) _Pragma("unroll") for (int k = 0; k < 2; ++k) dst[m][k] = *(const PG8_LAS bf16x8*)(lds + PG8_SA(b, h) + aoff + m * 2048 + k * 1024); } while (0)
#define PG8_LDB(dst, b, h) do { _Pragma("unroll") for (int n = 0; n < 2; ++n) _Pragma("unroll") for (int k = 0; k < 2; ++k) dst[n][k] = *(const PG8_LAS bf16x8*)(lds + PG8_SB(b, h) + boff + n * 2048 + k * 1024); } while (0)
#define PG8_MMA(ai, bj, At, Bt) do { __builtin_amdgcn_s_setprio(1); _Pragma("unroll") for (int m = 0; m < 4; ++m) _Pragma("unroll") for (int n = 0; n < 2; ++n) _Pragma("unroll") for (int k = 0; k < 2; ++k) \
        acc[ai][bj][m][n] = __builtin_amdgcn_mfma_f32_16x16x32_bf16(Bt[n][k], At[m][k], acc[ai][bj][m][n], 0, 0, 0); __builtin_amdgcn_s_setprio(0); } while (0)
#define PG8_WAIT_V(n) asm volatile("s_waitcnt vmcnt(" #n ")" ::: "memory")
#define PG8_WAIT_L(n) asm volatile("s_waitcnt lgkmcnt(" #n ")" ::: "memory")
#define PG8_BAR __builtin_amdgcn_s_barrier()
#define PG8_SCHED __builtin_amdgcn_sched_barrier(0)
    Unit cur, nxt; int ui = 0;
    if (!S.next(0, cur)) return;
    f32x4 acc[2][2][4][2];
#pragma unroll
    for (int a = 0; a < 2; ++a)
#pragma unroll
        for (int b = 0; b < 2; ++b)
#pragma unroll
            for (int m = 0; m < 4; ++m)
#pragma unroll
                for (int n = 0; n < 2; ++n) acc[a][b][m][n] = (f32x4){0.f, 0.f, 0.f, 0.f};
    bf16x8 At[4][2], B0[2][2], B1[2][2];
    const char* cA = (const char*)g.A + (size_t)cur.pm * tstep + (size_t)cur.ko * 2; const char* cB = (const char*)g.Bt + (size_t)cur.pn * tstep + (size_t)cur.ko * 2;
    S.a_ready(cur);
    if constexpr (SP2) {
        PG8_STAGE(PG8_SB(0, 0), cB, voffB); PG8_STAGE(PG8_SB(0, 1), cB + hstep, voffB); PG8_STAGE(PG8_SA(0, 0), cA, voffA); PG8_STAGE(PG8_SA(0, 1), cA + hstep, voffA);
        if (wr == 1) PG8_BAR;
        PG8_WAIT_V(2); PG8_BAR;
        PG8_STAGE(PG8_SB(1, 0), cB + kstep, voffB); PG8_STAGE(PG8_SA(1, 0), cA + kstep, voffA); PG8_STAGE(PG8_SB(1, 1), cB + hstep + kstep, voffB);
        PG8_WAIT_V(6); PG8_BAR;
    } else {
        PG8_STAGE(PG8_SB(0, 0), cB, voffB); PG8_STAGE(PG8_SA(0, 0), cA, voffA); PG8_STAGE(PG8_SB(0, 1), cB + hstep, voffB); PG8_STAGE(PG8_SA(0, 1), cA + hstep, voffA);
        if (wr == 1) PG8_BAR;
        PG8_WAIT_V(4); PG8_BAR;
        PG8_STAGE(PG8_SB(1, 0), cB + kstep, voffB); PG8_STAGE(PG8_SA(1, 0), cA + kstep, voffA); PG8_STAGE(PG8_SB(1, 1), cB + hstep + kstep, voffB);
        PG8_WAIT_V(6); PG8_BAR;
    }
    for (;;) {
        const bool has_next = S.next(ui + 1, nxt);
        const char* nA = has_next ? (const char*)g.A + (size_t)nxt.pm * tstep + (size_t)nxt.ko * 2 : cA; const char* nB = has_next ? (const char*)g.Bt + (size_t)nxt.pn * tstep + (size_t)nxt.ko * 2 : cB;
        for (int t = 0; t < nt; t += 2) {
            const bool last = (t == nt - 2);
            const char* a1 = cA + (size_t)(t + 1) * kstep;
            const char* a2 = last ? nA : cA + (size_t)(t + 2) * kstep; const char* b2 = last ? nB : cB + (size_t)(t + 2) * kstep;
            const char* a3 = a2 + kstep; const char* b3 = b2 + kstep;
            if (last && has_next) S.a_ready(nxt);
            if constexpr (SP2) {
            PG8_LDB(B0, 0, 0); PG8_LDB(B1, 0, 1); PG8_SCHED; PG8_LDA(At, 0, 0); PG8_STAGE(PG8_SA(1, 1), a1 + hstep, voffA);
            PG8_WAIT_V(8); PG8_WAIT_L(0); PG8_BAR; PG8_MMA(0, 0, At, B0); PG8_MMA(0, 1, At, B1); PG8_BAR; PG8_SCHED;
            PG8_LDA(At, 0, 1); PG8_STAGE(PG8_SB(0, 0), b2, voffB); PG8_STAGE(PG8_SB(0, 1), b2 + hstep, voffB); PG8_STAGE(PG8_SA(0, 0), a2, voffA);
            PG8_WAIT_V(8); PG8_WAIT_L(0); PG8_BAR; PG8_MMA(1, 0, At, B0); PG8_MMA(1, 1, At, B1); PG8_BAR; PG8_SCHED;
            PG8_LDB(B0, 1, 0); PG8_LDB(B1, 1, 1); PG8_SCHED; PG8_LDA(At, 1, 0); PG8_STAGE(PG8_SA(0, 1), a2 + hstep, voffA);
            PG8_WAIT_V(8); PG8_WAIT_L(0); PG8_BAR; PG8_MMA(0, 0, At, B0); PG8_MMA(0, 1, At, B1); PG8_BAR; PG8_SCHED;
            PG8_LDA(At, 1, 1); PG8_STAGE(PG8_SB(1, 0), b3, voffB); PG8_STAGE(PG8_SB(1, 1), b3 + hstep, voffB); PG8_STAGE(PG8_SA(1, 0), a3, voffA);
            PG8_WAIT_V(8); PG8_WAIT_L(0); PG8_BAR; PG8_MMA(1, 0, At, B0); PG8_MMA(1, 1, At, B1); PG8_BAR; PG8_SCHED;
            } else {
            PG8_LDB(B0, 0, 0); PG8_SCHED; PG8_LDA(At, 0, 0); PG8_STAGE(PG8_SA(1, 1), a1 + hstep, voffA);
            PG8_WAIT_L(8); PG8_BAR; PG8_WAIT_L(0); PG8_MMA(0, 0, At, B0); PG8_BAR; PG8_SCHED;
            PG8_LDB(B1, 0, 1); PG8_STAGE(PG8_SB(0, 0), b2, voffB);
            PG8_BAR; PG8_WAIT_L(0); PG8_MMA(0, 1, At, B1); PG8_BAR;
            PG8_LDA(At, 0, 1); PG8_STAGE(PG8_SA(0, 0), a2, voffA);
            PG8_BAR; PG8_WAIT_L(0); PG8_MMA(1, 0, At, B0); PG8_BAR; PG8_SCHED;
            PG8_STAGE(PG8_SB(0, 1), b2 + hstep, voffB);
            PG8_WAIT_V(6); PG8_BAR; PG8_MMA(1, 1, At, B1); PG8_BAR;
            PG8_LDB(B0, 1, 0); PG8_SCHED; PG8_LDA(At, 1, 0); PG8_STAGE(PG8_SA(0, 1), a2 + hstep, voffA);
            PG8_WAIT_L(8); PG8_BAR; PG8_WAIT_L(0); PG8_MMA(0, 0, At, B0); PG8_BAR; PG8_SCHED;
            PG8_LDB(B1, 1, 1); PG8_STAGE(PG8_SB(1, 0), b3, voffB);
            PG8_BAR; PG8_WAIT_L(0); PG8_MMA(0, 1, At, B1); PG8_BAR;
            PG8_LDA(At, 1, 1); PG8_STAGE(PG8_SA(1, 0), a3, voffA);
            PG8_BAR; PG8_WAIT_L(0); PG8_MMA(1, 0, At, B0); PG8_BAR; PG8_SCHED;
            PG8_STAGE(PG8_SB(1, 1), b3 + hstep, voffB);
            PG8_WAIT_V(6); PG8_BAR; PG8_MMA(1, 1, At, B1); PG8_BAR;
            }
        }
        if constexpr (ALIGN_EPI) { if (wr == 0) PG8_BAR; }
        if constexpr (!Epi::AFTER_DRAIN) { E(acc, cur, wr, wc, fr, fq); S.done(cur); }
        if (!has_next) break;
#pragma unroll
        for (int a = 0; a < 2; ++a)
#pragma unroll
            for (int b = 0; b < 2; ++b)
#pragma unroll
                for (int m = 0; m < 4; ++m)
#pragma unroll
                    for (int n = 0; n < 2; ++n) acc[a][b][m][n] = (f32x4){0.f, 0.f, 0.f, 0.f};
        cur = nxt; cA = nA; cB = nB; ++ui;
        if constexpr (ALIGN_EPI) { if (wr == 1) PG8_BAR; }
    }
    PG8_WAIT_V(0);
    if constexpr (!ALIGN_EPI) { if (wr == 0) PG8_BAR; }
    PG8_BAR;
    if constexpr (Epi::AFTER_DRAIN) { E.fused(acc, cur, wr, wc, fr, fq, lds, wid, lane); S.done(cur); }
#undef PG8_SA
#undef PG8_SB
#undef PG8_STAGE
#undef PG8_LDA
#undef PG8_LDB
#undef PG8_MMA
#undef PG8_WAIT_V
#undef PG8_WAIT_L
#undef PG8_BAR
#undef PG8_SCHED
}
}
#ifndef PG8_SP2
#define PG8_SP2 true
#endif
#ifndef PG8_ALIGN
#define PG8_ALIGN true
#endif
constexpr int D = 2048, NB = 4, SEQ = 4096, CL = 256, DEPTH = 4;
constexpr int ML = NB * SEQ, MC = NB * CL, MT = ML + MC;
constexpr int INW = 15360, DFF = 5632, NFF = 2 * DFF;
constexpr int C_RK = 0, C_RV = 512, C_NK = 1536, C_NV = 2560, C_RQ = 3584, C_RG = 4096, C_NQ = 5120, C_HY = 6144, C_GT = 9216;
constexpr float EPS = 1e-6f;
constexpr int NWAVES = 8;
constexpr size_t al256(size_t x) { return (x + 255) & ~(size_t)255; }
constexpr size_t WS_CTL = 0, CTL_ZERO_BYTES = 1u << 20;
constexpr size_t WS_MOD = WS_CTL + CTL_ZERO_BYTES;
constexpr size_t WS_ROPE = WS_MOD + al256((size_t)4 * 5 * 12288 * 4);
constexpr size_t PS_FH2 = 0;
constexpr size_t PS_FH2B = PS_FH2 + al256((size_t)4352 * 64 * 4);
constexpr size_t PS_TAPC = PS_FH2B + al256((size_t)4352 * 64 * 2);
constexpr size_t PS_KF = PS_TAPC + al256((size_t)2 * 2 * 1024 * 256 * 4);
constexpr size_t PS_WIN = PS_KF + al256((size_t)2 * 1024 * 8192 * 8);
constexpr size_t PS_WBR = PS_WIN + al256((size_t)INW * D * 2);
constexpr size_t PS_WOUT = PS_WBR + al256((size_t)3 * D * 1024 * 2);
constexpr size_t PS_WF1 = PS_WOUT + al256((size_t)D * D * 2);
constexpr size_t PS_WF2 = PS_WF1 + al256((size_t)NFF * D * 2);
constexpr size_t PS_BYTES = PS_WF2 + al256((size_t)D * DFF * 2);
constexpr size_t WS_PSET = WS_ROPE + al256(64 * 16 * 8);
constexpr size_t WS_XC = WS_PSET + 2 * PS_BYTES;
constexpr size_t WS_H = WS_XC + al256((size_t)MC * D * 4);
constexpr size_t WS_Z = WS_H + al256((size_t)MT * D * 2);
constexpr size_t WS_HYT = WS_Z + al256((size_t)MT * INW * 2);
constexpr size_t WS_YT = WS_HYT + al256((size_t)3 * NB * 1024 * SEQ * 2);
constexpr size_t WS_YS = WS_YT + al256((size_t)NB * 1024 * SEQ * 2);
constexpr size_t WS_ACC = WS_YS + al256((size_t)3 * MT * 1024 * 2);
constexpr size_t WS_U = WS_ACC + al256((size_t)MT * D * 2);
constexpr size_t WS_KV = WS_U + al256((size_t)MT * DFF * 2);
constexpr size_t WS_SA = WS_KV + al256((size_t)NB * 8 * 2 * 34 * 8192 * 4);
constexpr size_t WS_SB = WS_SA + al256((size_t)272 * 4 * DFF * 2);
constexpr size_t WS_SLAB = WS_SB + al256((size_t)272 * 2 * DFF * 2);
constexpr size_t WS_FB4 = WS_SLAB + al256((size_t)4 * MC * D * 4);
constexpr size_t WS_END = WS_FB4 + al256((size_t)4 * 4352 * 64 * 2);
constexpr int NSPLIT = 4;
constexpr int CW_BAR = 4096;
constexpr int RING_BYTES = 131072, LDSCTL_OFF = RING_BYTES, MISC_OFF = LDSCTL_OFF + 320, LDS_BYTES = 147456;

#define GAS __attribute__((address_space(1)))
#define LAS __attribute__((address_space(3)))
typedef unsigned short bf16;
typedef unsigned v4u __attribute__((ext_vector_type(4)));
typedef unsigned v2u __attribute__((ext_vector_type(2)));
typedef float f32x4 __attribute__((ext_vector_type(4)));
typedef float f32x2 __attribute__((ext_vector_type(2)));
typedef short bf16x8 __attribute__((ext_vector_type(8)));
typedef GAS unsigned gu32;
#define LDS_WAIT() asm volatile("s_waitcnt lgkmcnt(0)" ::: "memory")
__device__ __forceinline__ unsigned f2bf(float f) { unsigned u = __builtin_bit_cast(unsigned, f); return (u + 0x7fffu + ((u >> 16) & 1u)) >> 16; }
__device__ __forceinline__ unsigned pk2(float lo, float hi) { return f2bf(lo) | (f2bf(hi) << 16); }
__device__ __forceinline__ float bflo(unsigned w) { return __uint_as_float(w << 16); }
__device__ __forceinline__ float bfhi(unsigned w) { return __uint_as_float(w & 0xffff0000u); }
__device__ __forceinline__ float bf1(bf16 b) { return __uint_as_float(((unsigned)b) << 16); }
__device__ __forceinline__ bf16x8 mk8(unsigned a, unsigned b, unsigned c, unsigned d) { v4u v = (v4u){a, b, c, d}; return __builtin_bit_cast(bf16x8, v); }
__device__ __forceinline__ f32x4 mfma16(bf16x8 a, bf16x8 b, f32x4 c) { return __builtin_amdgcn_mfma_f32_16x16x32_bf16(a, b, c, 0, 0, 0); }
__device__ __forceinline__ float sin_rev(float r) { return __builtin_amdgcn_sinf(r - floorf(r)); }
__device__ __forceinline__ float cos_rev(float r) { return __builtin_amdgcn_cosf(r - floorf(r)); }
__device__ __forceinline__ float sin_rad(float x) { return sin_rev(x * 0.15915494309189535f); }
__device__ __forceinline__ float ex2(float x) { return __builtin_amdgcn_exp2f(x); }
__device__ __forceinline__ float wave_sum(float v) {
#pragma unroll
    for (int o = 1; o < 64; o <<= 1) v += __shfl_xor(v, o);
    return v;
}
__device__ __forceinline__ int otid() { int t = threadIdx.x; asm volatile("" : "+v"(t)); return t; }
__device__ __forceinline__ int opq(int v) { asm volatile("" : "+s"(v)); return v; }
#define XB_TMO      128
#define XB_XCNT(j)  (256  + 64 * (j))
#define XB_XSUB(j)  (1280 + 64 * (j))
#define XB_XGEN(j)  (2304 + 64 * (j))
#define XB_TOP      3328
#define XB_TOPGEN   3392
#define XCD_BAR_WORDS 3456
#define XB_SPIN_CAP (1u << 18)

__device__ __forceinline__ unsigned xb_ld(unsigned* p)              { return __hip_atomic_load(p, __ATOMIC_RELAXED, __HIP_MEMORY_SCOPE_AGENT); }
__device__ __forceinline__ unsigned xb_add(unsigned* p, unsigned v) { return __hip_atomic_fetch_add(p, v, __ATOMIC_RELAXED, __HIP_MEMORY_SCOPE_AGENT); }
__device__ __forceinline__ unsigned xb_xcc_id() { return (unsigned)__builtin_amdgcn_s_getreg((3 << 11) | 20) & 0xFu; }
#define XB_SPIN(cond, bar) do { unsigned _sp = 0; while (cond) { __builtin_amdgcn_s_sleep(1); \
    if ((++_sp & 255u) == 0u) { if (xb_ld(&(bar)[XB_TMO])) break; if (_sp > XB_SPIN_CAP) { atomicAdd(&(bar)[XB_TMO], 1u); break; } } } } while (0)

struct XcdBarrier {
    unsigned* bar; unsigned x;
    volatile LAS unsigned* st;
};

__device__ __forceinline__ XcdBarrier xcd_barrier_post(unsigned* bar, volatile LAS unsigned* st) {
    XcdBarrier b; b.bar = bar; b.x = xb_xcc_id(); b.st = st;
    if (threadIdx.x == 0) (void)xb_add(&bar[XB_XCNT(b.x)], 1u);
    return b;
}
__device__ __forceinline__ void xcd_barrier_complete(unsigned* bar, unsigned x, unsigned& nloc, unsigned& nx) {
    const unsigned G = gridDim.x * gridDim.y * gridDim.z;
    unsigned sum, cnt, mine, sp = 0u;
    for (;;) {
        sum = 0u; cnt = 0u; mine = 0u;
#pragma unroll
        for (unsigned j = 0; j < 16; ++j) { const unsigned c = xb_ld(&bar[XB_XCNT(j)]); sum += c; cnt += (c > 0u) ? 1u : 0u; mine = (j == x) ? c : mine; }
        if (sum == G) break;
        __builtin_amdgcn_s_sleep(1);
        if ((++sp & 255u) == 0u) { if (xb_ld(&bar[XB_TMO])) break; if (sp > XB_SPIN_CAP) { atomicAdd(&bar[XB_TMO], 1u); break; } }
    }
    nloc = mine > 0u ? mine : 1u; nx = cnt > 0u ? cnt : 1u;
}

__device__ __forceinline__ void xcd_barrier(const XcdBarrier& b) {
    asm volatile("s_waitcnt vmcnt(0)" ::: "memory");
    __syncthreads();
    if (threadIdx.x == 0) {
        unsigned* bar = b.bar;
        __builtin_amdgcn_s_waitcnt(0);
        unsigned nloc = b.st[0], nx = b.st[1];
        if (nloc == 0u) { xcd_barrier_complete(bar, b.x, nloc, nx); b.st[0] = nloc; b.st[1] = nx; }
        const unsigned old = xb_add(&bar[XB_XSUB(b.x)], 1u);
        const unsigned gen = old / nloc;
        if (old + 1u == (gen + 1u) * nloc) {
            __builtin_amdgcn_fence(__ATOMIC_RELEASE, "agent");
            asm volatile("s_waitcnt vmcnt(0)" ::: "memory");
            const unsigned og = xb_add(&bar[XB_TOP], 1u);
            const unsigned tg = og / nx;
            if (og + 1u == (tg + 1u) * nx) xb_add(&bar[XB_TOPGEN], 1u);
            else XB_SPIN(xb_ld(&bar[XB_TOPGEN]) == tg, bar);
            __builtin_amdgcn_fence(__ATOMIC_ACQUIRE, "agent");
            xb_add(&bar[XB_XGEN(b.x)], 1u);
            asm volatile("s_waitcnt vmcnt(0)" ::: "memory");
        } else {
            XB_SPIN(xb_ld(&bar[XB_XGEN(b.x)]) == gen, bar);
            __builtin_amdgcn_fence(__ATOMIC_ACQUIRE, "agent");
            asm volatile("s_waitcnt vmcnt(0)" ::: "memory");
        }
    }
    __syncthreads();
}
__device__ __forceinline__ void p0_transpose_item(const float* W, int K, int N, bf16* WT, int row_off, LAS float* scr, int item, int lane) {
    const int nblk = N / 32, kb = item / nblk, nb = item % nblk, k0 = 64 * kb, n0 = 32 * nb;
#pragma unroll 16
    for (int i = 0; i < 32; ++i) { const int kk = 2 * i + (lane >> 5); scr[kk * 33 + (lane & 31)] = __builtin_nontemporal_load(W + (size_t)(k0 + kk) * N + n0 + (lane & 31)); }
    LDS_WAIT(); asm volatile("" ::: "memory");
    const int c = lane & 7;
#pragma unroll
    for (int j = 0; j < 4; ++j) { const int n = (lane >> 3) + 8 * j; const LAS float* s = scr + (8 * c) * 33 + n;
        v4u o; o.x = pk2(s[0 * 33], s[1 * 33]); o.y = pk2(s[2 * 33], s[3 * 33]); o.z = pk2(s[4 * 33], s[5 * 33]); o.w = pk2(s[6 * 33], s[7 * 33]);
        __builtin_nontemporal_store(o, (GAS v4u*)(WT + (size_t)(row_off + n0 + n) * K + k0 + 8 * c)); }
    LDS_WAIT(); asm volatile("" ::: "memory");
}
struct Args { const float* in[27]; float* out; unsigned char* ws; int seq_lo, seq_hi; };
__device__ __forceinline__ const float* inp(int i) { const char* ka = (const char*)__builtin_amdgcn_kernarg_segment_ptr(); int off = i * 8; asm volatile("" : "+s"(off)); return *(const float* const*)(ka + off); }
__device__ __forceinline__ unsigned char* wsb() { const char* ka = (const char*)__builtin_amdgcn_kernarg_segment_ptr(); int off = 27 * 8 + 8; asm volatile("" : "+s"(off)); return *(unsigned char* const*)(ka + off); }
__device__ __forceinline__ float* outb() { const char* ka = (const char*)__builtin_amdgcn_kernarg_segment_ptr(); int off = 27 * 8; asm volatile("" : "+s"(off)); return *(float* const*)(ka + off); }
__device__ __forceinline__ unsigned char* psb(int set) { return wsb() + WS_PSET + (size_t)set * PS_BYTES; }
enum { I_X = 0, I_C, I_CTX, I_CCTX, I_WMOD, I_BMOD, I_G1, I_G2, I_WIN, I_HCW, I_HCB, I_FW1, I_FB1, I_FW2, I_FB2, I_FW3, I_FFQ, I_HBIAS, I_RDEC, I_RPB, I_WBR, I_WOUT, I_FFW1, I_FFCW, I_FFCB, I_FFW2, I_GF };

__device__ __forceinline__ void ph_prologue(const Args& A, LAS unsigned char* lds, int tid) {
    LAS float* sc = (LAS float*)lds;
    LAS float* red = sc + 5 * 2048;
    const float* c = inp(I_C); const float* cc = inp(I_CCTX);
    for (int i = tid; i < 5 * 2048; i += 512) { const int r = i >> 11, k = i & 2047; const float v = (r < 4) ? c[r * 2048 + k] : cc[k]; sc[i] = v / (1.0f + __expf(-v)); }
    __syncthreads();
    float* mod = (float*)(wsb() + WS_MOD);
    const int kq = tid >> 6, col = tid & 63;
    for (int u = blockIdx.x; u < DEPTH * 192; u += gridDim.x) {
        const int l = u / 192, n0 = (u % 192) * 64;
        const float* W = inp(I_WMOD) + (size_t)l * 2048 * 12288 + n0 + col;
        float a0 = 0.f, a1 = 0.f, a2 = 0.f, a3 = 0.f, a4 = 0.f;
#pragma unroll 16
        for (int k = kq * 256; k < kq * 256 + 256; ++k) { const float w = W[(size_t)k * 12288];
            a0 += sc[k] * w; a1 += sc[2048 + k] * w; a2 += sc[4096 + k] * w; a3 += sc[6144 + k] * w; a4 += sc[8192 + k] * w; }
        red[(kq * 5 + 0) * 64 + col] = a0; red[(kq * 5 + 1) * 64 + col] = a1; red[(kq * 5 + 2) * 64 + col] = a2; red[(kq * 5 + 3) * 64 + col] = a3; red[(kq * 5 + 4) * 64 + col] = a4;
        __syncthreads();
        if (tid < 320) { const int r = tid >> 6; float s = inp(I_BMOD)[l * 12288 + n0 + col];
#pragma unroll
            for (int q = 0; q < 8; ++q) s += red[(q * 5 + r) * 64 + col];
            mod[((size_t)l * 5 + r) * 12288 + n0 + col] = s; }
        __syncthreads();
    }
    if (blockIdx.x == 0) { f32x2* rope = (f32x2*)(wsb() + WS_ROPE);
        for (int i = tid; i < 1024; i += 512) { const int pos = i >> 4, j = i & 15; const float inv = exp2f(-(float)j * (13.287712379549449f / 16.0f));
            const float rev = (float)pos * inv * 0.15915494309189535f; rope[i] = (f32x2){cos_rev(rev), sin_rev(rev)}; } }
}

__device__ __forceinline__ void ph_convert(const Args& A, int l, int set, int it_lo, int it_hi, int wk, int nwk, LAS unsigned char* lds, int wave, int lane) {
    LAS float* scr = (LAS float*)(lds + wave * 16384);
    const int gw = wk * NWAVES + wave, NGW = nwk * NWAVES;
    constexpr int I_IN = (D / 64) * (INW / 32), I_BR = (1024 / 64) * (D / 32), I_OUT = (D / 64) * (D / 32), I_F1 = (D / 64) * (NFF / 32);
    const float* win = inp(I_WIN) + (size_t)l * D * INW; const float* wbr = inp(I_WBR) + (size_t)l * 3 * 1024 * D; const float* wout = inp(I_WOUT) + (size_t)l * D * D;
    const float* wf1 = inp(I_FFW1) + (size_t)l * D * NFF; const float* wf2 = inp(I_FFW2) + (size_t)l * DFF * D;
    unsigned char* ps = psb(set);
    bf16* WIN = (bf16*)(ps + PS_WIN); bf16* WBR = (bf16*)(ps + PS_WBR); bf16* WOUT = (bf16*)(ps + PS_WOUT); bf16* WF1 = (bf16*)(ps + PS_WF1); bf16* WF2 = (bf16*)(ps + PS_WF2);
    for (int it = it_lo + gw; it < it_hi; it += NGW) {
        int r = it;
        if (r < I_IN) { p0_transpose_item(win, D, INW, WIN, 0, scr, r, lane); continue; } r -= I_IN;
        if (r < I_BR) { p0_transpose_item(wbr, 1024, D, WBR, 0, scr, r, lane); continue; } r -= I_BR;
        if (r < I_BR) { p0_transpose_item(wbr + (size_t)1024 * D, 1024, D, WBR + (size_t)D * 1024, 0, scr, r, lane); continue; } r -= I_BR;
        if (r < I_BR) { p0_transpose_item(wbr + (size_t)2 * 1024 * D, 1024, D, WBR + (size_t)2 * D * 1024, 0, scr, r, lane); continue; } r -= I_BR;
        if (r < I_OUT) { p0_transpose_item(wout, D, D, WOUT, 0, scr, r, lane); continue; } r -= I_OUT;
        if (r < I_F1) { const int n0 = (r % (NFF / 32)) * 32, f0 = (n0 < DFF) ? n0 : n0 - DFF, nrow = 256 * (f0 >> 7) + ((n0 < DFF) ? 0 : 128) + (f0 & 127);
            p0_transpose_item(wf1, D, NFF, WF1, nrow - n0, scr, r, lane); continue; } r -= I_F1;
        p0_transpose_item(wf2, DFF, D, WF2, 0, scr, r, lane);
    }
}
constexpr int CONV_ITEMS = (D / 64) * (INW / 32) + 3 * (1024 / 64) * (D / 32) + (D / 64) * (D / 32) + (D / 64) * (NFF / 32) + (DFF / 64) * (D / 32);
__device__ __forceinline__ void ph_filt1(const Args& A, int l, int set, int wk, int nwk, LAS unsigned char* lds, int tid) {
    LAS float* feat = (LAS float*)lds;
    LAS float* h1 = feat + 8 * 33;
    LAS float* w1s = h1 + 8 * 64;
    LAS float* w2s = w1s + 33 * 64;
    const float* w1 = inp(I_FW1) + (size_t)l * 33 * 64; const float* b1 = inp(I_FB1) + l * 64; const float* w2 = inp(I_FW2) + (size_t)l * 64 * 64; const float* b2 = inp(I_FB2) + l * 64;
    const float* fq = inp(I_FFQ) + l * 64; bf16* FH2B = (bf16*)(wsb() + WS_FB4) + (size_t)l * 4352 * 64;
    const int pl = tid >> 6, o = tid & 63;
    __syncthreads();
    for (int i = tid; i < 33 * 64; i += 512) w1s[i] = w1[i];
    for (int i = tid; i < 64 * 64; i += 512) w2s[i] = w2[i];
    const float b1o = b1[o], b2o = b2[o], fqo = fq[o];
    __syncthreads();
    for (int u = wk; u < 544; u += nwk) {
        const int pos = u * 8 + pl; const bool isc = pos >= 4096; const int Lf = isc ? 256 : 4096, tp = isc ? pos - 4096 : pos;
        if (o < 33) { float f;
            if (o == 0) f = (float)tp / (float)(Lf - 1);
            else { const int i = (o - 1) & 15; const float fr = 1e-4f + (float)i * ((15.0f - 1e-4f) / 15.0f); const float rev = fr * (float)tp / (float)Lf; f = (o <= 16) ? cos_rev(rev) : -sin_rev(rev); }
            feat[pl * 33 + o] = f; }
        __syncthreads();
        float a = b1o;
#pragma unroll 11
        for (int i = 0; i < 33; ++i) a += feat[pl * 33 + i] * w1s[i * 64 + o];
        h1[pl * 64 + o] = sin_rad(fqo * a);
        __syncthreads();
        float b = b2o;
#pragma unroll 16
        for (int j = 0; j < 64; ++j) b += h1[pl * 64 + j] * w2s[j * 64 + o];
        FH2B[(size_t)pos * 64 + o] = (bf16)f2bf(sin_rad(fqo * b));
        __syncthreads();
    }
}
__device__ __forceinline__ void ph_norm(const float* xlat, const float* xctx, const float* g, const float* modl, int sh_off, int sc_off, bf16* H, int Mrows, const float* slab, const float* sgate, float* xc_out, int wave, int lane) {
    const int gw = blockIdx.x * NWAVES + wave, NGW = gridDim.x * NWAVES;
    for (int base = gw * 8; base < ML; base += NGW * 8) {
        const float* mv = modl + (size_t)(base >> 12) * 12288;
        f32x4 Gv[8], Sv[8];
#pragma unroll
        for (int j = 0; j < 8; ++j) { const int idx = (lane + 64 * j) * 4; Gv[j] = *(const f32x4*)(g + idx) * (*(const f32x4*)(mv + sc_off + idx) + 1.0f); Sv[j] = *(const f32x4*)(mv + sh_off + idx); }
        f32x4 v[8], nx[8];
#pragma unroll
        for (int j = 0; j < 8; ++j) nx[j] = *(const f32x4*)(xlat + (size_t)base * D + (lane + 64 * j) * 4);
#pragma unroll 1
        for (int i = 0; i < 8; ++i) { const int m = base + i; float ss = 0.f;
#pragma unroll
            for (int j = 0; j < 8; ++j) { v[j] = nx[j]; ss += (v[j].x * v[j].x + v[j].y * v[j].y) + (v[j].z * v[j].z + v[j].w * v[j].w); }
            if (i < 7) {
#pragma unroll
                for (int j = 0; j < 8; ++j) nx[j] = *(const f32x4*)(xlat + (size_t)(m + 1) * D + (lane + 64 * j) * 4); }
            const float rstd = 1.0f / sqrtf(wave_sum(ss) * (1.0f / D) + EPS);
#pragma unroll
            for (int j = 0; j < 8; ++j) { const int idx = (lane + 64 * j) * 4; const f32x4 y = v[j] * rstd * Gv[j] + Sv[j];
                v2u w; w.x = pk2(y.x, y.y); w.y = pk2(y.z, y.w); *(v2u*)(H + (size_t)m * D + idx) = w; } }
    }
    for (int m = ML + gw; m < Mrows; m += NGW) {
        const float* xr = xctx + (size_t)(m - ML) * D; const float* mv = modl + (size_t)4 * 12288;
        f32x4 v[8]; float ss = 0.f;
#pragma unroll
        for (int j = 0; j < 8; ++j) { const int idx = (lane + 64 * j) * 4; v[j] = *(const f32x4*)(xr + idx);
            if (slab) { const float* sp = slab + (size_t)(m - ML) * D + idx; f32x4 p = *(const f32x4*)sp;
#pragma unroll
                for (int q = 1; q < NSPLIT; ++q) p = p + *(const f32x4*)(sp + (size_t)q * MC * D);
                v[j] = v[j] + *(const f32x4*)(sgate + idx) * p; *(f32x4*)(xc_out + (size_t)(m - ML) * D + idx) = v[j]; }
            ss += (v[j].x * v[j].x + v[j].y * v[j].y) + (v[j].z * v[j].z + v[j].w * v[j].w); }
        const float rstd = 1.0f / sqrtf(wave_sum(ss) * (1.0f / D) + EPS);
#pragma unroll
        for (int j = 0; j < 8; ++j) { const int idx = (lane + 64 * j) * 4;
            const f32x4 gg = *(const f32x4*)(g + idx), sh = *(const f32x4*)(mv + sh_off + idx), sc = *(const f32x4*)(mv + sc_off + idx);
            const f32x4 y = v[j] * rstd * gg * (sc + 1.0f) + sh;
            v2u w; w.x = pk2(y.x, y.y); w.y = pk2(y.z, y.w);
            *(v2u*)(H + (size_t)m * D + idx) = w; }
    }
}

__device__ __forceinline__ int fphys(int i) { return i + 2 * (i >> 5); }
__device__ __forceinline__ void bfly_dif(f32x2& a, f32x2& b, float c, float s) { const f32x2 u = a, v = b; a = u + v; const f32x2 d = u - v; b = __builtin_elementwise_fma(d.yx, (f32x2){s, -s}, d * (f32x2){c, c}); }
__device__ __forceinline__ void bfly_idit(f32x2& a, f32x2& b, float c, float s) { const f32x2 u = a, q = b; const f32x2 v = __builtin_elementwise_fma(q.yx, (f32x2){-s, s}, q * (f32x2){c, c}); a = u + v; b = u - v; }
template <bool ZHI> __device__ __forceinline__ void dif16(f32x2 (&x)[16], float th) {
    asm volatile("" : "+v"(th));
#pragma unroll
    for (int k = 0; k < 8; ++k) { const float fr = th + (float)k * 0.0625f; const float c = __builtin_amdgcn_cosf(fr), s = __builtin_amdgcn_sinf(fr);
        if (ZHI) { const f32x2 u = x[k]; x[k + 8] = (f32x2){u.x * c + u.y * s, u.y * c - u.x * s}; } else bfly_dif(x[k], x[k + 8], c, s); }
#pragma unroll
    for (int k = 0; k < 4; ++k) { const float fr = 2.0f * th + (float)k * 0.125f; const float c = __builtin_amdgcn_cosf(fr), s = __builtin_amdgcn_sinf(fr);
        bfly_dif(x[k], x[k + 4], c, s); bfly_dif(x[8 + k], x[12 + k], c, s); }
#pragma unroll
    for (int k = 0; k < 2; ++k) { const float fr = 4.0f * th + (float)k * 0.25f; const float c = __builtin_amdgcn_cosf(fr), s = __builtin_amdgcn_sinf(fr);
#pragma unroll
        for (int b = 0; b < 16; b += 4) bfly_dif(x[b + k], x[b + k + 2], c, s); }
    { const float fr = 8.0f * th; const float c = __builtin_amdgcn_cosf(fr), s = __builtin_amdgcn_sinf(fr);
#pragma unroll
        for (int b = 0; b < 16; b += 2) bfly_dif(x[b], x[b + 1], c, s); }
}
__device__ __forceinline__ void idit16(f32x2 (&x)[16], float th) {
    asm volatile("" : "+v"(th));
    { const float fr = 8.0f * th; const float c = __builtin_amdgcn_cosf(fr), s = __builtin_amdgcn_sinf(fr);
#pragma unroll
        for (int b = 0; b < 16; b += 2) bfly_idit(x[b], x[b + 1], c, s); }
#pragma unroll
    for (int k = 0; k < 2; ++k) { const float fr = 4.0f * th + (float)k * 0.25f; const float c = __builtin_amdgcn_cosf(fr), s = __builtin_amdgcn_sinf(fr);
#pragma unroll
        for (int b = 0; b < 16; b += 4) bfly_idit(x[b + k], x[b + k + 2], c, s); }
#pragma unroll
    for (int k = 0; k < 4; ++k) { const float fr = 2.0f * th + (float)k * 0.125f; const float c = __builtin_amdgcn_cosf(fr), s = __builtin_amdgcn_sinf(fr);
        bfly_idit(x[k], x[k + 4], c, s); bfly_idit(x[8 + k], x[12 + k], c, s); }
#pragma unroll
    for (int k = 0; k < 8; ++k) { const float fr = th + (float)k * 0.0625f; const float c = __builtin_amdgcn_cosf(fr), s = __builtin_amdgcn_sinf(fr); bfly_idit(x[k], x[k + 8], c, s); }
}
template <bool INV, int PSTRIDE> __device__ __forceinline__ void fft_pass(LAS f32x2* buf, int base, float th) {
    LAS f32x2* p = buf + fphys(base);
    f32x2 x[16];
#pragma unroll
    for (int k = 0; k < 16; ++k) x[k] = p[k * PSTRIDE];
    if (INV) idit16(x, th); else dif16<false>(x, th);
#pragma unroll
    for (int k = 0; k < 16; ++k) p[k * PSTRIDE] = x[k];
}
constexpr int FFT_LDS_BYTES = (8192 + 512 + 8) * 8;
__device__ __forceinline__ float block_sum(float v, LAS float* red, int tid) {
    v = wave_sum(v);
    __syncthreads();
    if ((tid & 63) == 0) red[tid >> 6] = v;
    __syncthreads();
    float s = 0.f;
#pragma unroll
    for (int i = 0; i < 8; ++i) s += red[i];
    return s;
}
__device__ __forceinline__ float hy_delta(int c) { const float d0 = -4.605170185988091f / 0.3f, d1 = -4.605170185988091f / 1.5f; return fabsf(d0 + (d1 - d0) * ((float)c / 1023.0f)); }
__device__ __forceinline__ void ph_filt2(const Args& A, int l, int set, int c_lo, int c_hi, int wk, int nwk, LAS unsigned char* lds, int tid) {
    LAS f32x2* buf = (LAS f32x2*)lds; LAS float* bufs = (LAS float*)lds; LAS float* red = (LAS float*)(lds + FFT_LDS_BYTES + 64); LAS float* w3s = red + 32;
    LAS float* ctap = w3s + 256;
    const float* w3 = inp(I_FW3) + (size_t)l * 64 * 4096; const bf16* FH2B = (const bf16*)(wsb() + WS_FB4) + (size_t)l * 4352 * 64;
    f32x2* KF = (f32x2*)(psb(set) + PS_KF); float* TAPC = (float*)(psb(set) + PS_TAPC);
    const int lane = tid & 63, w = tid >> 6, g = lane >> 4, li = lane & 15;
    for (int c = c_lo + wk; c < c_hi; c += nwk) {
        __syncthreads();
        if (tid < 256) w3s[tid] = w3[(size_t)(tid & 63) * 4096 + (tid >> 7) * 2048 + ((tid >> 6) & 1) * 1024 + c];
        __syncthreads();
        bf16x8 bfr[2];
#pragma unroll
        for (int ks = 0; ks < 2; ++ks) { float v[8];
#pragma unroll
            for (int j = 0; j < 8; ++j) v[j] = (li < 4) ? w3s[li * 64 + 32 * ks + 8 * g + j] : 0.f;
            bfr[ks] = mk8(pk2(v[0], v[1]), pk2(v[2], v[3]), pk2(v[4], v[5]), pk2(v[6], v[7])); }
        const float delta = hy_delta(c); float ssq = 0.f, ssqc = 0.f;
        const int comp = li >> 1;
#pragma unroll 1
        for (int rb = 0; rb < 272; rb += 64) {
            bf16x8 a0[8], a1[8];
#pragma unroll
            for (int rk = 0; rk < 8; ++rk) { const int rt = rb + w + 8 * rk; const bf16* ap = FH2B + (size_t)((rt < 272 ? rt : 0) * 16 + li) * 64 + 8 * g;
                a0[rk] = *(const bf16x8*)ap; a1[rk] = *(const bf16x8*)(ap + 32); }
#pragma unroll
            for (int rk = 0; rk < 8; ++rk) { const int rt = rb + w + 8 * rk; const int t0 = rt * 16;
                f32x4 acc = (f32x4){0.f, 0.f, 0.f, 0.f};
                acc = mfma16(a0[rk], bfr[0], acc); acc = mfma16(a1[rk], bfr[1], acc);
                if (li < 4 && rt < 272) {
                    if (rt < 256) {
#pragma unroll
                        for (int j = 0; j < 4; ++j) { const int t = t0 + 4 * g + j; const float val = acc[j] * __expf(-((float)t / 4095.0f) * delta);
                            if ((li & 1) == 0) { bufs[2 * fphys(t) + comp] = val; ssq += val * val; }
                            else if (t >= 1) { bufs[2 * fphys(8192 - t) + comp] = val; ssq += val * val; }
                            else bufs[2 * fphys(4096) + comp] = 0.f; }
                    } else {
#pragma unroll
                        for (int j = 0; j < 4; ++j) { const int m = t0 - 4096 + 4 * g + j; const float val = acc[j] * __expf(-((float)m / 255.0f) * delta);
                            ctap[li * 256 + m] = val; if ((li & 1) == 0 || m >= 1) ssqc += val * val; }
                    }
                }
            }
        }
        const bool o0 = (li < 2), o1 = (li == 2 || li == 3);
        const float scl0 = (1.0f / 8192.0f) / sqrtf(block_sum(o0 ? ssq : 0.f, red, tid) + EPS), scl1 = (1.0f / 8192.0f) / sqrtf(block_sum(o1 ? ssq : 0.f, red, tid) + EPS);
        const float sc0 = 1.0f / sqrtf(block_sum(o0 ? ssqc : 0.f, red, tid) + EPS), sc1 = 1.0f / sqrtf(block_sum(o1 ? ssqc : 0.f, red, tid) + EPS);
        __syncthreads();
        fft_pass<false, 544>(buf, tid, (float)tid * (1.0f / 8192.0f));
        __syncthreads();
        fft_pass<false, 34>(buf, (tid >> 5) * 512 + (tid & 31), (float)(tid & 31) * (1.0f / 512.0f));
        __syncthreads();
        fft_pass<false, 2>(buf, (tid >> 1) * 32 + (tid & 1), (float)(tid & 1) * (1.0f / 32.0f));
        __syncthreads();
#pragma unroll
        for (int r = 0; r < 8; ++r) { LAS f32x4* pp = (LAS f32x4*)(buf + fphys(2 * tid) + 1088 * r); const f32x4 ab = *pp; *pp = (f32x4){ab.x + ab.z, ab.y + ab.w, ab.x - ab.z, ab.y - ab.w}; }
        __syncthreads();
        f32x2* d0 = KF + (size_t)c * 8192; f32x2* d1 = KF + (size_t)(1024 + c) * 8192;
#pragma unroll 4
        for (int i = 0; i < 16; ++i) { const int p = tid + 512 * i; const int f = (int)(__brev((unsigned)p) >> 19); const int pp = (int)(__brev((unsigned)((8192 - f) & 8191)) >> 19);
            const f32x2 z = buf[fphys(p)], zp = buf[fphys(pp)];
            d0[p] = (f32x2){(z.x + zp.x) * 0.5f * scl0, (z.y - zp.y) * 0.5f * scl0};
            d1[p] = (f32x2){(z.y + zp.y) * 0.5f * scl1, (zp.x - z.x) * 0.5f * scl1}; }
        for (int q = tid; q < 1024; q += 512) { const int od = q >> 8, m = q & 255; TAPC[((size_t)od * 1024 + c) * 256 + m] = ctap[q] * ((od < 2) ? sc0 : sc1); }
    }
}

__device__ __forceinline__ void ph_hyprep(const Args& A, int l, LAS unsigned char* lds, int tid) {
    LAS bf16* T = (LAS bf16*)lds;
    const bf16* Z = (const bf16*)(wsb() + WS_Z); bf16* HYT = (bf16*)(wsb() + WS_HYT);
    const float* cw = inp(I_HCW) + (size_t)l * 3 * 3072; const float* cb = inp(I_HCB) + (size_t)l * 3072;
    v4u pre[5];
#define HP_LOAD(u_) do { const int cg_ = (u_) % 12, tt_ = ((u_) / 12) & 63, b_ = (u_) / 768; \
        _Pragma("unroll") for (int e = 0; e < 5; ++e) { const int q = tid + 512 * e; const int r = q >> 5, ch8 = q & 31, t = tt_ * 64 - 1 + r; pre[e] = (v4u){0u, 0u, 0u, 0u}; \
            if (q < 66 * 32 && t >= 0 && t < SEQ) pre[e] = *(const v4u*)(Z + (size_t)(b_ * SEQ + t) * INW + C_HY + cg_ * 256 + ch8 * 8); } } while (0)
    int u = blockIdx.x;
    if (u < 3072) HP_LOAD(u);
    for (; u < 3072; u += gridDim.x) {
        const int cg = u % 12, tt = (u / 12) & 63, b = u / 768;
        __syncthreads();
#pragma unroll
        for (int e = 0; e < 5; ++e) { const int q = tid + 512 * e; if (q < 66 * 32) *(LAS v4u*)(T + (q >> 5) * 264 + (q & 31) * 8) = pre[e]; }
        __syncthreads();
        if (u + (int)gridDim.x < 3072) HP_LOAD(u + (int)gridDim.x);
        const int ch = tid & 255, half = tid >> 8, gch = cg * 256 + ch;
        const float w0 = cw[gch], w1 = cw[3072 + gch], w2 = cw[6144 + gch], bb = cb[gch];
        const int part = gch >> 10, c = gch & 1023;
        bf16* outp = HYT + ((size_t)(part * NB + b) * 1024 + c) * SEQ + tt * 64 + half * 32;
#pragma unroll
        for (int tq = 0; tq < 4; ++tq) { float vv[8];
#pragma unroll
            for (int e = 0; e < 8; ++e) { const int tl = half * 32 + tq * 8 + e;
                vv[e] = w0 * bf1(T[tl * 264 + ch]) + w1 * bf1(T[(tl + 1) * 264 + ch]) + w2 * bf1(T[(tl + 2) * 264 + ch]) + bb; }
            v4u w; w.x = pk2(vv[0], vv[1]); w.y = pk2(vv[2], vv[3]); w.z = pk2(vv[4], vv[5]); w.w = pk2(vv[6], vv[7]);
            *(v4u*)(outp + tq * 8) = w; }
    }
#undef HP_LOAD
}
__device__ __forceinline__ void ph_hyctx(const Args& A, int l, LAS unsigned char* lds, int tid) {
    const bf16* Z = (const bf16*)(wsb() + WS_Z); bf16* YS = (bf16*)(wsb() + WS_YS); const float* TAPC = (const float*)(psb(l & 1) + PS_TAPC);
    const float* cw = inp(I_HCW) + (size_t)l * 3 * 3072; const float* cb = inp(I_HCB) + (size_t)l * 3072; const float* hb = inp(I_HBIAS) + (size_t)l * 2 * 1024;
    const int ch = tid >> 6, q = tid & 63, t0 = 4 * q;
    LAS float* Y = (LAS float*)lds + ch * 1552; LAS float* Y1 = Y + 256; LAS float* G0 = Y + 512; LAS float* G1 = Y + 1032;
    for (int u = blockIdx.x; u < 512; u += gridDim.x) {
        const int b = u >> 7, c = (u & 127) * 8 + ch;
        __syncthreads();
        float pv[3][4];
#pragma unroll
        for (int part = 0; part < 3; ++part) { const int gch = part * 1024 + c; const float w0 = cw[gch], w1 = cw[3072 + gch], w2 = cw[6144 + gch], bb = cb[gch];
            const bf16* zp = Z + (size_t)(ML + b * CL + t0) * INW + C_HY + gch;
            float zz[6];
#pragma unroll
            for (int e = 0; e < 6; ++e) { const int t = t0 - 1 + e; zz[e] = (t >= 0 && t < CL) ? bf1(zp[(ptrdiff_t)(e - 1) * INW]) : 0.f; }
#pragma unroll
            for (int r = 0; r < 4; ++r) pv[part][r] = w0 * zz[r] + w1 * zz[r + 1] + w2 * zz[r + 2] + bb; }
        *(LAS f32x4*)(Y + t0) = (f32x4){pv[2][0], pv[2][1], pv[2][2], pv[2][3]};
#pragma unroll
        for (int r = 0; r < 4; ++r) { const int m = t0 + r;
            G0[m + 259] = TAPC[((size_t)(0 * 2 + 0) * 1024 + c) * 256 + m]; G1[m + 259] = TAPC[((size_t)(1 * 2 + 0) * 1024 + c) * 256 + m];
            if (m >= 1) { G0[259 - m] = TAPC[((size_t)(0 * 2 + 1) * 1024 + c) * 256 + m]; G1[259 - m] = TAPC[((size_t)(1 * 2 + 1) * 1024 + c) * 256 + m]; } }
        if (q == 0) { G0[515] = 0.f; G1[515] = 0.f; G0[516] = 0.f; G1[516] = 0.f; }
        __syncthreads();
        float yprev[4] = {pv[2][0], pv[2][1], pv[2][2], pv[2][3]};
#pragma unroll
        for (int ord = 0; ord < 2; ++ord) {
            const LAS float* Ys = ord ? Y1 : Y; const LAS float* G = ord ? G1 : G0;
            float acc[4] = {0.f, 0.f, 0.f, 0.f};
#pragma unroll 4
            for (int sp = 0; sp < 64; ++sp) { const f32x4 yv = *(const LAS f32x4*)(Ys + 4 * sp); const LAS float* gp = G + 4 * (q - sp) + 256;
                const f32x4 ga = *(const LAS f32x4*)gp, gb = *(const LAS f32x4*)(gp + 4);
                const float g[8] = {ga.x, ga.y, ga.z, ga.w, gb.x, gb.y, gb.z, gb.w}; const float yy[4] = {yv.x, yv.y, yv.z, yv.w};
#pragma unroll
                for (int r = 0; r < 4; ++r)
#pragma unroll
                    for (int j = 0; j < 4; ++j) acc[r] += yy[j] * g[r - j + 3]; }
            const float bias = hb[ord * 1024 + c];
#pragma unroll
            for (int r = 0; r < 4; ++r) yprev[r] = pv[ord][r] * (acc[r] + bias * yprev[r]);
            if (ord == 0) { *(LAS f32x4*)(Y1 + t0) = (f32x4){yprev[0], yprev[1], yprev[2], yprev[3]}; __syncthreads(); }
        }
#pragma unroll
        for (int r = 0; r < 4; ++r) YS[(size_t)(ML + b * CL + t0 + r) * 1024 + c] = (bf16)f2bf(yprev[r]);
    }
}
__device__ __forceinline__ void unpack8(v4u v, float (&x)[8]) { x[0] = bflo(v.x); x[1] = bfhi(v.x); x[2] = bflo(v.y); x[3] = bfhi(v.y); x[4] = bflo(v.z); x[5] = bfhi(v.z); x[6] = bflo(v.w); x[7] = bfhi(v.w); }
__device__ __forceinline__ v4u pack8(const float (&x)[8]) { v4u w; w.x = pk2(x[0], x[1]); w.y = pk2(x[2], x[3]); w.z = pk2(x[4], x[5]); w.w = pk2(x[6], x[7]); return w; }
__device__ __forceinline__ void rope8(float (&lo)[8], float (&hi)[8], const f32x2* rt) {
#pragma unroll
    for (int e = 0; e < 8; ++e) { const f32x2 cs = rt[e]; const float a = lo[e], b = hi[e]; lo[e] = a * cs.x - b * cs.y; hi[e] = b * cs.x + a * cs.y; }
}
__device__ __forceinline__ void vt_store(LAS bf16* Vt, int ld, int d0, int r, v4u vv) {
    Vt[(d0 + 0) * ld + r] = (bf16)(vv.x & 0xffffu); Vt[(d0 + 1) * ld + r] = (bf16)(vv.x >> 16);
    Vt[(d0 + 2) * ld + r] = (bf16)(vv.y & 0xffffu); Vt[(d0 + 3) * ld + r] = (bf16)(vv.y >> 16);
    Vt[(d0 + 4) * ld + r] = (bf16)(vv.z & 0xffffu); Vt[(d0 + 5) * ld + r] = (bf16)(vv.z >> 16);
    Vt[(d0 + 6) * ld + r] = (bf16)(vv.w & 0xffffu); Vt[(d0 + 7) * ld + r] = (bf16)(vv.w >> 16);
}
constexpr float LOG2E = 1.4426950408889634f;
typedef short s16x4 __attribute__((ext_vector_type(4)));
__device__ __forceinline__ bf16x8 tr_frag(const LAS bf16* tile, int ld, int r0, int r1, int c0, int li) {
    const s16x4 lo = __builtin_amdgcn_ds_read_tr16_b64_v4i16((LAS s16x4*)(tile + (r0 + (li >> 2)) * ld + c0 + 4 * (li & 3)));
    const s16x4 hi = __builtin_amdgcn_ds_read_tr16_b64_v4i16((LAS s16x4*)(tile + (r1 + (li >> 2)) * ld + c0 + 4 * (li & 3)));
    return (bf16x8){lo.x, lo.y, lo.z, lo.w, hi.x, hi.y, hi.z, hi.w};
}
__device__ __forceinline__ void ph_ret1(const Args& A, int l, int nctx_units, LAS unsigned char* lds, int tid) {
    LAS bf16* Kf = (LAS bf16*)lds; LAS bf16* Kb = Kf + 128 * 72; LAS bf16* Vs = Kb + 128 * 72;
    const bf16* Z = (const bf16*)(wsb() + WS_Z); float* KV = (float*)(wsb() + WS_KV); const f32x2* rope = (const f32x2*)(wsb() + WS_ROPE);
    const int lane = tid & 63, w = tid >> 6, g = lane >> 4, li = lane & 15;
    const int tok = tid >> 2, pp = tid & 3, a = (pp & 1) + ((pp >> 1) << 2);
    const int nunits = 1024 + nctx_units;
    v4u pk[2], pv[4];
#define R1_DEC(uid_, b_, h_, n_, ci_, m0_, isc_) const bool isc_ = (uid_) >= 1024; int b_, h_, n_, ci_; size_t m0_; \
        if (!isc_) { b_ = (uid_) >> 8; h_ = ((uid_) >> 5) & 7; n_ = (uid_) & 31; m0_ = (size_t)b_ * SEQ + n_ * 128; ci_ = 2 + n_; } \
        else { const int i_ = (uid_) - 1024; b_ = i_ >> 4; h_ = (i_ >> 1) & 7; n_ = i_ & 1; m0_ = (size_t)ML + b_ * CL + n_ * 128; ci_ = n_; }
#define R1_LOAD(uid_) do { R1_DEC(uid_, b2, h2, n2, ci2, m02, isc2) (void)ci2; (void)n2; (void)isc2; const bf16* kr = Z + (m02 + tok) * INW + C_RK + h2 * 64; pk[0] = *(const v4u*)(kr + 8 * a); pk[1] = *(const v4u*)(kr + 8 * a + 16); \
        _Pragma("unroll") for (int e = 0; e < 4; ++e) { const int q = tid + 512 * e; pv[e] = *(const v4u*)(Z + (m02 + (q >> 4)) * INW + C_RV + h2 * 128 + (q & 15) * 8); } } while (0)
    int uid = blockIdx.x;
    if (uid < nunits) R1_LOAD(uid);
    for (; uid < nunits; uid += gridDim.x) {
        R1_DEC(uid, b, h, n, ci, m0, isc) (void)m0;
        const float lgf = inp(I_RDEC)[(l * 2 + 0) * 8 + h] * LOG2E, lgb = inp(I_RDEC)[(l * 2 + 1) * 8 + h] * LOG2E;
        __syncthreads();
        { float lo[8], hi[8]; unpack8(pk[0], lo); unpack8(pk[1], hi);
            if (!isc) { const int t = n * 128 + tok; const int pos = (a < 4) ? (t >> 6) : (t & 63); rope8(lo, hi, rope + pos * 16 + 8 * (a & 1)); }
            const float zf = ex2(lgf * (float)(127 - tok)) * 0.125f, zb = ex2(lgb * (float)tok) * 0.125f;
            float lf[8], hf[8];
#pragma unroll
            for (int e = 0; e < 8; ++e) { lf[e] = lo[e] * zf; hf[e] = hi[e] * zf; lo[e] *= zb; hi[e] *= zb; }
            *(LAS v4u*)(Kf + tok * 72 + 8 * a) = pack8(lf); *(LAS v4u*)(Kf + tok * 72 + 8 * a + 16) = pack8(hf);
            *(LAS v4u*)(Kb + tok * 72 + 8 * a) = pack8(lo); *(LAS v4u*)(Kb + tok * 72 + 8 * a + 16) = pack8(hi); }
#pragma unroll
        for (int e = 0; e < 4; ++e) { const int q = tid + 512 * e; *(LAS v4u*)(Vs + (q >> 4) * 144 + (q & 15) * 8) = pv[e]; }
        __syncthreads();
        if (uid + (int)gridDim.x < nunits) R1_LOAD(uid + (int)gridDim.x);
        bf16x8 af[4];
#pragma unroll
        for (int ks = 0; ks < 4; ++ks) af[ks] = tr_frag(Vs, 144, 32 * ks + 8 * g, 32 * ks + 8 * g + 4, 16 * w, li);
#pragma unroll
        for (int dir = 0; dir < 2; ++dir) { const LAS bf16* KT = dir ? Kb : Kf;
            float* dst = KV + ((size_t)((b * 8 + h) * 2 + dir) * 34 + ci) * 8192;
#pragma unroll
            for (int nc = 0; nc < 4; ++nc) { f32x4 acc = (f32x4){0.f, 0.f, 0.f, 0.f};
#pragma unroll
                for (int ks = 0; ks < 4; ++ks) acc = mfma16(af[ks], tr_frag(KT, 72, 32 * ks + 8 * g, 32 * ks + 8 * g + 4, 16 * nc, li), acc);
#pragma unroll
                for (int j = 0; j < 4; ++j) dst[(16 * w + 4 * g + j) * 64 + 16 * nc + li] = acc[j]; } }
    }
#undef R1_LOAD
}
__device__ __forceinline__ void ph_natt(const Args& A, int l, int mode, LAS unsigned char* lds, int tid) {
    LAS bf16* Qs = (LAS bf16*)lds; LAS bf16* KV0 = (LAS bf16*)lds; LAS float* rpbs = (LAS float*)(lds + 2 * (64 * 136 + 64 * 144) * 2);
    const bf16* Z = (const bf16*)(wsb() + WS_Z); bf16* YS = (bf16*)(wsb() + WS_YS) + (size_t)2 * MT * 1024;
    const int lane = tid & 63, w = tid >> 6, g = lane >> 4, li = lane & 15;
    const float SCALE = 0.08838834764831845f * LOG2E;
    const int sr0 = tid >> 4, sch = tid & 15;
    const int ufirst = mode ? ((int)blockIdx.x - ((int)gridDim.x - 32)) : (int)blockIdx.x, ucount = mode ? 32 : 512;
    if (ufirst < 0) return;
    for (int uid = ufirst; uid < ucount; uid += (mode ? 32 : (int)gridDim.x)) {
        int b, h, rq = 0; size_t m0;
        if (!mode) { b = uid >> 7; h = (uid >> 4) & 7; rq = uid & 15; m0 = (size_t)b * SEQ + rq * 256; }
        else { b = uid >> 3; h = uid & 7; m0 = (size_t)ML + b * CL; }
        const size_t mc0 = (size_t)ML + b * CL;
        const int qr = 4 * rq + (w >> 1), rs_w = min(max(qr - 4, 0), 56);
        const int kr_lo = min(max(4 * rq - 4, 0), 56), kr_hi = min(max(4 * rq - 1, 0), 56) + 7;
        const int nwin = mode ? 0 : (kr_hi - kr_lo + 1), ntile = nwin + 4;
        int qc[2], cs[2], nlo_w[2], nhi_w[2];
#pragma unroll
        for (int i = 0; i < 2; ++i) { const int cw = 2 * (w & 1) + i; qc[i] = 16 * cw + li; cs[i] = min(max(qc[i] - 8, 0), 48);
            nlo_w[i] = (cw <= 1) ? 0 : cw - 1; nhi_w[i] = (cw == 0) ? 1 : ((cw == 3) ? 3 : cw + 1); }
        v4u kreg[2], vreg[2];
#define NA_LOAD(t_) do { const int t__ = (t_); const size_t mk = (t__ < nwin) ? ((size_t)b * SEQ + (kr_lo + t__) * 64) : (mc0 + (t__ - nwin) * 64); \
            _Pragma("unroll") for (int e = 0; e < 2; ++e) { const bf16* zr = Z + (mk + sr0 + 32 * e) * INW + h * 128 + sch * 8; kreg[e] = *(const v4u*)(zr + C_NK); vreg[e] = *(const v4u*)(zr + C_NV); } } while (0)
#define NA_STORE(buf_) do { LAS bf16* Kd = KV0 + (buf_) * (64 * 136 + 64 * 144); LAS bf16* Vd = Kd + 64 * 136; \
            _Pragma("unroll") for (int e = 0; e < 2; ++e) { *(LAS v4u*)(Kd + (sr0 + 32 * e) * 136 + sch * 8) = kreg[e]; *(LAS v4u*)(Vd + (sr0 + 32 * e) * 144 + sch * 8) = vreg[e]; } } while (0)
        __syncthreads();
        NA_LOAD(0);
        for (int q = tid; q < 4096; q += 512) { const int r = q >> 4, chn = q & 15; *(LAS v4u*)(Qs + r * 136 + chn * 8) = *(const v4u*)(Z + (m0 + r) * INW + C_NQ + h * 128 + chn * 8); }
        if (!mode) for (int i = tid; i < 465; i += 512) rpbs[i] = inp(I_RPB)[((size_t)l * 8 + h) * 465 + i] * LOG2E;
        __syncthreads();
        bf16x8 qf[2][4];
#pragma unroll
        for (int i = 0; i < 2; ++i)
#pragma unroll
            for (int ks = 0; ks < 4; ++ks) qf[i][ks] = *(const LAS bf16x8*)(Qs + (32 * w + 16 * i + li) * 136 + 32 * ks + 8 * g);
        __syncthreads();
        NA_STORE(0);
        __syncthreads();
        f32x4 o[2][8];
#pragma unroll
        for (int i = 0; i < 2; ++i)
#pragma unroll
            for (int nd = 0; nd < 8; ++nd) o[i][nd] = (f32x4){0.f, 0.f, 0.f, 0.f};
        float mrun[2] = {-1e30f, -1e30f}, lrun[2] = {0.f, 0.f};
        for (int t = 0; t < ntile; ++t) {
            const bool win = t < nwin; const int kr = kr_lo + t;
            if (t + 1 < ntile) NA_LOAD(t + 1);
            const LAS bf16* Ks = KV0 + (t & 1) * (64 * 136 + 64 * 144); const LAS bf16* Vs = Ks + 64 * 136;
            const bool active = !win || (kr >= rs_w && kr <= rs_w + 7);
            if (active) {
                const int nlo0 = win ? nlo_w[0] : 0, nhi0 = win ? nhi_w[0] : 3, nlo1 = win ? nlo_w[1] : 0, nhi1 = win ? nhi_w[1] : 3;
                f32x4 s[2][4];
#pragma unroll
                for (int n = 0; n < 4; ++n) { s[0][n] = (f32x4){0.f, 0.f, 0.f, 0.f}; s[1][n] = (f32x4){0.f, 0.f, 0.f, 0.f};
                    const bool u0 = (n >= nlo0 && n <= nhi0), u1 = (n >= nlo1 && n <= nhi1);
                    if (u0 || u1) {
#pragma unroll
                        for (int ks = 0; ks < 4; ++ks) { const bf16x8 kf = *(const LAS bf16x8*)(Ks + (16 * n + li) * 136 + 32 * ks + 8 * g);
                            if (u0) s[0][n] = mfma16(kf, qf[0][ks], s[0][n]);
                            if (u1) s[1][n] = mfma16(kf, qf[1][ks], s[1][n]); } } }
                bf16x8 pf[2][2];
#pragma unroll
                for (int i = 0; i < 2; ++i) {
                    float tmax = -1e30f;
#pragma unroll
                    for (int n = 0; n < 4; ++n)
#pragma unroll
                        for (int j = 0; j < 4; ++j) { float v = s[i][n][j] * SCALE;
                            if (win) { const int kc = 16 * n + 4 * g + j; const bool valid = (kc >= cs[i]) && (kc < cs[i] + 16);
                                const int dc = min(max(kc - qc[i] + 15, 0), 30), dr = min(max(kr - qr + 7, 0), 14);
                                v = valid ? v + rpbs[dr * 31 + dc] : -1e30f; }
                            s[i][n][j] = v; tmax = fmaxf(tmax, v); }
                    tmax = fmaxf(tmax, __shfl_xor(tmax, 16)); tmax = fmaxf(tmax, __shfl_xor(tmax, 32));
                    const bool upd = tmax > mrun[i] + 8.0f;
                    const float mnew = upd ? tmax : mrun[i];
                    float psum = 0.f;
#pragma unroll
                    for (int n = 0; n < 4; ++n)
#pragma unroll
                        for (int j = 0; j < 4; ++j) { const float pv = ex2(s[i][n][j] - mnew); s[i][n][j] = pv; psum += pv; }
                    psum += __shfl_xor(psum, 16); psum += __shfl_xor(psum, 32);
                    if (__any(upd)) { const float alpha = ex2(mrun[i] - mnew); lrun[i] *= alpha;
#pragma unroll
                        for (int nd = 0; nd < 8; ++nd) o[i][nd] = o[i][nd] * alpha; }
                    lrun[i] += psum; mrun[i] = mnew;
#pragma unroll
                    for (int kk = 0; kk < 2; ++kk) pf[i][kk] = mk8(pk2(s[i][2 * kk][0], s[i][2 * kk][1]), pk2(s[i][2 * kk][2], s[i][2 * kk][3]), pk2(s[i][2 * kk + 1][0], s[i][2 * kk + 1][1]), pk2(s[i][2 * kk + 1][2], s[i][2 * kk + 1][3]));
                }
#pragma unroll
                for (int kk = 0; kk < 2; ++kk) { const bool u0 = (2 * kk + 1 >= nlo0 && 2 * kk <= nhi0), u1 = (2 * kk + 1 >= nlo1 && 2 * kk <= nhi1);
                    if (u0 || u1) {
#pragma unroll
                        for (int nd = 0; nd < 8; ++nd) { const bf16x8 vf = tr_frag(Vs, 144, 32 * kk + 4 * g, 32 * kk + 16 + 4 * g, 16 * nd, li);
                            if (u0) o[0][nd] = mfma16(vf, pf[0][kk], o[0][nd]);
                            if (u1) o[1][nd] = mfma16(vf, pf[1][kk], o[1][nd]); } } }
            }
            if (t + 1 < ntile) NA_STORE((t + 1) & 1);
            __syncthreads();
        }
#undef NA_LOAD
#undef NA_STORE
#pragma unroll
        for (int i = 0; i < 2; ++i) { const float inv = 1.0f / lrun[i]; const size_t mrow = m0 + 32 * w + 16 * i + li;
#pragma unroll
            for (int nd = 0; nd < 8; ++nd) { v2u wv; wv.x = pk2(o[i][nd][0] * inv, o[i][nd][1] * inv); wv.y = pk2(o[i][nd][2] * inv, o[i][nd][3] * inv);
                *(v2u*)(YS + mrow * 1024 + h * 128 + 16 * nd + 4 * g) = wv; } }
    }
}

__device__ __forceinline__ void ph_hyfft(const Args& A, int l, LAS unsigned char* lds, int tid) {
    LAS f32x2* buf = (LAS f32x2*)lds;
    const bf16* HYT = (const bf16*)(wsb() + WS_HYT); bf16* YT = (bf16*)(wsb() + WS_YT); const f32x2* KF = (const f32x2*)(psb(l & 1) + PS_KF);
    const float* hb = inp(I_HBIAS) + (size_t)l * 2 * 1024;
    const int baseB = (tid >> 5) * 512 + (tid & 31), baseC = (tid >> 1) * 32 + (tid & 1);
    const float thA = (float)tid * (1.0f / 8192.0f), thB = (float)(tid & 31) * (1.0f / 512.0f), thC = (float)(tid & 1) * (1.0f / 32.0f);
    const size_t bstr = (size_t)1024 * SEQ;
    bf16 vr0[8], vr1[8];
#define HF_PTR(u_, part_) (HYT + ((size_t)((part_) * NB + ((u_) & 1) * 2) * 1024 + ((u_) >> 1)) * SEQ)
    int u = blockIdx.x;
    if (u < 2048) { const bf16* vp = HF_PTR(u, 2);
#pragma unroll
        for (int i = 0; i < 8; ++i) { vr0[i] = vp[tid + 512 * i]; vr1[i] = vp[bstr + tid + 512 * i]; } }
    for (; u < 2048; u += gridDim.x) {
        const int c = u >> 1, b0 = (u & 1) * 2;
        float y0[8], y1[8];
#pragma unroll
        for (int i = 0; i < 8; ++i) { y0[i] = bf1(vr0[i]); y1[i] = bf1(vr1[i]); }
#pragma unroll
        for (int ord = 0; ord < 2; ++ord) {
            f32x4 kreg[8]; bf16 xr0[8], xr1[8];
            { const f32x4* kf = (const f32x4*)(KF + (size_t)(ord * 1024 + c) * 8192); const bf16* xp = HF_PTR(u, ord);
#pragma unroll
                for (int r = 0; r < 8; ++r) { kreg[r] = kf[tid + 512 * r]; xr0[r] = xp[tid + 512 * r]; xr1[r] = xp[bstr + tid + 512 * r]; } }
            { f32x2 x[16];
#pragma unroll
                for (int k = 0; k < 8; ++k) { x[k] = (f32x2){y0[k], y1[k]}; x[k + 8] = (f32x2){0.f, 0.f}; }
                dif16<true>(x, thA);
                __syncthreads();
#pragma unroll
                for (int k = 0; k < 16; ++k) buf[fphys(tid) + 544 * k] = x[k]; }
            __syncthreads();
            fft_pass<false, 34>(buf, baseB, thB);
            __syncthreads();
            fft_pass<false, 2>(buf, baseC, thC);
            __syncthreads();
#pragma unroll
            for (int r = 0; r < 8; ++r) { LAS f32x4* pp = (LAS f32x4*)(buf + fphys(2 * tid) + 1088 * r); const f32x4 ab = *pp; const f32x4 kk = kreg[r];
                const float ax = ab.x + ab.z, ay = ab.y + ab.w, bx = ab.x - ab.z, by = ab.y - ab.w;
                const float px = ax * kk.x - ay * kk.y, py = ax * kk.y + ay * kk.x, qx = bx * kk.z - by * kk.w, qy = bx * kk.w + by * kk.z;
                *pp = (f32x4){px + qx, py + qy, px - qx, py - qy}; }
            __syncthreads();
            fft_pass<true, 2>(buf, baseC, thC);
            __syncthreads();
            fft_pass<true, 34>(buf, baseB, thB);
            __syncthreads();
            if (ord == 1 && u + (int)gridDim.x < 2048) { const bf16* vp = HF_PTR(u + (int)gridDim.x, 2);
#pragma unroll
                for (int i = 0; i < 8; ++i) { vr0[i] = vp[tid + 512 * i]; vr1[i] = vp[bstr + tid + 512 * i]; } }
            { f32x2 x[16];
#pragma unroll
                for (int k = 0; k < 16; ++k) x[k] = buf[fphys(tid) + 544 * k];
                idit16(x, thA);
                const float bias = hb[ord * 1024 + c];
#pragma unroll
                for (int k = 0; k < 8; ++k) { y0[k] = bf1(xr0[k]) * (x[k].x + bias * y0[k]); y1[k] = bf1(xr1[k]) * (x[k].y + bias * y1[k]); } }
        }
        bf16* o0 = YT + ((size_t)b0 * 1024 + c) * SEQ;
#pragma unroll
        for (int i = 0; i < 8; ++i) { const int t = tid + 512 * i; o0[t] = (bf16)f2bf(y0[i]); o0[bstr + t] = (bf16)f2bf(y1[i]); }
    }
#undef HF_PTR
}
__device__ __forceinline__ void ph_scan(const Args& A, int l, int tid) {
    float* KV = (float*)(wsb() + WS_KV);
    for (int gt = blockIdx.x * 512 + tid; gt < NB * 8 * 2 * 2048; gt += gridDim.x * 512) {
        const int bhd = gt >> 11, e4 = gt & 2047, dir = bhd & 1, h = (bhd >> 1) & 7;
        const float gC = ex2(inp(I_RDEC)[(l * 2 + dir) * 8 + h] * LOG2E * 128.0f);
        f32x4* base = (f32x4*)(KV + (size_t)bhd * 34 * 8192) + e4;
        f32x4 s = (f32x4){0.f, 0.f, 0.f, 0.f};
#pragma unroll 1
        for (int sb8 = 0; sb8 < 34; sb8 += 8) {
            f32x4 tv[8];
#pragma unroll
            for (int k = 0; k < 8; ++k) { const int step = min(sb8 + k, 33); const int ci = (dir == 0) ? step : (step == 0 ? 1 : (step == 1 ? 0 : 35 - step)); tv[k] = base[(size_t)ci * 2048]; }
#pragma unroll
            for (int k = 0; k < 8; ++k) { const int step = sb8 + k; if (step < 34) { const int ci = (dir == 0) ? step : (step == 0 ? 1 : (step == 1 ? 0 : 35 - step)); base[(size_t)ci * 2048] = s; s = s * gC + tv[k]; } } }
    }
}

__device__ __forceinline__ void ph_hypost(const Args& A, LAS unsigned char* lds, int tid) {
    LAS bf16* T = (LAS bf16*)lds;
    const bf16* YT = (const bf16*)(wsb() + WS_YT); bf16* YS = (bf16*)(wsb() + WS_YS);
    for (int u = blockIdx.x; u < 1024; u += gridDim.x) {
        const int cg = u & 3, tt = (u >> 2) & 63, b = u >> 8;
        __syncthreads();
        for (int q = tid; q < 2048; q += 512) { const int c = q >> 3, t8 = q & 7;
            *(LAS v4u*)(T + c * 72 + t8 * 8) = *(const v4u*)(YT + ((size_t)b * 1024 + cg * 256 + c) * SEQ + tt * 64 + t8 * 8); }
        __syncthreads();
        const int t = tid >> 3, c32 = tid & 7;
#pragma unroll
        for (int q = 0; q < 4; ++q) { const int cb = c32 * 32 + q * 8; v4u w;
            w.x = (unsigned)T[(cb + 0) * 72 + t] | ((unsigned)T[(cb + 1) * 72 + t] << 16); w.y = (unsigned)T[(cb + 2) * 72 + t] | ((unsigned)T[(cb + 3) * 72 + t] << 16);
            w.z = (unsigned)T[(cb + 4) * 72 + t] | ((unsigned)T[(cb + 5) * 72 + t] << 16); w.w = (unsigned)T[(cb + 6) * 72 + t] | ((unsigned)T[(cb + 7) * 72 + t] << 16);
            *(v4u*)(YS + (size_t)(b * SEQ + tt * 64 + t) * 1024 + cg * 256 + cb) = w; }
    }
}
__device__ __forceinline__ void ph_ret3(const Args& A, int l, int nctx_units, LAS unsigned char* lds, int tid) {
    LAS bf16* Qs = (LAS bf16*)lds; LAS bf16* Ks = Qs + 128 * 72; LAS bf16* Vs = Ks + 128 * 72; LAS bf16* Sf = Vs + 128 * 144; LAS bf16* Sb = Sf + 128 * 72;
    const bf16* Z = (const bf16*)(wsb() + WS_Z); const float* KV = (const float*)(wsb() + WS_KV); const f32x2* rope = (const f32x2*)(wsb() + WS_ROPE);
    bf16* YS = (bf16*)(wsb() + WS_YS) + (size_t)MT * 1024;
    const int lane = tid & 63, w = tid >> 6, g = lane >> 4, li = lane & 15;
    const int tok = tid >> 2, pp = tid & 3, a = (pp & 1) + ((pp >> 1) << 2);
    const int nunits = 1024 + nctx_units;
    v4u pk[2], pv[4];
#define R3_LOAD(uid_) do { R1_DEC(uid_, b2, h2, n2, ci2, m02, isc2) (void)n2; (void)isc2; const bf16* qr = Z + (m02 + tok) * INW + C_RQ + h2 * 64; const bf16* kr = Z + (m02 + tok) * INW + C_RK + h2 * 64; \
        (void)qr; pk[0] = *(const v4u*)(kr + 8 * a); pk[1] = *(const v4u*)(kr + 8 * a + 16); \
        (void)ci2; _Pragma("unroll") for (int e = 0; e < 4; ++e) { const int q = tid + 512 * e; pv[e] = *(const v4u*)(Z + (m02 + (q >> 4)) * INW + C_RV + h2 * 128 + (q & 15) * 8); } } while (0)
    int uid = blockIdx.x;
    if (uid < nunits) R3_LOAD(uid);
    for (; uid < nunits; uid += gridDim.x) {
        R1_DEC(uid, b, h, n, ci, m0, isc)
        const float lgf = inp(I_RDEC)[(l * 2 + 0) * 8 + h] * LOG2E, lgb = inp(I_RDEC)[(l * 2 + 1) * 8 + h] * LOG2E;
        __syncthreads();
        { const int t = n * 128 + tok; const int pos = (a < 4) ? (t >> 6) : (t & 63); const f32x2* rt = rope + pos * 16 + 8 * (a & 1);
            float lo[8], hi[8];
            { const bf16* qr = Z + (m0 + tok) * INW + C_RQ + h * 64; unpack8(*(const v4u*)(qr + 8 * a), lo); unpack8(*(const v4u*)(qr + 8 * a + 16), hi); }
            if (!isc) rope8(lo, hi, rt);
            *(LAS v4u*)(Qs + tok * 72 + 8 * a) = pack8(lo); *(LAS v4u*)(Qs + tok * 72 + 8 * a + 16) = pack8(hi);
            unpack8(pk[0], lo); unpack8(pk[1], hi);
            if (!isc) rope8(lo, hi, rt);
#pragma unroll
            for (int e = 0; e < 8; ++e) { lo[e] *= 0.125f; hi[e] *= 0.125f; }
            *(LAS v4u*)(Ks + tok * 72 + 8 * a) = pack8(lo); *(LAS v4u*)(Ks + tok * 72 + 8 * a + 16) = pack8(hi); }
#pragma unroll
        for (int e = 0; e < 4; ++e) { const int q = tid + 512 * e; *(LAS v4u*)(Vs + (q >> 4) * 144 + (q & 15) * 8) = pv[e]; }
#pragma unroll
        for (int dir = 0; dir < 2; ++dir) { LAS bf16* S = dir ? Sb : Sf; const f32x4* src = (const f32x4*)(KV + ((size_t)((b * 8 + h) * 2 + dir) * 34 + ci) * 8192);
#pragma unroll
            for (int e = 0; e < 4; ++e) { const int q = tid + 512 * e; const f32x4 v = src[q]; v2u wv; wv.x = pk2(v.x, v.y); wv.y = pk2(v.z, v.w); *(LAS v2u*)(S + (q >> 4) * 72 + (q & 15) * 4) = wv; } }
        __syncthreads();
        if (uid + (int)gridDim.x < nunits) R3_LOAD(uid + (int)gridDim.x);
        const int iq = 16 * w + li; const size_t mrow = m0 + iq;
        v2u gq[8];
#pragma unroll
        for (int nd = 0; nd < 8; ++nd) gq[nd] = *(const v2u*)(Z + mrow * INW + C_RG + h * 128 + 16 * nd + 4 * g);
        bf16x8 qf[2];
#pragma unroll
        for (int ks = 0; ks < 2; ++ks) qf[ks] = *(const LAS bf16x8*)(Qs + iq * 72 + 32 * ks + 8 * g);
        f32x4 s[8];
#pragma unroll
        for (int nn = 0; nn < 8; ++nn) { s[nn] = (f32x4){0.f, 0.f, 0.f, 0.f};
#pragma unroll
            for (int ks = 0; ks < 2; ++ks) s[nn] = mfma16(*(const LAS bf16x8*)(Ks + (16 * nn + li) * 72 + 32 * ks + 8 * g), qf[ks], s[nn]);
#pragma unroll
            for (int j = 0; j < 4; ++j) { const int d = iq - (16 * nn + 4 * g + j); s[nn][j] *= (d >= 0) ? ex2(lgf * (float)d) : ex2(lgb * (float)(-d)); } }
        f32x4 o[8];
#pragma unroll
        for (int nd = 0; nd < 8; ++nd) o[nd] = (f32x4){0.f, 0.f, 0.f, 0.f};
#pragma unroll
        for (int kk = 0; kk < 4; ++kk) {
            const bf16x8 pf = mk8(pk2(s[2 * kk][0], s[2 * kk][1]), pk2(s[2 * kk][2], s[2 * kk][3]), pk2(s[2 * kk + 1][0], s[2 * kk + 1][1]), pk2(s[2 * kk + 1][2], s[2 * kk + 1][3]));
#pragma unroll
            for (int nd = 0; nd < 8; ++nd) o[nd] = mfma16(tr_frag(Vs, 144, 32 * kk + 4 * g, 32 * kk + 16 + 4 * g, 16 * nd, li), pf, o[nd]); }
        const float xif = ex2(lgf * (float)(iq + 1)), xib = ex2(lgb * (float)(128 - iq));
        float ss = 0.f;
#pragma unroll
        for (int nd = 0; nd < 8; ++nd) { f32x4 tf = (f32x4){0.f, 0.f, 0.f, 0.f}, tb = (f32x4){0.f, 0.f, 0.f, 0.f};
#pragma unroll
            for (int ks = 0; ks < 2; ++ks) { tf = mfma16(*(const LAS bf16x8*)(Sf + (16 * nd + li) * 72 + 32 * ks + 8 * g), qf[ks], tf);
                tb = mfma16(*(const LAS bf16x8*)(Sb + (16 * nd + li) * 72 + 32 * ks + 8 * g), qf[ks], tb); }
            o[nd] = o[nd] + tf * xif + tb * xib;
            ss += (o[nd][0] * o[nd][0] + o[nd][1] * o[nd][1]) + (o[nd][2] * o[nd][2] + o[nd][3] * o[nd][3]); }
        ss += __shfl_xor(ss, 16); ss += __shfl_xor(ss, 32);
        const float rn = 1.0f / sqrtf(ss * (1.0f / 128.0f) + EPS);
#pragma unroll
        for (int nd = 0; nd < 8; ++nd) { const int dv = 16 * nd + 4 * g; const v2u gv = gq[nd];
            const float g0 = bflo(gv.x), g1 = bfhi(gv.x), g2 = bflo(gv.y), g3 = bfhi(gv.y);
            v2u wv; wv.x = pk2(g0 * __builtin_amdgcn_rcpf(1.0f + __expf(-g0)) * o[nd][0] * rn, g1 * __builtin_amdgcn_rcpf(1.0f + __expf(-g1)) * o[nd][1] * rn);
            wv.y = pk2(g2 * __builtin_amdgcn_rcpf(1.0f + __expf(-g2)) * o[nd][2] * rn, g3 * __builtin_amdgcn_rcpf(1.0f + __expf(-g3)) * o[nd][3] * rn);
            *(v2u*)(YS + mrow * 1024 + h * 128 + dv) = wv; }
    }
#undef R3_LOAD
#undef R1_DEC
}

__device__ __forceinline__ float gelu_fx(float x) { const float x2 = x * x; const float arg = x * (x2 * (-2.0f * 1.4426950408889634f * 0.7978845608028654f * 0.044715f) + (-2.0f * 1.4426950408889634f * 0.7978845608028654f));
    return x * __builtin_amdgcn_rcpf(1.0f + __builtin_amdgcn_exp2f(arg)); }
__device__ __forceinline__ void ph_ffnfix(const Args& A, int l, int Mrows, int tid) {
    const bf16* SA = (const bf16*)(wsb() + WS_SA); const bf16* SB = (const bf16*)(wsb() + WS_SB); bf16* U = (bf16*)(wsb() + WS_U);
    const float* cw = inp(I_FFCW) + (size_t)l * 3 * DFF; const float* cb = inp(I_FFCB) + (size_t)l * DFF;
    const int nblk = Mrows / 64;
    for (int u = blockIdx.x; u < nblk * 2; u += gridDim.x) {
        const int blk = u >> 1, hi = u & 1, R = blk * 64 + (hi ? 63 : 0);
        const bool seq_first = (R < ML) ? ((R & (SEQ - 1)) == 0) : ((R & (CL - 1)) == 0), seq_last = (R < ML) ? ((R & (SEQ - 1)) == SEQ - 1) : ((R & (CL - 1)) == CL - 1);
        const bf16* pprev = hi ? SA + ((size_t)blk * 4 + 2) * DFF : SA + ((size_t)(blk - 1) * 4 + 3) * DFF;
        const bf16* pcur = SA + ((size_t)blk * 4 + (hi ? 3 : 0)) * DFF;
        const bf16* pnext = hi ? SA + ((size_t)(blk + 1) * 4 + 0) * DFF : SA + ((size_t)blk * 4 + 1) * DFF;
        const bf16* pb = SB + ((size_t)blk * 2 + hi) * DFF;
        const bool zp = (!hi && seq_first), zn = (hi && seq_last);
        for (int q = tid; q < DFF / 8; q += 512) { const int f = q * 8;
            float am[8], a0[8], aq[8], bg[8]; const v4u z4 = (v4u){0u, 0u, 0u, 0u};
            unpack8(zp ? z4 : *(const v4u*)(pprev + f), am); unpack8(*(const v4u*)(pcur + f), a0); unpack8(zn ? z4 : *(const v4u*)(pnext + f), aq); unpack8(*(const v4u*)(pb + f), bg);
            float r[8];
#pragma unroll
            for (int e = 0; e < 8; ++e) r[e] = gelu_fx(cw[f + e] * am[e] + cw[DFF + f + e] * a0[e] + cw[2 * DFF + f + e] * aq[e] + cb[f + e]) * bg[e];
            *(v4u*)(U + (size_t)R * DFF + f) = pack8(r); }
    }
}
__device__ __forceinline__ void ph_final(const Args& A, int wave, int lane) {
    const int gw = blockIdx.x * NWAVES + wave, NGW = gridDim.x * NWAVES; const float* g = inp(I_GF);
    for (int m = gw; m < ML; m += NGW) { float* xr = outb() + (size_t)m * D; f32x4 v[8]; float ss = 0.f;
#pragma unroll
        for (int j = 0; j < 8; ++j) { v[j] = *(const f32x4*)(xr + (lane + 64 * j) * 4); ss += (v[j].x * v[j].x + v[j].y * v[j].y) + (v[j].z * v[j].z + v[j].w * v[j].w); }
        const float rstd = 1.0f / sqrtf(wave_sum(ss) * (1.0f / D) + EPS);
#pragma unroll
        for (int j = 0; j < 8; ++j) { const int idx = (lane + 64 * j) * 4; *(f32x4*)(xr + idx) = v[j] * rstd * *(const f32x4*)(g + idx); }
    }
}
#ifndef SKEW_US
#define SKEW_US 0
#endif
__device__ __forceinline__ void spin_us(int us) { if (us > 0) { const unsigned long long t0 = __builtin_amdgcn_s_memrealtime(); while (__builtin_amdgcn_s_memrealtime() - t0 < (unsigned long long)us * 100ull) __builtin_amdgcn_s_sleep(8); } }
constexpr int FILT_F = 816, FILT_I = 896;
constexpr int BG_SPLIT = 22016;
constexpr int SEQ_PER_LAYER = 11, NSEQ = 1 + DEPTH * SEQ_PER_LAYER + 1;
__global__ void __launch_bounds__(NWAVES * 64, 2) fwd(Args A) {
    extern __shared__ __attribute__((aligned(16))) unsigned char lds_raw[];
    LAS unsigned char* lds = (LAS unsigned char*)lds_raw;
    volatile LAS unsigned* MISC = (volatile LAS unsigned*)(lds + MISC_OFF);
    for (int u = threadIdx.x; u < (LDS_BYTES - LDSCTL_OFF) / 4; u += NWAVES * 64) ((LAS unsigned*)(lds + LDSCTL_OFF))[u] = 0u;
    __syncthreads();
    (void)xcd_barrier_post((unsigned*)(wsb() + WS_CTL) + CW_BAR, MISC + 8);
    const int lo = A.seq_lo, hi = A.seq_hi;
#ifdef PROBE_K
    unsigned long long pr_acc = 0ull, pr_prev = __builtin_amdgcn_s_memrealtime();
#endif
#define G ((int)gridDim.x)
#ifdef PROBE_SUB
#define PROBE_K 999
#define SUBT(n, stmt) do { unsigned long long t0_ = 0; if ((n) == PROBE_SUB && blockIdx.x == PROBE_WG && threadIdx.x == 0) t0_ = __builtin_amdgcn_s_memrealtime(); stmt; if ((n) == PROBE_SUB && blockIdx.x == PROBE_WG && threadIdx.x == 0) pr_acc += __builtin_amdgcn_s_memrealtime() - t0_; } while (0)
#else
#define SUBT(n, stmt) do { stmt; } while (0)
#endif
#ifdef PROBE_K
#ifndef PROBE_WG
#define PROBE_WG 0
#endif
#ifndef PROBE_WAIT
#define PROBE_WAIT 0
#endif
#define PROBE_PH(s) (((s) == 0) ? 100 : (((s) - 1) % SEQ_PER_LAYER))
#define PROBE_ARRIVE(s) do { if (blockIdx.x == PROBE_WG && threadIdx.x == 0) { const unsigned long long now_ = __builtin_amdgcn_s_memrealtime(); if (!PROBE_WAIT && PROBE_PH(s) == PROBE_K) pr_acc += now_ - pr_prev; pr_prev = now_; } } while (0)
#define PROBE_EXIT(s) do { if (blockIdx.x == PROBE_WG && threadIdx.x == 0) { const unsigned long long now_ = __builtin_amdgcn_s_memrealtime(); if (PROBE_WAIT && PROBE_PH(s) == PROBE_K) pr_acc += now_ - pr_prev; pr_prev = now_; } } while (0)
#else
#define PROBE_ARRIVE(s) do { } while (0)
#define PROBE_EXIT(s) do { } while (0)
#endif
#define RUN(s) (lo <= (s) && (s) < hi)
#ifndef DUP
#define DUP 0
#endif
#define DUPN(id) ((((DUP) >> (id)) & 1) ? 2 : 1)
#define TID_HERE const int tid = otid(), lane = tid & 63, wave = __builtin_amdgcn_readfirstlane(tid >> 6); (void)lane; (void)wave
#ifdef ONLY
#define PH_ON(k) ((k) == ONLY)
#elif defined(SKIP)
#define PH_ON(k) ((k) != SKIP)
#else
#define PH_ON(k) true
#endif
#define SEAM(s) do { PROBE_ARRIVE(s); if (RUN((s) + 1)) { XcdBarrier bar_; bar_.bar = (unsigned*)(wsb() + WS_CTL) + CW_BAR; bar_.x = xb_xcc_id(); bar_.st = (volatile LAS unsigned*)(lds + MISC_OFF) + 8; xcd_barrier(bar_); if (DUPN(16) > 1) xcd_barrier(bar_); } PROBE_EXIT(s); } while (0)
#define H ((bf16*)(wsb() + WS_H))
#define Z ((bf16*)(wsb() + WS_Z))
#define ACC ((bf16*)(wsb() + WS_ACC))
#define U ((bf16*)(wsb() + WS_U))
#define YS ((bf16*)(wsb() + WS_YS))
#define XC ((float*)(wsb() + WS_XC))
#define WIN ((const bf16*)(psb(l & 1) + PS_WIN))
#define WBR ((const bf16*)(psb(l & 1) + PS_WBR))
#define WOUT ((const bf16*)(psb(l & 1) + PS_WOUT))
#define WF1 ((const bf16*)(psb(l & 1) + PS_WF1))
#define WF2 ((const bf16*)(psb(l & 1) + PS_WF2))

    if (PH_ON(100) && RUN(0)) { TID_HERE; ph_prologue(A, lds, tid); __syncthreads(); ph_convert(A, 0, 0, 0, CONV_ITEMS, (int)blockIdx.x, G, lds, wave, lane); __syncthreads(); for (int fl = 0; fl < DEPTH; ++fl) ph_filt1(A, fl, 0, (int)blockIdx.x, G, lds, tid); SEAM(0); }

    for (int l = 0; l < DEPTH; ++l) {
        const int sb = 1 + l * SEQ_PER_LAYER;
        if (hi <= sb || lo >= sb + SEQ_PER_LAYER) continue;
        const bool lastl = (l == DEPTH - 1);
        const int Mrows = lastl ? ML : MT, nctx = lastl ? 0 : 64;
#define modl ((const float*)(wsb() + WS_MOD) + (size_t)l * 5 * 12288)
#define xlat_in ((l == 0) ? inp(I_X) : (const float*)outb())
#define xctx_in ((l == 0) ? inp(I_CTX) : (const float*)XC)

        if (PH_ON(0) && RUN(sb + 0)) { TID_HERE;
            if (l == 0) ph_filt2(A, 0, 0, 0, 1024, (int)blockIdx.x, G, lds, tid);
            else ph_convert(A, l, l & 1, 0, CONV_ITEMS, (int)blockIdx.x, G, lds, wave, lane);
            ph_norm(xlat_in, xctx_in, inp(I_G1) + (size_t)l * D, modl, 0, D, H, MT, (l > 0) ? (const float*)(wsb() + WS_SLAB) : (const float*)nullptr,
                    (const float*)(wsb() + WS_MOD) + ((size_t)(l - 1) * 5 + 4) * 12288 + 5 * D, XC, wave, lane);
            SEAM(sb + 0);
        }
        if (PH_ON(1) && RUN(sb + 1)) { TID_HERE;
            if (SKEW_US > 0 && (blockIdx.x & 8)) spin_us(SKEW_US);
            { pg8::Gemm g{H, WIN, opq(MT), opq(INW), opq(D), 0}; pg8::StaticOrder S; S.init(g.M, g.N, G, (int)blockIdx.x);
              pg8::EpiStore E{Z, INW};
              for (int r_ = 0; r_ < DUPN(15); ++r_) pg8::gemm_phase<pg8::EpiStore, pg8::StaticOrder, PG8_ALIGN, PG8_SP2>(lds, g, S, E); }
            SEAM(sb + 1);
        }
        if (PH_ON(2) && RUN(sb + 2)) { TID_HERE;
            SUBT(1, ph_hyprep(A, l, lds, tid));
            SUBT(2, ph_ret1(A, l, 64, lds, tid));
            SUBT(3, ph_natt(A, l, 0, lds, tid));
            SUBT(4, if (!lastl) ph_hyctx(A, l, lds, tid));
            SEAM(sb + 2);
        }
        if (PH_ON(3) && RUN(sb + 3)) { TID_HERE;
#ifndef NO_D1
            SUBT(5, ph_hyfft(A, l, lds, tid));
#endif
#ifndef NO_D2
            SUBT(6, ph_scan(A, l, tid));
#endif
            SEAM(sb + 3);
        }
        if (PH_ON(4) && RUN(sb + 4)) { TID_HERE;
            SUBT(7, ph_hypost(A, lds, tid));
            SUBT(8, ph_ret3(A, l, nctx, lds, tid));
            if (!lastl) { __syncthreads(); ph_natt(A, l, 1, lds, tid); }
            SEAM(sb + 4);
        }
        if (PH_ON(5) && RUN(sb + 5)) { TID_HERE;
            __syncthreads();
            for (int r_ = 0; r_ < DUPN(13); ++r_)
            for (int i = 0; i < 3; ++i) {
                pg8::Gemm g{YS + (size_t)i * MT * 1024, WBR + (size_t)i * D * 1024, Mrows, opq(D), opq(1024), 0}; pg8::StaticOrder S; S.init(g.M, g.N, G, (int)blockIdx.x);
                pg8::EpiMerge E{ACC, Z + C_GT + i * D, INW, i == 0 ? 1 : 0};
                pg8::gemm_phase<pg8::EpiMerge, pg8::StaticOrder, PG8_ALIGN, PG8_SP2>(lds, g, S, E);
            }
            if (!lastl && blockIdx.x >= 32) { __syncthreads(); ph_filt2(A, l + 1, (l + 1) & 1, 0, FILT_F, (int)blockIdx.x - 32, G - 32, lds, tid); }
            SEAM(sb + 5);
        }
        if (PH_ON(6) && RUN(sb + 6)) { TID_HERE;
            __syncthreads();
            { pg8::Gemm g{ACC, WOUT, opq(ML), opq(D), opq(D), 0}; pg8::StaticOrder S; S.init(g.M, g.N, G, (int)blockIdx.x);
              pg8::EpiResid E{xlat_in, xctx_in, outb(), XC, modl, 2 * D};
              pg8::gemm_phase<pg8::EpiResid, pg8::StaticOrder, PG8_ALIGN, PG8_SP2>(lds, g, S, E); }
            if (!lastl) { pg8::Gemm g{ACC, WOUT, opq(MT), opq(D), opq(D / NSPLIT), opq(D)}; pg8::CtxSplitOrder S{NSPLIT, D / NSPLIT, (int)blockIdx.x};
              pg8::EpiSlab E{(float*)(wsb() + WS_SLAB), D / NSPLIT};
              pg8::gemm_phase<pg8::EpiSlab, pg8::CtxSplitOrder, PG8_ALIGN, PG8_SP2>(lds, g, S, E); }
            SEAM(sb + 6);
        }
        if (PH_ON(7) && RUN(sb + 7)) { TID_HERE;
            ph_norm(outb(), xctx_in, inp(I_G2) + (size_t)l * D, modl, 3 * D, 4 * D, H, Mrows, (const float*)(wsb() + WS_SLAB), modl + (size_t)4 * 12288 + 2 * D, XC, wave, lane);
            SEAM(sb + 7);
        }
        if (PH_ON(8) && RUN(sb + 8)) { TID_HERE;
            __syncthreads();
            if (SKEW_US > 0 && (blockIdx.x & 8)) spin_us(SKEW_US);
            pg8::Gemm g{H, WF1, Mrows, opq(NFF), opq(D), 0}; pg8::StaticOrder S; S.init(g.M, g.N, G, (int)blockIdx.x);
            pg8::EpiFfn E{U, (bf16*)(wsb() + WS_SA), (bf16*)(wsb() + WS_SB), inp(I_FFCW) + (size_t)l * 3 * DFF, inp(I_FFCB) + (size_t)l * DFF};
            for (int r_ = 0; r_ < DUPN(14); ++r_) pg8::gemm_phase<pg8::EpiFfn, pg8::StaticOrder, PG8_ALIGN, PG8_SP2>(lds, g, S, E);
            if (!lastl && blockIdx.x >= 176) { __syncthreads(); ph_filt2(A, l + 1, (l + 1) & 1, FILT_F, FILT_I, (int)blockIdx.x - 176, G - 176, lds, tid); }
            SEAM(sb + 8);
        }
        if (PH_ON(9) && RUN(sb + 9)) { TID_HERE;
            for (int r_ = 0; r_ < DUPN(11); ++r_) ph_ffnfix(A, l, Mrows, tid);
            SEAM(sb + 9);
        }
        if (PH_ON(10) && RUN(sb + 10)) { TID_HERE;
            __syncthreads();
            { pg8::Gemm g{U, WF2, opq(ML), opq(D), opq(DFF), 0}; pg8::StaticOrder S; S.init(g.M, g.N, G, (int)blockIdx.x);
              pg8::EpiResid E{outb(), XC, outb(), XC, modl, 5 * D};
              pg8::gemm_phase<pg8::EpiResid, pg8::StaticOrder, PG8_ALIGN, PG8_SP2>(lds, g, S, E); }
            if (!lastl) { pg8::Gemm g{U, WF2, opq(MT), opq(D), opq(DFF / NSPLIT), opq(DFF)}; pg8::CtxSplitOrder S{NSPLIT, DFF / NSPLIT, (int)blockIdx.x};
              pg8::EpiSlab E{(float*)(wsb() + WS_SLAB), DFF / NSPLIT};
              pg8::gemm_phase<pg8::EpiSlab, pg8::CtxSplitOrder, PG8_ALIGN, PG8_SP2>(lds, g, S, E); }
            if (!lastl && blockIdx.x >= 128) { __syncthreads(); ph_filt2(A, l + 1, (l + 1) & 1, FILT_I, 1024, (int)blockIdx.x - 128, G - 128, lds, tid); }
            SEAM(sb + 10);
        }
    }
    if (PH_ON(101) && RUN(NSEQ - 1)) { TID_HERE; ph_final(A, wave, lane); }
#ifdef PROBE_K
    if (blockIdx.x == PROBE_WG && threadIdx.x == 0) { const unsigned long long t0 = __builtin_amdgcn_s_memrealtime(); while (__builtin_amdgcn_s_memrealtime() - t0 < 4ull * pr_acc) __builtin_amdgcn_s_sleep(8); }
#endif
#undef RUN
#undef SEAM
#undef H
#undef Z
#undef ACC
#undef U
#undef YS
#undef XC
#undef WIN
#undef WBR
#undef WOUT
#undef WF1
#undef WF2
#undef G
#undef modl
#undef xlat_in
#undef xctx_in
}

extern "C" void kernel_launch(void* const* d_in, const int* in_sizes, int n_in, void* d_out, int out_size, void* d_ws, size_t ws_size, hipStream_t stream) {
    static int grid = 0;
    if (grid == 0) {
        if (n_in != 27 || out_size != ML * D || ws_size < WS_END) { fprintf(stderr, "kernel_launch: unexpected shapes (n_in %d out %d ws %zu need %zu)\n", n_in, out_size, ws_size, (size_t)WS_END); grid = -1; return; }
        int dev = 0, cus = 0, per_cu = 0;
        if (hipGetDevice(&dev) != hipSuccess || hipDeviceGetAttribute(&cus, hipDeviceAttributeMultiprocessorCount, dev) != hipSuccess) { grid = -1; return; }
        if (hipFuncSetAttribute((const void*)fwd, hipFuncAttributeMaxDynamicSharedMemorySize, LDS_BYTES) != hipSuccess) { fprintf(stderr, "kernel_launch: hipFuncSetAttribute failed\n"); grid = -1; return; }
        if (hipOccupancyMaxActiveBlocksPerMultiprocessor(&per_cu, (const void*)fwd, NWAVES * 64, LDS_BYTES) != hipSuccess || per_cu < 1) fprintf(stderr, "kernel_launch: occupancy query says %d\n", per_cu);
        (void)hipGetLastError();
        grid = cus;
    }
    if (grid < 0) return;
    (void)hipMemsetAsync((char*)d_ws + WS_CTL, 0, CTL_ZERO_BYTES, stream);
    Args a{};
    for (int i = 0; i < 27; ++i) a.in[i] = (const float*)d_in[i];
    a.out = (float*)d_out; a.ws = (unsigned char*)d_ws;
#if MK_SINGLE
    a.seq_lo = 0; a.seq_hi = NSEQ;
    hipLaunchKernelGGL(fwd, dim3(grid), dim3(NWAVES * 64), LDS_BYTES, stream, a);
#else
    for (int s = 0; s < NSEQ; ++s) { a.seq_lo = s; a.seq_hi = s + 1; hipLaunchKernelGGL(fwd, dim3(grid), dim3(NWAVES * 64), LDS_BYTES, stream, a); }
#endif
}
```

```cpp
#include <hip/hip_runtime.h>
#include <cstdio>
#include <cstdint>
#ifndef MK_SINGLE
#define MK_SINGLE 1
#endif
namespace pg8 {
#define PG8_LAS __attribute__((address_space(3)))
typedef unsigned short bf16_t;
typedef short bf16x8 __attribute__((ext_vector_type(8)));
typedef float f32x4 __attribute__((ext_vector_type(4)));
typedef unsigned u32x4 __attribute__((ext_vector_type(4)));
constexpr int BM = 256, BK = 64, HALF = 128, HTB = HALF * BK * 2  , STAGE_BYTES = 8 * HTB, NXCD = 8, WGM = 8;

__host__ __device__ __forceinline__ int lds_byte(int r, int c) { const int st = (r >> 4) * 2 + (c >> 5), rr = r & 15, cc = c & 31, ob = rr * 64 + cc * 2; return st * 1024 + (ob ^ (((ob >> 9) & 1) << 5)); }
__host__ __device__ __forceinline__ void stage_rc(int b, int& R, int& C) { const int st = b / 1024, sb = b % 1024, swz = sb ^ (((sb >> 9) & 1) << 5); R = (st >> 1) * 16 + swz / 64; C = (st & 1) * 32 + (swz % 64) / 2; }
__host__ __device__ __forceinline__ int perm32(int rho) { const int n = rho >> 4, i = rho & 15; return 8 * (i >> 2) + 4 * n + (i & 3); }

struct Unit { int pm, pn, ko; };
struct Gemm { const bf16_t* A; const bf16_t* Bt; int M, N, K, ld; };

struct StaticOrder {
    int nM, nN, nwg, G, c;
    __host__ __device__ void init(int M, int N, int G_, int c_) { nM = M / BM; nN = N / BM; nwg = nM * nN; G = G_; c = c_; }
    __host__ __device__ bool next(int i, Unit& u) const {
        const long L = (long)i * G + c; if (L >= nwg) return false;
        int wgid = (int)L; { const int q = nwg / NXCD, r = nwg % NXCD, xcd = wgid % NXCD, off = wgid / NXCD; wgid = (xcd < r ? xcd * (q + 1) : r * (q + 1) + (xcd - r) * q) + off; }
        const int nig = WGM * nN, gid = wgid / nig, fm = gid * WGM, gsz = (nM - fm) < WGM ? (nM - fm) : WGM;
        u.pm = fm + ((wgid % nig) % gsz); u.pn = (wgid % nig) / gsz; u.ko = 0; return true;
    }
    __device__ __forceinline__ void a_ready(const Unit&) const {}
    __device__ __forceinline__ void done(const Unit&) const {}
};
__device__ __forceinline__ unsigned cvt_pk_bf16(float lo, float hi) { unsigned r; asm volatile("v_cvt_pk_bf16_f32 %0, %1, %2" : "=v"(r) : "v"(lo), "v"(hi)); return r; }
typedef float f32x2 __attribute__((ext_vector_type(2)));
__device__ __forceinline__ float bflo(unsigned w) { return __uint_as_float(w << 16); }
__device__ __forceinline__ float bfhi(unsigned w) { return __uint_as_float(w & 0xffff0000u); }
__device__ __forceinline__ float sigm(float x) { return __builtin_amdgcn_rcpf(1.0f + __expf(-x)); }
struct EpiStore {
    static constexpr bool PERM = true, AFTER_DRAIN = false;
    bf16_t* O; int ldc;
    __device__ __forceinline__ void operator()(const f32x4 (&acc)[2][2][4][2], const Unit& u, int wr, int wc, int fr, int fq) const {
        const int row0 = u.pm * BM + wr * 64 + fr, col0 = u.pn * BM + wc * 32 + 8 * fq;
#pragma unroll
        for (int ai = 0; ai < 2; ++ai)
#pragma unroll
            for (int m = 0; m < 4; ++m) { bf16_t* rowp = O + (size_t)(row0 + ai * HALF + m * 16) * ldc + col0;
#pragma unroll
                for (int bj = 0; bj < 2; ++bj) { const f32x4 v0 = acc[ai][bj][m][0], v1 = acc[ai][bj][m][1];
                    u32x4 w; w.x = cvt_pk_bf16(v0[0], v0[1]); w.y = cvt_pk_bf16(v0[2], v0[3]); w.z = cvt_pk_bf16(v1[0], v1[1]); w.w = cvt_pk_bf16(v1[2], v1[3]);
                    __builtin_nontemporal_store(w, (u32x4*)(rowp + bj * HALF)); } }
    }
};
struct EpiMerge {
    static constexpr bool PERM = true, AFTER_DRAIN = false;
    bf16_t* O; const bf16_t* gate; int ldg; int first;
    __device__ __forceinline__ void operator()(const f32x4 (&acc)[2][2][4][2], const Unit& u, int wr, int wc, int fr, int fq) const {
        const int row0 = u.pm * BM + wr * 64 + fr, col0 = u.pn * BM + wc * 32 + 8 * fq;
#pragma unroll
        for (int ai = 0; ai < 2; ++ai)
#pragma unroll
            for (int m = 0; m < 4; ++m) { const size_t row = (size_t)(row0 + ai * HALF + m * 16);
#pragma unroll
                for (int bj = 0; bj < 2; ++bj) { const int col = col0 + bj * HALF;
                    const u32x4 gv = *(const u32x4*)(gate + row * ldg + col);
                    u32x4 pv = (u32x4){0u, 0u, 0u, 0u}; if (!first) pv = *(const u32x4*)(O + row * 2048 + col);
                    const f32x4 v0 = acc[ai][bj][m][0], v1 = acc[ai][bj][m][1];
                    u32x4 w;
                    w.x = cvt_pk_bf16(bflo(pv.x) + v0[0] * sigm(bflo(gv.x)), bfhi(pv.x) + v0[1] * sigm(bfhi(gv.x)));
                    w.y = cvt_pk_bf16(bflo(pv.y) + v0[2] * sigm(bflo(gv.y)), bfhi(pv.y) + v0[3] * sigm(bfhi(gv.y)));
                    w.z = cvt_pk_bf16(bflo(pv.z) + v1[0] * sigm(bflo(gv.z)), bfhi(pv.z) + v1[1] * sigm(bfhi(gv.z)));
                    w.w = cvt_pk_bf16(bflo(pv.w) + v1[2] * sigm(bflo(gv.w)), bfhi(pv.w) + v1[3] * sigm(bfhi(gv.w)));
                    *(u32x4*)(O + row * 2048 + col) = w; } }
    }
};
struct EpiResid {
    static constexpr bool PERM = false, AFTER_DRAIN = false;
    const float* base_lat; const float* base_ctx; float* out_lat; float* out_ctx; const float* modl; int goff;
    __device__ __forceinline__ void operator()(const f32x4 (&acc)[2][2][4][2], const Unit& u, int wr, int wc, int fr, int fq) const {
        const bool isctx = u.pm >= 64; const int r = isctx ? 4 : (u.pm >> 4);
        const float* gvp = modl + (size_t)r * 12288 + goff;
        const float* bs = isctx ? base_ctx : base_lat; float* os = isctx ? out_ctx : out_lat;
        const int row0 = (isctx ? u.pm - 64 : u.pm) * BM + wr * 64 + fr, col0 = u.pn * BM + wc * 32 + 4 * fq;
        f32x4 g4[2][2];
#pragma unroll
        for (int bj = 0; bj < 2; ++bj)
#pragma unroll
            for (int n = 0; n < 2; ++n) g4[bj][n] = *(const f32x4*)(gvp + col0 + bj * HALF + n * 16);
#pragma unroll
        for (int ai = 0; ai < 2; ++ai)
#pragma unroll
            for (int m = 0; m < 4; ++m) { const size_t off = (size_t)(row0 + ai * HALF + m * 16) * 2048 + col0;
#pragma unroll
                for (int bj = 0; bj < 2; ++bj)
#pragma unroll
                    for (int n = 0; n < 2; ++n) { const f32x4 b4 = *(const f32x4*)(bs + off + bj * HALF + n * 16);
                        *(f32x4*)(os + off + bj * HALF + n * 16) = b4 + g4[bj][n] * acc[ai][bj][m][n]; } }
    }
};

__device__ __forceinline__ float dpp_ror1(float v) { return __int_as_float(__builtin_amdgcn_update_dpp(0, __float_as_int(v), 0x121, 0xf, 0xf, false)); }
__device__ __forceinline__ float dpp_rol1(float v) { return __int_as_float(__builtin_amdgcn_update_dpp(0, __float_as_int(v), 0x12f, 0xf, 0xf, false)); }
__device__ __forceinline__ float gelu_fast(float x) { const float x2 = x * x; const float arg = x * (x2 * (-2.0f * 1.4426950408889634f * 0.7978845608028654f * 0.044715f) + (-2.0f * 1.4426950408889634f * 0.7978845608028654f));
    return x * __builtin_amdgcn_rcpf(1.0f + __builtin_amdgcn_exp2f(arg)); }
struct EpiFfn {
    static constexpr bool PERM = true, AFTER_DRAIN = false;
    bf16_t* U; bf16_t* SA; bf16_t* SB; const float* cw; const float* cb;
    __device__ __forceinline__ void operator()(const f32x4 (&acc)[2][2][4][2], const Unit& u, int wr, int wc, int fr, int fq) const {
        const int f0 = u.pn * 128 + wc * 32 + 8 * fq;
        f32x4 w0[2], w1[2], w2[2], bb[2];
#pragma unroll
        for (int n = 0; n < 2; ++n) { w0[n] = *(const f32x4*)(cw + f0 + 4 * n); w1[n] = *(const f32x4*)(cw + 5632 + f0 + 4 * n); w2[n] = *(const f32x4*)(cw + 2 * 5632 + f0 + 4 * n); bb[n] = *(const f32x4*)(cb + f0 + 4 * n); }
#pragma unroll
        for (int ai = 0; ai < 2; ++ai) {
            const int row0 = u.pm * BM + ai * HALF + wr * 64 + fr, blk = u.pm * 4 + ai * 2 + wr;
            f32x4 o[4][2];
#pragma unroll
            for (int n = 0; n < 2; ++n)
#pragma unroll
                for (int e = 0; e < 4; ++e) {
                    const float a0 = acc[ai][0][0][n][e], a1 = acc[ai][0][1][n][e], a2 = acc[ai][0][2][n][e], a3 = acc[ai][0][3][n][e];
                    const float r0 = dpp_ror1(a0), r1 = dpp_ror1(a1), r2 = dpp_ror1(a2), r3 = dpp_ror1(a3);
                    const float l0 = dpp_rol1(a0), l1 = dpp_rol1(a1), l2 = dpp_rol1(a2), l3 = dpp_rol1(a3);
                    const bool first = (fr == 0), last = (fr == 15);
                    const float p0 = r0, p1 = first ? r0 : r1, p2 = first ? r1 : r2, p3 = first ? r2 : r3;
                    const float n0 = last ? l1 : l0, n1 = last ? l2 : l1, n2 = last ? l3 : l2, n3 = l3;
                    const float k0 = w0[n][e], k1 = w1[n][e], k2 = w2[n][e], kb = bb[n][e];
                    o[0][n][e] = gelu_fast(k0 * p0 + k1 * a0 + k2 * n0 + kb) * acc[ai][1][0][n][e];
                    o[1][n][e] = gelu_fast(k0 * p1 + k1 * a1 + k2 * n1 + kb) * acc[ai][1][1][n][e];
                    o[2][n][e] = gelu_fast(k0 * p2 + k1 * a2 + k2 * n2 + kb) * acc[ai][1][2][n][e];
                    o[3][n][e] = gelu_fast(k0 * p3 + k1 * a3 + k2 * n3 + kb) * acc[ai][1][3][n][e];
                }
#pragma unroll
            for (int m = 0; m < 4; ++m) { u32x4 w; w.x = cvt_pk_bf16(o[m][0][0], o[m][0][1]); w.y = cvt_pk_bf16(o[m][0][2], o[m][0][3]); w.z = cvt_pk_bf16(o[m][1][0], o[m][1][1]); w.w = cvt_pk_bf16(o[m][1][2], o[m][1][3]);
                *(u32x4*)(U + (size_t)(row0 + m * 16) * 5632 + f0) = w; }
            const int sel = (fr == 0) ? 0 : (fr == 1) ? 1 : (fr == 14) ? 2 : (fr == 15) ? 3 : -1;
            if (sel >= 0) { const int m = (sel < 2) ? 0 : 3;
                const f32x4 a0 = (m == 0) ? acc[ai][0][0][0] : acc[ai][0][3][0], a1 = (m == 0) ? acc[ai][0][0][1] : acc[ai][0][3][1];
                u32x4 w; w.x = cvt_pk_bf16(a0[0], a0[1]); w.y = cvt_pk_bf16(a0[2], a0[3]); w.z = cvt_pk_bf16(a1[0], a1[1]); w.w = cvt_pk_bf16(a1[2], a1[3]);
                *(u32x4*)(SA + ((size_t)blk * 4 + sel) * 5632 + f0) = w;
                if (sel == 0 || sel == 3) { const f32x4 b0 = (m == 0) ? acc[ai][1][0][0] : acc[ai][1][3][0], b1 = (m == 0) ? acc[ai][1][0][1] : acc[ai][1][3][1];
                    u32x4 v; v.x = cvt_pk_bf16(b0[0], b0[1]); v.y = cvt_pk_bf16(b0[2], b0[3]); v.z = cvt_pk_bf16(b1[0], b1[1]); v.w = cvt_pk_bf16(b1[2], b1[3]);
                    *(u32x4*)(SB + ((size_t)blk * 2 + (sel == 0 ? 0 : 1)) * 5632 + f0) = v; } }
        }
    }
};

struct CtxSplitOrder {
    int nsplit, klen, c;
    __device__ __forceinline__ bool next(int i, Unit& u) const { if (i > 0 || c >= 32 * nsplit) return false; const int tile = c / nsplit, s = c - tile * nsplit; u.pm = 64 + (tile >> 3); u.pn = tile & 7; u.ko = s * klen; return true; }
    __device__ __forceinline__ void a_ready(const Unit&) const {}
    __device__ __forceinline__ void done(const Unit&) const {}
};
struct EpiSlab {
    static constexpr bool PERM = false, AFTER_DRAIN = false;
    float* slab; int klen;
    __device__ __forceinline__ void operator()(const f32x4 (&acc)[2][2][4][2], const Unit& u, int wr, int wc, int fr, int fq) const {
        float* os = slab + (size_t)(u.ko / klen) * 1024 * 2048;
        const int row0 = (u.pm - 64) * BM + wr * 64 + fr, col0 = u.pn * BM + wc * 32 + 4 * fq;
#pragma unroll
        for (int ai = 0; ai < 2; ++ai)
#pragma unroll
            for (int m = 0; m < 4; ++m) { const size_t off = (size_t)(row0 + ai * HALF + m * 16) * 2048 + col0;
#pragma unroll
                for (int bj = 0; bj < 2; ++bj)
#pragma unroll
                    for (int n = 0; n < 2; ++n) *(f32x4*)(os + off + bj * HALF + n * 16) = acc[ai][bj][m][n]; }
    }
};
template <class Epi, class Sched, bool ALIGN_EPI = false, bool SP2 = false>
__device__ __forceinline__ void gemm_phase(PG8_LAS unsigned char* lds, const Gemm g, const Sched& S, const Epi& E) {
    int tid_ = threadIdx.x; asm volatile("" : "+v"(tid_)); const int tid = tid_, wid = __builtin_amdgcn_readfirstlane(tid >> 6), lane = tid & 63, wr = wid >> 2, wc = wid & 3, fr = lane & 15, fq = lane >> 4;
    const int K = g.K, nt = K / BK, LD = g.ld ? g.ld : g.K;
    unsigned voffA[2], voffB[2];
#pragma unroll
    for (int i = 0; i < 2; ++i) { int R, C; stage_rc(tid * 16 + i * 8192, R, C); const int Rb = Epi::PERM ? ((R & ~31) + perm32(R & 31)) : R;
        voffA[i] = (unsigned)(R * LD + C) * 2u; voffB[i] = (unsigned)(Rb * LD + C) * 2u; }
    const size_t kstep = (size_t)(BK * 2);
    const size_t hstep = (size_t)HALF * LD * 2;
    const size_t tstep = 2 * hstep;
    const unsigned ldsw = (unsigned)wid * 1024u;
    const int aoff = lds_byte(wr * 64 + fr, fq * 8), boff = lds_byte(wc * 32 + fr, fq * 8);
#define PG8_SA(b, h) (((b) * 2 + (h)) * HTB)
#define PG8_SB(b, h) ((4 + (b) * 2 + (h)) * HTB)
#define PG8_STAGE(bufoff, gbase, voff) do { _Pragma("unroll") for (int _i = 0; _i < 2; ++_i) \
        __builtin_amdgcn_global_load_lds((const unsigned*)((const char*)(gbase) + (voff)[_i]), (PG8_LAS unsigned*)(lds + (bufoff) + ldsw + _i * 8192), 16, 0, 0); } while (0)
#define PG8_LDA(dst, b, h) do { _Pragma("unroll") for (int m = 0; m < 4; ++m) _Pragma("unroll") for (int k = 0; k < 2; ++k) dst[m][k] = *(const PG8_LAS bf16x8*)(lds + PG8_SA(b, h) + aoff + m * 2048 + k * 1024); } while (0)
#define PG8_LDB(dst, b, h) do { _Pragma("unroll") for (int n = 0; n < 2; ++n) _Pragma("unroll") for (int k = 0; k < 2; ++k) dst[n][k] = *(const PG8_LAS bf16x8*)(lds + PG8_SB(b, h) + boff + n * 2048 + k * 1024); } while (0)
#define PG8_MMA(ai, bj, At, Bt) do { __builtin_amdgcn_s_setprio(1); _Pragma("unroll") for (int m = 0; m < 4; ++m) _Pragma("unroll") for (int n = 0; n < 2; ++n) _Pragma("unroll") for (int k = 0; k < 2; ++k) \
        acc[ai][bj][m][n] = __builtin_amdgcn_mfma_f32_16x16x32_bf16(Bt[n][k], At[m][k], acc[ai][bj][m][n], 0, 0, 0); __builtin_amdgcn_s_setprio(0); } while (0)
#define PG8_WAIT_V(n) asm volatile("s_waitcnt vmcnt(" #n ")" ::: "memory")
#define PG8_WAIT_L(n) asm volatile("s_waitcnt lgkmcnt(" #n ")" ::: "memory")
#define PG8_BAR __builtin_amdgcn_s_barrier()
#define PG8_SCHED __builtin_amdgcn_sched_barrier(0)
    Unit cur, nxt; int ui = 0;
    if (!S.next(0, cur)) return;
    f32x4 acc[2][2][4][2];
#pragma unroll
    for (int a = 0; a < 2; ++a)
#pragma unroll
        for (int b = 0; b < 2; ++b)
#pragma unroll
            for (int m = 0; m < 4; ++m)
#pragma unroll
                for (int n = 0; n < 2; ++n) acc[a][b][m][n] = (f32x4){0.f, 0.f, 0.f, 0.f};
    bf16x8 At[4][2], B0[2][2], B1[2][2];
    const char* cA = (const char*)g.A + (size_t)cur.pm * tstep + (size_t)cur.ko * 2; const char* cB = (const char*)g.Bt + (size_t)cur.pn * tstep + (size_t)cur.ko * 2;
    S.a_ready(cur);
    if constexpr (SP2) {
        PG8_STAGE(PG8_SB(0, 0), cB, voffB); PG8_STAGE(PG8_SB(0, 1), cB + hstep, voffB); PG8_STAGE(PG8_SA(0, 0), cA, voffA); PG8_STAGE(PG8_SA(0, 1), cA + hstep, voffA);
        if (wr == 1) PG8_BAR;
        PG8_WAIT_V(2); PG8_BAR;
        PG8_STAGE(PG8_SB(1, 0), cB + kstep, voffB); PG8_STAGE(PG8_SA(1, 0), cA + kstep, voffA); PG8_STAGE(PG8_SB(1, 1), cB + hstep + kstep, voffB);
        PG8_WAIT_V(6); PG8_BAR;
    } else {
        PG8_STAGE(PG8_SB(0, 0), cB, voffB); PG8_STAGE(PG8_SA(0, 0), cA, voffA); PG8_STAGE(PG8_SB(0, 1), cB + hstep, voffB); PG8_STAGE(PG8_SA(0, 1), cA + hstep, voffA);
        if (wr == 1) PG8_BAR;
        PG8_WAIT_V(4); PG8_BAR;
        PG8_STAGE(PG8_SB(1, 0), cB + kstep, voffB); PG8_STAGE(PG8_SA(1, 0), cA + kstep, voffA); PG8_STAGE(PG8_SB(1, 1), cB + hstep + kstep, voffB);
        PG8_WAIT_V(6); PG8_BAR;
    }
    for (;;) {
        const bool has_next = S.next(ui + 1, nxt);
        const char* nA = has_next ? (const char*)g.A + (size_t)nxt.pm * tstep + (size_t)nxt.ko * 2 : cA; const char* nB = has_next ? (const char*)g.Bt + (size_t)nxt.pn * tstep + (size_t)nxt.ko * 2 : cB;
        for (int t = 0; t < nt; t += 2) {
            const bool last = (t == nt - 2);
            const char* a1 = cA + (size_t)(t + 1) * kstep;
            const char* a2 = last ? nA : cA + (size_t)(t + 2) * kstep; const char* b2 = last ? nB : cB + (size_t)(t + 2) * kstep;
            const char* a3 = a2 + kstep; const char* b3 = b2 + kstep;
            if (last && has_next) S.a_ready(nxt);
            if constexpr (SP2) {
            PG8_LDB(B0, 0, 0); PG8_LDB(B1, 0, 1); PG8_SCHED; PG8_LDA(At, 0, 0); PG8_STAGE(PG8_SA(1, 1), a1 + hstep, voffA);
            PG8_WAIT_V(8); PG8_WAIT_L(0); PG8_BAR; PG8_MMA(0, 0, At, B0); PG8_MMA(0, 1, At, B1); PG8_BAR; PG8_SCHED;
            PG8_LDA(At, 0, 1); PG8_STAGE(PG8_SB(0, 0), b2, voffB); PG8_STAGE(PG8_SB(0, 1), b2 + hstep, voffB); PG8_STAGE(PG8_SA(0, 0), a2, voffA);
            PG8_WAIT_V(8); PG8_WAIT_L(0); PG8_BAR; PG8_MMA(1, 0, At, B0); PG8_MMA(1, 1, At, B1); PG8_BAR; PG8_SCHED;
            PG8_LDB(B0, 1, 0); PG8_LDB(B1, 1, 1); PG8_SCHED; PG8_LDA(At, 1, 0); PG8_STAGE(PG8_SA(0, 1), a2 + hstep, voffA);
            PG8_WAIT_V(8); PG8_WAIT_L(0); PG8_BAR; PG8_MMA(0, 0, At, B0); PG8_MMA(0, 1, At, B1); PG8_BAR; PG8_SCHED;
            PG8_LDA(At, 1, 1); PG8_STAGE(PG8_SB(1, 0), b3, voffB); PG8_STAGE(PG8_SB(1, 1), b3 + hstep, voffB); PG8_STAGE(PG8_SA(1, 0), a3, voffA);
            PG8_WAIT_V(8); PG8_WAIT_L(0); PG8_BAR; PG8_MMA(1, 0, At, B0); PG8_MMA(1, 1, At, B1); PG8_BAR; PG8_SCHED;
            } else {
            PG8_LDB(B0, 0, 0); PG8_SCHED; PG8_LDA(At, 0, 0); PG8_STAGE(PG8_SA(1, 1), a1 + hstep, voffA);
            PG8_WAIT_L(8); PG8_BAR; PG8_WAIT_L(0); PG8_MMA(0, 0, At, B0); PG8_BAR; PG8_SCHED;
            PG8_LDB(B1, 0, 1); PG8_STAGE(PG8_SB(0, 0), b2, voffB);
            PG8_BAR; PG8_WAIT_L(0); PG8_MMA(0, 1, At, B1); PG8_BAR;
            PG8_LDA(At, 0, 1); PG8_STAGE(PG8_SA(0, 0), a2, voffA);
            PG8_BAR; PG8_WAIT_L(0); PG8_MMA(1, 0, At, B0); PG8_BAR; PG8_SCHED;
            PG8_STAGE(PG8_SB(0, 1), b2 + hstep, voffB);
            PG8_WAIT_V(6); PG8_BAR; PG8_MMA(1, 1, At, B1); PG8_BAR;
            PG8_LDB(B0, 1, 0); PG8_SCHED; PG8_LDA(At, 1, 0); PG8_STAGE(PG8_SA(0, 1), a2 + hstep, voffA);
            PG8_WAIT_L(8); PG8_BAR; PG8_WAIT_L(0); PG8_MMA(0, 0, At, B0); PG8_BAR; PG8_SCHED;
            PG8_LDB(B1, 1, 1); PG8_STAGE(PG8_SB(1, 0), b3, voffB);
            PG8_BAR; PG8_WAIT_L(0); PG8_MMA(0, 1, At, B1); PG8_BAR;
            PG8_LDA(At, 1, 1); PG8_STAGE(PG8_SA(1, 0), a3, voffA);
            PG8_BAR; PG8_WAIT_L(0); PG8_MMA(1, 0, At, B0); PG8_BAR; PG8_SCHED;
            PG8_STAGE(PG8_SB(1, 1), b3 + hstep, voffB);
            PG8_WAIT_V(6); PG8_BAR; PG8_MMA(1, 1, At, B1); PG8_BAR;
            }
        }
        if constexpr (ALIGN_EPI) { if (wr == 0) PG8_BAR; }
        if constexpr (!Epi::AFTER_DRAIN) { E(acc, cur, wr, wc, fr, fq); S.done(cur); }
        if (!has_next) break;
#pragma unroll
        for (int a = 0; a < 2; ++a)
#pragma unroll
            for (int b = 0; b < 2; ++b)
#pragma unroll
                for (int m = 0; m < 4; ++m)
#pragma unroll
                    for (int n = 0; n < 2; ++n) acc[a][b][m][n] = (f32x4){0.f, 0.f, 0.f, 0.f};
        cur = nxt; cA = nA; cB = nB; ++ui;
        if constexpr (ALIGN_EPI) { if (wr == 1) PG8_BAR; }
    }
    PG8_WAIT_V(0);
    if constexpr (!ALIGN_EPI) { if (wr == 0) PG8_BAR; }
    PG8_BAR;
    if constexpr (Epi::AFTER_DRAIN) { E.fused(acc, cur, wr, wc, fr, fq, lds, wid, lane); S.done(cur); }
#undef PG8_SA
#undef PG8_SB
#undef PG8_STAGE
#undef PG8_LDA
#undef PG8_LDB
#undef PG8_MMA
#undef PG8_WAIT_V
#undef PG8_WAIT_L
#undef PG8_BAR
#undef PG8_SCHED
}
}
#ifndef PG8_SP2
#define PG8_SP2 true
#endif
#ifndef PG8_ALIGN
#define PG8_ALIGN true
#endif
constexpr int D = 2048, NB = 4, SEQ = 4096, CL = 256, DEPTH = 4;
constexpr int ML = NB * SEQ, MC = NB * CL, MT = ML + MC;
constexpr int INW = 15360, DFF = 5632, NFF = 2 * DFF;
constexpr int C_RK = 0, C_RV = 512, C_NK = 1536, C_NV = 2560, C_RQ = 3584, C_RG = 4096, C_NQ = 5120, C_HY = 6144, C_GT = 9216;
constexpr float EPS = 1e-6f;
constexpr int NWAVES = 8;
constexpr size_t al256(size_t x) { return (x + 255) & ~(size_t)255; }
constexpr size_t WS_CTL = 0, CTL_ZERO_BYTES = 1u << 20;
constexpr size_t WS_MOD = WS_CTL + CTL_ZERO_BYTES;
constexpr size_t WS_ROPE = WS_MOD + al256((size_t)4 * 5 * 12288 * 4);
constexpr size_t PS_FH2 = 0;
constexpr size_t PS_FH2B = PS_FH2 + al256((size_t)4352 * 64 * 4);
constexpr size_t PS_TAPC = PS_FH2B + al256((size_t)4352 * 64 * 2);
constexpr size_t PS_KF = PS_TAPC + al256((size_t)2 * 2 * 1024 * 256 * 4);
constexpr size_t PS_WIN = PS_KF + al256((size_t)2 * 1024 * 8192 * 8);
constexpr size_t PS_WBR = PS_WIN + al256((size_t)INW * D * 2);
constexpr size_t PS_WOUT = PS_WBR + al256((size_t)3 * D * 1024 * 2);
constexpr size_t PS_WF1 = PS_WOUT + al256((size_t)D * D * 2);
constexpr size_t PS_WF2 = PS_WF1 + al256((size_t)NFF * D * 2);
constexpr size_t PS_BYTES = PS_WF2 + al256((size_t)D * DFF * 2);
constexpr size_t WS_PSET = WS_ROPE + al256(64 * 16 * 8);
constexpr size_t WS_XC = WS_PSET + 2 * PS_BYTES;
constexpr size_t WS_H = WS_XC + al256((size_t)MC * D * 4);
constexpr size_t WS_Z = WS_H + al256((size_t)MT * D * 2);
constexpr size_t WS_HYT = WS_Z + al256((size_t)MT * INW * 2);
constexpr size_t WS_YT = WS_HYT + al256((size_t)3 * NB * 1024 * SEQ * 2);
constexpr size_t WS_YS = WS_YT + al256((size_t)NB * 1024 * SEQ * 2);
constexpr size_t WS_ACC = WS_YS + al256((size_t)3 * MT * 1024 * 2);
constexpr size_t WS_U = WS_ACC + al256((size_t)MT * D * 2);
constexpr size_t WS_KV = WS_U + al256((size_t)MT * DFF * 2);
constexpr size_t WS_SA = WS_KV + al256((size_t)NB * 8 * 2 * 34 * 8192 * 4);
constexpr size_t WS_SB = WS_SA + al256((size_t)272 * 4 * DFF * 2);
constexpr size_t WS_SLAB = WS_SB + al256((size_t)272 * 2 * DFF * 2);
constexpr size_t WS_FB4 = WS_SLAB + al256((size_t)4 * MC * D * 4);
constexpr size_t WS_END = WS_FB4 + al256((size_t)4 * 4352 * 64 * 2);
constexpr int NSPLIT = 4;
constexpr int CW_BAR = 4096;
constexpr int RING_BYTES = 131072, LDSCTL_OFF = RING_BYTES, MISC_OFF = LDSCTL_OFF + 320, LDS_BYTES = 147456;

#define GAS __attribute__((address_space(1)))
#define LAS __attribute__((address_space(3)))
typedef unsigned short bf16;
typedef unsigned v4u __attribute__((ext_vector_type(4)));
typedef unsigned v2u __attribute__((ext_vector_type(2)));
typedef float f32x4 __attribute__((ext_vector_type(4)));
typedef float f32x2 __attribute__((ext_vector_type(2)));
typedef short bf16x8 __attribute__((ext_vector_type(8)));
typedef GAS unsigned gu32;
#define LDS_WAIT() asm volatile("s_waitcnt lgkmcnt(0)" ::: "memory")
__device__ __forceinline__ unsigned f2bf(float f) { unsigned u = __builtin_bit_cast(unsigned, f); return (u + 0x7fffu + ((u >> 16) & 1u)) >> 16; }
__device__ __forceinline__ unsigned pk2(float lo, float hi) { return f2bf(lo) | (f2bf(hi) << 16); }
__device__ __forceinline__ float bflo(unsigned w) { return __uint_as_float(w << 16); }
__device__ __forceinline__ float bfhi(unsigned w) { return __uint_as_float(w & 0xffff0000u); }
__device__ __forceinline__ float bf1(bf16 b) { return __uint_as_float(((unsigned)b) << 16); }
__device__ __forceinline__ bf16x8 mk8(unsigned a, unsigned b, unsigned c, unsigned d) { v4u v = (v4u){a, b, c, d}; return __builtin_bit_cast(bf16x8, v); }
__device__ __forceinline__ f32x4 mfma16(bf16x8 a, bf16x8 b, f32x4 c) { return __builtin_amdgcn_mfma_f32_16x16x32_bf16(a, b, c, 0, 0, 0); }
__device__ __forceinline__ float sin_rev(float r) { return __builtin_amdgcn_sinf(r - floorf(r)); }
__device__ __forceinline__ float cos_rev(float r) { return __builtin_amdgcn_cosf(r - floorf(r)); }
__device__ __forceinline__ float sin_rad(float x) { return sin_rev(x * 0.15915494309189535f); }
__device__ __forceinline__ float ex2(float x) { return __builtin_amdgcn_exp2f(x); }
__device__ __forceinline__ float wave_sum(float v) {
#pragma unroll
    for (int o = 1; o < 64; o <<= 1) v += __shfl_xor(v, o);
    return v;
}
__device__ __forceinline__ int otid() { int t = threadIdx.x; asm volatile("" : "+v"(t)); return t; }
__device__ __forceinline__ int opq(int v) { asm volatile("" : "+s"(v)); return v; }
#define XB_TMO      128
#define XB_XCNT(j)  (256  + 64 * (j))
#define XB_XSUB(j)  (1280 + 64 * (j))
#define XB_XGEN(j)  (2304 + 64 * (j))
#define XB_TOP      3328
#define XB_TOPGEN   3392
#define XCD_BAR_WORDS 3456
#define XB_SPIN_CAP (1u << 18)

__device__ __forceinline__ unsigned xb_ld(unsigned* p)              { return __hip_atomic_load(p, __ATOMIC_RELAXED, __HIP_MEMORY_SCOPE_AGENT); }
__device__ __forceinline__ unsigned xb_add(unsigned* p, unsigned v) { return __hip_atomic_fetch_add(p, v, __ATOMIC_RELAXED, __HIP_MEMORY_SCOPE_AGENT); }
__device__ __forceinline__ unsigned xb_xcc_id() { return (unsigned)__builtin_amdgcn_s_getreg((3 << 11) | 20) & 0xFu; }
#define XB_SPIN(cond, bar) do { unsigned _sp = 0; while (cond) { __builtin_amdgcn_s_sleep(1); \
    if ((++_sp & 255u) == 0u) { if (xb_ld(&(bar)[XB_TMO])) break; if (_sp > XB_SPIN_CAP) { atomicAdd(&(bar)[XB_TMO], 1u); break; } } } } while (0)

struct XcdBarrier {
    unsigned* bar; unsigned x;
    volatile LAS unsigned* st;
};

__device__ __forceinline__ XcdBarrier xcd_barrier_post(unsigned* bar, volatile LAS unsigned* st) {
    XcdBarrier b; b.bar = bar; b.x = xb_xcc_id(); b.st = st;
    if (threadIdx.x == 0) (void)xb_add(&bar[XB_XCNT(b.x)], 1u);
    return b;
}
__device__ __forceinline__ void xcd_barrier_complete(unsigned* bar, unsigned x, unsigned& nloc, unsigned& nx) {
    const unsigned G = gridDim.x * gridDim.y * gridDim.z;
    unsigned sum, cnt, mine, sp = 0u;
    for (;;) {
        sum = 0u; cnt = 0u; mine = 0u;
#pragma unroll
        for (unsigned j = 0; j < 16; ++j) { const unsigned c = xb_ld(&bar[XB_XCNT(j)]); sum += c; cnt += (c > 0u) ? 1u : 0u; mine = (j == x) ? c : mine; }
        if (sum == G) break;
        __builtin_amdgcn_s_sleep(1);
        if ((++sp & 255u) == 0u) { if (xb_ld(&bar[XB_TMO])) break; if (sp > XB_SPIN_CAP) { atomicAdd(&bar[XB_TMO], 1u); break; } }
    }
    nloc = mine > 0u ? mine : 1u; nx = cnt > 0u ? cnt : 1u;
}

__device__ __forceinline__ void xcd_barrier(const XcdBarrier& b) {
    asm volatile("s_waitcnt vmcnt(0)" ::: "memory");
    __syncthreads();
    if (threadIdx.x == 0) {
        unsigned* bar = b.bar;
        __builtin_amdgcn_s_waitcnt(0);
        unsigned nloc = b.st[0], nx = b.st[1];
        if (nloc == 0u) { xcd_barrier_complete(bar, b.x, nloc, nx); b.st[0] = nloc; b.st[1] = nx; }
        const unsigned old = xb_add(&bar[XB_XSUB(b.x)], 1u);
        const unsigned gen = old / nloc;
        if (old + 1u == (gen + 1u) * nloc) {
            __builtin_amdgcn_fence(__ATOMIC_RELEASE, "agent");
            asm volatile("s_waitcnt vmcnt(0)" ::: "memory");
            const unsigned og = xb_add(&bar[XB_TOP], 1u);
            const unsigned tg = og / nx;
            if (og + 1u == (tg + 1u) * nx) xb_add(&bar[XB_TOPGEN], 1u);
            else XB_SPIN(xb_ld(&bar[XB_TOPGEN]) == tg, bar);
            __builtin_amdgcn_fence(__ATOMIC_ACQUIRE, "agent");
            xb_add(&bar[XB_XGEN(b.x)], 1u);
            asm volatile("s_waitcnt vmcnt(0)" ::: "memory");
        } else {
            XB_SPIN(xb_ld(&bar[XB_XGEN(b.x)]) == gen, bar);
            __builtin_amdgcn_fence(__ATOMIC_ACQUIRE, "agent");
            asm volatile("s_waitcnt vmcnt(0)" ::: "memory");
        }
    }
    __syncthreads();
}
__device__ __forceinline__ void p0_transpose_item(const float* W, int K, int N, bf16* WT, int row_off, LAS float* scr, int item, int lane) {
    const int nblk = N / 32, kb = item / nblk, nb = item % nblk, k0 = 64 * kb, n0 = 32 * nb;
#pragma unroll 16
    for (int i = 0; i < 32; ++i) { const int kk = 2 * i + (lane >> 5); scr[kk * 33 + (lane & 31)] = __builtin_nontemporal_load(W + (size_t)(k0 + kk) * N + n0 + (lane & 31)); }
    LDS_WAIT(); asm volatile("" ::: "memory");
    const int c = lane & 7;
#pragma unroll
    for (int j = 0; j < 4; ++j) { const int n = (lane >> 3) + 8 * j; const LAS float* s = scr + (8 * c) * 33 + n;
        v4u o; o.x = pk2(s[0 * 33], s[1 * 33]); o.y = pk2(s[2 * 33], s[3 * 33]); o.z = pk2(s[4 * 33], s[5 * 33]); o.w = pk2(s[6 * 33], s[7 * 33]);
        __builtin_nontemporal_store(o, (GAS v4u*)(WT + (size_t)(row_off + n0 + n) * K + k0 + 8 * c)); }
    LDS_WAIT(); asm volatile("" ::: "memory");
}
struct Args { const float* in[27]; float* out; unsigned char* ws; int seq_lo, seq_hi; };
__device__ __forceinline__ const float* inp(int i) { const char* ka = (const char*)__builtin_amdgcn_kernarg_segment_ptr(); int off = i * 8; asm volatile("" : "+s"(off)); return *(const float* const*)(ka + off); }
__device__ __forceinline__ unsigned char* wsb() { const char* ka = (const char*)__builtin_amdgcn_kernarg_segment_ptr(); int off = 27 * 8 + 8; asm volatile("" : "+s"(off)); return *(unsigned char* const*)(ka + off); }
__device__ __forceinline__ float* outb() { const char* ka = (const char*)__builtin_amdgcn_kernarg_segment_ptr(); int off = 27 * 8; asm volatile("" : "+s"(off)); return *(float* const*)(ka + off); }
__device__ __forceinline__ unsigned char* psb(int set) { return wsb() + WS_PSET + (size_t)set * PS_BYTES; }
enum { I_X = 0, I_C, I_CTX, I_CCTX, I_WMOD, I_BMOD, I_G1, I_G2, I_WIN, I_HCW, I_HCB, I_FW1, I_FB1, I_FW2, I_FB2, I_FW3, I_FFQ, I_HBIAS, I_RDEC, I_RPB, I_WBR, I_WOUT, I_FFW1, I_FFCW, I_FFCB, I_FFW2, I_GF };

__device__ __forceinline__ void ph_prologue(const Args& A, LAS unsigned char* lds, int tid) {
    LAS float* sc = (LAS float*)lds;
    LAS float* red = sc + 5 * 2048;
    const float* c = inp(I_C); const float* cc = inp(I_CCTX);
    for (int i = tid; i < 5 * 2048; i += 512) { const int r = i >> 11, k = i & 2047; const float v = (r < 4) ? c[r * 2048 + k] : cc[k]; sc[i] = v / (1.0f + __expf(-v)); }
    __syncthreads();
    float* mod = (float*)(wsb() + WS_MOD);
    const int kq = tid >> 6, col = tid & 63;
    for (int u = blockIdx.x; u < DEPTH * 192; u += gridDim.x) {
        const int l = u / 192, n0 = (u % 192) * 64;
        const float* W = inp(I_WMOD) + (size_t)l * 2048 * 12288 + n0 + col;
        float a0 = 0.f, a1 = 0.f, a2 = 0.f, a3 = 0.f, a4 = 0.f;
#pragma unroll 16
        for (int k = kq * 256; k < kq * 256 + 256; ++k) { const float w = W[(size_t)k * 12288];
            a0 += sc[k] * w; a1 += sc[2048 + k] * w; a2 += sc[4096 + k] * w; a3 += sc[6144 + k] * w; a4 += sc[8192 + k] * w; }
        red[(kq * 5 + 0) * 64 + col] = a0; red[(kq * 5 + 1) * 64 + col] = a1; red[(kq * 5 + 2) * 64 + col] = a2; red[(kq * 5 + 3) * 64 + col] = a3; red[(kq * 5 + 4) * 64 + col] = a4;
        __syncthreads();
        if (tid < 320) { const int r = tid >> 6; float s = inp(I_BMOD)[l * 12288 + n0 + col];
#pragma unroll
            for (int q = 0; q < 8; ++q) s += red[(q * 5 + r) * 64 + col];
            mod[((size_t)l * 5 + r) * 12288 + n0 + col] = s; }
        __syncthreads();
    }
    if (blockIdx.x == 0) { f32x2* rope = (f32x2*)(wsb() + WS_ROPE);
        for (int i = tid; i < 1024; i += 512) { const int pos = i >> 4, j = i & 15; const float inv = exp2f(-(float)j * (13.287712379549449f / 16.0f));
            const float rev = (float)pos * inv * 0.15915494309189535f; rope[i] = (f32x2){cos_rev(rev), sin_rev(rev)}; } }
}

__device__ __forceinline__ void ph_convert(const Args& A, int l, int set, int it_lo, int it_hi, int wk, int nwk, LAS unsigned char* lds, int wave, int lane) {
    LAS float* scr = (LAS float*)(lds + wave * 16384);
    const int gw = wk * NWAVES + wave, NGW = nwk * NWAVES;
    constexpr int I_IN = (D / 64) * (INW / 32), I_BR = (1024 / 64) * (D / 32), I_OUT = (D / 64) * (D / 32), I_F1 = (D / 64) * (NFF / 32);
    const float* win = inp(I_WIN) + (size_t)l * D * INW; const float* wbr = inp(I_WBR) + (size_t)l * 3 * 1024 * D; const float* wout = inp(I_WOUT) + (size_t)l * D * D;
    const float* wf1 = inp(I_FFW1) + (size_t)l * D * NFF; const float* wf2 = inp(I_FFW2) + (size_t)l * DFF * D;
    unsigned char* ps = psb(set);
    bf16* WIN = (bf16*)(ps + PS_WIN); bf16* WBR = (bf16*)(ps + PS_WBR); bf16* WOUT = (bf16*)(ps + PS_WOUT); bf16* WF1 = (bf16*)(ps + PS_WF1); bf16* WF2 = (bf16*)(ps + PS_WF2);
    for (int it = it_lo + gw; it < it_hi; it += NGW) {
        int r = it;
        if (r < I_IN) { p0_transpose_item(win, D, INW, WIN, 0, scr, r, lane); continue; } r -= I_IN;
        if (r < I_BR) { p0_transpose_item(wbr, 1024, D, WBR, 0, scr, r, lane); continue; } r -= I_BR;
        if (r < I_BR) { p0_transpose_item(wbr + (size_t)1024 * D, 1024, D, WBR + (size_t)D * 1024, 0, scr, r, lane); continue; } r -= I_BR;
        if (r < I_BR) { p0_transpose_item(wbr + (size_t)2 * 1024 * D, 1024, D, WBR + (size_t)2 * D * 1024, 0, scr, r, lane); continue; } r -= I_BR;
        if (r < I_OUT) { p0_transpose_item(wout, D, D, WOUT, 0, scr, r, lane); continue; } r -= I_OUT;
        if (r < I_F1) { const int n0 = (r % (NFF / 32)) * 32, f0 = (n0 < DFF) ? n0 : n0 - DFF, nrow = 256 * (f0 >> 7) + ((n0 < DFF) ? 0 : 128) + (f0 & 127);
            p0_transpose_item(wf1, D, NFF, WF1, nrow - n0, scr, r, lane); continue; } r -= I_F1;
        p0_transpose_item(wf2, DFF, D, WF2, 0, scr, r, lane);
    }
}
constexpr int CONV_ITEMS = (D / 64) * (INW / 32) + 3 * (1024 / 64) * (D / 32) + (D / 64) * (D / 32) + (D / 64) * (NFF / 32) + (DFF / 64) * (D / 32);
__device__ __forceinline__ void ph_filt1(const Args& A, int l, int set, int wk, int nwk, LAS unsigned char* lds, int tid) {
    LAS float* feat = (LAS float*)lds;
    LAS float* h1 = feat + 8 * 33;
    LAS float* w1s = h1 + 8 * 64;
    LAS float* w2s = w1s + 33 * 64;
    const float* w1 = inp(I_FW1) + (size_t)l * 33 * 64; const float* b1 = inp(I_FB1) + l * 64; const float* w2 = inp(I_FW2) + (size_t)l * 64 * 64; const float* b2 = inp(I_FB2) + l * 64;
    const float* fq = inp(I_FFQ) + l * 64; bf16* FH2B = (bf16*)(wsb() + WS_FB4) + (size_t)l * 4352 * 64;
    const int pl = tid >> 6, o = tid & 63;
    __syncthreads();
    for (int i = tid; i < 33 * 64; i += 512) w1s[i] = w1[i];
    for (int i = tid; i < 64 * 64; i += 512) w2s[i] = w2[i];
    const float b1o = b1[o], b2o = b2[o], fqo = fq[o];
    __syncthreads();
    for (int u = wk; u < 544; u += nwk) {
        const int pos = u * 8 + pl; const bool isc = pos >= 4096; const int Lf = isc ? 256 : 4096, tp = isc ? pos - 4096 : pos;
        if (o < 33) { float f;
            if (o == 0) f = (float)tp / (float)(Lf - 1);
            else { const int i = (o - 1) & 15; const float fr = 1e-4f + (float)i * ((15.0f - 1e-4f) / 15.0f); const float rev = fr * (float)tp / (float)Lf; f = (o <= 16) ? cos_rev(rev) : -sin_rev(rev); }
            feat[pl * 33 + o] = f; }
        __syncthreads();
        float a = b1o;
#pragma unroll 11
        for (int i = 0; i < 33; ++i) a += feat[pl * 33 + i] * w1s[i * 64 + o];
        h1[pl * 64 + o] = sin_rad(fqo * a);
        __syncthreads();
        float b = b2o;
#pragma unroll 16
        for (int j = 0; j < 64; ++j) b += h1[pl * 64 + j] * w2s[j * 64 + o];
        FH2B[(size_t)pos * 64 + o] = (bf16)f2bf(sin_rad(fqo * b));
        __syncthreads();
    }
}
__device__ __forceinline__ void ph_norm(const float* xlat, const float* xctx, const float* g, const float* modl, int sh_off, int sc_off, bf16* H, int Mrows, const float* slab, const float* sgate, float* xc_out, int wave, int lane) {
    const int gw = blockIdx.x * NWAVES + wave, NGW = gridDim.x * NWAVES;
    for (int base = gw * 8; base < ML; base += NGW * 8) {
        const float* mv = modl + (size_t)(base >> 12) * 12288;
        f32x4 Gv[8], Sv[8];
#pragma unroll
        for (int j = 0; j < 8; ++j) { const int idx = (lane + 64 * j) * 4; Gv[j] = *(const f32x4*)(g + idx) * (*(const f32x4*)(mv + sc_off + idx) + 1.0f); Sv[j] = *(const f32x4*)(mv + sh_off + idx); }
        f32x4 v[8], nx[8];
#pragma unroll
        for (int j = 0; j < 8; ++j) nx[j] = *(const f32x4*)(xlat + (size_t)base * D + (lane + 64 * j) * 4);
#pragma unroll 1
        for (int i = 0; i < 8; ++i) { const int m = base + i; float ss = 0.f;
#pragma unroll
            for (int j = 0; j < 8; ++j) { v[j] = nx[j]; ss += (v[j].x * v[j].x + v[j].y * v[j].y) + (v[j].z * v[j].z + v[j].w * v[j].w); }
            if (i < 7) {
#pragma unroll
                for (int j = 0; j < 8; ++j) nx[j] = *(const f32x4*)(xlat + (size_t)(m + 1) * D + (lane + 64 * j) * 4); }
            const float rstd = 1.0f / sqrtf(wave_sum(ss) * (1.0f / D) + EPS);
#pragma unroll
            for (int j = 0; j < 8; ++j) { const int idx = (lane + 64 * j) * 4; const f32x4 y = v[j] * rstd * Gv[j] + Sv[j];
                v2u w; w.x = pk2(y.x, y.y); w.y = pk2(y.z, y.w); *(v2u*)(H + (size_t)m * D + idx) = w; } }
    }
    for (int m = ML + gw; m < Mrows; m += NGW) {
        const float* xr = xctx + (size_t)(m - ML) * D; const float* mv = modl + (size_t)4 * 12288;
        f32x4 v[8]; float ss = 0.f;
#pragma unroll
        for (int j = 0; j < 8; ++j) { const int idx = (lane + 64 * j) * 4; v[j] = *(const f32x4*)(xr + idx);
            if (slab) { const float* sp = slab + (size_t)(m - ML) * D + idx; f32x4 p = *(const f32x4*)sp;
#pragma unroll
                for (int q = 1; q < NSPLIT; ++q) p = p + *(const f32x4*)(sp + (size_t)q * MC * D);
                v[j] = v[j] + *(const f32x4*)(sgate + idx) * p; *(f32x4*)(xc_out + (size_t)(m - ML) * D + idx) = v[j]; }
            ss += (v[j].x * v[j].x + v[j].y * v[j].y) + (v[j].z * v[j].z + v[j].w * v[j].w); }
        const float rstd = 1.0f / sqrtf(wave_sum(ss) * (1.0f / D) + EPS);
#pragma unroll
        for (int j = 0; j < 8; ++j) { const int idx = (lane + 64 * j) * 4;
            const f32x4 gg = *(const f32x4*)(g + idx), sh = *(const f32x4*)(mv + sh_off + idx), sc = *(const f32x4*)(mv + sc_off + idx);
            const f32x4 y = v[j] * rstd * gg * (sc + 1.0f) + sh;
            v2u w; w.x = pk2(y.x, y.y); w.y = pk2(y.z, y.w);
            *(v2u*)(H + (size_t)m * D + idx) = w; }
    }
}

__device__ __forceinline__ int fphys(int i) { return i + 2 * (i >> 5); }
__device__ __forceinline__ void bfly_dif(f32x2& a, f32x2& b, float c, float s) { const f32x2 u = a, v = b; a = u + v; const f32x2 d = u - v; b = __builtin_elementwise_fma(d.yx, (f32x2){s, -s}, d * (f32x2){c, c}); }
__device__ __forceinline__ void bfly_idit(f32x2& a, f32x2& b, float c, float s) { const f32x2 u = a, q = b; const f32x2 v = __builtin_elementwise_fma(q.yx, (f32x2){-s, s}, q * (f32x2){c, c}); a = u + v; b = u - v; }
template <bool ZHI> __device__ __forceinline__ void dif16(f32x2 (&x)[16], float th) {
    asm volatile("" : "+v"(th));
#pragma unroll
    for (int k = 0; k < 8; ++k) { const float fr = th + (float)k * 0.0625f; const float c = __builtin_amdgcn_cosf(fr), s = __builtin_amdgcn_sinf(fr);
        if (ZHI) { const f32x2 u = x[k]; x[k + 8] = (f32x2){u.x * c + u.y * s, u.y * c - u.x * s}; } else bfly_dif(x[k], x[k + 8], c, s); }
#pragma unroll
    for (int k = 0; k < 4; ++k) { const float fr = 2.0f * th + (float)k * 0.125f; const float c = __builtin_amdgcn_cosf(fr), s = __builtin_amdgcn_sinf(fr);
        bfly_dif(x[k], x[k + 4], c, s); bfly_dif(x[8 + k], x[12 + k], c, s); }
#pragma unroll
    for (int k = 0; k < 2; ++k) { const float fr = 4.0f * th + (float)k * 0.25f; const float c = __builtin_amdgcn_cosf(fr), s = __builtin_amdgcn_sinf(fr);
#pragma unroll
        for (int b = 0; b < 16; b += 4) bfly_dif(x[b + k], x[b + k + 2], c, s); }
    { const float fr = 8.0f * th; const float c = __builtin_amdgcn_cosf(fr), s = __builtin_amdgcn_sinf(fr);
#pragma unroll
        for (int b = 0; b < 16; b += 2) bfly_dif(x[b], x[b + 1], c, s); }
}
__device__ __forceinline__ void idit16(f32x2 (&x)[16], float th) {
    asm volatile("" : "+v"(th));
    { const float fr = 8.0f * th; const float c = __builtin_amdgcn_cosf(fr), s = __builtin_amdgcn_sinf(fr);
#pragma unroll
        for (int b = 0; b < 16; b += 2) bfly_idit(x[b], x[b + 1], c, s); }
#pragma unroll
    for (int k = 0; k < 2; ++k) { const float fr = 4.0f * th + (float)k * 0.25f; const float c = __builtin_amdgcn_cosf(fr), s = __builtin_amdgcn_sinf(fr);
#pragma unroll
        for (int b = 0; b < 16; b += 4) bfly_idit(x[b + k], x[b + k + 2], c, s); }
#pragma unroll
    for (int k = 0; k < 4; ++k) { const float fr = 2.0f * th + (float)k * 0.125f; const float c = __builtin_amdgcn_cosf(fr), s = __builtin_amdgcn_sinf(fr);
        bfly_idit(x[k], x[k + 4], c, s); bfly_idit(x[8 + k], x[12 + k], c, s); }
#pragma unroll
    for (int k = 0; k < 8; ++k) { const float fr = th + (float)k * 0.0625f; const float c = __builtin_amdgcn_cosf(fr), s = __builtin_amdgcn_sinf(fr); bfly_idit(x[k], x[k + 8], c, s); }
}
template <bool INV, int PSTRIDE> __device__ __forceinline__ void fft_pass(LAS f32x2* buf, int base, float th) {
    LAS f32x2* p = buf + fphys(base);
    f32x2 x[16];
#pragma unroll
    for (int k = 0; k < 16; ++k) x[k] = p[k * PSTRIDE];
    if (INV) idit16(x, th); else dif16<false>(x, th);
#pragma unroll
    for (int k = 0; k < 16; ++k) p[k * PSTRIDE] = x[k];
}
constexpr int FFT_LDS_BYTES = (8192 + 512 + 8) * 8;
__device__ __forceinline__ float block_sum(float v, LAS float* red, int tid) {
    v = wave_sum(v);
    __syncthreads();
    if ((tid & 63) == 0) red[tid >> 6] = v;
    __syncthreads();
    float s = 0.f;
#pragma unroll
    for (int i = 0; i < 8; ++i) s += red[i];
    return s;
}
__device__ __forceinline__ float hy_delta(int c) { const float d0 = -4.605170185988091f / 0.3f, d1 = -4.605170185988091f / 1.5f; return fabsf(d0 + (d1 - d0) * ((float)c / 1023.0f)); }
__device__ __forceinline__ void ph_filt2(const Args& A, int l, int set, int c_lo, int c_hi, int wk, int nwk, LAS unsigned char* lds, int tid) {
    LAS f32x2* buf = (LAS f32x2*)lds; LAS float* bufs = (LAS float*)lds; LAS float* red = (LAS float*)(lds + FFT_LDS_BYTES + 64); LAS float* w3s = red + 32;
    LAS float* ctap = w3s + 256;
    const float* w3 = inp(I_FW3) + (size_t)l * 64 * 4096; const bf16* FH2B = (const bf16*)(wsb() + WS_FB4) + (size_t)l * 4352 * 64;
    f32x2* KF = (f32x2*)(psb(set) + PS_KF); float* TAPC = (float*)(psb(set) + PS_TAPC);
    const int lane = tid & 63, w = tid >> 6, g = lane >> 4, li = lane & 15;
    for (int c = c_lo + wk; c < c_hi; c += nwk) {
        __syncthreads();
        if (tid < 256) w3s[tid] = w3[(size_t)(tid & 63) * 4096 + (tid >> 7) * 2048 + ((tid >> 6) & 1) * 1024 + c];
        __syncthreads();
        bf16x8 bfr[2];
#pragma unroll
        for (int ks = 0; ks < 2; ++ks) { float v[8];
#pragma unroll
            for (int j = 0; j < 8; ++j) v[j] = (li < 4) ? w3s[li * 64 + 32 * ks + 8 * g + j] : 0.f;
            bfr[ks] = mk8(pk2(v[0], v[1]), pk2(v[2], v[3]), pk2(v[4], v[5]), pk2(v[6], v[7])); }
        const float delta = hy_delta(c); float ssq = 0.f, ssqc = 0.f;
        const int comp = li >> 1;
#pragma unroll 1
        for (int rb = 0; rb < 272; rb += 64) {
            bf16x8 a0[8], a1[8];
#pragma unroll
            for (int rk = 0; rk < 8; ++rk) { const int rt = rb + w + 8 * rk; const bf16* ap = FH2B + (size_t)((rt < 272 ? rt : 0) * 16 + li) * 64 + 8 * g;
                a0[rk] = *(const bf16x8*)ap; a1[rk] = *(const bf16x8*)(ap + 32); }
#pragma unroll
            for (int rk = 0; rk < 8; ++rk) { const int rt = rb + w + 8 * rk; const int t0 = rt * 16;
                f32x4 acc = (f32x4){0.f, 0.f, 0.f, 0.f};
                acc = mfma16(a0[rk], bfr[0], acc); acc = mfma16(a1[rk], bfr[1], acc);
                if (li < 4 && rt < 272) {
                    if (rt < 256) {
#pragma unroll
                        for (int j = 0; j < 4; ++j) { const int t = t0 + 4 * g + j; const float val = acc[j] * __expf(-((float)t * (1.0f / 4095.0f)) * delta);
                            if ((li & 1) == 0) { bufs[2 * fphys(t) + comp] = val; ssq += val * val; }
                            else if (t >= 1) { bufs[2 * fphys(8192 - t) + comp] = val; ssq += val * val; }
                            else bufs[2 * fphys(4096) + comp] = 0.f; }
                    } else {
#pragma unroll
                        for (int j = 0; j < 4; ++j) { const int m = t0 - 4096 + 4 * g + j; const float val = acc[j] * __expf(-((float)m * (1.0f / 255.0f)) * delta);
                            ctap[li * 256 + m] = val; if ((li & 1) == 0 || m >= 1) ssqc += val * val; }
                    }
                }
            }
        }
        const bool o0 = (li < 2), o1 = (li == 2 || li == 3);
        const float scl0 = (1.0f / 8192.0f) / sqrtf(block_sum(o0 ? ssq : 0.f, red, tid) + EPS), scl1 = (1.0f / 8192.0f) / sqrtf(block_sum(o1 ? ssq : 0.f, red, tid) + EPS);
        const float sc0 = 1.0f / sqrtf(block_sum(o0 ? ssqc : 0.f, red, tid) + EPS), sc1 = 1.0f / sqrtf(block_sum(o1 ? ssqc : 0.f, red, tid) + EPS);
        __syncthreads();
        fft_pass<false, 544>(buf, tid, (float)tid * (1.0f / 8192.0f));
        __syncthreads();
        fft_pass<false, 34>(buf, (tid >> 5) * 512 + (tid & 31), (float)(tid & 31) * (1.0f / 512.0f));
        __syncthreads();
        fft_pass<false, 2>(buf, (tid >> 1) * 32 + (tid & 1), (float)(tid & 1) * (1.0f / 32.0f));
        __syncthreads();
#pragma unroll
        for (int r = 0; r < 8; ++r) { LAS f32x4* pp = (LAS f32x4*)(buf + fphys(2 * tid) + 1088 * r); const f32x4 ab = *pp; *pp = (f32x4){ab.x + ab.z, ab.y + ab.w, ab.x - ab.z, ab.y - ab.w}; }
        __syncthreads();
        f32x2* d0 = KF + (size_t)c * 8192; f32x2* d1 = KF + (size_t)(1024 + c) * 8192;
#pragma unroll 4
        for (int i = 0; i < 16; ++i) { const int p = tid + 512 * i; const int f = (int)(__brev((unsigned)p) >> 19); const int pp = (int)(__brev((unsigned)((8192 - f) & 8191)) >> 19);
            const f32x2 z = buf[fphys(p)], zp = buf[fphys(pp)];
            d0[p] = (f32x2){(z.x + zp.x) * 0.5f * scl0, (z.y - zp.y) * 0.5f * scl0};
            d1[p] = (f32x2){(z.y + zp.y) * 0.5f * scl1, (zp.x - z.x) * 0.5f * scl1}; }
        for (int q = tid; q < 1024; q += 512) { const int od = q >> 8, m = q & 255; TAPC[((size_t)od * 1024 + c) * 256 + m] = ctap[q] * ((od < 2) ? sc0 : sc1); }
    }
}

__device__ __forceinline__ void ph_hyprep(const Args& A, int l, LAS unsigned char* lds, int tid) {
    LAS bf16* T = (LAS bf16*)lds;
    const bf16* Z = (const bf16*)(wsb() + WS_Z); bf16* HYT = (bf16*)(wsb() + WS_HYT);
    const float* cw = inp(I_HCW) + (size_t)l * 3 * 3072; const float* cb = inp(I_HCB) + (size_t)l * 3072;
    v4u pre[5];
#define HP_LOAD(u_) do { const int cg_ = (u_) % 12, tt_ = ((u_) / 12) & 63, b_ = (u_) / 768; \
        _Pragma("unroll") for (int e = 0; e < 5; ++e) { const int q = tid + 512 * e; const int r = q >> 5, ch8 = q & 31, t = tt_ * 64 - 1 + r; pre[e] = (v4u){0u, 0u, 0u, 0u}; \
            if (q < 66 * 32 && t >= 0 && t < SEQ) pre[e] = *(const v4u*)(Z + (size_t)(b_ * SEQ + t) * INW + C_HY + cg_ * 256 + ch8 * 8); } } while (0)
    int u = blockIdx.x;
    if (u < 3072) HP_LOAD(u);
    for (; u < 3072; u += gridDim.x) {
        const int cg = u % 12, tt = (u / 12) & 63, b = u / 768;
        __syncthreads();
#pragma unroll
        for (int e = 0; e < 5; ++e) { const int q = tid + 512 * e; if (q < 66 * 32) *(LAS v4u*)(T + (q >> 5) * 264 + (q & 31) * 8) = pre[e]; }
        __syncthreads();
        if (u + (int)gridDim.x < 3072) HP_LOAD(u + (int)gridDim.x);
        const int ch = tid & 255, half = tid >> 8, gch = cg * 256 + ch;
        const float w0 = cw[gch], w1 = cw[3072 + gch], w2 = cw[6144 + gch], bb = cb[gch];
        const int part = gch >> 10, c = gch & 1023;
        bf16* outp = HYT + ((size_t)(part * NB + b) * 1024 + c) * SEQ + tt * 64 + half * 32;
#pragma unroll
        for (int tq = 0; tq < 4; ++tq) { float vv[8];
#pragma unroll
            for (int e = 0; e < 8; ++e) { const int tl = half * 32 + tq * 8 + e;
                vv[e] = w0 * bf1(T[tl * 264 + ch]) + w1 * bf1(T[(tl + 1) * 264 + ch]) + w2 * bf1(T[(tl + 2) * 264 + ch]) + bb; }
            v4u w; w.x = pk2(vv[0], vv[1]); w.y = pk2(vv[2], vv[3]); w.z = pk2(vv[4], vv[5]); w.w = pk2(vv[6], vv[7]);
            *(v4u*)(outp + tq * 8) = w; }
    }
#undef HP_LOAD
}
__device__ __forceinline__ void ph_hyctx(const Args& A, int l, LAS unsigned char* lds, int tid) {
    const bf16* Z = (const bf16*)(wsb() + WS_Z); bf16* YS = (bf16*)(wsb() + WS_YS); const float* TAPC = (const float*)(psb(l & 1) + PS_TAPC);
    const float* cw = inp(I_HCW) + (size_t)l * 3 * 3072; const float* cb = inp(I_HCB) + (size_t)l * 3072; const float* hb = inp(I_HBIAS) + (size_t)l * 2 * 1024;
    const int ch = tid >> 6, q = tid & 63, t0 = 4 * q;
    LAS float* Y = (LAS float*)lds + ch * 1552; LAS float* Y1 = Y + 256; LAS float* G0 = Y + 512; LAS float* G1 = Y + 1032;
    for (int u = blockIdx.x; u < 512; u += gridDim.x) {
        const int b = u >> 7, c = (u & 127) * 8 + ch;
        __syncthreads();
        float pv[3][4];
#pragma unroll
        for (int part = 0; part < 3; ++part) { const int gch = part * 1024 + c; const float w0 = cw[gch], w1 = cw[3072 + gch], w2 = cw[6144 + gch], bb = cb[gch];
            const bf16* zp = Z + (size_t)(ML + b * CL + t0) * INW + C_HY + gch;
            float zz[6];
#pragma unroll
            for (int e = 0; e < 6; ++e) { const int t = t0 - 1 + e; zz[e] = (t >= 0 && t < CL) ? bf1(zp[(ptrdiff_t)(e - 1) * INW]) : 0.f; }
#pragma unroll
            for (int r = 0; r < 4; ++r) pv[part][r] = w0 * zz[r] + w1 * zz[r + 1] + w2 * zz[r + 2] + bb; }
        *(LAS f32x4*)(Y + t0) = (f32x4){pv[2][0], pv[2][1], pv[2][2], pv[2][3]};
#pragma unroll
        for (int r = 0; r < 4; ++r) { const int m = t0 + r;
            G0[m + 259] = TAPC[((size_t)(0 * 2 + 0) * 1024 + c) * 256 + m]; G1[m + 259] = TAPC[((size_t)(1 * 2 + 0) * 1024 + c) * 256 + m];
            if (m >= 1) { G0[259 - m] = TAPC[((size_t)(0 * 2 + 1) * 1024 + c) * 256 + m]; G1[259 - m] = TAPC[((size_t)(1 * 2 + 1) * 1024 + c) * 256 + m]; } }
        if (q == 0) { G0[515] = 0.f; G1[515] = 0.f; G0[516] = 0.f; G1[516] = 0.f; }
        __syncthreads();
        float yprev[4] = {pv[2][0], pv[2][1], pv[2][2], pv[2][3]};
#pragma unroll
        for (int ord = 0; ord < 2; ++ord) {
            const LAS float* Ys = ord ? Y1 : Y; const LAS float* G = ord ? G1 : G0;
            float acc[4] = {0.f, 0.f, 0.f, 0.f};
#pragma unroll 4
            for (int sp = 0; sp < 64; ++sp) { const f32x4 yv = *(const LAS f32x4*)(Ys + 4 * sp); const LAS float* gp = G + 4 * (q - sp) + 256;
                const f32x4 ga = *(const LAS f32x4*)gp, gb = *(const LAS f32x4*)(gp + 4);
                const float g[8] = {ga.x, ga.y, ga.z, ga.w, gb.x, gb.y, gb.z, gb.w}; const float yy[4] = {yv.x, yv.y, yv.z, yv.w};
#pragma unroll
                for (int r = 0; r < 4; ++r)
#pragma unroll
                    for (int j = 0; j < 4; ++j) acc[r] += yy[j] * g[r - j + 3]; }
            const float bias = hb[ord * 1024 + c];
#pragma unroll
            for (int r = 0; r < 4; ++r) yprev[r] = pv[ord][r] * (acc[r] + bias * yprev[r]);
            if (ord == 0) { *(LAS f32x4*)(Y1 + t0) = (f32x4){yprev[0], yprev[1], yprev[2], yprev[3]}; __syncthreads(); }
        }
#pragma unroll
        for (int r = 0; r < 4; ++r) YS[(size_t)(ML + b * CL + t0 + r) * 1024 + c] = (bf16)f2bf(yprev[r]);
    }
}
__device__ __forceinline__ void unpack8(v4u v, float (&x)[8]) { x[0] = bflo(v.x); x[1] = bfhi(v.x); x[2] = bflo(v.y); x[3] = bfhi(v.y); x[4] = bflo(v.z); x[5] = bfhi(v.z); x[6] = bflo(v.w); x[7] = bfhi(v.w); }
__device__ __forceinline__ v4u pack8(const float (&x)[8]) { v4u w; w.x = pk2(x[0], x[1]); w.y = pk2(x[2], x[3]); w.z = pk2(x[4], x[5]); w.w = pk2(x[6], x[7]); return w; }
__device__ __forceinline__ void rope8(float (&lo)[8], float (&hi)[8], const f32x2* rt) {
#pragma unroll
    for (int e = 0; e < 8; ++e) { const f32x2 cs = rt[e]; const float a = lo[e], b = hi[e]; lo[e] = a * cs.x - b * cs.y; hi[e] = b * cs.x + a * cs.y; }
}
__device__ __forceinline__ void vt_store(LAS bf16* Vt, int ld, int d0, int r, v4u vv) {
    Vt[(d0 + 0) * ld + r] = (bf16)(vv.x & 0xffffu); Vt[(d0 + 1) * ld + r] = (bf16)(vv.x >> 16);
    Vt[(d0 + 2) * ld + r] = (bf16)(vv.y & 0xffffu); Vt[(d0 + 3) * ld + r] = (bf16)(vv.y >> 16);
    Vt[(d0 + 4) * ld + r] = (bf16)(vv.z & 0xffffu); Vt[(d0 + 5) * ld + r] = (bf16)(vv.z >> 16);
    Vt[(d0 + 6) * ld + r] = (bf16)(vv.w & 0xffffu); Vt[(d0 + 7) * ld + r] = (bf16)(vv.w >> 16);
}
constexpr float LOG2E = 1.4426950408889634f;
typedef short s16x4 __attribute__((ext_vector_type(4)));
__device__ __forceinline__ bf16x8 tr_frag(const LAS bf16* tile, int ld, int r0, int r1, int c0, int li) {
    const s16x4 lo = __builtin_amdgcn_ds_read_tr16_b64_v4i16((LAS s16x4*)(tile + (r0 + (li >> 2)) * ld + c0 + 4 * (li & 3)));
    const s16x4 hi = __builtin_amdgcn_ds_read_tr16_b64_v4i16((LAS s16x4*)(tile + (r1 + (li >> 2)) * ld + c0 + 4 * (li & 3)));
    return (bf16x8){lo.x, lo.y, lo.z, lo.w, hi.x, hi.y, hi.z, hi.w};
}
__device__ __forceinline__ void ph_ret1(const Args& A, int l, int nctx_units, LAS unsigned char* lds, int tid) {
    LAS bf16* Kf = (LAS bf16*)lds; LAS bf16* Kb = Kf + 128 * 72; LAS bf16* Vs = Kb + 128 * 72;
    const bf16* Z = (const bf16*)(wsb() + WS_Z); float* KV = (float*)(wsb() + WS_KV); const f32x2* rope = (const f32x2*)(wsb() + WS_ROPE);
    const int lane = tid & 63, w = tid >> 6, g = lane >> 4, li = lane & 15;
    const int tok = tid >> 2, pp = tid & 3, a = (pp & 1) + ((pp >> 1) << 2);
    const int nunits = 1024 + nctx_units;
    v4u pk[2], pv[4];
#define R1_DEC(uid_, b_, h_, n_, ci_, m0_, isc_) const bool isc_ = (uid_) >= 1024; int b_, h_, n_, ci_; size_t m0_; \
        if (!isc_) { b_ = (uid_) >> 8; h_ = ((uid_) >> 5) & 7; n_ = (uid_) & 31; m0_ = (size_t)b_ * SEQ + n_ * 128; ci_ = 2 + n_; } \
        else { const int i_ = (uid_) - 1024; b_ = i_ >> 4; h_ = (i_ >> 1) & 7; n_ = i_ & 1; m0_ = (size_t)ML + b_ * CL + n_ * 128; ci_ = n_; }
#define R1_LOAD(uid_) do { R1_DEC(uid_, b2, h2, n2, ci2, m02, isc2) (void)ci2; (void)n2; (void)isc2; const bf16* kr = Z + (m02 + tok) * INW + C_RK + h2 * 64; pk[0] = *(const v4u*)(kr + 8 * a); pk[1] = *(const v4u*)(kr + 8 * a + 16); \
        _Pragma("unroll") for (int e = 0; e < 4; ++e) { const int q = tid + 512 * e; pv[e] = *(const v4u*)(Z + (m02 + (q >> 4)) * INW + C_RV + h2 * 128 + (q & 15) * 8); } } while (0)
    int uid = blockIdx.x;
    if (uid < nunits) R1_LOAD(uid);
    for (; uid < nunits; uid += gridDim.x) {
        R1_DEC(uid, b, h, n, ci, m0, isc) (void)m0;
        const float lgf = inp(I_RDEC)[(l * 2 + 0) * 8 + h] * LOG2E, lgb = inp(I_RDEC)[(l * 2 + 1) * 8 + h] * LOG2E;
        __syncthreads();
        { float lo[8], hi[8]; unpack8(pk[0], lo); unpack8(pk[1], hi);
            if (!isc) { const int t = n * 128 + tok; const int pos = (a < 4) ? (t >> 6) : (t & 63); rope8(lo, hi, rope + pos * 16 + 8 * (a & 1)); }
            const float zf = ex2(lgf * (float)(127 - tok)) * 0.125f, zb = ex2(lgb * (float)tok) * 0.125f;
            float lf[8], hf[8];
#pragma unroll
            for (int e = 0; e < 8; ++e) { lf[e] = lo[e] * zf; hf[e] = hi[e] * zf; lo[e] *= zb; hi[e] *= zb; }
            *(LAS v4u*)(Kf + tok * 72 + 8 * a) = pack8(lf); *(LAS v4u*)(Kf + tok * 72 + 8 * a + 16) = pack8(hf);
            *(LAS v4u*)(Kb + tok * 72 + 8 * a) = pack8(lo); *(LAS v4u*)(Kb + tok * 72 + 8 * a + 16) = pack8(hi); }
#pragma unroll
        for (int e = 0; e < 4; ++e) { const int q = tid + 512 * e; *(LAS v4u*)(Vs + (q >> 4) * 144 + (q & 15) * 8) = pv[e]; }
        __syncthreads();
        if (uid + (int)gridDim.x < nunits) R1_LOAD(uid + (int)gridDim.x);
        bf16x8 af[4];
#pragma unroll
        for (int ks = 0; ks < 4; ++ks) af[ks] = tr_frag(Vs, 144, 32 * ks + 8 * g, 32 * ks + 8 * g + 4, 16 * w, li);
#pragma unroll
        for (int dir = 0; dir < 2; ++dir) { const LAS bf16* KT = dir ? Kb : Kf;
            float* dst = KV + ((size_t)((b * 8 + h) * 2 + dir) * 34 + ci) * 8192;
#pragma unroll
            for (int nc = 0; nc < 4; ++nc) { f32x4 acc = (f32x4){0.f, 0.f, 0.f, 0.f};
#pragma unroll
                for (int ks = 0; ks < 4; ++ks) acc = mfma16(af[ks], tr_frag(KT, 72, 32 * ks + 8 * g, 32 * ks + 8 * g + 4, 16 * nc, li), acc);
#pragma unroll
                for (int j = 0; j < 4; ++j) dst[(16 * w + 4 * g + j) * 64 + 16 * nc + li] = acc[j]; } }
    }
#undef R1_LOAD
}
__device__ __forceinline__ void ph_natt(const Args& A, int l, int mode, LAS unsigned char* lds, int tid) {
    LAS bf16* Qs = (LAS bf16*)lds; LAS bf16* KV0 = (LAS bf16*)lds; LAS float* rpbs = (LAS float*)(lds + 2 * (64 * 136 + 64 * 144) * 2);
    const bf16* Z = (const bf16*)(wsb() + WS_Z); bf16* YS = (bf16*)(wsb() + WS_YS) + (size_t)2 * MT * 1024;
    const int lane = tid & 63, w = tid >> 6, g = lane >> 4, li = lane & 15;
    const float SCALE = 0.08838834764831845f * LOG2E;
    const int sr0 = tid >> 4, sch = tid & 15;
    const int ufirst = mode ? ((int)blockIdx.x - ((int)gridDim.x - 32)) : (int)blockIdx.x, ucount = mode ? 32 : 512;
    if (ufirst < 0) return;
    for (int uid = ufirst; uid < ucount; uid += (mode ? 32 : (int)gridDim.x)) {
        int b, h, rq = 0; size_t m0;
        if (!mode) { b = uid >> 7; h = (uid >> 4) & 7; rq = uid & 15; m0 = (size_t)b * SEQ + rq * 256; }
        else { b = uid >> 3; h = uid & 7; m0 = (size_t)ML + b * CL; }
        const size_t mc0 = (size_t)ML + b * CL;
        const int qr = 4 * rq + (w >> 1), rs_w = min(max(qr - 4, 0), 56);
        const int kr_lo = min(max(4 * rq - 4, 0), 56), kr_hi = min(max(4 * rq - 1, 0), 56) + 7;
        const int nwin = mode ? 0 : (kr_hi - kr_lo + 1), ntile = nwin + 4;
        int qc[2], cs[2], nlo_w[2], nhi_w[2];
#pragma unroll
        for (int i = 0; i < 2; ++i) { const int cw = 2 * (w & 1) + i; qc[i] = 16 * cw + li; cs[i] = min(max(qc[i] - 8, 0), 48);
            nlo_w[i] = (cw <= 1) ? 0 : cw - 1; nhi_w[i] = (cw == 0) ? 1 : ((cw == 3) ? 3 : cw + 1); }
        v4u kreg[2], vreg[2];
#define NA_LOAD(t_) do { const int t__ = (t_); const size_t mk = (t__ < nwin) ? ((size_t)b * SEQ + (kr_lo + t__) * 64) : (mc0 + (t__ - nwin) * 64); \
            _Pragma("unroll") for (int e = 0; e < 2; ++e) { const bf16* zr = Z + (mk + sr0 + 32 * e) * INW + h * 128 + sch * 8; kreg[e] = *(const v4u*)(zr + C_NK); vreg[e] = *(const v4u*)(zr + C_NV); } } while (0)
#define NA_STORE(buf_) do { LAS bf16* Kd = KV0 + (buf_) * (64 * 136 + 64 * 144); LAS bf16* Vd = Kd + 64 * 136; \
            _Pragma("unroll") for (int e = 0; e < 2; ++e) { *(LAS v4u*)(Kd + (sr0 + 32 * e) * 136 + sch * 8) = kreg[e]; *(LAS v4u*)(Vd + (sr0 + 32 * e) * 144 + sch * 8) = vreg[e]; } } while (0)
        __syncthreads();
        NA_LOAD(0);
        for (int q = tid; q < 4096; q += 512) { const int r = q >> 4, chn = q & 15; *(LAS v4u*)(Qs + r * 136 + chn * 8) = *(const v4u*)(Z + (m0 + r) * INW + C_NQ + h * 128 + chn * 8); }
        if (!mode) for (int i = tid; i < 465; i += 512) rpbs[i] = inp(I_RPB)[((size_t)l * 8 + h) * 465 + i] * LOG2E;
        __syncthreads();
        bf16x8 qf[2][4];
#pragma unroll
        for (int i = 0; i < 2; ++i)
#pragma unroll
            for (int ks = 0; ks < 4; ++ks) qf[i][ks] = *(const LAS bf16x8*)(Qs + (32 * w + 16 * i + li) * 136 + 32 * ks + 8 * g);
        __syncthreads();
        NA_STORE(0);
        __syncthreads();
        f32x4 o[2][8];
#pragma unroll
        for (int i = 0; i < 2; ++i)
#pragma unroll
            for (int nd = 0; nd < 8; ++nd) o[i][nd] = (f32x4){0.f, 0.f, 0.f, 0.f};
        float mrun[2] = {-1e30f, -1e30f}, lrun[2] = {0.f, 0.f};
        for (int t = 0; t < ntile; ++t) {
            const bool win = t < nwin; const int kr = kr_lo + t;
            if (t + 1 < ntile) NA_LOAD(t + 1);
            const LAS bf16* Ks = KV0 + (t & 1) * (64 * 136 + 64 * 144); const LAS bf16* Vs = Ks + 64 * 136;
            const bool active = !win || (kr >= rs_w && kr <= rs_w + 7);
            if (active) {
                const int nlo0 = win ? nlo_w[0] : 0, nhi0 = win ? nhi_w[0] : 3, nlo1 = win ? nlo_w[1] : 0, nhi1 = win ? nhi_w[1] : 3;
                f32x4 s[2][4];
#pragma unroll
                for (int n = 0; n < 4; ++n) { s[0][n] = (f32x4){0.f, 0.f, 0.f, 0.f}; s[1][n] = (f32x4){0.f, 0.f, 0.f, 0.f};
                    const bool u0 = (n >= nlo0 && n <= nhi0), u1 = (n >= nlo1 && n <= nhi1);
                    if (u0 || u1) {
#pragma unroll
                        for (int ks = 0; ks < 4; ++ks) { const bf16x8 kf = *(const LAS bf16x8*)(Ks + (16 * n + li) * 136 + 32 * ks + 8 * g);
                            if (u0) s[0][n] = mfma16(kf, qf[0][ks], s[0][n]);
                            if (u1) s[1][n] = mfma16(kf, qf[1][ks], s[1][n]); } } }
                bf16x8 pf[2][2];
#pragma unroll
                for (int i = 0; i < 2; ++i) {
                    float tmax = -1e30f;
#pragma unroll
                    for (int n = 0; n < 4; ++n)
#pragma unroll
                        for (int j = 0; j < 4; ++j) { float v = s[i][n][j] * SCALE;
                            if (win) { const int kc = 16 * n + 4 * g + j; const bool valid = (kc >= cs[i]) && (kc < cs[i] + 16);
                                const int dc = min(max(kc - qc[i] + 15, 0), 30), dr = min(max(kr - qr + 7, 0), 14);
                                v = valid ? v + rpbs[dr * 31 + dc] : -1e30f; }
                            s[i][n][j] = v; tmax = fmaxf(tmax, v); }
                    tmax = fmaxf(tmax, __shfl_xor(tmax, 16)); tmax = fmaxf(tmax, __shfl_xor(tmax, 32));
                    const bool upd = tmax > mrun[i] + 8.0f;
                    const float mnew = upd ? tmax : mrun[i];
                    float psum = 0.f;
#pragma unroll
                    for (int n = 0; n < 4; ++n)
#pragma unroll
                        for (int j = 0; j < 4; ++j) { const float pv = ex2(s[i][n][j] - mnew); s[i][n][j] = pv; psum += pv; }
                    psum += __shfl_xor(psum, 16); psum += __shfl_xor(psum, 32);
                    if (__any(upd)) { const float alpha = ex2(mrun[i] - mnew); lrun[i] *= alpha;
#pragma unroll
                        for (int nd = 0; nd < 8; ++nd) o[i][nd] = o[i][nd] * alpha; }
                    lrun[i] += psum; mrun[i] = mnew;
#pragma unroll
                    for (int kk = 0; kk < 2; ++kk) pf[i][kk] = mk8(pk2(s[i][2 * kk][0], s[i][2 * kk][1]), pk2(s[i][2 * kk][2], s[i][2 * kk][3]), pk2(s[i][2 * kk + 1][0], s[i][2 * kk + 1][1]), pk2(s[i][2 * kk + 1][2], s[i][2 * kk + 1][3]));
                }
#pragma unroll
                for (int kk = 0; kk < 2; ++kk) { const bool u0 = (2 * kk + 1 >= nlo0 && 2 * kk <= nhi0), u1 = (2 * kk + 1 >= nlo1 && 2 * kk <= nhi1);
                    if (u0 || u1) {
#pragma unroll
                        for (int nd = 0; nd < 8; ++nd) { const bf16x8 vf = tr_frag(Vs, 144, 32 * kk + 4 * g, 32 * kk + 16 + 4 * g, 16 * nd, li);
                            if (u0) o[0][nd] = mfma16(vf, pf[0][kk], o[0][nd]);
                            if (u1) o[1][nd] = mfma16(vf, pf[1][kk], o[1][nd]); } } }
            }
            if (t + 1 < ntile) NA_STORE((t + 1) & 1);
            __syncthreads();
        }
#undef NA_LOAD
#undef NA_STORE
#pragma unroll
        for (int i = 0; i < 2; ++i) { const float inv = 1.0f / lrun[i]; const size_t mrow = m0 + 32 * w + 16 * i + li;
#pragma unroll
            for (int nd = 0; nd < 8; ++nd) { v2u wv; wv.x = pk2(o[i][nd][0] * inv, o[i][nd][1] * inv); wv.y = pk2(o[i][nd][2] * inv, o[i][nd][3] * inv);
                *(v2u*)(YS + mrow * 1024 + h * 128 + 16 * nd + 4 * g) = wv; } }
    }
}

__device__ __forceinline__ void ph_hyfft(const Args& A, int l, LAS unsigned char* lds, int tid) {
    LAS f32x2* buf = (LAS f32x2*)lds;
    const bf16* HYT = (const bf16*)(wsb() + WS_HYT); bf16* YT = (bf16*)(wsb() + WS_YT); const f32x2* KF = (const f32x2*)(psb(l & 1) + PS_KF);
    const float* hb = inp(I_HBIAS) + (size_t)l * 2 * 1024;
    const int baseB = (tid >> 5) * 512 + (tid & 31), baseC = (tid >> 1) * 32 + (tid & 1);
    const float thA = (float)tid * (1.0f / 8192.0f), thB = (float)(tid & 31) * (1.0f / 512.0f), thC = (float)(tid & 1) * (1.0f / 32.0f);
    const size_t bstr = (size_t)1024 * SEQ;
    bf16 vr0[8], vr1[8];
#define HF_PTR(u_, part_) (HYT + ((size_t)((part_) * NB + ((u_) & 1) * 2) * 1024 + ((u_) >> 1)) * SEQ)
    int u = blockIdx.x;
    if (u < 2048) { const bf16* vp = HF_PTR(u, 2);
#pragma unroll
        for (int i = 0; i < 8; ++i) { vr0[i] = vp[tid + 512 * i]; vr1[i] = vp[bstr + tid + 512 * i]; } }
    for (; u < 2048; u += gridDim.x) {
        const int c = u >> 1, b0 = (u & 1) * 2;
        float y0[8], y1[8];
#pragma unroll
        for (int i = 0; i < 8; ++i) { y0[i] = bf1(vr0[i]); y1[i] = bf1(vr1[i]); }
#pragma unroll
        for (int ord = 0; ord < 2; ++ord) {
            f32x4 kreg[8]; bf16 xr0[8], xr1[8];
            { const f32x4* kf = (const f32x4*)(KF + (size_t)(ord * 1024 + c) * 8192); const bf16* xp = HF_PTR(u, ord);
#pragma unroll
                for (int r = 0; r < 8; ++r) { kreg[r] = kf[tid + 512 * r]; xr0[r] = xp[tid + 512 * r]; xr1[r] = xp[bstr + tid + 512 * r]; } }
            { f32x2 x[16];
#pragma unroll
                for (int k = 0; k < 8; ++k) { x[k] = (f32x2){y0[k], y1[k]}; x[k + 8] = (f32x2){0.f, 0.f}; }
                dif16<true>(x, thA);
                __syncthreads();
#pragma unroll
                for (int k = 0; k < 16; ++k) buf[fphys(tid) + 544 * k] = x[k]; }
            __syncthreads();
            fft_pass<false, 34>(buf, baseB, thB);
            __syncthreads();
            fft_pass<false, 2>(buf, baseC, thC);
            __syncthreads();
#pragma unroll
            for (int r = 0; r < 8; ++r) { LAS f32x4* pp = (LAS f32x4*)(buf + fphys(2 * tid) + 1088 * r); const f32x4 ab = *pp; const f32x4 kk = kreg[r];
                const float ax = ab.x + ab.z, ay = ab.y + ab.w, bx = ab.x - ab.z, by = ab.y - ab.w;
                const float px = ax * kk.x - ay * kk.y, py = ax * kk.y + ay * kk.x, qx = bx * kk.z - by * kk.w, qy = bx * kk.w + by * kk.z;
                *pp = (f32x4){px + qx, py + qy, px - qx, py - qy}; }
            __syncthreads();
            fft_pass<true, 2>(buf, baseC, thC);
            __syncthreads();
            fft_pass<true, 34>(buf, baseB, thB);
            __syncthreads();
            if (ord == 1 && u + (int)gridDim.x < 2048) { const bf16* vp = HF_PTR(u + (int)gridDim.x, 2);
#pragma unroll
                for (int i = 0; i < 8; ++i) { vr0[i] = vp[tid + 512 * i]; vr1[i] = vp[bstr + tid + 512 * i]; } }
            { f32x2 x[16];
#pragma unroll
                for (int k = 0; k < 16; ++k) x[k] = buf[fphys(tid) + 544 * k];
                idit16(x, thA);
                const float bias = hb[ord * 1024 + c];
#pragma unroll
                for (int k = 0; k < 8; ++k) { y0[k] = bf1(xr0[k]) * (x[k].x + bias * y0[k]); y1[k] = bf1(xr1[k]) * (x[k].y + bias * y1[k]); } }
        }
        bf16* o0 = YT + ((size_t)b0 * 1024 + c) * SEQ;
#pragma unroll
        for (int i = 0; i < 8; ++i) { const int t = tid + 512 * i; o0[t] = (bf16)f2bf(y0[i]); o0[bstr + t] = (bf16)f2bf(y1[i]); }
    }
#undef HF_PTR
}
__device__ __forceinline__ void ph_scan(const Args& A, int l, int tid) {
    float* KV = (float*)(wsb() + WS_KV);
    for (int gt = blockIdx.x * 512 + tid; gt < NB * 8 * 2 * 2048; gt += gridDim.x * 512) {
        const int bhd = gt >> 11, e4 = gt & 2047, dir = bhd & 1, h = (bhd >> 1) & 7;
        const float gC = ex2(inp(I_RDEC)[(l * 2 + dir) * 8 + h] * LOG2E * 128.0f);
        f32x4* base = (f32x4*)(KV + (size_t)bhd * 34 * 8192) + e4;
        f32x4 s = (f32x4){0.f, 0.f, 0.f, 0.f};
#pragma unroll 1
        for (int sb8 = 0; sb8 < 34; sb8 += 8) {
            f32x4 tv[8];
#pragma unroll
            for (int k = 0; k < 8; ++k) { const int step = min(sb8 + k, 33); const int ci = (dir == 0) ? step : (step == 0 ? 1 : (step == 1 ? 0 : 35 - step)); tv[k] = base[(size_t)ci * 2048]; }
#pragma unroll
            for (int k = 0; k < 8; ++k) { const int step = sb8 + k; if (step < 34) { const int ci = (dir == 0) ? step : (step == 0 ? 1 : (step == 1 ? 0 : 35 - step)); base[(size_t)ci * 2048] = s; s = s * gC + tv[k]; } } }
    }
}

__device__ __forceinline__ void ph_hypost(const Args& A, LAS unsigned char* lds, int tid) {
    LAS bf16* T = (LAS bf16*)lds;
    const bf16* YT = (const bf16*)(wsb() + WS_YT); bf16* YS = (bf16*)(wsb() + WS_YS);
    for (int u = blockIdx.x; u < 1024; u += gridDim.x) {
        const int cg = u & 3, tt = (u >> 2) & 63, b = u >> 8;
        __syncthreads();
        for (int q = tid; q < 2048; q += 512) { const int c = q >> 3, t8 = q & 7;
            *(LAS v4u*)(T + c * 72 + t8 * 8) = *(const v4u*)(YT + ((size_t)b * 1024 + cg * 256 + c) * SEQ + tt * 64 + t8 * 8); }
        __syncthreads();
        const int t = tid >> 3, c32 = tid & 7;
#pragma unroll
        for (int q = 0; q < 4; ++q) { const int cb = c32 * 32 + q * 8; v4u w;
            w.x = (unsigned)T[(cb + 0) * 72 + t] | ((unsigned)T[(cb + 1) * 72 + t] << 16); w.y = (unsigned)T[(cb + 2) * 72 + t] | ((unsigned)T[(cb + 3) * 72 + t] << 16);
            w.z = (unsigned)T[(cb + 4) * 72 + t] | ((unsigned)T[(cb + 5) * 72 + t] << 16); w.w = (unsigned)T[(cb + 6) * 72 + t] | ((unsigned)T[(cb + 7) * 72 + t] << 16);
            *(v4u*)(YS + (size_t)(b * SEQ + tt * 64 + t) * 1024 + cg * 256 + cb) = w; }
    }
}
__device__ __forceinline__ void ph_ret3(const Args& A, int l, int nctx_units, LAS unsigned char* lds, int tid) {
    LAS bf16* Qs = (LAS bf16*)lds; LAS bf16* Ks = Qs + 128 * 72; LAS bf16* Vs = Ks + 128 * 72; LAS bf16* Sf = Vs + 128 * 144; LAS bf16* Sb = Sf + 128 * 72;
    const bf16* Z = (const bf16*)(wsb() + WS_Z); const float* KV = (const float*)(wsb() + WS_KV); const f32x2* rope = (const f32x2*)(wsb() + WS_ROPE);
    bf16* YS = (bf16*)(wsb() + WS_YS) + (size_t)MT * 1024;
    const int lane = tid & 63, w = tid >> 6, g = lane >> 4, li = lane & 15;
    const int tok = tid >> 2, pp = tid & 3, a = (pp & 1) + ((pp >> 1) << 2);
    const int nunits = 1024 + nctx_units;
    v4u pk[2], pv[4];
#define R3_LOAD(uid_) do { R1_DEC(uid_, b2, h2, n2, ci2, m02, isc2) (void)n2; (void)isc2; const bf16* qr = Z + (m02 + tok) * INW + C_RQ + h2 * 64; const bf16* kr = Z + (m02 + tok) * INW + C_RK + h2 * 64; \
        (void)qr; pk[0] = *(const v4u*)(kr + 8 * a); pk[1] = *(const v4u*)(kr + 8 * a + 16); \
        (void)ci2; _Pragma("unroll") for (int e = 0; e < 4; ++e) { const int q = tid + 512 * e; pv[e] = *(const v4u*)(Z + (m02 + (q >> 4)) * INW + C_RV + h2 * 128 + (q & 15) * 8); } } while (0)
    int uid = blockIdx.x;
    if (uid < nunits) R3_LOAD(uid);
    for (; uid < nunits; uid += gridDim.x) {
        R1_DEC(uid, b, h, n, ci, m0, isc)
        const float lgf = inp(I_RDEC)[(l * 2 + 0) * 8 + h] * LOG2E, lgb = inp(I_RDEC)[(l * 2 + 1) * 8 + h] * LOG2E;
        __syncthreads();
        { const int t = n * 128 + tok; const int pos = (a < 4) ? (t >> 6) : (t & 63); const f32x2* rt = rope + pos * 16 + 8 * (a & 1);
            float lo[8], hi[8];
            { const bf16* qr = Z + (m0 + tok) * INW + C_RQ + h * 64; unpack8(*(const v4u*)(qr + 8 * a), lo); unpack8(*(const v4u*)(qr + 8 * a + 16), hi); }
            if (!isc) rope8(lo, hi, rt);
            *(LAS v4u*)(Qs + tok * 72 + 8 * a) = pack8(lo); *(LAS v4u*)(Qs + tok * 72 + 8 * a + 16) = pack8(hi);
            unpack8(pk[0], lo); unpack8(pk[1], hi);
            if (!isc) rope8(lo, hi, rt);
#pragma unroll
            for (int e = 0; e < 8; ++e) { lo[e] *= 0.125f; hi[e] *= 0.125f; }
            *(LAS v4u*)(Ks + tok * 72 + 8 * a) = pack8(lo); *(LAS v4u*)(Ks + tok * 72 + 8 * a + 16) = pack8(hi); }
#pragma unroll
        for (int e = 0; e < 4; ++e) { const int q = tid + 512 * e; *(LAS v4u*)(Vs + (q >> 4) * 144 + (q & 15) * 8) = pv[e]; }
#pragma unroll
        for (int dir = 0; dir < 2; ++dir) { LAS bf16* S = dir ? Sb : Sf; const f32x4* src = (const f32x4*)(KV + ((size_t)((b * 8 + h) * 2 + dir) * 34 + ci) * 8192);
#pragma unroll
            for (int e = 0; e < 4; ++e) { const int q = tid + 512 * e; const f32x4 v = src[q]; v2u wv; wv.x = pk2(v.x, v.y); wv.y = pk2(v.z, v.w); *(LAS v2u*)(S + (q >> 4) * 72 + (q & 15) * 4) = wv; } }
        __syncthreads();
        if (uid + (int)gridDim.x < nunits) R3_LOAD(uid + (int)gridDim.x);
        const int iq = 16 * w + li; const size_t mrow = m0 + iq;
        v2u gq[8];
#pragma unroll
        for (int nd = 0; nd < 8; ++nd) gq[nd] = *(const v2u*)(Z + mrow * INW + C_RG + h * 128 + 16 * nd + 4 * g);
        bf16x8 qf[2];
#pragma unroll
        for (int ks = 0; ks < 2; ++ks) qf[ks] = *(const LAS bf16x8*)(Qs + iq * 72 + 32 * ks + 8 * g);
        f32x4 s[8];
#pragma unroll
        for (int nn = 0; nn < 8; ++nn) { s[nn] = (f32x4){0.f, 0.f, 0.f, 0.f};
#pragma unroll
            for (int ks = 0; ks < 2; ++ks) s[nn] = mfma16(*(const LAS bf16x8*)(Ks + (16 * nn + li) * 72 + 32 * ks + 8 * g), qf[ks], s[nn]);
#pragma unroll
            for (int j = 0; j < 4; ++j) { const int d = iq - (16 * nn + 4 * g + j); s[nn][j] *= (d >= 0) ? ex2(lgf * (float)d) : ex2(lgb * (float)(-d)); } }
        f32x4 o[8];
#pragma unroll
        for (int nd = 0; nd < 8; ++nd) o[nd] = (f32x4){0.f, 0.f, 0.f, 0.f};
#pragma unroll
        for (int kk = 0; kk < 4; ++kk) {
            const bf16x8 pf = mk8(pk2(s[2 * kk][0], s[2 * kk][1]), pk2(s[2 * kk][2], s[2 * kk][3]), pk2(s[2 * kk + 1][0], s[2 * kk + 1][1]), pk2(s[2 * kk + 1][2], s[2 * kk + 1][3]));
#pragma unroll
            for (int nd = 0; nd < 8; ++nd) o[nd] = mfma16(tr_frag(Vs, 144, 32 * kk + 4 * g, 32 * kk + 16 + 4 * g, 16 * nd, li), pf, o[nd]); }
        const float xif = ex2(lgf * (float)(iq + 1)), xib = ex2(lgb * (float)(128 - iq));
        float ss = 0.f;
#pragma unroll
        for (int nd = 0; nd < 8; ++nd) { f32x4 tf = (f32x4){0.f, 0.f, 0.f, 0.f}, tb = (f32x4){0.f, 0.f, 0.f, 0.f};
#pragma unroll
            for (int ks = 0; ks < 2; ++ks) { tf = mfma16(*(const LAS bf16x8*)(Sf + (16 * nd + li) * 72 + 32 * ks + 8 * g), qf[ks], tf);
                tb = mfma16(*(const LAS bf16x8*)(Sb + (16 * nd + li) * 72 + 32 * ks + 8 * g), qf[ks], tb); }
            o[nd] = o[nd] + tf * xif + tb * xib;
            ss += (o[nd][0] * o[nd][0] + o[nd][1] * o[nd][1]) + (o[nd][2] * o[nd][2] + o[nd][3] * o[nd][3]); }
        ss += __shfl_xor(ss, 16); ss += __shfl_xor(ss, 32);
        const float rn = 1.0f / sqrtf(ss * (1.0f / 128.0f) + EPS);
#pragma unroll
        for (int nd = 0; nd < 8; ++nd) { const int dv = 16 * nd + 4 * g; const v2u gv = gq[nd];
            const float g0 = bflo(gv.x), g1 = bfhi(gv.x), g2 = bflo(gv.y), g3 = bfhi(gv.y);
            v2u wv; wv.x = pk2(g0 * __builtin_amdgcn_rcpf(1.0f + __expf(-g0)) * o[nd][0] * rn, g1 * __builtin_amdgcn_rcpf(1.0f + __expf(-g1)) * o[nd][1] * rn);
            wv.y = pk2(g2 * __builtin_amdgcn_rcpf(1.0f + __expf(-g2)) * o[nd][2] * rn, g3 * __builtin_amdgcn_rcpf(1.0f + __expf(-g3)) * o[nd][3] * rn);
            *(v2u*)(YS + mrow * 1024 + h * 128 + dv) = wv; }
    }
#undef R3_LOAD
#undef R1_DEC
}

__device__ __forceinline__ float gelu_fx(float x) { const float x2 = x * x; const float arg = x * (x2 * (-2.0f * 1.4426950408889634f * 0.7978845608028654f * 0.044715f) + (-2.0f * 1.4426950408889634f * 0.7978845608028654f));
    return x * __builtin_amdgcn_rcpf(1.0f + __builtin_amdgcn_exp2f(arg)); }
__device__ __forceinline__ void ph_ffnfix(const Args& A, int l, int Mrows, int tid) {
    const bf16* SA = (const bf16*)(wsb() + WS_SA); const bf16* SB = (const bf16*)(wsb() + WS_SB); bf16* U = (bf16*)(wsb() + WS_U);
    const float* cw = inp(I_FFCW) + (size_t)l * 3 * DFF; const float* cb = inp(I_FFCB) + (size_t)l * DFF;
    const int nblk = Mrows / 64;
    for (int u = blockIdx.x; u < nblk * 2; u += gridDim.x) {
        const int blk = u >> 1, hi = u & 1, R = blk * 64 + (hi ? 63 : 0);
        const bool seq_first = (R < ML) ? ((R & (SEQ - 1)) == 0) : ((R & (CL - 1)) == 0), seq_last = (R < ML) ? ((R & (SEQ - 1)) == SEQ - 1) : ((R & (CL - 1)) == CL - 1);
        const bf16* pprev = hi ? SA + ((size_t)blk * 4 + 2) * DFF : SA + ((size_t)(blk - 1) * 4 + 3) * DFF;
        const bf16* pcur = SA + ((size_t)blk * 4 + (hi ? 3 : 0)) * DFF;
        const bf16* pnext = hi ? SA + ((size_t)(blk + 1) * 4 + 0) * DFF : SA + ((size_t)blk * 4 + 1) * DFF;
        const bf16* pb = SB + ((size_t)blk * 2 + hi) * DFF;
        const bool zp = (!hi && seq_first), zn = (hi && seq_last);
        for (int q = tid; q < DFF / 8; q += 512) { const int f = q * 8;
            float am[8], a0[8], aq[8], bg[8]; const v4u z4 = (v4u){0u, 0u, 0u, 0u};
            unpack8(zp ? z4 : *(const v4u*)(pprev + f), am); unpack8(*(const v4u*)(pcur + f), a0); unpack8(zn ? z4 : *(const v4u*)(pnext + f), aq); unpack8(*(const v4u*)(pb + f), bg);
            float r[8];
#pragma unroll
            for (int e = 0; e < 8; ++e) r[e] = gelu_fx(cw[f + e] * am[e] + cw[DFF + f + e] * a0[e] + cw[2 * DFF + f + e] * aq[e] + cb[f + e]) * bg[e];
            *(v4u*)(U + (size_t)R * DFF + f) = pack8(r); }
    }
}
__device__ __forceinline__ void ph_final(const Args& A, int wave, int lane) {
    const int gw = blockIdx.x * NWAVES + wave, NGW = gridDim.x * NWAVES; const float* g = inp(I_GF);
    for (int m = gw; m < ML; m += NGW) { float* xr = outb() + (size_t)m * D; f32x4 v[8]; float ss = 0.f;
#pragma unroll
        for (int j = 0; j < 8; ++j) { v[j] = *(const f32x4*)(xr + (lane + 64 * j) * 4); ss += (v[j].x * v[j].x + v[j].y * v[j].y) + (v[j].z * v[j].z + v[j].w * v[j].w); }
        const float rstd = 1.0f / sqrtf(wave_sum(ss) * (1.0f / D) + EPS);
#pragma unroll
        for (int j = 0; j < 8; ++j) { const int idx = (lane + 64 * j) * 4; *(f32x4*)(xr + idx) = v[j] * rstd * *(const f32x4*)(g + idx); }
    }
}
#ifndef SKEW_US
#define SKEW_US 0
#endif
__device__ __forceinline__ void spin_us(int us) { if (us > 0) { const unsigned long long t0 = __builtin_amdgcn_s_memrealtime(); while (__builtin_amdgcn_s_memrealtime() - t0 < (unsigned long long)us * 100ull) __builtin_amdgcn_s_sleep(8); } }
constexpr int FILT_F = 816, FILT_I = 896;
constexpr int BG_SPLIT = 22016;
constexpr int SEQ_PER_LAYER = 11, NSEQ = 1 + DEPTH * SEQ_PER_LAYER + 1;
__global__ void __launch_bounds__(NWAVES * 64, 2) fwd(Args A) {
    extern __shared__ __attribute__((aligned(16))) unsigned char lds_raw[];
    LAS unsigned char* lds = (LAS unsigned char*)lds_raw;
    volatile LAS unsigned* MISC = (volatile LAS unsigned*)(lds + MISC_OFF);
    for (int u = threadIdx.x; u < (LDS_BYTES - LDSCTL_OFF) / 4; u += NWAVES * 64) ((LAS unsigned*)(lds + LDSCTL_OFF))[u] = 0u;
    __syncthreads();
    (void)xcd_barrier_post((unsigned*)(wsb() + WS_CTL) + CW_BAR, MISC + 8);
    const int lo = A.seq_lo, hi = A.seq_hi;
#ifdef PROBE_K
    unsigned long long pr_acc = 0ull, pr_prev = __builtin_amdgcn_s_memrealtime();
#endif
#define G ((int)gridDim.x)
#ifdef PROBE_SUB
#define PROBE_K 999
#define SUBT(n, stmt) do { unsigned long long t0_ = 0; if ((n) == PROBE_SUB && blockIdx.x == PROBE_WG && threadIdx.x == 0) t0_ = __builtin_amdgcn_s_memrealtime(); stmt; if ((n) == PROBE_SUB && blockIdx.x == PROBE_WG && threadIdx.x == 0) pr_acc += __builtin_amdgcn_s_memrealtime() - t0_; } while (0)
#else
#define SUBT(n, stmt) do { stmt; } while (0)
#endif
#ifdef PROBE_K
#ifndef PROBE_WG
#define PROBE_WG 0
#endif
#ifndef PROBE_WAIT
#define PROBE_WAIT 0
#endif
#define PROBE_PH(s) (((s) == 0) ? 100 : (((s) - 1) % SEQ_PER_LAYER))
#define PROBE_ARRIVE(s) do { if (blockIdx.x == PROBE_WG && threadIdx.x == 0) { const unsigned long long now_ = __builtin_amdgcn_s_memrealtime(); if (!PROBE_WAIT && PROBE_PH(s) == PROBE_K) pr_acc += now_ - pr_prev; pr_prev = now_; } } while (0)
#define PROBE_EXIT(s) do { if (blockIdx.x == PROBE_WG && threadIdx.x == 0) { const unsigned long long now_ = __builtin_amdgcn_s_memrealtime(); if (PROBE_WAIT && PROBE_PH(s) == PROBE_K) pr_acc += now_ - pr_prev; pr_prev = now_; } } while (0)
#else
#define PROBE_ARRIVE(s) do { } while (0)
#define PROBE_EXIT(s) do { } while (0)
#endif
#define RUN(s) (lo <= (s) && (s) < hi)
#ifndef DUP
#define DUP 0
#endif
#define DUPN(id) ((((DUP) >> (id)) & 1) ? 2 : 1)
#define TID_HERE const int tid = otid(), lane = tid & 63, wave = __builtin_amdgcn_readfirstlane(tid >> 6); (void)lane; (void)wave
#ifdef ONLY
#define PH_ON(k) ((k) == ONLY)
#elif defined(SKIP)
#define PH_ON(k) ((k) != SKIP)
#else
#define PH_ON(k) true
#endif
#define SEAM(s) do { PROBE_ARRIVE(s); if (RUN((s) + 1)) { XcdBarrier bar_; bar_.bar = (unsigned*)(wsb() + WS_CTL) + CW_BAR; bar_.x = xb_xcc_id(); bar_.st = (volatile LAS unsigned*)(lds + MISC_OFF) + 8; xcd_barrier(bar_); if (DUPN(16) > 1) xcd_barrier(bar_); } PROBE_EXIT(s); } while (0)
#define H ((bf16*)(wsb() + WS_H))
#define Z ((bf16*)(wsb() + WS_Z))
#define ACC ((bf16*)(wsb() + WS_ACC))
#define U ((bf16*)(wsb() + WS_U))
#define YS ((bf16*)(wsb() + WS_YS))
#define XC ((float*)(wsb() + WS_XC))
#define WIN ((const bf16*)(psb(l & 1) + PS_WIN))
#define WBR ((const bf16*)(psb(l & 1) + PS_WBR))
#define WOUT ((const bf16*)(psb(l & 1) + PS_WOUT))
#define WF1 ((const bf16*)(psb(l & 1) + PS_WF1))
#define WF2 ((const bf16*)(psb(l & 1) + PS_WF2))

    if (PH_ON(100) && RUN(0)) { TID_HERE; ph_prologue(A, lds, tid); __syncthreads(); ph_convert(A, 0, 0, 0, CONV_ITEMS, (int)blockIdx.x, G, lds, wave, lane); __syncthreads(); for (int fl = 0; fl < DEPTH; ++fl) ph_filt1(A, fl, 0, (int)blockIdx.x, G, lds, tid); SEAM(0); }

    for (int l = 0; l < DEPTH; ++l) {
        const int sb = 1 + l * SEQ_PER_LAYER;
        if (hi <= sb || lo >= sb + SEQ_PER_LAYER) continue;
        const bool lastl = (l == DEPTH - 1);
        const int Mrows = lastl ? ML : MT, nctx = lastl ? 0 : 64;
#define modl ((const float*)(wsb() + WS_MOD) + (size_t)l * 5 * 12288)
#define xlat_in ((l == 0) ? inp(I_X) : (const float*)outb())
#define xctx_in ((l == 0) ? inp(I_CTX) : (const float*)XC)

        if (PH_ON(0) && RUN(sb + 0)) { TID_HERE;
            if (l == 0) ph_filt2(A, 0, 0, 0, 1024, (int)blockIdx.x, G, lds, tid);
            else ph_convert(A, l, l & 1, 0, CONV_ITEMS, (int)blockIdx.x, G, lds, wave, lane);
            ph_norm(xlat_in, xctx_in, inp(I_G1) + (size_t)l * D, modl, 0, D, H, MT, (l > 0) ? (const float*)(wsb() + WS_SLAB) : (const float*)nullptr,
                    (const float*)(wsb() + WS_MOD) + ((size_t)(l - 1) * 5 + 4) * 12288 + 5 * D, XC, wave, lane);
            SEAM(sb + 0);
        }
        if (PH_ON(1) && RUN(sb + 1)) { TID_HERE;
            if (SKEW_US > 0 && (blockIdx.x & 8)) spin_us(SKEW_US);
            { pg8::Gemm g{H, WIN, opq(MT), opq(INW), opq(D), 0}; pg8::StaticOrder S; S.init(g.M, g.N, G, (int)blockIdx.x);
              pg8::EpiStore E{Z, INW};
              for (int r_ = 0; r_ < DUPN(15); ++r_) pg8::gemm_phase<pg8::EpiStore, pg8::StaticOrder, PG8_ALIGN, PG8_SP2>(lds, g, S, E); }
            SEAM(sb + 1);
        }
        if (PH_ON(2) && RUN(sb + 2)) { TID_HERE;
            SUBT(1, ph_hyprep(A, l, lds, tid));
            SUBT(2, ph_ret1(A, l, 64, lds, tid));
            SUBT(3, ph_natt(A, l, 0, lds, tid));
            SUBT(4, if (!lastl) ph_hyctx(A, l, lds, tid));
            SEAM(sb + 2);
        }
        if (PH_ON(3) && RUN(sb + 3)) { TID_HERE;
#ifndef NO_D1
            SUBT(5, ph_hyfft(A, l, lds, tid));
#endif
#ifndef NO_D2
            SUBT(6, ph_scan(A, l, tid));
#endif
            SEAM(sb + 3);
        }
        if (PH_ON(4) && RUN(sb + 4)) { TID_HERE;
            SUBT(7, ph_hypost(A, lds, tid));
            SUBT(8, ph_ret3(A, l, nctx, lds, tid));
            if (!lastl) { __syncthreads(); ph_natt(A, l, 1, lds, tid); }
            SEAM(sb + 4);
        }
        if (PH_ON(5) && RUN(sb + 5)) { TID_HERE;
            __syncthreads();
            for (int r_ = 0; r_ < DUPN(13); ++r_)
            for (int i = 0; i < 3; ++i) {
                pg8::Gemm g{YS + (size_t)i * MT * 1024, WBR + (size_t)i * D * 1024, Mrows, opq(D), opq(1024), 0}; pg8::StaticOrder S; S.init(g.M, g.N, G, (int)blockIdx.x);
                pg8::EpiMerge E{ACC, Z + C_GT + i * D, INW, i == 0 ? 1 : 0};
                pg8::gemm_phase<pg8::EpiMerge, pg8::StaticOrder, PG8_ALIGN, PG8_SP2>(lds, g, S, E);
            }
            if (!lastl && blockIdx.x >= 32) { __syncthreads(); ph_filt2(A, l + 1, (l + 1) & 1, 0, FILT_F, (int)blockIdx.x - 32, G - 32, lds, tid); }
            SEAM(sb + 5);
        }
        if (PH_ON(6) && RUN(sb + 6)) { TID_HERE;
            __syncthreads();
            { pg8::Gemm g{ACC, WOUT, opq(ML), opq(D), opq(D), 0}; pg8::StaticOrder S; S.init(g.M, g.N, G, (int)blockIdx.x);
              pg8::EpiResid E{xlat_in, xctx_in, outb(), XC, modl, 2 * D};
              pg8::gemm_phase<pg8::EpiResid, pg8::StaticOrder, PG8_ALIGN, PG8_SP2>(lds, g, S, E); }
            if (!lastl) { pg8::Gemm g{ACC, WOUT, opq(MT), opq(D), opq(D / NSPLIT), opq(D)}; pg8::CtxSplitOrder S{NSPLIT, D / NSPLIT, (int)blockIdx.x};
              pg8::EpiSlab E{(float*)(wsb() + WS_SLAB), D / NSPLIT};
              pg8::gemm_phase<pg8::EpiSlab, pg8::CtxSplitOrder, PG8_ALIGN, PG8_SP2>(lds, g, S, E); }
            SEAM(sb + 6);
        }
        if (PH_ON(7) && RUN(sb + 7)) { TID_HERE;
            ph_norm(outb(), xctx_in, inp(I_G2) + (size_t)l * D, modl, 3 * D, 4 * D, H, Mrows, (const float*)(wsb() + WS_SLAB), modl + (size_t)4 * 12288 + 2 * D, XC, wave, lane);
            SEAM(sb + 7);
        }
        if (PH_ON(8) && RUN(sb + 8)) { TID_HERE;
            __syncthreads();
            if (SKEW_US > 0 && (blockIdx.x & 8)) spin_us(SKEW_US);
            pg8::Gemm g{H, WF1, Mrows, opq(NFF), opq(D), 0}; pg8::StaticOrder S; S.init(g.M, g.N, G, (int)blockIdx.x);
            pg8::EpiFfn E{U, (bf16*)(wsb() + WS_SA), (bf16*)(wsb() + WS_SB), inp(I_FFCW) + (size_t)l * 3 * DFF, inp(I_FFCB) + (size_t)l * DFF};
            for (int r_ = 0; r_ < DUPN(14); ++r_) pg8::gemm_phase<pg8::EpiFfn, pg8::StaticOrder, PG8_ALIGN, PG8_SP2>(lds, g, S, E);
            if (!lastl && blockIdx.x >= 176) { __syncthreads(); ph_filt2(A, l + 1, (l + 1) & 1, FILT_F, FILT_I, (int)blockIdx.x - 176, G - 176, lds, tid); }
            SEAM(sb + 8);
        }
        if (PH_ON(9) && RUN(sb + 9)) { TID_HERE;
            for (int r_ = 0; r_ < DUPN(11); ++r_) ph_ffnfix(A, l, Mrows, tid);
            SEAM(sb + 9);
        }
        if (PH_ON(10) && RUN(sb + 10)) { TID_HERE;
            __syncthreads();
            { pg8::Gemm g{U, WF2, opq(ML), opq(D), opq(DFF), 0}; pg8::StaticOrder S; S.init(g.M, g.N, G, (int)blockIdx.x);
              pg8::EpiResid E{outb(), XC, outb(), XC, modl, 5 * D};
              pg8::gemm_phase<pg8::EpiResid, pg8::StaticOrder, PG8_ALIGN, PG8_SP2>(lds, g, S, E); }
            if (!lastl) { pg8::Gemm g{U, WF2, opq(MT), opq(D), opq(DFF / NSPLIT), opq(DFF)}; pg8::CtxSplitOrder S{NSPLIT, DFF / NSPLIT, (int)blockIdx.x};
              pg8::EpiSlab E{(float*)(wsb() + WS_SLAB), DFF / NSPLIT};
              pg8::gemm_phase<pg8::EpiSlab, pg8::CtxSplitOrder, PG8_ALIGN, PG8_SP2>(lds, g, S, E); }
            if (!lastl && blockIdx.x >= 128) { __syncthreads(); ph_filt2(A, l + 1, (l + 1) & 1, FILT_I, 1024, (int)blockIdx.x - 128, G - 128, lds, tid); }
            SEAM(sb + 10);
        }
    }
    if (PH_ON(101) && RUN(NSEQ - 1)) { TID_HERE; ph_final(A, wave, lane); }
#ifdef PROBE_K
    if (blockIdx.x == PROBE_WG && threadIdx.x == 0) { const unsigned long long t0 = __builtin_amdgcn_s_memrealtime(); while (__builtin_amdgcn_s_memrealtime() - t0 < 4ull * pr_acc) __builtin_amdgcn_s_sleep(8); }
#endif
#undef RUN
#undef SEAM
#undef H
#undef Z
#undef ACC
#undef U
#undef YS
#undef XC
#undef WIN
#undef WBR
#undef WOUT
#undef WF1
#undef WF2
#undef G
#undef modl
#undef xlat_in
#undef xctx_in
}

extern "C" void kernel_launch(void* const* d_in, const int* in_sizes, int n_in, void* d_out, int out_size, void* d_ws, size_t ws_size, hipStream_t stream) {
    static int grid = 0;
    if (grid == 0) {
        if (n_in != 27 || out_size != ML * D || ws_size < WS_END) { fprintf(stderr, "kernel_launch: unexpected shapes (n_in %d out %d ws %zu need %zu)\n", n_in, out_size, ws_size, (size_t)WS_END); grid = -1; return; }
        int dev = 0, cus = 0, per_cu = 0;
        if (hipGetDevice(&dev) != hipSuccess || hipDeviceGetAttribute(&cus, hipDeviceAttributeMultiprocessorCount, dev) != hipSuccess) { grid = -1; return; }
        if (hipFuncSetAttribute((const void*)fwd, hipFuncAttributeMaxDynamicSharedMemorySize, LDS_BYTES) != hipSuccess) { fprintf(stderr, "kernel_launch: hipFuncSetAttribute failed\n"); grid = -1; return; }
        if (hipOccupancyMaxActiveBlocksPerMultiprocessor(&per_cu, (const void*)fwd, NWAVES * 64, LDS_BYTES) != hipSuccess || per_cu < 1) fprintf(stderr, "kernel_launch: occupancy query says %d\n", per_cu);
        (void)hipGetLastError();
        grid = cus;
    }
    if (grid < 0) return;
    (void)hipMemsetAsync((char*)d_ws + WS_CTL, 0, CTL_ZERO_BYTES, stream);
    Args a{};
    for (int i = 0; i < 27; ++i) a.in[i] = (const float*)d_in[i];
    a.out = (float*)d_out; a.ws = (unsigned char*)d_ws;
#if MK_SINGLE
    a.seq_lo = 0; a.seq_hi = NSEQ;
    hipLaunchKernelGGL(fwd, dim3(grid), dim3(NWAVES * 64), LDS_BYTES, stream, a);
#else
    for (int s = 0; s < NSEQ; ++s) { a.seq_lo = s; a.seq_hi = s + 1; hipLaunchKernelGGL(fwd, dim3(grid), dim3(NWAVES * 64), LDS_BYTES, stream, a); }
#endif
}
```

```cpp
#include <hip/hip_runtime.h>
#include <cstdio>
#include <cstdint>
#ifndef MK_SINGLE
#define MK_SINGLE 1
#endif
namespace pg8 {
#define PG8_LAS __attribute__((address_space(3)))
typedef unsigned short bf16_t;
typedef short bf16x8 __attribute__((ext_vector_type(8)));
typedef float f32x4 __attribute__((ext_vector_type(4)));
typedef unsigned u32x4 __attribute__((ext_vector_type(4)));
constexpr int BM = 256, BK = 64, HALF = 128, HTB = HALF * BK * 2  , STAGE_BYTES = 8 * HTB, NXCD = 8, WGM = 8;

__host__ __device__ __forceinline__ int lds_byte(int r, int c) { const int st = (r >> 4) * 2 + (c >> 5), rr = r & 15, cc = c & 31, ob = rr * 64 + cc * 2; return st * 1024 + (ob ^ (((ob >> 9) & 1) << 5)); }
__host__ __device__ __forceinline__ void stage_rc(int b, int& R, int& C) { const int st = b / 1024, sb = b % 1024, swz = sb ^ (((sb >> 9) & 1) << 5); R = (st >> 1) * 16 + swz / 64; C = (st & 1) * 32 + (swz % 64) / 2; }
__host__ __device__ __forceinline__ int perm32(int rho) { const int n = rho >> 4, i = rho & 15; return 8 * (i >> 2) + 4 * n + (i & 3); }

struct Unit { int pm, pn, ko; };
struct Gemm { const bf16_t* A; const bf16_t* Bt; int M, N, K, ld; };

struct StaticOrder {
    int nM, nN, nwg, G, c;
    __host__ __device__ void init(int M, int N, int G_, int c_) { nM = M / BM; nN = N / BM; nwg = nM * nN; G = G_; c = c_; }
    __host__ __device__ bool next(int i, Unit& u) const {
        const long L = (long)i * G + c; if (L >= nwg) return false;
        int wgid = (int)L; { const int q = nwg / NXCD, r = nwg % NXCD, xcd = wgid % NXCD, off = wgid / NXCD; wgid = (xcd < r ? xcd * (q + 1) : r * (q + 1) + (xcd - r) * q) + off; }
        const int nig = WGM * nN, gid = wgid / nig, fm = gid * WGM, gsz = (nM - fm) < WGM ? (nM - fm) : WGM;
        u.pm = fm + ((wgid % nig) % gsz); u.pn = (wgid % nig) / gsz; u.ko = 0; return true;
    }
    __device__ __forceinline__ void a_ready(const Unit&) const {}
    __device__ __forceinline__ void done(const Unit&) const {}
};
__device__ __forceinline__ unsigned cvt_pk_bf16(float lo, float hi) { unsigned r; asm volatile("v_cvt_pk_bf16_f32 %0, %1, %2" : "=v"(r) : "v"(lo), "v"(hi)); return r; }
typedef float f32x2 __attribute__((ext_vector_type(2)));
__device__ __forceinline__ float bflo(unsigned w) { return __uint_as_float(w << 16); }
__device__ __forceinline__ float bfhi(unsigned w) { return __uint_as_float(w & 0xffff0000u); }
__device__ __forceinline__ float sigm(float x) { return __builtin_amdgcn_rcpf(1.0f + __expf(-x)); }
struct EpiStore {
    static constexpr bool PERM = true, AFTER_DRAIN = false;
    bf16_t* O; int ldc;
    __device__ __forceinline__ void operator()(const f32x4 (&acc)[2][2][4][2], const Unit& u, int wr, int wc, int fr, int fq) const {
        const int row0 = u.pm * BM + wr * 64 + fr, col0 = u.pn * BM + wc * 32 + 8 * fq;
#pragma unroll
        for (int ai = 0; ai < 2; ++ai)
#pragma unroll
            for (int m = 0; m < 4; ++m) { bf16_t* rowp = O + (size_t)(row0 + ai * HALF + m * 16) * ldc + col0;
#pragma unroll
                for (int bj = 0; bj < 2; ++bj) { const f32x4 v0 = acc[ai][bj][m][0], v1 = acc[ai][bj][m][1];
                    u32x4 w; w.x = cvt_pk_bf16(v0[0], v0[1]); w.y = cvt_pk_bf16(v0[2], v0[3]); w.z = cvt_pk_bf16(v1[0], v1[1]); w.w = cvt_pk_bf16(v1[2], v1[3]);
                    __builtin_nontemporal_store(w, (u32x4*)(rowp + bj * HALF)); } }
    }
};
struct EpiMerge {
    static constexpr bool PERM = true, AFTER_DRAIN = false;
    bf16_t* O; const bf16_t* gate; int ldg; int first;
    __device__ __forceinline__ void operator()(const f32x4 (&acc)[2][2][4][2], const Unit& u, int wr, int wc, int fr, int fq) const {
        const int row0 = u.pm * BM + wr * 64 + fr, col0 = u.pn * BM + wc * 32 + 8 * fq;
#pragma unroll
        for (int ai = 0; ai < 2; ++ai)
#pragma unroll
            for (int m = 0; m < 4; ++m) { const size_t row = (size_t)(row0 + ai * HALF + m * 16);
#pragma unroll
                for (int bj = 0; bj < 2; ++bj) { const int col = col0 + bj * HALF;
                    const u32x4 gv = *(const u32x4*)(gate + row * ldg + col);
                    u32x4 pv = (u32x4){0u, 0u, 0u, 0u}; if (!first) pv = *(const u32x4*)(O + row * 2048 + col);
                    const f32x4 v0 = acc[ai][bj][m][0], v1 = acc[ai][bj][m][1];
                    u32x4 w;
                    w.x = cvt_pk_bf16(bflo(pv.x) + v0[0] * sigm(bflo(gv.x)), bfhi(pv.x) + v0[1] * sigm(bfhi(gv.x)));
                    w.y = cvt_pk_bf16(bflo(pv.y) + v0[2] * sigm(bflo(gv.y)), bfhi(pv.y) + v0[3] * sigm(bfhi(gv.y)));
                    w.z = cvt_pk_bf16(bflo(pv.z) + v1[0] * sigm(bflo(gv.z)), bfhi(pv.z) + v1[1] * sigm(bfhi(gv.z)));
                    w.w = cvt_pk_bf16(bflo(pv.w) + v1[2] * sigm(bflo(gv.w)), bfhi(pv.w) + v1[3] * sigm(bfhi(gv.w)));
                    *(u32x4*)(O + row * 2048 + col) = w; } }
    }
};
struct EpiResid {
    static constexpr bool PERM = false, AFTER_DRAIN = false;
    const float* base_lat; const float* base_ctx; float* out_lat; float* out_ctx; const float* modl; int goff;
    __device__ __forceinline__ void operator()(const f32x4 (&acc)[2][2][4][2], const Unit& u, int wr, int wc, int fr, int fq) const {
        const bool isctx = u.pm >= 64; const int r = isctx ? 4 : (u.pm >> 4);
        const float* gvp = modl + (size_t)r * 12288 + goff;
        const float* bs = isctx ? base_ctx : base_lat; float* os = isctx ? out_ctx : out_lat;
        const int row0 = (isctx ? u.pm - 64 : u.pm) * BM + wr * 64 + fr, col0 = u.pn * BM + wc * 32 + 4 * fq;
        f32x4 g4[2][2];
#pragma unroll
        for (int bj = 0; bj < 2; ++bj)
#pragma unroll
            for (int n = 0; n < 2; ++n) g4[bj][n] = *(const f32x4*)(gvp + col0 + bj * HALF + n * 16);
#pragma unroll
        for (int ai = 0; ai < 2; ++ai)
#pragma unroll
            for (int m = 0; m < 4; ++m) { const size_t off = (size_t)(row0 + ai * HALF + m * 16) * 2048 + col0;
#pragma unroll
                for (int bj = 0; bj < 2; ++bj)
#pragma unroll
                    for (int n = 0; n < 2; ++n) { const f32x4 b4 = *(const f32x4*)(bs + off + bj * HALF + n * 16);
                        *(f32x4*)(os + off + bj * HALF + n * 16) = b4 + g4[bj][n] * acc[ai][bj][m][n]; } }
    }
};

__device__ __forceinline__ float dpp_ror1(float v) { return __int_as_float(__builtin_amdgcn_update_dpp(0, __float_as_int(v), 0x121, 0xf, 0xf, false)); }
__device__ __forceinline__ float dpp_rol1(float v) { return __int_as_float(__builtin_amdgcn_update_dpp(0, __float_as_int(v), 0x12f, 0xf, 0xf, false)); }
__device__ __forceinline__ float gelu_fast(float x) { const float x2 = x * x; const float arg = x * (x2 * (-2.0f * 1.4426950408889634f * 0.7978845608028654f * 0.044715f) + (-2.0f * 1.4426950408889634f * 0.7978845608028654f));
    return x * __builtin_amdgcn_rcpf(1.0f + __builtin_amdgcn_exp2f(arg)); }
struct EpiFfn {
    static constexpr bool PERM = true, AFTER_DRAIN = false;
    bf16_t* U; bf16_t* SA; bf16_t* SB; const float* cw; const float* cb;
    __device__ __forceinline__ void operator()(const f32x4 (&acc)[2][2][4][2], const Unit& u, int wr, int wc, int fr, int fq) const {
        const int f0 = u.pn * 128 + wc * 32 + 8 * fq;
        f32x4 w0[2], w1[2], w2[2], bb[2];
#pragma unroll
        for (int n = 0; n < 2; ++n) { w0[n] = *(const f32x4*)(cw + f0 + 4 * n); w1[n] = *(const f32x4*)(cw + 5632 + f0 + 4 * n); w2[n] = *(const f32x4*)(cw + 2 * 5632 + f0 + 4 * n); bb[n] = *(const f32x4*)(cb + f0 + 4 * n); }
#pragma unroll
        for (int ai = 0; ai < 2; ++ai) {
            const int row0 = u.pm * BM + ai * HALF + wr * 64 + fr, blk = u.pm * 4 + ai * 2 + wr;
            f32x4 o[4][2];
#pragma unroll
            for (int n = 0; n < 2; ++n)
#pragma unroll
                for (int e = 0; e < 4; ++e) {
                    const float a0 = acc[ai][0][0][n][e], a1 = acc[ai][0][1][n][e], a2 = acc[ai][0][2][n][e], a3 = acc[ai][0][3][n][e];
                    const float r0 = dpp_ror1(a0), r1 = dpp_ror1(a1), r2 = dpp_ror1(a2), r3 = dpp_ror1(a3);
                    const float l0 = dpp_rol1(a0), l1 = dpp_rol1(a1), l2 = dpp_rol1(a2), l3 = dpp_rol1(a3);
                    const bool first = (fr == 0), last = (fr == 15);
                    const float p0 = r0, p1 = first ? r0 : r1, p2 = first ? r1 : r2, p3 = first ? r2 : r3;
                    const float n0 = last ? l1 : l0, n1 = last ? l2 : l1, n2 = last ? l3 : l2, n3 = l3;
                    const float k0 = w0[n][e], k1 = w1[n][e], k2 = w2[n][e], kb = bb[n][e];
                    o[0][n][e] = gelu_fast(k0 * p0 + k1 * a0 + k2 * n0 + kb) * acc[ai][1][0][n][e];
                    o[1][n][e] = gelu_fast(k0 * p1 + k1 * a1 + k2 * n1 + kb) * acc[ai][1][1][n][e];
                    o[2][n][e] = gelu_fast(k0 * p2 + k1 * a2 + k2 * n2 + kb) * acc[ai][1][2][n][e];
                    o[3][n][e] = gelu_fast(k0 * p3 + k1 * a3 + k2 * n3 + kb) * acc[ai][1][3][n][e];
                }
#pragma unroll
            for (int m = 0; m < 4; ++m) { u32x4 w; w.x = cvt_pk_bf16(o[m][0][0], o[m][0][1]); w.y = cvt_pk_bf16(o[m][0][2], o[m][0][3]); w.z = cvt_pk_bf16(o[m][1][0], o[m][1][1]); w.w = cvt_pk_bf16(o[m][1][2], o[m][1][3]);
                *(u32x4*)(U + (size_t)(row0 + m * 16) * 5632 + f0) = w; }
            const int sel = (fr == 0) ? 0 : (fr == 1) ? 1 : (fr == 14) ? 2 : (fr == 15) ? 3 : -1;
            if (sel >= 0) { const int m = (sel < 2) ? 0 : 3;
                const f32x4 a0 = (m == 0) ? acc[ai][0][0][0] : acc[ai][0][3][0], a1 = (m == 0) ? acc[ai][0][0][1] : acc[ai][0][3][1];
                u32x4 w; w.x = cvt_pk_bf16(a0[0], a0[1]); w.y = cvt_pk_bf16(a0[2], a0[3]); w.z = cvt_pk_bf16(a1[0], a1[1]); w.w = cvt_pk_bf16(a1[2], a1[3]);
                *(u32x4*)(SA + ((size_t)blk * 4 + sel) * 5632 + f0) = w;
                if (sel == 0 || sel == 3) { const f32x4 b0 = (m == 0) ? acc[ai][1][0][0] : acc[ai][1][3][0], b1 = (m == 0) ? acc[ai][1][0][1] : acc[ai][1][3][1];
                    u32x4 v; v.x = cvt_pk_bf16(b0[0], b0[1]); v.y = cvt_pk_bf16(b0[2], b0[3]); v.z = cvt_pk_bf16(b1[0], b1[1]); v.w = cvt_pk_bf16(b1[2], b1[3]);
                    *(u32x4*)(SB + ((size_t)blk * 2 + (sel == 0 ? 0 : 1)) * 5632 + f0) = v; } }
        }
    }
};

struct CtxSplitOrder {
    int nsplit, klen, c;
    __device__ __forceinline__ bool next(int i, Unit& u) const { if (i > 0 || c >= 32 * nsplit) return false; const int tile = c / nsplit, s = c - tile * nsplit; u.pm = 64 + (tile >> 3); u.pn = tile & 7; u.ko = s * klen; return true; }
    __device__ __forceinline__ void a_ready(const Unit&) const {}
    __device__ __forceinline__ void done(const Unit&) const {}
};
struct EpiSlab {
    static constexpr bool PERM = false, AFTER_DRAIN = false;
    float* slab; int klen;
    __device__ __forceinline__ void operator()(const f32x4 (&acc)[2][2][4][2], const Unit& u, int wr, int wc, int fr, int fq) const {
        float* os = slab + (size_t)(u.ko / klen) * 1024 * 2048;
        const int row0 = (u.pm - 64) * BM + wr * 64 + fr, col0 = u.pn * BM + wc * 32 + 4 * fq;
#pragma unroll
        for (int ai = 0; ai < 2; ++ai)
#pragma unroll
            for (int m = 0; m < 4; ++m) { const size_t off = (size_t)(row0 + ai * HALF + m * 16) * 2048 + col0;
#pragma unroll
                for (int bj = 0; bj < 2; ++bj)
#pragma unroll
                    for (int n = 0; n < 2; ++n) *(f32x4*)(os + off + bj * HALF + n * 16) = acc[ai][bj][m][n]; }
    }
};
template <class Epi, class Sched, bool ALIGN_EPI = false, bool SP2 = false>
__device__ __forceinline__ void gemm_phase(PG8_LAS unsigned char* lds, const Gemm g, const Sched& S, const Epi& E) {
    int tid_ = threadIdx.x; asm volatile("" : "+v"(tid_)); const int tid = tid_, wid = __builtin_amdgcn_readfirstlane(tid >> 6), lane = tid & 63, wr = wid >> 2, wc = wid & 3, fr = lane & 15, fq = lane >> 4;
    const int K = g.K, nt = K / BK, LD = g.ld ? g.ld : g.K;
    unsigned voffA[2], voffB[2];
#pragma unroll
    for (int i = 0; i < 2; ++i) { int R, C; stage_rc(tid * 16 + i * 8192, R, C); const int Rb = Epi::PERM ? ((R & ~31) + perm32(R & 31)) : R;
        voffA[i] = (unsigned)(R * LD + C) * 2u; voffB[i] = (unsigned)(Rb * LD + C) * 2u; }
    const size_t kstep = (size_t)(BK * 2);
    const size_t hstep = (size_t)HALF * LD * 2;
    const size_t tstep = 2 * hstep;
    const unsigned ldsw = (unsigned)wid * 1024u;
    const int aoff = lds_byte(wr * 64 + fr, fq * 8), boff = lds_byte(wc * 32 + fr, fq * 8);
#define PG8_SA(b, h) (((b) * 2 + (h)) * HTB)
#define PG8_SB(b, h) ((4 + (b) * 2 + (h)) * HTB)
#define PG8_STAGE(bufoff, gbase, voff) do { _Pragma("unroll") for (int _i = 0; _i < 2; ++_i) \
        __builtin_amdgcn_global_load_lds((const unsigned*)((const char*)(gbase) + (voff)[_i]), (PG8_LAS unsigned*)(lds + (bufoff) + ldsw + _i * 8192), 16, 0, 0); } while (0)
#define PG8_LDA(dst, b, h) do { _Pragma("unroll") for (int m = 0; m < 4; ++m) _Pragma("unroll") for (int k = 0; k < 2; ++k) dst[m][k] = *(const PG8_LAS bf16x8*)(lds + PG8_SA(b, h) + aoff + m * 2048 + k * 1024); } while (0)
#define PG8_LDB(dst, b, h) do { _Pragma("unroll") for (int n = 0; n < 2; ++n) _Pragma("unroll") for (int k = 0; k < 2; ++k) dst[n][k] = *(const PG8_LAS bf16x8*)(lds + PG8_SB(b, h) + boff + n * 2048 + k * 1024); } while (0)
#define PG8_MMA(ai, bj, At, Bt) do { __builtin_amdgcn_s_setprio(1); _Pragma("unroll") for (int m = 0; m < 4; ++m) _Pragma("unroll") for (int n = 0; n < 2; ++n) _Pragma("unroll") for (int k = 0; k < 2; ++k) \
        acc[ai][bj][m][n] = __builtin_amdgcn_mfma_f32_16x16x32_bf16(Bt[n][k], At[m][k], acc[ai][bj][m][n], 0, 0, 0); __builtin_amdgcn_s_setprio(0); } while (0)
#define PG8_WAIT_V(n) asm volatile("s_waitcnt vmcnt(" #n ")" ::: "memory")
#define PG8_WAIT_L(n) asm volatile("s_waitcnt lgkmcnt(" #n ")" ::: "memory")
#define PG8_BAR __builtin_amdgcn_s_barrier()
#define PG8_SCHED __builtin_amdgcn_sched_barrier(0)
    Unit cur, nxt; int ui = 0;
    if (!S.next(0, cur)) return;
    f32x4 acc[2][2][4][2];
#pragma unroll
    for (int a = 0; a < 2; ++a)
#pragma unroll
        for (int b = 0; b < 2; ++b)
#pragma unroll
            for (int m = 0; m < 4; ++m)
#pragma unroll
                for (int n = 0; n < 2; ++n) acc[a][b][m][n] = (f32x4){0.f, 0.f, 0.f, 0.f};
    bf16x8 At[4][2], B0[2][2], B1[2][2];
    const char* cA = (const char*)g.A + (size_t)cur.pm * tstep + (size_t)cur.ko * 2; const char* cB = (const char*)g.Bt + (size_t)cur.pn * tstep + (size_t)cur.ko * 2;
    S.a_ready(cur);
    if constexpr (SP2) {
        PG8_STAGE(PG8_SB(0, 0), cB, voffB); PG8_STAGE(PG8_SB(0, 1), cB + hstep, voffB); PG8_STAGE(PG8_SA(0, 0), cA, voffA); PG8_STAGE(PG8_SA(0, 1), cA + hstep, voffA);
        if (wr == 1) PG8_BAR;
        PG8_WAIT_V(2); PG8_BAR;
        PG8_STAGE(PG8_SB(1, 0), cB + kstep, voffB); PG8_STAGE(PG8_SA(1, 0), cA + kstep, voffA); PG8_STAGE(PG8_SB(1, 1), cB + hstep + kstep, voffB);
        PG8_WAIT_V(6); PG8_BAR;
    } else {
        PG8_STAGE(PG8_SB(0, 0), cB, voffB); PG8_STAGE(PG8_SA(0, 0), cA, voffA); PG8_STAGE(PG8_SB(0, 1), cB + hstep, voffB); PG8_STAGE(PG8_SA(0, 1), cA + hstep, voffA);
        if (wr == 1) PG8_BAR;
        PG8_WAIT_V(4); PG8_BAR;
        PG8_STAGE(PG8_SB(1, 0), cB + kstep, voffB); PG8_STAGE(PG8_SA(1, 0), cA + kstep, voffA); PG8_STAGE(PG8_SB(1, 1), cB + hstep + kstep, voffB);
        PG8_WAIT_V(6); PG8_BAR;
    }
    for (;;) {
        const bool has_next = S.next(ui + 1, nxt);
        const char* nA = has_next ? (const char*)g.A + (size_t)nxt.pm * tstep + (size_t)nxt.ko * 2 : cA; const char* nB = has_next ? (const char*)g.Bt + (size_t)nxt.pn * tstep + (size_t)nxt.ko * 2 : cB;
        for (int t = 0; t < nt; t += 2) {
            const bool last = (t == nt - 2);
            const char* a1 = cA + (size_t)(t + 1) * kstep;
            const char* a2 = last ? nA : cA + (size_t)(t + 2) * kstep; const char* b2 = last ? nB : cB + (size_t)(t + 2) * kstep;
            const char* a3 = a2 + kstep; const char* b3 = b2 + kstep;
            if (last && has_next) S.a_ready(nxt);
            if constexpr (SP2) {
            PG8_LDB(B0, 0, 0); PG8_LDB(B1, 0, 1); PG8_SCHED; PG8_LDA(At, 0, 0); PG8_STAGE(PG8_SA(1, 1), a1 + hstep, voffA);
            PG8_WAIT_V(8); PG8_WAIT_L(0); PG8_BAR; PG8_MMA(0, 0, At, B0); PG8_MMA(0, 1, At, B1); PG8_BAR; PG8_SCHED;
            PG8_LDA(At, 0, 1); PG8_STAGE(PG8_SB(0, 0), b2, voffB); PG8_STAGE(PG8_SB(0, 1), b2 + hstep, voffB); PG8_STAGE(PG8_SA(0, 0), a2, voffA);
            PG8_WAIT_V(8); PG8_WAIT_L(0); PG8_BAR; PG8_MMA(1, 0, At, B0); PG8_MMA(1, 1, At, B1); PG8_BAR; PG8_SCHED;
            PG8_LDB(B0, 1, 0); PG8_LDB(B1, 1, 1); PG8_SCHED; PG8_LDA(At, 1, 0); PG8_STAGE(PG8_SA(0, 1), a2 + hstep, voffA);
            PG8_WAIT_V(8); PG8_WAIT_L(0); PG8_BAR; PG8_MMA(0, 0, At, B0); PG8_MMA(0, 1, At, B1); PG8_BAR; PG8_SCHED;
            PG8_LDA(At, 1, 1); PG8_STAGE(PG8_SB(1, 0), b3, voffB); PG8_STAGE(PG8_SB(1, 1), b3 + hstep, voffB); PG8_STAGE(PG8_SA(1, 0), a3, voffA);
            PG8_WAIT_V(8); PG8_WAIT_L(0); PG8_BAR; PG8_MMA(1, 0, At, B0); PG8_MMA(1, 1, At, B1); PG8_BAR; PG8_SCHED;
            } else {
            PG8_LDB(B0, 0, 0); PG8_SCHED; PG8_LDA(At, 0, 0); PG8_STAGE(PG8_SA(1, 1), a1 + hstep, voffA);
            PG8_WAIT_L(8); PG8_BAR; PG8_WAIT_L(0); PG8_MMA(0, 0, At, B0); PG8_BAR; PG8_SCHED;
            PG8_LDB(B1, 0, 1); PG8_STAGE(PG8_SB(0, 0), b2, voffB);
            PG8_BAR; PG8_WAIT_L(0); PG8_MMA(0, 1, At, B1); PG8_BAR;
            PG8_LDA(At, 0, 1); PG8_STAGE(PG8_SA(0, 0), a2, voffA);
            PG8_BAR; PG8_WAIT_L(0); PG8_MMA(1, 0, At, B0); PG8_BAR; PG8_SCHED;
            PG8_STAGE(PG8_SB(0, 1), b2 + hstep, voffB);
            PG8_WAIT_V(6); PG8_BAR; PG8_MMA(1, 1, At, B1); PG8_BAR;
            PG8_LDB(B0, 1, 0); PG8_SCHED; PG8_LDA(At, 1, 0); PG8_STAGE(PG8_SA(0, 1), a2 + hstep, voffA);
            PG8_WAIT_L(8); PG8_BAR; PG8_WAIT_L(0); PG8_MMA(0, 0, At, B0); PG8_BAR; PG8_SCHED;
            PG8_LDB(B1, 1, 1); PG8_STAGE(PG8_SB(1, 0), b3, voffB);
            PG8_BAR; PG8_WAIT_L(0); PG8_MMA(0, 1, At, B1); PG8_BAR;
            PG8_LDA(At, 1, 1); PG8_STAGE(PG8_SA(1, 0), a3, voffA);
            PG8_BAR; PG8_WAIT_L(0); PG8_MMA(1, 0, At, B0); PG8_BAR; PG8_SCHED;
            PG8_STAGE(PG8_SB(1, 1), b3 + hstep, voffB);
            PG8_WAIT_V(6); PG8_BAR; PG8_MMA(1, 1, At, B1); PG8_BAR;
            }
        }
        if constexpr (ALIGN_EPI) { if (wr == 0) PG8_BAR; }
        if constexpr (!Epi::AFTER_DRAIN) { E(acc, cur, wr, wc, fr, fq); S.done(cur); }
        if (!has_next) break;
#pragma unroll
        for (int a = 0; a < 2; ++a)
#pragma unroll
            for (int b = 0; b < 2; ++b)
#pragma unroll
                for (int m = 0; m < 4; ++m)
#pragma unroll
                    for (int n = 0; n < 2; ++n) acc[a][b][m][n] = (f32x4){0.f, 0.f, 0.f, 0.f};
        cur = nxt; cA = nA; cB = nB; ++ui;
        if constexpr (ALIGN_EPI) { if (wr == 1) PG8_BAR; }
    }
    PG8_WAIT_V(0);
    if constexpr (!ALIGN_EPI) { if (wr == 0) PG8_BAR; }
    PG8_BAR;
    if constexpr (Epi::AFTER_DRAIN) { E.fused(acc, cur, wr, wc, fr, fq, lds, wid, lane); S.done(cur); }
#undef PG8_SA
#undef PG8_SB
#undef PG8_STAGE
#undef PG8_LDA
#undef PG8_LDB
#undef PG8_MMA
#undef PG8_WAIT_V
#undef PG8_WAIT_L
#undef PG8_BAR
#undef PG8_SCHED
}
}
#ifndef PG8_SP2
#define PG8_SP2 true
#endif
#ifndef PG8_ALIGN
#define PG8_ALIGN true
#endif
constexpr int D = 2048, NB = 4, SEQ = 4096, CL = 256, DEPTH = 4;
constexpr int ML = NB * SEQ, MC = NB * CL, MT = ML + MC;
constexpr int INW = 15360, DFF = 5632, NFF = 2 * DFF;
constexpr int C_RK = 0, C_RV = 512, C_NK = 1536, C_NV = 2560, C_RQ = 3584, C_RG = 4096, C_NQ = 5120, C_HY = 6144, C_GT = 9216;
constexpr float EPS = 1e-6f;
constexpr int NWAVES = 8;
constexpr size_t al256(size_t x) { return (x + 255) & ~(size_t)255; }
constexpr size_t WS_CTL = 0, CTL_ZERO_BYTES = 1u << 20;
constexpr size_t WS_MOD = WS_CTL + CTL_ZERO_BYTES;
constexpr size_t WS_ROPE = WS_MOD + al256((size_t)4 * 5 * 12288 * 4);
constexpr size_t PS_FH2 = 0;
constexpr size_t PS_FH2B = PS_FH2 + al256((size_t)4352 * 64 * 4);
constexpr size_t PS_TAPC = PS_FH2B + al256((size_t)4352 * 64 * 2);
constexpr size_t PS_KF = PS_TAPC + al256((size_t)2 * 2 * 1024 * 256 * 4);
constexpr size_t PS_WIN = PS_KF + al256((size_t)2 * 1024 * 8192 * 8);
constexpr size_t PS_WBR = PS_WIN + al256((size_t)INW * D * 2);
constexpr size_t PS_WOUT = PS_WBR + al256((size_t)3 * D * 1024 * 2);
constexpr size_t PS_WF1 = PS_WOUT + al256((size_t)D * D * 2);
constexpr size_t PS_WF2 = PS_WF1 + al256((size_t)NFF * D * 2);
constexpr size_t PS_BYTES = PS_WF2 + al256((size_t)D * DFF * 2);
constexpr size_t WS_PSET = WS_ROPE + al256(64 * 16 * 8);
constexpr size_t WS_XC = WS_PSET + 2 * PS_BYTES;
constexpr size_t WS_H = WS_XC + al256((size_t)MC * D * 4);
constexpr size_t WS_Z = WS_H + al256((size_t)MT * D * 2);
constexpr size_t WS_HYT = WS_Z + al256((size_t)MT * INW * 2);
constexpr size_t WS_YT = WS_HYT + al256((size_t)3 * NB * 1024 * SEQ * 2);
constexpr size_t WS_YS = WS_YT + al256((size_t)NB * 1024 * SEQ * 2);
constexpr size_t WS_ACC = WS_YS + al256((size_t)3 * MT * 1024 * 2);
constexpr size_t WS_U = WS_ACC + al256((size_t)MT * D * 2);
constexpr size_t WS_KV = WS_U + al256((size_t)MT * DFF * 2);
constexpr size_t WS_SA = WS_KV + al256((size_t)NB * 8 * 2 * 34 * 8192 * 4);
constexpr size_t WS_SB = WS_SA + al256((size_t)272 * 4 * DFF * 2);
constexpr size_t WS_SLAB = WS_SB + al256((size_t)272 * 2 * DFF * 2);
constexpr size_t WS_FB4 = WS_SLAB + al256((size_t)4 * MC * D * 4);
constexpr size_t WS_END = WS_FB4 + al256((size_t)4 * 4352 * 64 * 2);
constexpr int NSPLIT = 4;
constexpr int CW_BAR = 4096;
constexpr int RING_BYTES = 131072, LDSCTL_OFF = RING_BYTES, MISC_OFF = LDSCTL_OFF + 320, LDS_BYTES = 147456;

#define GAS __attribute__((address_space(1)))
#define LAS __attribute__((address_space(3)))
typedef unsigned short bf16;
typedef unsigned v4u __attribute__((ext_vector_type(4)));
typedef unsigned v2u __attribute__((ext_vector_type(2)));
typedef float f32x4 __attribute__((ext_vector_type(4)));
typedef float f32x2 __attribute__((ext_vector_type(2)));
typedef short bf16x8 __attribute__((ext_vector_type(8)));
typedef GAS unsigned gu32;
#define LDS_WAIT() asm volatile("s_waitcnt lgkmcnt(0)" ::: "memory")
__device__ __forceinline__ unsigned f2bf(float f) { unsigned u = __builtin_bit_cast(unsigned, f); return (u + 0x7fffu + ((u >> 16) & 1u)) >> 16; }
__device__ __forceinline__ unsigned pk2(float lo, float hi) { return f2bf(lo) | (f2bf(hi) << 16); }
__device__ __forceinline__ float bflo(unsigned w) { return __uint_as_float(w << 16); }
__device__ __forceinline__ float bfhi(unsigned w) { return __uint_as_float(w & 0xffff0000u); }
__device__ __forceinline__ float bf1(bf16 b) { return __uint_as_float(((unsigned)b) << 16); }
__device__ __forceinline__ bf16x8 mk8(unsigned a, unsigned b, unsigned c, unsigned d) { v4u v = (v4u){a, b, c, d}; return __builtin_bit_cast(bf16x8, v); }
__device__ __forceinline__ f32x4 mfma16(bf16x8 a, bf16x8 b, f32x4 c) { return __builtin_amdgcn_mfma_f32_16x16x32_bf16(a, b, c, 0, 0, 0); }
__device__ __forceinline__ float sin_rev(float r) { return __builtin_amdgcn_sinf(r - floorf(r)); }
__device__ __forceinline__ float cos_rev(float r) { return __builtin_amdgcn_cosf(r - floorf(r)); }
__device__ __forceinline__ float sin_rad(float x) { return sin_rev(x * 0.15915494309189535f); }
__device__ __forceinline__ float ex2(float x) { return __builtin_amdgcn_exp2f(x); }
__device__ __forceinline__ float wave_sum(float v) {
#pragma unroll
    for (int o = 1; o < 64; o <<= 1) v += __shfl_xor(v, o);
    return v;
}
__device__ __forceinline__ int otid() { int t = threadIdx.x; asm volatile("" : "+v"(t)); return t; }
__device__ __forceinline__ int opq(int v) { asm volatile("" : "+s"(v)); return v; }
#define XB_TMO      128
#define XB_XCNT(j)  (256  + 64 * (j))
#define XB_XSUB(j)  (1280 + 64 * (j))
#define XB_XGEN(j)  (2304 + 64 * (j))
#define XB_TOP      3328
#define XB_TOPGEN   3392
#define XCD_BAR_WORDS 3456
#define XB_SPIN_CAP (1u << 18)

__device__ __forceinline__ unsigned xb_ld(unsigned* p)              { return __hip_atomic_load(p, __ATOMIC_RELAXED, __HIP_MEMORY_SCOPE_AGENT); }
__device__ __forceinline__ unsigned xb_add(unsigned* p, unsigned v) { return __hip_atomic_fetch_add(p, v, __ATOMIC_RELAXED, __HIP_MEMORY_SCOPE_AGENT); }
__device__ __forceinline__ unsigned xb_xcc_id() { return (unsigned)__builtin_amdgcn_s_getreg((3 << 11) | 20) & 0xFu; }
#define XB_SPIN(cond, bar) do { unsigned _sp = 0; while (cond) { __builtin_amdgcn_s_sleep(1); \
    if ((++_sp & 255u) == 0u) { if (xb_ld(&(bar)[XB_TMO])) break; if (_sp > XB_SPIN_CAP) { atomicAdd(&(bar)[XB_TMO], 1u); break; } } } } while (0)

struct XcdBarrier {
    unsigned* bar; unsigned x;
    volatile LAS unsigned* st;
};

__device__ __forceinline__ XcdBarrier xcd_barrier_post(unsigned* bar, volatile LAS unsigned* st) {
    XcdBarrier b; b.bar = bar; b.x = xb_xcc_id(); b.st = st;
    if (threadIdx.x == 0) (void)xb_add(&bar[XB_XCNT(b.x)], 1u);
    return b;
}
__device__ __forceinline__ void xcd_barrier_complete(unsigned* bar, unsigned x, unsigned& nloc, unsigned& nx) {
    const unsigned G = gridDim.x * gridDim.y * gridDim.z;
    unsigned sum, cnt, mine, sp = 0u;
    for (;;) {
        sum = 0u; cnt = 0u; mine = 0u;
#pragma unroll
        for (unsigned j = 0; j < 16; ++j) { const unsigned c = xb_ld(&bar[XB_XCNT(j)]); sum += c; cnt += (c > 0u) ? 1u : 0u; mine = (j == x) ? c : mine; }
        if (sum == G) break;
        __builtin_amdgcn_s_sleep(1);
        if ((++sp & 255u) == 0u) { if (xb_ld(&bar[XB_TMO])) break; if (sp > XB_SPIN_CAP) { atomicAdd(&bar[XB_TMO], 1u); break; } }
    }
    nloc = mine > 0u ? mine : 1u; nx = cnt > 0u ? cnt : 1u;
}

__device__ __forceinline__ void xcd_barrier(const XcdBarrier& b) {
    asm volatile("s_waitcnt vmcnt(0)" ::: "memory");
    __syncthreads();
    if (threadIdx.x == 0) {
        unsigned* bar = b.bar;
        __builtin_amdgcn_s_waitcnt(0);
        unsigned nloc = b.st[0], nx = b.st[1];
        if (nloc == 0u) { xcd_barrier_complete(bar, b.x, nloc, nx); b.st[0] = nloc; b.st[1] = nx; }
        const unsigned old = xb_add(&bar[XB_XSUB(b.x)], 1u);
        const unsigned gen = old / nloc;
        if (old + 1u == (gen + 1u) * nloc) {
            __builtin_amdgcn_fence(__ATOMIC_RELEASE, "agent");
            asm volatile("s_waitcnt vmcnt(0)" ::: "memory");
            const unsigned og = xb_add(&bar[XB_TOP], 1u);
            const unsigned tg = og / nx;
            if (og + 1u == (tg + 1u) * nx) xb_add(&bar[XB_TOPGEN], 1u);
            else XB_SPIN(xb_ld(&bar[XB_TOPGEN]) == tg, bar);
            __builtin_amdgcn_fence(__ATOMIC_ACQUIRE, "agent");
            xb_add(&bar[XB_XGEN(b.x)], 1u);
            asm volatile("s_waitcnt vmcnt(0)" ::: "memory");
        } else {
            XB_SPIN(xb_ld(&bar[XB_XGEN(b.x)]) == gen, bar);
            __builtin_amdgcn_fence(__ATOMIC_ACQUIRE, "agent");
            asm volatile("s_waitcnt vmcnt(0)" ::: "memory");
        }
    }
    __syncthreads();
}
__device__ __forceinline__ void p0_transpose_item(const float* W, int K, int N, bf16* WT, int row_off, LAS float* scr, int item, int lane) {
    const int nblk = N / 32, kb = item / nblk, nb = item % nblk, k0 = 64 * kb, n0 = 32 * nb;
#pragma unroll 16
    for (int i = 0; i < 32; ++i) { const int kk = 2 * i + (lane >> 5); scr[kk * 33 + (lane & 31)] = __builtin_nontemporal_load(W + (size_t)(k0 + kk) * N + n0 + (lane & 31)); }
    LDS_WAIT(); asm volatile("" ::: "memory");
    const int c = lane & 7;
#pragma unroll
    for (int j = 0; j < 4; ++j) { const int n = (lane >> 3) + 8 * j; const LAS float* s = scr + (8 * c) * 33 + n;
        v4u o; o.x = pk2(s[0 * 33], s[1 * 33]); o.y = pk2(s[2 * 33], s[3 * 33]); o.z = pk2(s[4 * 33], s[5 * 33]); o.w = pk2(s[6 * 33], s[7 * 33]);
        __builtin_nontemporal_store(o, (GAS v4u*)(WT + (size_t)(row_off + n0 + n) * K + k0 + 8 * c)); }
    LDS_WAIT(); asm volatile("" ::: "memory");
}
struct Args { const float* in[27]; float* out; unsigned char* ws; int seq_lo, seq_hi; };
__device__ __forceinline__ const float* inp(int i) { const char* ka = (const char*)__builtin_amdgcn_kernarg_segment_ptr(); int off = i * 8; asm volatile("" : "+s"(off)); return *(const float* const*)(ka + off); }
__device__ __forceinline__ unsigned char* wsb() { const char* ka = (const char*)__builtin_amdgcn_kernarg_segment_ptr(); int off = 27 * 8 + 8; asm volatile("" : "+s"(off)); return *(unsigned char* const*)(ka + off); }
__device__ __forceinline__ float* outb() { const char* ka = (const char*)__builtin_amdgcn_kernarg_segment_ptr(); int off = 27 * 8; asm volatile("" : "+s"(off)); return *(float* const*)(ka + off); }
__device__ __forceinline__ unsigned char* psb(int set) { return wsb() + WS_PSET + (size_t)set * PS_BYTES; }
enum { I_X = 0, I_C, I_CTX, I_CCTX, I_WMOD, I_BMOD, I_G1, I_G2, I_WIN, I_HCW, I_HCB, I_FW1, I_FB1, I_FW2, I_FB2, I_FW3, I_FFQ, I_HBIAS, I_RDEC, I_RPB, I_WBR, I_WOUT, I_FFW1, I_FFCW, I_FFCB, I_FFW2, I_GF };

__device__ __forceinline__ void ph_prologue(const Args& A, LAS unsigned char* lds, int tid) {
    LAS float* sc = (LAS float*)lds;
    LAS float* red = sc + 5 * 2048;
    const float* c = inp(I_C); const float* cc = inp(I_CCTX);
    for (int i = tid; i < 5 * 2048; i += 512) { const int r = i >> 11, k = i & 2047; const float v = (r < 4) ? c[r * 2048 + k] : cc[k]; sc[i] = v / (1.0f + __expf(-v)); }
    __syncthreads();
    float* mod = (float*)(wsb() + WS_MOD);
    const int kq = tid >> 6, col = tid & 63;
    for (int u = blockIdx.x; u < DEPTH * 192; u += gridDim.x) {
        const int l = u / 192, n0 = (u % 192) * 64;
        const float* W = inp(I_WMOD) + (size_t)l * 2048 * 12288 + n0 + col;
        float a0 = 0.f, a1 = 0.f, a2 = 0.f, a3 = 0.f, a4 = 0.f;
#pragma unroll 16
        for (int k = kq * 256; k < kq * 256 + 256; ++k) { const float w = W[(size_t)k * 12288];
            a0 += sc[k] * w; a1 += sc[2048 + k] * w; a2 += sc[4096 + k] * w; a3 += sc[6144 + k] * w; a4 += sc[8192 + k] * w; }
        red[(kq * 5 + 0) * 64 + col] = a0; red[(kq * 5 + 1) * 64 + col] = a1; red[(kq * 5 + 2) * 64 + col] = a2; red[(kq * 5 + 3) * 64 + col] = a3; red[(kq * 5 + 4) * 64 + col] = a4;
        __syncthreads();
        if (tid < 320) { const int r = tid >> 6; float s = inp(I_BMOD)[l * 12288 + n0 + col];
#pragma unroll
            for (int q = 0; q < 8; ++q) s += red[(q * 5 + r) * 64 + col];
            mod[((size_t)l * 5 + r) * 12288 + n0 + col] = s; }
        __syncthreads();
    }
    if (blockIdx.x == 0) { f32x2* rope = (f32x2*)(wsb() + WS_ROPE);
        for (int i = tid; i < 1024; i += 512) { const int pos = i >> 4, j = i & 15; const float inv = exp2f(-(float)j * (13.287712379549449f / 16.0f));
            const float rev = (float)pos * inv * 0.15915494309189535f; rope[i] = (f32x2){cos_rev(rev), sin_rev(rev)}; } }
}

__device__ __forceinline__ void ph_convert(const Args& A, int l, int set, int it_lo, int it_hi, int wk, int nwk, LAS unsigned char* lds, int wave, int lane) {
    LAS float* scr = (LAS float*)(lds + wave * 16384);
    const int gw = wk * NWAVES + wave, NGW = nwk * NWAVES;
    constexpr int I_IN = (D / 64) * (INW / 32), I_BR = (1024 / 64) * (D / 32), I_OUT = (D / 64) * (D / 32), I_F1 = (D / 64) * (NFF / 32);
    const float* win = inp(I_WIN) + (size_t)l * D * INW; const float* wbr = inp(I_WBR) + (size_t)l * 3 * 1024 * D; const float* wout = inp(I_WOUT) + (size_t)l * D * D;
    const float* wf1 = inp(I_FFW1) + (size_t)l * D * NFF; const float* wf2 = inp(I_FFW2) + (size_t)l * DFF * D;
    unsigned char* ps = psb(set);
    bf16* WIN = (bf16*)(ps + PS_WIN); bf16* WBR = (bf16*)(ps + PS_WBR); bf16* WOUT = (bf16*)(ps + PS_WOUT); bf16* WF1 = (bf16*)(ps + PS_WF1); bf16* WF2 = (bf16*)(ps + PS_WF2);
    for (int it = it_lo + gw; it < it_hi; it += NGW) {
        int r = it;
        if (r < I_IN) { p0_transpose_item(win, D, INW, WIN, 0, scr, r, lane); continue; } r -= I_IN;
        if (r < I_BR) { p0_transpose_item(wbr, 1024, D, WBR, 0, scr, r, lane); continue; } r -= I_BR;
        if (r < I_BR) { p0_transpose_item(wbr + (size_t)1024 * D, 1024, D, WBR + (size_t)D * 1024, 0, scr, r, lane); continue; } r -= I_BR;
        if (r < I_BR) { p0_transpose_item(wbr + (size_t)2 * 1024 * D, 1024, D, WBR + (size_t)2 * D * 1024, 0, scr, r, lane); continue; } r -= I_BR;
        if (r < I_OUT) { p0_transpose_item(wout, D, D, WOUT, 0, scr, r, lane); continue; } r -= I_OUT;
        if (r < I_F1) { const int n0 = (r % (NFF / 32)) * 32, f0 = (n0 < DFF) ? n0 : n0 - DFF, nrow = 256 * (f0 >> 7) + ((n0 < DFF) ? 0 : 128) + (f0 & 127);
            p0_transpose_item(wf1, D, NFF, WF1, nrow - n0, scr, r, lane); continue; } r -= I_F1;
        p0_transpose_item(wf2, DFF, D, WF2, 0, scr, r, lane);
    }
}
constexpr int CONV_ITEMS = (D / 64) * (INW / 32) + 3 * (1024 / 64) * (D / 32) + (D / 64) * (D / 32) + (D / 64) * (NFF / 32) + (DFF / 64) * (D / 32);
__device__ __forceinline__ void ph_filt1(const Args& A, int l, int set, int wk, int nwk, LAS unsigned char* lds, int tid) {
    LAS float* feat = (LAS float*)lds;
    LAS float* h1 = feat + 8 * 33;
    LAS float* w1s = h1 + 8 * 64;
    LAS float* w2s = w1s + 33 * 64;
    const float* w1 = inp(I_FW1) + (size_t)l * 33 * 64; const float* b1 = inp(I_FB1) + l * 64; const float* w2 = inp(I_FW2) + (size_t)l * 64 * 64; const float* b2 = inp(I_FB2) + l * 64;
    const float* fq = inp(I_FFQ) + l * 64; bf16* FH2B = (bf16*)(wsb() + WS_FB4) + (size_t)l * 4352 * 64;
    const int pl = tid >> 6, o = tid & 63;
    __syncthreads();
    for (int i = tid; i < 33 * 64; i += 512) w1s[i] = w1[i];
    for (int i = tid; i < 64 * 64; i += 512) w2s[i] = w2[i];
    const float b1o = b1[o], b2o = b2[o], fqo = fq[o];
    __syncthreads();
    for (int u = wk; u < 544; u += nwk) {
        const int pos = u * 8 + pl; const bool isc = pos >= 4096; const int Lf = isc ? 256 : 4096, tp = isc ? pos - 4096 : pos;
        if (o < 33) { float f;
            if (o == 0) f = (float)tp / (float)(Lf - 1);
            else { const int i = (o - 1) & 15; const float fr = 1e-4f + (float)i * ((15.0f - 1e-4f) / 15.0f); const float rev = fr * (float)tp / (float)Lf; f = (o <= 16) ? cos_rev(rev) : -sin_rev(rev); }
            feat[pl * 33 + o] = f; }
        __syncthreads();
        float a = b1o;
#pragma unroll 11
        for (int i = 0; i < 33; ++i) a += feat[pl * 33 + i] * w1s[i * 64 + o];
        h1[pl * 64 + o] = sin_rad(fqo * a);
        __syncthreads();
        float b = b2o;
#pragma unroll 16
        for (int j = 0; j < 64; ++j) b += h1[pl * 64 + j] * w2s[j * 64 + o];
        FH2B[(size_t)pos * 64 + o] = (bf16)f2bf(sin_rad(fqo * b));
        __syncthreads();
    }
}
__device__ __forceinline__ void ph_norm(const float* xlat, const float* xctx, const float* g, const float* modl, int sh_off, int sc_off, bf16* H, int Mrows, const float* slab, const float* sgate, float* xc_out, int wave, int lane) {
    const int gw = blockIdx.x * NWAVES + wave, NGW = gridDim.x * NWAVES;
    for (int base = gw * 8; base < ML; base += NGW * 8) {
        const float* mv = modl + (size_t)(base >> 12) * 12288;
        f32x4 Gv[8], Sv[8];
#pragma unroll
        for (int j = 0; j < 8; ++j) { const int idx = (lane + 64 * j) * 4; Gv[j] = *(const f32x4*)(g + idx) * (*(const f32x4*)(mv + sc_off + idx) + 1.0f); Sv[j] = *(const f32x4*)(mv + sh_off + idx); }
        f32x4 v[8], nx[8];
#pragma unroll
        for (int j = 0; j < 8; ++j) nx[j] = *(const f32x4*)(xlat + (size_t)base * D + (lane + 64 * j) * 4);
#pragma unroll 1
        for (int i = 0; i < 8; ++i) { const int m = base + i; float ss = 0.f;
#pragma unroll
            for (int j = 0; j < 8; ++j) { v[j] = nx[j]; ss += (v[j].x * v[j].x + v[j].y * v[j].y) + (v[j].z * v[j].z + v[j].w * v[j].w); }
            if (i < 7) {
#pragma unroll
                for (int j = 0; j < 8; ++j) nx[j] = *(const f32x4*)(xlat + (size_t)(m + 1) * D + (lane + 64 * j) * 4); }
            const float rstd = 1.0f / sqrtf(wave_sum(ss) * (1.0f / D) + EPS);
#pragma unroll
            for (int j = 0; j < 8; ++j) { const int idx = (lane + 64 * j) * 4; const f32x4 y = v[j] * rstd * Gv[j] + Sv[j];
                v2u w; w.x = pk2(y.x, y.y); w.y = pk2(y.z, y.w); *(v2u*)(H + (size_t)m * D + idx) = w; } }
    }
    for (int m = ML + gw; m < Mrows; m += NGW) {
        const float* xr = xctx + (size_t)(m - ML) * D; const float* mv = modl + (size_t)4 * 12288;
        f32x4 v[8]; float ss = 0.f;
#pragma unroll
        for (int j = 0; j < 8; ++j) { const int idx = (lane + 64 * j) * 4; v[j] = *(const f32x4*)(xr + idx);
            if (slab) { const float* sp = slab + (size_t)(m - ML) * D + idx; f32x4 p = *(const f32x4*)sp;
#pragma unroll
                for (int q = 1; q < NSPLIT; ++q) p = p + *(const f32x4*)(sp + (size_t)q * MC * D);
                v[j] = v[j] + *(const f32x4*)(sgate + idx) * p; *(f32x4*)(xc_out + (size_t)(m - ML) * D + idx) = v[j]; }
            ss += (v[j].x * v[j].x + v[j].y * v[j].y) + (v[j].z * v[j].z + v[j].w * v[j].w); }
        const float rstd = 1.0f / sqrtf(wave_sum(ss) * (1.0f / D) + EPS);
#pragma unroll
        for (int j = 0; j < 8; ++j) { const int idx = (lane + 64 * j) * 4;
            const f32x4 gg = *(const f32x4*)(g + idx), sh = *(const f32x4*)(mv + sh_off + idx), sc = *(const f32x4*)(mv + sc_off + idx);
            const f32x4 y = v[j] * rstd * gg * (sc + 1.0f) + sh;
            v2u w; w.x = pk2(y.x, y.y); w.y = pk2(y.z, y.w);
            *(v2u*)(H + (size_t)m * D + idx) = w; }
    }
}

__device__ __forceinline__ int fphys(int i) { return i + 2 * (i >> 5); }
__device__ __forceinline__ void bfly_dif(f32x2& a, f32x2& b, float c, float s) { const f32x2 u = a, v = b; a = u + v; const f32x2 d = u - v; b = __builtin_elementwise_fma(d.yx, (f32x2){s, -s}, d * (f32x2){c, c}); }
__device__ __forceinline__ void bfly_idit(f32x2& a, f32x2& b, float c, float s) { const f32x2 u = a, q = b; const f32x2 v = __builtin_elementwise_fma(q.yx, (f32x2){-s, s}, q * (f32x2){c, c}); a = u + v; b = u - v; }
template <bool ZHI> __device__ __forceinline__ void dif16(f32x2 (&x)[16], float th) {
    asm volatile("" : "+v"(th));
#pragma unroll
    for (int k = 0; k < 8; ++k) { const float fr = th + (float)k * 0.0625f; const float c = __builtin_amdgcn_cosf(fr), s = __builtin_amdgcn_sinf(fr);
        if (ZHI) { const f32x2 u = x[k]; x[k + 8] = (f32x2){u.x * c + u.y * s, u.y * c - u.x * s}; } else bfly_dif(x[k], x[k + 8], c, s); }
#pragma unroll
    for (int k = 0; k < 4; ++k) { const float fr = 2.0f * th + (float)k * 0.125f; const float c = __builtin_amdgcn_cosf(fr), s = __builtin_amdgcn_sinf(fr);
        bfly_dif(x[k], x[k + 4], c, s); bfly_dif(x[8 + k], x[12 + k], c, s); }
#pragma unroll
    for (int k = 0; k < 2; ++k) { const float fr = 4.0f * th + (float)k * 0.25f; const float c = __builtin_amdgcn_cosf(fr), s = __builtin_amdgcn_sinf(fr);
#pragma unroll
        for (int b = 0; b < 16; b += 4) bfly_dif(x[b + k], x[b + k + 2], c, s); }
    { const float fr = 8.0f * th; const float c = __builtin_amdgcn_cosf(fr), s = __builtin_amdgcn_sinf(fr);
#pragma unroll
        for (int b = 0; b < 16; b += 2) bfly_dif(x[b], x[b + 1], c, s); }
}
__device__ __forceinline__ void idit16(f32x2 (&x)[16], float th) {
    asm volatile("" : "+v"(th));
    { const float fr = 8.0f * th; const float c = __builtin_amdgcn_cosf(fr), s = __builtin_amdgcn_sinf(fr);
#pragma unroll
        for (int b = 0; b < 16; b += 2) bfly_idit(x[b], x[b + 1], c, s); }
#pragma unroll
    for (int k = 0; k < 2; ++k) { const float fr = 4.0f * th + (float)k * 0.25f; const float c = __builtin_amdgcn_cosf(fr), s = __builtin_amdgcn_sinf(fr);
#pragma unroll
        for (int b = 0; b < 16; b += 4) bfly_idit(x[b + k], x[b + k + 2], c, s); }
#pragma unroll
    for (int k = 0; k < 4; ++k) { const float fr = 2.0f * th + (float)k * 0.125f; const float c = __builtin_amdgcn_cosf(fr), s = __builtin_amdgcn_sinf(fr);
        bfly_idit(x[k], x[k + 4], c, s); bfly_idit(x[8 + k], x[12 + k], c, s); }
#pragma unroll
    for (int k = 0; k < 8; ++k) { const float fr = th + (float)k * 0.0625f; const float c = __builtin_amdgcn_cosf(fr), s = __builtin_amdgcn_sinf(fr); bfly_idit(x[k], x[k + 8], c, s); }
}
template <bool INV, int PSTRIDE> __device__ __forceinline__ void fft_pass(LAS f32x2* buf, int base, float th) {
    LAS f32x2* p = buf + fphys(base);
    f32x2 x[16];
#pragma unroll
    for (int k = 0; k < 16; ++k) x[k] = p[k * PSTRIDE];
    if (INV) idit16(x, th); else dif16<false>(x, th);
#pragma unroll
    for (int k = 0; k < 16; ++k) p[k * PSTRIDE] = x[k];
}
constexpr int FFT_LDS_BYTES = (8192 + 512 + 8) * 8;
__device__ __forceinline__ float block_sum(float v, LAS float* red, int tid) {
    v = wave_sum(v);
    __syncthreads();
    if ((tid & 63) == 0) red[tid >> 6] = v;
    __syncthreads();
    float s = 0.f;
#pragma unroll
    for (int i = 0; i < 8; ++i) s += red[i];
    return s;
}
__device__ __forceinline__ float hy_delta(int c) { const float d0 = -4.605170185988091f / 0.3f, d1 = -4.605170185988091f / 1.5f; return fabsf(d0 + (d1 - d0) * ((float)c / 1023.0f)); }
__device__ __forceinline__ void ph_filt2(const Args& A, int l, int set, int c_lo, int c_hi, int wk, int nwk, LAS unsigned char* lds, int tid) {
    LAS f32x2* buf = (LAS f32x2*)lds; LAS float* bufs = (LAS float*)lds; LAS float* red = (LAS float*)(lds + FFT_LDS_BYTES + 64); LAS float* w3s = red + 32;
    LAS float* ctap = w3s + 256;
    const float* w3 = inp(I_FW3) + (size_t)l * 64 * 4096; const bf16* FH2B = (const bf16*)(wsb() + WS_FB4) + (size_t)l * 4352 * 64;
    f32x2* KF = (f32x2*)(psb(set) + PS_KF); float* TAPC = (float*)(psb(set) + PS_TAPC);
    const int lane = tid & 63, w = tid >> 6, g = lane >> 4, li = lane & 15;
    for (int c = c_lo + wk; c < c_hi; c += nwk) {
        __syncthreads();
        if (tid < 256) w3s[tid] = w3[(size_t)(tid & 63) * 4096 + (tid >> 7) * 2048 + ((tid >> 6) & 1) * 1024 + c];
        __syncthreads();
        bf16x8 bfr[2];
#pragma unroll
        for (int ks = 0; ks < 2; ++ks) { float v[8];
#pragma unroll
            for (int j = 0; j < 8; ++j) v[j] = (li < 4) ? w3s[li * 64 + 32 * ks + 8 * g + j] : 0.f;
            bfr[ks] = mk8(pk2(v[0], v[1]), pk2(v[2], v[3]), pk2(v[4], v[5]), pk2(v[6], v[7])); }
        const float delta = hy_delta(c); float ssq = 0.f, ssqc = 0.f;
        const int comp = li >> 1;
#pragma unroll 1
        for (int rb = 0; rb < 272; rb += 64) {
            bf16x8 a0[8], a1[8];
#pragma unroll
            for (int rk = 0; rk < 8; ++rk) { const int rt = rb + w + 8 * rk; const bf16* ap = FH2B + (size_t)((rt < 272 ? rt : 0) * 16 + li) * 64 + 8 * g;
                a0[rk] = *(const bf16x8*)ap; a1[rk] = *(const bf16x8*)(ap + 32); }
#pragma unroll
            for (int rk = 0; rk < 8; ++rk) { const int rt = rb + w + 8 * rk; const int t0 = rt * 16;
                f32x4 acc = (f32x4){0.f, 0.f, 0.f, 0.f};
                acc = mfma16(a0[rk], bfr[0], acc); acc = mfma16(a1[rk], bfr[1], acc);
                if (li < 4 && rt < 272) {
                    if (rt < 256) {
#pragma unroll
                        for (int j = 0; j < 4; ++j) { const int t = t0 + 4 * g + j; const float val = acc[j] * __expf(-((float)t * (1.0f / 4095.0f)) * delta);
                            if ((li & 1) == 0) { bufs[2 * fphys(t) + comp] = val; ssq += val * val; }
                            else if (t >= 1) { bufs[2 * fphys(8192 - t) + comp] = val; ssq += val * val; }
                            else bufs[2 * fphys(4096) + comp] = 0.f; }
                    } else {
#pragma unroll
                        for (int j = 0; j < 4; ++j) { const int m = t0 - 4096 + 4 * g + j; const float val = acc[j] * __expf(-((float)m * (1.0f / 255.0f)) * delta);
                            ctap[li * 256 + m] = val; if ((li & 1) == 0 || m >= 1) ssqc += val * val; }
                    }
                }
            }
        }
        const bool o0 = (li < 2), o1 = (li == 2 || li == 3);
        const float scl0 = (1.0f / 8192.0f) / sqrtf(block_sum(o0 ? ssq : 0.f, red, tid) + EPS), scl1 = (1.0f / 8192.0f) / sqrtf(block_sum(o1 ? ssq : 0.f, red, tid) + EPS);
        const float sc0 = 1.0f / sqrtf(block_sum(o0 ? ssqc : 0.f, red, tid) + EPS), sc1 = 1.0f / sqrtf(block_sum(o1 ? ssqc : 0.f, red, tid) + EPS);
        __syncthreads();
        fft_pass<false, 544>(buf, tid, (float)tid * (1.0f / 8192.0f));
        __syncthreads();
        fft_pass<false, 34>(buf, (tid >> 5) * 512 + (tid & 31), (float)(tid & 31) * (1.0f / 512.0f));
        __syncthreads();
        fft_pass<false, 2>(buf, (tid >> 1) * 32 + (tid & 1), (float)(tid & 1) * (1.0f / 32.0f));
        __syncthreads();
#pragma unroll
        for (int r = 0; r < 8; ++r) { LAS f32x4* pp = (LAS f32x4*)(buf + fphys(2 * tid) + 1088 * r); const f32x4 ab = *pp; *pp = (f32x4){ab.x + ab.z, ab.y + ab.w, ab.x - ab.z, ab.y - ab.w}; }
        __syncthreads();
        f32x2* d0 = KF + (size_t)c * 8192; f32x2* d1 = KF + (size_t)(1024 + c) * 8192;
#pragma unroll 4
        for (int i = 0; i < 16; ++i) { const int p = tid + 512 * i; const int f = (int)(__brev((unsigned)p) >> 19); const int pp = (int)(__brev((unsigned)((8192 - f) & 8191)) >> 19);
            const f32x2 z = buf[fphys(p)], zp = buf[fphys(pp)];
            d0[p] = (f32x2){(z.x + zp.x) * 0.5f * scl0, (z.y - zp.y) * 0.5f * scl0};
            d1[p] = (f32x2){(z.y + zp.y) * 0.5f * scl1, (zp.x - z.x) * 0.5f * scl1}; }
        for (int q = tid; q < 1024; q += 512) { const int od = q >> 8, m = q & 255; TAPC[((size_t)od * 1024 + c) * 256 + m] = ctap[q] * ((od < 2) ? sc0 : sc1); }
    }
}

__device__ __forceinline__ void ph_hyprep(const Args& A, int l, LAS unsigned char* lds, int tid) {
    LAS bf16* T = (LAS bf16*)lds;
    const bf16* Z = (const bf16*)(wsb() + WS_Z); bf16* HYT = (bf16*)(wsb() + WS_HYT);
    const float* cw = inp(I_HCW) + (size_t)l * 3 * 3072; const float* cb = inp(I_HCB) + (size_t)l * 3072;
    v4u pre[5];
#define HP_LOAD(u_) do { const int cg_ = (u_) % 12, tt_ = ((u_) / 12) & 63, b_ = (u_) / 768; \
        _Pragma("unroll") for (int e = 0; e < 5; ++e) { const int q = tid + 512 * e; const int r = q >> 5, ch8 = q & 31, t = tt_ * 64 - 1 + r; pre[e] = (v4u){0u, 0u, 0u, 0u}; \
            if (q < 66 * 32 && t >= 0 && t < SEQ) pre[e] = *(const v4u*)(Z + (size_t)(b_ * SEQ + t) * INW + C_HY + cg_ * 256 + ch8 * 8); } } while (0)
    int u = blockIdx.x;
    if (u < 3072) HP_LOAD(u);
    for (; u < 3072; u += gridDim.x) {
        const int cg = u % 12, tt = (u / 12) & 63, b = u / 768;
        __syncthreads();
#pragma unroll
        for (int e = 0; e < 5; ++e) { const int q = tid + 512 * e; if (q < 66 * 32) *(LAS v4u*)(T + (q >> 5) * 264 + (q & 31) * 8) = pre[e]; }
        __syncthreads();
        if (u + (int)gridDim.x < 3072) HP_LOAD(u + (int)gridDim.x);
        const int ch = tid & 255, half = tid >> 8, gch = cg * 256 + ch;
        const float w0 = cw[gch], w1 = cw[3072 + gch], w2 = cw[6144 + gch], bb = cb[gch];
        const int part = gch >> 10, c = gch & 1023;
        bf16* outp = HYT + ((size_t)(part * NB + b) * 1024 + c) * SEQ + tt * 64 + half * 32;
#pragma unroll
        for (int tq = 0; tq < 4; ++tq) { float vv[8];
#pragma unroll
            for (int e = 0; e < 8; ++e) { const int tl = half * 32 + tq * 8 + e;
                vv[e] = w0 * bf1(T[tl * 264 + ch]) + w1 * bf1(T[(tl + 1) * 264 + ch]) + w2 * bf1(T[(tl + 2) * 264 + ch]) + bb; }
            v4u w; w.x = pk2(vv[0], vv[1]); w.y = pk2(vv[2], vv[3]); w.z = pk2(vv[4], vv[5]); w.w = pk2(vv[6], vv[7]);
            *(v4u*)(outp + tq * 8) = w; }
    }
#undef HP_LOAD
}
__device__ __forceinline__ void ph_hyctx(const Args& A, int l, LAS unsigned char* lds, int tid) {
    const bf16* Z = (const bf16*)(wsb() + WS_Z); bf16* YS = (bf16*)(wsb() + WS_YS); const float* TAPC = (const float*)(psb(l & 1) + PS_TAPC);
    const float* cw = inp(I_HCW) + (size_t)l * 3 * 3072; const float* cb = inp(I_HCB) + (size_t)l * 3072; const float* hb = inp(I_HBIAS) + (size_t)l * 2 * 1024;
    const int ch = tid >> 6, q = tid & 63, t0 = 4 * q;
    LAS float* Y = (LAS float*)lds + ch * 1552; LAS float* Y1 = Y + 256; LAS float* G0 = Y + 512; LAS float* G1 = Y + 1032;
    LAS bf16* R = (LAS bf16*)((LAS float*)lds + 8 * 1552);
    for (int u = blockIdx.x; u < 512; u += gridDim.x) {
        const int b = u >> 7, cg8 = (u & 127) * 8, c = cg8 + ch;
        __syncthreads();
        for (int i = tid; i < 768; i += 512) { const int row = i / 3, part = i - row * 3; *(LAS v4u*)(R + row * 24 + part * 8) = *(const v4u*)(Z + (size_t)(ML + b * CL + row) * INW + C_HY + part * 1024 + cg8); }
#pragma unroll
        for (int r = 0; r < 4; ++r) { const int m = t0 + r;
            G0[m + 259] = TAPC[((size_t)(0 * 2 + 0) * 1024 + c) * 256 + m]; G1[m + 259] = TAPC[((size_t)(1 * 2 + 0) * 1024 + c) * 256 + m];
            if (m >= 1) { G0[259 - m] = TAPC[((size_t)(0 * 2 + 1) * 1024 + c) * 256 + m]; G1[259 - m] = TAPC[((size_t)(1 * 2 + 1) * 1024 + c) * 256 + m]; } }
        if (q == 0) { G0[515] = 0.f; G1[515] = 0.f; G0[516] = 0.f; G1[516] = 0.f; }
        __syncthreads();
        float pv[3][4];
#pragma unroll
        for (int part = 0; part < 3; ++part) { const int gch = part * 1024 + c; const float w0 = cw[gch], w1 = cw[3072 + gch], w2 = cw[6144 + gch], bb = cb[gch];
            float zz[6];
#pragma unroll
            for (int e = 0; e < 6; ++e) { const int t = t0 - 1 + e; zz[e] = (t >= 0 && t < CL) ? bf1(R[t * 24 + part * 8 + ch]) : 0.f; }
#pragma unroll
            for (int r = 0; r < 4; ++r) pv[part][r] = w0 * zz[r] + w1 * zz[r + 1] + w2 * zz[r + 2] + bb; }
        *(LAS f32x4*)(Y + t0) = (f32x4){pv[2][0], pv[2][1], pv[2][2], pv[2][3]};
        __syncthreads();
        float yprev[4] = {pv[2][0], pv[2][1], pv[2][2], pv[2][3]};
#pragma unroll
        for (int ord = 0; ord < 2; ++ord) {
            const LAS float* Ys = ord ? Y1 : Y; const LAS float* G = ord ? G1 : G0;
            float acc[4] = {0.f, 0.f, 0.f, 0.f};
#pragma unroll 4
            for (int sp = 0; sp < 64; ++sp) { const f32x4 yv = *(const LAS f32x4*)(Ys + 4 * sp); const LAS float* gp = G + 4 * (q - sp) + 256;
                const f32x4 ga = *(const LAS f32x4*)gp, gb = *(const LAS f32x4*)(gp + 4);
                const float g[8] = {ga.x, ga.y, ga.z, ga.w, gb.x, gb.y, gb.z, gb.w}; const float yy[4] = {yv.x, yv.y, yv.z, yv.w};
#pragma unroll
                for (int r = 0; r < 4; ++r)
#pragma unroll
                    for (int j = 0; j < 4; ++j) acc[r] += yy[j] * g[r - j + 3]; }
            const float bias = hb[ord * 1024 + c];
#pragma unroll
            for (int r = 0; r < 4; ++r) yprev[r] = pv[ord][r] * (acc[r] + bias * yprev[r]);
            if (ord == 0) { *(LAS f32x4*)(Y1 + t0) = (f32x4){yprev[0], yprev[1], yprev[2], yprev[3]}; __syncthreads(); }
        }
#pragma unroll
        for (int r = 0; r < 4; ++r) YS[(size_t)(ML + b * CL + t0 + r) * 1024 + c] = (bf16)f2bf(yprev[r]);
    }
}
__device__ __forceinline__ void unpack8(v4u v, float (&x)[8]) { x[0] = bflo(v.x); x[1] = bfhi(v.x); x[2] = bflo(v.y); x[3] = bfhi(v.y); x[4] = bflo(v.z); x[5] = bfhi(v.z); x[6] = bflo(v.w); x[7] = bfhi(v.w); }
__device__ __forceinline__ v4u pack8(const float (&x)[8]) { v4u w; w.x = pk2(x[0], x[1]); w.y = pk2(x[2], x[3]); w.z = pk2(x[4], x[5]); w.w = pk2(x[6], x[7]); return w; }
__device__ __forceinline__ void rope8(float (&lo)[8], float (&hi)[8], const f32x2* rt) {
#pragma unroll
    for (int e = 0; e < 8; ++e) { const f32x2 cs = rt[e]; const float a = lo[e], b = hi[e]; lo[e] = a * cs.x - b * cs.y; hi[e] = b * cs.x + a * cs.y; }
}
__device__ __forceinline__ void vt_store(LAS bf16* Vt, int ld, int d0, int r, v4u vv) {
    Vt[(d0 + 0) * ld + r] = (bf16)(vv.x & 0xffffu); Vt[(d0 + 1) * ld + r] = (bf16)(vv.x >> 16);
    Vt[(d0 + 2) * ld + r] = (bf16)(vv.y & 0xffffu); Vt[(d0 + 3) * ld + r] = (bf16)(vv.y >> 16);
    Vt[(d0 + 4) * ld + r] = (bf16)(vv.z & 0xffffu); Vt[(d0 + 5) * ld + r] = (bf16)(vv.z >> 16);
    Vt[(d0 + 6) * ld + r] = (bf16)(vv.w & 0xffffu); Vt[(d0 + 7) * ld + r] = (bf16)(vv.w >> 16);
}
constexpr float LOG2E = 1.4426950408889634f;
typedef short s16x4 __attribute__((ext_vector_type(4)));
__device__ __forceinline__ bf16x8 tr_frag(const LAS bf16* tile, int ld, int r0, int r1, int c0, int li) {
    const s16x4 lo = __builtin_amdgcn_ds_read_tr16_b64_v4i16((LAS s16x4*)(tile + (r0 + (li >> 2)) * ld + c0 + 4 * (li & 3)));
    const s16x4 hi = __builtin_amdgcn_ds_read_tr16_b64_v4i16((LAS s16x4*)(tile + (r1 + (li >> 2)) * ld + c0 + 4 * (li & 3)));
    return (bf16x8){lo.x, lo.y, lo.z, lo.w, hi.x, hi.y, hi.z, hi.w};
}
__device__ __forceinline__ void ph_ret1(const Args& A, int l, int nctx_units, LAS unsigned char* lds, int tid) {
    LAS bf16* Kf = (LAS bf16*)lds; LAS bf16* Kb = Kf + 128 * 72; LAS bf16* Vs = Kb + 128 * 72;
    const bf16* Z = (const bf16*)(wsb() + WS_Z); float* KV = (float*)(wsb() + WS_KV); const f32x2* rope = (const f32x2*)(wsb() + WS_ROPE);
    const int lane = tid & 63, w = tid >> 6, g = lane >> 4, li = lane & 15;
    const int tok = tid >> 2, pp = tid & 3, a = (pp & 1) + ((pp >> 1) << 2);
    const int nunits = 1024 + nctx_units;
    v4u pk[2], pv[4];
#define R1_DEC(uid_, b_, h_, n_, ci_, m0_, isc_) const bool isc_ = (uid_) >= 1024; int b_, h_, n_, ci_; size_t m0_; \
        if (!isc_) { b_ = (uid_) >> 8; h_ = ((uid_) >> 5) & 7; n_ = (uid_) & 31; m0_ = (size_t)b_ * SEQ + n_ * 128; ci_ = 2 + n_; } \
        else { const int i_ = (uid_) - 1024; b_ = i_ >> 4; h_ = (i_ >> 1) & 7; n_ = i_ & 1; m0_ = (size_t)ML + b_ * CL + n_ * 128; ci_ = n_; }
#define R1_LOAD(uid_) do { R1_DEC(uid_, b2, h2, n2, ci2, m02, isc2) (void)ci2; (void)n2; (void)isc2; const bf16* kr = Z + (m02 + tok) * INW + C_RK + h2 * 64; pk[0] = *(const v4u*)(kr + 8 * a); pk[1] = *(const v4u*)(kr + 8 * a + 16); \
        _Pragma("unroll") for (int e = 0; e < 4; ++e) { const int q = tid + 512 * e; pv[e] = *(const v4u*)(Z + (m02 + (q >> 4)) * INW + C_RV + h2 * 128 + (q & 15) * 8); } } while (0)
    int uid = blockIdx.x;
    if (uid < nunits) R1_LOAD(uid);
    for (; uid < nunits; uid += gridDim.x) {
        R1_DEC(uid, b, h, n, ci, m0, isc) (void)m0;
        const float lgf = inp(I_RDEC)[(l * 2 + 0) * 8 + h] * LOG2E, lgb = inp(I_RDEC)[(l * 2 + 1) * 8 + h] * LOG2E;
        __syncthreads();
        { float lo[8], hi[8]; unpack8(pk[0], lo); unpack8(pk[1], hi);
            if (!isc) { const int t = n * 128 + tok; const int pos = (a < 4) ? (t >> 6) : (t & 63); rope8(lo, hi, rope + pos * 16 + 8 * (a & 1)); }
            const float zf = ex2(lgf * (float)(127 - tok)) * 0.125f, zb = ex2(lgb * (float)tok) * 0.125f;
            float lf[8], hf[8];
#pragma unroll
            for (int e = 0; e < 8; ++e) { lf[e] = lo[e] * zf; hf[e] = hi[e] * zf; lo[e] *= zb; hi[e] *= zb; }
            *(LAS v4u*)(Kf + tok * 72 + 8 * a) = pack8(lf); *(LAS v4u*)(Kf + tok * 72 + 8 * a + 16) = pack8(hf);
            *(LAS v4u*)(Kb + tok * 72 + 8 * a) = pack8(lo); *(LAS v4u*)(Kb + tok * 72 + 8 * a + 16) = pack8(hi); }
#pragma unroll
        for (int e = 0; e < 4; ++e) { const int q = tid + 512 * e; *(LAS v4u*)(Vs + (q >> 4) * 144 + (q & 15) * 8) = pv[e]; }
        __syncthreads();
        if (uid + (int)gridDim.x < nunits) R1_LOAD(uid + (int)gridDim.x);
        bf16x8 af[4];
#pragma unroll
        for (int ks = 0; ks < 4; ++ks) af[ks] = tr_frag(Vs, 144, 32 * ks + 8 * g, 32 * ks + 8 * g + 4, 16 * w, li);
#pragma unroll
        for (int dir = 0; dir < 2; ++dir) { const LAS bf16* KT = dir ? Kb : Kf;
            float* dst = KV + ((size_t)((b * 8 + h) * 2 + dir) * 34 + ci) * 8192;
#pragma unroll
            for (int nc = 0; nc < 4; ++nc) { f32x4 acc = (f32x4){0.f, 0.f, 0.f, 0.f};
#pragma unroll
                for (int ks = 0; ks < 4; ++ks) acc = mfma16(af[ks], tr_frag(KT, 72, 32 * ks + 8 * g, 32 * ks + 8 * g + 4, 16 * nc, li), acc);
#pragma unroll
                for (int j = 0; j < 4; ++j) dst[(16 * w + 4 * g + j) * 64 + 16 * nc + li] = acc[j]; } }
    }
#undef R1_LOAD
}
__device__ __forceinline__ void ph_natt(const Args& A, int l, int mode, LAS unsigned char* lds, int tid) {
    LAS bf16* Qs = (LAS bf16*)lds; LAS bf16* KV0 = (LAS bf16*)lds; LAS float* rpbs = (LAS float*)(lds + 2 * (64 * 136 + 64 * 144) * 2);
    const bf16* Z = (const bf16*)(wsb() + WS_Z); bf16* YS = (bf16*)(wsb() + WS_YS) + (size_t)2 * MT * 1024;
    const int lane = tid & 63, w = tid >> 6, g = lane >> 4, li = lane & 15;
    const float SCALE = 0.08838834764831845f * LOG2E;
    const int sr0 = tid >> 4, sch = tid & 15;
    const int ufirst = mode ? ((int)blockIdx.x - ((int)gridDim.x - 32)) : (int)blockIdx.x, ucount = mode ? 32 : 512;
    if (ufirst < 0) return;
    for (int uid = ufirst; uid < ucount; uid += (mode ? 32 : (int)gridDim.x)) {
        int b, h, rq = 0; size_t m0;
        if (!mode) { b = uid >> 7; h = (uid >> 4) & 7; rq = uid & 15; m0 = (size_t)b * SEQ + rq * 256; }
        else { b = uid >> 3; h = uid & 7; m0 = (size_t)ML + b * CL; }
        const size_t mc0 = (size_t)ML + b * CL;
        const int qr = 4 * rq + (w >> 1), rs_w = min(max(qr - 4, 0), 56);
        const int kr_lo = min(max(4 * rq - 4, 0), 56), kr_hi = min(max(4 * rq - 1, 0), 56) + 7;
        const int nwin = mode ? 0 : (kr_hi - kr_lo + 1), ntile = nwin + 4;
        int qc[2], cs[2], nlo_w[2], nhi_w[2];
#pragma unroll
        for (int i = 0; i < 2; ++i) { const int cw = 2 * (w & 1) + i; qc[i] = 16 * cw + li; cs[i] = min(max(qc[i] - 8, 0), 48);
            nlo_w[i] = (cw <= 1) ? 0 : cw - 1; nhi_w[i] = (cw == 0) ? 1 : ((cw == 3) ? 3 : cw + 1); }
        v4u kreg[2], vreg[2];
#define NA_LOAD(t_) do { const int t__ = (t_); const size_t mk = (t__ < nwin) ? ((size_t)b * SEQ + (kr_lo + t__) * 64) : (mc0 + (t__ - nwin) * 64); \
            _Pragma("unroll") for (int e = 0; e < 2; ++e) { const bf16* zr = Z + (mk + sr0 + 32 * e) * INW + h * 128 + sch * 8; kreg[e] = *(const v4u*)(zr + C_NK); vreg[e] = *(const v4u*)(zr + C_NV); } } while (0)
#define NA_STORE(buf_) do { LAS bf16* Kd = KV0 + (buf_) * (64 * 136 + 64 * 144); LAS bf16* Vd = Kd + 64 * 136; \
            _Pragma("unroll") for (int e = 0; e < 2; ++e) { *(LAS v4u*)(Kd + (sr0 + 32 * e) * 136 + sch * 8) = kreg[e]; *(LAS v4u*)(Vd + (sr0 + 32 * e) * 144 + sch * 8) = vreg[e]; } } while (0)
        __syncthreads();
        NA_LOAD(0);
        for (int q = tid; q < 4096; q += 512) { const int r = q >> 4, chn = q & 15; *(LAS v4u*)(Qs + r * 136 + chn * 8) = *(const v4u*)(Z + (m0 + r) * INW + C_NQ + h * 128 + chn * 8); }
        if (!mode) for (int i = tid; i < 465; i += 512) rpbs[i] = inp(I_RPB)[((size_t)l * 8 + h) * 465 + i] * LOG2E;
        __syncthreads();
        bf16x8 qf[2][4];
#pragma unroll
        for (int i = 0; i < 2; ++i)
#pragma unroll
            for (int ks = 0; ks < 4; ++ks) qf[i][ks] = *(const LAS bf16x8*)(Qs + (32 * w + 16 * i + li) * 136 + 32 * ks + 8 * g);
        __syncthreads();
        NA_STORE(0);
        __syncthreads();
        f32x4 o[2][8];
#pragma unroll
        for (int i = 0; i < 2; ++i)
#pragma unroll
            for (int nd = 0; nd < 8; ++nd) o[i][nd] = (f32x4){0.f, 0.f, 0.f, 0.f};
        float mrun[2] = {-1e30f, -1e30f}, lrun[2] = {0.f, 0.f};
        for (int t = 0; t < ntile; ++t) {
            const bool win = t < nwin; const int kr = kr_lo + t;
            if (t + 1 < ntile) NA_LOAD(t + 1);
            const LAS bf16* Ks = KV0 + (t & 1) * (64 * 136 + 64 * 144); const LAS bf16* Vs = Ks + 64 * 136;
            const bool active = !win || (kr >= rs_w && kr <= rs_w + 7);
            if (active) {
                const int nlo0 = win ? nlo_w[0] : 0, nhi0 = win ? nhi_w[0] : 3, nlo1 = win ? nlo_w[1] : 0, nhi1 = win ? nhi_w[1] : 3;
                f32x4 s[2][4];
#pragma unroll
                for (int n = 0; n < 4; ++n) { s[0][n] = (f32x4){0.f, 0.f, 0.f, 0.f}; s[1][n] = (f32x4){0.f, 0.f, 0.f, 0.f};
                    const bool u0 = (n >= nlo0 && n <= nhi0), u1 = (n >= nlo1 && n <= nhi1);
                    if (u0 || u1) {
#pragma unroll
                        for (int ks = 0; ks < 4; ++ks) { const bf16x8 kf = *(const LAS bf16x8*)(Ks + (16 * n + li) * 136 + 32 * ks + 8 * g);
                            if (u0) s[0][n] = mfma16(kf, qf[0][ks], s[0][n]);
                            if (u1) s[1][n] = mfma16(kf, qf[1][ks], s[1][n]); } } }
                bf16x8 pf[2][2];
#pragma unroll
                for (int i = 0; i < 2; ++i) {
                    float tmax = -1e30f;
#pragma unroll
                    for (int n = 0; n < 4; ++n)
#pragma unroll
                        for (int j = 0; j < 4; ++j) { float v = s[i][n][j] * SCALE;
                            if (win) { const int kc = 16 * n + 4 * g + j; const bool valid = (kc >= cs[i]) && (kc < cs[i] + 16);
                                const int dc = min(max(kc - qc[i] + 15, 0), 30), dr = min(max(kr - qr + 7, 0), 14);
                                v = valid ? v + rpbs[dr * 31 + dc] : -1e30f; }
                            s[i][n][j] = v; tmax = fmaxf(tmax, v); }
                    tmax = fmaxf(tmax, __shfl_xor(tmax, 16)); tmax = fmaxf(tmax, __shfl_xor(tmax, 32));
                    const bool upd = tmax > mrun[i] + 8.0f;
                    const float mnew = upd ? tmax : mrun[i];
                    float psum = 0.f;
#pragma unroll
                    for (int n = 0; n < 4; ++n)
#pragma unroll
                        for (int j = 0; j < 4; ++j) { const float pv = ex2(s[i][n][j] - mnew); s[i][n][j] = pv; psum += pv; }
                    psum += __shfl_xor(psum, 16); psum += __shfl_xor(psum, 32);
                    if (__any(upd)) { const float alpha = ex2(mrun[i] - mnew); lrun[i] *= alpha;
#pragma unroll
                        for (int nd = 0; nd < 8; ++nd) o[i][nd] = o[i][nd] * alpha; }
                    lrun[i] += psum; mrun[i] = mnew;
#pragma unroll
                    for (int kk = 0; kk < 2; ++kk) pf[i][kk] = mk8(pk2(s[i][2 * kk][0], s[i][2 * kk][1]), pk2(s[i][2 * kk][2], s[i][2 * kk][3]), pk2(s[i][2 * kk + 1][0], s[i][2 * kk + 1][1]), pk2(s[i][2 * kk + 1][2], s[i][2 * kk + 1][3]));
                }
#pragma unroll
                for (int kk = 0; kk < 2; ++kk) { const bool u0 = (2 * kk + 1 >= nlo0 && 2 * kk <= nhi0), u1 = (2 * kk + 1 >= nlo1 && 2 * kk <= nhi1);
                    if (u0 || u1) {
#pragma unroll
                        for (int nd = 0; nd < 8; ++nd) { const bf16x8 vf = tr_frag(Vs, 144, 32 * kk + 4 * g, 32 * kk + 16 + 4 * g, 16 * nd, li);
                            if (u0) o[0][nd] = mfma16(vf, pf[0][kk], o[0][nd]);
                            if (u1) o[1][nd] = mfma16(vf, pf[1][kk], o[1][nd]); } } }
            }
            if (t + 1 < ntile) NA_STORE((t + 1) & 1);
            __syncthreads();
        }
#undef NA_LOAD
#undef NA_STORE
#pragma unroll
        for (int i = 0; i < 2; ++i) { const float inv = 1.0f / lrun[i]; const size_t mrow = m0 + 32 * w + 16 * i + li;
#pragma unroll
            for (int nd = 0; nd < 8; ++nd) { v2u wv; wv.x = pk2(o[i][nd][0] * inv, o[i][nd][1] * inv); wv.y = pk2(o[i][nd][2] * inv, o[i][nd][3] * inv);
                *(v2u*)(YS + mrow * 1024 + h * 128 + 16 * nd + 4 * g) = wv; } }
    }
}

__device__ __forceinline__ void ph_hyfft(const Args& A, int l, LAS unsigned char* lds, int tid) {
    LAS f32x2* buf = (LAS f32x2*)lds;
    const bf16* HYT = (const bf16*)(wsb() + WS_HYT); bf16* YT = (bf16*)(wsb() + WS_YT); const f32x2* KF = (const f32x2*)(psb(l & 1) + PS_KF);
    const float* hb = inp(I_HBIAS) + (size_t)l * 2 * 1024;
    const int baseB = (tid >> 5) * 512 + (tid & 31), baseC = (tid >> 1) * 32 + (tid & 1);
    const float thA = (float)tid * (1.0f / 8192.0f), thB = (float)(tid & 31) * (1.0f / 512.0f), thC = (float)(tid & 1) * (1.0f / 32.0f);
    const size_t bstr = (size_t)1024 * SEQ;
    bf16 vr0[8], vr1[8];
#define HF_PTR(u_, part_) (HYT + ((size_t)((part_) * NB + ((u_) & 1) * 2) * 1024 + ((u_) >> 1)) * SEQ)
    int u = blockIdx.x;
    if (u < 2048) { const bf16* vp = HF_PTR(u, 2);
#pragma unroll
        for (int i = 0; i < 8; ++i) { vr0[i] = vp[tid + 512 * i]; vr1[i] = vp[bstr + tid + 512 * i]; } }
    for (; u < 2048; u += gridDim.x) {
        const int c = u >> 1, b0 = (u & 1) * 2;
        float y0[8], y1[8];
#pragma unroll
        for (int i = 0; i < 8; ++i) { y0[i] = bf1(vr0[i]); y1[i] = bf1(vr1[i]); }
#pragma unroll
        for (int ord = 0; ord < 2; ++ord) {
            f32x4 kreg[8]; bf16 xr0[8], xr1[8];
            { const f32x4* kf = (const f32x4*)(KF + (size_t)(ord * 1024 + c) * 8192); const bf16* xp = HF_PTR(u, ord);
#pragma unroll
                for (int r = 0; r < 8; ++r) { kreg[r] = kf[tid + 512 * r]; xr0[r] = xp[tid + 512 * r]; xr1[r] = xp[bstr + tid + 512 * r]; } }
            { f32x2 x[16];
#pragma unroll
                for (int k = 0; k < 8; ++k) { x[k] = (f32x2){y0[k], y1[k]}; x[k + 8] = (f32x2){0.f, 0.f}; }
                dif16<true>(x, thA);
                __syncthreads();
#pragma unroll
                for (int k = 0; k < 16; ++k) buf[fphys(tid) + 544 * k] = x[k]; }
            __syncthreads();
            fft_pass<false, 34>(buf, baseB, thB);
            __syncthreads();
            fft_pass<false, 2>(buf, baseC, thC);
            __syncthreads();
#pragma unroll
            for (int r = 0; r < 8; ++r) { LAS f32x4* pp = (LAS f32x4*)(buf + fphys(2 * tid) + 1088 * r); const f32x4 ab = *pp; const f32x4 kk = kreg[r];
                const float ax = ab.x + ab.z, ay = ab.y + ab.w, bx = ab.x - ab.z, by = ab.y - ab.w;
                const float px = ax * kk.x - ay * kk.y, py = ax * kk.y + ay * kk.x, qx = bx * kk.z - by * kk.w, qy = bx * kk.w + by * kk.z;
                *pp = (f32x4){px + qx, py + qy, px - qx, py - qy}; }
            __syncthreads();
            fft_pass<true, 2>(buf, baseC, thC);
            __syncthreads();
            fft_pass<true, 34>(buf, baseB, thB);
            __syncthreads();
            if (ord == 1 && u + (int)gridDim.x < 2048) { const bf16* vp = HF_PTR(u + (int)gridDim.x, 2);
#pragma unroll
                for (int i = 0; i < 8; ++i) { vr0[i] = vp[tid + 512 * i]; vr1[i] = vp[bstr + tid + 512 * i]; } }
            { f32x2 x[16];
#pragma unroll
                for (int k = 0; k < 16; ++k) x[k] = buf[fphys(tid) + 544 * k];
                idit16(x, thA);
                const float bias = hb[ord * 1024 + c];
#pragma unroll
                for (int k = 0; k < 8; ++k) { y0[k] = bf1(xr0[k]) * (x[k].x + bias * y0[k]); y1[k] = bf1(xr1[k]) * (x[k].y + bias * y1[k]); } }
        }
        bf16* o0 = YT + ((size_t)b0 * 1024 + c) * SEQ;
#pragma unroll
        for (int i = 0; i < 8; ++i) { const int t = tid + 512 * i; o0[t] = (bf16)f2bf(y0[i]); o0[bstr + t] = (bf16)f2bf(y1[i]); }
    }
#undef HF_PTR
}
__device__ __forceinline__ void ph_scan(const Args& A, int l, int tid) {
    float* KV = (float*)(wsb() + WS_KV);
    for (int gt = blockIdx.x * 512 + tid; gt < NB * 8 * 2 * 2048; gt += gridDim.x * 512) {
        const int bhd = gt >> 11, e4 = gt & 2047, dir = bhd & 1, h = (bhd >> 1) & 7;
        const float gC = ex2(inp(I_RDEC)[(l * 2 + dir) * 8 + h] * LOG2E * 128.0f);
        f32x4* base = (f32x4*)(KV + (size_t)bhd * 34 * 8192) + e4;
        f32x4 s = (f32x4){0.f, 0.f, 0.f, 0.f};
#pragma unroll 1
        for (int sb8 = 0; sb8 < 34; sb8 += 8) {
            f32x4 tv[8];
#pragma unroll
            for (int k = 0; k < 8; ++k) { const int step = min(sb8 + k, 33); const int ci = (dir == 0) ? step : (step == 0 ? 1 : (step == 1 ? 0 : 35 - step)); tv[k] = base[(size_t)ci * 2048]; }
#pragma unroll
            for (int k = 0; k < 8; ++k) { const int step = sb8 + k; if (step < 34) { const int ci = (dir == 0) ? step : (step == 0 ? 1 : (step == 1 ? 0 : 35 - step)); base[(size_t)ci * 2048] = s; s = s * gC + tv[k]; } } }
    }
}

__device__ __forceinline__ void ph_hypost(const Args& A, LAS unsigned char* lds, int tid) {
    LAS bf16* T = (LAS bf16*)lds;
    const bf16* YT = (const bf16*)(wsb() + WS_YT); bf16* YS = (bf16*)(wsb() + WS_YS);
    for (int u = blockIdx.x; u < 1024; u += gridDim.x) {
        const int cg = u & 3, tt = (u >> 2) & 63, b = u >> 8;
        __syncthreads();
        for (int q = tid; q < 2048; q += 512) { const int c = q >> 3, t8 = q & 7;
            *(LAS v4u*)(T + c * 72 + t8 * 8) = *(const v4u*)(YT + ((size_t)b * 1024 + cg * 256 + c) * SEQ + tt * 64 + t8 * 8); }
        __syncthreads();
        const int t = tid >> 3, c32 = tid & 7;
#pragma unroll
        for (int q = 0; q < 4; ++q) { const int cb = c32 * 32 + q * 8; v4u w;
            w.x = (unsigned)T[(cb + 0) * 72 + t] | ((unsigned)T[(cb + 1) * 72 + t] << 16); w.y = (unsigned)T[(cb + 2) * 72 + t] | ((unsigned)T[(cb + 3) * 72 + t] << 16);
            w.z = (unsigned)T[(cb + 4) * 72 + t] | ((unsigned)T[(cb + 5) * 72 + t] << 16); w.w = (unsigned)T[(cb + 6) * 72 + t] | ((unsigned)T[(cb + 7) * 72 + t] << 16);
            *(v4u*)(YS + (size_t)(b * SEQ + tt * 64 + t) * 1024 + cg * 256 + cb) = w; }
    }
}
__device__ __forceinline__ void ph_ret3(const Args& A, int l, int nctx_units, LAS unsigned char* lds, int tid) {
    LAS bf16* Qs = (LAS bf16*)lds; LAS bf16* Ks = Qs + 128 * 72; LAS bf16* Vs = Ks + 128 * 72; LAS bf16* Sf = Vs + 128 * 144; LAS bf16* Sb = Sf + 128 * 72;
    const bf16* Z = (const bf16*)(wsb() + WS_Z); const float* KV = (const float*)(wsb() + WS_KV); const f32x2* rope = (const f32x2*)(wsb() + WS_ROPE);
    bf16* YS = (bf16*)(wsb() + WS_YS) + (size_t)MT * 1024;
    const int lane = tid & 63, w = tid >> 6, g = lane >> 4, li = lane & 15;
    const int tok = tid >> 2, pp = tid & 3, a = (pp & 1) + ((pp >> 1) << 2);
    const int nunits = 1024 + nctx_units;
    v4u pk[2], pv[4];
#define R3_LOAD(uid_) do { R1_DEC(uid_, b2, h2, n2, ci2, m02, isc2) (void)n2; (void)isc2; const bf16* qr = Z + (m02 + tok) * INW + C_RQ + h2 * 64; const bf16* kr = Z + (m02 + tok) * INW + C_RK + h2 * 64; \
        (void)qr; pk[0] = *(const v4u*)(kr + 8 * a); pk[1] = *(const v4u*)(kr + 8 * a + 16); \
        (void)ci2; _Pragma("unroll") for (int e = 0; e < 4; ++e) { const int q = tid + 512 * e; pv[e] = *(const v4u*)(Z + (m02 + (q >> 4)) * INW + C_RV + h2 * 128 + (q & 15) * 8); } } while (0)
    int uid = blockIdx.x;
    if (uid < nunits) R3_LOAD(uid);
    for (; uid < nunits; uid += gridDim.x) {
        R1_DEC(uid, b, h, n, ci, m0, isc)
        const float lgf = inp(I_RDEC)[(l * 2 + 0) * 8 + h] * LOG2E, lgb = inp(I_RDEC)[(l * 2 + 1) * 8 + h] * LOG2E;
        __syncthreads();
        { const int t = n * 128 + tok; const int pos = (a < 4) ? (t >> 6) : (t & 63); const f32x2* rt = rope + pos * 16 + 8 * (a & 1);
            float lo[8], hi[8];
            { const bf16* qr = Z + (m0 + tok) * INW + C_RQ + h * 64; unpack8(*(const v4u*)(qr + 8 * a), lo); unpack8(*(const v4u*)(qr + 8 * a + 16), hi); }
            if (!isc) rope8(lo, hi, rt);
            *(LAS v4u*)(Qs + tok * 72 + 8 * a) = pack8(lo); *(LAS v4u*)(Qs + tok * 72 + 8 * a + 16) = pack8(hi);
            unpack8(pk[0], lo); unpack8(pk[1], hi);
            if (!isc) rope8(lo, hi, rt);
#pragma unroll
            for (int e = 0; e < 8; ++e) { lo[e] *= 0.125f; hi[e] *= 0.125f; }
            *(LAS v4u*)(Ks + tok * 72 + 8 * a) = pack8(lo); *(LAS v4u*)(Ks + tok * 72 + 8 * a + 16) = pack8(hi); }
#pragma unroll
        for (int e = 0; e < 4; ++e) { const int q = tid + 512 * e; *(LAS v4u*)(Vs + (q >> 4) * 144 + (q & 15) * 8) = pv[e]; }
#pragma unroll
        for (int dir = 0; dir < 2; ++dir) { LAS bf16* S = dir ? Sb : Sf; const f32x4* src = (const f32x4*)(KV + ((size_t)((b * 8 + h) * 2 + dir) * 34 + ci) * 8192);
#pragma unroll
            for (int e = 0; e < 4; ++e) { const int q = tid + 512 * e; const f32x4 v = src[q]; v2u wv; wv.x = pk2(v.x, v.y); wv.y = pk2(v.z, v.w); *(LAS v2u*)(S + (q >> 4) * 72 + (q & 15) * 4) = wv; } }
        __syncthreads();
        if (uid + (int)gridDim.x < nunits) R3_LOAD(uid + (int)gridDim.x);
        const int iq = 16 * w + li; const size_t mrow = m0 + iq;
        v2u gq[8];
#pragma unroll
        for (int nd = 0; nd < 8; ++nd) gq[nd] = *(const v2u*)(Z + mrow * INW + C_RG + h * 128 + 16 * nd + 4 * g);
        bf16x8 qf[2];
#pragma unroll
        for (int ks = 0; ks < 2; ++ks) qf[ks] = *(const LAS bf16x8*)(Qs + iq * 72 + 32 * ks + 8 * g);
        f32x4 s[8];
#pragma unroll
        for (int nn = 0; nn < 8; ++nn) { s[nn] = (f32x4){0.f, 0.f, 0.f, 0.f};
#pragma unroll
            for (int ks = 0; ks < 2; ++ks) s[nn] = mfma16(*(const LAS bf16x8*)(Ks + (16 * nn + li) * 72 + 32 * ks + 8 * g), qf[ks], s[nn]);
#pragma unroll
            for (int j = 0; j < 4; ++j) { const int d = iq - (16 * nn + 4 * g + j); s[nn][j] *= (d >= 0) ? ex2(lgf * (float)d) : ex2(lgb * (float)(-d)); } }
        f32x4 o[8];
#pragma unroll
        for (int nd = 0; nd < 8; ++nd) o[nd] = (f32x4){0.f, 0.f, 0.f, 0.f};
#pragma unroll
        for (int kk = 0; kk < 4; ++kk) {
            const bf16x8 pf = mk8(pk2(s[2 * kk][0], s[2 * kk][1]), pk2(s[2 * kk][2], s[2 * kk][3]), pk2(s[2 * kk + 1][0], s[2 * kk + 1][1]), pk2(s[2 * kk + 1][2], s[2 * kk + 1][3]));
#pragma unroll
            for (int nd = 0; nd < 8; ++nd) o[nd] = mfma16(tr_frag(Vs, 144, 32 * kk + 4 * g, 32 * kk + 16 + 4 * g, 16 * nd, li), pf, o[nd]); }
        const float xif = ex2(lgf * (float)(iq + 1)), xib = ex2(lgb * (float)(128 - iq));
        float ss = 0.f;
#pragma unroll
        for (int nd = 0; nd < 8; ++nd) { f32x4 tf = (f32x4){0.f, 0.f, 0.f, 0.f}, tb = (f32x4){0.f, 0.f, 0.f, 0.f};
#pragma unroll
            for (int ks = 0; ks < 2; ++ks) { tf = mfma16(*(const LAS bf16x8*)(Sf + (16 * nd + li) * 72 + 32 * ks + 8 * g), qf[ks], tf);
                tb = mfma16(*(const LAS bf16x8*)(Sb + (16 * nd + li) * 72 + 32 * ks + 8 * g), qf[ks], tb); }
            o[nd] = o[nd] + tf * xif + tb * xib;
            ss += (o[nd][0] * o[nd][0] + o[nd][1] * o[nd][1]) + (o[nd][2] * o[nd][2] + o[nd][3] * o[nd][3]); }
        ss += __shfl_xor(ss, 16); ss += __shfl_xor(ss, 32);
        const float rn = 1.0f / sqrtf(ss * (1.0f / 128.0f) + EPS);
#pragma unroll
        for (int nd = 0; nd < 8; ++nd) { const int dv = 16 * nd + 4 * g; const v2u gv = gq[nd];
            const float g0 = bflo(gv.x), g1 = bfhi(gv.x), g2 = bflo(gv.y), g3 = bfhi(gv.y);
            v2u wv; wv.x = pk2(g0 * __builtin_amdgcn_rcpf(1.0f + __expf(-g0)) * o[nd][0] * rn, g1 * __builtin_amdgcn_rcpf(1.0f + __expf(-g1)) * o[nd][1] * rn);
            wv.y = pk2(g2 * __builtin_amdgcn_rcpf(1.0f + __expf(-g2)) * o[nd][2] * rn, g3 * __builtin_amdgcn_rcpf(1.0f + __expf(-g3)) * o[nd][3] * rn);
            *(v2u*)(YS + mrow * 1024 + h * 128 + dv) = wv; }
    }
#undef R3_LOAD
#undef R1_DEC
}

__device__ __forceinline__ float gelu_fx(float x) { const float x2 = x * x; const float arg = x * (x2 * (-2.0f * 1.4426950408889634f * 0.7978845608028654f * 0.044715f) + (-2.0f * 1.4426950408889634f * 0.7978845608028654f));
    return x * __builtin_amdgcn_rcpf(1.0f + __builtin_amdgcn_exp2f(arg)); }
__device__ __forceinline__ void ph_ffnfix(const Args& A, int l, int Mrows, int tid) {
    const bf16* SA = (const bf16*)(wsb() + WS_SA); const bf16* SB = (const bf16*)(wsb() + WS_SB); bf16* U = (bf16*)(wsb() + WS_U);
    const float* cw = inp(I_FFCW) + (size_t)l * 3 * DFF; const float* cb = inp(I_FFCB) + (size_t)l * DFF;
    const int nblk = Mrows / 64;
    for (int u = blockIdx.x; u < nblk * 2; u += gridDim.x) {
        const int blk = u >> 1, hi = u & 1, R = blk * 64 + (hi ? 63 : 0);
        const bool seq_first = (R < ML) ? ((R & (SEQ - 1)) == 0) : ((R & (CL - 1)) == 0), seq_last = (R < ML) ? ((R & (SEQ - 1)) == SEQ - 1) : ((R & (CL - 1)) == CL - 1);
        const bf16* pprev = hi ? SA + ((size_t)blk * 4 + 2) * DFF : SA + ((size_t)(blk - 1) * 4 + 3) * DFF;
        const bf16* pcur = SA + ((size_t)blk * 4 + (hi ? 3 : 0)) * DFF;
        const bf16* pnext = hi ? SA + ((size_t)(blk + 1) * 4 + 0) * DFF : SA + ((size_t)blk * 4 + 1) * DFF;
        const bf16* pb = SB + ((size_t)blk * 2 + hi) * DFF;
        const bool zp = (!hi && seq_first), zn = (hi && seq_last);
        for (int q = tid; q < DFF / 8; q += 512) { const int f = q * 8;
            float am[8], a0[8], aq[8], bg[8]; const v4u z4 = (v4u){0u, 0u, 0u, 0u};
            unpack8(zp ? z4 : *(const v4u*)(pprev + f), am); unpack8(*(const v4u*)(pcur + f), a0); unpack8(zn ? z4 : *(const v4u*)(pnext + f), aq); unpack8(*(const v4u*)(pb + f), bg);
            float r[8];
#pragma unroll
            for (int e = 0; e < 8; ++e) r[e] = gelu_fx(cw[f + e] * am[e] + cw[DFF + f + e] * a0[e] + cw[2 * DFF + f + e] * aq[e] + cb[f + e]) * bg[e];
            *(v4u*)(U + (size_t)R * DFF + f) = pack8(r); }
    }
}
__device__ __forceinline__ void ph_final(const Args& A, int wave, int lane) {
    const int gw = blockIdx.x * NWAVES + wave, NGW = gridDim.x * NWAVES; const float* g = inp(I_GF);
    for (int m = gw; m < ML; m += NGW) { float* xr = outb() + (size_t)m * D; f32x4 v[8]; float ss = 0.f;
#pragma unroll
        for (int j = 0; j < 8; ++j) { v[j] = *(const f32x4*)(xr + (lane + 64 * j) * 4); ss += (v[j].x * v[j].x + v[j].y * v[j].y) + (v[j].z * v[j].z + v[j].w * v[j].w); }
        const float rstd = 1.0f / sqrtf(wave_sum(ss) * (1.0f / D) + EPS);
#pragma unroll
        for (int j = 0; j < 8; ++j) { const int idx = (lane + 64 * j) * 4; *(f32x4*)(xr + idx) = v[j] * rstd * *(const f32x4*)(g + idx); }
    }
}
#ifndef SKEW_US
#define SKEW_US 0
#endif
__device__ __forceinline__ void spin_us(int us) { if (us > 0) { const unsigned long long t0 = __builtin_amdgcn_s_memrealtime(); while (__builtin_amdgcn_s_memrealtime() - t0 < (unsigned long long)us * 100ull) __builtin_amdgcn_s_sleep(8); } }
constexpr int FILT_F = 816, FILT_I = 896;
constexpr int BG_SPLIT = 22016;
constexpr int SEQ_PER_LAYER = 11, NSEQ = 1 + DEPTH * SEQ_PER_LAYER + 1;
__global__ void __launch_bounds__(NWAVES * 64, 2) fwd(Args A) {
    extern __shared__ __attribute__((aligned(16))) unsigned char lds_raw[];
    LAS unsigned char* lds = (LAS unsigned char*)lds_raw;
    volatile LAS unsigned* MISC = (volatile LAS unsigned*)(lds + MISC_OFF);
    for (int u = threadIdx.x; u < (LDS_BYTES - LDSCTL_OFF) / 4; u += NWAVES * 64) ((LAS unsigned*)(lds + LDSCTL_OFF))[u] = 0u;
    __syncthreads();
    (void)xcd_barrier_post((unsigned*)(wsb() + WS_CTL) + CW_BAR, MISC + 8);
    const int lo = A.seq_lo, hi = A.seq_hi;
#ifdef PROBE_K
    unsigned long long pr_acc = 0ull, pr_prev = __builtin_amdgcn_s_memrealtime();
#endif
#define G ((int)gridDim.x)
#ifdef PROBE_SUB
#define PROBE_K 999
#define SUBT(n, stmt) do { unsigned long long t0_ = 0; if ((n) == PROBE_SUB && blockIdx.x == PROBE_WG && threadIdx.x == 0) t0_ = __builtin_amdgcn_s_memrealtime(); stmt; if ((n) == PROBE_SUB && blockIdx.x == PROBE_WG && threadIdx.x == 0) pr_acc += __builtin_amdgcn_s_memrealtime() - t0_; } while (0)
#else
#define SUBT(n, stmt) do { stmt; } while (0)
#endif
#ifdef PROBE_K
#ifndef PROBE_WG
#define PROBE_WG 0
#endif
#ifndef PROBE_WAIT
#define PROBE_WAIT 0
#endif
#define PROBE_PH(s) (((s) == 0) ? 100 : (((s) - 1) % SEQ_PER_LAYER))
#define PROBE_ARRIVE(s) do { if (blockIdx.x == PROBE_WG && threadIdx.x == 0) { const unsigned long long now_ = __builtin_amdgcn_s_memrealtime(); if (!PROBE_WAIT && PROBE_PH(s) == PROBE_K) pr_acc += now_ - pr_prev; pr_prev = now_; } } while (0)
#define PROBE_EXIT(s) do { if (blockIdx.x == PROBE_WG && threadIdx.x == 0) { const unsigned long long now_ = __builtin_amdgcn_s_memrealtime(); if (PROBE_WAIT && PROBE_PH(s) == PROBE_K) pr_acc += now_ - pr_prev; pr_prev = now_; } } while (0)
#else
#define PROBE_ARRIVE(s) do { } while (0)
#define PROBE_EXIT(s) do { } while (0)
#endif
#define RUN(s) (lo <= (s) && (s) < hi)
#ifndef DUP
#define DUP 0
#endif
#define DUPN(id) ((((DUP) >> (id)) & 1) ? 2 : 1)
#define TID_HERE const int tid = otid(), lane = tid & 63, wave = __builtin_amdgcn_readfirstlane(tid >> 6); (void)lane; (void)wave
#ifdef ONLY
#define PH_ON(k) ((k) == ONLY)
#elif defined(SKIP)
#define PH_ON(k) ((k) != SKIP)
#else
#define PH_ON(k) true
#endif
#define SEAM(s) do { PROBE_ARRIVE(s); if (RUN((s) + 1)) { XcdBarrier bar_; bar_.bar = (unsigned*)(wsb() + WS_CTL) + CW_BAR; bar_.x = xb_xcc_id(); bar_.st = (volatile LAS unsigned*)(lds + MISC_OFF) + 8; xcd_barrier(bar_); if (DUPN(16) > 1) xcd_barrier(bar_); } PROBE_EXIT(s); } while (0)
#define H ((bf16*)(wsb() + WS_H))
#define Z ((bf16*)(wsb() + WS_Z))
#define ACC ((bf16*)(wsb() + WS_ACC))
#define U ((bf16*)(wsb() + WS_U))
#define YS ((bf16*)(wsb() + WS_YS))
#define XC ((float*)(wsb() + WS_XC))
#define WIN ((const bf16*)(psb(l & 1) + PS_WIN))
#define WBR ((const bf16*)(psb(l & 1) + PS_WBR))
#define WOUT ((const bf16*)(psb(l & 1) + PS_WOUT))
#define WF1 ((const bf16*)(psb(l & 1) + PS_WF1))
#define WF2 ((const bf16*)(psb(l & 1) + PS_WF2))

    if (PH_ON(100) && RUN(0)) { TID_HERE; ph_prologue(A, lds, tid); __syncthreads(); ph_convert(A, 0, 0, 0, CONV_ITEMS, (int)blockIdx.x, G, lds, wave, lane); __syncthreads(); for (int fl = 0; fl < DEPTH; ++fl) ph_filt1(A, fl, 0, (int)blockIdx.x, G, lds, tid); SEAM(0); }

    for (int l = 0; l < DEPTH; ++l) {
        const int sb = 1 + l * SEQ_PER_LAYER;
        if (hi <= sb || lo >= sb + SEQ_PER_LAYER) continue;
        const bool lastl = (l == DEPTH - 1);
        const int Mrows = lastl ? ML : MT, nctx = lastl ? 0 : 64;
#define modl ((const float*)(wsb() + WS_MOD) + (size_t)l * 5 * 12288)
#define xlat_in ((l == 0) ? inp(I_X) : (const float*)outb())
#define xctx_in ((l == 0) ? inp(I_CTX) : (const float*)XC)

        if (PH_ON(0) && RUN(sb + 0)) { TID_HERE;
            if (l == 0) ph_filt2(A, 0, 0, 0, 1024, (int)blockIdx.x, G, lds, tid);
            else ph_convert(A, l, l & 1, 0, CONV_ITEMS, (int)blockIdx.x, G, lds, wave, lane);
            ph_norm(xlat_in, xctx_in, inp(I_G1) + (size_t)l * D, modl, 0, D, H, MT, (l > 0) ? (const float*)(wsb() + WS_SLAB) : (const float*)nullptr,
                    (const float*)(wsb() + WS_MOD) + ((size_t)(l - 1) * 5 + 4) * 12288 + 5 * D, XC, wave, lane);
            SEAM(sb + 0);
        }
        if (PH_ON(1) && RUN(sb + 1)) { TID_HERE;
            if (SKEW_US > 0 && (blockIdx.x & 8)) spin_us(SKEW_US);
            { pg8::Gemm g{H, WIN, opq(MT), opq(INW), opq(D), 0}; pg8::StaticOrder S; S.init(g.M, g.N, G, (int)blockIdx.x);
              pg8::EpiStore E{Z, INW};
              for (int r_ = 0; r_ < DUPN(15); ++r_) pg8::gemm_phase<pg8::EpiStore, pg8::StaticOrder, PG8_ALIGN, PG8_SP2>(lds, g, S, E); }
            SEAM(sb + 1);
        }
        if (PH_ON(2) && RUN(sb + 2)) { TID_HERE;
            SUBT(1, ph_hyprep(A, l, lds, tid));
            SUBT(2, ph_ret1(A, l, 64, lds, tid));
            SUBT(3, ph_natt(A, l, 0, lds, tid));
            SUBT(4, if (!lastl) ph_hyctx(A, l, lds, tid));
            SEAM(sb + 2);
        }
        if (PH_ON(3) && RUN(sb + 3)) { TID_HERE;
#ifndef NO_D1
            SUBT(5, ph_hyfft(A, l, lds, tid));
#endif
#ifndef NO_D2
            SUBT(6, ph_scan(A, l, tid));
#endif
            SEAM(sb + 3);
        }
        if (PH_ON(4) && RUN(sb + 4)) { TID_HERE;
            SUBT(7, ph_hypost(A, lds, tid));
            SUBT(8, ph_ret3(A, l, nctx, lds, tid));
            if (!lastl) { __syncthreads(); ph_natt(A, l, 1, lds, tid); }
            SEAM(sb + 4);
        }
        if (PH_ON(5) && RUN(sb + 5)) { TID_HERE;
            __syncthreads();
            for (int r_ = 0; r_ < DUPN(13); ++r_)
            for (int i = 0; i < 3; ++i) {
                pg8::Gemm g{YS + (size_t)i * MT * 1024, WBR + (size_t)i * D * 1024, Mrows, opq(D), opq(1024), 0}; pg8::StaticOrder S; S.init(g.M, g.N, G, (int)blockIdx.x);
                pg8::EpiMerge E{ACC, Z + C_GT + i * D, INW, i == 0 ? 1 : 0};
                pg8::gemm_phase<pg8::EpiMerge, pg8::StaticOrder, PG8_ALIGN, PG8_SP2>(lds, g, S, E);
            }
            if (!lastl && blockIdx.x >= 32) { __syncthreads(); ph_filt2(A, l + 1, (l + 1) & 1, 0, FILT_F, (int)blockIdx.x - 32, G - 32, lds, tid); }
            SEAM(sb + 5);
        }
        if (PH_ON(6) && RUN(sb + 6)) { TID_HERE;
            __syncthreads();
            { pg8::Gemm g{ACC, WOUT, opq(ML), opq(D), opq(D), 0}; pg8::StaticOrder S; S.init(g.M, g.N, G, (int)blockIdx.x);
              pg8::EpiResid E{xlat_in, xctx_in, outb(), XC, modl, 2 * D};
              pg8::gemm_phase<pg8::EpiResid, pg8::StaticOrder, PG8_ALIGN, PG8_SP2>(lds, g, S, E); }
            if (!lastl) { pg8::Gemm g{ACC, WOUT, opq(MT), opq(D), opq(D / NSPLIT), opq(D)}; pg8::CtxSplitOrder S{NSPLIT, D / NSPLIT, (int)blockIdx.x};
              pg8::EpiSlab E{(float*)(wsb() + WS_SLAB), D / NSPLIT};
              pg8::gemm_phase<pg8::EpiSlab, pg8::CtxSplitOrder, PG8_ALIGN, PG8_SP2>(lds, g, S, E); }
            SEAM(sb + 6);
        }
        if (PH_ON(7) && RUN(sb + 7)) { TID_HERE;
            ph_norm(outb(), xctx_in, inp(I_G2) + (size_t)l * D, modl, 3 * D, 4 * D, H, Mrows, (const float*)(wsb() + WS_SLAB), modl + (size_t)4 * 12288 + 2 * D, XC, wave, lane);
            SEAM(sb + 7);
        }
        if (PH_ON(8) && RUN(sb + 8)) { TID_HERE;
            __syncthreads();
            if (SKEW_US > 0 && (blockIdx.x & 8)) spin_us(SKEW_US);
            pg8::Gemm g{H, WF1, Mrows, opq(NFF), opq(D), 0}; pg8::StaticOrder S; S.init(g.M, g.N, G, (int)blockIdx.x);
            pg8::EpiFfn E{U, (bf16*)(wsb() + WS_SA), (bf16*)(wsb() + WS_SB), inp(I_FFCW) + (size_t)l * 3 * DFF, inp(I_FFCB) + (size_t)l * DFF};
            for (int r_ = 0; r_ < DUPN(14); ++r_) pg8::gemm_phase<pg8::EpiFfn, pg8::StaticOrder, PG8_ALIGN, PG8_SP2>(lds, g, S, E);
            if (!lastl && blockIdx.x >= 176) { __syncthreads(); ph_filt2(A, l + 1, (l + 1) & 1, FILT_F, FILT_I, (int)blockIdx.x - 176, G - 176, lds, tid); }
            SEAM(sb + 8);
        }
        if (PH_ON(9) && RUN(sb + 9)) { TID_HERE;
            for (int r_ = 0; r_ < DUPN(11); ++r_) ph_ffnfix(A, l, Mrows, tid);
            SEAM(sb + 9);
        }
        if (PH_ON(10) && RUN(sb + 10)) { TID_HERE;
            __syncthreads();
            { pg8::Gemm g{U, WF2, opq(ML), opq(D), opq(DFF), 0}; pg8::StaticOrder S; S.init(g.M, g.N, G, (int)blockIdx.x);
              pg8::EpiResid E{outb(), XC, outb(), XC, modl, 5 * D};
              pg8::gemm_phase<pg8::EpiResid, pg8::StaticOrder, PG8_ALIGN, PG8_SP2>(lds, g, S, E); }
            if (!lastl) { pg8::Gemm g{U, WF2, opq(MT), opq(D), opq(DFF / NSPLIT), opq(DFF)}; pg8::CtxSplitOrder S{NSPLIT, DFF / NSPLIT, (int)blockIdx.x};
              pg8::EpiSlab E{(float*)(wsb() + WS_SLAB), DFF / NSPLIT};
              pg8::gemm_phase<pg8::EpiSlab, pg8::CtxSplitOrder, PG8_ALIGN, PG8_SP2>(lds, g, S, E); }
            if (!lastl && blockIdx.x >= 128) { __syncthreads(); ph_filt2(A, l + 1, (l + 1) & 1, FILT_I, 1024, (int)blockIdx.x - 128, G - 128, lds, tid); }
            SEAM(sb + 10);
        }
    }
    if (PH_ON(101) && RUN(NSEQ - 1)) { TID_HERE; ph_final(A, wave, lane); }
#ifdef PROBE_K
    if (blockIdx.x == PROBE_WG && threadIdx.x == 0) { const unsigned long long t0 = __builtin_amdgcn_s_memrealtime(); while (__builtin_amdgcn_s_memrealtime() - t0 < 4ull * pr_acc) __builtin_amdgcn_s_sleep(8); }
#endif
#undef RUN
#undef SEAM
#undef H
#undef Z
#undef ACC
#undef U
#undef YS
#undef XC
#undef WIN
#undef WBR
#undef WOUT
#undef WF1
#undef WF2
#undef G
#undef modl
#undef xlat_in
#undef xctx_in
}

extern "C" void kernel_launch(void* const* d_in, const int* in_sizes, int n_in, void* d_out, int out_size, void* d_ws, size_t ws_size, hipStream_t stream) {
    static int grid = 0;
    if (grid == 0) {
        if (n_in != 27 || out_size != ML * D || ws_size < WS_END) { fprintf(stderr, "kernel_launch: unexpected shapes (n_in %d out %d ws %zu need %zu)\n", n_in, out_size, ws_size, (size_t)WS_END); grid = -1; return; }
        int dev = 0, cus = 0, per_cu = 0;
        if (hipGetDevice(&dev) != hipSuccess || hipDeviceGetAttribute(&cus, hipDeviceAttributeMultiprocessorCount, dev) != hipSuccess) { grid = -1; return; }
        if (hipFuncSetAttribute((const void*)fwd, hipFuncAttributeMaxDynamicSharedMemorySize, LDS_BYTES) != hipSuccess) { fprintf(stderr, "kernel_launch: hipFuncSetAttribute failed\n"); grid = -1; return; }
        if (hipOccupancyMaxActiveBlocksPerMultiprocessor(&per_cu, (const void*)fwd, NWAVES * 64, LDS_BYTES) != hipSuccess || per_cu < 1) fprintf(stderr, "kernel_launch: occupancy query says %d\n", per_cu);
        (void)hipGetLastError();
        grid = cus;
    }
    if (grid < 0) return;
    (void)hipMemsetAsync((char*)d_ws + WS_CTL, 0, CTL_ZERO_BYTES, stream);
    Args a{};
    for (int i = 0; i < 27; ++i) a.in[i] = (const float*)d_in[i];
    a.out = (float*)d_out; a.ws = (unsigned char*)d_ws;
#if MK_SINGLE
    a.seq_lo = 0; a.seq_hi = NSEQ;
    hipLaunchKernelGGL(fwd, dim3(grid), dim3(NWAVES * 64), LDS_BYTES, stream, a);
#else
    for (int s = 0; s < NSEQ; ++s) { a.seq_lo = s; a.seq_hi = s + 1; hipLaunchKernelGGL(fwd, dim3(grid), dim3(NWAVES * 64), LDS_BYTES, stream, a); }
#endif
}
```

```cpp
#include <hip/hip_runtime.h>
#include <cstdio>
#include <cstdint>
#ifndef MK_SINGLE
#define MK_SINGLE 1
#endif
namespace pg8 {
#define PG8_LAS __attribute__((address_space(3)))
typedef unsigned short bf16_t;
typedef short bf16x8 __attribute__((ext_vector_type(8)));
typedef float f32x4 __attribute__((ext_vector_type(4)));
typedef unsigned u32x4 __attribute__((ext_vector_type(4)));
constexpr int BM = 256, BK = 64, HALF = 128, HTB = HALF * BK * 2  , STAGE_BYTES = 8 * HTB, NXCD = 8, WGM = 8;

__host__ __device__ __forceinline__ int lds_byte(int r, int c) { const int st = (r >> 4) * 2 + (c >> 5), rr = r & 15, cc = c & 31, ob = rr * 64 + cc * 2; return st * 1024 + (ob ^ (((ob >> 9) & 1) << 5)); }
__host__ __device__ __forceinline__ void stage_rc(int b, int& R, int& C) { const int st = b / 1024, sb = b % 1024, swz = sb ^ (((sb >> 9) & 1) << 5); R = (st >> 1) * 16 + swz / 64; C = (st & 1) * 32 + (swz % 64) / 2; }
__host__ __device__ __forceinline__ int perm32(int rho) { const int n = rho >> 4, i = rho & 15; return 8 * (i >> 2) + 4 * n + (i & 3); }

struct Unit { int pm, pn, ko; };
struct Gemm { const bf16_t* A; const bf16_t* Bt; int M, N, K, ld; };

struct StaticOrder {
    int nM, nN, nwg, G, c;
    __host__ __device__ void init(int M, int N, int G_, int c_) { nM = M / BM; nN = N / BM; nwg = nM * nN; G = G_; c = c_; }
    __host__ __device__ bool next(int i, Unit& u) const {
        const long L = (long)i * G + c; if (L >= nwg) return false;
        int wgid = (int)L; { const int q = nwg / NXCD, r = nwg % NXCD, xcd = wgid % NXCD, off = wgid / NXCD; wgid = (xcd < r ? xcd * (q + 1) : r * (q + 1) + (xcd - r) * q) + off; }
        const int nig = WGM * nN, gid = wgid / nig, fm = gid * WGM, gsz = (nM - fm) < WGM ? (nM - fm) : WGM;
        u.pm = fm + ((wgid % nig) % gsz); u.pn = (wgid % nig) / gsz; u.ko = 0; return true;
    }
    __device__ __forceinline__ void a_ready(const Unit&) const {}
    __device__ __forceinline__ void done(const Unit&) const {}
};
__device__ __forceinline__ unsigned cvt_pk_bf16(float lo, float hi) { unsigned r; asm volatile("v_cvt_pk_bf16_f32 %0, %1, %2" : "=v"(r) : "v"(lo), "v"(hi)); return r; }
typedef float f32x2 __attribute__((ext_vector_type(2)));
__device__ __forceinline__ float bflo(unsigned w) { return __uint_as_float(w << 16); }
__device__ __forceinline__ float bfhi(unsigned w) { return __uint_as_float(w & 0xffff0000u); }
__device__ __forceinline__ float sigm(float x) { return __builtin_amdgcn_rcpf(1.0f + __expf(-x)); }
struct EpiStore {
    static constexpr bool PERM = true, AFTER_DRAIN = false;
    bf16_t* O; int ldc;
    __device__ __forceinline__ void operator()(const f32x4 (&acc)[2][2][4][2], const Unit& u, int wr, int wc, int fr, int fq) const {
        const int row0 = u.pm * BM + wr * 64 + fr, col0 = u.pn * BM + wc * 32 + 8 * fq;
#pragma unroll
        for (int ai = 0; ai < 2; ++ai)
#pragma unroll
            for (int m = 0; m < 4; ++m) { bf16_t* rowp = O + (size_t)(row0 + ai * HALF + m * 16) * ldc + col0;
#pragma unroll
                for (int bj = 0; bj < 2; ++bj) { const f32x4 v0 = acc[ai][bj][m][0], v1 = acc[ai][bj][m][1];
                    u32x4 w; w.x = cvt_pk_bf16(v0[0], v0[1]); w.y = cvt_pk_bf16(v0[2], v0[3]); w.z = cvt_pk_bf16(v1[0], v1[1]); w.w = cvt_pk_bf16(v1[2], v1[3]);
                    __builtin_nontemporal_store(w, (u32x4*)(rowp + bj * HALF)); } }
    }
};
struct EpiMerge {
    static constexpr bool PERM = true, AFTER_DRAIN = false;
    bf16_t* O; const bf16_t* gate; int ldg; int first;
    __device__ __forceinline__ void operator()(const f32x4 (&acc)[2][2][4][2], const Unit& u, int wr, int wc, int fr, int fq) const {
        const int row0 = u.pm * BM + wr * 64 + fr, col0 = u.pn * BM + wc * 32 + 8 * fq;
#pragma unroll
        for (int ai = 0; ai < 2; ++ai)
#pragma unroll
            for (int m = 0; m < 4; ++m) { const size_t row = (size_t)(row0 + ai * HALF + m * 16);
#pragma unroll
                for (int bj = 0; bj < 2; ++bj) { const int col = col0 + bj * HALF;
                    const u32x4 gv = *(const u32x4*)(gate + row * ldg + col);
                    u32x4 pv = (u32x4){0u, 0u, 0u, 0u}; if (!first) pv = *(const u32x4*)(O + row * 2048 + col);
                    const f32x4 v0 = acc[ai][bj][m][0], v1 = acc[ai][bj][m][1];
                    u32x4 w;
                    w.x = cvt_pk_bf16(bflo(pv.x) + v0[0] * sigm(bflo(gv.x)), bfhi(pv.x) + v0[1] * sigm(bfhi(gv.x)));
                    w.y = cvt_pk_bf16(bflo(pv.y) + v0[2] * sigm(bflo(gv.y)), bfhi(pv.y) + v0[3] * sigm(bfhi(gv.y)));
                    w.z = cvt_pk_bf16(bflo(pv.z) + v1[0] * sigm(bflo(gv.z)), bfhi(pv.z) + v1[1] * sigm(bfhi(gv.z)));
                    w.w = cvt_pk_bf16(bflo(pv.w) + v1[2] * sigm(bflo(gv.w)), bfhi(pv.w) + v1[3] * sigm(bfhi(gv.w)));
                    *(u32x4*)(O + row * 2048 + col) = w; } }
    }
};
struct EpiResid {
    static constexpr bool PERM = false, AFTER_DRAIN = false;
    const float* base_lat; const float* base_ctx; float* out_lat; float* out_ctx; const float* modl; int goff;
    __device__ __forceinline__ void operator()(const f32x4 (&acc)[2][2][4][2], const Unit& u, int wr, int wc, int fr, int fq) const {
        const bool isctx = u.pm >= 64; const int r = isctx ? 4 : (u.pm >> 4);
        const float* gvp = modl + (size_t)r * 12288 + goff;
        const float* bs = isctx ? base_ctx : base_lat; float* os = isctx ? out_ctx : out_lat;
        const int row0 = (isctx ? u.pm - 64 : u.pm) * BM + wr * 64 + fr, col0 = u.pn * BM + wc * 32 + 4 * fq;
        f32x4 g4[2][2];
#pragma unroll
        for (int bj = 0; bj < 2; ++bj)
#pragma unroll
            for (int n = 0; n < 2; ++n) g4[bj][n] = *(const f32x4*)(gvp + col0 + bj * HALF + n * 16);
#pragma unroll
        for (int ai = 0; ai < 2; ++ai)
#pragma unroll
            for (int m = 0; m < 4; ++m) { const size_t off = (size_t)(row0 + ai * HALF + m * 16) * 2048 + col0;
#pragma unroll
                for (int bj = 0; bj < 2; ++bj)
#pragma unroll
                    for (int n = 0; n < 2; ++n) { const f32x4 b4 = *(const f32x4*)(bs + off + bj * HALF + n * 16);
                        *(f32x4*)(os + off + bj * HALF + n * 16) = b4 + g4[bj][n] * acc[ai][bj][m][n]; } }
    }
};

__device__ __forceinline__ float dpp_ror1(float v) { return __int_as_float(__builtin_amdgcn_update_dpp(0, __float_as_int(v), 0x121, 0xf, 0xf, false)); }
__device__ __forceinline__ float dpp_rol1(float v) { return __int_as_float(__builtin_amdgcn_update_dpp(0, __float_as_int(v), 0x12f, 0xf, 0xf, false)); }
__device__ __forceinline__ float gelu_fast(float x) { const float x2 = x * x; const float arg = x * (x2 * (-2.0f * 1.4426950408889634f * 0.7978845608028654f * 0.044715f) + (-2.0f * 1.4426950408889634f * 0.7978845608028654f));
    return x * __builtin_amdgcn_rcpf(1.0f + __builtin_amdgcn_exp2f(arg)); }
struct EpiFfn {
    static constexpr bool PERM = true, AFTER_DRAIN = false;
    bf16_t* U; bf16_t* SA; bf16_t* SB; const float* cw; const float* cb;
    __device__ __forceinline__ void operator()(const f32x4 (&acc)[2][2][4][2], const Unit& u, int wr, int wc, int fr, int fq) const {
        const int f0 = u.pn * 128 + wc * 32 + 8 * fq;
        f32x4 w0[2], w1[2], w2[2], bb[2];
#pragma unroll
        for (int n = 0; n < 2; ++n) { w0[n] = *(const f32x4*)(cw + f0 + 4 * n); w1[n] = *(const f32x4*)(cw + 5632 + f0 + 4 * n); w2[n] = *(const f32x4*)(cw + 2 * 5632 + f0 + 4 * n); bb[n] = *(const f32x4*)(cb + f0 + 4 * n); }
#pragma unroll
        for (int ai = 0; ai < 2; ++ai) {
            const int row0 = u.pm * BM + ai * HALF + wr * 64 + fr, blk = u.pm * 4 + ai * 2 + wr;
            f32x4 o[4][2];
#pragma unroll
            for (int n = 0; n < 2; ++n)
#pragma unroll
                for (int e = 0; e < 4; ++e) {
                    const float a0 = acc[ai][0][0][n][e], a1 = acc[ai][0][1][n][e], a2 = acc[ai][0][2][n][e], a3 = acc[ai][0][3][n][e];
                    const float r0 = dpp_ror1(a0), r1 = dpp_ror1(a1), r2 = dpp_ror1(a2), r3 = dpp_ror1(a3);
                    const float l0 = dpp_rol1(a0), l1 = dpp_rol1(a1), l2 = dpp_rol1(a2), l3 = dpp_rol1(a3);
                    const bool first = (fr == 0), last = (fr == 15);
                    const float p0 = r0, p1 = first ? r0 : r1, p2 = first ? r1 : r2, p3 = first ? r2 : r3;
                    const float n0 = last ? l1 : l0, n1 = last ? l2 : l1, n2 = last ? l3 : l2, n3 = l3;
                    const float k0 = w0[n][e], k1 = w1[n][e], k2 = w2[n][e], kb = bb[n][e];
                    o[0][n][e] = gelu_fast(k0 * p0 + k1 * a0 + k2 * n0 + kb) * acc[ai][1][0][n][e];
                    o[1][n][e] = gelu_fast(k0 * p1 + k1 * a1 + k2 * n1 + kb) * acc[ai][1][1][n][e];
                    o[2][n][e] = gelu_fast(k0 * p2 + k1 * a2 + k2 * n2 + kb) * acc[ai][1][2][n][e];
                    o[3][n][e] = gelu_fast(k0 * p3 + k1 * a3 + k2 * n3 + kb) * acc[ai][1][3][n][e];
                }
#pragma unroll
            for (int m = 0; m < 4; ++m) { u32x4 w; w.x = cvt_pk_bf16(o[m][0][0], o[m][0][1]); w.y = cvt_pk_bf16(o[m][0][2], o[m][0][3]); w.z = cvt_pk_bf16(o[m][1][0], o[m][1][1]); w.w = cvt_pk_bf16(o[m][1][2], o[m][1][3]);
                *(u32x4*)(U + (size_t)(row0 + m * 16) * 5632 + f0) = w; }
            const int sel = (fr == 0) ? 0 : (fr == 1) ? 1 : (fr == 14) ? 2 : (fr == 15) ? 3 : -1;
            if (sel >= 0) { const int m = (sel < 2) ? 0 : 3;
                const f32x4 a0 = (m == 0) ? acc[ai][0][0][0] : acc[ai][0][3][0], a1 = (m == 0) ? acc[ai][0][0][1] : acc[ai][0][3][1];
                u32x4 w; w.x = cvt_pk_bf16(a0[0], a0[1]); w.y = cvt_pk_bf16(a0[2], a0[3]); w.z = cvt_pk_bf16(a1[0], a1[1]); w.w = cvt_pk_bf16(a1[2], a1[3]);
                *(u32x4*)(SA + ((size_t)blk * 4 + sel) * 5632 + f0) = w;
                if (sel == 0 || sel == 3) { const f32x4 b0 = (m == 0) ? acc[ai][1][0][0] : acc[ai][1][3][0], b1 = (m == 0) ? acc[ai][1][0][1] : acc[ai][1][3][1];
                    u32x4 v; v.x = cvt_pk_bf16(b0[0], b0[1]); v.y = cvt_pk_bf16(b0[2], b0[3]); v.z = cvt_pk_bf16(b1[0], b1[1]); v.w = cvt_pk_bf16(b1[2], b1[3]);
                    *(u32x4*)(SB + ((size_t)blk * 2 + (sel == 0 ? 0 : 1)) * 5632 + f0) = v; } }
        }
    }
};

struct CtxSplitOrder {
    int nsplit, klen, c;
    __device__ __forceinline__ bool next(int i, Unit& u) const { if (i > 0 || c >= 32 * nsplit) return false; const int tile = c / nsplit, s = c - tile * nsplit; u.pm = 64 + (tile >> 3); u.pn = tile & 7; u.ko = s * klen; return true; }
    __device__ __forceinline__ void a_ready(const Unit&) const {}
    __device__ __forceinline__ void done(const Unit&) const {}
};
struct EpiSlab {
    static constexpr bool PERM = false, AFTER_DRAIN = false;
    float* slab; int klen;
    __device__ __forceinline__ void operator()(const f32x4 (&acc)[2][2][4][2], const Unit& u, int wr, int wc, int fr, int fq) const {
        float* os = slab + (size_t)(u.ko / klen) * 1024 * 2048;
        const int row0 = (u.pm - 64) * BM + wr * 64 + fr, col0 = u.pn * BM + wc * 32 + 4 * fq;
#pragma unroll
        for (int ai = 0; ai < 2; ++ai)
#pragma unroll
            for (int m = 0; m < 4; ++m) { const size_t off = (size_t)(row0 + ai * HALF + m * 16) * 2048 + col0;
#pragma unroll
                for (int bj = 0; bj < 2; ++bj)
#pragma unroll
                    for (int n = 0; n < 2; ++n) *(f32x4*)(os + off + bj * HALF + n * 16) = acc[ai][bj][m][n]; }
    }
};
template <class Epi, class Sched, bool ALIGN_EPI = false, bool SP2 = false>
__device__ __forceinline__ void gemm_phase(PG8_LAS unsigned char* lds, const Gemm g, const Sched& S, const Epi& E) {
    int tid_ = threadIdx.x; asm volatile("" : "+v"(tid_)); const int tid = tid_, wid = __builtin_amdgcn_readfirstlane(tid >> 6), lane = tid & 63, wr = wid >> 2, wc = wid & 3, fr = lane & 15, fq = lane >> 4;
    const int K = g.K, nt = K / BK, LD = g.ld ? g.ld : g.K;
    unsigned voffA[2], voffB[2];
#pragma unroll
    for (int i = 0; i < 2; ++i) { int R, C; stage_rc(tid * 16 + i * 8192, R, C); const int Rb = Epi::PERM ? ((R & ~31) + perm32(R & 31)) : R;
        voffA[i] = (unsigned)(R * LD + C) * 2u; voffB[i] = (unsigned)(Rb * LD + C) * 2u; }
    const size_t kstep = (size_t)(BK * 2);
    const size_t hstep = (size_t)HALF * LD * 2;
    const size_t tstep = 2 * hstep;
    const unsigned ldsw = (unsigned)wid * 1024u;
    const int aoff = lds_byte(wr * 64 + fr, fq * 8), boff = lds_byte(wc * 32 + fr, fq * 8);
#define PG8_SA(b, h) (((b) * 2 + (h)) * HTB)
#define PG8_SB(b, h) ((4 + (b) * 2 + (h)) * HTB)
#define PG8_STAGE(bufoff, gbase, voff) do { _Pragma("unroll") for (int _i = 0; _i < 2; ++_i) \
        __builtin_amdgcn_global_load_lds((const unsigned*)((const char*)(gbase) + (voff)[_i]), (PG8_LAS unsigned*)(lds + (bufoff) + ldsw + _i * 8192), 16, 0, 0); } while (0)
#define PG8_LDA(dst, b, h) do { _Pragma("unroll") for (int m = 0; m < 4; ++m) _Pragma("unroll") for (int k = 0; k < 2; ++k) dst[m][k] = *(const PG8_LAS bf16x8*)(lds + PG8_SA(b, h) + aoff + m * 2048 + k * 1024); } while (0)
#define PG8_LDB(dst, b, h) do { _Pragma("unroll") for (int n = 0; n < 2; ++n) _Pragma("unroll") for (int k = 0; k < 2; ++k) dst[n][k] = *(const PG8_LAS bf16x8*)(lds + PG8_SB(b, h) + boff + n * 2048 + k * 1024); } while (0)
#define PG8_MMA(ai, bj, At, Bt) do { __builtin_amdgcn_s_setprio(1); _Pragma("unroll") for (int m = 0; m < 4; ++m) _Pragma("unroll") for (int n = 0; n < 2; ++n) _Pragma("unroll") for (int k = 0; k < 2; ++k) \
        acc[ai][bj][m][n] = __builtin_amdgcn_mfma_f32_16x16x32_bf16(Bt[n][k], At[m][k], acc[ai][bj][m][n], 0, 0, 0); __builtin_amdgcn_s_setprio(0); } while (0)
#define PG8_WAIT_V(n) asm volatile("s_waitcnt vmcnt(" #n ")" ::: "memory")
#define PG8_WAIT_L(n) asm volatile("s_waitcnt lgkmcnt(" #n ")" ::: "memory")
#define PG8_BAR __builtin_amdgcn_s_barrier()
#define PG8_SCHED __builtin_amdgcn_sched_barrier(0)
    Unit cur, nxt; int ui = 0;
    if (!S.next(0, cur)) return;
    f32x4 acc[2][2][4][2];
#pragma unroll
    for (int a = 0; a < 2; ++a)
#pragma unroll
        for (int b = 0; b < 2; ++b)
#pragma unroll
            for (int m = 0; m < 4; ++m)
#pragma unroll
                for (int n = 0; n < 2; ++n) acc[a][b][m][n] = (f32x4){0.f, 0.f, 0.f, 0.f};
    bf16x8 At[4][2], B0[2][2], B1[2][2];
    const char* cA = (const char*)g.A + (size_t)cur.pm * tstep + (size_t)cur.ko * 2; const char* cB = (const char*)g.Bt + (size_t)cur.pn * tstep + (size_t)cur.ko * 2;
    S.a_ready(cur);
    if constexpr (SP2) {
        PG8_STAGE(PG8_SB(0, 0), cB, voffB); PG8_STAGE(PG8_SB(0, 1), cB + hstep, voffB); PG8_STAGE(PG8_SA(0, 0), cA, voffA); PG8_STAGE(PG8_SA(0, 1), cA + hstep, voffA);
        if (wr == 1) PG8_BAR;
        PG8_WAIT_V(2); PG8_BAR;
        PG8_STAGE(PG8_SB(1, 0), cB + kstep, voffB); PG8_STAGE(PG8_SA(1, 0), cA + kstep, voffA); PG8_STAGE(PG8_SB(1, 1), cB + hstep + kstep, voffB);
        PG8_WAIT_V(6); PG8_BAR;
    } else {
        PG8_STAGE(PG8_SB(0, 0), cB, voffB); PG8_STAGE(PG8_SA(0, 0), cA, voffA); PG8_STAGE(PG8_SB(0, 1), cB + hstep, voffB); PG8_STAGE(PG8_SA(0, 1), cA + hstep, voffA);
        if (wr == 1) PG8_BAR;
        PG8_WAIT_V(4); PG8_BAR;
        PG8_STAGE(PG8_SB(1, 0), cB + kstep, voffB); PG8_STAGE(PG8_SA(1, 0), cA + kstep, voffA); PG8_STAGE(PG8_SB(1, 1), cB + hstep + kstep, voffB);
        PG8_WAIT_V(6); PG8_BAR;
    }
    for (;;) {
        const bool has_next = S.next(ui + 1, nxt);
        const char* nA = has_next ? (const char*)g.A + (size_t)nxt.pm * tstep + (size_t)nxt.ko * 2 : cA; const char* nB = has_next ? (const char*)g.Bt + (size_t)nxt.pn * tstep + (size_t)nxt.ko * 2 : cB;
        for (int t = 0; t < nt; t += 2) {
            const bool last = (t == nt - 2);
            const char* a1 = cA + (size_t)(t + 1) * kstep;
            const char* a2 = last ? nA : cA + (size_t)(t + 2) * kstep; const char* b2 = last ? nB : cB + (size_t)(t + 2) * kstep;
            const char* a3 = a2 + kstep; const char* b3 = b2 + kstep;
            if (last && has_next) S.a_ready(nxt);
            if constexpr (SP2) {
            PG8_LDB(B0, 0, 0); PG8_LDB(B1, 0, 1); PG8_SCHED; PG8_LDA(At, 0, 0); PG8_STAGE(PG8_SA(1, 1), a1 + hstep, voffA);
            PG8_WAIT_V(8); PG8_WAIT_L(0); PG8_BAR; PG8_MMA(0, 0, At, B0); PG8_MMA(0, 1, At, B1); PG8_BAR; PG8_SCHED;
            PG8_LDA(At, 0, 1); PG8_STAGE(PG8_SB(0, 0), b2, voffB); PG8_STAGE(PG8_SB(0, 1), b2 + hstep, voffB); PG8_STAGE(PG8_SA(0, 0), a2, voffA);
            PG8_WAIT_V(8); PG8_WAIT_L(0); PG8_BAR; PG8_MMA(1, 0, At, B0); PG8_MMA(1, 1, At, B1); PG8_BAR; PG8_SCHED;
            PG8_LDB(B0, 1, 0); PG8_LDB(B1, 1, 1); PG8_SCHED; PG8_LDA(At, 1, 0); PG8_STAGE(PG8_SA(0, 1), a2 + hstep, voffA);
            PG8_WAIT_V(8); PG8_WAIT_L(0); PG8_BAR; PG8_MMA(0, 0, At, B0); PG8_MMA(0, 1, At, B1); PG8_BAR; PG8_SCHED;
            PG8_LDA(At, 1, 1); PG8_STAGE(PG8_SB(1, 0), b3, voffB); PG8_STAGE(PG8_SB(1, 1), b3 + hstep, voffB); PG8_STAGE(PG8_SA(1, 0), a3, voffA);
            PG8_WAIT_V(8); PG8_WAIT_L(0); PG8_BAR; PG8_MMA(1, 0, At, B0); PG8_MMA(1, 1, At, B1); PG8_BAR; PG8_SCHED;
            } else {
            PG8_LDB(B0, 0, 0); PG8_SCHED; PG8_LDA(At, 0, 0); PG8_STAGE(PG8_SA(1, 1), a1 + hstep, voffA);
            PG8_WAIT_L(8); PG8_BAR; PG8_WAIT_L(0); PG8_MMA(0, 0, At, B0); PG8_BAR; PG8_SCHED;
            PG8_LDB(B1, 0, 1); PG8_STAGE(PG8_SB(0, 0), b2, voffB);
            PG8_BAR; PG8_WAIT_L(0); PG8_MMA(0, 1, At, B1); PG8_BAR;
            PG8_LDA(At, 0, 1); PG8_STAGE(PG8_SA(0, 0), a2, voffA);
            PG8_BAR; PG8_WAIT_L(0); PG8_MMA(1, 0, At, B0); PG8_BAR; PG8_SCHED;
            PG8_STAGE(PG8_SB(0, 1), b2 + hstep, voffB);
            PG8_WAIT_V(6); PG8_BAR; PG8_MMA(1, 1, At, B1); PG8_BAR;
            PG8_LDB(B0, 1, 0); PG8_SCHED; PG8_LDA(At, 1, 0); PG8_STAGE(PG8_SA(0, 1), a2 + hstep, voffA);
            PG8_WAIT_L(8); PG8_BAR; PG8_WAIT_L(0); PG8_MMA(0, 0, At, B0); PG8_BAR; PG8_SCHED;
            PG8_LDB(B1, 1, 1); PG8_STAGE(PG8_SB(1, 0), b3, voffB);
            PG8_BAR; PG8_WAIT_L(0); PG8_MMA(0, 1, At, B1); PG8_BAR;
            PG8_LDA(At, 1, 1); PG8_STAGE(PG8_SA(1, 0), a3, voffA);
            PG8_BAR; PG8_WAIT_L(0); PG8_MMA(1, 0, At, B0); PG8_BAR; PG8_SCHED;
            PG8_STAGE(PG8_SB(1, 1), b3 + hstep, voffB);
            PG8_WAIT_V(6); PG8_BAR; PG8_MMA(1, 1, At, B1); PG8_BAR;
            }
        }
        if constexpr (ALIGN_EPI) { if (wr == 0) PG8_BAR; }
        if constexpr (!Epi::AFTER_DRAIN) { E(acc, cur, wr, wc, fr, fq); S.done(cur); }
        if (!has_next) break;
#pragma unroll
        for (int a = 0; a < 2; ++a)
#pragma unroll
            for (int b = 0; b < 2; ++b)
#pragma unroll
                for (int m = 0; m < 4; ++m)
#pragma unroll
                    for (int n = 0; n < 2; ++n) acc[a][b][m][n] = (f32x4){0.f, 0.f, 0.f, 0.f};
        cur = nxt; cA = nA; cB = nB; ++ui;
        if constexpr (ALIGN_EPI) { if (wr == 1) PG8_BAR; }
    }
    PG8_WAIT_V(0);
    if constexpr (!ALIGN_EPI) { if (wr == 0) PG8_BAR; }
    PG8_BAR;
    if constexpr (Epi::AFTER_DRAIN) { E.fused(acc, cur, wr, wc, fr, fq, lds, wid, lane); S.done(cur); }
#undef PG8_SA
#undef PG8_SB
#undef PG8_STAGE
#undef PG8_LDA
#undef PG8_LDB
#undef PG8_MMA
#undef PG8_WAIT_V
#undef PG8_WAIT_L
#undef PG8_BAR
#undef PG8_SCHED
}
}
#ifndef PG8_SP2
#define PG8_SP2 true
#endif
#ifndef PG8_ALIGN
#define PG8_ALIGN true
#endif
constexpr int D = 2048, NB = 4, SEQ = 4096, CL = 256, DEPTH = 4;
constexpr int ML = NB * SEQ, MC = NB * CL, MT = ML + MC;
constexpr int INW = 15360, DFF = 5632, NFF = 2 * DFF;
constexpr int C_RK = 0, C_RV = 512, C_NK = 1536, C_NV = 2560, C_RQ = 3584, C_RG = 4096, C_NQ = 5120, C_HY = 6144, C_GT = 9216;
constexpr float EPS = 1e-6f;
constexpr int NWAVES = 8;
constexpr size_t al256(size_t x) { return (x + 255) & ~(size_t)255; }
constexpr size_t WS_CTL = 0, CTL_ZERO_BYTES = 1u << 20;
constexpr size_t WS_MOD = WS_CTL + CTL_ZERO_BYTES;
constexpr size_t WS_ROPE = WS_MOD + al256((size_t)4 * 5 * 12288 * 4);
constexpr size_t PS_FH2 = 0;
constexpr size_t PS_FH2B = PS_FH2 + al256((size_t)4352 * 64 * 4);
constexpr size_t PS_TAPC = PS_FH2B + al256((size_t)4352 * 64 * 2);
constexpr size_t PS_KF = PS_TAPC + al256((size_t)2 * 2 * 1024 * 256 * 4);
constexpr size_t PS_WIN = PS_KF + al256((size_t)2 * 1024 * 8192 * 8);
constexpr size_t PS_WBR = PS_WIN + al256((size_t)INW * D * 2);
constexpr size_t PS_WOUT = PS_WBR + al256((size_t)3 * D * 1024 * 2);
constexpr size_t PS_WF1 = PS_WOUT + al256((size_t)D * D * 2);
constexpr size_t PS_WF2 = PS_WF1 + al256((size_t)NFF * D * 2);
constexpr size_t PS_BYTES = PS_WF2 + al256((size_t)D * DFF * 2);
constexpr size_t WS_PSET = WS_ROPE + al256(64 * 16 * 8);
constexpr size_t WS_XC = WS_PSET + 2 * PS_BYTES;
constexpr size_t WS_H = WS_XC + al256((size_t)MC * D * 4);
constexpr size_t WS_Z = WS_H + al256((size_t)MT * D * 2);
constexpr size_t WS_HYT = WS_Z + al256((size_t)MT * INW * 2);
constexpr size_t WS_YT = WS_HYT + al256((size_t)3 * NB * 1024 * SEQ * 2);
constexpr size_t WS_YS = WS_YT + al256((size_t)NB * 1024 * SEQ * 2);
constexpr size_t WS_ACC = WS_YS + al256((size_t)3 * MT * 1024 * 2);
constexpr size_t WS_U = WS_ACC + al256((size_t)MT * D * 2);
constexpr size_t WS_KV = WS_U + al256((size_t)MT * DFF * 2);
constexpr size_t WS_SA = WS_KV + al256((size_t)NB * 8 * 2 * 34 * 8192 * 4);
constexpr size_t WS_SB = WS_SA + al256((size_t)272 * 4 * DFF * 2);
constexpr size_t WS_SLAB = WS_SB + al256((size_t)272 * 2 * DFF * 2);
constexpr size_t WS_FB4 = WS_SLAB + al256((size_t)4 * MC * D * 4);
constexpr size_t WS_END = WS_FB4 + al256((size_t)4 * 4352 * 64 * 2);
constexpr int NSPLIT = 4;
constexpr int CW_BAR = 4096, CW_DYN = 8192;
constexpr int RING_BYTES = 131072, LDSCTL_OFF = RING_BYTES, MISC_OFF = LDSCTL_OFF + 320, LDS_BYTES = 147456;

#define GAS __attribute__((address_space(1)))
#define LAS __attribute__((address_space(3)))
typedef unsigned short bf16;
typedef unsigned v4u __attribute__((ext_vector_type(4)));
typedef unsigned v2u __attribute__((ext_vector_type(2)));
typedef float f32x4 __attribute__((ext_vector_type(4)));
typedef float f32x2 __attribute__((ext_vector_type(2)));
typedef short bf16x8 __attribute__((ext_vector_type(8)));
typedef GAS unsigned gu32;
#define LDS_WAIT() asm volatile("s_waitcnt lgkmcnt(0)" ::: "memory")
__device__ __forceinline__ unsigned f2bf(float f) { unsigned u = __builtin_bit_cast(unsigned, f); return (u + 0x7fffu + ((u >> 16) & 1u)) >> 16; }
__device__ __forceinline__ unsigned pk2(float lo, float hi) { return f2bf(lo) | (f2bf(hi) << 16); }
__device__ __forceinline__ float bflo(unsigned w) { return __uint_as_float(w << 16); }
__device__ __forceinline__ float bfhi(unsigned w) { return __uint_as_float(w & 0xffff0000u); }
__device__ __forceinline__ float bf1(bf16 b) { return __uint_as_float(((unsigned)b) << 16); }
__device__ __forceinline__ bf16x8 mk8(unsigned a, unsigned b, unsigned c, unsigned d) { v4u v = (v4u){a, b, c, d}; return __builtin_bit_cast(bf16x8, v); }
__device__ __forceinline__ f32x4 mfma16(bf16x8 a, bf16x8 b, f32x4 c) { return __builtin_amdgcn_mfma_f32_16x16x32_bf16(a, b, c, 0, 0, 0); }
__device__ __forceinline__ float sin_rev(float r) { return __builtin_amdgcn_sinf(r - floorf(r)); }
__device__ __forceinline__ float cos_rev(float r) { return __builtin_amdgcn_cosf(r - floorf(r)); }
__device__ __forceinline__ float sin_rad(float x) { return sin_rev(x * 0.15915494309189535f); }
__device__ __forceinline__ float ex2(float x) { return __builtin_amdgcn_exp2f(x); }
__device__ __forceinline__ float wave_sum(float v) {
#pragma unroll
    for (int o = 1; o < 64; o <<= 1) v += __shfl_xor(v, o);
    return v;
}
__device__ __forceinline__ int otid() { int t = threadIdx.x; asm volatile("" : "+v"(t)); return t; }
__device__ __forceinline__ int opq(int v) { asm volatile("" : "+s"(v)); return v; }
#define XB_TMO      128
#define XB_XCNT(j)  (256  + 64 * (j))
#define XB_XSUB(j)  (1280 + 64 * (j))
#define XB_XGEN(j)  (2304 + 64 * (j))
#define XB_TOP      3328
#define XB_TOPGEN   3392
#define XCD_BAR_WORDS 3456
#define XB_SPIN_CAP (1u << 18)

__device__ __forceinline__ unsigned xb_ld(unsigned* p)              { return __hip_atomic_load(p, __ATOMIC_RELAXED, __HIP_MEMORY_SCOPE_AGENT); }
__device__ __forceinline__ unsigned xb_add(unsigned* p, unsigned v) { return __hip_atomic_fetch_add(p, v, __ATOMIC_RELAXED, __HIP_MEMORY_SCOPE_AGENT); }
__device__ __forceinline__ unsigned xb_xcc_id() { return (unsigned)__builtin_amdgcn_s_getreg((3 << 11) | 20) & 0xFu; }
#define XB_SPIN(cond, bar) do { unsigned _sp = 0; while (cond) { __builtin_amdgcn_s_sleep(1); \
    if ((++_sp & 255u) == 0u) { if (xb_ld(&(bar)[XB_TMO])) break; if (_sp > XB_SPIN_CAP) { atomicAdd(&(bar)[XB_TMO], 1u); break; } } } } while (0)

struct XcdBarrier {
    unsigned* bar; unsigned x;
    volatile LAS unsigned* st;
};

__device__ __forceinline__ XcdBarrier xcd_barrier_post(unsigned* bar, volatile LAS unsigned* st) {
    XcdBarrier b; b.bar = bar; b.x = xb_xcc_id(); b.st = st;
    if (threadIdx.x == 0) (void)xb_add(&bar[XB_XCNT(b.x)], 1u);
    return b;
}
__device__ __forceinline__ void xcd_barrier_complete(unsigned* bar, unsigned x, unsigned& nloc, unsigned& nx) {
    const unsigned G = gridDim.x * gridDim.y * gridDim.z;
    unsigned sum, cnt, mine, sp = 0u;
    for (;;) {
        sum = 0u; cnt = 0u; mine = 0u;
#pragma unroll
        for (unsigned j = 0; j < 16; ++j) { const unsigned c = xb_ld(&bar[XB_XCNT(j)]); sum += c; cnt += (c > 0u) ? 1u : 0u; mine = (j == x) ? c : mine; }
        if (sum == G) break;
        __builtin_amdgcn_s_sleep(1);
        if ((++sp & 255u) == 0u) { if (xb_ld(&bar[XB_TMO])) break; if (sp > XB_SPIN_CAP) { atomicAdd(&bar[XB_TMO], 1u); break; } }
    }
    nloc = mine > 0u ? mine : 1u; nx = cnt > 0u ? cnt : 1u;
}

__device__ __forceinline__ void xcd_barrier(const XcdBarrier& b) {
    asm volatile("s_waitcnt vmcnt(0)" ::: "memory");
    __syncthreads();
    if (threadIdx.x == 0) {
        unsigned* bar = b.bar;
        __builtin_amdgcn_s_waitcnt(0);
        unsigned nloc = b.st[0], nx = b.st[1];
        if (nloc == 0u) { xcd_barrier_complete(bar, b.x, nloc, nx); b.st[0] = nloc; b.st[1] = nx; }
        const unsigned old = xb_add(&bar[XB_XSUB(b.x)], 1u);
        const unsigned gen = old / nloc;
        if (old + 1u == (gen + 1u) * nloc) {
            __builtin_amdgcn_fence(__ATOMIC_RELEASE, "agent");
            asm volatile("s_waitcnt vmcnt(0)" ::: "memory");
            const unsigned og = xb_add(&bar[XB_TOP], 1u);
            const unsigned tg = og / nx;
            if (og + 1u == (tg + 1u) * nx) xb_add(&bar[XB_TOPGEN], 1u);
            else XB_SPIN(xb_ld(&bar[XB_TOPGEN]) == tg, bar);
            __builtin_amdgcn_fence(__ATOMIC_ACQUIRE, "agent");
            xb_add(&bar[XB_XGEN(b.x)], 1u);
            asm volatile("s_waitcnt vmcnt(0)" ::: "memory");
        } else {
            XB_SPIN(xb_ld(&bar[XB_XGEN(b.x)]) == gen, bar);
            __builtin_amdgcn_fence(__ATOMIC_ACQUIRE, "agent");
            asm volatile("s_waitcnt vmcnt(0)" ::: "memory");
        }
    }
    __syncthreads();
}
__device__ __forceinline__ void p0_transpose_item(const float* W, int K, int N, bf16* WT, int row_off, LAS float* scr, int item, int lane) {
    const int nblk = N / 32, kb = item / nblk, nb = item % nblk, k0 = 64 * kb, n0 = 32 * nb;
#pragma unroll 16
    for (int i = 0; i < 32; ++i) { const int kk = 2 * i + (lane >> 5); scr[kk * 33 + (lane & 31)] = __builtin_nontemporal_load(W + (size_t)(k0 + kk) * N + n0 + (lane & 31)); }
    LDS_WAIT(); asm volatile("" ::: "memory");
    const int c = lane & 7;
#pragma unroll
    for (int j = 0; j < 4; ++j) { const int n = (lane >> 3) + 8 * j; const LAS float* s = scr + (8 * c) * 33 + n;
        v4u o; o.x = pk2(s[0 * 33], s[1 * 33]); o.y = pk2(s[2 * 33], s[3 * 33]); o.z = pk2(s[4 * 33], s[5 * 33]); o.w = pk2(s[6 * 33], s[7 * 33]);
        __builtin_nontemporal_store(o, (GAS v4u*)(WT + (size_t)(row_off + n0 + n) * K + k0 + 8 * c)); }
    LDS_WAIT(); asm volatile("" ::: "memory");
}
struct Args { const float* in[27]; float* out; unsigned char* ws; int seq_lo, seq_hi; };
__device__ __forceinline__ const float* inp(int i) { const char* ka = (const char*)__builtin_amdgcn_kernarg_segment_ptr(); int off = i * 8; asm volatile("" : "+s"(off)); return *(const float* const*)(ka + off); }
__device__ __forceinline__ unsigned char* wsb() { const char* ka = (const char*)__builtin_amdgcn_kernarg_segment_ptr(); int off = 27 * 8 + 8; asm volatile("" : "+s"(off)); return *(unsigned char* const*)(ka + off); }
__device__ __forceinline__ float* outb() { const char* ka = (const char*)__builtin_amdgcn_kernarg_segment_ptr(); int off = 27 * 8; asm volatile("" : "+s"(off)); return *(float* const*)(ka + off); }
__device__ __forceinline__ unsigned char* psb(int set) { return wsb() + WS_PSET + (size_t)set * PS_BYTES; }
enum { I_X = 0, I_C, I_CTX, I_CCTX, I_WMOD, I_BMOD, I_G1, I_G2, I_WIN, I_HCW, I_HCB, I_FW1, I_FB1, I_FW2, I_FB2, I_FW3, I_FFQ, I_HBIAS, I_RDEC, I_RPB, I_WBR, I_WOUT, I_FFW1, I_FFCW, I_FFCB, I_FFW2, I_GF };

__device__ __forceinline__ void ph_prologue(const Args& A, LAS unsigned char* lds, int tid) {
    LAS float* sc = (LAS float*)lds;
    LAS float* red = sc + 5 * 2048;
    const float* c = inp(I_C); const float* cc = inp(I_CCTX);
    for (int i = tid; i < 5 * 2048; i += 512) { const int r = i >> 11, k = i & 2047; const float v = (r < 4) ? c[r * 2048 + k] : cc[k]; sc[i] = v / (1.0f + __expf(-v)); }
    __syncthreads();
    float* mod = (float*)(wsb() + WS_MOD);
    const int kq = tid >> 6, col = tid & 63;
    for (int u = blockIdx.x; u < DEPTH * 192; u += gridDim.x) {
        const int l = u / 192, n0 = (u % 192) * 64;
        const float* W = inp(I_WMOD) + (size_t)l * 2048 * 12288 + n0 + col;
        float a0 = 0.f, a1 = 0.f, a2 = 0.f, a3 = 0.f, a4 = 0.f;
#pragma unroll 16
        for (int k = kq * 256; k < kq * 256 + 256; ++k) { const float w = W[(size_t)k * 12288];
            a0 += sc[k] * w; a1 += sc[2048 + k] * w; a2 += sc[4096 + k] * w; a3 += sc[6144 + k] * w; a4 += sc[8192 + k] * w; }
        red[(kq * 5 + 0) * 64 + col] = a0; red[(kq * 5 + 1) * 64 + col] = a1; red[(kq * 5 + 2) * 64 + col] = a2; red[(kq * 5 + 3) * 64 + col] = a3; red[(kq * 5 + 4) * 64 + col] = a4;
        __syncthreads();
        if (tid < 320) { const int r = tid >> 6; float s = inp(I_BMOD)[l * 12288 + n0 + col];
#pragma unroll
            for (int q = 0; q < 8; ++q) s += red[(q * 5 + r) * 64 + col];
            mod[((size_t)l * 5 + r) * 12288 + n0 + col] = s; }
        __syncthreads();
    }
    if (blockIdx.x == 0) { f32x2* rope = (f32x2*)(wsb() + WS_ROPE);
        for (int i = tid; i < 1024; i += 512) { const int pos = i >> 4, j = i & 15; const float inv = exp2f(-(float)j * (13.287712379549449f / 16.0f));
            const float rev = (float)pos * inv * 0.15915494309189535f; rope[i] = (f32x2){cos_rev(rev), sin_rev(rev)}; } }
}

__device__ __forceinline__ void ph_convert(const Args& A, int l, int set, int it_lo, int it_hi, int wk, int nwk, LAS unsigned char* lds, int wave, int lane) {
    LAS float* scr = (LAS float*)(lds + wave * 16384);
    const int gw = wk * NWAVES + wave, NGW = nwk * NWAVES;
    constexpr int I_IN = (D / 64) * (INW / 32), I_BR = (1024 / 64) * (D / 32), I_OUT = (D / 64) * (D / 32), I_F1 = (D / 64) * (NFF / 32);
    const float* win = inp(I_WIN) + (size_t)l * D * INW; const float* wbr = inp(I_WBR) + (size_t)l * 3 * 1024 * D; const float* wout = inp(I_WOUT) + (size_t)l * D * D;
    const float* wf1 = inp(I_FFW1) + (size_t)l * D * NFF; const float* wf2 = inp(I_FFW2) + (size_t)l * DFF * D;
    unsigned char* ps = psb(set);
    bf16* WIN = (bf16*)(ps + PS_WIN); bf16* WBR = (bf16*)(ps + PS_WBR); bf16* WOUT = (bf16*)(ps + PS_WOUT); bf16* WF1 = (bf16*)(ps + PS_WF1); bf16* WF2 = (bf16*)(ps + PS_WF2);
    for (int it = it_lo + gw; it < it_hi; it += NGW) {
        int r = it;
        if (r < I_IN) { p0_transpose_item(win, D, INW, WIN, 0, scr, r, lane); continue; } r -= I_IN;
        if (r < I_BR) { p0_transpose_item(wbr, 1024, D, WBR, 0, scr, r, lane); continue; } r -= I_BR;
        if (r < I_BR) { p0_transpose_item(wbr + (size_t)1024 * D, 1024, D, WBR + (size_t)D * 1024, 0, scr, r, lane); continue; } r -= I_BR;
        if (r < I_BR) { p0_transpose_item(wbr + (size_t)2 * 1024 * D, 1024, D, WBR + (size_t)2 * D * 1024, 0, scr, r, lane); continue; } r -= I_BR;
        if (r < I_OUT) { p0_transpose_item(wout, D, D, WOUT, 0, scr, r, lane); continue; } r -= I_OUT;
        if (r < I_F1) { const int n0 = (r % (NFF / 32)) * 32, f0 = (n0 < DFF) ? n0 : n0 - DFF, nrow = 256 * (f0 >> 7) + ((n0 < DFF) ? 0 : 128) + (f0 & 127);
            p0_transpose_item(wf1, D, NFF, WF1, nrow - n0, scr, r, lane); continue; } r -= I_F1;
        p0_transpose_item(wf2, DFF, D, WF2, 0, scr, r, lane);
    }
}
constexpr int CONV_ITEMS = (D / 64) * (INW / 32) + 3 * (1024 / 64) * (D / 32) + (D / 64) * (D / 32) + (D / 64) * (NFF / 32) + (DFF / 64) * (D / 32);
__device__ __forceinline__ void ph_filt1(const Args& A, int l, int set, int wk, int nwk, LAS unsigned char* lds, int tid) {
    LAS float* feat = (LAS float*)lds;
    LAS float* h1 = feat + 8 * 33;
    LAS float* w1s = h1 + 8 * 64;
    LAS float* w2s = w1s + 33 * 64;
    const float* w1 = inp(I_FW1) + (size_t)l * 33 * 64; const float* b1 = inp(I_FB1) + l * 64; const float* w2 = inp(I_FW2) + (size_t)l * 64 * 64; const float* b2 = inp(I_FB2) + l * 64;
    const float* fq = inp(I_FFQ) + l * 64; bf16* FH2B = (bf16*)(wsb() + WS_FB4) + (size_t)l * 4352 * 64;
    const int pl = tid >> 6, o = tid & 63;
    __syncthreads();
    for (int i = tid; i < 33 * 64; i += 512) w1s[i] = w1[i];
    for (int i = tid; i < 64 * 64; i += 512) w2s[i] = w2[i];
    const float b1o = b1[o], b2o = b2[o], fqo = fq[o];
    __syncthreads();
    for (int u = wk; u < 544; u += nwk) {
        const int pos = u * 8 + pl; const bool isc = pos >= 4096; const int Lf = isc ? 256 : 4096, tp = isc ? pos - 4096 : pos;
        if (o < 33) { float f;
            if (o == 0) f = (float)tp / (float)(Lf - 1);
            else { const int i = (o - 1) & 15; const float fr = 1e-4f + (float)i * ((15.0f - 1e-4f) / 15.0f); const float rev = fr * (float)tp / (float)Lf; f = (o <= 16) ? cos_rev(rev) : -sin_rev(rev); }
            feat[pl * 33 + o] = f; }
        __syncthreads();
        float a = b1o;
#pragma unroll 11
        for (int i = 0; i < 33; ++i) a += feat[pl * 33 + i] * w1s[i * 64 + o];
        h1[pl * 64 + o] = sin_rad(fqo * a);
        __syncthreads();
        float b = b2o;
#pragma unroll 16
        for (int j = 0; j < 64; ++j) b += h1[pl * 64 + j] * w2s[j * 64 + o];
        FH2B[(size_t)pos * 64 + o] = (bf16)f2bf(sin_rad(fqo * b));
        __syncthreads();
    }
}
__device__ __forceinline__ void ph_norm(const float* xlat, const float* xctx, const float* g, const float* modl, int sh_off, int sc_off, bf16* H, int Mrows, const float* slab, const float* sgate, float* xc_out, int wave, int lane) {
    const int gw = blockIdx.x * NWAVES + wave, NGW = gridDim.x * NWAVES;
    for (int base = gw * 8; base < ML; base += NGW * 8) {
        const float* mv = modl + (size_t)(base >> 12) * 12288;
        f32x4 Gv[8], Sv[8];
#pragma unroll
        for (int j = 0; j < 8; ++j) { const int idx = (lane + 64 * j) * 4; Gv[j] = *(const f32x4*)(g + idx) * (*(const f32x4*)(mv + sc_off + idx) + 1.0f); Sv[j] = *(const f32x4*)(mv + sh_off + idx); }
        f32x4 v[8], nx[8];
#pragma unroll
        for (int j = 0; j < 8; ++j) nx[j] = *(const f32x4*)(xlat + (size_t)base * D + (lane + 64 * j) * 4);
#pragma unroll 1
        for (int i = 0; i < 8; ++i) { const int m = base + i; float ss = 0.f;
#pragma unroll
            for (int j = 0; j < 8; ++j) { v[j] = nx[j]; ss += (v[j].x * v[j].x + v[j].y * v[j].y) + (v[j].z * v[j].z + v[j].w * v[j].w); }
            if (i < 7) {
#pragma unroll
                for (int j = 0; j < 8; ++j) nx[j] = *(const f32x4*)(xlat + (size_t)(m + 1) * D + (lane + 64 * j) * 4); }
            const float rstd = 1.0f / sqrtf(wave_sum(ss) * (1.0f / D) + EPS);
#pragma unroll
            for (int j = 0; j < 8; ++j) { const int idx = (lane + 64 * j) * 4; const f32x4 y = v[j] * rstd * Gv[j] + Sv[j];
                v2u w; w.x = pk2(y.x, y.y); w.y = pk2(y.z, y.w); *(v2u*)(H + (size_t)m * D + idx) = w; } }
    }
    for (int m = ML + gw; m < Mrows; m += NGW) {
        const float* xr = xctx + (size_t)(m - ML) * D; const float* mv = modl + (size_t)4 * 12288;
        f32x4 v[8]; float ss = 0.f;
#pragma unroll
        for (int j = 0; j < 8; ++j) { const int idx = (lane + 64 * j) * 4; v[j] = *(const f32x4*)(xr + idx);
            if (slab) { const float* sp = slab + (size_t)(m - ML) * D + idx; f32x4 p = *(const f32x4*)sp;
#pragma unroll
                for (int q = 1; q < NSPLIT; ++q) p = p + *(const f32x4*)(sp + (size_t)q * MC * D);
                v[j] = v[j] + *(const f32x4*)(sgate + idx) * p; *(f32x4*)(xc_out + (size_t)(m - ML) * D + idx) = v[j]; }
            ss += (v[j].x * v[j].x + v[j].y * v[j].y) + (v[j].z * v[j].z + v[j].w * v[j].w); }
        const float rstd = 1.0f / sqrtf(wave_sum(ss) * (1.0f / D) + EPS);
#pragma unroll
        for (int j = 0; j < 8; ++j) { const int idx = (lane + 64 * j) * 4;
            const f32x4 gg = *(const f32x4*)(g + idx), sh = *(const f32x4*)(mv + sh_off + idx), sc = *(const f32x4*)(mv + sc_off + idx);
            const f32x4 y = v[j] * rstd * gg * (sc + 1.0f) + sh;
            v2u w; w.x = pk2(y.x, y.y); w.y = pk2(y.z, y.w);
            *(v2u*)(H + (size_t)m * D + idx) = w; }
    }
}

__device__ __forceinline__ int fphys(int i) { return i + 2 * (i >> 5); }
__device__ __forceinline__ void bfly_dif(f32x2& a, f32x2& b, float c, float s) { const f32x2 u = a, v = b; a = u + v; const f32x2 d = u - v; b = __builtin_elementwise_fma(d.yx, (f32x2){s, -s}, d * (f32x2){c, c}); }
__device__ __forceinline__ void bfly_idit(f32x2& a, f32x2& b, float c, float s) { const f32x2 u = a, q = b; const f32x2 v = __builtin_elementwise_fma(q.yx, (f32x2){-s, s}, q * (f32x2){c, c}); a = u + v; b = u - v; }
template <bool ZHI> __device__ __forceinline__ void dif16(f32x2 (&x)[16], float th) {
    asm volatile("" : "+v"(th));
#pragma unroll
    for (int k = 0; k < 8; ++k) { const float fr = th + (float)k * 0.0625f; const float c = __builtin_amdgcn_cosf(fr), s = __builtin_amdgcn_sinf(fr);
        if (ZHI) { const f32x2 u = x[k]; x[k + 8] = (f32x2){u.x * c + u.y * s, u.y * c - u.x * s}; } else bfly_dif(x[k], x[k + 8], c, s); }
#pragma unroll
    for (int k = 0; k < 4; ++k) { const float fr = 2.0f * th + (float)k * 0.125f; const float c = __builtin_amdgcn_cosf(fr), s = __builtin_amdgcn_sinf(fr);
        bfly_dif(x[k], x[k + 4], c, s); bfly_dif(x[8 + k], x[12 + k], c, s); }
#pragma unroll
    for (int k = 0; k < 2; ++k) { const float fr = 4.0f * th + (float)k * 0.25f; const float c = __builtin_amdgcn_cosf(fr), s = __builtin_amdgcn_sinf(fr);
#pragma unroll
        for (int b = 0; b < 16; b += 4) bfly_dif(x[b + k], x[b + k + 2], c, s); }
    { const float fr = 8.0f * th; const float c = __builtin_amdgcn_cosf(fr), s = __builtin_amdgcn_sinf(fr);
#pragma unroll
        for (int b = 0; b < 16; b += 2) bfly_dif(x[b], x[b + 1], c, s); }
}
__device__ __forceinline__ void idit16(f32x2 (&x)[16], float th) {
    asm volatile("" : "+v"(th));
    { const float fr = 8.0f * th; const float c = __builtin_amdgcn_cosf(fr), s = __builtin_amdgcn_sinf(fr);
#pragma unroll
        for (int b = 0; b < 16; b += 2) bfly_idit(x[b], x[b + 1], c, s); }
#pragma unroll
    for (int k = 0; k < 2; ++k) { const float fr = 4.0f * th + (float)k * 0.25f; const float c = __builtin_amdgcn_cosf(fr), s = __builtin_amdgcn_sinf(fr);
#pragma unroll
        for (int b = 0; b < 16; b += 4) bfly_idit(x[b + k], x[b + k + 2], c, s); }
#pragma unroll
    for (int k = 0; k < 4; ++k) { const float fr = 2.0f * th + (float)k * 0.125f; const float c = __builtin_amdgcn_cosf(fr), s = __builtin_amdgcn_sinf(fr);
        bfly_idit(x[k], x[k + 4], c, s); bfly_idit(x[8 + k], x[12 + k], c, s); }
#pragma unroll
    for (int k = 0; k < 8; ++k) { const float fr = th + (float)k * 0.0625f; const float c = __builtin_amdgcn_cosf(fr), s = __builtin_amdgcn_sinf(fr); bfly_idit(x[k], x[k + 8], c, s); }
}
template <bool INV, int PSTRIDE> __device__ __forceinline__ void fft_pass(LAS f32x2* buf, int base, float th) {
    LAS f32x2* p = buf + fphys(base);
    f32x2 x[16];
#pragma unroll
    for (int k = 0; k < 16; ++k) x[k] = p[k * PSTRIDE];
    if (INV) idit16(x, th); else dif16<false>(x, th);
#pragma unroll
    for (int k = 0; k < 16; ++k) p[k * PSTRIDE] = x[k];
}
constexpr int FFT_LDS_BYTES = (8192 + 512 + 8) * 8;
__device__ __forceinline__ float block_sum(float v, LAS float* red, int tid) {
    v = wave_sum(v);
    __syncthreads();
    if ((tid & 63) == 0) red[tid >> 6] = v;
    __syncthreads();
    float s = 0.f;
#pragma unroll
    for (int i = 0; i < 8; ++i) s += red[i];
    return s;
}
__device__ __forceinline__ float hy_delta(int c) { const float d0 = -4.605170185988091f / 0.3f, d1 = -4.605170185988091f / 1.5f; return fabsf(d0 + (d1 - d0) * ((float)c / 1023.0f)); }
__device__ __forceinline__ void ph_filt2(const Args& A, int l, int set, int c_lo, int c_hi, int wk, int nwk, LAS unsigned char* lds, int tid) {
    LAS f32x2* buf = (LAS f32x2*)lds; LAS float* bufs = (LAS float*)lds; LAS float* red = (LAS float*)(lds + FFT_LDS_BYTES + 64); LAS float* w3s = red + 32;
    LAS float* ctap = w3s + 256;
    const float* w3 = inp(I_FW3) + (size_t)l * 64 * 4096; const bf16* FH2B = (const bf16*)(wsb() + WS_FB4) + (size_t)l * 4352 * 64;
    f32x2* KF = (f32x2*)(psb(set) + PS_KF); float* TAPC = (float*)(psb(set) + PS_TAPC);
    const int lane = tid & 63, w = tid >> 6, g = lane >> 4, li = lane & 15;
    for (int c = c_lo + wk; c < c_hi; c += nwk) {
        __syncthreads();
        if (tid < 256) w3s[tid] = w3[(size_t)(tid & 63) * 4096 + (tid >> 7) * 2048 + ((tid >> 6) & 1) * 1024 + c];
        __syncthreads();
        bf16x8 bfr[2];
#pragma unroll
        for (int ks = 0; ks < 2; ++ks) { float v[8];
#pragma unroll
            for (int j = 0; j < 8; ++j) v[j] = (li < 4) ? w3s[li * 64 + 32 * ks + 8 * g + j] : 0.f;
            bfr[ks] = mk8(pk2(v[0], v[1]), pk2(v[2], v[3]), pk2(v[4], v[5]), pk2(v[6], v[7])); }
        const float delta = hy_delta(c); float ssq = 0.f, ssqc = 0.f;
        const int comp = li >> 1;
#pragma unroll 1
        for (int rb = 0; rb < 272; rb += 64) {
            bf16x8 a0[8], a1[8];
#pragma unroll
            for (int rk = 0; rk < 8; ++rk) { const int rt = rb + w + 8 * rk; const bf16* ap = FH2B + (size_t)((rt < 272 ? rt : 0) * 16 + li) * 64 + 8 * g;
                a0[rk] = *(const bf16x8*)ap; a1[rk] = *(const bf16x8*)(ap + 32); }
#pragma unroll
            for (int rk = 0; rk < 8; ++rk) { const int rt = rb + w + 8 * rk; const int t0 = rt * 16;
                f32x4 acc = (f32x4){0.f, 0.f, 0.f, 0.f};
                acc = mfma16(a0[rk], bfr[0], acc); acc = mfma16(a1[rk], bfr[1], acc);
                if (li < 4 && rt < 272) {
                    if (rt < 256) {
#pragma unroll
                        for (int j = 0; j < 4; ++j) { const int t = t0 + 4 * g + j; const float val = acc[j] * __expf(-((float)t * (1.0f / 4095.0f)) * delta);
                            if ((li & 1) == 0) { bufs[2 * fphys(t) + comp] = val; ssq += val * val; }
                            else if (t >= 1) { bufs[2 * fphys(8192 - t) + comp] = val; ssq += val * val; }
                            else bufs[2 * fphys(4096) + comp] = 0.f; }
                    } else {
#pragma unroll
                        for (int j = 0; j < 4; ++j) { const int m = t0 - 4096 + 4 * g + j; const float val = acc[j] * __expf(-((float)m * (1.0f / 255.0f)) * delta);
                            ctap[li * 256 + m] = val; if ((li & 1) == 0 || m >= 1) ssqc += val * val; }
                    }
                }
            }
        }
        const bool o0 = (li < 2), o1 = (li == 2 || li == 3);
        const float scl0 = (1.0f / 8192.0f) / sqrtf(block_sum(o0 ? ssq : 0.f, red, tid) + EPS), scl1 = (1.0f / 8192.0f) / sqrtf(block_sum(o1 ? ssq : 0.f, red, tid) + EPS);
        const float sc0 = 1.0f / sqrtf(block_sum(o0 ? ssqc : 0.f, red, tid) + EPS), sc1 = 1.0f / sqrtf(block_sum(o1 ? ssqc : 0.f, red, tid) + EPS);
        __syncthreads();
        fft_pass<false, 544>(buf, tid, (float)tid * (1.0f / 8192.0f));
        __syncthreads();
        fft_pass<false, 34>(buf, (tid >> 5) * 512 + (tid & 31), (float)(tid & 31) * (1.0f / 512.0f));
        __syncthreads();
        fft_pass<false, 2>(buf, (tid >> 1) * 32 + (tid & 1), (float)(tid & 1) * (1.0f / 32.0f));
        __syncthreads();
#pragma unroll
        for (int r = 0; r < 8; ++r) { LAS f32x4* pp = (LAS f32x4*)(buf + fphys(2 * tid) + 1088 * r); const f32x4 ab = *pp; *pp = (f32x4){ab.x + ab.z, ab.y + ab.w, ab.x - ab.z, ab.y - ab.w}; }
        __syncthreads();
        f32x2* d0 = KF + (size_t)c * 8192; f32x2* d1 = KF + (size_t)(1024 + c) * 8192;
#pragma unroll 4
        for (int i = 0; i < 16; ++i) { const int p = tid + 512 * i; const int f = (int)(__brev((unsigned)p) >> 19); const int pp = (int)(__brev((unsigned)((8192 - f) & 8191)) >> 19);
            const f32x2 z = buf[fphys(p)], zp = buf[fphys(pp)];
            d0[p] = (f32x2){(z.x + zp.x) * 0.5f * scl0, (z.y - zp.y) * 0.5f * scl0};
            d1[p] = (f32x2){(z.y + zp.y) * 0.5f * scl1, (zp.x - z.x) * 0.5f * scl1}; }
        for (int q = tid; q < 1024; q += 512) { const int od = q >> 8, m = q & 255; TAPC[((size_t)od * 1024 + c) * 256 + m] = ctap[q] * ((od < 2) ? sc0 : sc1); }
    }
}

__device__ __forceinline__ void ph_hyprep(const Args& A, int l, LAS unsigned char* lds, int tid) {
    LAS bf16* T = (LAS bf16*)lds;
    const bf16* Z = (const bf16*)(wsb() + WS_Z); bf16* HYT = (bf16*)(wsb() + WS_HYT);
    const float* cw = inp(I_HCW) + (size_t)l * 3 * 3072; const float* cb = inp(I_HCB) + (size_t)l * 3072;
    v4u pre[5];
#define HP_LOAD(u_) do { const int cg_ = (u_) % 12, tt_ = ((u_) / 12) & 63, b_ = (u_) / 768; \
        _Pragma("unroll") for (int e = 0; e < 5; ++e) { const int q = tid + 512 * e; const int r = q >> 5, ch8 = q & 31, t = tt_ * 64 - 1 + r; pre[e] = (v4u){0u, 0u, 0u, 0u}; \
            if (q < 66 * 32 && t >= 0 && t < SEQ) pre[e] = *(const v4u*)(Z + (size_t)(b_ * SEQ + t) * INW + C_HY + cg_ * 256 + ch8 * 8); } } while (0)
    int u = blockIdx.x;
    if (u < 3072) HP_LOAD(u);
    for (; u < 3072; u += gridDim.x) {
        const int cg = u % 12, tt = (u / 12) & 63, b = u / 768;
        __syncthreads();
#pragma unroll
        for (int e = 0; e < 5; ++e) { const int q = tid + 512 * e; if (q < 66 * 32) *(LAS v4u*)(T + (q >> 5) * 264 + (q & 31) * 8) = pre[e]; }
        __syncthreads();
        if (u + (int)gridDim.x < 3072) HP_LOAD(u + (int)gridDim.x);
        const int ch = tid & 255, half = tid >> 8, gch = cg * 256 + ch;
        const float w0 = cw[gch], w1 = cw[3072 + gch], w2 = cw[6144 + gch], bb = cb[gch];
        const int part = gch >> 10, c = gch & 1023;
        bf16* outp = HYT + ((size_t)(part * NB + b) * 1024 + c) * SEQ + tt * 64 + half * 32;
#pragma unroll
        for (int tq = 0; tq < 4; ++tq) { float vv[8];
#pragma unroll
            for (int e = 0; e < 8; ++e) { const int tl = half * 32 + tq * 8 + e;
                vv[e] = w0 * bf1(T[tl * 264 + ch]) + w1 * bf1(T[(tl + 1) * 264 + ch]) + w2 * bf1(T[(tl + 2) * 264 + ch]) + bb; }
            v4u w; w.x = pk2(vv[0], vv[1]); w.y = pk2(vv[2], vv[3]); w.z = pk2(vv[4], vv[5]); w.w = pk2(vv[6], vv[7]);
            *(v4u*)(outp + tq * 8) = w; }
    }
#undef HP_LOAD
}
__device__ __forceinline__ void ph_hyctx(const Args& A, int l, LAS unsigned char* lds, int tid) {
    const bf16* Z = (const bf16*)(wsb() + WS_Z); bf16* YS = (bf16*)(wsb() + WS_YS); const float* TAPC = (const float*)(psb(l & 1) + PS_TAPC);
    const float* cw = inp(I_HCW) + (size_t)l * 3 * 3072; const float* cb = inp(I_HCB) + (size_t)l * 3072; const float* hb = inp(I_HBIAS) + (size_t)l * 2 * 1024;
    const int ch = tid >> 6, q = tid & 63, t0 = 4 * q;
    LAS float* Y = (LAS float*)lds + ch * 1552; LAS float* Y1 = Y + 256; LAS float* G0 = Y + 512; LAS float* G1 = Y + 1032;
    LAS bf16* R = (LAS bf16*)((LAS float*)lds + 8 * 1552);
    for (int u = blockIdx.x; u < 512; u += gridDim.x) {
        const int b = u >> 7, cg8 = (u & 127) * 8, c = cg8 + ch;
        __syncthreads();
        for (int i = tid; i < 768; i += 512) { const int row = i / 3, part = i - row * 3; *(LAS v4u*)(R + row * 24 + part * 8) = *(const v4u*)(Z + (size_t)(ML + b * CL + row) * INW + C_HY + part * 1024 + cg8); }
#pragma unroll
        for (int r = 0; r < 4; ++r) { const int m = t0 + r;
            G0[m + 259] = TAPC[((size_t)(0 * 2 + 0) * 1024 + c) * 256 + m]; G1[m + 259] = TAPC[((size_t)(1 * 2 + 0) * 1024 + c) * 256 + m];
            if (m >= 1) { G0[259 - m] = TAPC[((size_t)(0 * 2 + 1) * 1024 + c) * 256 + m]; G1[259 - m] = TAPC[((size_t)(1 * 2 + 1) * 1024 + c) * 256 + m]; } }
        if (q == 0) { G0[515] = 0.f; G1[515] = 0.f; G0[516] = 0.f; G1[516] = 0.f; }
        __syncthreads();
        float pv[3][4];
#pragma unroll
        for (int part = 0; part < 3; ++part) { const int gch = part * 1024 + c; const float w0 = cw[gch], w1 = cw[3072 + gch], w2 = cw[6144 + gch], bb = cb[gch];
            float zz[6];
#pragma unroll
            for (int e = 0; e < 6; ++e) { const int t = t0 - 1 + e; zz[e] = (t >= 0 && t < CL) ? bf1(R[t * 24 + part * 8 + ch]) : 0.f; }
#pragma unroll
            for (int r = 0; r < 4; ++r) pv[part][r] = w0 * zz[r] + w1 * zz[r + 1] + w2 * zz[r + 2] + bb; }
        *(LAS f32x4*)(Y + t0) = (f32x4){pv[2][0], pv[2][1], pv[2][2], pv[2][3]};
        __syncthreads();
        float yprev[4] = {pv[2][0], pv[2][1], pv[2][2], pv[2][3]};
#pragma unroll
        for (int ord = 0; ord < 2; ++ord) {
            const LAS float* Ys = ord ? Y1 : Y; const LAS float* G = ord ? G1 : G0;
            float acc[4] = {0.f, 0.f, 0.f, 0.f};
#pragma unroll 4
            for (int sp = 0; sp < 64; ++sp) { const f32x4 yv = *(const LAS f32x4*)(Ys + 4 * sp); const LAS float* gp = G + 4 * (q - sp) + 256;
                const f32x4 ga = *(const LAS f32x4*)gp, gb = *(const LAS f32x4*)(gp + 4);
                const float g[8] = {ga.x, ga.y, ga.z, ga.w, gb.x, gb.y, gb.z, gb.w}; const float yy[4] = {yv.x, yv.y, yv.z, yv.w};
#pragma unroll
                for (int r = 0; r < 4; ++r)
#pragma unroll
                    for (int j = 0; j < 4; ++j) acc[r] += yy[j] * g[r - j + 3]; }
            const float bias = hb[ord * 1024 + c];
#pragma unroll
            for (int r = 0; r < 4; ++r) yprev[r] = pv[ord][r] * (acc[r] + bias * yprev[r]);
            if (ord == 0) { *(LAS f32x4*)(Y1 + t0) = (f32x4){yprev[0], yprev[1], yprev[2], yprev[3]}; __syncthreads(); }
        }
#pragma unroll
        for (int r = 0; r < 4; ++r) YS[(size_t)(ML + b * CL + t0 + r) * 1024 + c] = (bf16)f2bf(yprev[r]);
    }
}
__device__ __forceinline__ void unpack8(v4u v, float (&x)[8]) { x[0] = bflo(v.x); x[1] = bfhi(v.x); x[2] = bflo(v.y); x[3] = bfhi(v.y); x[4] = bflo(v.z); x[5] = bfhi(v.z); x[6] = bflo(v.w); x[7] = bfhi(v.w); }
__device__ __forceinline__ v4u pack8(const float (&x)[8]) { v4u w; w.x = pk2(x[0], x[1]); w.y = pk2(x[2], x[3]); w.z = pk2(x[4], x[5]); w.w = pk2(x[6], x[7]); return w; }
__device__ __forceinline__ void rope8(float (&lo)[8], float (&hi)[8], const f32x2* rt) {
#pragma unroll
    for (int e = 0; e < 8; ++e) { const f32x2 cs = rt[e]; const float a = lo[e], b = hi[e]; lo[e] = a * cs.x - b * cs.y; hi[e] = b * cs.x + a * cs.y; }
}
__device__ __forceinline__ void vt_store(LAS bf16* Vt, int ld, int d0, int r, v4u vv) {
    Vt[(d0 + 0) * ld + r] = (bf16)(vv.x & 0xffffu); Vt[(d0 + 1) * ld + r] = (bf16)(vv.x >> 16);
    Vt[(d0 + 2) * ld + r] = (bf16)(vv.y & 0xffffu); Vt[(d0 + 3) * ld + r] = (bf16)(vv.y >> 16);
    Vt[(d0 + 4) * ld + r] = (bf16)(vv.z & 0xffffu); Vt[(d0 + 5) * ld + r] = (bf16)(vv.z >> 16);
    Vt[(d0 + 6) * ld + r] = (bf16)(vv.w & 0xffffu); Vt[(d0 + 7) * ld + r] = (bf16)(vv.w >> 16);
}
constexpr float LOG2E = 1.4426950408889634f;
typedef short s16x4 __attribute__((ext_vector_type(4)));
__device__ __forceinline__ bf16x8 tr_frag(const LAS bf16* tile, int ld, int r0, int r1, int c0, int li) {
    const s16x4 lo = __builtin_amdgcn_ds_read_tr16_b64_v4i16((LAS s16x4*)(tile + (r0 + (li >> 2)) * ld + c0 + 4 * (li & 3)));
    const s16x4 hi = __builtin_amdgcn_ds_read_tr16_b64_v4i16((LAS s16x4*)(tile + (r1 + (li >> 2)) * ld + c0 + 4 * (li & 3)));
    return (bf16x8){lo.x, lo.y, lo.z, lo.w, hi.x, hi.y, hi.z, hi.w};
}
__device__ __forceinline__ void ph_ret1(const Args& A, int l, int nctx_units, LAS unsigned char* lds, int tid) {
    LAS bf16* Kf = (LAS bf16*)lds; LAS bf16* Kb = Kf + 128 * 72; LAS bf16* Vs = Kb + 128 * 72;
    const bf16* Z = (const bf16*)(wsb() + WS_Z); float* KV = (float*)(wsb() + WS_KV); const f32x2* rope = (const f32x2*)(wsb() + WS_ROPE);
    const int lane = tid & 63, w = tid >> 6, g = lane >> 4, li = lane & 15;
    const int tok = tid >> 2, pp = tid & 3, a = (pp & 1) + ((pp >> 1) << 2);
    const int nunits = 1024 + nctx_units;
    v4u pk[2], pv[4];
#define R1_DEC(uid_, b_, h_, n_, ci_, m0_, isc_) const bool isc_ = (uid_) >= 1024; int b_, h_, n_, ci_; size_t m0_; \
        if (!isc_) { b_ = (uid_) >> 8; h_ = ((uid_) >> 5) & 7; n_ = (uid_) & 31; m0_ = (size_t)b_ * SEQ + n_ * 128; ci_ = 2 + n_; } \
        else { const int i_ = (uid_) - 1024; b_ = i_ >> 4; h_ = (i_ >> 1) & 7; n_ = i_ & 1; m0_ = (size_t)ML + b_ * CL + n_ * 128; ci_ = n_; }
#define R1_LOAD(uid_) do { R1_DEC(uid_, b2, h2, n2, ci2, m02, isc2) (void)ci2; (void)n2; (void)isc2; const bf16* kr = Z + (m02 + tok) * INW + C_RK + h2 * 64; pk[0] = *(const v4u*)(kr + 8 * a); pk[1] = *(const v4u*)(kr + 8 * a + 16); \
        _Pragma("unroll") for (int e = 0; e < 4; ++e) { const int q = tid + 512 * e; pv[e] = *(const v4u*)(Z + (m02 + (q >> 4)) * INW + C_RV + h2 * 128 + (q & 15) * 8); } } while (0)
    int uid = blockIdx.x;
    if (uid < nunits) R1_LOAD(uid);
    for (; uid < nunits; uid += gridDim.x) {
        R1_DEC(uid, b, h, n, ci, m0, isc) (void)m0;
        const float lgf = inp(I_RDEC)[(l * 2 + 0) * 8 + h] * LOG2E, lgb = inp(I_RDEC)[(l * 2 + 1) * 8 + h] * LOG2E;
        __syncthreads();
        { float lo[8], hi[8]; unpack8(pk[0], lo); unpack8(pk[1], hi);
            if (!isc) { const int t = n * 128 + tok; const int pos = (a < 4) ? (t >> 6) : (t & 63); rope8(lo, hi, rope + pos * 16 + 8 * (a & 1)); }
            const float zf = ex2(lgf * (float)(127 - tok)) * 0.125f, zb = ex2(lgb * (float)tok) * 0.125f;
            float lf[8], hf[8];
#pragma unroll
            for (int e = 0; e < 8; ++e) { lf[e] = lo[e] * zf; hf[e] = hi[e] * zf; lo[e] *= zb; hi[e] *= zb; }
            *(LAS v4u*)(Kf + tok * 72 + 8 * a) = pack8(lf); *(LAS v4u*)(Kf + tok * 72 + 8 * a + 16) = pack8(hf);
            *(LAS v4u*)(Kb + tok * 72 + 8 * a) = pack8(lo); *(LAS v4u*)(Kb + tok * 72 + 8 * a + 16) = pack8(hi); }
#pragma unroll
        for (int e = 0; e < 4; ++e) { const int q = tid + 512 * e; *(LAS v4u*)(Vs + (q >> 4) * 144 + (q & 15) * 8) = pv[e]; }
        __syncthreads();
        if (uid + (int)gridDim.x < nunits) R1_LOAD(uid + (int)gridDim.x);
        bf16x8 af[4];
#pragma unroll
        for (int ks = 0; ks < 4; ++ks) af[ks] = tr_frag(Vs, 144, 32 * ks + 8 * g, 32 * ks + 8 * g + 4, 16 * w, li);
#pragma unroll
        for (int dir = 0; dir < 2; ++dir) { const LAS bf16* KT = dir ? Kb : Kf;
            float* dst = KV + ((size_t)((b * 8 + h) * 2 + dir) * 34 + ci) * 8192;
#pragma unroll
            for (int nc = 0; nc < 4; ++nc) { f32x4 acc = (f32x4){0.f, 0.f, 0.f, 0.f};
#pragma unroll
                for (int ks = 0; ks < 4; ++ks) acc = mfma16(af[ks], tr_frag(KT, 72, 32 * ks + 8 * g, 32 * ks + 8 * g + 4, 16 * nc, li), acc);
#pragma unroll
                for (int j = 0; j < 4; ++j) dst[(16 * w + 4 * g + j) * 64 + 16 * nc + li] = acc[j]; } }
    }
#undef R1_LOAD
}
__device__ __forceinline__ void ph_natt(const Args& A, int l, int mode, LAS unsigned char* lds, int tid) {
    LAS bf16* Qs = (LAS bf16*)lds; LAS bf16* KV0 = (LAS bf16*)lds; LAS float* rpbs = (LAS float*)(lds + 2 * (64 * 136 + 64 * 144) * 2);
    const bf16* Z = (const bf16*)(wsb() + WS_Z); bf16* YS = (bf16*)(wsb() + WS_YS) + (size_t)2 * MT * 1024;
    const int lane = tid & 63, w = tid >> 6, g = lane >> 4, li = lane & 15;
    const float SCALE = 0.08838834764831845f * LOG2E;
    const int sr0 = tid >> 4, sch = tid & 15;
    const int ufirst = mode ? ((int)blockIdx.x - ((int)gridDim.x - 32)) : (int)blockIdx.x, ucount = mode ? 32 : 512;
    if (ufirst < 0) return;
    for (int uid = ufirst; uid < ucount; uid += (mode ? 32 : (int)gridDim.x)) {
        int b, h, rq = 0; size_t m0;
        if (!mode) { b = uid >> 7; h = (uid >> 4) & 7; rq = uid & 15; m0 = (size_t)b * SEQ + rq * 256; }
        else { b = uid >> 3; h = uid & 7; m0 = (size_t)ML + b * CL; }
        const size_t mc0 = (size_t)ML + b * CL;
        const int qr = 4 * rq + (w >> 1), rs_w = min(max(qr - 4, 0), 56);
        const int kr_lo = min(max(4 * rq - 4, 0), 56), kr_hi = min(max(4 * rq - 1, 0), 56) + 7;
        const int nwin = mode ? 0 : (kr_hi - kr_lo + 1), ntile = nwin + 4;
        int qc[2], cs[2], nlo_w[2], nhi_w[2];
#pragma unroll
        for (int i = 0; i < 2; ++i) { const int cw = 2 * (w & 1) + i; qc[i] = 16 * cw + li; cs[i] = min(max(qc[i] - 8, 0), 48);
            nlo_w[i] = (cw <= 1) ? 0 : cw - 1; nhi_w[i] = (cw == 0) ? 1 : ((cw == 3) ? 3 : cw + 1); }
        v4u kreg[2], vreg[2];
#define NA_LOAD(t_) do { const int t__ = (t_); const size_t mk = (t__ < nwin) ? ((size_t)b * SEQ + (kr_lo + t__) * 64) : (mc0 + (t__ - nwin) * 64); \
            _Pragma("unroll") for (int e = 0; e < 2; ++e) { const bf16* zr = Z + (mk + sr0 + 32 * e) * INW + h * 128 + sch * 8; kreg[e] = *(const v4u*)(zr + C_NK); vreg[e] = *(const v4u*)(zr + C_NV); } } while (0)
#define NA_STORE(buf_) do { LAS bf16* Kd = KV0 + (buf_) * (64 * 136 + 64 * 144); LAS bf16* Vd = Kd + 64 * 136; \
            _Pragma("unroll") for (int e = 0; e < 2; ++e) { *(LAS v4u*)(Kd + (sr0 + 32 * e) * 136 + sch * 8) = kreg[e]; *(LAS v4u*)(Vd + (sr0 + 32 * e) * 144 + sch * 8) = vreg[e]; } } while (0)
        __syncthreads();
        NA_LOAD(0);
        for (int q = tid; q < 4096; q += 512) { const int r = q >> 4, chn = q & 15; *(LAS v4u*)(Qs + r * 136 + chn * 8) = *(const v4u*)(Z + (m0 + r) * INW + C_NQ + h * 128 + chn * 8); }
        if (!mode) for (int i = tid; i < 465; i += 512) rpbs[i] = inp(I_RPB)[((size_t)l * 8 + h) * 465 + i] * LOG2E;
        __syncthreads();
        bf16x8 qf[2][4];
#pragma unroll
        for (int i = 0; i < 2; ++i)
#pragma unroll
            for (int ks = 0; ks < 4; ++ks) qf[i][ks] = *(const LAS bf16x8*)(Qs + (32 * w + 16 * i + li) * 136 + 32 * ks + 8 * g);
        __syncthreads();
        NA_STORE(0);
        __syncthreads();
        f32x4 o[2][8];
#pragma unroll
        for (int i = 0; i < 2; ++i)
#pragma unroll
            for (int nd = 0; nd < 8; ++nd) o[i][nd] = (f32x4){0.f, 0.f, 0.f, 0.f};
        float mrun[2] = {-1e30f, -1e30f}, lrun[2] = {0.f, 0.f};
        for (int t = 0; t < ntile; ++t) {
            const bool win = t < nwin; const int kr = kr_lo + t;
            if (t + 1 < ntile) NA_LOAD(t + 1);
            const LAS bf16* Ks = KV0 + (t & 1) * (64 * 136 + 64 * 144); const LAS bf16* Vs = Ks + 64 * 136;
            const bool active = !win || (kr >= rs_w && kr <= rs_w + 7);
            if (active) {
                const int nlo0 = win ? nlo_w[0] : 0, nhi0 = win ? nhi_w[0] : 3, nlo1 = win ? nlo_w[1] : 0, nhi1 = win ? nhi_w[1] : 3;
                f32x4 s[2][4];
#pragma unroll
                for (int n = 0; n < 4; ++n) { s[0][n] = (f32x4){0.f, 0.f, 0.f, 0.f}; s[1][n] = (f32x4){0.f, 0.f, 0.f, 0.f};
                    const bool u0 = (n >= nlo0 && n <= nhi0), u1 = (n >= nlo1 && n <= nhi1);
                    if (u0 || u1) {
#pragma unroll
                        for (int ks = 0; ks < 4; ++ks) { const bf16x8 kf = *(const LAS bf16x8*)(Ks + (16 * n + li) * 136 + 32 * ks + 8 * g);
                            if (u0) s[0][n] = mfma16(kf, qf[0][ks], s[0][n]);
                            if (u1) s[1][n] = mfma16(kf, qf[1][ks], s[1][n]); } } }
                bf16x8 pf[2][2];
#pragma unroll
                for (int i = 0; i < 2; ++i) {
                    float tmax = -1e30f;
#pragma unroll
                    for (int n = 0; n < 4; ++n)
#pragma unroll
                        for (int j = 0; j < 4; ++j) { float v = s[i][n][j] * SCALE;
                            if (win) { const int kc = 16 * n + 4 * g + j; const bool valid = (kc >= cs[i]) && (kc < cs[i] + 16);
                                const int dc = min(max(kc - qc[i] + 15, 0), 30), dr = min(max(kr - qr + 7, 0), 14);
                                v = valid ? v + rpbs[dr * 31 + dc] : -1e30f; }
                            s[i][n][j] = v; tmax = fmaxf(tmax, v); }
                    tmax = fmaxf(tmax, __shfl_xor(tmax, 16)); tmax = fmaxf(tmax, __shfl_xor(tmax, 32));
                    const bool upd = tmax > mrun[i] + 8.0f;
                    const float mnew = upd ? tmax : mrun[i];
                    float psum = 0.f;
#pragma unroll
                    for (int n = 0; n < 4; ++n)
#pragma unroll
                        for (int j = 0; j < 4; ++j) { const float pv = ex2(s[i][n][j] - mnew); s[i][n][j] = pv; psum += pv; }
                    psum += __shfl_xor(psum, 16); psum += __shfl_xor(psum, 32);
                    if (__any(upd)) { const float alpha = ex2(mrun[i] - mnew); lrun[i] *= alpha;
#pragma unroll
                        for (int nd = 0; nd < 8; ++nd) o[i][nd] = o[i][nd] * alpha; }
                    lrun[i] += psum; mrun[i] = mnew;
#pragma unroll
                    for (int kk = 0; kk < 2; ++kk) pf[i][kk] = mk8(pk2(s[i][2 * kk][0], s[i][2 * kk][1]), pk2(s[i][2 * kk][2], s[i][2 * kk][3]), pk2(s[i][2 * kk + 1][0], s[i][2 * kk + 1][1]), pk2(s[i][2 * kk + 1][2], s[i][2 * kk + 1][3]));
                }
#pragma unroll
                for (int kk = 0; kk < 2; ++kk) { const bool u0 = (2 * kk + 1 >= nlo0 && 2 * kk <= nhi0), u1 = (2 * kk + 1 >= nlo1 && 2 * kk <= nhi1);
                    if (u0 || u1) {
#pragma unroll
                        for (int nd = 0; nd < 8; ++nd) { const bf16x8 vf = tr_frag(Vs, 144, 32 * kk + 4 * g, 32 * kk + 16 + 4 * g, 16 * nd, li);
                            if (u0) o[0][nd] = mfma16(vf, pf[0][kk], o[0][nd]);
                            if (u1) o[1][nd] = mfma16(vf, pf[1][kk], o[1][nd]); } } }
            }
            if (t + 1 < ntile) NA_STORE((t + 1) & 1);
            __syncthreads();
        }
#undef NA_LOAD
#undef NA_STORE
#pragma unroll
        for (int i = 0; i < 2; ++i) { const float inv = 1.0f / lrun[i]; const size_t mrow = m0 + 32 * w + 16 * i + li;
#pragma unroll
            for (int nd = 0; nd < 8; ++nd) { v2u wv; wv.x = pk2(o[i][nd][0] * inv, o[i][nd][1] * inv); wv.y = pk2(o[i][nd][2] * inv, o[i][nd][3] * inv);
                *(v2u*)(YS + mrow * 1024 + h * 128 + 16 * nd + 4 * g) = wv; } }
    }
}

__device__ __forceinline__ void ph_hyfft(const Args& A, int l, LAS unsigned char* lds, int tid) {
    LAS f32x2* buf = (LAS f32x2*)lds;
    const bf16* HYT = (const bf16*)(wsb() + WS_HYT); bf16* YT = (bf16*)(wsb() + WS_YT); const f32x2* KF = (const f32x2*)(psb(l & 1) + PS_KF);
    const float* hb = inp(I_HBIAS) + (size_t)l * 2 * 1024;
    const int baseB = (tid >> 5) * 512 + (tid & 31), baseC = (tid >> 1) * 32 + (tid & 1);
    const float thA = (float)tid * (1.0f / 8192.0f), thB = (float)(tid & 31) * (1.0f / 512.0f), thC = (float)(tid & 1) * (1.0f / 32.0f);
    const size_t bstr = (size_t)1024 * SEQ;
    bf16 vr0[8], vr1[8];
#define HF_PTR(u_, part_) (HYT + ((size_t)((part_) * NB + ((u_) & 1) * 2) * 1024 + ((u_) >> 1)) * SEQ)
    int u = blockIdx.x;
    if (u < 2048) { const bf16* vp = HF_PTR(u, 2);
#pragma unroll
        for (int i = 0; i < 8; ++i) { vr0[i] = vp[tid + 512 * i]; vr1[i] = vp[bstr + tid + 512 * i]; } }
    for (; u < 2048; u += gridDim.x) {
        const int c = u >> 1, b0 = (u & 1) * 2;
        float y0[8], y1[8];
#pragma unroll
        for (int i = 0; i < 8; ++i) { y0[i] = bf1(vr0[i]); y1[i] = bf1(vr1[i]); }
#pragma unroll
        for (int ord = 0; ord < 2; ++ord) {
            f32x4 kreg[8]; bf16 xr0[8], xr1[8];
            { const f32x4* kf = (const f32x4*)(KF + (size_t)(ord * 1024 + c) * 8192); const bf16* xp = HF_PTR(u, ord);
#pragma unroll
                for (int r = 0; r < 8; ++r) { kreg[r] = kf[tid + 512 * r]; xr0[r] = xp[tid + 512 * r]; xr1[r] = xp[bstr + tid + 512 * r]; } }
            { f32x2 x[16];
#pragma unroll
                for (int k = 0; k < 8; ++k) { x[k] = (f32x2){y0[k], y1[k]}; x[k + 8] = (f32x2){0.f, 0.f}; }
                dif16<true>(x, thA);
                __syncthreads();
#pragma unroll
                for (int k = 0; k < 16; ++k) buf[fphys(tid) + 544 * k] = x[k]; }
            __syncthreads();
            fft_pass<false, 34>(buf, baseB, thB);
            __syncthreads();
            fft_pass<false, 2>(buf, baseC, thC);
            __syncthreads();
#pragma unroll
            for (int r = 0; r < 8; ++r) { LAS f32x4* pp = (LAS f32x4*)(buf + fphys(2 * tid) + 1088 * r); const f32x4 ab = *pp; const f32x4 kk = kreg[r];
                const float ax = ab.x + ab.z, ay = ab.y + ab.w, bx = ab.x - ab.z, by = ab.y - ab.w;
                const float px = ax * kk.x - ay * kk.y, py = ax * kk.y + ay * kk.x, qx = bx * kk.z - by * kk.w, qy = bx * kk.w + by * kk.z;
                *pp = (f32x4){px + qx, py + qy, px - qx, py - qy}; }
            __syncthreads();
            fft_pass<true, 2>(buf, baseC, thC);
            __syncthreads();
            fft_pass<true, 34>(buf, baseB, thB);
            __syncthreads();
            if (ord == 1 && u + (int)gridDim.x < 2048) { const bf16* vp = HF_PTR(u + (int)gridDim.x, 2);
#pragma unroll
                for (int i = 0; i < 8; ++i) { vr0[i] = vp[tid + 512 * i]; vr1[i] = vp[bstr + tid + 512 * i]; } }
            { f32x2 x[16];
#pragma unroll
                for (int k = 0; k < 16; ++k) x[k] = buf[fphys(tid) + 544 * k];
                idit16(x, thA);
                const float bias = hb[ord * 1024 + c];
#pragma unroll
                for (int k = 0; k < 8; ++k) { y0[k] = bf1(xr0[k]) * (x[k].x + bias * y0[k]); y1[k] = bf1(xr1[k]) * (x[k].y + bias * y1[k]); } }
        }
        bf16* o0 = YT + ((size_t)b0 * 1024 + c) * SEQ;
#pragma unroll
        for (int i = 0; i < 8; ++i) { const int t = tid + 512 * i; o0[t] = (bf16)f2bf(y0[i]); o0[bstr + t] = (bf16)f2bf(y1[i]); }
    }
#undef HF_PTR
}
__device__ __forceinline__ void ph_scan(const Args& A, int l, int tid) {
    float* KV = (float*)(wsb() + WS_KV);
    for (int gt = blockIdx.x * 512 + tid; gt < NB * 8 * 2 * 2048; gt += gridDim.x * 512) {
        const int bhd = gt >> 11, e4 = gt & 2047, dir = bhd & 1, h = (bhd >> 1) & 7;
        const float gC = ex2(inp(I_RDEC)[(l * 2 + dir) * 8 + h] * LOG2E * 128.0f);
        f32x4* base = (f32x4*)(KV + (size_t)bhd * 34 * 8192) + e4;
        f32x4 s = (f32x4){0.f, 0.f, 0.f, 0.f};
#pragma unroll 1
        for (int sb8 = 0; sb8 < 34; sb8 += 8) {
            f32x4 tv[8];
#pragma unroll
            for (int k = 0; k < 8; ++k) { const int step = min(sb8 + k, 33); const int ci = (dir == 0) ? step : (step == 0 ? 1 : (step == 1 ? 0 : 35 - step)); tv[k] = base[(size_t)ci * 2048]; }
#pragma unroll
            for (int k = 0; k < 8; ++k) { const int step = sb8 + k; if (step < 34) { const int ci = (dir == 0) ? step : (step == 0 ? 1 : (step == 1 ? 0 : 35 - step)); base[(size_t)ci * 2048] = s; s = s * gC + tv[k]; } } }
    }
}

__device__ __forceinline__ void ph_hypost(const Args& A, LAS unsigned char* lds, int tid) {
    LAS bf16* T = (LAS bf16*)lds;
    const bf16* YT = (const bf16*)(wsb() + WS_YT); bf16* YS = (bf16*)(wsb() + WS_YS);
    for (int u = blockIdx.x; u < 1024; u += gridDim.x) {
        const int cg = u & 3, tt = (u >> 2) & 63, b = u >> 8;
        __syncthreads();
        for (int q = tid; q < 2048; q += 512) { const int c = q >> 3, t8 = q & 7;
            *(LAS v4u*)(T + c * 72 + t8 * 8) = *(const v4u*)(YT + ((size_t)b * 1024 + cg * 256 + c) * SEQ + tt * 64 + t8 * 8); }
        __syncthreads();
        const int t = tid >> 3, c32 = tid & 7;
#pragma unroll
        for (int q = 0; q < 4; ++q) { const int cb = c32 * 32 + q * 8; v4u w;
            w.x = (unsigned)T[(cb + 0) * 72 + t] | ((unsigned)T[(cb + 1) * 72 + t] << 16); w.y = (unsigned)T[(cb + 2) * 72 + t] | ((unsigned)T[(cb + 3) * 72 + t] << 16);
            w.z = (unsigned)T[(cb + 4) * 72 + t] | ((unsigned)T[(cb + 5) * 72 + t] << 16); w.w = (unsigned)T[(cb + 6) * 72 + t] | ((unsigned)T[(cb + 7) * 72 + t] << 16);
            *(v4u*)(YS + (size_t)(b * SEQ + tt * 64 + t) * 1024 + cg * 256 + cb) = w; }
    }
}
__device__ __forceinline__ void ph_ret3(const Args& A, int l, int nctx_units, LAS unsigned char* lds, int tid) {
    LAS bf16* Qs = (LAS bf16*)lds; LAS bf16* Ks = Qs + 128 * 72; LAS bf16* Vs = Ks + 128 * 72; LAS bf16* Sf = Vs + 128 * 144; LAS bf16* Sb = Sf + 128 * 72;
    const bf16* Z = (const bf16*)(wsb() + WS_Z); const float* KV = (const float*)(wsb() + WS_KV); const f32x2* rope = (const f32x2*)(wsb() + WS_ROPE);
    bf16* YS = (bf16*)(wsb() + WS_YS) + (size_t)MT * 1024;
    const int lane = tid & 63, w = tid >> 6, g = lane >> 4, li = lane & 15;
    const int tok = tid >> 2, pp = tid & 3, a = (pp & 1) + ((pp >> 1) << 2);
    const int nunits = 1024 + nctx_units;
    v4u pk[2], pv[4];
#define R3_LOAD(uid_) do { R1_DEC(uid_, b2, h2, n2, ci2, m02, isc2) (void)n2; (void)isc2; const bf16* qr = Z + (m02 + tok) * INW + C_RQ + h2 * 64; const bf16* kr = Z + (m02 + tok) * INW + C_RK + h2 * 64; \
        (void)qr; pk[0] = *(const v4u*)(kr + 8 * a); pk[1] = *(const v4u*)(kr + 8 * a + 16); \
        (void)ci2; _Pragma("unroll") for (int e = 0; e < 4; ++e) { const int q = tid + 512 * e; pv[e] = *(const v4u*)(Z + (m02 + (q >> 4)) * INW + C_RV + h2 * 128 + (q & 15) * 8); } } while (0)
    int uid = blockIdx.x;
    if (uid < nunits) R3_LOAD(uid);
    for (; uid < nunits; uid += gridDim.x) {
        R1_DEC(uid, b, h, n, ci, m0, isc)
        const float lgf = inp(I_RDEC)[(l * 2 + 0) * 8 + h] * LOG2E, lgb = inp(I_RDEC)[(l * 2 + 1) * 8 + h] * LOG2E;
        __syncthreads();
        { const int t = n * 128 + tok; const int pos = (a < 4) ? (t >> 6) : (t & 63); const f32x2* rt = rope + pos * 16 + 8 * (a & 1);
            float lo[8], hi[8];
            { const bf16* qr = Z + (m0 + tok) * INW + C_RQ + h * 64; unpack8(*(const v4u*)(qr + 8 * a), lo); unpack8(*(const v4u*)(qr + 8 * a + 16), hi); }
            if (!isc) rope8(lo, hi, rt);
            *(LAS v4u*)(Qs + tok * 72 + 8 * a) = pack8(lo); *(LAS v4u*)(Qs + tok * 72 + 8 * a + 16) = pack8(hi);
            unpack8(pk[0], lo); unpack8(pk[1], hi);
            if (!isc) rope8(lo, hi, rt);
#pragma unroll
            for (int e = 0; e < 8; ++e) { lo[e] *= 0.125f; hi[e] *= 0.125f; }
            *(LAS v4u*)(Ks + tok * 72 + 8 * a) = pack8(lo); *(LAS v4u*)(Ks + tok * 72 + 8 * a + 16) = pack8(hi); }
#pragma unroll
        for (int e = 0; e < 4; ++e) { const int q = tid + 512 * e; *(LAS v4u*)(Vs + (q >> 4) * 144 + (q & 15) * 8) = pv[e]; }
#pragma unroll
        for (int dir = 0; dir < 2; ++dir) { LAS bf16* S = dir ? Sb : Sf; const f32x4* src = (const f32x4*)(KV + ((size_t)((b * 8 + h) * 2 + dir) * 34 + ci) * 8192);
#pragma unroll
            for (int e = 0; e < 4; ++e) { const int q = tid + 512 * e; const f32x4 v = src[q]; v2u wv; wv.x = pk2(v.x, v.y); wv.y = pk2(v.z, v.w); *(LAS v2u*)(S + (q >> 4) * 72 + (q & 15) * 4) = wv; } }
        __syncthreads();
        if (uid + (int)gridDim.x < nunits) R3_LOAD(uid + (int)gridDim.x);
        const int iq = 16 * w + li; const size_t mrow = m0 + iq;
        bf16x8 qf[2];
#pragma unroll
        for (int ks = 0; ks < 2; ++ks) qf[ks] = *(const LAS bf16x8*)(Qs + iq * 72 + 32 * ks + 8 * g);
        f32x4 s[8];
#pragma unroll
        for (int nn = 0; nn < 8; ++nn) { s[nn] = (f32x4){0.f, 0.f, 0.f, 0.f};
#pragma unroll
            for (int ks = 0; ks < 2; ++ks) s[nn] = mfma16(*(const LAS bf16x8*)(Ks + (16 * nn + li) * 72 + 32 * ks + 8 * g), qf[ks], s[nn]);
#pragma unroll
            for (int j = 0; j < 4; ++j) { const int d = iq - (16 * nn + 4 * g + j); s[nn][j] *= (d >= 0) ? ex2(lgf * (float)d) : ex2(lgb * (float)(-d)); } }
        f32x4 o[8];
#pragma unroll
        for (int nd = 0; nd < 8; ++nd) o[nd] = (f32x4){0.f, 0.f, 0.f, 0.f};
#pragma unroll
        for (int kk = 0; kk < 4; ++kk) {
            const bf16x8 pf = mk8(pk2(s[2 * kk][0], s[2 * kk][1]), pk2(s[2 * kk][2], s[2 * kk][3]), pk2(s[2 * kk + 1][0], s[2 * kk + 1][1]), pk2(s[2 * kk + 1][2], s[2 * kk + 1][3]));
#pragma unroll
            for (int nd = 0; nd < 8; ++nd) o[nd] = mfma16(tr_frag(Vs, 144, 32 * kk + 4 * g, 32 * kk + 16 + 4 * g, 16 * nd, li), pf, o[nd]); }
        v2u gq[8];
#pragma unroll
        for (int nd = 0; nd < 8; ++nd) gq[nd] = *(const v2u*)(Z + mrow * INW + C_RG + h * 128 + 16 * nd + 4 * g);
        const float xif = ex2(lgf * (float)(iq + 1)), xib = ex2(lgb * (float)(128 - iq));
        float ss = 0.f;
#pragma unroll
        for (int nd = 0; nd < 8; ++nd) { f32x4 tf = (f32x4){0.f, 0.f, 0.f, 0.f}, tb = (f32x4){0.f, 0.f, 0.f, 0.f};
#pragma unroll
            for (int ks = 0; ks < 2; ++ks) { tf = mfma16(*(const LAS bf16x8*)(Sf + (16 * nd + li) * 72 + 32 * ks + 8 * g), qf[ks], tf);
                tb = mfma16(*(const LAS bf16x8*)(Sb + (16 * nd + li) * 72 + 32 * ks + 8 * g), qf[ks], tb); }
            o[nd] = o[nd] + tf * xif + tb * xib;
            ss += (o[nd][0] * o[nd][0] + o[nd][1] * o[nd][1]) + (o[nd][2] * o[nd][2] + o[nd][3] * o[nd][3]); }
        ss += __shfl_xor(ss, 16); ss += __shfl_xor(ss, 32);
        const float rn = 1.0f / sqrtf(ss * (1.0f / 128.0f) + EPS);
#pragma unroll
        for (int nd = 0; nd < 8; ++nd) { const int dv = 16 * nd + 4 * g; const v2u gv = gq[nd];
            const float g0 = bflo(gv.x), g1 = bfhi(gv.x), g2 = bflo(gv.y), g3 = bfhi(gv.y);
            v2u wv; wv.x = pk2(g0 * __builtin_amdgcn_rcpf(1.0f + __expf(-g0)) * o[nd][0] * rn, g1 * __builtin_amdgcn_rcpf(1.0f + __expf(-g1)) * o[nd][1] * rn);
            wv.y = pk2(g2 * __builtin_amdgcn_rcpf(1.0f + __expf(-g2)) * o[nd][2] * rn, g3 * __builtin_amdgcn_rcpf(1.0f + __expf(-g3)) * o[nd][3] * rn);
            *(v2u*)(YS + mrow * 1024 + h * 128 + dv) = wv; }
    }
#undef R3_LOAD
#undef R1_DEC
}

__device__ __forceinline__ float gelu_fx(float x) { const float x2 = x * x; const float arg = x * (x2 * (-2.0f * 1.4426950408889634f * 0.7978845608028654f * 0.044715f) + (-2.0f * 1.4426950408889634f * 0.7978845608028654f));
    return x * __builtin_amdgcn_rcpf(1.0f + __builtin_amdgcn_exp2f(arg)); }
__device__ __forceinline__ void ph_ffnfix(const Args& A, int l, int Mrows, int tid) {
    const bf16* SA = (const bf16*)(wsb() + WS_SA); const bf16* SB = (const bf16*)(wsb() + WS_SB); bf16* U = (bf16*)(wsb() + WS_U);
    const float* cw = inp(I_FFCW) + (size_t)l * 3 * DFF; const float* cb = inp(I_FFCB) + (size_t)l * DFF;
    const int nblk = Mrows / 64;
    for (int u = blockIdx.x; u < nblk * 2; u += gridDim.x) {
        const int blk = u >> 1, hi = u & 1, R = blk * 64 + (hi ? 63 : 0);
        const bool seq_first = (R < ML) ? ((R & (SEQ - 1)) == 0) : ((R & (CL - 1)) == 0), seq_last = (R < ML) ? ((R & (SEQ - 1)) == SEQ - 1) : ((R & (CL - 1)) == CL - 1);
        const bf16* pprev = hi ? SA + ((size_t)blk * 4 + 2) * DFF : SA + ((size_t)(blk - 1) * 4 + 3) * DFF;
        const bf16* pcur = SA + ((size_t)blk * 4 + (hi ? 3 : 0)) * DFF;
        const bf16* pnext = hi ? SA + ((size_t)(blk + 1) * 4 + 0) * DFF : SA + ((size_t)blk * 4 + 1) * DFF;
        const bf16* pb = SB + ((size_t)blk * 2 + hi) * DFF;
        const bool zp = (!hi && seq_first), zn = (hi && seq_last);
        for (int q = tid; q < DFF / 8; q += 512) { const int f = q * 8;
            float am[8], a0[8], aq[8], bg[8]; const v4u z4 = (v4u){0u, 0u, 0u, 0u};
            unpack8(zp ? z4 : *(const v4u*)(pprev + f), am); unpack8(*(const v4u*)(pcur + f), a0); unpack8(zn ? z4 : *(const v4u*)(pnext + f), aq); unpack8(*(const v4u*)(pb + f), bg);
            float r[8];
#pragma unroll
            for (int e = 0; e < 8; ++e) r[e] = gelu_fx(cw[f + e] * am[e] + cw[DFF + f + e] * a0[e] + cw[2 * DFF + f + e] * aq[e] + cb[f + e]) * bg[e];
            *(v4u*)(U + (size_t)R * DFF + f) = pack8(r); }
    }
}
__device__ __forceinline__ void ph_final(const Args& A, int wave, int lane) {
    const int gw = blockIdx.x * NWAVES + wave, NGW = gridDim.x * NWAVES; const float* g = inp(I_GF);
    for (int m = gw; m < ML; m += NGW) { float* xr = outb() + (size_t)m * D; f32x4 v[8]; float ss = 0.f;
#pragma unroll
        for (int j = 0; j < 8; ++j) { v[j] = *(const f32x4*)(xr + (lane + 64 * j) * 4); ss += (v[j].x * v[j].x + v[j].y * v[j].y) + (v[j].z * v[j].z + v[j].w * v[j].w); }
        const float rstd = 1.0f / sqrtf(wave_sum(ss) * (1.0f / D) + EPS);
#pragma unroll
        for (int j = 0; j < 8; ++j) { const int idx = (lane + 64 * j) * 4; *(f32x4*)(xr + idx) = v[j] * rstd * *(const f32x4*)(g + idx); }
    }
}
#ifndef SKEW_US
#define SKEW_US 0
#endif
__device__ __forceinline__ void spin_us(int us) { if (us > 0) { const unsigned long long t0 = __builtin_amdgcn_s_memrealtime(); while (__builtin_amdgcn_s_memrealtime() - t0 < (unsigned long long)us * 100ull) __builtin_amdgcn_s_sleep(8); } }
constexpr int FILT_F = 816, FILT_I = 896;
constexpr int BG_SPLIT = 22016;
constexpr int SEQ_PER_LAYER = 11, NSEQ = 1 + DEPTH * SEQ_PER_LAYER + 1;
__global__ void __launch_bounds__(NWAVES * 64, 2) fwd(Args A) {
    extern __shared__ __attribute__((aligned(16))) unsigned char lds_raw[];
    LAS unsigned char* lds = (LAS unsigned char*)lds_raw;
    volatile LAS unsigned* MISC = (volatile LAS unsigned*)(lds + MISC_OFF);
    for (int u = threadIdx.x; u < (LDS_BYTES - LDSCTL_OFF) / 4; u += NWAVES * 64) ((LAS unsigned*)(lds + LDSCTL_OFF))[u] = 0u;
    __syncthreads();
    (void)xcd_barrier_post((unsigned*)(wsb() + WS_CTL) + CW_BAR, MISC + 8);
    const int lo = A.seq_lo, hi = A.seq_hi;
#ifdef PROBE_K
    volatile LAS unsigned long long* pr_ = (volatile LAS unsigned long long*)(lds + MISC_OFF + 128);
    if (threadIdx.x == 0) { pr_[0] = 0ull; pr_[1] = __builtin_amdgcn_s_memrealtime(); }
#define pr_acc pr_[0]
#define pr_prev pr_[1]
#endif
#define G ((int)gridDim.x)
#ifdef PROBE_SUB
#define PROBE_K 999
#define SUBT(n, stmt) do { unsigned long long t0_ = 0; if ((n) == PROBE_SUB && blockIdx.x == PROBE_WG && threadIdx.x == 0) t0_ = __builtin_amdgcn_s_memrealtime(); stmt; if ((n) == PROBE_SUB && blockIdx.x == PROBE_WG && threadIdx.x == 0) pr_acc += __builtin_amdgcn_s_memrealtime() - t0_; } while (0)
#else
#define SUBT(n, stmt) do { stmt; } while (0)
#endif
#ifdef PROBE_K
#ifndef PROBE_WG
#define PROBE_WG 0
#endif
#ifndef PROBE_WAIT
#define PROBE_WAIT 0
#endif
#define PROBE_PH(s) (((s) == 0) ? 100 : (((s) - 1) % SEQ_PER_LAYER))
#define PROBE_ARRIVE(s) do { if (blockIdx.x == PROBE_WG && threadIdx.x == 0) { const unsigned long long now_ = __builtin_amdgcn_s_memrealtime(); if (!PROBE_WAIT && PROBE_PH(s) == PROBE_K) pr_acc += now_ - pr_prev; pr_prev = now_; } } while (0)
#define PROBE_EXIT(s) do { if (blockIdx.x == PROBE_WG && threadIdx.x == 0) { const unsigned long long now_ = __builtin_amdgcn_s_memrealtime(); if (PROBE_WAIT && PROBE_PH(s) == PROBE_K) pr_acc += now_ - pr_prev; pr_prev = now_; } } while (0)
#else
#define PROBE_ARRIVE(s) do { } while (0)
#define PROBE_EXIT(s) do { } while (0)
#endif
#define RUN(s) (lo <= (s) && (s) < hi)
#ifndef DUP
#define DUP 0
#endif
#define DUPN(id) ((((DUP) >> (id)) & 1) ? 2 : 1)
#define TID_HERE const int tid = otid(), lane = tid & 63, wave = __builtin_amdgcn_readfirstlane(tid >> 6); (void)lane; (void)wave
#ifdef ONLY
#define PH_ON(k) ((k) == ONLY)
#elif defined(SKIP)
#define PH_ON(k) ((k) != SKIP)
#else
#define PH_ON(k) true
#endif
#define SEAM(s) do { PROBE_ARRIVE(s); if (RUN((s) + 1)) { XcdBarrier bar_; bar_.bar = (unsigned*)(wsb() + WS_CTL) + CW_BAR; bar_.x = xb_xcc_id(); bar_.st = (volatile LAS unsigned*)(lds + MISC_OFF) + 8; xcd_barrier(bar_); if (DUPN(16) > 1) xcd_barrier(bar_); } PROBE_EXIT(s); } while (0)
#define H ((bf16*)(wsb() + WS_H))
#define Z ((bf16*)(wsb() + WS_Z))
#define ACC ((bf16*)(wsb() + WS_ACC))
#define U ((bf16*)(wsb() + WS_U))
#define YS ((bf16*)(wsb() + WS_YS))
#define XC ((float*)(wsb() + WS_XC))
#define WIN ((const bf16*)(psb(l & 1) + PS_WIN))
#define WBR ((const bf16*)(psb(l & 1) + PS_WBR))
#define WOUT ((const bf16*)(psb(l & 1) + PS_WOUT))
#define WF1 ((const bf16*)(psb(l & 1) + PS_WF1))
#define WF2 ((const bf16*)(psb(l & 1) + PS_WF2))

    if (PH_ON(100) && RUN(0)) { TID_HERE; ph_prologue(A, lds, tid); __syncthreads(); ph_convert(A, 0, 0, 0, CONV_ITEMS, (int)blockIdx.x, G, lds, wave, lane); __syncthreads(); for (int fl = 0; fl < DEPTH; ++fl) ph_filt1(A, fl, 0, (int)blockIdx.x, G, lds, tid); SEAM(0); }

    for (int l = 0; l < DEPTH; ++l) {
        const int sb = 1 + l * SEQ_PER_LAYER;
        if (hi <= sb || lo >= sb + SEQ_PER_LAYER) continue;
        const bool lastl = (l == DEPTH - 1);
        const int Mrows = lastl ? ML : MT, nctx = lastl ? 0 : 64;
#define modl ((const float*)(wsb() + WS_MOD) + (size_t)l * 5 * 12288)
#define xlat_in ((l == 0) ? inp(I_X) : (const float*)outb())
#define xctx_in ((l == 0) ? inp(I_CTX) : (const float*)XC)

        if (PH_ON(0) && RUN(sb + 0)) { TID_HERE;
            if (l == 0) ph_filt2(A, 0, 0, 0, 1024, (int)blockIdx.x, G, lds, tid);
            else ph_convert(A, l, l & 1, 0, CONV_ITEMS, (int)blockIdx.x, G, lds, wave, lane);
            ph_norm(xlat_in, xctx_in, inp(I_G1) + (size_t)l * D, modl, 0, D, H, MT, (l > 0) ? (const float*)(wsb() + WS_SLAB) : (const float*)nullptr,
                    (const float*)(wsb() + WS_MOD) + ((size_t)(l - 1) * 5 + 4) * 12288 + 5 * D, XC, wave, lane);
            SEAM(sb + 0);
        }
        if (PH_ON(1) && RUN(sb + 1)) { TID_HERE;
            if (SKEW_US > 0 && (blockIdx.x & 8)) spin_us(SKEW_US);
            { pg8::Gemm g{H, WIN, opq(MT), opq(INW), opq(D), 0}; pg8::StaticOrder S; S.init(g.M, g.N, G, (int)blockIdx.x);
              pg8::EpiStore E{Z, INW};
              for (int r_ = 0; r_ < DUPN(15); ++r_) pg8::gemm_phase<pg8::EpiStore, pg8::StaticOrder, PG8_ALIGN, PG8_SP2>(lds, g, S, E); }
            SEAM(sb + 1);
        }
        if (PH_ON(2) && RUN(sb + 2)) { TID_HERE;
            SUBT(1, ph_hyprep(A, l, lds, tid));
            SUBT(2, ph_ret1(A, l, 64, lds, tid));
            SUBT(3, ph_natt(A, l, 0, lds, tid));
            SUBT(4, if (!lastl) ph_hyctx(A, l, lds, tid));
            SEAM(sb + 2);
        }
        if (PH_ON(3) && RUN(sb + 3)) { TID_HERE;
#ifndef NO_D1
            SUBT(5, ph_hyfft(A, l, lds, tid));
#endif
#ifndef NO_D2
            SUBT(6, ph_scan(A, l, tid));
#endif
            SEAM(sb + 3);
        }
        if (PH_ON(4) && RUN(sb + 4)) { TID_HERE;
            SUBT(7, ph_hypost(A, lds, tid));
            SUBT(8, ph_ret3(A, l, nctx, lds, tid));
            if (!lastl) { __syncthreads(); ph_natt(A, l, 1, lds, tid); }
            SEAM(sb + 4);
        }
        if (PH_ON(5) && RUN(sb + 5)) { TID_HERE;
            __syncthreads();
            for (int r_ = 0; r_ < DUPN(13); ++r_)
            for (int i = 0; i < 3; ++i) {
                pg8::Gemm g{YS + (size_t)i * MT * 1024, WBR + (size_t)i * D * 1024, Mrows, opq(D), opq(1024), 0}; pg8::StaticOrder S; S.init(g.M, g.N, G, (int)blockIdx.x);
                pg8::EpiMerge E{ACC, Z + C_GT + i * D, INW, i == 0 ? 1 : 0};
                pg8::gemm_phase<pg8::EpiMerge, pg8::StaticOrder, PG8_ALIGN, PG8_SP2>(lds, g, S, E);
            }
            if (!lastl && blockIdx.x >= 32) { __syncthreads(); ph_filt2(A, l + 1, (l + 1) & 1, 0, FILT_F, (int)blockIdx.x - 32, G - 32, lds, tid); }
            SEAM(sb + 5);
        }
        if (PH_ON(6) && RUN(sb + 6)) { TID_HERE;
            __syncthreads();
            { pg8::Gemm g{ACC, WOUT, opq(ML), opq(D), opq(D), 0}; pg8::StaticOrder S; S.init(g.M, g.N, G, (int)blockIdx.x);
              pg8::EpiResid E{xlat_in, xctx_in, outb(), XC, modl, 2 * D};
              pg8::gemm_phase<pg8::EpiResid, pg8::StaticOrder, PG8_ALIGN, PG8_SP2>(lds, g, S, E); }
            if (!lastl) { pg8::Gemm g{ACC, WOUT, opq(MT), opq(D), opq(D / NSPLIT), opq(D)}; pg8::CtxSplitOrder S{NSPLIT, D / NSPLIT, (int)blockIdx.x};
              pg8::EpiSlab E{(float*)(wsb() + WS_SLAB), D / NSPLIT};
              pg8::gemm_phase<pg8::EpiSlab, pg8::CtxSplitOrder, PG8_ALIGN, PG8_SP2>(lds, g, S, E); }
            SEAM(sb + 6);
        }
        if (PH_ON(7) && RUN(sb + 7)) { TID_HERE;
            ph_norm(outb(), xctx_in, inp(I_G2) + (size_t)l * D, modl, 3 * D, 4 * D, H, Mrows, (const float*)(wsb() + WS_SLAB), modl + (size_t)4 * 12288 + 2 * D, XC, wave, lane);
            SEAM(sb + 7);
        }
        if (PH_ON(8) && RUN(sb + 8)) { TID_HERE;
            __syncthreads();
            if (SKEW_US > 0 && (blockIdx.x & 8)) spin_us(SKEW_US);
            pg8::Gemm g{H, WF1, Mrows, opq(NFF), opq(D), 0}; pg8::StaticOrder S; S.init(g.M, g.N, G, (int)blockIdx.x);
            pg8::EpiFfn E{U, (bf16*)(wsb() + WS_SA), (bf16*)(wsb() + WS_SB), inp(I_FFCW) + (size_t)l * 3 * DFF, inp(I_FFCB) + (size_t)l * DFF};
            for (int r_ = 0; r_ < DUPN(14); ++r_) pg8::gemm_phase<pg8::EpiFfn, pg8::StaticOrder, PG8_ALIGN, PG8_SP2>(lds, g, S, E);
            if (!lastl && blockIdx.x >= 176) { __syncthreads(); ph_filt2(A, l + 1, (l + 1) & 1, FILT_F, FILT_I, (int)blockIdx.x - 176, G - 176, lds, tid); }
            SEAM(sb + 8);
        }
        if (PH_ON(9) && RUN(sb + 9)) { TID_HERE;
            for (int r_ = 0; r_ < DUPN(11); ++r_) ph_ffnfix(A, l, Mrows, tid);
            SEAM(sb + 9);
        }
        if (PH_ON(10) && RUN(sb + 10)) { TID_HERE;
            __syncthreads();
            { pg8::Gemm g{U, WF2, opq(ML), opq(D), opq(DFF), 0}; pg8::StaticOrder S; S.init(g.M, g.N, G, (int)blockIdx.x);
              pg8::EpiResid E{outb(), XC, outb(), XC, modl, 5 * D};
              pg8::gemm_phase<pg8::EpiResid, pg8::StaticOrder, PG8_ALIGN, PG8_SP2>(lds, g, S, E); }
            if (!lastl) { pg8::Gemm g{U, WF2, opq(MT), opq(D), opq(DFF / NSPLIT), opq(DFF)}; pg8::CtxSplitOrder S{NSPLIT, DFF / NSPLIT, (int)blockIdx.x};
              pg8::EpiSlab E{(float*)(wsb() + WS_SLAB), DFF / NSPLIT};
              pg8::gemm_phase<pg8::EpiSlab, pg8::CtxSplitOrder, PG8_ALIGN, PG8_SP2>(lds, g, S, E); }
            if (!lastl && blockIdx.x >= 128) { __syncthreads(); ph_filt2(A, l + 1, (l + 1) & 1, FILT_I, 1024, (int)blockIdx.x - 128, G - 128, lds, tid); }
            SEAM(sb + 10);
        }
    }
    if (PH_ON(101) && RUN(NSEQ - 1)) { TID_HERE; ph_final(A, wave, lane); }
#ifdef PROBE_K
    if (blockIdx.x == PROBE_WG && threadIdx.x == 0) { const unsigned long long t0 = __builtin_amdgcn_s_memrealtime(); while (__builtin_amdgcn_s_memrealtime() - t0 < 4ull * pr_acc) __builtin_amdgcn_s_sleep(8); }
#endif
#undef RUN
#undef SEAM
#undef H
#undef Z
#undef ACC
#undef U
#undef YS
#undef XC
#undef WIN
#undef WBR
#undef WOUT
#undef WF1
#undef WF2
#undef G
#undef modl
#undef xlat_in
#undef xctx_in
}

extern "C" void kernel_launch(void* const* d_in, const int* in_sizes, int n_in, void* d_out, int out_size, void* d_ws, size_t ws_size, hipStream_t stream) {
    static int grid = 0;
    if (grid == 0) {
        if (n_in != 27 || out_size != ML * D || ws_size < WS_END) { fprintf(stderr, "kernel_launch: unexpected shapes (n_in %d out %d ws %zu need %zu)\n", n_in, out_size, ws_size, (size_t)WS_END); grid = -1; return; }
        int dev = 0, cus = 0, per_cu = 0;
        if (hipGetDevice(&dev) != hipSuccess || hipDeviceGetAttribute(&cus, hipDeviceAttributeMultiprocessorCount, dev) != hipSuccess) { grid = -1; return; }
        if (hipFuncSetAttribute((const void*)fwd, hipFuncAttributeMaxDynamicSharedMemorySize, LDS_BYTES) != hipSuccess) { fprintf(stderr, "kernel_launch: hipFuncSetAttribute failed\n"); grid = -1; return; }
        if (hipOccupancyMaxActiveBlocksPerMultiprocessor(&per_cu, (const void*)fwd, NWAVES * 64, LDS_BYTES) != hipSuccess || per_cu < 1) fprintf(stderr, "kernel_launch: occupancy query says %d\n", per_cu);
        (void)hipGetLastError();
        grid = cus;
    }
    if (grid < 0) return;
    (void)hipMemsetAsync((char*)d_ws + WS_CTL, 0, CTL_ZERO_BYTES, stream);
    Args a{};
    for (int i = 0; i < 27; ++i) a.in[i] = (const float*)d_in[i];
    a.out = (float*)d_out; a.ws = (unsigned char*)d_ws;
#if MK_SINGLE
    a.seq_lo = 0; a.seq_hi = NSEQ;
    hipLaunchKernelGGL(fwd, dim3(grid), dim3(NWAVES * 64), LDS_BYTES, stream, a);
#else
    for (int s = 0; s < NSEQ; ++s) { a.seq_lo = s; a.seq_hi = s + 1; hipLaunchKernelGGL(fwd, dim3(grid), dim3(NWAVES * 64), LDS_BYTES, stream, a); }
#endif
}
```

```cpp
#include <hip/hip_runtime.h>
#include <cstdio>
#include <cstdint>
#ifndef MK_SINGLE
#define MK_SINGLE 1
#endif
namespace pg8 {
#define PG8_LAS __attribute__((address_space(3)))
typedef unsigned short bf16_t;
typedef short bf16x8 __attribute__((ext_vector_type(8)));
typedef float f32x4 __attribute__((ext_vector_type(4)));
typedef unsigned u32x4 __attribute__((ext_vector_type(4)));
constexpr int BM = 256, BK = 64, HALF = 128, HTB = HALF * BK * 2  , STAGE_BYTES = 8 * HTB, NXCD = 8, WGM = 8;

__host__ __device__ __forceinline__ int lds_byte(int r, int c) { const int st = (r >> 4) * 2 + (c >> 5), rr = r & 15, cc = c & 31, ob = rr * 64 + cc * 2; return st * 1024 + (ob ^ (((ob >> 9) & 1) << 5)); }
__host__ __device__ __forceinline__ void stage_rc(int b, int& R, int& C) { const int st = b / 1024, sb = b % 1024, swz = sb ^ (((sb >> 9) & 1) << 5); R = (st >> 1) * 16 + swz / 64; C = (st & 1) * 32 + (swz % 64) / 2; }
__host__ __device__ __forceinline__ int perm32(int rho) { const int n = rho >> 4, i = rho & 15; return 8 * (i >> 2) + 4 * n + (i & 3); }

struct Unit { int pm, pn, ko; };
struct Gemm { const bf16_t* A; const bf16_t* Bt; int M, N, K, ld; };

struct StaticOrder {
    int nM, nN, nwg, G, c;
    __host__ __device__ void init(int M, int N, int G_, int c_) { nM = M / BM; nN = N / BM; nwg = nM * nN; G = G_; c = c_; }
    __host__ __device__ bool next(int i, Unit& u) const {
        const long L = (long)i * G + c; if (L >= nwg) return false;
        int wgid = (int)L; { const int q = nwg / NXCD, r = nwg % NXCD, xcd = wgid % NXCD, off = wgid / NXCD; wgid = (xcd < r ? xcd * (q + 1) : r * (q + 1) + (xcd - r) * q) + off; }
        const int nig = WGM * nN, gid = wgid / nig, fm = gid * WGM, gsz = (nM - fm) < WGM ? (nM - fm) : WGM;
        u.pm = fm + ((wgid % nig) % gsz); u.pn = (wgid % nig) / gsz; u.ko = 0; return true;
    }
    __device__ __forceinline__ void a_ready(const Unit&) const {}
    __device__ __forceinline__ void done(const Unit&) const {}
};
__device__ __forceinline__ unsigned cvt_pk_bf16(float lo, float hi) { unsigned r; asm volatile("v_cvt_pk_bf16_f32 %0, %1, %2" : "=v"(r) : "v"(lo), "v"(hi)); return r; }
typedef float f32x2 __attribute__((ext_vector_type(2)));
__device__ __forceinline__ float bflo(unsigned w) { return __uint_as_float(w << 16); }
__device__ __forceinline__ float bfhi(unsigned w) { return __uint_as_float(w & 0xffff0000u); }
__device__ __forceinline__ float sigm(float x) { return __builtin_amdgcn_rcpf(1.0f + __expf(-x)); }
struct EpiStore {
    static constexpr bool PERM = true, AFTER_DRAIN = false;
    bf16_t* O; int ldc;
    __device__ __forceinline__ void operator()(const f32x4 (&acc)[2][2][4][2], const Unit& u, int wr, int wc, int fr, int fq) const {
        const int row0 = u.pm * BM + wr * 64 + fr, col0 = u.pn * BM + wc * 32 + 8 * fq;
#pragma unroll
        for (int ai = 0; ai < 2; ++ai)
#pragma unroll
            for (int m = 0; m < 4; ++m) { bf16_t* rowp = O + (size_t)(row0 + ai * HALF + m * 16) * ldc + col0;
#pragma unroll
                for (int bj = 0; bj < 2; ++bj) { const f32x4 v0 = acc[ai][bj][m][0], v1 = acc[ai][bj][m][1];
                    u32x4 w; w.x = cvt_pk_bf16(v0[0], v0[1]); w.y = cvt_pk_bf16(v0[2], v0[3]); w.z = cvt_pk_bf16(v1[0], v1[1]); w.w = cvt_pk_bf16(v1[2], v1[3]);
                    __builtin_nontemporal_store(w, (u32x4*)(rowp + bj * HALF)); } }
    }
};
struct EpiMerge {
    static constexpr bool PERM = true, AFTER_DRAIN = false;
    bf16_t* O; const bf16_t* gate; int ldg; int first;
    __device__ __forceinline__ void operator()(const f32x4 (&acc)[2][2][4][2], const Unit& u, int wr, int wc, int fr, int fq) const {
        const int row0 = u.pm * BM + wr * 64 + fr, col0 = u.pn * BM + wc * 32 + 8 * fq;
#pragma unroll
        for (int ai = 0; ai < 2; ++ai)
#pragma unroll
            for (int m = 0; m < 4; ++m) { const size_t row = (size_t)(row0 + ai * HALF + m * 16);
#pragma unroll
                for (int bj = 0; bj < 2; ++bj) { const int col = col0 + bj * HALF;
                    const u32x4 gv = *(const u32x4*)(gate + row * ldg + col);
                    u32x4 pv = (u32x4){0u, 0u, 0u, 0u}; if (!first) pv = *(const u32x4*)(O + row * 2048 + col);
                    const f32x4 v0 = acc[ai][bj][m][0], v1 = acc[ai][bj][m][1];
                    u32x4 w;
                    w.x = cvt_pk_bf16(bflo(pv.x) + v0[0] * sigm(bflo(gv.x)), bfhi(pv.x) + v0[1] * sigm(bfhi(gv.x)));
                    w.y = cvt_pk_bf16(bflo(pv.y) + v0[2] * sigm(bflo(gv.y)), bfhi(pv.y) + v0[3] * sigm(bfhi(gv.y)));
                    w.z = cvt_pk_bf16(bflo(pv.z) + v1[0] * sigm(bflo(gv.z)), bfhi(pv.z) + v1[1] * sigm(bfhi(gv.z)));
                    w.w = cvt_pk_bf16(bflo(pv.w) + v1[2] * sigm(bflo(gv.w)), bfhi(pv.w) + v1[3] * sigm(bfhi(gv.w)));
                    *(u32x4*)(O + row * 2048 + col) = w; } }
    }
};
struct EpiResid {
    static constexpr bool PERM = false, AFTER_DRAIN = false;
    const float* base_lat; const float* base_ctx; float* out_lat; float* out_ctx; const float* modl; int goff;
    __device__ __forceinline__ void operator()(const f32x4 (&acc)[2][2][4][2], const Unit& u, int wr, int wc, int fr, int fq) const {
        const bool isctx = u.pm >= 64; const int r = isctx ? 4 : (u.pm >> 4);
        const float* gvp = modl + (size_t)r * 12288 + goff;
        const float* bs = isctx ? base_ctx : base_lat; float* os = isctx ? out_ctx : out_lat;
        const int row0 = (isctx ? u.pm - 64 : u.pm) * BM + wr * 64 + fr, col0 = u.pn * BM + wc * 32 + 4 * fq;
        f32x4 g4[2][2];
#pragma unroll
        for (int bj = 0; bj < 2; ++bj)
#pragma unroll
            for (int n = 0; n < 2; ++n) g4[bj][n] = *(const f32x4*)(gvp + col0 + bj * HALF + n * 16);
#pragma unroll
        for (int ai = 0; ai < 2; ++ai)
#pragma unroll
            for (int m = 0; m < 4; ++m) { const size_t off = (size_t)(row0 + ai * HALF + m * 16) * 2048 + col0;
#pragma unroll
                for (int bj = 0; bj < 2; ++bj)
#pragma unroll
                    for (int n = 0; n < 2; ++n) { const f32x4 b4 = *(const f32x4*)(bs + off + bj * HALF + n * 16);
                        *(f32x4*)(os + off + bj * HALF + n * 16) = b4 + g4[bj][n] * acc[ai][bj][m][n]; } }
    }
};

__device__ __forceinline__ float dpp_ror1(float v) { return __int_as_float(__builtin_amdgcn_update_dpp(0, __float_as_int(v), 0x121, 0xf, 0xf, false)); }
__device__ __forceinline__ float dpp_rol1(float v) { return __int_as_float(__builtin_amdgcn_update_dpp(0, __float_as_int(v), 0x12f, 0xf, 0xf, false)); }
__device__ __forceinline__ float gelu_fast(float x) { const float x2 = x * x; const float arg = x * (x2 * (-2.0f * 1.4426950408889634f * 0.7978845608028654f * 0.044715f) + (-2.0f * 1.4426950408889634f * 0.7978845608028654f));
    return x * __builtin_amdgcn_rcpf(1.0f + __builtin_amdgcn_exp2f(arg)); }
struct EpiFfn {
    static constexpr bool PERM = true, AFTER_DRAIN = false;
    bf16_t* U; bf16_t* SA; bf16_t* SB; const float* cw; const float* cb;
    __device__ __forceinline__ void operator()(const f32x4 (&acc)[2][2][4][2], const Unit& u, int wr, int wc, int fr, int fq) const {
        const int f0 = u.pn * 128 + wc * 32 + 8 * fq;
        f32x4 w0[2], w1[2], w2[2], bb[2];
#pragma unroll
        for (int n = 0; n < 2; ++n) { w0[n] = *(const f32x4*)(cw + f0 + 4 * n); w1[n] = *(const f32x4*)(cw + 5632 + f0 + 4 * n); w2[n] = *(const f32x4*)(cw + 2 * 5632 + f0 + 4 * n); bb[n] = *(const f32x4*)(cb + f0 + 4 * n); }
#pragma unroll
        for (int ai = 0; ai < 2; ++ai) {
            const int row0 = u.pm * BM + ai * HALF + wr * 64 + fr, blk = u.pm * 4 + ai * 2 + wr;
            f32x4 o[4][2];
#pragma unroll
            for (int n = 0; n < 2; ++n)
#pragma unroll
                for (int e = 0; e < 4; ++e) {
                    const float a0 = acc[ai][0][0][n][e], a1 = acc[ai][0][1][n][e], a2 = acc[ai][0][2][n][e], a3 = acc[ai][0][3][n][e];
                    const float r0 = dpp_ror1(a0), r1 = dpp_ror1(a1), r2 = dpp_ror1(a2), r3 = dpp_ror1(a3);
                    const float l0 = dpp_rol1(a0), l1 = dpp_rol1(a1), l2 = dpp_rol1(a2), l3 = dpp_rol1(a3);
                    const bool first = (fr == 0), last = (fr == 15);
                    const float p0 = r0, p1 = first ? r0 : r1, p2 = first ? r1 : r2, p3 = first ? r2 : r3;
                    const float n0 = last ? l1 : l0, n1 = last ? l2 : l1, n2 = last ? l3 : l2, n3 = l3;
                    const float k0 = w0[n][e], k1 = w1[n][e], k2 = w2[n][e], kb = bb[n][e];
                    o[0][n][e] = gelu_fast(k0 * p0 + k1 * a0 + k2 * n0 + kb) * acc[ai][1][0][n][e];
                    o[1][n][e] = gelu_fast(k0 * p1 + k1 * a1 + k2 * n1 + kb) * acc[ai][1][1][n][e];
                    o[2][n][e] = gelu_fast(k0 * p2 + k1 * a2 + k2 * n2 + kb) * acc[ai][1][2][n][e];
                    o[3][n][e] = gelu_fast(k0 * p3 + k1 * a3 + k2 * n3 + kb) * acc[ai][1][3][n][e];
                }
#pragma unroll
            for (int m = 0; m < 4; ++m) { u32x4 w; w.x = cvt_pk_bf16(o[m][0][0], o[m][0][1]); w.y = cvt_pk_bf16(o[m][0][2], o[m][0][3]); w.z = cvt_pk_bf16(o[m][1][0], o[m][1][1]); w.w = cvt_pk_bf16(o[m][1][2], o[m][1][3]);
                *(u32x4*)(U + (size_t)(row0 + m * 16) * 5632 + f0) = w; }
            const int sel = (fr == 0) ? 0 : (fr == 1) ? 1 : (fr == 14) ? 2 : (fr == 15) ? 3 : -1;
            if (sel >= 0) { const int m = (sel < 2) ? 0 : 3;
                const f32x4 a0 = (m == 0) ? acc[ai][0][0][0] : acc[ai][0][3][0], a1 = (m == 0) ? acc[ai][0][0][1] : acc[ai][0][3][1];
                u32x4 w; w.x = cvt_pk_bf16(a0[0], a0[1]); w.y = cvt_pk_bf16(a0[2], a0[3]); w.z = cvt_pk_bf16(a1[0], a1[1]); w.w = cvt_pk_bf16(a1[2], a1[3]);
                *(u32x4*)(SA + ((size_t)blk * 4 + sel) * 5632 + f0) = w;
                if (sel == 0 || sel == 3) { const f32x4 b0 = (m == 0) ? acc[ai][1][0][0] : acc[ai][1][3][0], b1 = (m == 0) ? acc[ai][1][0][1] : acc[ai][1][3][1];
                    u32x4 v; v.x = cvt_pk_bf16(b0[0], b0[1]); v.y = cvt_pk_bf16(b0[2], b0[3]); v.z = cvt_pk_bf16(b1[0], b1[1]); v.w = cvt_pk_bf16(b1[2], b1[3]);
                    *(u32x4*)(SB + ((size_t)blk * 2 + (sel == 0 ? 0 : 1)) * 5632 + f0) = v; } }
        }
    }
};

struct CtxSplitOrder {
    int nsplit, klen, c;
    __device__ __forceinline__ bool next(int i, Unit& u) const { if (i > 0 || c >= 32 * nsplit) return false; const int tile = c / nsplit, s = c - tile * nsplit; u.pm = 64 + (tile >> 3); u.pn = tile & 7; u.ko = s * klen; return true; }
    __device__ __forceinline__ void a_ready(const Unit&) const {}
    __device__ __forceinline__ void done(const Unit&) const {}
};
struct EpiSlab {
    static constexpr bool PERM = false, AFTER_DRAIN = false;
    float* slab; int klen;
    __device__ __forceinline__ void operator()(const f32x4 (&acc)[2][2][4][2], const Unit& u, int wr, int wc, int fr, int fq) const {
        float* os = slab + (size_t)(u.ko / klen) * 1024 * 2048;
        const int row0 = (u.pm - 64) * BM + wr * 64 + fr, col0 = u.pn * BM + wc * 32 + 4 * fq;
#pragma unroll
        for (int ai = 0; ai < 2; ++ai)
#pragma unroll
            for (int m = 0; m < 4; ++m) { const size_t off = (size_t)(row0 + ai * HALF + m * 16) * 2048 + col0;
#pragma unroll
                for (int bj = 0; bj < 2; ++bj)
#pragma unroll
                    for (int n = 0; n < 2; ++n) *(f32x4*)(os + off + bj * HALF + n * 16) = acc[ai][bj][m][n]; }
    }
};
template <class Epi, class Sched, bool ALIGN_EPI = false, bool SP2 = false>
__device__ __forceinline__ void gemm_phase(PG8_LAS unsigned char* lds, const Gemm g, const Sched& S, const Epi& E) {
    int tid_ = threadIdx.x; asm volatile("" : "+v"(tid_)); const int tid = tid_, wid = __builtin_amdgcn_readfirstlane(tid >> 6), lane = tid & 63, wr = wid >> 2, wc = wid & 3, fr = lane & 15, fq = lane >> 4;
    const int K = g.K, nt = K / BK, LD = g.ld ? g.ld : g.K;
    unsigned voffA[2], voffB[2];
#pragma unroll
    for (int i = 0; i < 2; ++i) { int R, C; stage_rc(tid * 16 + i * 8192, R, C); const int Rb = Epi::PERM ? ((R & ~31) + perm32(R & 31)) : R;
        voffA[i] = (unsigned)(R * LD + C) * 2u; voffB[i] = (unsigned)(Rb * LD + C) * 2u; }
    const size_t kstep = (size_t)(BK * 2);
    const size_t hstep = (size_t)HALF * LD * 2;
    const size_t tstep = 2 * hstep;
    const unsigned ldsw = (unsigned)wid * 1024u;
    const int aoff = lds_byte(wr * 64 + fr, fq * 8), boff = lds_byte(wc * 32 + fr, fq * 8);
#define PG8_SA(b, h) (((b) * 2 + (h)) * HTB)
#define PG8_SB(b, h) ((4 + (b) * 2 + (h)) * HTB)
#define PG8_STAGE(bufoff, gbase, voff) do { _Pragma("unroll") for (int _i = 0; _i < 2; ++_i) \
        __builtin_amdgcn_global_load_lds((const unsigned*)((const char*)(gbase) + (voff)[_i]), (PG8_LAS unsigned*)(lds + (bufoff) + ldsw + _i * 8192), 16, 0, 0); } while (0)
#define PG8_LDA(dst, b, h) do { _Pragma("unroll") for (int m = 0; m < 4; ++m) _Pragma("unroll") for (int k = 0; k < 2; ++k) dst[m][k] = *(const PG8_LAS bf16x8*)(lds + PG8_SA(b, h) + aoff + m * 2048 + k * 1024); } while (0)
#define PG8_LDB(dst, b, h) do { _Pragma("unroll") for (int n = 0; n < 2; ++n) _Pragma("unroll") for (int k = 0; k < 2; ++k) dst[n][k] = *(const PG8_LAS bf16x8*)(lds + PG8_SB(b, h) + boff + n * 2048 + k * 1024); } while (0)
#define PG8_MMA(ai, bj, At, Bt) do { __builtin_amdgcn_s_setprio(1); _Pragma("unroll") for (int m = 0; m < 4; ++m) _Pragma("unroll") for (int n = 0; n < 2; ++n) _Pragma("unroll") for (int k = 0; k < 2; ++k) \
        acc[ai][bj][m][n] = __builtin_amdgcn_mfma_f32_16x16x32_bf16(Bt[n][k], At[m][k], acc[ai][bj][m][n], 0, 0, 0); __builtin_amdgcn_s_setprio(0); } while (0)
#define PG8_WAIT_V(n) asm volatile("s_waitcnt vmcnt(" #n ")" ::: "memory")
#define PG8_WAIT_L(n) asm volatile("s_waitcnt lgkmcnt(" #n ")" ::: "memory")
#define PG8_BAR __builtin_amdgcn_s_barrier()
#define PG8_SCHED __builtin_amdgcn_sched_barrier(0)
    Unit cur, nxt; int ui = 0;
    if (!S.next(0, cur)) return;
    f32x4 acc[2][2][4][2];
#pragma unroll
    for (int a = 0; a < 2; ++a)
#pragma unroll
        for (int b = 0; b < 2; ++b)
#pragma unroll
            for (int m = 0; m < 4; ++m)
#pragma unroll
                for (int n = 0; n < 2; ++n) acc[a][b][m][n] = (f32x4){0.f, 0.f, 0.f, 0.f};
    bf16x8 At[4][2], B0[2][2], B1[2][2];
    const char* cA = (const char*)g.A + (size_t)cur.pm * tstep + (size_t)cur.ko * 2; const char* cB = (const char*)g.Bt + (size_t)cur.pn * tstep + (size_t)cur.ko * 2;
    S.a_ready(cur);
    if constexpr (SP2) {
        PG8_STAGE(PG8_SB(0, 0), cB, voffB); PG8_STAGE(PG8_SB(0, 1), cB + hstep, voffB); PG8_STAGE(PG8_SA(0, 0), cA, voffA); PG8_STAGE(PG8_SA(0, 1), cA + hstep, voffA);
        if (wr == 1) PG8_BAR;
        PG8_WAIT_V(2); PG8_BAR;
        PG8_STAGE(PG8_SB(1, 0), cB + kstep, voffB); PG8_STAGE(PG8_SA(1, 0), cA + kstep, voffA); PG8_STAGE(PG8_SB(1, 1), cB + hstep + kstep, voffB);
        PG8_WAIT_V(6); PG8_BAR;
    } else {
        PG8_STAGE(PG8_SB(0, 0), cB, voffB); PG8_STAGE(PG8_SA(0, 0), cA, voffA); PG8_STAGE(PG8_SB(0, 1), cB + hstep, voffB); PG8_STAGE(PG8_SA(0, 1), cA + hstep, voffA);
        if (wr == 1) PG8_BAR;
        PG8_WAIT_V(4); PG8_BAR;
        PG8_STAGE(PG8_SB(1, 0), cB + kstep, voffB); PG8_STAGE(PG8_SA(1, 0), cA + kstep, voffA); PG8_STAGE(PG8_SB(1, 1), cB + hstep + kstep, voffB);
        PG8_WAIT_V(6); PG8_BAR;
    }
    for (;;) {
        const bool has_next = S.next(ui + 1, nxt);
        const char* nA = has_next ? (const char*)g.A + (size_t)nxt.pm * tstep + (size_t)nxt.ko * 2 : cA; const char* nB = has_next ? (const char*)g.Bt + (size_t)nxt.pn * tstep + (size_t)nxt.ko * 2 : cB;
        for (int t = 0; t < nt; t += 2) {
            const bool last = (t == nt - 2);
            const char* a1 = cA + (size_t)(t + 1) * kstep;
            const char* a2 = last ? nA : cA + (size_t)(t + 2) * kstep; const char* b2 = last ? nB : cB + (size_t)(t + 2) * kstep;
            const char* a3 = a2 + kstep; const char* b3 = b2 + kstep;
            if (last && has_next) S.a_ready(nxt);
            if constexpr (SP2) {
            PG8_LDB(B0, 0, 0); PG8_LDB(B1, 0, 1); PG8_SCHED; PG8_LDA(At, 0, 0); PG8_STAGE(PG8_SA(1, 1), a1 + hstep, voffA);
            PG8_WAIT_V(8); PG8_WAIT_L(0); PG8_BAR; PG8_MMA(0, 0, At, B0); PG8_MMA(0, 1, At, B1); PG8_BAR; PG8_SCHED;
            PG8_LDA(At, 0, 1); PG8_STAGE(PG8_SB(0, 0), b2, voffB); PG8_STAGE(PG8_SB(0, 1), b2 + hstep, voffB); PG8_STAGE(PG8_SA(0, 0), a2, voffA);
            PG8_WAIT_V(8); PG8_WAIT_L(0); PG8_BAR; PG8_MMA(1, 0, At, B0); PG8_MMA(1, 1, At, B1); PG8_BAR; PG8_SCHED;
            PG8_LDB(B0, 1, 0); PG8_LDB(B1, 1, 1); PG8_SCHED; PG8_LDA(At, 1, 0); PG8_STAGE(PG8_SA(0, 1), a2 + hstep, voffA);
            PG8_WAIT_V(8); PG8_WAIT_L(0); PG8_BAR; PG8_MMA(0, 0, At, B0); PG8_MMA(0, 1, At, B1); PG8_BAR; PG8_SCHED;
            PG8_LDA(At, 1, 1); PG8_STAGE(PG8_SB(1, 0), b3, voffB); PG8_STAGE(PG8_SB(1, 1), b3 + hstep, voffB); PG8_STAGE(PG8_SA(1, 0), a3, voffA);
            PG8_WAIT_V(8); PG8_WAIT_L(0); PG8_BAR; PG8_MMA(1, 0, At, B0); PG8_MMA(1, 1, At, B1); PG8_BAR; PG8_SCHED;
            } else {
            PG8_LDB(B0, 0, 0); PG8_SCHED; PG8_LDA(At, 0, 0); PG8_STAGE(PG8_SA(1, 1), a1 + hstep, voffA);
            PG8_WAIT_L(8); PG8_BAR; PG8_WAIT_L(0); PG8_MMA(0, 0, At, B0); PG8_BAR; PG8_SCHED;
            PG8_LDB(B1, 0, 1); PG8_STAGE(PG8_SB(0, 0), b2, voffB);
            PG8_BAR; PG8_WAIT_L(0); PG8_MMA(0, 1, At, B1); PG8_BAR;
            PG8_LDA(At, 0, 1); PG8_STAGE(PG8_SA(0, 0), a2, voffA);
            PG8_BAR; PG8_WAIT_L(0); PG8_MMA(1, 0, At, B0); PG8_BAR; PG8_SCHED;
            PG8_STAGE(PG8_SB(0, 1), b2 + hstep, voffB);
            PG8_WAIT_V(6); PG8_BAR; PG8_MMA(1, 1, At, B1); PG8_BAR;
            PG8_LDB(B0, 1, 0); PG8_SCHED; PG8_LDA(At, 1, 0); PG8_STAGE(PG8_SA(0, 1), a2 + hstep, voffA);
            PG8_WAIT_L(8); PG8_BAR; PG8_WAIT_L(0); PG8_MMA(0, 0, At, B0); PG8_BAR; PG8_SCHED;
            PG8_LDB(B1, 1, 1); PG8_STAGE(PG8_SB(1, 0), b3, voffB);
            PG8_BAR; PG8_WAIT_L(0); PG8_MMA(0, 1, At, B1); PG8_BAR;
            PG8_LDA(At, 1, 1); PG8_STAGE(PG8_SA(1, 0), a3, voffA);
            PG8_BAR; PG8_WAIT_L(0); PG8_MMA(1, 0, At, B0); PG8_BAR; PG8_SCHED;
            PG8_STAGE(PG8_SB(1, 1), b3 + hstep, voffB);
            PG8_WAIT_V(6); PG8_BAR; PG8_MMA(1, 1, At, B1); PG8_BAR;
            }
        }
        if constexpr (ALIGN_EPI) { if (wr == 0) PG8_BAR; }
        if constexpr (!Epi::AFTER_DRAIN) { E(acc, cur, wr, wc, fr, fq); S.done(cur); }
        if (!has_next) break;
#pragma unroll
        for (int a = 0; a < 2; ++a)
#pragma unroll
            for (int b = 0; b < 2; ++b)
#pragma unroll
                for (int m = 0; m < 4; ++m)
#pragma unroll
                    for (int n = 0; n < 2; ++n) acc[a][b][m][n] = (f32x4){0.f, 0.f, 0.f, 0.f};
        cur = nxt; cA = nA; cB = nB; ++ui;
        if constexpr (ALIGN_EPI) { if (wr == 1) PG8_BAR; }
    }
    PG8_WAIT_V(0);
    if constexpr (!ALIGN_EPI) { if (wr == 0) PG8_BAR; }
    PG8_BAR;
    if constexpr (Epi::AFTER_DRAIN) { E.fused(acc, cur, wr, wc, fr, fq, lds, wid, lane); S.done(cur); }
#undef PG8_SA
#undef PG8_SB
#undef PG8_STAGE
#undef PG8_LDA
#undef PG8_LDB
#undef PG8_MMA
#undef PG8_WAIT_V
#undef PG8_WAIT_L
#undef PG8_BAR
#undef PG8_SCHED
}
}
#ifndef PG8_SP2
#define PG8_SP2 true
#endif
#ifndef PG8_ALIGN
#define PG8_ALIGN true
#endif
constexpr int D = 2048, NB = 4, SEQ = 4096, CL = 256, DEPTH = 4;
constexpr int ML = NB * SEQ, MC = NB * CL, MT = ML + MC;
constexpr int INW = 15360, DFF = 5632, NFF = 2 * DFF;
constexpr int C_RK = 0, C_RV = 512, C_NK = 1536, C_NV = 2560, C_RQ = 3584, C_RG = 4096, C_NQ = 5120, C_HY = 6144, C_GT = 9216;
constexpr float EPS = 1e-6f;
constexpr int NWAVES = 8;
constexpr size_t al256(size_t x) { return (x + 255) & ~(size_t)255; }
constexpr size_t WS_CTL = 0, CTL_ZERO_BYTES = 1u << 20;
constexpr size_t WS_MOD = WS_CTL + CTL_ZERO_BYTES;
constexpr size_t WS_ROPE = WS_MOD + al256((size_t)4 * 5 * 12288 * 4);
constexpr size_t PS_FH2 = 0;
constexpr size_t PS_FH2B = PS_FH2 + al256((size_t)4352 * 64 * 4);
constexpr size_t PS_TAPC = PS_FH2B + al256((size_t)4352 * 64 * 2);
constexpr size_t PS_KF = PS_TAPC + al256((size_t)2 * 2 * 1024 * 256 * 4);
constexpr size_t PS_WIN = PS_KF + al256((size_t)2 * 1024 * 8192 * 8);
constexpr size_t PS_WBR = PS_WIN + al256((size_t)INW * D * 2);
constexpr size_t PS_WOUT = PS_WBR + al256((size_t)3 * D * 1024 * 2);
constexpr size_t PS_WF1 = PS_WOUT + al256((size_t)D * D * 2);
constexpr size_t PS_WF2 = PS_WF1 + al256((size_t)NFF * D * 2);
constexpr size_t PS_BYTES = PS_WF2 + al256((size_t)D * DFF * 2);
constexpr size_t WS_PSET = WS_ROPE + al256(64 * 16 * 8);
constexpr size_t WS_XC = WS_PSET + 2 * PS_BYTES;
constexpr size_t WS_H = WS_XC + al256((size_t)MC * D * 4);
constexpr size_t WS_Z = WS_H + al256((size_t)MT * D * 2);
constexpr size_t WS_HYT = WS_Z + al256((size_t)MT * INW * 2);
constexpr size_t WS_YT = WS_HYT + al256((size_t)3 * NB * 1024 * SEQ * 2);
constexpr size_t WS_YS = WS_YT + al256((size_t)NB * 1024 * SEQ * 2);
constexpr size_t WS_ACC = WS_YS + al256((size_t)3 * MT * 1024 * 2);
constexpr size_t WS_U = WS_ACC + al256((size_t)MT * D * 2);
constexpr size_t WS_KV = WS_U + al256((size_t)MT * DFF * 2);
constexpr size_t WS_SA = WS_KV + al256((size_t)NB * 8 * 2 * 34 * 8192 * 4);
constexpr size_t WS_SB = WS_SA + al256((size_t)272 * 4 * DFF * 2);
constexpr size_t WS_SLAB = WS_SB + al256((size_t)272 * 2 * DFF * 2);
constexpr size_t WS_FB4 = WS_SLAB + al256((size_t)4 * MC * D * 4);
constexpr size_t WS_END = WS_FB4 + al256((size_t)4 * 4352 * 64 * 2);
constexpr int NSPLIT = 4;
constexpr int CW_BAR = 4096, CW_DYN = 8192;
constexpr int RING_BYTES = 131072, LDS_BYTES = 147456, LDSCTL_OFF = LDS_BYTES - 1024, MISC_OFF = LDSCTL_OFF + 320;

#define GAS __attribute__((address_space(1)))
#define LAS __attribute__((address_space(3)))
typedef unsigned short bf16;
typedef unsigned v4u __attribute__((ext_vector_type(4)));
typedef unsigned v2u __attribute__((ext_vector_type(2)));
typedef float f32x4 __attribute__((ext_vector_type(4)));
typedef float f32x2 __attribute__((ext_vector_type(2)));
typedef short bf16x8 __attribute__((ext_vector_type(8)));
typedef GAS unsigned gu32;
#define LDS_WAIT() asm volatile("s_waitcnt lgkmcnt(0)" ::: "memory")
__device__ __forceinline__ unsigned f2bf(float f) { unsigned u = __builtin_bit_cast(unsigned, f); return (u + 0x7fffu + ((u >> 16) & 1u)) >> 16; }
typedef __bf16 bf16x2_t __attribute__((ext_vector_type(2)));
__device__ __forceinline__ unsigned pk2(float lo, float hi) { const bf16x2_t v = {(__bf16)lo, (__bf16)hi}; return __builtin_bit_cast(unsigned, v); }
__device__ __forceinline__ float bflo(unsigned w) { return __uint_as_float(w << 16); }
__device__ __forceinline__ float bfhi(unsigned w) { return __uint_as_float(w & 0xffff0000u); }
__device__ __forceinline__ float bf1(bf16 b) { return __uint_as_float(((unsigned)b) << 16); }
__device__ __forceinline__ bf16x8 mk8(unsigned a, unsigned b, unsigned c, unsigned d) { v4u v = (v4u){a, b, c, d}; return __builtin_bit_cast(bf16x8, v); }
__device__ __forceinline__ f32x4 mfma16(bf16x8 a, bf16x8 b, f32x4 c) { return __builtin_amdgcn_mfma_f32_16x16x32_bf16(a, b, c, 0, 0, 0); }
__device__ __forceinline__ float sin_rev(float r) { return __builtin_amdgcn_sinf(r - floorf(r)); }
__device__ __forceinline__ float cos_rev(float r) { return __builtin_amdgcn_cosf(r - floorf(r)); }
__device__ __forceinline__ float sin_rad(float x) { return sin_rev(x * 0.15915494309189535f); }
__device__ __forceinline__ float ex2(float x) { return __builtin_amdgcn_exp2f(x); }
__device__ __forceinline__ float wave_sum(float v) {
#pragma unroll
    for (int o = 1; o < 64; o <<= 1) v += __shfl_xor(v, o);
    return v;
}
__device__ __forceinline__ int otid() { int t = threadIdx.x; asm volatile("" : "+v"(t)); return t; }
__device__ __forceinline__ int opq(int v) { asm volatile("" : "+s"(v)); return v; }
#define XB_TMO      128
#define XB_XCNT(j)  (256  + 64 * (j))
#define XB_XSUB(j)  (1280 + 64 * (j))
#define XB_XGEN(j)  (2304 + 64 * (j))
#define XB_TOP      3328
#define XB_TOPGEN   3392
#define XCD_BAR_WORDS 3456
#define XB_SPIN_CAP (1u << 18)

__device__ __forceinline__ unsigned xb_ld(unsigned* p)              { return __hip_atomic_load(p, __ATOMIC_RELAXED, __HIP_MEMORY_SCOPE_AGENT); }
__device__ __forceinline__ unsigned xb_add(unsigned* p, unsigned v) { return __hip_atomic_fetch_add(p, v, __ATOMIC_RELAXED, __HIP_MEMORY_SCOPE_AGENT); }
__device__ __forceinline__ unsigned xb_xcc_id() { return (unsigned)__builtin_amdgcn_s_getreg((3 << 11) | 20) & 0xFu; }
#define XB_SPIN(cond, bar) do { unsigned _sp = 0; while (cond) { __builtin_amdgcn_s_sleep(1); \
    if ((++_sp & 255u) == 0u) { if (xb_ld(&(bar)[XB_TMO])) break; if (_sp > XB_SPIN_CAP) { atomicAdd(&(bar)[XB_TMO], 1u); break; } } } } while (0)

struct XcdBarrier {
    unsigned* bar; unsigned x;
    volatile LAS unsigned* st;
};

__device__ __forceinline__ XcdBarrier xcd_barrier_post(unsigned* bar, volatile LAS unsigned* st) {
    XcdBarrier b; b.bar = bar; b.x = xb_xcc_id(); b.st = st;
    if (threadIdx.x == 0) (void)xb_add(&bar[XB_XCNT(b.x)], 1u);
    return b;
}
__device__ __forceinline__ void xcd_barrier_complete(unsigned* bar, unsigned x, unsigned& nloc, unsigned& nx) {
    const unsigned G = gridDim.x * gridDim.y * gridDim.z;
    unsigned sum, cnt, mine, sp = 0u;
    for (;;) {
        sum = 0u; cnt = 0u; mine = 0u;
#pragma unroll
        for (unsigned j = 0; j < 16; ++j) { const unsigned c = xb_ld(&bar[XB_XCNT(j)]); sum += c; cnt += (c > 0u) ? 1u : 0u; mine = (j == x) ? c : mine; }
        if (sum == G) break;
        __builtin_amdgcn_s_sleep(1);
        if ((++sp & 255u) == 0u) { if (xb_ld(&bar[XB_TMO])) break; if (sp > XB_SPIN_CAP) { atomicAdd(&bar[XB_TMO], 1u); break; } }
    }
    nloc = mine > 0u ? mine : 1u; nx = cnt > 0u ? cnt : 1u;
}

__device__ __forceinline__ void xcd_barrier(const XcdBarrier& b) {
    asm volatile("s_waitcnt vmcnt(0)" ::: "memory");
    __syncthreads();
    if (threadIdx.x == 0) {
        unsigned* bar = b.bar;
        __builtin_amdgcn_s_waitcnt(0);
        unsigned nloc = b.st[0], nx = b.st[1];
        if (nloc == 0u) { xcd_barrier_complete(bar, b.x, nloc, nx); b.st[0] = nloc; b.st[1] = nx; }
        const unsigned old = xb_add(&bar[XB_XSUB(b.x)], 1u);
        const unsigned gen = old / nloc;
        if (old + 1u == (gen + 1u) * nloc) {
            __builtin_amdgcn_fence(__ATOMIC_RELEASE, "agent");
            asm volatile("s_waitcnt vmcnt(0)" ::: "memory");
            const unsigned og = xb_add(&bar[XB_TOP], 1u);
            const unsigned tg = og / nx;
            if (og + 1u == (tg + 1u) * nx) xb_add(&bar[XB_TOPGEN], 1u);
            else XB_SPIN(xb_ld(&bar[XB_TOPGEN]) == tg, bar);
            __builtin_amdgcn_fence(__ATOMIC_ACQUIRE, "agent");
            xb_add(&bar[XB_XGEN(b.x)], 1u);
            asm volatile("s_waitcnt vmcnt(0)" ::: "memory");
        } else {
            XB_SPIN(xb_ld(&bar[XB_XGEN(b.x)]) == gen, bar);
            __builtin_amdgcn_fence(__ATOMIC_ACQUIRE, "agent");
            asm volatile("s_waitcnt vmcnt(0)" ::: "memory");
        }
    }
    __syncthreads();
}
__device__ __forceinline__ void p0_transpose_item(const float* W, int K, int N, bf16* WT, int row_off, LAS float* scr, int item, int lane) {
    const int nblk = N / 32, kb = item / nblk, nb = item % nblk, k0 = 64 * kb, n0 = 32 * nb;
#pragma unroll 16
    for (int i = 0; i < 32; ++i) { const int kk = 2 * i + (lane >> 5); scr[kk * 33 + (lane & 31)] = __builtin_nontemporal_load(W + (size_t)(k0 + kk) * N + n0 + (lane & 31)); }
    LDS_WAIT(); asm volatile("" ::: "memory");
    const int c = lane & 7;
#pragma unroll
    for (int j = 0; j < 4; ++j) { const int n = (lane >> 3) + 8 * j; const LAS float* s = scr + (8 * c) * 33 + n;
        v4u o; o.x = pk2(s[0 * 33], s[1 * 33]); o.y = pk2(s[2 * 33], s[3 * 33]); o.z = pk2(s[4 * 33], s[5 * 33]); o.w = pk2(s[6 * 33], s[7 * 33]);
        __builtin_nontemporal_store(o, (GAS v4u*)(WT + (size_t)(row_off + n0 + n) * K + k0 + 8 * c)); }
    LDS_WAIT(); asm volatile("" ::: "memory");
}
struct Args { const float* in[27]; float* out; unsigned char* ws; int seq_lo, seq_hi; };
__device__ __forceinline__ const float* inp(int i) { const char* ka = (const char*)__builtin_amdgcn_kernarg_segment_ptr(); int off = i * 8; asm volatile("" : "+s"(off)); return *(const float* const*)(ka + off); }
__device__ __forceinline__ unsigned char* wsb() { const char* ka = (const char*)__builtin_amdgcn_kernarg_segment_ptr(); int off = 27 * 8 + 8; asm volatile("" : "+s"(off)); return *(unsigned char* const*)(ka + off); }
__device__ __forceinline__ float* outb() { const char* ka = (const char*)__builtin_amdgcn_kernarg_segment_ptr(); int off = 27 * 8; asm volatile("" : "+s"(off)); return *(float* const*)(ka + off); }
__device__ __forceinline__ unsigned char* psb(int set) { return wsb() + WS_PSET + (size_t)set * PS_BYTES; }
enum { I_X = 0, I_C, I_CTX, I_CCTX, I_WMOD, I_BMOD, I_G1, I_G2, I_WIN, I_HCW, I_HCB, I_FW1, I_FB1, I_FW2, I_FB2, I_FW3, I_FFQ, I_HBIAS, I_RDEC, I_RPB, I_WBR, I_WOUT, I_FFW1, I_FFCW, I_FFCB, I_FFW2, I_GF };

__device__ __forceinline__ void ph_prologue(const Args& A, LAS unsigned char* lds, int tid) {
    LAS float* sc = (LAS float*)lds;
    LAS float* red = sc + 5 * 2048;
    const float* c = inp(I_C); const float* cc = inp(I_CCTX);
    for (int i = tid; i < 5 * 2048; i += 512) { const int r = i >> 11, k = i & 2047; const float v = (r < 4) ? c[r * 2048 + k] : cc[k]; sc[i] = v / (1.0f + __expf(-v)); }
    __syncthreads();
    float* mod = (float*)(wsb() + WS_MOD);
    const int kq = tid >> 6, col = tid & 63;
    for (int u = blockIdx.x; u < DEPTH * 192; u += gridDim.x) {
        const int l = u / 192, n0 = (u % 192) * 64;
        const float* W = inp(I_WMOD) + (size_t)l * 2048 * 12288 + n0 + col;
        float a0 = 0.f, a1 = 0.f, a2 = 0.f, a3 = 0.f, a4 = 0.f;
#pragma unroll 16
        for (int k = kq * 256; k < kq * 256 + 256; ++k) { const float w = W[(size_t)k * 12288];
            a0 += sc[k] * w; a1 += sc[2048 + k] * w; a2 += sc[4096 + k] * w; a3 += sc[6144 + k] * w; a4 += sc[8192 + k] * w; }
        red[(kq * 5 + 0) * 64 + col] = a0; red[(kq * 5 + 1) * 64 + col] = a1; red[(kq * 5 + 2) * 64 + col] = a2; red[(kq * 5 + 3) * 64 + col] = a3; red[(kq * 5 + 4) * 64 + col] = a4;
        __syncthreads();
        if (tid < 320) { const int r = tid >> 6; float s = inp(I_BMOD)[l * 12288 + n0 + col];
#pragma unroll
            for (int q = 0; q < 8; ++q) s += red[(q * 5 + r) * 64 + col];
            mod[((size_t)l * 5 + r) * 12288 + n0 + col] = s; }
        __syncthreads();
    }
    if (blockIdx.x == 0) { f32x2* rope = (f32x2*)(wsb() + WS_ROPE);
        for (int i = tid; i < 1024; i += 512) { const int pos = i >> 4, j = i & 15; const float inv = exp2f(-(float)j * (13.287712379549449f / 16.0f));
            const float rev = (float)pos * inv * 0.15915494309189535f; rope[i] = (f32x2){cos_rev(rev), sin_rev(rev)}; } }
}

__device__ __forceinline__ void ph_convert(const Args& A, int l, int set, int it_lo, int it_hi, int wk, int nwk, LAS unsigned char* lds, int wave, int lane) {
    LAS float* scr = (LAS float*)(lds + wave * 16384);
    const int gw = wk * NWAVES + wave, NGW = nwk * NWAVES;
    constexpr int I_IN = (D / 64) * (INW / 32), I_BR = (1024 / 64) * (D / 32), I_OUT = (D / 64) * (D / 32), I_F1 = (D / 64) * (NFF / 32);
    const float* win = inp(I_WIN) + (size_t)l * D * INW; const float* wbr = inp(I_WBR) + (size_t)l * 3 * 1024 * D; const float* wout = inp(I_WOUT) + (size_t)l * D * D;
    const float* wf1 = inp(I_FFW1) + (size_t)l * D * NFF; const float* wf2 = inp(I_FFW2) + (size_t)l * DFF * D;
    unsigned char* ps = psb(set);
    bf16* WIN = (bf16*)(ps + PS_WIN); bf16* WBR = (bf16*)(ps + PS_WBR); bf16* WOUT = (bf16*)(ps + PS_WOUT); bf16* WF1 = (bf16*)(ps + PS_WF1); bf16* WF2 = (bf16*)(ps + PS_WF2);
    for (int it = it_lo + gw; it < it_hi; it += NGW) {
        int r = it;
        if (r < I_IN) { p0_transpose_item(win, D, INW, WIN, 0, scr, r, lane); continue; } r -= I_IN;
        if (r < I_BR) { p0_transpose_item(wbr, 1024, D, WBR, 0, scr, r, lane); continue; } r -= I_BR;
        if (r < I_BR) { p0_transpose_item(wbr + (size_t)1024 * D, 1024, D, WBR + (size_t)D * 1024, 0, scr, r, lane); continue; } r -= I_BR;
        if (r < I_BR) { p0_transpose_item(wbr + (size_t)2 * 1024 * D, 1024, D, WBR + (size_t)2 * D * 1024, 0, scr, r, lane); continue; } r -= I_BR;
        if (r < I_OUT) { p0_transpose_item(wout, D, D, WOUT, 0, scr, r, lane); continue; } r -= I_OUT;
        if (r < I_F1) { const int n0 = (r % (NFF / 32)) * 32, f0 = (n0 < DFF) ? n0 : n0 - DFF, nrow = 256 * (f0 >> 7) + ((n0 < DFF) ? 0 : 128) + (f0 & 127);
            p0_transpose_item(wf1, D, NFF, WF1, nrow - n0, scr, r, lane); continue; } r -= I_F1;
        p0_transpose_item(wf2, DFF, D, WF2, 0, scr, r, lane);
    }
}
constexpr int CONV_ITEMS = (D / 64) * (INW / 32) + 3 * (1024 / 64) * (D / 32) + (D / 64) * (D / 32) + (D / 64) * (NFF / 32) + (DFF / 64) * (D / 32);
__device__ __forceinline__ void ph_filt1(const Args& A, int l, int set, int wk, int nwk, LAS unsigned char* lds, int tid) {
    LAS float* feat = (LAS float*)lds;
    LAS float* h1 = feat + 8 * 33;
    LAS float* w1s = h1 + 8 * 64;
    LAS float* w2s = w1s + 33 * 64;
    const float* w1 = inp(I_FW1) + (size_t)l * 33 * 64; const float* b1 = inp(I_FB1) + l * 64; const float* w2 = inp(I_FW2) + (size_t)l * 64 * 64; const float* b2 = inp(I_FB2) + l * 64;
    const float* fq = inp(I_FFQ) + l * 64; bf16* FH2B = (bf16*)(wsb() + WS_FB4) + (size_t)l * 4352 * 64;
    const int pl = tid >> 6, o = tid & 63;
    __syncthreads();
    for (int i = tid; i < 33 * 64; i += 512) w1s[i] = w1[i];
    for (int i = tid; i < 64 * 64; i += 512) w2s[i] = w2[i];
    const float b1o = b1[o], b2o = b2[o], fqo = fq[o];
    __syncthreads();
    for (int u = wk; u < 544; u += nwk) {
        const int pos = u * 8 + pl; const bool isc = pos >= 4096; const int Lf = isc ? 256 : 4096, tp = isc ? pos - 4096 : pos;
        if (o < 33) { float f;
            if (o == 0) f = (float)tp / (float)(Lf - 1);
            else { const int i = (o - 1) & 15; const float fr = 1e-4f + (float)i * ((15.0f - 1e-4f) / 15.0f); const float rev = fr * (float)tp / (float)Lf; f = (o <= 16) ? cos_rev(rev) : -sin_rev(rev); }
            feat[pl * 33 + o] = f; }
        __syncthreads();
        float a = b1o;
#pragma unroll 11
        for (int i = 0; i < 33; ++i) a += feat[pl * 33 + i] * w1s[i * 64 + o];
        h1[pl * 64 + o] = sin_rad(fqo * a);
        __syncthreads();
        float b = b2o;
#pragma unroll 16
        for (int j = 0; j < 64; ++j) b += h1[pl * 64 + j] * w2s[j * 64 + o];
        FH2B[(size_t)pos * 64 + o] = (bf16)f2bf(sin_rad(fqo * b));
        __syncthreads();
    }
}
__device__ __forceinline__ void ph_norm(const float* xlat, const float* xctx, const float* g, const float* modl, int sh_off, int sc_off, bf16* H, int Mrows, const float* slab, const float* sgate, float* xc_out, int wave, int lane) {
    const int gw = blockIdx.x * NWAVES + wave, NGW = gridDim.x * NWAVES;
    for (int base = gw * 8; base < ML; base += NGW * 8) {
        const float* mv = modl + (size_t)(base >> 12) * 12288;
        f32x4 Gv[8], Sv[8];
#pragma unroll
        for (int j = 0; j < 8; ++j) { const int idx = (lane + 64 * j) * 4; Gv[j] = *(const f32x4*)(g + idx) * (*(const f32x4*)(mv + sc_off + idx) + 1.0f); Sv[j] = *(const f32x4*)(mv + sh_off + idx); }
        f32x4 v[8], nx[8];
#pragma unroll
        for (int j = 0; j < 8; ++j) nx[j] = *(const f32x4*)(xlat + (size_t)base * D + (lane + 64 * j) * 4);
#pragma unroll 1
        for (int i = 0; i < 8; ++i) { const int m = base + i; float ss = 0.f;
#pragma unroll
            for (int j = 0; j < 8; ++j) { v[j] = nx[j]; ss += (v[j].x * v[j].x + v[j].y * v[j].y) + (v[j].z * v[j].z + v[j].w * v[j].w); }
            if (i < 7) {
#pragma unroll
                for (int j = 0; j < 8; ++j) nx[j] = *(const f32x4*)(xlat + (size_t)(m + 1) * D + (lane + 64 * j) * 4); }
            const float rstd = 1.0f / sqrtf(wave_sum(ss) * (1.0f / D) + EPS);
#pragma unroll
            for (int j = 0; j < 8; ++j) { const int idx = (lane + 64 * j) * 4; const f32x4 y = v[j] * rstd * Gv[j] + Sv[j];
                v2u w; w.x = pk2(y.x, y.y); w.y = pk2(y.z, y.w); *(v2u*)(H + (size_t)m * D + idx) = w; } }
    }
    for (int m = ML + gw; m < Mrows; m += NGW) {
        const float* xr = xctx + (size_t)(m - ML) * D; const float* mv = modl + (size_t)4 * 12288;
        f32x4 v[8]; float ss = 0.f;
#pragma unroll
        for (int j = 0; j < 8; ++j) { const int idx = (lane + 64 * j) * 4; v[j] = *(const f32x4*)(xr + idx);
            if (slab) { const float* sp = slab + (size_t)(m - ML) * D + idx; f32x4 p = *(const f32x4*)sp;
#pragma unroll
                for (int q = 1; q < NSPLIT; ++q) p = p + *(const f32x4*)(sp + (size_t)q * MC * D);
                v[j] = v[j] + *(const f32x4*)(sgate + idx) * p; *(f32x4*)(xc_out + (size_t)(m - ML) * D + idx) = v[j]; }
            ss += (v[j].x * v[j].x + v[j].y * v[j].y) + (v[j].z * v[j].z + v[j].w * v[j].w); }
        const float rstd = 1.0f / sqrtf(wave_sum(ss) * (1.0f / D) + EPS);
#pragma unroll
        for (int j = 0; j < 8; ++j) { const int idx = (lane + 64 * j) * 4;
            const f32x4 gg = *(const f32x4*)(g + idx), sh = *(const f32x4*)(mv + sh_off + idx), sc = *(const f32x4*)(mv + sc_off + idx);
            const f32x4 y = v[j] * rstd * gg * (sc + 1.0f) + sh;
            v2u w; w.x = pk2(y.x, y.y); w.y = pk2(y.z, y.w);
            *(v2u*)(H + (size_t)m * D + idx) = w; }
    }
}

__device__ __forceinline__ int fphys(int i) { return i + 2 * (i >> 5); }
__device__ __forceinline__ void bfly_dif(f32x2& a, f32x2& b, float c, float s) { const f32x2 u = a, v = b; a = u + v; const f32x2 d = u - v; b = __builtin_elementwise_fma(d.yx, (f32x2){s, -s}, d * (f32x2){c, c}); }
__device__ __forceinline__ void bfly_idit(f32x2& a, f32x2& b, float c, float s) { const f32x2 u = a, q = b; const f32x2 v = __builtin_elementwise_fma(q.yx, (f32x2){-s, s}, q * (f32x2){c, c}); a = u + v; b = u - v; }
template <bool ZHI> __device__ __forceinline__ void dif16(f32x2 (&x)[16], float th) {
    asm volatile("" : "+v"(th));
#pragma unroll
    for (int k = 0; k < 8; ++k) { const float fr = th + (float)k * 0.0625f; const float c = __builtin_amdgcn_cosf(fr), s = __builtin_amdgcn_sinf(fr);
        if (ZHI) { const f32x2 u = x[k]; x[k + 8] = (f32x2){u.x * c + u.y * s, u.y * c - u.x * s}; } else bfly_dif(x[k], x[k + 8], c, s); }
#pragma unroll
    for (int k = 0; k < 4; ++k) { const float fr = 2.0f * th + (float)k * 0.125f; const float c = __builtin_amdgcn_cosf(fr), s = __builtin_amdgcn_sinf(fr);
        bfly_dif(x[k], x[k + 4], c, s); bfly_dif(x[8 + k], x[12 + k], c, s); }
#pragma unroll
    for (int k = 0; k < 2; ++k) { const float fr = 4.0f * th + (float)k * 0.25f; const float c = __builtin_amdgcn_cosf(fr), s = __builtin_amdgcn_sinf(fr);
#pragma unroll
        for (int b = 0; b < 16; b += 4) bfly_dif(x[b + k], x[b + k + 2], c, s); }
    { const float fr = 8.0f * th; const float c = __builtin_amdgcn_cosf(fr), s = __builtin_amdgcn_sinf(fr);
#pragma unroll
        for (int b = 0; b < 16; b += 2) bfly_dif(x[b], x[b + 1], c, s); }
}
__device__ __forceinline__ void idit16(f32x2 (&x)[16], float th) {
    asm volatile("" : "+v"(th));
    { const float fr = 8.0f * th; const float c = __builtin_amdgcn_cosf(fr), s = __builtin_amdgcn_sinf(fr);
#pragma unroll
        for (int b = 0; b < 16; b += 2) bfly_idit(x[b], x[b + 1], c, s); }
#pragma unroll
    for (int k = 0; k < 2; ++k) { const float fr = 4.0f * th + (float)k * 0.25f; const float c = __builtin_amdgcn_cosf(fr), s = __builtin_amdgcn_sinf(fr);
#pragma unroll
        for (int b = 0; b < 16; b += 4) bfly_idit(x[b + k], x[b + k + 2], c, s); }
#pragma unroll
    for (int k = 0; k < 4; ++k) { const float fr = 2.0f * th + (float)k * 0.125f; const float c = __builtin_amdgcn_cosf(fr), s = __builtin_amdgcn_sinf(fr);
        bfly_idit(x[k], x[k + 4], c, s); bfly_idit(x[8 + k], x[12 + k], c, s); }
#pragma unroll
    for (int k = 0; k < 8; ++k) { const float fr = th + (float)k * 0.0625f; const float c = __builtin_amdgcn_cosf(fr), s = __builtin_amdgcn_sinf(fr); bfly_idit(x[k], x[k + 8], c, s); }
}
template <bool INV, int PSTRIDE> __device__ __forceinline__ void fft_pass(LAS f32x2* buf, int base, float th) {
    LAS f32x2* p = buf + fphys(base);
    f32x2 x[16];
#pragma unroll
    for (int k = 0; k < 16; ++k) x[k] = p[k * PSTRIDE];
    if (INV) idit16(x, th); else dif16<false>(x, th);
#pragma unroll
    for (int k = 0; k < 16; ++k) p[k * PSTRIDE] = x[k];
}
template <bool INV, int PSTRIDE> __device__ __forceinline__ void fft_pass2(LAS f32x2* bufa, LAS f32x2* bufb, int base, float th) {
    LAS f32x2* pa = bufa + fphys(base); LAS f32x2* pb = bufb + fphys(base);
    f32x2 xa[16], xb[16];
#pragma unroll
    for (int k = 0; k < 16; ++k) { xa[k] = pa[k * PSTRIDE]; xb[k] = pb[k * PSTRIDE]; }
    if (INV) { idit16(xa, th); idit16(xb, th); } else { dif16<false>(xa, th); dif16<false>(xb, th); }
#pragma unroll
    for (int k = 0; k < 16; ++k) { pa[k * PSTRIDE] = xa[k]; pb[k * PSTRIDE] = xb[k]; }
}
constexpr int FFT_LDS_BYTES = (8192 + 512 + 8) * 8;
__device__ __forceinline__ float block_sum(float v, LAS float* red, int tid) {
    v = wave_sum(v);
    __syncthreads();
    if ((tid & 63) == 0) red[tid >> 6] = v;
    __syncthreads();
    float s = 0.f;
#pragma unroll
    for (int i = 0; i < 8; ++i) s += red[i];
    return s;
}
__device__ __forceinline__ float hy_delta(int c) { const float d0 = -4.605170185988091f / 0.3f, d1 = -4.605170185988091f / 1.5f; return fabsf(d0 + (d1 - d0) * ((float)c / 1023.0f)); }
__device__ __forceinline__ void ph_filt2(const Args& A, int l, int set, int c_lo, int c_hi, int wk, int nwk, LAS unsigned char* lds, int tid) {
    LAS f32x2* buf = (LAS f32x2*)lds; LAS float* bufs = (LAS float*)lds; LAS float* red = (LAS float*)(lds + FFT_LDS_BYTES + 64); LAS float* w3s = red + 32;
    LAS float* ctap = w3s + 256;
    const float* w3 = inp(I_FW3) + (size_t)l * 64 * 4096; const bf16* FH2B = (const bf16*)(wsb() + WS_FB4) + (size_t)l * 4352 * 64;
    f32x2* KF = (f32x2*)(psb(set) + PS_KF); float* TAPC = (float*)(psb(set) + PS_TAPC);
    const int lane = tid & 63, w = tid >> 6, g = lane >> 4, li = lane & 15;
    for (int c = c_lo + wk; c < c_hi; c += nwk) {
        __syncthreads();
        if (tid < 256) w3s[tid] = w3[(size_t)(tid & 63) * 4096 + (tid >> 7) * 2048 + ((tid >> 6) & 1) * 1024 + c];
        __syncthreads();
        bf16x8 bfr[2];
#pragma unroll
        for (int ks = 0; ks < 2; ++ks) { float v[8];
#pragma unroll
            for (int j = 0; j < 8; ++j) v[j] = (li < 4) ? w3s[li * 64 + 32 * ks + 8 * g + j] : 0.f;
            bfr[ks] = mk8(pk2(v[0], v[1]), pk2(v[2], v[3]), pk2(v[4], v[5]), pk2(v[6], v[7])); }
        const float delta = hy_delta(c); float ssq = 0.f, ssqc = 0.f;
        const int comp = li >> 1;
#pragma unroll 1
        for (int rb = 0; rb < 272; rb += 64) {
            bf16x8 a0[8], a1[8];
#pragma unroll
            for (int rk = 0; rk < 8; ++rk) { const int rt = rb + w + 8 * rk; const bf16* ap = FH2B + (size_t)((rt < 272 ? rt : 0) * 16 + li) * 64 + 8 * g;
                a0[rk] = *(const bf16x8*)ap; a1[rk] = *(const bf16x8*)(ap + 32); }
#pragma unroll
            for (int rk = 0; rk < 8; ++rk) { const int rt = rb + w + 8 * rk; const int t0 = rt * 16;
                f32x4 acc = (f32x4){0.f, 0.f, 0.f, 0.f};
                acc = mfma16(a0[rk], bfr[0], acc); acc = mfma16(a1[rk], bfr[1], acc);
                if (li < 4 && rt < 272) {
                    if (rt < 256) {
#pragma unroll
                        for (int j = 0; j < 4; ++j) { const int t = t0 + 4 * g + j; const float val = acc[j] * __expf(-((float)t * (1.0f / 4095.0f)) * delta);
                            if ((li & 1) == 0) { bufs[2 * fphys(t) + comp] = val; ssq += val * val; }
                            else if (t >= 1) { bufs[2 * fphys(8192 - t) + comp] = val; ssq += val * val; }
                            else bufs[2 * fphys(4096) + comp] = 0.f; }
                    } else {
#pragma unroll
                        for (int j = 0; j < 4; ++j) { const int m = t0 - 4096 + 4 * g + j; const float val = acc[j] * __expf(-((float)m * (1.0f / 255.0f)) * delta);
                            ctap[li * 256 + m] = val; if ((li & 1) == 0 || m >= 1) ssqc += val * val; }
                    }
                }
            }
        }
        const bool o0 = (li < 2), o1 = (li == 2 || li == 3);
        const float scl0 = (1.0f / 8192.0f) / sqrtf(block_sum(o0 ? ssq : 0.f, red, tid) + EPS), scl1 = (1.0f / 8192.0f) / sqrtf(block_sum(o1 ? ssq : 0.f, red, tid) + EPS);
        const float sc0 = 1.0f / sqrtf(block_sum(o0 ? ssqc : 0.f, red, tid) + EPS), sc1 = 1.0f / sqrtf(block_sum(o1 ? ssqc : 0.f, red, tid) + EPS);
        __syncthreads();
        fft_pass<false, 544>(buf, tid, (float)tid * (1.0f / 8192.0f));
        __syncthreads();
        fft_pass<false, 34>(buf, (tid >> 5) * 512 + (tid & 31), (float)(tid & 31) * (1.0f / 512.0f));
        __syncthreads();
        fft_pass<false, 2>(buf, (tid >> 1) * 32 + (tid & 1), (float)(tid & 1) * (1.0f / 32.0f));
        __syncthreads();
#pragma unroll
        for (int r = 0; r < 8; ++r) { LAS f32x4* pp = (LAS f32x4*)(buf + fphys(2 * tid) + 1088 * r); const f32x4 ab = *pp; *pp = (f32x4){ab.x + ab.z, ab.y + ab.w, ab.x - ab.z, ab.y - ab.w}; }
        __syncthreads();
        f32x2* d0 = KF + (size_t)c * 8192; f32x2* d1 = KF + (size_t)(1024 + c) * 8192;
#pragma unroll 4
        for (int i = 0; i < 16; ++i) { const int p = tid + 512 * i; const int f = (int)(__brev((unsigned)p) >> 19); const int pp = (int)(__brev((unsigned)((8192 - f) & 8191)) >> 19);
            const f32x2 z = buf[fphys(p)], zp = buf[fphys(pp)];
            d0[p] = (f32x2){(z.x + zp.x) * 0.5f * scl0, (z.y - zp.y) * 0.5f * scl0};
            d1[p] = (f32x2){(z.y + zp.y) * 0.5f * scl1, (zp.x - z.x) * 0.5f * scl1}; }
        for (int q = tid; q < 1024; q += 512) { const int od = q >> 8, m = q & 255; TAPC[((size_t)od * 1024 + c) * 256 + m] = ctap[q] * ((od < 2) ? sc0 : sc1); }
    }
}

__device__ __forceinline__ void ph_hyprep(const Args& A, int l, LAS unsigned char* lds, int tid) {
    LAS bf16* T = (LAS bf16*)lds;
    const bf16* Z = (const bf16*)(wsb() + WS_Z); bf16* HYT = (bf16*)(wsb() + WS_HYT);
    const float* cw = inp(I_HCW) + (size_t)l * 3 * 3072; const float* cb = inp(I_HCB) + (size_t)l * 3072;
    v4u pre[5];
#define HP_LOAD(u_) do { const int cg_ = (u_) % 12, tt_ = ((u_) / 12) & 63, b_ = (u_) / 768; \
        _Pragma("unroll") for (int e = 0; e < 5; ++e) { const int q = tid + 512 * e; const int r = q >> 5, ch8 = q & 31, t = tt_ * 64 - 1 + r; pre[e] = (v4u){0u, 0u, 0u, 0u}; \
            if (q < 66 * 32 && t >= 0 && t < SEQ) pre[e] = *(const v4u*)(Z + (size_t)(b_ * SEQ + t) * INW + C_HY + cg_ * 256 + ch8 * 8); } } while (0)
    int u = blockIdx.x;
    if (u < 3072) HP_LOAD(u);
    for (; u < 3072; u += gridDim.x) {
        const int cg = u % 12, tt = (u / 12) & 63, b = u / 768;
        __syncthreads();
#pragma unroll
        for (int e = 0; e < 5; ++e) { const int q = tid + 512 * e; if (q < 66 * 32) *(LAS v4u*)(T + (q >> 5) * 264 + (q & 31) * 8) = pre[e]; }
        __syncthreads();
        if (u + (int)gridDim.x < 3072) HP_LOAD(u + (int)gridDim.x);
        const int ch = tid & 255, half = tid >> 8, gch = cg * 256 + ch;
        const float w0 = cw[gch], w1 = cw[3072 + gch], w2 = cw[6144 + gch], bb = cb[gch];
        const int part = gch >> 10, c = gch & 1023;
        bf16* outp = HYT + ((size_t)(part * NB + b) * 1024 + c) * SEQ + tt * 64 + half * 32;
#pragma unroll
        for (int tq = 0; tq < 4; ++tq) { float vv[8];
#pragma unroll
            for (int e = 0; e < 8; ++e) { const int tl = half * 32 + tq * 8 + e;
                vv[e] = w0 * bf1(T[tl * 264 + ch]) + w1 * bf1(T[(tl + 1) * 264 + ch]) + w2 * bf1(T[(tl + 2) * 264 + ch]) + bb; }
            v4u w; w.x = pk2(vv[0], vv[1]); w.y = pk2(vv[2], vv[3]); w.z = pk2(vv[4], vv[5]); w.w = pk2(vv[6], vv[7]);
            *(v4u*)(outp + tq * 8) = w; }
    }
#undef HP_LOAD
}
__device__ __forceinline__ void ph_hyctx(const Args& A, int l, LAS unsigned char* lds, int tid) {
    const bf16* Z = (const bf16*)(wsb() + WS_Z); bf16* YS = (bf16*)(wsb() + WS_YS); const float* TAPC = (const float*)(psb(l & 1) + PS_TAPC);
    const float* cw = inp(I_HCW) + (size_t)l * 3 * 3072; const float* cb = inp(I_HCB) + (size_t)l * 3072; const float* hb = inp(I_HBIAS) + (size_t)l * 2 * 1024;
    const int ch = tid >> 6, q = tid & 63, t0 = 4 * q;
    LAS float* Y = (LAS float*)lds + ch * 1552; LAS float* Y1 = Y + 256; LAS float* G0 = Y + 512; LAS float* G1 = Y + 1032;
    LAS bf16* R = (LAS bf16*)((LAS float*)lds + 8 * 1552);
    for (int u = blockIdx.x; u < 512; u += gridDim.x) {
        const int b = u >> 7, cg8 = (u & 127) * 8, c = cg8 + ch;
        __syncthreads();
        for (int i = tid; i < 768; i += 512) { const int row = i / 3, part = i - row * 3; *(LAS v4u*)(R + row * 24 + part * 8) = *(const v4u*)(Z + (size_t)(ML + b * CL + row) * INW + C_HY + part * 1024 + cg8); }
#pragma unroll
        for (int r = 0; r < 4; ++r) { const int m = t0 + r;
            G0[m + 259] = TAPC[((size_t)(0 * 2 + 0) * 1024 + c) * 256 + m]; G1[m + 259] = TAPC[((size_t)(1 * 2 + 0) * 1024 + c) * 256 + m];
            if (m >= 1) { G0[259 - m] = TAPC[((size_t)(0 * 2 + 1) * 1024 + c) * 256 + m]; G1[259 - m] = TAPC[((size_t)(1 * 2 + 1) * 1024 + c) * 256 + m]; } }
        if (q == 0) { G0[515] = 0.f; G1[515] = 0.f; G0[516] = 0.f; G1[516] = 0.f; }
        __syncthreads();
        float pv[3][4];
#pragma unroll
        for (int part = 0; part < 3; ++part) { const int gch = part * 1024 + c; const float w0 = cw[gch], w1 = cw[3072 + gch], w2 = cw[6144 + gch], bb = cb[gch];
            float zz[6];
#pragma unroll
            for (int e = 0; e < 6; ++e) { const int t = t0 - 1 + e; zz[e] = (t >= 0 && t < CL) ? bf1(R[t * 24 + part * 8 + ch]) : 0.f; }
#pragma unroll
            for (int r = 0; r < 4; ++r) pv[part][r] = w0 * zz[r] + w1 * zz[r + 1] + w2 * zz[r + 2] + bb; }
        *(LAS f32x4*)(Y + t0) = (f32x4){pv[2][0], pv[2][1], pv[2][2], pv[2][3]};
        __syncthreads();
        float yprev[4] = {pv[2][0], pv[2][1], pv[2][2], pv[2][3]};
#pragma unroll
        for (int ord = 0; ord < 2; ++ord) {
            const LAS float* Ys = ord ? Y1 : Y; const LAS float* G = ord ? G1 : G0;
            float acc[4] = {0.f, 0.f, 0.f, 0.f};
#pragma unroll 4
            for (int sp = 0; sp < 64; ++sp) { const f32x4 yv = *(const LAS f32x4*)(Ys + 4 * sp); const LAS float* gp = G + 4 * (q - sp) + 256;
                const f32x4 ga = *(const LAS f32x4*)gp, gb = *(const LAS f32x4*)(gp + 4);
                const float g[8] = {ga.x, ga.y, ga.z, ga.w, gb.x, gb.y, gb.z, gb.w}; const float yy[4] = {yv.x, yv.y, yv.z, yv.w};
#pragma unroll
                for (int r = 0; r < 4; ++r)
#pragma unroll
                    for (int j = 0; j < 4; ++j) acc[r] += yy[j] * g[r - j + 3]; }
            const float bias = hb[ord * 1024 + c];
#pragma unroll
            for (int r = 0; r < 4; ++r) yprev[r] = pv[ord][r] * (acc[r] + bias * yprev[r]);
            if (ord == 0) { *(LAS f32x4*)(Y1 + t0) = (f32x4){yprev[0], yprev[1], yprev[2], yprev[3]}; __syncthreads(); }
        }
#pragma unroll
        for (int r = 0; r < 4; ++r) YS[(size_t)(ML + b * CL + t0 + r) * 1024 + c] = (bf16)f2bf(yprev[r]);
    }
}
__device__ __forceinline__ void unpack8(v4u v, float (&x)[8]) { x[0] = bflo(v.x); x[1] = bfhi(v.x); x[2] = bflo(v.y); x[3] = bfhi(v.y); x[4] = bflo(v.z); x[5] = bfhi(v.z); x[6] = bflo(v.w); x[7] = bfhi(v.w); }
__device__ __forceinline__ v4u pack8(const float (&x)[8]) { v4u w; w.x = pk2(x[0], x[1]); w.y = pk2(x[2], x[3]); w.z = pk2(x[4], x[5]); w.w = pk2(x[6], x[7]); return w; }
__device__ __forceinline__ void rope8(float (&lo)[8], float (&hi)[8], const f32x2* rt) {
#pragma unroll
    for (int e = 0; e < 8; ++e) { const f32x2 cs = rt[e]; const float a = lo[e], b = hi[e]; lo[e] = a * cs.x - b * cs.y; hi[e] = b * cs.x + a * cs.y; }
}
__device__ __forceinline__ void vt_store(LAS bf16* Vt, int ld, int d0, int r, v4u vv) {
    Vt[(d0 + 0) * ld + r] = (bf16)(vv.x & 0xffffu); Vt[(d0 + 1) * ld + r] = (bf16)(vv.x >> 16);
    Vt[(d0 + 2) * ld + r] = (bf16)(vv.y & 0xffffu); Vt[(d0 + 3) * ld + r] = (bf16)(vv.y >> 16);
    Vt[(d0 + 4) * ld + r] = (bf16)(vv.z & 0xffffu); Vt[(d0 + 5) * ld + r] = (bf16)(vv.z >> 16);
    Vt[(d0 + 6) * ld + r] = (bf16)(vv.w & 0xffffu); Vt[(d0 + 7) * ld + r] = (bf16)(vv.w >> 16);
}
constexpr float LOG2E = 1.4426950408889634f;
typedef short s16x4 __attribute__((ext_vector_type(4)));
__device__ __forceinline__ bf16x8 tr_frag(const LAS bf16* tile, int ld, int r0, int r1, int c0, int li) {
    const s16x4 lo = __builtin_amdgcn_ds_read_tr16_b64_v4i16((LAS s16x4*)(tile + (r0 + (li >> 2)) * ld + c0 + 4 * (li & 3)));
    const s16x4 hi = __builtin_amdgcn_ds_read_tr16_b64_v4i16((LAS s16x4*)(tile + (r1 + (li >> 2)) * ld + c0 + 4 * (li & 3)));
    return (bf16x8){lo.x, lo.y, lo.z, lo.w, hi.x, hi.y, hi.z, hi.w};
}
__device__ __forceinline__ void ph_ret1(const Args& A, int l, int nctx_units, LAS unsigned char* lds, int tid) {
    LAS bf16* Kf = (LAS bf16*)lds; LAS bf16* Kb = Kf + 128 * 72; LAS bf16* Vs = Kb + 128 * 72;
    const bf16* Z = (const bf16*)(wsb() + WS_Z); float* KV = (float*)(wsb() + WS_KV); const f32x2* rope = (const f32x2*)(wsb() + WS_ROPE);
    const int lane = tid & 63, w = tid >> 6, g = lane >> 4, li = lane & 15;
    const int tok = tid >> 2, pp = tid & 3, a = (pp & 1) + ((pp >> 1) << 2);
    const int nunits = 1024 + nctx_units;
    v4u pk[2], pv[4];
#define R1_DEC(uid_, b_, h_, n_, ci_, m0_, isc_) const bool isc_ = (uid_) >= 1024; int b_, h_, n_, ci_; size_t m0_; \
        if (!isc_) { b_ = (uid_) >> 8; h_ = ((uid_) >> 5) & 7; n_ = (uid_) & 31; m0_ = (size_t)b_ * SEQ + n_ * 128; ci_ = 2 + n_; } \
        else { const int i_ = (uid_) - 1024; b_ = i_ >> 4; h_ = (i_ >> 1) & 7; n_ = i_ & 1; m0_ = (size_t)ML + b_ * CL + n_ * 128; ci_ = n_; }
#define R1_LOAD(uid_) do { R1_DEC(uid_, b2, h2, n2, ci2, m02, isc2) (void)ci2; (void)n2; (void)isc2; const bf16* kr = Z + (m02 + tok) * INW + C_RK + h2 * 64; pk[0] = *(const v4u*)(kr + 8 * a); pk[1] = *(const v4u*)(kr + 8 * a + 16); \
        _Pragma("unroll") for (int e = 0; e < 4; ++e) { const int q = tid + 512 * e; pv[e] = *(const v4u*)(Z + (m02 + (q >> 4)) * INW + C_RV + h2 * 128 + (q & 15) * 8); } } while (0)
    int uid = blockIdx.x;
    if (uid < nunits) R1_LOAD(uid);
    for (; uid < nunits; uid += gridDim.x) {
        R1_DEC(uid, b, h, n, ci, m0, isc) (void)m0;
        const float lgf = inp(I_RDEC)[(l * 2 + 0) * 8 + h] * LOG2E, lgb = inp(I_RDEC)[(l * 2 + 1) * 8 + h] * LOG2E;
        __syncthreads();
        { float lo[8], hi[8]; unpack8(pk[0], lo); unpack8(pk[1], hi);
            if (!isc) { const int t = n * 128 + tok; const int pos = (a < 4) ? (t >> 6) : (t & 63); rope8(lo, hi, rope + pos * 16 + 8 * (a & 1)); }
            const float zf = ex2(lgf * (float)(127 - tok)) * 0.125f, zb = ex2(lgb * (float)tok) * 0.125f;
            float lf[8], hf[8];
#pragma unroll
            for (int e = 0; e < 8; ++e) { lf[e] = lo[e] * zf; hf[e] = hi[e] * zf; lo[e] *= zb; hi[e] *= zb; }
            *(LAS v4u*)(Kf + tok * 72 + 8 * a) = pack8(lf); *(LAS v4u*)(Kf + tok * 72 + 8 * a + 16) = pack8(hf);
            *(LAS v4u*)(Kb + tok * 72 + 8 * a) = pack8(lo); *(LAS v4u*)(Kb + tok * 72 + 8 * a + 16) = pack8(hi); }
#pragma unroll
        for (int e = 0; e < 4; ++e) { const int q = tid + 512 * e; *(LAS v4u*)(Vs + (q >> 4) * 144 + (q & 15) * 8) = pv[e]; }
        __syncthreads();
        if (uid + (int)gridDim.x < nunits) R1_LOAD(uid + (int)gridDim.x);
        bf16x8 af[4];
#pragma unroll
        for (int ks = 0; ks < 4; ++ks) af[ks] = tr_frag(Vs, 144, 32 * ks + 8 * g, 32 * ks + 8 * g + 4, 16 * w, li);
#pragma unroll
        for (int dir = 0; dir < 2; ++dir) { const LAS bf16* KT = dir ? Kb : Kf;
            float* dst = KV + ((size_t)((b * 8 + h) * 2 + dir) * 34 + ci) * 8192;
#pragma unroll
            for (int nc = 0; nc < 4; ++nc) { f32x4 acc = (f32x4){0.f, 0.f, 0.f, 0.f};
#pragma unroll
                for (int ks = 0; ks < 4; ++ks) acc = mfma16(af[ks], tr_frag(KT, 72, 32 * ks + 8 * g, 32 * ks + 8 * g + 4, 16 * nc, li), acc);
#pragma unroll
                for (int j = 0; j < 4; ++j) dst[(16 * w + 4 * g + j) * 64 + 16 * nc + li] = acc[j]; } }
    }
#undef R1_LOAD
}
__device__ __forceinline__ void ph_natt(const Args& A, int l, int mode, LAS unsigned char* lds, int tid) {
    LAS bf16* Qs = (LAS bf16*)lds; LAS bf16* KV0 = (LAS bf16*)lds; LAS float* rpbs = (LAS float*)(lds + 2 * (64 * 136 + 64 * 144) * 2);
    const bf16* Z = (const bf16*)(wsb() + WS_Z); bf16* YS = (bf16*)(wsb() + WS_YS) + (size_t)2 * MT * 1024;
    const int lane = tid & 63, w = tid >> 6, g = lane >> 4, li = lane & 15;
    const float SCALE = 0.08838834764831845f * LOG2E;
    const int sr0 = tid >> 4, sch = tid & 15;
    const int ufirst = mode ? ((int)blockIdx.x - ((int)gridDim.x - 32)) : (int)blockIdx.x, ucount = mode ? 32 : 512;
    if (ufirst < 0) return;
    for (int uid = ufirst; uid < ucount; uid += (mode ? 32 : (int)gridDim.x)) {
        int b, h, rq = 0; size_t m0;
        if (!mode) { b = uid >> 7; h = (uid >> 4) & 7; rq = uid & 15; m0 = (size_t)b * SEQ + rq * 256; }
        else { b = uid >> 3; h = uid & 7; m0 = (size_t)ML + b * CL; }
        const size_t mc0 = (size_t)ML + b * CL;
        const int qr = 4 * rq + (w >> 1), rs_w = min(max(qr - 4, 0), 56);
        const int kr_lo = min(max(4 * rq - 4, 0), 56), kr_hi = min(max(4 * rq - 1, 0), 56) + 7;
        const int nwin = mode ? 0 : (kr_hi - kr_lo + 1), ntile = nwin + 4;
        int qc[2], cs[2], nlo_w[2], nhi_w[2];
#pragma unroll
        for (int i = 0; i < 2; ++i) { const int cw = 2 * (w & 1) + i; qc[i] = 16 * cw + li; cs[i] = min(max(qc[i] - 8, 0), 48);
            nlo_w[i] = (cw <= 1) ? 0 : cw - 1; nhi_w[i] = (cw == 0) ? 1 : ((cw == 3) ? 3 : cw + 1); }
        v4u kreg[2], vreg[2];
#define NA_LOAD(t_) do { const int t__ = (t_); const size_t mk = (t__ < nwin) ? ((size_t)b * SEQ + (kr_lo + t__) * 64) : (mc0 + (t__ - nwin) * 64); \
            _Pragma("unroll") for (int e = 0; e < 2; ++e) { const bf16* zr = Z + (mk + sr0 + 32 * e) * INW + h * 128 + sch * 8; kreg[e] = *(const v4u*)(zr + C_NK); vreg[e] = *(const v4u*)(zr + C_NV); } } while (0)
#define NA_STORE(buf_) do { LAS bf16* Kd = KV0 + (buf_) * (64 * 136 + 64 * 144); LAS bf16* Vd = Kd + 64 * 136; \
            _Pragma("unroll") for (int e = 0; e < 2; ++e) { *(LAS v4u*)(Kd + (sr0 + 32 * e) * 136 + sch * 8) = kreg[e]; *(LAS v4u*)(Vd + (sr0 + 32 * e) * 144 + sch * 8) = vreg[e]; } } while (0)
        __syncthreads();
        NA_LOAD(0);
        for (int q = tid; q < 4096; q += 512) { const int r = q >> 4, chn = q & 15; *(LAS v4u*)(Qs + r * 136 + chn * 8) = *(const v4u*)(Z + (m0 + r) * INW + C_NQ + h * 128 + chn * 8); }
        if (!mode) for (int i = tid; i < 465; i += 512) rpbs[i] = inp(I_RPB)[((size_t)l * 8 + h) * 465 + i] * LOG2E;
        __syncthreads();
        bf16x8 qf[2][4];
#pragma unroll
        for (int i = 0; i < 2; ++i)
#pragma unroll
            for (int ks = 0; ks < 4; ++ks) qf[i][ks] = *(const LAS bf16x8*)(Qs + (32 * w + 16 * i + li) * 136 + 32 * ks + 8 * g);
        __syncthreads();
        NA_STORE(0);
        __syncthreads();
        f32x4 o[2][8];
#pragma unroll
        for (int i = 0; i < 2; ++i)
#pragma unroll
            for (int nd = 0; nd < 8; ++nd) o[i][nd] = (f32x4){0.f, 0.f, 0.f, 0.f};
        float mrun[2] = {-1e30f, -1e30f}, lrun[2] = {0.f, 0.f};
        for (int t = 0; t < ntile; ++t) {
            const bool win = t < nwin; const int kr = kr_lo + t;
            if (t + 1 < ntile) NA_LOAD(t + 1);
            const LAS bf16* Ks = KV0 + (t & 1) * (64 * 136 + 64 * 144); const LAS bf16* Vs = Ks + 64 * 136;
            const bool active = !win || (kr >= rs_w && kr <= rs_w + 7);
            if (active) {
                const int nlo0 = win ? nlo_w[0] : 0, nhi0 = win ? nhi_w[0] : 3, nlo1 = win ? nlo_w[1] : 0, nhi1 = win ? nhi_w[1] : 3;
                f32x4 s[2][4];
#pragma unroll
                for (int n = 0; n < 4; ++n) { s[0][n] = (f32x4){0.f, 0.f, 0.f, 0.f}; s[1][n] = (f32x4){0.f, 0.f, 0.f, 0.f};
                    const bool u0 = (n >= nlo0 && n <= nhi0), u1 = (n >= nlo1 && n <= nhi1);
                    if (u0 || u1) {
#pragma unroll
                        for (int ks = 0; ks < 4; ++ks) { const bf16x8 kf = *(const LAS bf16x8*)(Ks + (16 * n + li) * 136 + 32 * ks + 8 * g);
                            if (u0) s[0][n] = mfma16(kf, qf[0][ks], s[0][n]);
                            if (u1) s[1][n] = mfma16(kf, qf[1][ks], s[1][n]); } } }
                bf16x8 pf[2][2];
#pragma unroll
                for (int i = 0; i < 2; ++i) {
                    float tmax = -1e30f;
#pragma unroll
                    for (int n = 0; n < 4; ++n)
#pragma unroll
                        for (int j = 0; j < 4; ++j) { float v = s[i][n][j] * SCALE;
                            if (win) { const int kc = 16 * n + 4 * g + j; const bool valid = (kc >= cs[i]) && (kc < cs[i] + 16);
                                const int dc = min(max(kc - qc[i] + 15, 0), 30), dr = min(max(kr - qr + 7, 0), 14);
                                v = valid ? v + rpbs[dr * 31 + dc] : -1e30f; }
                            s[i][n][j] = v; tmax = fmaxf(tmax, v); }
                    tmax = fmaxf(tmax, __shfl_xor(tmax, 16)); tmax = fmaxf(tmax, __shfl_xor(tmax, 32));
                    const bool upd = tmax > mrun[i] + 8.0f;
                    const float mnew = upd ? tmax : mrun[i];
                    float psum = 0.f;
#pragma unroll
                    for (int n = 0; n < 4; ++n)
#pragma unroll
                        for (int j = 0; j < 4; ++j) { const float pv = ex2(s[i][n][j] - mnew); s[i][n][j] = pv; psum += pv; }
                    psum += __shfl_xor(psum, 16); psum += __shfl_xor(psum, 32);
                    if (__any(upd)) { const float alpha = ex2(mrun[i] - mnew); lrun[i] *= alpha;
#pragma unroll
                        for (int nd = 0; nd < 8; ++nd) o[i][nd] = o[i][nd] * alpha; }
                    lrun[i] += psum; mrun[i] = mnew;
#pragma unroll
                    for (int kk = 0; kk < 2; ++kk) pf[i][kk] = mk8(pk2(s[i][2 * kk][0], s[i][2 * kk][1]), pk2(s[i][2 * kk][2], s[i][2 * kk][3]), pk2(s[i][2 * kk + 1][0], s[i][2 * kk + 1][1]), pk2(s[i][2 * kk + 1][2], s[i][2 * kk + 1][3]));
                }
#pragma unroll
                for (int kk = 0; kk < 2; ++kk) { const bool u0 = (2 * kk + 1 >= nlo0 && 2 * kk <= nhi0), u1 = (2 * kk + 1 >= nlo1 && 2 * kk <= nhi1);
                    if (u0 || u1) {
#pragma unroll
                        for (int nd = 0; nd < 8; ++nd) { const bf16x8 vf = tr_frag(Vs, 144, 32 * kk + 4 * g, 32 * kk + 16 + 4 * g, 16 * nd, li);
                            if (u0) o[0][nd] = mfma16(vf, pf[0][kk], o[0][nd]);
                            if (u1) o[1][nd] = mfma16(vf, pf[1][kk], o[1][nd]); } } }
            }
            if (t + 1 < ntile) NA_STORE((t + 1) & 1);
            __syncthreads();
        }
#undef NA_LOAD
#undef NA_STORE
#pragma unroll
        for (int i = 0; i < 2; ++i) { const float inv = 1.0f / lrun[i]; const size_t mrow = m0 + 32 * w + 16 * i + li;
#pragma unroll
            for (int nd = 0; nd < 8; ++nd) { v2u wv; wv.x = pk2(o[i][nd][0] * inv, o[i][nd][1] * inv); wv.y = pk2(o[i][nd][2] * inv, o[i][nd][3] * inv);
                *(v2u*)(YS + mrow * 1024 + h * 128 + 16 * nd + 4 * g) = wv; } }
    }
}

__device__ __forceinline__ void ph_hyfft(const Args& A, int l, LAS unsigned char* lds, int tid) {
    LAS f32x2* bufa = (LAS f32x2*)lds; LAS f32x2* bufb = (LAS f32x2*)(lds + FFT_LDS_BYTES);
    const bf16* HYT = (const bf16*)(wsb() + WS_HYT); bf16* YT = (bf16*)(wsb() + WS_YT); const f32x2* KF = (const f32x2*)(psb(l & 1) + PS_KF);
    const float* hb = inp(I_HBIAS) + (size_t)l * 2 * 1024;
    const int baseB = (tid >> 5) * 512 + (tid & 31), baseC = (tid >> 1) * 32 + (tid & 1);
    const float thA = (float)tid * (1.0f / 8192.0f), thB = (float)(tid & 31) * (1.0f / 512.0f), thC = (float)(tid & 1) * (1.0f / 32.0f);
    const size_t bstr = (size_t)1024 * SEQ;
#define HF_PTR(c_, part_, b_) (HYT + ((size_t)((part_) * NB + (b_)) * 1024 + (c_)) * SEQ)
    for (int c = blockIdx.x; c < 1024; c += gridDim.x) {
        float y[4][8];
#pragma unroll
        for (int b = 0; b < 4; ++b) { const bf16* vp = HF_PTR(c, 2, b);
#pragma unroll
            for (int i = 0; i < 8; ++i) y[b][i] = bf1(vp[tid + 512 * i]); }
#pragma unroll
        for (int ord = 0; ord < 2; ++ord) {
            f32x4 kreg[8]; bf16 xg[4][8];
            { const f32x4* kf = (const f32x4*)(KF + (size_t)(ord * 1024 + c) * 8192);
#pragma unroll
                for (int r = 0; r < 8; ++r) kreg[r] = kf[tid + 512 * r];
#pragma unroll
                for (int b = 0; b < 4; ++b) { const bf16* xp = HF_PTR(c, ord, b);
#pragma unroll
                    for (int i = 0; i < 8; ++i) xg[b][i] = xp[tid + 512 * i]; } }
            { f32x2 xa[16], xb[16];
#pragma unroll
                for (int k = 0; k < 8; ++k) { xa[k] = (f32x2){y[0][k], y[1][k]}; xa[k + 8] = (f32x2){0.f, 0.f}; xb[k] = (f32x2){y[2][k], y[3][k]}; xb[k + 8] = (f32x2){0.f, 0.f}; }
                dif16<true>(xa, thA); dif16<true>(xb, thA);
                __syncthreads();
#pragma unroll
                for (int k = 0; k < 16; ++k) { bufa[fphys(tid) + 544 * k] = xa[k]; bufb[fphys(tid) + 544 * k] = xb[k]; } }
            __syncthreads();
            fft_pass2<false, 34>(bufa, bufb, baseB, thB);
            __syncthreads();
            fft_pass2<false, 2>(bufa, bufb, baseC, thC);
            __syncthreads();
#pragma unroll
            for (int r = 0; r < 8; ++r) { const f32x4 kk = kreg[r];
#pragma unroll
                for (int q = 0; q < 2; ++q) { LAS f32x4* pp = (LAS f32x4*)((q ? bufb : bufa) + fphys(2 * tid) + 1088 * r); const f32x4 ab = *pp;
                    const float ax = ab.x + ab.z, ay = ab.y + ab.w, bx = ab.x - ab.z, by = ab.y - ab.w;
                    const float px = ax * kk.x - ay * kk.y, py = ax * kk.y + ay * kk.x, qx = bx * kk.z - by * kk.w, qy = bx * kk.w + by * kk.z;
                    *pp = (f32x4){px + qx, py + qy, px - qx, py - qy}; } }
            __syncthreads();
            fft_pass2<true, 2>(bufa, bufb, baseC, thC);
            __syncthreads();
            fft_pass2<true, 34>(bufa, bufb, baseB, thB);
            __syncthreads();
            { f32x2 xa[16], xb[16];
#pragma unroll
                for (int k = 0; k < 16; ++k) { xa[k] = bufa[fphys(tid) + 544 * k]; xb[k] = bufb[fphys(tid) + 544 * k]; }
                idit16(xa, thA); idit16(xb, thA);
                const float bias = hb[ord * 1024 + c];
#pragma unroll
                for (int k = 0; k < 8; ++k) { y[0][k] = bf1(xg[0][k]) * (xa[k].x + bias * y[0][k]); y[1][k] = bf1(xg[1][k]) * (xa[k].y + bias * y[1][k]);
                    y[2][k] = bf1(xg[2][k]) * (xb[k].x + bias * y[2][k]); y[3][k] = bf1(xg[3][k]) * (xb[k].y + bias * y[3][k]); } }
        }
#pragma unroll
        for (int b = 0; b < 4; ++b) { bf16* o0 = YT + ((size_t)b * 1024 + c) * SEQ;
#pragma unroll
            for (int i = 0; i < 8; ++i) o0[tid + 512 * i] = (bf16)f2bf(y[b][i]); }
    }
#undef HF_PTR
    (void)bstr;
}
__device__ __forceinline__ void ph_scan(const Args& A, int l, int tid) {
    float* KV = (float*)(wsb() + WS_KV);
    for (int gt = blockIdx.x * 512 + tid; gt < NB * 8 * 2 * 2048; gt += gridDim.x * 512) {
        const int bhd = gt >> 11, e4 = gt & 2047, dir = bhd & 1, h = (bhd >> 1) & 7;
        const float gC = ex2(inp(I_RDEC)[(l * 2 + dir) * 8 + h] * LOG2E * 128.0f);
        f32x4* base = (f32x4*)(KV + (size_t)bhd * 34 * 8192) + e4;
        f32x4 s = (f32x4){0.f, 0.f, 0.f, 0.f};
#pragma unroll 1
        for (int sb8 = 0; sb8 < 34; sb8 += 8) {
            f32x4 tv[8];
#pragma unroll
            for (int k = 0; k < 8; ++k) { const int step = min(sb8 + k, 33); const int ci = (dir == 0) ? step : (step == 0 ? 1 : (step == 1 ? 0 : 35 - step)); tv[k] = base[(size_t)ci * 2048]; }
#pragma unroll
            for (int k = 0; k < 8; ++k) { const int step = sb8 + k; if (step < 34) { const int ci = (dir == 0) ? step : (step == 0 ? 1 : (step == 1 ? 0 : 35 - step)); base[(size_t)ci * 2048] = s; s = s * gC + tv[k]; } } }
    }
}

__device__ __forceinline__ void ph_hypost(const Args& A, LAS unsigned char* lds, int tid) {
    LAS bf16* T = (LAS bf16*)lds;
    const bf16* YT = (const bf16*)(wsb() + WS_YT); bf16* YS = (bf16*)(wsb() + WS_YS);
    for (int u = blockIdx.x; u < 1024; u += gridDim.x) {
        const int cg = u & 3, tt = (u >> 2) & 63, b = u >> 8;
        __syncthreads();
        for (int q = tid; q < 2048; q += 512) { const int c = q >> 3, t8 = q & 7;
            *(LAS v4u*)(T + c * 72 + t8 * 8) = *(const v4u*)(YT + ((size_t)b * 1024 + cg * 256 + c) * SEQ + tt * 64 + t8 * 8); }
        __syncthreads();
        const int t = tid >> 3, c32 = tid & 7;
#pragma unroll
        for (int q = 0; q < 4; ++q) { const int cb = c32 * 32 + q * 8; v4u w;
            w.x = (unsigned)T[(cb + 0) * 72 + t] | ((unsigned)T[(cb + 1) * 72 + t] << 16); w.y = (unsigned)T[(cb + 2) * 72 + t] | ((unsigned)T[(cb + 3) * 72 + t] << 16);
            w.z = (unsigned)T[(cb + 4) * 72 + t] | ((unsigned)T[(cb + 5) * 72 + t] << 16); w.w = (unsigned)T[(cb + 6) * 72 + t] | ((unsigned)T[(cb + 7) * 72 + t] << 16);
            *(v4u*)(YS + (size_t)(b * SEQ + tt * 64 + t) * 1024 + cg * 256 + cb) = w; }
    }
}
__device__ __forceinline__ void ph_ret3(const Args& A, int l, int nctx_units, LAS unsigned char* lds, int tid) {
    LAS bf16* Qs = (LAS bf16*)lds; LAS bf16* Ks = Qs + 128 * 72; LAS bf16* Vs = Ks + 128 * 72; LAS bf16* Sf = Vs + 128 * 144; LAS bf16* Sb = Sf + 128 * 72;
    const bf16* Z = (const bf16*)(wsb() + WS_Z); const float* KV = (const float*)(wsb() + WS_KV); const f32x2* rope = (const f32x2*)(wsb() + WS_ROPE);
    bf16* YS = (bf16*)(wsb() + WS_YS) + (size_t)MT * 1024;
    const int lane = tid & 63, w = tid >> 6, g = lane >> 4, li = lane & 15;
    const int tok = tid >> 2, pp = tid & 3, a = (pp & 1) + ((pp >> 1) << 2);
    const int nunits = 1024 + nctx_units;
    v4u pk[2], pv[4];
#define R3_LOAD(uid_) do { R1_DEC(uid_, b2, h2, n2, ci2, m02, isc2) (void)n2; (void)isc2; const bf16* qr = Z + (m02 + tok) * INW + C_RQ + h2 * 64; const bf16* kr = Z + (m02 + tok) * INW + C_RK + h2 * 64; \
        (void)qr; pk[0] = *(const v4u*)(kr + 8 * a); pk[1] = *(const v4u*)(kr + 8 * a + 16); \
        (void)ci2; _Pragma("unroll") for (int e = 0; e < 4; ++e) { const int q = tid + 512 * e; pv[e] = *(const v4u*)(Z + (m02 + (q >> 4)) * INW + C_RV + h2 * 128 + (q & 15) * 8); } } while (0)
    int uid = blockIdx.x;
    if (uid < nunits) R3_LOAD(uid);
    for (; uid < nunits; uid += gridDim.x) {
        R1_DEC(uid, b, h, n, ci, m0, isc)
        const float lgf = inp(I_RDEC)[(l * 2 + 0) * 8 + h] * LOG2E, lgb = inp(I_RDEC)[(l * 2 + 1) * 8 + h] * LOG2E;
        __syncthreads();
        { const int t = n * 128 + tok; const int pos = (a < 4) ? (t >> 6) : (t & 63); const f32x2* rt = rope + pos * 16 + 8 * (a & 1);
            float lo[8], hi[8];
            { const bf16* qr = Z + (m0 + tok) * INW + C_RQ + h * 64; unpack8(*(const v4u*)(qr + 8 * a), lo); unpack8(*(const v4u*)(qr + 8 * a + 16), hi); }
            if (!isc) rope8(lo, hi, rt);
            *(LAS v4u*)(Qs + tok * 72 + 8 * a) = pack8(lo); *(LAS v4u*)(Qs + tok * 72 + 8 * a + 16) = pack8(hi);
            unpack8(pk[0], lo); unpack8(pk[1], hi);
            if (!isc) rope8(lo, hi, rt);
#pragma unroll
            for (int e = 0; e < 8; ++e) { lo[e] *= 0.125f; hi[e] *= 0.125f; }
            *(LAS v4u*)(Ks + tok * 72 + 8 * a) = pack8(lo); *(LAS v4u*)(Ks + tok * 72 + 8 * a + 16) = pack8(hi); }
#pragma unroll
        for (int e = 0; e < 4; ++e) { const int q = tid + 512 * e; *(LAS v4u*)(Vs + (q >> 4) * 144 + (q & 15) * 8) = pv[e]; }
#pragma unroll
        for (int dir = 0; dir < 2; ++dir) { LAS bf16* S = dir ? Sb : Sf; const f32x4* src = (const f32x4*)(KV + ((size_t)((b * 8 + h) * 2 + dir) * 34 + ci) * 8192);
#pragma unroll
            for (int e = 0; e < 4; ++e) { const int q = tid + 512 * e; const f32x4 v = src[q]; v2u wv; wv.x = pk2(v.x, v.y); wv.y = pk2(v.z, v.w); *(LAS v2u*)(S + (q >> 4) * 72 + (q & 15) * 4) = wv; } }
        __syncthreads();
        if (uid + (int)gridDim.x < nunits) R3_LOAD(uid + (int)gridDim.x);
        const int iq = 16 * w + li; const size_t mrow = m0 + iq;
        bf16x8 qf[2];
#pragma unroll
        for (int ks = 0; ks < 2; ++ks) qf[ks] = *(const LAS bf16x8*)(Qs + iq * 72 + 32 * ks + 8 * g);
        f32x4 s[8];
#pragma unroll
        for (int nn = 0; nn < 8; ++nn) { s[nn] = (f32x4){0.f, 0.f, 0.f, 0.f};
#pragma unroll
            for (int ks = 0; ks < 2; ++ks) s[nn] = mfma16(*(const LAS bf16x8*)(Ks + (16 * nn + li) * 72 + 32 * ks + 8 * g), qf[ks], s[nn]);
#pragma unroll
            for (int j = 0; j < 4; ++j) { const int d = iq - (16 * nn + 4 * g + j); s[nn][j] *= (d >= 0) ? ex2(lgf * (float)d) : ex2(lgb * (float)(-d)); } }
        f32x4 o[8];
#pragma unroll
        for (int nd = 0; nd < 8; ++nd) o[nd] = (f32x4){0.f, 0.f, 0.f, 0.f};
#pragma unroll
        for (int kk = 0; kk < 4; ++kk) {
            const bf16x8 pf = mk8(pk2(s[2 * kk][0], s[2 * kk][1]), pk2(s[2 * kk][2], s[2 * kk][3]), pk2(s[2 * kk + 1][0], s[2 * kk + 1][1]), pk2(s[2 * kk + 1][2], s[2 * kk + 1][3]));
#pragma unroll
            for (int nd = 0; nd < 8; ++nd) o[nd] = mfma16(tr_frag(Vs, 144, 32 * kk + 4 * g, 32 * kk + 16 + 4 * g, 16 * nd, li), pf, o[nd]); }
        v2u gq[8];
#pragma unroll
        for (int nd = 0; nd < 8; ++nd) gq[nd] = *(const v2u*)(Z + mrow * INW + C_RG + h * 128 + 16 * nd + 4 * g);
        const float xif = ex2(lgf * (float)(iq + 1)), xib = ex2(lgb * (float)(128 - iq));
        float ss = 0.f;
#pragma unroll
        for (int nd = 0; nd < 8; ++nd) { f32x4 tf = (f32x4){0.f, 0.f, 0.f, 0.f}, tb = (f32x4){0.f, 0.f, 0.f, 0.f};
#pragma unroll
            for (int ks = 0; ks < 2; ++ks) { tf = mfma16(*(const LAS bf16x8*)(Sf + (16 * nd + li) * 72 + 32 * ks + 8 * g), qf[ks], tf);
                tb = mfma16(*(const LAS bf16x8*)(Sb + (16 * nd + li) * 72 + 32 * ks + 8 * g), qf[ks], tb); }
            o[nd] = o[nd] + tf * xif + tb * xib;
            ss += (o[nd][0] * o[nd][0] + o[nd][1] * o[nd][1]) + (o[nd][2] * o[nd][2] + o[nd][3] * o[nd][3]); }
        ss += __shfl_xor(ss, 16); ss += __shfl_xor(ss, 32);
        const float rn = 1.0f / sqrtf(ss * (1.0f / 128.0f) + EPS);
#pragma unroll
        for (int nd = 0; nd < 8; ++nd) { const int dv = 16 * nd + 4 * g; const v2u gv = gq[nd];
            const float g0 = bflo(gv.x), g1 = bfhi(gv.x), g2 = bflo(gv.y), g3 = bfhi(gv.y);
            v2u wv; wv.x = pk2(g0 * __builtin_amdgcn_rcpf(1.0f + __expf(-g0)) * o[nd][0] * rn, g1 * __builtin_amdgcn_rcpf(1.0f + __expf(-g1)) * o[nd][1] * rn);
            wv.y = pk2(g2 * __builtin_amdgcn_rcpf(1.0f + __expf(-g2)) * o[nd][2] * rn, g3 * __builtin_amdgcn_rcpf(1.0f + __expf(-g3)) * o[nd][3] * rn);
            *(v2u*)(YS + mrow * 1024 + h * 128 + dv) = wv; }
    }
#undef R3_LOAD
#undef R1_DEC
}

__device__ __forceinline__ float gelu_fx(float x) { const float x2 = x * x; const float arg = x * (x2 * (-2.0f * 1.4426950408889634f * 0.7978845608028654f * 0.044715f) + (-2.0f * 1.4426950408889634f * 0.7978845608028654f));
    return x * __builtin_amdgcn_rcpf(1.0f + __builtin_amdgcn_exp2f(arg)); }
__device__ __forceinline__ void ph_ffnfix(const Args& A, int l, int Mrows, int tid) {
    const bf16* SA = (const bf16*)(wsb() + WS_SA); const bf16* SB = (const bf16*)(wsb() + WS_SB); bf16* U = (bf16*)(wsb() + WS_U);
    const float* cw = inp(I_FFCW) + (size_t)l * 3 * DFF; const float* cb = inp(I_FFCB) + (size_t)l * DFF;
    const int nblk = Mrows / 64;
    for (int u = blockIdx.x; u < nblk * 2; u += gridDim.x) {
        const int blk = u >> 1, hi = u & 1, R = blk * 64 + (hi ? 63 : 0);
        const bool seq_first = (R < ML) ? ((R & (SEQ - 1)) == 0) : ((R & (CL - 1)) == 0), seq_last = (R < ML) ? ((R & (SEQ - 1)) == SEQ - 1) : ((R & (CL - 1)) == CL - 1);
        const bf16* pprev = hi ? SA + ((size_t)blk * 4 + 2) * DFF : SA + ((size_t)(blk - 1) * 4 + 3) * DFF;
        const bf16* pcur = SA + ((size_t)blk * 4 + (hi ? 3 : 0)) * DFF;
        const bf16* pnext = hi ? SA + ((size_t)(blk + 1) * 4 + 0) * DFF : SA + ((size_t)blk * 4 + 1) * DFF;
        const bf16* pb = SB + ((size_t)blk * 2 + hi) * DFF;
        const bool zp = (!hi && seq_first), zn = (hi && seq_last);
        for (int q = tid; q < DFF / 8; q += 512) { const int f = q * 8;
            float am[8], a0[8], aq[8], bg[8]; const v4u z4 = (v4u){0u, 0u, 0u, 0u};
            unpack8(zp ? z4 : *(const v4u*)(pprev + f), am); unpack8(*(const v4u*)(pcur + f), a0); unpack8(zn ? z4 : *(const v4u*)(pnext + f), aq); unpack8(*(const v4u*)(pb + f), bg);
            float r[8];
#pragma unroll
            for (int e = 0; e < 8; ++e) r[e] = gelu_fx(cw[f + e] * am[e] + cw[DFF + f + e] * a0[e] + cw[2 * DFF + f + e] * aq[e] + cb[f + e]) * bg[e];
            *(v4u*)(U + (size_t)R * DFF + f) = pack8(r); }
    }
}
__device__ __forceinline__ void ph_final(const Args& A, int wave, int lane) {
    const int gw = blockIdx.x * NWAVES + wave, NGW = gridDim.x * NWAVES; const float* g = inp(I_GF);
    for (int m = gw; m < ML; m += NGW) { float* xr = outb() + (size_t)m * D; f32x4 v[8]; float ss = 0.f;
#pragma unroll
        for (int j = 0; j < 8; ++j) { v[j] = *(const f32x4*)(xr + (lane + 64 * j) * 4); ss += (v[j].x * v[j].x + v[j].y * v[j].y) + (v[j].z * v[j].z + v[j].w * v[j].w); }
        const float rstd = 1.0f / sqrtf(wave_sum(ss) * (1.0f / D) + EPS);
#pragma unroll
        for (int j = 0; j < 8; ++j) { const int idx = (lane + 64 * j) * 4; *(f32x4*)(xr + idx) = v[j] * rstd * *(const f32x4*)(g + idx); }
    }
}
#ifndef F_ALIGN
#define F_ALIGN PG8_ALIGN
#endif
#ifndef F_SP2
#define F_SP2 PG8_SP2
#endif
#ifndef SKEW_US
#define SKEW_US 0
#endif
__device__ __forceinline__ void spin_us(int us) { if (us > 0) { const unsigned long long t0 = __builtin_amdgcn_s_memrealtime(); while (__builtin_amdgcn_s_memrealtime() - t0 < (unsigned long long)us * 100ull) __builtin_amdgcn_s_sleep(8); } }
constexpr int FILT_F = 816, FILT_I = 896;
constexpr int BG_SPLIT = 22016;
constexpr int SEQ_PER_LAYER = 11, NSEQ = 1 + DEPTH * SEQ_PER_LAYER + 1;
__global__ void __launch_bounds__(NWAVES * 64, 2) fwd(Args A) {
    extern __shared__ __attribute__((aligned(16))) unsigned char lds_raw[];
    LAS unsigned char* lds = (LAS unsigned char*)lds_raw;
    volatile LAS unsigned* MISC = (volatile LAS unsigned*)(lds + MISC_OFF);
    for (int u = threadIdx.x; u < (LDS_BYTES - LDSCTL_OFF) / 4; u += NWAVES * 64) ((LAS unsigned*)(lds + LDSCTL_OFF))[u] = 0u;
    __syncthreads();
    (void)xcd_barrier_post((unsigned*)(wsb() + WS_CTL) + CW_BAR, MISC + 8);
    const int lo = A.seq_lo, hi = A.seq_hi;
#ifdef PROBE_K
    volatile LAS unsigned long long* pr_ = (volatile LAS unsigned long long*)(lds + MISC_OFF + 128);
    if (threadIdx.x == 0) { pr_[0] = 0ull; pr_[1] = __builtin_amdgcn_s_memrealtime(); }
#define pr_acc pr_[0]
#define pr_prev pr_[1]
#endif
#define G ((int)gridDim.x)
#ifdef PROBE_SUB
#define PROBE_K 999
#define SUBT(n, stmt) do { unsigned long long t0_ = 0; if ((n) == PROBE_SUB && blockIdx.x == PROBE_WG && threadIdx.x == 0) t0_ = __builtin_amdgcn_s_memrealtime(); stmt; if ((n) == PROBE_SUB && blockIdx.x == PROBE_WG && threadIdx.x == 0) pr_acc += __builtin_amdgcn_s_memrealtime() - t0_; } while (0)
#else
#define SUBT(n, stmt) do { stmt; } while (0)
#endif
#ifdef PROBE_K
#ifndef PROBE_WG
#define PROBE_WG 0
#endif
#ifndef PROBE_WAIT
#define PROBE_WAIT 0
#endif
#define PROBE_PH(s) (((s) == 0) ? 100 : (((s) - 1) % SEQ_PER_LAYER))
#define PROBE_ARRIVE(s) do { if (blockIdx.x == PROBE_WG && threadIdx.x == 0) { const unsigned long long now_ = __builtin_amdgcn_s_memrealtime(); if (!PROBE_WAIT && PROBE_PH(s) == PROBE_K) pr_acc += now_ - pr_prev; pr_prev = now_; } } while (0)
#define PROBE_EXIT(s) do { if (blockIdx.x == PROBE_WG && threadIdx.x == 0) { const unsigned long long now_ = __builtin_amdgcn_s_memrealtime(); if (PROBE_WAIT && PROBE_PH(s) == PROBE_K) pr_acc += now_ - pr_prev; pr_prev = now_; } } while (0)
#else
#define PROBE_ARRIVE(s) do { } while (0)
#define PROBE_EXIT(s) do { } while (0)
#endif
#define RUN(s) (lo <= (s) && (s) < hi)
#ifndef DUP
#define DUP 0
#endif
#define DUPN(id) ((((DUP) >> (id)) & 1) ? 2 : 1)
#define TID_HERE const int tid = otid(), lane = tid & 63, wave = __builtin_amdgcn_readfirstlane(tid >> 6); (void)lane; (void)wave
#ifdef ONLY
#define PH_ON(k) ((k) == ONLY)
#elif defined(SKIP)
#define PH_ON(k) ((k) != SKIP)
#else
#define PH_ON(k) true
#endif
#define SEAM(s) do { PROBE_ARRIVE(s); if (RUN((s) + 1)) { XcdBarrier bar_; bar_.bar = (unsigned*)(wsb() + WS_CTL) + CW_BAR; bar_.x = xb_xcc_id(); bar_.st = (volatile LAS unsigned*)(lds + MISC_OFF) + 8; xcd_barrier(bar_); if (DUPN(16) > 1) xcd_barrier(bar_); } PROBE_EXIT(s); } while (0)
#define H ((bf16*)(wsb() + WS_H))
#define Z ((bf16*)(wsb() + WS_Z))
#define ACC ((bf16*)(wsb() + WS_ACC))
#define U ((bf16*)(wsb() + WS_U))
#define YS ((bf16*)(wsb() + WS_YS))
#define XC ((float*)(wsb() + WS_XC))
#define WIN ((const bf16*)(psb(l & 1) + PS_WIN))
#define WBR ((const bf16*)(psb(l & 1) + PS_WBR))
#define WOUT ((const bf16*)(psb(l & 1) + PS_WOUT))
#define WF1 ((const bf16*)(psb(l & 1) + PS_WF1))
#define WF2 ((const bf16*)(psb(l & 1) + PS_WF2))

    if (PH_ON(100) && RUN(0)) { TID_HERE; ph_prologue(A, lds, tid); __syncthreads(); ph_convert(A, 0, 0, 0, CONV_ITEMS, (int)blockIdx.x, G, lds, wave, lane); __syncthreads(); for (int fl = 0; fl < DEPTH; ++fl) ph_filt1(A, fl, 0, (int)blockIdx.x, G, lds, tid); SEAM(0); }

    for (int l = 0; l < DEPTH; ++l) {
        const int sb = 1 + l * SEQ_PER_LAYER;
        if (hi <= sb || lo >= sb + SEQ_PER_LAYER) continue;
        const bool lastl = (l == DEPTH - 1);
        const int Mrows = lastl ? ML : MT, nctx = lastl ? 0 : 64;
#define modl ((const float*)(wsb() + WS_MOD) + (size_t)l * 5 * 12288)
#define xlat_in ((l == 0) ? inp(I_X) : (const float*)outb())
#define xctx_in ((l == 0) ? inp(I_CTX) : (const float*)XC)

        if (PH_ON(0) && RUN(sb + 0)) { TID_HERE;
            if (l == 0) ph_filt2(A, 0, 0, 0, 1024, (int)blockIdx.x, G, lds, tid);
            else ph_convert(A, l, l & 1, 0, CONV_ITEMS, (int)blockIdx.x, G, lds, wave, lane);
            ph_norm(xlat_in, xctx_in, inp(I_G1) + (size_t)l * D, modl, 0, D, H, MT, (l > 0) ? (const float*)(wsb() + WS_SLAB) : (const float*)nullptr,
                    (const float*)(wsb() + WS_MOD) + ((size_t)(l - 1) * 5 + 4) * 12288 + 5 * D, XC, wave, lane);
            SEAM(sb + 0);
        }
        if (PH_ON(1) && RUN(sb + 1)) { TID_HERE;
            if (SKEW_US > 0 && (blockIdx.x & 8)) spin_us(SKEW_US);
            { pg8::Gemm g{H, WIN, opq(MT), opq(INW), opq(D), 0}; pg8::StaticOrder S; S.init(g.M, g.N, G, (int)blockIdx.x);
              pg8::EpiStore E{Z, INW};
              for (int r_ = 0; r_ < DUPN(15); ++r_) pg8::gemm_phase<pg8::EpiStore, pg8::StaticOrder, PG8_ALIGN, PG8_SP2>(lds, g, S, E); }
            SEAM(sb + 1);
        }
        if (PH_ON(2) && RUN(sb + 2)) { TID_HERE;
            SUBT(1, ph_hyprep(A, l, lds, tid));
            SUBT(2, ph_ret1(A, l, 64, lds, tid));
            SUBT(3, ph_natt(A, l, 0, lds, tid));
            SUBT(4, if (!lastl) ph_hyctx(A, l, lds, tid));
            SEAM(sb + 2);
        }
        if (PH_ON(3) && RUN(sb + 3)) { TID_HERE;
#ifndef NO_D1
            SUBT(5, ph_hyfft(A, l, lds, tid));
#endif
#ifndef NO_D2
            SUBT(6, ph_scan(A, l, tid));
#endif
            SEAM(sb + 3);
        }
        if (PH_ON(4) && RUN(sb + 4)) { TID_HERE;
            SUBT(7, ph_hypost(A, lds, tid));
            SUBT(8, ph_ret3(A, l, nctx, lds, tid));
            if (!lastl) { __syncthreads(); ph_natt(A, l, 1, lds, tid); }
            SEAM(sb + 4);
        }
        if (PH_ON(5) && RUN(sb + 5)) { TID_HERE;
            __syncthreads();
            for (int r_ = 0; r_ < DUPN(13); ++r_)
            for (int i = 0; i < 3; ++i) {
                pg8::Gemm g{YS + (size_t)i * MT * 1024, WBR + (size_t)i * D * 1024, Mrows, opq(D), opq(1024), 0}; pg8::StaticOrder S; S.init(g.M, g.N, G, (int)blockIdx.x);
                pg8::EpiMerge E{ACC, Z + C_GT + i * D, INW, i == 0 ? 1 : 0};
                pg8::gemm_phase<pg8::EpiMerge, pg8::StaticOrder, F_ALIGN, F_SP2>(lds, g, S, E);
            }
            if (!lastl && blockIdx.x >= 32) { __syncthreads(); ph_filt2(A, l + 1, (l + 1) & 1, 0, FILT_F, (int)blockIdx.x - 32, G - 32, lds, tid); }
            SEAM(sb + 5);
        }
        if (PH_ON(6) && RUN(sb + 6)) { TID_HERE;
            __syncthreads();
            { pg8::Gemm g{ACC, WOUT, opq(ML), opq(D), opq(D), 0}; pg8::StaticOrder S; S.init(g.M, g.N, G, (int)blockIdx.x);
              pg8::EpiResid E{xlat_in, xctx_in, outb(), XC, modl, 2 * D};
              pg8::gemm_phase<pg8::EpiResid, pg8::StaticOrder, PG8_ALIGN, PG8_SP2>(lds, g, S, E); }
            if (!lastl) { pg8::Gemm g{ACC, WOUT, opq(MT), opq(D), opq(D / NSPLIT), opq(D)}; pg8::CtxSplitOrder S{NSPLIT, D / NSPLIT, (int)blockIdx.x};
              pg8::EpiSlab E{(float*)(wsb() + WS_SLAB), D / NSPLIT};
              pg8::gemm_phase<pg8::EpiSlab, pg8::CtxSplitOrder, PG8_ALIGN, PG8_SP2>(lds, g, S, E); }
            SEAM(sb + 6);
        }
        if (PH_ON(7) && RUN(sb + 7)) { TID_HERE;
            ph_norm(outb(), xctx_in, inp(I_G2) + (size_t)l * D, modl, 3 * D, 4 * D, H, Mrows, (const float*)(wsb() + WS_SLAB), modl + (size_t)4 * 12288 + 2 * D, XC, wave, lane);
            SEAM(sb + 7);
        }
        if (PH_ON(8) && RUN(sb + 8)) { TID_HERE;
            __syncthreads();
            if (SKEW_US > 0 && (blockIdx.x & 8)) spin_us(SKEW_US);
            pg8::Gemm g{H, WF1, Mrows, opq(NFF), opq(D), 0}; pg8::StaticOrder S; S.init(g.M, g.N, G, (int)blockIdx.x);
            pg8::EpiFfn E{U, (bf16*)(wsb() + WS_SA), (bf16*)(wsb() + WS_SB), inp(I_FFCW) + (size_t)l * 3 * DFF, inp(I_FFCB) + (size_t)l * DFF};
            for (int r_ = 0; r_ < DUPN(14); ++r_) pg8::gemm_phase<pg8::EpiFfn, pg8::StaticOrder, PG8_ALIGN, PG8_SP2>(lds, g, S, E);
            if (!lastl && blockIdx.x >= 176) { __syncthreads(); ph_filt2(A, l + 1, (l + 1) & 1, FILT_F, FILT_I, (int)blockIdx.x - 176, G - 176, lds, tid); }
            SEAM(sb + 8);
        }
        if (PH_ON(9) && RUN(sb + 9)) { TID_HERE;
            for (int r_ = 0; r_ < DUPN(11); ++r_) ph_ffnfix(A, l, Mrows, tid);
            SEAM(sb + 9);
        }
        if (PH_ON(10) && RUN(sb + 10)) { TID_HERE;
            __syncthreads();
            { pg8::Gemm g{U, WF2, opq(ML), opq(D), opq(DFF), 0}; pg8::StaticOrder S; S.init(g.M, g.N, G, (int)blockIdx.x);
              pg8::EpiResid E{outb(), XC, outb(), XC, modl, 5 * D};
              pg8::gemm_phase<pg8::EpiResid, pg8::StaticOrder, PG8_ALIGN, PG8_SP2>(lds, g, S, E); }
            if (!lastl) { pg8::Gemm g{U, WF2, opq(MT), opq(D), opq(DFF / NSPLIT), opq(DFF)}; pg8::CtxSplitOrder S{NSPLIT, DFF / NSPLIT, (int)blockIdx.x};
              pg8::EpiSlab E{(float*)(wsb() + WS_SLAB), DFF / NSPLIT};
              pg8::gemm_phase<pg8::EpiSlab, pg8::CtxSplitOrder, PG8_ALIGN, PG8_SP2>(lds, g, S, E); }
            if (!lastl && blockIdx.x >= 128) { __syncthreads(); ph_filt2(A, l + 1, (l + 1) & 1, FILT_I, 1024, (int)blockIdx.x - 128, G - 128, lds, tid); }
            SEAM(sb + 10);
        }
    }
    if (PH_ON(101) && RUN(NSEQ - 1)) { TID_HERE; ph_final(A, wave, lane); }
#ifdef PROBE_K
    if (blockIdx.x == PROBE_WG && threadIdx.x == 0) { const unsigned long long t0 = __builtin_amdgcn_s_memrealtime(); while (__builtin_amdgcn_s_memrealtime() - t0 < 4ull * pr_acc) __builtin_amdgcn_s_sleep(8); }
#endif
#undef RUN
#undef SEAM
#undef H
#undef Z
#undef ACC
#undef U
#undef YS
#undef XC
#undef WIN
#undef WBR
#undef WOUT
#undef WF1
#undef WF2
#undef G
#undef modl
#undef xlat_in
#undef xctx_in
}

extern "C" void kernel_launch(void* const* d_in, const int* in_sizes, int n_in, void* d_out, int out_size, void* d_ws, size_t ws_size, hipStream_t stream) {
    static int grid = 0;
    if (grid == 0) {
        if (n_in != 27 || out_size != ML * D || ws_size < WS_END) { fprintf(stderr, "kernel_launch: unexpected shapes (n_in %d out %d ws %zu need %zu)\n", n_in, out_size, ws_size, (size_t)WS_END); grid = -1; return; }
        int dev = 0, cus = 0, per_cu = 0;
        if (hipGetDevice(&dev) != hipSuccess || hipDeviceGetAttribute(&cus, hipDeviceAttributeMultiprocessorCount, dev) != hipSuccess) { grid = -1; return; }
        if (hipFuncSetAttribute((const void*)fwd, hipFuncAttributeMaxDynamicSharedMemorySize, LDS_BYTES) != hipSuccess) { fprintf(stderr, "kernel_launch: hipFuncSetAttribute failed\n"); grid = -1; return; }
        if (hipOccupancyMaxActiveBlocksPerMultiprocessor(&per_cu, (const void*)fwd, NWAVES * 64, LDS_BYTES) != hipSuccess || per_cu < 1) fprintf(stderr, "kernel_launch: occupancy query says %d\n", per_cu);
        (void)hipGetLastError();
        grid = cus;
    }
    if (grid < 0) return;
    (void)hipMemsetAsync((char*)d_ws + WS_CTL, 0, CTL_ZERO_BYTES, stream);
    Args a{};
    for (int i = 0; i < 27; ++i) a.in[i] = (const float*)d_in[i];
    a.out = (float*)d_out; a.ws = (unsigned char*)d_ws;
#if MK_SINGLE
    a.seq_lo = 0; a.seq_hi = NSEQ;
    hipLaunchKernelGGL(fwd, dim3(grid), dim3(NWAVES * 64), LDS_BYTES, stream, a);
#else
    for (int s = 0; s < NSEQ; ++s) { a.seq_lo = s; a.seq_hi = s + 1; hipLaunchKernelGGL(fwd, dim3(grid), dim3(NWAVES * 64), LDS_BYTES, stream, a); }
#endif
}
```

```cpp
#include <hip/hip_runtime.h>
#include <cstdio>
#include <cstdint>
#ifndef MK_SINGLE
#define MK_SINGLE 1
#endif
namespace pg8 {
#define PG8_LAS __attribute__((address_space(3)))
typedef unsigned short bf16_t;
typedef short bf16x8 __attribute__((ext_vector_type(8)));
typedef float f32x4 __attribute__((ext_vector_type(4)));
typedef unsigned u32x4 __attribute__((ext_vector_type(4)));
constexpr int BM = 256, BK = 64, HALF = 128, HTB = HALF * BK * 2  , STAGE_BYTES = 8 * HTB, NXCD = 8, WGM = 8;

__host__ __device__ __forceinline__ int lds_byte(int r, int c) { const int st = (r >> 4) * 2 + (c >> 5), rr = r & 15, cc = c & 31, ob = rr * 64 + cc * 2; return st * 1024 + (ob ^ (((ob >> 9) & 1) << 5)); }
__host__ __device__ __forceinline__ void stage_rc(int b, int& R, int& C) { const int st = b / 1024, sb = b % 1024, swz = sb ^ (((sb >> 9) & 1) << 5); R = (st >> 1) * 16 + swz / 64; C = (st & 1) * 32 + (swz % 64) / 2; }
__host__ __device__ __forceinline__ int perm32(int rho) { const int n = rho >> 4, i = rho & 15; return 8 * (i >> 2) + 4 * n + (i & 3); }

struct Unit { int pm, pn, ko; };
struct Gemm { const bf16_t* A; const bf16_t* Bt; int M, N, K, ld; };

struct StaticOrder {
    int nM, nN, nwg, G, c;
    __host__ __device__ void init(int M, int N, int G_, int c_) { nM = M / BM; nN = N / BM; nwg = nM * nN; G = G_; c = c_; }
    __host__ __device__ bool next(int i, Unit& u) const {
        const long L = (long)i * G + c; if (L >= nwg) return false;
        int wgid = (int)L; { const int q = nwg / NXCD, r = nwg % NXCD, xcd = wgid % NXCD, off = wgid / NXCD; wgid = (xcd < r ? xcd * (q + 1) : r * (q + 1) + (xcd - r) * q) + off; }
        const int nig = WGM * nN, gid = wgid / nig, fm = gid * WGM, gsz = (nM - fm) < WGM ? (nM - fm) : WGM;
        u.pm = fm + ((wgid % nig) % gsz); u.pn = (wgid % nig) / gsz; u.ko = 0; return true;
    }
    __device__ __forceinline__ void a_ready(const Unit&) const {}
    __device__ __forceinline__ void done(const Unit&) const {}
};
__device__ __forceinline__ unsigned cvt_pk_bf16(float lo, float hi) { unsigned r; asm volatile("v_cvt_pk_bf16_f32 %0, %1, %2" : "=v"(r) : "v"(lo), "v"(hi)); return r; }
typedef float f32x2 __attribute__((ext_vector_type(2)));
__device__ __forceinline__ float bflo(unsigned w) { return __uint_as_float(w << 16); }
__device__ __forceinline__ float bfhi(unsigned w) { return __uint_as_float(w & 0xffff0000u); }
__device__ __forceinline__ float sigm(float x) { return __builtin_amdgcn_rcpf(1.0f + __expf(-x)); }
struct EpiStore {
    static constexpr bool PERM = true, AFTER_DRAIN = false;
    bf16_t* O; int ldc; unsigned char* GQ; int gate_col0, gq_ld;
    __device__ __forceinline__ void operator()(const f32x4 (&acc)[2][2][4][2], const Unit& u, int wr, int wc, int fr, int fq) const {
        const int row0 = u.pm * BM + wr * 64 + fr, col0 = u.pn * BM + wc * 32 + 8 * fq;
        if (GQ != nullptr && u.pn * BM >= gate_col0) {
            const int gc0 = col0 - gate_col0;
#pragma unroll
            for (int ai = 0; ai < 2; ++ai)
#pragma unroll
                for (int m = 0; m < 4; ++m) { unsigned char* rowp = GQ + (size_t)(row0 + ai * HALF + m * 16) * gq_ld + gc0;
#pragma unroll
                    for (int bj = 0; bj < 2; ++bj) { const f32x4 v0 = acc[ai][bj][m][0], v1 = acc[ai][bj][m][1];
                        unsigned q[8];
#pragma unroll
                        for (int t = 0; t < 4; ++t) { q[t] = (unsigned)(sigm(v0[t]) * 255.0f + 0.5f); q[4 + t] = (unsigned)(sigm(v1[t]) * 255.0f + 0.5f); }
                        typedef unsigned u32x2 __attribute__((ext_vector_type(2)));
                        u32x2 w; w.x = q[0] | (q[1] << 8) | (q[2] << 16) | (q[3] << 24); w.y = q[4] | (q[5] << 8) | (q[6] << 16) | (q[7] << 24);
                        __builtin_nontemporal_store(w, (u32x2*)(rowp + bj * HALF)); } }
            return;
        }
#pragma unroll
        for (int ai = 0; ai < 2; ++ai)
#pragma unroll
            for (int m = 0; m < 4; ++m) { bf16_t* rowp = O + (size_t)(row0 + ai * HALF + m * 16) * ldc + col0;
#pragma unroll
                for (int bj = 0; bj < 2; ++bj) { const f32x4 v0 = acc[ai][bj][m][0], v1 = acc[ai][bj][m][1];
                    u32x4 w; w.x = cvt_pk_bf16(v0[0], v0[1]); w.y = cvt_pk_bf16(v0[2], v0[3]); w.z = cvt_pk_bf16(v1[0], v1[1]); w.w = cvt_pk_bf16(v1[2], v1[3]);
                    __builtin_nontemporal_store(w, (u32x4*)(rowp + bj * HALF)); } }
    }
};
struct EpiMerge {
    static constexpr bool PERM = true, AFTER_DRAIN = false;
    bf16_t* O; const unsigned char* gate; int ldg; int first;
    __device__ __forceinline__ void operator()(const f32x4 (&acc)[2][2][4][2], const Unit& u, int wr, int wc, int fr, int fq) const {
        const int row0 = u.pm * BM + wr * 64 + fr, col0 = u.pn * BM + wc * 32 + 8 * fq;
        typedef unsigned u32x2 __attribute__((ext_vector_type(2)));
        const float k = 1.0f / 255.0f;
#pragma unroll
        for (int ai = 0; ai < 2; ++ai)
#pragma unroll
            for (int m = 0; m < 4; ++m) { const size_t row = (size_t)(row0 + ai * HALF + m * 16);
#pragma unroll
                for (int bj = 0; bj < 2; ++bj) { const int col = col0 + bj * HALF;
                    const u32x2 gv = *(const u32x2*)(gate + row * ldg + col);
                    u32x4 pv = (u32x4){0u, 0u, 0u, 0u}; if (!first) pv = *(const u32x4*)(O + row * 2048 + col);
                    const f32x4 v0 = acc[ai][bj][m][0], v1 = acc[ai][bj][m][1];
                    u32x4 w;
                    w.x = cvt_pk_bf16(bflo(pv.x) + v0[0] * ((float)(gv.x & 255u) * k), bfhi(pv.x) + v0[1] * ((float)((gv.x >> 8) & 255u) * k));
                    w.y = cvt_pk_bf16(bflo(pv.y) + v0[2] * ((float)((gv.x >> 16) & 255u) * k), bfhi(pv.y) + v0[3] * ((float)(gv.x >> 24) * k));
                    w.z = cvt_pk_bf16(bflo(pv.z) + v1[0] * ((float)(gv.y & 255u) * k), bfhi(pv.z) + v1[1] * ((float)((gv.y >> 8) & 255u) * k));
                    w.w = cvt_pk_bf16(bflo(pv.w) + v1[2] * ((float)((gv.y >> 16) & 255u) * k), bfhi(pv.w) + v1[3] * ((float)(gv.y >> 24) * k));
                    *(u32x4*)(O + row * 2048 + col) = w; } }
    }
};
struct EpiResid {
    static constexpr bool PERM = false, AFTER_DRAIN = false;
    const float* base_lat; const float* base_ctx; float* out_lat; float* out_ctx; const float* modl; int goff;
    __device__ __forceinline__ void operator()(const f32x4 (&acc)[2][2][4][2], const Unit& u, int wr, int wc, int fr, int fq) const {
        const bool isctx = u.pm >= 64; const int r = isctx ? 4 : (u.pm >> 4);
        const float* gvp = modl + (size_t)r * 12288 + goff;
        const float* bs = isctx ? base_ctx : base_lat; float* os = isctx ? out_ctx : out_lat;
        const int row0 = (isctx ? u.pm - 64 : u.pm) * BM + wr * 64 + fr, col0 = u.pn * BM + wc * 32 + 4 * fq;
        f32x4 g4[2][2];
#pragma unroll
        for (int bj = 0; bj < 2; ++bj)
#pragma unroll
            for (int n = 0; n < 2; ++n) g4[bj][n] = *(const f32x4*)(gvp + col0 + bj * HALF + n * 16);
#pragma unroll
        for (int ai = 0; ai < 2; ++ai)
#pragma unroll
            for (int m = 0; m < 4; ++m) { const size_t off = (size_t)(row0 + ai * HALF + m * 16) * 2048 + col0;
#pragma unroll
                for (int bj = 0; bj < 2; ++bj)
#pragma unroll
                    for (int n = 0; n < 2; ++n) { const f32x4 b4 = *(const f32x4*)(bs + off + bj * HALF + n * 16);
                        *(f32x4*)(os + off + bj * HALF + n * 16) = b4 + g4[bj][n] * acc[ai][bj][m][n]; } }
    }
};

__device__ __forceinline__ float dpp_ror1(float v) { return __int_as_float(__builtin_amdgcn_update_dpp(0, __float_as_int(v), 0x121, 0xf, 0xf, false)); }
__device__ __forceinline__ float dpp_rol1(float v) { return __int_as_float(__builtin_amdgcn_update_dpp(0, __float_as_int(v), 0x12f, 0xf, 0xf, false)); }
__device__ __forceinline__ float gelu_fast(float x) { const float x2 = x * x; const float arg = x * (x2 * (-2.0f * 1.4426950408889634f * 0.7978845608028654f * 0.044715f) + (-2.0f * 1.4426950408889634f * 0.7978845608028654f));
    return x * __builtin_amdgcn_rcpf(1.0f + __builtin_amdgcn_exp2f(arg)); }
struct EpiFfn {
    static constexpr bool PERM = true, AFTER_DRAIN = false;
    bf16_t* U; bf16_t* SA; bf16_t* SB; const float* cw; const float* cb;
    __device__ __forceinline__ void operator()(const f32x4 (&acc)[2][2][4][2], const Unit& u, int wr, int wc, int fr, int fq) const {
        const int f0 = u.pn * 128 + wc * 32 + 8 * fq;
        f32x4 w0[2], w1[2], w2[2], bb[2];
#pragma unroll
        for (int n = 0; n < 2; ++n) { w0[n] = *(const f32x4*)(cw + f0 + 4 * n); w1[n] = *(const f32x4*)(cw + 5632 + f0 + 4 * n); w2[n] = *(const f32x4*)(cw + 2 * 5632 + f0 + 4 * n); bb[n] = *(const f32x4*)(cb + f0 + 4 * n); }
#pragma unroll
        for (int ai = 0; ai < 2; ++ai) {
            const int row0 = u.pm * BM + ai * HALF + wr * 64 + fr, blk = u.pm * 4 + ai * 2 + wr;
            f32x4 o[4][2];
#pragma unroll
            for (int n = 0; n < 2; ++n)
#pragma unroll
                for (int e = 0; e < 4; ++e) {
                    const float a0 = acc[ai][0][0][n][e], a1 = acc[ai][0][1][n][e], a2 = acc[ai][0][2][n][e], a3 = acc[ai][0][3][n][e];
                    const float r0 = dpp_ror1(a0), r1 = dpp_ror1(a1), r2 = dpp_ror1(a2), r3 = dpp_ror1(a3);
                    const float l0 = dpp_rol1(a0), l1 = dpp_rol1(a1), l2 = dpp_rol1(a2), l3 = dpp_rol1(a3);
                    const bool first = (fr == 0), last = (fr == 15);
                    const float p0 = r0, p1 = first ? r0 : r1, p2 = first ? r1 : r2, p3 = first ? r2 : r3;
                    const float n0 = last ? l1 : l0, n1 = last ? l2 : l1, n2 = last ? l3 : l2, n3 = l3;
                    const float k0 = w0[n][e], k1 = w1[n][e], k2 = w2[n][e], kb = bb[n][e];
                    o[0][n][e] = gelu_fast(k0 * p0 + k1 * a0 + k2 * n0 + kb) * acc[ai][1][0][n][e];
                    o[1][n][e] = gelu_fast(k0 * p1 + k1 * a1 + k2 * n1 + kb) * acc[ai][1][1][n][e];
                    o[2][n][e] = gelu_fast(k0 * p2 + k1 * a2 + k2 * n2 + kb) * acc[ai][1][2][n][e];
                    o[3][n][e] = gelu_fast(k0 * p3 + k1 * a3 + k2 * n3 + kb) * acc[ai][1][3][n][e];
                }
#pragma unroll
            for (int m = 0; m < 4; ++m) { u32x4 w; w.x = cvt_pk_bf16(o[m][0][0], o[m][0][1]); w.y = cvt_pk_bf16(o[m][0][2], o[m][0][3]); w.z = cvt_pk_bf16(o[m][1][0], o[m][1][1]); w.w = cvt_pk_bf16(o[m][1][2], o[m][1][3]);
                *(u32x4*)(U + (size_t)(row0 + m * 16) * 5632 + f0) = w; }
            const int sel = (fr == 0) ? 0 : (fr == 1) ? 1 : (fr == 14) ? 2 : (fr == 15) ? 3 : -1;
            if (sel >= 0) { const int m = (sel < 2) ? 0 : 3;
                const f32x4 a0 = (m == 0) ? acc[ai][0][0][0] : acc[ai][0][3][0], a1 = (m == 0) ? acc[ai][0][0][1] : acc[ai][0][3][1];
                u32x4 w; w.x = cvt_pk_bf16(a0[0], a0[1]); w.y = cvt_pk_bf16(a0[2], a0[3]); w.z = cvt_pk_bf16(a1[0], a1[1]); w.w = cvt_pk_bf16(a1[2], a1[3]);
                *(u32x4*)(SA + ((size_t)blk * 4 + sel) * 5632 + f0) = w;
                if (sel == 0 || sel == 3) { const f32x4 b0 = (m == 0) ? acc[ai][1][0][0] : acc[ai][1][3][0], b1 = (m == 0) ? acc[ai][1][0][1] : acc[ai][1][3][1];
                    u32x4 v; v.x = cvt_pk_bf16(b0[0], b0[1]); v.y = cvt_pk_bf16(b0[2], b0[3]); v.z = cvt_pk_bf16(b1[0], b1[1]); v.w = cvt_pk_bf16(b1[2], b1[3]);
                    *(u32x4*)(SB + ((size_t)blk * 2 + (sel == 0 ? 0 : 1)) * 5632 + f0) = v; } }
        }
    }
};

struct CtxSplitOrder {
    int nsplit, klen, c;
    __device__ __forceinline__ bool next(int i, Unit& u) const { if (i > 0 || c >= 32 * nsplit) return false; const int tile = c / nsplit, s = c - tile * nsplit; u.pm = 64 + (tile >> 3); u.pn = tile & 7; u.ko = s * klen; return true; }
    __device__ __forceinline__ void a_ready(const Unit&) const {}
    __device__ __forceinline__ void done(const Unit&) const {}
};
struct EpiSlab {
    static constexpr bool PERM = false, AFTER_DRAIN = false;
    float* slab; int klen;
    __device__ __forceinline__ void operator()(const f32x4 (&acc)[2][2][4][2], const Unit& u, int wr, int wc, int fr, int fq) const {
        float* os = slab + (size_t)(u.ko / klen) * 1024 * 2048;
        const int row0 = (u.pm - 64) * BM + wr * 64 + fr, col0 = u.pn * BM + wc * 32 + 4 * fq;
#pragma unroll
        for (int ai = 0; ai < 2; ++ai)
#pragma unroll
            for (int m = 0; m < 4; ++m) { const size_t off = (size_t)(row0 + ai * HALF + m * 16) * 2048 + col0;
#pragma unroll
                for (int bj = 0; bj < 2; ++bj)
#pragma unroll
                    for (int n = 0; n < 2; ++n) *(f32x4*)(os + off + bj * HALF + n * 16) = acc[ai][bj][m][n]; }
    }
};
template <class Epi, class Sched, bool ALIGN_EPI = false, bool SP2 = false>
__device__ __forceinline__ void gemm_phase(PG8_LAS unsigned char* lds, const Gemm g, const Sched& S, const Epi& E) {
    int tid_ = threadIdx.x; asm volatile("" : "+v"(tid_)); const int tid = tid_, wid = __builtin_amdgcn_readfirstlane(tid >> 6), lane = tid & 63, wr = wid >> 2, wc = wid & 3, fr = lane & 15, fq = lane >> 4;
    const int K = g.K, nt = K / BK, LD = g.ld ? g.ld : g.K;
    unsigned voffA[2], voffB[2];
#pragma unroll
    for (int i = 0; i < 2; ++i) { int R, C; stage_rc(tid * 16 + i * 8192, R, C); const int Rb = Epi::PERM ? ((R & ~31) + perm32(R & 31)) : R;
        voffA[i] = (unsigned)(R * LD + C) * 2u; voffB[i] = (unsigned)(Rb * LD + C) * 2u; }
    const size_t kstep = (size_t)(BK * 2);
    const size_t hstep = (size_t)HALF * LD * 2;
    const size_t tstep = 2 * hstep;
    const unsigned ldsw = (unsigned)wid * 1024u;
    const int aoff = lds_byte(wr * 64 + fr, fq * 8), boff = lds_byte(wc * 32 + fr, fq * 8);
#define PG8_SA(b, h) (((b) * 2 + (h)) * HTB)
#define PG8_SB(b, h) ((4 + (b) * 2 + (h)) * HTB)
#define PG8_STAGE(bufoff, gbase, voff) do { _Pragma("unroll") for (int _i = 0; _i < 2; ++_i) \
        __builtin_amdgcn_global_load_lds((const unsigned*)((const char*)(gbase) + (voff)[_i]), (PG8_LAS unsigned*)(lds + (bufoff) + ldsw + _i * 8192), 16, 0, 0); } while (0)
#define PG8_LDA(dst, b, h) do { _Pragma("unroll") for (int m = 0; m < 4; ++m) _Pragma("unroll") for (int k = 0; k < 2; ++k) dst[m][k] = *(const PG8_LAS bf16x8*)(lds + PG8_SA(b, h) + aoff + m * 2048 + k * 1024); } while (0)
#define PG8_LDB(dst, b, h) do { _Pragma("unroll") for (int n = 0; n < 2; ++n) _Pragma("unroll") for (int k = 0; k < 2; ++k) dst[n][k] = *(const PG8_LAS bf16x8*)(lds + PG8_SB(b, h) + boff + n * 2048 + k * 1024); } while (0)
#define PG8_MMA(ai, bj, At, Bt) do { __builtin_amdgcn_s_setprio(1); _Pragma("unroll") for (int m = 0; m < 4; ++m) _Pragma("unroll") for (int n = 0; n < 2; ++n) _Pragma("unroll") for (int k = 0; k < 2; ++k) \
        acc[ai][bj][m][n] = __builtin_amdgcn_mfma_f32_16x16x32_bf16(Bt[n][k], At[m][k], acc[ai][bj][m][n], 0, 0, 0); __builtin_amdgcn_s_setprio(0); } while (0)
#define PG8_WAIT_V(n) asm volatile("s_waitcnt vmcnt(" #n ")" ::: "memory")
#define PG8_WAIT_L(n) asm volatile("s_waitcnt lgkmcnt(" #n ")" ::: "memory")
#define PG8_BAR __builtin_amdgcn_s_barrier()
#define PG8_SCHED __builtin_amdgcn_sched_barrier(0)
    Unit cur, nxt; int ui = 0;
    if (!S.next(0, cur)) return;
    f32x4 acc[2][2][4][2];
#pragma unroll
    for (int a = 0; a < 2; ++a)
#pragma unroll
        for (int b = 0; b < 2; ++b)
#pragma unroll
            for (int m = 0; m < 4; ++m)
#pragma unroll
                for (int n = 0; n < 2; ++n) acc[a][b][m][n] = (f32x4){0.f, 0.f, 0.f, 0.f};
    bf16x8 At[4][2], B0[2][2], B1[2][2];
    const char* cA = (const char*)g.A + (size_t)cur.pm * tstep + (size_t)cur.ko * 2; const char* cB = (const char*)g.Bt + (size_t)cur.pn * tstep + (size_t)cur.ko * 2;
    S.a_ready(cur);
    if constexpr (SP2) {
        PG8_STAGE(PG8_SB(0, 0), cB, voffB); PG8_STAGE(PG8_SB(0, 1), cB + hstep, voffB); PG8_STAGE(PG8_SA(0, 0), cA, voffA); PG8_STAGE(PG8_SA(0, 1), cA + hstep, voffA);
        if (wr == 1) PG8_BAR;
        PG8_WAIT_V(2); PG8_BAR;
        PG8_STAGE(PG8_SB(1, 0), cB + kstep, voffB); PG8_STAGE(PG8_SA(1, 0), cA + kstep, voffA); PG8_STAGE(PG8_SB(1, 1), cB + hstep + kstep, voffB);
        PG8_WAIT_V(6); PG8_BAR;
    } else {
        PG8_STAGE(PG8_SB(0, 0), cB, voffB); PG8_STAGE(PG8_SA(0, 0), cA, voffA); PG8_STAGE(PG8_SB(0, 1), cB + hstep, voffB); PG8_STAGE(PG8_SA(0, 1), cA + hstep, voffA);
        if (wr == 1) PG8_BAR;
        PG8_WAIT_V(4); PG8_BAR;
        PG8_STAGE(PG8_SB(1, 0), cB + kstep, voffB); PG8_STAGE(PG8_SA(1, 0), cA + kstep, voffA); PG8_STAGE(PG8_SB(1, 1), cB + hstep + kstep, voffB);
        PG8_WAIT_V(6); PG8_BAR;
    }
    for (;;) {
        const bool has_next = S.next(ui + 1, nxt);
        const char* nA = has_next ? (const char*)g.A + (size_t)nxt.pm * tstep + (size_t)nxt.ko * 2 : cA; const char* nB = has_next ? (const char*)g.Bt + (size_t)nxt.pn * tstep + (size_t)nxt.ko * 2 : cB;
        for (int t = 0; t < nt; t += 2) {
            const bool last = (t == nt - 2);
            const char* a1 = cA + (size_t)(t + 1) * kstep;
            const char* a2 = last ? nA : cA + (size_t)(t + 2) * kstep; const char* b2 = last ? nB : cB + (size_t)(t + 2) * kstep;
            const char* a3 = a2 + kstep; const char* b3 = b2 + kstep;
            if (last && has_next) S.a_ready(nxt);
            if constexpr (SP2) {
            PG8_LDB(B0, 0, 0); PG8_LDB(B1, 0, 1); PG8_SCHED; PG8_LDA(At, 0, 0); PG8_STAGE(PG8_SA(1, 1), a1 + hstep, voffA);
            PG8_WAIT_V(8); PG8_WAIT_L(0); PG8_BAR; PG8_MMA(0, 0, At, B0); PG8_MMA(0, 1, At, B1); PG8_BAR; PG8_SCHED;
            PG8_LDA(At, 0, 1); PG8_STAGE(PG8_SB(0, 0), b2, voffB); PG8_STAGE(PG8_SB(0, 1), b2 + hstep, voffB); PG8_STAGE(PG8_SA(0, 0), a2, voffA);
            PG8_WAIT_V(8); PG8_WAIT_L(0); PG8_BAR; PG8_MMA(1, 0, At, B0); PG8_MMA(1, 1, At, B1); PG8_BAR; PG8_SCHED;
            PG8_LDB(B0, 1, 0); PG8_LDB(B1, 1, 1); PG8_SCHED; PG8_LDA(At, 1, 0); PG8_STAGE(PG8_SA(0, 1), a2 + hstep, voffA);
            PG8_WAIT_V(8); PG8_WAIT_L(0); PG8_BAR; PG8_MMA(0, 0, At, B0); PG8_MMA(0, 1, At, B1); PG8_BAR; PG8_SCHED;
            PG8_LDA(At, 1, 1); PG8_STAGE(PG8_SB(1, 0), b3, voffB); PG8_STAGE(PG8_SB(1, 1), b3 + hstep, voffB); PG8_STAGE(PG8_SA(1, 0), a3, voffA);
            PG8_WAIT_V(8); PG8_WAIT_L(0); PG8_BAR; PG8_MMA(1, 0, At, B0); PG8_MMA(1, 1, At, B1); PG8_BAR; PG8_SCHED;
            } else {
            PG8_LDB(B0, 0, 0); PG8_SCHED; PG8_LDA(At, 0, 0); PG8_STAGE(PG8_SA(1, 1), a1 + hstep, voffA);
            PG8_WAIT_L(8); PG8_BAR; PG8_WAIT_L(0); PG8_MMA(0, 0, At, B0); PG8_BAR; PG8_SCHED;
            PG8_LDB(B1, 0, 1); PG8_STAGE(PG8_SB(0, 0), b2, voffB);
            PG8_BAR; PG8_WAIT_L(0); PG8_MMA(0, 1, At, B1); PG8_BAR;
            PG8_LDA(At, 0, 1); PG8_STAGE(PG8_SA(0, 0), a2, voffA);
            PG8_BAR; PG8_WAIT_L(0); PG8_MMA(1, 0, At, B0); PG8_BAR; PG8_SCHED;
            PG8_STAGE(PG8_SB(0, 1), b2 + hstep, voffB);
            PG8_WAIT_V(6); PG8_BAR; PG8_MMA(1, 1, At, B1); PG8_BAR;
            PG8_LDB(B0, 1, 0); PG8_SCHED; PG8_LDA(At, 1, 0); PG8_STAGE(PG8_SA(0, 1), a2 + hstep, voffA);
            PG8_WAIT_L(8); PG8_BAR; PG8_WAIT_L(0); PG8_MMA(0, 0, At, B0); PG8_BAR; PG8_SCHED;
            PG8_LDB(B1, 1, 1); PG8_STAGE(PG8_SB(1, 0), b3, voffB);
            PG8_BAR; PG8_WAIT_L(0); PG8_MMA(0, 1, At, B1); PG8_BAR;
            PG8_LDA(At, 1, 1); PG8_STAGE(PG8_SA(1, 0), a3, voffA);
            PG8_BAR; PG8_WAIT_L(0); PG8_MMA(1, 0, At, B0); PG8_BAR; PG8_SCHED;
            PG8_STAGE(PG8_SB(1, 1), b3 + hstep, voffB);
            PG8_WAIT_V(6); PG8_BAR; PG8_MMA(1, 1, At, B1); PG8_BAR;
            }
        }
        if constexpr (ALIGN_EPI) { if (wr == 0) PG8_BAR; }
        if constexpr (!Epi::AFTER_DRAIN) { E(acc, cur, wr, wc, fr, fq); S.done(cur); }
        if (!has_next) break;
#pragma unroll
        for (int a = 0; a < 2; ++a)
#pragma unroll
            for (int b = 0; b < 2; ++b)
#pragma unroll
                for (int m = 0; m < 4; ++m)
#pragma unroll
                    for (int n = 0; n < 2; ++n) acc[a][b][m][n] = (f32x4){0.f, 0.f, 0.f, 0.f};
        cur = nxt; cA = nA; cB = nB; ++ui;
        if constexpr (ALIGN_EPI) { if (wr == 1) PG8_BAR; }
    }
    PG8_WAIT_V(0);
    if constexpr (!ALIGN_EPI) { if (wr == 0) PG8_BAR; }
    PG8_BAR;
    if constexpr (Epi::AFTER_DRAIN) { E.fused(acc, cur, wr, wc, fr, fq, lds, wid, lane); S.done(cur); }
#undef PG8_SA
#undef PG8_SB
#undef PG8_STAGE
#undef PG8_LDA
#undef PG8_LDB
#undef PG8_MMA
#undef PG8_WAIT_V
#undef PG8_WAIT_L
#undef PG8_BAR
#undef PG8_SCHED
}
}
#ifndef PG8_SP2
#define PG8_SP2 true
#endif
#ifndef PG8_ALIGN
#define PG8_ALIGN true
#endif
constexpr int D = 2048, NB = 4, SEQ = 4096, CL = 256, DEPTH = 4;
constexpr int ML = NB * SEQ, MC = NB * CL, MT = ML + MC;
constexpr int INW = 15360, DFF = 5632, NFF = 2 * DFF;
constexpr int C_RK = 0, C_RV = 512, C_NK = 1536, C_NV = 2560, C_RQ = 3584, C_RG = 4096, C_NQ = 5120, C_HY = 6144, C_GT = 9216;
constexpr float EPS = 1e-6f;
constexpr int NWAVES = 8;
constexpr size_t al256(size_t x) { return (x + 255) & ~(size_t)255; }
constexpr size_t WS_CTL = 0, CTL_ZERO_BYTES = 1u << 20;
constexpr size_t WS_MOD = WS_CTL + CTL_ZERO_BYTES;
constexpr size_t WS_ROPE = WS_MOD + al256((size_t)4 * 5 * 12288 * 4);
constexpr size_t PS_FH2 = 0;
constexpr size_t PS_FH2B = PS_FH2 + al256((size_t)4352 * 64 * 4);
constexpr size_t PS_TAPC = PS_FH2B + al256((size_t)4352 * 64 * 2);
constexpr size_t PS_KF = PS_TAPC + al256((size_t)2 * 2 * 1024 * 256 * 4);
constexpr size_t PS_WIN = PS_KF + al256((size_t)2 * 1024 * 8192 * 8);
constexpr size_t PS_WBR = PS_WIN + al256((size_t)INW * D * 2);
constexpr size_t PS_WOUT = PS_WBR + al256((size_t)3 * D * 1024 * 2);
constexpr size_t PS_WF1 = PS_WOUT + al256((size_t)D * D * 2);
constexpr size_t PS_WF2 = PS_WF1 + al256((size_t)NFF * D * 2);
constexpr size_t PS_BYTES = PS_WF2 + al256((size_t)D * DFF * 2);
constexpr size_t WS_PSET = WS_ROPE + al256(64 * 16 * 8);
constexpr size_t WS_XC = WS_PSET + 2 * PS_BYTES;
constexpr size_t WS_H = WS_XC + al256((size_t)MC * D * 4);
constexpr size_t WS_Z = WS_H + al256((size_t)MT * D * 2);
constexpr size_t WS_HYT = WS_Z + al256((size_t)MT * INW * 2);
constexpr size_t WS_YT = WS_HYT + al256((size_t)3 * NB * 1024 * SEQ * 2);
constexpr size_t WS_YS = WS_YT + al256((size_t)NB * 1024 * SEQ * 2);
constexpr size_t WS_ACC = WS_YS + al256((size_t)3 * MT * 1024 * 2);
constexpr size_t WS_U = WS_ACC + al256((size_t)MT * D * 2);
constexpr size_t WS_KV = WS_U + al256((size_t)MT * DFF * 2);
constexpr size_t WS_SA = WS_KV + al256((size_t)NB * 8 * 2 * 34 * 8192 * 4);
constexpr size_t WS_SB = WS_SA + al256((size_t)272 * 4 * DFF * 2);
constexpr size_t WS_SLAB = WS_SB + al256((size_t)272 * 2 * DFF * 2);
constexpr size_t WS_FB4 = WS_SLAB + al256((size_t)4 * MC * D * 4);
constexpr size_t WS_GQ = WS_FB4 + al256((size_t)4 * 4352 * 64 * 2);
constexpr size_t WS_END = WS_GQ + al256((size_t)MT * 3 * D);
constexpr int NSPLIT = 4;
constexpr int CW_BAR = 4096, CW_DYN = 8192;
constexpr int RING_BYTES = 131072, LDS_BYTES = 147456, LDSCTL_OFF = LDS_BYTES - 1024, MISC_OFF = LDSCTL_OFF + 320;

#define GAS __attribute__((address_space(1)))
#define LAS __attribute__((address_space(3)))
typedef unsigned short bf16;
typedef unsigned v4u __attribute__((ext_vector_type(4)));
typedef unsigned v2u __attribute__((ext_vector_type(2)));
typedef float f32x4 __attribute__((ext_vector_type(4)));
typedef float f32x2 __attribute__((ext_vector_type(2)));
typedef short bf16x8 __attribute__((ext_vector_type(8)));
typedef GAS unsigned gu32;
#define LDS_WAIT() asm volatile("s_waitcnt lgkmcnt(0)" ::: "memory")
__device__ __forceinline__ unsigned f2bf(float f) { unsigned u = __builtin_bit_cast(unsigned, f); return (u + 0x7fffu + ((u >> 16) & 1u)) >> 16; }
typedef __bf16 bf16x2_t __attribute__((ext_vector_type(2)));
__device__ __forceinline__ unsigned pk2(float lo, float hi) { const bf16x2_t v = {(__bf16)lo, (__bf16)hi}; return __builtin_bit_cast(unsigned, v); }
__device__ __forceinline__ float bflo(unsigned w) { return __uint_as_float(w << 16); }
__device__ __forceinline__ float bfhi(unsigned w) { return __uint_as_float(w & 0xffff0000u); }
__device__ __forceinline__ float bf1(bf16 b) { return __uint_as_float(((unsigned)b) << 16); }
__device__ __forceinline__ bf16x8 mk8(unsigned a, unsigned b, unsigned c, unsigned d) { v4u v = (v4u){a, b, c, d}; return __builtin_bit_cast(bf16x8, v); }
__device__ __forceinline__ f32x4 mfma16(bf16x8 a, bf16x8 b, f32x4 c) { return __builtin_amdgcn_mfma_f32_16x16x32_bf16(a, b, c, 0, 0, 0); }
__device__ __forceinline__ float sin_rev(float r) { return __builtin_amdgcn_sinf(r - floorf(r)); }
__device__ __forceinline__ float cos_rev(float r) { return __builtin_amdgcn_cosf(r - floorf(r)); }
__device__ __forceinline__ float sin_rad(float x) { return sin_rev(x * 0.15915494309189535f); }
__device__ __forceinline__ float ex2(float x) { return __builtin_amdgcn_exp2f(x); }
__device__ __forceinline__ float wave_sum(float v) {
#pragma unroll
    for (int o = 1; o < 64; o <<= 1) v += __shfl_xor(v, o);
    return v;
}
__device__ __forceinline__ int otid() { int t = threadIdx.x; asm volatile("" : "+v"(t)); return t; }
__device__ __forceinline__ int opq(int v) { asm volatile("" : "+s"(v)); return v; }
#define XB_TMO      128
#define XB_XCNT(j)  (256  + 64 * (j))
#define XB_XSUB(j)  (1280 + 64 * (j))
#define XB_XGEN(j)  (2304 + 64 * (j))
#define XB_TOP      3328
#define XB_TOPGEN   3392
#define XCD_BAR_WORDS 3456
#define XB_SPIN_CAP (1u << 18)

__device__ __forceinline__ unsigned xb_ld(unsigned* p)              { return __hip_atomic_load(p, __ATOMIC_RELAXED, __HIP_MEMORY_SCOPE_AGENT); }
__device__ __forceinline__ unsigned xb_add(unsigned* p, unsigned v) { return __hip_atomic_fetch_add(p, v, __ATOMIC_RELAXED, __HIP_MEMORY_SCOPE_AGENT); }
__device__ __forceinline__ unsigned xb_xcc_id() { return (unsigned)__builtin_amdgcn_s_getreg((3 << 11) | 20) & 0xFu; }
#define XB_SPIN(cond, bar) do { unsigned _sp = 0; while (cond) { __builtin_amdgcn_s_sleep(1); \
    if ((++_sp & 255u) == 0u) { if (xb_ld(&(bar)[XB_TMO])) break; if (_sp > XB_SPIN_CAP) { atomicAdd(&(bar)[XB_TMO], 1u); break; } } } } while (0)

struct XcdBarrier {
    unsigned* bar; unsigned x;
    volatile LAS unsigned* st;
};

__device__ __forceinline__ XcdBarrier xcd_barrier_post(unsigned* bar, volatile LAS unsigned* st) {
    XcdBarrier b; b.bar = bar; b.x = xb_xcc_id(); b.st = st;
    if (threadIdx.x == 0) (void)xb_add(&bar[XB_XCNT(b.x)], 1u);
    return b;
}
__device__ __forceinline__ void xcd_barrier_complete(unsigned* bar, unsigned x, unsigned& nloc, unsigned& nx) {
    const unsigned G = gridDim.x * gridDim.y * gridDim.z;
    unsigned sum, cnt, mine, sp = 0u;
    for (;;) {
        sum = 0u; cnt = 0u; mine = 0u;
#pragma unroll
        for (unsigned j = 0; j < 16; ++j) { const unsigned c = xb_ld(&bar[XB_XCNT(j)]); sum += c; cnt += (c > 0u) ? 1u : 0u; mine = (j == x) ? c : mine; }
        if (sum == G) break;
        __builtin_amdgcn_s_sleep(1);
        if ((++sp & 255u) == 0u) { if (xb_ld(&bar[XB_TMO])) break; if (sp > XB_SPIN_CAP) { atomicAdd(&bar[XB_TMO], 1u); break; } }
    }
    nloc = mine > 0u ? mine : 1u; nx = cnt > 0u ? cnt : 1u;
}

__device__ __forceinline__ void xcd_barrier(const XcdBarrier& b) {
    asm volatile("s_waitcnt vmcnt(0)" ::: "memory");
    __syncthreads();
    if (threadIdx.x == 0) {
        unsigned* bar = b.bar;
        __builtin_amdgcn_s_waitcnt(0);
        unsigned nloc = b.st[0], nx = b.st[1];
        if (nloc == 0u) { xcd_barrier_complete(bar, b.x, nloc, nx); b.st[0] = nloc; b.st[1] = nx; }
        const unsigned old = xb_add(&bar[XB_XSUB(b.x)], 1u);
        const unsigned gen = old / nloc;
        if (old + 1u == (gen + 1u) * nloc) {
            __builtin_amdgcn_fence(__ATOMIC_RELEASE, "agent");
            asm volatile("s_waitcnt vmcnt(0)" ::: "memory");
            const unsigned og = xb_add(&bar[XB_TOP], 1u);
            const unsigned tg = og / nx;
            if (og + 1u == (tg + 1u) * nx) xb_add(&bar[XB_TOPGEN], 1u);
            else XB_SPIN(xb_ld(&bar[XB_TOPGEN]) == tg, bar);
            __builtin_amdgcn_fence(__ATOMIC_ACQUIRE, "agent");
            xb_add(&bar[XB_XGEN(b.x)], 1u);
            asm volatile("s_waitcnt vmcnt(0)" ::: "memory");
        } else {
            XB_SPIN(xb_ld(&bar[XB_XGEN(b.x)]) == gen, bar);
            __builtin_amdgcn_fence(__ATOMIC_ACQUIRE, "agent");
            asm volatile("s_waitcnt vmcnt(0)" ::: "memory");
        }
    }
    __syncthreads();
}
__device__ __forceinline__ void p0_transpose_item(const float* W, int K, int N, bf16* WT, int row_off, LAS float* scr, int item, int lane) {
    const int nblk = N / 32, kb = item / nblk, nb = item % nblk, k0 = 64 * kb, n0 = 32 * nb;
#pragma unroll 16
    for (int i = 0; i < 32; ++i) { const int kk = 2 * i + (lane >> 5); scr[kk * 33 + (lane & 31)] = __builtin_nontemporal_load(W + (size_t)(k0 + kk) * N + n0 + (lane & 31)); }
    LDS_WAIT(); asm volatile("" ::: "memory");
    const int c = lane & 7;
#pragma unroll
    for (int j = 0; j < 4; ++j) { const int n = (lane >> 3) + 8 * j; const LAS float* s = scr + (8 * c) * 33 + n;
        v4u o; o.x = pk2(s[0 * 33], s[1 * 33]); o.y = pk2(s[2 * 33], s[3 * 33]); o.z = pk2(s[4 * 33], s[5 * 33]); o.w = pk2(s[6 * 33], s[7 * 33]);
        __builtin_nontemporal_store(o, (GAS v4u*)(WT + (size_t)(row_off + n0 + n) * K + k0 + 8 * c)); }
    LDS_WAIT(); asm volatile("" ::: "memory");
}
struct Args { const float* in[27]; float* out; unsigned char* ws; int seq_lo, seq_hi; };
__device__ __forceinline__ const float* inp(int i) { const char* ka = (const char*)__builtin_amdgcn_kernarg_segment_ptr(); int off = i * 8; asm volatile("" : "+s"(off)); return *(const float* const*)(ka + off); }
__device__ __forceinline__ unsigned char* wsb() { const char* ka = (const char*)__builtin_amdgcn_kernarg_segment_ptr(); int off = 27 * 8 + 8; asm volatile("" : "+s"(off)); return *(unsigned char* const*)(ka + off); }
__device__ __forceinline__ float* outb() { const char* ka = (const char*)__builtin_amdgcn_kernarg_segment_ptr(); int off = 27 * 8; asm volatile("" : "+s"(off)); return *(float* const*)(ka + off); }
__device__ __forceinline__ unsigned char* psb(int set) { return wsb() + WS_PSET + (size_t)set * PS_BYTES; }
enum { I_X = 0, I_C, I_CTX, I_CCTX, I_WMOD, I_BMOD, I_G1, I_G2, I_WIN, I_HCW, I_HCB, I_FW1, I_FB1, I_FW2, I_FB2, I_FW3, I_FFQ, I_HBIAS, I_RDEC, I_RPB, I_WBR, I_WOUT, I_FFW1, I_FFCW, I_FFCB, I_FFW2, I_GF };

__device__ __forceinline__ void ph_prologue(const Args& A, LAS unsigned char* lds, int tid) {
    LAS float* sc = (LAS float*)lds;
    LAS float* red = sc + 5 * 2048;
    const float* c = inp(I_C); const float* cc = inp(I_CCTX);
    for (int i = tid; i < 5 * 2048; i += 512) { const int r = i >> 11, k = i & 2047; const float v = (r < 4) ? c[r * 2048 + k] : cc[k]; sc[i] = v / (1.0f + __expf(-v)); }
    __syncthreads();
    float* mod = (float*)(wsb() + WS_MOD);
    const int kq = tid >> 6, col = tid & 63;
    for (int u = blockIdx.x; u < DEPTH * 192; u += gridDim.x) {
        const int l = u / 192, n0 = (u % 192) * 64;
        const float* W = inp(I_WMOD) + (size_t)l * 2048 * 12288 + n0 + col;
        float a0 = 0.f, a1 = 0.f, a2 = 0.f, a3 = 0.f, a4 = 0.f;
#pragma unroll 16
        for (int k = kq * 256; k < kq * 256 + 256; ++k) { const float w = W[(size_t)k * 12288];
            a0 += sc[k] * w; a1 += sc[2048 + k] * w; a2 += sc[4096 + k] * w; a3 += sc[6144 + k] * w; a4 += sc[8192 + k] * w; }
        red[(kq * 5 + 0) * 64 + col] = a0; red[(kq * 5 + 1) * 64 + col] = a1; red[(kq * 5 + 2) * 64 + col] = a2; red[(kq * 5 + 3) * 64 + col] = a3; red[(kq * 5 + 4) * 64 + col] = a4;
        __syncthreads();
        if (tid < 320) { const int r = tid >> 6; float s = inp(I_BMOD)[l * 12288 + n0 + col];
#pragma unroll
            for (int q = 0; q < 8; ++q) s += red[(q * 5 + r) * 64 + col];
            mod[((size_t)l * 5 + r) * 12288 + n0 + col] = s; }
        __syncthreads();
    }
    if (blockIdx.x == 0) { f32x2* rope = (f32x2*)(wsb() + WS_ROPE);
        for (int i = tid; i < 1024; i += 512) { const int pos = i >> 4, j = i & 15; const float inv = exp2f(-(float)j * (13.287712379549449f / 16.0f));
            const float rev = (float)pos * inv * 0.15915494309189535f; rope[i] = (f32x2){cos_rev(rev), sin_rev(rev)}; } }
}

__device__ __forceinline__ void ph_convert(const Args& A, int l, int set, int it_lo, int it_hi, int wk, int nwk, LAS unsigned char* lds, int wave, int lane) {
    LAS float* scr = (LAS float*)(lds + wave * 16384);
    const int gw = wk * NWAVES + wave, NGW = nwk * NWAVES;
    constexpr int I_IN = (D / 64) * (INW / 32), I_BR = (1024 / 64) * (D / 32), I_OUT = (D / 64) * (D / 32), I_F1 = (D / 64) * (NFF / 32);
    const float* win = inp(I_WIN) + (size_t)l * D * INW; const float* wbr = inp(I_WBR) + (size_t)l * 3 * 1024 * D; const float* wout = inp(I_WOUT) + (size_t)l * D * D;
    const float* wf1 = inp(I_FFW1) + (size_t)l * D * NFF; const float* wf2 = inp(I_FFW2) + (size_t)l * DFF * D;
    unsigned char* ps = psb(set);
    bf16* WIN = (bf16*)(ps + PS_WIN); bf16* WBR = (bf16*)(ps + PS_WBR); bf16* WOUT = (bf16*)(ps + PS_WOUT); bf16* WF1 = (bf16*)(ps + PS_WF1); bf16* WF2 = (bf16*)(ps + PS_WF2);
    for (int it = it_lo + gw; it < it_hi; it += NGW) {
        int r = it;
        if (r < I_IN) { p0_transpose_item(win, D, INW, WIN, 0, scr, r, lane); continue; } r -= I_IN;
        if (r < I_BR) { p0_transpose_item(wbr, 1024, D, WBR, 0, scr, r, lane); continue; } r -= I_BR;
        if (r < I_BR) { p0_transpose_item(wbr + (size_t)1024 * D, 1024, D, WBR + (size_t)D * 1024, 0, scr, r, lane); continue; } r -= I_BR;
        if (r < I_BR) { p0_transpose_item(wbr + (size_t)2 * 1024 * D, 1024, D, WBR + (size_t)2 * D * 1024, 0, scr, r, lane); continue; } r -= I_BR;
        if (r < I_OUT) { p0_transpose_item(wout, D, D, WOUT, 0, scr, r, lane); continue; } r -= I_OUT;
        if (r < I_F1) { const int n0 = (r % (NFF / 32)) * 32, f0 = (n0 < DFF) ? n0 : n0 - DFF, nrow = 256 * (f0 >> 7) + ((n0 < DFF) ? 0 : 128) + (f0 & 127);
            p0_transpose_item(wf1, D, NFF, WF1, nrow - n0, scr, r, lane); continue; } r -= I_F1;
        p0_transpose_item(wf2, DFF, D, WF2, 0, scr, r, lane);
    }
}
constexpr int CONV_ITEMS = (D / 64) * (INW / 32) + 3 * (1024 / 64) * (D / 32) + (D / 64) * (D / 32) + (D / 64) * (NFF / 32) + (DFF / 64) * (D / 32);
__device__ __forceinline__ void ph_filt1(const Args& A, int l, int set, int wk, int nwk, LAS unsigned char* lds, int tid) {
    LAS float* feat = (LAS float*)lds;
    LAS float* h1 = feat + 8 * 33;
    LAS float* w1s = h1 + 8 * 64;
    LAS float* w2s = w1s + 33 * 64;
    const float* w1 = inp(I_FW1) + (size_t)l * 33 * 64; const float* b1 = inp(I_FB1) + l * 64; const float* w2 = inp(I_FW2) + (size_t)l * 64 * 64; const float* b2 = inp(I_FB2) + l * 64;
    const float* fq = inp(I_FFQ) + l * 64; bf16* FH2B = (bf16*)(wsb() + WS_FB4) + (size_t)l * 4352 * 64;
    const int pl = tid >> 6, o = tid & 63;
    __syncthreads();
    for (int i = tid; i < 33 * 64; i += 512) w1s[i] = w1[i];
    for (int i = tid; i < 64 * 64; i += 512) w2s[i] = w2[i];
    const float b1o = b1[o], b2o = b2[o], fqo = fq[o];
    __syncthreads();
    for (int u = wk; u < 544; u += nwk) {
        const int pos = u * 8 + pl; const bool isc = pos >= 4096; const int Lf = isc ? 256 : 4096, tp = isc ? pos - 4096 : pos;
        if (o < 33) { float f;
            if (o == 0) f = (float)tp / (float)(Lf - 1);
            else { const int i = (o - 1) & 15; const float fr = 1e-4f + (float)i * ((15.0f - 1e-4f) / 15.0f); const float rev = fr * (float)tp / (float)Lf; f = (o <= 16) ? cos_rev(rev) : -sin_rev(rev); }
            feat[pl * 33 + o] = f; }
        __syncthreads();
        float a = b1o;
#pragma unroll 11
        for (int i = 0; i < 33; ++i) a += feat[pl * 33 + i] * w1s[i * 64 + o];
        h1[pl * 64 + o] = sin_rad(fqo * a);
        __syncthreads();
        float b = b2o;
#pragma unroll 16
        for (int j = 0; j < 64; ++j) b += h1[pl * 64 + j] * w2s[j * 64 + o];
        FH2B[(size_t)pos * 64 + o] = (bf16)f2bf(sin_rad(fqo * b));
        __syncthreads();
    }
}
__device__ __forceinline__ void ph_norm(const float* xlat, const float* xctx, const float* g, const float* modl, int sh_off, int sc_off, bf16* H, int Mrows, const float* slab, const float* sgate, float* xc_out, int wave, int lane) {
    const int gw = blockIdx.x * NWAVES + wave, NGW = gridDim.x * NWAVES;
    for (int base = gw * 8; base < ML; base += NGW * 8) {
        const float* mv = modl + (size_t)(base >> 12) * 12288;
        f32x4 Gv[8], Sv[8];
#pragma unroll
        for (int j = 0; j < 8; ++j) { const int idx = (lane + 64 * j) * 4; Gv[j] = *(const f32x4*)(g + idx) * (*(const f32x4*)(mv + sc_off + idx) + 1.0f); Sv[j] = *(const f32x4*)(mv + sh_off + idx); }
        f32x4 v[8], nx[8];
#pragma unroll
        for (int j = 0; j < 8; ++j) nx[j] = *(const f32x4*)(xlat + (size_t)base * D + (lane + 64 * j) * 4);
#pragma unroll 1
        for (int i = 0; i < 8; ++i) { const int m = base + i; float ss = 0.f;
#pragma unroll
            for (int j = 0; j < 8; ++j) { v[j] = nx[j]; ss += (v[j].x * v[j].x + v[j].y * v[j].y) + (v[j].z * v[j].z + v[j].w * v[j].w); }
            if (i < 7) {
#pragma unroll
                for (int j = 0; j < 8; ++j) nx[j] = *(const f32x4*)(xlat + (size_t)(m + 1) * D + (lane + 64 * j) * 4); }
            const float rstd = 1.0f / sqrtf(wave_sum(ss) * (1.0f / D) + EPS);
#pragma unroll
            for (int j = 0; j < 8; ++j) { const int idx = (lane + 64 * j) * 4; const f32x4 y = v[j] * rstd * Gv[j] + Sv[j];
                v2u w; w.x = pk2(y.x, y.y); w.y = pk2(y.z, y.w); *(v2u*)(H + (size_t)m * D + idx) = w; } }
    }
    for (int m = ML + gw; m < Mrows; m += NGW) {
        const float* xr = xctx + (size_t)(m - ML) * D; const float* mv = modl + (size_t)4 * 12288;
        f32x4 v[8]; float ss = 0.f;
#pragma unroll
        for (int j = 0; j < 8; ++j) { const int idx = (lane + 64 * j) * 4; v[j] = *(const f32x4*)(xr + idx);
            if (slab) { const float* sp = slab + (size_t)(m - ML) * D + idx; f32x4 p = *(const f32x4*)sp;
#pragma unroll
                for (int q = 1; q < NSPLIT; ++q) p = p + *(const f32x4*)(sp + (size_t)q * MC * D);
                v[j] = v[j] + *(const f32x4*)(sgate + idx) * p; *(f32x4*)(xc_out + (size_t)(m - ML) * D + idx) = v[j]; }
            ss += (v[j].x * v[j].x + v[j].y * v[j].y) + (v[j].z * v[j].z + v[j].w * v[j].w); }
        const float rstd = 1.0f / sqrtf(wave_sum(ss) * (1.0f / D) + EPS);
#pragma unroll
        for (int j = 0; j < 8; ++j) { const int idx = (lane + 64 * j) * 4;
            const f32x4 gg = *(const f32x4*)(g + idx), sh = *(const f32x4*)(mv + sh_off + idx), sc = *(const f32x4*)(mv + sc_off + idx);
            const f32x4 y = v[j] * rstd * gg * (sc + 1.0f) + sh;
            v2u w; w.x = pk2(y.x, y.y); w.y = pk2(y.z, y.w);
            *(v2u*)(H + (size_t)m * D + idx) = w; }
    }
}

__device__ __forceinline__ int fphys(int i) { return i + 2 * (i >> 5); }
__device__ __forceinline__ void bfly_dif(f32x2& a, f32x2& b, float c, float s) { const f32x2 u = a, v = b; a = u + v; const f32x2 d = u - v; b = __builtin_elementwise_fma(d.yx, (f32x2){s, -s}, d * (f32x2){c, c}); }
__device__ __forceinline__ void bfly_idit(f32x2& a, f32x2& b, float c, float s) { const f32x2 u = a, q = b; const f32x2 v = __builtin_elementwise_fma(q.yx, (f32x2){-s, s}, q * (f32x2){c, c}); a = u + v; b = u - v; }
template <bool ZHI> __device__ __forceinline__ void dif16(f32x2 (&x)[16], float th) {
    asm volatile("" : "+v"(th));
#pragma unroll
    for (int k = 0; k < 8; ++k) { const float fr = th + (float)k * 0.0625f; const float c = __builtin_amdgcn_cosf(fr), s = __builtin_amdgcn_sinf(fr);
        if (ZHI) { const f32x2 u = x[k]; x[k + 8] = (f32x2){u.x * c + u.y * s, u.y * c - u.x * s}; } else bfly_dif(x[k], x[k + 8], c, s); }
#pragma unroll
    for (int k = 0; k < 4; ++k) { const float fr = 2.0f * th + (float)k * 0.125f; const float c = __builtin_amdgcn_cosf(fr), s = __builtin_amdgcn_sinf(fr);
        bfly_dif(x[k], x[k + 4], c, s); bfly_dif(x[8 + k], x[12 + k], c, s); }
#pragma unroll
    for (int k = 0; k < 2; ++k) { const float fr = 4.0f * th + (float)k * 0.25f; const float c = __builtin_amdgcn_cosf(fr), s = __builtin_amdgcn_sinf(fr);
#pragma unroll
        for (int b = 0; b < 16; b += 4) bfly_dif(x[b + k], x[b + k + 2], c, s); }
    { const float fr = 8.0f * th; const float c = __builtin_amdgcn_cosf(fr), s = __builtin_amdgcn_sinf(fr);
#pragma unroll
        for (int b = 0; b < 16; b += 2) bfly_dif(x[b], x[b + 1], c, s); }
}
__device__ __forceinline__ void idit16(f32x2 (&x)[16], float th) {
    asm volatile("" : "+v"(th));
    { const float fr = 8.0f * th; const float c = __builtin_amdgcn_cosf(fr), s = __builtin_amdgcn_sinf(fr);
#pragma unroll
        for (int b = 0; b < 16; b += 2) bfly_idit(x[b], x[b + 1], c, s); }
#pragma unroll
    for (int k = 0; k < 2; ++k) { const float fr = 4.0f * th + (float)k * 0.25f; const float c = __builtin_amdgcn_cosf(fr), s = __builtin_amdgcn_sinf(fr);
#pragma unroll
        for (int b = 0; b < 16; b += 4) bfly_idit(x[b + k], x[b + k + 2], c, s); }
#pragma unroll
    for (int k = 0; k < 4; ++k) { const float fr = 2.0f * th + (float)k * 0.125f; const float c = __builtin_amdgcn_cosf(fr), s = __builtin_amdgcn_sinf(fr);
        bfly_idit(x[k], x[k + 4], c, s); bfly_idit(x[8 + k], x[12 + k], c, s); }
#pragma unroll
    for (int k = 0; k < 8; ++k) { const float fr = th + (float)k * 0.0625f; const float c = __builtin_amdgcn_cosf(fr), s = __builtin_amdgcn_sinf(fr); bfly_idit(x[k], x[k + 8], c, s); }
}
template <bool INV, int PSTRIDE> __device__ __forceinline__ void fft_pass(LAS f32x2* buf, int base, float th) {
    LAS f32x2* p = buf + fphys(base);
    f32x2 x[16];
#pragma unroll
    for (int k = 0; k < 16; ++k) x[k] = p[k * PSTRIDE];
    if (INV) idit16(x, th); else dif16<false>(x, th);
#pragma unroll
    for (int k = 0; k < 16; ++k) p[k * PSTRIDE] = x[k];
}
template <bool INV, int PSTRIDE> __device__ __forceinline__ void fft_pass2(LAS f32x2* bufa, LAS f32x2* bufb, int base, float th) {
    LAS f32x2* pa = bufa + fphys(base); LAS f32x2* pb = bufb + fphys(base);
    f32x2 xa[16], xb[16];
#pragma unroll
    for (int k = 0; k < 16; ++k) { xa[k] = pa[k * PSTRIDE]; xb[k] = pb[k * PSTRIDE]; }
    if (INV) { idit16(xa, th); idit16(xb, th); } else { dif16<false>(xa, th); dif16<false>(xb, th); }
#pragma unroll
    for (int k = 0; k < 16; ++k) { pa[k * PSTRIDE] = xa[k]; pb[k * PSTRIDE] = xb[k]; }
}
constexpr int FFT_LDS_BYTES = (8192 + 512 + 8) * 8;
__device__ __forceinline__ float block_sum(float v, LAS float* red, int tid) {
    v = wave_sum(v);
    __syncthreads();
    if ((tid & 63) == 0) red[tid >> 6] = v;
    __syncthreads();
    float s = 0.f;
#pragma unroll
    for (int i = 0; i < 8; ++i) s += red[i];
    return s;
}
__device__ __forceinline__ float hy_delta(int c) { const float d0 = -4.605170185988091f / 0.3f, d1 = -4.605170185988091f / 1.5f; return fabsf(d0 + (d1 - d0) * ((float)c / 1023.0f)); }
__device__ __forceinline__ void ph_filt2(const Args& A, int l, int set, int c_lo, int c_hi, int wk, int nwk, LAS unsigned char* lds, int tid) {
    LAS f32x2* buf = (LAS f32x2*)lds; LAS float* bufs = (LAS float*)lds; LAS float* red = (LAS float*)(lds + FFT_LDS_BYTES + 64); LAS float* w3s = red + 32;
    LAS float* ctap = w3s + 256;
    const float* w3 = inp(I_FW3) + (size_t)l * 64 * 4096; const bf16* FH2B = (const bf16*)(wsb() + WS_FB4) + (size_t)l * 4352 * 64;
    f32x2* KF = (f32x2*)(psb(set) + PS_KF); float* TAPC = (float*)(psb(set) + PS_TAPC);
    const int lane = tid & 63, w = tid >> 6, g = lane >> 4, li = lane & 15;
    for (int c = c_lo + wk; c < c_hi; c += nwk) {
        __syncthreads();
        if (tid < 256) w3s[tid] = w3[(size_t)(tid & 63) * 4096 + (tid >> 7) * 2048 + ((tid >> 6) & 1) * 1024 + c];
        __syncthreads();
        bf16x8 bfr[2];
#pragma unroll
        for (int ks = 0; ks < 2; ++ks) { float v[8];
#pragma unroll
            for (int j = 0; j < 8; ++j) v[j] = (li < 4) ? w3s[li * 64 + 32 * ks + 8 * g + j] : 0.f;
            bfr[ks] = mk8(pk2(v[0], v[1]), pk2(v[2], v[3]), pk2(v[4], v[5]), pk2(v[6], v[7])); }
        const float delta = hy_delta(c); float ssq = 0.f, ssqc = 0.f;
        const int comp = li >> 1;
#pragma unroll 1
        for (int rb = 0; rb < 272; rb += 64) {
            bf16x8 a0[8], a1[8];
#pragma unroll
            for (int rk = 0; rk < 8; ++rk) { const int rt = rb + w + 8 * rk; const bf16* ap = FH2B + (size_t)((rt < 272 ? rt : 0) * 16 + li) * 64 + 8 * g;
                a0[rk] = *(const bf16x8*)ap; a1[rk] = *(const bf16x8*)(ap + 32); }
#pragma unroll
            for (int rk = 0; rk < 8; ++rk) { const int rt = rb + w + 8 * rk; const int t0 = rt * 16;
                f32x4 acc = (f32x4){0.f, 0.f, 0.f, 0.f};
                acc = mfma16(a0[rk], bfr[0], acc); acc = mfma16(a1[rk], bfr[1], acc);
                if (li < 4 && rt < 272) {
                    if (rt < 256) {
#pragma unroll
                        for (int j = 0; j < 4; ++j) { const int t = t0 + 4 * g + j; const float val = acc[j] * __expf(-((float)t * (1.0f / 4095.0f)) * delta);
                            if ((li & 1) == 0) { bufs[2 * fphys(t) + comp] = val; ssq += val * val; }
                            else if (t >= 1) { bufs[2 * fphys(8192 - t) + comp] = val; ssq += val * val; }
                            else bufs[2 * fphys(4096) + comp] = 0.f; }
                    } else {
#pragma unroll
                        for (int j = 0; j < 4; ++j) { const int m = t0 - 4096 + 4 * g + j; const float val = acc[j] * __expf(-((float)m * (1.0f / 255.0f)) * delta);
                            ctap[li * 256 + m] = val; if ((li & 1) == 0 || m >= 1) ssqc += val * val; }
                    }
                }
            }
        }
        const bool o0 = (li < 2), o1 = (li == 2 || li == 3);
        const float scl0 = (1.0f / 8192.0f) / sqrtf(block_sum(o0 ? ssq : 0.f, red, tid) + EPS), scl1 = (1.0f / 8192.0f) / sqrtf(block_sum(o1 ? ssq : 0.f, red, tid) + EPS);
        const float sc0 = 1.0f / sqrtf(block_sum(o0 ? ssqc : 0.f, red, tid) + EPS), sc1 = 1.0f / sqrtf(block_sum(o1 ? ssqc : 0.f, red, tid) + EPS);
        __syncthreads();
        fft_pass<false, 544>(buf, tid, (float)tid * (1.0f / 8192.0f));
        __syncthreads();
        fft_pass<false, 34>(buf, (tid >> 5) * 512 + (tid & 31), (float)(tid & 31) * (1.0f / 512.0f));
        __syncthreads();
        fft_pass<false, 2>(buf, (tid >> 1) * 32 + (tid & 1), (float)(tid & 1) * (1.0f / 32.0f));
        __syncthreads();
#pragma unroll
        for (int r = 0; r < 8; ++r) { LAS f32x4* pp = (LAS f32x4*)(buf + fphys(2 * tid) + 1088 * r); const f32x4 ab = *pp; *pp = (f32x4){ab.x + ab.z, ab.y + ab.w, ab.x - ab.z, ab.y - ab.w}; }
        __syncthreads();
        f32x2* d0 = KF + (size_t)c * 8192; f32x2* d1 = KF + (size_t)(1024 + c) * 8192;
#pragma unroll 4
        for (int i = 0; i < 16; ++i) { const int p = tid + 512 * i; const int f = (int)(__brev((unsigned)p) >> 19); const int pp = (int)(__brev((unsigned)((8192 - f) & 8191)) >> 19);
            const f32x2 z = buf[fphys(p)], zp = buf[fphys(pp)];
            d0[p] = (f32x2){(z.x + zp.x) * 0.5f * scl0, (z.y - zp.y) * 0.5f * scl0};
            d1[p] = (f32x2){(z.y + zp.y) * 0.5f * scl1, (zp.x - z.x) * 0.5f * scl1}; }
        for (int q = tid; q < 1024; q += 512) { const int od = q >> 8, m = q & 255; TAPC[((size_t)od * 1024 + c) * 256 + m] = ctap[q] * ((od < 2) ? sc0 : sc1); }
    }
}

__device__ __forceinline__ void ph_hyprep(const Args& A, int l, LAS unsigned char* lds, int tid) {
    LAS bf16* T = (LAS bf16*)lds;
    const bf16* Z = (const bf16*)(wsb() + WS_Z); bf16* HYT = (bf16*)(wsb() + WS_HYT);
    const float* cw = inp(I_HCW) + (size_t)l * 3 * 3072; const float* cb = inp(I_HCB) + (size_t)l * 3072;
    v4u pre[5];
#define HP_LOAD(u_) do { const int cg_ = (u_) % 12, tt_ = ((u_) / 12) & 63, b_ = (u_) / 768; \
        _Pragma("unroll") for (int e = 0; e < 5; ++e) { const int q = tid + 512 * e; const int r = q >> 5, ch8 = q & 31, t = tt_ * 64 - 1 + r; pre[e] = (v4u){0u, 0u, 0u, 0u}; \
            if (q < 66 * 32 && t >= 0 && t < SEQ) pre[e] = *(const v4u*)(Z + (size_t)(b_ * SEQ + t) * INW + C_HY + cg_ * 256 + ch8 * 8); } } while (0)
    int u = blockIdx.x;
    if (u < 3072) HP_LOAD(u);
    for (; u < 3072; u += gridDim.x) {
        const int cg = u % 12, tt = (u / 12) & 63, b = u / 768;
        __syncthreads();
#pragma unroll
        for (int e = 0; e < 5; ++e) { const int q = tid + 512 * e; if (q < 66 * 32) *(LAS v4u*)(T + (q >> 5) * 264 + (q & 31) * 8) = pre[e]; }
        __syncthreads();
        if (u + (int)gridDim.x < 3072) HP_LOAD(u + (int)gridDim.x);
        const int ch = tid & 255, half = tid >> 8, gch = cg * 256 + ch;
        const float w0 = cw[gch], w1 = cw[3072 + gch], w2 = cw[6144 + gch], bb = cb[gch];
        const int part = gch >> 10, c = gch & 1023;
        bf16* outp = HYT + ((size_t)(part * NB + b) * 1024 + c) * SEQ + tt * 64 + half * 32;
#pragma unroll
        for (int tq = 0; tq < 4; ++tq) { float vv[8];
#pragma unroll
            for (int e = 0; e < 8; ++e) { const int tl = half * 32 + tq * 8 + e;
                vv[e] = w0 * bf1(T[tl * 264 + ch]) + w1 * bf1(T[(tl + 1) * 264 + ch]) + w2 * bf1(T[(tl + 2) * 264 + ch]) + bb; }
            v4u w; w.x = pk2(vv[0], vv[1]); w.y = pk2(vv[2], vv[3]); w.z = pk2(vv[4], vv[5]); w.w = pk2(vv[6], vv[7]);
            *(v4u*)(outp + tq * 8) = w; }
    }
#undef HP_LOAD
}
__device__ __forceinline__ void ph_hyctx(const Args& A, int l, LAS unsigned char* lds, int tid) {
    const bf16* Z = (const bf16*)(wsb() + WS_Z); bf16* YS = (bf16*)(wsb() + WS_YS); const float* TAPC = (const float*)(psb(l & 1) + PS_TAPC);
    const float* cw = inp(I_HCW) + (size_t)l * 3 * 3072; const float* cb = inp(I_HCB) + (size_t)l * 3072; const float* hb = inp(I_HBIAS) + (size_t)l * 2 * 1024;
    const int ch = tid >> 6, q = tid & 63, t0 = 4 * q;
    LAS float* Y = (LAS float*)lds + ch * 1552; LAS float* Y1 = Y + 256; LAS float* G0 = Y + 512; LAS float* G1 = Y + 1032;
    LAS bf16* R = (LAS bf16*)((LAS float*)lds + 8 * 1552);
    for (int u = blockIdx.x; u < 512; u += gridDim.x) {
        const int b = u >> 7, cg8 = (u & 127) * 8, c = cg8 + ch;
        __syncthreads();
        for (int i = tid; i < 768; i += 512) { const int row = i / 3, part = i - row * 3; *(LAS v4u*)(R + row * 24 + part * 8) = *(const v4u*)(Z + (size_t)(ML + b * CL + row) * INW + C_HY + part * 1024 + cg8); }
#pragma unroll
        for (int r = 0; r < 4; ++r) { const int m = t0 + r;
            G0[m + 259] = TAPC[((size_t)(0 * 2 + 0) * 1024 + c) * 256 + m]; G1[m + 259] = TAPC[((size_t)(1 * 2 + 0) * 1024 + c) * 256 + m];
            if (m >= 1) { G0[259 - m] = TAPC[((size_t)(0 * 2 + 1) * 1024 + c) * 256 + m]; G1[259 - m] = TAPC[((size_t)(1 * 2 + 1) * 1024 + c) * 256 + m]; } }
        if (q == 0) { G0[515] = 0.f; G1[515] = 0.f; G0[516] = 0.f; G1[516] = 0.f; }
        __syncthreads();
        float pv[3][4];
#pragma unroll
        for (int part = 0; part < 3; ++part) { const int gch = part * 1024 + c; const float w0 = cw[gch], w1 = cw[3072 + gch], w2 = cw[6144 + gch], bb = cb[gch];
            float zz[6];
#pragma unroll
            for (int e = 0; e < 6; ++e) { const int t = t0 - 1 + e; zz[e] = (t >= 0 && t < CL) ? bf1(R[t * 24 + part * 8 + ch]) : 0.f; }
#pragma unroll
            for (int r = 0; r < 4; ++r) pv[part][r] = w0 * zz[r] + w1 * zz[r + 1] + w2 * zz[r + 2] + bb; }
        *(LAS f32x4*)(Y + t0) = (f32x4){pv[2][0], pv[2][1], pv[2][2], pv[2][3]};
        __syncthreads();
        float yprev[4] = {pv[2][0], pv[2][1], pv[2][2], pv[2][3]};
#pragma unroll
        for (int ord = 0; ord < 2; ++ord) {
            const LAS float* Ys = ord ? Y1 : Y; const LAS float* G = ord ? G1 : G0;
            float acc[4] = {0.f, 0.f, 0.f, 0.f};
#pragma unroll 4
            for (int sp = 0; sp < 64; ++sp) { const f32x4 yv = *(const LAS f32x4*)(Ys + 4 * sp); const LAS float* gp = G + 4 * (q - sp) + 256;
                const f32x4 ga = *(const LAS f32x4*)gp, gb = *(const LAS f32x4*)(gp + 4);
                const float g[8] = {ga.x, ga.y, ga.z, ga.w, gb.x, gb.y, gb.z, gb.w}; const float yy[4] = {yv.x, yv.y, yv.z, yv.w};
#pragma unroll
                for (int r = 0; r < 4; ++r)
#pragma unroll
                    for (int j = 0; j < 4; ++j) acc[r] += yy[j] * g[r - j + 3]; }
            const float bias = hb[ord * 1024 + c];
#pragma unroll
            for (int r = 0; r < 4; ++r) yprev[r] = pv[ord][r] * (acc[r] + bias * yprev[r]);
            if (ord == 0) { *(LAS f32x4*)(Y1 + t0) = (f32x4){yprev[0], yprev[1], yprev[2], yprev[3]}; __syncthreads(); }
        }
#pragma unroll
        for (int r = 0; r < 4; ++r) YS[(size_t)(ML + b * CL + t0 + r) * 1024 + c] = (bf16)f2bf(yprev[r]);
    }
}
__device__ __forceinline__ void unpack8(v4u v, float (&x)[8]) { x[0] = bflo(v.x); x[1] = bfhi(v.x); x[2] = bflo(v.y); x[3] = bfhi(v.y); x[4] = bflo(v.z); x[5] = bfhi(v.z); x[6] = bflo(v.w); x[7] = bfhi(v.w); }
__device__ __forceinline__ v4u pack8(const float (&x)[8]) { v4u w; w.x = pk2(x[0], x[1]); w.y = pk2(x[2], x[3]); w.z = pk2(x[4], x[5]); w.w = pk2(x[6], x[7]); return w; }
__device__ __forceinline__ void rope8(float (&lo)[8], float (&hi)[8], const f32x2* rt) {
#pragma unroll
    for (int e = 0; e < 8; ++e) { const f32x2 cs = rt[e]; const float a = lo[e], b = hi[e]; lo[e] = a * cs.x - b * cs.y; hi[e] = b * cs.x + a * cs.y; }
}
__device__ __forceinline__ void vt_store(LAS bf16* Vt, int ld, int d0, int r, v4u vv) {
    Vt[(d0 + 0) * ld + r] = (bf16)(vv.x & 0xffffu); Vt[(d0 + 1) * ld + r] = (bf16)(vv.x >> 16);
    Vt[(d0 + 2) * ld + r] = (bf16)(vv.y & 0xffffu); Vt[(d0 + 3) * ld + r] = (bf16)(vv.y >> 16);
    Vt[(d0 + 4) * ld + r] = (bf16)(vv.z & 0xffffu); Vt[(d0 + 5) * ld + r] = (bf16)(vv.z >> 16);
    Vt[(d0 + 6) * ld + r] = (bf16)(vv.w & 0xffffu); Vt[(d0 + 7) * ld + r] = (bf16)(vv.w >> 16);
}
constexpr float LOG2E = 1.4426950408889634f;
typedef short s16x4 __attribute__((ext_vector_type(4)));
__device__ __forceinline__ bf16x8 tr_frag(const LAS bf16* tile, int ld, int r0, int r1, int c0, int li) {
    const s16x4 lo = __builtin_amdgcn_ds_read_tr16_b64_v4i16((LAS s16x4*)(tile + (r0 + (li >> 2)) * ld + c0 + 4 * (li & 3)));
    const s16x4 hi = __builtin_amdgcn_ds_read_tr16_b64_v4i16((LAS s16x4*)(tile + (r1 + (li >> 2)) * ld + c0 + 4 * (li & 3)));
    return (bf16x8){lo.x, lo.y, lo.z, lo.w, hi.x, hi.y, hi.z, hi.w};
}
__device__ __forceinline__ void ph_ret1(const Args& A, int l, int nctx_units, LAS unsigned char* lds, int tid) {
    LAS bf16* Kf = (LAS bf16*)lds; LAS bf16* Kb = Kf + 128 * 72; LAS bf16* Vs = Kb + 128 * 72;
    const bf16* Z = (const bf16*)(wsb() + WS_Z); float* KV = (float*)(wsb() + WS_KV); const f32x2* rope = (const f32x2*)(wsb() + WS_ROPE);
    const int lane = tid & 63, w = tid >> 6, g = lane >> 4, li = lane & 15;
    const int tok = tid >> 2, pp = tid & 3, a = (pp & 1) + ((pp >> 1) << 2);
    const int nunits = 1024 + nctx_units;
    v4u pk[2], pv[4];
#define R1_DEC(uid_, b_, h_, n_, ci_, m0_, isc_) const bool isc_ = (uid_) >= 1024; int b_, h_, n_, ci_; size_t m0_; \
        if (!isc_) { b_ = (uid_) >> 8; h_ = ((uid_) >> 5) & 7; n_ = (uid_) & 31; m0_ = (size_t)b_ * SEQ + n_ * 128; ci_ = 2 + n_; } \
        else { const int i_ = (uid_) - 1024; b_ = i_ >> 4; h_ = (i_ >> 1) & 7; n_ = i_ & 1; m0_ = (size_t)ML + b_ * CL + n_ * 128; ci_ = n_; }
#define R1_LOAD(uid_) do { R1_DEC(uid_, b2, h2, n2, ci2, m02, isc2) (void)ci2; (void)n2; (void)isc2; const bf16* kr = Z + (m02 + tok) * INW + C_RK + h2 * 64; pk[0] = *(const v4u*)(kr + 8 * a); pk[1] = *(const v4u*)(kr + 8 * a + 16); \
        _Pragma("unroll") for (int e = 0; e < 4; ++e) { const int q = tid + 512 * e; pv[e] = *(const v4u*)(Z + (m02 + (q >> 4)) * INW + C_RV + h2 * 128 + (q & 15) * 8); } } while (0)
    int uid = blockIdx.x;
    if (uid < nunits) R1_LOAD(uid);
    for (; uid < nunits; uid += gridDim.x) {
        R1_DEC(uid, b, h, n, ci, m0, isc) (void)m0;
        const float lgf = inp(I_RDEC)[(l * 2 + 0) * 8 + h] * LOG2E, lgb = inp(I_RDEC)[(l * 2 + 1) * 8 + h] * LOG2E;
        __syncthreads();
        { float lo[8], hi[8]; unpack8(pk[0], lo); unpack8(pk[1], hi);
            if (!isc) { const int t = n * 128 + tok; const int pos = (a < 4) ? (t >> 6) : (t & 63); rope8(lo, hi, rope + pos * 16 + 8 * (a & 1)); }
            const float zf = ex2(lgf * (float)(127 - tok)) * 0.125f, zb = ex2(lgb * (float)tok) * 0.125f;
            float lf[8], hf[8];
#pragma unroll
            for (int e = 0; e < 8; ++e) { lf[e] = lo[e] * zf; hf[e] = hi[e] * zf; lo[e] *= zb; hi[e] *= zb; }
            *(LAS v4u*)(Kf + tok * 72 + 8 * a) = pack8(lf); *(LAS v4u*)(Kf + tok * 72 + 8 * a + 16) = pack8(hf);
            *(LAS v4u*)(Kb + tok * 72 + 8 * a) = pack8(lo); *(LAS v4u*)(Kb + tok * 72 + 8 * a + 16) = pack8(hi); }
#pragma unroll
        for (int e = 0; e < 4; ++e) { const int q = tid + 512 * e; *(LAS v4u*)(Vs + (q >> 4) * 144 + (q & 15) * 8) = pv[e]; }
        __syncthreads();
        if (uid + (int)gridDim.x < nunits) R1_LOAD(uid + (int)gridDim.x);
        bf16x8 af[4];
#pragma unroll
        for (int ks = 0; ks < 4; ++ks) af[ks] = tr_frag(Vs, 144, 32 * ks + 8 * g, 32 * ks + 8 * g + 4, 16 * w, li);
#pragma unroll
        for (int dir = 0; dir < 2; ++dir) { const LAS bf16* KT = dir ? Kb : Kf;
            float* dst = KV + ((size_t)((b * 8 + h) * 2 + dir) * 34 + ci) * 8192;
#pragma unroll
            for (int nc = 0; nc < 4; ++nc) { f32x4 acc = (f32x4){0.f, 0.f, 0.f, 0.f};
#pragma unroll
                for (int ks = 0; ks < 4; ++ks) acc = mfma16(af[ks], tr_frag(KT, 72, 32 * ks + 8 * g, 32 * ks + 8 * g + 4, 16 * nc, li), acc);
#pragma unroll
                for (int j = 0; j < 4; ++j) dst[(16 * w + 4 * g + j) * 64 + 16 * nc + li] = acc[j]; } }
    }
#undef R1_LOAD
}
__device__ __forceinline__ void ph_natt(const Args& A, int l, int mode, LAS unsigned char* lds, int tid) {
    LAS bf16* Qs = (LAS bf16*)lds; LAS bf16* KV0 = (LAS bf16*)lds; LAS float* rpbs = (LAS float*)(lds + 2 * (64 * 136 + 64 * 144) * 2);
    const bf16* Z = (const bf16*)(wsb() + WS_Z); bf16* YS = (bf16*)(wsb() + WS_YS) + (size_t)2 * MT * 1024;
    const int lane = tid & 63, w = tid >> 6, g = lane >> 4, li = lane & 15;
    const float SCALE = 0.08838834764831845f * LOG2E;
    const int sr0 = tid >> 4, sch = tid & 15;
    const int ufirst = mode ? ((int)blockIdx.x - ((int)gridDim.x - 32)) : (int)blockIdx.x, ucount = mode ? 32 : 512;
    if (ufirst < 0) return;
    for (int uid = ufirst; uid < ucount; uid += (mode ? 32 : (int)gridDim.x)) {
        int b, h, rq = 0; size_t m0;
        if (!mode) { b = uid >> 7; h = (uid >> 4) & 7; rq = uid & 15; m0 = (size_t)b * SEQ + rq * 256; }
        else { b = uid >> 3; h = uid & 7; m0 = (size_t)ML + b * CL; }
        const size_t mc0 = (size_t)ML + b * CL;
        const int qr = 4 * rq + (w >> 1), rs_w = min(max(qr - 4, 0), 56);
        const int kr_lo = min(max(4 * rq - 4, 0), 56), kr_hi = min(max(4 * rq - 1, 0), 56) + 7;
        const int nwin = mode ? 0 : (kr_hi - kr_lo + 1), ntile = nwin + 4;
        int qc[2], cs[2], nlo_w[2], nhi_w[2];
#pragma unroll
        for (int i = 0; i < 2; ++i) { const int cw = 2 * (w & 1) + i; qc[i] = 16 * cw + li; cs[i] = min(max(qc[i] - 8, 0), 48);
            nlo_w[i] = (cw <= 1) ? 0 : cw - 1; nhi_w[i] = (cw == 0) ? 1 : ((cw == 3) ? 3 : cw + 1); }
        v4u kreg[2], vreg[2];
#define NA_LOAD(t_) do { const int t__ = (t_); const size_t mk = (t__ < nwin) ? ((size_t)b * SEQ + (kr_lo + t__) * 64) : (mc0 + (t__ - nwin) * 64); \
            _Pragma("unroll") for (int e = 0; e < 2; ++e) { const bf16* zr = Z + (mk + sr0 + 32 * e) * INW + h * 128 + sch * 8; kreg[e] = *(const v4u*)(zr + C_NK); vreg[e] = *(const v4u*)(zr + C_NV); } } while (0)
#define NA_STORE(buf_) do { LAS bf16* Kd = KV0 + (buf_) * (64 * 136 + 64 * 144); LAS bf16* Vd = Kd + 64 * 136; \
            _Pragma("unroll") for (int e = 0; e < 2; ++e) { *(LAS v4u*)(Kd + (sr0 + 32 * e) * 136 + sch * 8) = kreg[e]; *(LAS v4u*)(Vd + (sr0 + 32 * e) * 144 + sch * 8) = vreg[e]; } } while (0)
        __syncthreads();
        NA_LOAD(0);
        for (int q = tid; q < 4096; q += 512) { const int r = q >> 4, chn = q & 15; *(LAS v4u*)(Qs + r * 136 + chn * 8) = *(const v4u*)(Z + (m0 + r) * INW + C_NQ + h * 128 + chn * 8); }
        if (!mode) for (int i = tid; i < 465; i += 512) rpbs[i] = inp(I_RPB)[((size_t)l * 8 + h) * 465 + i] * LOG2E;
        __syncthreads();
        bf16x8 qf[2][4];
#pragma unroll
        for (int i = 0; i < 2; ++i)
#pragma unroll
            for (int ks = 0; ks < 4; ++ks) qf[i][ks] = *(const LAS bf16x8*)(Qs + (32 * w + 16 * i + li) * 136 + 32 * ks + 8 * g);
        __syncthreads();
        NA_STORE(0);
        __syncthreads();
        f32x4 o[2][8];
#pragma unroll
        for (int i = 0; i < 2; ++i)
#pragma unroll
            for (int nd = 0; nd < 8; ++nd) o[i][nd] = (f32x4){0.f, 0.f, 0.f, 0.f};
        float mrun[2] = {-1e30f, -1e30f}, lrun[2] = {0.f, 0.f};
        for (int t = 0; t < ntile; ++t) {
            const bool win = t < nwin; const int kr = kr_lo + t;
            if (t + 1 < ntile) NA_LOAD(t + 1);
            const LAS bf16* Ks = KV0 + (t & 1) * (64 * 136 + 64 * 144); const LAS bf16* Vs = Ks + 64 * 136;
            const bool active = !win || (kr >= rs_w && kr <= rs_w + 7);
            if (active) {
                const int nlo0 = win ? nlo_w[0] : 0, nhi0 = win ? nhi_w[0] : 3, nlo1 = win ? nlo_w[1] : 0, nhi1 = win ? nhi_w[1] : 3;
                f32x4 s[2][4];
#pragma unroll
                for (int n = 0; n < 4; ++n) { s[0][n] = (f32x4){0.f, 0.f, 0.f, 0.f}; s[1][n] = (f32x4){0.f, 0.f, 0.f, 0.f};
                    const bool u0 = (n >= nlo0 && n <= nhi0), u1 = (n >= nlo1 && n <= nhi1);
                    if (u0 || u1) {
#pragma unroll
                        for (int ks = 0; ks < 4; ++ks) { const bf16x8 kf = *(const LAS bf16x8*)(Ks + (16 * n + li) * 136 + 32 * ks + 8 * g);
                            if (u0) s[0][n] = mfma16(kf, qf[0][ks], s[0][n]);
                            if (u1) s[1][n] = mfma16(kf, qf[1][ks], s[1][n]); } } }
                bf16x8 pf[2][2];
#pragma unroll
                for (int i = 0; i < 2; ++i) {
                    float tmax = -1e30f;
#pragma unroll
                    for (int n = 0; n < 4; ++n)
#pragma unroll
                        for (int j = 0; j < 4; ++j) { float v = s[i][n][j] * SCALE;
                            if (win) { const int kc = 16 * n + 4 * g + j; const bool valid = (kc >= cs[i]) && (kc < cs[i] + 16);
                                const int dc = min(max(kc - qc[i] + 15, 0), 30), dr = min(max(kr - qr + 7, 0), 14);
                                v = valid ? v + rpbs[dr * 31 + dc] : -1e30f; }
                            s[i][n][j] = v; tmax = fmaxf(tmax, v); }
                    tmax = fmaxf(tmax, __shfl_xor(tmax, 16)); tmax = fmaxf(tmax, __shfl_xor(tmax, 32));
                    const bool upd = tmax > mrun[i] + 8.0f;
                    const float mnew = upd ? tmax : mrun[i];
                    float psum = 0.f;
#pragma unroll
                    for (int n = 0; n < 4; ++n)
#pragma unroll
                        for (int j = 0; j < 4; ++j) { const float pv = ex2(s[i][n][j] - mnew); s[i][n][j] = pv; psum += pv; }
                    psum += __shfl_xor(psum, 16); psum += __shfl_xor(psum, 32);
                    if (__any(upd)) { const float alpha = ex2(mrun[i] - mnew); lrun[i] *= alpha;
#pragma unroll
                        for (int nd = 0; nd < 8; ++nd) o[i][nd] = o[i][nd] * alpha; }
                    lrun[i] += psum; mrun[i] = mnew;
#pragma unroll
                    for (int kk = 0; kk < 2; ++kk) pf[i][kk] = mk8(pk2(s[i][2 * kk][0], s[i][2 * kk][1]), pk2(s[i][2 * kk][2], s[i][2 * kk][3]), pk2(s[i][2 * kk + 1][0], s[i][2 * kk + 1][1]), pk2(s[i][2 * kk + 1][2], s[i][2 * kk + 1][3]));
                }
#pragma unroll
                for (int kk = 0; kk < 2; ++kk) { const bool u0 = (2 * kk + 1 >= nlo0 && 2 * kk <= nhi0), u1 = (2 * kk + 1 >= nlo1 && 2 * kk <= nhi1);
                    if (u0 || u1) {
#pragma unroll
                        for (int nd = 0; nd < 8; ++nd) { const bf16x8 vf = tr_frag(Vs, 144, 32 * kk + 4 * g, 32 * kk + 16 + 4 * g, 16 * nd, li);
                            if (u0) o[0][nd] = mfma16(vf, pf[0][kk], o[0][nd]);
                            if (u1) o[1][nd] = mfma16(vf, pf[1][kk], o[1][nd]); } } }
            }
            if (t + 1 < ntile) NA_STORE((t + 1) & 1);
            __syncthreads();
        }
#undef NA_LOAD
#undef NA_STORE
#pragma unroll
        for (int i = 0; i < 2; ++i) { const float inv = 1.0f / lrun[i]; const size_t mrow = m0 + 32 * w + 16 * i + li;
#pragma unroll
            for (int nd = 0; nd < 8; ++nd) { v2u wv; wv.x = pk2(o[i][nd][0] * inv, o[i][nd][1] * inv); wv.y = pk2(o[i][nd][2] * inv, o[i][nd][3] * inv);
                *(v2u*)(YS + mrow * 1024 + h * 128 + 16 * nd + 4 * g) = wv; } }
    }
}

__device__ __forceinline__ void ph_hyfft(const Args& A, int l, LAS unsigned char* lds, int tid) {
    LAS f32x2* bufa = (LAS f32x2*)lds; LAS f32x2* bufb = (LAS f32x2*)(lds + FFT_LDS_BYTES);
    const bf16* HYT = (const bf16*)(wsb() + WS_HYT); bf16* YT = (bf16*)(wsb() + WS_YT); const f32x2* KF = (const f32x2*)(psb(l & 1) + PS_KF);
    const float* hb = inp(I_HBIAS) + (size_t)l * 2 * 1024;
    const int baseB = (tid >> 5) * 512 + (tid & 31), baseC = (tid >> 1) * 32 + (tid & 1);
    const float thA = (float)tid * (1.0f / 8192.0f), thB = (float)(tid & 31) * (1.0f / 512.0f), thC = (float)(tid & 1) * (1.0f / 32.0f);
    const size_t bstr = (size_t)1024 * SEQ;
#define HF_PTR(c_, part_, b_) (HYT + ((size_t)((part_) * NB + (b_)) * 1024 + (c_)) * SEQ)
    for (int c = blockIdx.x; c < 1024; c += gridDim.x) {
        float y[4][8];
#pragma unroll
        for (int b = 0; b < 4; ++b) { const bf16* vp = HF_PTR(c, 2, b);
#pragma unroll
            for (int i = 0; i < 8; ++i) y[b][i] = bf1(vp[tid + 512 * i]); }
#pragma unroll
        for (int ord = 0; ord < 2; ++ord) {
            f32x4 kreg[8]; bf16 xg[4][8];
            { const f32x4* kf = (const f32x4*)(KF + (size_t)(ord * 1024 + c) * 8192);
#pragma unroll
                for (int r = 0; r < 8; ++r) kreg[r] = kf[tid + 512 * r];
#pragma unroll
                for (int b = 0; b < 4; ++b) { const bf16* xp = HF_PTR(c, ord, b);
#pragma unroll
                    for (int i = 0; i < 8; ++i) xg[b][i] = xp[tid + 512 * i]; } }
            { f32x2 xa[16], xb[16];
#pragma unroll
                for (int k = 0; k < 8; ++k) { xa[k] = (f32x2){y[0][k], y[1][k]}; xa[k + 8] = (f32x2){0.f, 0.f}; xb[k] = (f32x2){y[2][k], y[3][k]}; xb[k + 8] = (f32x2){0.f, 0.f}; }
                dif16<true>(xa, thA); dif16<true>(xb, thA);
                __syncthreads();
#pragma unroll
                for (int k = 0; k < 16; ++k) { bufa[fphys(tid) + 544 * k] = xa[k]; bufb[fphys(tid) + 544 * k] = xb[k]; } }
            __syncthreads();
            fft_pass2<false, 34>(bufa, bufb, baseB, thB);
            __syncthreads();
            fft_pass2<false, 2>(bufa, bufb, baseC, thC);
            __syncthreads();
#pragma unroll
            for (int r = 0; r < 8; ++r) { const f32x4 kk = kreg[r];
#pragma unroll
                for (int q = 0; q < 2; ++q) { LAS f32x4* pp = (LAS f32x4*)((q ? bufb : bufa) + fphys(2 * tid) + 1088 * r); const f32x4 ab = *pp;
                    const float ax = ab.x + ab.z, ay = ab.y + ab.w, bx = ab.x - ab.z, by = ab.y - ab.w;
                    const float px = ax * kk.x - ay * kk.y, py = ax * kk.y + ay * kk.x, qx = bx * kk.z - by * kk.w, qy = bx * kk.w + by * kk.z;
                    *pp = (f32x4){px + qx, py + qy, px - qx, py - qy}; } }
            __syncthreads();
            fft_pass2<true, 2>(bufa, bufb, baseC, thC);
            __syncthreads();
            fft_pass2<true, 34>(bufa, bufb, baseB, thB);
            __syncthreads();
            { f32x2 xa[16], xb[16];
#pragma unroll
                for (int k = 0; k < 16; ++k) { xa[k] = bufa[fphys(tid) + 544 * k]; xb[k] = bufb[fphys(tid) + 544 * k]; }
                idit16(xa, thA); idit16(xb, thA);
                const float bias = hb[ord * 1024 + c];
#pragma unroll
                for (int k = 0; k < 8; ++k) { y[0][k] = bf1(xg[0][k]) * (xa[k].x + bias * y[0][k]); y[1][k] = bf1(xg[1][k]) * (xa[k].y + bias * y[1][k]);
                    y[2][k] = bf1(xg[2][k]) * (xb[k].x + bias * y[2][k]); y[3][k] = bf1(xg[3][k]) * (xb[k].y + bias * y[3][k]); } }
        }
#pragma unroll
        for (int b = 0; b < 4; ++b) { bf16* o0 = YT + ((size_t)b * 1024 + c) * SEQ;
#pragma unroll
            for (int i = 0; i < 8; ++i) o0[tid + 512 * i] = (bf16)f2bf(y[b][i]); }
    }
#undef HF_PTR
    (void)bstr;
}
__device__ __forceinline__ void ph_scan(const Args& A, int l, int tid) {
    float* KV = (float*)(wsb() + WS_KV);
    for (int gt = blockIdx.x * 512 + tid; gt < NB * 8 * 2 * 2048; gt += gridDim.x * 512) {
        const int bhd = gt >> 11, e4 = gt & 2047, dir = bhd & 1, h = (bhd >> 1) & 7;
        const float gC = ex2(inp(I_RDEC)[(l * 2 + dir) * 8 + h] * LOG2E * 128.0f);
        f32x4* base = (f32x4*)(KV + (size_t)bhd * 34 * 8192) + e4;
        f32x4 s = (f32x4){0.f, 0.f, 0.f, 0.f};
#pragma unroll 1
        for (int sb8 = 0; sb8 < 34; sb8 += 8) {
            f32x4 tv[8];
#pragma unroll
            for (int k = 0; k < 8; ++k) { const int step = min(sb8 + k, 33); const int ci = (dir == 0) ? step : (step == 0 ? 1 : (step == 1 ? 0 : 35 - step)); tv[k] = base[(size_t)ci * 2048]; }
#pragma unroll
            for (int k = 0; k < 8; ++k) { const int step = sb8 + k; if (step < 34) { const int ci = (dir == 0) ? step : (step == 0 ? 1 : (step == 1 ? 0 : 35 - step)); base[(size_t)ci * 2048] = s; s = s * gC + tv[k]; } } }
    }
}

__device__ __forceinline__ void ph_hypost(const Args& A, LAS unsigned char* lds, int tid) {
    LAS bf16* T = (LAS bf16*)lds;
    const bf16* YT = (const bf16*)(wsb() + WS_YT); bf16* YS = (bf16*)(wsb() + WS_YS);
    for (int u = blockIdx.x; u < 1024; u += gridDim.x) {
        const int cg = u & 3, tt = (u >> 2) & 63, b = u >> 8;
        __syncthreads();
        for (int q = tid; q < 2048; q += 512) { const int c = q >> 3, t8 = q & 7;
            *(LAS v4u*)(T + c * 72 + t8 * 8) = *(const v4u*)(YT + ((size_t)b * 1024 + cg * 256 + c) * SEQ + tt * 64 + t8 * 8); }
        __syncthreads();
        const int t = tid >> 3, c32 = tid & 7;
#pragma unroll
        for (int q = 0; q < 4; ++q) { const int cb = c32 * 32 + q * 8; v4u w;
            w.x = (unsigned)T[(cb + 0) * 72 + t] | ((unsigned)T[(cb + 1) * 72 + t] << 16); w.y = (unsigned)T[(cb + 2) * 72 + t] | ((unsigned)T[(cb + 3) * 72 + t] << 16);
            w.z = (unsigned)T[(cb + 4) * 72 + t] | ((unsigned)T[(cb + 5) * 72 + t] << 16); w.w = (unsigned)T[(cb + 6) * 72 + t] | ((unsigned)T[(cb + 7) * 72 + t] << 16);
            *(v4u*)(YS + (size_t)(b * SEQ + tt * 64 + t) * 1024 + cg * 256 + cb) = w; }
    }
}
__device__ __forceinline__ void ph_ret3(const Args& A, int l, int nctx_units, LAS unsigned char* lds, int tid) {
    LAS bf16* Qs = (LAS bf16*)lds; LAS bf16* Ks = Qs + 128 * 72; LAS bf16* Vs = Ks + 128 * 72; LAS bf16* Sf = Vs + 128 * 144; LAS bf16* Sb = Sf + 128 * 72;
    const bf16* Z = (const bf16*)(wsb() + WS_Z); const float* KV = (const float*)(wsb() + WS_KV); const f32x2* rope = (const f32x2*)(wsb() + WS_ROPE);
    bf16* YS = (bf16*)(wsb() + WS_YS) + (size_t)MT * 1024;
    const int lane = tid & 63, w = tid >> 6, g = lane >> 4, li = lane & 15;
    const int tok = tid >> 2, pp = tid & 3, a = (pp & 1) + ((pp >> 1) << 2);
    const int nunits = 1024 + nctx_units;
    v4u pk[2], pv[4];
#define R3_LOAD(uid_) do { R1_DEC(uid_, b2, h2, n2, ci2, m02, isc2) (void)n2; (void)isc2; const bf16* qr = Z + (m02 + tok) * INW + C_RQ + h2 * 64; const bf16* kr = Z + (m02 + tok) * INW + C_RK + h2 * 64; \
        (void)qr; pk[0] = *(const v4u*)(kr + 8 * a); pk[1] = *(const v4u*)(kr + 8 * a + 16); \
        (void)ci2; _Pragma("unroll") for (int e = 0; e < 4; ++e) { const int q = tid + 512 * e; pv[e] = *(const v4u*)(Z + (m02 + (q >> 4)) * INW + C_RV + h2 * 128 + (q & 15) * 8); } } while (0)
    int uid = blockIdx.x;
    if (uid < nunits) R3_LOAD(uid);
    for (; uid < nunits; uid += gridDim.x) {
        R1_DEC(uid, b, h, n, ci, m0, isc)
        const float lgf = inp(I_RDEC)[(l * 2 + 0) * 8 + h] * LOG2E, lgb = inp(I_RDEC)[(l * 2 + 1) * 8 + h] * LOG2E;
        __syncthreads();
        { const int t = n * 128 + tok; const int pos = (a < 4) ? (t >> 6) : (t & 63); const f32x2* rt = rope + pos * 16 + 8 * (a & 1);
            float lo[8], hi[8];
            { const bf16* qr = Z + (m0 + tok) * INW + C_RQ + h * 64; unpack8(*(const v4u*)(qr + 8 * a), lo); unpack8(*(const v4u*)(qr + 8 * a + 16), hi); }
            if (!isc) rope8(lo, hi, rt);
            *(LAS v4u*)(Qs + tok * 72 + 8 * a) = pack8(lo); *(LAS v4u*)(Qs + tok * 72 + 8 * a + 16) = pack8(hi);
            unpack8(pk[0], lo); unpack8(pk[1], hi);
            if (!isc) rope8(lo, hi, rt);
#pragma unroll
            for (int e = 0; e < 8; ++e) { lo[e] *= 0.125f; hi[e] *= 0.125f; }
            *(LAS v4u*)(Ks + tok * 72 + 8 * a) = pack8(lo); *(LAS v4u*)(Ks + tok * 72 + 8 * a + 16) = pack8(hi); }
#pragma unroll
        for (int e = 0; e < 4; ++e) { const int q = tid + 512 * e; *(LAS v4u*)(Vs + (q >> 4) * 144 + (q & 15) * 8) = pv[e]; }
#pragma unroll
        for (int dir = 0; dir < 2; ++dir) { LAS bf16* S = dir ? Sb : Sf; const f32x4* src = (const f32x4*)(KV + ((size_t)((b * 8 + h) * 2 + dir) * 34 + ci) * 8192);
#pragma unroll
            for (int e = 0; e < 4; ++e) { const int q = tid + 512 * e; const f32x4 v = src[q]; v2u wv; wv.x = pk2(v.x, v.y); wv.y = pk2(v.z, v.w); *(LAS v2u*)(S + (q >> 4) * 72 + (q & 15) * 4) = wv; } }
        __syncthreads();
        if (uid + (int)gridDim.x < nunits) R3_LOAD(uid + (int)gridDim.x);
        const int iq = 16 * w + li; const size_t mrow = m0 + iq;
        bf16x8 qf[2];
#pragma unroll
        for (int ks = 0; ks < 2; ++ks) qf[ks] = *(const LAS bf16x8*)(Qs + iq * 72 + 32 * ks + 8 * g);
        f32x4 s[8];
#pragma unroll
        for (int nn = 0; nn < 8; ++nn) { s[nn] = (f32x4){0.f, 0.f, 0.f, 0.f};
#pragma unroll
            for (int ks = 0; ks < 2; ++ks) s[nn] = mfma16(*(const LAS bf16x8*)(Ks + (16 * nn + li) * 72 + 32 * ks + 8 * g), qf[ks], s[nn]);
#pragma unroll
            for (int j = 0; j < 4; ++j) { const int d = iq - (16 * nn + 4 * g + j); s[nn][j] *= (d >= 0) ? ex2(lgf * (float)d) : ex2(lgb * (float)(-d)); } }
        f32x4 o[8];
#pragma unroll
        for (int nd = 0; nd < 8; ++nd) o[nd] = (f32x4){0.f, 0.f, 0.f, 0.f};
#pragma unroll
        for (int kk = 0; kk < 4; ++kk) {
            const bf16x8 pf = mk8(pk2(s[2 * kk][0], s[2 * kk][1]), pk2(s[2 * kk][2], s[2 * kk][3]), pk2(s[2 * kk + 1][0], s[2 * kk + 1][1]), pk2(s[2 * kk + 1][2], s[2 * kk + 1][3]));
#pragma unroll
            for (int nd = 0; nd < 8; ++nd) o[nd] = mfma16(tr_frag(Vs, 144, 32 * kk + 4 * g, 32 * kk + 16 + 4 * g, 16 * nd, li), pf, o[nd]); }
        v2u gq[8];
#pragma unroll
        for (int nd = 0; nd < 8; ++nd) gq[nd] = *(const v2u*)(Z + mrow * INW + C_RG + h * 128 + 16 * nd + 4 * g);
        const float xif = ex2(lgf * (float)(iq + 1)), xib = ex2(lgb * (float)(128 - iq));
        float ss = 0.f;
#pragma unroll
        for (int nd = 0; nd < 8; ++nd) { f32x4 tf = (f32x4){0.f, 0.f, 0.f, 0.f}, tb = (f32x4){0.f, 0.f, 0.f, 0.f};
#pragma unroll
            for (int ks = 0; ks < 2; ++ks) { tf = mfma16(*(const LAS bf16x8*)(Sf + (16 * nd + li) * 72 + 32 * ks + 8 * g), qf[ks], tf);
                tb = mfma16(*(const LAS bf16x8*)(Sb + (16 * nd + li) * 72 + 32 * ks + 8 * g), qf[ks], tb); }
            o[nd] = o[nd] + tf * xif + tb * xib;
            ss += (o[nd][0] * o[nd][0] + o[nd][1] * o[nd][1]) + (o[nd][2] * o[nd][2] + o[nd][3] * o[nd][3]); }
        ss += __shfl_xor(ss, 16); ss += __shfl_xor(ss, 32);
        const float rn = 1.0f / sqrtf(ss * (1.0f / 128.0f) + EPS);
#pragma unroll
        for (int nd = 0; nd < 8; ++nd) { const int dv = 16 * nd + 4 * g; const v2u gv = gq[nd];
            const float g0 = bflo(gv.x), g1 = bfhi(gv.x), g2 = bflo(gv.y), g3 = bfhi(gv.y);
            v2u wv; wv.x = pk2(g0 * __builtin_amdgcn_rcpf(1.0f + __expf(-g0)) * o[nd][0] * rn, g1 * __builtin_amdgcn_rcpf(1.0f + __expf(-g1)) * o[nd][1] * rn);
            wv.y = pk2(g2 * __builtin_amdgcn_rcpf(1.0f + __expf(-g2)) * o[nd][2] * rn, g3 * __builtin_amdgcn_rcpf(1.0f + __expf(-g3)) * o[nd][3] * rn);
            *(v2u*)(YS + mrow * 1024 + h * 128 + dv) = wv; }
    }
#undef R3_LOAD
#undef R1_DEC
}

__device__ __forceinline__ float gelu_fx(float x) { const float x2 = x * x; const float arg = x * (x2 * (-2.0f * 1.4426950408889634f * 0.7978845608028654f * 0.044715f) + (-2.0f * 1.4426950408889634f * 0.7978845608028654f));
    return x * __builtin_amdgcn_rcpf(1.0f + __builtin_amdgcn_exp2f(arg)); }
__device__ __forceinline__ void ph_ffnfix(const Args& A, int l, int Mrows, int tid) {
    const bf16* SA = (const bf16*)(wsb() + WS_SA); const bf16* SB = (const bf16*)(wsb() + WS_SB); bf16* U = (bf16*)(wsb() + WS_U);
    const float* cw = inp(I_FFCW) + (size_t)l * 3 * DFF; const float* cb = inp(I_FFCB) + (size_t)l * DFF;
    const int nblk = Mrows / 64;
    for (int u = blockIdx.x; u < nblk * 2; u += gridDim.x) {
        const int blk = u >> 1, hi = u & 1, R = blk * 64 + (hi ? 63 : 0);
        const bool seq_first = (R < ML) ? ((R & (SEQ - 1)) == 0) : ((R & (CL - 1)) == 0), seq_last = (R < ML) ? ((R & (SEQ - 1)) == SEQ - 1) : ((R & (CL - 1)) == CL - 1);
        const bf16* pprev = hi ? SA + ((size_t)blk * 4 + 2) * DFF : SA + ((size_t)(blk - 1) * 4 + 3) * DFF;
        const bf16* pcur = SA + ((size_t)blk * 4 + (hi ? 3 : 0)) * DFF;
        const bf16* pnext = hi ? SA + ((size_t)(blk + 1) * 4 + 0) * DFF : SA + ((size_t)blk * 4 + 1) * DFF;
        const bf16* pb = SB + ((size_t)blk * 2 + hi) * DFF;
        const bool zp = (!hi && seq_first), zn = (hi && seq_last);
        for (int q = tid; q < DFF / 8; q += 512) { const int f = q * 8;
            float am[8], a0[8], aq[8], bg[8]; const v4u z4 = (v4u){0u, 0u, 0u, 0u};
            unpack8(zp ? z4 : *(const v4u*)(pprev + f), am); unpack8(*(const v4u*)(pcur + f), a0); unpack8(zn ? z4 : *(const v4u*)(pnext + f), aq); unpack8(*(const v4u*)(pb + f), bg);
            float r[8];
#pragma unroll
            for (int e = 0; e < 8; ++e) r[e] = gelu_fx(cw[f + e] * am[e] + cw[DFF + f + e] * a0[e] + cw[2 * DFF + f + e] * aq[e] + cb[f + e]) * bg[e];
            *(v4u*)(U + (size_t)R * DFF + f) = pack8(r); }
    }
}
__device__ __forceinline__ void ph_final(const Args& A, int wave, int lane) {
    const int gw = blockIdx.x * NWAVES + wave, NGW = gridDim.x * NWAVES; const float* g = inp(I_GF);
    for (int m = gw; m < ML; m += NGW) { float* xr = outb() + (size_t)m * D; f32x4 v[8]; float ss = 0.f;
#pragma unroll
        for (int j = 0; j < 8; ++j) { v[j] = *(const f32x4*)(xr + (lane + 64 * j) * 4); ss += (v[j].x * v[j].x + v[j].y * v[j].y) + (v[j].z * v[j].z + v[j].w * v[j].w); }
        const float rstd = 1.0f / sqrtf(wave_sum(ss) * (1.0f / D) + EPS);
#pragma unroll
        for (int j = 0; j < 8; ++j) { const int idx = (lane + 64 * j) * 4; *(f32x4*)(xr + idx) = v[j] * rstd * *(const f32x4*)(g + idx); }
    }
}
#ifndef F_ALIGN
#define F_ALIGN PG8_ALIGN
#endif
#ifndef F_SP2
#define F_SP2 PG8_SP2
#endif
#ifndef SKEW_US
#define SKEW_US 0
#endif
__device__ __forceinline__ void spin_us(int us) { if (us > 0) { const unsigned long long t0 = __builtin_amdgcn_s_memrealtime(); while (__builtin_amdgcn_s_memrealtime() - t0 < (unsigned long long)us * 100ull) __builtin_amdgcn_s_sleep(8); } }
constexpr int FILT_F = 816, FILT_I = 896;
constexpr int BG_SPLIT = 22016;
constexpr int SEQ_PER_LAYER = 11, NSEQ = 1 + DEPTH * SEQ_PER_LAYER + 1;
__global__ void __launch_bounds__(NWAVES * 64, 2) fwd(Args A) {
    extern __shared__ __attribute__((aligned(16))) unsigned char lds_raw[];
    LAS unsigned char* lds = (LAS unsigned char*)lds_raw;
    volatile LAS unsigned* MISC = (volatile LAS unsigned*)(lds + MISC_OFF);
    for (int u = threadIdx.x; u < (LDS_BYTES - LDSCTL_OFF) / 4; u += NWAVES * 64) ((LAS unsigned*)(lds + LDSCTL_OFF))[u] = 0u;
    __syncthreads();
    (void)xcd_barrier_post((unsigned*)(wsb() + WS_CTL) + CW_BAR, MISC + 8);
    const int lo = A.seq_lo, hi = A.seq_hi;
#ifdef PROBE_K
    volatile LAS unsigned long long* pr_ = (volatile LAS unsigned long long*)(lds + MISC_OFF + 128);
    if (threadIdx.x == 0) { pr_[0] = 0ull; pr_[1] = __builtin_amdgcn_s_memrealtime(); }
#define pr_acc pr_[0]
#define pr_prev pr_[1]
#endif
#define G ((int)gridDim.x)
#ifdef PROBE_SUB
#define PROBE_K 999
#define SUBT(n, stmt) do { unsigned long long t0_ = 0; if ((n) == PROBE_SUB && blockIdx.x == PROBE_WG && threadIdx.x == 0) t0_ = __builtin_amdgcn_s_memrealtime(); stmt; if ((n) == PROBE_SUB && blockIdx.x == PROBE_WG && threadIdx.x == 0) pr_acc += __builtin_amdgcn_s_memrealtime() - t0_; } while (0)
#else
#define SUBT(n, stmt) do { stmt; } while (0)
#endif
#ifdef PROBE_K
#ifndef PROBE_WG
#define PROBE_WG 0
#endif
#ifndef PROBE_WAIT
#define PROBE_WAIT 0
#endif
#define PROBE_PH(s) (((s) == 0) ? 100 : (((s) - 1) % SEQ_PER_LAYER))
#define PROBE_ARRIVE(s) do { if (blockIdx.x == PROBE_WG && threadIdx.x == 0) { const unsigned long long now_ = __builtin_amdgcn_s_memrealtime(); if (!PROBE_WAIT && PROBE_PH(s) == PROBE_K) pr_acc += now_ - pr_prev; pr_prev = now_; } } while (0)
#define PROBE_EXIT(s) do { if (blockIdx.x == PROBE_WG && threadIdx.x == 0) { const unsigned long long now_ = __builtin_amdgcn_s_memrealtime(); if (PROBE_WAIT && PROBE_PH(s) == PROBE_K) pr_acc += now_ - pr_prev; pr_prev = now_; } } while (0)
#else
#define PROBE_ARRIVE(s) do { } while (0)
#define PROBE_EXIT(s) do { } while (0)
#endif
#define RUN(s) (lo <= (s) && (s) < hi)
#ifndef DUP
#define DUP 0
#endif
#define DUPN(id) ((((DUP) >> (id)) & 1) ? 2 : 1)
#define TID_HERE const int tid = otid(), lane = tid & 63, wave = __builtin_amdgcn_readfirstlane(tid >> 6); (void)lane; (void)wave
#ifdef ONLY
#define PH_ON(k) ((k) == ONLY)
#elif defined(SKIP)
#define PH_ON(k) ((k) != SKIP)
#else
#define PH_ON(k) true
#endif
#define SEAM(s) do { PROBE_ARRIVE(s); if (RUN((s) + 1)) { XcdBarrier bar_; bar_.bar = (unsigned*)(wsb() + WS_CTL) + CW_BAR; bar_.x = xb_xcc_id(); bar_.st = (volatile LAS unsigned*)(lds + MISC_OFF) + 8; xcd_barrier(bar_); if (DUPN(16) > 1) xcd_barrier(bar_); } PROBE_EXIT(s); } while (0)
#define H ((bf16*)(wsb() + WS_H))
#define Z ((bf16*)(wsb() + WS_Z))
#define ACC ((bf16*)(wsb() + WS_ACC))
#define U ((bf16*)(wsb() + WS_U))
#define YS ((bf16*)(wsb() + WS_YS))
#define XC ((float*)(wsb() + WS_XC))
#define WIN ((const bf16*)(psb(l & 1) + PS_WIN))
#define WBR ((const bf16*)(psb(l & 1) + PS_WBR))
#define WOUT ((const bf16*)(psb(l & 1) + PS_WOUT))
#define WF1 ((const bf16*)(psb(l & 1) + PS_WF1))
#define WF2 ((const bf16*)(psb(l & 1) + PS_WF2))

    if (PH_ON(100) && RUN(0)) { TID_HERE; ph_prologue(A, lds, tid); __syncthreads(); ph_convert(A, 0, 0, 0, CONV_ITEMS, (int)blockIdx.x, G, lds, wave, lane); __syncthreads(); for (int fl = 0; fl < DEPTH; ++fl) ph_filt1(A, fl, 0, (int)blockIdx.x, G, lds, tid); SEAM(0); }

    for (int l = 0; l < DEPTH; ++l) {
        const int sb = 1 + l * SEQ_PER_LAYER;
        if (hi <= sb || lo >= sb + SEQ_PER_LAYER) continue;
        const bool lastl = (l == DEPTH - 1);
        const int Mrows = lastl ? ML : MT, nctx = lastl ? 0 : 64;
#define modl ((const float*)(wsb() + WS_MOD) + (size_t)l * 5 * 12288)
#define xlat_in ((l == 0) ? inp(I_X) : (const float*)outb())
#define xctx_in ((l == 0) ? inp(I_CTX) : (const float*)XC)

        if (PH_ON(0) && RUN(sb + 0)) { TID_HERE;
            if (l == 0) ph_filt2(A, 0, 0, 0, 1024, (int)blockIdx.x, G, lds, tid);
            else ph_convert(A, l, l & 1, 0, CONV_ITEMS, (int)blockIdx.x, G, lds, wave, lane);
            ph_norm(xlat_in, xctx_in, inp(I_G1) + (size_t)l * D, modl, 0, D, H, MT, (l > 0) ? (const float*)(wsb() + WS_SLAB) : (const float*)nullptr,
                    (const float*)(wsb() + WS_MOD) + ((size_t)(l - 1) * 5 + 4) * 12288 + 5 * D, XC, wave, lane);
            SEAM(sb + 0);
        }
        if (PH_ON(1) && RUN(sb + 1)) { TID_HERE;
            if (SKEW_US > 0 && (blockIdx.x & 8)) spin_us(SKEW_US);
            { pg8::Gemm g{H, WIN, opq(MT), opq(INW), opq(D), 0}; pg8::StaticOrder S; S.init(g.M, g.N, G, (int)blockIdx.x);
              pg8::EpiStore E{Z, INW, (unsigned char*)(wsb() + WS_GQ), C_GT, 3 * D};
              for (int r_ = 0; r_ < DUPN(15); ++r_) pg8::gemm_phase<pg8::EpiStore, pg8::StaticOrder, PG8_ALIGN, PG8_SP2>(lds, g, S, E); }
            SEAM(sb + 1);
        }
        if (PH_ON(2) && RUN(sb + 2)) { TID_HERE;
            SUBT(1, ph_hyprep(A, l, lds, tid));
            SUBT(2, ph_ret1(A, l, 64, lds, tid));
            SUBT(3, ph_natt(A, l, 0, lds, tid));
            SUBT(4, if (!lastl) ph_hyctx(A, l, lds, tid));
            SEAM(sb + 2);
        }
        if (PH_ON(3) && RUN(sb + 3)) { TID_HERE;
#ifndef NO_D1
            SUBT(5, ph_hyfft(A, l, lds, tid));
#endif
#ifndef NO_D2
            SUBT(6, ph_scan(A, l, tid));
#endif
            SEAM(sb + 3);
        }
        if (PH_ON(4) && RUN(sb + 4)) { TID_HERE;
            SUBT(7, ph_hypost(A, lds, tid));
            SUBT(8, ph_ret3(A, l, nctx, lds, tid));
            if (!lastl) { __syncthreads(); ph_natt(A, l, 1, lds, tid); }
            SEAM(sb + 4);
        }
        if (PH_ON(5) && RUN(sb + 5)) { TID_HERE;
            __syncthreads();
            for (int r_ = 0; r_ < DUPN(13); ++r_)
            for (int i = 0; i < 3; ++i) {
                pg8::Gemm g{YS + (size_t)i * MT * 1024, WBR + (size_t)i * D * 1024, Mrows, opq(D), opq(1024), 0}; pg8::StaticOrder S; S.init(g.M, g.N, G, (int)blockIdx.x);
                pg8::EpiMerge E{ACC, (const unsigned char*)(wsb() + WS_GQ) + i * D, 3 * D, i == 0 ? 1 : 0};
                pg8::gemm_phase<pg8::EpiMerge, pg8::StaticOrder, F_ALIGN, F_SP2>(lds, g, S, E);
            }
            if (!lastl && blockIdx.x >= 32) { __syncthreads(); ph_filt2(A, l + 1, (l + 1) & 1, 0, FILT_F, (int)blockIdx.x - 32, G - 32, lds, tid); }
            SEAM(sb + 5);
        }
        if (PH_ON(6) && RUN(sb + 6)) { TID_HERE;
            __syncthreads();
            { pg8::Gemm g{ACC, WOUT, opq(ML), opq(D), opq(D), 0}; pg8::StaticOrder S; S.init(g.M, g.N, G, (int)blockIdx.x);
              pg8::EpiResid E{xlat_in, xctx_in, outb(), XC, modl, 2 * D};
              pg8::gemm_phase<pg8::EpiResid, pg8::StaticOrder, PG8_ALIGN, PG8_SP2>(lds, g, S, E); }
            if (!lastl) { pg8::Gemm g{ACC, WOUT, opq(MT), opq(D), opq(D / NSPLIT), opq(D)}; pg8::CtxSplitOrder S{NSPLIT, D / NSPLIT, (int)blockIdx.x};
              pg8::EpiSlab E{(float*)(wsb() + WS_SLAB), D / NSPLIT};
              pg8::gemm_phase<pg8::EpiSlab, pg8::CtxSplitOrder, PG8_ALIGN, PG8_SP2>(lds, g, S, E); }
            SEAM(sb + 6);
        }
        if (PH_ON(7) && RUN(sb + 7)) { TID_HERE;
            ph_norm(outb(), xctx_in, inp(I_G2) + (size_t)l * D, modl, 3 * D, 4 * D, H, Mrows, (const float*)(wsb() + WS_SLAB), modl + (size_t)4 * 12288 + 2 * D, XC, wave, lane);
            SEAM(sb + 7);
        }
        if (PH_ON(8) && RUN(sb + 8)) { TID_HERE;
            __syncthreads();
            if (SKEW_US > 0 && (blockIdx.x & 8)) spin_us(SKEW_US);
            pg8::Gemm g{H, WF1, Mrows, opq(NFF), opq(D), 0}; pg8::StaticOrder S; S.init(g.M, g.N, G, (int)blockIdx.x);
            pg8::EpiFfn E{U, (bf16*)(wsb() + WS_SA), (bf16*)(wsb() + WS_SB), inp(I_FFCW) + (size_t)l * 3 * DFF, inp(I_FFCB) + (size_t)l * DFF};
            for (int r_ = 0; r_ < DUPN(14); ++r_) pg8::gemm_phase<pg8::EpiFfn, pg8::StaticOrder, PG8_ALIGN, PG8_SP2>(lds, g, S, E);
            if (!lastl && blockIdx.x >= 176) { __syncthreads(); ph_filt2(A, l + 1, (l + 1) & 1, FILT_F, FILT_I, (int)blockIdx.x - 176, G - 176, lds, tid); }
            SEAM(sb + 8);
        }
        if (PH_ON(9) && RUN(sb + 9)) { TID_HERE;
            for (int r_ = 0; r_ < DUPN(11); ++r_) ph_ffnfix(A, l, Mrows, tid);
            SEAM(sb + 9);
        }
        if (PH_ON(10) && RUN(sb + 10)) { TID_HERE;
            __syncthreads();
            { pg8::Gemm g{U, WF2, opq(ML), opq(D), opq(DFF), 0}; pg8::StaticOrder S; S.init(g.M, g.N, G, (int)blockIdx.x);
              pg8::EpiResid E{outb(), XC, outb(), XC, modl, 5 * D};
              pg8::gemm_phase<pg8::EpiResid, pg8::StaticOrder, PG8_ALIGN, PG8_SP2>(lds, g, S, E); }
            if (!lastl) { pg8::Gemm g{U, WF2, opq(MT), opq(D), opq(DFF / NSPLIT), opq(DFF)}; pg8::CtxSplitOrder S{NSPLIT, DFF / NSPLIT, (int)blockIdx.x};
              pg8::EpiSlab E{(float*)(wsb() + WS_SLAB), DFF / NSPLIT};
              pg8::gemm_phase<pg8::EpiSlab, pg8::CtxSplitOrder, PG8_ALIGN, PG8_SP2>(lds, g, S, E); }
            if (!lastl && blockIdx.x >= 128) { __syncthreads(); ph_filt2(A, l + 1, (l + 1) & 1, FILT_I, 1024, (int)blockIdx.x - 128, G - 128, lds, tid); }
            SEAM(sb + 10);
        }
    }
    if (PH_ON(101) && RUN(NSEQ - 1)) { TID_HERE; ph_final(A, wave, lane); }
#ifdef PROBE_K
    if (blockIdx.x == PROBE_WG && threadIdx.x == 0) { const unsigned long long t0 = __builtin_amdgcn_s_memrealtime(); while (__builtin_amdgcn_s_memrealtime() - t0 < 4ull * pr_acc) __builtin_amdgcn_s_sleep(8); }
#endif
#undef RUN
#undef SEAM
#undef H
#undef Z
#undef ACC
#undef U
#undef YS
#undef XC
#undef WIN
#undef WBR
#undef WOUT
#undef WF1
#undef WF2
#undef G
#undef modl
#undef xlat_in
#undef xctx_in
}

extern "C" void kernel_launch(void* const* d_in, const int* in_sizes, int n_in, void* d_out, int out_size, void* d_ws, size_t ws_size, hipStream_t stream) {
    static int grid = 0;
    if (grid == 0) {
        if (n_in != 27 || out_size != ML * D || ws_size < WS_END) { fprintf(stderr, "kernel_launch: unexpected shapes (n_in %d out %d ws %zu need %zu)\n", n_in, out_size, ws_size, (size_t)WS_END); grid = -1; return; }
        int dev = 0, cus = 0, per_cu = 0;
        if (hipGetDevice(&dev) != hipSuccess || hipDeviceGetAttribute(&cus, hipDeviceAttributeMultiprocessorCount, dev) != hipSuccess) { grid = -1; return; }
        if (hipFuncSetAttribute((const void*)fwd, hipFuncAttributeMaxDynamicSharedMemorySize, LDS_BYTES) != hipSuccess) { fprintf(stderr, "kernel_launch: hipFuncSetAttribute failed\n"); grid = -1; return; }
        if (hipOccupancyMaxActiveBlocksPerMultiprocessor(&per_cu, (const void*)fwd, NWAVES * 64, LDS_BYTES) != hipSuccess || per_cu < 1) fprintf(stderr, "kernel_launch: occupancy query says %d\n", per_cu);
        (void)hipGetLastError();
        grid = cus;
    }
    if (grid < 0) return;
    (void)hipMemsetAsync((char*)d_ws + WS_CTL, 0, CTL_ZERO_BYTES, stream);
    Args a{};
    for (int i = 0; i < 27; ++i) a.in[i] = (const float*)d_in[i];
    a.out = (float*)d_out; a.ws = (unsigned char*)d_ws;
#if MK_SINGLE
    a.seq_lo = 0; a.seq_hi = NSEQ;
    hipLaunchKernelGGL(fwd, dim3(grid), dim3(NWAVES * 64), LDS_BYTES, stream, a);
#else
    for (int s = 0; s < NSEQ; ++s) { a.seq_lo = s; a.seq_hi = s + 1; hipLaunchKernelGGL(fwd, dim3(grid), dim3(NWAVES * 64), LDS_BYTES, stream, a); }
#endif
}
```

```cpp
#include <hip/hip_runtime.h>
#include <cstdio>
#include <cstdint>
#ifndef MK_SINGLE
#define MK_SINGLE 1
#endif
namespace pg8 {
#define PG8_LAS __attribute__((address_space(3)))
typedef unsigned short bf16_t;
typedef short bf16x8 __attribute__((ext_vector_type(8)));
typedef float f32x4 __attribute__((ext_vector_type(4)));
typedef unsigned u32x4 __attribute__((ext_vector_type(4)));
constexpr int BM = 256, BK = 64, HALF = 128, HTB = HALF * BK * 2  , STAGE_BYTES = 8 * HTB, NXCD = 8, WGM = 8;

__host__ __device__ __forceinline__ int lds_byte(int r, int c) { const int st = (r >> 4) * 2 + (c >> 5), rr = r & 15, cc = c & 31, ob = rr * 64 + cc * 2; return st * 1024 + (ob ^ (((ob >> 9) & 1) << 5)); }
__host__ __device__ __forceinline__ void stage_rc(int b, int& R, int& C) { const int st = b / 1024, sb = b % 1024, swz = sb ^ (((sb >> 9) & 1) << 5); R = (st >> 1) * 16 + swz / 64; C = (st & 1) * 32 + (swz % 64) / 2; }
__host__ __device__ __forceinline__ int perm32(int rho) { const int n = rho >> 4, i = rho & 15; return 8 * (i >> 2) + 4 * n + (i & 3); }

struct Unit { int pm, pn, ko, br; long ao, bo; };
struct Gemm { const bf16_t* A; const bf16_t* Bt; int M, N, K, ld; };

struct StaticOrder {
    int nM, nN, nwg, G, c;
    __host__ __device__ void init(int M, int N, int G_, int c_) { nM = M / BM; nN = N / BM; nwg = nM * nN; G = G_; c = c_; }
    __host__ __device__ bool next(int i, Unit& u) const {
        const long L = (long)i * G + c; if (L >= nwg) return false;
        int wgid = (int)L; { const int q = nwg / NXCD, r = nwg % NXCD, xcd = wgid % NXCD, off = wgid / NXCD; wgid = (xcd < r ? xcd * (q + 1) : r * (q + 1) + (xcd - r) * q) + off; }
        const int nig = WGM * nN, gid = wgid / nig, fm = gid * WGM, gsz = (nM - fm) < WGM ? (nM - fm) : WGM;
        u.pm = fm + ((wgid % nig) % gsz); u.pn = (wgid % nig) / gsz; u.ko = 0; u.br = 0; u.ao = 0; u.bo = 0; return true;
    }
    __device__ __forceinline__ void a_ready(const Unit&) const {}
    __device__ __forceinline__ void done(const Unit&) const {}
};
__device__ __forceinline__ unsigned cvt_pk_bf16(float lo, float hi) { unsigned r; asm volatile("v_cvt_pk_bf16_f32 %0, %1, %2" : "=v"(r) : "v"(lo), "v"(hi)); return r; }
typedef float f32x2 __attribute__((ext_vector_type(2)));
__device__ __forceinline__ float bflo(unsigned w) { return __uint_as_float(w << 16); }
__device__ __forceinline__ float bfhi(unsigned w) { return __uint_as_float(w & 0xffff0000u); }
__device__ __forceinline__ float sigm(float x) { return __builtin_amdgcn_rcpf(1.0f + __expf(-x)); }
struct EpiStore {
    static constexpr bool PERM = true, AFTER_DRAIN = false, CHAIN = false;
    bf16_t* O; int ldc; unsigned char* GQ; int gate_col0, gq_ld;
    __device__ __forceinline__ void operator()(const f32x4 (&acc)[2][2][4][2], const Unit& u, int wr, int wc, int fr, int fq) const {
        const int row0 = u.pm * BM + wr * 64 + fr, col0 = u.pn * BM + wc * 32 + 8 * fq;
        if (GQ != nullptr && u.pn * BM >= gate_col0) {
            const int gc0 = col0 - gate_col0;
#pragma unroll
            for (int ai = 0; ai < 2; ++ai)
#pragma unroll
                for (int m = 0; m < 4; ++m) { unsigned char* rowp = GQ + (size_t)(row0 + ai * HALF + m * 16) * gq_ld + gc0;
#pragma unroll
                    for (int bj = 0; bj < 2; ++bj) { const f32x4 v0 = acc[ai][bj][m][0], v1 = acc[ai][bj][m][1];
                        unsigned q[8];
#pragma unroll
                        for (int t = 0; t < 4; ++t) { q[t] = max(1u, (unsigned)(sigm(v0[t]) * 255.0f + 0.5f)); q[4 + t] = max(1u, (unsigned)(sigm(v1[t]) * 255.0f + 0.5f)); }
                        typedef unsigned u32x2 __attribute__((ext_vector_type(2)));
                        u32x2 w; w.x = q[0] | (q[1] << 8) | (q[2] << 16) | (q[3] << 24); w.y = q[4] | (q[5] << 8) | (q[6] << 16) | (q[7] << 24);
                        __builtin_nontemporal_store(w, (u32x2*)(rowp + bj * HALF)); } }
            return;
        }
#pragma unroll
        for (int ai = 0; ai < 2; ++ai)
#pragma unroll
            for (int m = 0; m < 4; ++m) { bf16_t* rowp = O + (size_t)(row0 + ai * HALF + m * 16) * ldc + col0;
#pragma unroll
                for (int bj = 0; bj < 2; ++bj) { const f32x4 v0 = acc[ai][bj][m][0], v1 = acc[ai][bj][m][1];
                    u32x4 w; w.x = cvt_pk_bf16(v0[0], v0[1]); w.y = cvt_pk_bf16(v0[2], v0[3]); w.z = cvt_pk_bf16(v1[0], v1[1]); w.w = cvt_pk_bf16(v1[2], v1[3]);
                    __builtin_nontemporal_store(w, (u32x4*)(rowp + bj * HALF)); } }
    }
};
struct EpiMerge {
    static constexpr bool PERM = true, AFTER_DRAIN = false, CHAIN = true;
    bf16_t* O; const unsigned char* gate0; int ldg;
    __device__ __forceinline__ bool chain(f32x4 (&acc)[2][2][4][2], const Unit& u, int wr, int wc, int fr, int fq) const {
        const int row0 = u.pm * BM + wr * 64 + fr, col0 = u.pn * BM + wc * 32 + 8 * fq;
        typedef unsigned u32x2 __attribute__((ext_vector_type(2)));
        const bool last = (u.br == 2); const unsigned char* ga = gate0 + u.br * 2048;
#pragma unroll
        for (int ai = 0; ai < 2; ++ai)
#pragma unroll
            for (int m = 0; m < 4; ++m) { const size_t row = (size_t)(row0 + ai * HALF + m * 16);
#pragma unroll
                for (int bj = 0; bj < 2; ++bj) { const int col = col0 + bj * HALF;
                    const u32x2 qa = *(const u32x2*)(ga + row * ldg + col);
                    float s[8];
                    if (!last) { const u32x2 qb = *(const u32x2*)(ga + 2048 + row * ldg + col);
#pragma unroll
                        for (int t = 0; t < 4; ++t) { s[t] = (float)((qa.x >> (8 * t)) & 255u) * __builtin_amdgcn_rcpf((float)((qb.x >> (8 * t)) & 255u)); s[4 + t] = (float)((qa.y >> (8 * t)) & 255u) * __builtin_amdgcn_rcpf((float)((qb.y >> (8 * t)) & 255u)); }
                    } else {
#pragma unroll
                        for (int t = 0; t < 4; ++t) { s[t] = (float)((qa.x >> (8 * t)) & 255u) * (1.0f / 255.0f); s[4 + t] = (float)((qa.y >> (8 * t)) & 255u) * (1.0f / 255.0f); } }
                    f32x4 v0 = acc[ai][bj][m][0], v1 = acc[ai][bj][m][1];
                    v0 = v0 * (f32x4){s[0], s[1], s[2], s[3]}; v1 = v1 * (f32x4){s[4], s[5], s[6], s[7]};
                    if (last) { u32x4 w; w.x = cvt_pk_bf16(v0[0], v0[1]); w.y = cvt_pk_bf16(v0[2], v0[3]); w.z = cvt_pk_bf16(v1[0], v1[1]); w.w = cvt_pk_bf16(v1[2], v1[3]);
                        *(u32x4*)(O + row * 2048 + col) = w; }
                    else { acc[ai][bj][m][0] = v0; acc[ai][bj][m][1] = v1; } } }
        return !last;
    }
};
struct EpiResid {
    static constexpr bool PERM = false, AFTER_DRAIN = false, CHAIN = false;
    const float* base_lat; const float* base_ctx; float* out_lat; float* out_ctx; const float* modl; int goff;
    __device__ __forceinline__ void operator()(const f32x4 (&acc)[2][2][4][2], const Unit& u, int wr, int wc, int fr, int fq) const {
        const bool isctx = u.pm >= 64; const int r = isctx ? 4 : (u.pm >> 4);
        const float* gvp = modl + (size_t)r * 12288 + goff;
        const float* bs = isctx ? base_ctx : base_lat; float* os = isctx ? out_ctx : out_lat;
        const int row0 = (isctx ? u.pm - 64 : u.pm) * BM + wr * 64 + fr, col0 = u.pn * BM + wc * 32 + 4 * fq;
        f32x4 g4[2][2];
#pragma unroll
        for (int bj = 0; bj < 2; ++bj)
#pragma unroll
            for (int n = 0; n < 2; ++n) g4[bj][n] = *(const f32x4*)(gvp + col0 + bj * HALF + n * 16);
#pragma unroll
        for (int ai = 0; ai < 2; ++ai)
#pragma unroll
            for (int m = 0; m < 4; ++m) { const size_t off = (size_t)(row0 + ai * HALF + m * 16) * 2048 + col0;
#pragma unroll
                for (int bj = 0; bj < 2; ++bj)
#pragma unroll
                    for (int n = 0; n < 2; ++n) { const f32x4 b4 = *(const f32x4*)(bs + off + bj * HALF + n * 16);
                        *(f32x4*)(os + off + bj * HALF + n * 16) = b4 + g4[bj][n] * acc[ai][bj][m][n]; } }
    }
};

__device__ __forceinline__ float dpp_ror1(float v) { return __int_as_float(__builtin_amdgcn_update_dpp(0, __float_as_int(v), 0x121, 0xf, 0xf, false)); }
__device__ __forceinline__ float dpp_rol1(float v) { return __int_as_float(__builtin_amdgcn_update_dpp(0, __float_as_int(v), 0x12f, 0xf, 0xf, false)); }
__device__ __forceinline__ float gelu_fast(float x) { const float x2 = x * x; const float arg = x * (x2 * (-2.0f * 1.4426950408889634f * 0.7978845608028654f * 0.044715f) + (-2.0f * 1.4426950408889634f * 0.7978845608028654f));
    return x * __builtin_amdgcn_rcpf(1.0f + __builtin_amdgcn_exp2f(arg)); }
struct EpiFfn {
    static constexpr bool PERM = true, AFTER_DRAIN = false, CHAIN = false;
    bf16_t* U; bf16_t* SA; bf16_t* SB; const float* cw; const float* cb;
    __device__ __forceinline__ void operator()(const f32x4 (&acc)[2][2][4][2], const Unit& u, int wr, int wc, int fr, int fq) const {
        const int f0 = u.pn * 128 + wc * 32 + 8 * fq;
        f32x4 w0[2], w1[2], w2[2], bb[2];
#pragma unroll
        for (int n = 0; n < 2; ++n) { w0[n] = *(const f32x4*)(cw + f0 + 4 * n); w1[n] = *(const f32x4*)(cw + 5632 + f0 + 4 * n); w2[n] = *(const f32x4*)(cw + 2 * 5632 + f0 + 4 * n); bb[n] = *(const f32x4*)(cb + f0 + 4 * n); }
#pragma unroll
        for (int ai = 0; ai < 2; ++ai) {
            const int row0 = u.pm * BM + ai * HALF + wr * 64 + fr, blk = u.pm * 4 + ai * 2 + wr;
            f32x4 o[4][2];
#pragma unroll
            for (int n = 0; n < 2; ++n)
#pragma unroll
                for (int e = 0; e < 4; ++e) {
                    const float a0 = acc[ai][0][0][n][e], a1 = acc[ai][0][1][n][e], a2 = acc[ai][0][2][n][e], a3 = acc[ai][0][3][n][e];
                    const float r0 = dpp_ror1(a0), r1 = dpp_ror1(a1), r2 = dpp_ror1(a2), r3 = dpp_ror1(a3);
                    const float l0 = dpp_rol1(a0), l1 = dpp_rol1(a1), l2 = dpp_rol1(a2), l3 = dpp_rol1(a3);
                    const bool first = (fr == 0), last = (fr == 15);
                    const float p0 = r0, p1 = first ? r0 : r1, p2 = first ? r1 : r2, p3 = first ? r2 : r3;
                    const float n0 = last ? l1 : l0, n1 = last ? l2 : l1, n2 = last ? l3 : l2, n3 = l3;
                    const float k0 = w0[n][e], k1 = w1[n][e], k2 = w2[n][e], kb = bb[n][e];
                    o[0][n][e] = gelu_fast(k0 * p0 + k1 * a0 + k2 * n0 + kb) * acc[ai][1][0][n][e];
                    o[1][n][e] = gelu_fast(k0 * p1 + k1 * a1 + k2 * n1 + kb) * acc[ai][1][1][n][e];
                    o[2][n][e] = gelu_fast(k0 * p2 + k1 * a2 + k2 * n2 + kb) * acc[ai][1][2][n][e];
                    o[3][n][e] = gelu_fast(k0 * p3 + k1 * a3 + k2 * n3 + kb) * acc[ai][1][3][n][e];
                }
#pragma unroll
            for (int m = 0; m < 4; ++m) { u32x4 w; w.x = cvt_pk_bf16(o[m][0][0], o[m][0][1]); w.y = cvt_pk_bf16(o[m][0][2], o[m][0][3]); w.z = cvt_pk_bf16(o[m][1][0], o[m][1][1]); w.w = cvt_pk_bf16(o[m][1][2], o[m][1][3]);
                *(u32x4*)(U + (size_t)(row0 + m * 16) * 5632 + f0) = w; }
            const int sel = (fr == 0) ? 0 : (fr == 1) ? 1 : (fr == 14) ? 2 : (fr == 15) ? 3 : -1;
            if (sel >= 0) { const int m = (sel < 2) ? 0 : 3;
                const f32x4 a0 = (m == 0) ? acc[ai][0][0][0] : acc[ai][0][3][0], a1 = (m == 0) ? acc[ai][0][0][1] : acc[ai][0][3][1];
                u32x4 w; w.x = cvt_pk_bf16(a0[0], a0[1]); w.y = cvt_pk_bf16(a0[2], a0[3]); w.z = cvt_pk_bf16(a1[0], a1[1]); w.w = cvt_pk_bf16(a1[2], a1[3]);
                *(u32x4*)(SA + ((size_t)blk * 4 + sel) * 5632 + f0) = w;
                if (sel == 0 || sel == 3) { const f32x4 b0 = (m == 0) ? acc[ai][1][0][0] : acc[ai][1][3][0], b1 = (m == 0) ? acc[ai][1][0][1] : acc[ai][1][3][1];
                    u32x4 v; v.x = cvt_pk_bf16(b0[0], b0[1]); v.y = cvt_pk_bf16(b0[2], b0[3]); v.z = cvt_pk_bf16(b1[0], b1[1]); v.w = cvt_pk_bf16(b1[2], b1[3]);
                    *(u32x4*)(SB + ((size_t)blk * 2 + (sel == 0 ? 0 : 1)) * 5632 + f0) = v; } }
        }
    }
};

struct CtxSplitOrder {
    int nsplit, klen, c;
    __device__ __forceinline__ bool next(int i, Unit& u) const { if (i > 0 || c >= 32 * nsplit) return false; const int tile = c / nsplit, s = c - tile * nsplit; u.pm = 64 + (tile >> 3); u.pn = tile & 7; u.ko = s * klen; u.br = 0; u.ao = 0; u.bo = 0; return true; }
    __device__ __forceinline__ void a_ready(const Unit&) const {}
    __device__ __forceinline__ void done(const Unit&) const {}
};
struct EpiSlab {
    static constexpr bool PERM = false, AFTER_DRAIN = false, CHAIN = false;
    float* slab; int klen;
    __device__ __forceinline__ void operator()(const f32x4 (&acc)[2][2][4][2], const Unit& u, int wr, int wc, int fr, int fq) const {
        float* os = slab + (size_t)(u.ko / klen) * 1024 * 2048;
        const int row0 = (u.pm - 64) * BM + wr * 64 + fr, col0 = u.pn * BM + wc * 32 + 4 * fq;
#pragma unroll
        for (int ai = 0; ai < 2; ++ai)
#pragma unroll
            for (int m = 0; m < 4; ++m) { const size_t off = (size_t)(row0 + ai * HALF + m * 16) * 2048 + col0;
#pragma unroll
                for (int bj = 0; bj < 2; ++bj)
#pragma unroll
                    for (int n = 0; n < 2; ++n) *(f32x4*)(os + off + bj * HALF + n * 16) = acc[ai][bj][m][n]; }
    }
};

struct MergeOrder {
    StaticOrder so; long a_stride, b_stride;
    __device__ __forceinline__ bool next(int i, Unit& u) const { const int ti = i / 3, br = i - ti * 3; if (!so.next(ti, u)) return false; u.br = br; u.ao = br * a_stride; u.bo = br * b_stride; return true; }
    __device__ __forceinline__ void a_ready(const Unit&) const {}
    __device__ __forceinline__ void done(const Unit&) const {}
};
template <class Epi, class Sched, bool ALIGN_EPI = false, bool SP2 = false>
__device__ __forceinline__ void gemm_phase(PG8_LAS unsigned char* lds, const Gemm g, const Sched& S, const Epi& E) {
    int tid_ = threadIdx.x; asm volatile("" : "+v"(tid_)); const int tid = tid_, wid = __builtin_amdgcn_readfirstlane(tid >> 6), lane = tid & 63, wr = wid >> 2, wc = wid & 3, fr = lane & 15, fq = lane >> 4;
    const int K = g.K, nt = K / BK, LD = g.ld ? g.ld : g.K;
    unsigned voffA[2], voffB[2];
#pragma unroll
    for (int i = 0; i < 2; ++i) { int R, C; stage_rc(tid * 16 + i * 8192, R, C); const int Rb = Epi::PERM ? ((R & ~31) + perm32(R & 31)) : R;
        voffA[i] = (unsigned)(R * LD + C) * 2u; voffB[i] = (unsigned)(Rb * LD + C) * 2u; }
    const size_t kstep = (size_t)(BK * 2);
    const size_t hstep = (size_t)HALF * LD * 2;
    const size_t tstep = 2 * hstep;
    const unsigned ldsw = (unsigned)wid * 1024u;
    const int aoff = lds_byte(wr * 64 + fr, fq * 8), boff = lds_byte(wc * 32 + fr, fq * 8);
#define PG8_SA(b, h) (((b) * 2 + (h)) * HTB)
#define PG8_SB(b, h) ((4 + (b) * 2 + (h)) * HTB)
#define PG8_STAGE(bufoff, gbase, voff) do { _Pragma("unroll") for (int _i = 0; _i < 2; ++_i) \
        __builtin_amdgcn_global_load_lds((const unsigned*)((const char*)(gbase) + (voff)[_i]), (PG8_LAS unsigned*)(lds + (bufoff) + ldsw + _i * 8192), 16, 0, 0); } while (0)
#define PG8_LDA(dst, b, h) do { _Pragma("unroll") for (int m = 0; m < 4; ++m) _Pragma("unroll") for (int k = 0; k < 2; ++k) dst[m][k] = *(const PG8_LAS bf16x8*)(lds + PG8_SA(b, h) + aoff + m * 2048 + k * 1024); } while (0)
#define PG8_LDB(dst, b, h) do { _Pragma("unroll") for (int n = 0; n < 2; ++n) _Pragma("unroll") for (int k = 0; k < 2; ++k) dst[n][k] = *(const PG8_LAS bf16x8*)(lds + PG8_SB(b, h) + boff + n * 2048 + k * 1024); } while (0)
#define PG8_MMA(ai, bj, At, Bt) do { __builtin_amdgcn_s_setprio(1); _Pragma("unroll") for (int m = 0; m < 4; ++m) _Pragma("unroll") for (int n = 0; n < 2; ++n) _Pragma("unroll") for (int k = 0; k < 2; ++k) \
        acc[ai][bj][m][n] = __builtin_amdgcn_mfma_f32_16x16x32_bf16(Bt[n][k], At[m][k], acc[ai][bj][m][n], 0, 0, 0); __builtin_amdgcn_s_setprio(0); } while (0)
#define PG8_WAIT_V(n) asm volatile("s_waitcnt vmcnt(" #n ")" ::: "memory")
#define PG8_WAIT_L(n) asm volatile("s_waitcnt lgkmcnt(" #n ")" ::: "memory")
#define PG8_BAR __builtin_amdgcn_s_barrier()
#define PG8_SCHED __builtin_amdgcn_sched_barrier(0)
    Unit cur, nxt; int ui = 0;
    if (!S.next(0, cur)) return;
    f32x4 acc[2][2][4][2];
#pragma unroll
    for (int a = 0; a < 2; ++a)
#pragma unroll
        for (int b = 0; b < 2; ++b)
#pragma unroll
            for (int m = 0; m < 4; ++m)
#pragma unroll
                for (int n = 0; n < 2; ++n) acc[a][b][m][n] = (f32x4){0.f, 0.f, 0.f, 0.f};
    bf16x8 At[4][2], B0[2][2], B1[2][2];
    const char* cA = (const char*)g.A + (size_t)cur.pm * tstep + (size_t)cur.ko * 2 + cur.ao; const char* cB = (const char*)g.Bt + (size_t)cur.pn * tstep + (size_t)cur.ko * 2 + cur.bo;
    S.a_ready(cur);
    if constexpr (SP2) {
        PG8_STAGE(PG8_SB(0, 0), cB, voffB); PG8_STAGE(PG8_SB(0, 1), cB + hstep, voffB); PG8_STAGE(PG8_SA(0, 0), cA, voffA); PG8_STAGE(PG8_SA(0, 1), cA + hstep, voffA);
        if (wr == 1) PG8_BAR;
        PG8_WAIT_V(2); PG8_BAR;
        PG8_STAGE(PG8_SB(1, 0), cB + kstep, voffB); PG8_STAGE(PG8_SA(1, 0), cA + kstep, voffA); PG8_STAGE(PG8_SB(1, 1), cB + hstep + kstep, voffB);
        PG8_WAIT_V(6); PG8_BAR;
    } else {
        PG8_STAGE(PG8_SB(0, 0), cB, voffB); PG8_STAGE(PG8_SA(0, 0), cA, voffA); PG8_STAGE(PG8_SB(0, 1), cB + hstep, voffB); PG8_STAGE(PG8_SA(0, 1), cA + hstep, voffA);
        if (wr == 1) PG8_BAR;
        PG8_WAIT_V(4); PG8_BAR;
        PG8_STAGE(PG8_SB(1, 0), cB + kstep, voffB); PG8_STAGE(PG8_SA(1, 0), cA + kstep, voffA); PG8_STAGE(PG8_SB(1, 1), cB + hstep + kstep, voffB);
        PG8_WAIT_V(6); PG8_BAR;
    }
    for (;;) {
        const bool has_next = S.next(ui + 1, nxt);
        const char* nA = has_next ? (const char*)g.A + (size_t)nxt.pm * tstep + (size_t)nxt.ko * 2 + nxt.ao : cA; const char* nB = has_next ? (const char*)g.Bt + (size_t)nxt.pn * tstep + (size_t)nxt.ko * 2 + nxt.bo : cB;
        for (int t = 0; t < nt; t += 2) {
            const bool last = (t == nt - 2);
            const char* a1 = cA + (size_t)(t + 1) * kstep;
            const char* a2 = last ? nA : cA + (size_t)(t + 2) * kstep; const char* b2 = last ? nB : cB + (size_t)(t + 2) * kstep;
            const char* a3 = a2 + kstep; const char* b3 = b2 + kstep;
            if (last && has_next) S.a_ready(nxt);
            if constexpr (SP2) {
            PG8_LDB(B0, 0, 0); PG8_LDB(B1, 0, 1); PG8_SCHED; PG8_LDA(At, 0, 0); PG8_STAGE(PG8_SA(1, 1), a1 + hstep, voffA);
            PG8_WAIT_V(8); PG8_WAIT_L(0); PG8_BAR; PG8_MMA(0, 0, At, B0); PG8_MMA(0, 1, At, B1); PG8_BAR; PG8_SCHED;
            PG8_LDA(At, 0, 1); PG8_STAGE(PG8_SB(0, 0), b2, voffB); PG8_STAGE(PG8_SB(0, 1), b2 + hstep, voffB); PG8_STAGE(PG8_SA(0, 0), a2, voffA);
            PG8_WAIT_V(8); PG8_WAIT_L(0); PG8_BAR; PG8_MMA(1, 0, At, B0); PG8_MMA(1, 1, At, B1); PG8_BAR; PG8_SCHED;
            PG8_LDB(B0, 1, 0); PG8_LDB(B1, 1, 1); PG8_SCHED; PG8_LDA(At, 1, 0); PG8_STAGE(PG8_SA(0, 1), a2 + hstep, voffA);
            PG8_WAIT_V(8); PG8_WAIT_L(0); PG8_BAR; PG8_MMA(0, 0, At, B0); PG8_MMA(0, 1, At, B1); PG8_BAR; PG8_SCHED;
            PG8_LDA(At, 1, 1); PG8_STAGE(PG8_SB(1, 0), b3, voffB); PG8_STAGE(PG8_SB(1, 1), b3 + hstep, voffB); PG8_STAGE(PG8_SA(1, 0), a3, voffA);
            PG8_WAIT_V(8); PG8_WAIT_L(0); PG8_BAR; PG8_MMA(1, 0, At, B0); PG8_MMA(1, 1, At, B1); PG8_BAR; PG8_SCHED;
            } else {
            PG8_LDB(B0, 0, 0); PG8_SCHED; PG8_LDA(At, 0, 0); PG8_STAGE(PG8_SA(1, 1), a1 + hstep, voffA);
            PG8_WAIT_L(8); PG8_BAR; PG8_WAIT_L(0); PG8_MMA(0, 0, At, B0); PG8_BAR; PG8_SCHED;
            PG8_LDB(B1, 0, 1); PG8_STAGE(PG8_SB(0, 0), b2, voffB);
            PG8_BAR; PG8_WAIT_L(0); PG8_MMA(0, 1, At, B1); PG8_BAR;
            PG8_LDA(At, 0, 1); PG8_STAGE(PG8_SA(0, 0), a2, voffA);
            PG8_BAR; PG8_WAIT_L(0); PG8_MMA(1, 0, At, B0); PG8_BAR; PG8_SCHED;
            PG8_STAGE(PG8_SB(0, 1), b2 + hstep, voffB);
            PG8_WAIT_V(6); PG8_BAR; PG8_MMA(1, 1, At, B1); PG8_BAR;
            PG8_LDB(B0, 1, 0); PG8_SCHED; PG8_LDA(At, 1, 0); PG8_STAGE(PG8_SA(0, 1), a2 + hstep, voffA);
            PG8_WAIT_L(8); PG8_BAR; PG8_WAIT_L(0); PG8_MMA(0, 0, At, B0); PG8_BAR; PG8_SCHED;
            PG8_LDB(B1, 1, 1); PG8_STAGE(PG8_SB(1, 0), b3, voffB);
            PG8_BAR; PG8_WAIT_L(0); PG8_MMA(0, 1, At, B1); PG8_BAR;
            PG8_LDA(At, 1, 1); PG8_STAGE(PG8_SA(1, 0), a3, voffA);
            PG8_BAR; PG8_WAIT_L(0); PG8_MMA(1, 0, At, B0); PG8_BAR; PG8_SCHED;
            PG8_STAGE(PG8_SB(1, 1), b3 + hstep, voffB);
            PG8_WAIT_V(6); PG8_BAR; PG8_MMA(1, 1, At, B1); PG8_BAR;
            }
        }
        if constexpr (ALIGN_EPI) { if (wr == 0) PG8_BAR; }
        bool keep_acc = false;
        if constexpr (Epi::CHAIN) { keep_acc = E.chain(acc, cur, wr, wc, fr, fq); S.done(cur); }
        else if constexpr (!Epi::AFTER_DRAIN) { E(acc, cur, wr, wc, fr, fq); S.done(cur); }
        if (!has_next) break;
        if (!keep_acc)
#pragma unroll
        for (int a = 0; a < 2; ++a)
#pragma unroll
            for (int b = 0; b < 2; ++b)
#pragma unroll
                for (int m = 0; m < 4; ++m)
#pragma unroll
                    for (int n = 0; n < 2; ++n) acc[a][b][m][n] = (f32x4){0.f, 0.f, 0.f, 0.f};
        cur = nxt; cA = nA; cB = nB; ++ui;
        if constexpr (ALIGN_EPI) { if (wr == 1) PG8_BAR; }
    }
    PG8_WAIT_V(0);
    if constexpr (!ALIGN_EPI) { if (wr == 0) PG8_BAR; }
    PG8_BAR;
    if constexpr (Epi::AFTER_DRAIN) { E.fused(acc, cur, wr, wc, fr, fq, lds, wid, lane); S.done(cur); }
#undef PG8_SA
#undef PG8_SB
#undef PG8_STAGE
#undef PG8_LDA
#undef PG8_LDB
#undef PG8_MMA
#undef PG8_WAIT_V
#undef PG8_WAIT_L
#undef PG8_BAR
#undef PG8_SCHED
}
}
#ifndef PG8_SP2
#define PG8_SP2 true
#endif
#ifndef PG8_ALIGN
#define PG8_ALIGN true
#endif
constexpr int D = 2048, NB = 4, SEQ = 4096, CL = 256, DEPTH = 4;
constexpr int ML = NB * SEQ, MC = NB * CL, MT = ML + MC;
constexpr int INW = 15360, DFF = 5632, NFF = 2 * DFF;
constexpr int C_RK = 0, C_RV = 512, C_NK = 1536, C_NV = 2560, C_RQ = 3584, C_RG = 4096, C_NQ = 5120, C_HY = 6144, C_GT = 9216;
constexpr float EPS = 1e-6f;
constexpr int NWAVES = 8;
constexpr size_t al256(size_t x) { return (x + 255) & ~(size_t)255; }
constexpr size_t WS_CTL = 0, CTL_ZERO_BYTES = 1u << 20;
constexpr size_t WS_MOD = WS_CTL + CTL_ZERO_BYTES;
constexpr size_t WS_ROPE = WS_MOD + al256((size_t)4 * 5 * 12288 * 4);
constexpr size_t PS_FH2 = 0;
constexpr size_t PS_FH2B = PS_FH2 + al256((size_t)4352 * 64 * 4);
constexpr size_t PS_TAPC = PS_FH2B + al256((size_t)4352 * 64 * 2);
constexpr size_t PS_KF = PS_TAPC + al256((size_t)2 * 2 * 1024 * 256 * 4);
constexpr size_t PS_WIN = PS_KF + al256((size_t)2 * 1024 * 8192 * 8);
constexpr size_t PS_WBR = PS_WIN + al256((size_t)INW * D * 2);
constexpr size_t PS_WOUT = PS_WBR + al256((size_t)3 * D * 1024 * 2);
constexpr size_t PS_WF1 = PS_WOUT + al256((size_t)D * D * 2);
constexpr size_t PS_WF2 = PS_WF1 + al256((size_t)NFF * D * 2);
constexpr size_t PS_BYTES = PS_WF2 + al256((size_t)D * DFF * 2);
constexpr size_t WS_PSET = WS_ROPE + al256(64 * 16 * 8);
constexpr size_t WS_XC = WS_PSET + 2 * PS_BYTES;
constexpr size_t WS_H = WS_XC + al256((size_t)MC * D * 4);
constexpr size_t WS_Z = WS_H + al256((size_t)MT * D * 2);
constexpr size_t WS_HYT = WS_Z + al256((size_t)MT * INW * 2);
constexpr size_t WS_YT = WS_HYT + al256((size_t)3 * NB * 1024 * SEQ * 2);
constexpr size_t WS_YS = WS_YT + al256((size_t)NB * 1024 * SEQ * 2);
constexpr size_t WS_ACC = WS_YS + al256((size_t)3 * MT * 1024 * 2);
constexpr size_t WS_U = WS_ACC + al256((size_t)MT * D * 2);
constexpr size_t WS_KV = WS_U + al256((size_t)MT * DFF * 2);
constexpr size_t WS_SA = WS_KV + al256((size_t)NB * 8 * 2 * 34 * 8192 * 4);
constexpr size_t WS_SB = WS_SA + al256((size_t)272 * 4 * DFF * 2);
constexpr size_t WS_SLAB = WS_SB + al256((size_t)272 * 2 * DFF * 2);
constexpr size_t WS_FB4 = WS_SLAB + al256((size_t)4 * MC * D * 4);
constexpr size_t WS_GQ = WS_FB4 + al256((size_t)4 * 4352 * 64 * 2);
constexpr size_t WS_END = WS_GQ + al256((size_t)MT * 3 * D);
constexpr int NSPLIT = 4;
constexpr int CW_BAR = 4096, CW_DYN = 8192;
constexpr int RING_BYTES = 131072, LDS_BYTES = 147456, LDSCTL_OFF = LDS_BYTES - 1024, MISC_OFF = LDSCTL_OFF + 320;

#define GAS __attribute__((address_space(1)))
#define LAS __attribute__((address_space(3)))
typedef unsigned short bf16;
typedef unsigned v4u __attribute__((ext_vector_type(4)));
typedef unsigned v2u __attribute__((ext_vector_type(2)));
typedef float f32x4 __attribute__((ext_vector_type(4)));
typedef float f32x2 __attribute__((ext_vector_type(2)));
typedef short bf16x8 __attribute__((ext_vector_type(8)));
typedef GAS unsigned gu32;
#define LDS_WAIT() asm volatile("s_waitcnt lgkmcnt(0)" ::: "memory")
__device__ __forceinline__ unsigned f2bf(float f) { unsigned u = __builtin_bit_cast(unsigned, f); return (u + 0x7fffu + ((u >> 16) & 1u)) >> 16; }
typedef __bf16 bf16x2_t __attribute__((ext_vector_type(2)));
__device__ __forceinline__ unsigned pk2(float lo, float hi) { const bf16x2_t v = {(__bf16)lo, (__bf16)hi}; return __builtin_bit_cast(unsigned, v); }
__device__ __forceinline__ float bflo(unsigned w) { return __uint_as_float(w << 16); }
__device__ __forceinline__ float bfhi(unsigned w) { return __uint_as_float(w & 0xffff0000u); }
__device__ __forceinline__ float bf1(bf16 b) { return __uint_as_float(((unsigned)b) << 16); }
__device__ __forceinline__ bf16x8 mk8(unsigned a, unsigned b, unsigned c, unsigned d) { v4u v = (v4u){a, b, c, d}; return __builtin_bit_cast(bf16x8, v); }
__device__ __forceinline__ f32x4 mfma16(bf16x8 a, bf16x8 b, f32x4 c) { return __builtin_amdgcn_mfma_f32_16x16x32_bf16(a, b, c, 0, 0, 0); }
__device__ __forceinline__ float sin_rev(float r) { return __builtin_amdgcn_sinf(r - floorf(r)); }
__device__ __forceinline__ float cos_rev(float r) { return __builtin_amdgcn_cosf(r - floorf(r)); }
__device__ __forceinline__ float sin_rad(float x) { return sin_rev(x * 0.15915494309189535f); }
__device__ __forceinline__ float ex2(float x) { return __builtin_amdgcn_exp2f(x); }
__device__ __forceinline__ float wave_sum(float v) {
#pragma unroll
    for (int o = 1; o < 64; o <<= 1) v += __shfl_xor(v, o);
    return v;
}
__device__ __forceinline__ int otid() { int t = threadIdx.x; asm volatile("" : "+v"(t)); return t; }
__device__ __forceinline__ int opq(int v) { asm volatile("" : "+s"(v)); return v; }
#define XB_TMO      128
#define XB_XCNT(j)  (256  + 64 * (j))
#define XB_XSUB(j)  (1280 + 64 * (j))
#define XB_XGEN(j)  (2304 + 64 * (j))
#define XB_TOP      3328
#define XB_TOPGEN   3392
#define XCD_BAR_WORDS 3456
#define XB_SPIN_CAP (1u << 18)

__device__ __forceinline__ unsigned xb_ld(unsigned* p)              { return __hip_atomic_load(p, __ATOMIC_RELAXED, __HIP_MEMORY_SCOPE_AGENT); }
__device__ __forceinline__ unsigned xb_add(unsigned* p, unsigned v) { return __hip_atomic_fetch_add(p, v, __ATOMIC_RELAXED, __HIP_MEMORY_SCOPE_AGENT); }
__device__ __forceinline__ unsigned xb_xcc_id() { return (unsigned)__builtin_amdgcn_s_getreg((3 << 11) | 20) & 0xFu; }
#define XB_SPIN(cond, bar) do { unsigned _sp = 0; while (cond) { __builtin_amdgcn_s_sleep(1); \
    if ((++_sp & 255u) == 0u) { if (xb_ld(&(bar)[XB_TMO])) break; if (_sp > XB_SPIN_CAP) { atomicAdd(&(bar)[XB_TMO], 1u); break; } } } } while (0)

struct XcdBarrier {
    unsigned* bar; unsigned x;
    volatile LAS unsigned* st;
};

__device__ __forceinline__ XcdBarrier xcd_barrier_post(unsigned* bar, volatile LAS unsigned* st) {
    XcdBarrier b; b.bar = bar; b.x = xb_xcc_id(); b.st = st;
    if (threadIdx.x == 0) (void)xb_add(&bar[XB_XCNT(b.x)], 1u);
    return b;
}
__device__ __forceinline__ void xcd_barrier_complete(unsigned* bar, unsigned x, unsigned& nloc, unsigned& nx) {
    const unsigned G = gridDim.x * gridDim.y * gridDim.z;
    unsigned sum, cnt, mine, sp = 0u;
    for (;;) {
        sum = 0u; cnt = 0u; mine = 0u;
#pragma unroll
        for (unsigned j = 0; j < 16; ++j) { const unsigned c = xb_ld(&bar[XB_XCNT(j)]); sum += c; cnt += (c > 0u) ? 1u : 0u; mine = (j == x) ? c : mine; }
        if (sum == G) break;
        __builtin_amdgcn_s_sleep(1);
        if ((++sp & 255u) == 0u) { if (xb_ld(&bar[XB_TMO])) break; if (sp > XB_SPIN_CAP) { atomicAdd(&bar[XB_TMO], 1u); break; } }
    }
    nloc = mine > 0u ? mine : 1u; nx = cnt > 0u ? cnt : 1u;
}

__device__ __forceinline__ void xcd_barrier(const XcdBarrier& b) {
    asm volatile("s_waitcnt vmcnt(0)" ::: "memory");
    __syncthreads();
    if (threadIdx.x == 0) {
        unsigned* bar = b.bar;
        __builtin_amdgcn_s_waitcnt(0);
        unsigned nloc = b.st[0], nx = b.st[1];
        if (nloc == 0u) { xcd_barrier_complete(bar, b.x, nloc, nx); b.st[0] = nloc; b.st[1] = nx; }
        const unsigned old = xb_add(&bar[XB_XSUB(b.x)], 1u);
        const unsigned gen = old / nloc;
        if (old + 1u == (gen + 1u) * nloc) {
            __builtin_amdgcn_fence(__ATOMIC_RELEASE, "agent");
            asm volatile("s_waitcnt vmcnt(0)" ::: "memory");
            const unsigned og = xb_add(&bar[XB_TOP], 1u);
            const unsigned tg = og / nx;
            if (og + 1u == (tg + 1u) * nx) xb_add(&bar[XB_TOPGEN], 1u);
            else XB_SPIN(xb_ld(&bar[XB_TOPGEN]) == tg, bar);
            __builtin_amdgcn_fence(__ATOMIC_ACQUIRE, "agent");
            xb_add(&bar[XB_XGEN(b.x)], 1u);
            asm volatile("s_waitcnt vmcnt(0)" ::: "memory");
        } else {
            XB_SPIN(xb_ld(&bar[XB_XGEN(b.x)]) == gen, bar);
            __builtin_amdgcn_fence(__ATOMIC_ACQUIRE, "agent");
            asm volatile("s_waitcnt vmcnt(0)" ::: "memory");
        }
    }
    __syncthreads();
}
__device__ __forceinline__ void p0_transpose_item(const float* W, int K, int N, bf16* WT, int row_off, LAS float* scr, int item, int lane) {
    const int nblk = N / 32, kb = item / nblk, nb = item % nblk, k0 = 64 * kb, n0 = 32 * nb;
#pragma unroll 16
    for (int i = 0; i < 32; ++i) { const int kk = 2 * i + (lane >> 5); scr[kk * 33 + (lane & 31)] = __builtin_nontemporal_load(W + (size_t)(k0 + kk) * N + n0 + (lane & 31)); }
    LDS_WAIT(); asm volatile("" ::: "memory");
    const int c = lane & 7;
#pragma unroll
    for (int j = 0; j < 4; ++j) { const int n = (lane >> 3) + 8 * j; const LAS float* s = scr + (8 * c) * 33 + n;
        v4u o; o.x = pk2(s[0 * 33], s[1 * 33]); o.y = pk2(s[2 * 33], s[3 * 33]); o.z = pk2(s[4 * 33], s[5 * 33]); o.w = pk2(s[6 * 33], s[7 * 33]);
        __builtin_nontemporal_store(o, (GAS v4u*)(WT + (size_t)(row_off + n0 + n) * K + k0 + 8 * c)); }
    LDS_WAIT(); asm volatile("" ::: "memory");
}
struct Args { const float* in[27]; float* out; unsigned char* ws; int seq_lo, seq_hi; };
__device__ __forceinline__ const float* inp(int i) { const char* ka = (const char*)__builtin_amdgcn_kernarg_segment_ptr(); int off = i * 8; asm volatile("" : "+s"(off)); return *(const float* const*)(ka + off); }
__device__ __forceinline__ unsigned char* wsb() { const char* ka = (const char*)__builtin_amdgcn_kernarg_segment_ptr(); int off = 27 * 8 + 8; asm volatile("" : "+s"(off)); return *(unsigned char* const*)(ka + off); }
__device__ __forceinline__ float* outb() { const char* ka = (const char*)__builtin_amdgcn_kernarg_segment_ptr(); int off = 27 * 8; asm volatile("" : "+s"(off)); return *(float* const*)(ka + off); }
__device__ __forceinline__ unsigned char* psb(int set) { return wsb() + WS_PSET + (size_t)set * PS_BYTES; }
enum { I_X = 0, I_C, I_CTX, I_CCTX, I_WMOD, I_BMOD, I_G1, I_G2, I_WIN, I_HCW, I_HCB, I_FW1, I_FB1, I_FW2, I_FB2, I_FW3, I_FFQ, I_HBIAS, I_RDEC, I_RPB, I_WBR, I_WOUT, I_FFW1, I_FFCW, I_FFCB, I_FFW2, I_GF };

__device__ __forceinline__ void ph_prologue(const Args& A, LAS unsigned char* lds, int tid) {
    LAS float* sc = (LAS float*)lds;
    LAS float* red = sc + 5 * 2048;
    const float* c = inp(I_C); const float* cc = inp(I_CCTX);
    for (int i = tid; i < 5 * 2048; i += 512) { const int r = i >> 11, k = i & 2047; const float v = (r < 4) ? c[r * 2048 + k] : cc[k]; sc[i] = v / (1.0f + __expf(-v)); }
    __syncthreads();
    float* mod = (float*)(wsb() + WS_MOD);
    const int kq = tid >> 6, col = tid & 63;
    for (int u = blockIdx.x; u < DEPTH * 192; u += gridDim.x) {
        const int l = u / 192, n0 = (u % 192) * 64;
        const float* W = inp(I_WMOD) + (size_t)l * 2048 * 12288 + n0 + col;
        float a0 = 0.f, a1 = 0.f, a2 = 0.f, a3 = 0.f, a4 = 0.f;
#pragma unroll 16
        for (int k = kq * 256; k < kq * 256 + 256; ++k) { const float w = W[(size_t)k * 12288];
            a0 += sc[k] * w; a1 += sc[2048 + k] * w; a2 += sc[4096 + k] * w; a3 += sc[6144 + k] * w; a4 += sc[8192 + k] * w; }
        red[(kq * 5 + 0) * 64 + col] = a0; red[(kq * 5 + 1) * 64 + col] = a1; red[(kq * 5 + 2) * 64 + col] = a2; red[(kq * 5 + 3) * 64 + col] = a3; red[(kq * 5 + 4) * 64 + col] = a4;
        __syncthreads();
        if (tid < 320) { const int r = tid >> 6; float s = inp(I_BMOD)[l * 12288 + n0 + col];
#pragma unroll
            for (int q = 0; q < 8; ++q) s += red[(q * 5 + r) * 64 + col];
            mod[((size_t)l * 5 + r) * 12288 + n0 + col] = s; }
        __syncthreads();
    }
    if (blockIdx.x == 0) { f32x2* rope = (f32x2*)(wsb() + WS_ROPE);
        for (int i = tid; i < 1024; i += 512) { const int pos = i >> 4, j = i & 15; const float inv = exp2f(-(float)j * (13.287712379549449f / 16.0f));
            const float rev = (float)pos * inv * 0.15915494309189535f; rope[i] = (f32x2){cos_rev(rev), sin_rev(rev)}; } }
}

__device__ __forceinline__ void ph_convert(const Args& A, int l, int set, int it_lo, int it_hi, int wk, int nwk, LAS unsigned char* lds, int wave, int lane) {
    LAS float* scr = (LAS float*)(lds + wave * 16384);
    const int gw = wk * NWAVES + wave, NGW = nwk * NWAVES;
    constexpr int I_IN = (D / 64) * (INW / 32), I_BR = (1024 / 64) * (D / 32), I_OUT = (D / 64) * (D / 32), I_F1 = (D / 64) * (NFF / 32);
    const float* win = inp(I_WIN) + (size_t)l * D * INW; const float* wbr = inp(I_WBR) + (size_t)l * 3 * 1024 * D; const float* wout = inp(I_WOUT) + (size_t)l * D * D;
    const float* wf1 = inp(I_FFW1) + (size_t)l * D * NFF; const float* wf2 = inp(I_FFW2) + (size_t)l * DFF * D;
    unsigned char* ps = psb(set);
    bf16* WIN = (bf16*)(ps + PS_WIN); bf16* WBR = (bf16*)(ps + PS_WBR); bf16* WOUT = (bf16*)(ps + PS_WOUT); bf16* WF1 = (bf16*)(ps + PS_WF1); bf16* WF2 = (bf16*)(ps + PS_WF2);
    for (int it = it_lo + gw; it < it_hi; it += NGW) {
        int r = it;
        if (r < I_IN) { p0_transpose_item(win, D, INW, WIN, 0, scr, r, lane); continue; } r -= I_IN;
        if (r < I_BR) { p0_transpose_item(wbr, 1024, D, WBR, 0, scr, r, lane); continue; } r -= I_BR;
        if (r < I_BR) { p0_transpose_item(wbr + (size_t)1024 * D, 1024, D, WBR + (size_t)D * 1024, 0, scr, r, lane); continue; } r -= I_BR;
        if (r < I_BR) { p0_transpose_item(wbr + (size_t)2 * 1024 * D, 1024, D, WBR + (size_t)2 * D * 1024, 0, scr, r, lane); continue; } r -= I_BR;
        if (r < I_OUT) { p0_transpose_item(wout, D, D, WOUT, 0, scr, r, lane); continue; } r -= I_OUT;
        if (r < I_F1) { const int n0 = (r % (NFF / 32)) * 32, f0 = (n0 < DFF) ? n0 : n0 - DFF, nrow = 256 * (f0 >> 7) + ((n0 < DFF) ? 0 : 128) + (f0 & 127);
            p0_transpose_item(wf1, D, NFF, WF1, nrow - n0, scr, r, lane); continue; } r -= I_F1;
        p0_transpose_item(wf2, DFF, D, WF2, 0, scr, r, lane);
    }
}
constexpr int CONV_ITEMS = (D / 64) * (INW / 32) + 3 * (1024 / 64) * (D / 32) + (D / 64) * (D / 32) + (D / 64) * (NFF / 32) + (DFF / 64) * (D / 32);
__device__ __forceinline__ void ph_filt1(const Args& A, int l, int set, int wk, int nwk, LAS unsigned char* lds, int tid) {
    LAS float* feat = (LAS float*)lds;
    LAS float* h1 = feat + 8 * 33;
    LAS float* w1s = h1 + 8 * 64;
    LAS float* w2s = w1s + 33 * 64;
    const float* w1 = inp(I_FW1) + (size_t)l * 33 * 64; const float* b1 = inp(I_FB1) + l * 64; const float* w2 = inp(I_FW2) + (size_t)l * 64 * 64; const float* b2 = inp(I_FB2) + l * 64;
    const float* fq = inp(I_FFQ) + l * 64; bf16* FH2B = (bf16*)(wsb() + WS_FB4) + (size_t)l * 4352 * 64;
    const int pl = tid >> 6, o = tid & 63;
    __syncthreads();
    for (int i = tid; i < 33 * 64; i += 512) w1s[i] = w1[i];
    for (int i = tid; i < 64 * 64; i += 512) w2s[i] = w2[i];
    const float b1o = b1[o], b2o = b2[o], fqo = fq[o];
    __syncthreads();
    for (int u = wk; u < 544; u += nwk) {
        const int pos = u * 8 + pl; const bool isc = pos >= 4096; const int Lf = isc ? 256 : 4096, tp = isc ? pos - 4096 : pos;
        if (o < 33) { float f;
            if (o == 0) f = (float)tp / (float)(Lf - 1);
            else { const int i = (o - 1) & 15; const float fr = 1e-4f + (float)i * ((15.0f - 1e-4f) / 15.0f); const float rev = fr * (float)tp / (float)Lf; f = (o <= 16) ? cos_rev(rev) : -sin_rev(rev); }
            feat[pl * 33 + o] = f; }
        __syncthreads();
        float a = b1o;
#pragma unroll 11
        for (int i = 0; i < 33; ++i) a += feat[pl * 33 + i] * w1s[i * 64 + o];
        h1[pl * 64 + o] = sin_rad(fqo * a);
        __syncthreads();
        float b = b2o;
#pragma unroll 16
        for (int j = 0; j < 64; ++j) b += h1[pl * 64 + j] * w2s[j * 64 + o];
        FH2B[(size_t)pos * 64 + o] = (bf16)f2bf(sin_rad(fqo * b));
        __syncthreads();
    }
}
__device__ __forceinline__ void ph_norm(const float* xlat, const float* xctx, const float* g, const float* modl, int sh_off, int sc_off, bf16* H, int Mrows, const float* slab, const float* sgate, float* xc_out, int wave, int lane) {
    const int gw = blockIdx.x * NWAVES + wave, NGW = gridDim.x * NWAVES;
    for (int base = gw * 8; base < ML; base += NGW * 8) {
        const float* mv = modl + (size_t)(base >> 12) * 12288;
        f32x4 Gv[8], Sv[8];
#pragma unroll
        for (int j = 0; j < 8; ++j) { const int idx = (lane + 64 * j) * 4; Gv[j] = *(const f32x4*)(g + idx) * (*(const f32x4*)(mv + sc_off + idx) + 1.0f); Sv[j] = *(const f32x4*)(mv + sh_off + idx); }
        f32x4 v[8], nx[8];
#pragma unroll
        for (int j = 0; j < 8; ++j) nx[j] = *(const f32x4*)(xlat + (size_t)base * D + (lane + 64 * j) * 4);
#pragma unroll 1
        for (int i = 0; i < 8; ++i) { const int m = base + i; float ss = 0.f;
#pragma unroll
            for (int j = 0; j < 8; ++j) { v[j] = nx[j]; ss += (v[j].x * v[j].x + v[j].y * v[j].y) + (v[j].z * v[j].z + v[j].w * v[j].w); }
            if (i < 7) {
#pragma unroll
                for (int j = 0; j < 8; ++j) nx[j] = *(const f32x4*)(xlat + (size_t)(m + 1) * D + (lane + 64 * j) * 4); }
            const float rstd = 1.0f / sqrtf(wave_sum(ss) * (1.0f / D) + EPS);
#pragma unroll
            for (int j = 0; j < 8; ++j) { const int idx = (lane + 64 * j) * 4; const f32x4 y = v[j] * rstd * Gv[j] + Sv[j];
                v2u w; w.x = pk2(y.x, y.y); w.y = pk2(y.z, y.w); *(v2u*)(H + (size_t)m * D + idx) = w; } }
    }
    for (int m = ML + gw; m < Mrows; m += NGW) {
        const float* xr = xctx + (size_t)(m - ML) * D; const float* mv = modl + (size_t)4 * 12288;
        f32x4 v[8]; float ss = 0.f;
#pragma unroll
        for (int j = 0; j < 8; ++j) { const int idx = (lane + 64 * j) * 4; v[j] = *(const f32x4*)(xr + idx);
            if (slab) { const float* sp = slab + (size_t)(m - ML) * D + idx; f32x4 p = *(const f32x4*)sp;
#pragma unroll
                for (int q = 1; q < NSPLIT; ++q) p = p + *(const f32x4*)(sp + (size_t)q * MC * D);
                v[j] = v[j] + *(const f32x4*)(sgate + idx) * p; *(f32x4*)(xc_out + (size_t)(m - ML) * D + idx) = v[j]; }
            ss += (v[j].x * v[j].x + v[j].y * v[j].y) + (v[j].z * v[j].z + v[j].w * v[j].w); }
        const float rstd = 1.0f / sqrtf(wave_sum(ss) * (1.0f / D) + EPS);
#pragma unroll
        for (int j = 0; j < 8; ++j) { const int idx = (lane + 64 * j) * 4;
            const f32x4 gg = *(const f32x4*)(g + idx), sh = *(const f32x4*)(mv + sh_off + idx), sc = *(const f32x4*)(mv + sc_off + idx);
            const f32x4 y = v[j] * rstd * gg * (sc + 1.0f) + sh;
            v2u w; w.x = pk2(y.x, y.y); w.y = pk2(y.z, y.w);
            *(v2u*)(H + (size_t)m * D + idx) = w; }
    }
}

__device__ __forceinline__ int fphys(int i) { return i + 2 * (i >> 5); }
__device__ __forceinline__ void bfly_dif(f32x2& a, f32x2& b, float c, float s) { const f32x2 u = a, v = b; a = u + v; const f32x2 d = u - v; b = __builtin_elementwise_fma(d.yx, (f32x2){s, -s}, d * (f32x2){c, c}); }
__device__ __forceinline__ void bfly_idit(f32x2& a, f32x2& b, float c, float s) { const f32x2 u = a, q = b; const f32x2 v = __builtin_elementwise_fma(q.yx, (f32x2){-s, s}, q * (f32x2){c, c}); a = u + v; b = u - v; }
template <bool ZHI> __device__ __forceinline__ void dif16(f32x2 (&x)[16], float th) {
    asm volatile("" : "+v"(th));
#pragma unroll
    for (int k = 0; k < 8; ++k) { const float fr = th + (float)k * 0.0625f; const float c = __builtin_amdgcn_cosf(fr), s = __builtin_amdgcn_sinf(fr);
        if (ZHI) { const f32x2 u = x[k]; x[k + 8] = (f32x2){u.x * c + u.y * s, u.y * c - u.x * s}; } else bfly_dif(x[k], x[k + 8], c, s); }
#pragma unroll
    for (int k = 0; k < 4; ++k) { const float fr = 2.0f * th + (float)k * 0.125f; const float c = __builtin_amdgcn_cosf(fr), s = __builtin_amdgcn_sinf(fr);
        bfly_dif(x[k], x[k + 4], c, s); bfly_dif(x[8 + k], x[12 + k], c, s); }
#pragma unroll
    for (int k = 0; k < 2; ++k) { const float fr = 4.0f * th + (float)k * 0.25f; const float c = __builtin_amdgcn_cosf(fr), s = __builtin_amdgcn_sinf(fr);
#pragma unroll
        for (int b = 0; b < 16; b += 4) bfly_dif(x[b + k], x[b + k + 2], c, s); }
    { const float fr = 8.0f * th; const float c = __builtin_amdgcn_cosf(fr), s = __builtin_amdgcn_sinf(fr);
#pragma unroll
        for (int b = 0; b < 16; b += 2) bfly_dif(x[b], x[b + 1], c, s); }
}
__device__ __forceinline__ void idit16(f32x2 (&x)[16], float th) {
    asm volatile("" : "+v"(th));
    { const float fr = 8.0f * th; const float c = __builtin_amdgcn_cosf(fr), s = __builtin_amdgcn_sinf(fr);
#pragma unroll
        for (int b = 0; b < 16; b += 2) bfly_idit(x[b], x[b + 1], c, s); }
#pragma unroll
    for (int k = 0; k < 2; ++k) { const float fr = 4.0f * th + (float)k * 0.25f; const float c = __builtin_amdgcn_cosf(fr), s = __builtin_amdgcn_sinf(fr);
#pragma unroll
        for (int b = 0; b < 16; b += 4) bfly_idit(x[b + k], x[b + k + 2], c, s); }
#pragma unroll
    for (int k = 0; k < 4; ++k) { const float fr = 2.0f * th + (float)k * 0.125f; const float c = __builtin_amdgcn_cosf(fr), s = __builtin_amdgcn_sinf(fr);
        bfly_idit(x[k], x[k + 4], c, s); bfly_idit(x[8 + k], x[12 + k], c, s); }
#pragma unroll
    for (int k = 0; k < 8; ++k) { const float fr = th + (float)k * 0.0625f; const float c = __builtin_amdgcn_cosf(fr), s = __builtin_amdgcn_sinf(fr); bfly_idit(x[k], x[k + 8], c, s); }
}
template <bool INV, int PSTRIDE> __device__ __forceinline__ void fft_pass(LAS f32x2* buf, int base, float th) {
    LAS f32x2* p = buf + fphys(base);
    f32x2 x[16];
#pragma unroll
    for (int k = 0; k < 16; ++k) x[k] = p[k * PSTRIDE];
    if (INV) idit16(x, th); else dif16<false>(x, th);
#pragma unroll
    for (int k = 0; k < 16; ++k) p[k * PSTRIDE] = x[k];
}
template <bool INV, int PSTRIDE> __device__ __forceinline__ void fft_pass2(LAS f32x2* bufa, LAS f32x2* bufb, int base, float th) {
    LAS f32x2* pa = bufa + fphys(base); LAS f32x2* pb = bufb + fphys(base);
    f32x2 xa[16], xb[16];
#pragma unroll
    for (int k = 0; k < 16; ++k) { xa[k] = pa[k * PSTRIDE]; xb[k] = pb[k * PSTRIDE]; }
    if (INV) { idit16(xa, th); idit16(xb, th); } else { dif16<false>(xa, th); dif16<false>(xb, th); }
#pragma unroll
    for (int k = 0; k < 16; ++k) { pa[k * PSTRIDE] = xa[k]; pb[k * PSTRIDE] = xb[k]; }
}
constexpr int FFT_LDS_BYTES = (8192 + 512 + 8) * 8;
__device__ __forceinline__ float block_sum(float v, LAS float* red, int tid) {
    v = wave_sum(v);
    __syncthreads();
    if ((tid & 63) == 0) red[tid >> 6] = v;
    __syncthreads();
    float s = 0.f;
#pragma unroll
    for (int i = 0; i < 8; ++i) s += red[i];
    return s;
}
__device__ __forceinline__ float hy_delta(int c) { const float d0 = -4.605170185988091f / 0.3f, d1 = -4.605170185988091f / 1.5f; return fabsf(d0 + (d1 - d0) * ((float)c / 1023.0f)); }
__device__ __forceinline__ void ph_filt2(const Args& A, int l, int set, int c_lo, int c_hi, int wk, int nwk, LAS unsigned char* lds, int tid) {
    LAS f32x2* buf = (LAS f32x2*)lds; LAS float* bufs = (LAS float*)lds; LAS float* red = (LAS float*)(lds + FFT_LDS_BYTES + 64); LAS float* w3s = red + 32;
    LAS float* ctap = w3s + 256;
    const float* w3 = inp(I_FW3) + (size_t)l * 64 * 4096; const bf16* FH2B = (const bf16*)(wsb() + WS_FB4) + (size_t)l * 4352 * 64;
    f32x2* KF = (f32x2*)(psb(set) + PS_KF); float* TAPC = (float*)(psb(set) + PS_TAPC);
    const int lane = tid & 63, w = tid >> 6, g = lane >> 4, li = lane & 15;
    for (int c = c_lo + wk; c < c_hi; c += nwk) {
        __syncthreads();
        if (tid < 256) w3s[tid] = w3[(size_t)(tid & 63) * 4096 + (tid >> 7) * 2048 + ((tid >> 6) & 1) * 1024 + c];
        __syncthreads();
        bf16x8 bfr[2];
#pragma unroll
        for (int ks = 0; ks < 2; ++ks) { float v[8];
#pragma unroll
            for (int j = 0; j < 8; ++j) v[j] = (li < 4) ? w3s[li * 64 + 32 * ks + 8 * g + j] : 0.f;
            bfr[ks] = mk8(pk2(v[0], v[1]), pk2(v[2], v[3]), pk2(v[4], v[5]), pk2(v[6], v[7])); }
        const float delta = hy_delta(c); float ssq = 0.f, ssqc = 0.f;
        const int comp = li >> 1;
#pragma unroll 1
        for (int rb = 0; rb < 272; rb += 64) {
            bf16x8 a0[8], a1[8];
#pragma unroll
            for (int rk = 0; rk < 8; ++rk) { const int rt = rb + w + 8 * rk; const bf16* ap = FH2B + (size_t)((rt < 272 ? rt : 0) * 16 + li) * 64 + 8 * g;
                a0[rk] = *(const bf16x8*)ap; a1[rk] = *(const bf16x8*)(ap + 32); }
#pragma unroll
            for (int rk = 0; rk < 8; ++rk) { const int rt = rb + w + 8 * rk; const int t0 = rt * 16;
                f32x4 acc = (f32x4){0.f, 0.f, 0.f, 0.f};
                acc = mfma16(a0[rk], bfr[0], acc); acc = mfma16(a1[rk], bfr[1], acc);
                if (li < 4 && rt < 272) {
                    if (rt < 256) {
#pragma unroll
                        for (int j = 0; j < 4; ++j) { const int t = t0 + 4 * g + j; const float val = acc[j] * __expf(-((float)t * (1.0f / 4095.0f)) * delta);
                            if ((li & 1) == 0) { bufs[2 * fphys(t) + comp] = val; ssq += val * val; }
                            else if (t >= 1) { bufs[2 * fphys(8192 - t) + comp] = val; ssq += val * val; }
                            else bufs[2 * fphys(4096) + comp] = 0.f; }
                    } else {
#pragma unroll
                        for (int j = 0; j < 4; ++j) { const int m = t0 - 4096 + 4 * g + j; const float val = acc[j] * __expf(-((float)m * (1.0f / 255.0f)) * delta);
                            ctap[li * 256 + m] = val; if ((li & 1) == 0 || m >= 1) ssqc += val * val; }
                    }
                }
            }
        }
        const bool o0 = (li < 2), o1 = (li == 2 || li == 3);
        const float scl0 = (1.0f / 8192.0f) / sqrtf(block_sum(o0 ? ssq : 0.f, red, tid) + EPS), scl1 = (1.0f / 8192.0f) / sqrtf(block_sum(o1 ? ssq : 0.f, red, tid) + EPS);
        const float sc0 = 1.0f / sqrtf(block_sum(o0 ? ssqc : 0.f, red, tid) + EPS), sc1 = 1.0f / sqrtf(block_sum(o1 ? ssqc : 0.f, red, tid) + EPS);
        __syncthreads();
        fft_pass<false, 544>(buf, tid, (float)tid * (1.0f / 8192.0f));
        __syncthreads();
        fft_pass<false, 34>(buf, (tid >> 5) * 512 + (tid & 31), (float)(tid & 31) * (1.0f / 512.0f));
        __syncthreads();
        fft_pass<false, 2>(buf, (tid >> 1) * 32 + (tid & 1), (float)(tid & 1) * (1.0f / 32.0f));
        __syncthreads();
#pragma unroll
        for (int r = 0; r < 8; ++r) { LAS f32x4* pp = (LAS f32x4*)(buf + fphys(2 * tid) + 1088 * r); const f32x4 ab = *pp; *pp = (f32x4){ab.x + ab.z, ab.y + ab.w, ab.x - ab.z, ab.y - ab.w}; }
        __syncthreads();
        f32x2* d0 = KF + (size_t)c * 8192; f32x2* d1 = KF + (size_t)(1024 + c) * 8192;
#pragma unroll 4
        for (int i = 0; i < 16; ++i) { const int p = tid + 512 * i; const int f = (int)(__brev((unsigned)p) >> 19); const int pp = (int)(__brev((unsigned)((8192 - f) & 8191)) >> 19);
            const f32x2 z = buf[fphys(p)], zp = buf[fphys(pp)];
            d0[p] = (f32x2){(z.x + zp.x) * 0.5f * scl0, (z.y - zp.y) * 0.5f * scl0};
            d1[p] = (f32x2){(z.y + zp.y) * 0.5f * scl1, (zp.x - z.x) * 0.5f * scl1}; }
        for (int q = tid; q < 1024; q += 512) { const int od = q >> 8, m = q & 255; TAPC[((size_t)od * 1024 + c) * 256 + m] = ctap[q] * ((od < 2) ? sc0 : sc1); }
    }
}

__device__ __forceinline__ void ph_hyprep(const Args& A, int l, LAS unsigned char* lds, int tid) {
    LAS bf16* T = (LAS bf16*)lds;
    const bf16* Z = (const bf16*)(wsb() + WS_Z); bf16* HYT = (bf16*)(wsb() + WS_HYT);
    const float* cw = inp(I_HCW) + (size_t)l * 3 * 3072; const float* cb = inp(I_HCB) + (size_t)l * 3072;
    v4u pre[5];
#define HP_LOAD(u_) do { const int cg_ = (u_) % 12, tt_ = ((u_) / 12) & 63, b_ = (u_) / 768; \
        _Pragma("unroll") for (int e = 0; e < 5; ++e) { const int q = tid + 512 * e; const int r = q >> 5, ch8 = q & 31, t = tt_ * 64 - 1 + r; pre[e] = (v4u){0u, 0u, 0u, 0u}; \
            if (q < 66 * 32 && t >= 0 && t < SEQ) pre[e] = *(const v4u*)(Z + (size_t)(b_ * SEQ + t) * INW + C_HY + cg_ * 256 + ch8 * 8); } } while (0)
    int u = blockIdx.x;
    if (u < 3072) HP_LOAD(u);
    for (; u < 3072; u += gridDim.x) {
        const int cg = u % 12, tt = (u / 12) & 63, b = u / 768;
        __syncthreads();
#pragma unroll
        for (int e = 0; e < 5; ++e) { const int q = tid + 512 * e; if (q < 66 * 32) *(LAS v4u*)(T + (q >> 5) * 264 + (q & 31) * 8) = pre[e]; }
        __syncthreads();
        if (u + (int)gridDim.x < 3072) HP_LOAD(u + (int)gridDim.x);
        const int ch = tid & 255, half = tid >> 8, gch = cg * 256 + ch;
        const float w0 = cw[gch], w1 = cw[3072 + gch], w2 = cw[6144 + gch], bb = cb[gch];
        const int part = gch >> 10, c = gch & 1023;
        bf16* outp = HYT + ((size_t)(part * NB + b) * 1024 + c) * SEQ + tt * 64 + half * 32;
#pragma unroll
        for (int tq = 0; tq < 4; ++tq) { float vv[8];
#pragma unroll
            for (int e = 0; e < 8; ++e) { const int tl = half * 32 + tq * 8 + e;
                vv[e] = w0 * bf1(T[tl * 264 + ch]) + w1 * bf1(T[(tl + 1) * 264 + ch]) + w2 * bf1(T[(tl + 2) * 264 + ch]) + bb; }
            v4u w; w.x = pk2(vv[0], vv[1]); w.y = pk2(vv[2], vv[3]); w.z = pk2(vv[4], vv[5]); w.w = pk2(vv[6], vv[7]);
            *(v4u*)(outp + tq * 8) = w; }
    }
#undef HP_LOAD
}
__device__ __forceinline__ void ph_hyctx(const Args& A, int l, LAS unsigned char* lds, int tid) {
    const bf16* Z = (const bf16*)(wsb() + WS_Z); bf16* YS = (bf16*)(wsb() + WS_YS); const float* TAPC = (const float*)(psb(l & 1) + PS_TAPC);
    const float* cw = inp(I_HCW) + (size_t)l * 3 * 3072; const float* cb = inp(I_HCB) + (size_t)l * 3072; const float* hb = inp(I_HBIAS) + (size_t)l * 2 * 1024;
    const int ch = tid >> 6, q = tid & 63, t0 = 4 * q;
    LAS float* Y = (LAS float*)lds + ch * 1552; LAS float* Y1 = Y + 256; LAS float* G0 = Y + 512; LAS float* G1 = Y + 1032;
    LAS bf16* R = (LAS bf16*)((LAS float*)lds + 8 * 1552);
    for (int u = blockIdx.x; u < 512; u += gridDim.x) {
        const int b = u >> 7, cg8 = (u & 127) * 8, c = cg8 + ch;
        __syncthreads();
        for (int i = tid; i < 768; i += 512) { const int row = i / 3, part = i - row * 3; *(LAS v4u*)(R + row * 24 + part * 8) = *(const v4u*)(Z + (size_t)(ML + b * CL + row) * INW + C_HY + part * 1024 + cg8); }
#pragma unroll
        for (int r = 0; r < 4; ++r) { const int m = t0 + r;
            G0[m + 259] = TAPC[((size_t)(0 * 2 + 0) * 1024 + c) * 256 + m]; G1[m + 259] = TAPC[((size_t)(1 * 2 + 0) * 1024 + c) * 256 + m];
            if (m >= 1) { G0[259 - m] = TAPC[((size_t)(0 * 2 + 1) * 1024 + c) * 256 + m]; G1[259 - m] = TAPC[((size_t)(1 * 2 + 1) * 1024 + c) * 256 + m]; } }
        if (q == 0) { G0[515] = 0.f; G1[515] = 0.f; G0[516] = 0.f; G1[516] = 0.f; }
        __syncthreads();
        float pv[3][4];
#pragma unroll
        for (int part = 0; part < 3; ++part) { const int gch = part * 1024 + c; const float w0 = cw[gch], w1 = cw[3072 + gch], w2 = cw[6144 + gch], bb = cb[gch];
            float zz[6];
#pragma unroll
            for (int e = 0; e < 6; ++e) { const int t = t0 - 1 + e; zz[e] = (t >= 0 && t < CL) ? bf1(R[t * 24 + part * 8 + ch]) : 0.f; }
#pragma unroll
            for (int r = 0; r < 4; ++r) pv[part][r] = w0 * zz[r] + w1 * zz[r + 1] + w2 * zz[r + 2] + bb; }
        *(LAS f32x4*)(Y + t0) = (f32x4){pv[2][0], pv[2][1], pv[2][2], pv[2][3]};
        __syncthreads();
        float yprev[4] = {pv[2][0], pv[2][1], pv[2][2], pv[2][3]};
#pragma unroll
        for (int ord = 0; ord < 2; ++ord) {
            const LAS float* Ys = ord ? Y1 : Y; const LAS float* G = ord ? G1 : G0;
            float acc[4] = {0.f, 0.f, 0.f, 0.f};
#pragma unroll 4
            for (int sp = 0; sp < 64; ++sp) { const f32x4 yv = *(const LAS f32x4*)(Ys + 4 * sp); const LAS float* gp = G + 4 * (q - sp) + 256;
                const f32x4 ga = *(const LAS f32x4*)gp, gb = *(const LAS f32x4*)(gp + 4);
                const float g[8] = {ga.x, ga.y, ga.z, ga.w, gb.x, gb.y, gb.z, gb.w}; const float yy[4] = {yv.x, yv.y, yv.z, yv.w};
#pragma unroll
                for (int r = 0; r < 4; ++r)
#pragma unroll
                    for (int j = 0; j < 4; ++j) acc[r] += yy[j] * g[r - j + 3]; }
            const float bias = hb[ord * 1024 + c];
#pragma unroll
            for (int r = 0; r < 4; ++r) yprev[r] = pv[ord][r] * (acc[r] + bias * yprev[r]);
            if (ord == 0) { *(LAS f32x4*)(Y1 + t0) = (f32x4){yprev[0], yprev[1], yprev[2], yprev[3]}; __syncthreads(); }
        }
#pragma unroll
        for (int r = 0; r < 4; ++r) YS[(size_t)(ML + b * CL + t0 + r) * 1024 + c] = (bf16)f2bf(yprev[r]);
    }
}
__device__ __forceinline__ void unpack8(v4u v, float (&x)[8]) { x[0] = bflo(v.x); x[1] = bfhi(v.x); x[2] = bflo(v.y); x[3] = bfhi(v.y); x[4] = bflo(v.z); x[5] = bfhi(v.z); x[6] = bflo(v.w); x[7] = bfhi(v.w); }
__device__ __forceinline__ v4u pack8(const float (&x)[8]) { v4u w; w.x = pk2(x[0], x[1]); w.y = pk2(x[2], x[3]); w.z = pk2(x[4], x[5]); w.w = pk2(x[6], x[7]); return w; }
__device__ __forceinline__ void rope8(float (&lo)[8], float (&hi)[8], const f32x2* rt) {
#pragma unroll
    for (int e = 0; e < 8; ++e) { const f32x2 cs = rt[e]; const float a = lo[e], b = hi[e]; lo[e] = a * cs.x - b * cs.y; hi[e] = b * cs.x + a * cs.y; }
}
__device__ __forceinline__ void vt_store(LAS bf16* Vt, int ld, int d0, int r, v4u vv) {
    Vt[(d0 + 0) * ld + r] = (bf16)(vv.x & 0xffffu); Vt[(d0 + 1) * ld + r] = (bf16)(vv.x >> 16);
    Vt[(d0 + 2) * ld + r] = (bf16)(vv.y & 0xffffu); Vt[(d0 + 3) * ld + r] = (bf16)(vv.y >> 16);
    Vt[(d0 + 4) * ld + r] = (bf16)(vv.z & 0xffffu); Vt[(d0 + 5) * ld + r] = (bf16)(vv.z >> 16);
    Vt[(d0 + 6) * ld + r] = (bf16)(vv.w & 0xffffu); Vt[(d0 + 7) * ld + r] = (bf16)(vv.w >> 16);
}
constexpr float LOG2E = 1.4426950408889634f;
typedef short s16x4 __attribute__((ext_vector_type(4)));
__device__ __forceinline__ bf16x8 tr_frag(const LAS bf16* tile, int ld, int r0, int r1, int c0, int li) {
    const s16x4 lo = __builtin_amdgcn_ds_read_tr16_b64_v4i16((LAS s16x4*)(tile + (r0 + (li >> 2)) * ld + c0 + 4 * (li & 3)));
    const s16x4 hi = __builtin_amdgcn_ds_read_tr16_b64_v4i16((LAS s16x4*)(tile + (r1 + (li >> 2)) * ld + c0 + 4 * (li & 3)));
    return (bf16x8){lo.x, lo.y, lo.z, lo.w, hi.x, hi.y, hi.z, hi.w};
}
__device__ __forceinline__ void ph_ret1(const Args& A, int l, int nctx_units, LAS unsigned char* lds, int tid) {
    LAS bf16* Kf = (LAS bf16*)lds; LAS bf16* Kb = Kf + 128 * 72; LAS bf16* Vs = Kb + 128 * 72;
    const bf16* Z = (const bf16*)(wsb() + WS_Z); float* KV = (float*)(wsb() + WS_KV); const f32x2* rope = (const f32x2*)(wsb() + WS_ROPE);
    const int lane = tid & 63, w = tid >> 6, g = lane >> 4, li = lane & 15;
    const int tok = tid >> 2, pp = tid & 3, a = (pp & 1) + ((pp >> 1) << 2);
    const int nunits = 1024 + nctx_units;
    v4u pk[2], pv[4];
#define R1_DEC(uid_, b_, h_, n_, ci_, m0_, isc_) const bool isc_ = (uid_) >= 1024; int b_, h_, n_, ci_; size_t m0_; \
        if (!isc_) { b_ = (uid_) >> 8; h_ = ((uid_) >> 5) & 7; n_ = (uid_) & 31; m0_ = (size_t)b_ * SEQ + n_ * 128; ci_ = 2 + n_; } \
        else { const int i_ = (uid_) - 1024; b_ = i_ >> 4; h_ = (i_ >> 1) & 7; n_ = i_ & 1; m0_ = (size_t)ML + b_ * CL + n_ * 128; ci_ = n_; }
#define R1_LOAD(uid_) do { R1_DEC(uid_, b2, h2, n2, ci2, m02, isc2) (void)ci2; (void)n2; (void)isc2; const bf16* kr = Z + (m02 + tok) * INW + C_RK + h2 * 64; pk[0] = *(const v4u*)(kr + 8 * a); pk[1] = *(const v4u*)(kr + 8 * a + 16); \
        _Pragma("unroll") for (int e = 0; e < 4; ++e) { const int q = tid + 512 * e; pv[e] = *(const v4u*)(Z + (m02 + (q >> 4)) * INW + C_RV + h2 * 128 + (q & 15) * 8); } } while (0)
    int uid = blockIdx.x;
    if (uid < nunits) R1_LOAD(uid);
    for (; uid < nunits; uid += gridDim.x) {
        R1_DEC(uid, b, h, n, ci, m0, isc) (void)m0;
        const float lgf = inp(I_RDEC)[(l * 2 + 0) * 8 + h] * LOG2E, lgb = inp(I_RDEC)[(l * 2 + 1) * 8 + h] * LOG2E;
        __syncthreads();
        { float lo[8], hi[8]; unpack8(pk[0], lo); unpack8(pk[1], hi);
            if (!isc) { const int t = n * 128 + tok; const int pos = (a < 4) ? (t >> 6) : (t & 63); rope8(lo, hi, rope + pos * 16 + 8 * (a & 1)); }
            const float zf = ex2(lgf * (float)(127 - tok)) * 0.125f, zb = ex2(lgb * (float)tok) * 0.125f;
            float lf[8], hf[8];
#pragma unroll
            for (int e = 0; e < 8; ++e) { lf[e] = lo[e] * zf; hf[e] = hi[e] * zf; lo[e] *= zb; hi[e] *= zb; }
            *(LAS v4u*)(Kf + tok * 72 + 8 * a) = pack8(lf); *(LAS v4u*)(Kf + tok * 72 + 8 * a + 16) = pack8(hf);
            *(LAS v4u*)(Kb + tok * 72 + 8 * a) = pack8(lo); *(LAS v4u*)(Kb + tok * 72 + 8 * a + 16) = pack8(hi); }
#pragma unroll
        for (int e = 0; e < 4; ++e) { const int q = tid + 512 * e; *(LAS v4u*)(Vs + (q >> 4) * 144 + (q & 15) * 8) = pv[e]; }
        __syncthreads();
        if (uid + (int)gridDim.x < nunits) R1_LOAD(uid + (int)gridDim.x);
        bf16x8 af[4];
#pragma unroll
        for (int ks = 0; ks < 4; ++ks) af[ks] = tr_frag(Vs, 144, 32 * ks + 8 * g, 32 * ks + 8 * g + 4, 16 * w, li);
#pragma unroll
        for (int dir = 0; dir < 2; ++dir) { const LAS bf16* KT = dir ? Kb : Kf;
            float* dst = KV + ((size_t)((b * 8 + h) * 2 + dir) * 34 + ci) * 8192;
#pragma unroll
            for (int nc = 0; nc < 4; ++nc) { f32x4 acc = (f32x4){0.f, 0.f, 0.f, 0.f};
#pragma unroll
                for (int ks = 0; ks < 4; ++ks) acc = mfma16(af[ks], tr_frag(KT, 72, 32 * ks + 8 * g, 32 * ks + 8 * g + 4, 16 * nc, li), acc);
#pragma unroll
                for (int j = 0; j < 4; ++j) dst[(16 * w + 4 * g + j) * 64 + 16 * nc + li] = acc[j]; } }
    }
#undef R1_LOAD
}
__device__ __forceinline__ void ph_natt(const Args& A, int l, int mode, LAS unsigned char* lds, int tid) {
    LAS bf16* Qs = (LAS bf16*)lds; LAS bf16* KV0 = (LAS bf16*)lds; LAS float* rpbs = (LAS float*)(lds + 2 * (64 * 136 + 64 * 144) * 2);
    const bf16* Z = (const bf16*)(wsb() + WS_Z); bf16* YS = (bf16*)(wsb() + WS_YS) + (size_t)2 * MT * 1024;
    const int lane = tid & 63, w = tid >> 6, g = lane >> 4, li = lane & 15;
    const float SCALE = 0.08838834764831845f * LOG2E;
    const int sr0 = tid >> 4, sch = tid & 15;
    const int ufirst = mode ? ((int)blockIdx.x - ((int)gridDim.x - 32)) : (int)blockIdx.x, ucount = mode ? 32 : 512;
    if (ufirst < 0) return;
    for (int uid = ufirst; uid < ucount; uid += (mode ? 32 : (int)gridDim.x)) {
        int b, h, rq = 0; size_t m0;
        if (!mode) { b = uid >> 7; h = (uid >> 4) & 7; rq = uid & 15; m0 = (size_t)b * SEQ + rq * 256; }
        else { b = uid >> 3; h = uid & 7; m0 = (size_t)ML + b * CL; }
        const size_t mc0 = (size_t)ML + b * CL;
        const int qr = 4 * rq + (w >> 1), rs_w = min(max(qr - 4, 0), 56);
        const int kr_lo = min(max(4 * rq - 4, 0), 56), kr_hi = min(max(4 * rq - 1, 0), 56) + 7;
        const int nwin = mode ? 0 : (kr_hi - kr_lo + 1), ntile = nwin + 4;
        int qc[2], cs[2], nlo_w[2], nhi_w[2];
#pragma unroll
        for (int i = 0; i < 2; ++i) { const int cw = 2 * (w & 1) + i; qc[i] = 16 * cw + li; cs[i] = min(max(qc[i] - 8, 0), 48);
            nlo_w[i] = (cw <= 1) ? 0 : cw - 1; nhi_w[i] = (cw == 0) ? 1 : ((cw == 3) ? 3 : cw + 1); }
        v4u kreg[2], vreg[2];
#define NA_LOAD(t_) do { const int t__ = (t_); const size_t mk = (t__ < nwin) ? ((size_t)b * SEQ + (kr_lo + t__) * 64) : (mc0 + (t__ - nwin) * 64); \
            _Pragma("unroll") for (int e = 0; e < 2; ++e) { const bf16* zr = Z + (mk + sr0 + 32 * e) * INW + h * 128 + sch * 8; kreg[e] = *(const v4u*)(zr + C_NK); vreg[e] = *(const v4u*)(zr + C_NV); } } while (0)
#define NA_STORE(buf_) do { LAS bf16* Kd = KV0 + (buf_) * (64 * 136 + 64 * 144); LAS bf16* Vd = Kd + 64 * 136; \
            _Pragma("unroll") for (int e = 0; e < 2; ++e) { *(LAS v4u*)(Kd + (sr0 + 32 * e) * 136 + sch * 8) = kreg[e]; *(LAS v4u*)(Vd + (sr0 + 32 * e) * 144 + sch * 8) = vreg[e]; } } while (0)
        __syncthreads();
        NA_LOAD(0);
        for (int q = tid; q < 4096; q += 512) { const int r = q >> 4, chn = q & 15; *(LAS v4u*)(Qs + r * 136 + chn * 8) = *(const v4u*)(Z + (m0 + r) * INW + C_NQ + h * 128 + chn * 8); }
        if (!mode) for (int i = tid; i < 465; i += 512) rpbs[i] = inp(I_RPB)[((size_t)l * 8 + h) * 465 + i] * LOG2E;
        __syncthreads();
        bf16x8 qf[2][4];
#pragma unroll
        for (int i = 0; i < 2; ++i)
#pragma unroll
            for (int ks = 0; ks < 4; ++ks) qf[i][ks] = *(const LAS bf16x8*)(Qs + (32 * w + 16 * i + li) * 136 + 32 * ks + 8 * g);
        __syncthreads();
        NA_STORE(0);
        __syncthreads();
        f32x4 o[2][8];
#pragma unroll
        for (int i = 0; i < 2; ++i)
#pragma unroll
            for (int nd = 0; nd < 8; ++nd) o[i][nd] = (f32x4){0.f, 0.f, 0.f, 0.f};
        float mrun[2] = {-1e30f, -1e30f}, lrun[2] = {0.f, 0.f};
        for (int t = 0; t < ntile; ++t) {
            const bool win = t < nwin; const int kr = kr_lo + t;
            if (t + 1 < ntile) NA_LOAD(t + 1);
            const LAS bf16* Ks = KV0 + (t & 1) * (64 * 136 + 64 * 144); const LAS bf16* Vs = Ks + 64 * 136;
            const bool active = !win || (kr >= rs_w && kr <= rs_w + 7);
            if (active) {
                const int nlo0 = win ? nlo_w[0] : 0, nhi0 = win ? nhi_w[0] : 3, nlo1 = win ? nlo_w[1] : 0, nhi1 = win ? nhi_w[1] : 3;
                f32x4 s[2][4];
#pragma unroll
                for (int n = 0; n < 4; ++n) { s[0][n] = (f32x4){0.f, 0.f, 0.f, 0.f}; s[1][n] = (f32x4){0.f, 0.f, 0.f, 0.f};
                    const bool u0 = (n >= nlo0 && n <= nhi0), u1 = (n >= nlo1 && n <= nhi1);
                    if (u0 || u1) {
#pragma unroll
                        for (int ks = 0; ks < 4; ++ks) { const bf16x8 kf = *(const LAS bf16x8*)(Ks + (16 * n + li) * 136 + 32 * ks + 8 * g);
                            if (u0) s[0][n] = mfma16(kf, qf[0][ks], s[0][n]);
                            if (u1) s[1][n] = mfma16(kf, qf[1][ks], s[1][n]); } } }
                bf16x8 pf[2][2];
#pragma unroll
                for (int i = 0; i < 2; ++i) {
                    float tmax = -1e30f;
#pragma unroll
                    for (int n = 0; n < 4; ++n)
#pragma unroll
                        for (int j = 0; j < 4; ++j) { float v = s[i][n][j] * SCALE;
                            if (win) { const int kc = 16 * n + 4 * g + j; const bool valid = (kc >= cs[i]) && (kc < cs[i] + 16);
                                const int dc = min(max(kc - qc[i] + 15, 0), 30), dr = min(max(kr - qr + 7, 0), 14);
                                v = valid ? v + rpbs[dr * 31 + dc] : -1e30f; }
                            s[i][n][j] = v; tmax = fmaxf(tmax, v); }
                    tmax = fmaxf(tmax, __shfl_xor(tmax, 16)); tmax = fmaxf(tmax, __shfl_xor(tmax, 32));
                    const bool upd = tmax > mrun[i] + 8.0f;
                    const float mnew = upd ? tmax : mrun[i];
                    float psum = 0.f;
#pragma unroll
                    for (int n = 0; n < 4; ++n)
#pragma unroll
                        for (int j = 0; j < 4; ++j) { const float pv = ex2(s[i][n][j] - mnew); s[i][n][j] = pv; psum += pv; }
                    psum += __shfl_xor(psum, 16); psum += __shfl_xor(psum, 32);
                    if (__any(upd)) { const float alpha = ex2(mrun[i] - mnew); lrun[i] *= alpha;
#pragma unroll
                        for (int nd = 0; nd < 8; ++nd) o[i][nd] = o[i][nd] * alpha; }
                    lrun[i] += psum; mrun[i] = mnew;
#pragma unroll
                    for (int kk = 0; kk < 2; ++kk) pf[i][kk] = mk8(pk2(s[i][2 * kk][0], s[i][2 * kk][1]), pk2(s[i][2 * kk][2], s[i][2 * kk][3]), pk2(s[i][2 * kk + 1][0], s[i][2 * kk + 1][1]), pk2(s[i][2 * kk + 1][2], s[i][2 * kk + 1][3]));
                }
#pragma unroll
                for (int kk = 0; kk < 2; ++kk) { const bool u0 = (2 * kk + 1 >= nlo0 && 2 * kk <= nhi0), u1 = (2 * kk + 1 >= nlo1 && 2 * kk <= nhi1);
                    if (u0 || u1) {
#pragma unroll
                        for (int nd = 0; nd < 8; ++nd) { const bf16x8 vf = tr_frag(Vs, 144, 32 * kk + 4 * g, 32 * kk + 16 + 4 * g, 16 * nd, li);
                            if (u0) o[0][nd] = mfma16(vf, pf[0][kk], o[0][nd]);
                            if (u1) o[1][nd] = mfma16(vf, pf[1][kk], o[1][nd]); } } }
            }
            if (t + 1 < ntile) NA_STORE((t + 1) & 1);
            __syncthreads();
        }
#undef NA_LOAD
#undef NA_STORE
#pragma unroll
        for (int i = 0; i < 2; ++i) { const float inv = 1.0f / lrun[i]; const size_t mrow = m0 + 32 * w + 16 * i + li;
#pragma unroll
            for (int nd = 0; nd < 8; ++nd) { v2u wv; wv.x = pk2(o[i][nd][0] * inv, o[i][nd][1] * inv); wv.y = pk2(o[i][nd][2] * inv, o[i][nd][3] * inv);
                *(v2u*)(YS + mrow * 1024 + h * 128 + 16 * nd + 4 * g) = wv; } }
    }
}

__device__ __forceinline__ void ph_hyfft(const Args& A, int l, LAS unsigned char* lds, int tid) {
    LAS f32x2* bufa = (LAS f32x2*)lds; LAS f32x2* bufb = (LAS f32x2*)(lds + FFT_LDS_BYTES);
    const bf16* HYT = (const bf16*)(wsb() + WS_HYT); bf16* YT = (bf16*)(wsb() + WS_YT); const f32x2* KF = (const f32x2*)(psb(l & 1) + PS_KF);
    const float* hb = inp(I_HBIAS) + (size_t)l * 2 * 1024;
    const int baseB = (tid >> 5) * 512 + (tid & 31), baseC = (tid >> 1) * 32 + (tid & 1);
    const float thA = (float)tid * (1.0f / 8192.0f), thB = (float)(tid & 31) * (1.0f / 512.0f), thC = (float)(tid & 1) * (1.0f / 32.0f);
    const size_t bstr = (size_t)1024 * SEQ;
#define HF_PTR(c_, part_, b_) (HYT + ((size_t)((part_) * NB + (b_)) * 1024 + (c_)) * SEQ)
    for (int c = blockIdx.x; c < 1024; c += gridDim.x) {
        float y[4][8];
#pragma unroll
        for (int b = 0; b < 4; ++b) { const bf16* vp = HF_PTR(c, 2, b);
#pragma unroll
            for (int i = 0; i < 8; ++i) y[b][i] = bf1(vp[tid + 512 * i]); }
#pragma unroll
        for (int ord = 0; ord < 2; ++ord) {
            f32x4 kreg[8]; bf16 xg[4][8];
            { const f32x4* kf = (const f32x4*)(KF + (size_t)(ord * 1024 + c) * 8192);
#pragma unroll
                for (int r = 0; r < 8; ++r) kreg[r] = kf[tid + 512 * r];
#pragma unroll
                for (int b = 0; b < 4; ++b) { const bf16* xp = HF_PTR(c, ord, b);
#pragma unroll
                    for (int i = 0; i < 8; ++i) xg[b][i] = xp[tid + 512 * i]; } }
            { f32x2 xa[16], xb[16];
#pragma unroll
                for (int k = 0; k < 8; ++k) { xa[k] = (f32x2){y[0][k], y[1][k]}; xa[k + 8] = (f32x2){0.f, 0.f}; xb[k] = (f32x2){y[2][k], y[3][k]}; xb[k + 8] = (f32x2){0.f, 0.f}; }
                dif16<true>(xa, thA); dif16<true>(xb, thA);
                __syncthreads();
#pragma unroll
                for (int k = 0; k < 16; ++k) { bufa[fphys(tid) + 544 * k] = xa[k]; bufb[fphys(tid) + 544 * k] = xb[k]; } }
            __syncthreads();
            fft_pass2<false, 34>(bufa, bufb, baseB, thB);
            __syncthreads();
            fft_pass2<false, 2>(bufa, bufb, baseC, thC);
            __syncthreads();
#pragma unroll
            for (int r = 0; r < 8; ++r) { const f32x4 kk = kreg[r];
#pragma unroll
                for (int q = 0; q < 2; ++q) { LAS f32x4* pp = (LAS f32x4*)((q ? bufb : bufa) + fphys(2 * tid) + 1088 * r); const f32x4 ab = *pp;
                    const float ax = ab.x + ab.z, ay = ab.y + ab.w, bx = ab.x - ab.z, by = ab.y - ab.w;
                    const float px = ax * kk.x - ay * kk.y, py = ax * kk.y + ay * kk.x, qx = bx * kk.z - by * kk.w, qy = bx * kk.w + by * kk.z;
                    *pp = (f32x4){px + qx, py + qy, px - qx, py - qy}; } }
            __syncthreads();
            fft_pass2<true, 2>(bufa, bufb, baseC, thC);
            __syncthreads();
            fft_pass2<true, 34>(bufa, bufb, baseB, thB);
            __syncthreads();
            { f32x2 xa[16], xb[16];
#pragma unroll
                for (int k = 0; k < 16; ++k) { xa[k] = bufa[fphys(tid) + 544 * k]; xb[k] = bufb[fphys(tid) + 544 * k]; }
                idit16(xa, thA); idit16(xb, thA);
                const float bias = hb[ord * 1024 + c];
#pragma unroll
                for (int k = 0; k < 8; ++k) { y[0][k] = bf1(xg[0][k]) * (xa[k].x + bias * y[0][k]); y[1][k] = bf1(xg[1][k]) * (xa[k].y + bias * y[1][k]);
                    y[2][k] = bf1(xg[2][k]) * (xb[k].x + bias * y[2][k]); y[3][k] = bf1(xg[3][k]) * (xb[k].y + bias * y[3][k]); } }
        }
#pragma unroll
        for (int b = 0; b < 4; ++b) { bf16* o0 = YT + ((size_t)b * 1024 + c) * SEQ;
#pragma unroll
            for (int i = 0; i < 8; ++i) o0[tid + 512 * i] = (bf16)f2bf(y[b][i]); }
    }
#undef HF_PTR
    (void)bstr;
}
__device__ __forceinline__ void ph_scan(const Args& A, int l, int tid) {
    float* KV = (float*)(wsb() + WS_KV);
    for (int gt = blockIdx.x * 512 + tid; gt < NB * 8 * 2 * 2048; gt += gridDim.x * 512) {
        const int bhd = gt >> 11, e4 = gt & 2047, dir = bhd & 1, h = (bhd >> 1) & 7;
        const float gC = ex2(inp(I_RDEC)[(l * 2 + dir) * 8 + h] * LOG2E * 128.0f);
        f32x4* base = (f32x4*)(KV + (size_t)bhd * 34 * 8192) + e4;
        f32x4 s = (f32x4){0.f, 0.f, 0.f, 0.f};
#pragma unroll 1
        for (int sb8 = 0; sb8 < 34; sb8 += 8) {
            f32x4 tv[8];
#pragma unroll
            for (int k = 0; k < 8; ++k) { const int step = min(sb8 + k, 33); const int ci = (dir == 0) ? step : (step == 0 ? 1 : (step == 1 ? 0 : 35 - step)); tv[k] = base[(size_t)ci * 2048]; }
#pragma unroll
            for (int k = 0; k < 8; ++k) { const int step = sb8 + k; if (step < 34) { const int ci = (dir == 0) ? step : (step == 0 ? 1 : (step == 1 ? 0 : 35 - step)); base[(size_t)ci * 2048] = s; s = s * gC + tv[k]; } } }
    }
}

__device__ __forceinline__ void ph_hypost(const Args& A, LAS unsigned char* lds, int tid) {
    LAS bf16* T = (LAS bf16*)lds;
    const bf16* YT = (const bf16*)(wsb() + WS_YT); bf16* YS = (bf16*)(wsb() + WS_YS);
    for (int u = blockIdx.x; u < 1024; u += gridDim.x) {
        const int cg = u & 3, tt = (u >> 2) & 63, b = u >> 8;
        __syncthreads();
        for (int q = tid; q < 2048; q += 512) { const int c = q >> 3, t8 = q & 7;
            *(LAS v4u*)(T + c * 72 + t8 * 8) = *(const v4u*)(YT + ((size_t)b * 1024 + cg * 256 + c) * SEQ + tt * 64 + t8 * 8); }
        __syncthreads();
        const int t = tid >> 3, c32 = tid & 7;
#pragma unroll
        for (int q = 0; q < 4; ++q) { const int cb = c32 * 32 + q * 8; v4u w;
            w.x = (unsigned)T[(cb + 0) * 72 + t] | ((unsigned)T[(cb + 1) * 72 + t] << 16); w.y = (unsigned)T[(cb + 2) * 72 + t] | ((unsigned)T[(cb + 3) * 72 + t] << 16);
            w.z = (unsigned)T[(cb + 4) * 72 + t] | ((unsigned)T[(cb + 5) * 72 + t] << 16); w.w = (unsigned)T[(cb + 6) * 72 + t] | ((unsigned)T[(cb + 7) * 72 + t] << 16);
            *(v4u*)(YS + (size_t)(b * SEQ + tt * 64 + t) * 1024 + cg * 256 + cb) = w; }
    }
}
__device__ __forceinline__ void ph_ret3(const Args& A, int l, int nctx_units, LAS unsigned char* lds, int tid) {
    LAS bf16* Qs = (LAS bf16*)lds; LAS bf16* Ks = Qs + 128 * 72; LAS bf16* Vs = Ks + 128 * 72; LAS bf16* Sf = Vs + 128 * 144; LAS bf16* Sb = Sf + 128 * 72;
    const bf16* Z = (const bf16*)(wsb() + WS_Z); const float* KV = (const float*)(wsb() + WS_KV); const f32x2* rope = (const f32x2*)(wsb() + WS_ROPE);
    bf16* YS = (bf16*)(wsb() + WS_YS) + (size_t)MT * 1024;
    const int lane = tid & 63, w = tid >> 6, g = lane >> 4, li = lane & 15;
    const int tok = tid >> 2, pp = tid & 3, a = (pp & 1) + ((pp >> 1) << 2);
    const int nunits = 1024 + nctx_units;
    v4u pk[2], pv[4];
#define R3_LOAD(uid_) do { R1_DEC(uid_, b2, h2, n2, ci2, m02, isc2) (void)n2; (void)isc2; const bf16* qr = Z + (m02 + tok) * INW + C_RQ + h2 * 64; const bf16* kr = Z + (m02 + tok) * INW + C_RK + h2 * 64; \
        (void)qr; pk[0] = *(const v4u*)(kr + 8 * a); pk[1] = *(const v4u*)(kr + 8 * a + 16); \
        (void)ci2; _Pragma("unroll") for (int e = 0; e < 4; ++e) { const int q = tid + 512 * e; pv[e] = *(const v4u*)(Z + (m02 + (q >> 4)) * INW + C_RV + h2 * 128 + (q & 15) * 8); } } while (0)
    int uid = blockIdx.x;
    if (uid < nunits) R3_LOAD(uid);
    for (; uid < nunits; uid += gridDim.x) {
        R1_DEC(uid, b, h, n, ci, m0, isc)
        const float lgf = inp(I_RDEC)[(l * 2 + 0) * 8 + h] * LOG2E, lgb = inp(I_RDEC)[(l * 2 + 1) * 8 + h] * LOG2E;
        __syncthreads();
        { const int t = n * 128 + tok; const int pos = (a < 4) ? (t >> 6) : (t & 63); const f32x2* rt = rope + pos * 16 + 8 * (a & 1);
            float lo[8], hi[8];
            { const bf16* qr = Z + (m0 + tok) * INW + C_RQ + h * 64; unpack8(*(const v4u*)(qr + 8 * a), lo); unpack8(*(const v4u*)(qr + 8 * a + 16), hi); }
            if (!isc) rope8(lo, hi, rt);
            *(LAS v4u*)(Qs + tok * 72 + 8 * a) = pack8(lo); *(LAS v4u*)(Qs + tok * 72 + 8 * a + 16) = pack8(hi);
            unpack8(pk[0], lo); unpack8(pk[1], hi);
            if (!isc) rope8(lo, hi, rt);
#pragma unroll
            for (int e = 0; e < 8; ++e) { lo[e] *= 0.125f; hi[e] *= 0.125f; }
            *(LAS v4u*)(Ks + tok * 72 + 8 * a) = pack8(lo); *(LAS v4u*)(Ks + tok * 72 + 8 * a + 16) = pack8(hi); }
#pragma unroll
        for (int e = 0; e < 4; ++e) { const int q = tid + 512 * e; *(LAS v4u*)(Vs + (q >> 4) * 144 + (q & 15) * 8) = pv[e]; }
#pragma unroll
        for (int dir = 0; dir < 2; ++dir) { LAS bf16* S = dir ? Sb : Sf; const f32x4* src = (const f32x4*)(KV + ((size_t)((b * 8 + h) * 2 + dir) * 34 + ci) * 8192);
#pragma unroll
            for (int e = 0; e < 4; ++e) { const int q = tid + 512 * e; const f32x4 v = src[q]; v2u wv; wv.x = pk2(v.x, v.y); wv.y = pk2(v.z, v.w); *(LAS v2u*)(S + (q >> 4) * 72 + (q & 15) * 4) = wv; } }
        __syncthreads();
        if (uid + (int)gridDim.x < nunits) R3_LOAD(uid + (int)gridDim.x);
        const int iq = 16 * w + li; const size_t mrow = m0 + iq;
        bf16x8 qf[2];
#pragma unroll
        for (int ks = 0; ks < 2; ++ks) qf[ks] = *(const LAS bf16x8*)(Qs + iq * 72 + 32 * ks + 8 * g);
        f32x4 s[8];
#pragma unroll
        for (int nn = 0; nn < 8; ++nn) { s[nn] = (f32x4){0.f, 0.f, 0.f, 0.f};
#pragma unroll
            for (int ks = 0; ks < 2; ++ks) s[nn] = mfma16(*(const LAS bf16x8*)(Ks + (16 * nn + li) * 72 + 32 * ks + 8 * g), qf[ks], s[nn]);
#pragma unroll
            for (int j = 0; j < 4; ++j) { const int d = iq - (16 * nn + 4 * g + j); s[nn][j] *= (d >= 0) ? ex2(lgf * (float)d) : ex2(lgb * (float)(-d)); } }
        f32x4 o[8];
#pragma unroll
        for (int nd = 0; nd < 8; ++nd) o[nd] = (f32x4){0.f, 0.f, 0.f, 0.f};
#pragma unroll
        for (int kk = 0; kk < 4; ++kk) {
            const bf16x8 pf = mk8(pk2(s[2 * kk][0], s[2 * kk][1]), pk2(s[2 * kk][2], s[2 * kk][3]), pk2(s[2 * kk + 1][0], s[2 * kk + 1][1]), pk2(s[2 * kk + 1][2], s[2 * kk + 1][3]));
#pragma unroll
            for (int nd = 0; nd < 8; ++nd) o[nd] = mfma16(tr_frag(Vs, 144, 32 * kk + 4 * g, 32 * kk + 16 + 4 * g, 16 * nd, li), pf, o[nd]); }
        v2u gq[8];
#pragma unroll
        for (int nd = 0; nd < 8; ++nd) gq[nd] = *(const v2u*)(Z + mrow * INW + C_RG + h * 128 + 16 * nd + 4 * g);
        const float xif = ex2(lgf * (float)(iq + 1)), xib = ex2(lgb * (float)(128 - iq));
        float ss = 0.f;
#pragma unroll
        for (int nd = 0; nd < 8; ++nd) { f32x4 tf = (f32x4){0.f, 0.f, 0.f, 0.f}, tb = (f32x4){0.f, 0.f, 0.f, 0.f};
#pragma unroll
            for (int ks = 0; ks < 2; ++ks) { tf = mfma16(*(const LAS bf16x8*)(Sf + (16 * nd + li) * 72 + 32 * ks + 8 * g), qf[ks], tf);
                tb = mfma16(*(const LAS bf16x8*)(Sb + (16 * nd + li) * 72 + 32 * ks + 8 * g), qf[ks], tb); }
            o[nd] = o[nd] + tf * xif + tb * xib;
            ss += (o[nd][0] * o[nd][0] + o[nd][1] * o[nd][1]) + (o[nd][2] * o[nd][2] + o[nd][3] * o[nd][3]); }
        ss += __shfl_xor(ss, 16); ss += __shfl_xor(ss, 32);
        const float rn = 1.0f / sqrtf(ss * (1.0f / 128.0f) + EPS);
#pragma unroll
        for (int nd = 0; nd < 8; ++nd) { const int dv = 16 * nd + 4 * g; const v2u gv = gq[nd];
            const float g0 = bflo(gv.x), g1 = bfhi(gv.x), g2 = bflo(gv.y), g3 = bfhi(gv.y);
            v2u wv; wv.x = pk2(g0 * __builtin_amdgcn_rcpf(1.0f + __expf(-g0)) * o[nd][0] * rn, g1 * __builtin_amdgcn_rcpf(1.0f + __expf(-g1)) * o[nd][1] * rn);
            wv.y = pk2(g2 * __builtin_amdgcn_rcpf(1.0f + __expf(-g2)) * o[nd][2] * rn, g3 * __builtin_amdgcn_rcpf(1.0f + __expf(-g3)) * o[nd][3] * rn);
            *(v2u*)(YS + mrow * 1024 + h * 128 + dv) = wv; }
    }
#undef R3_LOAD
#undef R1_DEC
}

__device__ __forceinline__ float gelu_fx(float x) { const float x2 = x * x; const float arg = x * (x2 * (-2.0f * 1.4426950408889634f * 0.7978845608028654f * 0.044715f) + (-2.0f * 1.4426950408889634f * 0.7978845608028654f));
    return x * __builtin_amdgcn_rcpf(1.0f + __builtin_amdgcn_exp2f(arg)); }
__device__ __forceinline__ void ph_ffnfix(const Args& A, int l, int Mrows, int tid) {
    const bf16* SA = (const bf16*)(wsb() + WS_SA); const bf16* SB = (const bf16*)(wsb() + WS_SB); bf16* U = (bf16*)(wsb() + WS_U);
    const float* cw = inp(I_FFCW) + (size_t)l * 3 * DFF; const float* cb = inp(I_FFCB) + (size_t)l * DFF;
    const int nblk = Mrows / 64;
    for (int u = blockIdx.x; u < nblk * 2; u += gridDim.x) {
        const int blk = u >> 1, hi = u & 1, R = blk * 64 + (hi ? 63 : 0);
        const bool seq_first = (R < ML) ? ((R & (SEQ - 1)) == 0) : ((R & (CL - 1)) == 0), seq_last = (R < ML) ? ((R & (SEQ - 1)) == SEQ - 1) : ((R & (CL - 1)) == CL - 1);
        const bf16* pprev = hi ? SA + ((size_t)blk * 4 + 2) * DFF : SA + ((size_t)(blk - 1) * 4 + 3) * DFF;
        const bf16* pcur = SA + ((size_t)blk * 4 + (hi ? 3 : 0)) * DFF;
        const bf16* pnext = hi ? SA + ((size_t)(blk + 1) * 4 + 0) * DFF : SA + ((size_t)blk * 4 + 1) * DFF;
        const bf16* pb = SB + ((size_t)blk * 2 + hi) * DFF;
        const bool zp = (!hi && seq_first), zn = (hi && seq_last);
        for (int q = tid; q < DFF / 8; q += 512) { const int f = q * 8;
            float am[8], a0[8], aq[8], bg[8]; const v4u z4 = (v4u){0u, 0u, 0u, 0u};
            unpack8(zp ? z4 : *(const v4u*)(pprev + f), am); unpack8(*(const v4u*)(pcur + f), a0); unpack8(zn ? z4 : *(const v4u*)(pnext + f), aq); unpack8(*(const v4u*)(pb + f), bg);
            float r[8];
#pragma unroll
            for (int e = 0; e < 8; ++e) r[e] = gelu_fx(cw[f + e] * am[e] + cw[DFF + f + e] * a0[e] + cw[2 * DFF + f + e] * aq[e] + cb[f + e]) * bg[e];
            *(v4u*)(U + (size_t)R * DFF + f) = pack8(r); }
    }
}
__device__ __forceinline__ void ph_final(const Args& A, int wave, int lane) {
    const int gw = blockIdx.x * NWAVES + wave, NGW = gridDim.x * NWAVES; const float* g = inp(I_GF);
    for (int m = gw; m < ML; m += NGW) { float* xr = outb() + (size_t)m * D; f32x4 v[8]; float ss = 0.f;
#pragma unroll
        for (int j = 0; j < 8; ++j) { v[j] = *(const f32x4*)(xr + (lane + 64 * j) * 4); ss += (v[j].x * v[j].x + v[j].y * v[j].y) + (v[j].z * v[j].z + v[j].w * v[j].w); }
        const float rstd = 1.0f / sqrtf(wave_sum(ss) * (1.0f / D) + EPS);
#pragma unroll
        for (int j = 0; j < 8; ++j) { const int idx = (lane + 64 * j) * 4; *(f32x4*)(xr + idx) = v[j] * rstd * *(const f32x4*)(g + idx); }
    }
}
#ifndef F_ALIGN
#define F_ALIGN PG8_ALIGN
#endif
#ifndef F_SP2
#define F_SP2 PG8_SP2
#endif
#ifndef SKEW_US
#define SKEW_US 0
#endif
__device__ __forceinline__ void spin_us(int us) { if (us > 0) { const unsigned long long t0 = __builtin_amdgcn_s_memrealtime(); while (__builtin_amdgcn_s_memrealtime() - t0 < (unsigned long long)us * 100ull) __builtin_amdgcn_s_sleep(8); } }
constexpr int FILT_F = 816, FILT_I = 896;
constexpr int BG_SPLIT = 22016;
constexpr int SEQ_PER_LAYER = 11, NSEQ = 1 + DEPTH * SEQ_PER_LAYER + 1;
__global__ void __launch_bounds__(NWAVES * 64, 2) fwd(Args A) {
    extern __shared__ __attribute__((aligned(16))) unsigned char lds_raw[];
    LAS unsigned char* lds = (LAS unsigned char*)lds_raw;
    volatile LAS unsigned* MISC = (volatile LAS unsigned*)(lds + MISC_OFF);
    for (int u = threadIdx.x; u < (LDS_BYTES - LDSCTL_OFF) / 4; u += NWAVES * 64) ((LAS unsigned*)(lds + LDSCTL_OFF))[u] = 0u;
    __syncthreads();
    (void)xcd_barrier_post((unsigned*)(wsb() + WS_CTL) + CW_BAR, MISC + 8);
    const int lo = A.seq_lo, hi = A.seq_hi;
#ifdef PROBE_K
    volatile LAS unsigned long long* pr_ = (volatile LAS unsigned long long*)(lds + MISC_OFF + 128);
    if (threadIdx.x == 0) { pr_[0] = 0ull; pr_[1] = __builtin_amdgcn_s_memrealtime(); }
#define pr_acc pr_[0]
#define pr_prev pr_[1]
#endif
#define G ((int)gridDim.x)
#ifdef PROBE_SUB
#define PROBE_K 999
#define SUBT(n, stmt) do { unsigned long long t0_ = 0; if ((n) == PROBE_SUB && blockIdx.x == PROBE_WG && threadIdx.x == 0) t0_ = __builtin_amdgcn_s_memrealtime(); stmt; if ((n) == PROBE_SUB && blockIdx.x == PROBE_WG && threadIdx.x == 0) pr_acc += __builtin_amdgcn_s_memrealtime() - t0_; } while (0)
#else
#define SUBT(n, stmt) do { stmt; } while (0)
#endif
#ifdef PROBE_K
#ifndef PROBE_WG
#define PROBE_WG 0
#endif
#ifndef PROBE_WAIT
#define PROBE_WAIT 0
#endif
#define PROBE_PH(s) (((s) == 0) ? 100 : (((s) - 1) % SEQ_PER_LAYER))
#define PROBE_ARRIVE(s) do { if (blockIdx.x == PROBE_WG && threadIdx.x == 0) { const unsigned long long now_ = __builtin_amdgcn_s_memrealtime(); if (!PROBE_WAIT && PROBE_PH(s) == PROBE_K) pr_acc += now_ - pr_prev; pr_prev = now_; } } while (0)
#define PROBE_EXIT(s) do { if (blockIdx.x == PROBE_WG && threadIdx.x == 0) { const unsigned long long now_ = __builtin_amdgcn_s_memrealtime(); if (PROBE_WAIT && PROBE_PH(s) == PROBE_K) pr_acc += now_ - pr_prev; pr_prev = now_; } } while (0)
#else
#define PROBE_ARRIVE(s) do { } while (0)
#define PROBE_EXIT(s) do { } while (0)
#endif
#define RUN(s) (lo <= (s) && (s) < hi)
#ifndef DUP
#define DUP 0
#endif
#define DUPN(id) ((((DUP) >> (id)) & 1) ? 2 : 1)
#define TID_HERE const int tid = otid(), lane = tid & 63, wave = __builtin_amdgcn_readfirstlane(tid >> 6); (void)lane; (void)wave
#ifdef ONLY
#define PH_ON(k) ((k) == ONLY)
#elif defined(SKIP)
#define PH_ON(k) ((k) != SKIP)
#else
#define PH_ON(k) true
#endif
#define SEAM(s) do { PROBE_ARRIVE(s); if (RUN((s) + 1)) { XcdBarrier bar_; bar_.bar = (unsigned*)(wsb() + WS_CTL) + CW_BAR; bar_.x = xb_xcc_id(); bar_.st = (volatile LAS unsigned*)(lds + MISC_OFF) + 8; xcd_barrier(bar_); if (DUPN(16) > 1) xcd_barrier(bar_); } PROBE_EXIT(s); } while (0)
#define H ((bf16*)(wsb() + WS_H))
#define Z ((bf16*)(wsb() + WS_Z))
#define ACC ((bf16*)(wsb() + WS_ACC))
#define U ((bf16*)(wsb() + WS_U))
#define YS ((bf16*)(wsb() + WS_YS))
#define XC ((float*)(wsb() + WS_XC))
#define WIN ((const bf16*)(psb(l & 1) + PS_WIN))
#define WBR ((const bf16*)(psb(l & 1) + PS_WBR))
#define WOUT ((const bf16*)(psb(l & 1) + PS_WOUT))
#define WF1 ((const bf16*)(psb(l & 1) + PS_WF1))
#define WF2 ((const bf16*)(psb(l & 1) + PS_WF2))

    if (PH_ON(100) && RUN(0)) { TID_HERE; ph_prologue(A, lds, tid); __syncthreads(); ph_convert(A, 0, 0, 0, CONV_ITEMS, (int)blockIdx.x, G, lds, wave, lane); __syncthreads(); for (int fl = 0; fl < DEPTH; ++fl) ph_filt1(A, fl, 0, (int)blockIdx.x, G, lds, tid); SEAM(0); }

    for (int l = 0; l < DEPTH; ++l) {
        const int sb = 1 + l * SEQ_PER_LAYER;
        if (hi <= sb || lo >= sb + SEQ_PER_LAYER) continue;
        const bool lastl = (l == DEPTH - 1);
        const int Mrows = lastl ? ML : MT, nctx = lastl ? 0 : 64;
#define modl ((const float*)(wsb() + WS_MOD) + (size_t)l * 5 * 12288)
#define xlat_in ((l == 0) ? inp(I_X) : (const float*)outb())
#define xctx_in ((l == 0) ? inp(I_CTX) : (const float*)XC)

        if (PH_ON(0) && RUN(sb + 0)) { TID_HERE;
            if (l == 0) ph_filt2(A, 0, 0, 0, 1024, (int)blockIdx.x, G, lds, tid);
            else ph_convert(A, l, l & 1, 0, CONV_ITEMS, (int)blockIdx.x, G, lds, wave, lane);
            ph_norm(xlat_in, xctx_in, inp(I_G1) + (size_t)l * D, modl, 0, D, H, MT, (l > 0) ? (const float*)(wsb() + WS_SLAB) : (const float*)nullptr,
                    (const float*)(wsb() + WS_MOD) + ((size_t)(l - 1) * 5 + 4) * 12288 + 5 * D, XC, wave, lane);
            SEAM(sb + 0);
        }
        if (PH_ON(1) && RUN(sb + 1)) { TID_HERE;
            if (SKEW_US > 0 && (blockIdx.x & 8)) spin_us(SKEW_US);
            { pg8::Gemm g{H, WIN, opq(MT), opq(INW), opq(D), 0}; pg8::StaticOrder S; S.init(g.M, g.N, G, (int)blockIdx.x);
              pg8::EpiStore E{Z, INW, (unsigned char*)(wsb() + WS_GQ), C_GT, 3 * D};
              for (int r_ = 0; r_ < DUPN(15); ++r_) pg8::gemm_phase<pg8::EpiStore, pg8::StaticOrder, PG8_ALIGN, PG8_SP2>(lds, g, S, E); }
            SEAM(sb + 1);
        }
        if (PH_ON(2) && RUN(sb + 2)) { TID_HERE;
            SUBT(1, ph_hyprep(A, l, lds, tid));
            SUBT(2, ph_ret1(A, l, 64, lds, tid));
            SUBT(3, ph_natt(A, l, 0, lds, tid));
            SUBT(4, if (!lastl) ph_hyctx(A, l, lds, tid));
            SEAM(sb + 2);
        }
        if (PH_ON(3) && RUN(sb + 3)) { TID_HERE;
#ifndef NO_D1
            SUBT(5, ph_hyfft(A, l, lds, tid));
#endif
#ifndef NO_D2
            SUBT(6, ph_scan(A, l, tid));
#endif
            SEAM(sb + 3);
        }
        if (PH_ON(4) && RUN(sb + 4)) { TID_HERE;
            SUBT(7, ph_hypost(A, lds, tid));
            SUBT(8, ph_ret3(A, l, nctx, lds, tid));
            if (!lastl) { __syncthreads(); ph_natt(A, l, 1, lds, tid); }
            SEAM(sb + 4);
        }
        if (PH_ON(5) && RUN(sb + 5)) { TID_HERE;
            __syncthreads();
            { pg8::Gemm g{YS, WBR, Mrows, opq(D), opq(1024), 0}; pg8::MergeOrder S; S.so.init(g.M, g.N, G, (int)blockIdx.x); S.a_stride = (long)MT * 1024 * 2; S.b_stride = (long)D * 1024 * 2;
              pg8::EpiMerge E{ACC, (const unsigned char*)(wsb() + WS_GQ), 3 * D};
              pg8::gemm_phase<pg8::EpiMerge, pg8::MergeOrder, F_ALIGN, F_SP2>(lds, g, S, E); }
            if (!lastl && blockIdx.x >= 32) { __syncthreads(); ph_filt2(A, l + 1, (l + 1) & 1, 0, FILT_F, (int)blockIdx.x - 32, G - 32, lds, tid); }
            SEAM(sb + 5);
        }
        if (PH_ON(6) && RUN(sb + 6)) { TID_HERE;
            __syncthreads();
            { pg8::Gemm g{ACC, WOUT, opq(ML), opq(D), opq(D), 0}; pg8::StaticOrder S; S.init(g.M, g.N, G, (int)blockIdx.x);
              pg8::EpiResid E{xlat_in, xctx_in, outb(), XC, modl, 2 * D};
              pg8::gemm_phase<pg8::EpiResid, pg8::StaticOrder, PG8_ALIGN, PG8_SP2>(lds, g, S, E); }
            if (!lastl) { pg8::Gemm g{ACC, WOUT, opq(MT), opq(D), opq(D / NSPLIT), opq(D)}; pg8::CtxSplitOrder S{NSPLIT, D / NSPLIT, (int)blockIdx.x};
              pg8::EpiSlab E{(float*)(wsb() + WS_SLAB), D / NSPLIT};
              pg8::gemm_phase<pg8::EpiSlab, pg8::CtxSplitOrder, PG8_ALIGN, PG8_SP2>(lds, g, S, E); }
            SEAM(sb + 6);
        }
        if (PH_ON(7) && RUN(sb + 7)) { TID_HERE;
            ph_norm(outb(), xctx_in, inp(I_G2) + (size_t)l * D, modl, 3 * D, 4 * D, H, Mrows, (const float*)(wsb() + WS_SLAB), modl + (size_t)4 * 12288 + 2 * D, XC, wave, lane);
            SEAM(sb + 7);
        }
        if (PH_ON(8) && RUN(sb + 8)) { TID_HERE;
            __syncthreads();
            if (SKEW_US > 0 && (blockIdx.x & 8)) spin_us(SKEW_US);
            pg8::Gemm g{H, WF1, Mrows, opq(NFF), opq(D), 0}; pg8::StaticOrder S; S.init(g.M, g.N, G, (int)blockIdx.x);
            pg8::EpiFfn E{U, (bf16*)(wsb() + WS_SA), (bf16*)(wsb() + WS_SB), inp(I_FFCW) + (size_t)l * 3 * DFF, inp(I_FFCB) + (size_t)l * DFF};
            for (int r_ = 0; r_ < DUPN(14); ++r_) pg8::gemm_phase<pg8::EpiFfn, pg8::StaticOrder, PG8_ALIGN, PG8_SP2>(lds, g, S, E);
            if (!lastl && blockIdx.x >= 176) { __syncthreads(); ph_filt2(A, l + 1, (l + 1) & 1, FILT_F, FILT_I, (int)blockIdx.x - 176, G - 176, lds, tid); }
            SEAM(sb + 8);
        }
        if (PH_ON(9) && RUN(sb + 9)) { TID_HERE;
            for (int r_ = 0; r_ < DUPN(11); ++r_) ph_ffnfix(A, l, Mrows, tid);
            SEAM(sb + 9);
        }
        if (PH_ON(10) && RUN(sb + 10)) { TID_HERE;
            __syncthreads();
            { pg8::Gemm g{U, WF2, opq(ML), opq(D), opq(DFF), 0}; pg8::StaticOrder S; S.init(g.M, g.N, G, (int)blockIdx.x);
              pg8::EpiResid E{outb(), XC, outb(), XC, modl, 5 * D};
              pg8::gemm_phase<pg8::EpiResid, pg8::StaticOrder, PG8_ALIGN, PG8_SP2>(lds, g, S, E); }
            if (!lastl) { pg8::Gemm g{U, WF2, opq(MT), opq(D), opq(DFF / NSPLIT), opq(DFF)}; pg8::CtxSplitOrder S{NSPLIT, DFF / NSPLIT, (int)blockIdx.x};
              pg8::EpiSlab E{(float*)(wsb() + WS_SLAB), DFF / NSPLIT};
              pg8::gemm_phase<pg8::EpiSlab, pg8::CtxSplitOrder, PG8_ALIGN, PG8_SP2>(lds, g, S, E); }
            if (!lastl && blockIdx.x >= 128) { __syncthreads(); ph_filt2(A, l + 1, (l + 1) & 1, FILT_I, 1024, (int)blockIdx.x - 128, G - 128, lds, tid); }
            SEAM(sb + 10);
        }
    }
    if (PH_ON(101) && RUN(NSEQ - 1)) { TID_HERE; ph_final(A, wave, lane); }
#ifdef PROBE_K
    if (blockIdx.x == PROBE_WG && threadIdx.x == 0) { const unsigned long long t0 = __builtin_amdgcn_s_memrealtime(); while (__builtin_amdgcn_s_memrealtime() - t0 < 4ull * pr_acc) __builtin_amdgcn_s_sleep(8); }
#endif
#undef RUN
#undef SEAM
#undef H
#undef Z
#undef ACC
#undef U
#undef YS
#undef XC
#undef WIN
#undef WBR
#undef WOUT
#undef WF1
#undef WF2
#undef G
#undef modl
#undef xlat_in
#undef xctx_in
}

extern "C" void kernel_launch(void* const* d_in, const int* in_sizes, int n_in, void* d_out, int out_size, void* d_ws, size_t ws_size, hipStream_t stream) {
    static int grid = 0;
    if (grid == 0) {
        if (n_in != 27 || out_size != ML * D || ws_size < WS_END) { fprintf(stderr, "kernel_launch: unexpected shapes (n_in %d out %d ws %zu need %zu)\n", n_in, out_size, ws_size, (size_t)WS_END); grid = -1; return; }
        int dev = 0, cus = 0, per_cu = 0;
        if (hipGetDevice(&dev) != hipSuccess || hipDeviceGetAttribute(&cus, hipDeviceAttributeMultiprocessorCount, dev) != hipSuccess) { grid = -1; return; }
        if (hipFuncSetAttribute((const void*)fwd, hipFuncAttributeMaxDynamicSharedMemorySize, LDS_BYTES) != hipSuccess) { fprintf(stderr, "kernel_launch: hipFuncSetAttribute failed\n"); grid = -1; return; }
        if (hipOccupancyMaxActiveBlocksPerMultiprocessor(&per_cu, (const void*)fwd, NWAVES * 64, LDS_BYTES) != hipSuccess || per_cu < 1) fprintf(stderr, "kernel_launch: occupancy query says %d\n", per_cu);
        (void)hipGetLastError();
        grid = cus;
    }
    if (grid < 0) return;
    (void)hipMemsetAsync((char*)d_ws + WS_CTL, 0, CTL_ZERO_BYTES, stream);
    Args a{};
    for (int i = 0; i < 27; ++i) a.in[i] = (const float*)d_in[i];
    a.out = (float*)d_out; a.ws = (unsigned char*)d_ws;
#if MK_SINGLE
    a.seq_lo = 0; a.seq_hi = NSEQ;
    hipLaunchKernelGGL(fwd, dim3(grid), dim3(NWAVES * 64), LDS_BYTES, stream, a);
#else
    for (int s = 0; s < NSEQ; ++s) { a.seq_lo = s; a.seq_hi = s + 1; hipLaunchKernelGGL(fwd, dim3(grid), dim3(NWAVES * 64), LDS_BYTES, stream, a); }
#endif
}
```
